# Optimizing an MI355X kernel written in HIP

```python
import math
import jax, jax.numpy as jnp
from jax import lax
import numpy as np

D_MODEL = 2048
BATCH = 4
SEQ = 4096
DEPTH = 2

DN_HEAD_DIM = 128
DN_HEADS = (D_MODEL // 2) // DN_HEAD_DIM
DN_WIDTH = DN_HEADS * DN_HEAD_DIM
CONV_WIDTH = 4
CHUNK = 64
POOL_WINDOWS = (2, 4, 8, 16)
POOL_GROUPS = len(POOL_WINDOWS)
POOL_WIDTH = D_MODEL - DN_WIDTH
POOL_GROUP_DIM = POOL_WIDTH // POOL_GROUPS
MIX_WIDTH = DN_WIDTH + POOL_WIDTH
IN_COLS = 4 * DN_WIDTH + 2 * DN_HEADS + POOL_WIDTH
N_EXPERTS = 16
N_GROUPS = 4
EXPERTS_PER_GROUP = N_EXPERTS // N_GROUPS
TOP_K = 2
D_EXPERT = 1024
DISPATCH_BLOCK = 128
PLE_DIM = 256
ALPHA = (2.0 * DEPTH) ** 0.25
BETA_INIT = (8.0 * DEPTH) ** -0.25
LN_EPS = 1e-5
RMS_EPS = 1e-6

kernel_name = "hybrid_deltanet_pool_groupmoe_deepnorm"


def layer_norm(x, g, b):
    xf = x.astype(jnp.float32)
    mu = jnp.mean(xf, -1, keepdims=True)
    var = jnp.mean(jnp.square(xf - mu), -1, keepdims=True)
    y = (xf - mu) * lax.rsqrt(var + LN_EPS) * g.astype(jnp.float32) + b.astype(jnp.float32)
    return y.astype(x.dtype)


def l2norm(t):
    return t * lax.rsqrt(jnp.sum(t * t, -1, keepdims=True) + RMS_EPS)


def causal_conv_silu(x, w):
    S = x.shape[1]
    xp = jnp.pad(x, ((0, 0), (CONV_WIDTH - 1, 0), (0, 0)))
    y = xp[:, 0:S] * w[0]
    for j in range(1, CONV_WIDTH):
        y = y + xp[:, j:j + S] * w[j]
    return jax.nn.silu(y)


def chunk_gated_delta_rule(q, k, v, beta, g):
    B, S, H, Dk = q.shape
    Dv = v.shape[-1]
    N = S // CHUNK

    def to_chunks(t):
        t = jnp.moveaxis(t, 2, 1)
        return t.reshape((B, H, N, CHUNK) + t.shape[3:])

    q = to_chunks(l2norm(q) * (Dk ** -0.5))
    k = to_chunks(l2norm(k))
    v = to_chunks(v)
    beta = to_chunks(beta)
    g = to_chunks(g)
    gam = jnp.cumsum(g, -1)
    ci = jnp.arange(CHUNK)
    incl = ci[:, None] >= ci[None, :]
    strict = ci[:, None] > ci[None, :]
    decay = jnp.exp(jnp.where(incl, gam[..., :, None] - gam[..., None, :], -jnp.inf))
    kb = k * beta[..., None]
    a = jnp.where(strict, jnp.einsum('bhnid,bhnjd->bhnij', kb, k) * decay, 0.0)
    lhs = a + jnp.eye(CHUNK, dtype=a.dtype)
    rhs = jnp.concatenate([v * beta[..., None], kb * jnp.exp(gam)[..., None]], -1)
    sol = lax.linalg.triangular_solve(lhs, rhs, left_side=True, lower=True, unit_diagonal=True)
    u, w = sol[..., :Dv], sol[..., Dv:]
    attn_qk = jnp.einsum('bhnid,bhnjd->bhnij', q, k) * decay
    q_dec = q * jnp.exp(gam)[..., None]
    k_dec = k * jnp.exp(gam[..., -1:] - gam)[..., None]
    chunk_decay = jnp.exp(gam[..., -1])

    def step(state, inp):
        qd, kd, wc, uc, aqk, cd = inp
        v_new = uc - jnp.einsum('bhck,bhkv->bhcv', wc, state)
        o = jnp.einsum('bhck,bhkv->bhcv', qd, state) + jnp.einsum('bhij,bhjv->bhiv', aqk, v_new)
        state = state * cd[..., None, None] + jnp.einsum('bhck,bhcv->bhkv', kd, v_new)
        return state, o

    xs = (jnp.moveaxis(q_dec, 2, 0), jnp.moveaxis(k_dec, 2, 0), jnp.moveaxis(w, 2, 0),
          jnp.moveaxis(u, 2, 0), jnp.moveaxis(attn_qk, 2, 0), jnp.moveaxis(chunk_decay, 2, 0))
    state0 = jnp.zeros((B, H, Dk, Dv), jnp.float32)
    _, o = lax.scan(step, state0, xs)
    o = jnp.moveaxis(o, 0, 2).reshape(B, H, S, Dv)
    return jnp.moveaxis(o, 1, 2)


def gated_deltanet_group(qkv_raw, z, b_raw, a_raw, conv_w, a_log, dt_bias, norm_w):
    B, S, _ = qkv_raw.shape
    qkv = causal_conv_silu(qkv_raw, conv_w).astype(jnp.float32)
    q, k, v = jnp.split(qkv, 3, axis=-1)
    q = q.reshape(B, S, DN_HEADS, DN_HEAD_DIM)
    k = k.reshape(B, S, DN_HEADS, DN_HEAD_DIM)
    v = v.reshape(B, S, DN_HEADS, DN_HEAD_DIM)
    beta = jax.nn.sigmoid(b_raw.astype(jnp.float32))
    g = -jnp.exp(a_log.astype(jnp.float32)) * jax.nn.softplus(a_raw.astype(jnp.float32) + dt_bias.astype(jnp.float32))
    o = chunk_gated_delta_rule(q, k, v, beta, g)
    o = o * lax.rsqrt(jnp.mean(o * o, -1, keepdims=True) + RMS_EPS) * norm_w.astype(jnp.float32)
    o = o * jax.nn.silu(z.astype(jnp.float32).reshape(B, S, DN_HEADS, DN_HEAD_DIM))
    return o.reshape(B, S, DN_WIDTH).astype(qkv_raw.dtype)


def multiscale_pool_group(u, w_pool, scale):
    B, S, _ = u.shape
    ug = u.astype(jnp.float32).reshape(B, S, POOL_GROUPS, POOL_GROUP_DIM)
    cs = jnp.cumsum(ug, axis=1)
    t = jnp.arange(S)
    outs = []
    for gi, win in enumerate(POOL_WINDOWS):
        csg = cs[:, :, gi]
        shifted = jnp.pad(csg[:, :S - win], ((0, 0), (win, 0), (0, 0)))
        cnt = jnp.minimum(t + 1, win).astype(jnp.float32)
        outs.append((csg - shifted) / cnt[None, :, None] - ug[:, :, gi])
    d = jnp.stack(outs, axis=2)
    y = jnp.einsum('bsgc,gcd->bsgd', d, w_pool.astype(jnp.float32))
    return (y.reshape(B, S, POOL_WIDTH) * scale.astype(jnp.float32)).astype(u.dtype)


def grouped_top2_moe(h, w_router, b_router, w_gate, w_up, w_down):
    T, D = h.shape
    TK = T * TOP_K
    logits = h.astype(jnp.float32) @ w_router.astype(jnp.float32) + b_router.astype(jnp.float32)
    probs = jax.nn.softmax(logits, -1).reshape(T, N_GROUPS, EXPERTS_PER_GROUP)
    group_score = jnp.sum(lax.top_k(probs, TOP_K)[0], -1)
    g_sel = jnp.argmax(group_score, -1)
    in_group = jnp.take_along_axis(probs, g_sel[:, None, None], axis=1)[:, 0]
    top_p, top_i = lax.top_k(in_group, TOP_K)
    expert_idx = g_sel[:, None] * EXPERTS_PER_GROUP + top_i
    gate = top_p / jnp.sum(top_p, -1, keepdims=True)

    flat_e = expert_idx.reshape(-1).astype(jnp.int32)
    flat_tok = jnp.repeat(jnp.arange(T, dtype=jnp.int32), TOP_K)
    flat_w = gate.reshape(-1)
    order = jnp.argsort(flat_e)
    se = flat_e[order]
    counts = jnp.bincount(flat_e, length=N_EXPERTS).astype(jnp.int32)
    start = jnp.cumsum(counts) - counts
    pcounts = (counts + DISPATCH_BLOCK - 1) // DISPATCH_BLOCK * DISPATCH_BLOCK
    pend = jnp.cumsum(pcounts)
    pstart = pend - pcounts
    dest = pstart[se] + jnp.arange(TK, dtype=jnp.int32) - start[se]
    n_rows = TK + N_EXPERTS * DISPATCH_BLOCK
    n_blocks = n_rows // DISPATCH_BLOCK
    src_tok = jnp.full((n_rows,), T, jnp.int32).at[dest].set(flat_tok[order])
    src_w = jnp.zeros((n_rows,), jnp.float32).at[dest].set(flat_w[order])
    block_start = jnp.arange(n_blocks, dtype=jnp.int32) * DISPATCH_BLOCK
    block_e = jnp.minimum(jnp.searchsorted(pend, block_start, side='right'), N_EXPERTS - 1)

    h_pad = jnp.concatenate([h, jnp.zeros((1, D), h.dtype)], 0)
    x_rows = h_pad[src_tok].reshape(n_blocks, DISPATCH_BLOCK, D)

    def expert_rows(args):
        xb, e = args
        hid = jax.nn.silu(xb @ w_gate[e]) * (xb @ w_up[e])
        return hid @ w_down[e]

    y_rows = lax.map(expert_rows, (x_rows, block_e)).reshape(n_rows, D)
    y_rows = y_rows * src_w[:, None].astype(y_rows.dtype)
    out = jax.ops.segment_sum(y_rows, src_tok, num_segments=T + 1)
    return out[:T]


def setup_inputs(seed: int = 0) -> dict:
    key = jax.random.key(seed)
    ks = jax.random.split(key, 24)
    f32 = jnp.float32
    nrm = lambda k, shape: jax.random.normal(k, shape, f32)
    dt = jnp.exp(jax.random.uniform(ks[5], (DEPTH, DN_HEADS), f32, math.log(1e-3), math.log(1e-1)))
    return {
        "x": nrm(ks[0], (BATCH, SEQ, D_MODEL)),
        "p": nrm(ks[1], (DEPTH, BATCH, SEQ, PLE_DIM)),
        "w_in": nrm(ks[2], (DEPTH, D_MODEL, IN_COLS)) * D_MODEL ** -0.5,
        "conv_w": nrm(ks[3], (DEPTH, CONV_WIDTH, 3 * DN_WIDTH)) * CONV_WIDTH ** -0.5,
        "a_log": jnp.log(jax.random.uniform(ks[4], (DEPTH, DN_HEADS), f32, 1.0, 16.0)),
        "dt_bias": dt + jnp.log(-jnp.expm1(-dt)),
        "dn_norm_w": 1.0 + 0.02 * nrm(ks[6], (DEPTH, DN_HEAD_DIM)),
        "pool_w": nrm(ks[7], (DEPTH, POOL_GROUPS, POOL_GROUP_DIM, POOL_GROUP_DIM)) * POOL_GROUP_DIM ** -0.5,
        "pool_scale": 1.0 + 0.1 * nrm(ks[8], (DEPTH, POOL_WIDTH)),
        "w_out": nrm(ks[9], (DEPTH, MIX_WIDTH, D_MODEL)) * (MIX_WIDTH ** -0.5 * BETA_INIT),
        "ln1_g": 1.0 + 0.02 * nrm(ks[10], (DEPTH, D_MODEL)),
        "ln1_b": 0.02 * nrm(ks[11], (DEPTH, D_MODEL)),
        "w_router": nrm(ks[12], (D_MODEL, N_EXPERTS)) * D_MODEL ** -0.5,
        "b_router": 0.01 * nrm(ks[13], (N_EXPERTS,)),
        "w_e_gate": nrm(ks[14], (DEPTH, N_EXPERTS, D_MODEL, D_EXPERT)) * D_MODEL ** -0.5,
        "w_e_up": nrm(ks[15], (DEPTH, N_EXPERTS, D_MODEL, D_EXPERT)) * D_MODEL ** -0.5,
        "w_e_down": nrm(ks[16], (DEPTH, N_EXPERTS, D_EXPERT, D_MODEL)) * (D_EXPERT ** -0.5 * BETA_INIT),
        "ln2_g": 1.0 + 0.02 * nrm(ks[17], (DEPTH, D_MODEL)),
        "ln2_b": 0.02 * nrm(ks[18], (DEPTH, D_MODEL)),
        "w_ple_proj": nrm(ks[19], (DEPTH, PLE_DIM, D_MODEL)) * (PLE_DIM ** -0.5 * BETA_INIT),
        "w_ple_gate": nrm(ks[20], (DEPTH, D_MODEL, D_MODEL)) * D_MODEL ** -0.5,
    }


def reference(x, p, w_in, conv_w, a_log, dt_bias, dn_norm_w, pool_w, pool_scale, w_out,
              ln1_g, ln1_b, w_router, b_router, w_e_gate, w_e_up, w_e_down, ln2_g, ln2_b,
              w_ple_proj, w_ple_gate):
    B, S, D = x.shape
    splits = [3 * DN_WIDTH, 4 * DN_WIDTH, 4 * DN_WIDTH + DN_HEADS, 4 * DN_WIDTH + 2 * DN_HEADS]
    for i in range(DEPTH):
        proj = x @ w_in[i]
        qkv_raw, z, b_raw, a_raw, u = jnp.split(proj, splits, axis=-1)
        y_dn = gated_deltanet_group(qkv_raw, z, b_raw, a_raw, conv_w[i], a_log[i], dt_bias[i], dn_norm_w[i])
        y_pool = multiscale_pool_group(u, pool_w[i], pool_scale[i])
        mix = jnp.concatenate([y_dn, y_pool], -1) @ w_out[i]
        x = layer_norm(ALPHA * x + mix, ln1_g[i], ln1_b[i])
        ffn = grouped_top2_moe(x.reshape(B * S, D), w_router, b_router,
                               w_e_gate[i], w_e_up[i], w_e_down[i]).reshape(B, S, D)
        x = layer_norm(ALPHA * x + ffn, ln2_g[i], ln2_b[i])
        x = x + jax.nn.sigmoid(x @ w_ple_gate[i]) * (p[i] @ w_ple_proj[i])
    return x
```

```cpp
#define MK_N_LAUNCHES 21
#include <hip/hip_runtime.h>
#include <cstdio>
#include <cstdint>

#define GAS __attribute__((address_space(1)))
#define LAS __attribute__((address_space(3)))
typedef unsigned short bf16;
typedef unsigned v4u __attribute__((ext_vector_type(4)));
typedef unsigned v2u __attribute__((ext_vector_type(2)));
typedef float f32x4 __attribute__((ext_vector_type(4)));
typedef float f32x2 __attribute__((ext_vector_type(2)));
typedef short bf16x8 __attribute__((ext_vector_type(8)));
typedef GAS unsigned gu32;

namespace pg8 {
constexpr int BM = 256, BK = 64, HALF = 128, HTB = HALF * BK * 2  , STAGE_BYTES = 8 * HTB, NXCD = 8, WGM = 8;
__host__ __device__ __forceinline__ int lds_byte(int r, int c) { const int st = (r >> 4) * 2 + (c >> 5), rr = r & 15, cc = c & 31, ob = rr * 64 + cc * 2; return st * 1024 + (ob ^ (((ob >> 9) & 1) << 5)); }
__host__ __device__ __forceinline__ void stage_rc(int b, int& R, int& C) { const int st = b / 1024, sb = b % 1024, swz = sb ^ (((sb >> 9) & 1) << 5); R = (st >> 1) * 16 + swz / 64; C = (st & 1) * 32 + (swz % 64) / 2; }
__host__ __device__ __forceinline__ int perm32(int rho) { const int n = rho >> 4, i = rho & 15; return 8 * (i >> 2) + 4 * n + (i & 3); }

struct Unit { int pm, pn; const char* A; const char* B; const int* rows; int nvalid; int aux; };

__device__ __forceinline__ unsigned cvt_pk_bf16(float lo, float hi) { unsigned r; asm volatile("v_cvt_pk_bf16_f32 %0, %1, %2" : "=v"(r) : "v"(lo), "v"(hi)); return r; }

template <class Epi, class Sched, bool GATHER>
__device__ __forceinline__ void gemm_phase(LAS unsigned char* lds, const int K, const int lda, const int ldb, const Sched& S, const Epi& E) {
    int tid_ = threadIdx.x; asm volatile("" : "+v"(tid_));
    const int tid = tid_, wid = __builtin_amdgcn_readfirstlane(tid >> 6), lane = tid & 63, wr = wid >> 2, wc = wid & 3, fr = lane & 15, fq = lane >> 4;
    const int nt = K / BK;
    unsigned voffA[2], voffB[2]; int RA[2], CA[2];
#pragma unroll
    for (int i = 0; i < 2; ++i) { int R, C; stage_rc(tid * 16 + i * 8192, R, C); const int Rb = Epi::PERM ? ((R & ~31) + perm32(R & 31)) : R;
        RA[i] = R; CA[i] = C; voffA[i] = (unsigned)(R * lda + C) * 2u; voffB[i] = (unsigned)(Rb * ldb + C) * 2u; }
    unsigned gA[2][2], gN[2][2];
    const size_t kstep = (size_t)(BK * 2);
    const size_t hstepA = GATHER ? 0 : (size_t)HALF * lda * 2, hstepB = (size_t)HALF * ldb * 2;
    const unsigned ldsw = (unsigned)wid * 1024u;
    const int aoff = lds_byte(wr * 64 + fr, fq * 8), boff = lds_byte(wc * 32 + fr, fq * 8);
#define PG8_SA(b, h) (((b) * 2 + (h)) * HTB)
#define PG8_SB(b, h) ((4 + (b) * 2 + (h)) * HTB)
#define PG8_STAGE_B(bufoff, gbase) do { _Pragma("unroll") for (int _i = 0; _i < 2; ++_i) \
        __builtin_amdgcn_global_load_lds((const unsigned*)((const char*)(gbase) + voffB[_i]), (LAS unsigned*)(lds + (bufoff) + ldsw + _i * 8192), 16, 0, 0); } while (0)
#define PG8_STAGE_A(bufoff, gbase, h) do { _Pragma("unroll") for (int _i = 0; _i < 2; ++_i) \
        __builtin_amdgcn_global_load_lds((const unsigned*)((const char*)(gbase) + (GATHER ? gA[h][_i] : voffA[_i]) + (h) * hstepA), (LAS unsigned*)(lds + (bufoff) + ldsw + _i * 8192), 16, 0, 0); } while (0)
#define PG8_LDA(dst, b, h) do { _Pragma("unroll") for (int m = 0; m < 4; ++m) _Pragma("unroll") for (int k = 0; k < 2; ++k) dst[m][k] = *(const LAS bf16x8*)(lds + PG8_SA(b, h) + aoff + m * 2048 + k * 1024); } while (0)
#define PG8_LDB(dst, b, h) do { _Pragma("unroll") for (int n = 0; n < 2; ++n) _Pragma("unroll") for (int k = 0; k < 2; ++k) dst[n][k] = *(const LAS bf16x8*)(lds + PG8_SB(b, h) + boff + n * 2048 + k * 1024); } while (0)
#define PG8_MMA(ai, bj, At, Bt) do { __builtin_amdgcn_s_setprio(1); _Pragma("unroll") for (int m = 0; m < 4; ++m) _Pragma("unroll") for (int n = 0; n < 2; ++n) _Pragma("unroll") for (int k = 0; k < 2; ++k) \
        acc[ai][bj][m][n] = __builtin_amdgcn_mfma_f32_16x16x32_bf16(Bt[n][k], At[m][k], acc[ai][bj][m][n], 0, 0, 0); __builtin_amdgcn_s_setprio(0); } while (0)
#define PG8_WAIT_V(n) asm volatile("s_waitcnt vmcnt(" #n ")" ::: "memory")
#define PG8_WAIT_L(n) asm volatile("s_waitcnt lgkmcnt(" #n ")" ::: "memory")
#define PG8_BAR __builtin_amdgcn_s_barrier()
#define PG8_SCHED __builtin_amdgcn_sched_barrier(0)
#define PG8_GLOAD(dst, u) do { _Pragma("unroll") for (int _h = 0; _h < 2; ++_h) _Pragma("unroll") for (int _i = 0; _i < 2; ++_i) { const int _r = _h * HALF + RA[_i]; \
        const int _t = (_r < (u).nvalid) ? (u).rows[_r] : 0; dst[_h][_i] = (unsigned)(_t * lda + CA[_i]) * 2u; } } while (0)
    Unit cur, nxt; int ui = 0;
    if (!S.next(0, cur)) return;
    f32x4 acc[2][2][4][2];
#pragma unroll
    for (int a = 0; a < 2; ++a)
#pragma unroll
        for (int b = 0; b < 2; ++b)
#pragma unroll
            for (int m = 0; m < 4; ++m)
#pragma unroll
                for (int n = 0; n < 2; ++n) acc[a][b][m][n] = (f32x4){0.f, 0.f, 0.f, 0.f};
    bf16x8 At[4][2], B0[2][2], B1[2][2];
    const char* cA = cur.A; const char* cB = cur.B;
    if constexpr (GATHER) { PG8_GLOAD(gA, cur); PG8_WAIT_V(0); }
    PG8_STAGE_B(PG8_SB(0, 0), cB); PG8_STAGE_B(PG8_SB(0, 1), cB + hstepB); PG8_STAGE_A(PG8_SA(0, 0), cA, 0); PG8_STAGE_A(PG8_SA(0, 1), cA, 1);
    if (wr == 1) PG8_BAR;
    PG8_WAIT_V(2); PG8_BAR;
    PG8_STAGE_B(PG8_SB(1, 0), cB + kstep); PG8_STAGE_A(PG8_SA(1, 0), cA + kstep, 0); PG8_STAGE_B(PG8_SB(1, 1), cB + hstepB + kstep);
    PG8_WAIT_V(6); PG8_BAR;
    for (;;) {
        const bool has_next = S.next(ui + 1, nxt);
        const char* nA = has_next ? nxt.A : cA; const char* nB = has_next ? nxt.B : cB;
        if constexpr (GATHER) { if (has_next) { PG8_GLOAD(gN, nxt); } else {
#pragma unroll
            for (int h = 0; h < 2; ++h)
#pragma unroll
                for (int i = 0; i < 2; ++i) gN[h][i] = gA[h][i]; } }
#pragma unroll 1
        for (int t = 0; t < nt; t += 2) {
            const bool last = (t == nt - 2);
            const char* a1 = cA + (size_t)(t + 1) * kstep;
            const char* a2 = last ? nA : cA + (size_t)(t + 2) * kstep; const char* b2 = last ? nB : cB + (size_t)(t + 2) * kstep;
            const char* a3 = a2 + kstep; const char* b3 = b2 + kstep;
            PG8_LDB(B0, 0, 0); PG8_LDB(B1, 0, 1); PG8_SCHED; PG8_LDA(At, 0, 0); PG8_STAGE_A(PG8_SA(1, 1), a1, 1);
            if constexpr (GATHER) { if (last) {
#pragma unroll
                for (int h = 0; h < 2; ++h)
#pragma unroll
                    for (int i = 0; i < 2; ++i) gA[h][i] = gN[h][i]; } }
            PG8_WAIT_V(8); PG8_WAIT_L(0); PG8_BAR; PG8_MMA(0, 0, At, B0); PG8_MMA(0, 1, At, B1); PG8_BAR; PG8_SCHED;
            PG8_LDA(At, 0, 1); PG8_STAGE_B(PG8_SB(0, 0), b2); PG8_STAGE_B(PG8_SB(0, 1), b2 + hstepB); PG8_STAGE_A(PG8_SA(0, 0), a2, 0);
            PG8_WAIT_V(8); PG8_WAIT_L(0); PG8_BAR; PG8_MMA(1, 0, At, B0); PG8_MMA(1, 1, At, B1); PG8_BAR; PG8_SCHED;
            PG8_LDB(B0, 1, 0); PG8_LDB(B1, 1, 1); PG8_SCHED; PG8_LDA(At, 1, 0); PG8_STAGE_A(PG8_SA(0, 1), a2, 1);
            PG8_WAIT_V(8); PG8_WAIT_L(0); PG8_BAR; PG8_MMA(0, 0, At, B0); PG8_MMA(0, 1, At, B1); PG8_BAR; PG8_SCHED;
            PG8_LDA(At, 1, 1); PG8_STAGE_B(PG8_SB(1, 0), b3); PG8_STAGE_B(PG8_SB(1, 1), b3 + hstepB); PG8_STAGE_A(PG8_SA(1, 0), a3, 0);
            PG8_WAIT_V(8); PG8_WAIT_L(0); PG8_BAR; PG8_MMA(1, 0, At, B0); PG8_MMA(1, 1, At, B1); PG8_BAR; PG8_SCHED;
        }
        if (wr == 0) PG8_BAR;
        E(acc, cur, wr, wc, fr, fq);
        if (!has_next) break;
#pragma unroll
        for (int a = 0; a < 2; ++a)
#pragma unroll
            for (int b = 0; b < 2; ++b)
#pragma unroll
                for (int m = 0; m < 4; ++m)
#pragma unroll
                    for (int n = 0; n < 2; ++n) acc[a][b][m][n] = (f32x4){0.f, 0.f, 0.f, 0.f};
        cur = nxt; cA = nA; cB = nB; ++ui;
        if (wr == 1) PG8_BAR;
    }
    PG8_WAIT_V(0);
    PG8_BAR;
#undef PG8_SA
#undef PG8_SB
#undef PG8_STAGE_A
#undef PG8_STAGE_B
#undef PG8_LDA
#undef PG8_LDB
#undef PG8_MMA
#undef PG8_WAIT_V
#undef PG8_WAIT_L
#undef PG8_BAR
#undef PG8_SCHED
#undef PG8_GLOAD
}
}

constexpr int NB = 4, SEQ = 4096, D = 2048, DEPTH = 2;
constexpr int T = NB * SEQ;
constexpr int NH = 8, HD = 128, DNW = 1024, CH = 64, NCH = SEQ / CH;
constexpr int PW = 1024, PG_DIM = 256;
constexpr int IN_COLS = 5136, NPROJ = 5120;
constexpr int NE = 16, DE = 1024, PLE = 256;
constexpr float ALPHA = 1.4142135623730951f;
constexpr float LN_EPS = 1e-5f, RMS_EPS = 1e-6f;
constexpr int LCAP = T;
constexpr int MAXTILES = 2 * T / 256 + NE;

constexpr size_t MiB = 1u << 20;
constexpr size_t WS_CTL = 0, CTL_ZERO_BYTES = 64 * 1024;
constexpr size_t WS_LIST = 2 * MiB;
constexpr size_t WS_TOKSLOT = 3 * MiB, WS_GATEW = WS_TOKSLOT + 128 * 1024, WS_STATS = WS_GATEW + 128 * 1024, WS_CD = WS_STATS + 128 * 1024, WS_WBA = WS_CD + 128 * 1024;
constexpr size_t WS_WIN = 4 * MiB, WS_WOUT = 44 * MiB, WS_WPG = 60 * MiB, WS_WPP = 76 * MiB, WS_WPOOL = 78 * MiB, WS_WGU = 80 * MiB, WS_WD = 336 * MiB, WS_PB16 = 464 * MiB;
constexpr size_t WS_XB = 480 * MiB, WS_R1 = 544 * MiB, WS_R2 = 704 * MiB, WS_R4 = 848 * MiB, WS_R5 = 944 * MiB, WS_END = 1008 * MiB;
constexpr size_t WS_PROJ = WS_R1, WS_HID = WS_R1;
constexpr size_t WS_U = WS_R2, WS_W = WS_R2 + 32 * MiB, WS_QD = WS_R2 + 64 * MiB, WS_KD = WS_R2 + 96 * MiB, WS_AQK = WS_R2 + 128 * MiB, WS_Y = WS_R2;
constexpr size_t WS_POOLD = WS_R4, WS_O = WS_R4 + 32 * MiB, WS_X1B = WS_R4, WS_PP = WS_R4;
constexpr size_t WS_MIXIN = WS_R5, WS_X2B = WS_R5;
static_assert((size_t)MAXTILES * 256 * 2048 * 2 <= 144 * MiB && (size_t)MAXTILES * 256 * 1024 * 2 <= 160 * MiB, "MoE row buffers");
constexpr int CW_TMO = 0, CW_CODE = 1, CW_CNT = 64  , CW_BAR = 4096;

constexpr int RING_OFF = 0, RING_BYTES = 131072;
constexpr int LDSCTL_OFF = RING_BYTES, MISC_OFF = LDSCTL_OFF + 320;
constexpr int AUX_OFF = LDSCTL_OFF + 1024;
constexpr int LDS_BYTES = 147456;
constexpr int NWAVES = 8;

#define RLX_AGENT __ATOMIC_RELAXED, __HIP_MEMORY_SCOPE_AGENT
#define LDS_WAIT() asm volatile("s_waitcnt lgkmcnt(0)" ::: "memory")
#define VM_WAIT() asm volatile("s_waitcnt vmcnt(0)" ::: "memory")
__device__ __forceinline__ unsigned f2bf(float f) { unsigned u = __builtin_bit_cast(unsigned, f); return (u + 0x7fffu + ((u >> 16) & 1u)) >> 16; }
__device__ __forceinline__ unsigned pk2(float lo, float hi) { return f2bf(lo) | (f2bf(hi) << 16); }
__device__ __forceinline__ float bf2f(unsigned short b) { return __builtin_bit_cast(float, ((unsigned)b) << 16); }
__device__ __forceinline__ float bflo(unsigned w) { return __builtin_bit_cast(float, w << 16); }
__device__ __forceinline__ float bfhi(unsigned w) { return __builtin_bit_cast(float, w & 0xffff0000u); }
__device__ __forceinline__ float sigmoidf_(float x) { return 1.0f / (1.0f + __expf(-x)); }
__device__ __forceinline__ float wave_sum(float v) {
#pragma unroll
    for (int o = 1; o < 64; o <<= 1) v += __shfl_xor(v, o);
    return v;
}
#define XB_TMO      128
#define XB_XCNT(j)  (256  + 64 * (j))
#define XB_XSUB(j)  (1280 + 64 * (j))
#define XB_XGEN(j)  (2304 + 64 * (j))
#define XB_TOP      3328
#define XB_TOPGEN   3392
#define XCD_BAR_WORDS 3456
#define XB_SPIN_CAP (1u << 18)

__device__ __forceinline__ unsigned xb_ld(unsigned* p)              { return __hip_atomic_load(p, __ATOMIC_RELAXED, __HIP_MEMORY_SCOPE_AGENT); }
__device__ __forceinline__ unsigned xb_add(unsigned* p, unsigned v) { return __hip_atomic_fetch_add(p, v, __ATOMIC_RELAXED, __HIP_MEMORY_SCOPE_AGENT); }
__device__ __forceinline__ unsigned xb_xcc_id() { return (unsigned)__builtin_amdgcn_s_getreg((3 << 11) | 20) & 0xFu; }
#define XB_SPIN(cond, bar) do { unsigned _sp = 0; while (cond) { __builtin_amdgcn_s_sleep(1); \
    if ((++_sp & 255u) == 0u) { if (xb_ld(&(bar)[XB_TMO])) break; if (_sp > XB_SPIN_CAP) { atomicAdd(&(bar)[XB_TMO], 1u); break; } } } } while (0)

struct XcdBarrier {
    unsigned* bar; unsigned x;
    volatile LAS unsigned* st;
};

__device__ __forceinline__ XcdBarrier xcd_barrier_post(unsigned* bar, volatile LAS unsigned* st) {
    XcdBarrier b; b.bar = bar; b.x = xb_xcc_id(); b.st = st;
    if (threadIdx.x == 0) (void)xb_add(&bar[XB_XCNT(b.x)], 1u);
    return b;
}
__device__ __forceinline__ void xcd_barrier_complete(unsigned* bar, unsigned x, unsigned& nloc, unsigned& nx) {
    const unsigned G = gridDim.x * gridDim.y * gridDim.z;
    unsigned sum, cnt, mine, sp = 0u;
    for (;;) {
        sum = 0u; cnt = 0u; mine = 0u;
#pragma unroll
        for (unsigned j = 0; j < 16; ++j) { const unsigned c = xb_ld(&bar[XB_XCNT(j)]); sum += c; cnt += (c > 0u) ? 1u : 0u; mine = (j == x) ? c : mine; }
        if (sum == G) break;
        __builtin_amdgcn_s_sleep(1);
        if ((++sp & 255u) == 0u) { if (xb_ld(&bar[XB_TMO])) break; if (sp > XB_SPIN_CAP) { atomicAdd(&bar[XB_TMO], 1u); break; } }
    }
    nloc = mine > 0u ? mine : 1u; nx = cnt > 0u ? cnt : 1u;
}

__device__ __forceinline__ void xcd_barrier(const XcdBarrier& b) {
    asm volatile("s_waitcnt vmcnt(0)" ::: "memory");
    __syncthreads();
    if (threadIdx.x == 0) {
        unsigned* bar = b.bar;
        __builtin_amdgcn_s_waitcnt(0);
        unsigned nloc = b.st[0], nx = b.st[1];
        if (nloc == 0u) { xcd_barrier_complete(bar, b.x, nloc, nx); b.st[0] = nloc; b.st[1] = nx; }
        const unsigned old = xb_add(&bar[XB_XSUB(b.x)], 1u);
        const unsigned gen = old / nloc;
        if (old + 1u == (gen + 1u) * nloc) {
            __builtin_amdgcn_fence(__ATOMIC_RELEASE, "agent");
            asm volatile("s_waitcnt vmcnt(0)" ::: "memory");
            const unsigned og = xb_add(&bar[XB_TOP], 1u);
            const unsigned tg = og / nx;
            if (og + 1u == (tg + 1u) * nx) xb_add(&bar[XB_TOPGEN], 1u);
            else XB_SPIN(xb_ld(&bar[XB_TOPGEN]) == tg, bar);
            __builtin_amdgcn_fence(__ATOMIC_ACQUIRE, "agent");
            xb_add(&bar[XB_XGEN(b.x)], 1u);
            asm volatile("s_waitcnt vmcnt(0)" ::: "memory");
        } else {
            XB_SPIN(xb_ld(&bar[XB_XGEN(b.x)]) == gen, bar);
            __builtin_amdgcn_fence(__ATOMIC_ACQUIRE, "agent");
            asm volatile("s_waitcnt vmcnt(0)" ::: "memory");
        }
    }
    __syncthreads();
}

struct Args { const float* in[21]; float* out; unsigned char* ws; int ph_lo, ph_hi, li, pad; };
enum { I_X = 0, I_P, I_WIN, I_CONVW, I_ALOG, I_DTB, I_NORMW, I_POOLW, I_POOLS, I_WOUT, I_LN1G, I_LN1B, I_WR, I_BR, I_WEG, I_WEU, I_WED, I_LN2G, I_LN2B, I_WPP, I_WPG };
struct Frame {
    LAS unsigned char* lds;
    volatile LAS unsigned* MISC;
    gu32* ctl;
    int tid, lane, wave, vcu, G;
};

#define PHASE_FRAME(F0) Frame F = F0; { int t_ = threadIdx.x; asm volatile("" : "+v"(t_)); F.tid = t_; F.lane = t_ & 63; }
#define OPQ_S(p) asm volatile("" : "+s"(p))
struct SchedDense {
    int nM, nN, nwg, G, c; const char* A; const char* B; size_t astep, bstep;
    __device__ __forceinline__ void init(int M, int N, int G_, int c_, const void* A_, int lda, const void* B_, int ldb) { nM = M / 256; nN = N / 256; nwg = nM * nN; G = G_; c = c_;
        A = (const char*)A_; B = (const char*)B_; astep = (size_t)256 * lda * 2; bstep = (size_t)256 * ldb * 2; }
    __device__ __forceinline__ bool next(int i, pg8::Unit& u) const {
        const long L = (long)i * G + c; if (L >= nwg) return false;
        int wgid = (int)L; { const int q = nwg / 8, r = nwg % 8, xcd = wgid % 8, off = wgid / 8; wgid = (xcd < r ? xcd * (q + 1) : r * (q + 1) + (xcd - r) * q) + off; }
        const int nig = 8 * nN, gid = wgid / nig, fm = gid * 8, gsz = (nM - fm) < 8 ? (nM - fm) : 8;
        u.pm = fm + ((wgid % nig) % gsz); u.pn = (wgid % nig) / gsz;
        u.A = A + (size_t)u.pm * astep; u.B = B + (size_t)u.pn * bstep; u.rows = nullptr; u.nvalid = 256; u.aux = 0; return true;
    }
};
struct SchedPool {
    int G, c; const char* A; const char* B;
    __device__ __forceinline__ bool next(int i, pg8::Unit& u) const {
        const int L = i * G + c; if (L >= 256) return false;
        u.pm = L >> 2; u.pn = L & 3; u.A = A + ((size_t)u.pm * 256 * PW + u.pn * 256) * 2; u.B = B + (size_t)u.pn * 65536 * 2; u.rows = nullptr; u.nvalid = 256; u.aux = 0; return true;
    }
};
struct SchedMoe {
    int G, c, mode; const LAS int* tab; const char* A; const char* B; const int* list;
    __device__ __forceinline__ bool next(int i, pg8::Unit& u) const {
        const int L = i * G + c, rt = L >> 3, pn = L & 7;
        const int ntiles = __builtin_amdgcn_readfirstlane(tab[16]); if (rt >= ntiles) return false;
        int e = 0;
#pragma unroll
        for (int k = 1; k < 16; ++k) { const int ts = __builtin_amdgcn_readfirstlane(tab[k]); if (rt >= ts) e = k; }
        const int ts = __builtin_amdgcn_readfirstlane(tab[e]), cn = __builtin_amdgcn_readfirstlane(tab[32 + e]);
        const int r0 = (rt - ts) * 256;
        u.pm = rt; u.pn = pn; u.aux = e;
        if (mode == 0) { u.A = A; u.rows = list + (size_t)e * LCAP + r0; u.nvalid = (cn - r0) < 256 ? (cn - r0) : 256; u.B = B + ((size_t)e * 2048 + pn * 256) * 2048 * 2; }
        else { u.A = A + (size_t)rt * 256 * DE * 2; u.rows = nullptr; u.nvalid = 256; u.B = B + ((size_t)e * 2048 + pn * 256) * DE * 2; }
        return true;
    }
};

using pg8::cvt_pk_bf16;
struct EpiBf16 {
    static constexpr bool PERM = true; bf16* O; int ldc;
    __device__ __forceinline__ void operator()(const f32x4 (&acc)[2][2][4][2], const pg8::Unit& u, int wr, int wc, int fr, int fq) const {
        const int row0 = u.pm * 256 + wr * 64 + fr, col0 = u.pn * 256 + wc * 32 + 8 * fq;
#pragma unroll
        for (int ai = 0; ai < 2; ++ai)
#pragma unroll
            for (int m = 0; m < 4; ++m) { bf16* rowp = O + (size_t)(row0 + ai * 128 + m * 16) * ldc + col0;
#pragma unroll
                for (int bj = 0; bj < 2; ++bj) { const f32x4 v0 = acc[ai][bj][m][0], v1 = acc[ai][bj][m][1];
                    v4u w; w.x = cvt_pk_bf16(v0[0], v0[1]); w.y = cvt_pk_bf16(v0[2], v0[3]); w.z = cvt_pk_bf16(v1[0], v1[1]); w.w = cvt_pk_bf16(v1[2], v1[3]);
                    *(v4u*)(rowp + bj * 128) = w; } }
    }
};
struct EpiPool {
    static constexpr bool PERM = true; bf16* O; const float* scale;
    __device__ __forceinline__ void operator()(const f32x4 (&acc)[2][2][4][2], const pg8::Unit& u, int wr, int wc, int fr, int fq) const {
        const int row0 = u.pm * 256 + wr * 64 + fr, cg = u.pn * 256 + wc * 32 + 8 * fq;
        f32x4 sv[2][2];
#pragma unroll
        for (int bj = 0; bj < 2; ++bj) { sv[bj][0] = *(const f32x4*)(scale + cg + bj * 128); sv[bj][1] = *(const f32x4*)(scale + cg + bj * 128 + 4); }
#pragma unroll
        for (int ai = 0; ai < 2; ++ai)
#pragma unroll
            for (int m = 0; m < 4; ++m) { bf16* rowp = O + (size_t)(row0 + ai * 128 + m * 16) * D + DNW + cg;
#pragma unroll
                for (int bj = 0; bj < 2; ++bj) { const f32x4 v0 = acc[ai][bj][m][0] * sv[bj][0], v1 = acc[ai][bj][m][1] * sv[bj][1];
                    v4u w; w.x = cvt_pk_bf16(v0[0], v0[1]); w.y = cvt_pk_bf16(v0[2], v0[3]); w.z = cvt_pk_bf16(v1[0], v1[1]); w.w = cvt_pk_bf16(v1[2], v1[3]);
                    *(v4u*)(rowp + bj * 128) = w; } }
    }
};
struct EpiRes {
    static constexpr bool PERM = false; const float* X; float* OUT;
    __device__ __forceinline__ void operator()(const f32x4 (&acc)[2][2][4][2], const pg8::Unit& u, int wr, int wc, int fr, int fq) const {
        const int row0 = u.pm * 256 + wr * 64 + fr, col0 = u.pn * 256 + wc * 32 + 4 * fq;
#pragma unroll
        for (int ai = 0; ai < 2; ++ai)
#pragma unroll
            for (int m = 0; m < 4; ++m) { const size_t off = (size_t)(row0 + ai * 128 + m * 16) * D + col0;
#pragma unroll
                for (int bj = 0; bj < 2; ++bj)
#pragma unroll
                    for (int n = 0; n < 2; ++n) { const f32x4 x = *(const f32x4*)(X + off + bj * 128 + n * 16); *(f32x4*)(OUT + off + bj * 128 + n * 16) = x * ALPHA + acc[ai][bj][m][n]; } }
    }
};
struct EpiSwiglu {
    static constexpr bool PERM = true; bf16* O;
    __device__ __forceinline__ void operator()(const f32x4 (&acc)[2][2][4][2], const pg8::Unit& u, int wr, int wc, int fr, int fq) const {
        const int row0 = u.pm * 256 + wr * 64 + fr, col0 = u.pn * 128 + wc * 32 + 8 * fq;
#pragma unroll
        for (int ai = 0; ai < 2; ++ai)
#pragma unroll
            for (int m = 0; m < 4; ++m) { bf16* rowp = O + (size_t)(row0 + ai * 128 + m * 16) * DE + col0;
                float h[8];
#pragma unroll
                for (int n = 0; n < 2; ++n)
#pragma unroll
                    for (int j = 0; j < 4; ++j) { const float g = acc[ai][0][m][n][j], up = acc[ai][1][m][n][j]; h[4 * n + j] = g * sigmoidf_(g) * up; }
                v4u w; w.x = cvt_pk_bf16(h[0], h[1]); w.y = cvt_pk_bf16(h[2], h[3]); w.z = cvt_pk_bf16(h[4], h[5]); w.w = cvt_pk_bf16(h[6], h[7]);
                *(v4u*)rowp = w; }
    }
};
struct EpiPle {
    static constexpr bool PERM = true; float* OUT; const bf16* PP; bf16* XB; int write_xb;
    __device__ __forceinline__ void operator()(const f32x4 (&acc)[2][2][4][2], const pg8::Unit& u, int wr, int wc, int fr, int fq) const {
        const int row0 = u.pm * 256 + wr * 64 + fr, col0 = u.pn * 256 + wc * 32 + 8 * fq;
#pragma unroll
        for (int ai = 0; ai < 2; ++ai)
#pragma unroll
            for (int m = 0; m < 4; ++m) { const size_t off0 = (size_t)(row0 + ai * 128 + m * 16) * D + col0;
#pragma unroll
                for (int bj = 0; bj < 2; ++bj) { const size_t off = off0 + bj * 128;
                    const f32x4 xa = *(const f32x4*)(OUT + off), xb = *(const f32x4*)(OUT + off + 4); const v4u pp = *(const v4u*)(PP + off);
                    const f32x4 a0 = acc[ai][bj][m][0], a1 = acc[ai][bj][m][1];
                    f32x4 o0, o1;
                    o0[0] = xa[0] + sigmoidf_(a0[0]) * bflo(pp.x); o0[1] = xa[1] + sigmoidf_(a0[1]) * bfhi(pp.x); o0[2] = xa[2] + sigmoidf_(a0[2]) * bflo(pp.y); o0[3] = xa[3] + sigmoidf_(a0[3]) * bfhi(pp.y);
                    o1[0] = xb[0] + sigmoidf_(a1[0]) * bflo(pp.z); o1[1] = xb[1] + sigmoidf_(a1[1]) * bfhi(pp.z); o1[2] = xb[2] + sigmoidf_(a1[2]) * bflo(pp.w); o1[3] = xb[3] + sigmoidf_(a1[3]) * bfhi(pp.w);
                    *(f32x4*)(OUT + off) = o0; *(f32x4*)(OUT + off + 4) = o1;
                    if (write_xb) { v4u w; w.x = cvt_pk_bf16(o0[0], o0[1]); w.y = cvt_pk_bf16(o0[2], o0[3]); w.z = cvt_pk_bf16(o1[0], o1[1]); w.w = cvt_pk_bf16(o1[2], o1[3]); *(v4u*)(XB + off) = w; } } }
    }
};

__device__ __forceinline__ void tr_item(const float* W, int ldw, int k0, int n0, bf16* WT, size_t drow0, int ldt, LAS float* scr, int lane) {
#pragma unroll 8
    for (int i = 0; i < 32; ++i) { const int kk = 2 * i + (lane >> 5); scr[kk * 33 + (lane & 31)] = W[(size_t)(k0 + kk) * ldw + n0 + (lane & 31)]; }
    LDS_WAIT(); asm volatile("" ::: "memory");
    const int c = lane & 7;
#pragma unroll
    for (int j = 0; j < 4; ++j) { const int n = (lane >> 3) + 8 * j; const LAS float* s = scr + (8 * c) * 33 + n;
        v4u o; o.x = pk2(s[0 * 33], s[1 * 33]); o.y = pk2(s[2 * 33], s[3 * 33]); o.z = pk2(s[4 * 33], s[5 * 33]); o.w = pk2(s[6 * 33], s[7 * 33]);
        *(GAS v4u*)(WT + (drow0 + n) * ldt + k0 + 8 * c) = o; }
    LDS_WAIT(); asm volatile("" ::: "memory");
}
__device__ __forceinline__ void p0_prologue(const Frame& F0, const Args& a) {
    PHASE_FRAME(F0);
    LAS float* scr = (LAS float*)(F.lds + RING_OFF + F.wave * 16384);
    const int gw = F.vcu * NWAVES + F.wave, NGW = F.G * NWAVES;
    unsigned char* ws = a.ws; OPQ_S(ws);
    constexpr int I_INA = 32 * 128, I_INB = 32 * 32, I_OUT = 32 * 64, I_PG = 32 * 64, I_PP = 4 * 64, I_POOL = 4 * 32, I_EG = NE * 32 * 32, I_EU = I_EG, I_ED = NE * 16 * 64;
    constexpr int I_LAYER = I_INA + I_INB + I_OUT + I_PG + I_PP + I_POOL + I_EG + I_EU + I_ED;
    for (int it = gw; it < DEPTH * I_LAYER; it += NGW) {
        const int l = it / I_LAYER; int r = it - l * I_LAYER;
        if (r < I_INA) { const int kb = r / 128, nb = r % 128; tr_item(a.in[I_WIN] + (size_t)l * D * IN_COLS, IN_COLS, 64 * kb, 32 * nb, (bf16*)(ws + WS_WIN) + (size_t)l * NPROJ * D, 32 * nb, D, scr, F.lane); continue; } r -= I_INA;
        if (r < I_INB) { const int kb = r / 32, nb = r % 32; tr_item(a.in[I_WIN] + (size_t)l * D * IN_COLS, IN_COLS, 64 * kb, 4112 + 32 * nb, (bf16*)(ws + WS_WIN) + (size_t)l * NPROJ * D, 4096 + 32 * nb, D, scr, F.lane); continue; } r -= I_INB;
        if (r < I_OUT) { const int kb = r / 64, nb = r % 64; tr_item(a.in[I_WOUT] + (size_t)l * D * D, D, 64 * kb, 32 * nb, (bf16*)(ws + WS_WOUT) + (size_t)l * D * D, 32 * nb, D, scr, F.lane); continue; } r -= I_OUT;
        if (r < I_PG) { const int kb = r / 64, nb = r % 64; tr_item(a.in[I_WPG] + (size_t)l * D * D, D, 64 * kb, 32 * nb, (bf16*)(ws + WS_WPG) + (size_t)l * D * D, 32 * nb, D, scr, F.lane); continue; } r -= I_PG;
        if (r < I_PP) { const int kb = r / 64, nb = r % 64; tr_item(a.in[I_WPP] + (size_t)l * PLE * D, D, 64 * kb, 32 * nb, (bf16*)(ws + WS_WPP) + (size_t)l * D * PLE, 32 * nb, PLE, scr, F.lane); continue; } r -= I_PP;
        if (r < I_POOL) { const int g = r / 32, rr = r % 32, kb = rr / 8, nb = rr % 8; tr_item(a.in[I_POOLW] + ((size_t)l * 4 + g) * 65536, 256, 64 * kb, 32 * nb, (bf16*)(ws + WS_WPOOL) + ((size_t)l * 4 + g) * 65536, 32 * nb, 256, scr, F.lane); continue; } r -= I_POOL;
        if (r < I_EG) { const int e = r / 1024, rr = r % 1024, kb = rr / 32, nb = rr % 32, h0 = 32 * nb;
            tr_item(a.in[I_WEG] + ((size_t)l * NE + e) * D * DE, DE, 64 * kb, h0, (bf16*)(ws + WS_WGU) + ((size_t)l * NE + e) * 2048 * D, (size_t)(h0 >> 7) * 256 + (h0 & 127), D, scr, F.lane); continue; } r -= I_EG;
        if (r < I_EU) { const int e = r / 1024, rr = r % 1024, kb = rr / 32, nb = rr % 32, h0 = 32 * nb;
            tr_item(a.in[I_WEU] + ((size_t)l * NE + e) * D * DE, DE, 64 * kb, h0, (bf16*)(ws + WS_WGU) + ((size_t)l * NE + e) * 2048 * D, (size_t)(h0 >> 7) * 256 + 128 + (h0 & 127), D, scr, F.lane); continue; } r -= I_EU;
        { const int e = r / 1024, rr = r % 1024, kb = rr / 64, nb = rr % 64;
            tr_item(a.in[I_WED] + ((size_t)l * NE + e) * DE * D, D, 64 * kb, 32 * nb, (bf16*)(ws + WS_WD) + ((size_t)l * NE + e) * D * DE, 32 * nb, DE, scr, F.lane); }
    }
    const size_t gt = (size_t)F.vcu * 512 + F.tid, NGT = (size_t)F.G * 512;
    { const GAS f32x4* src = (const GAS f32x4*)a.in[I_X]; GAS v4u* dst = (GAS v4u*)(ws + WS_XB);
        for (size_t i = gt; i < (size_t)T * D / 8; i += NGT) { const f32x4 v0 = src[2 * i], v1 = src[2 * i + 1]; v4u o; o.x = pk2(v0[0], v0[1]); o.y = pk2(v0[2], v0[3]); o.z = pk2(v1[0], v1[1]); o.w = pk2(v1[2], v1[3]); dst[i] = o; } }
    { const GAS f32x4* src = (const GAS f32x4*)a.in[I_P]; GAS v4u* dst = (GAS v4u*)(ws + WS_PB16);
        for (size_t i = gt; i < (size_t)DEPTH * T * PLE / 8; i += NGT) { const f32x4 v0 = src[2 * i], v1 = src[2 * i + 1]; v4u o; o.x = pk2(v0[0], v0[1]); o.y = pk2(v0[2], v0[3]); o.z = pk2(v1[0], v1[1]); o.w = pk2(v1[2], v1[3]); dst[i] = o; } }
    for (size_t i = gt; i < (size_t)DEPTH * 16 * D; i += NGT) { const int l = (int)(i / (16 * D)), j = (int)((i / D) % 16), k = (int)(i % D);
        ((bf16*)(ws + WS_WBA))[i] = (bf16)f2bf(a.in[I_WIN][((size_t)l * D + k) * IN_COLS + 4096 + j]); }
}

constexpr int QS_LD = 132, AS_LD = 68;
__device__ __forceinline__ void phase_dn_prep(const Frame& F0, const Args& a, int layer) {
    PHASE_FRAME(F0);
    unsigned char* ws = a.ws; OPQ_S(ws);
    LAS float* QS = (LAS float*)F.lds; LAS float* KS = QS + 64 * QS_LD; LAS float* VS = KS + 64 * QS_LD; LAS float* AS = VS + 64 * QS_LD;
    LAS float* betaS = AS + 64 * AS_LD; LAS float* gS = betaS + 512; LAS float* gamh = gS + 512; LAS float* betah = gamh + 64; LAS float* egam = betah + 64; LAS float* bgam = egam + 64; LAS float* ekd = bgam + 64;
    const bf16* XB = (const bf16*)(ws + WS_XB); const bf16* PROJ = (const bf16*)(ws + WS_PROJ); const bf16* WBA = (const bf16*)(ws + WS_WBA) + (size_t)layer * 16 * D;
    bf16* U = (bf16*)(ws + WS_U); bf16* W = (bf16*)(ws + WS_W); bf16* QD = (bf16*)(ws + WS_QD); bf16* KD = (bf16*)(ws + WS_KD); bf16* AQK = (bf16*)(ws + WS_AQK); float* CD = (float*)(ws + WS_CD);
    bf16* POOLD = (bf16*)(ws + WS_POOLD);
    const float* convw = a.in[I_CONVW] + (size_t)layer * 4 * 3072; const float* alog = a.in[I_ALOG] + layer * NH; const float* dtb = a.in[I_DTB] + layer * NH;
    const int tid = F.tid;
    for (int unit = F.vcu; unit < NB * NCH; unit += F.G) {
        const int b = unit / NCH, n = unit % NCH, r0 = b * SEQ + n * CH, sq0 = n * CH;
        { const int col = 2 * tid, win = 2 << (col >> 8); const bf16* up = PROJ + (size_t)r0 * NPROJ + 4096 + col;
            float s0 = 0.f, s1 = 0.f;
            for (int j = 1; j < win; ++j) if (sq0 - j >= 0) { const unsigned w = *(const unsigned*)(up - (ptrdiff_t)j * NPROJ); s0 += bflo(w); s1 += bfhi(w); }
            for (int i = 0; i < CH; ++i) { const unsigned w = *(const unsigned*)(up + (size_t)i * NPROJ); const float x0 = bflo(w), x1 = bfhi(w); s0 += x0; s1 += x1;
                const int pos = sq0 + i; const float inv = 1.0f / (float)((pos + 1) < win ? (pos + 1) : win);
                *(unsigned*)(POOLD + (size_t)(r0 + i) * PW + col) = pk2(s0 * inv - x0, s1 * inv - x1);
                if (pos - win + 1 >= 0) { const unsigned wo = *(const unsigned*)(up + (ptrdiff_t)(i - win + 1) * NPROJ); s0 -= bflo(wo); s1 -= bfhi(wo); } } }
        { const int tok = tid >> 3, cp = tid & 7; const bf16* xr = XB + (size_t)(r0 + tok) * D; const bf16* w0 = WBA + (size_t)(2 * cp) * D; const bf16* w1 = w0 + D;
            float s0 = 0.f, s1 = 0.f;
            for (int k = 0; k < D; k += 8) { const v4u xv = *(const v4u*)(xr + k), av = *(const v4u*)(w0 + k), bv = *(const v4u*)(w1 + k);
#pragma unroll
                for (int j = 0; j < 4; ++j) { const float xl = bflo(xv[j]), xh = bfhi(xv[j]); s0 += xl * bflo(av[j]) + xh * bfhi(av[j]); s1 += xl * bflo(bv[j]) + xh * bfhi(bv[j]); } }
            if (cp < 4) { betaS[tok * 8 + 2 * cp] = sigmoidf_(s0); betaS[tok * 8 + 2 * cp + 1] = sigmoidf_(s1); }
            else { const int h = 2 * (cp - 4);
                const float z0 = s0 + dtb[h], z1 = s1 + dtb[h + 1];
                const float sp0 = z0 > 20.f ? z0 : log1pf(__expf(z0)), sp1 = z1 > 20.f ? z1 : log1pf(__expf(z1));
                gS[tok * 8 + h] = -__expf(alog[h]) * sp0; gS[tok * 8 + h + 1] = -__expf(alog[h + 1]) * sp1; } }
        __syncthreads();
        if (tid < 8) { float run = 0.f; for (int t = 0; t < CH; ++t) { run += gS[t * 8 + tid]; gS[t * 8 + tid] = run; } }
        __syncthreads();
        for (int h = 0; h < NH; ++h) {
            const size_t chd = (size_t)unit * NH + h;
            { const int c = tid & 127, rg = tid >> 7;
#pragma unroll
                for (int part = 0; part < 3; ++part) { const int col = part * 1024 + h * HD + c; LAS float* tile = part == 0 ? QS : (part == 1 ? KS : VS);
                    const float cw0 = convw[col], cw1 = convw[3072 + col], cw2 = convw[2 * 3072 + col], cw3 = convw[3 * 3072 + col];
                    const bf16* src = PROJ + (size_t)(r0 + rg * 16) * NPROJ + col; const int s = sq0 + rg * 16;
                    float xm3 = (s - 3 >= 0) ? bf2f(*(src - 3 * (ptrdiff_t)NPROJ)) : 0.f, xm2 = (s - 2 >= 0) ? bf2f(*(src - 2 * (ptrdiff_t)NPROJ)) : 0.f, xm1 = (s - 1 >= 0) ? bf2f(*(src - (ptrdiff_t)NPROJ)) : 0.f;
#pragma unroll 4
                    for (int i = 0; i < 16; ++i) { const float x = bf2f(src[(size_t)i * NPROJ]); const float y = cw0 * xm3 + cw1 * xm2 + cw2 * xm1 + cw3 * x;
                        tile[(rg * 16 + i) * QS_LD + c] = y * sigmoidf_(y); xm3 = xm2; xm2 = xm1; xm1 = x; } } }
            if (tid < 64) { const float gi = gS[tid * 8 + h], bi = betaS[tid * 8 + h], eg = __expf(gi); gamh[tid] = gi; betah[tid] = bi; egam[tid] = eg; bgam[tid] = bi * eg; ekd[tid] = __expf(gS[63 * 8 + h] - gi); }
            __syncthreads();
            { const int tok = tid >> 3, part = tid & 7; LAS float* qp = QS + tok * QS_LD + part * 16; LAS float* kp = KS + tok * QS_LD + part * 16;
                f32x4 qv[4], kv[4]; float sq = 0.f, sk = 0.f;
#pragma unroll
                for (int j = 0; j < 4; ++j) { qv[j] = *(LAS f32x4*)(qp + 4 * j); kv[j] = *(LAS f32x4*)(kp + 4 * j);
                    sq += (qv[j][0] * qv[j][0] + qv[j][1] * qv[j][1]) + (qv[j][2] * qv[j][2] + qv[j][3] * qv[j][3]); sk += (kv[j][0] * kv[j][0] + kv[j][1] * kv[j][1]) + (kv[j][2] * kv[j][2] + kv[j][3] * kv[j][3]); }
                sq += __shfl_xor(sq, 1); sq += __shfl_xor(sq, 2); sq += __shfl_xor(sq, 4); sk += __shfl_xor(sk, 1); sk += __shfl_xor(sk, 2); sk += __shfl_xor(sk, 4);
                const float rq = 1.0f / sqrtf(sq + RMS_EPS) * 0.08838834764831845f, rk = 1.0f / sqrtf(sk + RMS_EPS);
#pragma unroll
                for (int j = 0; j < 4; ++j) { *(LAS f32x4*)(qp + 4 * j) = qv[j] * rq; *(LAS f32x4*)(kp + 4 * j) = kv[j] * rk; } }
            __syncthreads();
            { const int i = tid >> 3, jb = tid & 7;
                for (int jj = 0; jj < 8; ++jj) { const int j = jb + 8 * jj; float av = 0.f, aq = 0.f;
                    if (j <= i) { float kk = 0.f, qk = 0.f; const LAS float* ki = KS + i * QS_LD; const LAS float* qi = QS + i * QS_LD; const LAS float* kj = KS + j * QS_LD;
#pragma unroll 8
                        for (int d = 0; d < HD; d += 4) { const f32x4 a4 = *(const LAS f32x4*)(ki + d), q4 = *(const LAS f32x4*)(qi + d), b4 = *(const LAS f32x4*)(kj + d);
                            kk += (a4[0] * b4[0] + a4[1] * b4[1]) + (a4[2] * b4[2] + a4[3] * b4[3]); qk += (q4[0] * b4[0] + q4[1] * b4[1]) + (q4[2] * b4[2] + q4[3] * b4[3]); }
                        const float dec = __expf(gamh[i] - gamh[j]); aq = qk * dec; av = (j < i) ? betah[i] * kk * dec : 0.f; }
                    AS[i * AS_LD + j] = av; AQK[chd * 4096 + i * 64 + j] = (bf16)f2bf(aq); } }
            __syncthreads();
#ifndef NO_INV
            if (F.wave == 0) { float Tc[64];
                unsigned asb = (unsigned)(uintptr_t)AS; int ln = F.lane; asm volatile("" : "+v"(asb), "+v"(ln));
                const LAS float* ASv = (const LAS float*)(uintptr_t)asb;
#pragma unroll
                for (int i = 0; i < 64; ++i) { float acc = (i == ln) ? 1.f : 0.f;
#pragma unroll
                    for (int j4 = 0; j4 < (i + 3) / 4; ++j4) { const f32x4 a4 = *(const LAS f32x4*)(ASv + i * AS_LD + 4 * j4);
#pragma unroll
                        for (int q = 0; q < 4; ++q) if (4 * j4 + q < i) acc -= a4[q] * Tc[4 * j4 + q]; }
                    Tc[i] = acc; }
                LDS_WAIT();
                LAS float* ASw = (LAS float*)(uintptr_t)asb + ln;
#pragma unroll
                for (int i = 0; i < 64; ++i) ASw[i * AS_LD] = Tc[i]; }
#endif
            __syncthreads();
            { const int c = tid & 127, rg = tid >> 7; float accu[16], accw[16];
#pragma unroll
                for (int ii = 0; ii < 16; ++ii) { accu[ii] = 0.f; accw[ii] = 0.f; }
                for (int j4 = 0; j4 < 4 * (rg + 1); ++j4) { float vb[4], kb[4];
#pragma unroll
                    for (int q = 0; q < 4; ++q) { const int j = 4 * j4 + q; vb[q] = VS[j * QS_LD + c] * betah[j]; kb[q] = KS[j * QS_LD + c] * bgam[j]; }
#pragma unroll
                    for (int ii = 0; ii < 16; ++ii) { const f32x4 t4 = *(const LAS f32x4*)(AS + (rg * 16 + ii) * AS_LD + 4 * j4);
                        accu[ii] += (t4[0] * vb[0] + t4[1] * vb[1]) + (t4[2] * vb[2] + t4[3] * vb[3]); accw[ii] += (t4[0] * kb[0] + t4[1] * kb[1]) + (t4[2] * kb[2] + t4[3] * kb[3]); } }
#pragma unroll
                for (int ii = 0; ii < 16; ++ii) { const int i = rg * 16 + ii; const size_t o = (size_t)(r0 + i) * DNW + h * HD + c;
                    U[o] = (bf16)f2bf(accu[ii]); W[o] = (bf16)f2bf(accw[ii]); QD[o] = (bf16)f2bf(QS[i * QS_LD + c] * egam[i]); KD[o] = (bf16)f2bf(KS[i * QS_LD + c] * ekd[i]); } }
            if (tid == 0) CD[chd] = egam[63];
            __syncthreads();
        }
    }
}

constexpr int SC_LD = 136, SC_ALD = 72;
__device__ __forceinline__ void phase_dn_scan(const Frame& F0, const Args& a) {
    PHASE_FRAME(F0);
    unsigned char* ws = a.ws; OPQ_S(ws);
    LAS bf16* WSm = (LAS bf16*)F.lds; LAS bf16* QDm = WSm + 64 * SC_LD; LAS bf16* KDm = QDm + 64 * SC_LD; LAS bf16* AQm = KDm + 64 * SC_LD;
    LAS float* Um = (LAS float*)(AQm + 64 * SC_ALD); LAS float* Sm = Um + 64 * 16; LAS float* Vn = Sm + 128 * 16;
    const bf16* U = (const bf16*)(ws + WS_U); const bf16* W = (const bf16*)(ws + WS_W); const bf16* QD = (const bf16*)(ws + WS_QD); const bf16* KD = (const bf16*)(ws + WS_KD); const bf16* AQK = (const bf16*)(ws + WS_AQK);
    const float* CD = (const float*)(ws + WS_CD); float* O = (float*)(ws + WS_O);
    const int tid = F.tid;
    for (int unit = F.vcu; unit < NB * NH * 8; unit += F.G) {
        const int b = unit >> 6, h = (unit >> 3) & 7, sl = unit & 7, c0 = h * HD + sl * 16;
        for (int i = tid; i < 128 * 16; i += 512) Sm[i] = 0.f;
        v4u rw[2], rq[2], rk[2], ra; v4u ru = (v4u){0u, 0u, 0u, 0u};
#define SC_ISSUE(nn) do { const size_t row0_ = (size_t)b * SEQ + (size_t)(nn) * CH; const size_t chd_ = ((size_t)b * NCH + (nn)) * NH + h; \
            _Pragma("unroll") for (int q = 0; q < 2; ++q) { const int p = tid + 512 * q, row = p >> 4, seg = p & 15; const size_t o = (row0_ + row) * DNW + h * HD + seg * 8; \
                rw[q] = *(const v4u*)(W + o); rq[q] = *(const v4u*)(QD + o); rk[q] = *(const v4u*)(KD + o); } \
            ra = *(const v4u*)(AQK + chd_ * 4096 + tid * 8); \
            if (tid < 128) { const int row = tid >> 1, hf = tid & 1; ru = *(const v4u*)(U + (row0_ + row) * DNW + c0 + hf * 8); } } while (0)
        SC_ISSUE(0);
        for (int n = 0; n < NCH; ++n) {
            const size_t row0 = (size_t)b * SEQ + (size_t)n * CH; const float cd = CD[((size_t)b * NCH + n) * NH + h];
#pragma unroll
            for (int q = 0; q < 2; ++q) { const int p = tid + 512 * q, row = p >> 4, seg = p & 15;
                *(LAS v4u*)(WSm + row * SC_LD + seg * 8) = rw[q]; *(LAS v4u*)(QDm + row * SC_LD + seg * 8) = rq[q]; *(LAS v4u*)(KDm + row * SC_LD + seg * 8) = rk[q]; }
            { const int row = tid >> 3, seg = tid & 7; *(LAS v4u*)(AQm + row * SC_ALD + seg * 8) = ra; }
            if (tid < 128) { const int row = tid >> 1, hf = tid & 1; LAS float* up = Um + row * 16 + hf * 8;
                up[0] = bflo(ru.x); up[1] = bfhi(ru.x); up[2] = bflo(ru.y); up[3] = bfhi(ru.y); up[4] = bflo(ru.z); up[5] = bfhi(ru.z); up[6] = bflo(ru.w); up[7] = bfhi(ru.w); }
            __syncthreads();
            if (n + 1 < NCH) SC_ISSUE(n + 1);
            const int i = tid >> 3, cq = tid & 7;
            float ws0 = 0.f, ws1 = 0.f, qs0 = 0.f, qs1 = 0.f;
#pragma unroll 4
            for (int k4 = 0; k4 < 32; ++k4) { const v2u wv = *(const LAS v2u*)(WSm + i * SC_LD + 4 * k4), qv = *(const LAS v2u*)(QDm + i * SC_LD + 4 * k4);
                const float wf[4] = {bflo(wv.x), bfhi(wv.x), bflo(wv.y), bfhi(wv.y)}, qf[4] = {bflo(qv.x), bfhi(qv.x), bflo(qv.y), bfhi(qv.y)};
#pragma unroll
                for (int kk = 0; kk < 4; ++kk) { const f32x2 s2 = *(const LAS f32x2*)(Sm + (4 * k4 + kk) * 16 + 2 * cq); ws0 += wf[kk] * s2[0]; ws1 += wf[kk] * s2[1]; qs0 += qf[kk] * s2[0]; qs1 += qf[kk] * s2[1]; } }
            { const f32x2 u2 = *(const LAS f32x2*)(Um + i * 16 + 2 * cq); *(LAS f32x2*)(Vn + i * 16 + 2 * cq) = (f32x2){u2[0] - ws0, u2[1] - ws1}; }
            __syncthreads();
            float o0 = qs0, o1 = qs1;
#pragma unroll 4
            for (int j4 = 0; j4 < 16; ++j4) { const v2u av = *(const LAS v2u*)(AQm + i * SC_ALD + 4 * j4); const float af[4] = {bflo(av.x), bfhi(av.x), bflo(av.y), bfhi(av.y)};
#pragma unroll
                for (int jj = 0; jj < 4; ++jj) { const f32x2 v2 = *(const LAS f32x2*)(Vn + (4 * j4 + jj) * 16 + 2 * cq); o0 += af[jj] * v2[0]; o1 += af[jj] * v2[1]; } }
            *(f32x2*)(O + (row0 + i) * DNW + c0 + 2 * cq) = (f32x2){o0, o1};
            { const int k = tid >> 2, c4 = (tid & 3) * 4; f32x4 s4 = *(const LAS f32x4*)(Sm + k * 16 + c4) * cd;
#pragma unroll 4
                for (int t = 0; t < CH; ++t) { const float kd = bf2f(KDm[t * SC_LD + k]); const f32x4 v4 = *(const LAS f32x4*)(Vn + t * 16 + c4); s4 += v4 * kd; }
                *(LAS f32x4*)(Sm + k * 16 + c4) = s4; }
            __syncthreads();
        }
    }
}

__device__ __forceinline__ void phase_dn_norm(const Frame& F0, const Args& a, int layer) {
    PHASE_FRAME(F0);
    unsigned char* ws = a.ws; OPQ_S(ws); const float* O = (const float*)(ws + WS_O); const bf16* PROJ = (const bf16*)(ws + WS_PROJ); bf16* MIXIN = (bf16*)(ws + WS_MIXIN);
    const float* nw = a.in[I_NORMW] + layer * HD; const f32x2 nw2 = *(const f32x2*)(nw + 2 * F.lane);
    const int gw = F.vcu * NWAVES + F.wave, NGW = F.G * NWAVES;
    for (int it = gw; it < T * NH; it += NGW) { const int tok = it >> 3, h = it & 7;
        const f32x2 o = *(const f32x2*)(O + (size_t)tok * DNW + h * HD + 2 * F.lane);
        const float ss = wave_sum(o[0] * o[0] + o[1] * o[1]); const float r = 1.0f / sqrtf(ss * (1.0f / HD) + RMS_EPS);
        const unsigned zz = *(const unsigned*)(PROJ + (size_t)tok * NPROJ + 3072 + h * HD + 2 * F.lane); const float z0 = bflo(zz), z1 = bfhi(zz);
        *(unsigned*)(MIXIN + (size_t)tok * D + h * HD + 2 * F.lane) = pk2(o[0] * r * nw2[0] * z0 * sigmoidf_(z0), o[1] * r * nw2[1] * z1 * sigmoidf_(z1)); }
}

__device__ __forceinline__ void phase_ln1_router(const Frame& F0, const Args& a, int layer) {
    PHASE_FRAME(F0);
    unsigned char* ws = a.ws; OPQ_S(ws);
    LAS float* WRt = (LAS float*)F.lds;
    LAS int* rowE = (LAS int*)(F.lds + AUX_OFF); LAS int* rowP = rowE + 128; LAS float* rowG = (LAS float*)(rowP + 128); LAS int* lcnt = (LAS int*)(rowG + 128); LAS int* lbase = lcnt + 16;
    const float* wr = a.in[I_WR]; const float* br = a.in[I_BR]; OPQ_S(wr); OPQ_S(br);
    for (int idx = F.tid; idx < D * NE; idx += 512) WRt[(idx & 15) * D + (idx >> 4)] = wr[idx];
    const float* PRE = a.out; bf16* X1B = (bf16*)(ws + WS_X1B); float* STATS = (float*)(ws + WS_STATS);
    const float* g1 = a.in[I_LN1G] + (size_t)layer * D; const float* b1 = a.in[I_LN1B] + (size_t)layer * D;
    int* LIST = (int*)(ws + WS_LIST); int* TOKSLOT = (int*)(ws + WS_TOKSLOT); float* GATEW = (float*)(ws + WS_GATEW);
    gu32* cnt = F.ctl + CW_CNT + 64 * layer;
    float brv[16];
#pragma unroll
    for (int e = 0; e < 16; ++e) brv[e] = br[e];
    for (int rb = F.vcu; rb < T / 64; rb += F.G) {
        if (F.tid < 16) lcnt[F.tid] = 0;
        __syncthreads();
        for (int r = 0; r < 8; ++r) { const int lr = F.wave * 8 + r, row = rb * 64 + lr;
            const GAS f32x4* xr = (const GAS f32x4*)(PRE + (size_t)row * D) + F.lane;
            f32x4 v[8]; float s = 0.f;
#pragma unroll
            for (int j = 0; j < 8; ++j) { v[j] = xr[64 * j]; s += (v[j][0] + v[j][1]) + (v[j][2] + v[j][3]); }
            const float mean = wave_sum(s) * (1.f / D); float s2 = 0.f;
#pragma unroll
            for (int j = 0; j < 8; ++j) { v[j] = v[j] - mean; s2 += (v[j][0] * v[j][0] + v[j][1] * v[j][1]) + (v[j][2] * v[j][2] + v[j][3] * v[j][3]); }
            const float rstd = 1.f / sqrtf(wave_sum(s2) * (1.f / D) + LN_EPS);
            if (F.lane == 0) { STATS[2 * row] = mean; STATS[2 * row + 1] = rstd; }
            GAS v2u* o8 = (GAS v2u*)(X1B + (size_t)row * D) + F.lane;
            float lg[16];
#pragma unroll
            for (int e = 0; e < 16; ++e) lg[e] = 0.f;
#pragma unroll
            for (int j = 0; j < 8; ++j) { const f32x4 gg = *(const f32x4*)(g1 + 256 * j + 4 * F.lane), bb = *(const f32x4*)(b1 + 256 * j + 4 * F.lane);
                v[j] = v[j] * rstd * gg + bb;
                v2u w; w.x = pk2(v[j][0], v[j][1]); w.y = pk2(v[j][2], v[j][3]); o8[64 * j] = w;
#pragma unroll
                for (int e = 0; e < 16; ++e) { const f32x4 w4 = *(const LAS f32x4*)(WRt + e * D + 256 * j + 4 * F.lane); lg[e] += (v[j][0] * w4[0] + v[j][1] * w4[1]) + (v[j][2] * w4[2] + v[j][3] * w4[3]); } }
            float mx = -3.0e38f;
#pragma unroll
            for (int e = 0; e < 16; ++e) { lg[e] = wave_sum(lg[e]) + brv[e]; mx = fmaxf(mx, lg[e]); }
            float p[16];
#pragma unroll
            for (int e = 0; e < 16; ++e) p[e] = __expf(lg[e] - mx);
            float gsc[4];
#pragma unroll
            for (int g = 0; g < 4; ++g) { const float a0 = p[4 * g], a1 = p[4 * g + 1], a2 = p[4 * g + 2], a3 = p[4 * g + 3];
                const float hi1 = fmaxf(a0, a1), lo1 = fminf(a0, a1), hi2 = fmaxf(a2, a3), lo2 = fminf(a2, a3);
                gsc[g] = fmaxf(hi1, hi2) + fmaxf(fminf(hi1, hi2), fmaxf(lo1, lo2)); }
            int gsel = 0; float best = gsc[0];
#pragma unroll
            for (int g = 1; g < 4; ++g) if (gsc[g] > best) { best = gsc[g]; gsel = g; }
            float q[4];
#pragma unroll
            for (int j = 0; j < 4; ++j) q[j] = gsel == 0 ? p[j] : (gsel == 1 ? p[4 + j] : (gsel == 2 ? p[8 + j] : p[12 + j]));
            int i0 = 0; float p0 = q[0];
#pragma unroll
            for (int j = 1; j < 4; ++j) if (q[j] > p0) { p0 = q[j]; i0 = j; }
            int i1 = -1; float p1 = -1.f;
#pragma unroll
            for (int j = 0; j < 4; ++j) if (j != i0 && q[j] > p1) { p1 = q[j]; i1 = j; }
            if (F.lane == 0) { const int e0 = gsel * 4 + i0, e1 = gsel * 4 + i1; const float inv = 1.0f / (p0 + p1);
                rowE[2 * lr] = e0; rowE[2 * lr + 1] = e1; rowG[2 * lr] = p0 * inv; rowG[2 * lr + 1] = p1 * inv;
                rowP[2 * lr] = __hip_atomic_fetch_add(&lcnt[e0], 1, __ATOMIC_RELAXED, __HIP_MEMORY_SCOPE_WORKGROUP); rowP[2 * lr + 1] = __hip_atomic_fetch_add(&lcnt[e1], 1, __ATOMIC_RELAXED, __HIP_MEMORY_SCOPE_WORKGROUP); }
        }
        __syncthreads();
        if (F.tid < 16) lbase[F.tid] = (int)__hip_atomic_fetch_add(cnt + F.tid, (unsigned)lcnt[F.tid], RLX_AGENT);
        __syncthreads();
        if (F.tid < 128) { const int e = rowE[F.tid], pos = lbase[e] + rowP[F.tid], tok = rb * 64 + (F.tid >> 1);
            LIST[(size_t)e * LCAP + pos] = tok; TOKSLOT[2 * tok + (F.tid & 1)] = e * LCAP + pos; GATEW[2 * tok + (F.tid & 1)] = rowG[F.tid]; }
        __syncthreads();
    }
}
__device__ __forceinline__ void moe_table(const Frame& F0, int layer) {
    PHASE_FRAME(F0);
    LAS int* tab = (LAS int*)(F.lds + AUX_OFF);
    __syncthreads();
    if (F.tid < 16) tab[32 + F.tid] = (int)__hip_atomic_load(F.ctl + CW_CNT + 64 * layer + F.tid, RLX_AGENT);
    __syncthreads();
    if (F.tid == 0) { int run = 0; for (int e = 0; e < 16; ++e) { tab[e] = run; run += (tab[32 + e] + 255) >> 8; } tab[16] = run; }
    __syncthreads();
}
__device__ __forceinline__ void phase_combine_ln2(const Frame& F0, const Args& a, int layer) {
    PHASE_FRAME(F0);
    unsigned char* ws = a.ws; OPQ_S(ws); const LAS int* tab = (const LAS int*)(F.lds + AUX_OFF);
    float* PRE = a.out; const float* STATS = (const float*)(ws + WS_STATS); const bf16* Y = (const bf16*)(ws + WS_Y); bf16* X2B = (bf16*)(ws + WS_X2B);
    const int* TOKSLOT = (const int*)(ws + WS_TOKSLOT); const float* GATEW = (const float*)(ws + WS_GATEW);
    const float* g1 = a.in[I_LN1G] + (size_t)layer * D; const float* b1 = a.in[I_LN1B] + (size_t)layer * D; const float* g2 = a.in[I_LN2G] + (size_t)layer * D; const float* b2 = a.in[I_LN2B] + (size_t)layer * D;
    const int gw = F.vcu * NWAVES + F.wave, NGW = F.G * NWAVES;
    for (int row = gw; row < T; row += NGW) {
        const float mean = STATS[2 * row], rstd = STATS[2 * row + 1];
        const int s0 = TOKSLOT[2 * row], s1 = TOKSLOT[2 * row + 1]; const float w0 = GATEW[2 * row], w1 = GATEW[2 * row + 1];
        const size_t y0 = (size_t)tab[s0 / LCAP] * 256 + (s0 % LCAP), y1 = (size_t)tab[s1 / LCAP] * 256 + (s1 % LCAP);
        GAS f32x4* xr = (GAS f32x4*)(PRE + (size_t)row * D) + F.lane; const GAS v2u* ya = (const GAS v2u*)(Y + y0 * D) + F.lane; const GAS v2u* yb = (const GAS v2u*)(Y + y1 * D) + F.lane;
        f32x4 v[8]; float s = 0.f;
#pragma unroll
        for (int j = 0; j < 8; ++j) { const f32x4 gg = *(const f32x4*)(g1 + 256 * j + 4 * F.lane), bb = *(const f32x4*)(b1 + 256 * j + 4 * F.lane);
            const f32x4 x1 = (xr[64 * j] - mean) * rstd * gg + bb; const v2u pa = ya[64 * j], pb = yb[64 * j];
            f32x4 f; f[0] = w0 * bflo(pa.x) + w1 * bflo(pb.x); f[1] = w0 * bfhi(pa.x) + w1 * bfhi(pb.x); f[2] = w0 * bflo(pa.y) + w1 * bflo(pb.y); f[3] = w0 * bfhi(pa.y) + w1 * bfhi(pb.y);
            v[j] = x1 * ALPHA + f; s += (v[j][0] + v[j][1]) + (v[j][2] + v[j][3]); }
        const float m2 = wave_sum(s) * (1.f / D); float q = 0.f;
#pragma unroll
        for (int j = 0; j < 8; ++j) { v[j] = v[j] - m2; q += (v[j][0] * v[j][0] + v[j][1] * v[j][1]) + (v[j][2] * v[j][2] + v[j][3] * v[j][3]); }
        const float r2 = 1.f / sqrtf(wave_sum(q) * (1.f / D) + LN_EPS);
        GAS v2u* o8 = (GAS v2u*)(X2B + (size_t)row * D) + F.lane;
#pragma unroll
        for (int j = 0; j < 8; ++j) { const f32x4 gg = *(const f32x4*)(g2 + 256 * j + 4 * F.lane), bb = *(const f32x4*)(b2 + 256 * j + 4 * F.lane);
            const f32x4 o = v[j] * r2 * gg + bb; xr[64 * j] = o; v2u w; w.x = pk2(o[0], o[1]); w.y = pk2(o[2], o[3]); o8[64 * j] = w; }
    }
}

#ifndef MK_N_LAUNCHES
#define MK_N_LAUNCHES 1
#endif
constexpr int NPHASE = 1 + 10 * DEPTH;
constexpr int N_LAUNCHES = MK_N_LAUNCHES;
static_assert(N_LAUNCHES == 1 || N_LAUNCHES == NPHASE, "MK_N_LAUNCHES is 1 or NPHASE");

__global__ void __launch_bounds__(NWAVES * 64, 2) trunk_fwd(Args args) {
    extern __shared__ __attribute__((aligned(16))) unsigned char lds[];
    Frame F;
    F.lds = (LAS unsigned char*)lds;
    F.MISC = (volatile LAS unsigned*)(F.lds + MISC_OFF);
    F.tid = threadIdx.x; F.lane = F.tid & 63; F.wave = __builtin_amdgcn_readfirstlane(F.tid >> 6);
    F.G = gridDim.x; { const int bx = blockIdx.x; F.vcu = (F.G % 8 == 0) ? (bx % 8) * (F.G / 8) + bx / 8 : bx; }
    unsigned char* ws = args.ws;
    F.ctl = (gu32*)(ws + WS_CTL);
    for (int u = F.tid; u < (LDS_BYTES - LDSCTL_OFF) / 4; u += NWAVES * 64) ((LAS unsigned*)(F.lds + LDSCTL_OFF))[u] = 0u;
    __syncthreads();
    XcdBarrier bar; bar.bar = (unsigned*)(F.ctl + CW_BAR); bar.x = 0; bar.st = nullptr;
    if (N_LAUNCHES == 1) bar = xcd_barrier_post((unsigned*)(F.ctl + CW_BAR), F.MISC + 8);
#define GRID_BAR() do { if (N_LAUNCHES == 1) xcd_barrier(bar); } while (0)
    const int lo = args.ph_lo, hi = args.ph_hi;
#ifndef PH_MASK
#define PH_MASK 0x7ff
#endif
#define IN(k) ((((k) == 0 ? 1u : (2u << (((k) - 1) % 10))) & (unsigned)(PH_MASK)) && lo <= (k) && (k) < hi)
#define SEAM(k) do { if (IN((k) + 1)) GRID_BAR(); } while (0)

    if (IN(0)) { p0_prologue(F, args); SEAM(0); }

#ifdef LAYER_UNROLL
#pragma unroll
#else
#pragma unroll 1
#endif
    for (int layer = 0; layer < DEPTH; ++layer) {
        const int pb = 1 + 10 * layer;
        unsigned char* ws = args.ws; OPQ_S(ws);
        if (IN(pb + 0)) {
            SchedDense S; S.init(T, NPROJ, F.G, (int)blockIdx.x, ws + WS_XB, D, (const bf16*)(ws + WS_WIN) + (size_t)layer * NPROJ * D, D);
            EpiBf16 E{(bf16*)(ws + WS_PROJ), NPROJ};
            pg8::gemm_phase<EpiBf16, SchedDense, false>(F.lds + RING_OFF, D, D, D, S, E);
            SEAM(pb + 0);
        }
        if (IN(pb + 1)) { phase_dn_prep(F, args, layer); SEAM(pb + 1); }
        if (IN(pb + 2)) { phase_dn_scan(F, args); SEAM(pb + 2); }
        if (IN(pb + 3)) {
            SchedPool S{F.G, (int)blockIdx.x, (const char*)(ws + WS_POOLD), (const char*)((const bf16*)(ws + WS_WPOOL) + (size_t)layer * 4 * 65536)};
            EpiPool E{(bf16*)(ws + WS_MIXIN), args.in[I_POOLS] + (size_t)layer * PW};
            pg8::gemm_phase<EpiPool, SchedPool, false>(F.lds + RING_OFF, 256, PW, 256, S, E);
            phase_dn_norm(F, args, layer);
            SEAM(pb + 3);
        }
        if (IN(pb + 4)) {
            SchedDense S; S.init(T, D, F.G, (int)blockIdx.x, ws + WS_MIXIN, D, (const bf16*)(ws + WS_WOUT) + (size_t)layer * D * D, D);
            EpiRes E{layer == 0 ? args.in[I_X] : args.out, args.out};
            pg8::gemm_phase<EpiRes, SchedDense, false>(F.lds + RING_OFF, D, D, D, S, E);
            SEAM(pb + 4);
        }
        if (IN(pb + 5)) { phase_ln1_router(F, args, layer); SEAM(pb + 5); }
        if (IN(pb + 6)) {
            moe_table(F, layer);
            SchedMoe S{F.G, (int)blockIdx.x, 0, (const LAS int*)(F.lds + AUX_OFF), (const char*)(ws + WS_X1B), (const char*)((const bf16*)(ws + WS_WGU) + (size_t)layer * NE * 2048 * D), (const int*)(ws + WS_LIST)};
            EpiSwiglu E{(bf16*)(ws + WS_HID)};
            pg8::gemm_phase<EpiSwiglu, SchedMoe, true>(F.lds + RING_OFF, D, D, D, S, E);
            SEAM(pb + 6);
        }
        if (IN(pb + 7)) {
            moe_table(F, layer);
            SchedMoe S{F.G, (int)blockIdx.x, 1, (const LAS int*)(F.lds + AUX_OFF), (const char*)(ws + WS_HID), (const char*)((const bf16*)(ws + WS_WD) + (size_t)layer * NE * D * DE), nullptr};
            EpiBf16 E{(bf16*)(ws + WS_Y), D};
            pg8::gemm_phase<EpiBf16, SchedMoe, false>(F.lds + RING_OFF, DE, DE, DE, S, E);
            SEAM(pb + 7);
        }
        if (IN(pb + 8)) { moe_table(F, layer); phase_combine_ln2(F, args, layer); SEAM(pb + 8); }
        if (IN(pb + 9)) {
            { SchedDense S; S.init(T, D, F.G, (int)blockIdx.x, (const bf16*)(ws + WS_PB16) + (size_t)layer * T * PLE, PLE, (const bf16*)(ws + WS_WPP) + (size_t)layer * D * PLE, PLE);
              EpiBf16 E{(bf16*)(ws + WS_PP), D};
              pg8::gemm_phase<EpiBf16, SchedDense, false>(F.lds + RING_OFF, PLE, PLE, PLE, S, E); }
            { SchedDense S; S.init(T, D, F.G, (int)blockIdx.x, ws + WS_X2B, D, (const bf16*)(ws + WS_WPG) + (size_t)layer * D * D, D);
              EpiPle E{args.out, (const bf16*)(ws + WS_PP), (bf16*)(ws + WS_XB), layer + 1 < DEPTH ? 1 : 0};
              pg8::gemm_phase<EpiPle, SchedDense, false>(F.lds + RING_OFF, D, D, D, S, E); }
            SEAM(pb + 9);
        }
    }
#undef IN
#undef SEAM
#undef GRID_BAR
}

extern "C" void kernel_launch(void* const* d_in, const int* in_sizes, int n_in, void* d_out, int out_size, void* d_ws, size_t ws_size, hipStream_t stream) {
    static int grid = 0;
    if (grid == 0) {
        if (n_in != 21 || in_sizes[0] != T * D || out_size != T * D || ws_size < WS_END) { fprintf(stderr, "kernel_launch: unexpected shapes (n_in %d, in0 %d, out %d, ws %zu); nothing launched\n", n_in, n_in > 0 ? in_sizes[0] : -1, out_size, ws_size); grid = -1; return; }
        int dev = 0, cus = 0, per_cu = 0;
        if (hipGetDevice(&dev) != hipSuccess || hipDeviceGetAttribute(&cus, hipDeviceAttributeMultiprocessorCount, dev) != hipSuccess) { grid = -1; return; }
        if (hipFuncSetAttribute((const void*)trunk_fwd, hipFuncAttributeMaxDynamicSharedMemorySize, LDS_BYTES) != hipSuccess) { fprintf(stderr, "kernel_launch: hipFuncSetAttribute failed\n"); grid = -1; return; }
        if (hipOccupancyMaxActiveBlocksPerMultiprocessor(&per_cu, (const void*)trunk_fwd, NWAVES * 64, LDS_BYTES) != hipSuccess || per_cu < 1) { fprintf(stderr, "kernel_launch: occupancy query reports %d workgroups per CU\n", per_cu); }
        (void)hipGetLastError();
        grid = cus;
    }
    if (grid < 0) return;
    if (hipMemsetAsync((char*)d_ws + WS_CTL, 0, CTL_ZERO_BYTES, stream) != hipSuccess) return;
    Args a{};
    for (int i = 0; i < 21; ++i) a.in[i] = (const float*)d_in[i];
    a.out = (float*)d_out; a.ws = (unsigned char*)d_ws;
    for (int li = 0; li < N_LAUNCHES; ++li) {
        a.ph_lo = (N_LAUNCHES == 1) ? 0 : li; a.ph_hi = (N_LAUNCHES == 1) ? NPHASE : li + 1; a.li = li; a.pad = 0;
        hipLaunchKernelGGL(trunk_fwd, dim3(grid), dim3(NWAVES * 64), LDS_BYTES, stream, a);
        const hipError_t le = hipPeekAtLastError();
        if (le != hipSuccess) { fprintf(stderr, "kernel_launch: launch %d failed: %s\n", li, hipGetErrorName(le)); break; }
    }
}
```

```cpp
#define MK_N_LAUNCHES 1
#include <hip/hip_runtime.h>
#include <cstdio>
#include <cstdint>

#define GAS __attribute__((address_space(1)))
#define LAS __attribute__((address_space(3)))
typedef unsigned short bf16;
typedef unsigned v4u __attribute__((ext_vector_type(4)));
typedef unsigned v2u __attribute__((ext_vector_type(2)));
typedef float f32x4 __attribute__((ext_vector_type(4)));
typedef float f32x2 __attribute__((ext_vector_type(2)));
typedef short bf16x8 __attribute__((ext_vector_type(8)));
typedef GAS unsigned gu32;

namespace pg8 {
constexpr int BM = 256, BK = 64, HALF = 128, HTB = HALF * BK * 2  , STAGE_BYTES = 8 * HTB, NXCD = 8, WGM = 8;
__host__ __device__ __forceinline__ int lds_byte(int r, int c) { const int st = (r >> 4) * 2 + (c >> 5), rr = r & 15, cc = c & 31, ob = rr * 64 + cc * 2; return st * 1024 + (ob ^ (((ob >> 9) & 1) << 5)); }
__host__ __device__ __forceinline__ void stage_rc(int b, int& R, int& C) { const int st = b / 1024, sb = b % 1024, swz = sb ^ (((sb >> 9) & 1) << 5); R = (st >> 1) * 16 + swz / 64; C = (st & 1) * 32 + (swz % 64) / 2; }
__host__ __device__ __forceinline__ int perm32(int rho) { const int n = rho >> 4, i = rho & 15; return 8 * (i >> 2) + 4 * n + (i & 3); }

struct Unit { int pm, pn; const char* A; const char* B; const int* rows; int nvalid; int aux; };

__device__ __forceinline__ unsigned cvt_pk_bf16(float lo, float hi) { unsigned r; asm volatile("v_cvt_pk_bf16_f32 %0, %1, %2" : "=v"(r) : "v"(lo), "v"(hi)); return r; }

template <class Epi, class Sched, bool GATHER>
__device__ __forceinline__ void gemm_phase(LAS unsigned char* lds, const int K, const int lda, const int ldb, const Sched& S, const Epi& E) {
    int tid_ = threadIdx.x; asm volatile("" : "+v"(tid_));
    const int tid = tid_, wid = __builtin_amdgcn_readfirstlane(tid >> 6), lane = tid & 63, wr = wid >> 2, wc = wid & 3, fr = lane & 15, fq = lane >> 4;
    const int nt = K / BK;
    unsigned voffA[2], voffB[2]; int RA[2], CA[2];
#pragma unroll
    for (int i = 0; i < 2; ++i) { int R, C; stage_rc(tid * 16 + i * 8192, R, C); const int Rb = Epi::PERM ? ((R & ~31) + perm32(R & 31)) : R;
        RA[i] = R; CA[i] = C; voffA[i] = (unsigned)(R * lda + C) * 2u; voffB[i] = (unsigned)(Rb * ldb + C) * 2u; }
    unsigned gA[2][2], gN[2][2];
    const size_t kstep = (size_t)(BK * 2);
    const size_t hstepA = GATHER ? 0 : (size_t)HALF * lda * 2, hstepB = (size_t)HALF * ldb * 2;
    const unsigned ldsw = (unsigned)wid * 1024u;
    const int aoff = lds_byte(wr * 64 + fr, fq * 8), boff = lds_byte(wc * 32 + fr, fq * 8);
#define PG8_SA(b, h) (((b) * 2 + (h)) * HTB)
#define PG8_SB(b, h) ((4 + (b) * 2 + (h)) * HTB)
#define PG8_STAGE_B(bufoff, gbase) do { _Pragma("unroll") for (int _i = 0; _i < 2; ++_i) \
        __builtin_amdgcn_global_load_lds((const unsigned*)((const char*)(gbase) + voffB[_i]), (LAS unsigned*)(lds + (bufoff) + ldsw + _i * 8192), 16, 0, 0); } while (0)
#define PG8_STAGE_A(bufoff, gbase, h) do { _Pragma("unroll") for (int _i = 0; _i < 2; ++_i) \
        __builtin_amdgcn_global_load_lds((const unsigned*)((const char*)(gbase) + (GATHER ? gA[h][_i] : voffA[_i]) + (h) * hstepA), (LAS unsigned*)(lds + (bufoff) + ldsw + _i * 8192), 16, 0, 0); } while (0)
#define PG8_LDA(dst, b, h) do { _Pragma("unroll") for (int m = 0; m < 4; ++m) _Pragma("unroll") for (int k = 0; k < 2; ++k) dst[m][k] = *(const LAS bf16x8*)(lds + PG8_SA(b, h) + aoff + m * 2048 + k * 1024); } while (0)
#define PG8_LDB(dst, b, h) do { _Pragma("unroll") for (int n = 0; n < 2; ++n) _Pragma("unroll") for (int k = 0; k < 2; ++k) dst[n][k] = *(const LAS bf16x8*)(lds + PG8_SB(b, h) + boff + n * 2048 + k * 1024); } while (0)
#define PG8_MMA(ai, bj, At, Bt) do { __builtin_amdgcn_s_setprio(1); _Pragma("unroll") for (int m = 0; m < 4; ++m) _Pragma("unroll") for (int n = 0; n < 2; ++n) _Pragma("unroll") for (int k = 0; k < 2; ++k) \
        acc[ai][bj][m][n] = __builtin_amdgcn_mfma_f32_16x16x32_bf16(Bt[n][k], At[m][k], acc[ai][bj][m][n], 0, 0, 0); __builtin_amdgcn_s_setprio(0); } while (0)
#define PG8_WAIT_V(n) asm volatile("s_waitcnt vmcnt(" #n ")" ::: "memory")
#define PG8_WAIT_L(n) asm volatile("s_waitcnt lgkmcnt(" #n ")" ::: "memory")
#define PG8_BAR __builtin_amdgcn_s_barrier()
#define PG8_SCHED __builtin_amdgcn_sched_barrier(0)
#define PG8_GLOAD(dst, u) do { _Pragma("unroll") for (int _h = 0; _h < 2; ++_h) _Pragma("unroll") for (int _i = 0; _i < 2; ++_i) { const int _r = _h * HALF + RA[_i]; \
        const int _t = (_r < (u).nvalid) ? (u).rows[_r] : 0; dst[_h][_i] = (unsigned)(_t * lda + CA[_i]) * 2u; } } while (0)
    Unit cur, nxt; int ui = 0;
    if (!S.next(0, cur)) return;
    f32x4 acc[2][2][4][2];
#pragma unroll
    for (int a = 0; a < 2; ++a)
#pragma unroll
        for (int b = 0; b < 2; ++b)
#pragma unroll
            for (int m = 0; m < 4; ++m)
#pragma unroll
                for (int n = 0; n < 2; ++n) acc[a][b][m][n] = (f32x4){0.f, 0.f, 0.f, 0.f};
    bf16x8 At[4][2], B0[2][2], B1[2][2];
    const char* cA = cur.A; const char* cB = cur.B;
    if constexpr (GATHER) { PG8_GLOAD(gA, cur); PG8_WAIT_V(0); }
    PG8_STAGE_B(PG8_SB(0, 0), cB); PG8_STAGE_B(PG8_SB(0, 1), cB + hstepB); PG8_STAGE_A(PG8_SA(0, 0), cA, 0); PG8_STAGE_A(PG8_SA(0, 1), cA, 1);
    if (wr == 1) PG8_BAR;
    PG8_WAIT_V(2); PG8_BAR;
    PG8_STAGE_B(PG8_SB(1, 0), cB + kstep); PG8_STAGE_A(PG8_SA(1, 0), cA + kstep, 0); PG8_STAGE_B(PG8_SB(1, 1), cB + hstepB + kstep);
    PG8_WAIT_V(6); PG8_BAR;
    for (;;) {
        const bool has_next = S.next(ui + 1, nxt);
        const char* nA = has_next ? nxt.A : cA; const char* nB = has_next ? nxt.B : cB;
        if constexpr (GATHER) { if (has_next) { PG8_GLOAD(gN, nxt); } else {
#pragma unroll
            for (int h = 0; h < 2; ++h)
#pragma unroll
                for (int i = 0; i < 2; ++i) gN[h][i] = gA[h][i]; } }
#pragma unroll 1
        for (int t = 0; t < nt; t += 2) {
            const bool last = (t == nt - 2);
            const char* a1 = cA + (size_t)(t + 1) * kstep;
            const char* a2 = last ? nA : cA + (size_t)(t + 2) * kstep; const char* b2 = last ? nB : cB + (size_t)(t + 2) * kstep;
            const char* a3 = a2 + kstep; const char* b3 = b2 + kstep;
            PG8_LDB(B0, 0, 0); PG8_LDB(B1, 0, 1); PG8_SCHED; PG8_LDA(At, 0, 0); PG8_STAGE_A(PG8_SA(1, 1), a1, 1);
            if constexpr (GATHER) { if (last) {
#pragma unroll
                for (int h = 0; h < 2; ++h)
#pragma unroll
                    for (int i = 0; i < 2; ++i) gA[h][i] = gN[h][i]; } }
            PG8_WAIT_V(8); PG8_WAIT_L(0); PG8_BAR; PG8_MMA(0, 0, At, B0); PG8_MMA(0, 1, At, B1); PG8_BAR; PG8_SCHED;
            PG8_LDA(At, 0, 1); PG8_STAGE_B(PG8_SB(0, 0), b2); PG8_STAGE_B(PG8_SB(0, 1), b2 + hstepB); PG8_STAGE_A(PG8_SA(0, 0), a2, 0);
            PG8_WAIT_V(8); PG8_WAIT_L(0); PG8_BAR; PG8_MMA(1, 0, At, B0); PG8_MMA(1, 1, At, B1); PG8_BAR; PG8_SCHED;
            PG8_LDB(B0, 1, 0); PG8_LDB(B1, 1, 1); PG8_SCHED; PG8_LDA(At, 1, 0); PG8_STAGE_A(PG8_SA(0, 1), a2, 1);
            PG8_WAIT_V(8); PG8_WAIT_L(0); PG8_BAR; PG8_MMA(0, 0, At, B0); PG8_MMA(0, 1, At, B1); PG8_BAR; PG8_SCHED;
            PG8_LDA(At, 1, 1); PG8_STAGE_B(PG8_SB(1, 0), b3); PG8_STAGE_B(PG8_SB(1, 1), b3 + hstepB); PG8_STAGE_A(PG8_SA(1, 0), a3, 0);
            PG8_WAIT_V(8); PG8_WAIT_L(0); PG8_BAR; PG8_MMA(1, 0, At, B0); PG8_MMA(1, 1, At, B1); PG8_BAR; PG8_SCHED;
        }
        if (wr == 0) PG8_BAR;
        E(acc, cur, wr, wc, fr, fq);
        if (!has_next) break;
#pragma unroll
        for (int a = 0; a < 2; ++a)
#pragma unroll
            for (int b = 0; b < 2; ++b)
#pragma unroll
                for (int m = 0; m < 4; ++m)
#pragma unroll
                    for (int n = 0; n < 2; ++n) acc[a][b][m][n] = (f32x4){0.f, 0.f, 0.f, 0.f};
        cur = nxt; cA = nA; cB = nB; ++ui;
        if (wr == 1) PG8_BAR;
    }
    PG8_WAIT_V(0);
    PG8_BAR;
#undef PG8_SA
#undef PG8_SB
#undef PG8_STAGE_A
#undef PG8_STAGE_B
#undef PG8_LDA
#undef PG8_LDB
#undef PG8_MMA
#undef PG8_WAIT_V
#undef PG8_WAIT_L
#undef PG8_BAR
#undef PG8_SCHED
#undef PG8_GLOAD
}
}

constexpr int NB = 4, SEQ = 4096, D = 2048, DEPTH = 2;
constexpr int T = NB * SEQ;
constexpr int NH = 8, HD = 128, DNW = 1024, CH = 64, NCH = SEQ / CH;
constexpr int PW = 1024, PG_DIM = 256;
constexpr int IN_COLS = 5136, NPROJ = 5120;
constexpr int NE = 16, DE = 1024, PLE = 256;
constexpr float ALPHA = 1.4142135623730951f;
constexpr float LN_EPS = 1e-5f, RMS_EPS = 1e-6f;
constexpr int LCAP = T;
constexpr int MAXTILES = 2 * T / 256 + NE;

constexpr size_t MiB = 1u << 20;
constexpr size_t WS_CTL = 0, CTL_ZERO_BYTES = 64 * 1024;
constexpr size_t WS_LIST = 2 * MiB;
constexpr size_t WS_TOKSLOT = 3 * MiB, WS_GATEW = WS_TOKSLOT + 128 * 1024, WS_STATS = WS_GATEW + 128 * 1024, WS_CD = WS_STATS + 128 * 1024, WS_WBA = WS_CD + 128 * 1024;
constexpr size_t WS_WIN = 4 * MiB, WS_WOUT = 44 * MiB, WS_WPG = 60 * MiB, WS_WPP = 76 * MiB, WS_WPOOL = 78 * MiB, WS_WGU = 80 * MiB, WS_WD = 336 * MiB, WS_PB16 = 464 * MiB;
constexpr size_t WS_XB = 480 * MiB, WS_R1 = 544 * MiB, WS_R2 = 704 * MiB, WS_R4 = 848 * MiB, WS_R5 = 944 * MiB, WS_END = 1008 * MiB;
constexpr size_t WS_PROJ = WS_R1, WS_HID = WS_R1;
constexpr size_t WS_U = WS_R2, WS_W = WS_R2 + 32 * MiB, WS_QD = WS_R2 + 64 * MiB, WS_KD = WS_R2 + 96 * MiB, WS_AQK = WS_R2 + 128 * MiB, WS_Y = WS_R2;
constexpr size_t WS_POOLD = WS_R4, WS_O = WS_R4 + 32 * MiB, WS_X1B = WS_R4, WS_PP = WS_R4;
constexpr size_t WS_MIXIN = WS_R5, WS_X2B = WS_R5;
static_assert((size_t)MAXTILES * 256 * 2048 * 2 <= 144 * MiB && (size_t)MAXTILES * 256 * 1024 * 2 <= 160 * MiB, "MoE row buffers");
constexpr int CW_TMO = 0, CW_CODE = 1, CW_CNT = 64  , CW_BAR = 4096;

constexpr int RING_OFF = 0, RING_BYTES = 131072;
constexpr int LDSCTL_OFF = RING_BYTES, MISC_OFF = LDSCTL_OFF + 320;
constexpr int AUX_OFF = LDSCTL_OFF + 1024;
constexpr int LDS_BYTES = 147456;
constexpr int NWAVES = 8;

#define RLX_AGENT __ATOMIC_RELAXED, __HIP_MEMORY_SCOPE_AGENT
#define LDS_WAIT() asm volatile("s_waitcnt lgkmcnt(0)" ::: "memory")
#define VM_WAIT() asm volatile("s_waitcnt vmcnt(0)" ::: "memory")
__device__ __forceinline__ unsigned f2bf(float f) { unsigned u = __builtin_bit_cast(unsigned, f); return (u + 0x7fffu + ((u >> 16) & 1u)) >> 16; }
__device__ __forceinline__ unsigned pk2(float lo, float hi) { return f2bf(lo) | (f2bf(hi) << 16); }
__device__ __forceinline__ float bf2f(unsigned short b) { return __builtin_bit_cast(float, ((unsigned)b) << 16); }
__device__ __forceinline__ float bflo(unsigned w) { return __builtin_bit_cast(float, w << 16); }
__device__ __forceinline__ float bfhi(unsigned w) { return __builtin_bit_cast(float, w & 0xffff0000u); }
__device__ __forceinline__ float sigmoidf_(float x) { return 1.0f / (1.0f + __expf(-x)); }
__device__ __forceinline__ float wave_sum(float v) {
#pragma unroll
    for (int o = 1; o < 64; o <<= 1) v += __shfl_xor(v, o);
    return v;
}
#define XB_TMO      128
#define XB_XCNT(j)  (256  + 64 * (j))
#define XB_XSUB(j)  (1280 + 64 * (j))
#define XB_XGEN(j)  (2304 + 64 * (j))
#define XB_TOP      3328
#define XB_TOPGEN   3392
#define XCD_BAR_WORDS 3456
#define XB_SPIN_CAP (1u << 18)

__device__ __forceinline__ unsigned xb_ld(unsigned* p)              { return __hip_atomic_load(p, __ATOMIC_RELAXED, __HIP_MEMORY_SCOPE_AGENT); }
__device__ __forceinline__ unsigned xb_add(unsigned* p, unsigned v) { return __hip_atomic_fetch_add(p, v, __ATOMIC_RELAXED, __HIP_MEMORY_SCOPE_AGENT); }
__device__ __forceinline__ unsigned xb_xcc_id() { return (unsigned)__builtin_amdgcn_s_getreg((3 << 11) | 20) & 0xFu; }
#define XB_SPIN(cond, bar) do { unsigned _sp = 0; while (cond) { __builtin_amdgcn_s_sleep(1); \
    if ((++_sp & 255u) == 0u) { if (xb_ld(&(bar)[XB_TMO])) break; if (_sp > XB_SPIN_CAP) { atomicAdd(&(bar)[XB_TMO], 1u); break; } } } } while (0)

struct XcdBarrier {
    unsigned* bar; unsigned x;
    volatile LAS unsigned* st;
};

__device__ __forceinline__ XcdBarrier xcd_barrier_post(unsigned* bar, volatile LAS unsigned* st) {
    XcdBarrier b; b.bar = bar; b.x = xb_xcc_id(); b.st = st;
    if (threadIdx.x == 0) (void)xb_add(&bar[XB_XCNT(b.x)], 1u);
    return b;
}
__device__ __forceinline__ void xcd_barrier_complete(unsigned* bar, unsigned x, unsigned& nloc, unsigned& nx) {
    const unsigned G = gridDim.x * gridDim.y * gridDim.z;
    unsigned sum, cnt, mine, sp = 0u;
    for (;;) {
        sum = 0u; cnt = 0u; mine = 0u;
#pragma unroll
        for (unsigned j = 0; j < 16; ++j) { const unsigned c = xb_ld(&bar[XB_XCNT(j)]); sum += c; cnt += (c > 0u) ? 1u : 0u; mine = (j == x) ? c : mine; }
        if (sum == G) break;
        __builtin_amdgcn_s_sleep(1);
        if ((++sp & 255u) == 0u) { if (xb_ld(&bar[XB_TMO])) break; if (sp > XB_SPIN_CAP) { atomicAdd(&bar[XB_TMO], 1u); break; } }
    }
    nloc = mine > 0u ? mine : 1u; nx = cnt > 0u ? cnt : 1u;
}

__device__ __forceinline__ void xcd_barrier(const XcdBarrier& b) {
    asm volatile("s_waitcnt vmcnt(0)" ::: "memory");
    __syncthreads();
    if (threadIdx.x == 0) {
        unsigned* bar = b.bar;
        __builtin_amdgcn_s_waitcnt(0);
        unsigned nloc = b.st[0], nx = b.st[1];
        if (nloc == 0u) { xcd_barrier_complete(bar, b.x, nloc, nx); b.st[0] = nloc; b.st[1] = nx; }
        const unsigned old = xb_add(&bar[XB_XSUB(b.x)], 1u);
        const unsigned gen = old / nloc;
        if (old + 1u == (gen + 1u) * nloc) {
            __builtin_amdgcn_fence(__ATOMIC_RELEASE, "agent");
            asm volatile("s_waitcnt vmcnt(0)" ::: "memory");
            const unsigned og = xb_add(&bar[XB_TOP], 1u);
            const unsigned tg = og / nx;
            if (og + 1u == (tg + 1u) * nx) xb_add(&bar[XB_TOPGEN], 1u);
            else XB_SPIN(xb_ld(&bar[XB_TOPGEN]) == tg, bar);
            __builtin_amdgcn_fence(__ATOMIC_ACQUIRE, "agent");
            xb_add(&bar[XB_XGEN(b.x)], 1u);
            asm volatile("s_waitcnt vmcnt(0)" ::: "memory");
        } else {
            XB_SPIN(xb_ld(&bar[XB_XGEN(b.x)]) == gen, bar);
            __builtin_amdgcn_fence(__ATOMIC_ACQUIRE, "agent");
            asm volatile("s_waitcnt vmcnt(0)" ::: "memory");
        }
    }
    __syncthreads();
}

struct Args { const float* in[21]; float* out; unsigned char* ws; int ph_lo, ph_hi, li, pad; };
enum { I_X = 0, I_P, I_WIN, I_CONVW, I_ALOG, I_DTB, I_NORMW, I_POOLW, I_POOLS, I_WOUT, I_LN1G, I_LN1B, I_WR, I_BR, I_WEG, I_WEU, I_WED, I_LN2G, I_LN2B, I_WPP, I_WPG };
struct Frame {
    LAS unsigned char* lds;
    volatile LAS unsigned* MISC;
    gu32* ctl;
    int tid, lane, wave, vcu, G;
};

#define PHASE_FRAME(F0) Frame F = F0; { int t_ = threadIdx.x; asm volatile("" : "+v"(t_)); F.tid = t_; F.lane = t_ & 63; }
#define OPQ_S(p) asm volatile("" : "+s"(p))
struct SchedDense {
    int nM, nN, nwg, G, c; const char* A; const char* B; size_t astep, bstep;
    __device__ __forceinline__ void init(int M, int N, int G_, int c_, const void* A_, int lda, const void* B_, int ldb) { nM = M / 256; nN = N / 256; nwg = nM * nN; G = G_; c = c_;
        A = (const char*)A_; B = (const char*)B_; astep = (size_t)256 * lda * 2; bstep = (size_t)256 * ldb * 2; }
    __device__ __forceinline__ bool next(int i, pg8::Unit& u) const {
        const long L = (long)i * G + c; if (L >= nwg) return false;
        int wgid = (int)L; { const int q = nwg / 8, r = nwg % 8, xcd = wgid % 8, off = wgid / 8; wgid = (xcd < r ? xcd * (q + 1) : r * (q + 1) + (xcd - r) * q) + off; }
        const int nig = 8 * nN, gid = wgid / nig, fm = gid * 8, gsz = (nM - fm) < 8 ? (nM - fm) : 8;
        u.pm = fm + ((wgid % nig) % gsz); u.pn = (wgid % nig) / gsz;
        u.A = A + (size_t)u.pm * astep; u.B = B + (size_t)u.pn * bstep; u.rows = nullptr; u.nvalid = 256; u.aux = 0; return true;
    }
};
struct SchedPool {
    int G, c; const char* A; const char* B;
    __device__ __forceinline__ bool next(int i, pg8::Unit& u) const {
        const int L = i * G + c; if (L >= 256) return false;
        u.pm = L >> 2; u.pn = L & 3; u.A = A + ((size_t)u.pm * 256 * PW + u.pn * 256) * 2; u.B = B + (size_t)u.pn * 65536 * 2; u.rows = nullptr; u.nvalid = 256; u.aux = 0; return true;
    }
};
struct SchedMoe {
    int G, c, mode; const LAS int* tab; const char* A; const char* B; const int* list;
    __device__ __forceinline__ bool next(int i, pg8::Unit& u) const {
        const int L = i * G + c, rt = L >> 3, pn = L & 7;
        const int ntiles = __builtin_amdgcn_readfirstlane(tab[16]); if (rt >= ntiles) return false;
        int e = 0;
#pragma unroll
        for (int k = 1; k < 16; ++k) { const int ts = __builtin_amdgcn_readfirstlane(tab[k]); if (rt >= ts) e = k; }
        const int ts = __builtin_amdgcn_readfirstlane(tab[e]), cn = __builtin_amdgcn_readfirstlane(tab[32 + e]);
        const int r0 = (rt - ts) * 256;
        u.pm = rt; u.pn = pn; u.aux = e;
        if (mode == 0) { u.A = A; u.rows = list + (size_t)e * LCAP + r0; u.nvalid = (cn - r0) < 256 ? (cn - r0) : 256; u.B = B + ((size_t)e * 2048 + pn * 256) * 2048 * 2; }
        else { u.A = A + (size_t)rt * 256 * DE * 2; u.rows = nullptr; u.nvalid = 256; u.B = B + ((size_t)e * 2048 + pn * 256) * DE * 2; }
        return true;
    }
};

using pg8::cvt_pk_bf16;
struct EpiBf16 {
    static constexpr bool PERM = true; bf16* O; int ldc;
    __device__ __forceinline__ void operator()(const f32x4 (&acc)[2][2][4][2], const pg8::Unit& u, int wr, int wc, int fr, int fq) const {
        const int row0 = u.pm * 256 + wr * 64 + fr, col0 = u.pn * 256 + wc * 32 + 8 * fq;
#pragma unroll
        for (int ai = 0; ai < 2; ++ai)
#pragma unroll
            for (int m = 0; m < 4; ++m) { bf16* rowp = O + (size_t)(row0 + ai * 128 + m * 16) * ldc + col0;
#pragma unroll
                for (int bj = 0; bj < 2; ++bj) { const f32x4 v0 = acc[ai][bj][m][0], v1 = acc[ai][bj][m][1];
                    v4u w; w.x = cvt_pk_bf16(v0[0], v0[1]); w.y = cvt_pk_bf16(v0[2], v0[3]); w.z = cvt_pk_bf16(v1[0], v1[1]); w.w = cvt_pk_bf16(v1[2], v1[3]);
                    *(v4u*)(rowp + bj * 128) = w; } }
    }
};
struct EpiPool {
    static constexpr bool PERM = true; bf16* O; const float* scale;
    __device__ __forceinline__ void operator()(const f32x4 (&acc)[2][2][4][2], const pg8::Unit& u, int wr, int wc, int fr, int fq) const {
        const int row0 = u.pm * 256 + wr * 64 + fr, cg = u.pn * 256 + wc * 32 + 8 * fq;
        f32x4 sv[2][2];
#pragma unroll
        for (int bj = 0; bj < 2; ++bj) { sv[bj][0] = *(const f32x4*)(scale + cg + bj * 128); sv[bj][1] = *(const f32x4*)(scale + cg + bj * 128 + 4); }
#pragma unroll
        for (int ai = 0; ai < 2; ++ai)
#pragma unroll
            for (int m = 0; m < 4; ++m) { bf16* rowp = O + (size_t)(row0 + ai * 128 + m * 16) * D + DNW + cg;
#pragma unroll
                for (int bj = 0; bj < 2; ++bj) { const f32x4 v0 = acc[ai][bj][m][0] * sv[bj][0], v1 = acc[ai][bj][m][1] * sv[bj][1];
                    v4u w; w.x = cvt_pk_bf16(v0[0], v0[1]); w.y = cvt_pk_bf16(v0[2], v0[3]); w.z = cvt_pk_bf16(v1[0], v1[1]); w.w = cvt_pk_bf16(v1[2], v1[3]);
                    *(v4u*)(rowp + bj * 128) = w; } }
    }
};
struct EpiRes {
    static constexpr bool PERM = false; const float* X; float* OUT;
    __device__ __forceinline__ void operator()(const f32x4 (&acc)[2][2][4][2], const pg8::Unit& u, int wr, int wc, int fr, int fq) const {
        const int row0 = u.pm * 256 + wr * 64 + fr, col0 = u.pn * 256 + wc * 32 + 4 * fq;
#pragma unroll
        for (int ai = 0; ai < 2; ++ai)
#pragma unroll
            for (int m = 0; m < 4; ++m) { const size_t off = (size_t)(row0 + ai * 128 + m * 16) * D + col0;
#pragma unroll
                for (int bj = 0; bj < 2; ++bj)
#pragma unroll
                    for (int n = 0; n < 2; ++n) { const f32x4 x = *(const f32x4*)(X + off + bj * 128 + n * 16); *(f32x4*)(OUT + off + bj * 128 + n * 16) = x * ALPHA + acc[ai][bj][m][n]; } }
    }
};
struct EpiSwiglu {
    static constexpr bool PERM = true; bf16* O;
    __device__ __forceinline__ void operator()(const f32x4 (&acc)[2][2][4][2], const pg8::Unit& u, int wr, int wc, int fr, int fq) const {
        const int row0 = u.pm * 256 + wr * 64 + fr, col0 = u.pn * 128 + wc * 32 + 8 * fq;
#pragma unroll
        for (int ai = 0; ai < 2; ++ai)
#pragma unroll
            for (int m = 0; m < 4; ++m) { bf16* rowp = O + (size_t)(row0 + ai * 128 + m * 16) * DE + col0;
                float h[8];
#pragma unroll
                for (int n = 0; n < 2; ++n)
#pragma unroll
                    for (int j = 0; j < 4; ++j) { const float g = acc[ai][0][m][n][j], up = acc[ai][1][m][n][j]; h[4 * n + j] = g * sigmoidf_(g) * up; }
                v4u w; w.x = cvt_pk_bf16(h[0], h[1]); w.y = cvt_pk_bf16(h[2], h[3]); w.z = cvt_pk_bf16(h[4], h[5]); w.w = cvt_pk_bf16(h[6], h[7]);
                *(v4u*)rowp = w; }
    }
};
struct EpiPle {
    static constexpr bool PERM = true; float* OUT; const bf16* PP; bf16* XB; int write_xb;
    __device__ __forceinline__ void operator()(const f32x4 (&acc)[2][2][4][2], const pg8::Unit& u, int wr, int wc, int fr, int fq) const {
        const int row0 = u.pm * 256 + wr * 64 + fr, col0 = u.pn * 256 + wc * 32 + 8 * fq;
#pragma unroll
        for (int ai = 0; ai < 2; ++ai)
#pragma unroll
            for (int m = 0; m < 4; ++m) { const size_t off0 = (size_t)(row0 + ai * 128 + m * 16) * D + col0;
#pragma unroll
                for (int bj = 0; bj < 2; ++bj) { const size_t off = off0 + bj * 128;
                    const f32x4 xa = *(const f32x4*)(OUT + off), xb = *(const f32x4*)(OUT + off + 4); const v4u pp = *(const v4u*)(PP + off);
                    const f32x4 a0 = acc[ai][bj][m][0], a1 = acc[ai][bj][m][1];
                    f32x4 o0, o1;
                    o0[0] = xa[0] + sigmoidf_(a0[0]) * bflo(pp.x); o0[1] = xa[1] + sigmoidf_(a0[1]) * bfhi(pp.x); o0[2] = xa[2] + sigmoidf_(a0[2]) * bflo(pp.y); o0[3] = xa[3] + sigmoidf_(a0[3]) * bfhi(pp.y);
                    o1[0] = xb[0] + sigmoidf_(a1[0]) * bflo(pp.z); o1[1] = xb[1] + sigmoidf_(a1[1]) * bfhi(pp.z); o1[2] = xb[2] + sigmoidf_(a1[2]) * bflo(pp.w); o1[3] = xb[3] + sigmoidf_(a1[3]) * bfhi(pp.w);
                    *(f32x4*)(OUT + off) = o0; *(f32x4*)(OUT + off + 4) = o1;
                    if (write_xb) { v4u w; w.x = cvt_pk_bf16(o0[0], o0[1]); w.y = cvt_pk_bf16(o0[2], o0[3]); w.z = cvt_pk_bf16(o1[0], o1[1]); w.w = cvt_pk_bf16(o1[2], o1[3]); *(v4u*)(XB + off) = w; } } }
    }
};

__device__ __forceinline__ void tr_item(const float* W, int ldw, int k0, int n0, bf16* WT, size_t drow0, int ldt, LAS float* scr, int lane) {
#pragma unroll 8
    for (int i = 0; i < 32; ++i) { const int kk = 2 * i + (lane >> 5); scr[kk * 33 + (lane & 31)] = W[(size_t)(k0 + kk) * ldw + n0 + (lane & 31)]; }
    LDS_WAIT(); asm volatile("" ::: "memory");
    const int c = lane & 7;
#pragma unroll
    for (int j = 0; j < 4; ++j) { const int n = (lane >> 3) + 8 * j; const LAS float* s = scr + (8 * c) * 33 + n;
        v4u o; o.x = pk2(s[0 * 33], s[1 * 33]); o.y = pk2(s[2 * 33], s[3 * 33]); o.z = pk2(s[4 * 33], s[5 * 33]); o.w = pk2(s[6 * 33], s[7 * 33]);
        *(GAS v4u*)(WT + (drow0 + n) * ldt + k0 + 8 * c) = o; }
    LDS_WAIT(); asm volatile("" ::: "memory");
}
__device__ __forceinline__ void p0_prologue(const Frame& F0, const Args& a) {
    PHASE_FRAME(F0);
    LAS float* scr = (LAS float*)(F.lds + RING_OFF + F.wave * 16384);
    const int gw = F.vcu * NWAVES + F.wave, NGW = F.G * NWAVES;
    unsigned char* ws = a.ws; OPQ_S(ws);
    constexpr int I_INA = 32 * 128, I_INB = 32 * 32, I_OUT = 32 * 64, I_PG = 32 * 64, I_PP = 4 * 64, I_POOL = 4 * 32, I_EG = NE * 32 * 32, I_EU = I_EG, I_ED = NE * 16 * 64;
    constexpr int I_LAYER = I_INA + I_INB + I_OUT + I_PG + I_PP + I_POOL + I_EG + I_EU + I_ED;
    for (int it = gw; it < DEPTH * I_LAYER; it += NGW) {
        const int l = it / I_LAYER; int r = it - l * I_LAYER;
        if (r < I_INA) { const int kb = r / 128, nb = r % 128; tr_item(a.in[I_WIN] + (size_t)l * D * IN_COLS, IN_COLS, 64 * kb, 32 * nb, (bf16*)(ws + WS_WIN) + (size_t)l * NPROJ * D, 32 * nb, D, scr, F.lane); continue; } r -= I_INA;
        if (r < I_INB) { const int kb = r / 32, nb = r % 32; tr_item(a.in[I_WIN] + (size_t)l * D * IN_COLS, IN_COLS, 64 * kb, 4112 + 32 * nb, (bf16*)(ws + WS_WIN) + (size_t)l * NPROJ * D, 4096 + 32 * nb, D, scr, F.lane); continue; } r -= I_INB;
        if (r < I_OUT) { const int kb = r / 64, nb = r % 64; tr_item(a.in[I_WOUT] + (size_t)l * D * D, D, 64 * kb, 32 * nb, (bf16*)(ws + WS_WOUT) + (size_t)l * D * D, 32 * nb, D, scr, F.lane); continue; } r -= I_OUT;
        if (r < I_PG) { const int kb = r / 64, nb = r % 64; tr_item(a.in[I_WPG] + (size_t)l * D * D, D, 64 * kb, 32 * nb, (bf16*)(ws + WS_WPG) + (size_t)l * D * D, 32 * nb, D, scr, F.lane); continue; } r -= I_PG;
        if (r < I_PP) { const int kb = r / 64, nb = r % 64; tr_item(a.in[I_WPP] + (size_t)l * PLE * D, D, 64 * kb, 32 * nb, (bf16*)(ws + WS_WPP) + (size_t)l * D * PLE, 32 * nb, PLE, scr, F.lane); continue; } r -= I_PP;
        if (r < I_POOL) { const int g = r / 32, rr = r % 32, kb = rr / 8, nb = rr % 8; tr_item(a.in[I_POOLW] + ((size_t)l * 4 + g) * 65536, 256, 64 * kb, 32 * nb, (bf16*)(ws + WS_WPOOL) + ((size_t)l * 4 + g) * 65536, 32 * nb, 256, scr, F.lane); continue; } r -= I_POOL;
        if (r < I_EG) { const int e = r / 1024, rr = r % 1024, kb = rr / 32, nb = rr % 32, h0 = 32 * nb;
            tr_item(a.in[I_WEG] + ((size_t)l * NE + e) * D * DE, DE, 64 * kb, h0, (bf16*)(ws + WS_WGU) + ((size_t)l * NE + e) * 2048 * D, (size_t)(h0 >> 7) * 256 + (h0 & 127), D, scr, F.lane); continue; } r -= I_EG;
        if (r < I_EU) { const int e = r / 1024, rr = r % 1024, kb = rr / 32, nb = rr % 32, h0 = 32 * nb;
            tr_item(a.in[I_WEU] + ((size_t)l * NE + e) * D * DE, DE, 64 * kb, h0, (bf16*)(ws + WS_WGU) + ((size_t)l * NE + e) * 2048 * D, (size_t)(h0 >> 7) * 256 + 128 + (h0 & 127), D, scr, F.lane); continue; } r -= I_EU;
        { const int e = r / 1024, rr = r % 1024, kb = rr / 64, nb = rr % 64;
            tr_item(a.in[I_WED] + ((size_t)l * NE + e) * DE * D, D, 64 * kb, 32 * nb, (bf16*)(ws + WS_WD) + ((size_t)l * NE + e) * D * DE, 32 * nb, DE, scr, F.lane); }
    }
    const size_t gt = (size_t)F.vcu * 512 + F.tid, NGT = (size_t)F.G * 512;
    { const GAS f32x4* src = (const GAS f32x4*)a.in[I_X]; GAS v4u* dst = (GAS v4u*)(ws + WS_XB);
        for (size_t i = gt; i < (size_t)T * D / 8; i += NGT) { const f32x4 v0 = src[2 * i], v1 = src[2 * i + 1]; v4u o; o.x = pk2(v0[0], v0[1]); o.y = pk2(v0[2], v0[3]); o.z = pk2(v1[0], v1[1]); o.w = pk2(v1[2], v1[3]); dst[i] = o; } }
    { const GAS f32x4* src = (const GAS f32x4*)a.in[I_P]; GAS v4u* dst = (GAS v4u*)(ws + WS_PB16);
        for (size_t i = gt; i < (size_t)DEPTH * T * PLE / 8; i += NGT) { const f32x4 v0 = src[2 * i], v1 = src[2 * i + 1]; v4u o; o.x = pk2(v0[0], v0[1]); o.y = pk2(v0[2], v0[3]); o.z = pk2(v1[0], v1[1]); o.w = pk2(v1[2], v1[3]); dst[i] = o; } }
    for (size_t i = gt; i < (size_t)DEPTH * 16 * D; i += NGT) { const int l = (int)(i / (16 * D)), j = (int)((i / D) % 16), k = (int)(i % D);
        ((bf16*)(ws + WS_WBA))[i] = (bf16)f2bf(a.in[I_WIN][((size_t)l * D + k) * IN_COLS + 4096 + j]); }
}

constexpr int QS_LD = 132, AS_LD = 68;
__device__ __forceinline__ void phase_dn_prep(const Frame& F0, const Args& a, int layer) {
    PHASE_FRAME(F0);
    unsigned char* ws = a.ws; OPQ_S(ws);
    LAS float* QS = (LAS float*)F.lds; LAS float* KS = QS + 64 * QS_LD; LAS float* VS = KS + 64 * QS_LD; LAS float* AS = VS + 64 * QS_LD;
    LAS float* betaS = AS + 64 * AS_LD; LAS float* gS = betaS + 512; LAS float* gamh = gS + 512; LAS float* betah = gamh + 64; LAS float* egam = betah + 64; LAS float* bgam = egam + 64; LAS float* ekd = bgam + 64;
    const bf16* XB = (const bf16*)(ws + WS_XB); const bf16* PROJ = (const bf16*)(ws + WS_PROJ); const bf16* WBA = (const bf16*)(ws + WS_WBA) + (size_t)layer * 16 * D;
    bf16* U = (bf16*)(ws + WS_U); bf16* W = (bf16*)(ws + WS_W); bf16* QD = (bf16*)(ws + WS_QD); bf16* KD = (bf16*)(ws + WS_KD); bf16* AQK = (bf16*)(ws + WS_AQK); float* CD = (float*)(ws + WS_CD);
    bf16* POOLD = (bf16*)(ws + WS_POOLD);
    const float* convw = a.in[I_CONVW] + (size_t)layer * 4 * 3072; const float* alog = a.in[I_ALOG] + layer * NH; const float* dtb = a.in[I_DTB] + layer * NH;
    const int tid = F.tid;
    for (int unit = F.vcu; unit < NB * NCH; unit += F.G) {
        const int b = unit / NCH, n = unit % NCH, r0 = b * SEQ + n * CH, sq0 = n * CH;
        { const int col = 2 * tid, win = 2 << (col >> 8); const bf16* up = PROJ + (size_t)r0 * NPROJ + 4096 + col;
            float s0 = 0.f, s1 = 0.f;
            for (int j = 1; j < win; ++j) if (sq0 - j >= 0) { const unsigned w = *(const unsigned*)(up - (ptrdiff_t)j * NPROJ); s0 += bflo(w); s1 += bfhi(w); }
            for (int i = 0; i < CH; ++i) { const unsigned w = *(const unsigned*)(up + (size_t)i * NPROJ); const float x0 = bflo(w), x1 = bfhi(w); s0 += x0; s1 += x1;
                const int pos = sq0 + i; const float inv = 1.0f / (float)((pos + 1) < win ? (pos + 1) : win);
                *(unsigned*)(POOLD + (size_t)(r0 + i) * PW + col) = pk2(s0 * inv - x0, s1 * inv - x1);
                if (pos - win + 1 >= 0) { const unsigned wo = *(const unsigned*)(up + (ptrdiff_t)(i - win + 1) * NPROJ); s0 -= bflo(wo); s1 -= bfhi(wo); } } }
        { const int tok = tid >> 3, cp = tid & 7; const bf16* xr = XB + (size_t)(r0 + tok) * D; const bf16* w0 = WBA + (size_t)(2 * cp) * D; const bf16* w1 = w0 + D;
            float s0 = 0.f, s1 = 0.f;
            for (int k = 0; k < D; k += 8) { const v4u xv = *(const v4u*)(xr + k), av = *(const v4u*)(w0 + k), bv = *(const v4u*)(w1 + k);
#pragma unroll
                for (int j = 0; j < 4; ++j) { const float xl = bflo(xv[j]), xh = bfhi(xv[j]); s0 += xl * bflo(av[j]) + xh * bfhi(av[j]); s1 += xl * bflo(bv[j]) + xh * bfhi(bv[j]); } }
            if (cp < 4) { betaS[tok * 8 + 2 * cp] = sigmoidf_(s0); betaS[tok * 8 + 2 * cp + 1] = sigmoidf_(s1); }
            else { const int h = 2 * (cp - 4);
                const float z0 = s0 + dtb[h], z1 = s1 + dtb[h + 1];
                const float sp0 = z0 > 20.f ? z0 : log1pf(__expf(z0)), sp1 = z1 > 20.f ? z1 : log1pf(__expf(z1));
                gS[tok * 8 + h] = -__expf(alog[h]) * sp0; gS[tok * 8 + h + 1] = -__expf(alog[h + 1]) * sp1; } }
        __syncthreads();
        if (tid < 8) { float run = 0.f; for (int t = 0; t < CH; ++t) { run += gS[t * 8 + tid]; gS[t * 8 + tid] = run; } }
        __syncthreads();
        for (int h = 0; h < NH; ++h) {
            const size_t chd = (size_t)unit * NH + h;
            { const int c = tid & 127, rg = tid >> 7;
#pragma unroll
                for (int part = 0; part < 3; ++part) { const int col = part * 1024 + h * HD + c; LAS float* tile = part == 0 ? QS : (part == 1 ? KS : VS);
                    const float cw0 = convw[col], cw1 = convw[3072 + col], cw2 = convw[2 * 3072 + col], cw3 = convw[3 * 3072 + col];
                    const bf16* src = PROJ + (size_t)(r0 + rg * 16) * NPROJ + col; const int s = sq0 + rg * 16;
                    float xm3 = (s - 3 >= 0) ? bf2f(*(src - 3 * (ptrdiff_t)NPROJ)) : 0.f, xm2 = (s - 2 >= 0) ? bf2f(*(src - 2 * (ptrdiff_t)NPROJ)) : 0.f, xm1 = (s - 1 >= 0) ? bf2f(*(src - (ptrdiff_t)NPROJ)) : 0.f;
#pragma unroll 4
                    for (int i = 0; i < 16; ++i) { const float x = bf2f(src[(size_t)i * NPROJ]); const float y = cw0 * xm3 + cw1 * xm2 + cw2 * xm1 + cw3 * x;
                        tile[(rg * 16 + i) * QS_LD + c] = y * sigmoidf_(y); xm3 = xm2; xm2 = xm1; xm1 = x; } } }
            if (tid < 64) { const float gi = gS[tid * 8 + h], bi = betaS[tid * 8 + h], eg = __expf(gi); gamh[tid] = gi; betah[tid] = bi; egam[tid] = eg; bgam[tid] = bi * eg; ekd[tid] = __expf(gS[63 * 8 + h] - gi); }
            __syncthreads();
            { const int tok = tid >> 3, part = tid & 7; LAS float* qp = QS + tok * QS_LD + part * 16; LAS float* kp = KS + tok * QS_LD + part * 16;
                f32x4 qv[4], kv[4]; float sq = 0.f, sk = 0.f;
#pragma unroll
                for (int j = 0; j < 4; ++j) { qv[j] = *(LAS f32x4*)(qp + 4 * j); kv[j] = *(LAS f32x4*)(kp + 4 * j);
                    sq += (qv[j][0] * qv[j][0] + qv[j][1] * qv[j][1]) + (qv[j][2] * qv[j][2] + qv[j][3] * qv[j][3]); sk += (kv[j][0] * kv[j][0] + kv[j][1] * kv[j][1]) + (kv[j][2] * kv[j][2] + kv[j][3] * kv[j][3]); }
                sq += __shfl_xor(sq, 1); sq += __shfl_xor(sq, 2); sq += __shfl_xor(sq, 4); sk += __shfl_xor(sk, 1); sk += __shfl_xor(sk, 2); sk += __shfl_xor(sk, 4);
                const float rq = 1.0f / sqrtf(sq + RMS_EPS) * 0.08838834764831845f, rk = 1.0f / sqrtf(sk + RMS_EPS);
#pragma unroll
                for (int j = 0; j < 4; ++j) { *(LAS f32x4*)(qp + 4 * j) = qv[j] * rq; *(LAS f32x4*)(kp + 4 * j) = kv[j] * rk; } }
            __syncthreads();
            { const int i = tid >> 3, jb = tid & 7;
                for (int jj = 0; jj < 8; ++jj) { const int j = jb + 8 * jj; float av = 0.f, aq = 0.f;
                    if (j <= i) { float kk = 0.f, qk = 0.f; const LAS float* ki = KS + i * QS_LD; const LAS float* qi = QS + i * QS_LD; const LAS float* kj = KS + j * QS_LD;
#pragma unroll 8
                        for (int d = 0; d < HD; d += 4) { const f32x4 a4 = *(const LAS f32x4*)(ki + d), q4 = *(const LAS f32x4*)(qi + d), b4 = *(const LAS f32x4*)(kj + d);
                            kk += (a4[0] * b4[0] + a4[1] * b4[1]) + (a4[2] * b4[2] + a4[3] * b4[3]); qk += (q4[0] * b4[0] + q4[1] * b4[1]) + (q4[2] * b4[2] + q4[3] * b4[3]); }
                        const float dec = __expf(gamh[i] - gamh[j]); aq = qk * dec; av = (j < i) ? betah[i] * kk * dec : 0.f; }
                    AS[i * AS_LD + j] = av; AQK[chd * 4096 + i * 64 + j] = (bf16)f2bf(aq); } }
            __syncthreads();
#ifndef NO_INV
            if (F.wave == 0) { float Tc[64];
                unsigned asb = (unsigned)(uintptr_t)AS; int ln = F.lane; asm volatile("" : "+v"(asb), "+v"(ln));
                const LAS float* ASv = (const LAS float*)(uintptr_t)asb;
#pragma unroll
                for (int i = 0; i < 64; ++i) { float acc = (i == ln) ? 1.f : 0.f;
#pragma unroll
                    for (int j4 = 0; j4 < (i + 3) / 4; ++j4) { const f32x4 a4 = *(const LAS f32x4*)(ASv + i * AS_LD + 4 * j4);
#pragma unroll
                        for (int q = 0; q < 4; ++q) if (4 * j4 + q < i) acc -= a4[q] * Tc[4 * j4 + q]; }
                    Tc[i] = acc; }
                LDS_WAIT();
                LAS float* ASw = (LAS float*)(uintptr_t)asb + ln;
#pragma unroll
                for (int i = 0; i < 64; ++i) ASw[i * AS_LD] = Tc[i]; }
#endif
            __syncthreads();
            { const int c = tid & 127, rg = tid >> 7; float accu[16], accw[16];
#pragma unroll
                for (int ii = 0; ii < 16; ++ii) { accu[ii] = 0.f; accw[ii] = 0.f; }
                for (int j4 = 0; j4 < 4 * (rg + 1); ++j4) { float vb[4], kb[4];
#pragma unroll
                    for (int q = 0; q < 4; ++q) { const int j = 4 * j4 + q; vb[q] = VS[j * QS_LD + c] * betah[j]; kb[q] = KS[j * QS_LD + c] * bgam[j]; }
#pragma unroll
                    for (int ii = 0; ii < 16; ++ii) { const f32x4 t4 = *(const LAS f32x4*)(AS + (rg * 16 + ii) * AS_LD + 4 * j4);
                        accu[ii] += (t4[0] * vb[0] + t4[1] * vb[1]) + (t4[2] * vb[2] + t4[3] * vb[3]); accw[ii] += (t4[0] * kb[0] + t4[1] * kb[1]) + (t4[2] * kb[2] + t4[3] * kb[3]); } }
#pragma unroll
                for (int ii = 0; ii < 16; ++ii) { const int i = rg * 16 + ii; const size_t o = (size_t)(r0 + i) * DNW + h * HD + c;
                    U[o] = (bf16)f2bf(accu[ii]); W[o] = (bf16)f2bf(accw[ii]); QD[o] = (bf16)f2bf(QS[i * QS_LD + c] * egam[i]); KD[o] = (bf16)f2bf(KS[i * QS_LD + c] * ekd[i]); } }
            if (tid == 0) CD[chd] = egam[63];
            __syncthreads();
        }
    }
}

constexpr int SC_LD = 136, SC_ALD = 72;
__device__ __forceinline__ void phase_dn_scan(const Frame& F0, const Args& a) {
    PHASE_FRAME(F0);
    unsigned char* ws = a.ws; OPQ_S(ws);
    LAS bf16* WSm = (LAS bf16*)F.lds; LAS bf16* QDm = WSm + 64 * SC_LD; LAS bf16* KDm = QDm + 64 * SC_LD; LAS bf16* AQm = KDm + 64 * SC_LD;
    LAS float* Um = (LAS float*)(AQm + 64 * SC_ALD); LAS float* Sm = Um + 64 * 16; LAS float* Vn = Sm + 128 * 16;
    const bf16* U = (const bf16*)(ws + WS_U); const bf16* W = (const bf16*)(ws + WS_W); const bf16* QD = (const bf16*)(ws + WS_QD); const bf16* KD = (const bf16*)(ws + WS_KD); const bf16* AQK = (const bf16*)(ws + WS_AQK);
    const float* CD = (const float*)(ws + WS_CD); float* O = (float*)(ws + WS_O);
    const int tid = F.tid;
    for (int unit = F.vcu; unit < NB * NH * 8; unit += F.G) {
        const int b = unit >> 6, h = (unit >> 3) & 7, sl = unit & 7, c0 = h * HD + sl * 16;
        for (int i = tid; i < 128 * 16; i += 512) Sm[i] = 0.f;
        v4u rw[2], rq[2], rk[2], ra; v4u ru = (v4u){0u, 0u, 0u, 0u};
#define SC_ISSUE(nn) do { const size_t row0_ = (size_t)b * SEQ + (size_t)(nn) * CH; const size_t chd_ = ((size_t)b * NCH + (nn)) * NH + h; \
            _Pragma("unroll") for (int q = 0; q < 2; ++q) { const int p = tid + 512 * q, row = p >> 4, seg = p & 15; const size_t o = (row0_ + row) * DNW + h * HD + seg * 8; \
                rw[q] = *(const v4u*)(W + o); rq[q] = *(const v4u*)(QD + o); rk[q] = *(const v4u*)(KD + o); } \
            ra = *(const v4u*)(AQK + chd_ * 4096 + tid * 8); \
            if (tid < 128) { const int row = tid >> 1, hf = tid & 1; ru = *(const v4u*)(U + (row0_ + row) * DNW + c0 + hf * 8); } } while (0)
        SC_ISSUE(0);
        for (int n = 0; n < NCH; ++n) {
            const size_t row0 = (size_t)b * SEQ + (size_t)n * CH; const float cd = CD[((size_t)b * NCH + n) * NH + h];
#pragma unroll
            for (int q = 0; q < 2; ++q) { const int p = tid + 512 * q, row = p >> 4, seg = p & 15;
                *(LAS v4u*)(WSm + row * SC_LD + seg * 8) = rw[q]; *(LAS v4u*)(QDm + row * SC_LD + seg * 8) = rq[q]; *(LAS v4u*)(KDm + row * SC_LD + seg * 8) = rk[q]; }
            { const int row = tid >> 3, seg = tid & 7; *(LAS v4u*)(AQm + row * SC_ALD + seg * 8) = ra; }
            if (tid < 128) { const int row = tid >> 1, hf = tid & 1; LAS float* up = Um + row * 16 + hf * 8;
                up[0] = bflo(ru.x); up[1] = bfhi(ru.x); up[2] = bflo(ru.y); up[3] = bfhi(ru.y); up[4] = bflo(ru.z); up[5] = bfhi(ru.z); up[6] = bflo(ru.w); up[7] = bfhi(ru.w); }
            __syncthreads();
            if (n + 1 < NCH) SC_ISSUE(n + 1);
            const int i = tid >> 3, cq = tid & 7;
            float ws0 = 0.f, ws1 = 0.f, qs0 = 0.f, qs1 = 0.f;
#pragma unroll 4
            for (int k4 = 0; k4 < 32; ++k4) { const v2u wv = *(const LAS v2u*)(WSm + i * SC_LD + 4 * k4), qv = *(const LAS v2u*)(QDm + i * SC_LD + 4 * k4);
                const float wf[4] = {bflo(wv.x), bfhi(wv.x), bflo(wv.y), bfhi(wv.y)}, qf[4] = {bflo(qv.x), bfhi(qv.x), bflo(qv.y), bfhi(qv.y)};
#pragma unroll
                for (int kk = 0; kk < 4; ++kk) { const f32x2 s2 = *(const LAS f32x2*)(Sm + (4 * k4 + kk) * 16 + 2 * cq); ws0 += wf[kk] * s2[0]; ws1 += wf[kk] * s2[1]; qs0 += qf[kk] * s2[0]; qs1 += qf[kk] * s2[1]; } }
            { const f32x2 u2 = *(const LAS f32x2*)(Um + i * 16 + 2 * cq); *(LAS f32x2*)(Vn + i * 16 + 2 * cq) = (f32x2){u2[0] - ws0, u2[1] - ws1}; }
            __syncthreads();
            float o0 = qs0, o1 = qs1;
#pragma unroll 4
            for (int j4 = 0; j4 < 16; ++j4) { const v2u av = *(const LAS v2u*)(AQm + i * SC_ALD + 4 * j4); const float af[4] = {bflo(av.x), bfhi(av.x), bflo(av.y), bfhi(av.y)};
#pragma unroll
                for (int jj = 0; jj < 4; ++jj) { const f32x2 v2 = *(const LAS f32x2*)(Vn + (4 * j4 + jj) * 16 + 2 * cq); o0 += af[jj] * v2[0]; o1 += af[jj] * v2[1]; } }
            *(f32x2*)(O + (row0 + i) * DNW + c0 + 2 * cq) = (f32x2){o0, o1};
            { const int k = tid >> 2, c4 = (tid & 3) * 4; f32x4 s4 = *(const LAS f32x4*)(Sm + k * 16 + c4) * cd;
#pragma unroll 4
                for (int t = 0; t < CH; ++t) { const float kd = bf2f(KDm[t * SC_LD + k]); const f32x4 v4 = *(const LAS f32x4*)(Vn + t * 16 + c4); s4 += v4 * kd; }
                *(LAS f32x4*)(Sm + k * 16 + c4) = s4; }
            __syncthreads();
        }
    }
}

__device__ __forceinline__ void phase_dn_norm(const Frame& F0, const Args& a, int layer) {
    PHASE_FRAME(F0);
    unsigned char* ws = a.ws; OPQ_S(ws); const float* O = (const float*)(ws + WS_O); const bf16* PROJ = (const bf16*)(ws + WS_PROJ); bf16* MIXIN = (bf16*)(ws + WS_MIXIN);
    const float* nw = a.in[I_NORMW] + layer * HD; const f32x2 nw2 = *(const f32x2*)(nw + 2 * F.lane);
    const int gw = F.vcu * NWAVES + F.wave, NGW = F.G * NWAVES;
    for (int it = gw; it < T * NH; it += NGW) { const int tok = it >> 3, h = it & 7;
        const f32x2 o = *(const f32x2*)(O + (size_t)tok * DNW + h * HD + 2 * F.lane);
        const float ss = wave_sum(o[0] * o[0] + o[1] * o[1]); const float r = 1.0f / sqrtf(ss * (1.0f / HD) + RMS_EPS);
        const unsigned zz = *(const unsigned*)(PROJ + (size_t)tok * NPROJ + 3072 + h * HD + 2 * F.lane); const float z0 = bflo(zz), z1 = bfhi(zz);
        *(unsigned*)(MIXIN + (size_t)tok * D + h * HD + 2 * F.lane) = pk2(o[0] * r * nw2[0] * z0 * sigmoidf_(z0), o[1] * r * nw2[1] * z1 * sigmoidf_(z1)); }
}

__device__ __forceinline__ void phase_ln1_router(const Frame& F0, const Args& a, int layer) {
    PHASE_FRAME(F0);
    unsigned char* ws = a.ws; OPQ_S(ws);
    LAS float* WRt = (LAS float*)F.lds;
    LAS int* rowE = (LAS int*)(F.lds + AUX_OFF); LAS int* rowP = rowE + 128; LAS float* rowG = (LAS float*)(rowP + 128); LAS int* lcnt = (LAS int*)(rowG + 128); LAS int* lbase = lcnt + 16;
    const float* wr = a.in[I_WR]; const float* br = a.in[I_BR]; OPQ_S(wr); OPQ_S(br);
    for (int idx = F.tid; idx < D * NE; idx += 512) WRt[(idx & 15) * D + (idx >> 4)] = wr[idx];
    const float* PRE = a.out; bf16* X1B = (bf16*)(ws + WS_X1B); float* STATS = (float*)(ws + WS_STATS);
    const float* g1 = a.in[I_LN1G] + (size_t)layer * D; const float* b1 = a.in[I_LN1B] + (size_t)layer * D;
    int* LIST = (int*)(ws + WS_LIST); int* TOKSLOT = (int*)(ws + WS_TOKSLOT); float* GATEW = (float*)(ws + WS_GATEW);
    gu32* cnt = F.ctl + CW_CNT + 64 * layer;
    float brv[16];
#pragma unroll
    for (int e = 0; e < 16; ++e) brv[e] = br[e];
    for (int rb = F.vcu; rb < T / 64; rb += F.G) {
        if (F.tid < 16) lcnt[F.tid] = 0;
        __syncthreads();
        for (int r = 0; r < 8; ++r) { const int lr = F.wave * 8 + r, row = rb * 64 + lr;
            const GAS f32x4* xr = (const GAS f32x4*)(PRE + (size_t)row * D) + F.lane;
            f32x4 v[8]; float s = 0.f;
#pragma unroll
            for (int j = 0; j < 8; ++j) { v[j] = xr[64 * j]; s += (v[j][0] + v[j][1]) + (v[j][2] + v[j][3]); }
            const float mean = wave_sum(s) * (1.f / D); float s2 = 0.f;
#pragma unroll
            for (int j = 0; j < 8; ++j) { v[j] = v[j] - mean; s2 += (v[j][0] * v[j][0] + v[j][1] * v[j][1]) + (v[j][2] * v[j][2] + v[j][3] * v[j][3]); }
            const float rstd = 1.f / sqrtf(wave_sum(s2) * (1.f / D) + LN_EPS);
            if (F.lane == 0) { STATS[2 * row] = mean; STATS[2 * row + 1] = rstd; }
            GAS v2u* o8 = (GAS v2u*)(X1B + (size_t)row * D) + F.lane;
            float lg[16];
#pragma unroll
            for (int e = 0; e < 16; ++e) lg[e] = 0.f;
#pragma unroll
            for (int j = 0; j < 8; ++j) { const f32x4 gg = *(const f32x4*)(g1 + 256 * j + 4 * F.lane), bb = *(const f32x4*)(b1 + 256 * j + 4 * F.lane);
                v[j] = v[j] * rstd * gg + bb;
                v2u w; w.x = pk2(v[j][0], v[j][1]); w.y = pk2(v[j][2], v[j][3]); o8[64 * j] = w;
#pragma unroll
                for (int e = 0; e < 16; ++e) { const f32x4 w4 = *(const LAS f32x4*)(WRt + e * D + 256 * j + 4 * F.lane); lg[e] += (v[j][0] * w4[0] + v[j][1] * w4[1]) + (v[j][2] * w4[2] + v[j][3] * w4[3]); } }
            float mx = -3.0e38f;
#pragma unroll
            for (int e = 0; e < 16; ++e) { lg[e] = wave_sum(lg[e]) + brv[e]; mx = fmaxf(mx, lg[e]); }
            float p[16];
#pragma unroll
            for (int e = 0; e < 16; ++e) p[e] = __expf(lg[e] - mx);
            float gsc[4];
#pragma unroll
            for (int g = 0; g < 4; ++g) { const float a0 = p[4 * g], a1 = p[4 * g + 1], a2 = p[4 * g + 2], a3 = p[4 * g + 3];
                const float hi1 = fmaxf(a0, a1), lo1 = fminf(a0, a1), hi2 = fmaxf(a2, a3), lo2 = fminf(a2, a3);
                gsc[g] = fmaxf(hi1, hi2) + fmaxf(fminf(hi1, hi2), fmaxf(lo1, lo2)); }
            int gsel = 0; float best = gsc[0];
#pragma unroll
            for (int g = 1; g < 4; ++g) if (gsc[g] > best) { best = gsc[g]; gsel = g; }
            float q[4];
#pragma unroll
            for (int j = 0; j < 4; ++j) q[j] = gsel == 0 ? p[j] : (gsel == 1 ? p[4 + j] : (gsel == 2 ? p[8 + j] : p[12 + j]));
            int i0 = 0; float p0 = q[0];
#pragma unroll
            for (int j = 1; j < 4; ++j) if (q[j] > p0) { p0 = q[j]; i0 = j; }
            int i1 = -1; float p1 = -1.f;
#pragma unroll
            for (int j = 0; j < 4; ++j) if (j != i0 && q[j] > p1) { p1 = q[j]; i1 = j; }
            if (F.lane == 0) { const int e0 = gsel * 4 + i0, e1 = gsel * 4 + i1; const float inv = 1.0f / (p0 + p1);
                rowE[2 * lr] = e0; rowE[2 * lr + 1] = e1; rowG[2 * lr] = p0 * inv; rowG[2 * lr + 1] = p1 * inv;
                rowP[2 * lr] = __hip_atomic_fetch_add(&lcnt[e0], 1, __ATOMIC_RELAXED, __HIP_MEMORY_SCOPE_WORKGROUP); rowP[2 * lr + 1] = __hip_atomic_fetch_add(&lcnt[e1], 1, __ATOMIC_RELAXED, __HIP_MEMORY_SCOPE_WORKGROUP); }
        }
        __syncthreads();
        if (F.tid < 16) lbase[F.tid] = (int)__hip_atomic_fetch_add(cnt + F.tid, (unsigned)lcnt[F.tid], RLX_AGENT);
        __syncthreads();
        if (F.tid < 128) { const int e = rowE[F.tid], pos = lbase[e] + rowP[F.tid], tok = rb * 64 + (F.tid >> 1);
            LIST[(size_t)e * LCAP + pos] = tok; TOKSLOT[2 * tok + (F.tid & 1)] = e * LCAP + pos; GATEW[2 * tok + (F.tid & 1)] = rowG[F.tid]; }
        __syncthreads();
    }
}
__device__ __forceinline__ void moe_table(const Frame& F0, int layer) {
    PHASE_FRAME(F0);
    LAS int* tab = (LAS int*)(F.lds + AUX_OFF);
    __syncthreads();
    if (F.tid < 16) tab[32 + F.tid] = (int)__hip_atomic_load(F.ctl + CW_CNT + 64 * layer + F.tid, RLX_AGENT);
    __syncthreads();
    if (F.tid == 0) { int run = 0; for (int e = 0; e < 16; ++e) { tab[e] = run; run += (tab[32 + e] + 255) >> 8; } tab[16] = run; }
    __syncthreads();
}
__device__ __forceinline__ void phase_combine_ln2(const Frame& F0, const Args& a, int layer) {
    PHASE_FRAME(F0);
    unsigned char* ws = a.ws; OPQ_S(ws); const LAS int* tab = (const LAS int*)(F.lds + AUX_OFF);
    float* PRE = a.out; const float* STATS = (const float*)(ws + WS_STATS); const bf16* Y = (const bf16*)(ws + WS_Y); bf16* X2B = (bf16*)(ws + WS_X2B);
    const int* TOKSLOT = (const int*)(ws + WS_TOKSLOT); const float* GATEW = (const float*)(ws + WS_GATEW);
    const float* g1 = a.in[I_LN1G] + (size_t)layer * D; const float* b1 = a.in[I_LN1B] + (size_t)layer * D; const float* g2 = a.in[I_LN2G] + (size_t)layer * D; const float* b2 = a.in[I_LN2B] + (size_t)layer * D;
    const int gw = F.vcu * NWAVES + F.wave, NGW = F.G * NWAVES;
    for (int row = gw; row < T; row += NGW) {
        const float mean = STATS[2 * row], rstd = STATS[2 * row + 1];
        const int s0 = TOKSLOT[2 * row], s1 = TOKSLOT[2 * row + 1]; const float w0 = GATEW[2 * row], w1 = GATEW[2 * row + 1];
        const size_t y0 = (size_t)tab[s0 / LCAP] * 256 + (s0 % LCAP), y1 = (size_t)tab[s1 / LCAP] * 256 + (s1 % LCAP);
        GAS f32x4* xr = (GAS f32x4*)(PRE + (size_t)row * D) + F.lane; const GAS v2u* ya = (const GAS v2u*)(Y + y0 * D) + F.lane; const GAS v2u* yb = (const GAS v2u*)(Y + y1 * D) + F.lane;
        f32x4 v[8]; float s = 0.f;
#pragma unroll
        for (int j = 0; j < 8; ++j) { const f32x4 gg = *(const f32x4*)(g1 + 256 * j + 4 * F.lane), bb = *(const f32x4*)(b1 + 256 * j + 4 * F.lane);
            const f32x4 x1 = (xr[64 * j] - mean) * rstd * gg + bb; const v2u pa = ya[64 * j], pb = yb[64 * j];
            f32x4 f; f[0] = w0 * bflo(pa.x) + w1 * bflo(pb.x); f[1] = w0 * bfhi(pa.x) + w1 * bfhi(pb.x); f[2] = w0 * bflo(pa.y) + w1 * bflo(pb.y); f[3] = w0 * bfhi(pa.y) + w1 * bfhi(pb.y);
            v[j] = x1 * ALPHA + f; s += (v[j][0] + v[j][1]) + (v[j][2] + v[j][3]); }
        const float m2 = wave_sum(s) * (1.f / D); float q = 0.f;
#pragma unroll
        for (int j = 0; j < 8; ++j) { v[j] = v[j] - m2; q += (v[j][0] * v[j][0] + v[j][1] * v[j][1]) + (v[j][2] * v[j][2] + v[j][3] * v[j][3]); }
        const float r2 = 1.f / sqrtf(wave_sum(q) * (1.f / D) + LN_EPS);
        GAS v2u* o8 = (GAS v2u*)(X2B + (size_t)row * D) + F.lane;
#pragma unroll
        for (int j = 0; j < 8; ++j) { const f32x4 gg = *(const f32x4*)(g2 + 256 * j + 4 * F.lane), bb = *(const f32x4*)(b2 + 256 * j + 4 * F.lane);
            const f32x4 o = v[j] * r2 * gg + bb; xr[64 * j] = o; v2u w; w.x = pk2(o[0], o[1]); w.y = pk2(o[2], o[3]); o8[64 * j] = w; }
    }
}

#ifndef MK_N_LAUNCHES
#define MK_N_LAUNCHES 1
#endif
constexpr int NPHASE = 1 + 10 * DEPTH;
constexpr int N_LAUNCHES = MK_N_LAUNCHES;
static_assert(N_LAUNCHES == 1 || N_LAUNCHES == NPHASE, "MK_N_LAUNCHES is 1 or NPHASE");

__global__ void __launch_bounds__(NWAVES * 64, 2) trunk_fwd(Args args) {
    extern __shared__ __attribute__((aligned(16))) unsigned char lds[];
    Frame F;
    F.lds = (LAS unsigned char*)lds;
    F.MISC = (volatile LAS unsigned*)(F.lds + MISC_OFF);
    F.tid = threadIdx.x; F.lane = F.tid & 63; F.wave = __builtin_amdgcn_readfirstlane(F.tid >> 6);
    F.G = gridDim.x; { const int bx = blockIdx.x; F.vcu = (F.G % 8 == 0) ? (bx % 8) * (F.G / 8) + bx / 8 : bx; }
    unsigned char* ws = args.ws;
    F.ctl = (gu32*)(ws + WS_CTL);
    for (int u = F.tid; u < (LDS_BYTES - LDSCTL_OFF) / 4; u += NWAVES * 64) ((LAS unsigned*)(F.lds + LDSCTL_OFF))[u] = 0u;
    __syncthreads();
    XcdBarrier bar; bar.bar = (unsigned*)(F.ctl + CW_BAR); bar.x = 0; bar.st = nullptr;
    if (N_LAUNCHES == 1) bar = xcd_barrier_post((unsigned*)(F.ctl + CW_BAR), F.MISC + 8);
#define GRID_BAR() do { if (N_LAUNCHES == 1) xcd_barrier(bar); } while (0)
    const int lo = args.ph_lo, hi = args.ph_hi;
#ifndef PH_MASK
#define PH_MASK 0x7ff
#endif
#define IN(k) ((((k) == 0 ? 1u : (2u << (((k) - 1) % 10))) & (unsigned)(PH_MASK)) && lo <= (k) && (k) < hi)
#define SEAM(k) do { if (IN((k) + 1)) GRID_BAR(); } while (0)

    if (IN(0)) { p0_prologue(F, args); SEAM(0); }

#ifdef LAYER_UNROLL
#pragma unroll
#else
#pragma unroll 1
#endif
    for (int layer = 0; layer < DEPTH; ++layer) {
        const int pb = 1 + 10 * layer;
        unsigned char* ws = args.ws; OPQ_S(ws);
        if (IN(pb + 0)) {
            SchedDense S; S.init(T, NPROJ, F.G, (int)blockIdx.x, ws + WS_XB, D, (const bf16*)(ws + WS_WIN) + (size_t)layer * NPROJ * D, D);
            EpiBf16 E{(bf16*)(ws + WS_PROJ), NPROJ};
            pg8::gemm_phase<EpiBf16, SchedDense, false>(F.lds + RING_OFF, D, D, D, S, E);
            SEAM(pb + 0);
        }
        if (IN(pb + 1)) { phase_dn_prep(F, args, layer); SEAM(pb + 1); }
        if (IN(pb + 2)) { phase_dn_scan(F, args); SEAM(pb + 2); }
        if (IN(pb + 3)) {
            SchedPool S{F.G, (int)blockIdx.x, (const char*)(ws + WS_POOLD), (const char*)((const bf16*)(ws + WS_WPOOL) + (size_t)layer * 4 * 65536)};
            EpiPool E{(bf16*)(ws + WS_MIXIN), args.in[I_POOLS] + (size_t)layer * PW};
            pg8::gemm_phase<EpiPool, SchedPool, false>(F.lds + RING_OFF, 256, PW, 256, S, E);
            phase_dn_norm(F, args, layer);
            SEAM(pb + 3);
        }
        if (IN(pb + 4)) {
            SchedDense S; S.init(T, D, F.G, (int)blockIdx.x, ws + WS_MIXIN, D, (const bf16*)(ws + WS_WOUT) + (size_t)layer * D * D, D);
            EpiRes E{layer == 0 ? args.in[I_X] : args.out, args.out};
            pg8::gemm_phase<EpiRes, SchedDense, false>(F.lds + RING_OFF, D, D, D, S, E);
            SEAM(pb + 4);
        }
        if (IN(pb + 5)) { phase_ln1_router(F, args, layer); SEAM(pb + 5); }
        if (IN(pb + 6)) {
            moe_table(F, layer);
            SchedMoe S{F.G, (int)blockIdx.x, 0, (const LAS int*)(F.lds + AUX_OFF), (const char*)(ws + WS_X1B), (const char*)((const bf16*)(ws + WS_WGU) + (size_t)layer * NE * 2048 * D), (const int*)(ws + WS_LIST)};
            EpiSwiglu E{(bf16*)(ws + WS_HID)};
            pg8::gemm_phase<EpiSwiglu, SchedMoe, true>(F.lds + RING_OFF, D, D, D, S, E);
            SEAM(pb + 6);
        }
        if (IN(pb + 7)) {
            moe_table(F, layer);
            SchedMoe S{F.G, (int)blockIdx.x, 1, (const LAS int*)(F.lds + AUX_OFF), (const char*)(ws + WS_HID), (const char*)((const bf16*)(ws + WS_WD) + (size_t)layer * NE * D * DE), nullptr};
            EpiBf16 E{(bf16*)(ws + WS_Y), D};
            pg8::gemm_phase<EpiBf16, SchedMoe, false>(F.lds + RING_OFF, DE, DE, DE, S, E);
            SEAM(pb + 7);
        }
        if (IN(pb + 8)) { moe_table(F, layer); phase_combine_ln2(F, args, layer); SEAM(pb + 8); }
        if (IN(pb + 9)) {
            { SchedDense S; S.init(T, D, F.G, (int)blockIdx.x, (const bf16*)(ws + WS_PB16) + (size_t)layer * T * PLE, PLE, (const bf16*)(ws + WS_WPP) + (size_t)layer * D * PLE, PLE);
              EpiBf16 E{(bf16*)(ws + WS_PP), D};
              pg8::gemm_phase<EpiBf16, SchedDense, false>(F.lds + RING_OFF, PLE, PLE, PLE, S, E); }
            { SchedDense S; S.init(T, D, F.G, (int)blockIdx.x, ws + WS_X2B, D, (const bf16*)(ws + WS_WPG) + (size_t)layer * D * D, D);
              EpiPle E{args.out, (const bf16*)(ws + WS_PP), (bf16*)(ws + WS_XB), layer + 1 < DEPTH ? 1 : 0};
              pg8::gemm_phase<EpiPle, SchedDense, false>(F.lds + RING_OFF, D, D, D, S, E); }
            SEAM(pb + 9);
        }
    }
#undef IN
#undef SEAM
#undef GRID_BAR
}

extern "C" void kernel_launch(void* const* d_in, const int* in_sizes, int n_in, void* d_out, int out_size, void* d_ws, size_t ws_size, hipStream_t stream) {
    static int grid = 0;
    if (grid == 0) {
        if (n_in != 21 || in_sizes[0] != T * D || out_size != T * D || ws_size < WS_END) { fprintf(stderr, "kernel_launch: unexpected shapes (n_in %d, in0 %d, out %d, ws %zu); nothing launched\n", n_in, n_in > 0 ? in_sizes[0] : -1, out_size, ws_size); grid = -1; return; }
        int dev = 0, cus = 0, per_cu = 0;
        if (hipGetDevice(&dev) != hipSuccess || hipDeviceGetAttribute(&cus, hipDeviceAttributeMultiprocessorCount, dev) != hipSuccess) { grid = -1; return; }
        if (hipFuncSetAttribute((const void*)trunk_fwd, hipFuncAttributeMaxDynamicSharedMemorySize, LDS_BYTES) != hipSuccess) { fprintf(stderr, "kernel_launch: hipFuncSetAttribute failed\n"); grid = -1; return; }
        if (hipOccupancyMaxActiveBlocksPerMultiprocessor(&per_cu, (const void*)trunk_fwd, NWAVES * 64, LDS_BYTES) != hipSuccess || per_cu < 1) { fprintf(stderr, "kernel_launch: occupancy query reports %d workgroups per CU\n", per_cu); }
        (void)hipGetLastError();
        grid = cus;
    }
    if (grid < 0) return;
    if (hipMemsetAsync((char*)d_ws + WS_CTL, 0, CTL_ZERO_BYTES, stream) != hipSuccess) return;
    Args a{};
    for (int i = 0; i < 21; ++i) a.in[i] = (const float*)d_in[i];
    a.out = (float*)d_out; a.ws = (unsigned char*)d_ws;
    for (int li = 0; li < N_LAUNCHES; ++li) {
        a.ph_lo = (N_LAUNCHES == 1) ? 0 : li; a.ph_hi = (N_LAUNCHES == 1) ? NPHASE : li + 1; a.li = li; a.pad = 0;
        hipLaunchKernelGGL(trunk_fwd, dim3(grid), dim3(NWAVES * 64), LDS_BYTES, stream, a);
        const hipError_t le = hipPeekAtLastError();
        if (le != hipSuccess) { fprintf(stderr, "kernel_launch: launch %d failed: %s\n", li, hipGetErrorName(le)); break; }
    }
}
```

```cpp
#define MK_N_LAUNCHES 1
#include <hip/hip_runtime.h>
#include <cstdio>
#include <cstdint>

#define GAS __attribute__((address_space(1)))
#define LAS __attribute__((address_space(3)))
typedef unsigned short bf16;
typedef unsigned v4u __attribute__((ext_vector_type(4)));
typedef unsigned v2u __attribute__((ext_vector_type(2)));
typedef float f32x4 __attribute__((ext_vector_type(4)));
typedef float f32x2 __attribute__((ext_vector_type(2)));
typedef short bf16x8 __attribute__((ext_vector_type(8)));
typedef GAS unsigned gu32;

namespace pg8 {
constexpr int BM = 256, BK = 64, HALF = 128, HTB = HALF * BK * 2  , STAGE_BYTES = 8 * HTB, NXCD = 8, WGM = 8;
__host__ __device__ __forceinline__ int lds_byte(int r, int c) { const int st = (r >> 4) * 2 + (c >> 5), rr = r & 15, cc = c & 31, ob = rr * 64 + cc * 2; return st * 1024 + (ob ^ (((ob >> 9) & 1) << 5)); }
__host__ __device__ __forceinline__ void stage_rc(int b, int& R, int& C) { const int st = b / 1024, sb = b % 1024, swz = sb ^ (((sb >> 9) & 1) << 5); R = (st >> 1) * 16 + swz / 64; C = (st & 1) * 32 + (swz % 64) / 2; }
__host__ __device__ __forceinline__ int perm32(int rho) { const int n = rho >> 4, i = rho & 15; return 8 * (i >> 2) + 4 * n + (i & 3); }

struct Unit { int pm, pn; const char* A; const char* B; const int* rows; int nvalid; int aux; };

__device__ __forceinline__ unsigned cvt_pk_bf16(float lo, float hi) { unsigned r; asm volatile("v_cvt_pk_bf16_f32 %0, %1, %2" : "=v"(r) : "v"(lo), "v"(hi)); return r; }

template <class Epi, class Sched, bool GATHER>
__device__ __forceinline__ void gemm_phase(LAS unsigned char* lds, const int K, const int lda, const int ldb, const Sched& S, const Epi& E) {
    int tid_ = threadIdx.x; asm volatile("" : "+v"(tid_));
    const int tid = tid_, wid = __builtin_amdgcn_readfirstlane(tid >> 6), lane = tid & 63, wr = wid >> 2, wc = wid & 3, fr = lane & 15, fq = lane >> 4;
    const int nt = K / BK;
    unsigned voffA[2], voffB[2]; int RA[2], CA[2];
#pragma unroll
    for (int i = 0; i < 2; ++i) { int R, C; stage_rc(tid * 16 + i * 8192, R, C); const int Rb = Epi::PERM ? ((R & ~31) + perm32(R & 31)) : R;
        RA[i] = R; CA[i] = C; voffA[i] = (unsigned)(R * lda + C) * 2u; voffB[i] = (unsigned)(Rb * ldb + C) * 2u; }
    unsigned gA[2][2], gN[2][2];
    const size_t kstep = (size_t)(BK * 2);
    const size_t hstepA = GATHER ? 0 : (size_t)HALF * lda * 2, hstepB = (size_t)HALF * ldb * 2;
    const unsigned ldsw = (unsigned)wid * 1024u;
    const int aoff = lds_byte(wr * 64 + fr, fq * 8), boff = lds_byte(wc * 32 + fr, fq * 8);
#define PG8_SA(b, h) (((b) * 2 + (h)) * HTB)
#define PG8_SB(b, h) ((4 + (b) * 2 + (h)) * HTB)
#define PG8_STAGE_B(bufoff, gbase) do { _Pragma("unroll") for (int _i = 0; _i < 2; ++_i) \
        __builtin_amdgcn_global_load_lds((const unsigned*)((const char*)(gbase) + voffB[_i]), (LAS unsigned*)(lds + (bufoff) + ldsw + _i * 8192), 16, 0, 0); } while (0)
#define PG8_STAGE_A(bufoff, gbase, h) do { _Pragma("unroll") for (int _i = 0; _i < 2; ++_i) \
        __builtin_amdgcn_global_load_lds((const unsigned*)((const char*)(gbase) + (GATHER ? gA[h][_i] : voffA[_i]) + (h) * hstepA), (LAS unsigned*)(lds + (bufoff) + ldsw + _i * 8192), 16, 0, 0); } while (0)
#define PG8_LDA(dst, b, h) do { _Pragma("unroll") for (int m = 0; m < 4; ++m) _Pragma("unroll") for (int k = 0; k < 2; ++k) dst[m][k] = *(const LAS bf16x8*)(lds + PG8_SA(b, h) + aoff + m * 2048 + k * 1024); } while (0)
#define PG8_LDB(dst, b, h) do { _Pragma("unroll") for (int n = 0; n < 2; ++n) _Pragma("unroll") for (int k = 0; k < 2; ++k) dst[n][k] = *(const LAS bf16x8*)(lds + PG8_SB(b, h) + boff + n * 2048 + k * 1024); } while (0)
#define PG8_MMA(ai, bj, At, Bt) do { __builtin_amdgcn_s_setprio(1); _Pragma("unroll") for (int m = 0; m < 4; ++m) _Pragma("unroll") for (int n = 0; n < 2; ++n) _Pragma("unroll") for (int k = 0; k < 2; ++k) \
        acc[ai][bj][m][n] = __builtin_amdgcn_mfma_f32_16x16x32_bf16(Bt[n][k], At[m][k], acc[ai][bj][m][n], 0, 0, 0); __builtin_amdgcn_s_setprio(0); } while (0)
#define PG8_WAIT_V(n) asm volatile("s_waitcnt vmcnt(" #n ")" ::: "memory")
#define PG8_WAIT_L(n) asm volatile("s_waitcnt lgkmcnt(" #n ")" ::: "memory")
#define PG8_BAR __builtin_amdgcn_s_barrier()
#define PG8_SCHED __builtin_amdgcn_sched_barrier(0)
#define PG8_GLOAD(dst, u) do { _Pragma("unroll") for (int _h = 0; _h < 2; ++_h) _Pragma("unroll") for (int _i = 0; _i < 2; ++_i) { const int _r = _h * HALF + RA[_i]; \
        const int _t = (_r < (u).nvalid) ? (u).rows[_r] : 0; dst[_h][_i] = (unsigned)(_t * lda + CA[_i]) * 2u; } } while (0)
    Unit cur, nxt; int ui = 0;
    if (!S.next(0, cur)) return;
    f32x4 acc[2][2][4][2];
#pragma unroll
    for (int a = 0; a < 2; ++a)
#pragma unroll
        for (int b = 0; b < 2; ++b)
#pragma unroll
            for (int m = 0; m < 4; ++m)
#pragma unroll
                for (int n = 0; n < 2; ++n) acc[a][b][m][n] = (f32x4){0.f, 0.f, 0.f, 0.f};
    bf16x8 At[4][2], B0[2][2], B1[2][2];
    const char* cA = cur.A; const char* cB = cur.B;
    if constexpr (GATHER) { PG8_GLOAD(gA, cur); PG8_WAIT_V(0); }
    PG8_STAGE_B(PG8_SB(0, 0), cB); PG8_STAGE_B(PG8_SB(0, 1), cB + hstepB); PG8_STAGE_A(PG8_SA(0, 0), cA, 0); PG8_STAGE_A(PG8_SA(0, 1), cA, 1);
    if (wr == 1) PG8_BAR;
    PG8_WAIT_V(2); PG8_BAR;
    PG8_STAGE_B(PG8_SB(1, 0), cB + kstep); PG8_STAGE_A(PG8_SA(1, 0), cA + kstep, 0); PG8_STAGE_B(PG8_SB(1, 1), cB + hstepB + kstep);
    PG8_WAIT_V(6); PG8_BAR;
    for (;;) {
        const bool has_next = S.next(ui + 1, nxt);
        const char* nA = has_next ? nxt.A : cA; const char* nB = has_next ? nxt.B : cB;
        if constexpr (GATHER) { if (has_next) { PG8_GLOAD(gN, nxt); } else {
#pragma unroll
            for (int h = 0; h < 2; ++h)
#pragma unroll
                for (int i = 0; i < 2; ++i) gN[h][i] = gA[h][i]; } }
#pragma unroll 1
        for (int t = 0; t < nt; t += 2) {
            const bool last = (t == nt - 2);
            const char* a1 = cA + (size_t)(t + 1) * kstep;
            const char* a2 = last ? nA : cA + (size_t)(t + 2) * kstep; const char* b2 = last ? nB : cB + (size_t)(t + 2) * kstep;
            const char* a3 = a2 + kstep; const char* b3 = b2 + kstep;
            PG8_LDB(B0, 0, 0); PG8_LDB(B1, 0, 1); PG8_SCHED; PG8_LDA(At, 0, 0); PG8_STAGE_A(PG8_SA(1, 1), a1, 1);
            if constexpr (GATHER) { if (last) {
#pragma unroll
                for (int h = 0; h < 2; ++h)
#pragma unroll
                    for (int i = 0; i < 2; ++i) gA[h][i] = gN[h][i]; } }
            PG8_WAIT_V(8); PG8_WAIT_L(0); PG8_BAR; PG8_MMA(0, 0, At, B0); PG8_MMA(0, 1, At, B1); PG8_BAR; PG8_SCHED;
            PG8_LDA(At, 0, 1); PG8_STAGE_B(PG8_SB(0, 0), b2); PG8_STAGE_B(PG8_SB(0, 1), b2 + hstepB); PG8_STAGE_A(PG8_SA(0, 0), a2, 0);
            PG8_WAIT_V(8); PG8_WAIT_L(0); PG8_BAR; PG8_MMA(1, 0, At, B0); PG8_MMA(1, 1, At, B1); PG8_BAR; PG8_SCHED;
            PG8_LDB(B0, 1, 0); PG8_LDB(B1, 1, 1); PG8_SCHED; PG8_LDA(At, 1, 0); PG8_STAGE_A(PG8_SA(0, 1), a2, 1);
            PG8_WAIT_V(8); PG8_WAIT_L(0); PG8_BAR; PG8_MMA(0, 0, At, B0); PG8_MMA(0, 1, At, B1); PG8_BAR; PG8_SCHED;
            PG8_LDA(At, 1, 1); PG8_STAGE_B(PG8_SB(1, 0), b3); PG8_STAGE_B(PG8_SB(1, 1), b3 + hstepB); PG8_STAGE_A(PG8_SA(1, 0), a3, 0);
            PG8_WAIT_V(8); PG8_WAIT_L(0); PG8_BAR; PG8_MMA(1, 0, At, B0); PG8_MMA(1, 1, At, B1); PG8_BAR; PG8_SCHED;
        }
        if (wr == 0) PG8_BAR;
        E(acc, cur, wr, wc, fr, fq);
        if (!has_next) break;
#pragma unroll
        for (int a = 0; a < 2; ++a)
#pragma unroll
            for (int b = 0; b < 2; ++b)
#pragma unroll
                for (int m = 0; m < 4; ++m)
#pragma unroll
                    for (int n = 0; n < 2; ++n) acc[a][b][m][n] = (f32x4){0.f, 0.f, 0.f, 0.f};
        cur = nxt; cA = nA; cB = nB; ++ui;
        if (wr == 1) PG8_BAR;
    }
    PG8_WAIT_V(0);
    PG8_BAR;
#undef PG8_SA
#undef PG8_SB
#undef PG8_STAGE_A
#undef PG8_STAGE_B
#undef PG8_LDA
#undef PG8_LDB
#undef PG8_MMA
#undef PG8_WAIT_V
#undef PG8_WAIT_L
#undef PG8_BAR
#undef PG8_SCHED
#undef PG8_GLOAD
}
}

constexpr int NB = 4, SEQ = 4096, D = 2048, DEPTH = 2;
constexpr int T = NB * SEQ;
constexpr int NH = 8, HD = 128, DNW = 1024, CH = 64, NCH = SEQ / CH;
constexpr int PW = 1024, PG_DIM = 256;
constexpr int IN_COLS = 5136, NPROJ = 5120;
constexpr int NE = 16, DE = 1024, PLE = 256;
constexpr float ALPHA = 1.4142135623730951f;
constexpr float LN_EPS = 1e-5f, RMS_EPS = 1e-6f;
constexpr int LCAP = T;
constexpr int MAXTILES = 2 * T / 256 + NE;

constexpr size_t MiB = 1u << 20;
constexpr size_t WS_CTL = 0, CTL_ZERO_BYTES = 64 * 1024;
constexpr size_t WS_LIST = 2 * MiB;
constexpr size_t WS_TOKSLOT = 3 * MiB, WS_GATEW = WS_TOKSLOT + 128 * 1024, WS_STATS = WS_GATEW + 128 * 1024, WS_CD = WS_STATS + 128 * 1024, WS_WBA = WS_CD + 128 * 1024;
constexpr size_t WS_WIN = 4 * MiB, WS_WOUT = 44 * MiB, WS_WPG = 60 * MiB, WS_WPP = 76 * MiB, WS_WPOOL = 78 * MiB, WS_WGU = 80 * MiB, WS_WD = 336 * MiB, WS_PB16 = 464 * MiB;
constexpr size_t WS_XB = 480 * MiB, WS_R1 = 544 * MiB, WS_R2 = 704 * MiB, WS_R4 = 848 * MiB, WS_R5 = 944 * MiB, WS_END = 1008 * MiB;
constexpr size_t WS_PROJ = WS_R1, WS_HID = WS_R1;
constexpr size_t WS_Y = WS_R2;
constexpr size_t WS_POOLD = WS_R4, WS_PP = WS_R4 + 32 * MiB, WS_X1B = WS_R2;
constexpr size_t WS_MIXIN = WS_R5, WS_X2B = WS_R5;
static_assert((size_t)MAXTILES * 256 * 2048 * 2 <= 144 * MiB && (size_t)MAXTILES * 256 * 1024 * 2 <= 160 * MiB, "MoE row buffers");
constexpr int CW_TMO = 0, CW_CODE = 1, CW_CNT = 64  , CW_BAR = 4096;

constexpr int RING_OFF = 0, RING_BYTES = 131072;
constexpr int LDSCTL_OFF = 152 * 1024, MISC_OFF = LDSCTL_OFF + 320;
constexpr int AUX_OFF = LDSCTL_OFF + 1024;
constexpr int LDS_BYTES = 163840;
constexpr int NWAVES = 8;

#define RLX_AGENT __ATOMIC_RELAXED, __HIP_MEMORY_SCOPE_AGENT
#define LDS_WAIT() asm volatile("s_waitcnt lgkmcnt(0)" ::: "memory")
#define VM_WAIT() asm volatile("s_waitcnt vmcnt(0)" ::: "memory")
__device__ __forceinline__ unsigned f2bf(float f) { unsigned u = __builtin_bit_cast(unsigned, f); return (u + 0x7fffu + ((u >> 16) & 1u)) >> 16; }
__device__ __forceinline__ unsigned pk2(float lo, float hi) { return f2bf(lo) | (f2bf(hi) << 16); }
__device__ __forceinline__ float bf2f(unsigned short b) { return __builtin_bit_cast(float, ((unsigned)b) << 16); }
__device__ __forceinline__ float bflo(unsigned w) { return __builtin_bit_cast(float, w << 16); }
__device__ __forceinline__ float bfhi(unsigned w) { return __builtin_bit_cast(float, w & 0xffff0000u); }
__device__ __forceinline__ float sigmoidf_(float x) { return __builtin_amdgcn_rcpf(1.0f + __expf(-x)); }
__device__ __forceinline__ float wave_sum(float v) {
#pragma unroll
    for (int o = 1; o < 64; o <<= 1) v += __shfl_xor(v, o);
    return v;
}
#define XB_TMO      128
#define XB_XCNT(j)  (256  + 64 * (j))
#define XB_XSUB(j)  (1280 + 64 * (j))
#define XB_XGEN(j)  (2304 + 64 * (j))
#define XB_TOP      3328
#define XB_TOPGEN   3392
#define XCD_BAR_WORDS 3456
#define XB_SPIN_CAP (1u << 18)

__device__ __forceinline__ unsigned xb_ld(unsigned* p)              { return __hip_atomic_load(p, __ATOMIC_RELAXED, __HIP_MEMORY_SCOPE_AGENT); }
__device__ __forceinline__ unsigned xb_add(unsigned* p, unsigned v) { return __hip_atomic_fetch_add(p, v, __ATOMIC_RELAXED, __HIP_MEMORY_SCOPE_AGENT); }
__device__ __forceinline__ unsigned xb_xcc_id() { return (unsigned)__builtin_amdgcn_s_getreg((3 << 11) | 20) & 0xFu; }
#define XB_SPIN(cond, bar) do { unsigned _sp = 0; while (cond) { __builtin_amdgcn_s_sleep(1); \
    if ((++_sp & 255u) == 0u) { if (xb_ld(&(bar)[XB_TMO])) break; if (_sp > XB_SPIN_CAP) { atomicAdd(&(bar)[XB_TMO], 1u); break; } } } } while (0)

struct XcdBarrier {
    unsigned* bar; unsigned x;
    volatile LAS unsigned* st;
};

__device__ __forceinline__ XcdBarrier xcd_barrier_post(unsigned* bar, volatile LAS unsigned* st) {
    XcdBarrier b; b.bar = bar; b.x = xb_xcc_id(); b.st = st;
    if (threadIdx.x == 0) (void)xb_add(&bar[XB_XCNT(b.x)], 1u);
    return b;
}
__device__ __forceinline__ void xcd_barrier_complete(unsigned* bar, unsigned x, unsigned& nloc, unsigned& nx) {
    const unsigned G = gridDim.x * gridDim.y * gridDim.z;
    unsigned sum, cnt, mine, sp = 0u;
    for (;;) {
        sum = 0u; cnt = 0u; mine = 0u;
#pragma unroll
        for (unsigned j = 0; j < 16; ++j) { const unsigned c = xb_ld(&bar[XB_XCNT(j)]); sum += c; cnt += (c > 0u) ? 1u : 0u; mine = (j == x) ? c : mine; }
        if (sum == G) break;
        __builtin_amdgcn_s_sleep(1);
        if ((++sp & 255u) == 0u) { if (xb_ld(&bar[XB_TMO])) break; if (sp > XB_SPIN_CAP) { atomicAdd(&bar[XB_TMO], 1u); break; } }
    }
    nloc = mine > 0u ? mine : 1u; nx = cnt > 0u ? cnt : 1u;
}

__device__ __forceinline__ void xcd_barrier(const XcdBarrier& b) {
    asm volatile("s_waitcnt vmcnt(0)" ::: "memory");
    __syncthreads();
    if (threadIdx.x == 0) {
        unsigned* bar = b.bar;
        __builtin_amdgcn_s_waitcnt(0);
        unsigned nloc = b.st[0], nx = b.st[1];
        if (nloc == 0u) { xcd_barrier_complete(bar, b.x, nloc, nx); b.st[0] = nloc; b.st[1] = nx; }
        const unsigned old = xb_add(&bar[XB_XSUB(b.x)], 1u);
        const unsigned gen = old / nloc;
        if (old + 1u == (gen + 1u) * nloc) {
            __builtin_amdgcn_fence(__ATOMIC_RELEASE, "agent");
            asm volatile("s_waitcnt vmcnt(0)" ::: "memory");
            const unsigned og = xb_add(&bar[XB_TOP], 1u);
            const unsigned tg = og / nx;
            if (og + 1u == (tg + 1u) * nx) xb_add(&bar[XB_TOPGEN], 1u);
            else XB_SPIN(xb_ld(&bar[XB_TOPGEN]) == tg, bar);
            __builtin_amdgcn_fence(__ATOMIC_ACQUIRE, "agent");
            xb_add(&bar[XB_XGEN(b.x)], 1u);
            asm volatile("s_waitcnt vmcnt(0)" ::: "memory");
        } else {
            XB_SPIN(xb_ld(&bar[XB_XGEN(b.x)]) == gen, bar);
            __builtin_amdgcn_fence(__ATOMIC_ACQUIRE, "agent");
            asm volatile("s_waitcnt vmcnt(0)" ::: "memory");
        }
    }
    __syncthreads();
}

struct Args { const float* in[21]; float* out; unsigned char* ws; int ph_lo, ph_hi, li, pad; };
enum { I_X = 0, I_P, I_WIN, I_CONVW, I_ALOG, I_DTB, I_NORMW, I_POOLW, I_POOLS, I_WOUT, I_LN1G, I_LN1B, I_WR, I_BR, I_WEG, I_WEU, I_WED, I_LN2G, I_LN2B, I_WPP, I_WPG };
struct Frame {
    LAS unsigned char* lds;
    volatile LAS unsigned* MISC;
    gu32* ctl;
    int tid, lane, wave, vcu, G;
};

#define PHASE_FRAME(F0) Frame F = F0; { int t_ = threadIdx.x; asm volatile("" : "+v"(t_)); F.tid = t_; F.lane = t_ & 63; }
#define OPQ_S(p) asm volatile("" : "+s"(p))
struct SchedDense {
    int nM, nN, nwg, G, c; const char* A; const char* B; size_t astep, bstep;
    __device__ __forceinline__ void init(int M, int N, int G_, int c_, const void* A_, int lda, const void* B_, int ldb) { nM = M / 256; nN = N / 256; nwg = nM * nN; G = G_; c = c_;
        A = (const char*)A_; B = (const char*)B_; astep = (size_t)256 * lda * 2; bstep = (size_t)256 * ldb * 2; }
    __device__ __forceinline__ bool next(int i, pg8::Unit& u) const {
        const long L = (long)i * G + c; if (L >= nwg) return false;
        int wgid = (int)L; { const int q = nwg / 8, r = nwg % 8, xcd = wgid % 8, off = wgid / 8; wgid = (xcd < r ? xcd * (q + 1) : r * (q + 1) + (xcd - r) * q) + off; }
        const int nig = 8 * nN, gid = wgid / nig, fm = gid * 8, gsz = (nM - fm) < 8 ? (nM - fm) : 8;
        u.pm = fm + ((wgid % nig) % gsz); u.pn = (wgid % nig) / gsz;
        u.A = A + (size_t)u.pm * astep; u.B = B + (size_t)u.pn * bstep; u.rows = nullptr; u.nvalid = 256; u.aux = 0; return true;
    }
};
struct SchedPool {
    int G, c; const char* A; const char* B;
    __device__ __forceinline__ bool next(int i, pg8::Unit& u) const {
        const int L = i * G + c; if (L >= 256) return false;
        u.pm = L >> 2; u.pn = L & 3; u.A = A + ((size_t)u.pm * 256 * PW + u.pn * 256) * 2; u.B = B + (size_t)u.pn * 65536 * 2; u.rows = nullptr; u.nvalid = 256; u.aux = 0; return true;
    }
};
struct SchedMoe {
    int G, c, mode; const LAS int* tab; const char* A; const char* B; const int* list;
    __device__ __forceinline__ bool next(int i, pg8::Unit& u) const {
        const int L = i * G + c, rt = L >> 3, pn = L & 7;
        const int ntiles = __builtin_amdgcn_readfirstlane(tab[16]); if (rt >= ntiles) return false;
        int e = 0;
#pragma unroll
        for (int k = 1; k < 16; ++k) { const int ts = __builtin_amdgcn_readfirstlane(tab[k]); if (rt >= ts) e = k; }
        const int ts = __builtin_amdgcn_readfirstlane(tab[e]), cn = __builtin_amdgcn_readfirstlane(tab[32 + e]);
        const int r0 = (rt - ts) * 256;
        u.pm = rt; u.pn = pn; u.aux = e;
        if (mode == 0) { u.A = A; u.rows = list + (size_t)e * LCAP + r0; u.nvalid = (cn - r0) < 256 ? (cn - r0) : 256; u.B = B + ((size_t)e * 2048 + pn * 256) * 2048 * 2; }
        else { u.A = A + (size_t)rt * 256 * DE * 2; u.rows = nullptr; u.nvalid = 256; u.B = B + ((size_t)e * 2048 + pn * 256) * DE * 2; }
        return true;
    }
};

using pg8::cvt_pk_bf16;
struct EpiBf16 {
    static constexpr bool PERM = true; bf16* O; int ldc;
    __device__ __forceinline__ void operator()(const f32x4 (&acc)[2][2][4][2], const pg8::Unit& u, int wr, int wc, int fr, int fq) const {
        const int row0 = u.pm * 256 + wr * 64 + fr, col0 = u.pn * 256 + wc * 32 + 8 * fq;
#pragma unroll
        for (int ai = 0; ai < 2; ++ai)
#pragma unroll
            for (int m = 0; m < 4; ++m) { bf16* rowp = O + (size_t)(row0 + ai * 128 + m * 16) * ldc + col0;
#pragma unroll
                for (int bj = 0; bj < 2; ++bj) { const f32x4 v0 = acc[ai][bj][m][0], v1 = acc[ai][bj][m][1];
                    v4u w; w.x = cvt_pk_bf16(v0[0], v0[1]); w.y = cvt_pk_bf16(v0[2], v0[3]); w.z = cvt_pk_bf16(v1[0], v1[1]); w.w = cvt_pk_bf16(v1[2], v1[3]);
                    *(v4u*)(rowp + bj * 128) = w; } }
    }
};
struct EpiPool {
    static constexpr bool PERM = true; bf16* O; const float* scale;
    __device__ __forceinline__ void operator()(const f32x4 (&acc)[2][2][4][2], const pg8::Unit& u, int wr, int wc, int fr, int fq) const {
        const int row0 = u.pm * 256 + wr * 64 + fr, cg = u.pn * 256 + wc * 32 + 8 * fq;
        f32x4 sv[2][2];
#pragma unroll
        for (int bj = 0; bj < 2; ++bj) { sv[bj][0] = *(const f32x4*)(scale + cg + bj * 128); sv[bj][1] = *(const f32x4*)(scale + cg + bj * 128 + 4); }
#pragma unroll
        for (int ai = 0; ai < 2; ++ai)
#pragma unroll
            for (int m = 0; m < 4; ++m) { bf16* rowp = O + (size_t)(row0 + ai * 128 + m * 16) * D + DNW + cg;
#pragma unroll
                for (int bj = 0; bj < 2; ++bj) { const f32x4 v0 = acc[ai][bj][m][0] * sv[bj][0], v1 = acc[ai][bj][m][1] * sv[bj][1];
                    v4u w; w.x = cvt_pk_bf16(v0[0], v0[1]); w.y = cvt_pk_bf16(v0[2], v0[3]); w.z = cvt_pk_bf16(v1[0], v1[1]); w.w = cvt_pk_bf16(v1[2], v1[3]);
                    *(v4u*)(rowp + bj * 128) = w; } }
    }
};
struct EpiRes {
    static constexpr bool PERM = false; const float* X; float* OUT;
    __device__ __forceinline__ void operator()(const f32x4 (&acc)[2][2][4][2], const pg8::Unit& u, int wr, int wc, int fr, int fq) const {
        const int row0 = u.pm * 256 + wr * 64 + fr, col0 = u.pn * 256 + wc * 32 + 4 * fq;
#pragma unroll
        for (int ai = 0; ai < 2; ++ai)
#pragma unroll
            for (int m = 0; m < 4; ++m) { const size_t off = (size_t)(row0 + ai * 128 + m * 16) * D + col0;
#pragma unroll
                for (int bj = 0; bj < 2; ++bj)
#pragma unroll
                    for (int n = 0; n < 2; ++n) { const f32x4 x = *(const f32x4*)(X + off + bj * 128 + n * 16); *(f32x4*)(OUT + off + bj * 128 + n * 16) = x * ALPHA + acc[ai][bj][m][n]; } }
    }
};
struct EpiSwiglu {
    static constexpr bool PERM = true; bf16* O;
    __device__ __forceinline__ void operator()(const f32x4 (&acc)[2][2][4][2], const pg8::Unit& u, int wr, int wc, int fr, int fq) const {
        const int row0 = u.pm * 256 + wr * 64 + fr, col0 = u.pn * 128 + wc * 32 + 8 * fq;
#pragma unroll
        for (int ai = 0; ai < 2; ++ai)
#pragma unroll
            for (int m = 0; m < 4; ++m) { bf16* rowp = O + (size_t)(row0 + ai * 128 + m * 16) * DE + col0;
                float h[8];
#pragma unroll
                for (int n = 0; n < 2; ++n)
#pragma unroll
                    for (int j = 0; j < 4; ++j) { const float g = acc[ai][0][m][n][j], up = acc[ai][1][m][n][j]; h[4 * n + j] = g * sigmoidf_(g) * up; }
                v4u w; w.x = cvt_pk_bf16(h[0], h[1]); w.y = cvt_pk_bf16(h[2], h[3]); w.z = cvt_pk_bf16(h[4], h[5]); w.w = cvt_pk_bf16(h[6], h[7]);
                *(v4u*)rowp = w; }
    }
};
struct EpiPle {
    static constexpr bool PERM = true; float* OUT; const bf16* PP; bf16* XB; int write_xb;
    __device__ __forceinline__ void operator()(const f32x4 (&acc)[2][2][4][2], const pg8::Unit& u, int wr, int wc, int fr, int fq) const {
        const int row0 = u.pm * 256 + wr * 64 + fr, col0 = u.pn * 256 + wc * 32 + 8 * fq;
#pragma unroll
        for (int ai = 0; ai < 2; ++ai)
#pragma unroll
            for (int m = 0; m < 4; ++m) { const size_t off0 = (size_t)(row0 + ai * 128 + m * 16) * D + col0;
#pragma unroll
                for (int bj = 0; bj < 2; ++bj) { const size_t off = off0 + bj * 128;
                    const f32x4 xa = *(const f32x4*)(OUT + off), xb = *(const f32x4*)(OUT + off + 4); const v4u pp = *(const v4u*)(PP + off);
                    const f32x4 a0 = acc[ai][bj][m][0], a1 = acc[ai][bj][m][1];
                    f32x4 o0, o1;
                    o0[0] = xa[0] + sigmoidf_(a0[0]) * bflo(pp.x); o0[1] = xa[1] + sigmoidf_(a0[1]) * bfhi(pp.x); o0[2] = xa[2] + sigmoidf_(a0[2]) * bflo(pp.y); o0[3] = xa[3] + sigmoidf_(a0[3]) * bfhi(pp.y);
                    o1[0] = xb[0] + sigmoidf_(a1[0]) * bflo(pp.z); o1[1] = xb[1] + sigmoidf_(a1[1]) * bfhi(pp.z); o1[2] = xb[2] + sigmoidf_(a1[2]) * bflo(pp.w); o1[3] = xb[3] + sigmoidf_(a1[3]) * bfhi(pp.w);
                    *(f32x4*)(OUT + off) = o0; *(f32x4*)(OUT + off + 4) = o1;
                    if (write_xb) { v4u w; w.x = cvt_pk_bf16(o0[0], o0[1]); w.y = cvt_pk_bf16(o0[2], o0[3]); w.z = cvt_pk_bf16(o1[0], o1[1]); w.w = cvt_pk_bf16(o1[2], o1[3]); *(v4u*)(XB + off) = w; } } }
    }
};

__device__ __forceinline__ void tr_item(const float* W, int ldw, int k0, int n0, bf16* WT, size_t drow0, int ldt, LAS float* scr, int lane) {
#pragma unroll 8
    for (int i = 0; i < 32; ++i) { const int kk = 2 * i + (lane >> 5); scr[kk * 33 + (lane & 31)] = W[(size_t)(k0 + kk) * ldw + n0 + (lane & 31)]; }
    LDS_WAIT(); asm volatile("" ::: "memory");
    const int c = lane & 7;
#pragma unroll
    for (int j = 0; j < 4; ++j) { const int n = (lane >> 3) + 8 * j; const LAS float* s = scr + (8 * c) * 33 + n;
        v4u o; o.x = pk2(s[0 * 33], s[1 * 33]); o.y = pk2(s[2 * 33], s[3 * 33]); o.z = pk2(s[4 * 33], s[5 * 33]); o.w = pk2(s[6 * 33], s[7 * 33]);
        *(GAS v4u*)(WT + (drow0 + n) * ldt + k0 + 8 * c) = o; }
    LDS_WAIT(); asm volatile("" ::: "memory");
}
__device__ __forceinline__ void p0_prologue(const Frame& F0, const Args& a) {
    PHASE_FRAME(F0);
    LAS float* scr = (LAS float*)(F.lds + RING_OFF + F.wave * 16384);
    const int gw = F.vcu * NWAVES + F.wave, NGW = F.G * NWAVES;
    unsigned char* ws = a.ws; OPQ_S(ws);
    constexpr int I_INA = 32 * 128, I_INB = 32 * 32, I_OUT = 32 * 64, I_PG = 32 * 64, I_PP = 4 * 64, I_POOL = 4 * 32, I_EG = NE * 32 * 32, I_EU = I_EG, I_ED = NE * 16 * 64;
    constexpr int I_LAYER = I_INA + I_INB + I_OUT + I_PG + I_PP + I_POOL + I_EG + I_EU + I_ED;
    for (int it = gw; it < DEPTH * I_LAYER; it += NGW) {
        const int l = it / I_LAYER; int r = it - l * I_LAYER;
        if (r < I_INA) { const int kb = r / 128, nb = r % 128; tr_item(a.in[I_WIN] + (size_t)l * D * IN_COLS, IN_COLS, 64 * kb, 32 * nb, (bf16*)(ws + WS_WIN) + (size_t)l * NPROJ * D, 32 * nb, D, scr, F.lane); continue; } r -= I_INA;
        if (r < I_INB) { const int kb = r / 32, nb = r % 32; tr_item(a.in[I_WIN] + (size_t)l * D * IN_COLS, IN_COLS, 64 * kb, 4112 + 32 * nb, (bf16*)(ws + WS_WIN) + (size_t)l * NPROJ * D, 4096 + 32 * nb, D, scr, F.lane); continue; } r -= I_INB;
        if (r < I_OUT) { const int kb = r / 64, nb = r % 64; tr_item(a.in[I_WOUT] + (size_t)l * D * D, D, 64 * kb, 32 * nb, (bf16*)(ws + WS_WOUT) + (size_t)l * D * D, 32 * nb, D, scr, F.lane); continue; } r -= I_OUT;
        if (r < I_PG) { const int kb = r / 64, nb = r % 64; tr_item(a.in[I_WPG] + (size_t)l * D * D, D, 64 * kb, 32 * nb, (bf16*)(ws + WS_WPG) + (size_t)l * D * D, 32 * nb, D, scr, F.lane); continue; } r -= I_PG;
        if (r < I_PP) { const int kb = r / 64, nb = r % 64; tr_item(a.in[I_WPP] + (size_t)l * PLE * D, D, 64 * kb, 32 * nb, (bf16*)(ws + WS_WPP) + (size_t)l * D * PLE, 32 * nb, PLE, scr, F.lane); continue; } r -= I_PP;
        if (r < I_POOL) { const int g = r / 32, rr = r % 32, kb = rr / 8, nb = rr % 8; tr_item(a.in[I_POOLW] + ((size_t)l * 4 + g) * 65536, 256, 64 * kb, 32 * nb, (bf16*)(ws + WS_WPOOL) + ((size_t)l * 4 + g) * 65536, 32 * nb, 256, scr, F.lane); continue; } r -= I_POOL;
        if (r < I_EG) { const int e = r / 1024, rr = r % 1024, kb = rr / 32, nb = rr % 32, h0 = 32 * nb;
            tr_item(a.in[I_WEG] + ((size_t)l * NE + e) * D * DE, DE, 64 * kb, h0, (bf16*)(ws + WS_WGU) + ((size_t)l * NE + e) * 2048 * D, (size_t)(h0 >> 7) * 256 + (h0 & 127), D, scr, F.lane); continue; } r -= I_EG;
        if (r < I_EU) { const int e = r / 1024, rr = r % 1024, kb = rr / 32, nb = rr % 32, h0 = 32 * nb;
            tr_item(a.in[I_WEU] + ((size_t)l * NE + e) * D * DE, DE, 64 * kb, h0, (bf16*)(ws + WS_WGU) + ((size_t)l * NE + e) * 2048 * D, (size_t)(h0 >> 7) * 256 + 128 + (h0 & 127), D, scr, F.lane); continue; } r -= I_EU;
        { const int e = r / 1024, rr = r % 1024, kb = rr / 64, nb = rr % 64;
            tr_item(a.in[I_WED] + ((size_t)l * NE + e) * DE * D, D, 64 * kb, 32 * nb, (bf16*)(ws + WS_WD) + ((size_t)l * NE + e) * D * DE, 32 * nb, DE, scr, F.lane); }
    }
    const size_t gt = (size_t)F.vcu * 512 + F.tid, NGT = (size_t)F.G * 512;
    { const GAS f32x4* src = (const GAS f32x4*)a.in[I_X]; GAS v4u* dst = (GAS v4u*)(ws + WS_XB);
        for (size_t i = gt; i < (size_t)T * D / 8; i += NGT) { const f32x4 v0 = src[2 * i], v1 = src[2 * i + 1]; v4u o; o.x = pk2(v0[0], v0[1]); o.y = pk2(v0[2], v0[3]); o.z = pk2(v1[0], v1[1]); o.w = pk2(v1[2], v1[3]); dst[i] = o; } }
    { const GAS f32x4* src = (const GAS f32x4*)a.in[I_P]; GAS v4u* dst = (GAS v4u*)(ws + WS_PB16);
        for (size_t i = gt; i < (size_t)DEPTH * T * PLE / 8; i += NGT) { const f32x4 v0 = src[2 * i], v1 = src[2 * i + 1]; v4u o; o.x = pk2(v0[0], v0[1]); o.y = pk2(v0[2], v0[3]); o.z = pk2(v1[0], v1[1]); o.w = pk2(v1[2], v1[3]); dst[i] = o; } }
    for (size_t i = gt; i < (size_t)DEPTH * 16 * D; i += NGT) { const int l = (int)(i / (16 * D)), j = (int)((i / D) % 16), k = (int)(i % D);
        ((bf16*)(ws + WS_WBA))[i] = (bf16)f2bf(a.in[I_WIN][((size_t)l * D + k) * IN_COLS + 4096 + j]); }
}

typedef float f32x16 __attribute__((ext_vector_type(16)));
typedef __bf16 bf2_t __attribute__((ext_vector_type(2)));
__device__ __forceinline__ unsigned pkbf(float lo, float hi) { const f32x2 v = {lo, hi}; return __builtin_bit_cast(unsigned, __builtin_convertvector(v, bf2_t)); }
#define MFMA32(a_, b_, c_) __builtin_amdgcn_mfma_f32_32x32x16_bf16((a_), (b_), (c_), 0, 0, 0)
#define PACK8(x, sp) __builtin_bit_cast(bf16x8, (v4u){pkbf((x)[8 * (sp)], (x)[8 * (sp) + 1]), pkbf((x)[8 * (sp) + 2], (x)[8 * (sp) + 3]), pkbf((x)[8 * (sp) + 4], (x)[8 * (sp) + 5]), pkbf((x)[8 * (sp) + 6], (x)[8 * (sp) + 7])})
#define RAW_BAR() do { asm volatile("s_waitcnt lgkmcnt(0)" ::: "memory"); __builtin_amdgcn_s_barrier(); asm volatile("" ::: "memory"); } while (0)
constexpr int IMG_ELEMS = 56 * 512, UIMG_ELEMS = 8 * 1024;
constexpr int FR_WN = 0, FR_QD = 16, FR_AQK = 32, FR_KDT = 40;
constexpr size_t WS_IMG = WS_R2, WS_UIMG = WS_R2 + 112 * MiB;
static_assert((size_t)NB * NCH * NH * IMG_ELEMS * 2 == 112 * MiB && (size_t)NB * NCH * NH * UIMG_ELEMS * 2 == 32 * MiB, "DeltaNet images");

constexpr int PQF = 0, PKF = 33792, PQS = 67584, PKS = 84992, PVT = 102400, PKT = 120832, PTAB = 139264;
constexpr int PAS = PQF;
constexpr int PTB = PKF, PT11T = PKF + 9216, PPART = PKF;
constexpr int F_LD = 132, S_LD = 136, T_LD = 72, A_LD = 68, TT_LD = 40;
__device__ __forceinline__ void phase_dn_prep(const Frame& F0, const Args& a, int layer) {
    PHASE_FRAME(F0);
    unsigned char* ws = a.ws; OPQ_S(ws);
    LAS unsigned char* lds = F.lds;
    LAS float* Qf = (LAS float*)(lds + PQF); LAS float* Kf = (LAS float*)(lds + PKF); LAS float* As = (LAS float*)(lds + PAS);
    LAS bf16* Qs = (LAS bf16*)(lds + PQS); LAS bf16* Ks = (LAS bf16*)(lds + PKS); LAS bf16* Vt = (LAS bf16*)(lds + PVT); LAS bf16* Kt = (LAS bf16*)(lds + PKT);
    LAS bf16* Tb = (LAS bf16*)(lds + PTB); LAS bf16* T11t = (LAS bf16*)(lds + PT11T);
    LAS float* betaS = (LAS float*)(lds + PTAB); LAS float* gS = betaS + 512; LAS float* gamh = gS + 512; LAS float* betah = gamh + 64; LAS float* egam = betah + 64; LAS float* bgam = egam + 64; LAS float* ekd = bgam + 64; LAS float* rkS = ekd + 64;
    const bf16* XB = (const bf16*)(ws + WS_XB); const bf16* PROJ = (const bf16*)(ws + WS_PROJ); const bf16* WBA = (const bf16*)(ws + WS_WBA) + (size_t)layer * 16 * D;
    bf16* IMG = (bf16*)(ws + WS_IMG); bf16* UIMG = (bf16*)(ws + WS_UIMG); float* CD = (float*)(ws + WS_CD); bf16* POOLD = (bf16*)(ws + WS_POOLD);
    const float* convw = a.in[I_CONVW] + (size_t)layer * 4 * 3072; const float* alog = a.in[I_ALOG] + layer * NH; const float* dtb = a.in[I_DTB] + layer * NH;
    const int tid = F.tid, lane = F.lane, wave = F.wave, c32 = lane & 31, hf = lane >> 5;
    for (int unit = F.vcu; unit < NB * NCH; unit += F.G) {
        const int b = unit / NCH, n = unit % NCH, r0 = b * SEQ + n * CH, sq0 = n * CH;
        { const int col = 2 * tid, wsel = col >> 8; const bf16* up = PROJ + (size_t)r0 * NPROJ + 4096 + col; bf16* dp = POOLD + (size_t)r0 * PW + col;
#define POOL_BODY(WIN) do { unsigned xr[CH + WIN - 1]; \
            _Pragma("unroll") for (int j = 0; j < WIN - 1; ++j) xr[j] = (sq0 - (WIN - 1) + j >= 0) ? *(const unsigned*)(up + (ptrdiff_t)(j - (WIN - 1)) * NPROJ) : 0u; \
            _Pragma("unroll") for (int i = 0; i < CH; ++i) xr[WIN - 1 + i] = *(const unsigned*)(up + (size_t)i * NPROJ); \
            float s0 = 0.f, s1 = 0.f; \
            _Pragma("unroll") for (int j = 0; j < WIN - 1; ++j) { s0 += bflo(xr[j]); s1 += bfhi(xr[j]); } \
            _Pragma("unroll") for (int i = 0; i < CH; ++i) { const float x0 = bflo(xr[WIN - 1 + i]), x1 = bfhi(xr[WIN - 1 + i]); s0 += x0; s1 += x1; \
                const int pos = sq0 + i; const float inv = 1.0f / (float)((pos + 1) < WIN ? (pos + 1) : WIN); \
                *(unsigned*)(dp + (size_t)i * PW) = pkbf(s0 * inv - x0, s1 * inv - x1); s0 -= bflo(xr[i]); s1 -= bfhi(xr[i]); } } while (0)
            if (wsel == 0) POOL_BODY(2); else if (wsel == 1) POOL_BODY(4); else if (wsel == 2) POOL_BODY(8); else POOL_BODY(16);
#undef POOL_BODY
        }
        { typedef float f32x4v __attribute__((ext_vector_type(4)));
            const int fr = lane & 15, fg = lane >> 4; f32x4v pacc[4];
#pragma unroll
            for (int mt = 0; mt < 4; ++mt) pacc[mt] = (f32x4v){0.f, 0.f, 0.f, 0.f};
#pragma unroll 2
            for (int s = 0; s < 8; ++s) { const int k0 = 256 * wave + 32 * s + 8 * fg;
                const bf16x8 bfr = *(const bf16x8*)(WBA + (size_t)fr * D + k0);
#pragma unroll
                for (int mt = 0; mt < 4; ++mt) { const bf16x8 afr = *(const bf16x8*)(XB + (size_t)(r0 + 16 * mt + fr) * D + k0); pacc[mt] = __builtin_amdgcn_mfma_f32_16x16x32_bf16(afr, bfr, pacc[mt], 0, 0, 0); } }
            LAS float* part = (LAS float*)(lds + PPART) + wave * 1024;
#pragma unroll
            for (int mt = 0; mt < 4; ++mt)
#pragma unroll
                for (int r = 0; r < 4; ++r) part[(16 * mt + 4 * fg + r) * 16 + fr] = pacc[mt][r]; }
        __syncthreads();
        { const int tok = tid >> 3, cp = tid & 7; float s0 = 0.f, s1 = 0.f;
#pragma unroll
            for (int w = 0; w < 8; ++w) { const f32x2 p2 = *(const LAS f32x2*)((LAS float*)(lds + PPART) + w * 1024 + tok * 16 + 2 * cp); s0 += p2[0]; s1 += p2[1]; }
            if (cp < 4) { betaS[tok * 8 + 2 * cp] = sigmoidf_(s0); betaS[tok * 8 + 2 * cp + 1] = sigmoidf_(s1); }
            else { const int h = 2 * (cp - 4); const float z0 = s0 + dtb[h], z1 = s1 + dtb[h + 1];
                const float sp0 = z0 > 20.f ? z0 : log1pf(__expf(z0)), sp1 = z1 > 20.f ? z1 : log1pf(__expf(z1));
                gS[tok * 8 + h] = -__expf(alog[h]) * sp0; gS[tok * 8 + h + 1] = -__expf(alog[h + 1]) * sp1; } }
        __syncthreads();
        if (tid < 8) { float run = 0.f; for (int t = 0; t < CH; ++t) { run += gS[t * 8 + tid]; gS[t * 8 + tid] = run; } }
        __syncthreads();
        for (int h = 0; h < NH; ++h) {
            const size_t chd = (size_t)unit * NH + h; bf16* img = IMG + chd * IMG_ELEMS; bf16* uimg = UIMG + chd * UIMG_ELEMS;
            if (tid < 64) { const float gi = gS[tid * 8 + h], bi = betaS[tid * 8 + h], eg = __expf(gi); gamh[tid] = gi; betah[tid] = bi; egam[tid] = eg; bgam[tid] = bi * eg; ekd[tid] = __expf(gS[63 * 8 + h] - gi); }
            __syncthreads();
            { const int c = tid & 127, rg = tid >> 7;
#pragma unroll
                for (int part = 0; part < 3; ++part) { const int col = part * 1024 + h * HD + c;
                    const float cw0 = convw[col], cw1 = convw[3072 + col], cw2 = convw[2 * 3072 + col], cw3 = convw[3 * 3072 + col];
                    const bf16* src = PROJ + (size_t)(r0 + rg * 16) * NPROJ + col; const int s = sq0 + rg * 16;
                    float xm3 = (s - 3 >= 0) ? bf2f(*(src - 3 * (ptrdiff_t)NPROJ)) : 0.f, xm2 = (s - 2 >= 0) ? bf2f(*(src - 2 * (ptrdiff_t)NPROJ)) : 0.f, xm1 = (s - 1 >= 0) ? bf2f(*(src - (ptrdiff_t)NPROJ)) : 0.f;
                    float y[16];
#pragma unroll
                    for (int i = 0; i < 16; ++i) { const float x = bf2f(src[(size_t)i * NPROJ]); const float t = cw0 * xm3 + cw1 * xm2 + cw2 * xm1 + cw3 * x; y[i] = t * sigmoidf_(t); xm3 = xm2; xm2 = xm1; xm1 = x; }
                    if (part == 0) {
#pragma unroll
                        for (int i = 0; i < 16; ++i) Qf[(rg * 16 + i) * F_LD + c] = y[i]; }
                    else if (part == 1) {
#pragma unroll
                        for (int i = 0; i < 16; ++i) Kf[(rg * 16 + i) * F_LD + c] = y[i]; }
                    else { v4u o0, o1;
                        o0.x = pkbf(y[0] * betah[rg * 16 + 0], y[1] * betah[rg * 16 + 1]); o0.y = pkbf(y[2] * betah[rg * 16 + 2], y[3] * betah[rg * 16 + 3]); o0.z = pkbf(y[4] * betah[rg * 16 + 4], y[5] * betah[rg * 16 + 5]); o0.w = pkbf(y[6] * betah[rg * 16 + 6], y[7] * betah[rg * 16 + 7]);
                        o1.x = pkbf(y[8] * betah[rg * 16 + 8], y[9] * betah[rg * 16 + 9]); o1.y = pkbf(y[10] * betah[rg * 16 + 10], y[11] * betah[rg * 16 + 11]); o1.z = pkbf(y[12] * betah[rg * 16 + 12], y[13] * betah[rg * 16 + 13]); o1.w = pkbf(y[14] * betah[rg * 16 + 14], y[15] * betah[rg * 16 + 15]);
                        *(LAS v4u*)(Vt + c * T_LD + rg * 16) = o0; *(LAS v4u*)(Vt + c * T_LD + rg * 16 + 8) = o1; } } }
            __syncthreads();
            { const int i = tid >> 3, part = tid & 7; const LAS float* qp = Qf + i * F_LD + part * 16; const LAS float* kp = Kf + i * F_LD + part * 16;
                f32x4 qv[4], kv[4]; float sq = 0.f, sk = 0.f;
#pragma unroll
                for (int j = 0; j < 4; ++j) { qv[j] = *(const LAS f32x4*)(qp + 4 * j); kv[j] = *(const LAS f32x4*)(kp + 4 * j);
                    sq += (qv[j][0] * qv[j][0] + qv[j][1] * qv[j][1]) + (qv[j][2] * qv[j][2] + qv[j][3] * qv[j][3]); sk += (kv[j][0] * kv[j][0] + kv[j][1] * kv[j][1]) + (kv[j][2] * kv[j][2] + kv[j][3] * kv[j][3]); }
                sq += __shfl_xor(sq, 1); sq += __shfl_xor(sq, 2); sq += __shfl_xor(sq, 4); sk += __shfl_xor(sk, 1); sk += __shfl_xor(sk, 2); sk += __shfl_xor(sk, 4);
                const float rq = 1.0f / sqrtf(sq + RMS_EPS) * 0.08838834764831845f, rk = 1.0f / sqrtf(sk + RMS_EPS);
                if (part == 0) rkS[i] = rk;
#pragma unroll
                for (int j = 0; j < 4; ++j) { qv[j] = qv[j] * rq; kv[j] = kv[j] * rk; }
                v4u w0, w1;
                w0.x = pkbf(qv[0][0], qv[0][1]); w0.y = pkbf(qv[0][2], qv[0][3]); w0.z = pkbf(qv[1][0], qv[1][1]); w0.w = pkbf(qv[1][2], qv[1][3]); w1.x = pkbf(qv[2][0], qv[2][1]); w1.y = pkbf(qv[2][2], qv[2][3]); w1.z = pkbf(qv[3][0], qv[3][1]); w1.w = pkbf(qv[3][2], qv[3][3]);
                *(LAS v4u*)(Qs + i * S_LD + part * 16) = w0; *(LAS v4u*)(Qs + i * S_LD + part * 16 + 8) = w1;
                w0.x = pkbf(kv[0][0], kv[0][1]); w0.y = pkbf(kv[0][2], kv[0][3]); w0.z = pkbf(kv[1][0], kv[1][1]); w0.w = pkbf(kv[1][2], kv[1][3]); w1.x = pkbf(kv[2][0], kv[2][1]); w1.y = pkbf(kv[2][2], kv[2][3]); w1.z = pkbf(kv[3][0], kv[3][1]); w1.w = pkbf(kv[3][2], kv[3][3]);
                *(LAS v4u*)(Ks + i * S_LD + part * 16) = w0; *(LAS v4u*)(Ks + i * S_LD + part * 16 + 8) = w1;
                const float eg = egam[i]; bf16* fq = img + ((size_t)(FR_QD + (i >> 5) * 8 + part) * 64 + (i & 31)) * 8;
                v4u h0, h1;
                h0.x = pkbf(qv[0][0] * eg, qv[0][1] * eg); h0.y = pkbf(qv[0][2] * eg, qv[0][3] * eg); h0.z = pkbf(qv[2][0] * eg, qv[2][1] * eg); h0.w = pkbf(qv[2][2] * eg, qv[2][3] * eg);
                h1.x = pkbf(qv[1][0] * eg, qv[1][1] * eg); h1.y = pkbf(qv[1][2] * eg, qv[1][3] * eg); h1.z = pkbf(qv[3][0] * eg, qv[3][1] * eg); h1.w = pkbf(qv[3][2] * eg, qv[3][3] * eg);
                *(v4u*)fq = h0; *(v4u*)(fq + 32 * 8) = h1; }
            __syncthreads();
            { const int c = tid & 127, rg = tid >> 7; float kb[16], kd[16];
#pragma unroll
                for (int i = 0; i < 16; ++i) { const int t = rg * 16 + i; const float kn = Kf[t * F_LD + c] * rkS[t]; kb[i] = kn * bgam[t]; kd[i] = kn * ekd[t]; }
                v4u o0, o1;
                o0.x = pkbf(kb[0], kb[1]); o0.y = pkbf(kb[2], kb[3]); o0.z = pkbf(kb[4], kb[5]); o0.w = pkbf(kb[6], kb[7]); o1.x = pkbf(kb[8], kb[9]); o1.y = pkbf(kb[10], kb[11]); o1.z = pkbf(kb[12], kb[13]); o1.w = pkbf(kb[14], kb[15]);
                *(LAS v4u*)(Kt + c * T_LD + rg * 16) = o0; *(LAS v4u*)(Kt + c * T_LD + rg * 16 + 8) = o1;
                bf16* fk = img + ((size_t)(FR_KDT + (c >> 5) * 4 + rg) * 64 + (c & 31)) * 8;
                v4u h0, h1;
                h0.x = pkbf(kd[0], kd[1]); h0.y = pkbf(kd[2], kd[3]); h0.z = pkbf(kd[8], kd[9]); h0.w = pkbf(kd[10], kd[11]);
                h1.x = pkbf(kd[4], kd[5]); h1.y = pkbf(kd[6], kd[7]); h1.z = pkbf(kd[12], kd[13]); h1.w = pkbf(kd[14], kd[15]);
                *(v4u*)fk = h0; *(v4u*)(fk + 32 * 8) = h1; }
            __syncthreads();
            if (wave < 6) { const int pr = wave % 3, iskk = wave / 3, mt = pr == 2 ? 1 : 0, nt = pr == 0 ? 0 : 1;
                const LAS bf16* xs = iskk ? Ks : Qs; f32x16 d;
#pragma unroll
                for (int r = 0; r < 16; ++r) d[r] = 0.f;
#pragma unroll
                for (int s = 0; s < 8; ++s) { const bf16x8 af = *(const LAS bf16x8*)(Ks + (32 * mt + c32) * S_LD + 16 * s + 8 * hf), bfr = *(const LAS bf16x8*)(xs + (32 * nt + c32) * S_LD + 16 * s + 8 * hf); d = MFMA32(af, bfr, d); }
                const int i = 32 * nt + c32; const float gi = gamh[i], bi = betah[i];
#pragma unroll
                for (int r = 0; r < 16; ++r) { const int j = 32 * mt + (r & 3) + 8 * (r >> 2) + 4 * hf; const float de = __expf(gi - gamh[j]);
                    d[r] = iskk ? ((j < i) ? bi * d[r] * de : 0.f) : ((j <= i) ? d[r] * de : 0.f); }
                if (iskk) {
#pragma unroll
                    for (int qd = 0; qd < 4; ++qd) *(LAS f32x4*)(As + i * A_LD + 32 * mt + 8 * qd + 4 * hf) = (f32x4){d[4 * qd], d[4 * qd + 1], d[4 * qd + 2], d[4 * qd + 3]}; }
                else {
#pragma unroll
                    for (int sp = 0; sp < 2; ++sp) *(bf16x8*)(img + ((size_t)(FR_AQK + nt * 4 + 2 * mt + sp) * 64 + lane) * 8) = PACK8(d, sp); } }
            __syncthreads();
            if (wave == 0) { float Tc[32];
                unsigned asb = (unsigned)(uintptr_t)(As + (32 * hf) * A_LD + 32 * hf); int cb = c32; asm volatile("" : "+v"(asb), "+v"(cb));
                const LAS float* Ab = (const LAS float*)(uintptr_t)asb;
#pragma unroll
                for (int i = 0; i < 32; ++i) { float acc = (i == cb) ? 1.f : 0.f;
#pragma unroll
                    for (int j4 = 0; j4 < (i + 3) / 4; ++j4) { const f32x4 a4 = *(const LAS f32x4*)(Ab + i * A_LD + 4 * j4);
#pragma unroll
                        for (int q = 0; q < 4; ++q) if (4 * j4 + q < i) acc -= a4[q] * Tc[4 * j4 + q]; }
                    Tc[i] = acc; }
#pragma unroll
                for (int i = 0; i < 32; ++i) Tb[(32 * hf + i) * T_LD + 32 * hf + c32] = (bf16)(pkbf(Tc[i], 0.f) & 0xffffu);
                if (hf == 0) {
#pragma unroll
                    for (int q = 0; q < 4; ++q) { v4u o; o.x = pkbf(Tc[8 * q], Tc[8 * q + 1]); o.y = pkbf(Tc[8 * q + 2], Tc[8 * q + 3]); o.z = pkbf(Tc[8 * q + 4], Tc[8 * q + 5]); o.w = pkbf(Tc[8 * q + 6], Tc[8 * q + 7]); *(LAS v4u*)(T11t + c32 * TT_LD + 8 * q) = o; } }
                asm volatile("s_waitcnt lgkmcnt(0)" ::: "memory");
                f32x16 x;
#pragma unroll
                for (int r = 0; r < 16; ++r) x[r] = 0.f;
#pragma unroll
                for (int s = 0; s < 2; ++s) { const LAS float* ap = As + (32 + c32) * A_LD + 16 * s + 8 * hf; const f32x4 a0 = *(const LAS f32x4*)ap, a1 = *(const LAS f32x4*)(ap + 4);
                    const bf16x8 af = __builtin_bit_cast(bf16x8, (v4u){pkbf(a0[0], a0[1]), pkbf(a0[2], a0[3]), pkbf(a1[0], a1[1]), pkbf(a1[2], a1[3])});
                    const bf16x8 bfr = *(const LAS bf16x8*)(T11t + c32 * TT_LD + 16 * s + 8 * hf); x = MFMA32(af, bfr, x); }
                f32x16 t21;
#pragma unroll
                for (int r = 0; r < 16; ++r) t21[r] = 0.f;
#pragma unroll
                for (int s = 0; s < 2; ++s) { const LAS bf16* tp = Tb + (32 + c32) * T_LD + 32 + 16 * s + 4 * hf; const v2u lo = *(const LAS v2u*)tp, hi = *(const LAS v2u*)(tp + 8);
                    const bf16x8 af = __builtin_bit_cast(bf16x8, (v4u){lo.x, lo.y, hi.x, hi.y}); const bf16x8 bfr = PACK8(x, s); t21 = MFMA32(af, bfr, t21); }
#pragma unroll
                for (int r = 0; r < 16; ++r) Tb[(32 + (r & 3) + 8 * (r >> 2) + 4 * hf) * T_LD + c32] = (bf16)(pkbf(-t21[r], 0.f) & 0xffffu);
            }
            __syncthreads();
            if (wave < 4) {
#pragma unroll
                for (int mt = 0; mt < 2; ++mt) { f32x16 d;
#pragma unroll
                    for (int r = 0; r < 16; ++r) d[r] = 0.f;
#pragma unroll
                    for (int s = 0; s < 4; ++s) if (s < 2 * (mt + 1)) { const bf16x8 af = *(const LAS bf16x8*)(Tb + (32 * mt + c32) * T_LD + 16 * s + 8 * hf), bfr = *(const LAS bf16x8*)(Vt + (32 * wave + c32) * T_LD + 16 * s + 8 * hf); d = MFMA32(af, bfr, d); }
                    bf16* up = uimg + ((size_t)(wave * 2 + mt) * 64 + lane) * 16; *(bf16x8*)up = PACK8(d, 0); *(bf16x8*)(up + 8) = PACK8(d, 1); } }
            else { const int ct = wave - 4;
#pragma unroll
                for (int nt = 0; nt < 2; ++nt) { f32x16 d;
#pragma unroll
                    for (int r = 0; r < 16; ++r) d[r] = 0.f;
#pragma unroll
                    for (int s = 0; s < 4; ++s) if (s < 2 * (nt + 1)) { const bf16x8 af = *(const LAS bf16x8*)(Kt + (32 * ct + c32) * T_LD + 16 * s + 8 * hf), bfr = *(const LAS bf16x8*)(Tb + (32 * nt + c32) * T_LD + 16 * s + 8 * hf); d = MFMA32(af, bfr, d); }
#pragma unroll
                    for (int r = 0; r < 16; ++r) d[r] = -d[r];
#pragma unroll
                    for (int sp = 0; sp < 2; ++sp) *(bf16x8*)(img + ((size_t)(FR_WN + nt * 8 + 2 * ct + sp) * 64 + lane) * 8) = PACK8(d, sp); } }
            if (tid == 0) CD[chd] = egam[63];
            __syncthreads();
        }
    }
}

constexpr int SCB = 57344, OT_OFF = 2 * SCB, OT_LD = 136, OT_BYTES = 64 * OT_LD * 2;
static_assert(OT_OFF + 2 * OT_BYTES <= 152 * 1024, "scan LDS");
__device__ __forceinline__ void phase_dn_scan(const Frame& F0, const Args& a, int layer, int unit) {
    PHASE_FRAME(F0);
    unsigned char* ws = a.ws; OPQ_S(ws);
    LAS unsigned char* lds = F.lds;
    const int b = unit >> 3, h = unit & 7, lane = F.lane;
    const bf16* IMG = (const bf16*)(ws + WS_IMG); const bf16* UIMG = (const bf16*)(ws + WS_UIMG); const float* CD = (const float*)(ws + WS_CD);
    const size_t chd0 = (size_t)b * NCH * NH + h;
    if (F.wave < 4) {
#ifndef SCAN_NO_COMPUTE
        const int w = F.wave, c32 = lane & 31, hf = lane >> 5;
        f32x16 S[4]; bf16x8 Sb[8];
#pragma unroll
        for (int mt = 0; mt < 4; ++mt)
#pragma unroll
            for (int r = 0; r < 16; ++r) S[mt][r] = 0.f;
#pragma unroll
        for (int s = 0; s < 8; ++s) Sb[s] = (bf16x8){0, 0, 0, 0, 0, 0, 0, 0};
        const float cdl = CD[chd0 + (size_t)lane * NH];
        v4u UA[4];
        const __amdgpu_buffer_rsrc_t rsU = __builtin_amdgcn_make_buffer_rsrc((void*)(UIMG + chd0 * UIMG_ELEMS), (short)0, NCH * NH * UIMG_ELEMS * 2, 0x00020000);
        const unsigned uoff = (unsigned)((w * 2) * 64 + lane) * 32u;
#define SC_LOADU(dst, nn) do { _Pragma("unroll") for (int mt_ = 0; mt_ < 2; ++mt_) { _Pragma("unroll") for (int hh_ = 0; hh_ < 2; ++hh_) dst[2 * mt_ + hh_] = __builtin_amdgcn_raw_buffer_load_b128(rsU, uoff + (unsigned)(mt_ * 2048 + hh_ * 16), (unsigned)(nn) * (unsigned)(NH * UIMG_ELEMS * 2), 0); } } while (0)
#define SC_FRAG(bufoff, fi) (*(const LAS bf16x8*)(lds + (bufoff) + (fi) * 1024 + lane * 16))
#define SC_CHUNK(nn, U, bufoff, otoff) do { \
        f32x16 aV[2], aO[2]; \
        _Pragma("unroll") for (int mt = 0; mt < 2; ++mt) { _Pragma("unroll") for (int q = 0; q < 4; ++q) { aV[mt][2 * q] = bflo(U[2 * mt][q]); aV[mt][2 * q + 1] = bfhi(U[2 * mt][q]); aV[mt][8 + 2 * q] = bflo(U[2 * mt + 1][q]); aV[mt][8 + 2 * q + 1] = bfhi(U[2 * mt + 1][q]); } \
            _Pragma("unroll") for (int r = 0; r < 16; ++r) aO[mt][r] = 0.f; } \
        if ((nn) + 1 < NCH) SC_LOADU(U, (nn) + 1); \
        const float cd = __builtin_bit_cast(float, __builtin_amdgcn_readlane(__builtin_bit_cast(int, cdl), (nn))); \
        _Pragma("unroll") for (int s = 0; s < 8; ++s) { _Pragma("unroll") for (int mt = 0; mt < 2; ++mt) { aV[mt] = MFMA32(SC_FRAG(bufoff, FR_WN + mt * 8 + s), Sb[s], aV[mt]); aO[mt] = MFMA32(SC_FRAG(bufoff, FR_QD + mt * 8 + s), Sb[s], aO[mt]); } } \
        _Pragma("unroll") for (int mt = 0; mt < 4; ++mt) S[mt] = S[mt] * cd; \
        bf16x8 Vb[4]; Vb[0] = PACK8(aV[0], 0); Vb[1] = PACK8(aV[0], 1); Vb[2] = PACK8(aV[1], 0); Vb[3] = PACK8(aV[1], 1); \
        aO[0] = MFMA32(SC_FRAG(bufoff, FR_AQK + 0), Vb[0], aO[0]); aO[0] = MFMA32(SC_FRAG(bufoff, FR_AQK + 1), Vb[1], aO[0]); \
        _Pragma("unroll") for (int s = 0; s < 4; ++s) aO[1] = MFMA32(SC_FRAG(bufoff, FR_AQK + 4 + s), Vb[s], aO[1]); \
        _Pragma("unroll") for (int mt = 0; mt < 4; ++mt) { _Pragma("unroll") for (int s = 0; s < 4; ++s) S[mt] = MFMA32(SC_FRAG(bufoff, FR_KDT + mt * 4 + s), Vb[s], S[mt]); } \
        _Pragma("unroll") for (int s = 0; s < 8; ++s) Sb[s] = PACK8(S[s >> 1], s & 1); \
        _Pragma("unroll") for (int mt = 0; mt < 2; ++mt) { _Pragma("unroll") for (int r = 0; r < 16; ++r) \
            *(LAS bf16*)(lds + (otoff) + ((32 * mt + (r & 3) + 8 * (r >> 2) + 4 * hf) * OT_LD + 32 * w + c32) * 2) = (bf16)(pkbf(aO[mt][r], 0.f) & 0xffffu); } \
        RAW_BAR(); } while (0)
        SC_LOADU(UA, 0);
        RAW_BAR();
#pragma unroll 1
        for (int n = 0; n < NCH; n += 2) { SC_CHUNK(n, UA, 0, OT_OFF); SC_CHUNK(n + 1, UA, SCB, OT_OFF + OT_BYTES); }
#undef SC_CHUNK
#undef SC_FRAG
#undef SC_LOADU
#endif
    } else {
#ifndef SCAN_NO_HELPER
        const int ht = F.tid - 256, tok = ht >> 2, q = ht & 3;
        const bf16* PROJ = (const bf16*)(ws + WS_PROJ); bf16* MIXIN = (bf16*)(ws + WS_MIXIN);
        const float* nw = a.in[I_NORMW] + layer * HD + 32 * q;
        v4u RA[14], ZA[4];
        const __amdgpu_buffer_rsrc_t rsI = __builtin_amdgcn_make_buffer_rsrc((void*)(IMG + chd0 * IMG_ELEMS), (short)0, NCH * NH * IMG_ELEMS * 2, 0x00020000);
        const __amdgpu_buffer_rsrc_t rsZ = __builtin_amdgcn_make_buffer_rsrc((void*)(PROJ + (size_t)b * SEQ * NPROJ), (short)0, SEQ * NPROJ * 2, 0x00020000);
        const unsigned zoff = (unsigned)(tok * NPROJ + 3072 + h * HD + 32 * q) * 2u;
#define SH_LOADIMG(dst, nn) do { _Pragma("unroll") for (int i_ = 0; i_ < 14; ++i_) dst[i_] = __builtin_amdgcn_raw_buffer_load_b128(rsI, (unsigned)ht * 16u, (unsigned)(nn) * (unsigned)(NH * IMG_ELEMS * 2) + (unsigned)i_ * 4096u, 0); } while (0)
#define SH_STOREIMG(src, bufoff) do { LAS v4u* p_ = (LAS v4u*)(lds + (bufoff)) + ht; _Pragma("unroll") for (int i_ = 0; i_ < 14; ++i_) p_[i_ * 256] = src[i_]; } while (0)
#define SH_LOADZ(dst, nn) do { _Pragma("unroll") for (int i_ = 0; i_ < 4; ++i_) dst[i_] = __builtin_amdgcn_raw_buffer_load_b128(rsZ, zoff + 16u * (unsigned)i_, (unsigned)(nn) * (unsigned)(CH * NPROJ * 2), 0); } while (0)
#define SH_EPI(mm, Z, otoff) do { const float* nwp_ = nw; asm volatile("" : "+v"(nwp_)); const LAS v4u* op_ = (const LAS v4u*)(lds + (otoff) + (tok * OT_LD + 32 * q) * 2); v4u ow[4]; float ss = 0.f; \
        _Pragma("unroll") for (int i_ = 0; i_ < 4; ++i_) { ow[i_] = op_[i_]; _Pragma("unroll") for (int j_ = 0; j_ < 4; ++j_) { const float x0 = bflo(ow[i_][j_]), x1 = bfhi(ow[i_][j_]); ss += x0 * x0 + x1 * x1; } } \
        ss += __shfl_xor(ss, 1); ss += __shfl_xor(ss, 2); const float rr = 1.0f / sqrtf(ss * (1.0f / HD) + RMS_EPS); \
        v4u* yp_ = (v4u*)(MIXIN + ((size_t)b * SEQ + (size_t)(mm) * CH + tok) * D + h * HD + 32 * q); \
        _Pragma("unroll") for (int i_ = 0; i_ < 4; ++i_) { __builtin_amdgcn_sched_barrier(0); v4u o_; const f32x4 n0 = *(const f32x4*)(nwp_ + 8 * i_), n1 = *(const f32x4*)(nwp_ + 8 * i_ + 4); \
            _Pragma("unroll") for (int j_ = 0; j_ < 4; ++j_) { const float z0 = bflo(Z[i_][j_]), z1 = bfhi(Z[i_][j_]); const float g0 = (j_ < 2 ? n0[2 * j_] : n1[2 * j_ - 4]), g1 = (j_ < 2 ? n0[2 * j_ + 1] : n1[2 * j_ - 3]); \
            o_[j_] = pkbf(bflo(ow[i_][j_]) * rr * g0 * z0 * sigmoidf_(z0), bfhi(ow[i_][j_]) * rr * g1 * z1 * sigmoidf_(z1)); } yp_[i_] = o_; } } while (0)
#define SH_STEP(nn, bufnext, otprev) do { \
        if ((nn) + 1 < NCH) SH_STOREIMG(RA, bufnext); \
        if ((nn) + 2 < NCH) SH_LOADIMG(RA, (nn) + 2); \
        if ((nn) >= 1) SH_EPI((nn) - 1, ZA, otprev); \
        SH_LOADZ(ZA, (nn)); \
        RAW_BAR(); } while (0)
        SH_LOADIMG(RA, 0);
        SH_STOREIMG(RA, 0);
        SH_LOADIMG(RA, 1);
        RAW_BAR();
#pragma unroll 1
        for (int n = 0; n < NCH; n += 2) { SH_STEP(n, SCB, OT_OFF + OT_BYTES); SH_STEP(n + 1, 0, OT_OFF); }
        SH_EPI(NCH - 1, ZA, OT_OFF + OT_BYTES);
#undef SH_STEP
#undef SH_EPI
#undef SH_LOADZ
#undef SH_STOREIMG
#undef SH_LOADIMG
#endif
    }
}

__device__ __forceinline__ void phase_ln1_router(const Frame& F0, const Args& a, int layer) {
    PHASE_FRAME(F0);
    unsigned char* ws = a.ws; OPQ_S(ws);
    LAS float* WRt = (LAS float*)F.lds;
    LAS int* rowE = (LAS int*)(F.lds + AUX_OFF); LAS int* rowP = rowE + 128; LAS float* rowG = (LAS float*)(rowP + 128); LAS int* lcnt = (LAS int*)(rowG + 128); LAS int* lbase = lcnt + 16;
    const float* wr = a.in[I_WR]; const float* br = a.in[I_BR]; OPQ_S(wr); OPQ_S(br);
    for (int idx = F.tid; idx < D * NE; idx += 512) WRt[(idx & 15) * D + (idx >> 4)] = wr[idx];
    const float* PRE = a.out; bf16* X1B = (bf16*)(ws + WS_X1B); float* STATS = (float*)(ws + WS_STATS);
    const float* g1 = a.in[I_LN1G] + (size_t)layer * D; const float* b1 = a.in[I_LN1B] + (size_t)layer * D;
    int* LIST = (int*)(ws + WS_LIST); int* TOKSLOT = (int*)(ws + WS_TOKSLOT); float* GATEW = (float*)(ws + WS_GATEW);
    gu32* cnt = F.ctl + CW_CNT + 64 * layer;
    float brv[16];
#pragma unroll
    for (int e = 0; e < 16; ++e) brv[e] = br[e];
    for (int rb = F.vcu; rb < T / 64; rb += F.G) {
        if (F.tid < 16) lcnt[F.tid] = 0;
        __syncthreads();
        for (int r = 0; r < 8; ++r) { const int lr = F.wave * 8 + r, row = rb * 64 + lr;
            const GAS f32x4* xr = (const GAS f32x4*)(PRE + (size_t)row * D) + F.lane;
            f32x4 v[8]; float s = 0.f;
#pragma unroll
            for (int j = 0; j < 8; ++j) { v[j] = xr[64 * j]; s += (v[j][0] + v[j][1]) + (v[j][2] + v[j][3]); }
            const float mean = wave_sum(s) * (1.f / D); float s2 = 0.f;
#pragma unroll
            for (int j = 0; j < 8; ++j) { v[j] = v[j] - mean; s2 += (v[j][0] * v[j][0] + v[j][1] * v[j][1]) + (v[j][2] * v[j][2] + v[j][3] * v[j][3]); }
            const float rstd = 1.f / sqrtf(wave_sum(s2) * (1.f / D) + LN_EPS);
            if (F.lane == 0) { STATS[2 * row] = mean; STATS[2 * row + 1] = rstd; }
            GAS v2u* o8 = (GAS v2u*)(X1B + (size_t)row * D) + F.lane;
            float lg[16];
#pragma unroll
            for (int e = 0; e < 16; ++e) lg[e] = 0.f;
#pragma unroll
            for (int j = 0; j < 8; ++j) { const f32x4 gg = *(const f32x4*)(g1 + 256 * j + 4 * F.lane), bb = *(const f32x4*)(b1 + 256 * j + 4 * F.lane);
                v[j] = v[j] * rstd * gg + bb;
                v2u w; w.x = pk2(v[j][0], v[j][1]); w.y = pk2(v[j][2], v[j][3]); o8[64 * j] = w;
#pragma unroll
                for (int e = 0; e < 16; ++e) { const f32x4 w4 = *(const LAS f32x4*)(WRt + e * D + 256 * j + 4 * F.lane); lg[e] += (v[j][0] * w4[0] + v[j][1] * w4[1]) + (v[j][2] * w4[2] + v[j][3] * w4[3]); } }
            float mx = -3.0e38f;
#pragma unroll
            for (int e = 0; e < 16; ++e) { lg[e] = wave_sum(lg[e]) + brv[e]; mx = fmaxf(mx, lg[e]); }
            float p[16];
#pragma unroll
            for (int e = 0; e < 16; ++e) p[e] = __expf(lg[e] - mx);
            float gsc[4];
#pragma unroll
            for (int g = 0; g < 4; ++g) { const float a0 = p[4 * g], a1 = p[4 * g + 1], a2 = p[4 * g + 2], a3 = p[4 * g + 3];
                const float hi1 = fmaxf(a0, a1), lo1 = fminf(a0, a1), hi2 = fmaxf(a2, a3), lo2 = fminf(a2, a3);
                gsc[g] = fmaxf(hi1, hi2) + fmaxf(fminf(hi1, hi2), fmaxf(lo1, lo2)); }
            int gsel = 0; float best = gsc[0];
#pragma unroll
            for (int g = 1; g < 4; ++g) if (gsc[g] > best) { best = gsc[g]; gsel = g; }
            float q[4];
#pragma unroll
            for (int j = 0; j < 4; ++j) q[j] = gsel == 0 ? p[j] : (gsel == 1 ? p[4 + j] : (gsel == 2 ? p[8 + j] : p[12 + j]));
            int i0 = 0; float p0 = q[0];
#pragma unroll
            for (int j = 1; j < 4; ++j) if (q[j] > p0) { p0 = q[j]; i0 = j; }
            int i1 = -1; float p1 = -1.f;
#pragma unroll
            for (int j = 0; j < 4; ++j) if (j != i0 && q[j] > p1) { p1 = q[j]; i1 = j; }
            if (F.lane == 0) { const int e0 = gsel * 4 + i0, e1 = gsel * 4 + i1; const float inv = 1.0f / (p0 + p1);
                rowE[2 * lr] = e0; rowE[2 * lr + 1] = e1; rowG[2 * lr] = p0 * inv; rowG[2 * lr + 1] = p1 * inv;
                rowP[2 * lr] = __hip_atomic_fetch_add(&lcnt[e0], 1, __ATOMIC_RELAXED, __HIP_MEMORY_SCOPE_WORKGROUP); rowP[2 * lr + 1] = __hip_atomic_fetch_add(&lcnt[e1], 1, __ATOMIC_RELAXED, __HIP_MEMORY_SCOPE_WORKGROUP); }
        }
        __syncthreads();
        if (F.tid < 16) lbase[F.tid] = (int)__hip_atomic_fetch_add(cnt + F.tid, (unsigned)lcnt[F.tid], RLX_AGENT);
        __syncthreads();
        if (F.tid < 128) { const int e = rowE[F.tid], pos = lbase[e] + rowP[F.tid], tok = rb * 64 + (F.tid >> 1);
            LIST[(size_t)e * LCAP + pos] = tok; TOKSLOT[2 * tok + (F.tid & 1)] = e * LCAP + pos; GATEW[2 * tok + (F.tid & 1)] = rowG[F.tid]; }
        __syncthreads();
    }
}
__device__ __forceinline__ void moe_table(const Frame& F0, int layer) {
    PHASE_FRAME(F0);
    LAS int* tab = (LAS int*)(F.lds + AUX_OFF);
    __syncthreads();
    if (F.tid < 16) tab[32 + F.tid] = (int)__hip_atomic_load(F.ctl + CW_CNT + 64 * layer + F.tid, RLX_AGENT);
    __syncthreads();
    if (F.tid == 0) { int run = 0; for (int e = 0; e < 16; ++e) { tab[e] = run; run += (tab[32 + e] + 255) >> 8; } tab[16] = run; }
    __syncthreads();
}
__device__ __forceinline__ void phase_combine_ln2(const Frame& F0, const Args& a, int layer) {
    PHASE_FRAME(F0);
    unsigned char* ws = a.ws; OPQ_S(ws); const LAS int* tab = (const LAS int*)(F.lds + AUX_OFF);
    float* PRE = a.out; const float* STATS = (const float*)(ws + WS_STATS); const bf16* Y = (const bf16*)(ws + WS_Y); bf16* X2B = (bf16*)(ws + WS_X2B);
    const int* TOKSLOT = (const int*)(ws + WS_TOKSLOT); const float* GATEW = (const float*)(ws + WS_GATEW);
    const float* g1 = a.in[I_LN1G] + (size_t)layer * D; const float* b1 = a.in[I_LN1B] + (size_t)layer * D; const float* g2 = a.in[I_LN2G] + (size_t)layer * D; const float* b2 = a.in[I_LN2B] + (size_t)layer * D;
    const int gw = F.vcu * NWAVES + F.wave, NGW = F.G * NWAVES;
    for (int row = gw; row < T; row += NGW) {
        const float mean = STATS[2 * row], rstd = STATS[2 * row + 1];
        const int s0 = TOKSLOT[2 * row], s1 = TOKSLOT[2 * row + 1]; const float w0 = GATEW[2 * row], w1 = GATEW[2 * row + 1];
        const size_t y0 = (size_t)tab[s0 / LCAP] * 256 + (s0 % LCAP), y1 = (size_t)tab[s1 / LCAP] * 256 + (s1 % LCAP);
        GAS f32x4* xr = (GAS f32x4*)(PRE + (size_t)row * D) + F.lane; const GAS v2u* ya = (const GAS v2u*)(Y + y0 * D) + F.lane; const GAS v2u* yb = (const GAS v2u*)(Y + y1 * D) + F.lane;
        f32x4 v[8]; float s = 0.f;
#pragma unroll
        for (int j = 0; j < 8; ++j) { const f32x4 gg = *(const f32x4*)(g1 + 256 * j + 4 * F.lane), bb = *(const f32x4*)(b1 + 256 * j + 4 * F.lane);
            const f32x4 x1 = (xr[64 * j] - mean) * rstd * gg + bb; const v2u pa = ya[64 * j], pb = yb[64 * j];
            f32x4 f; f[0] = w0 * bflo(pa.x) + w1 * bflo(pb.x); f[1] = w0 * bfhi(pa.x) + w1 * bfhi(pb.x); f[2] = w0 * bflo(pa.y) + w1 * bflo(pb.y); f[3] = w0 * bfhi(pa.y) + w1 * bfhi(pb.y);
            v[j] = x1 * ALPHA + f; s += (v[j][0] + v[j][1]) + (v[j][2] + v[j][3]); }
        const float m2 = wave_sum(s) * (1.f / D); float q = 0.f;
#pragma unroll
        for (int j = 0; j < 8; ++j) { v[j] = v[j] - m2; q += (v[j][0] * v[j][0] + v[j][1] * v[j][1]) + (v[j][2] * v[j][2] + v[j][3] * v[j][3]); }
        const float r2 = 1.f / sqrtf(wave_sum(q) * (1.f / D) + LN_EPS);
        GAS v2u* o8 = (GAS v2u*)(X2B + (size_t)row * D) + F.lane;
#pragma unroll
        for (int j = 0; j < 8; ++j) { const f32x4 gg = *(const f32x4*)(g2 + 256 * j + 4 * F.lane), bb = *(const f32x4*)(b2 + 256 * j + 4 * F.lane);
            const f32x4 o = v[j] * r2 * gg + bb; xr[64 * j] = o; v2u w; w.x = pk2(o[0], o[1]); w.y = pk2(o[2], o[3]); o8[64 * j] = w; }
    }
}

#ifndef MK_N_LAUNCHES
#define MK_N_LAUNCHES 1
#endif
constexpr int NPL = 9;
constexpr int NPHASE = 1 + NPL * DEPTH;
constexpr int N_LAUNCHES = MK_N_LAUNCHES;
static_assert(N_LAUNCHES == 1 || N_LAUNCHES == NPHASE, "MK_N_LAUNCHES is 1 or NPHASE");

__global__ void __launch_bounds__(NWAVES * 64, 2) trunk_fwd(Args args) {
    extern __shared__ __attribute__((aligned(16))) unsigned char lds[];
    Frame F;
    F.lds = (LAS unsigned char*)lds;
    F.MISC = (volatile LAS unsigned*)(F.lds + MISC_OFF);
    F.tid = threadIdx.x; F.lane = F.tid & 63; F.wave = __builtin_amdgcn_readfirstlane(F.tid >> 6);
    F.G = gridDim.x; { const int bx = blockIdx.x; F.vcu = (F.G % 8 == 0) ? (bx % 8) * (F.G / 8) + bx / 8 : bx; }
    unsigned char* ws = args.ws;
    F.ctl = (gu32*)(ws + WS_CTL);
    for (int u = F.tid; u < (LDS_BYTES - LDSCTL_OFF) / 4; u += NWAVES * 64) ((LAS unsigned*)(F.lds + LDSCTL_OFF))[u] = 0u;
    __syncthreads();
    XcdBarrier bar; bar.bar = (unsigned*)(F.ctl + CW_BAR); bar.x = 0; bar.st = nullptr;
    if (N_LAUNCHES == 1) bar = xcd_barrier_post((unsigned*)(F.ctl + CW_BAR), F.MISC + 8);
#define GRID_BAR() do { if (N_LAUNCHES == 1) xcd_barrier(bar); } while (0)
    const int lo = args.ph_lo, hi = args.ph_hi;
#ifndef PH_MASK
#define PH_MASK 0x7ff
#endif
#define IN(k) ((((k) == 0 ? 1u : (2u << (((k) - 1) % NPL))) & (unsigned)(PH_MASK)) && lo <= (k) && (k) < hi)
#define SEAM(k) do { if (IN((k) + 1)) GRID_BAR(); } while (0)

    if (IN(0)) { p0_prologue(F, args); SEAM(0); }

#ifdef LAYER_UNROLL
#pragma unroll
#else
#pragma unroll 1
#endif
    for (int layer = 0; layer < DEPTH; ++layer) {
        const int pb = 1 + NPL * layer;
        unsigned char* ws = args.ws; OPQ_S(ws);
        if (IN(pb + 0)) {
            SchedDense S; S.init(T, NPROJ, F.G, (int)blockIdx.x, ws + WS_XB, D, (const bf16*)(ws + WS_WIN) + (size_t)layer * NPROJ * D, D);
            EpiBf16 E{(bf16*)(ws + WS_PROJ), NPROJ};
            pg8::gemm_phase<EpiBf16, SchedDense, false>(F.lds + RING_OFF, D, D, D, S, E);
            SEAM(pb + 0);
        }
        if (IN(pb + 1)) { phase_dn_prep(F, args, layer); SEAM(pb + 1); }
        if (IN(pb + 2)) {
            if (blockIdx.x < 32 || F.G <= 32) { for (int u = blockIdx.x; u < NB * NH; u += (F.G < 32 ? F.G : 32)) phase_dn_scan(F, args, layer, u); }
            if (blockIdx.x >= 32 || F.G <= 32) { const int G2 = F.G <= 32 ? F.G : F.G - 32, c2 = F.G <= 32 ? (int)blockIdx.x : (int)blockIdx.x - 32;
                { SchedPool S{G2, c2, (const char*)(ws + WS_POOLD), (const char*)((const bf16*)(ws + WS_WPOOL) + (size_t)layer * 4 * 65536)};
                  EpiPool E{(bf16*)(ws + WS_MIXIN), args.in[I_POOLS] + (size_t)layer * PW};
                  pg8::gemm_phase<EpiPool, SchedPool, false>(F.lds + RING_OFF, 256, PW, 256, S, E); }
                { SchedDense S; S.init(T, D, G2, c2, (const bf16*)(ws + WS_PB16) + (size_t)layer * T * PLE, PLE, (const bf16*)(ws + WS_WPP) + (size_t)layer * D * PLE, PLE);
                  EpiBf16 E{(bf16*)(ws + WS_PP), D};
                  pg8::gemm_phase<EpiBf16, SchedDense, false>(F.lds + RING_OFF, PLE, PLE, PLE, S, E); } }
            SEAM(pb + 2);
        }
        if (IN(pb + 3)) {
            SchedDense S; S.init(T, D, F.G, (int)blockIdx.x, ws + WS_MIXIN, D, (const bf16*)(ws + WS_WOUT) + (size_t)layer * D * D, D);
            EpiRes E{layer == 0 ? args.in[I_X] : args.out, args.out};
            pg8::gemm_phase<EpiRes, SchedDense, false>(F.lds + RING_OFF, D, D, D, S, E);
            SEAM(pb + 3);
        }
        if (IN(pb + 4)) { phase_ln1_router(F, args, layer); SEAM(pb + 4); }
        if (IN(pb + 5)) {
            moe_table(F, layer);
            SchedMoe S{F.G, (int)blockIdx.x, 0, (const LAS int*)(F.lds + AUX_OFF), (const char*)(ws + WS_X1B), (const char*)((const bf16*)(ws + WS_WGU) + (size_t)layer * NE * 2048 * D), (const int*)(ws + WS_LIST)};
            EpiSwiglu E{(bf16*)(ws + WS_HID)};
            pg8::gemm_phase<EpiSwiglu, SchedMoe, true>(F.lds + RING_OFF, D, D, D, S, E);
            SEAM(pb + 5);
        }
        if (IN(pb + 6)) {
            moe_table(F, layer);
            SchedMoe S{F.G, (int)blockIdx.x, 1, (const LAS int*)(F.lds + AUX_OFF), (const char*)(ws + WS_HID), (const char*)((const bf16*)(ws + WS_WD) + (size_t)layer * NE * D * DE), nullptr};
            EpiBf16 E{(bf16*)(ws + WS_Y), D};
            pg8::gemm_phase<EpiBf16, SchedMoe, false>(F.lds + RING_OFF, DE, DE, DE, S, E);
            SEAM(pb + 6);
        }
        if (IN(pb + 7)) { moe_table(F, layer); phase_combine_ln2(F, args, layer); SEAM(pb + 7); }
        if (IN(pb + 8)) {
            { SchedDense S; S.init(T, D, F.G, (int)blockIdx.x, ws + WS_X2B, D, (const bf16*)(ws + WS_WPG) + (size_t)layer * D * D, D);
              EpiPle E{args.out, (const bf16*)(ws + WS_PP), (bf16*)(ws + WS_XB), layer + 1 < DEPTH ? 1 : 0};
              pg8::gemm_phase<EpiPle, SchedDense, false>(F.lds + RING_OFF, D, D, D, S, E); }
            SEAM(pb + 8);
        }
    }
#undef IN
#undef SEAM
#undef GRID_BAR
}

extern "C" void kernel_launch(void* const* d_in, const int* in_sizes, int n_in, void* d_out, int out_size, void* d_ws, size_t ws_size, hipStream_t stream) {
    static int grid = 0;
    if (grid == 0) {
        if (n_in != 21 || in_sizes[0] != T * D || out_size != T * D || ws_size < WS_END) { fprintf(stderr, "kernel_launch: unexpected shapes (n_in %d, in0 %d, out %d, ws %zu); nothing launched\n", n_in, n_in > 0 ? in_sizes[0] : -1, out_size, ws_size); grid = -1; return; }
        int dev = 0, cus = 0, per_cu = 0;
        if (hipGetDevice(&dev) != hipSuccess || hipDeviceGetAttribute(&cus, hipDeviceAttributeMultiprocessorCount, dev) != hipSuccess) { grid = -1; return; }
        if (hipFuncSetAttribute((const void*)trunk_fwd, hipFuncAttributeMaxDynamicSharedMemorySize, LDS_BYTES) != hipSuccess) { fprintf(stderr, "kernel_launch: hipFuncSetAttribute failed\n"); grid = -1; return; }
        if (hipOccupancyMaxActiveBlocksPerMultiprocessor(&per_cu, (const void*)trunk_fwd, NWAVES * 64, LDS_BYTES) != hipSuccess || per_cu < 1) { fprintf(stderr, "kernel_launch: occupancy query reports %d workgroups per CU\n", per_cu); }
        (void)hipGetLastError();
        grid = cus;
    }
    if (grid < 0) return;
    if (hipMemsetAsync((char*)d_ws + WS_CTL, 0, CTL_ZERO_BYTES, stream) != hipSuccess) return;
    Args a{};
    for (int i = 0; i < 21; ++i) a.in[i] = (const float*)d_in[i];
    a.out = (float*)d_out; a.ws = (unsigned char*)d_ws;
    for (int li = 0; li < N_LAUNCHES; ++li) {
        a.ph_lo = (N_LAUNCHES == 1) ? 0 : li; a.ph_hi = (N_LAUNCHES == 1) ? NPHASE : li + 1; a.li = li; a.pad = 0;
        hipLaunchKernelGGL(trunk_fwd, dim3(grid), dim3(NWAVES * 64), LDS_BYTES, stream, a);
        const hipError_t le = hipPeekAtLastError();
        if (le != hipSuccess) { fprintf(stderr, "kernel_launch: launch %d failed: %s\n", li, hipGetErrorName(le)); break; }
    }
}
```

```cpp
#define MK_N_LAUNCHES 1
#include <hip/hip_runtime.h>
#include <cstdio>
#include <cstdint>

#define GAS __attribute__((address_space(1)))
#define LAS __attribute__((address_space(3)))
typedef unsigned short bf16;
typedef unsigned v4u __attribute__((ext_vector_type(4)));
typedef unsigned v2u __attribute__((ext_vector_type(2)));
typedef float f32x4 __attribute__((ext_vector_type(4)));
typedef float f32x2 __attribute__((ext_vector_type(2)));
typedef short bf16x8 __attribute__((ext_vector_type(8)));
typedef GAS unsigned gu32;

namespace pg8 {
constexpr int BM = 256, BK = 64, HALF = 128, HTB = HALF * BK * 2  , STAGE_BYTES = 8 * HTB, NXCD = 8, WGM = 8;
__host__ __device__ __forceinline__ int lds_byte(int r, int c) { const int st = (r >> 4) * 2 + (c >> 5), rr = r & 15, cc = c & 31, ob = rr * 64 + cc * 2; return st * 1024 + (ob ^ (((ob >> 9) & 1) << 5)); }
__host__ __device__ __forceinline__ void stage_rc(int b, int& R, int& C) { const int st = b / 1024, sb = b % 1024, swz = sb ^ (((sb >> 9) & 1) << 5); R = (st >> 1) * 16 + swz / 64; C = (st & 1) * 32 + (swz % 64) / 2; }
__host__ __device__ __forceinline__ int perm32(int rho) { const int n = rho >> 4, i = rho & 15; return 8 * (i >> 2) + 4 * n + (i & 3); }

struct Unit { int pm, pn; const char* A; const char* B; const int* rows; int nvalid; int aux; };

__device__ __forceinline__ unsigned cvt_pk_bf16(float lo, float hi) { unsigned r; asm volatile("v_cvt_pk_bf16_f32 %0, %1, %2" : "=v"(r) : "v"(lo), "v"(hi)); return r; }

template <class Epi, class Sched, bool GATHER>
__device__ __forceinline__ void gemm_phase(LAS unsigned char* lds, const int K, const int lda, const int ldb, const Sched& S, const Epi& E) {
    int tid_ = threadIdx.x; asm volatile("" : "+v"(tid_));
    const int tid = tid_, wid = __builtin_amdgcn_readfirstlane(tid >> 6), lane = tid & 63, wr = wid >> 2, wc = wid & 3, fr = lane & 15, fq = lane >> 4;
    const int nt = K / BK;
    unsigned voffA[2], voffB[2]; int RA[2], CA[2];
#pragma unroll
    for (int i = 0; i < 2; ++i) { int R, C; stage_rc(tid * 16 + i * 8192, R, C); const int Rb = Epi::PERM ? ((R & ~31) + perm32(R & 31)) : R;
        RA[i] = R; CA[i] = C; voffA[i] = (unsigned)(R * lda + C) * 2u; voffB[i] = (unsigned)(Rb * ldb + C) * 2u; }
    unsigned gA[2][2], gN[2][2];
    const size_t kstep = (size_t)(BK * 2);
    const size_t hstepA = GATHER ? 0 : (size_t)HALF * lda * 2, hstepB = (size_t)HALF * ldb * 2;
    const unsigned ldsw = (unsigned)wid * 1024u;
    const int aoff = lds_byte(wr * 64 + fr, fq * 8), boff = lds_byte(wc * 32 + fr, fq * 8);
#define PG8_SA(b, h) (((b) * 2 + (h)) * HTB)
#define PG8_SB(b, h) ((4 + (b) * 2 + (h)) * HTB)
#define PG8_STAGE_B(bufoff, gbase) do { _Pragma("unroll") for (int _i = 0; _i < 2; ++_i) \
        __builtin_amdgcn_global_load_lds((const unsigned*)((const char*)(gbase) + voffB[_i]), (LAS unsigned*)(lds + (bufoff) + ldsw + _i * 8192), 16, 0, 0); } while (0)
#define PG8_STAGE_A(bufoff, gbase, h) do { _Pragma("unroll") for (int _i = 0; _i < 2; ++_i) \
        __builtin_amdgcn_global_load_lds((const unsigned*)((const char*)(gbase) + (GATHER ? gA[h][_i] : voffA[_i]) + (h) * hstepA), (LAS unsigned*)(lds + (bufoff) + ldsw + _i * 8192), 16, 0, 0); } while (0)
#define PG8_LDA(dst, b, h) do { _Pragma("unroll") for (int m = 0; m < 4; ++m) _Pragma("unroll") for (int k = 0; k < 2; ++k) dst[m][k] = *(const LAS bf16x8*)(lds + PG8_SA(b, h) + aoff + m * 2048 + k * 1024); } while (0)
#define PG8_LDB(dst, b, h) do { _Pragma("unroll") for (int n = 0; n < 2; ++n) _Pragma("unroll") for (int k = 0; k < 2; ++k) dst[n][k] = *(const LAS bf16x8*)(lds + PG8_SB(b, h) + boff + n * 2048 + k * 1024); } while (0)
#define PG8_MMA(ai, bj, At, Bt) do { __builtin_amdgcn_s_setprio(1); _Pragma("unroll") for (int m = 0; m < 4; ++m) _Pragma("unroll") for (int n = 0; n < 2; ++n) _Pragma("unroll") for (int k = 0; k < 2; ++k) \
        acc[ai][bj][m][n] = __builtin_amdgcn_mfma_f32_16x16x32_bf16(Bt[n][k], At[m][k], acc[ai][bj][m][n], 0, 0, 0); __builtin_amdgcn_s_setprio(0); } while (0)
#define PG8_WAIT_V(n) asm volatile("s_waitcnt vmcnt(" #n ")" ::: "memory")
#define PG8_WAIT_L(n) asm volatile("s_waitcnt lgkmcnt(" #n ")" ::: "memory")
#define PG8_BAR __builtin_amdgcn_s_barrier()
#define PG8_SCHED __builtin_amdgcn_sched_barrier(0)
#define PG8_GLOAD(dst, u) do { _Pragma("unroll") for (int _h = 0; _h < 2; ++_h) _Pragma("unroll") for (int _i = 0; _i < 2; ++_i) { const int _r = _h * HALF + RA[_i]; \
        const int _t = (_r < (u).nvalid) ? (u).rows[_r] : 0; dst[_h][_i] = (unsigned)(_t * lda + CA[_i]) * 2u; } } while (0)
    Unit cur, nxt; int ui = 0;
    if (!S.next(0, cur)) return;
    f32x4 acc[2][2][4][2];
#pragma unroll
    for (int a = 0; a < 2; ++a)
#pragma unroll
        for (int b = 0; b < 2; ++b)
#pragma unroll
            for (int m = 0; m < 4; ++m)
#pragma unroll
                for (int n = 0; n < 2; ++n) acc[a][b][m][n] = (f32x4){0.f, 0.f, 0.f, 0.f};
    bf16x8 At[4][2], B0[2][2], B1[2][2];
    const char* cA = cur.A; const char* cB = cur.B;
    if constexpr (GATHER) { PG8_GLOAD(gA, cur); PG8_WAIT_V(0); }
    PG8_STAGE_B(PG8_SB(0, 0), cB); PG8_STAGE_B(PG8_SB(0, 1), cB + hstepB); PG8_STAGE_A(PG8_SA(0, 0), cA, 0); PG8_STAGE_A(PG8_SA(0, 1), cA, 1);
    if (wr == 1) PG8_BAR;
    PG8_WAIT_V(2); PG8_BAR;
    PG8_STAGE_B(PG8_SB(1, 0), cB + kstep); PG8_STAGE_A(PG8_SA(1, 0), cA + kstep, 0); PG8_STAGE_B(PG8_SB(1, 1), cB + hstepB + kstep);
    PG8_WAIT_V(6); PG8_BAR;
    for (;;) {
        const bool has_next = S.next(ui + 1, nxt);
        const char* nA = has_next ? nxt.A : cA; const char* nB = has_next ? nxt.B : cB;
        if constexpr (GATHER) { if (has_next) { PG8_GLOAD(gN, nxt); } else {
#pragma unroll
            for (int h = 0; h < 2; ++h)
#pragma unroll
                for (int i = 0; i < 2; ++i) gN[h][i] = gA[h][i]; } }
#pragma unroll 1
        for (int t = 0; t < nt; t += 2) {
            const bool last = (t == nt - 2);
            const char* a1 = cA + (size_t)(t + 1) * kstep;
            const char* a2 = last ? nA : cA + (size_t)(t + 2) * kstep; const char* b2 = last ? nB : cB + (size_t)(t + 2) * kstep;
            const char* a3 = a2 + kstep; const char* b3 = b2 + kstep;
            PG8_LDB(B0, 0, 0); PG8_LDB(B1, 0, 1); PG8_SCHED; PG8_LDA(At, 0, 0); PG8_STAGE_A(PG8_SA(1, 1), a1, 1);
            if constexpr (GATHER) { if (last) {
#pragma unroll
                for (int h = 0; h < 2; ++h)
#pragma unroll
                    for (int i = 0; i < 2; ++i) gA[h][i] = gN[h][i]; } }
            PG8_WAIT_V(8); PG8_WAIT_L(0); PG8_BAR; PG8_MMA(0, 0, At, B0); PG8_MMA(0, 1, At, B1); PG8_BAR; PG8_SCHED;
            PG8_LDA(At, 0, 1); PG8_STAGE_B(PG8_SB(0, 0), b2); PG8_STAGE_B(PG8_SB(0, 1), b2 + hstepB); PG8_STAGE_A(PG8_SA(0, 0), a2, 0);
            PG8_WAIT_V(8); PG8_WAIT_L(0); PG8_BAR; PG8_MMA(1, 0, At, B0); PG8_MMA(1, 1, At, B1); PG8_BAR; PG8_SCHED;
            PG8_LDB(B0, 1, 0); PG8_LDB(B1, 1, 1); PG8_SCHED; PG8_LDA(At, 1, 0); PG8_STAGE_A(PG8_SA(0, 1), a2, 1);
            PG8_WAIT_V(8); PG8_WAIT_L(0); PG8_BAR; PG8_MMA(0, 0, At, B0); PG8_MMA(0, 1, At, B1); PG8_BAR; PG8_SCHED;
            PG8_LDA(At, 1, 1); PG8_STAGE_B(PG8_SB(1, 0), b3); PG8_STAGE_B(PG8_SB(1, 1), b3 + hstepB); PG8_STAGE_A(PG8_SA(1, 0), a3, 0);
            PG8_WAIT_V(8); PG8_WAIT_L(0); PG8_BAR; PG8_MMA(1, 0, At, B0); PG8_MMA(1, 1, At, B1); PG8_BAR; PG8_SCHED;
        }
        if (wr == 0) PG8_BAR;
        E(acc, cur, wr, wc, fr, fq);
        if (!has_next) break;
#pragma unroll
        for (int a = 0; a < 2; ++a)
#pragma unroll
            for (int b = 0; b < 2; ++b)
#pragma unroll
                for (int m = 0; m < 4; ++m)
#pragma unroll
                    for (int n = 0; n < 2; ++n) acc[a][b][m][n] = (f32x4){0.f, 0.f, 0.f, 0.f};
        cur = nxt; cA = nA; cB = nB; ++ui;
        if (wr == 1) PG8_BAR;
    }
    PG8_WAIT_V(0);
    PG8_BAR;
#undef PG8_SA
#undef PG8_SB
#undef PG8_STAGE_A
#undef PG8_STAGE_B
#undef PG8_LDA
#undef PG8_LDB
#undef PG8_MMA
#undef PG8_WAIT_V
#undef PG8_WAIT_L
#undef PG8_BAR
#undef PG8_SCHED
#undef PG8_GLOAD
}
}

constexpr int NB = 4, SEQ = 4096, D = 2048, DEPTH = 2;
constexpr int T = NB * SEQ;
constexpr int NH = 8, HD = 128, DNW = 1024, CH = 64, NCH = SEQ / CH;
constexpr int PW = 1024, PG_DIM = 256;
constexpr int IN_COLS = 5136, NPROJ = 5120;
constexpr int NE = 16, DE = 1024, PLE = 256;
constexpr float ALPHA = 1.4142135623730951f;
constexpr float LN_EPS = 1e-5f, RMS_EPS = 1e-6f;
constexpr int LCAP = T;
constexpr int MAXTILES = 2 * T / 256 + NE;

constexpr size_t MiB = 1u << 20;
constexpr size_t WS_CTL = 0, CTL_ZERO_BYTES = 64 * 1024;
constexpr size_t WS_LIST = 2 * MiB;
constexpr size_t WS_TOKSLOT = 3 * MiB, WS_GATEW = WS_TOKSLOT + 128 * 1024, WS_STATS = WS_GATEW + 128 * 1024, WS_CD = WS_STATS + 128 * 1024, WS_WBA = WS_CD + 128 * 1024;
constexpr size_t WS_WIN = 4 * MiB, WS_WOUT = 44 * MiB, WS_WPG = 60 * MiB, WS_WPP = 76 * MiB, WS_WPOOL = 78 * MiB, WS_WGU = 80 * MiB, WS_WD = 336 * MiB, WS_PB16 = 464 * MiB;
constexpr size_t WS_XB = 480 * MiB, WS_R1 = 544 * MiB, WS_R2 = 704 * MiB, WS_R4 = 848 * MiB, WS_R5 = 944 * MiB, WS_END = 1008 * MiB;
constexpr size_t WS_PROJ = WS_R1, WS_HID = WS_R1;
constexpr size_t WS_Y = WS_R2;
constexpr size_t WS_POOLD = WS_R4, WS_PP = WS_R4 + 32 * MiB, WS_X1B = WS_R2;
constexpr size_t WS_MIXIN = WS_R5, WS_X2B = WS_R5;
static_assert((size_t)MAXTILES * 256 * 2048 * 2 <= 144 * MiB && (size_t)MAXTILES * 256 * 1024 * 2 <= 160 * MiB, "MoE row buffers");
constexpr int CW_TMO = 0, CW_CODE = 1, CW_CNT = 64  , CW_BAR = 4096;

constexpr int RING_OFF = 0, RING_BYTES = 131072;
constexpr int LDSCTL_OFF = 152 * 1024, MISC_OFF = LDSCTL_OFF + 320;
constexpr int AUX_OFF = LDSCTL_OFF + 1024;
constexpr int LDS_BYTES = 163840;
constexpr int NWAVES = 8;

#define RLX_AGENT __ATOMIC_RELAXED, __HIP_MEMORY_SCOPE_AGENT
#define LDS_WAIT() asm volatile("s_waitcnt lgkmcnt(0)" ::: "memory")
#define VM_WAIT() asm volatile("s_waitcnt vmcnt(0)" ::: "memory")
__device__ __forceinline__ unsigned f2bf(float f) { unsigned u = __builtin_bit_cast(unsigned, f); return (u + 0x7fffu + ((u >> 16) & 1u)) >> 16; }
__device__ __forceinline__ unsigned pk2(float lo, float hi) { return f2bf(lo) | (f2bf(hi) << 16); }
__device__ __forceinline__ float bf2f(unsigned short b) { return __builtin_bit_cast(float, ((unsigned)b) << 16); }
__device__ __forceinline__ float bflo(unsigned w) { return __builtin_bit_cast(float, w << 16); }
__device__ __forceinline__ float bfhi(unsigned w) { return __builtin_bit_cast(float, w & 0xffff0000u); }
__device__ __forceinline__ float sigmoidf_(float x) { return __builtin_amdgcn_rcpf(1.0f + __expf(-x)); }
__device__ __forceinline__ float wave_sum(float v) {
#pragma unroll
    for (int o = 1; o < 64; o <<= 1) v += __shfl_xor(v, o);
    return v;
}
#define XB_TMO      128
#define XB_XCNT(j)  (256  + 64 * (j))
#define XB_XSUB(j)  (1280 + 64 * (j))
#define XB_XGEN(j)  (2304 + 64 * (j))
#define XB_TOP      3328
#define XB_TOPGEN   3392
#define XCD_BAR_WORDS 3456
#define XB_SPIN_CAP (1u << 18)

__device__ __forceinline__ unsigned xb_ld(unsigned* p)              { return __hip_atomic_load(p, __ATOMIC_RELAXED, __HIP_MEMORY_SCOPE_AGENT); }
__device__ __forceinline__ unsigned xb_add(unsigned* p, unsigned v) { return __hip_atomic_fetch_add(p, v, __ATOMIC_RELAXED, __HIP_MEMORY_SCOPE_AGENT); }
__device__ __forceinline__ unsigned xb_xcc_id() { return (unsigned)__builtin_amdgcn_s_getreg((3 << 11) | 20) & 0xFu; }
#define XB_SPIN(cond, bar) do { unsigned _sp = 0; while (cond) { __builtin_amdgcn_s_sleep(1); \
    if ((++_sp & 255u) == 0u) { if (xb_ld(&(bar)[XB_TMO])) break; if (_sp > XB_SPIN_CAP) { atomicAdd(&(bar)[XB_TMO], 1u); break; } } } } while (0)

struct XcdBarrier {
    unsigned* bar; unsigned x;
    volatile LAS unsigned* st;
};

__device__ __forceinline__ XcdBarrier xcd_barrier_post(unsigned* bar, volatile LAS unsigned* st) {
    XcdBarrier b; b.bar = bar; b.x = xb_xcc_id(); b.st = st;
    if (threadIdx.x == 0) (void)xb_add(&bar[XB_XCNT(b.x)], 1u);
    return b;
}
__device__ __forceinline__ void xcd_barrier_complete(unsigned* bar, unsigned x, unsigned& nloc, unsigned& nx) {
    const unsigned G = gridDim.x * gridDim.y * gridDim.z;
    unsigned sum, cnt, mine, sp = 0u;
    for (;;) {
        sum = 0u; cnt = 0u; mine = 0u;
#pragma unroll
        for (unsigned j = 0; j < 16; ++j) { const unsigned c = xb_ld(&bar[XB_XCNT(j)]); sum += c; cnt += (c > 0u) ? 1u : 0u; mine = (j == x) ? c : mine; }
        if (sum == G) break;
        __builtin_amdgcn_s_sleep(1);
        if ((++sp & 255u) == 0u) { if (xb_ld(&bar[XB_TMO])) break; if (sp > XB_SPIN_CAP) { atomicAdd(&bar[XB_TMO], 1u); break; } }
    }
    nloc = mine > 0u ? mine : 1u; nx = cnt > 0u ? cnt : 1u;
}

__device__ __forceinline__ void xcd_barrier(const XcdBarrier& b) {
    asm volatile("s_waitcnt vmcnt(0)" ::: "memory");
    __syncthreads();
    if (threadIdx.x == 0) {
        unsigned* bar = b.bar;
        __builtin_amdgcn_s_waitcnt(0);
        unsigned nloc = b.st[0], nx = b.st[1];
        if (nloc == 0u) { xcd_barrier_complete(bar, b.x, nloc, nx); b.st[0] = nloc; b.st[1] = nx; }
        const unsigned old = xb_add(&bar[XB_XSUB(b.x)], 1u);
        const unsigned gen = old / nloc;
        if (old + 1u == (gen + 1u) * nloc) {
            __builtin_amdgcn_fence(__ATOMIC_RELEASE, "agent");
            asm volatile("s_waitcnt vmcnt(0)" ::: "memory");
            const unsigned og = xb_add(&bar[XB_TOP], 1u);
            const unsigned tg = og / nx;
            if (og + 1u == (tg + 1u) * nx) xb_add(&bar[XB_TOPGEN], 1u);
            else XB_SPIN(xb_ld(&bar[XB_TOPGEN]) == tg, bar);
            __builtin_amdgcn_fence(__ATOMIC_ACQUIRE, "agent");
            xb_add(&bar[XB_XGEN(b.x)], 1u);
            asm volatile("s_waitcnt vmcnt(0)" ::: "memory");
        } else {
            XB_SPIN(xb_ld(&bar[XB_XGEN(b.x)]) == gen, bar);
            __builtin_amdgcn_fence(__ATOMIC_ACQUIRE, "agent");
            asm volatile("s_waitcnt vmcnt(0)" ::: "memory");
        }
    }
    __syncthreads();
}

struct Args { const float* in[21]; float* out; unsigned char* ws; int ph_lo, ph_hi, li, pad; };
enum { I_X = 0, I_P, I_WIN, I_CONVW, I_ALOG, I_DTB, I_NORMW, I_POOLW, I_POOLS, I_WOUT, I_LN1G, I_LN1B, I_WR, I_BR, I_WEG, I_WEU, I_WED, I_LN2G, I_LN2B, I_WPP, I_WPG };
struct Frame {
    LAS unsigned char* lds;
    volatile LAS unsigned* MISC;
    gu32* ctl;
    int tid, lane, wave, vcu, G;
};

#define PHASE_FRAME(F0) Frame F = F0; { int t_ = threadIdx.x; asm volatile("" : "+v"(t_)); F.tid = t_; F.lane = t_ & 63; }
#define OPQ_S(p) asm volatile("" : "+s"(p))
#define OPQ_G(T, expr) ({ GAS T* g_ = (GAS T*)(expr); asm volatile("" : "+s"(g_)); (T*)g_; })
struct SchedDense {
    int nM, nN, nwg, G, c; const char* A; const char* B; size_t astep, bstep;
    __device__ __forceinline__ void init(int M, int N, int G_, int c_, const void* A_, int lda, const void* B_, int ldb) { nM = M / 256; nN = N / 256; nwg = nM * nN; G = G_; c = c_;
        A = (const char*)A_; B = (const char*)B_; astep = (size_t)256 * lda * 2; bstep = (size_t)256 * ldb * 2; }
    __device__ __forceinline__ bool next(int i, pg8::Unit& u) const {
        const long L = (long)i * G + c; if (L >= nwg) return false;
        int wgid = (int)L; { const int q = nwg / 8, r = nwg % 8, xcd = wgid % 8, off = wgid / 8; wgid = (xcd < r ? xcd * (q + 1) : r * (q + 1) + (xcd - r) * q) + off; }
        const int nig = 8 * nN, gid = wgid / nig, fm = gid * 8, gsz = (nM - fm) < 8 ? (nM - fm) : 8;
        u.pm = fm + ((wgid % nig) % gsz); u.pn = (wgid % nig) / gsz;
        u.A = A + (size_t)u.pm * astep; u.B = B + (size_t)u.pn * bstep; u.rows = nullptr; u.nvalid = 256; u.aux = 0; return true;
    }
};
struct SchedPool {
    int G, c; const char* A; const char* B;
    __device__ __forceinline__ bool next(int i, pg8::Unit& u) const {
        const int L = i * G + c; if (L >= 256) return false;
        u.pm = L >> 2; u.pn = L & 3; u.A = A + ((size_t)u.pm * 256 * PW + u.pn * 256) * 2; u.B = B + (size_t)u.pn * 65536 * 2; u.rows = nullptr; u.nvalid = 256; u.aux = 0; return true;
    }
};
struct SchedMoe {
    int G, c, mode; const LAS int* tab; const char* A; const char* B; const int* list;
    __device__ __forceinline__ bool next(int i, pg8::Unit& u) const {
        const int L = i * G + c, rt = L >> 3, pn = L & 7;
        const int ntiles = __builtin_amdgcn_readfirstlane(tab[16]); if (rt >= ntiles) return false;
        int e = 0;
#pragma unroll
        for (int k = 1; k < 16; ++k) { const int ts = __builtin_amdgcn_readfirstlane(tab[k]); if (rt >= ts) e = k; }
        const int ts = __builtin_amdgcn_readfirstlane(tab[e]), cn = __builtin_amdgcn_readfirstlane(tab[32 + e]);
        const int r0 = (rt - ts) * 256;
        u.pm = rt; u.pn = pn; u.aux = e;
        if (mode == 0) { u.A = A; u.rows = list + (size_t)e * LCAP + r0; u.nvalid = (cn - r0) < 256 ? (cn - r0) : 256; u.B = B + ((size_t)e * 2048 + pn * 256) * 2048 * 2; }
        else { u.A = A + (size_t)rt * 256 * DE * 2; u.rows = nullptr; u.nvalid = 256; u.B = B + ((size_t)e * 2048 + pn * 256) * DE * 2; }
        return true;
    }
};

using pg8::cvt_pk_bf16;
struct EpiBf16 {
    static constexpr bool PERM = true; bf16* O; int ldc;
    __device__ __forceinline__ void operator()(const f32x4 (&acc)[2][2][4][2], const pg8::Unit& u, int wr, int wc, int fr, int fq) const {
        const int row0 = u.pm * 256 + wr * 64 + fr, col0 = u.pn * 256 + wc * 32 + 8 * fq;
#pragma unroll
        for (int ai = 0; ai < 2; ++ai)
#pragma unroll
            for (int m = 0; m < 4; ++m) { bf16* rowp = O + (size_t)(row0 + ai * 128 + m * 16) * ldc + col0;
#pragma unroll
                for (int bj = 0; bj < 2; ++bj) { const f32x4 v0 = acc[ai][bj][m][0], v1 = acc[ai][bj][m][1];
                    v4u w; w.x = cvt_pk_bf16(v0[0], v0[1]); w.y = cvt_pk_bf16(v0[2], v0[3]); w.z = cvt_pk_bf16(v1[0], v1[1]); w.w = cvt_pk_bf16(v1[2], v1[3]);
                    *(v4u*)(rowp + bj * 128) = w; } }
    }
};
struct EpiPool {
    static constexpr bool PERM = true; bf16* O; const float* scale;
    __device__ __forceinline__ void operator()(const f32x4 (&acc)[2][2][4][2], const pg8::Unit& u, int wr, int wc, int fr, int fq) const {
        const int row0 = u.pm * 256 + wr * 64 + fr, cg = u.pn * 256 + wc * 32 + 8 * fq;
        f32x4 sv[2][2];
#pragma unroll
        for (int bj = 0; bj < 2; ++bj) { sv[bj][0] = *(const f32x4*)(scale + cg + bj * 128); sv[bj][1] = *(const f32x4*)(scale + cg + bj * 128 + 4); }
#pragma unroll
        for (int ai = 0; ai < 2; ++ai)
#pragma unroll
            for (int m = 0; m < 4; ++m) { bf16* rowp = O + (size_t)(row0 + ai * 128 + m * 16) * D + DNW + cg;
#pragma unroll
                for (int bj = 0; bj < 2; ++bj) { const f32x4 v0 = acc[ai][bj][m][0] * sv[bj][0], v1 = acc[ai][bj][m][1] * sv[bj][1];
                    v4u w; w.x = cvt_pk_bf16(v0[0], v0[1]); w.y = cvt_pk_bf16(v0[2], v0[3]); w.z = cvt_pk_bf16(v1[0], v1[1]); w.w = cvt_pk_bf16(v1[2], v1[3]);
                    *(v4u*)(rowp + bj * 128) = w; } }
    }
};
struct EpiRes {
    static constexpr bool PERM = false; const float* X; float* OUT;
    __device__ __forceinline__ void operator()(const f32x4 (&acc)[2][2][4][2], const pg8::Unit& u, int wr, int wc, int fr, int fq) const {
        const int row0 = u.pm * 256 + wr * 64 + fr, col0 = u.pn * 256 + wc * 32 + 4 * fq;
#pragma unroll
        for (int ai = 0; ai < 2; ++ai)
#pragma unroll
            for (int m = 0; m < 4; ++m) { const size_t off = (size_t)(row0 + ai * 128 + m * 16) * D + col0;
#pragma unroll
                for (int bj = 0; bj < 2; ++bj)
#pragma unroll
                    for (int n = 0; n < 2; ++n) { const f32x4 x = *(const f32x4*)(X + off + bj * 128 + n * 16); *(f32x4*)(OUT + off + bj * 128 + n * 16) = x * ALPHA + acc[ai][bj][m][n]; } }
    }
};
struct EpiSwiglu {
    static constexpr bool PERM = true; bf16* O;
    __device__ __forceinline__ void operator()(const f32x4 (&acc)[2][2][4][2], const pg8::Unit& u, int wr, int wc, int fr, int fq) const {
        const int row0 = u.pm * 256 + wr * 64 + fr, col0 = u.pn * 128 + wc * 32 + 8 * fq;
#pragma unroll
        for (int ai = 0; ai < 2; ++ai)
#pragma unroll
            for (int m = 0; m < 4; ++m) { bf16* rowp = O + (size_t)(row0 + ai * 128 + m * 16) * DE + col0;
                float h[8];
#pragma unroll
                for (int n = 0; n < 2; ++n)
#pragma unroll
                    for (int j = 0; j < 4; ++j) { const float g = acc[ai][0][m][n][j], up = acc[ai][1][m][n][j]; h[4 * n + j] = g * sigmoidf_(g) * up; }
                v4u w; w.x = cvt_pk_bf16(h[0], h[1]); w.y = cvt_pk_bf16(h[2], h[3]); w.z = cvt_pk_bf16(h[4], h[5]); w.w = cvt_pk_bf16(h[6], h[7]);
                *(v4u*)rowp = w; }
    }
};
struct EpiPle {
    static constexpr bool PERM = true; float* OUT; const bf16* PP; bf16* XB; int write_xb;
    __device__ __forceinline__ void operator()(const f32x4 (&acc)[2][2][4][2], const pg8::Unit& u, int wr, int wc, int fr, int fq) const {
        const int row0 = u.pm * 256 + wr * 64 + fr, col0 = u.pn * 256 + wc * 32 + 8 * fq;
#pragma unroll
        for (int ai = 0; ai < 2; ++ai)
#pragma unroll
            for (int m = 0; m < 4; ++m) { const size_t off0 = (size_t)(row0 + ai * 128 + m * 16) * D + col0;
#pragma unroll
                for (int bj = 0; bj < 2; ++bj) { const size_t off = off0 + bj * 128;
                    const f32x4 xa = *(const f32x4*)(OUT + off), xb = *(const f32x4*)(OUT + off + 4); const v4u pp = *(const v4u*)(PP + off);
                    const f32x4 a0 = acc[ai][bj][m][0], a1 = acc[ai][bj][m][1];
                    f32x4 o0, o1;
                    o0[0] = xa[0] + sigmoidf_(a0[0]) * bflo(pp.x); o0[1] = xa[1] + sigmoidf_(a0[1]) * bfhi(pp.x); o0[2] = xa[2] + sigmoidf_(a0[2]) * bflo(pp.y); o0[3] = xa[3] + sigmoidf_(a0[3]) * bfhi(pp.y);
                    o1[0] = xb[0] + sigmoidf_(a1[0]) * bflo(pp.z); o1[1] = xb[1] + sigmoidf_(a1[1]) * bfhi(pp.z); o1[2] = xb[2] + sigmoidf_(a1[2]) * bflo(pp.w); o1[3] = xb[3] + sigmoidf_(a1[3]) * bfhi(pp.w);
                    *(f32x4*)(OUT + off) = o0; *(f32x4*)(OUT + off + 4) = o1;
                    if (write_xb) { v4u w; w.x = cvt_pk_bf16(o0[0], o0[1]); w.y = cvt_pk_bf16(o0[2], o0[3]); w.z = cvt_pk_bf16(o1[0], o1[1]); w.w = cvt_pk_bf16(o1[2], o1[3]); *(v4u*)(XB + off) = w; } } }
    }
};

__device__ __forceinline__ void tr_item(const float* W, int ldw, int k0, int n0, bf16* WT, size_t drow0, int ldt, LAS float* scr, int lane) {
#pragma unroll 8
    for (int i = 0; i < 32; ++i) { const int kk = 2 * i + (lane >> 5); scr[kk * 33 + (lane & 31)] = W[(size_t)(k0 + kk) * ldw + n0 + (lane & 31)]; }
    LDS_WAIT(); asm volatile("" ::: "memory");
    const int c = lane & 7;
#pragma unroll
    for (int j = 0; j < 4; ++j) { const int n = (lane >> 3) + 8 * j; const LAS float* s = scr + (8 * c) * 33 + n;
        v4u o; o.x = pk2(s[0 * 33], s[1 * 33]); o.y = pk2(s[2 * 33], s[3 * 33]); o.z = pk2(s[4 * 33], s[5 * 33]); o.w = pk2(s[6 * 33], s[7 * 33]);
        *(GAS v4u*)(WT + (drow0 + n) * ldt + k0 + 8 * c) = o; }
    LDS_WAIT(); asm volatile("" ::: "memory");
}
__device__ __forceinline__ void p0_prologue(const Frame& F0, const Args& a) {
    PHASE_FRAME(F0);
    LAS float* scr = (LAS float*)(F.lds + RING_OFF + F.wave * 16384);
    const int gw = F.vcu * NWAVES + F.wave, NGW = F.G * NWAVES;
    unsigned char* ws = OPQ_G(unsigned char, a.ws);
    constexpr int I_INA = 32 * 128, I_INB = 32 * 32, I_OUT = 32 * 64, I_PG = 32 * 64, I_PP = 4 * 64, I_POOL = 4 * 32, I_EG = NE * 32 * 32, I_EU = I_EG, I_ED = NE * 16 * 64;
    constexpr int I_LAYER = I_INA + I_INB + I_OUT + I_PG + I_PP + I_POOL + I_EG + I_EU + I_ED;
    for (int it = gw; it < DEPTH * I_LAYER; it += NGW) {
        const int l = it / I_LAYER; int r = it - l * I_LAYER;
        if (r < I_INA) { const int kb = r / 128, nb = r % 128; tr_item(a.in[I_WIN] + (size_t)l * D * IN_COLS, IN_COLS, 64 * kb, 32 * nb, (bf16*)(ws + WS_WIN) + (size_t)l * NPROJ * D, 32 * nb, D, scr, F.lane); continue; } r -= I_INA;
        if (r < I_INB) { const int kb = r / 32, nb = r % 32; tr_item(a.in[I_WIN] + (size_t)l * D * IN_COLS, IN_COLS, 64 * kb, 4112 + 32 * nb, (bf16*)(ws + WS_WIN) + (size_t)l * NPROJ * D, 4096 + 32 * nb, D, scr, F.lane); continue; } r -= I_INB;
        if (r < I_OUT) { const int kb = r / 64, nb = r % 64; tr_item(a.in[I_WOUT] + (size_t)l * D * D, D, 64 * kb, 32 * nb, (bf16*)(ws + WS_WOUT) + (size_t)l * D * D, 32 * nb, D, scr, F.lane); continue; } r -= I_OUT;
        if (r < I_PG) { const int kb = r / 64, nb = r % 64; tr_item(a.in[I_WPG] + (size_t)l * D * D, D, 64 * kb, 32 * nb, (bf16*)(ws + WS_WPG) + (size_t)l * D * D, 32 * nb, D, scr, F.lane); continue; } r -= I_PG;
        if (r < I_PP) { const int kb = r / 64, nb = r % 64; tr_item(a.in[I_WPP] + (size_t)l * PLE * D, D, 64 * kb, 32 * nb, (bf16*)(ws + WS_WPP) + (size_t)l * D * PLE, 32 * nb, PLE, scr, F.lane); continue; } r -= I_PP;
        if (r < I_POOL) { const int g = r / 32, rr = r % 32, kb = rr / 8, nb = rr % 8; tr_item(a.in[I_POOLW] + ((size_t)l * 4 + g) * 65536, 256, 64 * kb, 32 * nb, (bf16*)(ws + WS_WPOOL) + ((size_t)l * 4 + g) * 65536, 32 * nb, 256, scr, F.lane); continue; } r -= I_POOL;
        if (r < I_EG) { const int e = r / 1024, rr = r % 1024, kb = rr / 32, nb = rr % 32, h0 = 32 * nb;
            tr_item(a.in[I_WEG] + ((size_t)l * NE + e) * D * DE, DE, 64 * kb, h0, (bf16*)(ws + WS_WGU) + ((size_t)l * NE + e) * 2048 * D, (size_t)(h0 >> 7) * 256 + (h0 & 127), D, scr, F.lane); continue; } r -= I_EG;
        if (r < I_EU) { const int e = r / 1024, rr = r % 1024, kb = rr / 32, nb = rr % 32, h0 = 32 * nb;
            tr_item(a.in[I_WEU] + ((size_t)l * NE + e) * D * DE, DE, 64 * kb, h0, (bf16*)(ws + WS_WGU) + ((size_t)l * NE + e) * 2048 * D, (size_t)(h0 >> 7) * 256 + 128 + (h0 & 127), D, scr, F.lane); continue; } r -= I_EU;
        { const int e = r / 1024, rr = r % 1024, kb = rr / 64, nb = rr % 64;
            tr_item(a.in[I_WED] + ((size_t)l * NE + e) * DE * D, D, 64 * kb, 32 * nb, (bf16*)(ws + WS_WD) + ((size_t)l * NE + e) * D * DE, 32 * nb, DE, scr, F.lane); }
    }
    const size_t gt = (size_t)F.vcu * 512 + F.tid, NGT = (size_t)F.G * 512;
    { const GAS f32x4* src = (const GAS f32x4*)a.in[I_X]; GAS v4u* dst = (GAS v4u*)(ws + WS_XB);
        for (size_t i = gt; i < (size_t)T * D / 8; i += NGT) { const f32x4 v0 = src[2 * i], v1 = src[2 * i + 1]; v4u o; o.x = pk2(v0[0], v0[1]); o.y = pk2(v0[2], v0[3]); o.z = pk2(v1[0], v1[1]); o.w = pk2(v1[2], v1[3]); dst[i] = o; } }
    { const GAS f32x4* src = (const GAS f32x4*)a.in[I_P]; GAS v4u* dst = (GAS v4u*)(ws + WS_PB16);
        for (size_t i = gt; i < (size_t)DEPTH * T * PLE / 8; i += NGT) { const f32x4 v0 = src[2 * i], v1 = src[2 * i + 1]; v4u o; o.x = pk2(v0[0], v0[1]); o.y = pk2(v0[2], v0[3]); o.z = pk2(v1[0], v1[1]); o.w = pk2(v1[2], v1[3]); dst[i] = o; } }
    for (size_t i = gt; i < (size_t)DEPTH * 16 * D; i += NGT) { const int l = (int)(i / (16 * D)), j = (int)((i / D) % 16), k = (int)(i % D);
        ((bf16*)(ws + WS_WBA))[i] = (bf16)f2bf(a.in[I_WIN][((size_t)l * D + k) * IN_COLS + 4096 + j]); }
}

typedef float f32x16 __attribute__((ext_vector_type(16)));
typedef __bf16 bf2_t __attribute__((ext_vector_type(2)));
__device__ __forceinline__ unsigned pkbf(float lo, float hi) { const f32x2 v = {lo, hi}; return __builtin_bit_cast(unsigned, __builtin_convertvector(v, bf2_t)); }
#define MFMA32(a_, b_, c_) __builtin_amdgcn_mfma_f32_32x32x16_bf16((a_), (b_), (c_), 0, 0, 0)
#define PACK8(x, sp) __builtin_bit_cast(bf16x8, (v4u){pkbf((x)[8 * (sp)], (x)[8 * (sp) + 1]), pkbf((x)[8 * (sp) + 2], (x)[8 * (sp) + 3]), pkbf((x)[8 * (sp) + 4], (x)[8 * (sp) + 5]), pkbf((x)[8 * (sp) + 6], (x)[8 * (sp) + 7])})
#define RAW_BAR() do { asm volatile("s_waitcnt lgkmcnt(0)" ::: "memory"); __builtin_amdgcn_s_barrier(); asm volatile("" ::: "memory"); } while (0)
constexpr int IMG_ELEMS = 56 * 512, UIMG_ELEMS = 8 * 1024;
constexpr int FR_WN = 0, FR_QD = 16, FR_AQK = 32, FR_KDT = 40;
constexpr size_t WS_IMG = WS_R2, WS_UIMG = WS_R2 + 112 * MiB;
static_assert((size_t)NB * NCH * NH * IMG_ELEMS * 2 == 112 * MiB && (size_t)NB * NCH * NH * UIMG_ELEMS * 2 == 32 * MiB, "DeltaNet images");

constexpr int PQF = 0, PKF = 33792, PQS = 67584, PKS = 84992, PVT = 102400, PKT = 120832, PTAB = 139264;
constexpr int PAS = PQF;
constexpr int PTB = PKF, PT11T = PKF + 9216, PPART = PKF;
constexpr int F_LD = 132, S_LD = 136, T_LD = 72, A_LD = 68, TT_LD = 40;
__device__ __forceinline__ void phase_dn_prep(const Frame& F0, const Args& a, int layer) {
    PHASE_FRAME(F0);
    unsigned char* ws = OPQ_G(unsigned char, a.ws);
    LAS unsigned char* lds = F.lds;
    LAS float* Qf = (LAS float*)(lds + PQF); LAS float* Kf = (LAS float*)(lds + PKF); LAS float* As = (LAS float*)(lds + PAS);
    LAS bf16* Qs = (LAS bf16*)(lds + PQS); LAS bf16* Ks = (LAS bf16*)(lds + PKS); LAS bf16* Vt = (LAS bf16*)(lds + PVT); LAS bf16* Kt = (LAS bf16*)(lds + PKT);
    LAS bf16* Tb = (LAS bf16*)(lds + PTB); LAS bf16* T11t = (LAS bf16*)(lds + PT11T);
    LAS float* betaS = (LAS float*)(lds + PTAB); LAS float* gS = betaS + 512; LAS float* gamh = gS + 512; LAS float* betah = gamh + 64; LAS float* egam = betah + 64; LAS float* bgam = egam + 64; LAS float* ekd = bgam + 64; LAS float* rkS = ekd + 64;
    const bf16* XB = (const bf16*)(ws + WS_XB); const bf16* PROJ = (const bf16*)(ws + WS_PROJ); const bf16* WBA = (const bf16*)(ws + WS_WBA) + (size_t)layer * 16 * D;
    bf16* IMG = (bf16*)(ws + WS_IMG); bf16* UIMG = (bf16*)(ws + WS_UIMG); float* CD = (float*)(ws + WS_CD); bf16* POOLD = (bf16*)(ws + WS_POOLD);
    const float* convw = a.in[I_CONVW] + (size_t)layer * 4 * 3072; const float* alog = a.in[I_ALOG] + layer * NH; const float* dtb = a.in[I_DTB] + layer * NH;
    const int tid = F.tid, lane = F.lane, wave = F.wave, c32 = lane & 31, hf = lane >> 5;
    for (int unit = F.vcu; unit < NB * NCH; unit += F.G) {
        const int b = unit / NCH, n = unit % NCH, r0 = b * SEQ + n * CH, sq0 = n * CH;
        { const int col = 2 * tid, wsel = col >> 8; const bf16* up = PROJ + (size_t)r0 * NPROJ + 4096 + col; bf16* dp = POOLD + (size_t)r0 * PW + col;
#define POOL_BODY(WIN) do { unsigned xr[CH + WIN - 1]; \
            _Pragma("unroll") for (int j = 0; j < WIN - 1; ++j) xr[j] = (sq0 - (WIN - 1) + j >= 0) ? *(const unsigned*)(up + (ptrdiff_t)(j - (WIN - 1)) * NPROJ) : 0u; \
            _Pragma("unroll") for (int i = 0; i < CH; ++i) xr[WIN - 1 + i] = *(const unsigned*)(up + (size_t)i * NPROJ); \
            float s0 = 0.f, s1 = 0.f; \
            _Pragma("unroll") for (int j = 0; j < WIN - 1; ++j) { s0 += bflo(xr[j]); s1 += bfhi(xr[j]); } \
            _Pragma("unroll") for (int i = 0; i < CH; ++i) { const float x0 = bflo(xr[WIN - 1 + i]), x1 = bfhi(xr[WIN - 1 + i]); s0 += x0; s1 += x1; \
                const int pos = sq0 + i; const float inv = 1.0f / (float)((pos + 1) < WIN ? (pos + 1) : WIN); \
                *(unsigned*)(dp + (size_t)i * PW) = pkbf(s0 * inv - x0, s1 * inv - x1); s0 -= bflo(xr[i]); s1 -= bfhi(xr[i]); } } while (0)
            if (wsel == 0) POOL_BODY(2); else if (wsel == 1) POOL_BODY(4); else if (wsel == 2) POOL_BODY(8); else POOL_BODY(16);
#undef POOL_BODY
        }
        { typedef float f32x4v __attribute__((ext_vector_type(4)));
            const int fr = lane & 15, fg = lane >> 4; f32x4v pacc[4];
#pragma unroll
            for (int mt = 0; mt < 4; ++mt) pacc[mt] = (f32x4v){0.f, 0.f, 0.f, 0.f};
#pragma unroll 2
            for (int s = 0; s < 8; ++s) { const int k0 = 256 * wave + 32 * s + 8 * fg;
                const bf16x8 bfr = *(const bf16x8*)(WBA + (size_t)fr * D + k0);
#pragma unroll
                for (int mt = 0; mt < 4; ++mt) { const bf16x8 afr = *(const bf16x8*)(XB + (size_t)(r0 + 16 * mt + fr) * D + k0); pacc[mt] = __builtin_amdgcn_mfma_f32_16x16x32_bf16(afr, bfr, pacc[mt], 0, 0, 0); } }
            LAS float* part = (LAS float*)(lds + PPART) + wave * 1024;
#pragma unroll
            for (int mt = 0; mt < 4; ++mt)
#pragma unroll
                for (int r = 0; r < 4; ++r) part[(16 * mt + 4 * fg + r) * 16 + fr] = pacc[mt][r]; }
        __syncthreads();
        { const int tok = tid >> 3, cp = tid & 7; float s0 = 0.f, s1 = 0.f;
#pragma unroll
            for (int w = 0; w < 8; ++w) { const f32x2 p2 = *(const LAS f32x2*)((LAS float*)(lds + PPART) + w * 1024 + tok * 16 + 2 * cp); s0 += p2[0]; s1 += p2[1]; }
            if (cp < 4) { betaS[tok * 8 + 2 * cp] = sigmoidf_(s0); betaS[tok * 8 + 2 * cp + 1] = sigmoidf_(s1); }
            else { const int h = 2 * (cp - 4); const float z0 = s0 + dtb[h], z1 = s1 + dtb[h + 1];
                const float sp0 = z0 > 20.f ? z0 : log1pf(__expf(z0)), sp1 = z1 > 20.f ? z1 : log1pf(__expf(z1));
                gS[tok * 8 + h] = -__expf(alog[h]) * sp0; gS[tok * 8 + h + 1] = -__expf(alog[h + 1]) * sp1; } }
        __syncthreads();
        if (tid < 8) { float run = 0.f; for (int t = 0; t < CH; ++t) { run += gS[t * 8 + tid]; gS[t * 8 + tid] = run; } }
        __syncthreads();
        unsigned craw[3][11];
#define PREP_LOADRAW(hh) do { const int cp_ = tid & 63, i0_ = (tid >> 6) * 8; \
            _Pragma("unroll") for (int part_ = 0; part_ < 3; ++part_) { const bf16* src_ = PROJ + (size_t)(r0 + i0_ - 3) * NPROJ + part_ * 1024 + (hh) * HD + 2 * cp_; \
                _Pragma("unroll") for (int j_ = 0; j_ < 11; ++j_) craw[part_][j_] = (sq0 + i0_ - 3 + j_ >= 0) ? *(const unsigned*)(src_ + (ptrdiff_t)j_ * NPROJ) : 0u; } } while (0)
        PREP_LOADRAW(0);
        for (int h = 0; h < NH; ++h) {
            const size_t chd = (size_t)unit * NH + h; bf16* img = IMG + chd * IMG_ELEMS; bf16* uimg = UIMG + chd * UIMG_ELEMS;
            if (tid < 64) { const float gi = gS[tid * 8 + h], bi = betaS[tid * 8 + h], eg = __expf(gi); gamh[tid] = gi; betah[tid] = bi; egam[tid] = eg; bgam[tid] = bi * eg; ekd[tid] = __expf(gS[63 * 8 + h] - gi); }
            RAW_BAR();
            { const int cp = tid & 63, rg8 = tid >> 6, i0 = rg8 * 8;
#pragma unroll
                for (int part = 0; part < 3; ++part) { const int col = part * 1024 + h * HD + 2 * cp;
                    const f32x2 cw0 = *(const f32x2*)(convw + col), cw1 = *(const f32x2*)(convw + 3072 + col), cw2 = *(const f32x2*)(convw + 2 * 3072 + col), cw3 = *(const f32x2*)(convw + 3 * 3072 + col);
                    float ya[8], yb[8];
#pragma unroll
                    for (int i = 0; i < 8; ++i) { const unsigned x3 = craw[part][i], x2 = craw[part][i + 1], x1 = craw[part][i + 2], x0 = craw[part][i + 3];
                        const float ta = cw0[0] * bflo(x3) + cw1[0] * bflo(x2) + cw2[0] * bflo(x1) + cw3[0] * bflo(x0), tb = cw0[1] * bfhi(x3) + cw1[1] * bfhi(x2) + cw2[1] * bfhi(x1) + cw3[1] * bfhi(x0);
                        ya[i] = ta * sigmoidf_(ta); yb[i] = tb * sigmoidf_(tb); }
                    if (part == 0) {
#pragma unroll
                        for (int i = 0; i < 8; ++i) *(LAS f32x2*)(Qf + (i0 + i) * F_LD + 2 * cp) = (f32x2){ya[i], yb[i]}; }
                    else if (part == 1) {
#pragma unroll
                        for (int i = 0; i < 8; ++i) *(LAS f32x2*)(Kf + (i0 + i) * F_LD + 2 * cp) = (f32x2){ya[i], yb[i]}; }
                    else { v4u o0, o1;
                        o0.x = pkbf(ya[0] * betah[i0 + 0], ya[1] * betah[i0 + 1]); o0.y = pkbf(ya[2] * betah[i0 + 2], ya[3] * betah[i0 + 3]); o0.z = pkbf(ya[4] * betah[i0 + 4], ya[5] * betah[i0 + 5]); o0.w = pkbf(ya[6] * betah[i0 + 6], ya[7] * betah[i0 + 7]);
                        o1.x = pkbf(yb[0] * betah[i0 + 0], yb[1] * betah[i0 + 1]); o1.y = pkbf(yb[2] * betah[i0 + 2], yb[3] * betah[i0 + 3]); o1.z = pkbf(yb[4] * betah[i0 + 4], yb[5] * betah[i0 + 5]); o1.w = pkbf(yb[6] * betah[i0 + 6], yb[7] * betah[i0 + 7]);
                        *(LAS v4u*)(Vt + (2 * cp) * T_LD + i0) = o0; *(LAS v4u*)(Vt + (2 * cp + 1) * T_LD + i0) = o1; } }
                if (h + 1 < NH) PREP_LOADRAW(h + 1); }
            { const int i = tid >> 3, part = tid & 7; const LAS float* qp = Qf + i * F_LD + part * 16; const LAS float* kp = Kf + i * F_LD + part * 16;
                f32x4 qv[4], kv[4]; float sq = 0.f, sk = 0.f;
#pragma unroll
                for (int j = 0; j < 4; ++j) { qv[j] = *(const LAS f32x4*)(qp + 4 * j); kv[j] = *(const LAS f32x4*)(kp + 4 * j);
                    sq += (qv[j][0] * qv[j][0] + qv[j][1] * qv[j][1]) + (qv[j][2] * qv[j][2] + qv[j][3] * qv[j][3]); sk += (kv[j][0] * kv[j][0] + kv[j][1] * kv[j][1]) + (kv[j][2] * kv[j][2] + kv[j][3] * kv[j][3]); }
                sq += __shfl_xor(sq, 1); sq += __shfl_xor(sq, 2); sq += __shfl_xor(sq, 4); sk += __shfl_xor(sk, 1); sk += __shfl_xor(sk, 2); sk += __shfl_xor(sk, 4);
                const float rq = 1.0f / sqrtf(sq + RMS_EPS) * 0.08838834764831845f, rk = 1.0f / sqrtf(sk + RMS_EPS);
                if (part == 0) rkS[i] = rk;
#pragma unroll
                for (int j = 0; j < 4; ++j) { qv[j] = qv[j] * rq; kv[j] = kv[j] * rk; }
                v4u w0, w1;
                w0.x = pkbf(qv[0][0], qv[0][1]); w0.y = pkbf(qv[0][2], qv[0][3]); w0.z = pkbf(qv[1][0], qv[1][1]); w0.w = pkbf(qv[1][2], qv[1][3]); w1.x = pkbf(qv[2][0], qv[2][1]); w1.y = pkbf(qv[2][2], qv[2][3]); w1.z = pkbf(qv[3][0], qv[3][1]); w1.w = pkbf(qv[3][2], qv[3][3]);
                *(LAS v4u*)(Qs + i * S_LD + part * 16) = w0; *(LAS v4u*)(Qs + i * S_LD + part * 16 + 8) = w1;
                w0.x = pkbf(kv[0][0], kv[0][1]); w0.y = pkbf(kv[0][2], kv[0][3]); w0.z = pkbf(kv[1][0], kv[1][1]); w0.w = pkbf(kv[1][2], kv[1][3]); w1.x = pkbf(kv[2][0], kv[2][1]); w1.y = pkbf(kv[2][2], kv[2][3]); w1.z = pkbf(kv[3][0], kv[3][1]); w1.w = pkbf(kv[3][2], kv[3][3]);
                *(LAS v4u*)(Ks + i * S_LD + part * 16) = w0; *(LAS v4u*)(Ks + i * S_LD + part * 16 + 8) = w1;
                const float eg = egam[i]; bf16* fq = img + ((size_t)(FR_QD + (i >> 5) * 8 + part) * 64 + (i & 31)) * 8;
                v4u h0, h1;
                h0.x = pkbf(qv[0][0] * eg, qv[0][1] * eg); h0.y = pkbf(qv[0][2] * eg, qv[0][3] * eg); h0.z = pkbf(qv[2][0] * eg, qv[2][1] * eg); h0.w = pkbf(qv[2][2] * eg, qv[2][3] * eg);
                h1.x = pkbf(qv[1][0] * eg, qv[1][1] * eg); h1.y = pkbf(qv[1][2] * eg, qv[1][3] * eg); h1.z = pkbf(qv[3][0] * eg, qv[3][1] * eg); h1.w = pkbf(qv[3][2] * eg, qv[3][3] * eg);
                *(v4u*)fq = h0; *(v4u*)(fq + 32 * 8) = h1; }
            RAW_BAR();
            { const int c = tid & 127, rg = tid >> 7; float kb[16], kd[16];
#pragma unroll
                for (int i = 0; i < 16; ++i) { const int t = rg * 16 + i; const float kn = Kf[t * F_LD + c] * rkS[t]; kb[i] = kn * bgam[t]; kd[i] = kn * ekd[t]; }
                v4u o0, o1;
                o0.x = pkbf(kb[0], kb[1]); o0.y = pkbf(kb[2], kb[3]); o0.z = pkbf(kb[4], kb[5]); o0.w = pkbf(kb[6], kb[7]); o1.x = pkbf(kb[8], kb[9]); o1.y = pkbf(kb[10], kb[11]); o1.z = pkbf(kb[12], kb[13]); o1.w = pkbf(kb[14], kb[15]);
                *(LAS v4u*)(Kt + c * T_LD + rg * 16) = o0; *(LAS v4u*)(Kt + c * T_LD + rg * 16 + 8) = o1;
                bf16* fk = img + ((size_t)(FR_KDT + (c >> 5) * 4 + rg) * 64 + (c & 31)) * 8;
                v4u h0, h1;
                h0.x = pkbf(kd[0], kd[1]); h0.y = pkbf(kd[2], kd[3]); h0.z = pkbf(kd[8], kd[9]); h0.w = pkbf(kd[10], kd[11]);
                h1.x = pkbf(kd[4], kd[5]); h1.y = pkbf(kd[6], kd[7]); h1.z = pkbf(kd[12], kd[13]); h1.w = pkbf(kd[14], kd[15]);
                *(v4u*)fk = h0; *(v4u*)(fk + 32 * 8) = h1; }
            RAW_BAR();
            if (wave < 6) { const int pr = wave % 3, iskk = wave / 3, mt = pr == 2 ? 1 : 0, nt = pr == 0 ? 0 : 1;
                const LAS bf16* xs = iskk ? Ks : Qs; f32x16 d;
#pragma unroll
                for (int r = 0; r < 16; ++r) d[r] = 0.f;
#pragma unroll
                for (int s = 0; s < 8; ++s) { const bf16x8 af = *(const LAS bf16x8*)(Ks + (32 * mt + c32) * S_LD + 16 * s + 8 * hf), bfr = *(const LAS bf16x8*)(xs + (32 * nt + c32) * S_LD + 16 * s + 8 * hf); d = MFMA32(af, bfr, d); }
                const int i = 32 * nt + c32; const float gi = gamh[i], bi = betah[i];
#pragma unroll
                for (int r = 0; r < 16; ++r) { const int j = 32 * mt + (r & 3) + 8 * (r >> 2) + 4 * hf; const float de = __expf(gi - gamh[j]);
                    d[r] = iskk ? ((j < i) ? bi * d[r] * de : 0.f) : ((j <= i) ? d[r] * de : 0.f); }
                if (iskk) {
#pragma unroll
                    for (int qd = 0; qd < 4; ++qd) *(LAS f32x4*)(As + i * A_LD + 32 * mt + 8 * qd + 4 * hf) = (f32x4){d[4 * qd], d[4 * qd + 1], d[4 * qd + 2], d[4 * qd + 3]}; }
                else {
#pragma unroll
                    for (int sp = 0; sp < 2; ++sp) *(bf16x8*)(img + ((size_t)(FR_AQK + nt * 4 + 2 * mt + sp) * 64 + lane) * 8) = PACK8(d, sp); } }
            RAW_BAR();
            if (wave == 0) { float Tc[32];
                unsigned asb = (unsigned)(uintptr_t)(As + (32 * hf) * A_LD + 32 * hf); int cb = c32; asm volatile("" : "+v"(asb), "+v"(cb));
                const LAS float* Ab = (const LAS float*)(uintptr_t)asb;
#pragma unroll
                for (int i = 0; i < 32; ++i) { float ac[4] = {(i == cb) ? 1.f : 0.f, 0.f, 0.f, 0.f};
#pragma unroll
                    for (int j4 = 0; j4 < (i + 3) / 4; ++j4) { const f32x4 a4 = *(const LAS f32x4*)(Ab + i * A_LD + 4 * j4);
#pragma unroll
                        for (int q = 0; q < 4; ++q) if (4 * j4 + q < i) ac[q] -= a4[q] * Tc[4 * j4 + q]; }
                    Tc[i] = (ac[0] + ac[1]) + (ac[2] + ac[3]); }
#pragma unroll
                for (int i = 0; i < 32; ++i) Tb[(32 * hf + i) * T_LD + 32 * hf + c32] = (bf16)(pkbf(Tc[i], 0.f) & 0xffffu);
                if (hf == 0) {
#pragma unroll
                    for (int q = 0; q < 4; ++q) { v4u o; o.x = pkbf(Tc[8 * q], Tc[8 * q + 1]); o.y = pkbf(Tc[8 * q + 2], Tc[8 * q + 3]); o.z = pkbf(Tc[8 * q + 4], Tc[8 * q + 5]); o.w = pkbf(Tc[8 * q + 6], Tc[8 * q + 7]); *(LAS v4u*)(T11t + c32 * TT_LD + 8 * q) = o; } }
                asm volatile("s_waitcnt lgkmcnt(0)" ::: "memory");
                f32x16 x;
#pragma unroll
                for (int r = 0; r < 16; ++r) x[r] = 0.f;
#pragma unroll
                for (int s = 0; s < 2; ++s) { const LAS float* ap = As + (32 + c32) * A_LD + 16 * s + 8 * hf; const f32x4 a0 = *(const LAS f32x4*)ap, a1 = *(const LAS f32x4*)(ap + 4);
                    const bf16x8 af = __builtin_bit_cast(bf16x8, (v4u){pkbf(a0[0], a0[1]), pkbf(a0[2], a0[3]), pkbf(a1[0], a1[1]), pkbf(a1[2], a1[3])});
                    const bf16x8 bfr = *(const LAS bf16x8*)(T11t + c32 * TT_LD + 16 * s + 8 * hf); x = MFMA32(af, bfr, x); }
                f32x16 t21;
#pragma unroll
                for (int r = 0; r < 16; ++r) t21[r] = 0.f;
#pragma unroll
                for (int s = 0; s < 2; ++s) { const LAS bf16* tp = Tb + (32 + c32) * T_LD + 32 + 16 * s + 4 * hf; const v2u lo = *(const LAS v2u*)tp, hi = *(const LAS v2u*)(tp + 8);
                    const bf16x8 af = __builtin_bit_cast(bf16x8, (v4u){lo.x, lo.y, hi.x, hi.y}); const bf16x8 bfr = PACK8(x, s); t21 = MFMA32(af, bfr, t21); }
#pragma unroll
                for (int r = 0; r < 16; ++r) Tb[(32 + (r & 3) + 8 * (r >> 2) + 4 * hf) * T_LD + c32] = (bf16)(pkbf(-t21[r], 0.f) & 0xffffu);
            }
            RAW_BAR();
            if (wave < 4) {
#pragma unroll
                for (int mt = 0; mt < 2; ++mt) { f32x16 d;
#pragma unroll
                    for (int r = 0; r < 16; ++r) d[r] = 0.f;
#pragma unroll
                    for (int s = 0; s < 4; ++s) if (s < 2 * (mt + 1)) { const bf16x8 af = *(const LAS bf16x8*)(Tb + (32 * mt + c32) * T_LD + 16 * s + 8 * hf), bfr = *(const LAS bf16x8*)(Vt + (32 * wave + c32) * T_LD + 16 * s + 8 * hf); d = MFMA32(af, bfr, d); }
                    bf16* up = uimg + ((size_t)(wave * 2 + mt) * 64 + lane) * 16; *(bf16x8*)up = PACK8(d, 0); *(bf16x8*)(up + 8) = PACK8(d, 1); } }
            else { const int ct = wave - 4;
#pragma unroll
                for (int nt = 0; nt < 2; ++nt) { f32x16 d;
#pragma unroll
                    for (int r = 0; r < 16; ++r) d[r] = 0.f;
#pragma unroll
                    for (int s = 0; s < 4; ++s) if (s < 2 * (nt + 1)) { const bf16x8 af = *(const LAS bf16x8*)(Kt + (32 * ct + c32) * T_LD + 16 * s + 8 * hf), bfr = *(const LAS bf16x8*)(Tb + (32 * nt + c32) * T_LD + 16 * s + 8 * hf); d = MFMA32(af, bfr, d); }
#pragma unroll
                    for (int r = 0; r < 16; ++r) d[r] = -d[r];
#pragma unroll
                    for (int sp = 0; sp < 2; ++sp) *(bf16x8*)(img + ((size_t)(FR_WN + nt * 8 + 2 * ct + sp) * 64 + lane) * 8) = PACK8(d, sp); } }
            if (tid == 0) CD[chd] = egam[63];
            RAW_BAR();
        }
#undef PREP_LOADRAW
    }
}

__host__ __device__ constexpr int sc_p(int k) { const int j = k - 32; return j < 12 ? j % 6 : (j - 12) % 5; }
__host__ __device__ constexpr int sc_slab(int k) { const int j = k - 32; return k < 32 ? (k >> 2) : (j < 12 ? j / 6 : 2 + (j - 12) / 5); }
__host__ __device__ constexpr int sc_kind(int k) { return k < 32 ? ((k & 3) < 2 ? 0 : 1) : ((sc_p(k) == 2 || sc_p(k) == 5) ? 1 : 2); }
__host__ __device__ constexpr int sc_idx(int k) { return k < 32 ? (k & 1) : (sc_p(k) == 0 ? 0 : sc_p(k) == 1 ? 1 : sc_p(k) == 2 ? 1 : sc_p(k) == 3 ? 2 : sc_p(k) == 4 ? 3 : 0); }
__host__ __device__ constexpr int sc_frag(int k) { return k < 32 ? (((k & 3) < 2 ? FR_WN : FR_QD) + (k & 1) * 8 + (k >> 2)) : (sc_kind(k) == 1 ? FR_AQK + sc_idx(k) * 4 + sc_slab(k) : FR_KDT + sc_idx(k) * 4 + sc_slab(k)); }
constexpr int SC_QD = 8;
constexpr int SCB = 57344, OT_OFF = 2 * SCB, OT_LD = 136, OT_BYTES = 64 * OT_LD * 2;
static_assert(OT_OFF + 2 * OT_BYTES <= 152 * 1024, "scan LDS");
__device__ __forceinline__ void phase_dn_scan(const Frame& F0, const Args& a, int layer, int unit) {
    PHASE_FRAME(F0);
    unsigned char* ws = OPQ_G(unsigned char, a.ws);
    LAS unsigned char* lds = F.lds;
    const int b = unit >> 3, h = unit & 7, lane = F.lane;
    const bf16* IMG = (const bf16*)(ws + WS_IMG); const bf16* UIMG = (const bf16*)(ws + WS_UIMG); const float* CD = (const float*)(ws + WS_CD);
    const size_t chd0 = (size_t)b * NCH * NH + h;
    if (F.wave < 4) {
#ifndef SCAN_NO_COMPUTE
        const int w = F.wave, c32 = lane & 31, hf = lane >> 5;
        f32x16 S0, S1, S2, S3;
#pragma unroll
        for (int r = 0; r < 16; ++r) { S0[r] = 0.f; S1[r] = 0.f; S2[r] = 0.f; S3[r] = 0.f; }
        const float cdl = CD[chd0 + (size_t)lane * NH];
        v4u UA[4];
        const __amdgpu_buffer_rsrc_t rsU = __builtin_amdgcn_make_buffer_rsrc((void*)(UIMG + chd0 * UIMG_ELEMS), (short)0, NCH * NH * UIMG_ELEMS * 2, 0x00020000);
        const unsigned uoff = (unsigned)((w * 2) * 64 + lane) * 32u;
#define SC_LOADU(dst, nn) do { _Pragma("unroll") for (int mt_ = 0; mt_ < 2; ++mt_) { _Pragma("unroll") for (int hh_ = 0; hh_ < 2; ++hh_) dst[2 * mt_ + hh_] = __builtin_amdgcn_raw_buffer_load_b128(rsU, uoff + (unsigned)(mt_ * 2048 + hh_ * 16), (unsigned)(nn) * (unsigned)(NH * UIMG_ELEMS * 2), 0); } } while (0)
#define SC_FRAG(bufoff, fi) (*(const LAS bf16x8*)(lds + (bufoff) + (fi) * 1024 + lane * 16))
#define SC_CHUNK(nn, U, bufoff, otoff) do { \
        f32x16 aV0, aV1, aO0, aO1; bf16x8 fq0, fq1, fq2, fq3, fq4, fq5, fq6, fq7, Sbs, Vb0, Vb1, Vb2, Vb3; \
        _Pragma("unroll") for (int q = 0; q < 4; ++q) { aV0[2 * q] = bflo(U[0][q]); aV0[2 * q + 1] = bfhi(U[0][q]); aV0[8 + 2 * q] = bflo(U[1][q]); aV0[8 + 2 * q + 1] = bfhi(U[1][q]); \
            aV1[2 * q] = bflo(U[2][q]); aV1[2 * q + 1] = bfhi(U[2][q]); aV1[8 + 2 * q] = bflo(U[3][q]); aV1[8 + 2 * q + 1] = bfhi(U[3][q]); } \
        _Pragma("unroll") for (int r = 0; r < 16; ++r) { aO0[r] = 0.f; aO1[r] = 0.f; } \
        if ((nn) + 1 < NCH) SC_LOADU(U, (nn) + 1); \
        const float cd = __builtin_bit_cast(float, __builtin_amdgcn_readlane(__builtin_bit_cast(int, cdl), (nn))); \
        fq0 = SC_FRAG(bufoff, 0); \
        fq1 = SC_FRAG(bufoff, 8); \
        fq2 = SC_FRAG(bufoff, 16); \
        fq3 = SC_FRAG(bufoff, 24); \
        fq4 = SC_FRAG(bufoff, 1); \
        fq5 = SC_FRAG(bufoff, 9); \
        fq6 = SC_FRAG(bufoff, 17); \
        fq7 = SC_FRAG(bufoff, 25); \
        Sbs = PACK8(S0, 0); \
        aV0 = MFMA32(fq0, Sbs, aV0); \
        fq0 = SC_FRAG(bufoff, 2); \
        aV1 = MFMA32(fq1, Sbs, aV1); \
        fq1 = SC_FRAG(bufoff, 10); \
        aO0 = MFMA32(fq2, Sbs, aO0); \
        fq2 = SC_FRAG(bufoff, 18); \
        aO1 = MFMA32(fq3, Sbs, aO1); \
        fq3 = SC_FRAG(bufoff, 26); \
        Sbs = PACK8(S0, 1); \
        aV0 = MFMA32(fq4, Sbs, aV0); \
        fq4 = SC_FRAG(bufoff, 3); \
        aV1 = MFMA32(fq5, Sbs, aV1); \
        fq5 = SC_FRAG(bufoff, 11); \
        aO0 = MFMA32(fq6, Sbs, aO0); \
        fq6 = SC_FRAG(bufoff, 19); \
        aO1 = MFMA32(fq7, Sbs, aO1); \
        fq7 = SC_FRAG(bufoff, 27); \
        Sbs = PACK8(S1, 0); \
        aV0 = MFMA32(fq0, Sbs, aV0); \
        fq0 = SC_FRAG(bufoff, 4); \
        aV1 = MFMA32(fq1, Sbs, aV1); \
        fq1 = SC_FRAG(bufoff, 12); \
        aO0 = MFMA32(fq2, Sbs, aO0); \
        fq2 = SC_FRAG(bufoff, 20); \
        aO1 = MFMA32(fq3, Sbs, aO1); \
        fq3 = SC_FRAG(bufoff, 28); \
        Sbs = PACK8(S1, 1); \
        aV0 = MFMA32(fq4, Sbs, aV0); \
        fq4 = SC_FRAG(bufoff, 5); \
        aV1 = MFMA32(fq5, Sbs, aV1); \
        fq5 = SC_FRAG(bufoff, 13); \
        aO0 = MFMA32(fq6, Sbs, aO0); \
        fq6 = SC_FRAG(bufoff, 21); \
        aO1 = MFMA32(fq7, Sbs, aO1); \
        fq7 = SC_FRAG(bufoff, 29); \
        Sbs = PACK8(S2, 0); \
        aV0 = MFMA32(fq0, Sbs, aV0); \
        fq0 = SC_FRAG(bufoff, 6); \
        aV1 = MFMA32(fq1, Sbs, aV1); \
        fq1 = SC_FRAG(bufoff, 14); \
        aO0 = MFMA32(fq2, Sbs, aO0); \
        fq2 = SC_FRAG(bufoff, 22); \
        aO1 = MFMA32(fq3, Sbs, aO1); \
        fq3 = SC_FRAG(bufoff, 30); \
        Sbs = PACK8(S2, 1); \
        aV0 = MFMA32(fq4, Sbs, aV0); \
        fq4 = SC_FRAG(bufoff, 7); \
        aV1 = MFMA32(fq5, Sbs, aV1); \
        fq5 = SC_FRAG(bufoff, 15); \
        aO0 = MFMA32(fq6, Sbs, aO0); \
        fq6 = SC_FRAG(bufoff, 23); \
        aO1 = MFMA32(fq7, Sbs, aO1); \
        fq7 = SC_FRAG(bufoff, 31); \
        Sbs = PACK8(S3, 0); \
        aV0 = MFMA32(fq0, Sbs, aV0); \
        fq0 = SC_FRAG(bufoff, 40); \
        aV1 = MFMA32(fq1, Sbs, aV1); \
        fq1 = SC_FRAG(bufoff, 44); \
        aO0 = MFMA32(fq2, Sbs, aO0); \
        fq2 = SC_FRAG(bufoff, 36); \
        aO1 = MFMA32(fq3, Sbs, aO1); \
        fq3 = SC_FRAG(bufoff, 48); \
        Sbs = PACK8(S3, 1); \
        aV0 = MFMA32(fq4, Sbs, aV0); \
        fq4 = SC_FRAG(bufoff, 52); \
        aV1 = MFMA32(fq5, Sbs, aV1); \
        fq5 = SC_FRAG(bufoff, 32); \
        S0 = S0 * cd; S1 = S1 * cd; S2 = S2 * cd; S3 = S3 * cd; \
        aO0 = MFMA32(fq6, Sbs, aO0); \
        fq6 = SC_FRAG(bufoff, 41); \
        aO1 = MFMA32(fq7, Sbs, aO1); \
        fq7 = SC_FRAG(bufoff, 45); \
        Vb0 = PACK8(aV0, 0); Vb1 = PACK8(aV0, 1); Vb2 = PACK8(aV1, 0); Vb3 = PACK8(aV1, 1); \
        S0 = MFMA32(fq0, Vb0, S0); \
        fq0 = SC_FRAG(bufoff, 37); \
        S1 = MFMA32(fq1, Vb0, S1); \
        fq1 = SC_FRAG(bufoff, 49); \
        aO1 = MFMA32(fq2, Vb0, aO1); \
        fq2 = SC_FRAG(bufoff, 53); \
        S2 = MFMA32(fq3, Vb0, S2); \
        fq3 = SC_FRAG(bufoff, 33); \
        S3 = MFMA32(fq4, Vb0, S3); \
        fq4 = SC_FRAG(bufoff, 42); \
        aO0 = MFMA32(fq5, Vb0, aO0); \
        fq5 = SC_FRAG(bufoff, 46); \
        S0 = MFMA32(fq6, Vb1, S0); \
        fq6 = SC_FRAG(bufoff, 38); \
        S1 = MFMA32(fq7, Vb1, S1); \
        fq7 = SC_FRAG(bufoff, 50); \
        aO1 = MFMA32(fq0, Vb1, aO1); \
        fq0 = SC_FRAG(bufoff, 54); \
        S2 = MFMA32(fq1, Vb1, S2); \
        fq1 = SC_FRAG(bufoff, 43); \
        S3 = MFMA32(fq2, Vb1, S3); \
        fq2 = SC_FRAG(bufoff, 47); \
        aO0 = MFMA32(fq3, Vb1, aO0); \
        fq3 = SC_FRAG(bufoff, 39); \
        S0 = MFMA32(fq4, Vb2, S0); \
        fq4 = SC_FRAG(bufoff, 51); \
        S1 = MFMA32(fq5, Vb2, S1); \
        fq5 = SC_FRAG(bufoff, 55); \
        aO1 = MFMA32(fq6, Vb2, aO1); \
        S2 = MFMA32(fq7, Vb2, S2); \
        S3 = MFMA32(fq0, Vb2, S3); \
        S0 = MFMA32(fq1, Vb3, S0); \
        S1 = MFMA32(fq2, Vb3, S1); \
        aO1 = MFMA32(fq3, Vb3, aO1); \
        S2 = MFMA32(fq4, Vb3, S2); \
        S3 = MFMA32(fq5, Vb3, S3); \
        _Pragma("unroll") for (int r = 0; r < 16; ++r) { \
            *(LAS bf16*)(lds + (otoff) + (((r & 3) + 8 * (r >> 2) + 4 * hf) * OT_LD + 32 * w + c32) * 2) = (bf16)(pkbf(aO0[r], 0.f) & 0xffffu); \
            *(LAS bf16*)(lds + (otoff) + ((32 + (r & 3) + 8 * (r >> 2) + 4 * hf) * OT_LD + 32 * w + c32) * 2) = (bf16)(pkbf(aO1[r], 0.f) & 0xffffu); } \
        RAW_BAR(); } while (0)
        SC_LOADU(UA, 0);
        RAW_BAR();
#pragma unroll 1
        for (int n = 0; n < NCH; n += 2) { SC_CHUNK(n, UA, 0, OT_OFF); SC_CHUNK(n + 1, UA, SCB, OT_OFF + OT_BYTES); }
#undef SC_CHUNK
#undef SC_FRAG
#undef SC_LOADU
#endif
    } else {
#ifndef SCAN_NO_HELPER
        const int ht = F.tid - 256, tok = ht >> 2, q = ht & 3;
        const bf16* PROJ = (const bf16*)(ws + WS_PROJ); bf16* MIXIN = (bf16*)(ws + WS_MIXIN);
        const float* nw = a.in[I_NORMW] + layer * HD + 32 * q; f32x4 nwv[8];
#pragma unroll
        for (int i = 0; i < 8; ++i) nwv[i] = *(const f32x4*)(nw + 4 * i);
        v4u RA[14], ZA[4];
        const __amdgpu_buffer_rsrc_t rsI = __builtin_amdgcn_make_buffer_rsrc((void*)(IMG + chd0 * IMG_ELEMS), (short)0, NCH * NH * IMG_ELEMS * 2, 0x00020000);
        const __amdgpu_buffer_rsrc_t rsZ = __builtin_amdgcn_make_buffer_rsrc((void*)(PROJ + (size_t)b * SEQ * NPROJ), (short)0, SEQ * NPROJ * 2, 0x00020000);
        const unsigned zoff = (unsigned)(tok * NPROJ + 3072 + h * HD + 32 * q) * 2u;
#define SH_LOADIMG(dst, nn) do { _Pragma("unroll") for (int i_ = 0; i_ < 14; ++i_) dst[i_] = __builtin_amdgcn_raw_buffer_load_b128(rsI, (unsigned)ht * 16u, (unsigned)(nn) * (unsigned)(NH * IMG_ELEMS * 2) + (unsigned)i_ * 4096u, 0); } while (0)
#define SH_STOREIMG(src, bufoff) do { LAS v4u* p_ = (LAS v4u*)(lds + (bufoff)) + ht; _Pragma("unroll") for (int i_ = 0; i_ < 14; ++i_) p_[i_ * 256] = src[i_]; } while (0)
#define SH_LOADZ(dst, nn) do { _Pragma("unroll") for (int i_ = 0; i_ < 4; ++i_) dst[i_] = __builtin_amdgcn_raw_buffer_load_b128(rsZ, zoff + 16u * (unsigned)i_, (unsigned)(nn) * (unsigned)(CH * NPROJ * 2), 0); } while (0)
#define SH_EPI(mm, Z, otoff) do { const LAS v4u* op_ = (const LAS v4u*)(lds + (otoff) + (tok * OT_LD + 32 * q) * 2); v4u ow[4]; float ss = 0.f; \
        _Pragma("unroll") for (int i_ = 0; i_ < 4; ++i_) { ow[i_] = op_[i_]; _Pragma("unroll") for (int j_ = 0; j_ < 4; ++j_) { const float x0 = bflo(ow[i_][j_]), x1 = bfhi(ow[i_][j_]); ss += x0 * x0 + x1 * x1; } } \
        ss += __shfl_xor(ss, 1); ss += __shfl_xor(ss, 2); const float rr = 1.0f / sqrtf(ss * (1.0f / HD) + RMS_EPS); \
        v4u* yp_ = (v4u*)(MIXIN + ((size_t)b * SEQ + (size_t)(mm) * CH + tok) * D + h * HD + 32 * q); \
        _Pragma("unroll") for (int i_ = 0; i_ < 4; ++i_) { __builtin_amdgcn_sched_barrier(0); v4u o_; const f32x4 n0 = nwv[2 * i_], n1 = nwv[2 * i_ + 1]; \
            _Pragma("unroll") for (int j_ = 0; j_ < 4; ++j_) { const float z0 = bflo(Z[i_][j_]), z1 = bfhi(Z[i_][j_]); const float g0 = (j_ < 2 ? n0[2 * j_] : n1[2 * j_ - 4]), g1 = (j_ < 2 ? n0[2 * j_ + 1] : n1[2 * j_ - 3]); \
            o_[j_] = pkbf(bflo(ow[i_][j_]) * rr * g0 * z0 * sigmoidf_(z0), bfhi(ow[i_][j_]) * rr * g1 * z1 * sigmoidf_(z1)); } yp_[i_] = o_; } } while (0)
#define SH_STEP(nn, bufnext, otprev) do { \
        if ((nn) + 1 < NCH) SH_STOREIMG(RA, bufnext); \
        if ((nn) + 2 < NCH) SH_LOADIMG(RA, (nn) + 2); \
        if ((nn) >= 1) SH_EPI((nn) - 1, ZA, otprev); \
        SH_LOADZ(ZA, (nn)); \
        RAW_BAR(); } while (0)
        SH_LOADIMG(RA, 0);
        SH_STOREIMG(RA, 0);
        SH_LOADIMG(RA, 1);
        RAW_BAR();
#pragma unroll 1
        for (int n = 0; n < NCH; n += 2) { SH_STEP(n, SCB, OT_OFF + OT_BYTES); SH_STEP(n + 1, 0, OT_OFF); }
        SH_EPI(NCH - 1, ZA, OT_OFF + OT_BYTES);
#undef SH_STEP
#undef SH_EPI
#undef SH_LOADZ
#undef SH_STOREIMG
#undef SH_LOADIMG
#endif
    }
}

__device__ __forceinline__ void phase_ln1_router(const Frame& F0, const Args& a, int layer) {
    PHASE_FRAME(F0);
    unsigned char* ws = OPQ_G(unsigned char, a.ws);
    LAS float* WRt = (LAS float*)F.lds;
    LAS int* rowE = (LAS int*)(F.lds + AUX_OFF); LAS int* rowP = rowE + 128; LAS float* rowG = (LAS float*)(rowP + 128); LAS int* lcnt = (LAS int*)(rowG + 128); LAS int* lbase = lcnt + 16;
    const float* wr = OPQ_G(const float, a.in[I_WR]); const float* br = OPQ_G(const float, a.in[I_BR]);
    for (int idx = F.tid; idx < D * NE; idx += 512) WRt[(idx & 15) * D + (idx >> 4)] = wr[idx];
    const float* PRE = a.out; bf16* X1B = (bf16*)(ws + WS_X1B); float* STATS = (float*)(ws + WS_STATS);
    const float* g1 = a.in[I_LN1G] + (size_t)layer * D; const float* b1 = a.in[I_LN1B] + (size_t)layer * D;
    int* LIST = (int*)(ws + WS_LIST); int* TOKSLOT = (int*)(ws + WS_TOKSLOT); float* GATEW = (float*)(ws + WS_GATEW);
    gu32* cnt = F.ctl + CW_CNT + 64 * layer;
    float brv[16];
#pragma unroll
    for (int e = 0; e < 16; ++e) brv[e] = br[e];
    for (int rb = F.vcu; rb < T / 64; rb += F.G) {
        if (F.tid < 16) lcnt[F.tid] = 0;
        __syncthreads();
        for (int r = 0; r < 8; ++r) { const int lr = F.wave * 8 + r, row = rb * 64 + lr;
            const GAS f32x4* xr = (const GAS f32x4*)(PRE + (size_t)row * D) + F.lane;
            f32x4 v[8]; float s = 0.f;
#pragma unroll
            for (int j = 0; j < 8; ++j) { v[j] = xr[64 * j]; s += (v[j][0] + v[j][1]) + (v[j][2] + v[j][3]); }
            const float mean = wave_sum(s) * (1.f / D); float s2 = 0.f;
#pragma unroll
            for (int j = 0; j < 8; ++j) { v[j] = v[j] - mean; s2 += (v[j][0] * v[j][0] + v[j][1] * v[j][1]) + (v[j][2] * v[j][2] + v[j][3] * v[j][3]); }
            const float rstd = 1.f / sqrtf(wave_sum(s2) * (1.f / D) + LN_EPS);
            if (F.lane == 0) { STATS[2 * row] = mean; STATS[2 * row + 1] = rstd; }
            GAS v2u* o8 = (GAS v2u*)(X1B + (size_t)row * D) + F.lane;
            float lg[16];
#pragma unroll
            for (int e = 0; e < 16; ++e) lg[e] = 0.f;
#pragma unroll
            for (int j = 0; j < 8; ++j) { const f32x4 gg = *(const f32x4*)(g1 + 256 * j + 4 * F.lane), bb = *(const f32x4*)(b1 + 256 * j + 4 * F.lane);
                v[j] = v[j] * rstd * gg + bb;
                v2u w; w.x = pk2(v[j][0], v[j][1]); w.y = pk2(v[j][2], v[j][3]); o8[64 * j] = w;
#pragma unroll
                for (int e = 0; e < 16; ++e) { const f32x4 w4 = *(const LAS f32x4*)(WRt + e * D + 256 * j + 4 * F.lane); lg[e] += (v[j][0] * w4[0] + v[j][1] * w4[1]) + (v[j][2] * w4[2] + v[j][3] * w4[3]); } }
            float mx = -3.0e38f;
#pragma unroll
            for (int e = 0; e < 16; ++e) { lg[e] = wave_sum(lg[e]) + brv[e]; mx = fmaxf(mx, lg[e]); }
            float p[16];
#pragma unroll
            for (int e = 0; e < 16; ++e) p[e] = __expf(lg[e] - mx);
            float gsc[4];
#pragma unroll
            for (int g = 0; g < 4; ++g) { const float a0 = p[4 * g], a1 = p[4 * g + 1], a2 = p[4 * g + 2], a3 = p[4 * g + 3];
                const float hi1 = fmaxf(a0, a1), lo1 = fminf(a0, a1), hi2 = fmaxf(a2, a3), lo2 = fminf(a2, a3);
                gsc[g] = fmaxf(hi1, hi2) + fmaxf(fminf(hi1, hi2), fmaxf(lo1, lo2)); }
            int gsel = 0; float best = gsc[0];
#pragma unroll
            for (int g = 1; g < 4; ++g) if (gsc[g] > best) { best = gsc[g]; gsel = g; }
            float q[4];
#pragma unroll
            for (int j = 0; j < 4; ++j) q[j] = gsel == 0 ? p[j] : (gsel == 1 ? p[4 + j] : (gsel == 2 ? p[8 + j] : p[12 + j]));
            int i0 = 0; float p0 = q[0];
#pragma unroll
            for (int j = 1; j < 4; ++j) if (q[j] > p0) { p0 = q[j]; i0 = j; }
            int i1 = -1; float p1 = -1.f;
#pragma unroll
            for (int j = 0; j < 4; ++j) if (j != i0 && q[j] > p1) { p1 = q[j]; i1 = j; }
            if (F.lane == 0) { const int e0 = gsel * 4 + i0, e1 = gsel * 4 + i1; const float inv = 1.0f / (p0 + p1);
                rowE[2 * lr] = e0; rowE[2 * lr + 1] = e1; rowG[2 * lr] = p0 * inv; rowG[2 * lr + 1] = p1 * inv;
                rowP[2 * lr] = __hip_atomic_fetch_add(&lcnt[e0], 1, __ATOMIC_RELAXED, __HIP_MEMORY_SCOPE_WORKGROUP); rowP[2 * lr + 1] = __hip_atomic_fetch_add(&lcnt[e1], 1, __ATOMIC_RELAXED, __HIP_MEMORY_SCOPE_WORKGROUP); }
        }
        __syncthreads();
        if (F.tid < 16) lbase[F.tid] = (int)__hip_atomic_fetch_add(cnt + F.tid, (unsigned)lcnt[F.tid], RLX_AGENT);
        __syncthreads();
        if (F.tid < 128) { const int e = rowE[F.tid], pos = lbase[e] + rowP[F.tid], tok = rb * 64 + (F.tid >> 1);
            LIST[(size_t)e * LCAP + pos] = tok; TOKSLOT[2 * tok + (F.tid & 1)] = e * LCAP + pos; GATEW[2 * tok + (F.tid & 1)] = rowG[F.tid]; }
        __syncthreads();
    }
}
__device__ __forceinline__ void moe_table(const Frame& F0, int layer) {
    PHASE_FRAME(F0);
    LAS int* tab = (LAS int*)(F.lds + AUX_OFF);
    __syncthreads();
    if (F.tid < 16) tab[32 + F.tid] = (int)__hip_atomic_load(F.ctl + CW_CNT + 64 * layer + F.tid, RLX_AGENT);
    __syncthreads();
    if (F.tid == 0) { int run = 0; for (int e = 0; e < 16; ++e) { tab[e] = run; run += (tab[32 + e] + 255) >> 8; } tab[16] = run; }
    __syncthreads();
}
__device__ __forceinline__ void phase_combine_ln2(const Frame& F0, const Args& a, int layer) {
    PHASE_FRAME(F0);
    unsigned char* ws = OPQ_G(unsigned char, a.ws); const LAS int* tab = (const LAS int*)(F.lds + AUX_OFF);
    float* PRE = a.out; const float* STATS = (const float*)(ws + WS_STATS); const bf16* Y = (const bf16*)(ws + WS_Y); bf16* X2B = (bf16*)(ws + WS_X2B);
    const int* TOKSLOT = (const int*)(ws + WS_TOKSLOT); const float* GATEW = (const float*)(ws + WS_GATEW);
    const float* g1 = a.in[I_LN1G] + (size_t)layer * D; const float* b1 = a.in[I_LN1B] + (size_t)layer * D; const float* g2 = a.in[I_LN2G] + (size_t)layer * D; const float* b2 = a.in[I_LN2B] + (size_t)layer * D;
    const int gw = F.vcu * NWAVES + F.wave, NGW = F.G * NWAVES;
    for (int row = gw; row < T; row += NGW) {
        const float mean = STATS[2 * row], rstd = STATS[2 * row + 1];
        const int s0 = TOKSLOT[2 * row], s1 = TOKSLOT[2 * row + 1]; const float w0 = GATEW[2 * row], w1 = GATEW[2 * row + 1];
        const size_t y0 = (size_t)tab[s0 / LCAP] * 256 + (s0 % LCAP), y1 = (size_t)tab[s1 / LCAP] * 256 + (s1 % LCAP);
        GAS f32x4* xr = (GAS f32x4*)(PRE + (size_t)row * D) + F.lane; const GAS v2u* ya = (const GAS v2u*)(Y + y0 * D) + F.lane; const GAS v2u* yb = (const GAS v2u*)(Y + y1 * D) + F.lane;
        f32x4 v[8]; float s = 0.f;
#pragma unroll
        for (int j = 0; j < 8; ++j) { const f32x4 gg = *(const f32x4*)(g1 + 256 * j + 4 * F.lane), bb = *(const f32x4*)(b1 + 256 * j + 4 * F.lane);
            const f32x4 x1 = (xr[64 * j] - mean) * rstd * gg + bb; const v2u pa = ya[64 * j], pb = yb[64 * j];
            f32x4 f; f[0] = w0 * bflo(pa.x) + w1 * bflo(pb.x); f[1] = w0 * bfhi(pa.x) + w1 * bfhi(pb.x); f[2] = w0 * bflo(pa.y) + w1 * bflo(pb.y); f[3] = w0 * bfhi(pa.y) + w1 * bfhi(pb.y);
            v[j] = x1 * ALPHA + f; s += (v[j][0] + v[j][1]) + (v[j][2] + v[j][3]); }
        const float m2 = wave_sum(s) * (1.f / D); float q = 0.f;
#pragma unroll
        for (int j = 0; j < 8; ++j) { v[j] = v[j] - m2; q += (v[j][0] * v[j][0] + v[j][1] * v[j][1]) + (v[j][2] * v[j][2] + v[j][3] * v[j][3]); }
        const float r2 = 1.f / sqrtf(wave_sum(q) * (1.f / D) + LN_EPS);
        GAS v2u* o8 = (GAS v2u*)(X2B + (size_t)row * D) + F.lane;
#pragma unroll
        for (int j = 0; j < 8; ++j) { const f32x4 gg = *(const f32x4*)(g2 + 256 * j + 4 * F.lane), bb = *(const f32x4*)(b2 + 256 * j + 4 * F.lane);
            const f32x4 o = v[j] * r2 * gg + bb; xr[64 * j] = o; v2u w; w.x = pk2(o[0], o[1]); w.y = pk2(o[2], o[3]); o8[64 * j] = w; }
    }
}

#ifndef MK_N_LAUNCHES
#define MK_N_LAUNCHES 1
#endif
constexpr int NPL = 9;
constexpr int NPHASE = 1 + NPL * DEPTH;
constexpr int N_LAUNCHES = MK_N_LAUNCHES;
static_assert(N_LAUNCHES == 1 || N_LAUNCHES == NPHASE, "MK_N_LAUNCHES is 1 or NPHASE");

__global__ void __launch_bounds__(NWAVES * 64, 2) trunk_fwd(Args args) {
    extern __shared__ __attribute__((aligned(16))) unsigned char lds[];
    Frame F;
    F.lds = (LAS unsigned char*)lds;
    F.MISC = (volatile LAS unsigned*)(F.lds + MISC_OFF);
    F.tid = threadIdx.x; F.lane = F.tid & 63; F.wave = __builtin_amdgcn_readfirstlane(F.tid >> 6);
    F.G = gridDim.x; { const int bx = blockIdx.x; F.vcu = (F.G % 8 == 0) ? (bx % 8) * (F.G / 8) + bx / 8 : bx; }
    unsigned char* ws = args.ws;
    F.ctl = (gu32*)(ws + WS_CTL);
    for (int u = F.tid; u < (LDS_BYTES - LDSCTL_OFF) / 4; u += NWAVES * 64) ((LAS unsigned*)(F.lds + LDSCTL_OFF))[u] = 0u;
    __syncthreads();
    XcdBarrier bar; bar.bar = (unsigned*)(F.ctl + CW_BAR); bar.x = 0; bar.st = nullptr;
    if (N_LAUNCHES == 1) bar = xcd_barrier_post((unsigned*)(F.ctl + CW_BAR), F.MISC + 8);
#define GRID_BAR() do { if (N_LAUNCHES == 1) xcd_barrier(bar); } while (0)
    const int lo = args.ph_lo, hi = args.ph_hi;
#ifndef PH_MASK
#define PH_MASK 0x7ff
#endif
#define IN(k) ((((k) == 0 ? 1u : (2u << (((k) - 1) % NPL))) & (unsigned)(PH_MASK)) && lo <= (k) && (k) < hi)
#define SEAM(k) do { if (IN((k) + 1)) GRID_BAR(); } while (0)
#ifndef PROBE_DUP
#define PROBE_DUP 0
#endif
#define REPS(k) ((((k) == 0 ? 1u : (2u << (((k) - 1) % NPL))) & (unsigned)(PROBE_DUP)) ? 2 : 1)

    if (IN(0)) { for (int rep = 0; rep < REPS(0); ++rep) { if (rep) GRID_BAR(); p0_prologue(F, args); } SEAM(0); }

#ifdef LAYER_UNROLL
#pragma unroll
#else
#pragma unroll 1
#endif
    for (int layer = 0; layer < DEPTH; ++layer) {
        const int pb = 1 + NPL * layer;
        unsigned char* ws = OPQ_G(unsigned char, args.ws);
        if (IN(pb + 0)) { for (int rep = 0; rep < REPS(pb + 0); ++rep) { if (rep) GRID_BAR();
            SchedDense S; S.init(T, NPROJ, F.G, (int)blockIdx.x, ws + WS_XB, D, (const bf16*)(ws + WS_WIN) + (size_t)layer * NPROJ * D, D);
            EpiBf16 E{(bf16*)(ws + WS_PROJ), NPROJ};
            pg8::gemm_phase<EpiBf16, SchedDense, false>(F.lds + RING_OFF, D, D, D, S, E);
            } SEAM(pb + 0);
        }
        if (IN(pb + 1)) { for (int rep = 0; rep < REPS(pb + 1); ++rep) { if (rep) GRID_BAR(); phase_dn_prep(F, args, layer); } SEAM(pb + 1); }
        if (IN(pb + 2)) { for (int rep = 0; rep < REPS(pb + 2); ++rep) { if (rep) GRID_BAR();
            if (blockIdx.x < 32 || F.G <= 32) { for (int u = blockIdx.x; u < NB * NH; u += (F.G < 32 ? F.G : 32)) phase_dn_scan(F, args, layer, u); }
            if (blockIdx.x >= 32 || F.G <= 32) { const int G2 = F.G <= 32 ? F.G : F.G - 32, c2 = F.G <= 32 ? (int)blockIdx.x : (int)blockIdx.x - 32;
                { SchedPool S{G2, c2, (const char*)(ws + WS_POOLD), (const char*)((const bf16*)(ws + WS_WPOOL) + (size_t)layer * 4 * 65536)};
                  EpiPool E{(bf16*)(ws + WS_MIXIN), args.in[I_POOLS] + (size_t)layer * PW};
                  pg8::gemm_phase<EpiPool, SchedPool, false>(F.lds + RING_OFF, 256, PW, 256, S, E); }
                { SchedDense S; S.init(T, D, G2, c2, (const bf16*)(ws + WS_PB16) + (size_t)layer * T * PLE, PLE, (const bf16*)(ws + WS_WPP) + (size_t)layer * D * PLE, PLE);
                  EpiBf16 E{(bf16*)(ws + WS_PP), D};
                  pg8::gemm_phase<EpiBf16, SchedDense, false>(F.lds + RING_OFF, PLE, PLE, PLE, S, E); } }
            } SEAM(pb + 2);
        }
        if (IN(pb + 3)) { for (int rep = 0; rep < REPS(pb + 3); ++rep) { if (rep) GRID_BAR();
            SchedDense S; S.init(T, D, F.G, (int)blockIdx.x, ws + WS_MIXIN, D, (const bf16*)(ws + WS_WOUT) + (size_t)layer * D * D, D);
            EpiRes E{layer == 0 ? args.in[I_X] : args.out, args.out};
            pg8::gemm_phase<EpiRes, SchedDense, false>(F.lds + RING_OFF, D, D, D, S, E);
            } SEAM(pb + 3);
        }
        if (IN(pb + 4)) { for (int rep = 0; rep < REPS(pb + 4); ++rep) { if (rep) GRID_BAR(); phase_ln1_router(F, args, layer); } SEAM(pb + 4); }
        if (IN(pb + 5)) { for (int rep = 0; rep < REPS(pb + 5); ++rep) { if (rep) GRID_BAR();
            moe_table(F, layer);
            SchedMoe S{F.G, (int)blockIdx.x, 0, (const LAS int*)(F.lds + AUX_OFF), (const char*)(ws + WS_X1B), (const char*)((const bf16*)(ws + WS_WGU) + (size_t)layer * NE * 2048 * D), (const int*)(ws + WS_LIST)};
            EpiSwiglu E{(bf16*)(ws + WS_HID)};
            pg8::gemm_phase<EpiSwiglu, SchedMoe, true>(F.lds + RING_OFF, D, D, D, S, E);
            } SEAM(pb + 5);
        }
        if (IN(pb + 6)) { for (int rep = 0; rep < REPS(pb + 6); ++rep) { if (rep) GRID_BAR();
            moe_table(F, layer);
            SchedMoe S{F.G, (int)blockIdx.x, 1, (const LAS int*)(F.lds + AUX_OFF), (const char*)(ws + WS_HID), (const char*)((const bf16*)(ws + WS_WD) + (size_t)layer * NE * D * DE), nullptr};
            EpiBf16 E{(bf16*)(ws + WS_Y), D};
            pg8::gemm_phase<EpiBf16, SchedMoe, false>(F.lds + RING_OFF, DE, DE, DE, S, E);
            } SEAM(pb + 6);
        }
        if (IN(pb + 7)) { for (int rep = 0; rep < REPS(pb + 7); ++rep) { if (rep) GRID_BAR(); moe_table(F, layer); phase_combine_ln2(F, args, layer); } SEAM(pb + 7); }
        if (IN(pb + 8)) { for (int rep = 0; rep < REPS(pb + 8); ++rep) { if (rep) GRID_BAR();
            { SchedDense S; S.init(T, D, F.G, (int)blockIdx.x, ws + WS_X2B, D, (const bf16*)(ws + WS_WPG) + (size_t)layer * D * D, D);
              EpiPle E{args.out, (const bf16*)(ws + WS_PP), (bf16*)(ws + WS_XB), layer + 1 < DEPTH ? 1 : 0};
              pg8::gemm_phase<EpiPle, SchedDense, false>(F.lds + RING_OFF, D, D, D, S, E); }
            } SEAM(pb + 8);
        }
    }
#undef IN
#undef SEAM
#undef GRID_BAR
}

extern "C" void kernel_launch(void* const* d_in, const int* in_sizes, int n_in, void* d_out, int out_size, void* d_ws, size_t ws_size, hipStream_t stream) {
    static int grid = 0;
    if (grid == 0) {
        if (n_in != 21 || in_sizes[0] != T * D || out_size != T * D || ws_size < WS_END) { fprintf(stderr, "kernel_launch: unexpected shapes (n_in %d, in0 %d, out %d, ws %zu); nothing launched\n", n_in, n_in > 0 ? in_sizes[0] : -1, out_size, ws_size); grid = -1; return; }
        int dev = 0, cus = 0, per_cu = 0;
        if (hipGetDevice(&dev) != hipSuccess || hipDeviceGetAttribute(&cus, hipDeviceAttributeMultiprocessorCount, dev) != hipSuccess) { grid = -1; return; }
        if (hipFuncSetAttribute((const void*)trunk_fwd, hipFuncAttributeMaxDynamicSharedMemorySize, LDS_BYTES) != hipSuccess) { fprintf(stderr, "kernel_launch: hipFuncSetAttribute failed\n"); grid = -1; return; }
        if (hipOccupancyMaxActiveBlocksPerMultiprocessor(&per_cu, (const void*)trunk_fwd, NWAVES * 64, LDS_BYTES) != hipSuccess || per_cu < 1) { fprintf(stderr, "kernel_launch: occupancy query reports %d workgroups per CU\n", per_cu); }
        (void)hipGetLastError();
        grid = cus;
    }
    if (grid < 0) return;
    if (hipMemsetAsync((char*)d_ws + WS_CTL, 0, CTL_ZERO_BYTES, stream) != hipSuccess) return;
    Args a{};
    for (int i = 0; i < 21; ++i) a.in[i] = (const float*)d_in[i];
    a.out = (float*)d_out; a.ws = (unsigned char*)d_ws;
    for (int li = 0; li < N_LAUNCHES; ++li) {
        a.ph_lo = (N_LAUNCHES == 1) ? 0 : li; a.ph_hi = (N_LAUNCHES == 1) ? NPHASE : li + 1; a.li = li; a.pad = 0;
        hipLaunchKernelGGL(trunk_fwd, dim3(grid), dim3(NWAVES * 64), LDS_BYTES, stream, a);
        const hipError_t le = hipPeekAtLastError();
        if (le != hipSuccess) { fprintf(stderr, "kernel_launch: launch %d failed: %s\n", li, hipGetErrorName(le)); break; }
    }
}
```

```cpp
#define MK_N_LAUNCHES 1
#include <hip/hip_runtime.h>
#include <cstdio>
#include <cstdint>

#define GAS __attribute__((address_space(1)))
#define LAS __attribute__((address_space(3)))
typedef unsigned short bf16;
typedef unsigned v4u __attribute__((ext_vector_type(4)));
typedef unsigned v2u __attribute__((ext_vector_type(2)));
typedef float f32x4 __attribute__((ext_vector_type(4)));
typedef float f32x2 __attribute__((ext_vector_type(2)));
typedef short bf16x8 __attribute__((ext_vector_type(8)));
typedef GAS unsigned gu32;

namespace pg8 {
constexpr int BM = 256, BK = 64, HALF = 128, HTB = HALF * BK * 2  , STAGE_BYTES = 8 * HTB, NXCD = 8, WGM = 8;
__host__ __device__ __forceinline__ int lds_byte(int r, int c) { const int st = (r >> 4) * 2 + (c >> 5), rr = r & 15, cc = c & 31, ob = rr * 64 + cc * 2; return st * 1024 + (ob ^ (((ob >> 9) & 1) << 5)); }
__host__ __device__ __forceinline__ void stage_rc(int b, int& R, int& C) { const int st = b / 1024, sb = b % 1024, swz = sb ^ (((sb >> 9) & 1) << 5); R = (st >> 1) * 16 + swz / 64; C = (st & 1) * 32 + (swz % 64) / 2; }
__host__ __device__ __forceinline__ int perm32(int rho) { const int n = rho >> 4, i = rho & 15; return 8 * (i >> 2) + 4 * n + (i & 3); }

struct Unit { int pm, pn; const char* A; const char* B; const int* rows; int nvalid; int aux; };

__device__ __forceinline__ unsigned cvt_pk_bf16(float lo, float hi) { unsigned r; asm volatile("v_cvt_pk_bf16_f32 %0, %1, %2" : "=v"(r) : "v"(lo), "v"(hi)); return r; }

template <class Epi, class Sched, bool GATHER>
__device__ __forceinline__ void gemm_phase(LAS unsigned char* lds, const int K, const int lda, const int ldb, const Sched& S, const Epi& E) {
    int tid_ = threadIdx.x; asm volatile("" : "+v"(tid_));
    const int tid = tid_, wid = __builtin_amdgcn_readfirstlane(tid >> 6), lane = tid & 63, wr = wid >> 2, wc = wid & 3, fr = lane & 15, fq = lane >> 4;
    const int nt = K / BK;
    unsigned voffA[2], voffB[2]; int RA[2], CA[2];
#pragma unroll
    for (int i = 0; i < 2; ++i) { int R, C; stage_rc(tid * 16 + i * 8192, R, C); const int Rb = Epi::PERM ? ((R & ~31) + perm32(R & 31)) : R;
        RA[i] = R; CA[i] = C; voffA[i] = (unsigned)(R * lda + C) * 2u; voffB[i] = (unsigned)(Rb * ldb + C) * 2u; }
    unsigned gA[2][2], gN[2][2];
    const size_t kstep = (size_t)(BK * 2);
    const size_t hstepA = GATHER ? 0 : (size_t)HALF * lda * 2, hstepB = (size_t)HALF * ldb * 2;
    const unsigned ldsw = (unsigned)wid * 1024u;
    const int aoff = lds_byte(wr * 64 + fr, fq * 8), boff = lds_byte(wc * 32 + fr, fq * 8);
#define PG8_SA(b, h) (((b) * 2 + (h)) * HTB)
#define PG8_SB(b, h) ((4 + (b) * 2 + (h)) * HTB)
#define PG8_STAGE_B(bufoff, gbase) do { _Pragma("unroll") for (int _i = 0; _i < 2; ++_i) \
        __builtin_amdgcn_global_load_lds((const unsigned*)((const char*)(gbase) + voffB[_i]), (LAS unsigned*)(lds + (bufoff) + ldsw + _i * 8192), 16, 0, 0); } while (0)
#define PG8_STAGE_A(bufoff, gbase, h) do { _Pragma("unroll") for (int _i = 0; _i < 2; ++_i) \
        __builtin_amdgcn_global_load_lds((const unsigned*)((const char*)(gbase) + (GATHER ? gA[h][_i] : voffA[_i]) + (h) * hstepA), (LAS unsigned*)(lds + (bufoff) + ldsw + _i * 8192), 16, 0, 0); } while (0)
#define PG8_LDA(dst, b, h) do { _Pragma("unroll") for (int m = 0; m < 4; ++m) _Pragma("unroll") for (int k = 0; k < 2; ++k) dst[m][k] = *(const LAS bf16x8*)(lds + PG8_SA(b, h) + aoff + m * 2048 + k * 1024); } while (0)
#define PG8_LDB(dst, b, h) do { _Pragma("unroll") for (int n = 0; n < 2; ++n) _Pragma("unroll") for (int k = 0; k < 2; ++k) dst[n][k] = *(const LAS bf16x8*)(lds + PG8_SB(b, h) + boff + n * 2048 + k * 1024); } while (0)
#define PG8_MMA(ai, bj, At, Bt) do { __builtin_amdgcn_s_setprio(1); _Pragma("unroll") for (int m = 0; m < 4; ++m) _Pragma("unroll") for (int n = 0; n < 2; ++n) _Pragma("unroll") for (int k = 0; k < 2; ++k) \
        acc[ai][bj][m][n] = __builtin_amdgcn_mfma_f32_16x16x32_bf16(Bt[n][k], At[m][k], acc[ai][bj][m][n], 0, 0, 0); __builtin_amdgcn_s_setprio(0); } while (0)
#define PG8_WAIT_V(n) asm volatile("s_waitcnt vmcnt(" #n ")" ::: "memory")
#define PG8_WAIT_L(n) asm volatile("s_waitcnt lgkmcnt(" #n ")" ::: "memory")
#define PG8_BAR __builtin_amdgcn_s_barrier()
#define PG8_SCHED __builtin_amdgcn_sched_barrier(0)
#define PG8_GLOAD(dst, u) do { _Pragma("unroll") for (int _h = 0; _h < 2; ++_h) _Pragma("unroll") for (int _i = 0; _i < 2; ++_i) { const int _r = _h * HALF + RA[_i]; \
        const int _t = (_r < (u).nvalid) ? (u).rows[_r] : 0; dst[_h][_i] = (unsigned)(_t * lda + CA[_i]) * 2u; } } while (0)
    Unit cur, nxt; int ui = 0;
    if (!S.next(0, cur)) return;
    f32x4 acc[2][2][4][2];
#pragma unroll
    for (int a = 0; a < 2; ++a)
#pragma unroll
        for (int b = 0; b < 2; ++b)
#pragma unroll
            for (int m = 0; m < 4; ++m)
#pragma unroll
                for (int n = 0; n < 2; ++n) acc[a][b][m][n] = (f32x4){0.f, 0.f, 0.f, 0.f};
    bf16x8 At[4][2], B0[2][2], B1[2][2];
    const char* cA = cur.A; const char* cB = cur.B;
    if constexpr (GATHER) { PG8_GLOAD(gA, cur); PG8_WAIT_V(0); }
    PG8_STAGE_B(PG8_SB(0, 0), cB); PG8_STAGE_B(PG8_SB(0, 1), cB + hstepB); PG8_STAGE_A(PG8_SA(0, 0), cA, 0); PG8_STAGE_A(PG8_SA(0, 1), cA, 1);
    if (wr == 1) PG8_BAR;
    PG8_WAIT_V(2); PG8_BAR;
    PG8_STAGE_B(PG8_SB(1, 0), cB + kstep); PG8_STAGE_A(PG8_SA(1, 0), cA + kstep, 0); PG8_STAGE_B(PG8_SB(1, 1), cB + hstepB + kstep);
    PG8_WAIT_V(6); PG8_BAR;
    for (;;) {
        const bool has_next = S.next(ui + 1, nxt);
        const char* nA = has_next ? nxt.A : cA; const char* nB = has_next ? nxt.B : cB;
        if constexpr (GATHER) { if (has_next) { PG8_GLOAD(gN, nxt); } else {
#pragma unroll
            for (int h = 0; h < 2; ++h)
#pragma unroll
                for (int i = 0; i < 2; ++i) gN[h][i] = gA[h][i]; } }
#pragma unroll 1
        for (int t = 0; t < nt; t += 2) {
            const bool last = (t == nt - 2);
            const char* a1 = cA + (size_t)(t + 1) * kstep;
            const char* a2 = last ? nA : cA + (size_t)(t + 2) * kstep; const char* b2 = last ? nB : cB + (size_t)(t + 2) * kstep;
            const char* a3 = a2 + kstep; const char* b3 = b2 + kstep;
            PG8_LDB(B0, 0, 0); PG8_LDB(B1, 0, 1); PG8_SCHED; PG8_LDA(At, 0, 0); PG8_STAGE_A(PG8_SA(1, 1), a1, 1);
            if constexpr (GATHER) { if (last) {
#pragma unroll
                for (int h = 0; h < 2; ++h)
#pragma unroll
                    for (int i = 0; i < 2; ++i) gA[h][i] = gN[h][i]; } }
            PG8_WAIT_V(8); PG8_WAIT_L(0); PG8_BAR; PG8_MMA(0, 0, At, B0); PG8_MMA(0, 1, At, B1); PG8_BAR; PG8_SCHED;
            PG8_LDA(At, 0, 1); PG8_STAGE_B(PG8_SB(0, 0), b2); PG8_STAGE_B(PG8_SB(0, 1), b2 + hstepB); PG8_STAGE_A(PG8_SA(0, 0), a2, 0);
            PG8_WAIT_V(8); PG8_WAIT_L(0); PG8_BAR; PG8_MMA(1, 0, At, B0); PG8_MMA(1, 1, At, B1); PG8_BAR; PG8_SCHED;
            PG8_LDB(B0, 1, 0); PG8_LDB(B1, 1, 1); PG8_SCHED; PG8_LDA(At, 1, 0); PG8_STAGE_A(PG8_SA(0, 1), a2, 1);
            PG8_WAIT_V(8); PG8_WAIT_L(0); PG8_BAR; PG8_MMA(0, 0, At, B0); PG8_MMA(0, 1, At, B1); PG8_BAR; PG8_SCHED;
            PG8_LDA(At, 1, 1); PG8_STAGE_B(PG8_SB(1, 0), b3); PG8_STAGE_B(PG8_SB(1, 1), b3 + hstepB); PG8_STAGE_A(PG8_SA(1, 0), a3, 0);
            PG8_WAIT_V(8); PG8_WAIT_L(0); PG8_BAR; PG8_MMA(1, 0, At, B0); PG8_MMA(1, 1, At, B1); PG8_BAR; PG8_SCHED;
        }
        if (wr == 0) PG8_BAR;
        E(acc, cur, wr, wc, fr, fq);
        if (!has_next) break;
#pragma unroll
        for (int a = 0; a < 2; ++a)
#pragma unroll
            for (int b = 0; b < 2; ++b)
#pragma unroll
                for (int m = 0; m < 4; ++m)
#pragma unroll
                    for (int n = 0; n < 2; ++n) acc[a][b][m][n] = (f32x4){0.f, 0.f, 0.f, 0.f};
        cur = nxt; cA = nA; cB = nB; ++ui;
        if (wr == 1) PG8_BAR;
    }
    PG8_WAIT_V(0);
    PG8_BAR;
#undef PG8_SA
#undef PG8_SB
#undef PG8_STAGE_A
#undef PG8_STAGE_B
#undef PG8_LDA
#undef PG8_LDB
#undef PG8_MMA
#undef PG8_WAIT_V
#undef PG8_WAIT_L
#undef PG8_BAR
#undef PG8_SCHED
#undef PG8_GLOAD
}
}

constexpr int NB = 4, SEQ = 4096, D = 2048, DEPTH = 2;
constexpr int T = NB * SEQ;
constexpr int NH = 8, HD = 128, DNW = 1024, CH = 64, NCH = SEQ / CH;
constexpr int PW = 1024, PG_DIM = 256;
constexpr int IN_COLS = 5136, NPROJ = 5120;
constexpr int NE = 16, DE = 1024, PLE = 256;
constexpr float ALPHA = 1.4142135623730951f;
constexpr float LN_EPS = 1e-5f, RMS_EPS = 1e-6f;
constexpr int LCAP = T;
constexpr int MAXTILES = 2 * T / 256 + NE;

constexpr size_t MiB = 1u << 20;
constexpr size_t WS_CTL = 0, CTL_ZERO_BYTES = 64 * 1024;
constexpr size_t WS_LIST = 2 * MiB;
constexpr size_t WS_TOKSLOT = 3 * MiB, WS_GATEW = WS_TOKSLOT + 128 * 1024, WS_STATS = WS_GATEW + 128 * 1024, WS_CD = WS_STATS + 128 * 1024, WS_WBA = WS_CD + 128 * 1024;
constexpr size_t WS_WIN = 4 * MiB, WS_WOUT = 44 * MiB, WS_WPG = 60 * MiB, WS_WPP = 76 * MiB, WS_WPOOL = 78 * MiB, WS_WGU = 80 * MiB, WS_WD = 336 * MiB, WS_PB16 = 464 * MiB;
constexpr size_t WS_XB = 480 * MiB, WS_R1 = 544 * MiB, WS_R2 = 704 * MiB, WS_R4 = 848 * MiB, WS_R5 = 944 * MiB, WS_END = 1008 * MiB;
constexpr size_t WS_PROJ = WS_R1, WS_HID = WS_R1;
constexpr size_t WS_Y = WS_R2;
constexpr size_t WS_POOLD = WS_R4, WS_PP = WS_R4 + 32 * MiB, WS_X1B = WS_R2;
constexpr size_t WS_MIXIN = WS_R5, WS_X2B = WS_R5;
static_assert((size_t)MAXTILES * 256 * 2048 * 2 <= 144 * MiB && (size_t)MAXTILES * 256 * 1024 * 2 <= 160 * MiB, "MoE row buffers");
constexpr int CW_TMO = 0, CW_CODE = 1, CW_CNT = 64  , CW_BAR = 4096;

constexpr int RING_OFF = 0, RING_BYTES = 131072;
constexpr int LDSCTL_OFF = 152 * 1024, MISC_OFF = LDSCTL_OFF + 320;
constexpr int AUX_OFF = LDSCTL_OFF + 1024;
constexpr int LDS_BYTES = 163840;
constexpr int NWAVES = 8;

#define RLX_AGENT __ATOMIC_RELAXED, __HIP_MEMORY_SCOPE_AGENT
#define LDS_WAIT() asm volatile("s_waitcnt lgkmcnt(0)" ::: "memory")
#define VM_WAIT() asm volatile("s_waitcnt vmcnt(0)" ::: "memory")
__device__ __forceinline__ unsigned f2bf(float f) { unsigned u = __builtin_bit_cast(unsigned, f); return (u + 0x7fffu + ((u >> 16) & 1u)) >> 16; }
__device__ __forceinline__ unsigned pk2(float lo, float hi) { return f2bf(lo) | (f2bf(hi) << 16); }
__device__ __forceinline__ float bf2f(unsigned short b) { return __builtin_bit_cast(float, ((unsigned)b) << 16); }
__device__ __forceinline__ float bflo(unsigned w) { return __builtin_bit_cast(float, w << 16); }
__device__ __forceinline__ float bfhi(unsigned w) { return __builtin_bit_cast(float, w & 0xffff0000u); }
__device__ __forceinline__ float sigmoidf_(float x) { return __builtin_amdgcn_rcpf(1.0f + __expf(-x)); }
__device__ __forceinline__ float wave_sum(float v) {
#pragma unroll
    for (int o = 1; o < 64; o <<= 1) v += __shfl_xor(v, o);
    return v;
}
#define XB_TMO      128
#define XB_XCNT(j)  (256  + 64 * (j))
#define XB_XSUB(j)  (1280 + 64 * (j))
#define XB_XGEN(j)  (2304 + 64 * (j))
#define XB_TOP      3328
#define XB_TOPGEN   3392
#define XCD_BAR_WORDS 3456
#define XB_SPIN_CAP (1u << 18)

__device__ __forceinline__ unsigned xb_ld(unsigned* p)              { return __hip_atomic_load(p, __ATOMIC_RELAXED, __HIP_MEMORY_SCOPE_AGENT); }
__device__ __forceinline__ unsigned xb_add(unsigned* p, unsigned v) { return __hip_atomic_fetch_add(p, v, __ATOMIC_RELAXED, __HIP_MEMORY_SCOPE_AGENT); }
__device__ __forceinline__ unsigned xb_xcc_id() { return (unsigned)__builtin_amdgcn_s_getreg((3 << 11) | 20) & 0xFu; }
#define XB_SPIN(cond, bar) do { unsigned _sp = 0; while (cond) { __builtin_amdgcn_s_sleep(1); \
    if ((++_sp & 255u) == 0u) { if (xb_ld(&(bar)[XB_TMO])) break; if (_sp > XB_SPIN_CAP) { atomicAdd(&(bar)[XB_TMO], 1u); break; } } } } while (0)

struct XcdBarrier {
    unsigned* bar; unsigned x;
    volatile LAS unsigned* st;
};

__device__ __forceinline__ XcdBarrier xcd_barrier_post(unsigned* bar, volatile LAS unsigned* st) {
    XcdBarrier b; b.bar = bar; b.x = xb_xcc_id(); b.st = st;
    if (threadIdx.x == 0) (void)xb_add(&bar[XB_XCNT(b.x)], 1u);
    return b;
}
__device__ __forceinline__ void xcd_barrier_complete(unsigned* bar, unsigned x, unsigned& nloc, unsigned& nx) {
    const unsigned G = gridDim.x * gridDim.y * gridDim.z;
    unsigned sum, cnt, mine, sp = 0u;
    for (;;) {
        sum = 0u; cnt = 0u; mine = 0u;
#pragma unroll
        for (unsigned j = 0; j < 16; ++j) { const unsigned c = xb_ld(&bar[XB_XCNT(j)]); sum += c; cnt += (c > 0u) ? 1u : 0u; mine = (j == x) ? c : mine; }
        if (sum == G) break;
        __builtin_amdgcn_s_sleep(1);
        if ((++sp & 255u) == 0u) { if (xb_ld(&bar[XB_TMO])) break; if (sp > XB_SPIN_CAP) { atomicAdd(&bar[XB_TMO], 1u); break; } }
    }
    nloc = mine > 0u ? mine : 1u; nx = cnt > 0u ? cnt : 1u;
}

__device__ __forceinline__ void xcd_barrier(const XcdBarrier& b) {
    asm volatile("s_waitcnt vmcnt(0)" ::: "memory");
    __syncthreads();
    if (threadIdx.x == 0) {
        unsigned* bar = b.bar;
        __builtin_amdgcn_s_waitcnt(0);
        unsigned nloc = b.st[0], nx = b.st[1];
        if (nloc == 0u) { xcd_barrier_complete(bar, b.x, nloc, nx); b.st[0] = nloc; b.st[1] = nx; }
        const unsigned old = xb_add(&bar[XB_XSUB(b.x)], 1u);
        const unsigned gen = old / nloc;
        if (old + 1u == (gen + 1u) * nloc) {
            __builtin_amdgcn_fence(__ATOMIC_RELEASE, "agent");
            asm volatile("s_waitcnt vmcnt(0)" ::: "memory");
            const unsigned og = xb_add(&bar[XB_TOP], 1u);
            const unsigned tg = og / nx;
            if (og + 1u == (tg + 1u) * nx) xb_add(&bar[XB_TOPGEN], 1u);
            else XB_SPIN(xb_ld(&bar[XB_TOPGEN]) == tg, bar);
            __builtin_amdgcn_fence(__ATOMIC_ACQUIRE, "agent");
            xb_add(&bar[XB_XGEN(b.x)], 1u);
            asm volatile("s_waitcnt vmcnt(0)" ::: "memory");
        } else {
            XB_SPIN(xb_ld(&bar[XB_XGEN(b.x)]) == gen, bar);
            __builtin_amdgcn_fence(__ATOMIC_ACQUIRE, "agent");
            asm volatile("s_waitcnt vmcnt(0)" ::: "memory");
        }
    }
    __syncthreads();
}

struct Args { const float* in[21]; float* out; unsigned char* ws; int ph_lo, ph_hi, li, pad; };
enum { I_X = 0, I_P, I_WIN, I_CONVW, I_ALOG, I_DTB, I_NORMW, I_POOLW, I_POOLS, I_WOUT, I_LN1G, I_LN1B, I_WR, I_BR, I_WEG, I_WEU, I_WED, I_LN2G, I_LN2B, I_WPP, I_WPG };
struct Frame {
    LAS unsigned char* lds;
    volatile LAS unsigned* MISC;
    gu32* ctl;
    int tid, lane, wave, vcu, G;
};

#define PHASE_FRAME(F0) Frame F = F0; { int t_ = threadIdx.x; asm volatile("" : "+v"(t_)); F.tid = t_; F.lane = t_ & 63; }
#define OPQ_S(p) asm volatile("" : "+s"(p))
#define OPQ_G(T, expr) ({ GAS T* g_ = (GAS T*)(expr); asm volatile("" : "+s"(g_)); (T*)g_; })
struct SchedDense {
    int nM, nN, nwg, G, c; const char* A; const char* B; size_t astep, bstep;
    __device__ __forceinline__ void init(int M, int N, int G_, int c_, const void* A_, int lda, const void* B_, int ldb) { nM = M / 256; nN = N / 256; nwg = nM * nN; G = G_; c = c_;
        A = (const char*)A_; B = (const char*)B_; astep = (size_t)256 * lda * 2; bstep = (size_t)256 * ldb * 2; }
    __device__ __forceinline__ bool next(int i, pg8::Unit& u) const {
        const long L = (long)i * G + c; if (L >= nwg) return false;
        int wgid = (int)L; { const int q = nwg / 8, r = nwg % 8, xcd = wgid % 8, off = wgid / 8; wgid = (xcd < r ? xcd * (q + 1) : r * (q + 1) + (xcd - r) * q) + off; }
        const int nig = 8 * nN, gid = wgid / nig, fm = gid * 8, gsz = (nM - fm) < 8 ? (nM - fm) : 8;
        u.pm = fm + ((wgid % nig) % gsz); u.pn = (wgid % nig) / gsz;
        u.A = A + (size_t)u.pm * astep; u.B = B + (size_t)u.pn * bstep; u.rows = nullptr; u.nvalid = 256; u.aux = 0; return true;
    }
};
struct SchedPool {
    int G, c; const char* A; const char* B;
    __device__ __forceinline__ bool next(int i, pg8::Unit& u) const {
        const int L = i * G + c; if (L >= 256) return false;
        u.pm = L >> 2; u.pn = L & 3; u.A = A + ((size_t)u.pm * 256 * PW + u.pn * 256) * 2; u.B = B + (size_t)u.pn * 65536 * 2; u.rows = nullptr; u.nvalid = 256; u.aux = 0; return true;
    }
};
struct SchedMoe {
    int G, c, mode; const LAS int* tab; const char* A; const char* B; const int* list;
    __device__ __forceinline__ bool next(int i, pg8::Unit& u) const {
        const int L = i * G + c, rt = L >> 3, pn = L & 7;
        const int ntiles = __builtin_amdgcn_readfirstlane(tab[16]); if (rt >= ntiles) return false;
        int e = 0;
#pragma unroll
        for (int k = 1; k < 16; ++k) { const int ts = __builtin_amdgcn_readfirstlane(tab[k]); if (rt >= ts) e = k; }
        const int ts = __builtin_amdgcn_readfirstlane(tab[e]), cn = __builtin_amdgcn_readfirstlane(tab[32 + e]);
        const int r0 = (rt - ts) * 256;
        u.pm = rt; u.pn = pn; u.aux = e;
        if (mode == 0) { u.A = A; u.rows = list + (size_t)e * LCAP + r0; u.nvalid = (cn - r0) < 256 ? (cn - r0) : 256; u.B = B + ((size_t)e * 2048 + pn * 256) * 2048 * 2; }
        else { u.A = A + (size_t)rt * 256 * DE * 2; u.rows = nullptr; u.nvalid = 256; u.B = B + ((size_t)e * 2048 + pn * 256) * DE * 2; }
        return true;
    }
};

using pg8::cvt_pk_bf16;
struct EpiBf16 {
    static constexpr bool PERM = true; bf16* O; int ldc;
    __device__ __forceinline__ void operator()(const f32x4 (&acc)[2][2][4][2], const pg8::Unit& u, int wr, int wc, int fr, int fq) const {
        const int row0 = u.pm * 256 + wr * 64 + fr, col0 = u.pn * 256 + wc * 32 + 8 * fq;
#pragma unroll
        for (int ai = 0; ai < 2; ++ai)
#pragma unroll
            for (int m = 0; m < 4; ++m) { bf16* rowp = O + (size_t)(row0 + ai * 128 + m * 16) * ldc + col0;
#pragma unroll
                for (int bj = 0; bj < 2; ++bj) { const f32x4 v0 = acc[ai][bj][m][0], v1 = acc[ai][bj][m][1];
                    v4u w; w.x = cvt_pk_bf16(v0[0], v0[1]); w.y = cvt_pk_bf16(v0[2], v0[3]); w.z = cvt_pk_bf16(v1[0], v1[1]); w.w = cvt_pk_bf16(v1[2], v1[3]);
                    *(v4u*)(rowp + bj * 128) = w; } }
    }
};
struct EpiPool {
    static constexpr bool PERM = true; bf16* O; const float* scale;
    __device__ __forceinline__ void operator()(const f32x4 (&acc)[2][2][4][2], const pg8::Unit& u, int wr, int wc, int fr, int fq) const {
        const int row0 = u.pm * 256 + wr * 64 + fr, cg = u.pn * 256 + wc * 32 + 8 * fq;
        f32x4 sv[2][2];
#pragma unroll
        for (int bj = 0; bj < 2; ++bj) { sv[bj][0] = *(const f32x4*)(scale + cg + bj * 128); sv[bj][1] = *(const f32x4*)(scale + cg + bj * 128 + 4); }
#pragma unroll
        for (int ai = 0; ai < 2; ++ai)
#pragma unroll
            for (int m = 0; m < 4; ++m) { bf16* rowp = O + (size_t)(row0 + ai * 128 + m * 16) * D + DNW + cg;
#pragma unroll
                for (int bj = 0; bj < 2; ++bj) { const f32x4 v0 = acc[ai][bj][m][0] * sv[bj][0], v1 = acc[ai][bj][m][1] * sv[bj][1];
                    v4u w; w.x = cvt_pk_bf16(v0[0], v0[1]); w.y = cvt_pk_bf16(v0[2], v0[3]); w.z = cvt_pk_bf16(v1[0], v1[1]); w.w = cvt_pk_bf16(v1[2], v1[3]);
                    *(v4u*)(rowp + bj * 128) = w; } }
    }
};
struct EpiRes {
    static constexpr bool PERM = true; const bf16* XB; bf16* PRE;
    __device__ __forceinline__ void operator()(const f32x4 (&acc)[2][2][4][2], const pg8::Unit& u, int wr, int wc, int fr, int fq) const {
        const int row0 = u.pm * 256 + wr * 64 + fr, col0 = u.pn * 256 + wc * 32 + 8 * fq;
#pragma unroll
        for (int ai = 0; ai < 2; ++ai)
#pragma unroll
            for (int m = 0; m < 4; ++m) { const size_t off0 = (size_t)(row0 + ai * 128 + m * 16) * D + col0;
#pragma unroll
                for (int bj = 0; bj < 2; ++bj) { const size_t off = off0 + bj * 128; const v4u x = *(const v4u*)(XB + off); const f32x4 a0 = acc[ai][bj][m][0], a1 = acc[ai][bj][m][1];
                    v4u w; w.x = cvt_pk_bf16(bflo(x.x) * ALPHA + a0[0], bfhi(x.x) * ALPHA + a0[1]); w.y = cvt_pk_bf16(bflo(x.y) * ALPHA + a0[2], bfhi(x.y) * ALPHA + a0[3]);
                    w.z = cvt_pk_bf16(bflo(x.z) * ALPHA + a1[0], bfhi(x.z) * ALPHA + a1[1]); w.w = cvt_pk_bf16(bflo(x.w) * ALPHA + a1[2], bfhi(x.w) * ALPHA + a1[3]);
                    *(v4u*)(PRE + off) = w; } }
    }
};
struct EpiSwiglu {
    static constexpr bool PERM = true; bf16* O;
    __device__ __forceinline__ void operator()(const f32x4 (&acc)[2][2][4][2], const pg8::Unit& u, int wr, int wc, int fr, int fq) const {
        const int row0 = u.pm * 256 + wr * 64 + fr, col0 = u.pn * 128 + wc * 32 + 8 * fq;
#pragma unroll
        for (int ai = 0; ai < 2; ++ai)
#pragma unroll
            for (int m = 0; m < 4; ++m) { bf16* rowp = O + (size_t)(row0 + ai * 128 + m * 16) * DE + col0;
                float h[8];
#pragma unroll
                for (int n = 0; n < 2; ++n)
#pragma unroll
                    for (int j = 0; j < 4; ++j) { const float g = acc[ai][0][m][n][j], up = acc[ai][1][m][n][j]; h[4 * n + j] = g * sigmoidf_(g) * up; }
                v4u w; w.x = cvt_pk_bf16(h[0], h[1]); w.y = cvt_pk_bf16(h[2], h[3]); w.z = cvt_pk_bf16(h[4], h[5]); w.w = cvt_pk_bf16(h[6], h[7]);
                *(v4u*)rowp = w; }
    }
};
struct EpiPle {
    static constexpr bool PERM = true; const bf16* X2B; const bf16* PP; bf16* XB; float* OUT; int last;
    __device__ __forceinline__ void operator()(const f32x4 (&acc)[2][2][4][2], const pg8::Unit& u, int wr, int wc, int fr, int fq) const {
        const int row0 = u.pm * 256 + wr * 64 + fr, col0 = u.pn * 256 + wc * 32 + 8 * fq;
#pragma unroll
        for (int ai = 0; ai < 2; ++ai)
#pragma unroll
            for (int m = 0; m < 4; ++m) { const size_t off0 = (size_t)(row0 + ai * 128 + m * 16) * D + col0;
#pragma unroll
                for (int bj = 0; bj < 2; ++bj) { const size_t off = off0 + bj * 128;
                    const v4u xx = *(const v4u*)(X2B + off), pp = *(const v4u*)(PP + off);
                    const f32x4 a0 = acc[ai][bj][m][0], a1 = acc[ai][bj][m][1];
                    f32x4 o0, o1;
                    o0[0] = bflo(xx.x) + sigmoidf_(a0[0]) * bflo(pp.x); o0[1] = bfhi(xx.x) + sigmoidf_(a0[1]) * bfhi(pp.x); o0[2] = bflo(xx.y) + sigmoidf_(a0[2]) * bflo(pp.y); o0[3] = bfhi(xx.y) + sigmoidf_(a0[3]) * bfhi(pp.y);
                    o1[0] = bflo(xx.z) + sigmoidf_(a1[0]) * bflo(pp.z); o1[1] = bfhi(xx.z) + sigmoidf_(a1[1]) * bfhi(pp.z); o1[2] = bflo(xx.w) + sigmoidf_(a1[2]) * bflo(pp.w); o1[3] = bfhi(xx.w) + sigmoidf_(a1[3]) * bfhi(pp.w);
                    if (last) { *(f32x4*)(OUT + off) = o0; *(f32x4*)(OUT + off + 4) = o1; }
                    else { v4u w; w.x = cvt_pk_bf16(o0[0], o0[1]); w.y = cvt_pk_bf16(o0[2], o0[3]); w.z = cvt_pk_bf16(o1[0], o1[1]); w.w = cvt_pk_bf16(o1[2], o1[3]); *(v4u*)(XB + off) = w; } } }
    }
};

__device__ __forceinline__ void tr_item(const float* W, int ldw, int k0, int n0, bf16* WT, size_t drow0, int ldt, LAS float* scr, int lane) {
#pragma unroll 8
    for (int i = 0; i < 32; ++i) { const int kk = 2 * i + (lane >> 5); scr[kk * 33 + (lane & 31)] = W[(size_t)(k0 + kk) * ldw + n0 + (lane & 31)]; }
    LDS_WAIT(); asm volatile("" ::: "memory");
    const int c = lane & 7;
#pragma unroll
    for (int j = 0; j < 4; ++j) { const int n = (lane >> 3) + 8 * j; const LAS float* s = scr + (8 * c) * 33 + n;
        v4u o; o.x = pk2(s[0 * 33], s[1 * 33]); o.y = pk2(s[2 * 33], s[3 * 33]); o.z = pk2(s[4 * 33], s[5 * 33]); o.w = pk2(s[6 * 33], s[7 * 33]);
        *(GAS v4u*)(WT + (drow0 + n) * ldt + k0 + 8 * c) = o; }
    LDS_WAIT(); asm volatile("" ::: "memory");
}
__device__ __forceinline__ void p0_prologue(const Frame& F0, const Args& a) {
    PHASE_FRAME(F0);
    LAS float* scr = (LAS float*)(F.lds + RING_OFF + F.wave * 16384);
    const int gw = F.vcu * NWAVES + F.wave, NGW = F.G * NWAVES;
    unsigned char* ws = OPQ_G(unsigned char, a.ws);
    constexpr int I_INA = 32 * 128, I_INB = 32 * 32, I_OUT = 32 * 64, I_PG = 32 * 64, I_PP = 4 * 64, I_POOL = 4 * 32, I_EG = NE * 32 * 32, I_EU = I_EG, I_ED = NE * 16 * 64;
    constexpr int I_LAYER = I_INA + I_INB + I_OUT + I_PG + I_PP + I_POOL + I_EG + I_EU + I_ED;
    for (int it = gw; it < DEPTH * I_LAYER; it += NGW) {
        const int l = it / I_LAYER; int r = it - l * I_LAYER;
        if (r < I_INA) { const int kb = r / 128, nb = r % 128; tr_item(a.in[I_WIN] + (size_t)l * D * IN_COLS, IN_COLS, 64 * kb, 32 * nb, (bf16*)(ws + WS_WIN) + (size_t)l * NPROJ * D, 32 * nb, D, scr, F.lane); continue; } r -= I_INA;
        if (r < I_INB) { const int kb = r / 32, nb = r % 32; tr_item(a.in[I_WIN] + (size_t)l * D * IN_COLS, IN_COLS, 64 * kb, 4112 + 32 * nb, (bf16*)(ws + WS_WIN) + (size_t)l * NPROJ * D, 4096 + 32 * nb, D, scr, F.lane); continue; } r -= I_INB;
        if (r < I_OUT) { const int kb = r / 64, nb = r % 64; tr_item(a.in[I_WOUT] + (size_t)l * D * D, D, 64 * kb, 32 * nb, (bf16*)(ws + WS_WOUT) + (size_t)l * D * D, 32 * nb, D, scr, F.lane); continue; } r -= I_OUT;
        if (r < I_PG) { const int kb = r / 64, nb = r % 64; tr_item(a.in[I_WPG] + (size_t)l * D * D, D, 64 * kb, 32 * nb, (bf16*)(ws + WS_WPG) + (size_t)l * D * D, 32 * nb, D, scr, F.lane); continue; } r -= I_PG;
        if (r < I_PP) { const int kb = r / 64, nb = r % 64; tr_item(a.in[I_WPP] + (size_t)l * PLE * D, D, 64 * kb, 32 * nb, (bf16*)(ws + WS_WPP) + (size_t)l * D * PLE, 32 * nb, PLE, scr, F.lane); continue; } r -= I_PP;
        if (r < I_POOL) { const int g = r / 32, rr = r % 32, kb = rr / 8, nb = rr % 8; tr_item(a.in[I_POOLW] + ((size_t)l * 4 + g) * 65536, 256, 64 * kb, 32 * nb, (bf16*)(ws + WS_WPOOL) + ((size_t)l * 4 + g) * 65536, 32 * nb, 256, scr, F.lane); continue; } r -= I_POOL;
        if (r < I_EG) { const int e = r / 1024, rr = r % 1024, kb = rr / 32, nb = rr % 32, h0 = 32 * nb;
            tr_item(a.in[I_WEG] + ((size_t)l * NE + e) * D * DE, DE, 64 * kb, h0, (bf16*)(ws + WS_WGU) + ((size_t)l * NE + e) * 2048 * D, (size_t)(h0 >> 7) * 256 + (h0 & 127), D, scr, F.lane); continue; } r -= I_EG;
        if (r < I_EU) { const int e = r / 1024, rr = r % 1024, kb = rr / 32, nb = rr % 32, h0 = 32 * nb;
            tr_item(a.in[I_WEU] + ((size_t)l * NE + e) * D * DE, DE, 64 * kb, h0, (bf16*)(ws + WS_WGU) + ((size_t)l * NE + e) * 2048 * D, (size_t)(h0 >> 7) * 256 + 128 + (h0 & 127), D, scr, F.lane); continue; } r -= I_EU;
        { const int e = r / 1024, rr = r % 1024, kb = rr / 64, nb = rr % 64;
            tr_item(a.in[I_WED] + ((size_t)l * NE + e) * DE * D, D, 64 * kb, 32 * nb, (bf16*)(ws + WS_WD) + ((size_t)l * NE + e) * D * DE, 32 * nb, DE, scr, F.lane); }
    }
    const size_t gt = (size_t)F.vcu * 512 + F.tid, NGT = (size_t)F.G * 512;
    { const GAS f32x4* src = (const GAS f32x4*)a.in[I_X]; GAS v4u* dst = (GAS v4u*)(ws + WS_XB);
        for (size_t i = gt; i < (size_t)T * D / 8; i += NGT) { const f32x4 v0 = src[2 * i], v1 = src[2 * i + 1]; v4u o; o.x = pk2(v0[0], v0[1]); o.y = pk2(v0[2], v0[3]); o.z = pk2(v1[0], v1[1]); o.w = pk2(v1[2], v1[3]); dst[i] = o; } }
    { const GAS f32x4* src = (const GAS f32x4*)a.in[I_P]; GAS v4u* dst = (GAS v4u*)(ws + WS_PB16);
        for (size_t i = gt; i < (size_t)DEPTH * T * PLE / 8; i += NGT) { const f32x4 v0 = src[2 * i], v1 = src[2 * i + 1]; v4u o; o.x = pk2(v0[0], v0[1]); o.y = pk2(v0[2], v0[3]); o.z = pk2(v1[0], v1[1]); o.w = pk2(v1[2], v1[3]); dst[i] = o; } }
    for (size_t i = gt; i < (size_t)DEPTH * 16 * D; i += NGT) { const int l = (int)(i / (16 * D)), j = (int)((i / D) % 16), k = (int)(i % D);
        ((bf16*)(ws + WS_WBA))[i] = (bf16)f2bf(a.in[I_WIN][((size_t)l * D + k) * IN_COLS + 4096 + j]); }
}

typedef float f32x16 __attribute__((ext_vector_type(16)));
typedef __bf16 bf2_t __attribute__((ext_vector_type(2)));
__device__ __forceinline__ unsigned pkbf(float lo, float hi) { const f32x2 v = {lo, hi}; return __builtin_bit_cast(unsigned, __builtin_convertvector(v, bf2_t)); }
#define MFMA32(a_, b_, c_) __builtin_amdgcn_mfma_f32_32x32x16_bf16((a_), (b_), (c_), 0, 0, 0)
#define PACK8(x, sp) __builtin_bit_cast(bf16x8, (v4u){pkbf((x)[8 * (sp)], (x)[8 * (sp) + 1]), pkbf((x)[8 * (sp) + 2], (x)[8 * (sp) + 3]), pkbf((x)[8 * (sp) + 4], (x)[8 * (sp) + 5]), pkbf((x)[8 * (sp) + 6], (x)[8 * (sp) + 7])})
#define RAW_BAR() do { asm volatile("s_waitcnt lgkmcnt(0)" ::: "memory"); __builtin_amdgcn_s_barrier(); asm volatile("" ::: "memory"); } while (0)
constexpr int IMG_ELEMS = 56 * 512, UIMG_ELEMS = 8 * 1024;
constexpr int FR_WN = 0, FR_QD = 16, FR_AQK = 32, FR_KDT = 40;
constexpr size_t WS_IMG = WS_R2, WS_UIMG = WS_R2 + 112 * MiB;
static_assert((size_t)NB * NCH * NH * IMG_ELEMS * 2 == 112 * MiB && (size_t)NB * NCH * NH * UIMG_ELEMS * 2 == 32 * MiB, "DeltaNet images");

constexpr int PQF = 0, PKF = 33792, PQS = 67584, PKS = 84992, PVT = 102400, PKT = 120832, PTAB = 139264;
constexpr int PAS = PQF;
constexpr int PTB = PKF, PT11T = PKF + 9216, PPART = PKF;
constexpr int F_LD = 132, S_LD = 136, T_LD = 72, A_LD = 68, TT_LD = 40;
__device__ __forceinline__ void phase_dn_prep(const Frame& F0, const Args& a, int layer) {
    PHASE_FRAME(F0);
    unsigned char* ws = OPQ_G(unsigned char, a.ws);
    LAS unsigned char* lds = F.lds;
    LAS float* Qf = (LAS float*)(lds + PQF); LAS float* Kf = (LAS float*)(lds + PKF); LAS float* As = (LAS float*)(lds + PAS);
    LAS bf16* Qs = (LAS bf16*)(lds + PQS); LAS bf16* Ks = (LAS bf16*)(lds + PKS); LAS bf16* Vt = (LAS bf16*)(lds + PVT); LAS bf16* Kt = (LAS bf16*)(lds + PKT);
    LAS bf16* Tb = (LAS bf16*)(lds + PTB); LAS bf16* T11t = (LAS bf16*)(lds + PT11T);
    LAS float* betaS = (LAS float*)(lds + PTAB); LAS float* gS = betaS + 512; LAS float* gamh = gS + 512; LAS float* betah = gamh + 64; LAS float* egam = betah + 64; LAS float* bgam = egam + 64; LAS float* ekd = bgam + 64; LAS float* rkS = ekd + 64;
    const bf16* XB = (const bf16*)(ws + WS_XB); const bf16* PROJ = (const bf16*)(ws + WS_PROJ); const bf16* WBA = (const bf16*)(ws + WS_WBA) + (size_t)layer * 16 * D;
    bf16* IMG = (bf16*)(ws + WS_IMG); bf16* UIMG = (bf16*)(ws + WS_UIMG); float* CD = (float*)(ws + WS_CD); bf16* POOLD = (bf16*)(ws + WS_POOLD);
    const float* convw = a.in[I_CONVW] + (size_t)layer * 4 * 3072; const float* alog = a.in[I_ALOG] + layer * NH; const float* dtb = a.in[I_DTB] + layer * NH;
    const int tid = F.tid, lane = F.lane, wave = F.wave, c32 = lane & 31, hf = lane >> 5;
    for (int unit = F.vcu; unit < NB * NCH; unit += F.G) {
        const int b = unit / NCH, n = unit % NCH, r0 = b * SEQ + n * CH, sq0 = n * CH;
        { const int col = 2 * tid, wsel = col >> 8; const bf16* up = PROJ + (size_t)r0 * NPROJ + 4096 + col; bf16* dp = POOLD + (size_t)r0 * PW + col;
#define POOL_BODY(WIN) do { unsigned xr[CH + WIN - 1]; \
            _Pragma("unroll") for (int j = 0; j < WIN - 1; ++j) xr[j] = (sq0 - (WIN - 1) + j >= 0) ? *(const unsigned*)(up + (ptrdiff_t)(j - (WIN - 1)) * NPROJ) : 0u; \
            _Pragma("unroll") for (int i = 0; i < CH; ++i) xr[WIN - 1 + i] = *(const unsigned*)(up + (size_t)i * NPROJ); \
            float s0 = 0.f, s1 = 0.f; \
            _Pragma("unroll") for (int j = 0; j < WIN - 1; ++j) { s0 += bflo(xr[j]); s1 += bfhi(xr[j]); } \
            _Pragma("unroll") for (int i = 0; i < CH; ++i) { const float x0 = bflo(xr[WIN - 1 + i]), x1 = bfhi(xr[WIN - 1 + i]); s0 += x0; s1 += x1; \
                const int pos = sq0 + i; const float inv = 1.0f / (float)((pos + 1) < WIN ? (pos + 1) : WIN); \
                *(unsigned*)(dp + (size_t)i * PW) = pkbf(s0 * inv - x0, s1 * inv - x1); s0 -= bflo(xr[i]); s1 -= bfhi(xr[i]); } } while (0)
            if (wsel == 0) POOL_BODY(2); else if (wsel == 1) POOL_BODY(4); else if (wsel == 2) POOL_BODY(8); else POOL_BODY(16);
#undef POOL_BODY
        }
        { typedef float f32x4v __attribute__((ext_vector_type(4)));
            const int fr = lane & 15, fg = lane >> 4; f32x4v pacc[4];
#pragma unroll
            for (int mt = 0; mt < 4; ++mt) pacc[mt] = (f32x4v){0.f, 0.f, 0.f, 0.f};
#pragma unroll 2
            for (int s = 0; s < 8; ++s) { const int k0 = 256 * wave + 32 * s + 8 * fg;
                const bf16x8 bfr = *(const bf16x8*)(WBA + (size_t)fr * D + k0);
#pragma unroll
                for (int mt = 0; mt < 4; ++mt) { const bf16x8 afr = *(const bf16x8*)(XB + (size_t)(r0 + 16 * mt + fr) * D + k0); pacc[mt] = __builtin_amdgcn_mfma_f32_16x16x32_bf16(afr, bfr, pacc[mt], 0, 0, 0); } }
            LAS float* part = (LAS float*)(lds + PPART) + wave * 1024;
#pragma unroll
            for (int mt = 0; mt < 4; ++mt)
#pragma unroll
                for (int r = 0; r < 4; ++r) part[(16 * mt + 4 * fg + r) * 16 + fr] = pacc[mt][r]; }
        __syncthreads();
        { const int tok = tid >> 3, cp = tid & 7; float s0 = 0.f, s1 = 0.f;
#pragma unroll
            for (int w = 0; w < 8; ++w) { const f32x2 p2 = *(const LAS f32x2*)((LAS float*)(lds + PPART) + w * 1024 + tok * 16 + 2 * cp); s0 += p2[0]; s1 += p2[1]; }
            if (cp < 4) { betaS[tok * 8 + 2 * cp] = sigmoidf_(s0); betaS[tok * 8 + 2 * cp + 1] = sigmoidf_(s1); }
            else { const int h = 2 * (cp - 4); const float z0 = s0 + dtb[h], z1 = s1 + dtb[h + 1];
                const float sp0 = z0 > 20.f ? z0 : log1pf(__expf(z0)), sp1 = z1 > 20.f ? z1 : log1pf(__expf(z1));
                gS[tok * 8 + h] = -__expf(alog[h]) * sp0; gS[tok * 8 + h + 1] = -__expf(alog[h + 1]) * sp1; } }
        __syncthreads();
        if (tid < 8) { float run = 0.f; for (int t = 0; t < CH; ++t) { run += gS[t * 8 + tid]; gS[t * 8 + tid] = run; } }
        __syncthreads();
        unsigned craw[3][11];
#define PREP_LOADRAW(hh) do { const int cp_ = tid & 63, i0_ = (tid >> 6) * 8; \
            _Pragma("unroll") for (int part_ = 0; part_ < 3; ++part_) { const bf16* src_ = PROJ + (size_t)(r0 + i0_ - 3) * NPROJ + part_ * 1024 + (hh) * HD + 2 * cp_; \
                _Pragma("unroll") for (int j_ = 0; j_ < 11; ++j_) craw[part_][j_] = (sq0 + i0_ - 3 + j_ >= 0) ? *(const unsigned*)(src_ + (ptrdiff_t)j_ * NPROJ) : 0u; } } while (0)
        PREP_LOADRAW(0);
        for (int h = 0; h < NH; ++h) {
            const size_t chd = (size_t)unit * NH + h; bf16* img = IMG + chd * IMG_ELEMS; bf16* uimg = UIMG + chd * UIMG_ELEMS;
            if (tid < 64) { const float gi = gS[tid * 8 + h], bi = betaS[tid * 8 + h], eg = __expf(gi); gamh[tid] = gi; betah[tid] = bi; egam[tid] = eg; bgam[tid] = bi * eg; ekd[tid] = __expf(gS[63 * 8 + h] - gi); }
            RAW_BAR();
            { const int cp = tid & 63, rg8 = tid >> 6, i0 = rg8 * 8;
#pragma unroll
                for (int part = 0; part < 3; ++part) { const int col = part * 1024 + h * HD + 2 * cp;
                    const f32x2 cw0 = *(const f32x2*)(convw + col), cw1 = *(const f32x2*)(convw + 3072 + col), cw2 = *(const f32x2*)(convw + 2 * 3072 + col), cw3 = *(const f32x2*)(convw + 3 * 3072 + col);
                    float ya[8], yb[8];
#pragma unroll
                    for (int i = 0; i < 8; ++i) { const unsigned x3 = craw[part][i], x2 = craw[part][i + 1], x1 = craw[part][i + 2], x0 = craw[part][i + 3];
                        const float ta = cw0[0] * bflo(x3) + cw1[0] * bflo(x2) + cw2[0] * bflo(x1) + cw3[0] * bflo(x0), tb = cw0[1] * bfhi(x3) + cw1[1] * bfhi(x2) + cw2[1] * bfhi(x1) + cw3[1] * bfhi(x0);
                        ya[i] = ta * sigmoidf_(ta); yb[i] = tb * sigmoidf_(tb); }
                    if (part == 0) {
#pragma unroll
                        for (int i = 0; i < 8; ++i) *(LAS f32x2*)(Qf + (i0 + i) * F_LD + 2 * cp) = (f32x2){ya[i], yb[i]}; }
                    else if (part == 1) {
#pragma unroll
                        for (int i = 0; i < 8; ++i) *(LAS f32x2*)(Kf + (i0 + i) * F_LD + 2 * cp) = (f32x2){ya[i], yb[i]}; }
                    else { v4u o0, o1;
                        o0.x = pkbf(ya[0] * betah[i0 + 0], ya[1] * betah[i0 + 1]); o0.y = pkbf(ya[2] * betah[i0 + 2], ya[3] * betah[i0 + 3]); o0.z = pkbf(ya[4] * betah[i0 + 4], ya[5] * betah[i0 + 5]); o0.w = pkbf(ya[6] * betah[i0 + 6], ya[7] * betah[i0 + 7]);
                        o1.x = pkbf(yb[0] * betah[i0 + 0], yb[1] * betah[i0 + 1]); o1.y = pkbf(yb[2] * betah[i0 + 2], yb[3] * betah[i0 + 3]); o1.z = pkbf(yb[4] * betah[i0 + 4], yb[5] * betah[i0 + 5]); o1.w = pkbf(yb[6] * betah[i0 + 6], yb[7] * betah[i0 + 7]);
                        *(LAS v4u*)(Vt + (2 * cp) * T_LD + i0) = o0; *(LAS v4u*)(Vt + (2 * cp + 1) * T_LD + i0) = o1; } }
                if (h + 1 < NH) PREP_LOADRAW(h + 1); }
            { const int i = tid >> 3, part = tid & 7; const LAS float* qp = Qf + i * F_LD + part * 16; const LAS float* kp = Kf + i * F_LD + part * 16;
                f32x4 qv[4], kv[4]; float sq = 0.f, sk = 0.f;
#pragma unroll
                for (int j = 0; j < 4; ++j) { qv[j] = *(const LAS f32x4*)(qp + 4 * j); kv[j] = *(const LAS f32x4*)(kp + 4 * j);
                    sq += (qv[j][0] * qv[j][0] + qv[j][1] * qv[j][1]) + (qv[j][2] * qv[j][2] + qv[j][3] * qv[j][3]); sk += (kv[j][0] * kv[j][0] + kv[j][1] * kv[j][1]) + (kv[j][2] * kv[j][2] + kv[j][3] * kv[j][3]); }
                sq += __shfl_xor(sq, 1); sq += __shfl_xor(sq, 2); sq += __shfl_xor(sq, 4); sk += __shfl_xor(sk, 1); sk += __shfl_xor(sk, 2); sk += __shfl_xor(sk, 4);
                const float rq = 1.0f / sqrtf(sq + RMS_EPS) * 0.08838834764831845f, rk = 1.0f / sqrtf(sk + RMS_EPS);
                if (part == 0) rkS[i] = rk;
#pragma unroll
                for (int j = 0; j < 4; ++j) { qv[j] = qv[j] * rq; kv[j] = kv[j] * rk; }
                v4u w0, w1;
                w0.x = pkbf(qv[0][0], qv[0][1]); w0.y = pkbf(qv[0][2], qv[0][3]); w0.z = pkbf(qv[1][0], qv[1][1]); w0.w = pkbf(qv[1][2], qv[1][3]); w1.x = pkbf(qv[2][0], qv[2][1]); w1.y = pkbf(qv[2][2], qv[2][3]); w1.z = pkbf(qv[3][0], qv[3][1]); w1.w = pkbf(qv[3][2], qv[3][3]);
                *(LAS v4u*)(Qs + i * S_LD + part * 16) = w0; *(LAS v4u*)(Qs + i * S_LD + part * 16 + 8) = w1;
                w0.x = pkbf(kv[0][0], kv[0][1]); w0.y = pkbf(kv[0][2], kv[0][3]); w0.z = pkbf(kv[1][0], kv[1][1]); w0.w = pkbf(kv[1][2], kv[1][3]); w1.x = pkbf(kv[2][0], kv[2][1]); w1.y = pkbf(kv[2][2], kv[2][3]); w1.z = pkbf(kv[3][0], kv[3][1]); w1.w = pkbf(kv[3][2], kv[3][3]);
                *(LAS v4u*)(Ks + i * S_LD + part * 16) = w0; *(LAS v4u*)(Ks + i * S_LD + part * 16 + 8) = w1;
                const float eg = egam[i]; bf16* fq = img + ((size_t)(FR_QD + (i >> 5) * 8 + part) * 64 + (i & 31)) * 8;
                v4u h0, h1;
                h0.x = pkbf(qv[0][0] * eg, qv[0][1] * eg); h0.y = pkbf(qv[0][2] * eg, qv[0][3] * eg); h0.z = pkbf(qv[2][0] * eg, qv[2][1] * eg); h0.w = pkbf(qv[2][2] * eg, qv[2][3] * eg);
                h1.x = pkbf(qv[1][0] * eg, qv[1][1] * eg); h1.y = pkbf(qv[1][2] * eg, qv[1][3] * eg); h1.z = pkbf(qv[3][0] * eg, qv[3][1] * eg); h1.w = pkbf(qv[3][2] * eg, qv[3][3] * eg);
                *(v4u*)fq = h0; *(v4u*)(fq + 32 * 8) = h1; }
            RAW_BAR();
            { const int c = tid & 127, rg = tid >> 7; float kb[16], kd[16];
#pragma unroll
                for (int i = 0; i < 16; ++i) { const int t = rg * 16 + i; const float kn = Kf[t * F_LD + c] * rkS[t]; kb[i] = kn * bgam[t]; kd[i] = kn * ekd[t]; }
                v4u o0, o1;
                o0.x = pkbf(kb[0], kb[1]); o0.y = pkbf(kb[2], kb[3]); o0.z = pkbf(kb[4], kb[5]); o0.w = pkbf(kb[6], kb[7]); o1.x = pkbf(kb[8], kb[9]); o1.y = pkbf(kb[10], kb[11]); o1.z = pkbf(kb[12], kb[13]); o1.w = pkbf(kb[14], kb[15]);
                *(LAS v4u*)(Kt + c * T_LD + rg * 16) = o0; *(LAS v4u*)(Kt + c * T_LD + rg * 16 + 8) = o1;
                bf16* fk = img + ((size_t)(FR_KDT + (c >> 5) * 4 + rg) * 64 + (c & 31)) * 8;
                v4u h0, h1;
                h0.x = pkbf(kd[0], kd[1]); h0.y = pkbf(kd[2], kd[3]); h0.z = pkbf(kd[8], kd[9]); h0.w = pkbf(kd[10], kd[11]);
                h1.x = pkbf(kd[4], kd[5]); h1.y = pkbf(kd[6], kd[7]); h1.z = pkbf(kd[12], kd[13]); h1.w = pkbf(kd[14], kd[15]);
                *(v4u*)fk = h0; *(v4u*)(fk + 32 * 8) = h1; }
            RAW_BAR();
            if (wave < 6) { const int pr = wave % 3, iskk = wave / 3, mt = pr == 2 ? 1 : 0, nt = pr == 0 ? 0 : 1;
                const LAS bf16* xs = iskk ? Ks : Qs; f32x16 d;
#pragma unroll
                for (int r = 0; r < 16; ++r) d[r] = 0.f;
#pragma unroll
                for (int s = 0; s < 8; ++s) { const bf16x8 af = *(const LAS bf16x8*)(Ks + (32 * mt + c32) * S_LD + 16 * s + 8 * hf), bfr = *(const LAS bf16x8*)(xs + (32 * nt + c32) * S_LD + 16 * s + 8 * hf); d = MFMA32(af, bfr, d); }
                const int i = 32 * nt + c32; const float gi = gamh[i], bi = betah[i];
#pragma unroll
                for (int r = 0; r < 16; ++r) { const int j = 32 * mt + (r & 3) + 8 * (r >> 2) + 4 * hf; const float de = __expf(gi - gamh[j]);
                    d[r] = iskk ? ((j < i) ? bi * d[r] * de : 0.f) : ((j <= i) ? d[r] * de : 0.f); }
                if (iskk) {
#pragma unroll
                    for (int qd = 0; qd < 4; ++qd) *(LAS f32x4*)(As + i * A_LD + 32 * mt + 8 * qd + 4 * hf) = (f32x4){d[4 * qd], d[4 * qd + 1], d[4 * qd + 2], d[4 * qd + 3]}; }
                else {
#pragma unroll
                    for (int sp = 0; sp < 2; ++sp) *(bf16x8*)(img + ((size_t)(FR_AQK + nt * 4 + 2 * mt + sp) * 64 + lane) * 8) = PACK8(d, sp); } }
            RAW_BAR();
            if (wave == 0) { float Tc[32];
                unsigned asb = (unsigned)(uintptr_t)(As + (32 * hf) * A_LD + 32 * hf); int cb = c32; asm volatile("" : "+v"(asb), "+v"(cb));
                const LAS float* Ab = (const LAS float*)(uintptr_t)asb;
#pragma unroll
                for (int i = 0; i < 32; ++i) { float ac[4] = {(i == cb) ? 1.f : 0.f, 0.f, 0.f, 0.f};
#pragma unroll
                    for (int j4 = 0; j4 < (i + 3) / 4; ++j4) { const f32x4 a4 = *(const LAS f32x4*)(Ab + i * A_LD + 4 * j4);
#pragma unroll
                        for (int q = 0; q < 4; ++q) if (4 * j4 + q < i) ac[q] -= a4[q] * Tc[4 * j4 + q]; }
                    Tc[i] = (ac[0] + ac[1]) + (ac[2] + ac[3]); }
#pragma unroll
                for (int i = 0; i < 32; ++i) Tb[(32 * hf + i) * T_LD + 32 * hf + c32] = (bf16)(pkbf(Tc[i], 0.f) & 0xffffu);
                if (hf == 0) {
#pragma unroll
                    for (int q = 0; q < 4; ++q) { v4u o; o.x = pkbf(Tc[8 * q], Tc[8 * q + 1]); o.y = pkbf(Tc[8 * q + 2], Tc[8 * q + 3]); o.z = pkbf(Tc[8 * q + 4], Tc[8 * q + 5]); o.w = pkbf(Tc[8 * q + 6], Tc[8 * q + 7]); *(LAS v4u*)(T11t + c32 * TT_LD + 8 * q) = o; } }
                asm volatile("s_waitcnt lgkmcnt(0)" ::: "memory");
                f32x16 x;
#pragma unroll
                for (int r = 0; r < 16; ++r) x[r] = 0.f;
#pragma unroll
                for (int s = 0; s < 2; ++s) { const LAS float* ap = As + (32 + c32) * A_LD + 16 * s + 8 * hf; const f32x4 a0 = *(const LAS f32x4*)ap, a1 = *(const LAS f32x4*)(ap + 4);
                    const bf16x8 af = __builtin_bit_cast(bf16x8, (v4u){pkbf(a0[0], a0[1]), pkbf(a0[2], a0[3]), pkbf(a1[0], a1[1]), pkbf(a1[2], a1[3])});
                    const bf16x8 bfr = *(const LAS bf16x8*)(T11t + c32 * TT_LD + 16 * s + 8 * hf); x = MFMA32(af, bfr, x); }
                f32x16 t21;
#pragma unroll
                for (int r = 0; r < 16; ++r) t21[r] = 0.f;
#pragma unroll
                for (int s = 0; s < 2; ++s) { const LAS bf16* tp = Tb + (32 + c32) * T_LD + 32 + 16 * s + 4 * hf; const v2u lo = *(const LAS v2u*)tp, hi = *(const LAS v2u*)(tp + 8);
                    const bf16x8 af = __builtin_bit_cast(bf16x8, (v4u){lo.x, lo.y, hi.x, hi.y}); const bf16x8 bfr = PACK8(x, s); t21 = MFMA32(af, bfr, t21); }
#pragma unroll
                for (int r = 0; r < 16; ++r) Tb[(32 + (r & 3) + 8 * (r >> 2) + 4 * hf) * T_LD + c32] = (bf16)(pkbf(-t21[r], 0.f) & 0xffffu);
            }
            RAW_BAR();
            if (wave < 4) {
#pragma unroll
                for (int mt = 0; mt < 2; ++mt) { f32x16 d;
#pragma unroll
                    for (int r = 0; r < 16; ++r) d[r] = 0.f;
#pragma unroll
                    for (int s = 0; s < 4; ++s) if (s < 2 * (mt + 1)) { const bf16x8 af = *(const LAS bf16x8*)(Tb + (32 * mt + c32) * T_LD + 16 * s + 8 * hf), bfr = *(const LAS bf16x8*)(Vt + (32 * wave + c32) * T_LD + 16 * s + 8 * hf); d = MFMA32(af, bfr, d); }
                    bf16* up = uimg + ((size_t)(wave * 2 + mt) * 64 + lane) * 16; *(bf16x8*)up = PACK8(d, 0); *(bf16x8*)(up + 8) = PACK8(d, 1); } }
            else { const int ct = wave - 4;
#pragma unroll
                for (int nt = 0; nt < 2; ++nt) { f32x16 d;
#pragma unroll
                    for (int r = 0; r < 16; ++r) d[r] = 0.f;
#pragma unroll
                    for (int s = 0; s < 4; ++s) if (s < 2 * (nt + 1)) { const bf16x8 af = *(const LAS bf16x8*)(Kt + (32 * ct + c32) * T_LD + 16 * s + 8 * hf), bfr = *(const LAS bf16x8*)(Tb + (32 * nt + c32) * T_LD + 16 * s + 8 * hf); d = MFMA32(af, bfr, d); }
#pragma unroll
                    for (int r = 0; r < 16; ++r) d[r] = -d[r];
#pragma unroll
                    for (int sp = 0; sp < 2; ++sp) *(bf16x8*)(img + ((size_t)(FR_WN + nt * 8 + 2 * ct + sp) * 64 + lane) * 8) = PACK8(d, sp); } }
            if (tid == 0) CD[chd] = egam[63];
            RAW_BAR();
        }
#undef PREP_LOADRAW
    }
}

__host__ __device__ constexpr int sc_p(int k) { const int j = k - 32; return j < 12 ? j % 6 : (j - 12) % 5; }
__host__ __device__ constexpr int sc_slab(int k) { const int j = k - 32; return k < 32 ? (k >> 2) : (j < 12 ? j / 6 : 2 + (j - 12) / 5); }
__host__ __device__ constexpr int sc_kind(int k) { return k < 32 ? ((k & 3) < 2 ? 0 : 1) : ((sc_p(k) == 2 || sc_p(k) == 5) ? 1 : 2); }
__host__ __device__ constexpr int sc_idx(int k) { return k < 32 ? (k & 1) : (sc_p(k) == 0 ? 0 : sc_p(k) == 1 ? 1 : sc_p(k) == 2 ? 1 : sc_p(k) == 3 ? 2 : sc_p(k) == 4 ? 3 : 0); }
__host__ __device__ constexpr int sc_frag(int k) { return k < 32 ? (((k & 3) < 2 ? FR_WN : FR_QD) + (k & 1) * 8 + (k >> 2)) : (sc_kind(k) == 1 ? FR_AQK + sc_idx(k) * 4 + sc_slab(k) : FR_KDT + sc_idx(k) * 4 + sc_slab(k)); }
constexpr int SC_QD = 8;
constexpr int SCB = 57344, OT_OFF = 2 * SCB, OT_LD = 136, OT_BYTES = 64 * OT_LD * 2;
static_assert(OT_OFF + 2 * OT_BYTES <= 152 * 1024, "scan LDS");
__device__ __forceinline__ void phase_dn_scan(const Frame& F0, const Args& a, int layer, int unit) {
    PHASE_FRAME(F0);
    unsigned char* ws = OPQ_G(unsigned char, a.ws);
    LAS unsigned char* lds = F.lds;
    const int b = unit >> 3, h = unit & 7, lane = F.lane;
    const bf16* IMG = (const bf16*)(ws + WS_IMG); const bf16* UIMG = (const bf16*)(ws + WS_UIMG); const float* CD = (const float*)(ws + WS_CD);
    const size_t chd0 = (size_t)b * NCH * NH + h;
    if (F.wave < 4) {
#ifndef SCAN_NO_COMPUTE
        const int w = F.wave, c32 = lane & 31, hf = lane >> 5;
        f32x16 S0, S1, S2, S3;
#pragma unroll
        for (int r = 0; r < 16; ++r) { S0[r] = 0.f; S1[r] = 0.f; S2[r] = 0.f; S3[r] = 0.f; }
        const float cdl = CD[chd0 + (size_t)lane * NH];
        v4u UA[4];
        const __amdgpu_buffer_rsrc_t rsU = __builtin_amdgcn_make_buffer_rsrc((void*)(UIMG + chd0 * UIMG_ELEMS), (short)0, NCH * NH * UIMG_ELEMS * 2, 0x00020000);
        const unsigned uoff = (unsigned)((w * 2) * 64 + lane) * 32u;
#define SC_LOADU(dst, nn) do { _Pragma("unroll") for (int mt_ = 0; mt_ < 2; ++mt_) { _Pragma("unroll") for (int hh_ = 0; hh_ < 2; ++hh_) dst[2 * mt_ + hh_] = __builtin_amdgcn_raw_buffer_load_b128(rsU, uoff + (unsigned)(mt_ * 2048 + hh_ * 16), (unsigned)(nn) * (unsigned)(NH * UIMG_ELEMS * 2), 0); } } while (0)
#define SC_FRAG(bufoff, fi) (*(const LAS bf16x8*)(lds + (bufoff) + (fi) * 1024 + lane * 16))
#define SC_CHUNK(nn, U, bufoff, otoff) do { \
        f32x16 aV0, aV1, aO0, aO1; bf16x8 fq0, fq1, fq2, fq3, fq4, fq5, fq6, fq7, Sbs, Vb0, Vb1, Vb2, Vb3; \
        _Pragma("unroll") for (int q = 0; q < 4; ++q) { aV0[2 * q] = bflo(U[0][q]); aV0[2 * q + 1] = bfhi(U[0][q]); aV0[8 + 2 * q] = bflo(U[1][q]); aV0[8 + 2 * q + 1] = bfhi(U[1][q]); \
            aV1[2 * q] = bflo(U[2][q]); aV1[2 * q + 1] = bfhi(U[2][q]); aV1[8 + 2 * q] = bflo(U[3][q]); aV1[8 + 2 * q + 1] = bfhi(U[3][q]); } \
        _Pragma("unroll") for (int r = 0; r < 16; ++r) { aO0[r] = 0.f; aO1[r] = 0.f; } \
        if ((nn) + 1 < NCH) SC_LOADU(U, (nn) + 1); \
        const float cd = __builtin_bit_cast(float, __builtin_amdgcn_readlane(__builtin_bit_cast(int, cdl), (nn))); \
        fq0 = SC_FRAG(bufoff, 0); \
        fq1 = SC_FRAG(bufoff, 8); \
        fq2 = SC_FRAG(bufoff, 16); \
        fq3 = SC_FRAG(bufoff, 24); \
        fq4 = SC_FRAG(bufoff, 1); \
        fq5 = SC_FRAG(bufoff, 9); \
        fq6 = SC_FRAG(bufoff, 17); \
        fq7 = SC_FRAG(bufoff, 25); \
        Sbs = PACK8(S0, 0); \
        aV0 = MFMA32(fq0, Sbs, aV0); \
        fq0 = SC_FRAG(bufoff, 2); \
        aV1 = MFMA32(fq1, Sbs, aV1); \
        fq1 = SC_FRAG(bufoff, 10); \
        aO0 = MFMA32(fq2, Sbs, aO0); \
        fq2 = SC_FRAG(bufoff, 18); \
        aO1 = MFMA32(fq3, Sbs, aO1); \
        fq3 = SC_FRAG(bufoff, 26); \
        Sbs = PACK8(S0, 1); \
        aV0 = MFMA32(fq4, Sbs, aV0); \
        fq4 = SC_FRAG(bufoff, 3); \
        aV1 = MFMA32(fq5, Sbs, aV1); \
        fq5 = SC_FRAG(bufoff, 11); \
        aO0 = MFMA32(fq6, Sbs, aO0); \
        fq6 = SC_FRAG(bufoff, 19); \
        aO1 = MFMA32(fq7, Sbs, aO1); \
        fq7 = SC_FRAG(bufoff, 27); \
        Sbs = PACK8(S1, 0); \
        aV0 = MFMA32(fq0, Sbs, aV0); \
        fq0 = SC_FRAG(bufoff, 4); \
        aV1 = MFMA32(fq1, Sbs, aV1); \
        fq1 = SC_FRAG(bufoff, 12); \
        aO0 = MFMA32(fq2, Sbs, aO0); \
        fq2 = SC_FRAG(bufoff, 20); \
        aO1 = MFMA32(fq3, Sbs, aO1); \
        fq3 = SC_FRAG(bufoff, 28); \
        Sbs = PACK8(S1, 1); \
        aV0 = MFMA32(fq4, Sbs, aV0); \
        fq4 = SC_FRAG(bufoff, 5); \
        aV1 = MFMA32(fq5, Sbs, aV1); \
        fq5 = SC_FRAG(bufoff, 13); \
        aO0 = MFMA32(fq6, Sbs, aO0); \
        fq6 = SC_FRAG(bufoff, 21); \
        aO1 = MFMA32(fq7, Sbs, aO1); \
        fq7 = SC_FRAG(bufoff, 29); \
        Sbs = PACK8(S2, 0); \
        aV0 = MFMA32(fq0, Sbs, aV0); \
        fq0 = SC_FRAG(bufoff, 6); \
        aV1 = MFMA32(fq1, Sbs, aV1); \
        fq1 = SC_FRAG(bufoff, 14); \
        aO0 = MFMA32(fq2, Sbs, aO0); \
        fq2 = SC_FRAG(bufoff, 22); \
        aO1 = MFMA32(fq3, Sbs, aO1); \
        fq3 = SC_FRAG(bufoff, 30); \
        Sbs = PACK8(S2, 1); \
        aV0 = MFMA32(fq4, Sbs, aV0); \
        fq4 = SC_FRAG(bufoff, 7); \
        aV1 = MFMA32(fq5, Sbs, aV1); \
        fq5 = SC_FRAG(bufoff, 15); \
        aO0 = MFMA32(fq6, Sbs, aO0); \
        fq6 = SC_FRAG(bufoff, 23); \
        aO1 = MFMA32(fq7, Sbs, aO1); \
        fq7 = SC_FRAG(bufoff, 31); \
        Sbs = PACK8(S3, 0); \
        aV0 = MFMA32(fq0, Sbs, aV0); \
        fq0 = SC_FRAG(bufoff, 40); \
        aV1 = MFMA32(fq1, Sbs, aV1); \
        fq1 = SC_FRAG(bufoff, 44); \
        aO0 = MFMA32(fq2, Sbs, aO0); \
        fq2 = SC_FRAG(bufoff, 36); \
        aO1 = MFMA32(fq3, Sbs, aO1); \
        fq3 = SC_FRAG(bufoff, 48); \
        Sbs = PACK8(S3, 1); \
        aV0 = MFMA32(fq4, Sbs, aV0); \
        fq4 = SC_FRAG(bufoff, 52); \
        aV1 = MFMA32(fq5, Sbs, aV1); \
        fq5 = SC_FRAG(bufoff, 32); \
        S0 = S0 * cd; S1 = S1 * cd; S2 = S2 * cd; S3 = S3 * cd; \
        aO0 = MFMA32(fq6, Sbs, aO0); \
        fq6 = SC_FRAG(bufoff, 41); \
        aO1 = MFMA32(fq7, Sbs, aO1); \
        fq7 = SC_FRAG(bufoff, 45); \
        Vb0 = PACK8(aV0, 0); Vb1 = PACK8(aV0, 1); Vb2 = PACK8(aV1, 0); Vb3 = PACK8(aV1, 1); \
        S0 = MFMA32(fq0, Vb0, S0); \
        fq0 = SC_FRAG(bufoff, 37); \
        S1 = MFMA32(fq1, Vb0, S1); \
        fq1 = SC_FRAG(bufoff, 49); \
        aO1 = MFMA32(fq2, Vb0, aO1); \
        fq2 = SC_FRAG(bufoff, 53); \
        S2 = MFMA32(fq3, Vb0, S2); \
        fq3 = SC_FRAG(bufoff, 33); \
        S3 = MFMA32(fq4, Vb0, S3); \
        fq4 = SC_FRAG(bufoff, 42); \
        aO0 = MFMA32(fq5, Vb0, aO0); \
        fq5 = SC_FRAG(bufoff, 46); \
        S0 = MFMA32(fq6, Vb1, S0); \
        fq6 = SC_FRAG(bufoff, 38); \
        S1 = MFMA32(fq7, Vb1, S1); \
        fq7 = SC_FRAG(bufoff, 50); \
        aO1 = MFMA32(fq0, Vb1, aO1); \
        fq0 = SC_FRAG(bufoff, 54); \
        S2 = MFMA32(fq1, Vb1, S2); \
        fq1 = SC_FRAG(bufoff, 43); \
        S3 = MFMA32(fq2, Vb1, S3); \
        fq2 = SC_FRAG(bufoff, 47); \
        aO0 = MFMA32(fq3, Vb1, aO0); \
        fq3 = SC_FRAG(bufoff, 39); \
        S0 = MFMA32(fq4, Vb2, S0); \
        fq4 = SC_FRAG(bufoff, 51); \
        S1 = MFMA32(fq5, Vb2, S1); \
        fq5 = SC_FRAG(bufoff, 55); \
        aO1 = MFMA32(fq6, Vb2, aO1); \
        S2 = MFMA32(fq7, Vb2, S2); \
        S3 = MFMA32(fq0, Vb2, S3); \
        S0 = MFMA32(fq1, Vb3, S0); \
        S1 = MFMA32(fq2, Vb3, S1); \
        aO1 = MFMA32(fq3, Vb3, aO1); \
        S2 = MFMA32(fq4, Vb3, S2); \
        S3 = MFMA32(fq5, Vb3, S3); \
        _Pragma("unroll") for (int r = 0; r < 16; ++r) { \
            *(LAS bf16*)(lds + (otoff) + (((r & 3) + 8 * (r >> 2) + 4 * hf) * OT_LD + 32 * w + c32) * 2) = (bf16)(pkbf(aO0[r], 0.f) & 0xffffu); \
            *(LAS bf16*)(lds + (otoff) + ((32 + (r & 3) + 8 * (r >> 2) + 4 * hf) * OT_LD + 32 * w + c32) * 2) = (bf16)(pkbf(aO1[r], 0.f) & 0xffffu); } \
        RAW_BAR(); } while (0)
        SC_LOADU(UA, 0);
        RAW_BAR();
#pragma unroll 1
        for (int n = 0; n < NCH; n += 2) { SC_CHUNK(n, UA, 0, OT_OFF); SC_CHUNK(n + 1, UA, SCB, OT_OFF + OT_BYTES); }
#undef SC_CHUNK
#undef SC_FRAG
#undef SC_LOADU
#endif
    } else {
#ifndef SCAN_NO_HELPER
        const int ht = F.tid - 256, tok = ht >> 2, q = ht & 3;
        const bf16* PROJ = (const bf16*)(ws + WS_PROJ); bf16* MIXIN = (bf16*)(ws + WS_MIXIN);
        const float* nw = a.in[I_NORMW] + layer * HD + 32 * q; f32x4 nwv[8];
#pragma unroll
        for (int i = 0; i < 8; ++i) nwv[i] = *(const f32x4*)(nw + 4 * i);
        v4u RA[14], ZA[4];
        const __amdgpu_buffer_rsrc_t rsI = __builtin_amdgcn_make_buffer_rsrc((void*)(IMG + chd0 * IMG_ELEMS), (short)0, NCH * NH * IMG_ELEMS * 2, 0x00020000);
        const __amdgpu_buffer_rsrc_t rsZ = __builtin_amdgcn_make_buffer_rsrc((void*)(PROJ + (size_t)b * SEQ * NPROJ), (short)0, SEQ * NPROJ * 2, 0x00020000);
        const unsigned zoff = (unsigned)(tok * NPROJ + 3072 + h * HD + 32 * q) * 2u;
#define SH_LOADIMG(dst, nn) do { _Pragma("unroll") for (int i_ = 0; i_ < 14; ++i_) dst[i_] = __builtin_amdgcn_raw_buffer_load_b128(rsI, (unsigned)ht * 16u, (unsigned)(nn) * (unsigned)(NH * IMG_ELEMS * 2) + (unsigned)i_ * 4096u, 0); } while (0)
#define SH_STOREIMG(src, bufoff) do { LAS v4u* p_ = (LAS v4u*)(lds + (bufoff)) + ht; _Pragma("unroll") for (int i_ = 0; i_ < 14; ++i_) p_[i_ * 256] = src[i_]; } while (0)
#define SH_LOADZ(dst, nn) do { _Pragma("unroll") for (int i_ = 0; i_ < 4; ++i_) dst[i_] = __builtin_amdgcn_raw_buffer_load_b128(rsZ, zoff + 16u * (unsigned)i_, (unsigned)(nn) * (unsigned)(CH * NPROJ * 2), 0); } while (0)
#define SH_EPI(mm, Z, otoff) do { const LAS v4u* op_ = (const LAS v4u*)(lds + (otoff) + (tok * OT_LD + 32 * q) * 2); v4u ow[4]; float ss = 0.f; \
        _Pragma("unroll") for (int i_ = 0; i_ < 4; ++i_) { ow[i_] = op_[i_]; _Pragma("unroll") for (int j_ = 0; j_ < 4; ++j_) { const float x0 = bflo(ow[i_][j_]), x1 = bfhi(ow[i_][j_]); ss += x0 * x0 + x1 * x1; } } \
        ss += __shfl_xor(ss, 1); ss += __shfl_xor(ss, 2); const float rr = 1.0f / sqrtf(ss * (1.0f / HD) + RMS_EPS); \
        v4u* yp_ = (v4u*)(MIXIN + ((size_t)b * SEQ + (size_t)(mm) * CH + tok) * D + h * HD + 32 * q); \
        _Pragma("unroll") for (int i_ = 0; i_ < 4; ++i_) { __builtin_amdgcn_sched_barrier(0); v4u o_; const f32x4 n0 = nwv[2 * i_], n1 = nwv[2 * i_ + 1]; \
            _Pragma("unroll") for (int j_ = 0; j_ < 4; ++j_) { const float z0 = bflo(Z[i_][j_]), z1 = bfhi(Z[i_][j_]); const float g0 = (j_ < 2 ? n0[2 * j_] : n1[2 * j_ - 4]), g1 = (j_ < 2 ? n0[2 * j_ + 1] : n1[2 * j_ - 3]); \
            o_[j_] = pkbf(bflo(ow[i_][j_]) * rr * g0 * z0 * sigmoidf_(z0), bfhi(ow[i_][j_]) * rr * g1 * z1 * sigmoidf_(z1)); } yp_[i_] = o_; } } while (0)
#define SH_STEP(nn, bufnext, otprev) do { \
        if ((nn) + 1 < NCH) SH_STOREIMG(RA, bufnext); \
        if ((nn) + 2 < NCH) SH_LOADIMG(RA, (nn) + 2); \
        if ((nn) >= 1) SH_EPI((nn) - 1, ZA, otprev); \
        SH_LOADZ(ZA, (nn)); \
        RAW_BAR(); } while (0)
        SH_LOADIMG(RA, 0);
        SH_STOREIMG(RA, 0);
        SH_LOADIMG(RA, 1);
        RAW_BAR();
#pragma unroll 1
        for (int n = 0; n < NCH; n += 2) { SH_STEP(n, SCB, OT_OFF + OT_BYTES); SH_STEP(n + 1, 0, OT_OFF); }
        SH_EPI(NCH - 1, ZA, OT_OFF + OT_BYTES);
#undef SH_STEP
#undef SH_EPI
#undef SH_LOADZ
#undef SH_STOREIMG
#undef SH_LOADIMG
#endif
    }
}

__device__ __forceinline__ void phase_ln1_router(const Frame& F0, const Args& a, int layer) {
    PHASE_FRAME(F0);
    unsigned char* ws = OPQ_G(unsigned char, a.ws);
    LAS float* WRt = (LAS float*)F.lds;
    LAS int* rowE = (LAS int*)(F.lds + AUX_OFF); LAS int* rowP = rowE + 128; LAS float* rowG = (LAS float*)(rowP + 128); LAS int* lcnt = (LAS int*)(rowG + 128); LAS int* lbase = lcnt + 16;
    const float* wr = OPQ_G(const float, a.in[I_WR]); const float* br = OPQ_G(const float, a.in[I_BR]);
    for (int idx = F.tid; idx < D * NE; idx += 512) WRt[(idx & 15) * D + (idx >> 4)] = wr[idx];
    const bf16* PRE = (const bf16*)a.out; bf16* X1B = (bf16*)(ws + WS_X1B); float* STATS = (float*)(ws + WS_STATS);
    const float* g1 = a.in[I_LN1G] + (size_t)layer * D; const float* b1 = a.in[I_LN1B] + (size_t)layer * D;
    int* LIST = (int*)(ws + WS_LIST); int* TOKSLOT = (int*)(ws + WS_TOKSLOT); float* GATEW = (float*)(ws + WS_GATEW);
    gu32* cnt = F.ctl + CW_CNT + 64 * layer;
    float brv[16];
#pragma unroll
    for (int e = 0; e < 16; ++e) brv[e] = br[e];
    for (int rb = F.vcu; rb < T / 64; rb += F.G) {
        if (F.tid < 16) lcnt[F.tid] = 0;
        __syncthreads();
        for (int r = 0; r < 8; ++r) { const int lr = F.wave * 8 + r, row = rb * 64 + lr;
            const GAS v2u* xr = (const GAS v2u*)(PRE + (size_t)row * D) + F.lane;
            f32x4 v[8]; float s = 0.f;
#pragma unroll
            for (int j = 0; j < 8; ++j) { const v2u t = xr[64 * j]; v[j] = (f32x4){bflo(t.x), bfhi(t.x), bflo(t.y), bfhi(t.y)}; s += (v[j][0] + v[j][1]) + (v[j][2] + v[j][3]); }
            const float mean = wave_sum(s) * (1.f / D); float s2 = 0.f;
#pragma unroll
            for (int j = 0; j < 8; ++j) { v[j] = v[j] - mean; s2 += (v[j][0] * v[j][0] + v[j][1] * v[j][1]) + (v[j][2] * v[j][2] + v[j][3] * v[j][3]); }
            const float rstd = 1.f / sqrtf(wave_sum(s2) * (1.f / D) + LN_EPS);
            if (F.lane == 0) { STATS[2 * row] = mean; STATS[2 * row + 1] = rstd; }
            GAS v2u* o8 = (GAS v2u*)(X1B + (size_t)row * D) + F.lane;
            float lg[16];
#pragma unroll
            for (int e = 0; e < 16; ++e) lg[e] = 0.f;
#pragma unroll
            for (int j = 0; j < 8; ++j) { const f32x4 gg = *(const f32x4*)(g1 + 256 * j + 4 * F.lane), bb = *(const f32x4*)(b1 + 256 * j + 4 * F.lane);
                v[j] = v[j] * rstd * gg + bb;
                v2u w; w.x = pk2(v[j][0], v[j][1]); w.y = pk2(v[j][2], v[j][3]); o8[64 * j] = w;
#pragma unroll
                for (int e = 0; e < 16; ++e) { const f32x4 w4 = *(const LAS f32x4*)(WRt + e * D + 256 * j + 4 * F.lane); lg[e] += (v[j][0] * w4[0] + v[j][1] * w4[1]) + (v[j][2] * w4[2] + v[j][3] * w4[3]); } }
            float mx = -3.0e38f;
#pragma unroll
            for (int e = 0; e < 16; ++e) { lg[e] = wave_sum(lg[e]) + brv[e]; mx = fmaxf(mx, lg[e]); }
            float p[16];
#pragma unroll
            for (int e = 0; e < 16; ++e) p[e] = __expf(lg[e] - mx);
            float gsc[4];
#pragma unroll
            for (int g = 0; g < 4; ++g) { const float a0 = p[4 * g], a1 = p[4 * g + 1], a2 = p[4 * g + 2], a3 = p[4 * g + 3];
                const float hi1 = fmaxf(a0, a1), lo1 = fminf(a0, a1), hi2 = fmaxf(a2, a3), lo2 = fminf(a2, a3);
                gsc[g] = fmaxf(hi1, hi2) + fmaxf(fminf(hi1, hi2), fmaxf(lo1, lo2)); }
            int gsel = 0; float best = gsc[0];
#pragma unroll
            for (int g = 1; g < 4; ++g) if (gsc[g] > best) { best = gsc[g]; gsel = g; }
            float q[4];
#pragma unroll
            for (int j = 0; j < 4; ++j) q[j] = gsel == 0 ? p[j] : (gsel == 1 ? p[4 + j] : (gsel == 2 ? p[8 + j] : p[12 + j]));
            int i0 = 0; float p0 = q[0];
#pragma unroll
            for (int j = 1; j < 4; ++j) if (q[j] > p0) { p0 = q[j]; i0 = j; }
            int i1 = -1; float p1 = -1.f;
#pragma unroll
            for (int j = 0; j < 4; ++j) if (j != i0 && q[j] > p1) { p1 = q[j]; i1 = j; }
            if (F.lane == 0) { const int e0 = gsel * 4 + i0, e1 = gsel * 4 + i1; const float inv = 1.0f / (p0 + p1);
                rowE[2 * lr] = e0; rowE[2 * lr + 1] = e1; rowG[2 * lr] = p0 * inv; rowG[2 * lr + 1] = p1 * inv;
                rowP[2 * lr] = __hip_atomic_fetch_add(&lcnt[e0], 1, __ATOMIC_RELAXED, __HIP_MEMORY_SCOPE_WORKGROUP); rowP[2 * lr + 1] = __hip_atomic_fetch_add(&lcnt[e1], 1, __ATOMIC_RELAXED, __HIP_MEMORY_SCOPE_WORKGROUP); }
        }
        __syncthreads();
        if (F.tid < 16) lbase[F.tid] = (int)__hip_atomic_fetch_add(cnt + F.tid, (unsigned)lcnt[F.tid], RLX_AGENT);
        __syncthreads();
        if (F.tid < 128) { const int e = rowE[F.tid], pos = lbase[e] + rowP[F.tid], tok = rb * 64 + (F.tid >> 1);
            LIST[(size_t)e * LCAP + pos] = tok; TOKSLOT[2 * tok + (F.tid & 1)] = e * LCAP + pos; GATEW[2 * tok + (F.tid & 1)] = rowG[F.tid]; }
        __syncthreads();
    }
}
__device__ __forceinline__ void moe_table(const Frame& F0, int layer) {
    PHASE_FRAME(F0);
    LAS int* tab = (LAS int*)(F.lds + AUX_OFF);
    __syncthreads();
    if (F.tid < 16) tab[32 + F.tid] = (int)__hip_atomic_load(F.ctl + CW_CNT + 64 * layer + F.tid, RLX_AGENT);
    __syncthreads();
    if (F.tid == 0) { int run = 0; for (int e = 0; e < 16; ++e) { tab[e] = run; run += (tab[32 + e] + 255) >> 8; } tab[16] = run; }
    __syncthreads();
}
__device__ __forceinline__ void phase_combine_ln2(const Frame& F0, const Args& a, int layer) {
    PHASE_FRAME(F0);
    unsigned char* ws = OPQ_G(unsigned char, a.ws); const LAS int* tab = (const LAS int*)(F.lds + AUX_OFF);
    const bf16* PRE = (const bf16*)a.out; const float* STATS = (const float*)(ws + WS_STATS); const bf16* Y = (const bf16*)(ws + WS_Y); bf16* X2B = (bf16*)(ws + WS_X2B);
    const int* TOKSLOT = (const int*)(ws + WS_TOKSLOT); const float* GATEW = (const float*)(ws + WS_GATEW);
    const float* g1 = a.in[I_LN1G] + (size_t)layer * D; const float* b1 = a.in[I_LN1B] + (size_t)layer * D; const float* g2 = a.in[I_LN2G] + (size_t)layer * D; const float* b2 = a.in[I_LN2B] + (size_t)layer * D;
    const int gw = F.vcu * NWAVES + F.wave, NGW = F.G * NWAVES;
    for (int row = gw; row < T; row += NGW) {
        const float mean = STATS[2 * row], rstd = STATS[2 * row + 1];
        const int s0 = TOKSLOT[2 * row], s1 = TOKSLOT[2 * row + 1]; const float w0 = GATEW[2 * row], w1 = GATEW[2 * row + 1];
        const size_t y0 = (size_t)tab[s0 / LCAP] * 256 + (s0 % LCAP), y1 = (size_t)tab[s1 / LCAP] * 256 + (s1 % LCAP);
        const GAS v2u* xr = (const GAS v2u*)(PRE + (size_t)row * D) + F.lane; const GAS v2u* ya = (const GAS v2u*)(Y + y0 * D) + F.lane; const GAS v2u* yb = (const GAS v2u*)(Y + y1 * D) + F.lane;
        f32x4 v[8]; float s = 0.f;
#pragma unroll
        for (int j = 0; j < 8; ++j) { const f32x4 gg = *(const f32x4*)(g1 + 256 * j + 4 * F.lane), bb = *(const f32x4*)(b1 + 256 * j + 4 * F.lane);
            const v2u xt = xr[64 * j]; const f32x4 x1 = ((f32x4){bflo(xt.x), bfhi(xt.x), bflo(xt.y), bfhi(xt.y)} - mean) * rstd * gg + bb; const v2u pa = ya[64 * j], pb = yb[64 * j];
            f32x4 f; f[0] = w0 * bflo(pa.x) + w1 * bflo(pb.x); f[1] = w0 * bfhi(pa.x) + w1 * bfhi(pb.x); f[2] = w0 * bflo(pa.y) + w1 * bflo(pb.y); f[3] = w0 * bfhi(pa.y) + w1 * bfhi(pb.y);
            v[j] = x1 * ALPHA + f; s += (v[j][0] + v[j][1]) + (v[j][2] + v[j][3]); }
        const float m2 = wave_sum(s) * (1.f / D); float q = 0.f;
#pragma unroll
        for (int j = 0; j < 8; ++j) { v[j] = v[j] - m2; q += (v[j][0] * v[j][0] + v[j][1] * v[j][1]) + (v[j][2] * v[j][2] + v[j][3] * v[j][3]); }
        const float r2 = 1.f / sqrtf(wave_sum(q) * (1.f / D) + LN_EPS);
        GAS v2u* o8 = (GAS v2u*)(X2B + (size_t)row * D) + F.lane;
#pragma unroll
        for (int j = 0; j < 8; ++j) { const f32x4 gg = *(const f32x4*)(g2 + 256 * j + 4 * F.lane), bb = *(const f32x4*)(b2 + 256 * j + 4 * F.lane);
            const f32x4 o = v[j] * r2 * gg + bb; v2u w; w.x = pk2(o[0], o[1]); w.y = pk2(o[2], o[3]); o8[64 * j] = w; }
    }
}

#ifndef MK_N_LAUNCHES
#define MK_N_LAUNCHES 1
#endif
constexpr int NPL = 9;
constexpr int NPHASE = 1 + NPL * DEPTH;
constexpr int N_LAUNCHES = MK_N_LAUNCHES;
static_assert(N_LAUNCHES == 1 || N_LAUNCHES == NPHASE, "MK_N_LAUNCHES is 1 or NPHASE");

__global__ void __launch_bounds__(NWAVES * 64, 2) trunk_fwd(Args args) {
    extern __shared__ __attribute__((aligned(16))) unsigned char lds[];
    Frame F;
    F.lds = (LAS unsigned char*)lds;
    F.MISC = (volatile LAS unsigned*)(F.lds + MISC_OFF);
    F.tid = threadIdx.x; F.lane = F.tid & 63; F.wave = __builtin_amdgcn_readfirstlane(F.tid >> 6);
    F.G = gridDim.x; { const int bx = blockIdx.x; F.vcu = (F.G % 8 == 0) ? (bx % 8) * (F.G / 8) + bx / 8 : bx; }
    unsigned char* ws = args.ws;
    F.ctl = (gu32*)(ws + WS_CTL);
    for (int u = F.tid; u < (LDS_BYTES - LDSCTL_OFF) / 4; u += NWAVES * 64) ((LAS unsigned*)(F.lds + LDSCTL_OFF))[u] = 0u;
    __syncthreads();
    XcdBarrier bar; bar.bar = (unsigned*)(F.ctl + CW_BAR); bar.x = 0; bar.st = nullptr;
    if (N_LAUNCHES == 1) bar = xcd_barrier_post((unsigned*)(F.ctl + CW_BAR), F.MISC + 8);
#define GRID_BAR() do { if (N_LAUNCHES == 1) xcd_barrier(bar); } while (0)
    const int lo = args.ph_lo, hi = args.ph_hi;
#ifndef PH_MASK
#define PH_MASK 0x7ff
#endif
#define IN(k) ((((k) == 0 ? 1u : (2u << (((k) - 1) % NPL))) & (unsigned)(PH_MASK)) && lo <= (k) && (k) < hi)
#define SEAM(k) do { if (IN((k) + 1)) GRID_BAR(); } while (0)
#ifndef PROBE_DUP
#define PROBE_DUP 0
#endif
#define REPS(k) ((((k) == 0 ? 1u : (2u << (((k) - 1) % NPL))) & (unsigned)(PROBE_DUP)) ? 2 : 1)

    if (IN(0)) { for (int rep = 0; rep < REPS(0); ++rep) { if (rep) GRID_BAR(); p0_prologue(F, args); } SEAM(0); }

#ifdef LAYER_UNROLL
#pragma unroll
#else
#pragma unroll 1
#endif
    for (int layer = 0; layer < DEPTH; ++layer) {
        const int pb = 1 + NPL * layer;
        unsigned char* ws = OPQ_G(unsigned char, args.ws);
        if (IN(pb + 0)) { for (int rep = 0; rep < REPS(pb + 0); ++rep) { if (rep) GRID_BAR();
            SchedDense S; S.init(T, NPROJ, F.G, (int)blockIdx.x, ws + WS_XB, D, (const bf16*)(ws + WS_WIN) + (size_t)layer * NPROJ * D, D);
            EpiBf16 E{(bf16*)(ws + WS_PROJ), NPROJ};
            pg8::gemm_phase<EpiBf16, SchedDense, false>(F.lds + RING_OFF, D, D, D, S, E);
            } SEAM(pb + 0);
        }
        if (IN(pb + 1)) { for (int rep = 0; rep < REPS(pb + 1); ++rep) { if (rep) GRID_BAR(); phase_dn_prep(F, args, layer); } SEAM(pb + 1); }
        if (IN(pb + 2)) { for (int rep = 0; rep < REPS(pb + 2); ++rep) { if (rep) GRID_BAR();
            if (blockIdx.x < 32 || F.G <= 32) { for (int u = blockIdx.x; u < NB * NH; u += (F.G < 32 ? F.G : 32)) { phase_dn_scan(F, args, layer, u);
#ifdef SCAN_TWICE
                __syncthreads(); phase_dn_scan(F, args, layer, u);
#endif
            } }
            if (blockIdx.x >= 32 || F.G <= 32) { const int G2 = F.G <= 32 ? F.G : F.G - 32, c2 = F.G <= 32 ? (int)blockIdx.x : (int)blockIdx.x - 32;
                { SchedPool S{G2, c2, (const char*)(ws + WS_POOLD), (const char*)((const bf16*)(ws + WS_WPOOL) + (size_t)layer * 4 * 65536)};
                  EpiPool E{(bf16*)(ws + WS_MIXIN), args.in[I_POOLS] + (size_t)layer * PW};
                  pg8::gemm_phase<EpiPool, SchedPool, false>(F.lds + RING_OFF, 256, PW, 256, S, E); }
                { SchedDense S; S.init(T, D, G2, c2, (const bf16*)(ws + WS_PB16) + (size_t)layer * T * PLE, PLE, (const bf16*)(ws + WS_WPP) + (size_t)layer * D * PLE, PLE);
                  EpiBf16 E{(bf16*)(ws + WS_PP), D};
                  pg8::gemm_phase<EpiBf16, SchedDense, false>(F.lds + RING_OFF, PLE, PLE, PLE, S, E); } }
            } SEAM(pb + 2);
        }
        if (IN(pb + 3)) { for (int rep = 0; rep < REPS(pb + 3); ++rep) { if (rep) GRID_BAR();
            SchedDense S; S.init(T, D, F.G, (int)blockIdx.x, ws + WS_MIXIN, D, (const bf16*)(ws + WS_WOUT) + (size_t)layer * D * D, D);
            EpiRes E{(const bf16*)(ws + WS_XB), (bf16*)args.out};
            pg8::gemm_phase<EpiRes, SchedDense, false>(F.lds + RING_OFF, D, D, D, S, E);
            } SEAM(pb + 3);
        }
        if (IN(pb + 4)) { for (int rep = 0; rep < REPS(pb + 4); ++rep) { if (rep) GRID_BAR(); phase_ln1_router(F, args, layer); } SEAM(pb + 4); }
        if (IN(pb + 5)) { for (int rep = 0; rep < REPS(pb + 5); ++rep) { if (rep) GRID_BAR();
            moe_table(F, layer);
            SchedMoe S{F.G, (int)blockIdx.x, 0, (const LAS int*)(F.lds + AUX_OFF), (const char*)(ws + WS_X1B), (const char*)((const bf16*)(ws + WS_WGU) + (size_t)layer * NE * 2048 * D), (const int*)(ws + WS_LIST)};
            EpiSwiglu E{(bf16*)(ws + WS_HID)};
            pg8::gemm_phase<EpiSwiglu, SchedMoe, true>(F.lds + RING_OFF, D, D, D, S, E);
            } SEAM(pb + 5);
        }
        if (IN(pb + 6)) { for (int rep = 0; rep < REPS(pb + 6); ++rep) { if (rep) GRID_BAR();
            moe_table(F, layer);
            SchedMoe S{F.G, (int)blockIdx.x, 1, (const LAS int*)(F.lds + AUX_OFF), (const char*)(ws + WS_HID), (const char*)((const bf16*)(ws + WS_WD) + (size_t)layer * NE * D * DE), nullptr};
            EpiBf16 E{(bf16*)(ws + WS_Y), D};
            pg8::gemm_phase<EpiBf16, SchedMoe, false>(F.lds + RING_OFF, DE, DE, DE, S, E);
            } SEAM(pb + 6);
        }
        if (IN(pb + 7)) { for (int rep = 0; rep < REPS(pb + 7); ++rep) { if (rep) GRID_BAR(); moe_table(F, layer); phase_combine_ln2(F, args, layer); } SEAM(pb + 7); }
        if (IN(pb + 8)) { for (int rep = 0; rep < REPS(pb + 8); ++rep) { if (rep) GRID_BAR();
            { SchedDense S; S.init(T, D, F.G, (int)blockIdx.x, ws + WS_X2B, D, (const bf16*)(ws + WS_WPG) + (size_t)layer * D * D, D);
              EpiPle E{(const bf16*)(ws + WS_X2B), (const bf16*)(ws + WS_PP), (bf16*)(ws + WS_XB), args.out, layer + 1 < DEPTH ? 0 : 1};
              pg8::gemm_phase<EpiPle, SchedDense, false>(F.lds + RING_OFF, D, D, D, S, E); }
            } SEAM(pb + 8);
        }
    }
#undef IN
#undef SEAM
#undef GRID_BAR
}

extern "C" void kernel_launch(void* const* d_in, const int* in_sizes, int n_in, void* d_out, int out_size, void* d_ws, size_t ws_size, hipStream_t stream) {
    static int grid = 0;
    if (grid == 0) {
        if (n_in != 21 || in_sizes[0] != T * D || out_size != T * D || ws_size < WS_END) { fprintf(stderr, "kernel_launch: unexpected shapes (n_in %d, in0 %d, out %d, ws %zu); nothing launched\n", n_in, n_in > 0 ? in_sizes[0] : -1, out_size, ws_size); grid = -1; return; }
        int dev = 0, cus = 0, per_cu = 0;
        if (hipGetDevice(&dev) != hipSuccess || hipDeviceGetAttribute(&cus, hipDeviceAttributeMultiprocessorCount, dev) != hipSuccess) { grid = -1; return; }
        if (hipFuncSetAttribute((const void*)trunk_fwd, hipFuncAttributeMaxDynamicSharedMemorySize, LDS_BYTES) != hipSuccess) { fprintf(stderr, "kernel_launch: hipFuncSetAttribute failed\n"); grid = -1; return; }
        if (hipOccupancyMaxActiveBlocksPerMultiprocessor(&per_cu, (const void*)trunk_fwd, NWAVES * 64, LDS_BYTES) != hipSuccess || per_cu < 1) { fprintf(stderr, "kernel_launch: occupancy query reports %d workgroups per CU\n", per_cu); }
        (void)hipGetLastError();
        grid = cus;
    }
    if (grid < 0) return;
    if (hipMemsetAsync((char*)d_ws + WS_CTL, 0, CTL_ZERO_BYTES, stream) != hipSuccess) return;
    Args a{};
    for (int i = 0; i < 21; ++i) a.in[i] = (const float*)d_in[i];
    a.out = (float*)d_out; a.ws = (unsigned char*)d_ws;
    for (int li = 0; li < N_LAUNCHES; ++li) {
        a.ph_lo = (N_LAUNCHES == 1) ? 0 : li; a.ph_hi = (N_LAUNCHES == 1) ? NPHASE : li + 1; a.li = li; a.pad = 0;
        hipLaunchKernelGGL(trunk_fwd, dim3(grid), dim3(NWAVES * 64), LDS_BYTES, stream, a);
        const hipError_t le = hipPeekAtLastError();
        if (le != hipSuccess) { fprintf(stderr, "kernel_launch: launch %d failed: %s\n", li, hipGetErrorName(le)); break; }
    }
}
```

```cpp
#define MK_N_LAUNCHES 1
#define CONVERT_ALL_IN_PROLOGUE 1
#include <hip/hip_runtime.h>
#include <cstdio>
#include <cstdint>

#define GAS __attribute__((address_space(1)))
#define LAS __attribute__((address_space(3)))
typedef unsigned short bf16;
typedef unsigned v4u __attribute__((ext_vector_type(4)));
typedef unsigned v2u __attribute__((ext_vector_type(2)));
typedef float f32x4 __attribute__((ext_vector_type(4)));
typedef float f32x2 __attribute__((ext_vector_type(2)));
typedef short bf16x8 __attribute__((ext_vector_type(8)));
typedef GAS unsigned gu32;

namespace pg8 {
constexpr int BM = 256, BK = 64, HALF = 128, HTB = HALF * BK * 2  , STAGE_BYTES = 8 * HTB, NXCD = 8, WGM = 8;
__host__ __device__ __forceinline__ int lds_byte(int r, int c) { const int st = (r >> 4) * 2 + (c >> 5), rr = r & 15, cc = c & 31, ob = rr * 64 + cc * 2; return st * 1024 + (ob ^ (((ob >> 9) & 1) << 5)); }
__host__ __device__ __forceinline__ void stage_rc(int b, int& R, int& C) { const int st = b / 1024, sb = b % 1024, swz = sb ^ (((sb >> 9) & 1) << 5); R = (st >> 1) * 16 + swz / 64; C = (st & 1) * 32 + (swz % 64) / 2; }
__host__ __device__ __forceinline__ int perm32(int rho) { const int n = rho >> 4, i = rho & 15; return 8 * (i >> 2) + 4 * n + (i & 3); }

struct Unit { int pm, pn; const char* A; const char* B; const int* rows; int nvalid; int aux; };

__device__ __forceinline__ unsigned cvt_pk_bf16(float lo, float hi) { unsigned r; asm volatile("v_cvt_pk_bf16_f32 %0, %1, %2" : "=v"(r) : "v"(lo), "v"(hi)); return r; }

template <class Epi, class Sched, bool GATHER>
__device__ __forceinline__ void gemm_phase(LAS unsigned char* lds, const int K, const int lda, const int ldb, const Sched& S, const Epi& E) {
    int tid_ = threadIdx.x; asm volatile("" : "+v"(tid_));
    const int tid = tid_, wid = __builtin_amdgcn_readfirstlane(tid >> 6), lane = tid & 63, wr = wid >> 2, wc = wid & 3, fr = lane & 15, fq = lane >> 4;
    const int nt = K / BK;
    unsigned voffA[2], voffB[2]; int RA[2], CA[2];
#pragma unroll
    for (int i = 0; i < 2; ++i) { int R, C; stage_rc(tid * 16 + i * 8192, R, C); const int Rb = Epi::PERM ? ((R & ~31) + perm32(R & 31)) : R;
        RA[i] = R; CA[i] = C; voffA[i] = (unsigned)(R * lda + C) * 2u; voffB[i] = (unsigned)(Rb * ldb + C) * 2u; }
    unsigned gA[2][2], gN[2][2];
    const size_t kstep = (size_t)(BK * 2);
    const size_t hstepA = GATHER ? 0 : (size_t)HALF * lda * 2, hstepB = (size_t)HALF * ldb * 2;
    const unsigned ldsw = (unsigned)wid * 1024u;
    const int aoff = lds_byte(wr * 64 + fr, fq * 8), boff = lds_byte(wc * 32 + fr, fq * 8);
#define PG8_SA(b, h) (((b) * 2 + (h)) * HTB)
#define PG8_SB(b, h) ((4 + (b) * 2 + (h)) * HTB)
#define PG8_STAGE_B(bufoff, gbase) do { _Pragma("unroll") for (int _i = 0; _i < 2; ++_i) \
        __builtin_amdgcn_global_load_lds((const unsigned*)((const char*)(gbase) + voffB[_i]), (LAS unsigned*)(lds + (bufoff) + ldsw + _i * 8192), 16, 0, 0); } while (0)
#define PG8_STAGE_A(bufoff, gbase, h) do { _Pragma("unroll") for (int _i = 0; _i < 2; ++_i) \
        __builtin_amdgcn_global_load_lds((const unsigned*)((const char*)(gbase) + (GATHER ? gA[h][_i] : voffA[_i]) + (h) * hstepA), (LAS unsigned*)(lds + (bufoff) + ldsw + _i * 8192), 16, 0, 0); } while (0)
#define PG8_LDA(dst, b, h) do { _Pragma("unroll") for (int m = 0; m < 4; ++m) _Pragma("unroll") for (int k = 0; k < 2; ++k) dst[m][k] = *(const LAS bf16x8*)(lds + PG8_SA(b, h) + aoff + m * 2048 + k * 1024); } while (0)
#define PG8_LDB(dst, b, h) do { _Pragma("unroll") for (int n = 0; n < 2; ++n) _Pragma("unroll") for (int k = 0; k < 2; ++k) dst[n][k] = *(const LAS bf16x8*)(lds + PG8_SB(b, h) + boff + n * 2048 + k * 1024); } while (0)
#define PG8_MMA(ai, bj, At, Bt) do { __builtin_amdgcn_s_setprio(1); _Pragma("unroll") for (int m = 0; m < 4; ++m) _Pragma("unroll") for (int n = 0; n < 2; ++n) _Pragma("unroll") for (int k = 0; k < 2; ++k) \
        acc[ai][bj][m][n] = __builtin_amdgcn_mfma_f32_16x16x32_bf16(Bt[n][k], At[m][k], acc[ai][bj][m][n], 0, 0, 0); __builtin_amdgcn_s_setprio(0); } while (0)
#define PG8_WAIT_V(n) asm volatile("s_waitcnt vmcnt(" #n ")" ::: "memory")
#define PG8_WAIT_L(n) asm volatile("s_waitcnt lgkmcnt(" #n ")" ::: "memory")
#define PG8_BAR __builtin_amdgcn_s_barrier()
#define PG8_SCHED __builtin_amdgcn_sched_barrier(0)
#define PG8_GLOAD(dst, u) do { _Pragma("unroll") for (int _h = 0; _h < 2; ++_h) _Pragma("unroll") for (int _i = 0; _i < 2; ++_i) { const int _r = _h * HALF + RA[_i]; \
        const int _t = (_r < (u).nvalid) ? (u).rows[_r] : 0; dst[_h][_i] = (unsigned)(_t * lda + CA[_i]) * 2u; } } while (0)
    Unit cur, nxt; int ui = 0;
    if (!S.next(0, cur)) return;
    f32x4 acc[2][2][4][2];
#pragma unroll
    for (int a = 0; a < 2; ++a)
#pragma unroll
        for (int b = 0; b < 2; ++b)
#pragma unroll
            for (int m = 0; m < 4; ++m)
#pragma unroll
                for (int n = 0; n < 2; ++n) acc[a][b][m][n] = (f32x4){0.f, 0.f, 0.f, 0.f};
    bf16x8 At[4][2], B0[2][2], B1[2][2];
    const char* cA = cur.A; const char* cB = cur.B;
    if constexpr (GATHER) { PG8_GLOAD(gA, cur); PG8_WAIT_V(0); }
    PG8_STAGE_B(PG8_SB(0, 0), cB); PG8_STAGE_B(PG8_SB(0, 1), cB + hstepB); PG8_STAGE_A(PG8_SA(0, 0), cA, 0); PG8_STAGE_A(PG8_SA(0, 1), cA, 1);
    if (wr == 1) PG8_BAR;
    PG8_WAIT_V(2); PG8_BAR;
    PG8_STAGE_B(PG8_SB(1, 0), cB + kstep); PG8_STAGE_A(PG8_SA(1, 0), cA + kstep, 0); PG8_STAGE_B(PG8_SB(1, 1), cB + hstepB + kstep);
    PG8_WAIT_V(6); PG8_BAR;
    for (;;) {
        const bool has_next = S.next(ui + 1, nxt);
        const char* nA = has_next ? nxt.A : cA; const char* nB = has_next ? nxt.B : cB;
        if constexpr (GATHER) { if (has_next) { PG8_GLOAD(gN, nxt); } else {
#pragma unroll
            for (int h = 0; h < 2; ++h)
#pragma unroll
                for (int i = 0; i < 2; ++i) gN[h][i] = gA[h][i]; } }
#pragma unroll 1
        for (int t = 0; t < nt; t += 2) {
            const bool last = (t == nt - 2);
            const char* a1 = cA + (size_t)(t + 1) * kstep;
            const char* a2 = last ? nA : cA + (size_t)(t + 2) * kstep; const char* b2 = last ? nB : cB + (size_t)(t + 2) * kstep;
            const char* a3 = a2 + kstep; const char* b3 = b2 + kstep;
            PG8_LDB(B0, 0, 0); PG8_LDB(B1, 0, 1); PG8_SCHED; PG8_LDA(At, 0, 0); PG8_STAGE_A(PG8_SA(1, 1), a1, 1);
            if constexpr (GATHER) { if (last) {
#pragma unroll
                for (int h = 0; h < 2; ++h)
#pragma unroll
                    for (int i = 0; i < 2; ++i) gA[h][i] = gN[h][i]; } }
            PG8_WAIT_V(8); PG8_WAIT_L(0); PG8_BAR; PG8_MMA(0, 0, At, B0); PG8_MMA(0, 1, At, B1); PG8_BAR; PG8_SCHED;
            PG8_LDA(At, 0, 1); PG8_STAGE_B(PG8_SB(0, 0), b2); PG8_STAGE_B(PG8_SB(0, 1), b2 + hstepB); PG8_STAGE_A(PG8_SA(0, 0), a2, 0);
            PG8_WAIT_V(8); PG8_WAIT_L(0); PG8_BAR; PG8_MMA(1, 0, At, B0); PG8_MMA(1, 1, At, B1); PG8_BAR; PG8_SCHED;
            PG8_LDB(B0, 1, 0); PG8_LDB(B1, 1, 1); PG8_SCHED; PG8_LDA(At, 1, 0); PG8_STAGE_A(PG8_SA(0, 1), a2, 1);
            PG8_WAIT_V(8); PG8_WAIT_L(0); PG8_BAR; PG8_MMA(0, 0, At, B0); PG8_MMA(0, 1, At, B1); PG8_BAR; PG8_SCHED;
            PG8_LDA(At, 1, 1); PG8_STAGE_B(PG8_SB(1, 0), b3); PG8_STAGE_B(PG8_SB(1, 1), b3 + hstepB); PG8_STAGE_A(PG8_SA(1, 0), a3, 0);
            PG8_WAIT_V(8); PG8_WAIT_L(0); PG8_BAR; PG8_MMA(1, 0, At, B0); PG8_MMA(1, 1, At, B1); PG8_BAR; PG8_SCHED;
        }
        if (wr == 0) PG8_BAR;
        E(acc, cur, wr, wc, fr, fq);
        if (!has_next) break;
#pragma unroll
        for (int a = 0; a < 2; ++a)
#pragma unroll
            for (int b = 0; b < 2; ++b)
#pragma unroll
                for (int m = 0; m < 4; ++m)
#pragma unroll
                    for (int n = 0; n < 2; ++n) acc[a][b][m][n] = (f32x4){0.f, 0.f, 0.f, 0.f};
        cur = nxt; cA = nA; cB = nB; ++ui;
        if (wr == 1) PG8_BAR;
    }
    PG8_WAIT_V(0);
    PG8_BAR;
#undef PG8_SA
#undef PG8_SB
#undef PG8_STAGE_A
#undef PG8_STAGE_B
#undef PG8_LDA
#undef PG8_LDB
#undef PG8_MMA
#undef PG8_WAIT_V
#undef PG8_WAIT_L
#undef PG8_BAR
#undef PG8_SCHED
#undef PG8_GLOAD
}
}

constexpr int NB = 4, SEQ = 4096, D = 2048, DEPTH = 2;
constexpr int T = NB * SEQ;
constexpr int NH = 8, HD = 128, DNW = 1024, CH = 64, NCH = SEQ / CH;
constexpr int PW = 1024, PG_DIM = 256;
constexpr int IN_COLS = 5136, NPROJ = 5120;
constexpr int NE = 16, DE = 1024, PLE = 256;
constexpr float ALPHA = 1.4142135623730951f;
constexpr float LN_EPS = 1e-5f, RMS_EPS = 1e-6f;
constexpr int LCAP = T;
constexpr int MAXTILES = 2 * T / 256 + NE;

constexpr size_t MiB = 1u << 20;
constexpr size_t WS_CTL = 0, CTL_ZERO_BYTES = 64 * 1024;
constexpr size_t WS_LIST = 2 * MiB;
constexpr size_t WS_TOKSLOT = 3 * MiB, WS_GATEW = WS_TOKSLOT + 128 * 1024, WS_STATS = WS_GATEW + 128 * 1024, WS_CD = WS_STATS + 128 * 1024, WS_WBA = WS_CD + 128 * 1024;
constexpr size_t WS_WIN = 4 * MiB, WS_WOUT = 44 * MiB, WS_WPG = 60 * MiB, WS_WPP = 76 * MiB, WS_WPOOL = 78 * MiB, WS_WGU = 80 * MiB, WS_WD = 336 * MiB, WS_PB16 = 464 * MiB;
constexpr size_t WS_XB = 480 * MiB, WS_R1 = 544 * MiB, WS_R2 = 704 * MiB, WS_R4 = 848 * MiB, WS_R5 = 944 * MiB, WS_END = 1008 * MiB;
constexpr size_t WS_PROJ = WS_R1, WS_HID = WS_R1;
constexpr size_t WS_Y = WS_R2;
constexpr size_t WS_POOLD = WS_R4, WS_PP = WS_R4 + 32 * MiB, WS_X1B = WS_R2;
constexpr size_t WS_MIXIN = WS_R5, WS_X2B = WS_R5;
static_assert((size_t)MAXTILES * 256 * 2048 * 2 <= 144 * MiB && (size_t)MAXTILES * 256 * 1024 * 2 <= 160 * MiB, "MoE row buffers");
constexpr int CW_TMO = 0, CW_CODE = 1, CW_CNT = 64  , CW_BAR = 4096;

constexpr int RING_OFF = 0, RING_BYTES = 131072;
constexpr int LDSCTL_OFF = 152 * 1024, MISC_OFF = LDSCTL_OFF + 320;
constexpr int AUX_OFF = LDSCTL_OFF + 1024;
constexpr int LDS_BYTES = 163840;
constexpr int NWAVES = 8;

#define RLX_AGENT __ATOMIC_RELAXED, __HIP_MEMORY_SCOPE_AGENT
#define LDS_WAIT() asm volatile("s_waitcnt lgkmcnt(0)" ::: "memory")
#define VM_WAIT() asm volatile("s_waitcnt vmcnt(0)" ::: "memory")
__device__ __forceinline__ unsigned f2bf(float f) { unsigned u = __builtin_bit_cast(unsigned, f); return (u + 0x7fffu + ((u >> 16) & 1u)) >> 16; }
__device__ __forceinline__ unsigned pk2(float lo, float hi) { return f2bf(lo) | (f2bf(hi) << 16); }
typedef __bf16 bf2_t __attribute__((ext_vector_type(2)));
__device__ __forceinline__ unsigned pkbf(float lo, float hi) { const f32x2 v = {lo, hi}; return __builtin_bit_cast(unsigned, __builtin_convertvector(v, bf2_t)); }
__device__ __forceinline__ float bf2f(unsigned short b) { return __builtin_bit_cast(float, ((unsigned)b) << 16); }
__device__ __forceinline__ float bflo(unsigned w) { return __builtin_bit_cast(float, w << 16); }
__device__ __forceinline__ float bfhi(unsigned w) { return __builtin_bit_cast(float, w & 0xffff0000u); }
__device__ __forceinline__ float sigmoidf_(float x) { return __builtin_amdgcn_rcpf(1.0f + __expf(-x)); }
__device__ __forceinline__ float wave_sum(float v) {
#pragma unroll
    for (int o = 1; o < 64; o <<= 1) v += __shfl_xor(v, o);
    return v;
}
#define XB_TMO      128
#define XB_XCNT(j)  (256  + 64 * (j))
#define XB_XSUB(j)  (1280 + 64 * (j))
#define XB_XGEN(j)  (2304 + 64 * (j))
#define XB_TOP      3328
#define XB_TOPGEN   3392
#define XCD_BAR_WORDS 3456
#define XB_SPIN_CAP (1u << 18)

__device__ __forceinline__ unsigned xb_ld(unsigned* p)              { return __hip_atomic_load(p, __ATOMIC_RELAXED, __HIP_MEMORY_SCOPE_AGENT); }
__device__ __forceinline__ unsigned xb_add(unsigned* p, unsigned v) { return __hip_atomic_fetch_add(p, v, __ATOMIC_RELAXED, __HIP_MEMORY_SCOPE_AGENT); }
__device__ __forceinline__ unsigned xb_xcc_id() { return (unsigned)__builtin_amdgcn_s_getreg((3 << 11) | 20) & 0xFu; }
#define XB_SPIN(cond, bar) do { unsigned _sp = 0; while (cond) { __builtin_amdgcn_s_sleep(1); \
    if ((++_sp & 255u) == 0u) { if (xb_ld(&(bar)[XB_TMO])) break; if (_sp > XB_SPIN_CAP) { atomicAdd(&(bar)[XB_TMO], 1u); break; } } } } while (0)

struct XcdBarrier {
    unsigned* bar; unsigned x;
    volatile LAS unsigned* st;
};

__device__ __forceinline__ XcdBarrier xcd_barrier_post(unsigned* bar, volatile LAS unsigned* st) {
    XcdBarrier b; b.bar = bar; b.x = xb_xcc_id(); b.st = st;
    if (threadIdx.x == 0) (void)xb_add(&bar[XB_XCNT(b.x)], 1u);
    return b;
}
__device__ __forceinline__ void xcd_barrier_complete(unsigned* bar, unsigned x, unsigned& nloc, unsigned& nx) {
    const unsigned G = gridDim.x * gridDim.y * gridDim.z;
    unsigned sum, cnt, mine, sp = 0u;
    for (;;) {
        sum = 0u; cnt = 0u; mine = 0u;
#pragma unroll
        for (unsigned j = 0; j < 16; ++j) { const unsigned c = xb_ld(&bar[XB_XCNT(j)]); sum += c; cnt += (c > 0u) ? 1u : 0u; mine = (j == x) ? c : mine; }
        if (sum == G) break;
        __builtin_amdgcn_s_sleep(1);
        if ((++sp & 255u) == 0u) { if (xb_ld(&bar[XB_TMO])) break; if (sp > XB_SPIN_CAP) { atomicAdd(&bar[XB_TMO], 1u); break; } }
    }
    nloc = mine > 0u ? mine : 1u; nx = cnt > 0u ? cnt : 1u;
}

__device__ __forceinline__ void xcd_barrier(const XcdBarrier& b) {
    asm volatile("s_waitcnt vmcnt(0)" ::: "memory");
    __syncthreads();
    if (threadIdx.x == 0) {
        unsigned* bar = b.bar;
        __builtin_amdgcn_s_waitcnt(0);
        unsigned nloc = b.st[0], nx = b.st[1];
        if (nloc == 0u) { xcd_barrier_complete(bar, b.x, nloc, nx); b.st[0] = nloc; b.st[1] = nx; }
        const unsigned old = xb_add(&bar[XB_XSUB(b.x)], 1u);
        const unsigned gen = old / nloc;
        if (old + 1u == (gen + 1u) * nloc) {
            __builtin_amdgcn_fence(__ATOMIC_RELEASE, "agent");
            asm volatile("s_waitcnt vmcnt(0)" ::: "memory");
            const unsigned og = xb_add(&bar[XB_TOP], 1u);
            const unsigned tg = og / nx;
            if (og + 1u == (tg + 1u) * nx) xb_add(&bar[XB_TOPGEN], 1u);
            else XB_SPIN(xb_ld(&bar[XB_TOPGEN]) == tg, bar);
            __builtin_amdgcn_fence(__ATOMIC_ACQUIRE, "agent");
            xb_add(&bar[XB_XGEN(b.x)], 1u);
            asm volatile("s_waitcnt vmcnt(0)" ::: "memory");
        } else {
            XB_SPIN(xb_ld(&bar[XB_XGEN(b.x)]) == gen, bar);
            __builtin_amdgcn_fence(__ATOMIC_ACQUIRE, "agent");
            asm volatile("s_waitcnt vmcnt(0)" ::: "memory");
        }
    }
    __syncthreads();
}

struct Args { const float* in[21]; float* out; unsigned char* ws; int ph_lo, ph_hi, li, pad; };
enum { I_X = 0, I_P, I_WIN, I_CONVW, I_ALOG, I_DTB, I_NORMW, I_POOLW, I_POOLS, I_WOUT, I_LN1G, I_LN1B, I_WR, I_BR, I_WEG, I_WEU, I_WED, I_LN2G, I_LN2B, I_WPP, I_WPG };
struct Frame {
    LAS unsigned char* lds;
    volatile LAS unsigned* MISC;
    gu32* ctl;
    int tid, lane, wave, vcu, G;
};

#define PHASE_FRAME(F0) Frame F = F0; { int t_ = threadIdx.x; asm volatile("" : "+v"(t_)); F.tid = t_; F.lane = t_ & 63; }
#define OPQ_S(p) asm volatile("" : "+s"(p))
#define OPQ_G(T, expr) ({ GAS T* g_ = (GAS T*)(expr); asm volatile("" : "+s"(g_)); (T*)g_; })
struct SchedDense {
    int nM, nN, nwg, G, c; const char* A; const char* B; size_t astep, bstep;
    __device__ __forceinline__ void init(int M, int N, int G_, int c_, const void* A_, int lda, const void* B_, int ldb) { nM = M / 256; nN = N / 256; nwg = nM * nN; G = G_; c = c_;
        A = (const char*)A_; B = (const char*)B_; astep = (size_t)256 * lda * 2; bstep = (size_t)256 * ldb * 2; }
    __device__ __forceinline__ bool next(int i, pg8::Unit& u) const {
        const long L = (long)i * G + c; if (L >= nwg) return false;
        int wgid = (int)L; { const int q = nwg / 8, r = nwg % 8, xcd = wgid % 8, off = wgid / 8; wgid = (xcd < r ? xcd * (q + 1) : r * (q + 1) + (xcd - r) * q) + off; }
        const int nig = 8 * nN, gid = wgid / nig, fm = gid * 8, gsz = (nM - fm) < 8 ? (nM - fm) : 8;
        u.pm = fm + ((wgid % nig) % gsz); u.pn = (wgid % nig) / gsz;
        u.A = A + (size_t)u.pm * astep; u.B = B + (size_t)u.pn * bstep; u.rows = nullptr; u.nvalid = 256; u.aux = 0; return true;
    }
};
struct SchedPool {
    int G, c; const char* A; const char* B;
    __device__ __forceinline__ bool next(int i, pg8::Unit& u) const {
        const int L = i * G + c; if (L >= 256) return false;
        u.pm = L >> 2; u.pn = L & 3; u.A = A + ((size_t)u.pm * 256 * PW + u.pn * 256) * 2; u.B = B + (size_t)u.pn * 65536 * 2; u.rows = nullptr; u.nvalid = 256; u.aux = 0; return true;
    }
};
struct SchedMoe {
    int G, c, mode; const LAS int* tab; const char* A; const char* B; const int* list;
    __device__ __forceinline__ bool next(int i, pg8::Unit& u) const {
        const int L = i * G + c, rt = L >> 3, pn = L & 7;
        const int ntiles = __builtin_amdgcn_readfirstlane(tab[16]); if (rt >= ntiles) return false;
        int e = 0;
#pragma unroll
        for (int k = 1; k < 16; ++k) { const int ts = __builtin_amdgcn_readfirstlane(tab[k]); if (rt >= ts) e = k; }
        const int ts = __builtin_amdgcn_readfirstlane(tab[e]), cn = __builtin_amdgcn_readfirstlane(tab[32 + e]);
        const int r0 = (rt - ts) * 256;
        u.pm = rt; u.pn = pn; u.aux = e;
        if (mode == 0) { u.A = A; u.rows = list + (size_t)e * LCAP + r0; u.nvalid = (cn - r0) < 256 ? (cn - r0) : 256; u.B = B + ((size_t)e * 2048 + pn * 256) * 2048 * 2; }
        else { u.A = A + (size_t)rt * 256 * DE * 2; u.rows = nullptr; u.nvalid = 256; u.B = B + ((size_t)e * 2048 + pn * 256) * DE * 2; }
        return true;
    }
};

using pg8::cvt_pk_bf16;
struct EpiBf16 {
    static constexpr bool PERM = true; bf16* O; int ldc;
    __device__ __forceinline__ void operator()(const f32x4 (&acc)[2][2][4][2], const pg8::Unit& u, int wr, int wc, int fr, int fq) const {
        const int row0 = u.pm * 256 + wr * 64 + fr, col0 = u.pn * 256 + wc * 32 + 8 * fq;
#pragma unroll
        for (int ai = 0; ai < 2; ++ai)
#pragma unroll
            for (int m = 0; m < 4; ++m) { bf16* rowp = O + (size_t)(row0 + ai * 128 + m * 16) * ldc + col0;
#pragma unroll
                for (int bj = 0; bj < 2; ++bj) { const f32x4 v0 = acc[ai][bj][m][0], v1 = acc[ai][bj][m][1];
                    v4u w; w.x = cvt_pk_bf16(v0[0], v0[1]); w.y = cvt_pk_bf16(v0[2], v0[3]); w.z = cvt_pk_bf16(v1[0], v1[1]); w.w = cvt_pk_bf16(v1[2], v1[3]);
                    *(v4u*)(rowp + bj * 128) = w; } }
    }
};
struct EpiPool {
    static constexpr bool PERM = true; bf16* O; const float* scale;
    __device__ __forceinline__ void operator()(const f32x4 (&acc)[2][2][4][2], const pg8::Unit& u, int wr, int wc, int fr, int fq) const {
        const int row0 = u.pm * 256 + wr * 64 + fr, cg = u.pn * 256 + wc * 32 + 8 * fq;
        f32x4 sv[2][2];
#pragma unroll
        for (int bj = 0; bj < 2; ++bj) { sv[bj][0] = *(const f32x4*)(scale + cg + bj * 128); sv[bj][1] = *(const f32x4*)(scale + cg + bj * 128 + 4); }
#pragma unroll
        for (int ai = 0; ai < 2; ++ai)
#pragma unroll
            for (int m = 0; m < 4; ++m) { bf16* rowp = O + (size_t)(row0 + ai * 128 + m * 16) * D + DNW + cg;
#pragma unroll
                for (int bj = 0; bj < 2; ++bj) { const f32x4 v0 = acc[ai][bj][m][0] * sv[bj][0], v1 = acc[ai][bj][m][1] * sv[bj][1];
                    v4u w; w.x = cvt_pk_bf16(v0[0], v0[1]); w.y = cvt_pk_bf16(v0[2], v0[3]); w.z = cvt_pk_bf16(v1[0], v1[1]); w.w = cvt_pk_bf16(v1[2], v1[3]);
                    *(v4u*)(rowp + bj * 128) = w; } }
    }
};
struct EpiRes {
    static constexpr bool PERM = true; const bf16* XB; bf16* PRE;
    __device__ __forceinline__ void operator()(const f32x4 (&acc)[2][2][4][2], const pg8::Unit& u, int wr, int wc, int fr, int fq) const {
        const int row0 = u.pm * 256 + wr * 64 + fr, col0 = u.pn * 256 + wc * 32 + 8 * fq;
#pragma unroll
        for (int ai = 0; ai < 2; ++ai)
#pragma unroll
            for (int m = 0; m < 4; ++m) { const size_t off0 = (size_t)(row0 + ai * 128 + m * 16) * D + col0;
#pragma unroll
                for (int bj = 0; bj < 2; ++bj) { const size_t off = off0 + bj * 128; const v4u x = *(const v4u*)(XB + off); const f32x4 a0 = acc[ai][bj][m][0], a1 = acc[ai][bj][m][1];
                    v4u w; w.x = cvt_pk_bf16(bflo(x.x) * ALPHA + a0[0], bfhi(x.x) * ALPHA + a0[1]); w.y = cvt_pk_bf16(bflo(x.y) * ALPHA + a0[2], bfhi(x.y) * ALPHA + a0[3]);
                    w.z = cvt_pk_bf16(bflo(x.z) * ALPHA + a1[0], bfhi(x.z) * ALPHA + a1[1]); w.w = cvt_pk_bf16(bflo(x.w) * ALPHA + a1[2], bfhi(x.w) * ALPHA + a1[3]);
                    *(v4u*)(PRE + off) = w; } }
    }
};
struct EpiSwiglu {
    static constexpr bool PERM = true; bf16* O;
    __device__ __forceinline__ void operator()(const f32x4 (&acc)[2][2][4][2], const pg8::Unit& u, int wr, int wc, int fr, int fq) const {
        const int row0 = u.pm * 256 + wr * 64 + fr, col0 = u.pn * 128 + wc * 32 + 8 * fq;
#pragma unroll
        for (int ai = 0; ai < 2; ++ai)
#pragma unroll
            for (int m = 0; m < 4; ++m) { bf16* rowp = O + (size_t)(row0 + ai * 128 + m * 16) * DE + col0;
                float h[8];
#pragma unroll
                for (int n = 0; n < 2; ++n)
#pragma unroll
                    for (int j = 0; j < 4; ++j) { const float g = acc[ai][0][m][n][j], up = acc[ai][1][m][n][j]; h[4 * n + j] = g * sigmoidf_(g) * up; }
                v4u w; w.x = cvt_pk_bf16(h[0], h[1]); w.y = cvt_pk_bf16(h[2], h[3]); w.z = cvt_pk_bf16(h[4], h[5]); w.w = cvt_pk_bf16(h[6], h[7]);
                *(v4u*)rowp = w; }
    }
};
struct EpiPle {
    static constexpr bool PERM = true; const bf16* X2B; const bf16* PP; bf16* XB; float* OUT; int last;
    __device__ __forceinline__ void operator()(const f32x4 (&acc)[2][2][4][2], const pg8::Unit& u, int wr, int wc, int fr, int fq) const {
        const int row0 = u.pm * 256 + wr * 64 + fr, col0 = u.pn * 256 + wc * 32 + 8 * fq;
#pragma unroll
        for (int ai = 0; ai < 2; ++ai)
#pragma unroll
            for (int m = 0; m < 4; ++m) { const size_t off0 = (size_t)(row0 + ai * 128 + m * 16) * D + col0;
#pragma unroll
                for (int bj = 0; bj < 2; ++bj) { const size_t off = off0 + bj * 128;
                    const v4u xx = *(const v4u*)(X2B + off), pp = *(const v4u*)(PP + off);
                    const f32x4 a0 = acc[ai][bj][m][0], a1 = acc[ai][bj][m][1];
                    f32x4 o0, o1;
                    o0[0] = bflo(xx.x) + sigmoidf_(a0[0]) * bflo(pp.x); o0[1] = bfhi(xx.x) + sigmoidf_(a0[1]) * bfhi(pp.x); o0[2] = bflo(xx.y) + sigmoidf_(a0[2]) * bflo(pp.y); o0[3] = bfhi(xx.y) + sigmoidf_(a0[3]) * bfhi(pp.y);
                    o1[0] = bflo(xx.z) + sigmoidf_(a1[0]) * bflo(pp.z); o1[1] = bfhi(xx.z) + sigmoidf_(a1[1]) * bfhi(pp.z); o1[2] = bflo(xx.w) + sigmoidf_(a1[2]) * bflo(pp.w); o1[3] = bfhi(xx.w) + sigmoidf_(a1[3]) * bfhi(pp.w);
                    if (last) { *(f32x4*)(OUT + off) = o0; *(f32x4*)(OUT + off + 4) = o1; }
                    else { v4u w; w.x = cvt_pk_bf16(o0[0], o0[1]); w.y = cvt_pk_bf16(o0[2], o0[3]); w.z = cvt_pk_bf16(o1[0], o1[1]); w.w = cvt_pk_bf16(o1[2], o1[3]); *(v4u*)(XB + off) = w; } } }
    }
};

__device__ __forceinline__ void tr_item(const float* W, int ldw, int k0, int n0, bf16* WT, size_t drow0, int ldt, LAS float* scr, int lane) {
#pragma unroll 8
    for (int i = 0; i < 32; ++i) { const int kk = 2 * i + (lane >> 5); scr[kk * 33 + (lane & 31)] = W[(size_t)(k0 + kk) * ldw + n0 + (lane & 31)]; }
    LDS_WAIT(); asm volatile("" ::: "memory");
    const int c = lane & 7;
#pragma unroll
    for (int j = 0; j < 4; ++j) { const int n = (lane >> 3) + 8 * j; const LAS float* s = scr + (8 * c) * 33 + n;
        v4u o; o.x = pk2(s[0 * 33], s[1 * 33]); o.y = pk2(s[2 * 33], s[3 * 33]); o.z = pk2(s[4 * 33], s[5 * 33]); o.w = pk2(s[6 * 33], s[7 * 33]);
        *(GAS v4u*)(WT + (drow0 + n) * ldt + k0 + 8 * c) = o; }
    LDS_WAIT(); asm volatile("" ::: "memory");
}
__device__ __forceinline__ void weight_items(const Args& a, unsigned char* ws, LAS float* scr, int lane, int group, int l, int gw, int NGW) {
    constexpr int I_INA = 32 * 128, I_INB = 32 * 32, I_OUT = 32 * 64, I_PG = 32 * 64, I_PP = 4 * 64, I_POOL = 4 * 32, I_EG = NE * 32 * 32, I_EU = I_EG, I_ED = NE * 16 * 64;
    if (group == 0) {
        for (int it = gw; it < I_INA + I_INB + I_PP + I_POOL; it += NGW) { int r = it;
            if (r < I_INA) { const int kb = r / 128, nb = r % 128; tr_item(a.in[I_WIN] + (size_t)l * D * IN_COLS, IN_COLS, 64 * kb, 32 * nb, (bf16*)(ws + WS_WIN) + (size_t)l * NPROJ * D, 32 * nb, D, scr, lane); continue; } r -= I_INA;
            if (r < I_INB) { const int kb = r / 32, nb = r % 32; tr_item(a.in[I_WIN] + (size_t)l * D * IN_COLS, IN_COLS, 64 * kb, 4112 + 32 * nb, (bf16*)(ws + WS_WIN) + (size_t)l * NPROJ * D, 4096 + 32 * nb, D, scr, lane); continue; } r -= I_INB;
            if (r < I_PP) { const int kb = r / 64, nb = r % 64; tr_item(a.in[I_WPP] + (size_t)l * PLE * D, D, 64 * kb, 32 * nb, (bf16*)(ws + WS_WPP) + (size_t)l * D * PLE, 32 * nb, PLE, scr, lane); continue; } r -= I_PP;
            { const int g = r / 32, rr = r % 32, kb = rr / 8, nb = rr % 8; tr_item(a.in[I_POOLW] + ((size_t)l * 4 + g) * 65536, 256, 64 * kb, 32 * nb, (bf16*)(ws + WS_WPOOL) + ((size_t)l * 4 + g) * 65536, 32 * nb, 256, scr, lane); } }
    } else {
        for (int it = gw; it < I_OUT + I_PG + I_EG + I_EU + I_ED; it += NGW) { int r = it;
            if (r < I_OUT) { const int kb = r / 64, nb = r % 64; tr_item(a.in[I_WOUT] + (size_t)l * D * D, D, 64 * kb, 32 * nb, (bf16*)(ws + WS_WOUT) + (size_t)l * D * D, 32 * nb, D, scr, lane); continue; } r -= I_OUT;
            if (r < I_PG) { const int kb = r / 64, nb = r % 64; tr_item(a.in[I_WPG] + (size_t)l * D * D, D, 64 * kb, 32 * nb, (bf16*)(ws + WS_WPG) + (size_t)l * D * D, 32 * nb, D, scr, lane); continue; } r -= I_PG;
            if (r < I_EG) { const int e = r / 1024, rr = r % 1024, kb = rr / 32, nb = rr % 32, h0 = 32 * nb;
                tr_item(a.in[I_WEG] + ((size_t)l * NE + e) * D * DE, DE, 64 * kb, h0, (bf16*)(ws + WS_WGU) + ((size_t)l * NE + e) * 2048 * D, (size_t)(h0 >> 7) * 256 + (h0 & 127), D, scr, lane); continue; } r -= I_EG;
            if (r < I_EU) { const int e = r / 1024, rr = r % 1024, kb = rr / 32, nb = rr % 32, h0 = 32 * nb;
                tr_item(a.in[I_WEU] + ((size_t)l * NE + e) * D * DE, DE, 64 * kb, h0, (bf16*)(ws + WS_WGU) + ((size_t)l * NE + e) * 2048 * D, (size_t)(h0 >> 7) * 256 + 128 + (h0 & 127), D, scr, lane); continue; } r -= I_EU;
            { const int e = r / 1024, rr = r % 1024, kb = rr / 64, nb = rr % 64;
                tr_item(a.in[I_WED] + ((size_t)l * NE + e) * DE * D, D, 64 * kb, 32 * nb, (bf16*)(ws + WS_WD) + ((size_t)l * NE + e) * D * DE, 32 * nb, DE, scr, lane); } }
    }
}
__device__ __forceinline__ void p0_prologue(const Frame& F0, const Args& a) {
    PHASE_FRAME(F0);
    LAS float* scr = (LAS float*)(F.lds + RING_OFF + F.wave * 16384);
    const int gw = F.vcu * NWAVES + F.wave, NGW = F.G * NWAVES;
    unsigned char* ws = OPQ_G(unsigned char, a.ws);
#pragma unroll 1
    for (int l = 0; l < DEPTH; ++l) weight_items(a, ws, scr, F.lane, 0, l, gw, NGW);
#ifdef CONVERT_ALL_IN_PROLOGUE
#pragma unroll 1
    for (int l = 0; l < DEPTH; ++l) weight_items(a, ws, scr, F.lane, 1, l, gw, NGW);
#endif
    const size_t gt = (size_t)F.vcu * 512 + F.tid, NGT = (size_t)F.G * 512;
    { const GAS f32x4* src = (const GAS f32x4*)a.in[I_X]; GAS v4u* dst = (GAS v4u*)(ws + WS_XB);
        for (size_t i = gt; i < (size_t)T * D / 8; i += NGT) { const f32x4 v0 = src[2 * i], v1 = src[2 * i + 1]; v4u o; o.x = pk2(v0[0], v0[1]); o.y = pk2(v0[2], v0[3]); o.z = pk2(v1[0], v1[1]); o.w = pk2(v1[2], v1[3]); dst[i] = o; } }
    { const GAS f32x4* src = (const GAS f32x4*)a.in[I_P]; GAS v4u* dst = (GAS v4u*)(ws + WS_PB16);
        for (size_t i = gt; i < (size_t)DEPTH * T * PLE / 8; i += NGT) { const f32x4 v0 = src[2 * i], v1 = src[2 * i + 1]; v4u o; o.x = pk2(v0[0], v0[1]); o.y = pk2(v0[2], v0[3]); o.z = pk2(v1[0], v1[1]); o.w = pk2(v1[2], v1[3]); dst[i] = o; } }
    for (size_t i = gt; i < (size_t)DEPTH * 16 * D; i += NGT) { const int l = (int)(i / (16 * D)), j = (int)((i / D) % 16), k = (int)(i % D);
        ((bf16*)(ws + WS_WBA))[i] = (bf16)f2bf(a.in[I_WIN][((size_t)l * D + k) * IN_COLS + 4096 + j]); }
}

typedef float f32x16 __attribute__((ext_vector_type(16)));
#define MFMA32(a_, b_, c_) __builtin_amdgcn_mfma_f32_32x32x16_bf16((a_), (b_), (c_), 0, 0, 0)
#define PACK8(x, sp) __builtin_bit_cast(bf16x8, (v4u){pkbf((x)[8 * (sp)], (x)[8 * (sp) + 1]), pkbf((x)[8 * (sp) + 2], (x)[8 * (sp) + 3]), pkbf((x)[8 * (sp) + 4], (x)[8 * (sp) + 5]), pkbf((x)[8 * (sp) + 6], (x)[8 * (sp) + 7])})
#define RAW_BAR() do { asm volatile("s_waitcnt lgkmcnt(0)" ::: "memory"); __builtin_amdgcn_s_barrier(); asm volatile("" ::: "memory"); } while (0)
constexpr int IMG_ELEMS = 56 * 512, UIMG_ELEMS = 8 * 1024;
constexpr int FR_WN = 0, FR_QD = 16, FR_AQK = 32, FR_KDT = 40;
constexpr size_t WS_IMG = WS_R2, WS_UIMG = WS_R2 + 112 * MiB;
static_assert((size_t)NB * NCH * NH * IMG_ELEMS * 2 == 112 * MiB && (size_t)NB * NCH * NH * UIMG_ELEMS * 2 == 32 * MiB, "DeltaNet images");

constexpr int PQF = 0, PKF = 33792, PQS = 67584, PKS = 84992, PVT = 102400, PKT = 120832, PTAB = 139264;
constexpr int PAS = PQF;
constexpr int PTB = PKF, PT11T = PKF + 9216, PPART = PKF;
constexpr int F_LD = 132, S_LD = 136, T_LD = 72, A_LD = 68, TT_LD = 40;
__device__ __forceinline__ void phase_dn_prep(const Frame& F0, const Args& a, int layer) {
    PHASE_FRAME(F0);
    unsigned char* ws = OPQ_G(unsigned char, a.ws);
    LAS unsigned char* lds = F.lds;
    LAS float* Qf = (LAS float*)(lds + PQF); LAS float* Kf = (LAS float*)(lds + PKF); LAS float* As = (LAS float*)(lds + PAS);
    LAS bf16* Qs = (LAS bf16*)(lds + PQS); LAS bf16* Ks = (LAS bf16*)(lds + PKS); LAS bf16* Vt = (LAS bf16*)(lds + PVT); LAS bf16* Kt = (LAS bf16*)(lds + PKT);
    LAS bf16* Tb = (LAS bf16*)(lds + PTB); LAS bf16* T11t = (LAS bf16*)(lds + PT11T);
    LAS float* betaS = (LAS float*)(lds + PTAB); LAS float* gS = betaS + 512; LAS float* gamh = gS + 512; LAS float* betah = gamh + 64; LAS float* egam = betah + 64; LAS float* bgam = egam + 64; LAS float* ekd = bgam + 64; LAS float* rkS = ekd + 64;
    const bf16* XB = (const bf16*)(ws + WS_XB); const bf16* PROJ = (const bf16*)(ws + WS_PROJ); const bf16* WBA = (const bf16*)(ws + WS_WBA) + (size_t)layer * 16 * D;
    bf16* IMG = (bf16*)(ws + WS_IMG); bf16* UIMG = (bf16*)(ws + WS_UIMG); float* CD = (float*)(ws + WS_CD); bf16* POOLD = (bf16*)(ws + WS_POOLD);
    const float* convw = a.in[I_CONVW] + (size_t)layer * 4 * 3072; const float* alog = a.in[I_ALOG] + layer * NH; const float* dtb = a.in[I_DTB] + layer * NH;
    const int tid = F.tid, lane = F.lane, wave = F.wave, c32 = lane & 31, hf = lane >> 5;
    for (int unit = F.vcu; unit < NB * NCH; unit += F.G) {
        const int b = unit / NCH, n = unit % NCH, r0 = b * SEQ + n * CH, sq0 = n * CH;
        { const int col = 2 * tid, wsel = col >> 8; const bf16* up = PROJ + (size_t)r0 * NPROJ + 4096 + col; bf16* dp = POOLD + (size_t)r0 * PW + col;
#define POOL_BODY(WIN) do { unsigned xr[CH + WIN - 1]; \
            _Pragma("unroll") for (int j = 0; j < WIN - 1; ++j) xr[j] = (sq0 - (WIN - 1) + j >= 0) ? *(const unsigned*)(up + (ptrdiff_t)(j - (WIN - 1)) * NPROJ) : 0u; \
            _Pragma("unroll") for (int i = 0; i < CH; ++i) xr[WIN - 1 + i] = *(const unsigned*)(up + (size_t)i * NPROJ); \
            float s0 = 0.f, s1 = 0.f; \
            _Pragma("unroll") for (int j = 0; j < WIN - 1; ++j) { s0 += bflo(xr[j]); s1 += bfhi(xr[j]); } \
            _Pragma("unroll") for (int i = 0; i < CH; ++i) { const float x0 = bflo(xr[WIN - 1 + i]), x1 = bfhi(xr[WIN - 1 + i]); s0 += x0; s1 += x1; \
                const int pos = sq0 + i; const float inv = 1.0f / (float)((pos + 1) < WIN ? (pos + 1) : WIN); \
                *(unsigned*)(dp + (size_t)i * PW) = pkbf(s0 * inv - x0, s1 * inv - x1); s0 -= bflo(xr[i]); s1 -= bfhi(xr[i]); } } while (0)
            if (wsel == 0) POOL_BODY(2); else if (wsel == 1) POOL_BODY(4); else if (wsel == 2) POOL_BODY(8); else POOL_BODY(16);
#undef POOL_BODY
        }
        { typedef float f32x4v __attribute__((ext_vector_type(4)));
            const int fr = lane & 15, fg = lane >> 4; f32x4v pacc[4];
#pragma unroll
            for (int mt = 0; mt < 4; ++mt) pacc[mt] = (f32x4v){0.f, 0.f, 0.f, 0.f};
#pragma unroll 2
            for (int s = 0; s < 8; ++s) { const int k0 = 256 * wave + 32 * s + 8 * fg;
                const bf16x8 bfr = *(const bf16x8*)(WBA + (size_t)fr * D + k0);
#pragma unroll
                for (int mt = 0; mt < 4; ++mt) { const bf16x8 afr = *(const bf16x8*)(XB + (size_t)(r0 + 16 * mt + fr) * D + k0); pacc[mt] = __builtin_amdgcn_mfma_f32_16x16x32_bf16(afr, bfr, pacc[mt], 0, 0, 0); } }
            LAS float* part = (LAS float*)(lds + PPART) + wave * 1024;
#pragma unroll
            for (int mt = 0; mt < 4; ++mt)
#pragma unroll
                for (int r = 0; r < 4; ++r) part[(16 * mt + 4 * fg + r) * 16 + fr] = pacc[mt][r]; }
        __syncthreads();
        { const int tok = tid >> 3, cp = tid & 7; float s0 = 0.f, s1 = 0.f;
#pragma unroll
            for (int w = 0; w < 8; ++w) { const f32x2 p2 = *(const LAS f32x2*)((LAS float*)(lds + PPART) + w * 1024 + tok * 16 + 2 * cp); s0 += p2[0]; s1 += p2[1]; }
            if (cp < 4) { betaS[tok * 8 + 2 * cp] = sigmoidf_(s0); betaS[tok * 8 + 2 * cp + 1] = sigmoidf_(s1); }
            else { const int h = 2 * (cp - 4); const float z0 = s0 + dtb[h], z1 = s1 + dtb[h + 1];
                const float sp0 = z0 > 20.f ? z0 : log1pf(__expf(z0)), sp1 = z1 > 20.f ? z1 : log1pf(__expf(z1));
                gS[tok * 8 + h] = -__expf(alog[h]) * sp0; gS[tok * 8 + h + 1] = -__expf(alog[h + 1]) * sp1; } }
        __syncthreads();
        if (tid < 8) { float run = 0.f; for (int t = 0; t < CH; ++t) { run += gS[t * 8 + tid]; gS[t * 8 + tid] = run; } }
        __syncthreads();
        unsigned craw[3][11];
#define PREP_LOADRAW(hh) do { const int cp_ = tid & 63, i0_ = (tid >> 6) * 8; \
            _Pragma("unroll") for (int part_ = 0; part_ < 3; ++part_) { const bf16* src_ = PROJ + (size_t)(r0 + i0_ - 3) * NPROJ + part_ * 1024 + (hh) * HD + 2 * cp_; \
                _Pragma("unroll") for (int j_ = 0; j_ < 11; ++j_) craw[part_][j_] = (sq0 + i0_ - 3 + j_ >= 0) ? *(const unsigned*)(src_ + (ptrdiff_t)j_ * NPROJ) : 0u; } } while (0)
        PREP_LOADRAW(0);
        for (int h = 0; h < NH; ++h) {
            const size_t chd = (size_t)unit * NH + h; bf16* img = IMG + chd * IMG_ELEMS; bf16* uimg = UIMG + chd * UIMG_ELEMS;
            if (tid < 64) { const float gi = gS[tid * 8 + h], bi = betaS[tid * 8 + h], eg = __expf(gi); gamh[tid] = gi; betah[tid] = bi; egam[tid] = eg; bgam[tid] = bi * eg; ekd[tid] = __expf(gS[63 * 8 + h] - gi); }
            RAW_BAR();
            { const int cp = tid & 63, rg8 = tid >> 6, i0 = rg8 * 8;
#pragma unroll
                for (int part = 0; part < 3; ++part) { const int col = part * 1024 + h * HD + 2 * cp;
                    const f32x2 cw0 = *(const f32x2*)(convw + col), cw1 = *(const f32x2*)(convw + 3072 + col), cw2 = *(const f32x2*)(convw + 2 * 3072 + col), cw3 = *(const f32x2*)(convw + 3 * 3072 + col);
                    float ya[8], yb[8];
#pragma unroll
                    for (int i = 0; i < 8; ++i) { const unsigned x3 = craw[part][i], x2 = craw[part][i + 1], x1 = craw[part][i + 2], x0 = craw[part][i + 3];
                        const float ta = cw0[0] * bflo(x3) + cw1[0] * bflo(x2) + cw2[0] * bflo(x1) + cw3[0] * bflo(x0), tb = cw0[1] * bfhi(x3) + cw1[1] * bfhi(x2) + cw2[1] * bfhi(x1) + cw3[1] * bfhi(x0);
                        ya[i] = ta * sigmoidf_(ta); yb[i] = tb * sigmoidf_(tb); }
                    if (part == 0) {
#pragma unroll
                        for (int i = 0; i < 8; ++i) *(LAS f32x2*)(Qf + (i0 + i) * F_LD + 2 * cp) = (f32x2){ya[i], yb[i]}; }
                    else if (part == 1) {
#pragma unroll
                        for (int i = 0; i < 8; ++i) *(LAS f32x2*)(Kf + (i0 + i) * F_LD + 2 * cp) = (f32x2){ya[i], yb[i]}; }
                    else { v4u o0, o1;
                        o0.x = pkbf(ya[0] * betah[i0 + 0], ya[1] * betah[i0 + 1]); o0.y = pkbf(ya[2] * betah[i0 + 2], ya[3] * betah[i0 + 3]); o0.z = pkbf(ya[4] * betah[i0 + 4], ya[5] * betah[i0 + 5]); o0.w = pkbf(ya[6] * betah[i0 + 6], ya[7] * betah[i0 + 7]);
                        o1.x = pkbf(yb[0] * betah[i0 + 0], yb[1] * betah[i0 + 1]); o1.y = pkbf(yb[2] * betah[i0 + 2], yb[3] * betah[i0 + 3]); o1.z = pkbf(yb[4] * betah[i0 + 4], yb[5] * betah[i0 + 5]); o1.w = pkbf(yb[6] * betah[i0 + 6], yb[7] * betah[i0 + 7]);
                        *(LAS v4u*)(Vt + (2 * cp) * T_LD + i0) = o0; *(LAS v4u*)(Vt + (2 * cp + 1) * T_LD + i0) = o1; } }
                if (h + 1 < NH) PREP_LOADRAW(h + 1); }
            { const int i = tid >> 3, part = tid & 7; const LAS float* qp = Qf + i * F_LD + part * 16; const LAS float* kp = Kf + i * F_LD + part * 16;
                f32x4 qv[4], kv[4]; float sq = 0.f, sk = 0.f;
#pragma unroll
                for (int j = 0; j < 4; ++j) { qv[j] = *(const LAS f32x4*)(qp + 4 * j); kv[j] = *(const LAS f32x4*)(kp + 4 * j);
                    sq += (qv[j][0] * qv[j][0] + qv[j][1] * qv[j][1]) + (qv[j][2] * qv[j][2] + qv[j][3] * qv[j][3]); sk += (kv[j][0] * kv[j][0] + kv[j][1] * kv[j][1]) + (kv[j][2] * kv[j][2] + kv[j][3] * kv[j][3]); }
                sq += __shfl_xor(sq, 1); sq += __shfl_xor(sq, 2); sq += __shfl_xor(sq, 4); sk += __shfl_xor(sk, 1); sk += __shfl_xor(sk, 2); sk += __shfl_xor(sk, 4);
                const float rq = 1.0f / sqrtf(sq + RMS_EPS) * 0.08838834764831845f, rk = 1.0f / sqrtf(sk + RMS_EPS);
                if (part == 0) rkS[i] = rk;
#pragma unroll
                for (int j = 0; j < 4; ++j) { qv[j] = qv[j] * rq; kv[j] = kv[j] * rk; }
                v4u w0, w1;
                w0.x = pkbf(qv[0][0], qv[0][1]); w0.y = pkbf(qv[0][2], qv[0][3]); w0.z = pkbf(qv[1][0], qv[1][1]); w0.w = pkbf(qv[1][2], qv[1][3]); w1.x = pkbf(qv[2][0], qv[2][1]); w1.y = pkbf(qv[2][2], qv[2][3]); w1.z = pkbf(qv[3][0], qv[3][1]); w1.w = pkbf(qv[3][2], qv[3][3]);
                *(LAS v4u*)(Qs + i * S_LD + part * 16) = w0; *(LAS v4u*)(Qs + i * S_LD + part * 16 + 8) = w1;
                w0.x = pkbf(kv[0][0], kv[0][1]); w0.y = pkbf(kv[0][2], kv[0][3]); w0.z = pkbf(kv[1][0], kv[1][1]); w0.w = pkbf(kv[1][2], kv[1][3]); w1.x = pkbf(kv[2][0], kv[2][1]); w1.y = pkbf(kv[2][2], kv[2][3]); w1.z = pkbf(kv[3][0], kv[3][1]); w1.w = pkbf(kv[3][2], kv[3][3]);
                *(LAS v4u*)(Ks + i * S_LD + part * 16) = w0; *(LAS v4u*)(Ks + i * S_LD + part * 16 + 8) = w1;
                const float eg = egam[i]; bf16* fq = img + ((size_t)(FR_QD + (i >> 5) * 8 + part) * 64 + (i & 31)) * 8;
                v4u h0, h1;
                h0.x = pkbf(qv[0][0] * eg, qv[0][1] * eg); h0.y = pkbf(qv[0][2] * eg, qv[0][3] * eg); h0.z = pkbf(qv[2][0] * eg, qv[2][1] * eg); h0.w = pkbf(qv[2][2] * eg, qv[2][3] * eg);
                h1.x = pkbf(qv[1][0] * eg, qv[1][1] * eg); h1.y = pkbf(qv[1][2] * eg, qv[1][3] * eg); h1.z = pkbf(qv[3][0] * eg, qv[3][1] * eg); h1.w = pkbf(qv[3][2] * eg, qv[3][3] * eg);
                *(v4u*)fq = h0; *(v4u*)(fq + 32 * 8) = h1; }
            RAW_BAR();
            { const int c = tid & 127, rg = tid >> 7; float kb[16], kd[16];
#pragma unroll
                for (int i = 0; i < 16; ++i) { const int t = rg * 16 + i; const float kn = Kf[t * F_LD + c] * rkS[t]; kb[i] = kn * bgam[t]; kd[i] = kn * ekd[t]; }
                v4u o0, o1;
                o0.x = pkbf(kb[0], kb[1]); o0.y = pkbf(kb[2], kb[3]); o0.z = pkbf(kb[4], kb[5]); o0.w = pkbf(kb[6], kb[7]); o1.x = pkbf(kb[8], kb[9]); o1.y = pkbf(kb[10], kb[11]); o1.z = pkbf(kb[12], kb[13]); o1.w = pkbf(kb[14], kb[15]);
                *(LAS v4u*)(Kt + c * T_LD + rg * 16) = o0; *(LAS v4u*)(Kt + c * T_LD + rg * 16 + 8) = o1;
                bf16* fk = img + ((size_t)(FR_KDT + (c >> 5) * 4 + rg) * 64 + (c & 31)) * 8;
                v4u h0, h1;
                h0.x = pkbf(kd[0], kd[1]); h0.y = pkbf(kd[2], kd[3]); h0.z = pkbf(kd[8], kd[9]); h0.w = pkbf(kd[10], kd[11]);
                h1.x = pkbf(kd[4], kd[5]); h1.y = pkbf(kd[6], kd[7]); h1.z = pkbf(kd[12], kd[13]); h1.w = pkbf(kd[14], kd[15]);
                *(v4u*)fk = h0; *(v4u*)(fk + 32 * 8) = h1; }
            RAW_BAR();
            if (wave < 6) { const int pr = wave % 3, iskk = wave / 3, mt = pr == 2 ? 1 : 0, nt = pr == 0 ? 0 : 1;
                const LAS bf16* xs = iskk ? Ks : Qs; f32x16 d;
#pragma unroll
                for (int r = 0; r < 16; ++r) d[r] = 0.f;
#pragma unroll
                for (int s = 0; s < 8; ++s) { const bf16x8 af = *(const LAS bf16x8*)(Ks + (32 * mt + c32) * S_LD + 16 * s + 8 * hf), bfr = *(const LAS bf16x8*)(xs + (32 * nt + c32) * S_LD + 16 * s + 8 * hf); d = MFMA32(af, bfr, d); }
                const int i = 32 * nt + c32; const float gi = gamh[i], bi = betah[i];
#pragma unroll
                for (int r = 0; r < 16; ++r) { const int j = 32 * mt + (r & 3) + 8 * (r >> 2) + 4 * hf; const float de = __expf(gi - gamh[j]);
                    d[r] = iskk ? ((j < i) ? bi * d[r] * de : 0.f) : ((j <= i) ? d[r] * de : 0.f); }
                if (iskk) {
#pragma unroll
                    for (int qd = 0; qd < 4; ++qd) *(LAS f32x4*)(As + i * A_LD + 32 * mt + 8 * qd + 4 * hf) = (f32x4){d[4 * qd], d[4 * qd + 1], d[4 * qd + 2], d[4 * qd + 3]}; }
                else {
#pragma unroll
                    for (int sp = 0; sp < 2; ++sp) *(bf16x8*)(img + ((size_t)(FR_AQK + nt * 4 + 2 * mt + sp) * 64 + lane) * 8) = PACK8(d, sp); } }
            RAW_BAR();
            if (wave == 0) { float Tc[32];
                unsigned asb = (unsigned)(uintptr_t)(As + (32 * hf) * A_LD + 32 * hf); int cb = c32; asm volatile("" : "+v"(asb), "+v"(cb));
                const LAS float* Ab = (const LAS float*)(uintptr_t)asb;
#pragma unroll
                for (int i = 0; i < 32; ++i) { float ac[4] = {(i == cb) ? 1.f : 0.f, 0.f, 0.f, 0.f};
#pragma unroll
                    for (int j4 = 0; j4 < (i + 3) / 4; ++j4) { const f32x4 a4 = *(const LAS f32x4*)(Ab + i * A_LD + 4 * j4);
#pragma unroll
                        for (int q = 0; q < 4; ++q) if (4 * j4 + q < i) ac[q] -= a4[q] * Tc[4 * j4 + q]; }
                    Tc[i] = (ac[0] + ac[1]) + (ac[2] + ac[3]); }
#pragma unroll
                for (int i = 0; i < 32; ++i) Tb[(32 * hf + i) * T_LD + 32 * hf + c32] = (bf16)(pkbf(Tc[i], 0.f) & 0xffffu);
                if (hf == 0) {
#pragma unroll
                    for (int q = 0; q < 4; ++q) { v4u o; o.x = pkbf(Tc[8 * q], Tc[8 * q + 1]); o.y = pkbf(Tc[8 * q + 2], Tc[8 * q + 3]); o.z = pkbf(Tc[8 * q + 4], Tc[8 * q + 5]); o.w = pkbf(Tc[8 * q + 6], Tc[8 * q + 7]); *(LAS v4u*)(T11t + c32 * TT_LD + 8 * q) = o; } }
                asm volatile("s_waitcnt lgkmcnt(0)" ::: "memory");
                f32x16 x;
#pragma unroll
                for (int r = 0; r < 16; ++r) x[r] = 0.f;
#pragma unroll
                for (int s = 0; s < 2; ++s) { const LAS float* ap = As + (32 + c32) * A_LD + 16 * s + 8 * hf; const f32x4 a0 = *(const LAS f32x4*)ap, a1 = *(const LAS f32x4*)(ap + 4);
                    const bf16x8 af = __builtin_bit_cast(bf16x8, (v4u){pkbf(a0[0], a0[1]), pkbf(a0[2], a0[3]), pkbf(a1[0], a1[1]), pkbf(a1[2], a1[3])});
                    const bf16x8 bfr = *(const LAS bf16x8*)(T11t + c32 * TT_LD + 16 * s + 8 * hf); x = MFMA32(af, bfr, x); }
                f32x16 t21;
#pragma unroll
                for (int r = 0; r < 16; ++r) t21[r] = 0.f;
#pragma unroll
                for (int s = 0; s < 2; ++s) { const LAS bf16* tp = Tb + (32 + c32) * T_LD + 32 + 16 * s + 4 * hf; const v2u lo = *(const LAS v2u*)tp, hi = *(const LAS v2u*)(tp + 8);
                    const bf16x8 af = __builtin_bit_cast(bf16x8, (v4u){lo.x, lo.y, hi.x, hi.y}); const bf16x8 bfr = PACK8(x, s); t21 = MFMA32(af, bfr, t21); }
#pragma unroll
                for (int r = 0; r < 16; ++r) Tb[(32 + (r & 3) + 8 * (r >> 2) + 4 * hf) * T_LD + c32] = (bf16)(pkbf(-t21[r], 0.f) & 0xffffu);
            }
            RAW_BAR();
            if (wave < 4) {
#pragma unroll
                for (int mt = 0; mt < 2; ++mt) { f32x16 d;
#pragma unroll
                    for (int r = 0; r < 16; ++r) d[r] = 0.f;
#pragma unroll
                    for (int s = 0; s < 4; ++s) if (s < 2 * (mt + 1)) { const bf16x8 af = *(const LAS bf16x8*)(Tb + (32 * mt + c32) * T_LD + 16 * s + 8 * hf), bfr = *(const LAS bf16x8*)(Vt + (32 * wave + c32) * T_LD + 16 * s + 8 * hf); d = MFMA32(af, bfr, d); }
                    bf16* up = uimg + ((size_t)(wave * 2 + mt) * 64 + lane) * 16; *(bf16x8*)up = PACK8(d, 0); *(bf16x8*)(up + 8) = PACK8(d, 1); } }
            else { const int ct = wave - 4;
#pragma unroll
                for (int nt = 0; nt < 2; ++nt) { f32x16 d;
#pragma unroll
                    for (int r = 0; r < 16; ++r) d[r] = 0.f;
#pragma unroll
                    for (int s = 0; s < 4; ++s) if (s < 2 * (nt + 1)) { const bf16x8 af = *(const LAS bf16x8*)(Kt + (32 * ct + c32) * T_LD + 16 * s + 8 * hf), bfr = *(const LAS bf16x8*)(Tb + (32 * nt + c32) * T_LD + 16 * s + 8 * hf); d = MFMA32(af, bfr, d); }
#pragma unroll
                    for (int r = 0; r < 16; ++r) d[r] = -d[r];
#pragma unroll
                    for (int sp = 0; sp < 2; ++sp) *(bf16x8*)(img + ((size_t)(FR_WN + nt * 8 + 2 * ct + sp) * 64 + lane) * 8) = PACK8(d, sp); } }
            if (tid == 0) CD[chd] = egam[63];
            RAW_BAR();
        }
#undef PREP_LOADRAW
    }
}

__host__ __device__ constexpr int sc_p(int k) { const int j = k - 32; return j < 12 ? j % 6 : (j - 12) % 5; }
__host__ __device__ constexpr int sc_slab(int k) { const int j = k - 32; return k < 32 ? (k >> 2) : (j < 12 ? j / 6 : 2 + (j - 12) / 5); }
__host__ __device__ constexpr int sc_kind(int k) { return k < 32 ? ((k & 3) < 2 ? 0 : 1) : ((sc_p(k) == 2 || sc_p(k) == 5) ? 1 : 2); }
__host__ __device__ constexpr int sc_idx(int k) { return k < 32 ? (k & 1) : (sc_p(k) == 0 ? 0 : sc_p(k) == 1 ? 1 : sc_p(k) == 2 ? 1 : sc_p(k) == 3 ? 2 : sc_p(k) == 4 ? 3 : 0); }
__host__ __device__ constexpr int sc_frag(int k) { return k < 32 ? (((k & 3) < 2 ? FR_WN : FR_QD) + (k & 1) * 8 + (k >> 2)) : (sc_kind(k) == 1 ? FR_AQK + sc_idx(k) * 4 + sc_slab(k) : FR_KDT + sc_idx(k) * 4 + sc_slab(k)); }
constexpr int SC_QD = 8;
constexpr int SCB = 57344, OT_OFF = 2 * SCB, OT_LD = 136, OT_BYTES = 64 * OT_LD * 2;
static_assert(OT_OFF + 2 * OT_BYTES <= 152 * 1024, "scan LDS");
__device__ __forceinline__ void phase_dn_scan(const Frame& F0, const Args& a, int layer, int unit) {
    PHASE_FRAME(F0);
    unsigned char* ws = OPQ_G(unsigned char, a.ws);
    LAS unsigned char* lds = F.lds;
    const int b = unit >> 3, h = unit & 7, lane = F.lane;
    const bf16* IMG = (const bf16*)(ws + WS_IMG); const bf16* UIMG = (const bf16*)(ws + WS_UIMG); const float* CD = (const float*)(ws + WS_CD);
    const size_t chd0 = (size_t)b * NCH * NH + h;
    if (F.wave < 4) {
#ifndef SCAN_NO_COMPUTE
        const int w = F.wave, c32 = lane & 31, hf = lane >> 5;
        f32x16 S0, S1, S2, S3;
#pragma unroll
        for (int r = 0; r < 16; ++r) { S0[r] = 0.f; S1[r] = 0.f; S2[r] = 0.f; S3[r] = 0.f; }
        const float cdl = CD[chd0 + (size_t)lane * NH];
        v4u UA[4];
        const __amdgpu_buffer_rsrc_t rsU = __builtin_amdgcn_make_buffer_rsrc((void*)(UIMG + chd0 * UIMG_ELEMS), (short)0, NCH * NH * UIMG_ELEMS * 2, 0x00020000);
        const unsigned uoff = (unsigned)((w * 2) * 64 + lane) * 32u;
#define SC_LOADU(dst, nn) do { _Pragma("unroll") for (int mt_ = 0; mt_ < 2; ++mt_) { _Pragma("unroll") for (int hh_ = 0; hh_ < 2; ++hh_) dst[2 * mt_ + hh_] = __builtin_amdgcn_raw_buffer_load_b128(rsU, uoff + (unsigned)(mt_ * 2048 + hh_ * 16), (unsigned)(nn) * (unsigned)(NH * UIMG_ELEMS * 2), 0); } } while (0)
#define SC_FRAG(bufoff, fi) (*(const LAS bf16x8*)(lds + (bufoff) + (fi) * 1024 + lane * 16))
#define SC_CHUNK(nn, U, bufoff, otoff) do { \
        f32x16 aV0, aV1, aO0, aO1; bf16x8 fq0, fq1, fq2, fq3, fq4, fq5, fq6, fq7, Sbs, Vb0, Vb1, Vb2, Vb3; \
        _Pragma("unroll") for (int q = 0; q < 4; ++q) { aV0[2 * q] = bflo(U[0][q]); aV0[2 * q + 1] = bfhi(U[0][q]); aV0[8 + 2 * q] = bflo(U[1][q]); aV0[8 + 2 * q + 1] = bfhi(U[1][q]); \
            aV1[2 * q] = bflo(U[2][q]); aV1[2 * q + 1] = bfhi(U[2][q]); aV1[8 + 2 * q] = bflo(U[3][q]); aV1[8 + 2 * q + 1] = bfhi(U[3][q]); } \
        _Pragma("unroll") for (int r = 0; r < 16; ++r) { aO0[r] = 0.f; aO1[r] = 0.f; } \
        if ((nn) + 1 < NCH) SC_LOADU(U, (nn) + 1); \
        const float cd = __builtin_bit_cast(float, __builtin_amdgcn_readlane(__builtin_bit_cast(int, cdl), (nn))); \
        fq0 = SC_FRAG(bufoff, 0); \
        fq1 = SC_FRAG(bufoff, 8); \
        fq2 = SC_FRAG(bufoff, 16); \
        fq3 = SC_FRAG(bufoff, 24); \
        fq4 = SC_FRAG(bufoff, 1); \
        fq5 = SC_FRAG(bufoff, 9); \
        fq6 = SC_FRAG(bufoff, 17); \
        fq7 = SC_FRAG(bufoff, 25); \
        Sbs = PACK8(S0, 0); \
        aV0 = MFMA32(fq0, Sbs, aV0); \
        fq0 = SC_FRAG(bufoff, 2); \
        aV1 = MFMA32(fq1, Sbs, aV1); \
        fq1 = SC_FRAG(bufoff, 10); \
        aO0 = MFMA32(fq2, Sbs, aO0); \
        fq2 = SC_FRAG(bufoff, 18); \
        aO1 = MFMA32(fq3, Sbs, aO1); \
        fq3 = SC_FRAG(bufoff, 26); \
        Sbs = PACK8(S0, 1); \
        aV0 = MFMA32(fq4, Sbs, aV0); \
        fq4 = SC_FRAG(bufoff, 3); \
        aV1 = MFMA32(fq5, Sbs, aV1); \
        fq5 = SC_FRAG(bufoff, 11); \
        aO0 = MFMA32(fq6, Sbs, aO0); \
        fq6 = SC_FRAG(bufoff, 19); \
        aO1 = MFMA32(fq7, Sbs, aO1); \
        fq7 = SC_FRAG(bufoff, 27); \
        Sbs = PACK8(S1, 0); \
        aV0 = MFMA32(fq0, Sbs, aV0); \
        fq0 = SC_FRAG(bufoff, 4); \
        aV1 = MFMA32(fq1, Sbs, aV1); \
        fq1 = SC_FRAG(bufoff, 12); \
        aO0 = MFMA32(fq2, Sbs, aO0); \
        fq2 = SC_FRAG(bufoff, 20); \
        aO1 = MFMA32(fq3, Sbs, aO1); \
        fq3 = SC_FRAG(bufoff, 28); \
        Sbs = PACK8(S1, 1); \
        aV0 = MFMA32(fq4, Sbs, aV0); \
        fq4 = SC_FRAG(bufoff, 5); \
        aV1 = MFMA32(fq5, Sbs, aV1); \
        fq5 = SC_FRAG(bufoff, 13); \
        aO0 = MFMA32(fq6, Sbs, aO0); \
        fq6 = SC_FRAG(bufoff, 21); \
        aO1 = MFMA32(fq7, Sbs, aO1); \
        fq7 = SC_FRAG(bufoff, 29); \
        Sbs = PACK8(S2, 0); \
        aV0 = MFMA32(fq0, Sbs, aV0); \
        fq0 = SC_FRAG(bufoff, 6); \
        aV1 = MFMA32(fq1, Sbs, aV1); \
        fq1 = SC_FRAG(bufoff, 14); \
        aO0 = MFMA32(fq2, Sbs, aO0); \
        fq2 = SC_FRAG(bufoff, 22); \
        aO1 = MFMA32(fq3, Sbs, aO1); \
        fq3 = SC_FRAG(bufoff, 30); \
        Sbs = PACK8(S2, 1); \
        aV0 = MFMA32(fq4, Sbs, aV0); \
        fq4 = SC_FRAG(bufoff, 7); \
        aV1 = MFMA32(fq5, Sbs, aV1); \
        fq5 = SC_FRAG(bufoff, 15); \
        aO0 = MFMA32(fq6, Sbs, aO0); \
        fq6 = SC_FRAG(bufoff, 23); \
        aO1 = MFMA32(fq7, Sbs, aO1); \
        fq7 = SC_FRAG(bufoff, 31); \
        Sbs = PACK8(S3, 0); \
        aV0 = MFMA32(fq0, Sbs, aV0); \
        fq0 = SC_FRAG(bufoff, 40); \
        aV1 = MFMA32(fq1, Sbs, aV1); \
        fq1 = SC_FRAG(bufoff, 44); \
        aO0 = MFMA32(fq2, Sbs, aO0); \
        fq2 = SC_FRAG(bufoff, 36); \
        aO1 = MFMA32(fq3, Sbs, aO1); \
        fq3 = SC_FRAG(bufoff, 48); \
        Sbs = PACK8(S3, 1); \
        aV0 = MFMA32(fq4, Sbs, aV0); \
        fq4 = SC_FRAG(bufoff, 52); \
        aV1 = MFMA32(fq5, Sbs, aV1); \
        fq5 = SC_FRAG(bufoff, 32); \
        S0 = S0 * cd; S1 = S1 * cd; S2 = S2 * cd; S3 = S3 * cd; \
        aO0 = MFMA32(fq6, Sbs, aO0); \
        fq6 = SC_FRAG(bufoff, 41); \
        aO1 = MFMA32(fq7, Sbs, aO1); \
        fq7 = SC_FRAG(bufoff, 45); \
        Vb0 = PACK8(aV0, 0); Vb1 = PACK8(aV0, 1); Vb2 = PACK8(aV1, 0); Vb3 = PACK8(aV1, 1); \
        S0 = MFMA32(fq0, Vb0, S0); \
        fq0 = SC_FRAG(bufoff, 37); \
        S1 = MFMA32(fq1, Vb0, S1); \
        fq1 = SC_FRAG(bufoff, 49); \
        aO1 = MFMA32(fq2, Vb0, aO1); \
        fq2 = SC_FRAG(bufoff, 53); \
        S2 = MFMA32(fq3, Vb0, S2); \
        fq3 = SC_FRAG(bufoff, 33); \
        S3 = MFMA32(fq4, Vb0, S3); \
        fq4 = SC_FRAG(bufoff, 42); \
        aO0 = MFMA32(fq5, Vb0, aO0); \
        fq5 = SC_FRAG(bufoff, 46); \
        S0 = MFMA32(fq6, Vb1, S0); \
        fq6 = SC_FRAG(bufoff, 38); \
        S1 = MFMA32(fq7, Vb1, S1); \
        fq7 = SC_FRAG(bufoff, 50); \
        aO1 = MFMA32(fq0, Vb1, aO1); \
        fq0 = SC_FRAG(bufoff, 54); \
        S2 = MFMA32(fq1, Vb1, S2); \
        fq1 = SC_FRAG(bufoff, 43); \
        S3 = MFMA32(fq2, Vb1, S3); \
        fq2 = SC_FRAG(bufoff, 47); \
        aO0 = MFMA32(fq3, Vb1, aO0); \
        fq3 = SC_FRAG(bufoff, 39); \
        S0 = MFMA32(fq4, Vb2, S0); \
        fq4 = SC_FRAG(bufoff, 51); \
        S1 = MFMA32(fq5, Vb2, S1); \
        fq5 = SC_FRAG(bufoff, 55); \
        aO1 = MFMA32(fq6, Vb2, aO1); \
        S2 = MFMA32(fq7, Vb2, S2); \
        S3 = MFMA32(fq0, Vb2, S3); \
        S0 = MFMA32(fq1, Vb3, S0); \
        S1 = MFMA32(fq2, Vb3, S1); \
        aO1 = MFMA32(fq3, Vb3, aO1); \
        S2 = MFMA32(fq4, Vb3, S2); \
        S3 = MFMA32(fq5, Vb3, S3); \
        _Pragma("unroll") for (int r = 0; r < 16; ++r) { \
            *(LAS bf16*)(lds + (otoff) + (((r & 3) + 8 * (r >> 2) + 4 * hf) * OT_LD + 32 * w + c32) * 2) = (bf16)(pkbf(aO0[r], 0.f) & 0xffffu); \
            *(LAS bf16*)(lds + (otoff) + ((32 + (r & 3) + 8 * (r >> 2) + 4 * hf) * OT_LD + 32 * w + c32) * 2) = (bf16)(pkbf(aO1[r], 0.f) & 0xffffu); } \
        RAW_BAR(); } while (0)
        SC_LOADU(UA, 0);
        RAW_BAR();
#pragma unroll 1
        for (int n = 0; n < NCH; n += 2) { SC_CHUNK(n, UA, 0, OT_OFF); SC_CHUNK(n + 1, UA, SCB, OT_OFF + OT_BYTES); }
#undef SC_CHUNK
#undef SC_FRAG
#undef SC_LOADU
#endif
    } else {
#ifndef SCAN_NO_HELPER
        const int ht = F.tid - 256, tok = ht >> 2, q = ht & 3;
        const bf16* PROJ = (const bf16*)(ws + WS_PROJ); bf16* MIXIN = (bf16*)(ws + WS_MIXIN);
        const float* nw = a.in[I_NORMW] + layer * HD + 32 * q; f32x4 nwv[8];
#pragma unroll
        for (int i = 0; i < 8; ++i) nwv[i] = *(const f32x4*)(nw + 4 * i);
        v4u RA[14], ZA[4];
        const __amdgpu_buffer_rsrc_t rsI = __builtin_amdgcn_make_buffer_rsrc((void*)(IMG + chd0 * IMG_ELEMS), (short)0, NCH * NH * IMG_ELEMS * 2, 0x00020000);
        const __amdgpu_buffer_rsrc_t rsZ = __builtin_amdgcn_make_buffer_rsrc((void*)(PROJ + (size_t)b * SEQ * NPROJ), (short)0, SEQ * NPROJ * 2, 0x00020000);
        const unsigned zoff = (unsigned)(tok * NPROJ + 3072 + h * HD + 32 * q) * 2u;
#define SH_LOADIMG(dst, nn) do { _Pragma("unroll") for (int i_ = 0; i_ < 14; ++i_) dst[i_] = __builtin_amdgcn_raw_buffer_load_b128(rsI, (unsigned)ht * 16u, (unsigned)(nn) * (unsigned)(NH * IMG_ELEMS * 2) + (unsigned)i_ * 4096u, 0); } while (0)
#define SH_STOREIMG(src, bufoff) do { LAS v4u* p_ = (LAS v4u*)(lds + (bufoff)) + ht; _Pragma("unroll") for (int i_ = 0; i_ < 14; ++i_) p_[i_ * 256] = src[i_]; } while (0)
#define SH_LOADZ(dst, nn) do { _Pragma("unroll") for (int i_ = 0; i_ < 4; ++i_) dst[i_] = __builtin_amdgcn_raw_buffer_load_b128(rsZ, zoff + 16u * (unsigned)i_, (unsigned)(nn) * (unsigned)(CH * NPROJ * 2), 0); } while (0)
#define SH_EPI(mm, Z, otoff) do { const LAS v4u* op_ = (const LAS v4u*)(lds + (otoff) + (tok * OT_LD + 32 * q) * 2); v4u ow[4]; float ss = 0.f; \
        _Pragma("unroll") for (int i_ = 0; i_ < 4; ++i_) { ow[i_] = op_[i_]; _Pragma("unroll") for (int j_ = 0; j_ < 4; ++j_) { const float x0 = bflo(ow[i_][j_]), x1 = bfhi(ow[i_][j_]); ss += x0 * x0 + x1 * x1; } } \
        ss += __shfl_xor(ss, 1); ss += __shfl_xor(ss, 2); const float rr = 1.0f / sqrtf(ss * (1.0f / HD) + RMS_EPS); \
        v4u* yp_ = (v4u*)(MIXIN + ((size_t)b * SEQ + (size_t)(mm) * CH + tok) * D + h * HD + 32 * q); \
        _Pragma("unroll") for (int i_ = 0; i_ < 4; ++i_) { __builtin_amdgcn_sched_barrier(0); v4u o_; const f32x4 n0 = nwv[2 * i_], n1 = nwv[2 * i_ + 1]; \
            _Pragma("unroll") for (int j_ = 0; j_ < 4; ++j_) { const float z0 = bflo(Z[i_][j_]), z1 = bfhi(Z[i_][j_]); const float g0 = (j_ < 2 ? n0[2 * j_] : n1[2 * j_ - 4]), g1 = (j_ < 2 ? n0[2 * j_ + 1] : n1[2 * j_ - 3]); \
            o_[j_] = pkbf(bflo(ow[i_][j_]) * rr * g0 * z0 * sigmoidf_(z0), bfhi(ow[i_][j_]) * rr * g1 * z1 * sigmoidf_(z1)); } yp_[i_] = o_; } } while (0)
#define SH_STEP(nn, bufnext, otprev) do { \
        if ((nn) + 1 < NCH) SH_STOREIMG(RA, bufnext); \
        if ((nn) + 2 < NCH) SH_LOADIMG(RA, (nn) + 2); \
        if ((nn) >= 1) SH_EPI((nn) - 1, ZA, otprev); \
        SH_LOADZ(ZA, (nn)); \
        RAW_BAR(); } while (0)
        SH_LOADIMG(RA, 0);
        SH_STOREIMG(RA, 0);
        SH_LOADIMG(RA, 1);
        RAW_BAR();
#pragma unroll 1
        for (int n = 0; n < NCH; n += 2) { SH_STEP(n, SCB, OT_OFF + OT_BYTES); SH_STEP(n + 1, 0, OT_OFF); }
        SH_EPI(NCH - 1, ZA, OT_OFF + OT_BYTES);
#undef SH_STEP
#undef SH_EPI
#undef SH_LOADZ
#undef SH_STOREIMG
#undef SH_LOADIMG
#endif
    }
}

__device__ __forceinline__ void phase_ln1_router(const Frame& F0, const Args& a, int layer, int probe = 0) {
    PHASE_FRAME(F0);
    unsigned char* ws = OPQ_G(unsigned char, a.ws);
    LAS float* WRt = (LAS float*)F.lds;
    LAS float* GV = (LAS float*)(F.lds + RING_BYTES);
    LAS int* rowE = (LAS int*)(F.lds + AUX_OFF); LAS int* rowP = rowE + 128; LAS float* rowG = (LAS float*)(rowP + 128); LAS int* lcnt = (LAS int*)(rowG + 128); LAS int* lbase = lcnt + 16;
    const float* wr = OPQ_G(const float, a.in[I_WR]); const float* br = OPQ_G(const float, a.in[I_BR]);
    for (int idx = F.tid; idx < D * NE; idx += 512) WRt[(idx & 15) * D + (idx >> 4)] = wr[idx];
    { const float* g1 = a.in[I_LN1G] + (size_t)layer * D; const float* b1 = a.in[I_LN1B] + (size_t)layer * D; for (int i = F.tid; i < D; i += 512) { GV[i] = g1[i]; GV[D + i] = b1[i]; } }
    const bf16* PRE = (const bf16*)a.out; bf16* X1B = (bf16*)(ws + (probe ? WS_R1 : WS_X1B)); float* STATS = (float*)(ws + (probe ? WS_R1 + 70 * MiB : WS_STATS));
    int* LIST = (int*)(ws + (probe ? WS_R1 + 72 * MiB : WS_LIST)); int* TOKSLOT = (int*)(ws + (probe ? WS_R1 + 80 * MiB : WS_TOKSLOT)); float* GATEW = (float*)(ws + (probe ? WS_R1 + 82 * MiB : WS_GATEW));
    gu32* cnt = F.ctl + CW_CNT + 64 * (layer + (probe ? 2 : 0));
    const int lane = F.lane; const float brl = br[(lane >> 2) & 15];
    for (int rb = F.vcu; rb < T / 64; rb += F.G) {
        if (F.tid < 16) lcnt[F.tid] = 0;
        __syncthreads();
        v2u XA[8], XB_[8];
#define PE_LOAD(X, r) do { const GAS v2u* xr_ = (const GAS v2u*)(PRE + (size_t)(rb * 64 + F.wave * 8 + (r)) * D) + lane; _Pragma("unroll") for (int j = 0; j < 8; ++j) X[j] = xr_[64 * j]; } while (0)
#define PE_ROW(X, r) do { const int lr = F.wave * 8 + (r), row = rb * 64 + lr; unsigned gvo_ = (unsigned)(uintptr_t)GV; asm volatile("" : "+v"(gvo_)); const LAS float* GVr = (const LAS float*)(uintptr_t)gvo_; \
            f32x4 v[8]; float s = 0.f; \
            _Pragma("unroll") for (int j = 0; j < 8; ++j) { v[j] = (f32x4){bflo(X[j].x), bfhi(X[j].x), bflo(X[j].y), bfhi(X[j].y)}; s += (v[j][0] + v[j][1]) + (v[j][2] + v[j][3]); } \
            const float mean = wave_sum(s) * (1.f / D); float s2 = 0.f; \
            _Pragma("unroll") for (int j = 0; j < 8; ++j) { v[j] = v[j] - mean; s2 += (v[j][0] * v[j][0] + v[j][1] * v[j][1]) + (v[j][2] * v[j][2] + v[j][3] * v[j][3]); } \
            const float rstd = 1.f / sqrtf(wave_sum(s2) * (1.f / D) + LN_EPS); \
            if (lane == 0) { STATS[2 * row] = mean; STATS[2 * row + 1] = rstd; } \
            GAS v2u* o8 = (GAS v2u*)(X1B + (size_t)row * D) + lane; \
            float lg[16]; \
            _Pragma("unroll") for (int e = 0; e < 16; ++e) lg[e] = 0.f; \
            _Pragma("unroll") for (int j = 0; j < 8; ++j) { const f32x4 gg = *(const LAS f32x4*)(GVr + 256 * j + 4 * lane), bb = *(const LAS f32x4*)(GVr + D + 256 * j + 4 * lane); \
                v[j] = v[j] * rstd * gg + bb; \
                v2u w; w.x = pkbf(v[j][0], v[j][1]); w.y = pkbf(v[j][2], v[j][3]); o8[64 * j] = w; \
                _Pragma("unroll") for (int e = 0; e < 16; ++e) { const f32x4 w4 = *(const LAS f32x4*)(WRt + e * D + 256 * j + 4 * lane); lg[e] += (v[j][0] * w4[0] + v[j][1] * w4[1]) + (v[j][2] * w4[2] + v[j][3] * w4[3]); } } \
              \
            float t8[8], t4[4], t2[2], t1; \
            { const bool hi = (lane & 32) != 0; _Pragma("unroll") for (int i = 0; i < 8; ++i) { const float snd = hi ? lg[i] : lg[8 + i], kp = hi ? lg[8 + i] : lg[i]; t8[i] = kp + __shfl_xor(snd, 32); } } \
            { const bool hi = (lane & 16) != 0; _Pragma("unroll") for (int i = 0; i < 4; ++i) { const float snd = hi ? t8[i] : t8[4 + i], kp = hi ? t8[4 + i] : t8[i]; t4[i] = kp + __shfl_xor(snd, 16); } } \
            { const bool hi = (lane & 8) != 0; _Pragma("unroll") for (int i = 0; i < 2; ++i) { const float snd = hi ? t4[i] : t4[2 + i], kp = hi ? t4[2 + i] : t4[i]; t2[i] = kp + __shfl_xor(snd, 8); } } \
            { const bool hi = (lane & 4) != 0; const float snd = hi ? t2[0] : t2[1], kp = hi ? t2[1] : t2[0]; t1 = kp + __shfl_xor(snd, 4); } \
            t1 += __shfl_xor(t1, 2); t1 += __shfl_xor(t1, 1); t1 += brl; \
            float lgu[16]; float mx = -3.0e38f; \
            _Pragma("unroll") for (int e = 0; e < 16; ++e) { lgu[e] = __builtin_bit_cast(float, __builtin_amdgcn_readlane(__builtin_bit_cast(int, t1), 4 * e)); mx = fmaxf(mx, lgu[e]); } \
            float p[16]; \
            _Pragma("unroll") for (int e = 0; e < 16; ++e) p[e] = __expf(lgu[e] - mx); \
            float gsc[4]; \
            _Pragma("unroll") for (int g = 0; g < 4; ++g) { const float a0 = p[4 * g], a1 = p[4 * g + 1], a2 = p[4 * g + 2], a3 = p[4 * g + 3]; \
                const float hi1 = fmaxf(a0, a1), lo1 = fminf(a0, a1), hi2 = fmaxf(a2, a3), lo2 = fminf(a2, a3); \
                gsc[g] = fmaxf(hi1, hi2) + fmaxf(fminf(hi1, hi2), fmaxf(lo1, lo2)); } \
            int gsel = 0; float best = gsc[0]; \
            _Pragma("unroll") for (int g = 1; g < 4; ++g) if (gsc[g] > best) { best = gsc[g]; gsel = g; } \
            float q[4]; \
            _Pragma("unroll") for (int j = 0; j < 4; ++j) q[j] = gsel == 0 ? p[j] : (gsel == 1 ? p[4 + j] : (gsel == 2 ? p[8 + j] : p[12 + j])); \
            int i0 = 0; float p0 = q[0]; \
            _Pragma("unroll") for (int j = 1; j < 4; ++j) if (q[j] > p0) { p0 = q[j]; i0 = j; } \
            int i1 = -1; float p1 = -1.f; \
            _Pragma("unroll") for (int j = 0; j < 4; ++j) if (j != i0 && q[j] > p1) { p1 = q[j]; i1 = j; } \
            if (lane == 0) { const int e0 = gsel * 4 + i0, e1 = gsel * 4 + i1; const float inv = 1.0f / (p0 + p1); \
                rowE[2 * lr] = e0; rowE[2 * lr + 1] = e1; rowG[2 * lr] = p0 * inv; rowG[2 * lr + 1] = p1 * inv; \
                rowP[2 * lr] = __hip_atomic_fetch_add(&lcnt[e0], 1, __ATOMIC_RELAXED, __HIP_MEMORY_SCOPE_WORKGROUP); rowP[2 * lr + 1] = __hip_atomic_fetch_add(&lcnt[e1], 1, __ATOMIC_RELAXED, __HIP_MEMORY_SCOPE_WORKGROUP); } } while (0)
        PE_LOAD(XA, 0);
#pragma unroll 1
        for (int r = 0; r < 8; r += 2) { PE_LOAD(XB_, r + 1); PE_ROW(XA, r); if (r + 2 < 8) PE_LOAD(XA, r + 2); PE_ROW(XB_, r + 1); }
#undef PE_LOAD
#undef PE_ROW
        __syncthreads();
        if (F.tid < 16) lbase[F.tid] = (int)__hip_atomic_fetch_add(cnt + F.tid, (unsigned)lcnt[F.tid], RLX_AGENT);
        __syncthreads();
        if (F.tid < 128) { const int e = rowE[F.tid], pos = lbase[e] + rowP[F.tid], tok = rb * 64 + (F.tid >> 1);
            LIST[(size_t)e * LCAP + pos] = tok; TOKSLOT[2 * tok + (F.tid & 1)] = e * LCAP + pos; GATEW[2 * tok + (F.tid & 1)] = rowG[F.tid]; }
        __syncthreads();
    }
}
__device__ __forceinline__ void moe_table(const Frame& F0, int layer) {
    PHASE_FRAME(F0);
    LAS int* tab = (LAS int*)(F.lds + AUX_OFF);
    __syncthreads();
    if (F.tid < 16) tab[32 + F.tid] = (int)__hip_atomic_load(F.ctl + CW_CNT + 64 * layer + F.tid, RLX_AGENT);
    __syncthreads();
    if (F.tid == 0) { int run = 0; for (int e = 0; e < 16; ++e) { tab[e] = run; run += (tab[32 + e] + 255) >> 8; } tab[16] = run; }
    __syncthreads();
}
__device__ __forceinline__ void phase_combine_ln2(const Frame& F0, const Args& a, int layer, int probe = 0) {
    PHASE_FRAME(F0);
    unsigned char* ws = OPQ_G(unsigned char, a.ws); const LAS int* tab = (const LAS int*)(F.lds + AUX_OFF);
    const bf16* PRE = (const bf16*)a.out; const float* STATS = (const float*)(ws + WS_STATS); const bf16* Y = (const bf16*)(ws + WS_Y); bf16* X2B = (bf16*)(ws + (probe ? WS_R1 : WS_X2B));
    const int* TOKSLOT = (const int*)(ws + WS_TOKSLOT); const float* GATEW = (const float*)(ws + WS_GATEW);
    LAS float* GV = (LAS float*)F.lds;
    { const float* g1 = a.in[I_LN1G] + (size_t)layer * D; const float* b1 = a.in[I_LN1B] + (size_t)layer * D; const float* g2 = a.in[I_LN2G] + (size_t)layer * D; const float* b2 = a.in[I_LN2B] + (size_t)layer * D;
        for (int i = F.tid; i < D; i += 512) { GV[i] = g1[i]; GV[D + i] = b1[i]; GV[2 * D + i] = g2[i]; GV[3 * D + i] = b2[i]; } }
    __syncthreads();
    const int gw = F.vcu * NWAVES + F.wave, NGW = F.G * NWAVES, nrows = (T - gw + NGW - 1) / NGW, lane = F.lane;
    for (int base = 0; base < nrows; base += 64) {
        const int nr = (nrows - base) < 64 ? (nrows - base) : 64;
        float m_mean = 0.f, m_rstd = 0.f, m_w0 = 0.f, m_w1 = 0.f; int m_y0 = 0, m_y1 = 0;
        if (lane < nr) { const int row = gw + NGW * (base + lane); m_mean = STATS[2 * row]; m_rstd = STATS[2 * row + 1]; m_w0 = GATEW[2 * row]; m_w1 = GATEW[2 * row + 1];
            const int s0 = TOKSLOT[2 * row], s1 = TOKSLOT[2 * row + 1]; m_y0 = tab[s0 / LCAP] * 256 + (s0 % LCAP); m_y1 = tab[s1 / LCAP] * 256 + (s1 % LCAP); }
        v2u XA[8], PA[8], QA[8], XB_[8], PB_[8], QB_[8];
#define PH_LOAD(X, P, Q, i) do { const int row_ = gw + NGW * (base + (i)); const size_t y0_ = (size_t)__builtin_amdgcn_readlane(m_y0, (i)), y1_ = (size_t)__builtin_amdgcn_readlane(m_y1, (i)); \
            const GAS v2u* xr_ = (const GAS v2u*)(PRE + (size_t)row_ * D) + lane; const GAS v2u* ya_ = (const GAS v2u*)(Y + y0_ * D) + lane; const GAS v2u* yb_ = (const GAS v2u*)(Y + y1_ * D) + lane; \
            _Pragma("unroll") for (int j = 0; j < 8; ++j) { X[j] = xr_[64 * j]; P[j] = ya_[64 * j]; Q[j] = yb_[64 * j]; } } while (0)
#define PH_ROW(X, P, Q, i) do { const int row_ = gw + NGW * (base + (i)); unsigned gvo_ = (unsigned)(uintptr_t)GV; asm volatile("" : "+v"(gvo_)); const LAS float* GVr = (const LAS float*)(uintptr_t)gvo_;     \
            const float mean = __builtin_bit_cast(float, __builtin_amdgcn_readlane(__builtin_bit_cast(int, m_mean), (i))), rstd = __builtin_bit_cast(float, __builtin_amdgcn_readlane(__builtin_bit_cast(int, m_rstd), (i))); \
            const float w0 = __builtin_bit_cast(float, __builtin_amdgcn_readlane(__builtin_bit_cast(int, m_w0), (i))), w1 = __builtin_bit_cast(float, __builtin_amdgcn_readlane(__builtin_bit_cast(int, m_w1), (i))); \
            f32x4 v[8]; float s = 0.f; \
            _Pragma("unroll") for (int j = 0; j < 8; ++j) { const f32x4 gg = *(const LAS f32x4*)(GVr + 256 * j + 4 * lane), bb = *(const LAS f32x4*)(GVr + D + 256 * j + 4 * lane); \
                const f32x4 x1 = ((f32x4){bflo(X[j].x), bfhi(X[j].x), bflo(X[j].y), bfhi(X[j].y)} - mean) * rstd * gg + bb; \
                f32x4 f; f[0] = w0 * bflo(P[j].x) + w1 * bflo(Q[j].x); f[1] = w0 * bfhi(P[j].x) + w1 * bfhi(Q[j].x); f[2] = w0 * bflo(P[j].y) + w1 * bflo(Q[j].y); f[3] = w0 * bfhi(P[j].y) + w1 * bfhi(Q[j].y); \
                v[j] = x1 * ALPHA + f; s += (v[j][0] + v[j][1]) + (v[j][2] + v[j][3]); } \
            const float m2 = wave_sum(s) * (1.f / D); float q = 0.f; \
            _Pragma("unroll") for (int j = 0; j < 8; ++j) { v[j] = v[j] - m2; q += (v[j][0] * v[j][0] + v[j][1] * v[j][1]) + (v[j][2] * v[j][2] + v[j][3] * v[j][3]); } \
            const float r2 = 1.f / sqrtf(wave_sum(q) * (1.f / D) + LN_EPS); \
            GAS v2u* o8 = (GAS v2u*)(X2B + (size_t)row_ * D) + lane; \
            _Pragma("unroll") for (int j = 0; j < 8; ++j) { const f32x4 gg = *(const LAS f32x4*)(GVr + 2 * D + 256 * j + 4 * lane), bb = *(const LAS f32x4*)(GVr + 3 * D + 256 * j + 4 * lane); \
                const f32x4 o = v[j] * r2 * gg + bb; v2u w; w.x = pkbf(o[0], o[1]); w.y = pkbf(o[2], o[3]); o8[64 * j] = w; } } while (0)
        PH_LOAD(XA, PA, QA, 0);
#pragma unroll 1
        for (int i = 0; i < nr; i += 2) {
            if (i + 1 < nr) PH_LOAD(XB_, PB_, QB_, i + 1);
            PH_ROW(XA, PA, QA, i);
            if (i + 2 < nr) PH_LOAD(XA, PA, QA, i + 2);
            if (i + 1 < nr) PH_ROW(XB_, PB_, QB_, i + 1);
        }
#undef PH_LOAD
#undef PH_ROW
    }
}

#ifndef MK_N_LAUNCHES
#define MK_N_LAUNCHES 1
#endif
constexpr int NPL = 9;
constexpr int NPHASE = 1 + NPL * DEPTH;
constexpr int N_LAUNCHES = MK_N_LAUNCHES;
static_assert(N_LAUNCHES == 1 || N_LAUNCHES == NPHASE, "MK_N_LAUNCHES is 1 or NPHASE");

__global__ void __launch_bounds__(NWAVES * 64, 2) trunk_fwd(Args args) {
    extern __shared__ __attribute__((aligned(16))) unsigned char lds[];
    Frame F;
    F.lds = (LAS unsigned char*)lds;
    F.MISC = (volatile LAS unsigned*)(F.lds + MISC_OFF);
    F.tid = threadIdx.x; F.lane = F.tid & 63; F.wave = __builtin_amdgcn_readfirstlane(F.tid >> 6);
    F.G = gridDim.x; { const int bx = blockIdx.x; F.vcu = (F.G % 8 == 0) ? (bx % 8) * (F.G / 8) + bx / 8 : bx; }
    unsigned char* ws = args.ws;
    F.ctl = (gu32*)(ws + WS_CTL);
    for (int u = F.tid; u < (LDS_BYTES - LDSCTL_OFF) / 4; u += NWAVES * 64) ((LAS unsigned*)(F.lds + LDSCTL_OFF))[u] = 0u;
    __syncthreads();
    XcdBarrier bar; bar.bar = (unsigned*)(F.ctl + CW_BAR); bar.x = 0; bar.st = nullptr;
    if (N_LAUNCHES == 1) bar = xcd_barrier_post((unsigned*)(F.ctl + CW_BAR), F.MISC + 8);
#define GRID_BAR() do { if (N_LAUNCHES == 1) xcd_barrier(bar); } while (0)
    const int lo = args.ph_lo, hi = args.ph_hi;
#ifndef PH_MASK
#define PH_MASK 0x7ff
#endif
#define IN(k) ((((k) == 0 ? 1u : (2u << (((k) - 1) % NPL))) & (unsigned)(PH_MASK)) && lo <= (k) && (k) < hi)
#define SEAM(k) do { if (IN((k) + 1)) GRID_BAR(); } while (0)
#ifndef PROBE_DUP
#define PROBE_DUP 0
#endif
#define REPS(k) ((((k) == 0 ? 1u : (2u << (((k) - 1) % NPL))) & (unsigned)(PROBE_DUP)) ? 2 : 1)

    if (IN(0)) { for (int rep = 0; rep < REPS(0); ++rep) { if (rep) GRID_BAR(); p0_prologue(F, args); } SEAM(0); }

#ifdef LAYER_UNROLL
#pragma unroll
#else
#pragma unroll 1
#endif
    for (int layer = 0; layer < DEPTH; ++layer) {
        const int pb = 1 + NPL * layer;
        unsigned char* ws = OPQ_G(unsigned char, args.ws);
        if (IN(pb + 0)) { for (int rep = 0; rep < REPS(pb + 0); ++rep) { if (rep) GRID_BAR();
            SchedDense S; S.init(T, NPROJ, F.G, (int)blockIdx.x, ws + WS_XB, D, (const bf16*)(ws + WS_WIN) + (size_t)layer * NPROJ * D, D);
            EpiBf16 E{(bf16*)(ws + WS_PROJ), NPROJ};
            pg8::gemm_phase<EpiBf16, SchedDense, false>(F.lds + RING_OFF, D, D, D, S, E);
            } SEAM(pb + 0);
        }
        if (IN(pb + 1)) { for (int rep = 0; rep < REPS(pb + 1); ++rep) { if (rep) GRID_BAR(); phase_dn_prep(F, args, layer); } SEAM(pb + 1); }
        if (IN(pb + 2)) { for (int rep = 0; rep < REPS(pb + 2); ++rep) { if (rep) GRID_BAR();
            if (blockIdx.x < 32 || F.G <= 32) { for (int u = blockIdx.x; u < NB * NH; u += (F.G < 32 ? F.G : 32)) { phase_dn_scan(F, args, layer, u);
#ifdef SCAN_TWICE
                __syncthreads(); phase_dn_scan(F, args, layer, u);
#endif
            } }
            if (blockIdx.x >= 32 || F.G <= 32) { const int G2 = F.G <= 32 ? F.G : F.G - 32, c2 = F.G <= 32 ? (int)blockIdx.x : (int)blockIdx.x - 32;
                { SchedPool S{G2, c2, (const char*)(ws + WS_POOLD), (const char*)((const bf16*)(ws + WS_WPOOL) + (size_t)layer * 4 * 65536)};
                  EpiPool E{(bf16*)(ws + WS_MIXIN), args.in[I_POOLS] + (size_t)layer * PW};
                  pg8::gemm_phase<EpiPool, SchedPool, false>(F.lds + RING_OFF, 256, PW, 256, S, E); }
                { SchedDense S; S.init(T, D, G2, c2, (const bf16*)(ws + WS_PB16) + (size_t)layer * T * PLE, PLE, (const bf16*)(ws + WS_WPP) + (size_t)layer * D * PLE, PLE);
                  EpiBf16 E{(bf16*)(ws + WS_PP), D};
                  pg8::gemm_phase<EpiBf16, SchedDense, false>(F.lds + RING_OFF, PLE, PLE, PLE, S, E); }
#ifndef CONVERT_ALL_IN_PROLOGUE
                { int t_ = threadIdx.x; asm volatile("" : "+v"(t_)); weight_items(args, ws, (LAS float*)(F.lds + RING_OFF + F.wave * 16384), t_ & 63, 1, layer, c2 * NWAVES + F.wave, G2 * NWAVES); }
#endif
                }
            } SEAM(pb + 2);
        }
        if (IN(pb + 3)) { for (int rep = 0; rep < REPS(pb + 3); ++rep) { if (rep) GRID_BAR();
            SchedDense S; S.init(T, D, F.G, (int)blockIdx.x, ws + WS_MIXIN, D, (const bf16*)(ws + WS_WOUT) + (size_t)layer * D * D, D);
            EpiRes E{(const bf16*)(ws + WS_XB), (bf16*)args.out};
#ifdef PROBE_PD
            { EpiRes E2{(const bf16*)(ws + WS_XB), (bf16*)(ws + WS_R1)}; pg8::gemm_phase<EpiRes, SchedDense, false>(F.lds + RING_OFF, D, D, D, S, E2); }
#endif
            pg8::gemm_phase<EpiRes, SchedDense, false>(F.lds + RING_OFF, D, D, D, S, E);
            } SEAM(pb + 3);
        }
        if (IN(pb + 4)) { for (int rep = 0; rep < REPS(pb + 4); ++rep) { if (rep) GRID_BAR();
#ifdef PROBE_PE
            phase_ln1_router(F, args, layer, 1); __syncthreads();
#endif
            phase_ln1_router(F, args, layer); } SEAM(pb + 4); }
        if (IN(pb + 5)) { for (int rep = 0; rep < REPS(pb + 5); ++rep) { if (rep) GRID_BAR();
            moe_table(F, layer);
            SchedMoe S{F.G, (int)blockIdx.x, 0, (const LAS int*)(F.lds + AUX_OFF), (const char*)(ws + WS_X1B), (const char*)((const bf16*)(ws + WS_WGU) + (size_t)layer * NE * 2048 * D), (const int*)(ws + WS_LIST)};
            EpiSwiglu E{(bf16*)(ws + WS_HID)};
            pg8::gemm_phase<EpiSwiglu, SchedMoe, true>(F.lds + RING_OFF, D, D, D, S, E);
            } SEAM(pb + 5);
        }
        if (IN(pb + 6)) { for (int rep = 0; rep < REPS(pb + 6); ++rep) { if (rep) GRID_BAR();
            moe_table(F, layer);
            SchedMoe S{F.G, (int)blockIdx.x, 1, (const LAS int*)(F.lds + AUX_OFF), (const char*)(ws + WS_HID), (const char*)((const bf16*)(ws + WS_WD) + (size_t)layer * NE * D * DE), nullptr};
            EpiBf16 E{(bf16*)(ws + WS_Y), D};
            pg8::gemm_phase<EpiBf16, SchedMoe, false>(F.lds + RING_OFF, DE, DE, DE, S, E);
            } SEAM(pb + 6);
        }
        if (IN(pb + 7)) { for (int rep = 0; rep < REPS(pb + 7); ++rep) { if (rep) GRID_BAR(); moe_table(F, layer);
#ifdef PROBE_PH
            phase_combine_ln2(F, args, layer, 1);
#endif
            phase_combine_ln2(F, args, layer); } SEAM(pb + 7); }
        if (IN(pb + 8)) { for (int rep = 0; rep < REPS(pb + 8); ++rep) { if (rep) GRID_BAR();
            { SchedDense S; S.init(T, D, F.G, (int)blockIdx.x, ws + WS_X2B, D, (const bf16*)(ws + WS_WPG) + (size_t)layer * D * D, D);
#ifdef PROBE_PI
              { EpiPle E2{(const bf16*)(ws + WS_X2B), (const bf16*)(ws + WS_PP), (bf16*)(ws + WS_R1), (float*)(ws + WS_R1), layer + 1 < DEPTH ? 0 : 1}; pg8::gemm_phase<EpiPle, SchedDense, false>(F.lds + RING_OFF, D, D, D, S, E2); }
#endif
              EpiPle E{(const bf16*)(ws + WS_X2B), (const bf16*)(ws + WS_PP), (bf16*)(ws + WS_XB), args.out, layer + 1 < DEPTH ? 0 : 1};
              pg8::gemm_phase<EpiPle, SchedDense, false>(F.lds + RING_OFF, D, D, D, S, E); }
            } SEAM(pb + 8);
        }
    }
#undef IN
#undef SEAM
#undef GRID_BAR
}

extern "C" void kernel_launch(void* const* d_in, const int* in_sizes, int n_in, void* d_out, int out_size, void* d_ws, size_t ws_size, hipStream_t stream) {
    static int grid = 0;
    if (grid == 0) {
        if (n_in != 21 || in_sizes[0] != T * D || out_size != T * D || ws_size < WS_END) { fprintf(stderr, "kernel_launch: unexpected shapes (n_in %d, in0 %d, out %d, ws %zu); nothing launched\n", n_in, n_in > 0 ? in_sizes[0] : -1, out_size, ws_size); grid = -1; return; }
        int dev = 0, cus = 0, per_cu = 0;
        if (hipGetDevice(&dev) != hipSuccess || hipDeviceGetAttribute(&cus, hipDeviceAttributeMultiprocessorCount, dev) != hipSuccess) { grid = -1; return; }
        if (hipFuncSetAttribute((const void*)trunk_fwd, hipFuncAttributeMaxDynamicSharedMemorySize, LDS_BYTES) != hipSuccess) { fprintf(stderr, "kernel_launch: hipFuncSetAttribute failed\n"); grid = -1; return; }
        if (hipOccupancyMaxActiveBlocksPerMultiprocessor(&per_cu, (const void*)trunk_fwd, NWAVES * 64, LDS_BYTES) != hipSuccess || per_cu < 1) { fprintf(stderr, "kernel_launch: occupancy query reports %d workgroups per CU\n", per_cu); }
        (void)hipGetLastError();
        grid = cus;
    }
    if (grid < 0) return;
    if (hipMemsetAsync((char*)d_ws + WS_CTL, 0, CTL_ZERO_BYTES, stream) != hipSuccess) return;
    Args a{};
    for (int i = 0; i < 21; ++i) a.in[i] = (const float*)d_in[i];
    a.out = (float*)d_out; a.ws = (unsigned char*)d_ws;
    for (int li = 0; li < N_LAUNCHES; ++li) {
        a.ph_lo = (N_LAUNCHES == 1) ? 0 : li; a.ph_hi = (N_LAUNCHES == 1) ? NPHASE : li + 1; a.li = li; a.pad = 0;
        hipLaunchKernelGGL(trunk_fwd, dim3(grid), dim3(NWAVES * 64), LDS_BYTES, stream, a);
        const hipError_t le = hipPeekAtLastError();
        if (le != hipSuccess) { fprintf(stderr, "kernel_launch: launch %d failed: %s\n", li, hipGetErrorName(le)); break; }
    }
}
```

```cpp
#define MK_N_LAUNCHES 1
#define CONVERT_ALL_IN_PROLOGUE 1
#include <hip/hip_runtime.h>
#include <cstdio>
#include <cstdint>

#define GAS __attribute__((address_space(1)))
#define LAS __attribute__((address_space(3)))
typedef unsigned short bf16;
typedef unsigned v4u __attribute__((ext_vector_type(4)));
typedef unsigned v2u __attribute__((ext_vector_type(2)));
typedef float f32x4 __attribute__((ext_vector_type(4)));
typedef float f32x2 __attribute__((ext_vector_type(2)));
typedef short bf16x8 __attribute__((ext_vector_type(8)));
typedef GAS unsigned gu32;

namespace pg8 {
constexpr int BM = 256, BK = 64, HALF = 128, HTB = HALF * BK * 2  , STAGE_BYTES = 8 * HTB, NXCD = 8, WGM = 8;
__host__ __device__ __forceinline__ int lds_byte(int r, int c) { const int st = (r >> 4) * 2 + (c >> 5), rr = r & 15, cc = c & 31, ob = rr * 64 + cc * 2; return st * 1024 + (ob ^ (((ob >> 9) & 1) << 5)); }
__host__ __device__ __forceinline__ void stage_rc(int b, int& R, int& C) { const int st = b / 1024, sb = b % 1024, swz = sb ^ (((sb >> 9) & 1) << 5); R = (st >> 1) * 16 + swz / 64; C = (st & 1) * 32 + (swz % 64) / 2; }
__host__ __device__ __forceinline__ int perm32(int rho) { const int n = rho >> 4, i = rho & 15; return 8 * (i >> 2) + 4 * n + (i & 3); }

struct Unit { int pm, pn; const char* A; const char* B; const int* rows; int nvalid; int aux; };

__device__ __forceinline__ unsigned cvt_pk_bf16(float lo, float hi) { unsigned r; asm volatile("v_cvt_pk_bf16_f32 %0, %1, %2" : "=v"(r) : "v"(lo), "v"(hi)); return r; }

template <class Epi, class Sched, bool GATHER>
__device__ __forceinline__ void gemm_phase(LAS unsigned char* lds, const int K, const int lda, const int ldb, const Sched& S, const Epi& E) {
    int tid_ = threadIdx.x; asm volatile("" : "+v"(tid_));
    const int tid = tid_, wid = __builtin_amdgcn_readfirstlane(tid >> 6), lane = tid & 63, wr = wid >> 2, wc = wid & 3, fr = lane & 15, fq = lane >> 4;
    const int nt = K / BK;
    unsigned voffA[2], voffB[2]; int RA[2], CA[2];
#pragma unroll
    for (int i = 0; i < 2; ++i) { int R, C; stage_rc(tid * 16 + i * 8192, R, C); const int Rb = Epi::PERM ? ((R & ~31) + perm32(R & 31)) : R;
        RA[i] = R; CA[i] = C; voffA[i] = (unsigned)(R * lda + C) * 2u; voffB[i] = (unsigned)(Rb * ldb + C) * 2u; }
    unsigned gA[2][2], gN[2][2];
    const size_t kstep = (size_t)(BK * 2);
    const size_t hstepA = GATHER ? 0 : (size_t)HALF * lda * 2, hstepB = (size_t)HALF * ldb * 2;
    const unsigned ldsw = (unsigned)wid * 1024u;
    const int aoff = lds_byte(wr * 64 + fr, fq * 8), boff = lds_byte(wc * 32 + fr, fq * 8);
#define PG8_SA(b, h) (((b) * 2 + (h)) * HTB)
#define PG8_SB(b, h) ((4 + (b) * 2 + (h)) * HTB)
#define PG8_STAGE_B(bufoff, gbase) do { _Pragma("unroll") for (int _i = 0; _i < 2; ++_i) \
        __builtin_amdgcn_global_load_lds((const unsigned*)((const char*)(gbase) + voffB[_i]), (LAS unsigned*)(lds + (bufoff) + ldsw + _i * 8192), 16, 0, 0); } while (0)
#define PG8_STAGE_A(bufoff, gbase, h) do { _Pragma("unroll") for (int _i = 0; _i < 2; ++_i) \
        __builtin_amdgcn_global_load_lds((const unsigned*)((const char*)(gbase) + (GATHER ? gA[h][_i] : voffA[_i]) + (h) * hstepA), (LAS unsigned*)(lds + (bufoff) + ldsw + _i * 8192), 16, 0, 0); } while (0)
#define PG8_LDA(dst, b, h) do { _Pragma("unroll") for (int m = 0; m < 4; ++m) _Pragma("unroll") for (int k = 0; k < 2; ++k) dst[m][k] = *(const LAS bf16x8*)(lds + PG8_SA(b, h) + aoff + m * 2048 + k * 1024); } while (0)
#define PG8_LDB(dst, b, h) do { _Pragma("unroll") for (int n = 0; n < 2; ++n) _Pragma("unroll") for (int k = 0; k < 2; ++k) dst[n][k] = *(const LAS bf16x8*)(lds + PG8_SB(b, h) + boff + n * 2048 + k * 1024); } while (0)
#define PG8_MMA(ai, bj, At, Bt) do { __builtin_amdgcn_s_setprio(1); _Pragma("unroll") for (int m = 0; m < 4; ++m) _Pragma("unroll") for (int n = 0; n < 2; ++n) _Pragma("unroll") for (int k = 0; k < 2; ++k) \
        acc[ai][bj][m][n] = __builtin_amdgcn_mfma_f32_16x16x32_bf16(Bt[n][k], At[m][k], acc[ai][bj][m][n], 0, 0, 0); __builtin_amdgcn_s_setprio(0); } while (0)
#define PG8_WAIT_V(n) asm volatile("s_waitcnt vmcnt(" #n ")" ::: "memory")
#define PG8_WAIT_L(n) asm volatile("s_waitcnt lgkmcnt(" #n ")" ::: "memory")
#define PG8_BAR __builtin_amdgcn_s_barrier()
#define PG8_SCHED __builtin_amdgcn_sched_barrier(0)
#define PG8_GLOAD(dst, u) do { _Pragma("unroll") for (int _h = 0; _h < 2; ++_h) _Pragma("unroll") for (int _i = 0; _i < 2; ++_i) { const int _r = _h * HALF + RA[_i]; \
        const int _t = (_r < (u).nvalid) ? (u).rows[_r] : 0; dst[_h][_i] = (unsigned)(_t * lda + CA[_i]) * 2u; } } while (0)
    Unit cur, nxt; int ui = 0;
    if (!S.next(0, cur)) return;
    f32x4 acc[2][2][4][2];
#pragma unroll
    for (int a = 0; a < 2; ++a)
#pragma unroll
        for (int b = 0; b < 2; ++b)
#pragma unroll
            for (int m = 0; m < 4; ++m)
#pragma unroll
                for (int n = 0; n < 2; ++n) acc[a][b][m][n] = (f32x4){0.f, 0.f, 0.f, 0.f};
    bf16x8 At[4][2], B0[2][2], B1[2][2];
    const char* cA = cur.A; const char* cB = cur.B;
    if constexpr (GATHER) { PG8_GLOAD(gA, cur); PG8_WAIT_V(0); }
    PG8_STAGE_B(PG8_SB(0, 0), cB); PG8_STAGE_B(PG8_SB(0, 1), cB + hstepB); PG8_STAGE_A(PG8_SA(0, 0), cA, 0); PG8_STAGE_A(PG8_SA(0, 1), cA, 1);
    if (wr == 1) PG8_BAR;
    PG8_WAIT_V(2); PG8_BAR;
    PG8_STAGE_B(PG8_SB(1, 0), cB + kstep); PG8_STAGE_A(PG8_SA(1, 0), cA + kstep, 0); PG8_STAGE_B(PG8_SB(1, 1), cB + hstepB + kstep);
    PG8_WAIT_V(6); PG8_BAR;
    for (;;) {
        const bool has_next = S.next(ui + 1, nxt);
        const char* nA = has_next ? nxt.A : cA; const char* nB = has_next ? nxt.B : cB;
        if constexpr (GATHER) { if (has_next) { PG8_GLOAD(gN, nxt); } else {
#pragma unroll
            for (int h = 0; h < 2; ++h)
#pragma unroll
                for (int i = 0; i < 2; ++i) gN[h][i] = gA[h][i]; } }
#pragma unroll 1
        for (int t = 0; t < nt; t += 2) {
            const bool last = (t == nt - 2);
            const char* a1 = cA + (size_t)(t + 1) * kstep;
            const char* a2 = last ? nA : cA + (size_t)(t + 2) * kstep; const char* b2 = last ? nB : cB + (size_t)(t + 2) * kstep;
            const char* a3 = a2 + kstep; const char* b3 = b2 + kstep;
            PG8_LDB(B0, 0, 0); PG8_LDB(B1, 0, 1); PG8_SCHED; PG8_LDA(At, 0, 0); PG8_STAGE_A(PG8_SA(1, 1), a1, 1);
            if constexpr (GATHER) { if (last) {
#pragma unroll
                for (int h = 0; h < 2; ++h)
#pragma unroll
                    for (int i = 0; i < 2; ++i) gA[h][i] = gN[h][i]; } }
            PG8_WAIT_V(8); PG8_WAIT_L(0); PG8_BAR; PG8_MMA(0, 0, At, B0); PG8_MMA(0, 1, At, B1); PG8_BAR; PG8_SCHED;
            PG8_LDA(At, 0, 1); PG8_STAGE_B(PG8_SB(0, 0), b2); PG8_STAGE_B(PG8_SB(0, 1), b2 + hstepB); PG8_STAGE_A(PG8_SA(0, 0), a2, 0);
            PG8_WAIT_V(8); PG8_WAIT_L(0); PG8_BAR; PG8_MMA(1, 0, At, B0); PG8_MMA(1, 1, At, B1); PG8_BAR; PG8_SCHED;
            PG8_LDB(B0, 1, 0); PG8_LDB(B1, 1, 1); PG8_SCHED; PG8_LDA(At, 1, 0); PG8_STAGE_A(PG8_SA(0, 1), a2, 1);
            PG8_WAIT_V(8); PG8_WAIT_L(0); PG8_BAR; PG8_MMA(0, 0, At, B0); PG8_MMA(0, 1, At, B1); PG8_BAR; PG8_SCHED;
            PG8_LDA(At, 1, 1); PG8_STAGE_B(PG8_SB(1, 0), b3); PG8_STAGE_B(PG8_SB(1, 1), b3 + hstepB); PG8_STAGE_A(PG8_SA(1, 0), a3, 0);
            PG8_WAIT_V(8); PG8_WAIT_L(0); PG8_BAR; PG8_MMA(1, 0, At, B0); PG8_MMA(1, 1, At, B1); PG8_BAR; PG8_SCHED;
        }
        if (wr == 0) PG8_BAR;
        E(acc, cur, wr, wc, fr, fq);
        if (!has_next) break;
#pragma unroll
        for (int a = 0; a < 2; ++a)
#pragma unroll
            for (int b = 0; b < 2; ++b)
#pragma unroll
                for (int m = 0; m < 4; ++m)
#pragma unroll
                    for (int n = 0; n < 2; ++n) acc[a][b][m][n] = (f32x4){0.f, 0.f, 0.f, 0.f};
        cur = nxt; cA = nA; cB = nB; ++ui;
        if (wr == 1) PG8_BAR;
    }
    PG8_WAIT_V(0);
    PG8_BAR;
#undef PG8_SA
#undef PG8_SB
#undef PG8_STAGE_A
#undef PG8_STAGE_B
#undef PG8_LDA
#undef PG8_LDB
#undef PG8_MMA
#undef PG8_WAIT_V
#undef PG8_WAIT_L
#undef PG8_BAR
#undef PG8_SCHED
#undef PG8_GLOAD
}
}

constexpr int NB = 4, SEQ = 4096, D = 2048, DEPTH = 2;
constexpr int T = NB * SEQ;
constexpr int NH = 8, HD = 128, DNW = 1024, CH = 64, NCH = SEQ / CH;
constexpr int PW = 1024, PG_DIM = 256;
constexpr int IN_COLS = 5136, NPROJ = 5120;
constexpr int NE = 16, DE = 1024, PLE = 256;
constexpr float ALPHA = 1.4142135623730951f;
constexpr float LN_EPS = 1e-5f, RMS_EPS = 1e-6f;
constexpr int LCAP = T;
constexpr int MAXTILES = 2 * T / 256 + NE;

constexpr size_t MiB = 1u << 20;
constexpr size_t WS_CTL = 0, CTL_ZERO_BYTES = 64 * 1024;
constexpr size_t WS_LIST = 2 * MiB;
constexpr size_t WS_TOKSLOT = 3 * MiB, WS_GATEW = WS_TOKSLOT + 128 * 1024, WS_STATS = WS_GATEW + 128 * 1024, WS_CD = WS_STATS + 128 * 1024, WS_WBA = WS_CD + 128 * 1024;
constexpr size_t WS_WIN = 4 * MiB, WS_WOUT = 44 * MiB, WS_WPG = 60 * MiB, WS_WPP = 76 * MiB, WS_WPOOL = 78 * MiB, WS_WGU = 80 * MiB, WS_WD = 336 * MiB, WS_PB16 = 464 * MiB;
constexpr size_t WS_XB = 480 * MiB, WS_R1 = 544 * MiB, WS_R2 = 704 * MiB, WS_R4 = 848 * MiB, WS_R5 = 944 * MiB, WS_END = 1008 * MiB;
constexpr size_t WS_PROJ = WS_R1, WS_HID = WS_R1;
constexpr size_t WS_Y = WS_R2;
constexpr size_t WS_POOLD = WS_R4, WS_PP = WS_R4 + 32 * MiB, WS_X1B = WS_R2;
constexpr size_t WS_MIXIN = WS_R5, WS_X2B = WS_R5;
static_assert((size_t)MAXTILES * 256 * 2048 * 2 <= 144 * MiB && (size_t)MAXTILES * 256 * 1024 * 2 <= 160 * MiB, "MoE row buffers");
constexpr int CW_TMO = 0, CW_CODE = 1, CW_CNT = 64  , CW_BAR = 4096;

constexpr int RING_OFF = 0, RING_BYTES = 131072;
constexpr int LDSCTL_OFF = 152 * 1024, MISC_OFF = LDSCTL_OFF + 320;
constexpr int AUX_OFF = LDSCTL_OFF + 1024;
constexpr int LDS_BYTES = 163840;
constexpr int NWAVES = 8;

#define RLX_AGENT __ATOMIC_RELAXED, __HIP_MEMORY_SCOPE_AGENT
#define LDS_WAIT() asm volatile("s_waitcnt lgkmcnt(0)" ::: "memory")
#define VM_WAIT() asm volatile("s_waitcnt vmcnt(0)" ::: "memory")
__device__ __forceinline__ unsigned f2bf(float f) { unsigned u = __builtin_bit_cast(unsigned, f); return (u + 0x7fffu + ((u >> 16) & 1u)) >> 16; }
__device__ __forceinline__ unsigned pk2(float lo, float hi) { return f2bf(lo) | (f2bf(hi) << 16); }
typedef __bf16 bf2_t __attribute__((ext_vector_type(2)));
__device__ __forceinline__ unsigned pkbf(float lo, float hi) { const f32x2 v = {lo, hi}; return __builtin_bit_cast(unsigned, __builtin_convertvector(v, bf2_t)); }
__device__ __forceinline__ float bf2f(unsigned short b) { return __builtin_bit_cast(float, ((unsigned)b) << 16); }
__device__ __forceinline__ float bflo(unsigned w) { return __builtin_bit_cast(float, w << 16); }
__device__ __forceinline__ float bfhi(unsigned w) { return __builtin_bit_cast(float, w & 0xffff0000u); }
__device__ __forceinline__ float sigmoidf_(float x) { return __builtin_amdgcn_rcpf(1.0f + __expf(-x)); }
__device__ __forceinline__ float wave_sum(float v) {
#pragma unroll
    for (int o = 1; o < 64; o <<= 1) v += __shfl_xor(v, o);
    return v;
}
#define XB_TMO      128
#define XB_XCNT(j)  (256  + 64 * (j))
#define XB_XSUB(j)  (1280 + 64 * (j))
#define XB_XGEN(j)  (2304 + 64 * (j))
#define XB_TOP      3328
#define XB_TOPGEN   3392
#define XCD_BAR_WORDS 3456
#define XB_SPIN_CAP (1u << 18)

__device__ __forceinline__ unsigned xb_ld(unsigned* p)              { return __hip_atomic_load(p, __ATOMIC_RELAXED, __HIP_MEMORY_SCOPE_AGENT); }
__device__ __forceinline__ unsigned xb_add(unsigned* p, unsigned v) { return __hip_atomic_fetch_add(p, v, __ATOMIC_RELAXED, __HIP_MEMORY_SCOPE_AGENT); }
__device__ __forceinline__ unsigned xb_xcc_id() { return (unsigned)__builtin_amdgcn_s_getreg((3 << 11) | 20) & 0xFu; }
#define XB_SPIN(cond, bar) do { unsigned _sp = 0; while (cond) { __builtin_amdgcn_s_sleep(1); \
    if ((++_sp & 255u) == 0u) { if (xb_ld(&(bar)[XB_TMO])) break; if (_sp > XB_SPIN_CAP) { atomicAdd(&(bar)[XB_TMO], 1u); break; } } } } while (0)

struct XcdBarrier {
    unsigned* bar; unsigned x;
    volatile LAS unsigned* st;
};

__device__ __forceinline__ XcdBarrier xcd_barrier_post(unsigned* bar, volatile LAS unsigned* st) {
    XcdBarrier b; b.bar = bar; b.x = xb_xcc_id(); b.st = st;
    if (threadIdx.x == 0) (void)xb_add(&bar[XB_XCNT(b.x)], 1u);
    return b;
}
__device__ __forceinline__ void xcd_barrier_complete(unsigned* bar, unsigned x, unsigned& nloc, unsigned& nx) {
    const unsigned G = gridDim.x * gridDim.y * gridDim.z;
    unsigned sum, cnt, mine, sp = 0u;
    for (;;) {
        sum = 0u; cnt = 0u; mine = 0u;
#pragma unroll
        for (unsigned j = 0; j < 16; ++j) { const unsigned c = xb_ld(&bar[XB_XCNT(j)]); sum += c; cnt += (c > 0u) ? 1u : 0u; mine = (j == x) ? c : mine; }
        if (sum == G) break;
        __builtin_amdgcn_s_sleep(1);
        if ((++sp & 255u) == 0u) { if (xb_ld(&bar[XB_TMO])) break; if (sp > XB_SPIN_CAP) { atomicAdd(&bar[XB_TMO], 1u); break; } }
    }
    nloc = mine > 0u ? mine : 1u; nx = cnt > 0u ? cnt : 1u;
}

__device__ __forceinline__ void xcd_barrier(const XcdBarrier& b) {
    asm volatile("s_waitcnt vmcnt(0)" ::: "memory");
    __syncthreads();
    if (threadIdx.x == 0) {
        unsigned* bar = b.bar;
        __builtin_amdgcn_s_waitcnt(0);
        unsigned nloc = b.st[0], nx = b.st[1];
        if (nloc == 0u) { xcd_barrier_complete(bar, b.x, nloc, nx); b.st[0] = nloc; b.st[1] = nx; }
        const unsigned old = xb_add(&bar[XB_XSUB(b.x)], 1u);
        const unsigned gen = old / nloc;
        if (old + 1u == (gen + 1u) * nloc) {
            __builtin_amdgcn_fence(__ATOMIC_RELEASE, "agent");
            asm volatile("s_waitcnt vmcnt(0)" ::: "memory");
            const unsigned og = xb_add(&bar[XB_TOP], 1u);
            const unsigned tg = og / nx;
            if (og + 1u == (tg + 1u) * nx) xb_add(&bar[XB_TOPGEN], 1u);
            else XB_SPIN(xb_ld(&bar[XB_TOPGEN]) == tg, bar);
            __builtin_amdgcn_fence(__ATOMIC_ACQUIRE, "agent");
            xb_add(&bar[XB_XGEN(b.x)], 1u);
            asm volatile("s_waitcnt vmcnt(0)" ::: "memory");
        } else {
            XB_SPIN(xb_ld(&bar[XB_XGEN(b.x)]) == gen, bar);
            __builtin_amdgcn_fence(__ATOMIC_ACQUIRE, "agent");
            asm volatile("s_waitcnt vmcnt(0)" ::: "memory");
        }
    }
    __syncthreads();
}

struct Args { const float* in[21]; float* out; unsigned char* ws; int ph_lo, ph_hi, li, pad; };
enum { I_X = 0, I_P, I_WIN, I_CONVW, I_ALOG, I_DTB, I_NORMW, I_POOLW, I_POOLS, I_WOUT, I_LN1G, I_LN1B, I_WR, I_BR, I_WEG, I_WEU, I_WED, I_LN2G, I_LN2B, I_WPP, I_WPG };
struct Frame {
    LAS unsigned char* lds;
    volatile LAS unsigned* MISC;
    gu32* ctl;
    int tid, lane, wave, vcu, G;
};

#define PHASE_FRAME(F0) Frame F = F0; { int t_ = threadIdx.x; asm volatile("" : "+v"(t_)); F.tid = t_; F.lane = t_ & 63; }
#define OPQ_S(p) asm volatile("" : "+s"(p))
#define OPQ_G(T, expr) ({ GAS T* g_ = (GAS T*)(expr); asm volatile("" : "+s"(g_)); (T*)g_; })
struct SchedDense {
    int nM, nN, nwg, G, c; const char* A; const char* B; size_t astep, bstep;
    __device__ __forceinline__ void init(int M, int N, int G_, int c_, const void* A_, int lda, const void* B_, int ldb) { nM = M / 256; nN = N / 256; nwg = nM * nN; G = G_; c = c_;
        A = (const char*)A_; B = (const char*)B_; astep = (size_t)256 * lda * 2; bstep = (size_t)256 * ldb * 2; }
    __device__ __forceinline__ bool next(int i, pg8::Unit& u) const {
        const long L = (long)i * G + c; if (L >= nwg) return false;
        int wgid = (int)L; { const int q = nwg / 8, r = nwg % 8, xcd = wgid % 8, off = wgid / 8; wgid = (xcd < r ? xcd * (q + 1) : r * (q + 1) + (xcd - r) * q) + off; }
        const int nig = 8 * nN, gid = wgid / nig, fm = gid * 8, gsz = (nM - fm) < 8 ? (nM - fm) : 8;
        u.pm = fm + ((wgid % nig) % gsz); u.pn = (wgid % nig) / gsz;
        u.A = A + (size_t)u.pm * astep; u.B = B + (size_t)u.pn * bstep; u.rows = nullptr; u.nvalid = 256; u.aux = 0; return true;
    }
};
struct SchedPool {
    int G, c; const char* A; const char* B;
    __device__ __forceinline__ bool next(int i, pg8::Unit& u) const {
        const int L = i * G + c; if (L >= 256) return false;
        u.pm = L >> 2; u.pn = L & 3; u.A = A + ((size_t)u.pm * 256 * PW + u.pn * 256) * 2; u.B = B + (size_t)u.pn * 65536 * 2; u.rows = nullptr; u.nvalid = 256; u.aux = 0; return true;
    }
};
struct SchedMoe {
    int G, c, mode; const LAS int* tab; const char* A; const char* B; const int* list;
    __device__ __forceinline__ bool next(int i, pg8::Unit& u) const {
        const int L = i * G + c, rt = L >> 3, pn = L & 7;
        const int ntiles = __builtin_amdgcn_readfirstlane(tab[16]); if (rt >= ntiles) return false;
        int e = 0;
#pragma unroll
        for (int k = 1; k < 16; ++k) { const int ts = __builtin_amdgcn_readfirstlane(tab[k]); if (rt >= ts) e = k; }
        const int ts = __builtin_amdgcn_readfirstlane(tab[e]), cn = __builtin_amdgcn_readfirstlane(tab[32 + e]);
        const int r0 = (rt - ts) * 256;
        u.pm = rt; u.pn = pn; u.aux = e;
        if (mode == 0) { u.A = A; u.rows = list + (size_t)e * LCAP + r0; u.nvalid = (cn - r0) < 256 ? (cn - r0) : 256; u.B = B + ((size_t)e * 2048 + pn * 256) * 2048 * 2; }
        else { u.A = A + (size_t)rt * 256 * DE * 2; u.rows = nullptr; u.nvalid = 256; u.B = B + ((size_t)e * 2048 + pn * 256) * DE * 2; }
        return true;
    }
};

using pg8::cvt_pk_bf16;
struct EpiBf16 {
    static constexpr bool PERM = true; bf16* O; int ldc;
    __device__ __forceinline__ void operator()(const f32x4 (&acc)[2][2][4][2], const pg8::Unit& u, int wr, int wc, int fr, int fq) const {
        const int row0 = u.pm * 256 + wr * 64 + fr, col0 = u.pn * 256 + wc * 32 + 8 * fq;
#pragma unroll
        for (int ai = 0; ai < 2; ++ai)
#pragma unroll
            for (int m = 0; m < 4; ++m) { bf16* rowp = O + (size_t)(row0 + ai * 128 + m * 16) * ldc + col0;
#pragma unroll
                for (int bj = 0; bj < 2; ++bj) { const f32x4 v0 = acc[ai][bj][m][0], v1 = acc[ai][bj][m][1];
                    v4u w; w.x = cvt_pk_bf16(v0[0], v0[1]); w.y = cvt_pk_bf16(v0[2], v0[3]); w.z = cvt_pk_bf16(v1[0], v1[1]); w.w = cvt_pk_bf16(v1[2], v1[3]);
                    *(v4u*)(rowp + bj * 128) = w; } }
    }
};
struct EpiPool {
    static constexpr bool PERM = true; bf16* O; const float* scale;
    __device__ __forceinline__ void operator()(const f32x4 (&acc)[2][2][4][2], const pg8::Unit& u, int wr, int wc, int fr, int fq) const {
        const int row0 = u.pm * 256 + wr * 64 + fr, cg = u.pn * 256 + wc * 32 + 8 * fq;
        f32x4 sv[2][2];
#pragma unroll
        for (int bj = 0; bj < 2; ++bj) { sv[bj][0] = *(const f32x4*)(scale + cg + bj * 128); sv[bj][1] = *(const f32x4*)(scale + cg + bj * 128 + 4); }
#pragma unroll
        for (int ai = 0; ai < 2; ++ai)
#pragma unroll
            for (int m = 0; m < 4; ++m) { bf16* rowp = O + (size_t)(row0 + ai * 128 + m * 16) * D + DNW + cg;
#pragma unroll
                for (int bj = 0; bj < 2; ++bj) { const f32x4 v0 = acc[ai][bj][m][0] * sv[bj][0], v1 = acc[ai][bj][m][1] * sv[bj][1];
                    v4u w; w.x = cvt_pk_bf16(v0[0], v0[1]); w.y = cvt_pk_bf16(v0[2], v0[3]); w.z = cvt_pk_bf16(v1[0], v1[1]); w.w = cvt_pk_bf16(v1[2], v1[3]);
                    *(v4u*)(rowp + bj * 128) = w; } }
    }
};
struct EpiRes {
    static constexpr bool PERM = true; const bf16* XB; bf16* PRE;
    __device__ __forceinline__ void operator()(const f32x4 (&acc)[2][2][4][2], const pg8::Unit& u, int wr, int wc, int fr, int fq) const {
        const int row0 = u.pm * 256 + wr * 64 + fr, col0 = u.pn * 256 + wc * 32 + 8 * fq;
#pragma unroll
        for (int ai = 0; ai < 2; ++ai)
#pragma unroll
            for (int m = 0; m < 4; ++m) { const size_t off0 = (size_t)(row0 + ai * 128 + m * 16) * D + col0;
#pragma unroll
                for (int bj = 0; bj < 2; ++bj) { const size_t off = off0 + bj * 128; const v4u x = *(const v4u*)(XB + off); const f32x4 a0 = acc[ai][bj][m][0], a1 = acc[ai][bj][m][1];
                    v4u w; w.x = cvt_pk_bf16(bflo(x.x) * ALPHA + a0[0], bfhi(x.x) * ALPHA + a0[1]); w.y = cvt_pk_bf16(bflo(x.y) * ALPHA + a0[2], bfhi(x.y) * ALPHA + a0[3]);
                    w.z = cvt_pk_bf16(bflo(x.z) * ALPHA + a1[0], bfhi(x.z) * ALPHA + a1[1]); w.w = cvt_pk_bf16(bflo(x.w) * ALPHA + a1[2], bfhi(x.w) * ALPHA + a1[3]);
                    *(v4u*)(PRE + off) = w; } }
    }
};
struct EpiSwiglu {
    static constexpr bool PERM = true; bf16* O;
    __device__ __forceinline__ void operator()(const f32x4 (&acc)[2][2][4][2], const pg8::Unit& u, int wr, int wc, int fr, int fq) const {
        const int row0 = u.pm * 256 + wr * 64 + fr, col0 = u.pn * 128 + wc * 32 + 8 * fq;
#pragma unroll
        for (int ai = 0; ai < 2; ++ai)
#pragma unroll
            for (int m = 0; m < 4; ++m) { bf16* rowp = O + (size_t)(row0 + ai * 128 + m * 16) * DE + col0;
                float h[8];
#pragma unroll
                for (int n = 0; n < 2; ++n)
#pragma unroll
                    for (int j = 0; j < 4; ++j) { const float g = acc[ai][0][m][n][j], up = acc[ai][1][m][n][j]; h[4 * n + j] = g * sigmoidf_(g) * up; }
                v4u w; w.x = cvt_pk_bf16(h[0], h[1]); w.y = cvt_pk_bf16(h[2], h[3]); w.z = cvt_pk_bf16(h[4], h[5]); w.w = cvt_pk_bf16(h[6], h[7]);
                *(v4u*)rowp = w; }
    }
};
struct EpiPle {
    static constexpr bool PERM = true; const bf16* X2B; const bf16* PP; bf16* XB; float* OUT; int last;
    __device__ __forceinline__ void operator()(const f32x4 (&acc)[2][2][4][2], const pg8::Unit& u, int wr, int wc, int fr, int fq) const {
        const int row0 = u.pm * 256 + wr * 64 + fr, col0 = u.pn * 256 + wc * 32 + 8 * fq;
#pragma unroll
        for (int ai = 0; ai < 2; ++ai)
#pragma unroll
            for (int m = 0; m < 4; ++m) { const size_t off0 = (size_t)(row0 + ai * 128 + m * 16) * D + col0;
#pragma unroll
                for (int bj = 0; bj < 2; ++bj) { const size_t off = off0 + bj * 128;
                    const v4u xx = *(const v4u*)(X2B + off), pp = *(const v4u*)(PP + off);
                    const f32x4 a0 = acc[ai][bj][m][0], a1 = acc[ai][bj][m][1];
                    f32x4 o0, o1;
                    o0[0] = bflo(xx.x) + sigmoidf_(a0[0]) * bflo(pp.x); o0[1] = bfhi(xx.x) + sigmoidf_(a0[1]) * bfhi(pp.x); o0[2] = bflo(xx.y) + sigmoidf_(a0[2]) * bflo(pp.y); o0[3] = bfhi(xx.y) + sigmoidf_(a0[3]) * bfhi(pp.y);
                    o1[0] = bflo(xx.z) + sigmoidf_(a1[0]) * bflo(pp.z); o1[1] = bfhi(xx.z) + sigmoidf_(a1[1]) * bfhi(pp.z); o1[2] = bflo(xx.w) + sigmoidf_(a1[2]) * bflo(pp.w); o1[3] = bfhi(xx.w) + sigmoidf_(a1[3]) * bfhi(pp.w);
                    if (last) { *(f32x4*)(OUT + off) = o0; *(f32x4*)(OUT + off + 4) = o1; }
                    else { v4u w; w.x = cvt_pk_bf16(o0[0], o0[1]); w.y = cvt_pk_bf16(o0[2], o0[3]); w.z = cvt_pk_bf16(o1[0], o1[1]); w.w = cvt_pk_bf16(o1[2], o1[3]); *(v4u*)(XB + off) = w; } } }
    }
};

__device__ __forceinline__ void tr_item(const float* W, int ldw, int k0, int n0, bf16* WT, size_t drow0, int ldt, LAS float* scr, int lane) {
#pragma unroll 8
    for (int i = 0; i < 32; ++i) { const int kk = 2 * i + (lane >> 5); scr[kk * 33 + (lane & 31)] = W[(size_t)(k0 + kk) * ldw + n0 + (lane & 31)]; }
    LDS_WAIT(); asm volatile("" ::: "memory");
    const int c = lane & 7;
#pragma unroll
    for (int j = 0; j < 4; ++j) { const int n = (lane >> 3) + 8 * j; const LAS float* s = scr + (8 * c) * 33 + n;
        v4u o; o.x = pk2(s[0 * 33], s[1 * 33]); o.y = pk2(s[2 * 33], s[3 * 33]); o.z = pk2(s[4 * 33], s[5 * 33]); o.w = pk2(s[6 * 33], s[7 * 33]);
        *(GAS v4u*)(WT + (drow0 + n) * ldt + k0 + 8 * c) = o; }
    LDS_WAIT(); asm volatile("" ::: "memory");
}
__device__ __forceinline__ void weight_items(const Args& a, unsigned char* ws, LAS float* scr, int lane, int group, int l, int gw, int NGW) {
    constexpr int I_INA = 32 * 128, I_INB = 32 * 32, I_OUT = 32 * 64, I_PG = 32 * 64, I_PP = 4 * 64, I_POOL = 4 * 32, I_EG = NE * 32 * 32, I_EU = I_EG, I_ED = NE * 16 * 64;
    if (group == 0) {
        for (int it = gw; it < I_INA + I_INB + I_PP + I_POOL; it += NGW) { int r = it;
            if (r < I_INA) { const int kb = r / 128, nb = r % 128; tr_item(a.in[I_WIN] + (size_t)l * D * IN_COLS, IN_COLS, 64 * kb, 32 * nb, (bf16*)(ws + WS_WIN) + (size_t)l * NPROJ * D, 32 * nb, D, scr, lane); continue; } r -= I_INA;
            if (r < I_INB) { const int kb = r / 32, nb = r % 32; tr_item(a.in[I_WIN] + (size_t)l * D * IN_COLS, IN_COLS, 64 * kb, 4112 + 32 * nb, (bf16*)(ws + WS_WIN) + (size_t)l * NPROJ * D, 4096 + 32 * nb, D, scr, lane); continue; } r -= I_INB;
            if (r < I_PP) { const int kb = r / 64, nb = r % 64; tr_item(a.in[I_WPP] + (size_t)l * PLE * D, D, 64 * kb, 32 * nb, (bf16*)(ws + WS_WPP) + (size_t)l * D * PLE, 32 * nb, PLE, scr, lane); continue; } r -= I_PP;
            { const int g = r / 32, rr = r % 32, kb = rr / 8, nb = rr % 8; tr_item(a.in[I_POOLW] + ((size_t)l * 4 + g) * 65536, 256, 64 * kb, 32 * nb, (bf16*)(ws + WS_WPOOL) + ((size_t)l * 4 + g) * 65536, 32 * nb, 256, scr, lane); } }
    } else {
        for (int it = gw; it < I_OUT + I_PG + I_EG + I_EU + I_ED; it += NGW) { int r = it;
            if (r < I_OUT) { const int kb = r / 64, nb = r % 64; tr_item(a.in[I_WOUT] + (size_t)l * D * D, D, 64 * kb, 32 * nb, (bf16*)(ws + WS_WOUT) + (size_t)l * D * D, 32 * nb, D, scr, lane); continue; } r -= I_OUT;
            if (r < I_PG) { const int kb = r / 64, nb = r % 64; tr_item(a.in[I_WPG] + (size_t)l * D * D, D, 64 * kb, 32 * nb, (bf16*)(ws + WS_WPG) + (size_t)l * D * D, 32 * nb, D, scr, lane); continue; } r -= I_PG;
            if (r < I_EG) { const int e = r / 1024, rr = r % 1024, kb = rr / 32, nb = rr % 32, h0 = 32 * nb;
                tr_item(a.in[I_WEG] + ((size_t)l * NE + e) * D * DE, DE, 64 * kb, h0, (bf16*)(ws + WS_WGU) + ((size_t)l * NE + e) * 2048 * D, (size_t)(h0 >> 7) * 256 + (h0 & 127), D, scr, lane); continue; } r -= I_EG;
            if (r < I_EU) { const int e = r / 1024, rr = r % 1024, kb = rr / 32, nb = rr % 32, h0 = 32 * nb;
                tr_item(a.in[I_WEU] + ((size_t)l * NE + e) * D * DE, DE, 64 * kb, h0, (bf16*)(ws + WS_WGU) + ((size_t)l * NE + e) * 2048 * D, (size_t)(h0 >> 7) * 256 + 128 + (h0 & 127), D, scr, lane); continue; } r -= I_EU;
            { const int e = r / 1024, rr = r % 1024, kb = rr / 64, nb = rr % 64;
                tr_item(a.in[I_WED] + ((size_t)l * NE + e) * DE * D, D, 64 * kb, 32 * nb, (bf16*)(ws + WS_WD) + ((size_t)l * NE + e) * D * DE, 32 * nb, DE, scr, lane); } }
    }
}
__device__ __forceinline__ void p0_prologue(const Frame& F0, const Args& a) {
    PHASE_FRAME(F0);
    LAS float* scr = (LAS float*)(F.lds + RING_OFF + F.wave * 16384);
    const int gw = F.vcu * NWAVES + F.wave, NGW = F.G * NWAVES;
    unsigned char* ws = OPQ_G(unsigned char, a.ws);
#pragma unroll 1
    for (int l = 0; l < DEPTH; ++l) weight_items(a, ws, scr, F.lane, 0, l, gw, NGW);
#ifdef CONVERT_ALL_IN_PROLOGUE
#pragma unroll 1
    for (int l = 0; l < DEPTH; ++l) weight_items(a, ws, scr, F.lane, 1, l, gw, NGW);
#endif
    const size_t gt = (size_t)F.vcu * 512 + F.tid, NGT = (size_t)F.G * 512;
    { const GAS f32x4* src = (const GAS f32x4*)a.in[I_X]; GAS v4u* dst = (GAS v4u*)(ws + WS_XB);
        for (size_t i = gt; i < (size_t)T * D / 8; i += NGT) { const f32x4 v0 = src[2 * i], v1 = src[2 * i + 1]; v4u o; o.x = pk2(v0[0], v0[1]); o.y = pk2(v0[2], v0[3]); o.z = pk2(v1[0], v1[1]); o.w = pk2(v1[2], v1[3]); dst[i] = o; } }
    { const GAS f32x4* src = (const GAS f32x4*)a.in[I_P]; GAS v4u* dst = (GAS v4u*)(ws + WS_PB16);
        for (size_t i = gt; i < (size_t)DEPTH * T * PLE / 8; i += NGT) { const f32x4 v0 = src[2 * i], v1 = src[2 * i + 1]; v4u o; o.x = pk2(v0[0], v0[1]); o.y = pk2(v0[2], v0[3]); o.z = pk2(v1[0], v1[1]); o.w = pk2(v1[2], v1[3]); dst[i] = o; } }
    for (size_t i = gt; i < (size_t)DEPTH * 16 * D; i += NGT) { const int l = (int)(i / (16 * D)), j = (int)((i / D) % 16), k = (int)(i % D);
        ((bf16*)(ws + WS_WBA))[i] = (bf16)f2bf(a.in[I_WIN][((size_t)l * D + k) * IN_COLS + 4096 + j]); }
}

typedef float f32x16 __attribute__((ext_vector_type(16)));
#define MFMA32(a_, b_, c_) __builtin_amdgcn_mfma_f32_32x32x16_bf16((a_), (b_), (c_), 0, 0, 0)
#define PACK8(x, sp) __builtin_bit_cast(bf16x8, (v4u){pkbf((x)[8 * (sp)], (x)[8 * (sp) + 1]), pkbf((x)[8 * (sp) + 2], (x)[8 * (sp) + 3]), pkbf((x)[8 * (sp) + 4], (x)[8 * (sp) + 5]), pkbf((x)[8 * (sp) + 6], (x)[8 * (sp) + 7])})
#define RAW_BAR() do { asm volatile("s_waitcnt lgkmcnt(0)" ::: "memory"); __builtin_amdgcn_s_barrier(); asm volatile("" ::: "memory"); } while (0)
constexpr int IMG_ELEMS = 56 * 512, UIMG_ELEMS = 8 * 1024;
constexpr int FR_WN = 0, FR_QD = 16, FR_AQK = 32, FR_KDT = 40;
constexpr size_t WS_IMG = WS_R2, WS_UIMG = WS_R2 + 112 * MiB;
static_assert((size_t)NB * NCH * NH * IMG_ELEMS * 2 == 112 * MiB && (size_t)NB * NCH * NH * UIMG_ELEMS * 2 == 32 * MiB, "DeltaNet images");

__device__ __forceinline__ void pool_diffs_unit(const Frame& F, unsigned char* ws, int pm, int g) {
    const bf16* PROJ = (const bf16*)(ws + WS_PROJ); bf16* POOLD = (bf16*)(ws + WS_POOLD);
    const int tid = F.tid, cp = tid & 127, rq = tid >> 7, r0 = 256 * pm + 64 * rq, sq0 = r0 % SEQ, col = 256 * g + 2 * cp;
    const bf16* up = PROJ + (size_t)r0 * NPROJ + 4096 + col; bf16* dp = POOLD + (size_t)r0 * PW + col;
#define POOL_BODY(WIN) do { unsigned xr[CH + WIN - 1]; \
        _Pragma("unroll") for (int j = 0; j < WIN - 1; ++j) xr[j] = (sq0 - (WIN - 1) + j >= 0) ? *(const unsigned*)(up + (ptrdiff_t)(j - (WIN - 1)) * NPROJ) : 0u; \
        _Pragma("unroll") for (int i = 0; i < CH; ++i) xr[WIN - 1 + i] = *(const unsigned*)(up + (size_t)i * NPROJ); \
        float s0 = 0.f, s1 = 0.f; \
        _Pragma("unroll") for (int j = 0; j < WIN - 1; ++j) { s0 += bflo(xr[j]); s1 += bfhi(xr[j]); } \
        _Pragma("unroll") for (int i = 0; i < CH; ++i) { const float x0 = bflo(xr[WIN - 1 + i]), x1 = bfhi(xr[WIN - 1 + i]); s0 += x0; s1 += x1; \
            const int pos = sq0 + i; const float inv = __builtin_amdgcn_rcpf((float)((pos + 1) < WIN ? (pos + 1) : WIN)); \
            *(unsigned*)(dp + (size_t)i * PW) = pkbf(s0 * inv - x0, s1 * inv - x1); s0 -= bflo(xr[i]); s1 -= bfhi(xr[i]); } } while (0)
    if (g == 0) POOL_BODY(2); else if (g == 1) POOL_BODY(4); else if (g == 2) POOL_BODY(8); else POOL_BODY(16);
#undef POOL_BODY
}
#ifndef PREP_DUP
#define PREP_DUP 0
#endif
constexpr int PQF = 0, PKF = 33792, PQS = 67584, PKS = 84992, PVT = 102400, PKT = 120832, PTAB = 139264;
constexpr int PAS = PQF;
constexpr int PTB = PKF, PT11T = PKF + 9216, PPART = PKF;
constexpr int F_LD = 132, S_LD = 136, T_LD = 72, A_LD = 68, TT_LD = 40;
__device__ __forceinline__ void phase_dn_prep(const Frame& F0, const Args& a, int layer) {
    PHASE_FRAME(F0);
    unsigned char* ws = OPQ_G(unsigned char, a.ws);
    LAS unsigned char* lds = F.lds;
    LAS float* Qf = (LAS float*)(lds + PQF); LAS float* Kf = (LAS float*)(lds + PKF); LAS float* As = (LAS float*)(lds + PAS);
    LAS bf16* Qs = (LAS bf16*)(lds + PQS); LAS bf16* Ks = (LAS bf16*)(lds + PKS); LAS bf16* Vt = (LAS bf16*)(lds + PVT); LAS bf16* Kt = (LAS bf16*)(lds + PKT);
    LAS bf16* Tb = (LAS bf16*)(lds + PTB); LAS bf16* T11t = (LAS bf16*)(lds + PT11T);
    LAS float* betaS = (LAS float*)(lds + PTAB); LAS float* gS = betaS + 512; LAS float* gamh = gS + 512; LAS float* betah = gamh + 64; LAS float* egam = betah + 64; LAS float* bgam = egam + 64; LAS float* ekd = bgam + 64; LAS float* rkS = ekd + 64;
    const bf16* XB = (const bf16*)(ws + WS_XB); const bf16* PROJ = (const bf16*)(ws + WS_PROJ); const bf16* WBA = (const bf16*)(ws + WS_WBA) + (size_t)layer * 16 * D;
    bf16* IMG = (bf16*)(ws + WS_IMG); bf16* UIMG = (bf16*)(ws + WS_UIMG); float* CD = (float*)(ws + WS_CD);
    const float* convw = a.in[I_CONVW] + (size_t)layer * 4 * 3072; const float* alog = a.in[I_ALOG] + layer * NH; const float* dtb = a.in[I_DTB] + layer * NH;
    const int tid = F.tid, lane = F.lane, wave = F.wave, c32 = lane & 31, hf = lane >> 5;
    for (int unit = F.vcu; unit < NB * NCH; unit += F.G) {
        const int b = unit / NCH, n = unit % NCH, r0 = b * SEQ + n * CH, sq0 = n * CH;
        for (int rep_ = 0; rep_ < ((PREP_DUP & 64) ? 2 : 1); ++rep_)
        { typedef float f32x4v __attribute__((ext_vector_type(4)));
            const int fr = lane & 15, fg = lane >> 4; f32x4v pacc[4];
#pragma unroll
            for (int mt = 0; mt < 4; ++mt) pacc[mt] = (f32x4v){0.f, 0.f, 0.f, 0.f};
#pragma unroll 2
            for (int s = 0; s < 8; ++s) { const int k0 = 256 * wave + 32 * s + 8 * fg;
                const bf16x8 bfr = *(const bf16x8*)(WBA + (size_t)fr * D + k0);
#pragma unroll
                for (int mt = 0; mt < 4; ++mt) { const bf16x8 afr = *(const bf16x8*)(XB + (size_t)(r0 + 16 * mt + fr) * D + k0); pacc[mt] = __builtin_amdgcn_mfma_f32_16x16x32_bf16(afr, bfr, pacc[mt], 0, 0, 0); } }
            LAS float* part = (LAS float*)(lds + PPART) + wave * 1024;
#pragma unroll
            for (int mt = 0; mt < 4; ++mt)
#pragma unroll
                for (int r = 0; r < 4; ++r) part[(16 * mt + 4 * fg + r) * 16 + fr] = pacc[mt][r]; }
        __syncthreads();
        { const int tok = tid >> 3, cp = tid & 7; float s0 = 0.f, s1 = 0.f;
#pragma unroll
            for (int w = 0; w < 8; ++w) { const f32x2 p2 = *(const LAS f32x2*)((LAS float*)(lds + PPART) + w * 1024 + tok * 16 + 2 * cp); s0 += p2[0]; s1 += p2[1]; }
            if (cp < 4) { betaS[tok * 8 + 2 * cp] = sigmoidf_(s0); betaS[tok * 8 + 2 * cp + 1] = sigmoidf_(s1); }
            else { const int h = 2 * (cp - 4); const float z0 = s0 + dtb[h], z1 = s1 + dtb[h + 1];
                const float sp0 = z0 > 20.f ? z0 : log1pf(__expf(z0)), sp1 = z1 > 20.f ? z1 : log1pf(__expf(z1));
                gS[tok * 8 + h] = -__expf(alog[h]) * sp0; gS[tok * 8 + h + 1] = -__expf(alog[h + 1]) * sp1; } }
        __syncthreads();
        if (tid < 8) { float run = 0.f; for (int t = 0; t < CH; ++t) { run += gS[t * 8 + tid]; gS[t * 8 + tid] = run; } }
        __syncthreads();
        unsigned craw[3][11];
#define PREP_LOADRAW(hh) do { const int cp_ = tid & 63, i0_ = (tid >> 6) * 8; \
            _Pragma("unroll") for (int part_ = 0; part_ < 3; ++part_) { const bf16* src_ = PROJ + (size_t)(r0 + i0_ - 3) * NPROJ + part_ * 1024 + (hh) * HD + 2 * cp_; \
                _Pragma("unroll") for (int j_ = 0; j_ < 11; ++j_) craw[part_][j_] = (sq0 + i0_ - 3 + j_ >= 0) ? *(const unsigned*)(src_ + (ptrdiff_t)j_ * NPROJ) : 0u; } } while (0)
        PREP_LOADRAW(0);
        for (int h = 0; h < NH; ++h) {
            const size_t chd = (size_t)unit * NH + h; bf16* img = IMG + chd * IMG_ELEMS; bf16* uimg = UIMG + chd * UIMG_ELEMS;
            if (tid < 64) { const float gi = gS[tid * 8 + h], bi = betaS[tid * 8 + h], eg = __expf(gi); gamh[tid] = gi; betah[tid] = bi; egam[tid] = eg; bgam[tid] = bi * eg; ekd[tid] = __expf(gS[63 * 8 + h] - gi); }
            RAW_BAR();
            for (int rep_ = 0; rep_ < ((PREP_DUP & 16) ? 2 : 1); ++rep_)
            { const int cp = tid & 63, rg8 = tid >> 6, i0 = rg8 * 8;
#pragma unroll
                for (int part = 0; part < 3; ++part) { const int col = part * 1024 + h * HD + 2 * cp;
                    const f32x2 cw0 = *(const f32x2*)(convw + col), cw1 = *(const f32x2*)(convw + 3072 + col), cw2 = *(const f32x2*)(convw + 2 * 3072 + col), cw3 = *(const f32x2*)(convw + 3 * 3072 + col);
                    float ya[8], yb[8];
#pragma unroll
                    for (int i = 0; i < 8; ++i) { const unsigned x3 = craw[part][i], x2 = craw[part][i + 1], x1 = craw[part][i + 2], x0 = craw[part][i + 3];
                        const float ta = cw0[0] * bflo(x3) + cw1[0] * bflo(x2) + cw2[0] * bflo(x1) + cw3[0] * bflo(x0), tb = cw0[1] * bfhi(x3) + cw1[1] * bfhi(x2) + cw2[1] * bfhi(x1) + cw3[1] * bfhi(x0);
                        ya[i] = ta * sigmoidf_(ta); yb[i] = tb * sigmoidf_(tb); }
                    if (part == 0) {
#pragma unroll
                        for (int i = 0; i < 8; ++i) *(LAS f32x2*)(Qf + (i0 + i) * F_LD + 2 * cp) = (f32x2){ya[i], yb[i]}; }
                    else if (part == 1) {
#pragma unroll
                        for (int i = 0; i < 8; ++i) *(LAS f32x2*)(Kf + (i0 + i) * F_LD + 2 * cp) = (f32x2){ya[i], yb[i]}; }
                    else { v4u o0, o1;
                        o0.x = pkbf(ya[0] * betah[i0 + 0], ya[1] * betah[i0 + 1]); o0.y = pkbf(ya[2] * betah[i0 + 2], ya[3] * betah[i0 + 3]); o0.z = pkbf(ya[4] * betah[i0 + 4], ya[5] * betah[i0 + 5]); o0.w = pkbf(ya[6] * betah[i0 + 6], ya[7] * betah[i0 + 7]);
                        o1.x = pkbf(yb[0] * betah[i0 + 0], yb[1] * betah[i0 + 1]); o1.y = pkbf(yb[2] * betah[i0 + 2], yb[3] * betah[i0 + 3]); o1.z = pkbf(yb[4] * betah[i0 + 4], yb[5] * betah[i0 + 5]); o1.w = pkbf(yb[6] * betah[i0 + 6], yb[7] * betah[i0 + 7]);
                        *(LAS v4u*)(Vt + (2 * cp) * T_LD + i0) = o0; *(LAS v4u*)(Vt + (2 * cp + 1) * T_LD + i0) = o1; } }
            }
            if (h + 1 < NH) PREP_LOADRAW(h + 1);
            for (int rep_ = 0; rep_ < ((PREP_DUP & 1) ? 2 : 1); ++rep_) { if (rep_) RAW_BAR();
            { const int i = tid >> 3, part = tid & 7; const LAS float* qp = Qf + i * F_LD + part * 16; const LAS float* kp = Kf + i * F_LD + part * 16;
                f32x4 qv[4], kv[4]; float sq = 0.f, sk = 0.f;
#pragma unroll
                for (int j = 0; j < 4; ++j) { qv[j] = *(const LAS f32x4*)(qp + 4 * j); kv[j] = *(const LAS f32x4*)(kp + 4 * j);
                    sq += (qv[j][0] * qv[j][0] + qv[j][1] * qv[j][1]) + (qv[j][2] * qv[j][2] + qv[j][3] * qv[j][3]); sk += (kv[j][0] * kv[j][0] + kv[j][1] * kv[j][1]) + (kv[j][2] * kv[j][2] + kv[j][3] * kv[j][3]); }
                sq += __shfl_xor(sq, 1); sq += __shfl_xor(sq, 2); sq += __shfl_xor(sq, 4); sk += __shfl_xor(sk, 1); sk += __shfl_xor(sk, 2); sk += __shfl_xor(sk, 4);
                const float rq = 1.0f / sqrtf(sq + RMS_EPS) * 0.08838834764831845f, rk = 1.0f / sqrtf(sk + RMS_EPS);
                if (part == 0) rkS[i] = rk;
#pragma unroll
                for (int j = 0; j < 4; ++j) { qv[j] = qv[j] * rq; kv[j] = kv[j] * rk; }
                v4u w0, w1;
                w0.x = pkbf(qv[0][0], qv[0][1]); w0.y = pkbf(qv[0][2], qv[0][3]); w0.z = pkbf(qv[1][0], qv[1][1]); w0.w = pkbf(qv[1][2], qv[1][3]); w1.x = pkbf(qv[2][0], qv[2][1]); w1.y = pkbf(qv[2][2], qv[2][3]); w1.z = pkbf(qv[3][0], qv[3][1]); w1.w = pkbf(qv[3][2], qv[3][3]);
                *(LAS v4u*)(Qs + i * S_LD + part * 16) = w0; *(LAS v4u*)(Qs + i * S_LD + part * 16 + 8) = w1;
                w0.x = pkbf(kv[0][0], kv[0][1]); w0.y = pkbf(kv[0][2], kv[0][3]); w0.z = pkbf(kv[1][0], kv[1][1]); w0.w = pkbf(kv[1][2], kv[1][3]); w1.x = pkbf(kv[2][0], kv[2][1]); w1.y = pkbf(kv[2][2], kv[2][3]); w1.z = pkbf(kv[3][0], kv[3][1]); w1.w = pkbf(kv[3][2], kv[3][3]);
                *(LAS v4u*)(Ks + i * S_LD + part * 16) = w0; *(LAS v4u*)(Ks + i * S_LD + part * 16 + 8) = w1;
                const float eg = egam[i]; bf16* fq = img + ((size_t)(FR_QD + (i >> 5) * 8 + part) * 64 + (i & 31)) * 8;
                v4u h0, h1;
                h0.x = pkbf(qv[0][0] * eg, qv[0][1] * eg); h0.y = pkbf(qv[0][2] * eg, qv[0][3] * eg); h0.z = pkbf(qv[2][0] * eg, qv[2][1] * eg); h0.w = pkbf(qv[2][2] * eg, qv[2][3] * eg);
                h1.x = pkbf(qv[1][0] * eg, qv[1][1] * eg); h1.y = pkbf(qv[1][2] * eg, qv[1][3] * eg); h1.z = pkbf(qv[3][0] * eg, qv[3][1] * eg); h1.w = pkbf(qv[3][2] * eg, qv[3][3] * eg);
                *(v4u*)fq = h0; *(v4u*)(fq + 32 * 8) = h1; }
            RAW_BAR();
            { const int c = tid & 127, rg = tid >> 7; float kb[16], kd[16];
#pragma unroll
                for (int i = 0; i < 16; ++i) { const int t = rg * 16 + i; const float kn = Kf[t * F_LD + c] * rkS[t]; kb[i] = kn * bgam[t]; kd[i] = kn * ekd[t]; }
                v4u o0, o1;
                o0.x = pkbf(kb[0], kb[1]); o0.y = pkbf(kb[2], kb[3]); o0.z = pkbf(kb[4], kb[5]); o0.w = pkbf(kb[6], kb[7]); o1.x = pkbf(kb[8], kb[9]); o1.y = pkbf(kb[10], kb[11]); o1.z = pkbf(kb[12], kb[13]); o1.w = pkbf(kb[14], kb[15]);
                *(LAS v4u*)(Kt + c * T_LD + rg * 16) = o0; *(LAS v4u*)(Kt + c * T_LD + rg * 16 + 8) = o1;
                bf16* fk = img + ((size_t)(FR_KDT + (c >> 5) * 4 + rg) * 64 + (c & 31)) * 8;
                v4u h0, h1;
                h0.x = pkbf(kd[0], kd[1]); h0.y = pkbf(kd[2], kd[3]); h0.z = pkbf(kd[8], kd[9]); h0.w = pkbf(kd[10], kd[11]);
                h1.x = pkbf(kd[4], kd[5]); h1.y = pkbf(kd[6], kd[7]); h1.z = pkbf(kd[12], kd[13]); h1.w = pkbf(kd[14], kd[15]);
                *(v4u*)fk = h0; *(v4u*)(fk + 32 * 8) = h1; }
            RAW_BAR();
            }
            for (int rep_ = 0; rep_ < ((PREP_DUP & 2) ? 2 : 1); ++rep_) { if (rep_) RAW_BAR();
            if (wave < 6) { const int pr = wave % 3, iskk = wave / 3, mt = pr == 2 ? 1 : 0, nt = pr == 0 ? 0 : 1;
                const LAS bf16* xs = iskk ? Ks : Qs; f32x16 d;
#pragma unroll
                for (int r = 0; r < 16; ++r) d[r] = 0.f;
#pragma unroll
                for (int s = 0; s < 8; ++s) { const bf16x8 af = *(const LAS bf16x8*)(Ks + (32 * mt + c32) * S_LD + 16 * s + 8 * hf), bfr = *(const LAS bf16x8*)(xs + (32 * nt + c32) * S_LD + 16 * s + 8 * hf); d = MFMA32(af, bfr, d); }
                const int i = 32 * nt + c32; const float gi = gamh[i], bi = betah[i];
#pragma unroll
                for (int r = 0; r < 16; ++r) { const int j = 32 * mt + (r & 3) + 8 * (r >> 2) + 4 * hf; const float de = __expf(gi - gamh[j]);
                    d[r] = iskk ? ((j < i) ? bi * d[r] * de : 0.f) : ((j <= i) ? d[r] * de : 0.f); }
                if (iskk) {
#pragma unroll
                    for (int qd = 0; qd < 4; ++qd) *(LAS f32x4*)(As + i * A_LD + 32 * mt + 8 * qd + 4 * hf) = (f32x4){d[4 * qd], d[4 * qd + 1], d[4 * qd + 2], d[4 * qd + 3]}; }
                else {
#pragma unroll
                    for (int sp = 0; sp < 2; ++sp) *(bf16x8*)(img + ((size_t)(FR_AQK + nt * 4 + 2 * mt + sp) * 64 + lane) * 8) = PACK8(d, sp); } }
            RAW_BAR();
            }
            for (int rep_ = 0; rep_ < ((PREP_DUP & 4) ? 2 : 1); ++rep_) { if (rep_) RAW_BAR();
            if (wave < 2) {
                unsigned asb = (unsigned)(uintptr_t)(As + (32 * wave) * A_LD + 32 * wave); int cb = c32; asm volatile("" : "+v"(asb), "+v"(cb));
                const LAS float* Ab = (const LAS float*)(uintptr_t)asb;
                float arow[32], Tc[32];
#pragma unroll
                for (int i = 0; i < 32; ++i) arow[i] = Ab[i * A_LD + cb];
#pragma unroll
                for (int i = 0; i < 32; ++i) { float ac[4] = {(i == cb) ? 1.f : 0.f, 0.f, 0.f, 0.f}; if (i > 0) asm volatile("" : "+v"(arow[i]), "+v"(Tc[i - 1]));
#pragma unroll
                    for (int j = 0; j < i; ++j) { const float aij = __builtin_bit_cast(float, __builtin_amdgcn_readlane(__builtin_bit_cast(int, arow[i]), j)); ac[j & 3] -= aij * Tc[j]; }
                    Tc[i] = (ac[0] + ac[1]) + (ac[2] + ac[3]); __builtin_amdgcn_sched_barrier(0); }
                if (hf == 0) {
#pragma unroll
                    for (int i = 0; i < 32; ++i) Tb[(32 * wave + i) * T_LD + 32 * wave + c32] = (bf16)(pkbf(Tc[i], 0.f) & 0xffffu);
                    if (wave == 0) {
#pragma unroll
                        for (int q = 0; q < 4; ++q) { v4u o; o.x = pkbf(Tc[8 * q], Tc[8 * q + 1]); o.y = pkbf(Tc[8 * q + 2], Tc[8 * q + 3]); o.z = pkbf(Tc[8 * q + 4], Tc[8 * q + 5]); o.w = pkbf(Tc[8 * q + 6], Tc[8 * q + 7]); *(LAS v4u*)(T11t + c32 * TT_LD + 8 * q) = o; } } } }
            RAW_BAR();
            if (wave == 0) {
                f32x16 x;
#pragma unroll
                for (int r = 0; r < 16; ++r) x[r] = 0.f;
#pragma unroll
                for (int s = 0; s < 2; ++s) { const LAS float* ap = As + (32 + c32) * A_LD + 16 * s + 8 * hf; const f32x4 a0 = *(const LAS f32x4*)ap, a1 = *(const LAS f32x4*)(ap + 4);
                    const bf16x8 af = __builtin_bit_cast(bf16x8, (v4u){pkbf(a0[0], a0[1]), pkbf(a0[2], a0[3]), pkbf(a1[0], a1[1]), pkbf(a1[2], a1[3])});
                    const bf16x8 bfr = *(const LAS bf16x8*)(T11t + c32 * TT_LD + 16 * s + 8 * hf); x = MFMA32(af, bfr, x); }
                f32x16 t21;
#pragma unroll
                for (int r = 0; r < 16; ++r) t21[r] = 0.f;
#pragma unroll
                for (int s = 0; s < 2; ++s) { const LAS bf16* tp = Tb + (32 + c32) * T_LD + 32 + 16 * s + 4 * hf; const v2u lo = *(const LAS v2u*)tp, hi = *(const LAS v2u*)(tp + 8);
                    const bf16x8 af = __builtin_bit_cast(bf16x8, (v4u){lo.x, lo.y, hi.x, hi.y}); const bf16x8 bfr = PACK8(x, s); t21 = MFMA32(af, bfr, t21); }
#pragma unroll
                for (int r = 0; r < 16; ++r) Tb[(32 + (r & 3) + 8 * (r >> 2) + 4 * hf) * T_LD + c32] = (bf16)(pkbf(-t21[r], 0.f) & 0xffffu);
            }
            RAW_BAR();
            }
            for (int rep_ = 0; rep_ < ((PREP_DUP & 8) ? 2 : 1); ++rep_) { if (rep_) RAW_BAR();
            if (wave < 4) {
#pragma unroll
                for (int mt = 0; mt < 2; ++mt) { f32x16 d;
#pragma unroll
                    for (int r = 0; r < 16; ++r) d[r] = 0.f;
#pragma unroll
                    for (int s = 0; s < 4; ++s) if (s < 2 * (mt + 1)) { const bf16x8 af = *(const LAS bf16x8*)(Tb + (32 * mt + c32) * T_LD + 16 * s + 8 * hf), bfr = *(const LAS bf16x8*)(Vt + (32 * wave + c32) * T_LD + 16 * s + 8 * hf); d = MFMA32(af, bfr, d); }
                    bf16* up = uimg + ((size_t)(wave * 2 + mt) * 64 + lane) * 16; *(bf16x8*)up = PACK8(d, 0); *(bf16x8*)(up + 8) = PACK8(d, 1); } }
            else { const int ct = wave - 4;
#pragma unroll
                for (int nt = 0; nt < 2; ++nt) { f32x16 d;
#pragma unroll
                    for (int r = 0; r < 16; ++r) d[r] = 0.f;
#pragma unroll
                    for (int s = 0; s < 4; ++s) if (s < 2 * (nt + 1)) { const bf16x8 af = *(const LAS bf16x8*)(Kt + (32 * ct + c32) * T_LD + 16 * s + 8 * hf), bfr = *(const LAS bf16x8*)(Tb + (32 * nt + c32) * T_LD + 16 * s + 8 * hf); d = MFMA32(af, bfr, d); }
#pragma unroll
                    for (int r = 0; r < 16; ++r) d[r] = -d[r];
#pragma unroll
                    for (int sp = 0; sp < 2; ++sp) *(bf16x8*)(img + ((size_t)(FR_WN + nt * 8 + 2 * ct + sp) * 64 + lane) * 8) = PACK8(d, sp); } }
            }
            if (tid == 0) CD[chd] = egam[63];
            RAW_BAR();
        }
#undef PREP_LOADRAW
    }
}

__host__ __device__ constexpr int sc_p(int k) { const int j = k - 32; return j < 12 ? j % 6 : (j - 12) % 5; }
__host__ __device__ constexpr int sc_slab(int k) { const int j = k - 32; return k < 32 ? (k >> 2) : (j < 12 ? j / 6 : 2 + (j - 12) / 5); }
__host__ __device__ constexpr int sc_kind(int k) { return k < 32 ? ((k & 3) < 2 ? 0 : 1) : ((sc_p(k) == 2 || sc_p(k) == 5) ? 1 : 2); }
__host__ __device__ constexpr int sc_idx(int k) { return k < 32 ? (k & 1) : (sc_p(k) == 0 ? 0 : sc_p(k) == 1 ? 1 : sc_p(k) == 2 ? 1 : sc_p(k) == 3 ? 2 : sc_p(k) == 4 ? 3 : 0); }
__host__ __device__ constexpr int sc_frag(int k) { return k < 32 ? (((k & 3) < 2 ? FR_WN : FR_QD) + (k & 1) * 8 + (k >> 2)) : (sc_kind(k) == 1 ? FR_AQK + sc_idx(k) * 4 + sc_slab(k) : FR_KDT + sc_idx(k) * 4 + sc_slab(k)); }
constexpr int SC_QD = 8;
constexpr int SCB = 57344, OT_OFF = 2 * SCB, OT_LD = 136, OT_BYTES = 64 * OT_LD * 2;
static_assert(OT_OFF + 2 * OT_BYTES <= 152 * 1024, "scan LDS");
__device__ __forceinline__ void phase_dn_scan(const Frame& F0, const Args& a, int layer, int unit) {
    PHASE_FRAME(F0);
    unsigned char* ws = OPQ_G(unsigned char, a.ws);
    LAS unsigned char* lds = F.lds;
    const int b = unit >> 3, h = unit & 7, lane = F.lane;
    const bf16* IMG = (const bf16*)(ws + WS_IMG); const bf16* UIMG = (const bf16*)(ws + WS_UIMG); const float* CD = (const float*)(ws + WS_CD);
    const size_t chd0 = (size_t)b * NCH * NH + h;
    if (F.wave < 4) {
#ifndef SCAN_NO_COMPUTE
        const int w = F.wave, c32 = lane & 31, hf = lane >> 5;
        f32x16 S0, S1, S2, S3;
#pragma unroll
        for (int r = 0; r < 16; ++r) { S0[r] = 0.f; S1[r] = 0.f; S2[r] = 0.f; S3[r] = 0.f; }
        const float cdl = CD[chd0 + (size_t)lane * NH];
        v4u UA[4];
        const __amdgpu_buffer_rsrc_t rsU = __builtin_amdgcn_make_buffer_rsrc((void*)(UIMG + chd0 * UIMG_ELEMS), (short)0, NCH * NH * UIMG_ELEMS * 2, 0x00020000);
        const unsigned uoff = (unsigned)((w * 2) * 64 + lane) * 32u;
#define SC_LOADU(dst, nn) do { _Pragma("unroll") for (int mt_ = 0; mt_ < 2; ++mt_) { _Pragma("unroll") for (int hh_ = 0; hh_ < 2; ++hh_) dst[2 * mt_ + hh_] = __builtin_amdgcn_raw_buffer_load_b128(rsU, uoff + (unsigned)(mt_ * 2048 + hh_ * 16), (unsigned)(nn) * (unsigned)(NH * UIMG_ELEMS * 2), 0); } } while (0)
#define SC_FRAG(bufoff, fi) (*(const LAS bf16x8*)(lds + (bufoff) + (fi) * 1024 + lane * 16))
#define SC_CHUNK(nn, U, bufoff, otoff) do { \
        f32x16 aV0, aV1, aO0, aO1; bf16x8 fq0, fq1, fq2, fq3, fq4, fq5, fq6, fq7, Sbs, Vb0, Vb1, Vb2, Vb3; \
        _Pragma("unroll") for (int q = 0; q < 4; ++q) { aV0[2 * q] = bflo(U[0][q]); aV0[2 * q + 1] = bfhi(U[0][q]); aV0[8 + 2 * q] = bflo(U[1][q]); aV0[8 + 2 * q + 1] = bfhi(U[1][q]); \
            aV1[2 * q] = bflo(U[2][q]); aV1[2 * q + 1] = bfhi(U[2][q]); aV1[8 + 2 * q] = bflo(U[3][q]); aV1[8 + 2 * q + 1] = bfhi(U[3][q]); } \
        _Pragma("unroll") for (int r = 0; r < 16; ++r) { aO0[r] = 0.f; aO1[r] = 0.f; } \
        if ((nn) + 1 < NCH) SC_LOADU(U, (nn) + 1); \
        const float cd = __builtin_bit_cast(float, __builtin_amdgcn_readlane(__builtin_bit_cast(int, cdl), (nn))); \
        fq0 = SC_FRAG(bufoff, 0); \
        fq1 = SC_FRAG(bufoff, 8); \
        fq2 = SC_FRAG(bufoff, 16); \
        fq3 = SC_FRAG(bufoff, 24); \
        fq4 = SC_FRAG(bufoff, 1); \
        fq5 = SC_FRAG(bufoff, 9); \
        fq6 = SC_FRAG(bufoff, 17); \
        fq7 = SC_FRAG(bufoff, 25); \
        Sbs = PACK8(S0, 0); \
        aV0 = MFMA32(fq0, Sbs, aV0); \
        fq0 = SC_FRAG(bufoff, 2); \
        aV1 = MFMA32(fq1, Sbs, aV1); \
        fq1 = SC_FRAG(bufoff, 10); \
        aO0 = MFMA32(fq2, Sbs, aO0); \
        fq2 = SC_FRAG(bufoff, 18); \
        aO1 = MFMA32(fq3, Sbs, aO1); \
        fq3 = SC_FRAG(bufoff, 26); \
        Sbs = PACK8(S0, 1); \
        aV0 = MFMA32(fq4, Sbs, aV0); \
        fq4 = SC_FRAG(bufoff, 3); \
        aV1 = MFMA32(fq5, Sbs, aV1); \
        fq5 = SC_FRAG(bufoff, 11); \
        aO0 = MFMA32(fq6, Sbs, aO0); \
        fq6 = SC_FRAG(bufoff, 19); \
        aO1 = MFMA32(fq7, Sbs, aO1); \
        fq7 = SC_FRAG(bufoff, 27); \
        Sbs = PACK8(S1, 0); \
        aV0 = MFMA32(fq0, Sbs, aV0); \
        fq0 = SC_FRAG(bufoff, 4); \
        aV1 = MFMA32(fq1, Sbs, aV1); \
        fq1 = SC_FRAG(bufoff, 12); \
        aO0 = MFMA32(fq2, Sbs, aO0); \
        fq2 = SC_FRAG(bufoff, 20); \
        aO1 = MFMA32(fq3, Sbs, aO1); \
        fq3 = SC_FRAG(bufoff, 28); \
        Sbs = PACK8(S1, 1); \
        aV0 = MFMA32(fq4, Sbs, aV0); \
        fq4 = SC_FRAG(bufoff, 5); \
        aV1 = MFMA32(fq5, Sbs, aV1); \
        fq5 = SC_FRAG(bufoff, 13); \
        aO0 = MFMA32(fq6, Sbs, aO0); \
        fq6 = SC_FRAG(bufoff, 21); \
        aO1 = MFMA32(fq7, Sbs, aO1); \
        fq7 = SC_FRAG(bufoff, 29); \
        Sbs = PACK8(S2, 0); \
        aV0 = MFMA32(fq0, Sbs, aV0); \
        fq0 = SC_FRAG(bufoff, 6); \
        aV1 = MFMA32(fq1, Sbs, aV1); \
        fq1 = SC_FRAG(bufoff, 14); \
        aO0 = MFMA32(fq2, Sbs, aO0); \
        fq2 = SC_FRAG(bufoff, 22); \
        aO1 = MFMA32(fq3, Sbs, aO1); \
        fq3 = SC_FRAG(bufoff, 30); \
        Sbs = PACK8(S2, 1); \
        aV0 = MFMA32(fq4, Sbs, aV0); \
        fq4 = SC_FRAG(bufoff, 7); \
        aV1 = MFMA32(fq5, Sbs, aV1); \
        fq5 = SC_FRAG(bufoff, 15); \
        aO0 = MFMA32(fq6, Sbs, aO0); \
        fq6 = SC_FRAG(bufoff, 23); \
        aO1 = MFMA32(fq7, Sbs, aO1); \
        fq7 = SC_FRAG(bufoff, 31); \
        Sbs = PACK8(S3, 0); \
        aV0 = MFMA32(fq0, Sbs, aV0); \
        fq0 = SC_FRAG(bufoff, 40); \
        aV1 = MFMA32(fq1, Sbs, aV1); \
        fq1 = SC_FRAG(bufoff, 44); \
        aO0 = MFMA32(fq2, Sbs, aO0); \
        fq2 = SC_FRAG(bufoff, 36); \
        aO1 = MFMA32(fq3, Sbs, aO1); \
        fq3 = SC_FRAG(bufoff, 48); \
        Sbs = PACK8(S3, 1); \
        aV0 = MFMA32(fq4, Sbs, aV0); \
        fq4 = SC_FRAG(bufoff, 52); \
        aV1 = MFMA32(fq5, Sbs, aV1); \
        fq5 = SC_FRAG(bufoff, 32); \
        S0 = S0 * cd; S1 = S1 * cd; S2 = S2 * cd; S3 = S3 * cd; \
        aO0 = MFMA32(fq6, Sbs, aO0); \
        fq6 = SC_FRAG(bufoff, 41); \
        aO1 = MFMA32(fq7, Sbs, aO1); \
        fq7 = SC_FRAG(bufoff, 45); \
        Vb0 = PACK8(aV0, 0); Vb1 = PACK8(aV0, 1); Vb2 = PACK8(aV1, 0); Vb3 = PACK8(aV1, 1); \
        S0 = MFMA32(fq0, Vb0, S0); \
        fq0 = SC_FRAG(bufoff, 37); \
        S1 = MFMA32(fq1, Vb0, S1); \
        fq1 = SC_FRAG(bufoff, 49); \
        aO1 = MFMA32(fq2, Vb0, aO1); \
        fq2 = SC_FRAG(bufoff, 53); \
        S2 = MFMA32(fq3, Vb0, S2); \
        fq3 = SC_FRAG(bufoff, 33); \
        S3 = MFMA32(fq4, Vb0, S3); \
        fq4 = SC_FRAG(bufoff, 42); \
        aO0 = MFMA32(fq5, Vb0, aO0); \
        fq5 = SC_FRAG(bufoff, 46); \
        S0 = MFMA32(fq6, Vb1, S0); \
        fq6 = SC_FRAG(bufoff, 38); \
        S1 = MFMA32(fq7, Vb1, S1); \
        fq7 = SC_FRAG(bufoff, 50); \
        aO1 = MFMA32(fq0, Vb1, aO1); \
        fq0 = SC_FRAG(bufoff, 54); \
        S2 = MFMA32(fq1, Vb1, S2); \
        fq1 = SC_FRAG(bufoff, 43); \
        S3 = MFMA32(fq2, Vb1, S3); \
        fq2 = SC_FRAG(bufoff, 47); \
        aO0 = MFMA32(fq3, Vb1, aO0); \
        fq3 = SC_FRAG(bufoff, 39); \
        S0 = MFMA32(fq4, Vb2, S0); \
        fq4 = SC_FRAG(bufoff, 51); \
        S1 = MFMA32(fq5, Vb2, S1); \
        fq5 = SC_FRAG(bufoff, 55); \
        aO1 = MFMA32(fq6, Vb2, aO1); \
        S2 = MFMA32(fq7, Vb2, S2); \
        S3 = MFMA32(fq0, Vb2, S3); \
        S0 = MFMA32(fq1, Vb3, S0); \
        S1 = MFMA32(fq2, Vb3, S1); \
        aO1 = MFMA32(fq3, Vb3, aO1); \
        S2 = MFMA32(fq4, Vb3, S2); \
        S3 = MFMA32(fq5, Vb3, S3); \
        _Pragma("unroll") for (int r = 0; r < 16; ++r) { \
            *(LAS bf16*)(lds + (otoff) + (((r & 3) + 8 * (r >> 2) + 4 * hf) * OT_LD + 32 * w + c32) * 2) = (bf16)(pkbf(aO0[r], 0.f) & 0xffffu); \
            *(LAS bf16*)(lds + (otoff) + ((32 + (r & 3) + 8 * (r >> 2) + 4 * hf) * OT_LD + 32 * w + c32) * 2) = (bf16)(pkbf(aO1[r], 0.f) & 0xffffu); } \
        RAW_BAR(); } while (0)
        SC_LOADU(UA, 0);
        RAW_BAR();
#pragma unroll 1
        for (int n = 0; n < NCH; n += 2) { SC_CHUNK(n, UA, 0, OT_OFF); SC_CHUNK(n + 1, UA, SCB, OT_OFF + OT_BYTES); }
#undef SC_CHUNK
#undef SC_FRAG
#undef SC_LOADU
#endif
    } else {
#ifndef SCAN_NO_HELPER
        const int ht = F.tid - 256, tok = ht >> 2, q = ht & 3;
        bf16* MIXIN = (bf16*)(ws + WS_MIXIN);
        v4u RA[14], RB[14];
        const __amdgpu_buffer_rsrc_t rsI = __builtin_amdgcn_make_buffer_rsrc((void*)(IMG + chd0 * IMG_ELEMS), (short)0, NCH * NH * IMG_ELEMS * 2, 0x00020000);
#define SH_LOADIMG(dst, nn) do { _Pragma("unroll") for (int i_ = 0; i_ < 14; ++i_) dst[i_] = __builtin_amdgcn_raw_buffer_load_b128(rsI, (unsigned)ht * 16u, (unsigned)(nn) * (unsigned)(NH * IMG_ELEMS * 2) + (unsigned)i_ * 4096u, 0); } while (0)
#define SH_STOREIMG(src, bufoff) do { LAS v4u* p_ = (LAS v4u*)(lds + (bufoff)) + ht; _Pragma("unroll") for (int i_ = 0; i_ < 14; ++i_) p_[i_ * 256] = src[i_]; } while (0)
#define SH_EPI(mm, otoff) do { const LAS v4u* op_ = (const LAS v4u*)(lds + (otoff) + (tok * OT_LD + 32 * q) * 2); \
        v4u* yp_ = (v4u*)(MIXIN + ((size_t)b * SEQ + (size_t)(mm) * CH + tok) * D + h * HD + 32 * q); \
        _Pragma("unroll") for (int i_ = 0; i_ < 4; ++i_) yp_[i_] = op_[i_]; } while (0)
#define SH_STEP(nn, Rcur, Rnext, bufnext, otprev) do { \
        if ((nn) + 2 < NCH) SH_LOADIMG(Rcur, (nn) + 2); \
        if ((nn) >= 1) SH_EPI((nn) - 1, otprev); \
        if ((nn) + 1 < NCH) SH_STOREIMG(Rnext, bufnext); \
        RAW_BAR(); } while (0)
        SH_LOADIMG(RA, 0); SH_LOADIMG(RB, 1);
        SH_STOREIMG(RA, 0);
        RAW_BAR();
#pragma unroll 1
        for (int n = 0; n < NCH; n += 2) { SH_STEP(n, RA, RB, SCB, OT_OFF + OT_BYTES); SH_STEP(n + 1, RB, RA, 0, OT_OFF); }
        SH_EPI(NCH - 1, OT_OFF + OT_BYTES);
#undef SH_STEP
#undef SH_EPI
#undef SH_STOREIMG
#undef SH_LOADIMG
#endif
    }
}

__device__ __forceinline__ void phase_dn_norm(const Frame& F0, const Args& a, int layer) {
    PHASE_FRAME(F0);
    unsigned char* ws = OPQ_G(unsigned char, a.ws);
    const bf16* PROJ = (const bf16*)(ws + WS_PROJ); bf16* MIXIN = (bf16*)(ws + WS_MIXIN);
    const int lane = F.lane, gw = F.vcu * NWAVES + F.wave, NGW = F.G * NWAVES;
    const float* nw = a.in[I_NORMW] + layer * HD + 16 * (lane & 7); f32x4 nwv[4];
#pragma unroll
    for (int i = 0; i < 4; ++i) nwv[i] = *(const f32x4*)(nw + 4 * i);
    v4u OA[2], ZA[2], OB[2], ZB[2];
#define DNN_LOAD(O_, Z_, t) do { const v4u* op_ = (const v4u*)(MIXIN + (size_t)(t) * D + 16 * lane); const v4u* zp_ = (const v4u*)(PROJ + (size_t)(t) * NPROJ + 3072 + 16 * lane); O_[0] = op_[0]; O_[1] = op_[1]; Z_[0] = zp_[0]; Z_[1] = zp_[1]; } while (0)
#define DNN_ROW(O_, Z_, t) do { float ss = 0.f; \
        _Pragma("unroll") for (int i = 0; i < 2; ++i) _Pragma("unroll") for (int j = 0; j < 4; ++j) { const float x0 = bflo(O_[i][j]), x1 = bfhi(O_[i][j]); ss += x0 * x0 + x1 * x1; } \
        ss += __shfl_xor(ss, 1); ss += __shfl_xor(ss, 2); ss += __shfl_xor(ss, 4); const float rr = 1.0f / sqrtf(ss * (1.0f / HD) + RMS_EPS); \
        v4u* yp_ = (v4u*)(MIXIN + (size_t)(t) * D + 16 * lane); \
        _Pragma("unroll") for (int i = 0; i < 2; ++i) { v4u o_; _Pragma("unroll") for (int j = 0; j < 4; ++j) { const float z0 = bflo(Z_[i][j]), z1 = bfhi(Z_[i][j]); const f32x4 nn = nwv[2 * i + (j >> 1)]; \
            o_[j] = pkbf(bflo(O_[i][j]) * rr * nn[2 * (j & 1)] * z0 * sigmoidf_(z0), bfhi(O_[i][j]) * rr * nn[2 * (j & 1) + 1] * z1 * sigmoidf_(z1)); } yp_[i] = o_; } } while (0)
    if (gw < T) DNN_LOAD(OA, ZA, gw);
#pragma unroll 1
    for (int t = gw; t < T; t += 2 * NGW) {
        if (t + NGW < T) DNN_LOAD(OB, ZB, t + NGW);
        DNN_ROW(OA, ZA, t);
        if (t + 2 * NGW < T) DNN_LOAD(OA, ZA, t + 2 * NGW);
        if (t + NGW < T) DNN_ROW(OB, ZB, t + NGW);
    }
#undef DNN_LOAD
#undef DNN_ROW
}

__device__ __forceinline__ void phase_ln1_router(const Frame& F0, const Args& a, int layer, int probe = 0) {
    PHASE_FRAME(F0);
    unsigned char* ws = OPQ_G(unsigned char, a.ws);
    LAS float* WRt = (LAS float*)F.lds;
    LAS float* GV = (LAS float*)(F.lds + RING_BYTES);
    LAS int* rowE = (LAS int*)(F.lds + AUX_OFF); LAS int* rowP = rowE + 128; LAS float* rowG = (LAS float*)(rowP + 128); LAS int* lcnt = (LAS int*)(rowG + 128); LAS int* lbase = lcnt + 16;
    const float* wr = OPQ_G(const float, a.in[I_WR]); const float* br = OPQ_G(const float, a.in[I_BR]);
    for (int idx = F.tid; idx < D * NE; idx += 512) WRt[(idx & 15) * D + (idx >> 4)] = wr[idx];
    { const float* g1 = a.in[I_LN1G] + (size_t)layer * D; const float* b1 = a.in[I_LN1B] + (size_t)layer * D; for (int i = F.tid; i < D; i += 512) { GV[i] = g1[i]; GV[D + i] = b1[i]; } }
    const bf16* PRE = (const bf16*)a.out; bf16* X1B = (bf16*)(ws + (probe ? WS_R1 : WS_X1B)); float* STATS = (float*)(ws + (probe ? WS_R1 + 70 * MiB : WS_STATS));
    int* LIST = (int*)(ws + (probe ? WS_R1 + 72 * MiB : WS_LIST)); int* TOKSLOT = (int*)(ws + (probe ? WS_R1 + 80 * MiB : WS_TOKSLOT)); float* GATEW = (float*)(ws + (probe ? WS_R1 + 82 * MiB : WS_GATEW));
    gu32* cnt = F.ctl + CW_CNT + 64 * (layer + (probe ? 2 : 0));
    const int lane = F.lane; const float brl = br[(lane >> 2) & 15];
    for (int rb = F.vcu; rb < T / 64; rb += F.G) {
        if (F.tid < 16) lcnt[F.tid] = 0;
        __syncthreads();
        v2u XA[8], XB_[8];
#define PE_LOAD(X, r) do { const GAS v2u* xr_ = (const GAS v2u*)(PRE + (size_t)(rb * 64 + F.wave * 8 + (r)) * D) + lane; _Pragma("unroll") for (int j = 0; j < 8; ++j) X[j] = xr_[64 * j]; } while (0)
#define PE_ROW(X, r) do { const int lr = F.wave * 8 + (r), row = rb * 64 + lr; unsigned gvo_ = (unsigned)(uintptr_t)GV; asm volatile("" : "+v"(gvo_)); const LAS float* GVr = (const LAS float*)(uintptr_t)gvo_; \
            f32x4 v[8]; float s = 0.f; \
            _Pragma("unroll") for (int j = 0; j < 8; ++j) { v[j] = (f32x4){bflo(X[j].x), bfhi(X[j].x), bflo(X[j].y), bfhi(X[j].y)}; s += (v[j][0] + v[j][1]) + (v[j][2] + v[j][3]); } \
            const float mean = wave_sum(s) * (1.f / D); float s2 = 0.f; \
            _Pragma("unroll") for (int j = 0; j < 8; ++j) { v[j] = v[j] - mean; s2 += (v[j][0] * v[j][0] + v[j][1] * v[j][1]) + (v[j][2] * v[j][2] + v[j][3] * v[j][3]); } \
            const float rstd = 1.f / sqrtf(wave_sum(s2) * (1.f / D) + LN_EPS); \
            if (lane == 0) { STATS[2 * row] = mean; STATS[2 * row + 1] = rstd; } \
            GAS v2u* o8 = (GAS v2u*)(X1B + (size_t)row * D) + lane; \
            float lg[16]; \
            _Pragma("unroll") for (int e = 0; e < 16; ++e) lg[e] = 0.f; \
            _Pragma("unroll") for (int j = 0; j < 8; ++j) { const f32x4 gg = *(const LAS f32x4*)(GVr + 256 * j + 4 * lane), bb = *(const LAS f32x4*)(GVr + D + 256 * j + 4 * lane); \
                v[j] = v[j] * rstd * gg + bb; \
                v2u w; w.x = pkbf(v[j][0], v[j][1]); w.y = pkbf(v[j][2], v[j][3]); o8[64 * j] = w; \
                _Pragma("unroll") for (int e = 0; e < 16; ++e) { const f32x4 w4 = *(const LAS f32x4*)(WRt + e * D + 256 * j + 4 * lane); lg[e] += (v[j][0] * w4[0] + v[j][1] * w4[1]) + (v[j][2] * w4[2] + v[j][3] * w4[3]); } } \
              \
            float t8[8], t4[4], t2[2], t1; \
            { const bool hi = (lane & 32) != 0; _Pragma("unroll") for (int i = 0; i < 8; ++i) { const float snd = hi ? lg[i] : lg[8 + i], kp = hi ? lg[8 + i] : lg[i]; t8[i] = kp + __shfl_xor(snd, 32); } } \
            { const bool hi = (lane & 16) != 0; _Pragma("unroll") for (int i = 0; i < 4; ++i) { const float snd = hi ? t8[i] : t8[4 + i], kp = hi ? t8[4 + i] : t8[i]; t4[i] = kp + __shfl_xor(snd, 16); } } \
            { const bool hi = (lane & 8) != 0; _Pragma("unroll") for (int i = 0; i < 2; ++i) { const float snd = hi ? t4[i] : t4[2 + i], kp = hi ? t4[2 + i] : t4[i]; t2[i] = kp + __shfl_xor(snd, 8); } } \
            { const bool hi = (lane & 4) != 0; const float snd = hi ? t2[0] : t2[1], kp = hi ? t2[1] : t2[0]; t1 = kp + __shfl_xor(snd, 4); } \
            t1 += __shfl_xor(t1, 2); t1 += __shfl_xor(t1, 1); t1 += brl; \
            float lgu[16]; float mx = -3.0e38f; \
            _Pragma("unroll") for (int e = 0; e < 16; ++e) { lgu[e] = __builtin_bit_cast(float, __builtin_amdgcn_readlane(__builtin_bit_cast(int, t1), 4 * e)); mx = fmaxf(mx, lgu[e]); } \
            float p[16]; \
            _Pragma("unroll") for (int e = 0; e < 16; ++e) p[e] = __expf(lgu[e] - mx); \
            float gsc[4]; \
            _Pragma("unroll") for (int g = 0; g < 4; ++g) { const float a0 = p[4 * g], a1 = p[4 * g + 1], a2 = p[4 * g + 2], a3 = p[4 * g + 3]; \
                const float hi1 = fmaxf(a0, a1), lo1 = fminf(a0, a1), hi2 = fmaxf(a2, a3), lo2 = fminf(a2, a3); \
                gsc[g] = fmaxf(hi1, hi2) + fmaxf(fminf(hi1, hi2), fmaxf(lo1, lo2)); } \
            int gsel = 0; float best = gsc[0]; \
            _Pragma("unroll") for (int g = 1; g < 4; ++g) if (gsc[g] > best) { best = gsc[g]; gsel = g; } \
            float q[4]; \
            _Pragma("unroll") for (int j = 0; j < 4; ++j) q[j] = gsel == 0 ? p[j] : (gsel == 1 ? p[4 + j] : (gsel == 2 ? p[8 + j] : p[12 + j])); \
            int i0 = 0; float p0 = q[0]; \
            _Pragma("unroll") for (int j = 1; j < 4; ++j) if (q[j] > p0) { p0 = q[j]; i0 = j; } \
            int i1 = -1; float p1 = -1.f; \
            _Pragma("unroll") for (int j = 0; j < 4; ++j) if (j != i0 && q[j] > p1) { p1 = q[j]; i1 = j; } \
            if (lane == 0) { const int e0 = gsel * 4 + i0, e1 = gsel * 4 + i1; const float inv = 1.0f / (p0 + p1); \
                rowE[2 * lr] = e0; rowE[2 * lr + 1] = e1; rowG[2 * lr] = p0 * inv; rowG[2 * lr + 1] = p1 * inv; \
                rowP[2 * lr] = __hip_atomic_fetch_add(&lcnt[e0], 1, __ATOMIC_RELAXED, __HIP_MEMORY_SCOPE_WORKGROUP); rowP[2 * lr + 1] = __hip_atomic_fetch_add(&lcnt[e1], 1, __ATOMIC_RELAXED, __HIP_MEMORY_SCOPE_WORKGROUP); } } while (0)
        PE_LOAD(XA, 0);
#pragma unroll 1
        for (int r = 0; r < 8; r += 2) { PE_LOAD(XB_, r + 1); PE_ROW(XA, r); if (r + 2 < 8) PE_LOAD(XA, r + 2); PE_ROW(XB_, r + 1); }
#undef PE_LOAD
#undef PE_ROW
        __syncthreads();
        if (F.tid < 16) lbase[F.tid] = (int)__hip_atomic_fetch_add(cnt + F.tid, (unsigned)lcnt[F.tid], RLX_AGENT);
        __syncthreads();
        if (F.tid < 128) { const int e = rowE[F.tid], pos = lbase[e] + rowP[F.tid], tok = rb * 64 + (F.tid >> 1);
            LIST[(size_t)e * LCAP + pos] = tok; TOKSLOT[2 * tok + (F.tid & 1)] = e * LCAP + pos; GATEW[2 * tok + (F.tid & 1)] = rowG[F.tid]; }
        __syncthreads();
    }
}
__device__ __forceinline__ void moe_table(const Frame& F0, int layer) {
    PHASE_FRAME(F0);
    LAS int* tab = (LAS int*)(F.lds + AUX_OFF);
    __syncthreads();
    if (F.tid < 16) tab[32 + F.tid] = (int)__hip_atomic_load(F.ctl + CW_CNT + 64 * layer + F.tid, RLX_AGENT);
    __syncthreads();
    if (F.tid == 0) { int run = 0; for (int e = 0; e < 16; ++e) { tab[e] = run; run += (tab[32 + e] + 255) >> 8; } tab[16] = run; }
    __syncthreads();
}
__device__ __forceinline__ void phase_combine_ln2(const Frame& F0, const Args& a, int layer, int probe = 0) {
    PHASE_FRAME(F0);
    unsigned char* ws = OPQ_G(unsigned char, a.ws); const LAS int* tab = (const LAS int*)(F.lds + AUX_OFF);
    const bf16* PRE = (const bf16*)a.out; const float* STATS = (const float*)(ws + WS_STATS); const bf16* Y = (const bf16*)(ws + WS_Y); bf16* X2B = (bf16*)(ws + (probe ? WS_R1 : WS_X2B));
    const int* TOKSLOT = (const int*)(ws + WS_TOKSLOT); const float* GATEW = (const float*)(ws + WS_GATEW);
    LAS float* GV = (LAS float*)F.lds;
    { const float* g1 = a.in[I_LN1G] + (size_t)layer * D; const float* b1 = a.in[I_LN1B] + (size_t)layer * D; const float* g2 = a.in[I_LN2G] + (size_t)layer * D; const float* b2 = a.in[I_LN2B] + (size_t)layer * D;
        for (int i = F.tid; i < D; i += 512) { GV[i] = g1[i]; GV[D + i] = b1[i]; GV[2 * D + i] = g2[i]; GV[3 * D + i] = b2[i]; } }
    __syncthreads();
    const int gw = F.vcu * NWAVES + F.wave, NGW = F.G * NWAVES, nrows = (T - gw + NGW - 1) / NGW, lane = F.lane;
    for (int base = 0; base < nrows; base += 64) {
        const int nr = (nrows - base) < 64 ? (nrows - base) : 64;
        float m_mean = 0.f, m_rstd = 0.f, m_w0 = 0.f, m_w1 = 0.f; int m_y0 = 0, m_y1 = 0;
        if (lane < nr) { const int row = gw + NGW * (base + lane); m_mean = STATS[2 * row]; m_rstd = STATS[2 * row + 1]; m_w0 = GATEW[2 * row]; m_w1 = GATEW[2 * row + 1];
            const int s0 = TOKSLOT[2 * row], s1 = TOKSLOT[2 * row + 1]; m_y0 = tab[s0 / LCAP] * 256 + (s0 % LCAP); m_y1 = tab[s1 / LCAP] * 256 + (s1 % LCAP); }
        v2u XA[8], PA[8], QA[8], XB_[8], PB_[8], QB_[8];
#define PH_LOAD(X, P, Q, i) do { const int row_ = gw + NGW * (base + (i)); const size_t y0_ = (size_t)__builtin_amdgcn_readlane(m_y0, (i)), y1_ = (size_t)__builtin_amdgcn_readlane(m_y1, (i)); \
            const GAS v2u* xr_ = (const GAS v2u*)(PRE + (size_t)row_ * D) + lane; const GAS v2u* ya_ = (const GAS v2u*)(Y + y0_ * D) + lane; const GAS v2u* yb_ = (const GAS v2u*)(Y + y1_ * D) + lane; \
            _Pragma("unroll") for (int j = 0; j < 8; ++j) { X[j] = xr_[64 * j]; P[j] = ya_[64 * j]; Q[j] = yb_[64 * j]; } } while (0)
#define PH_ROW(X, P, Q, i) do { const int row_ = gw + NGW * (base + (i)); unsigned gvo_ = (unsigned)(uintptr_t)GV; asm volatile("" : "+v"(gvo_)); const LAS float* GVr = (const LAS float*)(uintptr_t)gvo_;     \
            const float mean = __builtin_bit_cast(float, __builtin_amdgcn_readlane(__builtin_bit_cast(int, m_mean), (i))), rstd = __builtin_bit_cast(float, __builtin_amdgcn_readlane(__builtin_bit_cast(int, m_rstd), (i))); \
            const float w0 = __builtin_bit_cast(float, __builtin_amdgcn_readlane(__builtin_bit_cast(int, m_w0), (i))), w1 = __builtin_bit_cast(float, __builtin_amdgcn_readlane(__builtin_bit_cast(int, m_w1), (i))); \
            f32x4 v[8]; float s = 0.f; \
            _Pragma("unroll") for (int j = 0; j < 8; ++j) { const f32x4 gg = *(const LAS f32x4*)(GVr + 256 * j + 4 * lane), bb = *(const LAS f32x4*)(GVr + D + 256 * j + 4 * lane); \
                const f32x4 x1 = ((f32x4){bflo(X[j].x), bfhi(X[j].x), bflo(X[j].y), bfhi(X[j].y)} - mean) * rstd * gg + bb; \
                f32x4 f; f[0] = w0 * bflo(P[j].x) + w1 * bflo(Q[j].x); f[1] = w0 * bfhi(P[j].x) + w1 * bfhi(Q[j].x); f[2] = w0 * bflo(P[j].y) + w1 * bflo(Q[j].y); f[3] = w0 * bfhi(P[j].y) + w1 * bfhi(Q[j].y); \
                v[j] = x1 * ALPHA + f; s += (v[j][0] + v[j][1]) + (v[j][2] + v[j][3]); } \
            const float m2 = wave_sum(s) * (1.f / D); float q = 0.f; \
            _Pragma("unroll") for (int j = 0; j < 8; ++j) { v[j] = v[j] - m2; q += (v[j][0] * v[j][0] + v[j][1] * v[j][1]) + (v[j][2] * v[j][2] + v[j][3] * v[j][3]); } \
            const float r2 = 1.f / sqrtf(wave_sum(q) * (1.f / D) + LN_EPS); \
            GAS v2u* o8 = (GAS v2u*)(X2B + (size_t)row_ * D) + lane; \
            _Pragma("unroll") for (int j = 0; j < 8; ++j) { const f32x4 gg = *(const LAS f32x4*)(GVr + 2 * D + 256 * j + 4 * lane), bb = *(const LAS f32x4*)(GVr + 3 * D + 256 * j + 4 * lane); \
                const f32x4 o = v[j] * r2 * gg + bb; v2u w; w.x = pkbf(o[0], o[1]); w.y = pkbf(o[2], o[3]); o8[64 * j] = w; } } while (0)
        PH_LOAD(XA, PA, QA, 0);
#pragma unroll 1
        for (int i = 0; i < nr; i += 2) {
            if (i + 1 < nr) PH_LOAD(XB_, PB_, QB_, i + 1);
            PH_ROW(XA, PA, QA, i);
            if (i + 2 < nr) PH_LOAD(XA, PA, QA, i + 2);
            if (i + 1 < nr) PH_ROW(XB_, PB_, QB_, i + 1);
        }
#undef PH_LOAD
#undef PH_ROW
    }
}

#ifndef MK_N_LAUNCHES
#define MK_N_LAUNCHES 1
#endif
constexpr int NPL = 10;
constexpr int NPHASE = 1 + NPL * DEPTH;
constexpr int N_LAUNCHES = MK_N_LAUNCHES;
static_assert(N_LAUNCHES == 1 || N_LAUNCHES == NPHASE, "MK_N_LAUNCHES is 1 or NPHASE");

__global__ void __launch_bounds__(NWAVES * 64, 2) trunk_fwd(Args args) {
    extern __shared__ __attribute__((aligned(16))) unsigned char lds[];
    Frame F;
    F.lds = (LAS unsigned char*)lds;
    F.MISC = (volatile LAS unsigned*)(F.lds + MISC_OFF);
    F.tid = threadIdx.x; F.lane = F.tid & 63; F.wave = __builtin_amdgcn_readfirstlane(F.tid >> 6);
    F.G = gridDim.x; { const int bx = blockIdx.x; F.vcu = (F.G % 8 == 0) ? (bx % 8) * (F.G / 8) + bx / 8 : bx; }
    unsigned char* ws = args.ws;
    F.ctl = (gu32*)(ws + WS_CTL);
    for (int u = F.tid; u < (LDS_BYTES - LDSCTL_OFF) / 4; u += NWAVES * 64) ((LAS unsigned*)(F.lds + LDSCTL_OFF))[u] = 0u;
    __syncthreads();
    XcdBarrier bar; bar.bar = (unsigned*)(F.ctl + CW_BAR); bar.x = 0; bar.st = nullptr;
    if (N_LAUNCHES == 1) bar = xcd_barrier_post((unsigned*)(F.ctl + CW_BAR), F.MISC + 8);
#define GRID_BAR() do { if (N_LAUNCHES == 1) xcd_barrier(bar); } while (0)
    const int lo = args.ph_lo, hi = args.ph_hi;
#ifndef PH_MASK
#define PH_MASK 0x7ff
#endif
#define IN(k) ((((k) == 0 ? 1u : (2u << (((k) - 1) % NPL))) & (unsigned)(PH_MASK)) && lo <= (k) && (k) < hi)
#define SEAM(k) do { if (IN((k) + 1)) GRID_BAR(); } while (0)
#ifndef PROBE_DUP
#define PROBE_DUP 0
#endif
#define REPS(k) ((((k) == 0 ? 1u : (2u << (((k) - 1) % NPL))) & (unsigned)(PROBE_DUP)) ? 2 : 1)

    if (IN(0)) { for (int rep = 0; rep < REPS(0); ++rep) { if (rep) GRID_BAR(); p0_prologue(F, args); } SEAM(0); }

#ifdef LAYER_UNROLL
#pragma unroll
#else
#pragma unroll 1
#endif
    for (int layer = 0; layer < DEPTH; ++layer) {
        const int pb = 1 + NPL * layer;
        unsigned char* ws = OPQ_G(unsigned char, args.ws);
        if (IN(pb + 0)) { for (int rep = 0; rep < REPS(pb + 0); ++rep) { if (rep) GRID_BAR();
            SchedDense S; S.init(T, NPROJ, F.G, (int)blockIdx.x, ws + WS_XB, D, (const bf16*)(ws + WS_WIN) + (size_t)layer * NPROJ * D, D);
            EpiBf16 E{(bf16*)(ws + WS_PROJ), NPROJ};
            pg8::gemm_phase<EpiBf16, SchedDense, false>(F.lds + RING_OFF, D, D, D, S, E);
            } SEAM(pb + 0);
        }
        if (IN(pb + 1)) { for (int rep = 0; rep < REPS(pb + 1); ++rep) { if (rep) GRID_BAR(); phase_dn_prep(F, args, layer); } SEAM(pb + 1); }
        if (IN(pb + 2)) { for (int rep = 0; rep < REPS(pb + 2); ++rep) { if (rep) GRID_BAR();
            if (blockIdx.x < 32 || F.G <= 32) { for (int u = blockIdx.x; u < NB * NH; u += (F.G < 32 ? F.G : 32)) { phase_dn_scan(F, args, layer, u);
#ifdef SCAN_TWICE
                __syncthreads(); phase_dn_scan(F, args, layer, u);
#endif
            } }
            if (blockIdx.x >= 32 || F.G <= 32) { const int G2 = F.G <= 32 ? F.G : F.G - 32, c2 = F.G <= 32 ? (int)blockIdx.x : (int)blockIdx.x - 32;
                { int t_ = threadIdx.x; asm volatile("" : "+v"(t_)); Frame Fp = F; Fp.tid = t_; Fp.lane = t_ & 63;
                  for (int L = c2; L < 256; L += G2) pool_diffs_unit(Fp, ws, L >> 2, L & 3);
                  asm volatile("s_waitcnt vmcnt(0)" ::: "memory"); __syncthreads(); }
                { SchedPool S{G2, c2, (const char*)(ws + WS_POOLD), (const char*)((const bf16*)(ws + WS_WPOOL) + (size_t)layer * 4 * 65536)};
                  EpiPool E{(bf16*)(ws + WS_MIXIN), args.in[I_POOLS] + (size_t)layer * PW};
                  pg8::gemm_phase<EpiPool, SchedPool, false>(F.lds + RING_OFF, 256, PW, 256, S, E); }
                { SchedDense S; S.init(T, D, G2, c2, (const bf16*)(ws + WS_PB16) + (size_t)layer * T * PLE, PLE, (const bf16*)(ws + WS_WPP) + (size_t)layer * D * PLE, PLE);
                  EpiBf16 E{(bf16*)(ws + WS_PP), D};
                  pg8::gemm_phase<EpiBf16, SchedDense, false>(F.lds + RING_OFF, PLE, PLE, PLE, S, E); }
#ifndef CONVERT_ALL_IN_PROLOGUE
                { int t_ = threadIdx.x; asm volatile("" : "+v"(t_)); weight_items(args, ws, (LAS float*)(F.lds + RING_OFF + F.wave * 16384), t_ & 63, 1, layer, c2 * NWAVES + F.wave, G2 * NWAVES); }
#endif
                }
            } SEAM(pb + 2);
        }
        if (IN(pb + 3)) { for (int rep = 0; rep < REPS(pb + 3); ++rep) { if (rep) GRID_BAR(); phase_dn_norm(F, args, layer); } SEAM(pb + 3); }
        if (IN(pb + 4)) { for (int rep = 0; rep < REPS(pb + 4); ++rep) { if (rep) GRID_BAR();
            SchedDense S; S.init(T, D, F.G, (int)blockIdx.x, ws + WS_MIXIN, D, (const bf16*)(ws + WS_WOUT) + (size_t)layer * D * D, D);
            EpiRes E{(const bf16*)(ws + WS_XB), (bf16*)args.out};
#ifdef PROBE_PD
            { EpiRes E2{(const bf16*)(ws + WS_XB), (bf16*)(ws + WS_R1)}; pg8::gemm_phase<EpiRes, SchedDense, false>(F.lds + RING_OFF, D, D, D, S, E2); }
#endif
            pg8::gemm_phase<EpiRes, SchedDense, false>(F.lds + RING_OFF, D, D, D, S, E);
            } SEAM(pb + 4);
        }
        if (IN(pb + 5)) { for (int rep = 0; rep < REPS(pb + 5); ++rep) { if (rep) GRID_BAR();
#ifdef PROBE_PE
            phase_ln1_router(F, args, layer, 1); __syncthreads();
#endif
            phase_ln1_router(F, args, layer); } SEAM(pb + 5); }
        if (IN(pb + 6)) { for (int rep = 0; rep < REPS(pb + 6); ++rep) { if (rep) GRID_BAR();
            moe_table(F, layer);
            SchedMoe S{F.G, (int)blockIdx.x, 0, (const LAS int*)(F.lds + AUX_OFF), (const char*)(ws + WS_X1B), (const char*)((const bf16*)(ws + WS_WGU) + (size_t)layer * NE * 2048 * D), (const int*)(ws + WS_LIST)};
            EpiSwiglu E{(bf16*)(ws + WS_HID)};
            pg8::gemm_phase<EpiSwiglu, SchedMoe, true>(F.lds + RING_OFF, D, D, D, S, E);
            } SEAM(pb + 6);
        }
        if (IN(pb + 7)) { for (int rep = 0; rep < REPS(pb + 7); ++rep) { if (rep) GRID_BAR();
            moe_table(F, layer);
            SchedMoe S{F.G, (int)blockIdx.x, 1, (const LAS int*)(F.lds + AUX_OFF), (const char*)(ws + WS_HID), (const char*)((const bf16*)(ws + WS_WD) + (size_t)layer * NE * D * DE), nullptr};
            EpiBf16 E{(bf16*)(ws + WS_Y), D};
            pg8::gemm_phase<EpiBf16, SchedMoe, false>(F.lds + RING_OFF, DE, DE, DE, S, E);
            } SEAM(pb + 7);
        }
        if (IN(pb + 8)) { for (int rep = 0; rep < REPS(pb + 8); ++rep) { if (rep) GRID_BAR(); moe_table(F, layer);
#ifdef PROBE_PH
            phase_combine_ln2(F, args, layer, 1);
#endif
            phase_combine_ln2(F, args, layer); } SEAM(pb + 8); }
        if (IN(pb + 9)) { for (int rep = 0; rep < REPS(pb + 9); ++rep) { if (rep) GRID_BAR();
            { SchedDense S; S.init(T, D, F.G, (int)blockIdx.x, ws + WS_X2B, D, (const bf16*)(ws + WS_WPG) + (size_t)layer * D * D, D);
#ifdef PROBE_PI
              { EpiPle E2{(const bf16*)(ws + WS_X2B), (const bf16*)(ws + WS_PP), (bf16*)(ws + WS_R1), (float*)(ws + WS_R1), layer + 1 < DEPTH ? 0 : 1}; pg8::gemm_phase<EpiPle, SchedDense, false>(F.lds + RING_OFF, D, D, D, S, E2); }
#endif
              EpiPle E{(const bf16*)(ws + WS_X2B), (const bf16*)(ws + WS_PP), (bf16*)(ws + WS_XB), args.out, layer + 1 < DEPTH ? 0 : 1};
              pg8::gemm_phase<EpiPle, SchedDense, false>(F.lds + RING_OFF, D, D, D, S, E); }
            } SEAM(pb + 9);
        }
    }
#undef IN
#undef SEAM
#undef GRID_BAR
}

extern "C" void kernel_launch(void* const* d_in, const int* in_sizes, int n_in, void* d_out, int out_size, void* d_ws, size_t ws_size, hipStream_t stream) {
    static int grid = 0;
    if (grid == 0) {
        if (n_in != 21 || in_sizes[0] != T * D || out_size != T * D || ws_size < WS_END) { fprintf(stderr, "kernel_launch: unexpected shapes (n_in %d, in0 %d, out %d, ws %zu); nothing launched\n", n_in, n_in > 0 ? in_sizes[0] : -1, out_size, ws_size); grid = -1; return; }
        int dev = 0, cus = 0, per_cu = 0;
        if (hipGetDevice(&dev) != hipSuccess || hipDeviceGetAttribute(&cus, hipDeviceAttributeMultiprocessorCount, dev) != hipSuccess) { grid = -1; return; }
        if (hipFuncSetAttribute((const void*)trunk_fwd, hipFuncAttributeMaxDynamicSharedMemorySize, LDS_BYTES) != hipSuccess) { fprintf(stderr, "kernel_launch: hipFuncSetAttribute failed\n"); grid = -1; return; }
        if (hipOccupancyMaxActiveBlocksPerMultiprocessor(&per_cu, (const void*)trunk_fwd, NWAVES * 64, LDS_BYTES) != hipSuccess || per_cu < 1) { fprintf(stderr, "kernel_launch: occupancy query reports %d workgroups per CU\n", per_cu); }
        (void)hipGetLastError();
        grid = cus;
    }
    if (grid < 0) return;
    if (hipMemsetAsync((char*)d_ws + WS_CTL, 0, CTL_ZERO_BYTES, stream) != hipSuccess) return;
    Args a{};
    for (int i = 0; i < 21; ++i) a.in[i] = (const float*)d_in[i];
    a.out = (float*)d_out; a.ws = (unsigned char*)d_ws;
    for (int li = 0; li < N_LAUNCHES; ++li) {
        a.ph_lo = (N_LAUNCHES == 1) ? 0 : li; a.ph_hi = (N_LAUNCHES == 1) ? NPHASE : li + 1; a.li = li; a.pad = 0;
        hipLaunchKernelGGL(trunk_fwd, dim3(grid), dim3(NWAVES * 64), LDS_BYTES, stream, a);
        const hipError_t le = hipPeekAtLastError();
        if (le != hipSuccess) { fprintf(stderr, "kernel_launch: launch %d failed: %s\n", li, hipGetErrorName(le)); break; }
    }
}
```

```cpp
#define MK_N_LAUNCHES 1
#define CONVERT_ALL_IN_PROLOGUE 1
#include <hip/hip_runtime.h>
#include <cstdio>
#include <cstdint>

#define GAS __attribute__((address_space(1)))
#define LAS __attribute__((address_space(3)))
typedef unsigned short bf16;
typedef unsigned v4u __attribute__((ext_vector_type(4)));
typedef unsigned v2u __attribute__((ext_vector_type(2)));
typedef float f32x4 __attribute__((ext_vector_type(4)));
typedef float f32x2 __attribute__((ext_vector_type(2)));
typedef short bf16x8 __attribute__((ext_vector_type(8)));
typedef GAS unsigned gu32;
typedef int v4i_t __attribute__((ext_vector_type(4)));
typedef int v8i_t __attribute__((ext_vector_type(8)));

namespace pg8 {
constexpr int BM = 256, BK = 64, HALF = 128, HTB = HALF * BK * 2  , STAGE_BYTES = 8 * HTB, NXCD = 8, WGM = 8;
__host__ __device__ __forceinline__ int lds_byte(int r, int c) { const int st = (r >> 4) * 2 + (c >> 5), rr = r & 15, cc = c & 31, ob = rr * 64 + cc * 2; return st * 1024 + (ob ^ (((ob >> 9) & 1) << 5)); }
__host__ __device__ __forceinline__ void stage_rc(int b, int& R, int& C) { const int st = b / 1024, sb = b % 1024, swz = sb ^ (((sb >> 9) & 1) << 5); R = (st >> 1) * 16 + swz / 64; C = (st & 1) * 32 + (swz % 64) / 2; }
__host__ __device__ __forceinline__ int perm32(int rho) { const int n = rho >> 4, i = rho & 15; return 8 * (i >> 2) + 4 * n + (i & 3); }

struct Unit { int pm, pn; const char* A; const char* B; const int* rows; int nvalid; int aux; };

__device__ __forceinline__ unsigned cvt_pk_bf16(float lo, float hi) { unsigned r; asm volatile("v_cvt_pk_bf16_f32 %0, %1, %2" : "=v"(r) : "v"(lo), "v"(hi)); return r; }

template <class Epi, class Sched, bool GATHER, bool FP8 = false>
__device__ __forceinline__ void gemm_phase(LAS unsigned char* lds, const int K, const int lda, const int ldb, const Sched& S, const Epi& E) {
    int tid_ = threadIdx.x; asm volatile("" : "+v"(tid_));
    const int tid = tid_, wid = __builtin_amdgcn_readfirstlane(tid >> 6), lane = tid & 63, wr = wid >> 2, wc = wid & 3, fr = lane & 15, fq = lane >> 4;
    const int nt = K / BK;
    unsigned voffA[2], voffB[2]; int RA[2], CA[2];
#pragma unroll
    for (int i = 0; i < 2; ++i) { int R, C; stage_rc(tid * 16 + i * 8192, R, C); const int Rb = Epi::PERM ? ((R & ~31) + perm32(R & 31)) : R;
        RA[i] = R; CA[i] = C; voffA[i] = (unsigned)(R * lda + C) * 2u; voffB[i] = (unsigned)(Rb * ldb + C) * 2u; }
    unsigned gA[2][2], gN[2][2];
    const size_t kstep = (size_t)(BK * 2);
    const size_t hstepA = GATHER ? 0 : (size_t)HALF * lda * 2, hstepB = (size_t)HALF * ldb * 2;
    const unsigned ldsw = (unsigned)wid * 1024u;
    const int aoff = lds_byte(wr * 64 + fr, fq * 8), boff = lds_byte(wc * 32 + fr, fq * 8);
#define PG8_SA(b, h) (((b) * 2 + (h)) * HTB)
#define PG8_SB(b, h) ((4 + (b) * 2 + (h)) * HTB)
#define PG8_STAGE_B(bufoff, gbase) do { _Pragma("unroll") for (int _i = 0; _i < 2; ++_i) \
        __builtin_amdgcn_global_load_lds((const unsigned*)((const char*)(gbase) + voffB[_i]), (LAS unsigned*)(lds + (bufoff) + ldsw + _i * 8192), 16, 0, 0); } while (0)
#define PG8_STAGE_A(bufoff, gbase, h) do { _Pragma("unroll") for (int _i = 0; _i < 2; ++_i) \
        __builtin_amdgcn_global_load_lds((const unsigned*)((const char*)(gbase) + (GATHER ? gA[h][_i] : voffA[_i]) + (h) * hstepA), (LAS unsigned*)(lds + (bufoff) + ldsw + _i * 8192), 16, 0, 0); } while (0)
#define PG8_CAT(x0, x1) __builtin_shufflevector(__builtin_bit_cast(v4i_t, (x0)), __builtin_bit_cast(v4i_t, (x1)), 0, 1, 2, 3, 4, 5, 6, 7)
#define PG8_LDA(dst, b, h) do { _Pragma("unroll") for (int m = 0; m < 4; ++m) { if constexpr (FP8) dst##8[m] = PG8_CAT(*(const LAS bf16x8*)(lds + PG8_SA(b, h) + aoff + m * 2048), *(const LAS bf16x8*)(lds + PG8_SA(b, h) + aoff + m * 2048 + 1024)); \
        else { _Pragma("unroll") for (int k = 0; k < 2; ++k) dst[m][k] = *(const LAS bf16x8*)(lds + PG8_SA(b, h) + aoff + m * 2048 + k * 1024); } } } while (0)
#define PG8_LDB(dst, b, h) do { _Pragma("unroll") for (int n = 0; n < 2; ++n) { if constexpr (FP8) dst##8[n] = PG8_CAT(*(const LAS bf16x8*)(lds + PG8_SB(b, h) + boff + n * 2048), *(const LAS bf16x8*)(lds + PG8_SB(b, h) + boff + n * 2048 + 1024)); \
        else { _Pragma("unroll") for (int k = 0; k < 2; ++k) dst[n][k] = *(const LAS bf16x8*)(lds + PG8_SB(b, h) + boff + n * 2048 + k * 1024); } } } while (0)
#define PG8_MMA(ai, bj, At, Bt) do { __builtin_amdgcn_s_setprio(1); \
        if constexpr (FP8) { _Pragma("unroll") for (int m = 0; m < 4; ++m) _Pragma("unroll") for (int n = 0; n < 2; ++n) \
            acc[ai][bj][m][n] = __builtin_amdgcn_mfma_scale_f32_16x16x128_f8f6f4(Bt##8[n], At##8[m], acc[ai][bj][m][n], 0, 0, 0, 0x7f7f7f7f, 0, 0x7f7f7f7f); } \
        else { _Pragma("unroll") for (int m = 0; m < 4; ++m) _Pragma("unroll") for (int n = 0; n < 2; ++n) _Pragma("unroll") for (int k = 0; k < 2; ++k) \
            acc[ai][bj][m][n] = __builtin_amdgcn_mfma_f32_16x16x32_bf16(Bt[n][k], At[m][k], acc[ai][bj][m][n], 0, 0, 0); } \
        __builtin_amdgcn_s_setprio(0); } while (0)
#define PG8_WAIT_V(n) asm volatile("s_waitcnt vmcnt(" #n ")" ::: "memory")
#define PG8_WAIT_L(n) asm volatile("s_waitcnt lgkmcnt(" #n ")" ::: "memory")
#define PG8_BAR __builtin_amdgcn_s_barrier()
#define PG8_SCHED __builtin_amdgcn_sched_barrier(0)
#define PG8_GLOAD(dst, u) do { _Pragma("unroll") for (int _h = 0; _h < 2; ++_h) _Pragma("unroll") for (int _i = 0; _i < 2; ++_i) { const int _r = _h * HALF + RA[_i]; \
        const int _t = (_r < (u).nvalid) ? (u).rows[_r] : 0; dst[_h][_i] = (unsigned)(_t * lda + CA[_i]) * 2u; } } while (0)
    Unit cur, nxt; int ui = 0;
    if (!S.next(0, cur)) return;
    f32x4 acc[2][2][4][2];
#pragma unroll
    for (int a = 0; a < 2; ++a)
#pragma unroll
        for (int b = 0; b < 2; ++b)
#pragma unroll
            for (int m = 0; m < 4; ++m)
#pragma unroll
                for (int n = 0; n < 2; ++n) acc[a][b][m][n] = (f32x4){0.f, 0.f, 0.f, 0.f};
    bf16x8 At[4][2], B0[2][2], B1[2][2]; v8i_t At8[4], B08[2], B18[2];
    const char* cA = cur.A; const char* cB = cur.B;
    if constexpr (GATHER) { PG8_GLOAD(gA, cur); PG8_WAIT_V(0); }
    PG8_STAGE_B(PG8_SB(0, 0), cB); PG8_STAGE_B(PG8_SB(0, 1), cB + hstepB); PG8_STAGE_A(PG8_SA(0, 0), cA, 0); PG8_STAGE_A(PG8_SA(0, 1), cA, 1);
    if (wr == 1) PG8_BAR;
    PG8_WAIT_V(2); PG8_BAR;
    PG8_STAGE_B(PG8_SB(1, 0), cB + kstep); PG8_STAGE_A(PG8_SA(1, 0), cA + kstep, 0); PG8_STAGE_B(PG8_SB(1, 1), cB + hstepB + kstep);
    PG8_WAIT_V(6); PG8_BAR;
    for (;;) {
        const bool has_next = S.next(ui + 1, nxt);
        const char* nA = has_next ? nxt.A : cA; const char* nB = has_next ? nxt.B : cB;
        if constexpr (GATHER) { if (has_next) { PG8_GLOAD(gN, nxt); } else {
#pragma unroll
            for (int h = 0; h < 2; ++h)
#pragma unroll
                for (int i = 0; i < 2; ++i) gN[h][i] = gA[h][i]; } }
#pragma unroll 1
        for (int t = 0; t < nt; t += 2) {
            const bool last = (t == nt - 2);
            const char* a1 = cA + (size_t)(t + 1) * kstep;
            const char* a2 = last ? nA : cA + (size_t)(t + 2) * kstep; const char* b2 = last ? nB : cB + (size_t)(t + 2) * kstep;
            const char* a3 = a2 + kstep; const char* b3 = b2 + kstep;
            PG8_LDB(B0, 0, 0); PG8_LDB(B1, 0, 1); PG8_SCHED; PG8_LDA(At, 0, 0); PG8_STAGE_A(PG8_SA(1, 1), a1, 1);
            if constexpr (GATHER) { if (last) {
#pragma unroll
                for (int h = 0; h < 2; ++h)
#pragma unroll
                    for (int i = 0; i < 2; ++i) gA[h][i] = gN[h][i]; } }
            PG8_WAIT_V(8); PG8_WAIT_L(0); PG8_BAR; PG8_MMA(0, 0, At, B0); PG8_MMA(0, 1, At, B1); PG8_BAR; PG8_SCHED;
            PG8_LDA(At, 0, 1); PG8_STAGE_B(PG8_SB(0, 0), b2); PG8_STAGE_B(PG8_SB(0, 1), b2 + hstepB); PG8_STAGE_A(PG8_SA(0, 0), a2, 0);
            PG8_WAIT_V(8); PG8_WAIT_L(0); PG8_BAR; PG8_MMA(1, 0, At, B0); PG8_MMA(1, 1, At, B1); PG8_BAR; PG8_SCHED;
            PG8_LDB(B0, 1, 0); PG8_LDB(B1, 1, 1); PG8_SCHED; PG8_LDA(At, 1, 0); PG8_STAGE_A(PG8_SA(0, 1), a2, 1);
            PG8_WAIT_V(8); PG8_WAIT_L(0); PG8_BAR; PG8_MMA(0, 0, At, B0); PG8_MMA(0, 1, At, B1); PG8_BAR; PG8_SCHED;
            PG8_LDA(At, 1, 1); PG8_STAGE_B(PG8_SB(1, 0), b3); PG8_STAGE_B(PG8_SB(1, 1), b3 + hstepB); PG8_STAGE_A(PG8_SA(1, 0), a3, 0);
            PG8_WAIT_V(8); PG8_WAIT_L(0); PG8_BAR; PG8_MMA(1, 0, At, B0); PG8_MMA(1, 1, At, B1); PG8_BAR; PG8_SCHED;
        }
        if (wr == 0) PG8_BAR;
        E(acc, cur, wr, wc, fr, fq);
        if (!has_next) break;
#pragma unroll
        for (int a = 0; a < 2; ++a)
#pragma unroll
            for (int b = 0; b < 2; ++b)
#pragma unroll
                for (int m = 0; m < 4; ++m)
#pragma unroll
                    for (int n = 0; n < 2; ++n) acc[a][b][m][n] = (f32x4){0.f, 0.f, 0.f, 0.f};
        cur = nxt; cA = nA; cB = nB; ++ui;
        if (wr == 1) PG8_BAR;
    }
    PG8_WAIT_V(0);
    PG8_BAR;
#undef PG8_SA
#undef PG8_SB
#undef PG8_STAGE_A
#undef PG8_STAGE_B
#undef PG8_LDA
#undef PG8_LDB
#undef PG8_MMA
#undef PG8_CAT
#undef PG8_WAIT_V
#undef PG8_WAIT_L
#undef PG8_BAR
#undef PG8_SCHED
#undef PG8_GLOAD
}
}

constexpr int NB = 4, SEQ = 4096, D = 2048, DEPTH = 2;
constexpr int T = NB * SEQ;
constexpr int NH = 8, HD = 128, DNW = 1024, CH = 64, NCH = SEQ / CH;
constexpr int PW = 1024, PG_DIM = 256;
constexpr int IN_COLS = 5136, NPROJ = 5120;
constexpr int NE = 16, DE = 1024, PLE = 256;
constexpr float ALPHA = 1.4142135623730951f;
constexpr float LN_EPS = 1e-5f, RMS_EPS = 1e-6f;
constexpr int LCAP = T;
constexpr int MAXTILES = 2 * T / 256 + NE;

constexpr size_t MiB = 1u << 20;
constexpr size_t WS_CTL = 0, CTL_ZERO_BYTES = 64 * 1024;
constexpr size_t WS_LIST = 2 * MiB;
constexpr size_t WS_TOKSLOT = 3 * MiB, WS_GATEW = WS_TOKSLOT + 128 * 1024, WS_STATS = WS_GATEW + 128 * 1024, WS_CD = WS_STATS + 128 * 1024, WS_WBA = WS_CD + 128 * 1024;
constexpr size_t WS_WIN = 4 * MiB, WS_WOUT = 44 * MiB, WS_WPG = 60 * MiB, WS_WPP = 76 * MiB, WS_WPOOL = 78 * MiB, WS_WGU = 80 * MiB, WS_WD = 336 * MiB, WS_PB16 = 464 * MiB;
constexpr size_t WS_XB = 480 * MiB, WS_R1 = 544 * MiB, WS_R2 = 704 * MiB, WS_R4 = 848 * MiB, WS_R5 = 944 * MiB, WS_END = 1008 * MiB;
constexpr size_t WS_PROJ = WS_R1, WS_HID = WS_R1;
constexpr size_t WS_Y = WS_R2;
constexpr size_t WS_POOLD = WS_R4, WS_PP = WS_R4 + 32 * MiB, WS_X1B = WS_R2;
constexpr size_t WS_MIXIN = WS_R5, WS_X2B = WS_R5;
constexpr size_t WS_X2F8 = WS_R1 + 96 * MiB;
static_assert((size_t)MAXTILES * 256 * 2048 * 2 <= 144 * MiB && (size_t)MAXTILES * 256 * 1024 * 2 <= 160 * MiB, "MoE row buffers");
constexpr int CW_TMO = 0, CW_CODE = 1, CW_CNT = 64  , CW_BAR = 4096;

constexpr int RING_OFF = 0, RING_BYTES = 131072;
constexpr int LDSCTL_OFF = 152 * 1024, MISC_OFF = LDSCTL_OFF + 320;
constexpr int AUX_OFF = LDSCTL_OFF + 1024;
constexpr int LDS_BYTES = 163840;
constexpr int NWAVES = 8;

#define RLX_AGENT __ATOMIC_RELAXED, __HIP_MEMORY_SCOPE_AGENT
#define LDS_WAIT() asm volatile("s_waitcnt lgkmcnt(0)" ::: "memory")
#define VM_WAIT() asm volatile("s_waitcnt vmcnt(0)" ::: "memory")
__device__ __forceinline__ unsigned f2bf(float f) { unsigned u = __builtin_bit_cast(unsigned, f); return (u + 0x7fffu + ((u >> 16) & 1u)) >> 16; }
__device__ __forceinline__ unsigned pk2(float lo, float hi) { return f2bf(lo) | (f2bf(hi) << 16); }
typedef __bf16 bf2_t __attribute__((ext_vector_type(2)));
__device__ __forceinline__ unsigned pkbf(float lo, float hi) { const f32x2 v = {lo, hi}; return __builtin_bit_cast(unsigned, __builtin_convertvector(v, bf2_t)); }
constexpr float F8_XS = 16.0f, F8_WS = 256.0f, F8_INV = 1.0f / 4096.0f;
__device__ __forceinline__ float f8clamp(float x) { return fminf(fmaxf(x, -448.0f), 448.0f); }
__device__ __forceinline__ unsigned pk4_fp8(float a, float b, float c, float d) { unsigned w = 0u; w = (unsigned)__builtin_amdgcn_cvt_pk_fp8_f32(f8clamp(a), f8clamp(b), (int)w, false); w = (unsigned)__builtin_amdgcn_cvt_pk_fp8_f32(f8clamp(c), f8clamp(d), (int)w, true); return w; }
__device__ __forceinline__ float bf2f(unsigned short b) { return __builtin_bit_cast(float, ((unsigned)b) << 16); }
__device__ __forceinline__ float bflo(unsigned w) { return __builtin_bit_cast(float, w << 16); }
__device__ __forceinline__ float bfhi(unsigned w) { return __builtin_bit_cast(float, w & 0xffff0000u); }
__device__ __forceinline__ float sigmoidf_(float x) { return __builtin_amdgcn_rcpf(1.0f + __expf(-x)); }
__device__ __forceinline__ float wave_sum(float v) {
#pragma unroll
    for (int o = 1; o < 64; o <<= 1) v += __shfl_xor(v, o);
    return v;
}
#define XB_TMO      128
#define XB_XCNT(j)  (256  + 64 * (j))
#define XB_XSUB(j)  (1280 + 64 * (j))
#define XB_XGEN(j)  (2304 + 64 * (j))
#define XB_TOP      3328
#define XB_TOPGEN   3392
#define XCD_BAR_WORDS 3456
#define XB_SPIN_CAP (1u << 18)

__device__ __forceinline__ unsigned xb_ld(unsigned* p)              { return __hip_atomic_load(p, __ATOMIC_RELAXED, __HIP_MEMORY_SCOPE_AGENT); }
__device__ __forceinline__ unsigned xb_add(unsigned* p, unsigned v) { return __hip_atomic_fetch_add(p, v, __ATOMIC_RELAXED, __HIP_MEMORY_SCOPE_AGENT); }
__device__ __forceinline__ unsigned xb_xcc_id() { return (unsigned)__builtin_amdgcn_s_getreg((3 << 11) | 20) & 0xFu; }
#define XB_SPIN(cond, bar) do { unsigned _sp = 0; while (cond) { __builtin_amdgcn_s_sleep(1); \
    if ((++_sp & 255u) == 0u) { if (xb_ld(&(bar)[XB_TMO])) break; if (_sp > XB_SPIN_CAP) { atomicAdd(&(bar)[XB_TMO], 1u); break; } } } } while (0)

struct XcdBarrier {
    unsigned* bar; unsigned x;
    volatile LAS unsigned* st;
};

__device__ __forceinline__ XcdBarrier xcd_barrier_post(unsigned* bar, volatile LAS unsigned* st) {
    XcdBarrier b; b.bar = bar; b.x = xb_xcc_id(); b.st = st;
    if (threadIdx.x == 0) (void)xb_add(&bar[XB_XCNT(b.x)], 1u);
    return b;
}
__device__ __forceinline__ void xcd_barrier_complete(unsigned* bar, unsigned x, unsigned& nloc, unsigned& nx) {
    const unsigned G = gridDim.x * gridDim.y * gridDim.z;
    unsigned sum, cnt, mine, sp = 0u;
    for (;;) {
        sum = 0u; cnt = 0u; mine = 0u;
#pragma unroll
        for (unsigned j = 0; j < 16; ++j) { const unsigned c = xb_ld(&bar[XB_XCNT(j)]); sum += c; cnt += (c > 0u) ? 1u : 0u; mine = (j == x) ? c : mine; }
        if (sum == G) break;
        __builtin_amdgcn_s_sleep(1);
        if ((++sp & 255u) == 0u) { if (xb_ld(&bar[XB_TMO])) break; if (sp > XB_SPIN_CAP) { atomicAdd(&bar[XB_TMO], 1u); break; } }
    }
    nloc = mine > 0u ? mine : 1u; nx = cnt > 0u ? cnt : 1u;
}

__device__ __forceinline__ void xcd_barrier(const XcdBarrier& b) {
    asm volatile("s_waitcnt vmcnt(0)" ::: "memory");
    __syncthreads();
    if (threadIdx.x == 0) {
        unsigned* bar = b.bar;
        __builtin_amdgcn_s_waitcnt(0);
        unsigned nloc = b.st[0], nx = b.st[1];
        if (nloc == 0u) { xcd_barrier_complete(bar, b.x, nloc, nx); b.st[0] = nloc; b.st[1] = nx; }
        const unsigned old = xb_add(&bar[XB_XSUB(b.x)], 1u);
        const unsigned gen = old / nloc;
        if (old + 1u == (gen + 1u) * nloc) {
            __builtin_amdgcn_fence(__ATOMIC_RELEASE, "agent");
            asm volatile("s_waitcnt vmcnt(0)" ::: "memory");
            const unsigned og = xb_add(&bar[XB_TOP], 1u);
            const unsigned tg = og / nx;
            if (og + 1u == (tg + 1u) * nx) xb_add(&bar[XB_TOPGEN], 1u);
            else XB_SPIN(xb_ld(&bar[XB_TOPGEN]) == tg, bar);
            __builtin_amdgcn_fence(__ATOMIC_ACQUIRE, "agent");
            xb_add(&bar[XB_XGEN(b.x)], 1u);
            asm volatile("s_waitcnt vmcnt(0)" ::: "memory");
        } else {
            XB_SPIN(xb_ld(&bar[XB_XGEN(b.x)]) == gen, bar);
            __builtin_amdgcn_fence(__ATOMIC_ACQUIRE, "agent");
            asm volatile("s_waitcnt vmcnt(0)" ::: "memory");
        }
    }
    __syncthreads();
}

struct Args { const float* in[21]; float* out; unsigned char* ws; int ph_lo, ph_hi, li, pad; };
enum { I_X = 0, I_P, I_WIN, I_CONVW, I_ALOG, I_DTB, I_NORMW, I_POOLW, I_POOLS, I_WOUT, I_LN1G, I_LN1B, I_WR, I_BR, I_WEG, I_WEU, I_WED, I_LN2G, I_LN2B, I_WPP, I_WPG };
struct Frame {
    LAS unsigned char* lds;
    volatile LAS unsigned* MISC;
    gu32* ctl;
    int tid, lane, wave, vcu, G;
};

#ifndef FP8_LAST
#define FP8_LAST 1
#endif
#ifndef FP8_PG
#define FP8_PG 0
#endif
#ifndef FP8_PI
#define FP8_PI 0
#endif
#define PHASE_FRAME(F0) Frame F = F0; { int t_ = threadIdx.x; asm volatile("" : "+v"(t_)); F.tid = t_; F.lane = t_ & 63; }
#define OPQ_S(p) asm volatile("" : "+s"(p))
#define OPQ_G(T, expr) ({ GAS T* g_ = (GAS T*)(expr); asm volatile("" : "+s"(g_)); (T*)g_; })
struct SchedDense {
    int nM, nN, nwg, G, c; const char* A; const char* B; size_t astep, bstep;
    __device__ __forceinline__ void init(int M, int N, int G_, int c_, const void* A_, int lda, const void* B_, int ldb) { nM = M / 256; nN = N / 256; nwg = nM * nN; G = G_; c = c_;
        A = (const char*)A_; B = (const char*)B_; astep = (size_t)256 * lda * 2; bstep = (size_t)256 * ldb * 2; }
    __device__ __forceinline__ bool next(int i, pg8::Unit& u) const {
        const long L = (long)i * G + c; if (L >= nwg) return false;
        int wgid = (int)L; { const int q = nwg / 8, r = nwg % 8, xcd = wgid % 8, off = wgid / 8; wgid = (xcd < r ? xcd * (q + 1) : r * (q + 1) + (xcd - r) * q) + off; }
        const int nig = 8 * nN, gid = wgid / nig, fm = gid * 8, gsz = (nM - fm) < 8 ? (nM - fm) : 8;
        u.pm = fm + ((wgid % nig) % gsz); u.pn = (wgid % nig) / gsz;
        u.A = A + (size_t)u.pm * astep; u.B = B + (size_t)u.pn * bstep; u.rows = nullptr; u.nvalid = 256; u.aux = 0; return true;
    }
};
struct SchedPool {
    int G, c; const char* A; const char* B;
    __device__ __forceinline__ bool next(int i, pg8::Unit& u) const {
        const int L = i * G + c; if (L >= 256) return false;
        u.pm = L >> 2; u.pn = L & 3; u.A = A + ((size_t)u.pm * 256 * PW + u.pn * 256) * 2; u.B = B + (size_t)u.pn * 65536 * 2; u.rows = nullptr; u.nvalid = 256; u.aux = 0; return true;
    }
};
struct SchedMoe {
    int G, c, mode; const LAS int* tab; const char* A; const char* B; const int* list; int esz;
    __device__ __forceinline__ bool next(int i, pg8::Unit& u) const {
        const int L = i * G + c, rt = L >> 3, pn = L & 7;
        const int ntiles = __builtin_amdgcn_readfirstlane(tab[16]); if (rt >= ntiles) return false;
        int e = 0;
#pragma unroll
        for (int k = 1; k < 16; ++k) { const int ts = __builtin_amdgcn_readfirstlane(tab[k]); if (rt >= ts) e = k; }
        const int ts = __builtin_amdgcn_readfirstlane(tab[e]), cn = __builtin_amdgcn_readfirstlane(tab[32 + e]);
        const int r0 = (rt - ts) * 256;
        u.pm = rt; u.pn = pn; u.aux = e;
        if (mode == 0) { u.A = A; u.rows = list + (size_t)e * LCAP + r0; u.nvalid = (cn - r0) < 256 ? (cn - r0) : 256; u.B = B + ((size_t)e * 2048 + pn * 256) * 2048 * esz; }
        else { u.A = A + (size_t)rt * 256 * DE * esz; u.rows = nullptr; u.nvalid = 256; u.B = B + ((size_t)e * 2048 + pn * 256) * DE * esz; }
        return true;
    }
};

using pg8::cvt_pk_bf16;
struct EpiBf16 {
    static constexpr bool PERM = true; bf16* O; int ldc; float scale = 1.0f;
    __device__ __forceinline__ void operator()(const f32x4 (&acc)[2][2][4][2], const pg8::Unit& u, int wr, int wc, int fr, int fq) const {
        const int row0 = u.pm * 256 + wr * 64 + fr, col0 = u.pn * 256 + wc * 32 + 8 * fq;
#pragma unroll
        for (int ai = 0; ai < 2; ++ai)
#pragma unroll
            for (int m = 0; m < 4; ++m) { bf16* rowp = O + (size_t)(row0 + ai * 128 + m * 16) * ldc + col0;
#pragma unroll
                for (int bj = 0; bj < 2; ++bj) { const f32x4 v0 = acc[ai][bj][m][0] * scale, v1 = acc[ai][bj][m][1] * scale;
                    v4u w; w.x = cvt_pk_bf16(v0[0], v0[1]); w.y = cvt_pk_bf16(v0[2], v0[3]); w.z = cvt_pk_bf16(v1[0], v1[1]); w.w = cvt_pk_bf16(v1[2], v1[3]);
                    *(v4u*)(rowp + bj * 128) = w; } }
    }
};
struct EpiPool {
    static constexpr bool PERM = true; bf16* O; const float* scale;
    __device__ __forceinline__ void operator()(const f32x4 (&acc)[2][2][4][2], const pg8::Unit& u, int wr, int wc, int fr, int fq) const {
        const int row0 = u.pm * 256 + wr * 64 + fr, cg = u.pn * 256 + wc * 32 + 8 * fq;
        f32x4 sv[2][2];
#pragma unroll
        for (int bj = 0; bj < 2; ++bj) { sv[bj][0] = *(const f32x4*)(scale + cg + bj * 128); sv[bj][1] = *(const f32x4*)(scale + cg + bj * 128 + 4); }
#pragma unroll
        for (int ai = 0; ai < 2; ++ai)
#pragma unroll
            for (int m = 0; m < 4; ++m) { bf16* rowp = O + (size_t)(row0 + ai * 128 + m * 16) * D + DNW + cg;
#pragma unroll
                for (int bj = 0; bj < 2; ++bj) { const f32x4 v0 = acc[ai][bj][m][0] * sv[bj][0], v1 = acc[ai][bj][m][1] * sv[bj][1];
                    v4u w; w.x = cvt_pk_bf16(v0[0], v0[1]); w.y = cvt_pk_bf16(v0[2], v0[3]); w.z = cvt_pk_bf16(v1[0], v1[1]); w.w = cvt_pk_bf16(v1[2], v1[3]);
                    *(v4u*)(rowp + bj * 128) = w; } }
    }
};
struct EpiRes {
    static constexpr bool PERM = true; const bf16* XB; bf16* PRE;
    __device__ __forceinline__ void operator()(const f32x4 (&acc)[2][2][4][2], const pg8::Unit& u, int wr, int wc, int fr, int fq) const {
        const int row0 = u.pm * 256 + wr * 64 + fr, col0 = u.pn * 256 + wc * 32 + 8 * fq;
#pragma unroll
        for (int ai = 0; ai < 2; ++ai)
#pragma unroll
            for (int m = 0; m < 4; ++m) { const size_t off0 = (size_t)(row0 + ai * 128 + m * 16) * D + col0;
#pragma unroll
                for (int bj = 0; bj < 2; ++bj) { const size_t off = off0 + bj * 128; const v4u x = *(const v4u*)(XB + off); const f32x4 a0 = acc[ai][bj][m][0], a1 = acc[ai][bj][m][1];
                    v4u w; w.x = cvt_pk_bf16(bflo(x.x) * ALPHA + a0[0], bfhi(x.x) * ALPHA + a0[1]); w.y = cvt_pk_bf16(bflo(x.y) * ALPHA + a0[2], bfhi(x.y) * ALPHA + a0[3]);
                    w.z = cvt_pk_bf16(bflo(x.z) * ALPHA + a1[0], bfhi(x.z) * ALPHA + a1[1]); w.w = cvt_pk_bf16(bflo(x.w) * ALPHA + a1[2], bfhi(x.w) * ALPHA + a1[3]);
                    *(v4u*)(PRE + off) = w; } }
    }
};
struct EpiSwiglu {
    static constexpr bool PERM = true; bf16* O; int f8 = 0; float ascale = 1.0f;
    __device__ __forceinline__ void operator()(const f32x4 (&acc)[2][2][4][2], const pg8::Unit& u, int wr, int wc, int fr, int fq) const {
        const int row0 = u.pm * 256 + wr * 64 + fr, col0 = u.pn * 128 + wc * 32 + 8 * fq;
#pragma unroll
        for (int ai = 0; ai < 2; ++ai)
#pragma unroll
            for (int m = 0; m < 4; ++m) { bf16* rowp = O + (size_t)(row0 + ai * 128 + m * 16) * DE + col0;
                float h[8];
#pragma unroll
                for (int n = 0; n < 2; ++n)
#pragma unroll
                    for (int j = 0; j < 4; ++j) { const float g = acc[ai][0][m][n][j] * ascale, up = acc[ai][1][m][n][j] * ascale; h[4 * n + j] = g * sigmoidf_(g) * up; }
                if (f8) { v2u w8; w8.x = pk4_fp8(h[0] * F8_XS, h[1] * F8_XS, h[2] * F8_XS, h[3] * F8_XS); w8.y = pk4_fp8(h[4] * F8_XS, h[5] * F8_XS, h[6] * F8_XS, h[7] * F8_XS);
                    *(v2u*)((unsigned char*)O + (size_t)(row0 + ai * 128 + m * 16) * DE + col0) = w8; }
                else { v4u w; w.x = cvt_pk_bf16(h[0], h[1]); w.y = cvt_pk_bf16(h[2], h[3]); w.z = cvt_pk_bf16(h[4], h[5]); w.w = cvt_pk_bf16(h[6], h[7]);
                *(v4u*)rowp = w; } }
    }
};
struct EpiPle {
    static constexpr bool PERM = true; const bf16* X2B; const bf16* PP; bf16* XB; float* OUT; int last; float ascale = 1.0f;
    __device__ __forceinline__ void operator()(const f32x4 (&acc)[2][2][4][2], const pg8::Unit& u, int wr, int wc, int fr, int fq) const {
        const int row0 = u.pm * 256 + wr * 64 + fr, col0 = u.pn * 256 + wc * 32 + 8 * fq;
#pragma unroll
        for (int ai = 0; ai < 2; ++ai)
#pragma unroll
            for (int m = 0; m < 4; ++m) { const size_t off0 = (size_t)(row0 + ai * 128 + m * 16) * D + col0;
#pragma unroll
                for (int bj = 0; bj < 2; ++bj) { const size_t off = off0 + bj * 128;
                    const v4u xx = *(const v4u*)(X2B + off), pp = *(const v4u*)(PP + off);
                    const f32x4 a0 = acc[ai][bj][m][0] * ascale, a1 = acc[ai][bj][m][1] * ascale;
                    f32x4 o0, o1;
                    o0[0] = bflo(xx.x) + sigmoidf_(a0[0]) * bflo(pp.x); o0[1] = bfhi(xx.x) + sigmoidf_(a0[1]) * bfhi(pp.x); o0[2] = bflo(xx.y) + sigmoidf_(a0[2]) * bflo(pp.y); o0[3] = bfhi(xx.y) + sigmoidf_(a0[3]) * bfhi(pp.y);
                    o1[0] = bflo(xx.z) + sigmoidf_(a1[0]) * bflo(pp.z); o1[1] = bfhi(xx.z) + sigmoidf_(a1[1]) * bfhi(pp.z); o1[2] = bflo(xx.w) + sigmoidf_(a1[2]) * bflo(pp.w); o1[3] = bfhi(xx.w) + sigmoidf_(a1[3]) * bfhi(pp.w);
                    if (last) { *(f32x4*)(OUT + off) = o0; *(f32x4*)(OUT + off + 4) = o1; }
                    else { v4u w; w.x = cvt_pk_bf16(o0[0], o0[1]); w.y = cvt_pk_bf16(o0[2], o0[3]); w.z = cvt_pk_bf16(o1[0], o1[1]); w.w = cvt_pk_bf16(o1[2], o1[3]); *(v4u*)(XB + off) = w; } } }
    }
};

__device__ __forceinline__ void tr_item(const float* W, int ldw, int k0, int n0, bf16* WT, size_t drow0, int ldt, LAS float* scr, int lane) {
#pragma unroll 8
    for (int i = 0; i < 32; ++i) { const int kk = 2 * i + (lane >> 5); scr[kk * 33 + (lane & 31)] = W[(size_t)(k0 + kk) * ldw + n0 + (lane & 31)]; }
    LDS_WAIT(); asm volatile("" ::: "memory");
    const int c = lane & 7;
#pragma unroll
    for (int j = 0; j < 4; ++j) { const int n = (lane >> 3) + 8 * j; const LAS float* s = scr + (8 * c) * 33 + n;
        v4u o; o.x = pk2(s[0 * 33], s[1 * 33]); o.y = pk2(s[2 * 33], s[3 * 33]); o.z = pk2(s[4 * 33], s[5 * 33]); o.w = pk2(s[6 * 33], s[7 * 33]);
        *(GAS v4u*)(WT + (drow0 + n) * ldt + k0 + 8 * c) = o; }
    LDS_WAIT(); asm volatile("" ::: "memory");
}
__device__ __forceinline__ void tr_item8(const float* W, int ldw, int k0, int n0, unsigned char* WT, size_t drow0, int ldt, LAS float* scr, int lane) {
#pragma unroll 8
    for (int i = 0; i < 32; ++i) { const int kk = 2 * i + (lane >> 5); scr[kk * 33 + (lane & 31)] = W[(size_t)(k0 + kk) * ldw + n0 + (lane & 31)]; }
    LDS_WAIT(); asm volatile("" ::: "memory");
    const int c = lane & 7;
#pragma unroll
    for (int j = 0; j < 4; ++j) { const int n = (lane >> 3) + 8 * j; const LAS float* s = scr + (8 * c) * 33 + n;
        v2u o; o.x = pk4_fp8(s[0 * 33] * F8_WS, s[1 * 33] * F8_WS, s[2 * 33] * F8_WS, s[3 * 33] * F8_WS); o.y = pk4_fp8(s[4 * 33] * F8_WS, s[5 * 33] * F8_WS, s[6 * 33] * F8_WS, s[7 * 33] * F8_WS);
        *(GAS v2u*)(WT + (drow0 + n) * ldt + k0 + 8 * c) = o; }
    LDS_WAIT(); asm volatile("" ::: "memory");
}
__device__ __forceinline__ void weight_items(const Args& a, unsigned char* ws, LAS float* scr, int lane, int group, int l, int gw, int NGW) {
    constexpr int I_INA = 32 * 128, I_INB = 32 * 32, I_OUT = 32 * 64, I_PG = 32 * 64, I_PP = 4 * 64, I_POOL = 4 * 32, I_EG = NE * 32 * 32, I_EU = I_EG, I_ED = NE * 16 * 64;
    if (group == 0) {
        for (int it = gw; it < I_INA + I_INB + I_PP + I_POOL; it += NGW) { int r = it;
            if (r < I_INA) { const int kb = r / 128, nb = r % 128; tr_item(a.in[I_WIN] + (size_t)l * D * IN_COLS, IN_COLS, 64 * kb, 32 * nb, (bf16*)(ws + WS_WIN) + (size_t)l * NPROJ * D, 32 * nb, D, scr, lane); continue; } r -= I_INA;
            if (r < I_INB) { const int kb = r / 32, nb = r % 32; tr_item(a.in[I_WIN] + (size_t)l * D * IN_COLS, IN_COLS, 64 * kb, 4112 + 32 * nb, (bf16*)(ws + WS_WIN) + (size_t)l * NPROJ * D, 4096 + 32 * nb, D, scr, lane); continue; } r -= I_INB;
            if (r < I_PP) { const int kb = r / 64, nb = r % 64; tr_item(a.in[I_WPP] + (size_t)l * PLE * D, D, 64 * kb, 32 * nb, (bf16*)(ws + WS_WPP) + (size_t)l * D * PLE, 32 * nb, PLE, scr, lane); continue; } r -= I_PP;
            { const int g = r / 32, rr = r % 32, kb = rr / 8, nb = rr % 8; tr_item(a.in[I_POOLW] + ((size_t)l * 4 + g) * 65536, 256, 64 * kb, 32 * nb, (bf16*)(ws + WS_WPOOL) + ((size_t)l * 4 + g) * 65536, 32 * nb, 256, scr, lane); } }
    } else {
        const bool f8 = FP8_LAST && (l == DEPTH - 1);
        for (int it = gw; it < I_OUT + I_PG + I_EG + I_EU + I_ED; it += NGW) { int r = it;
            if (r < I_OUT) { const int kb = r / 64, nb = r % 64; tr_item(a.in[I_WOUT] + (size_t)l * D * D, D, 64 * kb, 32 * nb, (bf16*)(ws + WS_WOUT) + (size_t)l * D * D, 32 * nb, D, scr, lane); continue; } r -= I_OUT;
            if (r < I_PG) { const int kb = r / 64, nb = r % 64; if (f8 && FP8_PI) tr_item8(a.in[I_WPG] + (size_t)l * D * D, D, 64 * kb, 32 * nb, ws + WS_WPG + (size_t)l * D * D * 2, 32 * nb, D, scr, lane); else tr_item(a.in[I_WPG] + (size_t)l * D * D, D, 64 * kb, 32 * nb, (bf16*)(ws + WS_WPG) + (size_t)l * D * D, 32 * nb, D, scr, lane); continue; } r -= I_PG;
            if (r < I_EG) { const int e = r / 1024, rr = r % 1024, kb = rr / 32, nb = rr % 32, h0 = 32 * nb;
                if (f8) tr_item8(a.in[I_WEG] + ((size_t)l * NE + e) * D * DE, DE, 64 * kb, h0, ws + WS_WGU + (size_t)l * NE * 2048 * D * 2 + (size_t)e * 2048 * D, (size_t)(h0 >> 7) * 256 + (h0 & 127), D, scr, lane);
                else tr_item(a.in[I_WEG] + ((size_t)l * NE + e) * D * DE, DE, 64 * kb, h0, (bf16*)(ws + WS_WGU) + ((size_t)l * NE + e) * 2048 * D, (size_t)(h0 >> 7) * 256 + (h0 & 127), D, scr, lane); continue; } r -= I_EG;
            if (r < I_EU) { const int e = r / 1024, rr = r % 1024, kb = rr / 32, nb = rr % 32, h0 = 32 * nb;
                if (f8) tr_item8(a.in[I_WEU] + ((size_t)l * NE + e) * D * DE, DE, 64 * kb, h0, ws + WS_WGU + (size_t)l * NE * 2048 * D * 2 + (size_t)e * 2048 * D, (size_t)(h0 >> 7) * 256 + 128 + (h0 & 127), D, scr, lane);
                else tr_item(a.in[I_WEU] + ((size_t)l * NE + e) * D * DE, DE, 64 * kb, h0, (bf16*)(ws + WS_WGU) + ((size_t)l * NE + e) * 2048 * D, (size_t)(h0 >> 7) * 256 + 128 + (h0 & 127), D, scr, lane); continue; } r -= I_EU;
            { const int e = r / 1024, rr = r % 1024, kb = rr / 64, nb = rr % 64;
                if (f8 && FP8_PG) tr_item8(a.in[I_WED] + ((size_t)l * NE + e) * DE * D, D, 64 * kb, 32 * nb, ws + WS_WD + (size_t)l * NE * D * DE * 2 + (size_t)e * D * DE, 32 * nb, DE, scr, lane);
                else tr_item(a.in[I_WED] + ((size_t)l * NE + e) * DE * D, D, 64 * kb, 32 * nb, (bf16*)(ws + WS_WD) + ((size_t)l * NE + e) * D * DE, 32 * nb, DE, scr, lane); } }
    }
}
__device__ __forceinline__ void p0_prologue(const Frame& F0, const Args& a) {
    PHASE_FRAME(F0);
    LAS float* scr = (LAS float*)(F.lds + RING_OFF + F.wave * 16384);
    const int gw = F.vcu * NWAVES + F.wave, NGW = F.G * NWAVES;
    unsigned char* ws = OPQ_G(unsigned char, a.ws);
#pragma unroll 1
    for (int l = 0; l < DEPTH; ++l) weight_items(a, ws, scr, F.lane, 0, l, gw, NGW);
#ifdef CONVERT_ALL_IN_PROLOGUE
#pragma unroll 1
    for (int l = 0; l < DEPTH; ++l) weight_items(a, ws, scr, F.lane, 1, l, gw, NGW);
#endif
    const size_t gt = (size_t)F.vcu * 512 + F.tid, NGT = (size_t)F.G * 512;
    { const GAS f32x4* src = (const GAS f32x4*)a.in[I_X]; GAS v4u* dst = (GAS v4u*)(ws + WS_XB);
        for (size_t i = gt; i < (size_t)T * D / 8; i += NGT) { const f32x4 v0 = src[2 * i], v1 = src[2 * i + 1]; v4u o; o.x = pk2(v0[0], v0[1]); o.y = pk2(v0[2], v0[3]); o.z = pk2(v1[0], v1[1]); o.w = pk2(v1[2], v1[3]); dst[i] = o; } }
    { const GAS f32x4* src = (const GAS f32x4*)a.in[I_P]; GAS v4u* dst = (GAS v4u*)(ws + WS_PB16);
        for (size_t i = gt; i < (size_t)DEPTH * T * PLE / 8; i += NGT) { const f32x4 v0 = src[2 * i], v1 = src[2 * i + 1]; v4u o; o.x = pk2(v0[0], v0[1]); o.y = pk2(v0[2], v0[3]); o.z = pk2(v1[0], v1[1]); o.w = pk2(v1[2], v1[3]); dst[i] = o; } }
    for (size_t i = gt; i < (size_t)DEPTH * 16 * D; i += NGT) { const int l = (int)(i / (16 * D)), j = (int)((i / D) % 16), k = (int)(i % D);
        ((bf16*)(ws + WS_WBA))[i] = (bf16)f2bf(a.in[I_WIN][((size_t)l * D + k) * IN_COLS + 4096 + j]); }
}

typedef float f32x16 __attribute__((ext_vector_type(16)));
#define MFMA32(a_, b_, c_) __builtin_amdgcn_mfma_f32_32x32x16_bf16((a_), (b_), (c_), 0, 0, 0)
#define PACK8(x, sp) __builtin_bit_cast(bf16x8, (v4u){pkbf((x)[8 * (sp)], (x)[8 * (sp) + 1]), pkbf((x)[8 * (sp) + 2], (x)[8 * (sp) + 3]), pkbf((x)[8 * (sp) + 4], (x)[8 * (sp) + 5]), pkbf((x)[8 * (sp) + 6], (x)[8 * (sp) + 7])})
#define RAW_BAR() do { asm volatile("s_waitcnt lgkmcnt(0)" ::: "memory"); __builtin_amdgcn_s_barrier(); asm volatile("" ::: "memory"); } while (0)
constexpr int IMG_ELEMS = 56 * 512, UIMG_ELEMS = 8 * 1024;
constexpr int FR_WN = 0, FR_QD = 16, FR_AQK = 32, FR_KDT = 40;
constexpr size_t WS_IMG = WS_R2, WS_UIMG = WS_R2 + 112 * MiB;
static_assert((size_t)NB * NCH * NH * IMG_ELEMS * 2 == 112 * MiB && (size_t)NB * NCH * NH * UIMG_ELEMS * 2 == 32 * MiB, "DeltaNet images");

__device__ __forceinline__ void pool_diffs_unit(const Frame& F, unsigned char* ws, int pm, int g) {
    const bf16* PROJ = (const bf16*)(ws + WS_PROJ); bf16* POOLD = (bf16*)(ws + WS_POOLD);
    const int tid = F.tid, cp = tid & 127, rq = tid >> 7, r0 = 256 * pm + 64 * rq, sq0 = r0 % SEQ, col = 256 * g + 2 * cp;
    const bf16* up = PROJ + (size_t)r0 * NPROJ + 4096 + col; bf16* dp = POOLD + (size_t)r0 * PW + col;
#define POOL_BODY(WIN) do { unsigned xr[CH + WIN - 1]; \
        _Pragma("unroll") for (int j = 0; j < WIN - 1; ++j) xr[j] = (sq0 - (WIN - 1) + j >= 0) ? *(const unsigned*)(up + (ptrdiff_t)(j - (WIN - 1)) * NPROJ) : 0u; \
        _Pragma("unroll") for (int i = 0; i < CH; ++i) xr[WIN - 1 + i] = *(const unsigned*)(up + (size_t)i * NPROJ); \
        float s0 = 0.f, s1 = 0.f; \
        _Pragma("unroll") for (int j = 0; j < WIN - 1; ++j) { s0 += bflo(xr[j]); s1 += bfhi(xr[j]); } \
        _Pragma("unroll") for (int i = 0; i < CH; ++i) { const float x0 = bflo(xr[WIN - 1 + i]), x1 = bfhi(xr[WIN - 1 + i]); s0 += x0; s1 += x1; \
            const int pos = sq0 + i; const float inv = __builtin_amdgcn_rcpf((float)((pos + 1) < WIN ? (pos + 1) : WIN)); \
            *(unsigned*)(dp + (size_t)i * PW) = pkbf(s0 * inv - x0, s1 * inv - x1); s0 -= bflo(xr[i]); s1 -= bfhi(xr[i]); } } while (0)
    if (g == 0) POOL_BODY(2); else if (g == 1) POOL_BODY(4); else if (g == 2) POOL_BODY(8); else POOL_BODY(16);
#undef POOL_BODY
}
#ifndef PREP_DUP
#define PREP_DUP 0
#endif
constexpr int PQF = 0, PKF = 33792, PQS = 67584, PKS = 84992, PVT = 102400, PKT = 120832, PTAB = 139264;
constexpr int PAS = PQF;
constexpr int PTB = PKF, PT11T = PKF + 9216, PPART = PKF;
constexpr int F_LD = 132, S_LD = 136, T_LD = 72, A_LD = 68, TT_LD = 40;
__device__ __forceinline__ void phase_dn_prep(const Frame& F0, const Args& a, int layer) {
    PHASE_FRAME(F0);
    unsigned char* ws = OPQ_G(unsigned char, a.ws);
    LAS unsigned char* lds = F.lds;
    LAS float* Qf = (LAS float*)(lds + PQF); LAS float* Kf = (LAS float*)(lds + PKF); LAS float* As = (LAS float*)(lds + PAS);
    LAS bf16* Qs = (LAS bf16*)(lds + PQS); LAS bf16* Ks = (LAS bf16*)(lds + PKS); LAS bf16* Vt = (LAS bf16*)(lds + PVT); LAS bf16* Kt = (LAS bf16*)(lds + PKT);
    LAS bf16* Tb = (LAS bf16*)(lds + PTB); LAS bf16* T11t = (LAS bf16*)(lds + PT11T);
    LAS float* betaS = (LAS float*)(lds + PTAB); LAS float* gS = betaS + 512; LAS float* gamh = gS + 512; LAS float* betah = gamh + 64; LAS float* egam = betah + 64; LAS float* bgam = egam + 64; LAS float* ekd = bgam + 64; LAS float* rkS = ekd + 64;
    const bf16* XB = (const bf16*)(ws + WS_XB); const bf16* PROJ = (const bf16*)(ws + WS_PROJ); const bf16* WBA = (const bf16*)(ws + WS_WBA) + (size_t)layer * 16 * D;
    bf16* IMG = (bf16*)(ws + WS_IMG); bf16* UIMG = (bf16*)(ws + WS_UIMG); float* CD = (float*)(ws + WS_CD);
    const float* convw = a.in[I_CONVW] + (size_t)layer * 4 * 3072; const float* alog = a.in[I_ALOG] + layer * NH; const float* dtb = a.in[I_DTB] + layer * NH;
    const int tid = F.tid, lane = F.lane, wave = F.wave, c32 = lane & 31, hf = lane >> 5;
    for (int unit = F.vcu; unit < NB * NCH; unit += F.G) {
        const int b = unit / NCH, n = unit % NCH, r0 = b * SEQ + n * CH, sq0 = n * CH;
        for (int rep_ = 0; rep_ < ((PREP_DUP & 64) ? 2 : 1); ++rep_)
        { typedef float f32x4v __attribute__((ext_vector_type(4)));
            const int fr = lane & 15, fg = lane >> 4; f32x4v pacc[4];
#pragma unroll
            for (int mt = 0; mt < 4; ++mt) pacc[mt] = (f32x4v){0.f, 0.f, 0.f, 0.f};
#pragma unroll 2
            for (int s = 0; s < 8; ++s) { const int k0 = 256 * wave + 32 * s + 8 * fg;
                const bf16x8 bfr = *(const bf16x8*)(WBA + (size_t)fr * D + k0);
#pragma unroll
                for (int mt = 0; mt < 4; ++mt) { const bf16x8 afr = *(const bf16x8*)(XB + (size_t)(r0 + 16 * mt + fr) * D + k0); pacc[mt] = __builtin_amdgcn_mfma_f32_16x16x32_bf16(afr, bfr, pacc[mt], 0, 0, 0); } }
            LAS float* part = (LAS float*)(lds + PPART) + wave * 1024;
#pragma unroll
            for (int mt = 0; mt < 4; ++mt)
#pragma unroll
                for (int r = 0; r < 4; ++r) part[(16 * mt + 4 * fg + r) * 16 + fr] = pacc[mt][r]; }
        __syncthreads();
        { const int tok = tid >> 3, cp = tid & 7; float s0 = 0.f, s1 = 0.f;
#pragma unroll
            for (int w = 0; w < 8; ++w) { const f32x2 p2 = *(const LAS f32x2*)((LAS float*)(lds + PPART) + w * 1024 + tok * 16 + 2 * cp); s0 += p2[0]; s1 += p2[1]; }
            if (cp < 4) { betaS[tok * 8 + 2 * cp] = sigmoidf_(s0); betaS[tok * 8 + 2 * cp + 1] = sigmoidf_(s1); }
            else { const int h = 2 * (cp - 4); const float z0 = s0 + dtb[h], z1 = s1 + dtb[h + 1];
                const float sp0 = z0 > 20.f ? z0 : log1pf(__expf(z0)), sp1 = z1 > 20.f ? z1 : log1pf(__expf(z1));
                gS[tok * 8 + h] = -__expf(alog[h]) * sp0; gS[tok * 8 + h + 1] = -__expf(alog[h + 1]) * sp1; } }
        __syncthreads();
        if (tid < 8) { float run = 0.f; for (int t = 0; t < CH; ++t) { run += gS[t * 8 + tid]; gS[t * 8 + tid] = run; } }
        __syncthreads();
        unsigned craw[3][11]; unsigned cdum[3][8];
#define PREP_LOADRAW(hh) do { const int cp_ = tid & 63, i0_ = (tid >> 6) * 8; \
            _Pragma("unroll") for (int part_ = 0; part_ < 3; ++part_) { const bf16* src_ = PROJ + (size_t)(r0 + i0_ - 3) * NPROJ + part_ * 1024 + (hh) * HD + 2 * cp_; \
                _Pragma("unroll") for (int j_ = 0; j_ < 11; ++j_) craw[part_][j_] = (sq0 + i0_ - 3 + j_ >= 0) ? *(const unsigned*)(src_ + (ptrdiff_t)j_ * NPROJ) : 0u; \
                if (PREP_DUP & 256) { _Pragma("unroll") for (int j_ = 3; j_ < 11; ++j_) cdum[part_][j_ - 3] = *(const unsigned*)(src_ + (ptrdiff_t)j_ * NPROJ + ((hh) ^ 1) * HD - (hh) * HD); } } } while (0)
        for (int rep2_ = 0; rep2_ < ((PREP_DUP & 128) ? 2 : 1); ++rep2_) {
        PREP_LOADRAW(0);
        for (int h = 0; h < NH; ++h) {
            const size_t chd = (size_t)unit * NH + h; bf16* img = IMG + chd * IMG_ELEMS; bf16* uimg = UIMG + chd * UIMG_ELEMS;
            if (tid < 64) { const float gi = gS[tid * 8 + h], bi = betaS[tid * 8 + h], eg = __expf(gi); gamh[tid] = gi; betah[tid] = bi; egam[tid] = eg; bgam[tid] = bi * eg; ekd[tid] = __expf(gS[63 * 8 + h] - gi); }
            RAW_BAR();
            for (int rep_ = 0; rep_ < ((PREP_DUP & 16) ? 2 : 1); ++rep_)
            { const int cp = tid & 63, rg8 = tid >> 6, i0 = rg8 * 8;
                if (PREP_DUP & 256) {
#pragma unroll
                    for (int p_ = 0; p_ < 3; ++p_)
#pragma unroll
                        for (int j_ = 0; j_ < 8; ++j_) asm volatile("" :: "v"(cdum[p_][j_])); }
#pragma unroll
                for (int part = 0; part < 3; ++part) { const int col = part * 1024 + h * HD + 2 * cp;
                    const f32x2 cw0 = *(const f32x2*)(convw + col), cw1 = *(const f32x2*)(convw + 3072 + col), cw2 = *(const f32x2*)(convw + 2 * 3072 + col), cw3 = *(const f32x2*)(convw + 3 * 3072 + col);
                    float ya[8], yb[8];
#pragma unroll
                    for (int i = 0; i < 8; ++i) { const unsigned x3 = craw[part][i], x2 = craw[part][i + 1], x1 = craw[part][i + 2], x0 = craw[part][i + 3];
                        const float ta = cw0[0] * bflo(x3) + cw1[0] * bflo(x2) + cw2[0] * bflo(x1) + cw3[0] * bflo(x0), tb = cw0[1] * bfhi(x3) + cw1[1] * bfhi(x2) + cw2[1] * bfhi(x1) + cw3[1] * bfhi(x0);
                        ya[i] = ta * sigmoidf_(ta); yb[i] = tb * sigmoidf_(tb); }
                    if (part == 0) {
#pragma unroll
                        for (int i = 0; i < 8; ++i) *(LAS f32x2*)(Qf + (i0 + i) * F_LD + 2 * cp) = (f32x2){ya[i], yb[i]}; }
                    else if (part == 1) {
#pragma unroll
                        for (int i = 0; i < 8; ++i) *(LAS f32x2*)(Kf + (i0 + i) * F_LD + 2 * cp) = (f32x2){ya[i], yb[i]}; }
                    else { v4u o0, o1;
                        o0.x = pkbf(ya[0] * betah[i0 + 0], ya[1] * betah[i0 + 1]); o0.y = pkbf(ya[2] * betah[i0 + 2], ya[3] * betah[i0 + 3]); o0.z = pkbf(ya[4] * betah[i0 + 4], ya[5] * betah[i0 + 5]); o0.w = pkbf(ya[6] * betah[i0 + 6], ya[7] * betah[i0 + 7]);
                        o1.x = pkbf(yb[0] * betah[i0 + 0], yb[1] * betah[i0 + 1]); o1.y = pkbf(yb[2] * betah[i0 + 2], yb[3] * betah[i0 + 3]); o1.z = pkbf(yb[4] * betah[i0 + 4], yb[5] * betah[i0 + 5]); o1.w = pkbf(yb[6] * betah[i0 + 6], yb[7] * betah[i0 + 7]);
                        *(LAS v4u*)(Vt + (2 * cp) * T_LD + i0) = o0; *(LAS v4u*)(Vt + (2 * cp + 1) * T_LD + i0) = o1; } }
            }
            if (h + 1 < NH) PREP_LOADRAW(h + 1);
            for (int rep_ = 0; rep_ < ((PREP_DUP & 1) ? 2 : 1); ++rep_) { if (rep_) RAW_BAR();
            { const int i = tid >> 3, part = tid & 7; const LAS float* qp = Qf + i * F_LD + part * 16; const LAS float* kp = Kf + i * F_LD + part * 16;
                f32x4 qv[4], kv[4]; float sq = 0.f, sk = 0.f;
#pragma unroll
                for (int j = 0; j < 4; ++j) { qv[j] = *(const LAS f32x4*)(qp + 4 * j); kv[j] = *(const LAS f32x4*)(kp + 4 * j);
                    sq += (qv[j][0] * qv[j][0] + qv[j][1] * qv[j][1]) + (qv[j][2] * qv[j][2] + qv[j][3] * qv[j][3]); sk += (kv[j][0] * kv[j][0] + kv[j][1] * kv[j][1]) + (kv[j][2] * kv[j][2] + kv[j][3] * kv[j][3]); }
                sq += __shfl_xor(sq, 1); sq += __shfl_xor(sq, 2); sq += __shfl_xor(sq, 4); sk += __shfl_xor(sk, 1); sk += __shfl_xor(sk, 2); sk += __shfl_xor(sk, 4);
                const float rq = 1.0f / sqrtf(sq + RMS_EPS) * 0.08838834764831845f, rk = 1.0f / sqrtf(sk + RMS_EPS);
                if (part == 0) rkS[i] = rk;
#pragma unroll
                for (int j = 0; j < 4; ++j) { qv[j] = qv[j] * rq; kv[j] = kv[j] * rk; }
                v4u w0, w1;
                w0.x = pkbf(qv[0][0], qv[0][1]); w0.y = pkbf(qv[0][2], qv[0][3]); w0.z = pkbf(qv[1][0], qv[1][1]); w0.w = pkbf(qv[1][2], qv[1][3]); w1.x = pkbf(qv[2][0], qv[2][1]); w1.y = pkbf(qv[2][2], qv[2][3]); w1.z = pkbf(qv[3][0], qv[3][1]); w1.w = pkbf(qv[3][2], qv[3][3]);
                *(LAS v4u*)(Qs + i * S_LD + part * 16) = w0; *(LAS v4u*)(Qs + i * S_LD + part * 16 + 8) = w1;
                w0.x = pkbf(kv[0][0], kv[0][1]); w0.y = pkbf(kv[0][2], kv[0][3]); w0.z = pkbf(kv[1][0], kv[1][1]); w0.w = pkbf(kv[1][2], kv[1][3]); w1.x = pkbf(kv[2][0], kv[2][1]); w1.y = pkbf(kv[2][2], kv[2][3]); w1.z = pkbf(kv[3][0], kv[3][1]); w1.w = pkbf(kv[3][2], kv[3][3]);
                *(LAS v4u*)(Ks + i * S_LD + part * 16) = w0; *(LAS v4u*)(Ks + i * S_LD + part * 16 + 8) = w1;
                const float eg = egam[i]; bf16* fq = img + ((size_t)(FR_QD + (i >> 5) * 8 + part) * 64 + (i & 31)) * 8;
                v4u h0, h1;
                h0.x = pkbf(qv[0][0] * eg, qv[0][1] * eg); h0.y = pkbf(qv[0][2] * eg, qv[0][3] * eg); h0.z = pkbf(qv[2][0] * eg, qv[2][1] * eg); h0.w = pkbf(qv[2][2] * eg, qv[2][3] * eg);
                h1.x = pkbf(qv[1][0] * eg, qv[1][1] * eg); h1.y = pkbf(qv[1][2] * eg, qv[1][3] * eg); h1.z = pkbf(qv[3][0] * eg, qv[3][1] * eg); h1.w = pkbf(qv[3][2] * eg, qv[3][3] * eg);
                *(v4u*)fq = h0; *(v4u*)(fq + 32 * 8) = h1; }
            RAW_BAR();
            { const int c = tid & 127, rg = tid >> 7; float kb[16], kd[16];
#pragma unroll
                for (int i = 0; i < 16; ++i) { const int t = rg * 16 + i; const float kn = Kf[t * F_LD + c] * rkS[t]; kb[i] = kn * bgam[t]; kd[i] = kn * ekd[t]; }
                v4u o0, o1;
                o0.x = pkbf(kb[0], kb[1]); o0.y = pkbf(kb[2], kb[3]); o0.z = pkbf(kb[4], kb[5]); o0.w = pkbf(kb[6], kb[7]); o1.x = pkbf(kb[8], kb[9]); o1.y = pkbf(kb[10], kb[11]); o1.z = pkbf(kb[12], kb[13]); o1.w = pkbf(kb[14], kb[15]);
                *(LAS v4u*)(Kt + c * T_LD + rg * 16) = o0; *(LAS v4u*)(Kt + c * T_LD + rg * 16 + 8) = o1;
                bf16* fk = img + ((size_t)(FR_KDT + (c >> 5) * 4 + rg) * 64 + (c & 31)) * 8;
                v4u h0, h1;
                h0.x = pkbf(kd[0], kd[1]); h0.y = pkbf(kd[2], kd[3]); h0.z = pkbf(kd[8], kd[9]); h0.w = pkbf(kd[10], kd[11]);
                h1.x = pkbf(kd[4], kd[5]); h1.y = pkbf(kd[6], kd[7]); h1.z = pkbf(kd[12], kd[13]); h1.w = pkbf(kd[14], kd[15]);
                *(v4u*)fk = h0; *(v4u*)(fk + 32 * 8) = h1; }
            RAW_BAR();
            }
            for (int rep_ = 0; rep_ < ((PREP_DUP & 2) ? 2 : 1); ++rep_) { if (rep_) RAW_BAR();
            if (wave < 6) { const int pr = wave % 3, iskk = wave / 3, mt = pr == 2 ? 1 : 0, nt = pr == 0 ? 0 : 1;
                const LAS bf16* xs = iskk ? Ks : Qs; f32x16 d;
#pragma unroll
                for (int r = 0; r < 16; ++r) d[r] = 0.f;
#pragma unroll
                for (int s = 0; s < 8; ++s) { const bf16x8 af = *(const LAS bf16x8*)(Ks + (32 * mt + c32) * S_LD + 16 * s + 8 * hf), bfr = *(const LAS bf16x8*)(xs + (32 * nt + c32) * S_LD + 16 * s + 8 * hf); d = MFMA32(af, bfr, d); }
                const int i = 32 * nt + c32; const float gi = gamh[i], bi = betah[i];
#pragma unroll
                for (int r = 0; r < 16; ++r) { const int j = 32 * mt + (r & 3) + 8 * (r >> 2) + 4 * hf; const float de = __expf(gi - gamh[j]);
                    d[r] = iskk ? ((j < i) ? bi * d[r] * de : 0.f) : ((j <= i) ? d[r] * de : 0.f); }
                if (iskk) {
#pragma unroll
                    for (int qd = 0; qd < 4; ++qd) *(LAS f32x4*)(As + i * A_LD + 32 * mt + 8 * qd + 4 * hf) = (f32x4){d[4 * qd], d[4 * qd + 1], d[4 * qd + 2], d[4 * qd + 3]}; }
                else {
#pragma unroll
                    for (int sp = 0; sp < 2; ++sp) *(bf16x8*)(img + ((size_t)(FR_AQK + nt * 4 + 2 * mt + sp) * 64 + lane) * 8) = PACK8(d, sp); } }
            RAW_BAR();
            }
            for (int rep_ = 0; rep_ < ((PREP_DUP & 4) ? 2 : 1); ++rep_) { if (rep_) RAW_BAR();
            if (wave < 2) {
                unsigned asb = (unsigned)(uintptr_t)(As + (32 * wave) * A_LD + 32 * wave); int cb = c32; asm volatile("" : "+v"(asb), "+v"(cb));
                const LAS float* Ab = (const LAS float*)(uintptr_t)asb;
                float arow[32], Tc[32];
#pragma unroll
                for (int i = 0; i < 32; ++i) arow[i] = Ab[i * A_LD + cb];
#pragma unroll
                for (int i = 0; i < 32; ++i) { float ac[4] = {(i == cb) ? 1.f : 0.f, 0.f, 0.f, 0.f}; if (i > 0) asm volatile("" : "+v"(arow[i]), "+v"(Tc[i - 1]));
#pragma unroll
                    for (int j = 0; j < i; ++j) { const float aij = __builtin_bit_cast(float, __builtin_amdgcn_readlane(__builtin_bit_cast(int, arow[i]), j)); ac[j & 3] -= aij * Tc[j]; }
                    Tc[i] = (ac[0] + ac[1]) + (ac[2] + ac[3]); __builtin_amdgcn_sched_barrier(0); }
                if (hf == 0) {
#pragma unroll
                    for (int i = 0; i < 32; ++i) Tb[(32 * wave + i) * T_LD + 32 * wave + c32] = (bf16)(pkbf(Tc[i], 0.f) & 0xffffu);
                    if (wave == 0) {
#pragma unroll
                        for (int q = 0; q < 4; ++q) { v4u o; o.x = pkbf(Tc[8 * q], Tc[8 * q + 1]); o.y = pkbf(Tc[8 * q + 2], Tc[8 * q + 3]); o.z = pkbf(Tc[8 * q + 4], Tc[8 * q + 5]); o.w = pkbf(Tc[8 * q + 6], Tc[8 * q + 7]); *(LAS v4u*)(T11t + c32 * TT_LD + 8 * q) = o; } } } }
            RAW_BAR();
            if (wave == 0) {
                f32x16 x;
#pragma unroll
                for (int r = 0; r < 16; ++r) x[r] = 0.f;
#pragma unroll
                for (int s = 0; s < 2; ++s) { const LAS float* ap = As + (32 + c32) * A_LD + 16 * s + 8 * hf; const f32x4 a0 = *(const LAS f32x4*)ap, a1 = *(const LAS f32x4*)(ap + 4);
                    const bf16x8 af = __builtin_bit_cast(bf16x8, (v4u){pkbf(a0[0], a0[1]), pkbf(a0[2], a0[3]), pkbf(a1[0], a1[1]), pkbf(a1[2], a1[3])});
                    const bf16x8 bfr = *(const LAS bf16x8*)(T11t + c32 * TT_LD + 16 * s + 8 * hf); x = MFMA32(af, bfr, x); }
                f32x16 t21;
#pragma unroll
                for (int r = 0; r < 16; ++r) t21[r] = 0.f;
#pragma unroll
                for (int s = 0; s < 2; ++s) { const LAS bf16* tp = Tb + (32 + c32) * T_LD + 32 + 16 * s + 4 * hf; const v2u lo = *(const LAS v2u*)tp, hi = *(const LAS v2u*)(tp + 8);
                    const bf16x8 af = __builtin_bit_cast(bf16x8, (v4u){lo.x, lo.y, hi.x, hi.y}); const bf16x8 bfr = PACK8(x, s); t21 = MFMA32(af, bfr, t21); }
#pragma unroll
                for (int r = 0; r < 16; ++r) Tb[(32 + (r & 3) + 8 * (r >> 2) + 4 * hf) * T_LD + c32] = (bf16)(pkbf(-t21[r], 0.f) & 0xffffu);
            }
            RAW_BAR();
            }
            for (int rep_ = 0; rep_ < ((PREP_DUP & 8) ? 2 : 1); ++rep_) { if (rep_) RAW_BAR();
            if (wave < 4) {
#pragma unroll
                for (int mt = 0; mt < 2; ++mt) { f32x16 d;
#pragma unroll
                    for (int r = 0; r < 16; ++r) d[r] = 0.f;
#pragma unroll
                    for (int s = 0; s < 4; ++s) if (s < 2 * (mt + 1)) { const bf16x8 af = *(const LAS bf16x8*)(Tb + (32 * mt + c32) * T_LD + 16 * s + 8 * hf), bfr = *(const LAS bf16x8*)(Vt + (32 * wave + c32) * T_LD + 16 * s + 8 * hf); d = MFMA32(af, bfr, d); }
                    bf16* up = uimg + ((size_t)(wave * 2 + mt) * 64 + lane) * 16; *(bf16x8*)up = PACK8(d, 0); *(bf16x8*)(up + 8) = PACK8(d, 1); } }
            else { const int ct = wave - 4;
#pragma unroll
                for (int nt = 0; nt < 2; ++nt) { f32x16 d;
#pragma unroll
                    for (int r = 0; r < 16; ++r) d[r] = 0.f;
#pragma unroll
                    for (int s = 0; s < 4; ++s) if (s < 2 * (nt + 1)) { const bf16x8 af = *(const LAS bf16x8*)(Kt + (32 * ct + c32) * T_LD + 16 * s + 8 * hf), bfr = *(const LAS bf16x8*)(Tb + (32 * nt + c32) * T_LD + 16 * s + 8 * hf); d = MFMA32(af, bfr, d); }
#pragma unroll
                    for (int r = 0; r < 16; ++r) d[r] = -d[r];
#pragma unroll
                    for (int sp = 0; sp < 2; ++sp) *(bf16x8*)(img + ((size_t)(FR_WN + nt * 8 + 2 * ct + sp) * 64 + lane) * 8) = PACK8(d, sp); } }
            }
            if (tid == 0) CD[chd] = egam[63];
            RAW_BAR();
        }
        }
#undef PREP_LOADRAW
    }
}

__host__ __device__ constexpr int sc_p(int k) { const int j = k - 32; return j < 12 ? j % 6 : (j - 12) % 5; }
__host__ __device__ constexpr int sc_slab(int k) { const int j = k - 32; return k < 32 ? (k >> 2) : (j < 12 ? j / 6 : 2 + (j - 12) / 5); }
__host__ __device__ constexpr int sc_kind(int k) { return k < 32 ? ((k & 3) < 2 ? 0 : 1) : ((sc_p(k) == 2 || sc_p(k) == 5) ? 1 : 2); }
__host__ __device__ constexpr int sc_idx(int k) { return k < 32 ? (k & 1) : (sc_p(k) == 0 ? 0 : sc_p(k) == 1 ? 1 : sc_p(k) == 2 ? 1 : sc_p(k) == 3 ? 2 : sc_p(k) == 4 ? 3 : 0); }
__host__ __device__ constexpr int sc_frag(int k) { return k < 32 ? (((k & 3) < 2 ? FR_WN : FR_QD) + (k & 1) * 8 + (k >> 2)) : (sc_kind(k) == 1 ? FR_AQK + sc_idx(k) * 4 + sc_slab(k) : FR_KDT + sc_idx(k) * 4 + sc_slab(k)); }
constexpr int SC_QD = 8;
constexpr int SCB = 57344, OT_OFF = 2 * SCB, OT_LD = 136, OT_BYTES = 64 * OT_LD * 2;
static_assert(OT_OFF + 2 * OT_BYTES <= 152 * 1024, "scan LDS");
__device__ __forceinline__ void phase_dn_scan(const Frame& F0, const Args& a, int layer, int unit) {
    PHASE_FRAME(F0);
    unsigned char* ws = OPQ_G(unsigned char, a.ws);
    LAS unsigned char* lds = F.lds;
    const int b = unit >> 3, h = unit & 7, lane = F.lane;
    const bf16* IMG = (const bf16*)(ws + WS_IMG); const bf16* UIMG = (const bf16*)(ws + WS_UIMG); const float* CD = (const float*)(ws + WS_CD);
    const size_t chd0 = (size_t)b * NCH * NH + h;
    if (F.wave < 4) {
#ifndef SCAN_NO_COMPUTE
        const int w = F.wave, c32 = lane & 31, hf = lane >> 5;
        f32x16 S0, S1, S2, S3;
#pragma unroll
        for (int r = 0; r < 16; ++r) { S0[r] = 0.f; S1[r] = 0.f; S2[r] = 0.f; S3[r] = 0.f; }
        const float cdl = CD[chd0 + (size_t)lane * NH];
        v4u UA[4];
        const __amdgpu_buffer_rsrc_t rsU = __builtin_amdgcn_make_buffer_rsrc((void*)(UIMG + chd0 * UIMG_ELEMS), (short)0, NCH * NH * UIMG_ELEMS * 2, 0x00020000);
        const unsigned uoff = (unsigned)((w * 2) * 64 + lane) * 32u;
#define SC_LOADU(dst, nn) do { _Pragma("unroll") for (int mt_ = 0; mt_ < 2; ++mt_) { _Pragma("unroll") for (int hh_ = 0; hh_ < 2; ++hh_) dst[2 * mt_ + hh_] = __builtin_amdgcn_raw_buffer_load_b128(rsU, uoff + (unsigned)(mt_ * 2048 + hh_ * 16), (unsigned)(nn) * (unsigned)(NH * UIMG_ELEMS * 2), 0); } } while (0)
#define SC_FRAG(bufoff, fi) (*(const LAS bf16x8*)(lds + (bufoff) + (fi) * 1024 + lane * 16))
#define SC_CHUNK(nn, U, bufoff, otoff) do { \
        f32x16 aV0, aV1, aO0, aO1; bf16x8 fq0, fq1, fq2, fq3, fq4, fq5, fq6, fq7, Sbs, Vb0, Vb1, Vb2, Vb3; \
        _Pragma("unroll") for (int q = 0; q < 4; ++q) { aV0[2 * q] = bflo(U[0][q]); aV0[2 * q + 1] = bfhi(U[0][q]); aV0[8 + 2 * q] = bflo(U[1][q]); aV0[8 + 2 * q + 1] = bfhi(U[1][q]); \
            aV1[2 * q] = bflo(U[2][q]); aV1[2 * q + 1] = bfhi(U[2][q]); aV1[8 + 2 * q] = bflo(U[3][q]); aV1[8 + 2 * q + 1] = bfhi(U[3][q]); } \
        _Pragma("unroll") for (int r = 0; r < 16; ++r) { aO0[r] = 0.f; aO1[r] = 0.f; } \
        if ((nn) + 1 < NCH) SC_LOADU(U, (nn) + 1); \
        const float cd = __builtin_bit_cast(float, __builtin_amdgcn_readlane(__builtin_bit_cast(int, cdl), (nn))); \
        fq0 = SC_FRAG(bufoff, 0); \
        fq1 = SC_FRAG(bufoff, 8); \
        fq2 = SC_FRAG(bufoff, 16); \
        fq3 = SC_FRAG(bufoff, 24); \
        fq4 = SC_FRAG(bufoff, 1); \
        fq5 = SC_FRAG(bufoff, 9); \
        fq6 = SC_FRAG(bufoff, 17); \
        fq7 = SC_FRAG(bufoff, 25); \
        Sbs = PACK8(S0, 0); \
        aV0 = MFMA32(fq0, Sbs, aV0); \
        fq0 = SC_FRAG(bufoff, 2); \
        aV1 = MFMA32(fq1, Sbs, aV1); \
        fq1 = SC_FRAG(bufoff, 10); \
        aO0 = MFMA32(fq2, Sbs, aO0); \
        fq2 = SC_FRAG(bufoff, 18); \
        aO1 = MFMA32(fq3, Sbs, aO1); \
        fq3 = SC_FRAG(bufoff, 26); \
        Sbs = PACK8(S0, 1); \
        aV0 = MFMA32(fq4, Sbs, aV0); \
        fq4 = SC_FRAG(bufoff, 3); \
        aV1 = MFMA32(fq5, Sbs, aV1); \
        fq5 = SC_FRAG(bufoff, 11); \
        aO0 = MFMA32(fq6, Sbs, aO0); \
        fq6 = SC_FRAG(bufoff, 19); \
        aO1 = MFMA32(fq7, Sbs, aO1); \
        fq7 = SC_FRAG(bufoff, 27); \
        Sbs = PACK8(S1, 0); \
        aV0 = MFMA32(fq0, Sbs, aV0); \
        fq0 = SC_FRAG(bufoff, 4); \
        aV1 = MFMA32(fq1, Sbs, aV1); \
        fq1 = SC_FRAG(bufoff, 12); \
        aO0 = MFMA32(fq2, Sbs, aO0); \
        fq2 = SC_FRAG(bufoff, 20); \
        aO1 = MFMA32(fq3, Sbs, aO1); \
        fq3 = SC_FRAG(bufoff, 28); \
        Sbs = PACK8(S1, 1); \
        aV0 = MFMA32(fq4, Sbs, aV0); \
        fq4 = SC_FRAG(bufoff, 5); \
        aV1 = MFMA32(fq5, Sbs, aV1); \
        fq5 = SC_FRAG(bufoff, 13); \
        aO0 = MFMA32(fq6, Sbs, aO0); \
        fq6 = SC_FRAG(bufoff, 21); \
        aO1 = MFMA32(fq7, Sbs, aO1); \
        fq7 = SC_FRAG(bufoff, 29); \
        Sbs = PACK8(S2, 0); \
        aV0 = MFMA32(fq0, Sbs, aV0); \
        fq0 = SC_FRAG(bufoff, 6); \
        aV1 = MFMA32(fq1, Sbs, aV1); \
        fq1 = SC_FRAG(bufoff, 14); \
        aO0 = MFMA32(fq2, Sbs, aO0); \
        fq2 = SC_FRAG(bufoff, 22); \
        aO1 = MFMA32(fq3, Sbs, aO1); \
        fq3 = SC_FRAG(bufoff, 30); \
        Sbs = PACK8(S2, 1); \
        aV0 = MFMA32(fq4, Sbs, aV0); \
        fq4 = SC_FRAG(bufoff, 7); \
        aV1 = MFMA32(fq5, Sbs, aV1); \
        fq5 = SC_FRAG(bufoff, 15); \
        aO0 = MFMA32(fq6, Sbs, aO0); \
        fq6 = SC_FRAG(bufoff, 23); \
        aO1 = MFMA32(fq7, Sbs, aO1); \
        fq7 = SC_FRAG(bufoff, 31); \
        Sbs = PACK8(S3, 0); \
        aV0 = MFMA32(fq0, Sbs, aV0); \
        fq0 = SC_FRAG(bufoff, 40); \
        aV1 = MFMA32(fq1, Sbs, aV1); \
        fq1 = SC_FRAG(bufoff, 44); \
        aO0 = MFMA32(fq2, Sbs, aO0); \
        fq2 = SC_FRAG(bufoff, 36); \
        aO1 = MFMA32(fq3, Sbs, aO1); \
        fq3 = SC_FRAG(bufoff, 48); \
        Sbs = PACK8(S3, 1); \
        aV0 = MFMA32(fq4, Sbs, aV0); \
        fq4 = SC_FRAG(bufoff, 52); \
        aV1 = MFMA32(fq5, Sbs, aV1); \
        fq5 = SC_FRAG(bufoff, 32); \
        S0 = S0 * cd; S1 = S1 * cd; S2 = S2 * cd; S3 = S3 * cd; \
        aO0 = MFMA32(fq6, Sbs, aO0); \
        fq6 = SC_FRAG(bufoff, 41); \
        aO1 = MFMA32(fq7, Sbs, aO1); \
        fq7 = SC_FRAG(bufoff, 45); \
        Vb0 = PACK8(aV0, 0); Vb1 = PACK8(aV0, 1); Vb2 = PACK8(aV1, 0); Vb3 = PACK8(aV1, 1); \
        S0 = MFMA32(fq0, Vb0, S0); \
        fq0 = SC_FRAG(bufoff, 37); \
        S1 = MFMA32(fq1, Vb0, S1); \
        fq1 = SC_FRAG(bufoff, 49); \
        aO1 = MFMA32(fq2, Vb0, aO1); \
        fq2 = SC_FRAG(bufoff, 53); \
        S2 = MFMA32(fq3, Vb0, S2); \
        fq3 = SC_FRAG(bufoff, 33); \
        S3 = MFMA32(fq4, Vb0, S3); \
        fq4 = SC_FRAG(bufoff, 42); \
        aO0 = MFMA32(fq5, Vb0, aO0); \
        fq5 = SC_FRAG(bufoff, 46); \
        S0 = MFMA32(fq6, Vb1, S0); \
        fq6 = SC_FRAG(bufoff, 38); \
        S1 = MFMA32(fq7, Vb1, S1); \
        fq7 = SC_FRAG(bufoff, 50); \
        aO1 = MFMA32(fq0, Vb1, aO1); \
        fq0 = SC_FRAG(bufoff, 54); \
        S2 = MFMA32(fq1, Vb1, S2); \
        fq1 = SC_FRAG(bufoff, 43); \
        S3 = MFMA32(fq2, Vb1, S3); \
        fq2 = SC_FRAG(bufoff, 47); \
        aO0 = MFMA32(fq3, Vb1, aO0); \
        fq3 = SC_FRAG(bufoff, 39); \
        S0 = MFMA32(fq4, Vb2, S0); \
        fq4 = SC_FRAG(bufoff, 51); \
        S1 = MFMA32(fq5, Vb2, S1); \
        fq5 = SC_FRAG(bufoff, 55); \
        aO1 = MFMA32(fq6, Vb2, aO1); \
        S2 = MFMA32(fq7, Vb2, S2); \
        S3 = MFMA32(fq0, Vb2, S3); \
        S0 = MFMA32(fq1, Vb3, S0); \
        S1 = MFMA32(fq2, Vb3, S1); \
        aO1 = MFMA32(fq3, Vb3, aO1); \
        S2 = MFMA32(fq4, Vb3, S2); \
        S3 = MFMA32(fq5, Vb3, S3); \
        _Pragma("unroll") for (int r = 0; r < 16; ++r) { \
            *(LAS bf16*)(lds + (otoff) + (((r & 3) + 8 * (r >> 2) + 4 * hf) * OT_LD + 32 * w + c32) * 2) = (bf16)(pkbf(aO0[r], 0.f) & 0xffffu); \
            *(LAS bf16*)(lds + (otoff) + ((32 + (r & 3) + 8 * (r >> 2) + 4 * hf) * OT_LD + 32 * w + c32) * 2) = (bf16)(pkbf(aO1[r], 0.f) & 0xffffu); } \
        RAW_BAR(); } while (0)
        SC_LOADU(UA, 0);
        RAW_BAR();
#pragma unroll 1
        for (int n = 0; n < NCH; n += 2) { SC_CHUNK(n, UA, 0, OT_OFF); SC_CHUNK(n + 1, UA, SCB, OT_OFF + OT_BYTES); }
#undef SC_CHUNK
#undef SC_FRAG
#undef SC_LOADU
#endif
    } else {
#ifndef SCAN_NO_HELPER
        const int ht = F.tid - 256, tok = ht >> 2, q = ht & 3;
        bf16* MIXIN = (bf16*)(ws + WS_MIXIN);
        v4u RA[14], RB[14];
        const __amdgpu_buffer_rsrc_t rsI = __builtin_amdgcn_make_buffer_rsrc((void*)(IMG + chd0 * IMG_ELEMS), (short)0, NCH * NH * IMG_ELEMS * 2, 0x00020000);
#define SH_LOADIMG(dst, nn) do { _Pragma("unroll") for (int i_ = 0; i_ < 14; ++i_) dst[i_] = __builtin_amdgcn_raw_buffer_load_b128(rsI, (unsigned)ht * 16u, (unsigned)(nn) * (unsigned)(NH * IMG_ELEMS * 2) + (unsigned)i_ * 4096u, 0); } while (0)
#define SH_STOREIMG(src, bufoff) do { LAS v4u* p_ = (LAS v4u*)(lds + (bufoff)) + ht; _Pragma("unroll") for (int i_ = 0; i_ < 14; ++i_) p_[i_ * 256] = src[i_]; } while (0)
#define SH_EPI(mm, otoff) do { const LAS v4u* op_ = (const LAS v4u*)(lds + (otoff) + (tok * OT_LD + 32 * q) * 2); \
        v4u* yp_ = (v4u*)(MIXIN + ((size_t)b * SEQ + (size_t)(mm) * CH + tok) * D + h * HD + 32 * q); \
        _Pragma("unroll") for (int i_ = 0; i_ < 4; ++i_) yp_[i_] = op_[i_]; } while (0)
#define SH_STEP(nn, Rcur, Rnext, bufnext, otprev) do { \
        if ((nn) + 2 < NCH) SH_LOADIMG(Rcur, (nn) + 2); \
        if ((nn) >= 1) SH_EPI((nn) - 1, otprev); \
        if ((nn) + 1 < NCH) SH_STOREIMG(Rnext, bufnext); \
        RAW_BAR(); } while (0)
        SH_LOADIMG(RA, 0); SH_LOADIMG(RB, 1);
        SH_STOREIMG(RA, 0);
        RAW_BAR();
#pragma unroll 1
        for (int n = 0; n < NCH; n += 2) { SH_STEP(n, RA, RB, SCB, OT_OFF + OT_BYTES); SH_STEP(n + 1, RB, RA, 0, OT_OFF); }
        SH_EPI(NCH - 1, OT_OFF + OT_BYTES);
#undef SH_STEP
#undef SH_EPI
#undef SH_STOREIMG
#undef SH_LOADIMG
#endif
    }
}

__device__ __forceinline__ void phase_dn_norm(const Frame& F0, const Args& a, int layer) {
    PHASE_FRAME(F0);
    unsigned char* ws = OPQ_G(unsigned char, a.ws);
    const bf16* PROJ = (const bf16*)(ws + WS_PROJ); bf16* MIXIN = (bf16*)(ws + WS_MIXIN);
    const int lane = F.lane, gw = F.vcu * NWAVES + F.wave, NGW = F.G * NWAVES;
    const float* nw = a.in[I_NORMW] + layer * HD + 16 * (lane & 7); f32x4 nwv[4];
#pragma unroll
    for (int i = 0; i < 4; ++i) nwv[i] = *(const f32x4*)(nw + 4 * i);
    v4u OA[2], ZA[2], OB[2], ZB[2];
#define DNN_LOAD(O_, Z_, t) do { const v4u* op_ = (const v4u*)(MIXIN + (size_t)(t) * D + 16 * lane); const v4u* zp_ = (const v4u*)(PROJ + (size_t)(t) * NPROJ + 3072 + 16 * lane); O_[0] = op_[0]; O_[1] = op_[1]; Z_[0] = zp_[0]; Z_[1] = zp_[1]; } while (0)
#define DNN_ROW(O_, Z_, t) do { float ss = 0.f; \
        _Pragma("unroll") for (int i = 0; i < 2; ++i) _Pragma("unroll") for (int j = 0; j < 4; ++j) { const float x0 = bflo(O_[i][j]), x1 = bfhi(O_[i][j]); ss += x0 * x0 + x1 * x1; } \
        ss += __shfl_xor(ss, 1); ss += __shfl_xor(ss, 2); ss += __shfl_xor(ss, 4); const float rr = 1.0f / sqrtf(ss * (1.0f / HD) + RMS_EPS); \
        v4u* yp_ = (v4u*)(MIXIN + (size_t)(t) * D + 16 * lane); \
        _Pragma("unroll") for (int i = 0; i < 2; ++i) { v4u o_; _Pragma("unroll") for (int j = 0; j < 4; ++j) { const float z0 = bflo(Z_[i][j]), z1 = bfhi(Z_[i][j]); const f32x4 nn = nwv[2 * i + (j >> 1)]; \
            o_[j] = pkbf(bflo(O_[i][j]) * rr * nn[2 * (j & 1)] * z0 * sigmoidf_(z0), bfhi(O_[i][j]) * rr * nn[2 * (j & 1) + 1] * z1 * sigmoidf_(z1)); } yp_[i] = o_; } } while (0)
    if (gw < T) DNN_LOAD(OA, ZA, gw);
#pragma unroll 1
    for (int t = gw; t < T; t += 2 * NGW) {
        if (t + NGW < T) DNN_LOAD(OB, ZB, t + NGW);
        DNN_ROW(OA, ZA, t);
        if (t + 2 * NGW < T) DNN_LOAD(OA, ZA, t + 2 * NGW);
        if (t + NGW < T) DNN_ROW(OB, ZB, t + NGW);
    }
#undef DNN_LOAD
#undef DNN_ROW
}

__device__ __forceinline__ void phase_ln1_router(const Frame& F0, const Args& a, int layer, int probe = 0, int f8 = 0) {
    PHASE_FRAME(F0);
    unsigned char* ws = OPQ_G(unsigned char, a.ws);
    LAS float* WRt = (LAS float*)F.lds;
    LAS float* GV = (LAS float*)(F.lds + RING_BYTES);
    LAS int* rowE = (LAS int*)(F.lds + AUX_OFF); LAS int* rowP = rowE + 128; LAS float* rowG = (LAS float*)(rowP + 128); LAS int* lcnt = (LAS int*)(rowG + 128); LAS int* lbase = lcnt + 16;
    const float* wr = OPQ_G(const float, a.in[I_WR]); const float* br = OPQ_G(const float, a.in[I_BR]);
    for (int idx = F.tid; idx < D * NE; idx += 512) WRt[(idx & 15) * D + (idx >> 4)] = wr[idx];
    { const float* g1 = a.in[I_LN1G] + (size_t)layer * D; const float* b1 = a.in[I_LN1B] + (size_t)layer * D; for (int i = F.tid; i < D; i += 512) { GV[i] = g1[i]; GV[D + i] = b1[i]; } }
    const bf16* PRE = (const bf16*)a.out; bf16* X1B = (bf16*)(ws + (probe ? WS_R1 : WS_X1B)); float* STATS = (float*)(ws + (probe ? WS_R1 + 70 * MiB : WS_STATS));
    int* LIST = (int*)(ws + (probe ? WS_R1 + 72 * MiB : WS_LIST)); int* TOKSLOT = (int*)(ws + (probe ? WS_R1 + 80 * MiB : WS_TOKSLOT)); float* GATEW = (float*)(ws + (probe ? WS_R1 + 82 * MiB : WS_GATEW));
    gu32* cnt = F.ctl + CW_CNT + 64 * (layer + (probe ? 2 : 0));
    const int lane = F.lane; const float brl = br[(lane >> 2) & 15];
    for (int rb = F.vcu; rb < T / 64; rb += F.G) {
        if (F.tid < 16) lcnt[F.tid] = 0;
        __syncthreads();
        v2u XA[8], XB_[8];
#define PE_LOAD(X, r) do { const GAS v2u* xr_ = (const GAS v2u*)(PRE + (size_t)(rb * 64 + F.wave * 8 + (r)) * D) + lane; _Pragma("unroll") for (int j = 0; j < 8; ++j) X[j] = xr_[64 * j]; } while (0)
#define PE_ROW(X, r) do { const int lr = F.wave * 8 + (r), row = rb * 64 + lr; unsigned gvo_ = (unsigned)(uintptr_t)GV; asm volatile("" : "+v"(gvo_)); const LAS float* GVr = (const LAS float*)(uintptr_t)gvo_; \
            f32x4 v[8]; float s = 0.f; \
            _Pragma("unroll") for (int j = 0; j < 8; ++j) { v[j] = (f32x4){bflo(X[j].x), bfhi(X[j].x), bflo(X[j].y), bfhi(X[j].y)}; s += (v[j][0] + v[j][1]) + (v[j][2] + v[j][3]); } \
            const float mean = wave_sum(s) * (1.f / D); float s2 = 0.f; \
            _Pragma("unroll") for (int j = 0; j < 8; ++j) { v[j] = v[j] - mean; s2 += (v[j][0] * v[j][0] + v[j][1] * v[j][1]) + (v[j][2] * v[j][2] + v[j][3] * v[j][3]); } \
            const float rstd = 1.f / sqrtf(wave_sum(s2) * (1.f / D) + LN_EPS); \
            if (lane == 0) { STATS[2 * row] = mean; STATS[2 * row + 1] = rstd; } \
            GAS v2u* o8 = (GAS v2u*)(X1B + (size_t)row * D) + lane; \
            float lg[16]; \
            _Pragma("unroll") for (int e = 0; e < 16; ++e) lg[e] = 0.f; \
            _Pragma("unroll") for (int j = 0; j < 8; ++j) { const f32x4 gg = *(const LAS f32x4*)(GVr + 256 * j + 4 * lane), bb = *(const LAS f32x4*)(GVr + D + 256 * j + 4 * lane); \
                v[j] = v[j] * rstd * gg + bb; \
                if (f8) ((GAS unsigned*)((GAS unsigned char*)X1B + (size_t)row * D) + lane)[64 * j] = pk4_fp8(v[j][0] * F8_XS, v[j][1] * F8_XS, v[j][2] * F8_XS, v[j][3] * F8_XS); \
                else { v2u w; w.x = pkbf(v[j][0], v[j][1]); w.y = pkbf(v[j][2], v[j][3]); o8[64 * j] = w; } \
                _Pragma("unroll") for (int e = 0; e < 16; ++e) { const f32x4 w4 = *(const LAS f32x4*)(WRt + e * D + 256 * j + 4 * lane); lg[e] += (v[j][0] * w4[0] + v[j][1] * w4[1]) + (v[j][2] * w4[2] + v[j][3] * w4[3]); } } \
              \
            float t8[8], t4[4], t2[2], t1; \
            { const bool hi = (lane & 32) != 0; _Pragma("unroll") for (int i = 0; i < 8; ++i) { const float snd = hi ? lg[i] : lg[8 + i], kp = hi ? lg[8 + i] : lg[i]; t8[i] = kp + __shfl_xor(snd, 32); } } \
            { const bool hi = (lane & 16) != 0; _Pragma("unroll") for (int i = 0; i < 4; ++i) { const float snd = hi ? t8[i] : t8[4 + i], kp = hi ? t8[4 + i] : t8[i]; t4[i] = kp + __shfl_xor(snd, 16); } } \
            { const bool hi = (lane & 8) != 0; _Pragma("unroll") for (int i = 0; i < 2; ++i) { const float snd = hi ? t4[i] : t4[2 + i], kp = hi ? t4[2 + i] : t4[i]; t2[i] = kp + __shfl_xor(snd, 8); } } \
            { const bool hi = (lane & 4) != 0; const float snd = hi ? t2[0] : t2[1], kp = hi ? t2[1] : t2[0]; t1 = kp + __shfl_xor(snd, 4); } \
            t1 += __shfl_xor(t1, 2); t1 += __shfl_xor(t1, 1); t1 += brl; \
            float lgu[16]; float mx = -3.0e38f; \
            _Pragma("unroll") for (int e = 0; e < 16; ++e) { lgu[e] = __builtin_bit_cast(float, __builtin_amdgcn_readlane(__builtin_bit_cast(int, t1), 4 * e)); mx = fmaxf(mx, lgu[e]); } \
            float p[16]; \
            _Pragma("unroll") for (int e = 0; e < 16; ++e) p[e] = __expf(lgu[e] - mx); \
            float gsc[4]; \
            _Pragma("unroll") for (int g = 0; g < 4; ++g) { const float a0 = p[4 * g], a1 = p[4 * g + 1], a2 = p[4 * g + 2], a3 = p[4 * g + 3]; \
                const float hi1 = fmaxf(a0, a1), lo1 = fminf(a0, a1), hi2 = fmaxf(a2, a3), lo2 = fminf(a2, a3); \
                gsc[g] = fmaxf(hi1, hi2) + fmaxf(fminf(hi1, hi2), fmaxf(lo1, lo2)); } \
            int gsel = 0; float best = gsc[0]; \
            _Pragma("unroll") for (int g = 1; g < 4; ++g) if (gsc[g] > best) { best = gsc[g]; gsel = g; } \
            float q[4]; \
            _Pragma("unroll") for (int j = 0; j < 4; ++j) q[j] = gsel == 0 ? p[j] : (gsel == 1 ? p[4 + j] : (gsel == 2 ? p[8 + j] : p[12 + j])); \
            int i0 = 0; float p0 = q[0]; \
            _Pragma("unroll") for (int j = 1; j < 4; ++j) if (q[j] > p0) { p0 = q[j]; i0 = j; } \
            int i1 = -1; float p1 = -1.f; \
            _Pragma("unroll") for (int j = 0; j < 4; ++j) if (j != i0 && q[j] > p1) { p1 = q[j]; i1 = j; } \
            if (lane == 0) { const int e0 = gsel * 4 + i0, e1 = gsel * 4 + i1; const float inv = 1.0f / (p0 + p1); \
                rowE[2 * lr] = e0; rowE[2 * lr + 1] = e1; rowG[2 * lr] = p0 * inv; rowG[2 * lr + 1] = p1 * inv; \
                rowP[2 * lr] = __hip_atomic_fetch_add(&lcnt[e0], 1, __ATOMIC_RELAXED, __HIP_MEMORY_SCOPE_WORKGROUP); rowP[2 * lr + 1] = __hip_atomic_fetch_add(&lcnt[e1], 1, __ATOMIC_RELAXED, __HIP_MEMORY_SCOPE_WORKGROUP); } } while (0)
        PE_LOAD(XA, 0);
#pragma unroll 1
        for (int r = 0; r < 8; r += 2) { PE_LOAD(XB_, r + 1); PE_ROW(XA, r); if (r + 2 < 8) PE_LOAD(XA, r + 2); PE_ROW(XB_, r + 1); }
#undef PE_LOAD
#undef PE_ROW
        __syncthreads();
        if (F.tid < 16) lbase[F.tid] = (int)__hip_atomic_fetch_add(cnt + F.tid, (unsigned)lcnt[F.tid], RLX_AGENT);
        __syncthreads();
        if (F.tid < 128) { const int e = rowE[F.tid], pos = lbase[e] + rowP[F.tid], tok = rb * 64 + (F.tid >> 1);
            LIST[(size_t)e * LCAP + pos] = tok; TOKSLOT[2 * tok + (F.tid & 1)] = e * LCAP + pos; GATEW[2 * tok + (F.tid & 1)] = rowG[F.tid]; }
        __syncthreads();
    }
}
__device__ __forceinline__ void moe_table(const Frame& F0, int layer) {
    PHASE_FRAME(F0);
    LAS int* tab = (LAS int*)(F.lds + AUX_OFF);
    __syncthreads();
    if (F.tid < 16) tab[32 + F.tid] = (int)__hip_atomic_load(F.ctl + CW_CNT + 64 * layer + F.tid, RLX_AGENT);
    __syncthreads();
    if (F.tid == 0) { int run = 0; for (int e = 0; e < 16; ++e) { tab[e] = run; run += (tab[32 + e] + 255) >> 8; } tab[16] = run; }
    __syncthreads();
}
__device__ __forceinline__ void phase_combine_ln2(const Frame& F0, const Args& a, int layer, int probe = 0, int f8 = 0) {
    PHASE_FRAME(F0);
    unsigned char* ws = OPQ_G(unsigned char, a.ws); const LAS int* tab = (const LAS int*)(F.lds + AUX_OFF);
    const bf16* PRE = (const bf16*)a.out; const float* STATS = (const float*)(ws + WS_STATS); const bf16* Y = (const bf16*)(ws + WS_Y); bf16* X2B = (bf16*)(ws + (probe ? WS_R1 : WS_X2B)); unsigned char* X2F8 = ws + WS_X2F8;
    const int* TOKSLOT = (const int*)(ws + WS_TOKSLOT); const float* GATEW = (const float*)(ws + WS_GATEW);
    LAS float* GV = (LAS float*)F.lds;
    { const float* g1 = a.in[I_LN1G] + (size_t)layer * D; const float* b1 = a.in[I_LN1B] + (size_t)layer * D; const float* g2 = a.in[I_LN2G] + (size_t)layer * D; const float* b2 = a.in[I_LN2B] + (size_t)layer * D;
        for (int i = F.tid; i < D; i += 512) { GV[i] = g1[i]; GV[D + i] = b1[i]; GV[2 * D + i] = g2[i]; GV[3 * D + i] = b2[i]; } }
    __syncthreads();
    const int gw = F.vcu * NWAVES + F.wave, NGW = F.G * NWAVES, nrows = (T - gw + NGW - 1) / NGW, lane = F.lane;
    for (int base = 0; base < nrows; base += 64) {
        const int nr = (nrows - base) < 64 ? (nrows - base) : 64;
        float m_mean = 0.f, m_rstd = 0.f, m_w0 = 0.f, m_w1 = 0.f; int m_y0 = 0, m_y1 = 0;
        if (lane < nr) { const int row = gw + NGW * (base + lane); m_mean = STATS[2 * row]; m_rstd = STATS[2 * row + 1]; m_w0 = GATEW[2 * row]; m_w1 = GATEW[2 * row + 1];
            const int s0 = TOKSLOT[2 * row], s1 = TOKSLOT[2 * row + 1]; m_y0 = tab[s0 / LCAP] * 256 + (s0 % LCAP); m_y1 = tab[s1 / LCAP] * 256 + (s1 % LCAP); }
        v2u XA[8], PA[8], QA[8], XB_[8], PB_[8], QB_[8];
#define PH_LOAD(X, P, Q, i) do { const int row_ = gw + NGW * (base + (i)); const size_t y0_ = (size_t)__builtin_amdgcn_readlane(m_y0, (i)), y1_ = (size_t)__builtin_amdgcn_readlane(m_y1, (i)); \
            const GAS v2u* xr_ = (const GAS v2u*)(PRE + (size_t)row_ * D) + lane; const GAS v2u* ya_ = (const GAS v2u*)(Y + y0_ * D) + lane; const GAS v2u* yb_ = (const GAS v2u*)(Y + y1_ * D) + lane; \
            _Pragma("unroll") for (int j = 0; j < 8; ++j) { X[j] = xr_[64 * j]; P[j] = ya_[64 * j]; Q[j] = yb_[64 * j]; } } while (0)
#define PH_ROW(X, P, Q, i) do { const int row_ = gw + NGW * (base + (i)); unsigned gvo_ = (unsigned)(uintptr_t)GV; asm volatile("" : "+v"(gvo_)); const LAS float* GVr = (const LAS float*)(uintptr_t)gvo_;     \
            const float mean = __builtin_bit_cast(float, __builtin_amdgcn_readlane(__builtin_bit_cast(int, m_mean), (i))), rstd = __builtin_bit_cast(float, __builtin_amdgcn_readlane(__builtin_bit_cast(int, m_rstd), (i))); \
            const float w0 = __builtin_bit_cast(float, __builtin_amdgcn_readlane(__builtin_bit_cast(int, m_w0), (i))), w1 = __builtin_bit_cast(float, __builtin_amdgcn_readlane(__builtin_bit_cast(int, m_w1), (i))); \
            f32x4 v[8]; float s = 0.f; \
            _Pragma("unroll") for (int j = 0; j < 8; ++j) { const f32x4 gg = *(const LAS f32x4*)(GVr + 256 * j + 4 * lane), bb = *(const LAS f32x4*)(GVr + D + 256 * j + 4 * lane); \
                const f32x4 x1 = ((f32x4){bflo(X[j].x), bfhi(X[j].x), bflo(X[j].y), bfhi(X[j].y)} - mean) * rstd * gg + bb; \
                f32x4 f; f[0] = w0 * bflo(P[j].x) + w1 * bflo(Q[j].x); f[1] = w0 * bfhi(P[j].x) + w1 * bfhi(Q[j].x); f[2] = w0 * bflo(P[j].y) + w1 * bflo(Q[j].y); f[3] = w0 * bfhi(P[j].y) + w1 * bfhi(Q[j].y); \
                v[j] = x1 * ALPHA + f; s += (v[j][0] + v[j][1]) + (v[j][2] + v[j][3]); } \
            const float m2 = wave_sum(s) * (1.f / D); float q = 0.f; \
            _Pragma("unroll") for (int j = 0; j < 8; ++j) { v[j] = v[j] - m2; q += (v[j][0] * v[j][0] + v[j][1] * v[j][1]) + (v[j][2] * v[j][2] + v[j][3] * v[j][3]); } \
            const float r2 = 1.f / sqrtf(wave_sum(q) * (1.f / D) + LN_EPS); \
            GAS v2u* o8 = (GAS v2u*)(X2B + (size_t)row_ * D) + lane; \
            _Pragma("unroll") for (int j = 0; j < 8; ++j) { const f32x4 gg = *(const LAS f32x4*)(GVr + 2 * D + 256 * j + 4 * lane), bb = *(const LAS f32x4*)(GVr + 3 * D + 256 * j + 4 * lane); \
                const f32x4 o = v[j] * r2 * gg + bb; v2u w; w.x = pkbf(o[0], o[1]); w.y = pkbf(o[2], o[3]); o8[64 * j] = w; \
                if (f8) ((GAS unsigned*)((GAS unsigned char*)X2F8 + (size_t)row_ * D) + lane)[64 * j] = pk4_fp8(o[0] * F8_XS, o[1] * F8_XS, o[2] * F8_XS, o[3] * F8_XS); } } while (0)
        PH_LOAD(XA, PA, QA, 0);
#pragma unroll 1
        for (int i = 0; i < nr; i += 2) {
            if (i + 1 < nr) PH_LOAD(XB_, PB_, QB_, i + 1);
            PH_ROW(XA, PA, QA, i);
            if (i + 2 < nr) PH_LOAD(XA, PA, QA, i + 2);
            if (i + 1 < nr) PH_ROW(XB_, PB_, QB_, i + 1);
        }
#undef PH_LOAD
#undef PH_ROW
    }
}

#ifndef MK_N_LAUNCHES
#define MK_N_LAUNCHES 1
#endif
constexpr int NPL = 10;
constexpr int NPHASE = 1 + NPL * DEPTH;
constexpr int N_LAUNCHES = MK_N_LAUNCHES;
static_assert(N_LAUNCHES == 1 || N_LAUNCHES == NPHASE, "MK_N_LAUNCHES is 1 or NPHASE");

#define GRID_BAR() do { if (N_LAUNCHES == 1) xcd_barrier(bar); } while (0)
#ifndef PH_MASK
#define PH_MASK 0x7ff
#endif
#define IN(k) ((((k) == 0 ? 1u : (2u << (((k) - 1) % NPL))) & (unsigned)(PH_MASK)) && lo <= (k) && (k) < hi)
#define SEAM(k) do { if (IN((k) + 1)) GRID_BAR(); } while (0)
#ifndef PROBE_DUP
#define PROBE_DUP 0
#endif
#define REPS(k) ((((k) == 0 ? 1u : (2u << (((k) - 1) % NPL))) & (unsigned)(PROBE_DUP)) ? 2 : 1)

template <int layer> __device__ __forceinline__ void layer_phases(const Frame& F, const Args& args, const XcdBarrier& bar, const int lo, const int hi) {
            const int pb = 1 + NPL * layer;
            unsigned char* ws = OPQ_G(unsigned char, args.ws);
            if (IN(pb + 0)) { for (int rep = 0; rep < REPS(pb + 0); ++rep) { if (rep) GRID_BAR();
                SchedDense S; S.init(T, NPROJ, F.G, (int)blockIdx.x, ws + WS_XB, D, (const bf16*)(ws + WS_WIN) + (size_t)layer * NPROJ * D, D);
                EpiBf16 E{(bf16*)(ws + WS_PROJ), NPROJ};
                pg8::gemm_phase<EpiBf16, SchedDense, false>(F.lds + RING_OFF, D, D, D, S, E);
                } SEAM(pb + 0);
            }
            if (IN(pb + 1)) { for (int rep = 0; rep < REPS(pb + 1); ++rep) { if (rep) GRID_BAR(); phase_dn_prep(F, args, layer); } SEAM(pb + 1); }
            if (IN(pb + 2)) { for (int rep = 0; rep < REPS(pb + 2); ++rep) { if (rep) GRID_BAR();
                if (blockIdx.x < 32 || F.G <= 32) { for (int u = blockIdx.x; u < NB * NH; u += (F.G < 32 ? F.G : 32)) { phase_dn_scan(F, args, layer, u);
#ifdef SCAN_TWICE
                    __syncthreads(); phase_dn_scan(F, args, layer, u);
#endif
                } }
                if (blockIdx.x >= 32 || F.G <= 32) { const int G2 = F.G <= 32 ? F.G : F.G - 32, c2 = F.G <= 32 ? (int)blockIdx.x : (int)blockIdx.x - 32;
                    { int t_ = threadIdx.x; asm volatile("" : "+v"(t_)); Frame Fp = F; Fp.tid = t_; Fp.lane = t_ & 63;
                      for (int L = c2; L < 256; L += G2) pool_diffs_unit(Fp, ws, L >> 2, L & 3);
                      asm volatile("s_waitcnt vmcnt(0)" ::: "memory"); __syncthreads(); }
                    { SchedPool S{G2, c2, (const char*)(ws + WS_POOLD), (const char*)((const bf16*)(ws + WS_WPOOL) + (size_t)layer * 4 * 65536)};
                      EpiPool E{(bf16*)(ws + WS_MIXIN), args.in[I_POOLS] + (size_t)layer * PW};
                      pg8::gemm_phase<EpiPool, SchedPool, false>(F.lds + RING_OFF, 256, PW, 256, S, E); }
                    { SchedDense S; S.init(T, D, G2, c2, (const bf16*)(ws + WS_PB16) + (size_t)layer * T * PLE, PLE, (const bf16*)(ws + WS_WPP) + (size_t)layer * D * PLE, PLE);
                      EpiBf16 E{(bf16*)(ws + WS_PP), D};
                      pg8::gemm_phase<EpiBf16, SchedDense, false>(F.lds + RING_OFF, PLE, PLE, PLE, S, E); }
#ifndef CONVERT_ALL_IN_PROLOGUE
                    { int t_ = threadIdx.x; asm volatile("" : "+v"(t_)); weight_items(args, ws, (LAS float*)(F.lds + RING_OFF + F.wave * 16384), t_ & 63, 1, layer, c2 * NWAVES + F.wave, G2 * NWAVES); }
#endif
                    }
                } SEAM(pb + 2);
            }
            if (IN(pb + 3)) { for (int rep = 0; rep < REPS(pb + 3); ++rep) { if (rep) GRID_BAR(); phase_dn_norm(F, args, layer); } SEAM(pb + 3); }
            if (IN(pb + 4)) { for (int rep = 0; rep < REPS(pb + 4); ++rep) { if (rep) GRID_BAR();
                SchedDense S; S.init(T, D, F.G, (int)blockIdx.x, ws + WS_MIXIN, D, (const bf16*)(ws + WS_WOUT) + (size_t)layer * D * D, D);
                EpiRes E{(const bf16*)(ws + WS_XB), (bf16*)args.out};
#ifdef PROBE_PD
                { EpiRes E2{(const bf16*)(ws + WS_XB), (bf16*)(ws + WS_R1)}; pg8::gemm_phase<EpiRes, SchedDense, false>(F.lds + RING_OFF, D, D, D, S, E2); }
#endif
                pg8::gemm_phase<EpiRes, SchedDense, false>(F.lds + RING_OFF, D, D, D, S, E);
                } SEAM(pb + 4);
            }
            if (IN(pb + 5)) { for (int rep = 0; rep < REPS(pb + 5); ++rep) { if (rep) GRID_BAR();
#ifdef PROBE_PE
                phase_ln1_router(F, args, layer, 1); __syncthreads();
#endif
                phase_ln1_router(F, args, layer, 0, (FP8_LAST && layer == DEPTH - 1) ? 1 : 0); } SEAM(pb + 5); }
            if (IN(pb + 6)) { for (int rep = 0; rep < REPS(pb + 6); ++rep) { if (rep) GRID_BAR();
                moe_table(F, layer);
                if (FP8_LAST && layer == DEPTH - 1) {
                    SchedMoe S{F.G, (int)blockIdx.x, 0, (const LAS int*)(F.lds + AUX_OFF), (const char*)(ws + WS_X1B), (const char*)(ws + WS_WGU + (size_t)layer * NE * 2048 * D * 2), (const int*)(ws + WS_LIST), 1};
                    EpiSwiglu E{(bf16*)(ws + WS_HID), FP8_PG, F8_INV};
                    pg8::gemm_phase<EpiSwiglu, SchedMoe, true, true>(F.lds + RING_OFF, D / 2, D / 2, D / 2, S, E);
                } else {
                    SchedMoe S{F.G, (int)blockIdx.x, 0, (const LAS int*)(F.lds + AUX_OFF), (const char*)(ws + WS_X1B), (const char*)((const bf16*)(ws + WS_WGU) + (size_t)layer * NE * 2048 * D), (const int*)(ws + WS_LIST), 2};
                    EpiSwiglu E{(bf16*)(ws + WS_HID)};
                    pg8::gemm_phase<EpiSwiglu, SchedMoe, true>(F.lds + RING_OFF, D, D, D, S, E);
                }
                } SEAM(pb + 6);
            }
            if (IN(pb + 7)) { for (int rep = 0; rep < REPS(pb + 7); ++rep) { if (rep) GRID_BAR();
                moe_table(F, layer);
                if (FP8_LAST && FP8_PG && layer == DEPTH - 1) {
                    SchedMoe S{F.G, (int)blockIdx.x, 1, (const LAS int*)(F.lds + AUX_OFF), (const char*)(ws + WS_HID), (const char*)(ws + WS_WD + (size_t)layer * NE * D * DE * 2), nullptr, 1};
                    EpiBf16 E{(bf16*)(ws + WS_Y), D, F8_INV};
                    pg8::gemm_phase<EpiBf16, SchedMoe, false, true>(F.lds + RING_OFF, DE / 2, DE / 2, DE / 2, S, E);
                } else {
                    SchedMoe S{F.G, (int)blockIdx.x, 1, (const LAS int*)(F.lds + AUX_OFF), (const char*)(ws + WS_HID), (const char*)((const bf16*)(ws + WS_WD) + (size_t)layer * NE * D * DE), nullptr, 2};
                    EpiBf16 E{(bf16*)(ws + WS_Y), D};
                    pg8::gemm_phase<EpiBf16, SchedMoe, false>(F.lds + RING_OFF, DE, DE, DE, S, E);
                }
                } SEAM(pb + 7);
            }
            if (IN(pb + 8)) { for (int rep = 0; rep < REPS(pb + 8); ++rep) { if (rep) GRID_BAR(); moe_table(F, layer);
#ifdef PROBE_PH
                phase_combine_ln2(F, args, layer, 1);
#endif
                phase_combine_ln2(F, args, layer, 0, (FP8_LAST && FP8_PI && layer == DEPTH - 1) ? 1 : 0); } SEAM(pb + 8); }
            if (IN(pb + 9)) { for (int rep = 0; rep < REPS(pb + 9); ++rep) { if (rep) GRID_BAR();
                if (FP8_LAST && FP8_PI && layer == DEPTH - 1) {
                    SchedDense S; S.init(T, D, F.G, (int)blockIdx.x, ws + WS_X2F8, D / 2, ws + WS_WPG + (size_t)layer * D * D * 2, D / 2);
                    EpiPle E{(const bf16*)(ws + WS_X2B), (const bf16*)(ws + WS_PP), (bf16*)(ws + WS_XB), args.out, 1, F8_INV};
                    pg8::gemm_phase<EpiPle, SchedDense, false, true>(F.lds + RING_OFF, D / 2, D / 2, D / 2, S, E);
                } else {
                    SchedDense S; S.init(T, D, F.G, (int)blockIdx.x, ws + WS_X2B, D, (const bf16*)(ws + WS_WPG) + (size_t)layer * D * D, D);
                    EpiPle E{(const bf16*)(ws + WS_X2B), (const bf16*)(ws + WS_PP), (bf16*)(ws + WS_XB), args.out, layer + 1 < DEPTH ? 0 : 1};
                    pg8::gemm_phase<EpiPle, SchedDense, false>(F.lds + RING_OFF, D, D, D, S, E);
                }
                } SEAM(pb + 9);
            }
}
__global__ void __launch_bounds__(NWAVES * 64, 2) trunk_fwd(Args args) {
    extern __shared__ __attribute__((aligned(16))) unsigned char lds[];
    Frame F;
    F.lds = (LAS unsigned char*)lds;
    F.MISC = (volatile LAS unsigned*)(F.lds + MISC_OFF);
    F.tid = threadIdx.x; F.lane = F.tid & 63; F.wave = __builtin_amdgcn_readfirstlane(F.tid >> 6);
    F.G = gridDim.x; { const int bx = blockIdx.x; F.vcu = (F.G % 8 == 0) ? (bx % 8) * (F.G / 8) + bx / 8 : bx; }
    unsigned char* ws = args.ws;
    F.ctl = (gu32*)(ws + WS_CTL);
    for (int u = F.tid; u < (LDS_BYTES - LDSCTL_OFF) / 4; u += NWAVES * 64) ((LAS unsigned*)(F.lds + LDSCTL_OFF))[u] = 0u;
    __syncthreads();
    XcdBarrier bar; bar.bar = (unsigned*)(F.ctl + CW_BAR); bar.x = 0; bar.st = nullptr;
    if (N_LAUNCHES == 1) bar = xcd_barrier_post((unsigned*)(F.ctl + CW_BAR), F.MISC + 8);
    const int lo = args.ph_lo, hi = args.ph_hi;
    if (IN(0)) { for (int rep = 0; rep < REPS(0); ++rep) { if (rep) GRID_BAR(); p0_prologue(F, args); } SEAM(0); }

    layer_phases<0>(F, args, bar, lo, hi);
    layer_phases<1>(F, args, bar, lo, hi);
    static_assert(DEPTH == 2, "layer_phases instantiations");
#undef IN
#undef SEAM
#undef GRID_BAR
}

extern "C" void kernel_launch(void* const* d_in, const int* in_sizes, int n_in, void* d_out, int out_size, void* d_ws, size_t ws_size, hipStream_t stream) {
    static int grid = 0;
    if (grid == 0) {
        if (n_in != 21 || in_sizes[0] != T * D || out_size != T * D || ws_size < WS_END) { fprintf(stderr, "kernel_launch: unexpected shapes (n_in %d, in0 %d, out %d, ws %zu); nothing launched\n", n_in, n_in > 0 ? in_sizes[0] : -1, out_size, ws_size); grid = -1; return; }
        int dev = 0, cus = 0, per_cu = 0;
        if (hipGetDevice(&dev) != hipSuccess || hipDeviceGetAttribute(&cus, hipDeviceAttributeMultiprocessorCount, dev) != hipSuccess) { grid = -1; return; }
        if (hipFuncSetAttribute((const void*)trunk_fwd, hipFuncAttributeMaxDynamicSharedMemorySize, LDS_BYTES) != hipSuccess) { fprintf(stderr, "kernel_launch: hipFuncSetAttribute failed\n"); grid = -1; return; }
        if (hipOccupancyMaxActiveBlocksPerMultiprocessor(&per_cu, (const void*)trunk_fwd, NWAVES * 64, LDS_BYTES) != hipSuccess || per_cu < 1) { fprintf(stderr, "kernel_launch: occupancy query reports %d workgroups per CU\n", per_cu); }
        (void)hipGetLastError();
        grid = cus;
    }
    if (grid < 0) return;
    if (hipMemsetAsync((char*)d_ws + WS_CTL, 0, CTL_ZERO_BYTES, stream) != hipSuccess) return;
    Args a{};
    for (int i = 0; i < 21; ++i) a.in[i] = (const float*)d_in[i];
    a.out = (float*)d_out; a.ws = (unsigned char*)d_ws;
    for (int li = 0; li < N_LAUNCHES; ++li) {
        a.ph_lo = (N_LAUNCHES == 1) ? 0 : li; a.ph_hi = (N_LAUNCHES == 1) ? NPHASE : li + 1; a.li = li; a.pad = 0;
        hipLaunchKernelGGL(trunk_fwd, dim3(grid), dim3(NWAVES * 64), LDS_BYTES, stream, a);
        const hipError_t le = hipPeekAtLastError();
        if (le != hipSuccess) { fprintf(stderr, "kernel_launch: launch %d failed: %s\n", li, hipGetErrorName(le)); break; }
    }
}
```

```cpp
#define MK_N_LAUNCHES 1
#define CONVERT_ALL_IN_PROLOGUE 1
#define FP8_ALL 1
#include <hip/hip_runtime.h>
#include <cstdio>
#include <cstdint>

#define GAS __attribute__((address_space(1)))
#define LAS __attribute__((address_space(3)))
typedef unsigned short bf16;
typedef unsigned v4u __attribute__((ext_vector_type(4)));
typedef unsigned v2u __attribute__((ext_vector_type(2)));
typedef float f32x4 __attribute__((ext_vector_type(4)));
typedef float f32x2 __attribute__((ext_vector_type(2)));
typedef short bf16x8 __attribute__((ext_vector_type(8)));
typedef GAS unsigned gu32;
typedef int v4i_t __attribute__((ext_vector_type(4)));
typedef int v8i_t __attribute__((ext_vector_type(8)));

namespace pg8 {
constexpr int BM = 256, BK = 64, HALF = 128, HTB = HALF * BK * 2  , STAGE_BYTES = 8 * HTB, NXCD = 8, WGM = 8;
__host__ __device__ __forceinline__ int lds_byte(int r, int c) { const int st = (r >> 4) * 2 + (c >> 5), rr = r & 15, cc = c & 31, ob = rr * 64 + cc * 2; return st * 1024 + (ob ^ (((ob >> 9) & 1) << 5)); }
__host__ __device__ __forceinline__ void stage_rc(int b, int& R, int& C) { const int st = b / 1024, sb = b % 1024, swz = sb ^ (((sb >> 9) & 1) << 5); R = (st >> 1) * 16 + swz / 64; C = (st & 1) * 32 + (swz % 64) / 2; }
__host__ __device__ __forceinline__ int perm32(int rho) { const int n = rho >> 4, i = rho & 15; return 8 * (i >> 2) + 4 * n + (i & 3); }

struct Unit { int pm, pn; const char* A; const char* B; const int* rows; int nvalid; int aux; };

__device__ __forceinline__ unsigned cvt_pk_bf16(float lo, float hi) { unsigned r; asm volatile("v_cvt_pk_bf16_f32 %0, %1, %2" : "=v"(r) : "v"(lo), "v"(hi)); return r; }

template <class Epi, class Sched, bool GATHER, bool FP8 = false>
__device__ __forceinline__ void gemm_phase(LAS unsigned char* lds, const int K, const int lda, const int ldb, const Sched& S, const Epi& E) {
    int tid_ = threadIdx.x; asm volatile("" : "+v"(tid_));
    const int tid = tid_, wid = __builtin_amdgcn_readfirstlane(tid >> 6), lane = tid & 63, wr = wid >> 2, wc = wid & 3, fr = lane & 15, fq = lane >> 4;
    const int nt = K / BK;
    unsigned voffA[2], voffB[2]; int RA[2], CA[2];
#pragma unroll
    for (int i = 0; i < 2; ++i) { int R, C; stage_rc(tid * 16 + i * 8192, R, C); const int Rb = Epi::PERM ? ((R & ~31) + perm32(R & 31)) : R;
        RA[i] = R; CA[i] = C; voffA[i] = (unsigned)(R * lda + C) * 2u; voffB[i] = (unsigned)(Rb * ldb + C) * 2u; }
    unsigned gA[2][2], gN[2][2];
    const size_t kstep = (size_t)(BK * 2);
    const size_t hstepA = GATHER ? 0 : (size_t)HALF * lda * 2, hstepB = (size_t)HALF * ldb * 2;
    const unsigned ldsw = (unsigned)wid * 1024u;
    const int aoff = lds_byte(wr * 64 + fr, fq * 8), boff = lds_byte(wc * 32 + fr, fq * 8);
#define PG8_SA(b, h) (((b) * 2 + (h)) * HTB)
#define PG8_SB(b, h) ((4 + (b) * 2 + (h)) * HTB)
#define PG8_STAGE_B(bufoff, gbase) do { _Pragma("unroll") for (int _i = 0; _i < 2; ++_i) \
        __builtin_amdgcn_global_load_lds((const unsigned*)((const char*)(gbase) + voffB[_i]), (LAS unsigned*)(lds + (bufoff) + ldsw + _i * 8192), 16, 0, 0); } while (0)
#define PG8_STAGE_A(bufoff, gbase, h) do { _Pragma("unroll") for (int _i = 0; _i < 2; ++_i) \
        __builtin_amdgcn_global_load_lds((const unsigned*)((const char*)(gbase) + (GATHER ? gA[h][_i] : voffA[_i]) + (h) * hstepA), (LAS unsigned*)(lds + (bufoff) + ldsw + _i * 8192), 16, 0, 0); } while (0)
#define PG8_CAT(x0, x1) __builtin_shufflevector(__builtin_bit_cast(v4i_t, (x0)), __builtin_bit_cast(v4i_t, (x1)), 0, 1, 2, 3, 4, 5, 6, 7)
#define PG8_LDA(dst, b, h) do { _Pragma("unroll") for (int m = 0; m < 4; ++m) { if constexpr (FP8) dst##8[m] = PG8_CAT(*(const LAS bf16x8*)(lds + PG8_SA(b, h) + aoff + m * 2048), *(const LAS bf16x8*)(lds + PG8_SA(b, h) + aoff + m * 2048 + 1024)); \
        else { _Pragma("unroll") for (int k = 0; k < 2; ++k) dst[m][k] = *(const LAS bf16x8*)(lds + PG8_SA(b, h) + aoff + m * 2048 + k * 1024); } } } while (0)
#define PG8_LDB(dst, b, h) do { _Pragma("unroll") for (int n = 0; n < 2; ++n) { if constexpr (FP8) dst##8[n] = PG8_CAT(*(const LAS bf16x8*)(lds + PG8_SB(b, h) + boff + n * 2048), *(const LAS bf16x8*)(lds + PG8_SB(b, h) + boff + n * 2048 + 1024)); \
        else { _Pragma("unroll") for (int k = 0; k < 2; ++k) dst[n][k] = *(const LAS bf16x8*)(lds + PG8_SB(b, h) + boff + n * 2048 + k * 1024); } } } while (0)
#define PG8_MMA(ai, bj, At, Bt) do { __builtin_amdgcn_s_setprio(1); \
        if constexpr (FP8) { _Pragma("unroll") for (int m = 0; m < 4; ++m) _Pragma("unroll") for (int n = 0; n < 2; ++n) \
            acc[ai][bj][m][n] = __builtin_amdgcn_mfma_scale_f32_16x16x128_f8f6f4(Bt##8[n], At##8[m], acc[ai][bj][m][n], 0, 0, 0, 0x7f7f7f7f, 0, 0x7f7f7f7f); } \
        else { _Pragma("unroll") for (int m = 0; m < 4; ++m) _Pragma("unroll") for (int n = 0; n < 2; ++n) _Pragma("unroll") for (int k = 0; k < 2; ++k) \
            acc[ai][bj][m][n] = __builtin_amdgcn_mfma_f32_16x16x32_bf16(Bt[n][k], At[m][k], acc[ai][bj][m][n], 0, 0, 0); } \
        __builtin_amdgcn_s_setprio(0); } while (0)
#define PG8_WAIT_V(n) asm volatile("s_waitcnt vmcnt(" #n ")" ::: "memory")
#define PG8_WAIT_L(n) asm volatile("s_waitcnt lgkmcnt(" #n ")" ::: "memory")
#define PG8_BAR __builtin_amdgcn_s_barrier()
#define PG8_SCHED __builtin_amdgcn_sched_barrier(0)
#define PG8_GLOAD(dst, u) do { _Pragma("unroll") for (int _h = 0; _h < 2; ++_h) _Pragma("unroll") for (int _i = 0; _i < 2; ++_i) { const int _r = _h * HALF + RA[_i]; \
        const int _t = (_r < (u).nvalid) ? (u).rows[_r] : 0; dst[_h][_i] = (unsigned)(_t * lda + CA[_i]) * 2u; } } while (0)
    Unit cur, nxt; int ui = 0;
    if (!S.next(0, cur)) return;
    f32x4 acc[2][2][4][2];
#pragma unroll
    for (int a = 0; a < 2; ++a)
#pragma unroll
        for (int b = 0; b < 2; ++b)
#pragma unroll
            for (int m = 0; m < 4; ++m)
#pragma unroll
                for (int n = 0; n < 2; ++n) acc[a][b][m][n] = (f32x4){0.f, 0.f, 0.f, 0.f};
    bf16x8 At[4][2], B0[2][2], B1[2][2]; v8i_t At8[4], B08[2], B18[2];
    const char* cA = cur.A; const char* cB = cur.B;
    if constexpr (GATHER) { PG8_GLOAD(gA, cur); PG8_WAIT_V(0); }
    PG8_STAGE_B(PG8_SB(0, 0), cB); PG8_STAGE_B(PG8_SB(0, 1), cB + hstepB); PG8_STAGE_A(PG8_SA(0, 0), cA, 0); PG8_STAGE_A(PG8_SA(0, 1), cA, 1);
    if (wr == 1) PG8_BAR;
    PG8_WAIT_V(2); PG8_BAR;
    PG8_STAGE_B(PG8_SB(1, 0), cB + kstep); PG8_STAGE_A(PG8_SA(1, 0), cA + kstep, 0); PG8_STAGE_B(PG8_SB(1, 1), cB + hstepB + kstep);
    PG8_WAIT_V(6); PG8_BAR;
    for (;;) {
        const bool has_next = S.next(ui + 1, nxt);
        const char* nA = has_next ? nxt.A : cA; const char* nB = has_next ? nxt.B : cB;
        if constexpr (GATHER) { if (has_next) { PG8_GLOAD(gN, nxt); } else {
#pragma unroll
            for (int h = 0; h < 2; ++h)
#pragma unroll
                for (int i = 0; i < 2; ++i) gN[h][i] = gA[h][i]; } }
#pragma unroll 1
        for (int t = 0; t < nt; t += 2) {
            const bool last = (t == nt - 2);
            const char* a1 = cA + (size_t)(t + 1) * kstep;
            const char* a2 = last ? nA : cA + (size_t)(t + 2) * kstep; const char* b2 = last ? nB : cB + (size_t)(t + 2) * kstep;
            const char* a3 = a2 + kstep; const char* b3 = b2 + kstep;
            PG8_LDB(B0, 0, 0); PG8_LDB(B1, 0, 1); PG8_SCHED; PG8_LDA(At, 0, 0); PG8_STAGE_A(PG8_SA(1, 1), a1, 1);
            if constexpr (GATHER) { if (last) {
#pragma unroll
                for (int h = 0; h < 2; ++h)
#pragma unroll
                    for (int i = 0; i < 2; ++i) gA[h][i] = gN[h][i]; } }
            PG8_WAIT_V(8); PG8_WAIT_L(0); PG8_BAR; PG8_MMA(0, 0, At, B0); PG8_MMA(0, 1, At, B1); PG8_BAR; PG8_SCHED;
            PG8_LDA(At, 0, 1); PG8_STAGE_B(PG8_SB(0, 0), b2); PG8_STAGE_B(PG8_SB(0, 1), b2 + hstepB); PG8_STAGE_A(PG8_SA(0, 0), a2, 0);
            PG8_WAIT_V(8); PG8_WAIT_L(0); PG8_BAR; PG8_MMA(1, 0, At, B0); PG8_MMA(1, 1, At, B1); PG8_BAR; PG8_SCHED;
            PG8_LDB(B0, 1, 0); PG8_LDB(B1, 1, 1); PG8_SCHED; PG8_LDA(At, 1, 0); PG8_STAGE_A(PG8_SA(0, 1), a2, 1);
            PG8_WAIT_V(8); PG8_WAIT_L(0); PG8_BAR; PG8_MMA(0, 0, At, B0); PG8_MMA(0, 1, At, B1); PG8_BAR; PG8_SCHED;
            PG8_LDA(At, 1, 1); PG8_STAGE_B(PG8_SB(1, 0), b3); PG8_STAGE_B(PG8_SB(1, 1), b3 + hstepB); PG8_STAGE_A(PG8_SA(1, 0), a3, 0);
            PG8_WAIT_V(8); PG8_WAIT_L(0); PG8_BAR; PG8_MMA(1, 0, At, B0); PG8_MMA(1, 1, At, B1); PG8_BAR; PG8_SCHED;
        }
        if (wr == 0) PG8_BAR;
        E(acc, cur, wr, wc, fr, fq);
        if (!has_next) break;
#pragma unroll
        for (int a = 0; a < 2; ++a)
#pragma unroll
            for (int b = 0; b < 2; ++b)
#pragma unroll
                for (int m = 0; m < 4; ++m)
#pragma unroll
                    for (int n = 0; n < 2; ++n) acc[a][b][m][n] = (f32x4){0.f, 0.f, 0.f, 0.f};
        cur = nxt; cA = nA; cB = nB; ++ui;
        if (wr == 1) PG8_BAR;
    }
    PG8_WAIT_V(0);
    PG8_BAR;
#undef PG8_SA
#undef PG8_SB
#undef PG8_STAGE_A
#undef PG8_STAGE_B
#undef PG8_LDA
#undef PG8_LDB
#undef PG8_MMA
#undef PG8_CAT
#undef PG8_WAIT_V
#undef PG8_WAIT_L
#undef PG8_BAR
#undef PG8_SCHED
#undef PG8_GLOAD
}
}

constexpr int NB = 4, SEQ = 4096, D = 2048, DEPTH = 2;
constexpr int T = NB * SEQ;
constexpr int NH = 8, HD = 128, DNW = 1024, CH = 64, NCH = SEQ / CH;
constexpr int PW = 1024, PG_DIM = 256;
constexpr int IN_COLS = 5136, NPROJ = 5120;
constexpr int NE = 16, DE = 1024, PLE = 256;
constexpr float ALPHA = 1.4142135623730951f;
constexpr float LN_EPS = 1e-5f, RMS_EPS = 1e-6f;
constexpr int LCAP = T;
constexpr int MAXTILES = 2 * T / 256 + NE;

constexpr size_t MiB = 1u << 20;
constexpr size_t WS_CTL = 0, CTL_ZERO_BYTES = 64 * 1024;
constexpr size_t WS_LIST = 2 * MiB;
constexpr size_t WS_TOKSLOT = 3 * MiB, WS_GATEW = WS_TOKSLOT + 128 * 1024, WS_STATS = WS_GATEW + 128 * 1024, WS_CD = WS_STATS + 128 * 1024, WS_WBA = WS_CD + 128 * 1024;
constexpr size_t WS_WIN = 4 * MiB, WS_WOUT = 44 * MiB, WS_WPG = 60 * MiB, WS_WPP = 76 * MiB, WS_WPOOL = 78 * MiB, WS_WGU = 80 * MiB, WS_WD = 336 * MiB, WS_PB16 = 464 * MiB;
constexpr size_t WS_XB = 480 * MiB, WS_R1 = 544 * MiB, WS_R2 = 704 * MiB, WS_R4 = 848 * MiB, WS_R5 = 944 * MiB, WS_END = 1008 * MiB;
constexpr size_t WS_PROJ = WS_R1, WS_HID = WS_R1;
constexpr size_t WS_Y = WS_R2;
constexpr size_t WS_POOLD = WS_R4, WS_PP = WS_R4 + 32 * MiB, WS_X1B = WS_R2;
constexpr size_t WS_MIXIN = WS_R5, WS_X2B = WS_R5;
constexpr size_t WS_X2F8 = WS_R1 + 96 * MiB;
static_assert((size_t)MAXTILES * 256 * 2048 * 2 <= 144 * MiB && (size_t)MAXTILES * 256 * 1024 * 2 <= 160 * MiB, "MoE row buffers");
constexpr int CW_TMO = 0, CW_CODE = 1, CW_CNT = 64  , CW_BAR = 4096;

constexpr int RING_OFF = 0, RING_BYTES = 131072;
constexpr int LDSCTL_OFF = 152 * 1024, MISC_OFF = LDSCTL_OFF + 320;
constexpr int AUX_OFF = LDSCTL_OFF + 1024;
constexpr int LDS_BYTES = 163840;
constexpr int NWAVES = 8;

#define RLX_AGENT __ATOMIC_RELAXED, __HIP_MEMORY_SCOPE_AGENT
#define LDS_WAIT() asm volatile("s_waitcnt lgkmcnt(0)" ::: "memory")
#define VM_WAIT() asm volatile("s_waitcnt vmcnt(0)" ::: "memory")
__device__ __forceinline__ unsigned f2bf(float f) { unsigned u = __builtin_bit_cast(unsigned, f); return (u + 0x7fffu + ((u >> 16) & 1u)) >> 16; }
__device__ __forceinline__ unsigned pk2(float lo, float hi) { return f2bf(lo) | (f2bf(hi) << 16); }
typedef __bf16 bf2_t __attribute__((ext_vector_type(2)));
__device__ __forceinline__ unsigned pkbf(float lo, float hi) { const f32x2 v = {lo, hi}; return __builtin_bit_cast(unsigned, __builtin_convertvector(v, bf2_t)); }
constexpr float F8_XS = 16.0f, F8_WS = 256.0f, F8_INV = 1.0f / 4096.0f;
__device__ __forceinline__ float f8clamp(float x) { return fminf(fmaxf(x, -448.0f), 448.0f); }
__device__ __forceinline__ unsigned pk4_fp8(float a, float b, float c, float d) { unsigned w = 0u; w = (unsigned)__builtin_amdgcn_cvt_pk_fp8_f32(f8clamp(a), f8clamp(b), (int)w, false); w = (unsigned)__builtin_amdgcn_cvt_pk_fp8_f32(f8clamp(c), f8clamp(d), (int)w, true); return w; }
__device__ __forceinline__ float bf2f(unsigned short b) { return __builtin_bit_cast(float, ((unsigned)b) << 16); }
__device__ __forceinline__ float bflo(unsigned w) { return __builtin_bit_cast(float, w << 16); }
__device__ __forceinline__ float bfhi(unsigned w) { return __builtin_bit_cast(float, w & 0xffff0000u); }
__device__ __forceinline__ float sigmoidf_(float x) { return __builtin_amdgcn_rcpf(1.0f + __expf(-x)); }
__device__ __forceinline__ float wave_sum(float v) {
#pragma unroll
    for (int o = 1; o < 64; o <<= 1) v += __shfl_xor(v, o);
    return v;
}
#define XB_TMO      128
#define XB_XCNT(j)  (256  + 64 * (j))
#define XB_XSUB(j)  (1280 + 64 * (j))
#define XB_XGEN(j)  (2304 + 64 * (j))
#define XB_TOP      3328
#define XB_TOPGEN   3392
#define XCD_BAR_WORDS 3456
#define XB_SPIN_CAP (1u << 18)

__device__ __forceinline__ unsigned xb_ld(unsigned* p)              { return __hip_atomic_load(p, __ATOMIC_RELAXED, __HIP_MEMORY_SCOPE_AGENT); }
__device__ __forceinline__ unsigned xb_add(unsigned* p, unsigned v) { return __hip_atomic_fetch_add(p, v, __ATOMIC_RELAXED, __HIP_MEMORY_SCOPE_AGENT); }
__device__ __forceinline__ unsigned xb_xcc_id() { return (unsigned)__builtin_amdgcn_s_getreg((3 << 11) | 20) & 0xFu; }
#define XB_SPIN(cond, bar) do { unsigned _sp = 0; while (cond) { __builtin_amdgcn_s_sleep(1); \
    if ((++_sp & 255u) == 0u) { if (xb_ld(&(bar)[XB_TMO])) break; if (_sp > XB_SPIN_CAP) { atomicAdd(&(bar)[XB_TMO], 1u); break; } } } } while (0)

struct XcdBarrier {
    unsigned* bar; unsigned x;
    volatile LAS unsigned* st;
};

__device__ __forceinline__ XcdBarrier xcd_barrier_post(unsigned* bar, volatile LAS unsigned* st) {
    XcdBarrier b; b.bar = bar; b.x = xb_xcc_id(); b.st = st;
    if (threadIdx.x == 0) (void)xb_add(&bar[XB_XCNT(b.x)], 1u);
    return b;
}
__device__ __forceinline__ void xcd_barrier_complete(unsigned* bar, unsigned x, unsigned& nloc, unsigned& nx) {
    const unsigned G = gridDim.x * gridDim.y * gridDim.z;
    unsigned sum, cnt, mine, sp = 0u;
    for (;;) {
        sum = 0u; cnt = 0u; mine = 0u;
#pragma unroll
        for (unsigned j = 0; j < 16; ++j) { const unsigned c = xb_ld(&bar[XB_XCNT(j)]); sum += c; cnt += (c > 0u) ? 1u : 0u; mine = (j == x) ? c : mine; }
        if (sum == G) break;
        __builtin_amdgcn_s_sleep(1);
        if ((++sp & 255u) == 0u) { if (xb_ld(&bar[XB_TMO])) break; if (sp > XB_SPIN_CAP) { atomicAdd(&bar[XB_TMO], 1u); break; } }
    }
    nloc = mine > 0u ? mine : 1u; nx = cnt > 0u ? cnt : 1u;
}

__device__ __forceinline__ void xcd_barrier(const XcdBarrier& b) {
    asm volatile("s_waitcnt vmcnt(0)" ::: "memory");
    __syncthreads();
    if (threadIdx.x == 0) {
        unsigned* bar = b.bar;
        __builtin_amdgcn_s_waitcnt(0);
        unsigned nloc = b.st[0], nx = b.st[1];
        if (nloc == 0u) { xcd_barrier_complete(bar, b.x, nloc, nx); b.st[0] = nloc; b.st[1] = nx; }
        const unsigned old = xb_add(&bar[XB_XSUB(b.x)], 1u);
        const unsigned gen = old / nloc;
        if (old + 1u == (gen + 1u) * nloc) {
            __builtin_amdgcn_fence(__ATOMIC_RELEASE, "agent");
            asm volatile("s_waitcnt vmcnt(0)" ::: "memory");
            const unsigned og = xb_add(&bar[XB_TOP], 1u);
            const unsigned tg = og / nx;
            if (og + 1u == (tg + 1u) * nx) xb_add(&bar[XB_TOPGEN], 1u);
            else XB_SPIN(xb_ld(&bar[XB_TOPGEN]) == tg, bar);
            __builtin_amdgcn_fence(__ATOMIC_ACQUIRE, "agent");
            xb_add(&bar[XB_XGEN(b.x)], 1u);
            asm volatile("s_waitcnt vmcnt(0)" ::: "memory");
        } else {
            XB_SPIN(xb_ld(&bar[XB_XGEN(b.x)]) == gen, bar);
            __builtin_amdgcn_fence(__ATOMIC_ACQUIRE, "agent");
            asm volatile("s_waitcnt vmcnt(0)" ::: "memory");
        }
    }
    __syncthreads();
}

struct Args { const float* in[21]; float* out; unsigned char* ws; int ph_lo, ph_hi, li, pad; };
enum { I_X = 0, I_P, I_WIN, I_CONVW, I_ALOG, I_DTB, I_NORMW, I_POOLW, I_POOLS, I_WOUT, I_LN1G, I_LN1B, I_WR, I_BR, I_WEG, I_WEU, I_WED, I_LN2G, I_LN2B, I_WPP, I_WPG };
struct Frame {
    LAS unsigned char* lds;
    volatile LAS unsigned* MISC;
    gu32* ctl;
    int tid, lane, wave, vcu, G;
};

#ifndef FP8_LAST
#define FP8_LAST 1
#endif
#ifndef FP8_PG
#define FP8_PG 0
#endif
#ifndef FP8_ALL
#define FP8_ALL 0
#endif
#define FP8_LAYER(l) (FP8_LAST && (FP8_ALL || (l) == DEPTH - 1))
#ifndef FP8_PI
#define FP8_PI 0
#endif
#define PHASE_FRAME(F0) Frame F = F0; { int t_ = threadIdx.x; asm volatile("" : "+v"(t_)); F.tid = t_; F.lane = t_ & 63; }
#define OPQ_S(p) asm volatile("" : "+s"(p))
#define OPQ_G(T, expr) ({ GAS T* g_ = (GAS T*)(expr); asm volatile("" : "+s"(g_)); (T*)g_; })
struct SchedDense {
    int nM, nN, nwg, G, c; const char* A; const char* B; size_t astep, bstep;
    __device__ __forceinline__ void init(int M, int N, int G_, int c_, const void* A_, int lda, const void* B_, int ldb) { nM = M / 256; nN = N / 256; nwg = nM * nN; G = G_; c = c_;
        A = (const char*)A_; B = (const char*)B_; astep = (size_t)256 * lda * 2; bstep = (size_t)256 * ldb * 2; }
    __device__ __forceinline__ bool next(int i, pg8::Unit& u) const {
        const long L = (long)i * G + c; if (L >= nwg) return false;
        int wgid = (int)L; { const int q = nwg / 8, r = nwg % 8, xcd = wgid % 8, off = wgid / 8; wgid = (xcd < r ? xcd * (q + 1) : r * (q + 1) + (xcd - r) * q) + off; }
        const int nig = 8 * nN, gid = wgid / nig, fm = gid * 8, gsz = (nM - fm) < 8 ? (nM - fm) : 8;
        u.pm = fm + ((wgid % nig) % gsz); u.pn = (wgid % nig) / gsz;
        u.A = A + (size_t)u.pm * astep; u.B = B + (size_t)u.pn * bstep; u.rows = nullptr; u.nvalid = 256; u.aux = 0; return true;
    }
};
struct SchedPool {
    int G, c; const char* A; const char* B;
    __device__ __forceinline__ bool next(int i, pg8::Unit& u) const {
        const int L = i * G + c; if (L >= 256) return false;
        u.pm = L >> 2; u.pn = L & 3; u.A = A + ((size_t)u.pm * 256 * PW + u.pn * 256) * 2; u.B = B + (size_t)u.pn * 65536 * 2; u.rows = nullptr; u.nvalid = 256; u.aux = 0; return true;
    }
};
struct SchedMoe {
    int G, c, mode; const LAS int* tab; const char* A; const char* B; const int* list; int esz;
    __device__ __forceinline__ bool next(int i, pg8::Unit& u) const {
        const int L = i * G + c, rt = L >> 3, pn = L & 7;
        const int ntiles = __builtin_amdgcn_readfirstlane(tab[16]); if (rt >= ntiles) return false;
        int e = 0;
#pragma unroll
        for (int k = 1; k < 16; ++k) { const int ts = __builtin_amdgcn_readfirstlane(tab[k]); if (rt >= ts) e = k; }
        const int ts = __builtin_amdgcn_readfirstlane(tab[e]), cn = __builtin_amdgcn_readfirstlane(tab[32 + e]);
        const int r0 = (rt - ts) * 256;
        u.pm = rt; u.pn = pn; u.aux = e;
        if (mode == 0) { u.A = A; u.rows = list + (size_t)e * LCAP + r0; u.nvalid = (cn - r0) < 256 ? (cn - r0) : 256; u.B = B + ((size_t)e * 2048 + pn * 256) * 2048 * esz; }
        else { u.A = A + (size_t)rt * 256 * DE * esz; u.rows = nullptr; u.nvalid = 256; u.B = B + ((size_t)e * 2048 + pn * 256) * DE * esz; }
        return true;
    }
};

using pg8::cvt_pk_bf16;
struct EpiBf16 {
    static constexpr bool PERM = true; bf16* O; int ldc; float scale = 1.0f;
    __device__ __forceinline__ void operator()(const f32x4 (&acc)[2][2][4][2], const pg8::Unit& u, int wr, int wc, int fr, int fq) const {
        const int row0 = u.pm * 256 + wr * 64 + fr, col0 = u.pn * 256 + wc * 32 + 8 * fq;
#pragma unroll
        for (int ai = 0; ai < 2; ++ai)
#pragma unroll
            for (int m = 0; m < 4; ++m) { bf16* rowp = O + (size_t)(row0 + ai * 128 + m * 16) * ldc + col0;
#pragma unroll
                for (int bj = 0; bj < 2; ++bj) { const f32x4 v0 = acc[ai][bj][m][0] * scale, v1 = acc[ai][bj][m][1] * scale;
                    v4u w; w.x = cvt_pk_bf16(v0[0], v0[1]); w.y = cvt_pk_bf16(v0[2], v0[3]); w.z = cvt_pk_bf16(v1[0], v1[1]); w.w = cvt_pk_bf16(v1[2], v1[3]);
                    *(v4u*)(rowp + bj * 128) = w; } }
    }
};
struct EpiPool {
    static constexpr bool PERM = true; bf16* O; const float* scale;
    __device__ __forceinline__ void operator()(const f32x4 (&acc)[2][2][4][2], const pg8::Unit& u, int wr, int wc, int fr, int fq) const {
        const int row0 = u.pm * 256 + wr * 64 + fr, cg = u.pn * 256 + wc * 32 + 8 * fq;
        f32x4 sv[2][2];
#pragma unroll
        for (int bj = 0; bj < 2; ++bj) { sv[bj][0] = *(const f32x4*)(scale + cg + bj * 128); sv[bj][1] = *(const f32x4*)(scale + cg + bj * 128 + 4); }
#pragma unroll
        for (int ai = 0; ai < 2; ++ai)
#pragma unroll
            for (int m = 0; m < 4; ++m) { bf16* rowp = O + (size_t)(row0 + ai * 128 + m * 16) * D + DNW + cg;
#pragma unroll
                for (int bj = 0; bj < 2; ++bj) { const f32x4 v0 = acc[ai][bj][m][0] * sv[bj][0], v1 = acc[ai][bj][m][1] * sv[bj][1];
                    v4u w; w.x = cvt_pk_bf16(v0[0], v0[1]); w.y = cvt_pk_bf16(v0[2], v0[3]); w.z = cvt_pk_bf16(v1[0], v1[1]); w.w = cvt_pk_bf16(v1[2], v1[3]);
                    *(v4u*)(rowp + bj * 128) = w; } }
    }
};
struct EpiRes {
    static constexpr bool PERM = true; const bf16* XB; bf16* PRE;
    __device__ __forceinline__ void operator()(const f32x4 (&acc)[2][2][4][2], const pg8::Unit& u, int wr, int wc, int fr, int fq) const {
        const int row0 = u.pm * 256 + wr * 64 + fr, col0 = u.pn * 256 + wc * 32 + 8 * fq;
#pragma unroll
        for (int ai = 0; ai < 2; ++ai)
#pragma unroll
            for (int m = 0; m < 4; ++m) { const size_t off0 = (size_t)(row0 + ai * 128 + m * 16) * D + col0;
#pragma unroll
                for (int bj = 0; bj < 2; ++bj) { const size_t off = off0 + bj * 128; const v4u x = *(const v4u*)(XB + off); const f32x4 a0 = acc[ai][bj][m][0], a1 = acc[ai][bj][m][1];
                    v4u w; w.x = cvt_pk_bf16(bflo(x.x) * ALPHA + a0[0], bfhi(x.x) * ALPHA + a0[1]); w.y = cvt_pk_bf16(bflo(x.y) * ALPHA + a0[2], bfhi(x.y) * ALPHA + a0[3]);
                    w.z = cvt_pk_bf16(bflo(x.z) * ALPHA + a1[0], bfhi(x.z) * ALPHA + a1[1]); w.w = cvt_pk_bf16(bflo(x.w) * ALPHA + a1[2], bfhi(x.w) * ALPHA + a1[3]);
                    *(v4u*)(PRE + off) = w; } }
    }
};
struct EpiSwiglu {
    static constexpr bool PERM = true; bf16* O; int f8 = 0; float ascale = 1.0f;
    __device__ __forceinline__ void operator()(const f32x4 (&acc)[2][2][4][2], const pg8::Unit& u, int wr, int wc, int fr, int fq) const {
        const int row0 = u.pm * 256 + wr * 64 + fr, col0 = u.pn * 128 + wc * 32 + 8 * fq;
#pragma unroll
        for (int ai = 0; ai < 2; ++ai)
#pragma unroll
            for (int m = 0; m < 4; ++m) { bf16* rowp = O + (size_t)(row0 + ai * 128 + m * 16) * DE + col0;
                float h[8];
#pragma unroll
                for (int n = 0; n < 2; ++n)
#pragma unroll
                    for (int j = 0; j < 4; ++j) { const float g = acc[ai][0][m][n][j] * ascale, up = acc[ai][1][m][n][j] * ascale; h[4 * n + j] = g * sigmoidf_(g) * up; }
                if (f8) { v2u w8; w8.x = pk4_fp8(h[0] * F8_XS, h[1] * F8_XS, h[2] * F8_XS, h[3] * F8_XS); w8.y = pk4_fp8(h[4] * F8_XS, h[5] * F8_XS, h[6] * F8_XS, h[7] * F8_XS);
                    *(v2u*)((unsigned char*)O + (size_t)(row0 + ai * 128 + m * 16) * DE + col0) = w8; }
                else { v4u w; w.x = cvt_pk_bf16(h[0], h[1]); w.y = cvt_pk_bf16(h[2], h[3]); w.z = cvt_pk_bf16(h[4], h[5]); w.w = cvt_pk_bf16(h[6], h[7]);
                *(v4u*)rowp = w; } }
    }
};
struct EpiPle {
    static constexpr bool PERM = true; const bf16* X2B; const bf16* PP; bf16* XB; float* OUT; int last; float ascale = 1.0f;
    __device__ __forceinline__ void operator()(const f32x4 (&acc)[2][2][4][2], const pg8::Unit& u, int wr, int wc, int fr, int fq) const {
        const int row0 = u.pm * 256 + wr * 64 + fr, col0 = u.pn * 256 + wc * 32 + 8 * fq;
#pragma unroll
        for (int ai = 0; ai < 2; ++ai)
#pragma unroll
            for (int m = 0; m < 4; ++m) { const size_t off0 = (size_t)(row0 + ai * 128 + m * 16) * D + col0;
#pragma unroll
                for (int bj = 0; bj < 2; ++bj) { const size_t off = off0 + bj * 128;
                    const v4u xx = *(const v4u*)(X2B + off), pp = *(const v4u*)(PP + off);
                    const f32x4 a0 = acc[ai][bj][m][0] * ascale, a1 = acc[ai][bj][m][1] * ascale;
                    f32x4 o0, o1;
                    o0[0] = bflo(xx.x) + sigmoidf_(a0[0]) * bflo(pp.x); o0[1] = bfhi(xx.x) + sigmoidf_(a0[1]) * bfhi(pp.x); o0[2] = bflo(xx.y) + sigmoidf_(a0[2]) * bflo(pp.y); o0[3] = bfhi(xx.y) + sigmoidf_(a0[3]) * bfhi(pp.y);
                    o1[0] = bflo(xx.z) + sigmoidf_(a1[0]) * bflo(pp.z); o1[1] = bfhi(xx.z) + sigmoidf_(a1[1]) * bfhi(pp.z); o1[2] = bflo(xx.w) + sigmoidf_(a1[2]) * bflo(pp.w); o1[3] = bfhi(xx.w) + sigmoidf_(a1[3]) * bfhi(pp.w);
                    if (last) { *(f32x4*)(OUT + off) = o0; *(f32x4*)(OUT + off + 4) = o1; }
                    else { v4u w; w.x = cvt_pk_bf16(o0[0], o0[1]); w.y = cvt_pk_bf16(o0[2], o0[3]); w.z = cvt_pk_bf16(o1[0], o1[1]); w.w = cvt_pk_bf16(o1[2], o1[3]); *(v4u*)(XB + off) = w; } } }
    }
};

__device__ __forceinline__ void tr_item(const float* W, int ldw, int k0, int n0, bf16* WT, size_t drow0, int ldt, LAS float* scr, int lane) {
#pragma unroll 8
    for (int i = 0; i < 32; ++i) { const int kk = 2 * i + (lane >> 5); scr[kk * 33 + (lane & 31)] = W[(size_t)(k0 + kk) * ldw + n0 + (lane & 31)]; }
    LDS_WAIT(); asm volatile("" ::: "memory");
    const int c = lane & 7;
#pragma unroll
    for (int j = 0; j < 4; ++j) { const int n = (lane >> 3) + 8 * j; const LAS float* s = scr + (8 * c) * 33 + n;
        v4u o; o.x = pk2(s[0 * 33], s[1 * 33]); o.y = pk2(s[2 * 33], s[3 * 33]); o.z = pk2(s[4 * 33], s[5 * 33]); o.w = pk2(s[6 * 33], s[7 * 33]);
        *(GAS v4u*)(WT + (drow0 + n) * ldt + k0 + 8 * c) = o; }
    LDS_WAIT(); asm volatile("" ::: "memory");
}
__device__ __forceinline__ void tr_item8(const float* W, int ldw, int k0, int n0, unsigned char* WT, size_t drow0, int ldt, LAS float* scr, int lane) {
#pragma unroll 8
    for (int i = 0; i < 32; ++i) { const int kk = 2 * i + (lane >> 5); scr[kk * 33 + (lane & 31)] = W[(size_t)(k0 + kk) * ldw + n0 + (lane & 31)]; }
    LDS_WAIT(); asm volatile("" ::: "memory");
    const int c = lane & 7;
#pragma unroll
    for (int j = 0; j < 4; ++j) { const int n = (lane >> 3) + 8 * j; const LAS float* s = scr + (8 * c) * 33 + n;
        v2u o; o.x = pk4_fp8(s[0 * 33] * F8_WS, s[1 * 33] * F8_WS, s[2 * 33] * F8_WS, s[3 * 33] * F8_WS); o.y = pk4_fp8(s[4 * 33] * F8_WS, s[5 * 33] * F8_WS, s[6 * 33] * F8_WS, s[7 * 33] * F8_WS);
        *(GAS v2u*)(WT + (drow0 + n) * ldt + k0 + 8 * c) = o; }
    LDS_WAIT(); asm volatile("" ::: "memory");
}
__device__ __forceinline__ void weight_items(const Args& a, unsigned char* ws, LAS float* scr, int lane, int group, int l, int gw, int NGW) {
    constexpr int I_INA = 32 * 128, I_INB = 32 * 32, I_OUT = 32 * 64, I_PG = 32 * 64, I_PP = 4 * 64, I_POOL = 4 * 32, I_EG = NE * 32 * 32, I_EU = I_EG, I_ED = NE * 16 * 64;
    if (group == 0) {
        for (int it = gw; it < I_INA + I_INB + I_PP + I_POOL; it += NGW) { int r = it;
            if (r < I_INA) { const int kb = r / 128, nb = r % 128; tr_item(a.in[I_WIN] + (size_t)l * D * IN_COLS, IN_COLS, 64 * kb, 32 * nb, (bf16*)(ws + WS_WIN) + (size_t)l * NPROJ * D, 32 * nb, D, scr, lane); continue; } r -= I_INA;
            if (r < I_INB) { const int kb = r / 32, nb = r % 32; tr_item(a.in[I_WIN] + (size_t)l * D * IN_COLS, IN_COLS, 64 * kb, 4112 + 32 * nb, (bf16*)(ws + WS_WIN) + (size_t)l * NPROJ * D, 4096 + 32 * nb, D, scr, lane); continue; } r -= I_INB;
            if (r < I_PP) { const int kb = r / 64, nb = r % 64; tr_item(a.in[I_WPP] + (size_t)l * PLE * D, D, 64 * kb, 32 * nb, (bf16*)(ws + WS_WPP) + (size_t)l * D * PLE, 32 * nb, PLE, scr, lane); continue; } r -= I_PP;
            { const int g = r / 32, rr = r % 32, kb = rr / 8, nb = rr % 8; tr_item(a.in[I_POOLW] + ((size_t)l * 4 + g) * 65536, 256, 64 * kb, 32 * nb, (bf16*)(ws + WS_WPOOL) + ((size_t)l * 4 + g) * 65536, 32 * nb, 256, scr, lane); } }
    } else {
        const bool f8 = FP8_LAYER(l);
        for (int it = gw; it < I_OUT + I_PG + I_EG + I_EU + I_ED; it += NGW) { int r = it;
            if (r < I_OUT) { const int kb = r / 64, nb = r % 64; tr_item(a.in[I_WOUT] + (size_t)l * D * D, D, 64 * kb, 32 * nb, (bf16*)(ws + WS_WOUT) + (size_t)l * D * D, 32 * nb, D, scr, lane); continue; } r -= I_OUT;
            if (r < I_PG) { const int kb = r / 64, nb = r % 64; if (f8 && FP8_PI) tr_item8(a.in[I_WPG] + (size_t)l * D * D, D, 64 * kb, 32 * nb, ws + WS_WPG + (size_t)l * D * D * 2, 32 * nb, D, scr, lane); else tr_item(a.in[I_WPG] + (size_t)l * D * D, D, 64 * kb, 32 * nb, (bf16*)(ws + WS_WPG) + (size_t)l * D * D, 32 * nb, D, scr, lane); continue; } r -= I_PG;
            if (r < I_EG) { const int e = r / 1024, rr = r % 1024, kb = rr / 32, nb = rr % 32, h0 = 32 * nb;
                if (f8) tr_item8(a.in[I_WEG] + ((size_t)l * NE + e) * D * DE, DE, 64 * kb, h0, ws + WS_WGU + (size_t)l * NE * 2048 * D * 2 + (size_t)e * 2048 * D, (size_t)(h0 >> 7) * 256 + (h0 & 127), D, scr, lane);
                else tr_item(a.in[I_WEG] + ((size_t)l * NE + e) * D * DE, DE, 64 * kb, h0, (bf16*)(ws + WS_WGU) + ((size_t)l * NE + e) * 2048 * D, (size_t)(h0 >> 7) * 256 + (h0 & 127), D, scr, lane); continue; } r -= I_EG;
            if (r < I_EU) { const int e = r / 1024, rr = r % 1024, kb = rr / 32, nb = rr % 32, h0 = 32 * nb;
                if (f8) tr_item8(a.in[I_WEU] + ((size_t)l * NE + e) * D * DE, DE, 64 * kb, h0, ws + WS_WGU + (size_t)l * NE * 2048 * D * 2 + (size_t)e * 2048 * D, (size_t)(h0 >> 7) * 256 + 128 + (h0 & 127), D, scr, lane);
                else tr_item(a.in[I_WEU] + ((size_t)l * NE + e) * D * DE, DE, 64 * kb, h0, (bf16*)(ws + WS_WGU) + ((size_t)l * NE + e) * 2048 * D, (size_t)(h0 >> 7) * 256 + 128 + (h0 & 127), D, scr, lane); continue; } r -= I_EU;
            { const int e = r / 1024, rr = r % 1024, kb = rr / 64, nb = rr % 64;
                if (f8 && FP8_PG) tr_item8(a.in[I_WED] + ((size_t)l * NE + e) * DE * D, D, 64 * kb, 32 * nb, ws + WS_WD + (size_t)l * NE * D * DE * 2 + (size_t)e * D * DE, 32 * nb, DE, scr, lane);
                else tr_item(a.in[I_WED] + ((size_t)l * NE + e) * DE * D, D, 64 * kb, 32 * nb, (bf16*)(ws + WS_WD) + ((size_t)l * NE + e) * D * DE, 32 * nb, DE, scr, lane); } }
    }
}
__device__ __forceinline__ void p0_prologue(const Frame& F0, const Args& a) {
    PHASE_FRAME(F0);
    LAS float* scr = (LAS float*)(F.lds + RING_OFF + F.wave * 16384);
    const int gw = F.vcu * NWAVES + F.wave, NGW = F.G * NWAVES;
    unsigned char* ws = OPQ_G(unsigned char, a.ws);
#pragma unroll 1
    for (int l = 0; l < DEPTH; ++l) weight_items(a, ws, scr, F.lane, 0, l, gw, NGW);
#ifdef CONVERT_ALL_IN_PROLOGUE
#pragma unroll 1
    for (int l = 0; l < DEPTH; ++l) weight_items(a, ws, scr, F.lane, 1, l, gw, NGW);
#endif
    const size_t gt = (size_t)F.vcu * 512 + F.tid, NGT = (size_t)F.G * 512;
    { const GAS f32x4* src = (const GAS f32x4*)a.in[I_X]; GAS v4u* dst = (GAS v4u*)(ws + WS_XB);
        for (size_t i = gt; i < (size_t)T * D / 8; i += NGT) { const f32x4 v0 = src[2 * i], v1 = src[2 * i + 1]; v4u o; o.x = pk2(v0[0], v0[1]); o.y = pk2(v0[2], v0[3]); o.z = pk2(v1[0], v1[1]); o.w = pk2(v1[2], v1[3]); dst[i] = o; } }
    { const GAS f32x4* src = (const GAS f32x4*)a.in[I_P]; GAS v4u* dst = (GAS v4u*)(ws + WS_PB16);
        for (size_t i = gt; i < (size_t)DEPTH * T * PLE / 8; i += NGT) { const f32x4 v0 = src[2 * i], v1 = src[2 * i + 1]; v4u o; o.x = pk2(v0[0], v0[1]); o.y = pk2(v0[2], v0[3]); o.z = pk2(v1[0], v1[1]); o.w = pk2(v1[2], v1[3]); dst[i] = o; } }
    for (size_t i = gt; i < (size_t)DEPTH * 16 * D; i += NGT) { const int l = (int)(i / (16 * D)), j = (int)((i / D) % 16), k = (int)(i % D);
        ((bf16*)(ws + WS_WBA))[i] = (bf16)f2bf(a.in[I_WIN][((size_t)l * D + k) * IN_COLS + 4096 + j]); }
}

typedef float f32x16 __attribute__((ext_vector_type(16)));
#define MFMA32(a_, b_, c_) __builtin_amdgcn_mfma_f32_32x32x16_bf16((a_), (b_), (c_), 0, 0, 0)
#define PACK8(x, sp) __builtin_bit_cast(bf16x8, (v4u){pkbf((x)[8 * (sp)], (x)[8 * (sp) + 1]), pkbf((x)[8 * (sp) + 2], (x)[8 * (sp) + 3]), pkbf((x)[8 * (sp) + 4], (x)[8 * (sp) + 5]), pkbf((x)[8 * (sp) + 6], (x)[8 * (sp) + 7])})
#define RAW_BAR() do { asm volatile("s_waitcnt lgkmcnt(0)" ::: "memory"); __builtin_amdgcn_s_barrier(); asm volatile("" ::: "memory"); } while (0)
constexpr int IMG_ELEMS = 56 * 512, UIMG_ELEMS = 8 * 1024;
constexpr int FR_WN = 0, FR_QD = 16, FR_AQK = 32, FR_KDT = 40;
constexpr size_t WS_IMG = WS_R2, WS_UIMG = WS_R2 + 112 * MiB;
static_assert((size_t)NB * NCH * NH * IMG_ELEMS * 2 == 112 * MiB && (size_t)NB * NCH * NH * UIMG_ELEMS * 2 == 32 * MiB, "DeltaNet images");

__device__ __forceinline__ void pool_diffs_unit(const Frame& F, unsigned char* ws, int pm, int g) {
    const bf16* PROJ = (const bf16*)(ws + WS_PROJ); bf16* POOLD = (bf16*)(ws + WS_POOLD);
    const int tid = F.tid, cp = tid & 127, rq = tid >> 7, r0 = 256 * pm + 64 * rq, sq0 = r0 % SEQ, col = 256 * g + 2 * cp;
    const bf16* up = PROJ + (size_t)r0 * NPROJ + 4096 + col; bf16* dp = POOLD + (size_t)r0 * PW + col;
#define POOL_BODY(WIN) do { unsigned xr[CH + WIN - 1]; \
        _Pragma("unroll") for (int j = 0; j < WIN - 1; ++j) xr[j] = (sq0 - (WIN - 1) + j >= 0) ? *(const unsigned*)(up + (ptrdiff_t)(j - (WIN - 1)) * NPROJ) : 0u; \
        _Pragma("unroll") for (int i = 0; i < CH; ++i) xr[WIN - 1 + i] = *(const unsigned*)(up + (size_t)i * NPROJ); \
        float s0 = 0.f, s1 = 0.f; \
        _Pragma("unroll") for (int j = 0; j < WIN - 1; ++j) { s0 += bflo(xr[j]); s1 += bfhi(xr[j]); } \
        _Pragma("unroll") for (int i = 0; i < CH; ++i) { const float x0 = bflo(xr[WIN - 1 + i]), x1 = bfhi(xr[WIN - 1 + i]); s0 += x0; s1 += x1; \
            const int pos = sq0 + i; const float inv = __builtin_amdgcn_rcpf((float)((pos + 1) < WIN ? (pos + 1) : WIN)); \
            *(unsigned*)(dp + (size_t)i * PW) = pkbf(s0 * inv - x0, s1 * inv - x1); s0 -= bflo(xr[i]); s1 -= bfhi(xr[i]); } } while (0)
    if (g == 0) POOL_BODY(2); else if (g == 1) POOL_BODY(4); else if (g == 2) POOL_BODY(8); else POOL_BODY(16);
#undef POOL_BODY
}
#ifndef PREP_DUP
#define PREP_DUP 0
#endif
constexpr int PQF = 0, PKF = 33792, PQS = 67584, PKS = 84992, PVT = 102400, PKT = 120832, PTAB = 139264;
constexpr int PAS = PQF;
constexpr int PTB = PKF, PT11T = PKF + 9216, PPART = PKF;
constexpr int F_LD = 132, S_LD = 136, T_LD = 72, A_LD = 68, TT_LD = 40;
__device__ __forceinline__ void phase_dn_prep(const Frame& F0, const Args& a, int layer) {
    PHASE_FRAME(F0);
    unsigned char* ws = OPQ_G(unsigned char, a.ws);
    LAS unsigned char* lds = F.lds;
    LAS float* Qf = (LAS float*)(lds + PQF); LAS float* Kf = (LAS float*)(lds + PKF); LAS float* As = (LAS float*)(lds + PAS);
    LAS bf16* Qs = (LAS bf16*)(lds + PQS); LAS bf16* Ks = (LAS bf16*)(lds + PKS); LAS bf16* Vt = (LAS bf16*)(lds + PVT); LAS bf16* Kt = (LAS bf16*)(lds + PKT);
    LAS bf16* Tb = (LAS bf16*)(lds + PTB); LAS bf16* T11t = (LAS bf16*)(lds + PT11T);
    LAS float* betaS = (LAS float*)(lds + PTAB); LAS float* gS = betaS + 512; LAS float* gamh = gS + 512; LAS float* betah = gamh + 64; LAS float* egam = betah + 64; LAS float* bgam = egam + 64; LAS float* ekd = bgam + 64; LAS float* rkS = ekd + 64;
    const bf16* XB = (const bf16*)(ws + WS_XB); const bf16* PROJ = (const bf16*)(ws + WS_PROJ); const bf16* WBA = (const bf16*)(ws + WS_WBA) + (size_t)layer * 16 * D;
    bf16* IMG = (bf16*)(ws + WS_IMG); bf16* UIMG = (bf16*)(ws + WS_UIMG); float* CD = (float*)(ws + WS_CD);
    const float* convw = a.in[I_CONVW] + (size_t)layer * 4 * 3072; const float* alog = a.in[I_ALOG] + layer * NH; const float* dtb = a.in[I_DTB] + layer * NH;
    const int tid = F.tid, lane = F.lane, wave = F.wave, c32 = lane & 31, hf = lane >> 5;
    for (int unit = F.vcu; unit < NB * NCH; unit += F.G) {
        const int b = unit / NCH, n = unit % NCH, r0 = b * SEQ + n * CH, sq0 = n * CH;
        for (int rep_ = 0; rep_ < ((PREP_DUP & 64) ? 2 : 1); ++rep_)
        { typedef float f32x4v __attribute__((ext_vector_type(4)));
            const int fr = lane & 15, fg = lane >> 4; f32x4v pacc[4];
#pragma unroll
            for (int mt = 0; mt < 4; ++mt) pacc[mt] = (f32x4v){0.f, 0.f, 0.f, 0.f};
#pragma unroll 2
            for (int s = 0; s < 8; ++s) { const int k0 = 256 * wave + 32 * s + 8 * fg;
                const bf16x8 bfr = *(const bf16x8*)(WBA + (size_t)fr * D + k0);
#pragma unroll
                for (int mt = 0; mt < 4; ++mt) { const bf16x8 afr = *(const bf16x8*)(XB + (size_t)(r0 + 16 * mt + fr) * D + k0); pacc[mt] = __builtin_amdgcn_mfma_f32_16x16x32_bf16(afr, bfr, pacc[mt], 0, 0, 0); } }
            LAS float* part = (LAS float*)(lds + PPART) + wave * 1024;
#pragma unroll
            for (int mt = 0; mt < 4; ++mt)
#pragma unroll
                for (int r = 0; r < 4; ++r) part[(16 * mt + 4 * fg + r) * 16 + fr] = pacc[mt][r]; }
        __syncthreads();
        { const int tok = tid >> 3, cp = tid & 7; float s0 = 0.f, s1 = 0.f;
#pragma unroll
            for (int w = 0; w < 8; ++w) { const f32x2 p2 = *(const LAS f32x2*)((LAS float*)(lds + PPART) + w * 1024 + tok * 16 + 2 * cp); s0 += p2[0]; s1 += p2[1]; }
            if (cp < 4) { betaS[tok * 8 + 2 * cp] = sigmoidf_(s0); betaS[tok * 8 + 2 * cp + 1] = sigmoidf_(s1); }
            else { const int h = 2 * (cp - 4); const float z0 = s0 + dtb[h], z1 = s1 + dtb[h + 1];
                const float sp0 = z0 > 20.f ? z0 : log1pf(__expf(z0)), sp1 = z1 > 20.f ? z1 : log1pf(__expf(z1));
                gS[tok * 8 + h] = -__expf(alog[h]) * sp0; gS[tok * 8 + h + 1] = -__expf(alog[h + 1]) * sp1; } }
        __syncthreads();
        if (tid < 8) { float run = 0.f; for (int t = 0; t < CH; ++t) { run += gS[t * 8 + tid]; gS[t * 8 + tid] = run; } }
        __syncthreads();
        unsigned craw[3][11]; unsigned cdum[3][8];
#define PREP_LOADRAW(hh) do { const int cp_ = tid & 63, i0_ = (tid >> 6) * 8; \
            _Pragma("unroll") for (int part_ = 0; part_ < 3; ++part_) { const bf16* src_ = PROJ + (size_t)(r0 + i0_ - 3) * NPROJ + part_ * 1024 + (hh) * HD + 2 * cp_; \
                _Pragma("unroll") for (int j_ = 0; j_ < 11; ++j_) craw[part_][j_] = (sq0 + i0_ - 3 + j_ >= 0) ? *(const unsigned*)(src_ + (ptrdiff_t)j_ * NPROJ) : 0u; \
                if (PREP_DUP & 256) { _Pragma("unroll") for (int j_ = 3; j_ < 11; ++j_) cdum[part_][j_ - 3] = *(const unsigned*)(src_ + (ptrdiff_t)j_ * NPROJ + ((hh) ^ 1) * HD - (hh) * HD); } } } while (0)
        for (int rep2_ = 0; rep2_ < ((PREP_DUP & 128) ? 2 : 1); ++rep2_) {
        PREP_LOADRAW(0);
        for (int h = 0; h < NH; ++h) {
            const size_t chd = (size_t)unit * NH + h; bf16* img = IMG + chd * IMG_ELEMS; bf16* uimg = UIMG + chd * UIMG_ELEMS;
            if (tid < 64) { const float gi = gS[tid * 8 + h], bi = betaS[tid * 8 + h], eg = __expf(gi); gamh[tid] = gi; betah[tid] = bi; egam[tid] = eg; bgam[tid] = bi * eg; ekd[tid] = __expf(gS[63 * 8 + h] - gi); }
            RAW_BAR();
            for (int rep_ = 0; rep_ < ((PREP_DUP & 16) ? 2 : 1); ++rep_)
            { const int cp = tid & 63, rg8 = tid >> 6, i0 = rg8 * 8;
                if (PREP_DUP & 256) {
#pragma unroll
                    for (int p_ = 0; p_ < 3; ++p_)
#pragma unroll
                        for (int j_ = 0; j_ < 8; ++j_) asm volatile("" :: "v"(cdum[p_][j_])); }
#pragma unroll
                for (int part = 0; part < 3; ++part) { const int col = part * 1024 + h * HD + 2 * cp;
                    const f32x2 cw0 = *(const f32x2*)(convw + col), cw1 = *(const f32x2*)(convw + 3072 + col), cw2 = *(const f32x2*)(convw + 2 * 3072 + col), cw3 = *(const f32x2*)(convw + 3 * 3072 + col);
                    float ya[8], yb[8];
#pragma unroll
                    for (int i = 0; i < 8; ++i) { const unsigned x3 = craw[part][i], x2 = craw[part][i + 1], x1 = craw[part][i + 2], x0 = craw[part][i + 3];
                        const float ta = cw0[0] * bflo(x3) + cw1[0] * bflo(x2) + cw2[0] * bflo(x1) + cw3[0] * bflo(x0), tb = cw0[1] * bfhi(x3) + cw1[1] * bfhi(x2) + cw2[1] * bfhi(x1) + cw3[1] * bfhi(x0);
                        ya[i] = ta * sigmoidf_(ta); yb[i] = tb * sigmoidf_(tb); }
                    if (part == 0) {
#pragma unroll
                        for (int i = 0; i < 8; ++i) *(LAS f32x2*)(Qf + (i0 + i) * F_LD + 2 * cp) = (f32x2){ya[i], yb[i]}; }
                    else if (part == 1) {
#pragma unroll
                        for (int i = 0; i < 8; ++i) *(LAS f32x2*)(Kf + (i0 + i) * F_LD + 2 * cp) = (f32x2){ya[i], yb[i]}; }
                    else { v4u o0, o1;
                        o0.x = pkbf(ya[0] * betah[i0 + 0], ya[1] * betah[i0 + 1]); o0.y = pkbf(ya[2] * betah[i0 + 2], ya[3] * betah[i0 + 3]); o0.z = pkbf(ya[4] * betah[i0 + 4], ya[5] * betah[i0 + 5]); o0.w = pkbf(ya[6] * betah[i0 + 6], ya[7] * betah[i0 + 7]);
                        o1.x = pkbf(yb[0] * betah[i0 + 0], yb[1] * betah[i0 + 1]); o1.y = pkbf(yb[2] * betah[i0 + 2], yb[3] * betah[i0 + 3]); o1.z = pkbf(yb[4] * betah[i0 + 4], yb[5] * betah[i0 + 5]); o1.w = pkbf(yb[6] * betah[i0 + 6], yb[7] * betah[i0 + 7]);
                        *(LAS v4u*)(Vt + (2 * cp) * T_LD + i0) = o0; *(LAS v4u*)(Vt + (2 * cp + 1) * T_LD + i0) = o1; } }
            }
            if (h + 1 < NH) PREP_LOADRAW(h + 1);
            for (int rep_ = 0; rep_ < ((PREP_DUP & 1) ? 2 : 1); ++rep_) { if (rep_) RAW_BAR();
            { const int i = tid >> 3, part = tid & 7; const LAS float* qp = Qf + i * F_LD + part * 16; const LAS float* kp = Kf + i * F_LD + part * 16;
                f32x4 qv[4], kv[4]; float sq = 0.f, sk = 0.f;
#pragma unroll
                for (int j = 0; j < 4; ++j) { qv[j] = *(const LAS f32x4*)(qp + 4 * j); kv[j] = *(const LAS f32x4*)(kp + 4 * j);
                    sq += (qv[j][0] * qv[j][0] + qv[j][1] * qv[j][1]) + (qv[j][2] * qv[j][2] + qv[j][3] * qv[j][3]); sk += (kv[j][0] * kv[j][0] + kv[j][1] * kv[j][1]) + (kv[j][2] * kv[j][2] + kv[j][3] * kv[j][3]); }
                sq += __shfl_xor(sq, 1); sq += __shfl_xor(sq, 2); sq += __shfl_xor(sq, 4); sk += __shfl_xor(sk, 1); sk += __shfl_xor(sk, 2); sk += __shfl_xor(sk, 4);
                const float rq = 1.0f / sqrtf(sq + RMS_EPS) * 0.08838834764831845f, rk = 1.0f / sqrtf(sk + RMS_EPS);
                if (part == 0) rkS[i] = rk;
#pragma unroll
                for (int j = 0; j < 4; ++j) { qv[j] = qv[j] * rq; kv[j] = kv[j] * rk; }
                v4u w0, w1;
                w0.x = pkbf(qv[0][0], qv[0][1]); w0.y = pkbf(qv[0][2], qv[0][3]); w0.z = pkbf(qv[1][0], qv[1][1]); w0.w = pkbf(qv[1][2], qv[1][3]); w1.x = pkbf(qv[2][0], qv[2][1]); w1.y = pkbf(qv[2][2], qv[2][3]); w1.z = pkbf(qv[3][0], qv[3][1]); w1.w = pkbf(qv[3][2], qv[3][3]);
                *(LAS v4u*)(Qs + i * S_LD + part * 16) = w0; *(LAS v4u*)(Qs + i * S_LD + part * 16 + 8) = w1;
                w0.x = pkbf(kv[0][0], kv[0][1]); w0.y = pkbf(kv[0][2], kv[0][3]); w0.z = pkbf(kv[1][0], kv[1][1]); w0.w = pkbf(kv[1][2], kv[1][3]); w1.x = pkbf(kv[2][0], kv[2][1]); w1.y = pkbf(kv[2][2], kv[2][3]); w1.z = pkbf(kv[3][0], kv[3][1]); w1.w = pkbf(kv[3][2], kv[3][3]);
                *(LAS v4u*)(Ks + i * S_LD + part * 16) = w0; *(LAS v4u*)(Ks + i * S_LD + part * 16 + 8) = w1;
                const float eg = egam[i]; bf16* fq = img + ((size_t)(FR_QD + (i >> 5) * 8 + part) * 64 + (i & 31)) * 8;
                v4u h0, h1;
                h0.x = pkbf(qv[0][0] * eg, qv[0][1] * eg); h0.y = pkbf(qv[0][2] * eg, qv[0][3] * eg); h0.z = pkbf(qv[2][0] * eg, qv[2][1] * eg); h0.w = pkbf(qv[2][2] * eg, qv[2][3] * eg);
                h1.x = pkbf(qv[1][0] * eg, qv[1][1] * eg); h1.y = pkbf(qv[1][2] * eg, qv[1][3] * eg); h1.z = pkbf(qv[3][0] * eg, qv[3][1] * eg); h1.w = pkbf(qv[3][2] * eg, qv[3][3] * eg);
                *(v4u*)fq = h0; *(v4u*)(fq + 32 * 8) = h1; }
            RAW_BAR();
            { const int c = tid & 127, rg = tid >> 7; float kb[16], kd[16];
#pragma unroll
                for (int i = 0; i < 16; ++i) { const int t = rg * 16 + i; const float kn = Kf[t * F_LD + c] * rkS[t]; kb[i] = kn * bgam[t]; kd[i] = kn * ekd[t]; }
                v4u o0, o1;
                o0.x = pkbf(kb[0], kb[1]); o0.y = pkbf(kb[2], kb[3]); o0.z = pkbf(kb[4], kb[5]); o0.w = pkbf(kb[6], kb[7]); o1.x = pkbf(kb[8], kb[9]); o1.y = pkbf(kb[10], kb[11]); o1.z = pkbf(kb[12], kb[13]); o1.w = pkbf(kb[14], kb[15]);
                *(LAS v4u*)(Kt + c * T_LD + rg * 16) = o0; *(LAS v4u*)(Kt + c * T_LD + rg * 16 + 8) = o1;
                bf16* fk = img + ((size_t)(FR_KDT + (c >> 5) * 4 + rg) * 64 + (c & 31)) * 8;
                v4u h0, h1;
                h0.x = pkbf(kd[0], kd[1]); h0.y = pkbf(kd[2], kd[3]); h0.z = pkbf(kd[8], kd[9]); h0.w = pkbf(kd[10], kd[11]);
                h1.x = pkbf(kd[4], kd[5]); h1.y = pkbf(kd[6], kd[7]); h1.z = pkbf(kd[12], kd[13]); h1.w = pkbf(kd[14], kd[15]);
                *(v4u*)fk = h0; *(v4u*)(fk + 32 * 8) = h1; }
            RAW_BAR();
            }
            for (int rep_ = 0; rep_ < ((PREP_DUP & 2) ? 2 : 1); ++rep_) { if (rep_) RAW_BAR();
            if (wave < 6) { const int pr = wave % 3, iskk = wave / 3, mt = pr == 2 ? 1 : 0, nt = pr == 0 ? 0 : 1;
                const LAS bf16* xs = iskk ? Ks : Qs; f32x16 d;
#pragma unroll
                for (int r = 0; r < 16; ++r) d[r] = 0.f;
#pragma unroll
                for (int s = 0; s < 8; ++s) { const bf16x8 af = *(const LAS bf16x8*)(Ks + (32 * mt + c32) * S_LD + 16 * s + 8 * hf), bfr = *(const LAS bf16x8*)(xs + (32 * nt + c32) * S_LD + 16 * s + 8 * hf); d = MFMA32(af, bfr, d); }
                const int i = 32 * nt + c32; const float gi = gamh[i], bi = betah[i];
#pragma unroll
                for (int r = 0; r < 16; ++r) { const int j = 32 * mt + (r & 3) + 8 * (r >> 2) + 4 * hf; const float de = __expf(gi - gamh[j]);
                    d[r] = iskk ? ((j < i) ? bi * d[r] * de : 0.f) : ((j <= i) ? d[r] * de : 0.f); }
                if (iskk) {
#pragma unroll
                    for (int qd = 0; qd < 4; ++qd) *(LAS f32x4*)(As + i * A_LD + 32 * mt + 8 * qd + 4 * hf) = (f32x4){d[4 * qd], d[4 * qd + 1], d[4 * qd + 2], d[4 * qd + 3]}; }
                else {
#pragma unroll
                    for (int sp = 0; sp < 2; ++sp) *(bf16x8*)(img + ((size_t)(FR_AQK + nt * 4 + 2 * mt + sp) * 64 + lane) * 8) = PACK8(d, sp); } }
            RAW_BAR();
            }
            for (int rep_ = 0; rep_ < ((PREP_DUP & 4) ? 2 : 1); ++rep_) { if (rep_) RAW_BAR();
            if (wave < 2) {
                unsigned asb = (unsigned)(uintptr_t)(As + (32 * wave) * A_LD + 32 * wave); int cb = c32; asm volatile("" : "+v"(asb), "+v"(cb));
                const LAS float* Ab = (const LAS float*)(uintptr_t)asb;
                float arow[32], Tc[32];
#pragma unroll
                for (int i = 0; i < 32; ++i) arow[i] = Ab[i * A_LD + cb];
#pragma unroll
                for (int i = 0; i < 32; ++i) { float ac[4] = {(i == cb) ? 1.f : 0.f, 0.f, 0.f, 0.f}; if (i > 0) asm volatile("" : "+v"(arow[i]), "+v"(Tc[i - 1]));
#pragma unroll
                    for (int j = 0; j < i; ++j) { const float aij = __builtin_bit_cast(float, __builtin_amdgcn_readlane(__builtin_bit_cast(int, arow[i]), j)); ac[j & 3] -= aij * Tc[j]; }
                    Tc[i] = (ac[0] + ac[1]) + (ac[2] + ac[3]); __builtin_amdgcn_sched_barrier(0); }
                if (hf == 0) {
#pragma unroll
                    for (int i = 0; i < 32; ++i) Tb[(32 * wave + i) * T_LD + 32 * wave + c32] = (bf16)(pkbf(Tc[i], 0.f) & 0xffffu);
                    if (wave == 0) {
#pragma unroll
                        for (int q = 0; q < 4; ++q) { v4u o; o.x = pkbf(Tc[8 * q], Tc[8 * q + 1]); o.y = pkbf(Tc[8 * q + 2], Tc[8 * q + 3]); o.z = pkbf(Tc[8 * q + 4], Tc[8 * q + 5]); o.w = pkbf(Tc[8 * q + 6], Tc[8 * q + 7]); *(LAS v4u*)(T11t + c32 * TT_LD + 8 * q) = o; } } } }
            RAW_BAR();
            if (wave == 0) {
                f32x16 x;
#pragma unroll
                for (int r = 0; r < 16; ++r) x[r] = 0.f;
#pragma unroll
                for (int s = 0; s < 2; ++s) { const LAS float* ap = As + (32 + c32) * A_LD + 16 * s + 8 * hf; const f32x4 a0 = *(const LAS f32x4*)ap, a1 = *(const LAS f32x4*)(ap + 4);
                    const bf16x8 af = __builtin_bit_cast(bf16x8, (v4u){pkbf(a0[0], a0[1]), pkbf(a0[2], a0[3]), pkbf(a1[0], a1[1]), pkbf(a1[2], a1[3])});
                    const bf16x8 bfr = *(const LAS bf16x8*)(T11t + c32 * TT_LD + 16 * s + 8 * hf); x = MFMA32(af, bfr, x); }
                f32x16 t21;
#pragma unroll
                for (int r = 0; r < 16; ++r) t21[r] = 0.f;
#pragma unroll
                for (int s = 0; s < 2; ++s) { const LAS bf16* tp = Tb + (32 + c32) * T_LD + 32 + 16 * s + 4 * hf; const v2u lo = *(const LAS v2u*)tp, hi = *(const LAS v2u*)(tp + 8);
                    const bf16x8 af = __builtin_bit_cast(bf16x8, (v4u){lo.x, lo.y, hi.x, hi.y}); const bf16x8 bfr = PACK8(x, s); t21 = MFMA32(af, bfr, t21); }
#pragma unroll
                for (int r = 0; r < 16; ++r) Tb[(32 + (r & 3) + 8 * (r >> 2) + 4 * hf) * T_LD + c32] = (bf16)(pkbf(-t21[r], 0.f) & 0xffffu);
            }
            RAW_BAR();
            }
            for (int rep_ = 0; rep_ < ((PREP_DUP & 8) ? 2 : 1); ++rep_) { if (rep_) RAW_BAR();
            if (wave < 4) {
#pragma unroll
                for (int mt = 0; mt < 2; ++mt) { f32x16 d;
#pragma unroll
                    for (int r = 0; r < 16; ++r) d[r] = 0.f;
#pragma unroll
                    for (int s = 0; s < 4; ++s) if (s < 2 * (mt + 1)) { const bf16x8 af = *(const LAS bf16x8*)(Tb + (32 * mt + c32) * T_LD + 16 * s + 8 * hf), bfr = *(const LAS bf16x8*)(Vt + (32 * wave + c32) * T_LD + 16 * s + 8 * hf); d = MFMA32(af, bfr, d); }
                    bf16* up = uimg + ((size_t)(wave * 2 + mt) * 64 + lane) * 16; *(bf16x8*)up = PACK8(d, 0); *(bf16x8*)(up + 8) = PACK8(d, 1); } }
            else { const int ct = wave - 4;
#pragma unroll
                for (int nt = 0; nt < 2; ++nt) { f32x16 d;
#pragma unroll
                    for (int r = 0; r < 16; ++r) d[r] = 0.f;
#pragma unroll
                    for (int s = 0; s < 4; ++s) if (s < 2 * (nt + 1)) { const bf16x8 af = *(const LAS bf16x8*)(Kt + (32 * ct + c32) * T_LD + 16 * s + 8 * hf), bfr = *(const LAS bf16x8*)(Tb + (32 * nt + c32) * T_LD + 16 * s + 8 * hf); d = MFMA32(af, bfr, d); }
#pragma unroll
                    for (int r = 0; r < 16; ++r) d[r] = -d[r];
#pragma unroll
                    for (int sp = 0; sp < 2; ++sp) *(bf16x8*)(img + ((size_t)(FR_WN + nt * 8 + 2 * ct + sp) * 64 + lane) * 8) = PACK8(d, sp); } }
            }
            if (tid == 0) CD[chd] = egam[63];
            RAW_BAR();
        }
        }
#undef PREP_LOADRAW
    }
}

__host__ __device__ constexpr int sc_p(int k) { const int j = k - 32; return j < 12 ? j % 6 : (j - 12) % 5; }
__host__ __device__ constexpr int sc_slab(int k) { const int j = k - 32; return k < 32 ? (k >> 2) : (j < 12 ? j / 6 : 2 + (j - 12) / 5); }
__host__ __device__ constexpr int sc_kind(int k) { return k < 32 ? ((k & 3) < 2 ? 0 : 1) : ((sc_p(k) == 2 || sc_p(k) == 5) ? 1 : 2); }
__host__ __device__ constexpr int sc_idx(int k) { return k < 32 ? (k & 1) : (sc_p(k) == 0 ? 0 : sc_p(k) == 1 ? 1 : sc_p(k) == 2 ? 1 : sc_p(k) == 3 ? 2 : sc_p(k) == 4 ? 3 : 0); }
__host__ __device__ constexpr int sc_frag(int k) { return k < 32 ? (((k & 3) < 2 ? FR_WN : FR_QD) + (k & 1) * 8 + (k >> 2)) : (sc_kind(k) == 1 ? FR_AQK + sc_idx(k) * 4 + sc_slab(k) : FR_KDT + sc_idx(k) * 4 + sc_slab(k)); }
constexpr int SC_QD = 8;
constexpr int SCB = 57344, OT_OFF = 2 * SCB, OT_LD = 136, OT_BYTES = 64 * OT_LD * 2;
static_assert(OT_OFF + 2 * OT_BYTES <= 152 * 1024, "scan LDS");
__device__ __forceinline__ void phase_dn_scan(const Frame& F0, const Args& a, int layer, int unit) {
    PHASE_FRAME(F0);
    unsigned char* ws = OPQ_G(unsigned char, a.ws);
    LAS unsigned char* lds = F.lds;
    const int b = unit >> 3, h = unit & 7, lane = F.lane;
    const bf16* IMG = (const bf16*)(ws + WS_IMG); const bf16* UIMG = (const bf16*)(ws + WS_UIMG); const float* CD = (const float*)(ws + WS_CD);
    const size_t chd0 = (size_t)b * NCH * NH + h;
    if (F.wave < 4) {
#ifndef SCAN_NO_COMPUTE
        const int w = F.wave, c32 = lane & 31, hf = lane >> 5;
        f32x16 S0, S1, S2, S3;
#pragma unroll
        for (int r = 0; r < 16; ++r) { S0[r] = 0.f; S1[r] = 0.f; S2[r] = 0.f; S3[r] = 0.f; }
        const float cdl = CD[chd0 + (size_t)lane * NH];
        v4u UA[4];
        const __amdgpu_buffer_rsrc_t rsU = __builtin_amdgcn_make_buffer_rsrc((void*)(UIMG + chd0 * UIMG_ELEMS), (short)0, NCH * NH * UIMG_ELEMS * 2, 0x00020000);
        const unsigned uoff = (unsigned)((w * 2) * 64 + lane) * 32u;
#define SC_LOADU(dst, nn) do { _Pragma("unroll") for (int mt_ = 0; mt_ < 2; ++mt_) { _Pragma("unroll") for (int hh_ = 0; hh_ < 2; ++hh_) dst[2 * mt_ + hh_] = __builtin_amdgcn_raw_buffer_load_b128(rsU, uoff + (unsigned)(mt_ * 2048 + hh_ * 16), (unsigned)(nn) * (unsigned)(NH * UIMG_ELEMS * 2), 0); } } while (0)
#define SC_FRAG(bufoff, fi) (*(const LAS bf16x8*)(lds + (bufoff) + (fi) * 1024 + lane * 16))
#define SC_CHUNK(nn, U, bufoff, otoff) do { \
        f32x16 aV0, aV1, aO0, aO1; bf16x8 fq0, fq1, fq2, fq3, fq4, fq5, fq6, fq7, Sbs, Vb0, Vb1, Vb2, Vb3; \
        _Pragma("unroll") for (int q = 0; q < 4; ++q) { aV0[2 * q] = bflo(U[0][q]); aV0[2 * q + 1] = bfhi(U[0][q]); aV0[8 + 2 * q] = bflo(U[1][q]); aV0[8 + 2 * q + 1] = bfhi(U[1][q]); \
            aV1[2 * q] = bflo(U[2][q]); aV1[2 * q + 1] = bfhi(U[2][q]); aV1[8 + 2 * q] = bflo(U[3][q]); aV1[8 + 2 * q + 1] = bfhi(U[3][q]); } \
        _Pragma("unroll") for (int r = 0; r < 16; ++r) { aO0[r] = 0.f; aO1[r] = 0.f; } \
        if ((nn) + 1 < NCH) SC_LOADU(U, (nn) + 1); \
        const float cd = __builtin_bit_cast(float, __builtin_amdgcn_readlane(__builtin_bit_cast(int, cdl), (nn))); \
        fq0 = SC_FRAG(bufoff, 0); \
        fq1 = SC_FRAG(bufoff, 8); \
        fq2 = SC_FRAG(bufoff, 16); \
        fq3 = SC_FRAG(bufoff, 24); \
        fq4 = SC_FRAG(bufoff, 1); \
        fq5 = SC_FRAG(bufoff, 9); \
        fq6 = SC_FRAG(bufoff, 17); \
        fq7 = SC_FRAG(bufoff, 25); \
        Sbs = PACK8(S0, 0); \
        aV0 = MFMA32(fq0, Sbs, aV0); \
        fq0 = SC_FRAG(bufoff, 2); \
        aV1 = MFMA32(fq1, Sbs, aV1); \
        fq1 = SC_FRAG(bufoff, 10); \
        aO0 = MFMA32(fq2, Sbs, aO0); \
        fq2 = SC_FRAG(bufoff, 18); \
        aO1 = MFMA32(fq3, Sbs, aO1); \
        fq3 = SC_FRAG(bufoff, 26); \
        Sbs = PACK8(S0, 1); \
        aV0 = MFMA32(fq4, Sbs, aV0); \
        fq4 = SC_FRAG(bufoff, 3); \
        aV1 = MFMA32(fq5, Sbs, aV1); \
        fq5 = SC_FRAG(bufoff, 11); \
        aO0 = MFMA32(fq6, Sbs, aO0); \
        fq6 = SC_FRAG(bufoff, 19); \
        aO1 = MFMA32(fq7, Sbs, aO1); \
        fq7 = SC_FRAG(bufoff, 27); \
        Sbs = PACK8(S1, 0); \
        aV0 = MFMA32(fq0, Sbs, aV0); \
        fq0 = SC_FRAG(bufoff, 4); \
        aV1 = MFMA32(fq1, Sbs, aV1); \
        fq1 = SC_FRAG(bufoff, 12); \
        aO0 = MFMA32(fq2, Sbs, aO0); \
        fq2 = SC_FRAG(bufoff, 20); \
        aO1 = MFMA32(fq3, Sbs, aO1); \
        fq3 = SC_FRAG(bufoff, 28); \
        Sbs = PACK8(S1, 1); \
        aV0 = MFMA32(fq4, Sbs, aV0); \
        fq4 = SC_FRAG(bufoff, 5); \
        aV1 = MFMA32(fq5, Sbs, aV1); \
        fq5 = SC_FRAG(bufoff, 13); \
        aO0 = MFMA32(fq6, Sbs, aO0); \
        fq6 = SC_FRAG(bufoff, 21); \
        aO1 = MFMA32(fq7, Sbs, aO1); \
        fq7 = SC_FRAG(bufoff, 29); \
        Sbs = PACK8(S2, 0); \
        aV0 = MFMA32(fq0, Sbs, aV0); \
        fq0 = SC_FRAG(bufoff, 6); \
        aV1 = MFMA32(fq1, Sbs, aV1); \
        fq1 = SC_FRAG(bufoff, 14); \
        aO0 = MFMA32(fq2, Sbs, aO0); \
        fq2 = SC_FRAG(bufoff, 22); \
        aO1 = MFMA32(fq3, Sbs, aO1); \
        fq3 = SC_FRAG(bufoff, 30); \
        Sbs = PACK8(S2, 1); \
        aV0 = MFMA32(fq4, Sbs, aV0); \
        fq4 = SC_FRAG(bufoff, 7); \
        aV1 = MFMA32(fq5, Sbs, aV1); \
        fq5 = SC_FRAG(bufoff, 15); \
        aO0 = MFMA32(fq6, Sbs, aO0); \
        fq6 = SC_FRAG(bufoff, 23); \
        aO1 = MFMA32(fq7, Sbs, aO1); \
        fq7 = SC_FRAG(bufoff, 31); \
        Sbs = PACK8(S3, 0); \
        aV0 = MFMA32(fq0, Sbs, aV0); \
        fq0 = SC_FRAG(bufoff, 40); \
        aV1 = MFMA32(fq1, Sbs, aV1); \
        fq1 = SC_FRAG(bufoff, 44); \
        aO0 = MFMA32(fq2, Sbs, aO0); \
        fq2 = SC_FRAG(bufoff, 36); \
        aO1 = MFMA32(fq3, Sbs, aO1); \
        fq3 = SC_FRAG(bufoff, 48); \
        Sbs = PACK8(S3, 1); \
        aV0 = MFMA32(fq4, Sbs, aV0); \
        fq4 = SC_FRAG(bufoff, 52); \
        aV1 = MFMA32(fq5, Sbs, aV1); \
        fq5 = SC_FRAG(bufoff, 32); \
        S0 = S0 * cd; S1 = S1 * cd; S2 = S2 * cd; S3 = S3 * cd; \
        aO0 = MFMA32(fq6, Sbs, aO0); \
        fq6 = SC_FRAG(bufoff, 41); \
        aO1 = MFMA32(fq7, Sbs, aO1); \
        fq7 = SC_FRAG(bufoff, 45); \
        Vb0 = PACK8(aV0, 0); Vb1 = PACK8(aV0, 1); Vb2 = PACK8(aV1, 0); Vb3 = PACK8(aV1, 1); \
        S0 = MFMA32(fq0, Vb0, S0); \
        fq0 = SC_FRAG(bufoff, 37); \
        S1 = MFMA32(fq1, Vb0, S1); \
        fq1 = SC_FRAG(bufoff, 49); \
        aO1 = MFMA32(fq2, Vb0, aO1); \
        fq2 = SC_FRAG(bufoff, 53); \
        S2 = MFMA32(fq3, Vb0, S2); \
        fq3 = SC_FRAG(bufoff, 33); \
        S3 = MFMA32(fq4, Vb0, S3); \
        fq4 = SC_FRAG(bufoff, 42); \
        aO0 = MFMA32(fq5, Vb0, aO0); \
        fq5 = SC_FRAG(bufoff, 46); \
        S0 = MFMA32(fq6, Vb1, S0); \
        fq6 = SC_FRAG(bufoff, 38); \
        S1 = MFMA32(fq7, Vb1, S1); \
        fq7 = SC_FRAG(bufoff, 50); \
        aO1 = MFMA32(fq0, Vb1, aO1); \
        fq0 = SC_FRAG(bufoff, 54); \
        S2 = MFMA32(fq1, Vb1, S2); \
        fq1 = SC_FRAG(bufoff, 43); \
        S3 = MFMA32(fq2, Vb1, S3); \
        fq2 = SC_FRAG(bufoff, 47); \
        aO0 = MFMA32(fq3, Vb1, aO0); \
        fq3 = SC_FRAG(bufoff, 39); \
        S0 = MFMA32(fq4, Vb2, S0); \
        fq4 = SC_FRAG(bufoff, 51); \
        S1 = MFMA32(fq5, Vb2, S1); \
        fq5 = SC_FRAG(bufoff, 55); \
        aO1 = MFMA32(fq6, Vb2, aO1); \
        S2 = MFMA32(fq7, Vb2, S2); \
        S3 = MFMA32(fq0, Vb2, S3); \
        S0 = MFMA32(fq1, Vb3, S0); \
        S1 = MFMA32(fq2, Vb3, S1); \
        aO1 = MFMA32(fq3, Vb3, aO1); \
        S2 = MFMA32(fq4, Vb3, S2); \
        S3 = MFMA32(fq5, Vb3, S3); \
        _Pragma("unroll") for (int r = 0; r < 16; ++r) { \
            *(LAS bf16*)(lds + (otoff) + (((r & 3) + 8 * (r >> 2) + 4 * hf) * OT_LD + 32 * w + c32) * 2) = (bf16)(pkbf(aO0[r], 0.f) & 0xffffu); \
            *(LAS bf16*)(lds + (otoff) + ((32 + (r & 3) + 8 * (r >> 2) + 4 * hf) * OT_LD + 32 * w + c32) * 2) = (bf16)(pkbf(aO1[r], 0.f) & 0xffffu); } \
        RAW_BAR(); } while (0)
        SC_LOADU(UA, 0);
        RAW_BAR();
#pragma unroll 1
        for (int n = 0; n < NCH; n += 2) { SC_CHUNK(n, UA, 0, OT_OFF); SC_CHUNK(n + 1, UA, SCB, OT_OFF + OT_BYTES); }
#undef SC_CHUNK
#undef SC_FRAG
#undef SC_LOADU
#endif
    } else {
#ifndef SCAN_NO_HELPER
        const int ht = F.tid - 256, tok = ht >> 2, q = ht & 3;
        bf16* MIXIN = (bf16*)(ws + WS_MIXIN);
        v4u RA[14], RB[14];
        const __amdgpu_buffer_rsrc_t rsI = __builtin_amdgcn_make_buffer_rsrc((void*)(IMG + chd0 * IMG_ELEMS), (short)0, NCH * NH * IMG_ELEMS * 2, 0x00020000);
#define SH_LOADIMG(dst, nn) do { _Pragma("unroll") for (int i_ = 0; i_ < 14; ++i_) dst[i_] = __builtin_amdgcn_raw_buffer_load_b128(rsI, (unsigned)ht * 16u, (unsigned)(nn) * (unsigned)(NH * IMG_ELEMS * 2) + (unsigned)i_ * 4096u, 0); } while (0)
#define SH_STOREIMG(src, bufoff) do { LAS v4u* p_ = (LAS v4u*)(lds + (bufoff)) + ht; _Pragma("unroll") for (int i_ = 0; i_ < 14; ++i_) p_[i_ * 256] = src[i_]; } while (0)
#define SH_EPI(mm, otoff) do { const LAS v4u* op_ = (const LAS v4u*)(lds + (otoff) + (tok * OT_LD + 32 * q) * 2); \
        v4u* yp_ = (v4u*)(MIXIN + ((size_t)b * SEQ + (size_t)(mm) * CH + tok) * D + h * HD + 32 * q); \
        _Pragma("unroll") for (int i_ = 0; i_ < 4; ++i_) yp_[i_] = op_[i_]; } while (0)
#define SH_STEP(nn, Rcur, Rnext, bufnext, otprev) do { \
        if ((nn) + 2 < NCH) SH_LOADIMG(Rcur, (nn) + 2); \
        if ((nn) >= 1) SH_EPI((nn) - 1, otprev); \
        if ((nn) + 1 < NCH) SH_STOREIMG(Rnext, bufnext); \
        RAW_BAR(); } while (0)
        SH_LOADIMG(RA, 0); SH_LOADIMG(RB, 1);
        SH_STOREIMG(RA, 0);
        RAW_BAR();
#pragma unroll 1
        for (int n = 0; n < NCH; n += 2) { SH_STEP(n, RA, RB, SCB, OT_OFF + OT_BYTES); SH_STEP(n + 1, RB, RA, 0, OT_OFF); }
        SH_EPI(NCH - 1, OT_OFF + OT_BYTES);
#undef SH_STEP
#undef SH_EPI
#undef SH_STOREIMG
#undef SH_LOADIMG
#endif
    }
}

__device__ __forceinline__ void phase_dn_norm(const Frame& F0, const Args& a, int layer) {
    PHASE_FRAME(F0);
    unsigned char* ws = OPQ_G(unsigned char, a.ws);
    const bf16* PROJ = (const bf16*)(ws + WS_PROJ); bf16* MIXIN = (bf16*)(ws + WS_MIXIN);
    const int lane = F.lane, gw = F.vcu * NWAVES + F.wave, NGW = F.G * NWAVES;
    const float* nw = a.in[I_NORMW] + layer * HD + 16 * (lane & 7); f32x4 nwv[4];
#pragma unroll
    for (int i = 0; i < 4; ++i) nwv[i] = *(const f32x4*)(nw + 4 * i);
    v4u OA[2], ZA[2], OB[2], ZB[2];
#define DNN_LOAD(O_, Z_, t) do { const v4u* op_ = (const v4u*)(MIXIN + (size_t)(t) * D + 16 * lane); const v4u* zp_ = (const v4u*)(PROJ + (size_t)(t) * NPROJ + 3072 + 16 * lane); O_[0] = op_[0]; O_[1] = op_[1]; Z_[0] = zp_[0]; Z_[1] = zp_[1]; } while (0)
#define DNN_ROW(O_, Z_, t) do { float ss = 0.f; \
        _Pragma("unroll") for (int i = 0; i < 2; ++i) _Pragma("unroll") for (int j = 0; j < 4; ++j) { const float x0 = bflo(O_[i][j]), x1 = bfhi(O_[i][j]); ss += x0 * x0 + x1 * x1; } \
        ss += __shfl_xor(ss, 1); ss += __shfl_xor(ss, 2); ss += __shfl_xor(ss, 4); const float rr = 1.0f / sqrtf(ss * (1.0f / HD) + RMS_EPS); \
        v4u* yp_ = (v4u*)(MIXIN + (size_t)(t) * D + 16 * lane); \
        _Pragma("unroll") for (int i = 0; i < 2; ++i) { v4u o_; _Pragma("unroll") for (int j = 0; j < 4; ++j) { const float z0 = bflo(Z_[i][j]), z1 = bfhi(Z_[i][j]); const f32x4 nn = nwv[2 * i + (j >> 1)]; \
            o_[j] = pkbf(bflo(O_[i][j]) * rr * nn[2 * (j & 1)] * z0 * sigmoidf_(z0), bfhi(O_[i][j]) * rr * nn[2 * (j & 1) + 1] * z1 * sigmoidf_(z1)); } yp_[i] = o_; } } while (0)
    if (gw < T) DNN_LOAD(OA, ZA, gw);
#pragma unroll 1
    for (int t = gw; t < T; t += 2 * NGW) {
        if (t + NGW < T) DNN_LOAD(OB, ZB, t + NGW);
        DNN_ROW(OA, ZA, t);
        if (t + 2 * NGW < T) DNN_LOAD(OA, ZA, t + 2 * NGW);
        if (t + NGW < T) DNN_ROW(OB, ZB, t + NGW);
    }
#undef DNN_LOAD
#undef DNN_ROW
}

__device__ __forceinline__ void phase_ln1_router(const Frame& F0, const Args& a, int layer, int probe = 0, int f8 = 0) {
    PHASE_FRAME(F0);
    unsigned char* ws = OPQ_G(unsigned char, a.ws);
    LAS float* WRt = (LAS float*)F.lds;
    LAS float* GV = (LAS float*)(F.lds + RING_BYTES);
    LAS int* rowE = (LAS int*)(F.lds + AUX_OFF); LAS int* rowP = rowE + 128; LAS float* rowG = (LAS float*)(rowP + 128); LAS int* lcnt = (LAS int*)(rowG + 128); LAS int* lbase = lcnt + 16;
    const float* wr = OPQ_G(const float, a.in[I_WR]); const float* br = OPQ_G(const float, a.in[I_BR]);
    for (int idx = F.tid; idx < D * NE; idx += 512) WRt[(idx & 15) * D + (idx >> 4)] = wr[idx];
    { const float* g1 = a.in[I_LN1G] + (size_t)layer * D; const float* b1 = a.in[I_LN1B] + (size_t)layer * D; for (int i = F.tid; i < D; i += 512) { GV[i] = g1[i]; GV[D + i] = b1[i]; } }
    const bf16* PRE = (const bf16*)a.out; bf16* X1B = (bf16*)(ws + (probe ? WS_R1 : WS_X1B)); float* STATS = (float*)(ws + (probe ? WS_R1 + 70 * MiB : WS_STATS));
    int* LIST = (int*)(ws + (probe ? WS_R1 + 72 * MiB : WS_LIST)); int* TOKSLOT = (int*)(ws + (probe ? WS_R1 + 80 * MiB : WS_TOKSLOT)); float* GATEW = (float*)(ws + (probe ? WS_R1 + 82 * MiB : WS_GATEW));
    gu32* cnt = F.ctl + CW_CNT + 64 * (layer + (probe ? 2 : 0));
    const int lane = F.lane; const float brl = br[(lane >> 2) & 15];
    for (int rb = F.vcu; rb < T / 64; rb += F.G) {
        if (F.tid < 16) lcnt[F.tid] = 0;
        __syncthreads();
        v2u XA[8], XB_[8];
#define PE_LOAD(X, r) do { const GAS v2u* xr_ = (const GAS v2u*)(PRE + (size_t)(rb * 64 + F.wave * 8 + (r)) * D) + lane; _Pragma("unroll") for (int j = 0; j < 8; ++j) X[j] = xr_[64 * j]; } while (0)
#define PE_ROW(X, r) do { const int lr = F.wave * 8 + (r), row = rb * 64 + lr; unsigned gvo_ = (unsigned)(uintptr_t)GV; asm volatile("" : "+v"(gvo_)); const LAS float* GVr = (const LAS float*)(uintptr_t)gvo_; \
            f32x4 v[8]; float s = 0.f; \
            _Pragma("unroll") for (int j = 0; j < 8; ++j) { v[j] = (f32x4){bflo(X[j].x), bfhi(X[j].x), bflo(X[j].y), bfhi(X[j].y)}; s += (v[j][0] + v[j][1]) + (v[j][2] + v[j][3]); } \
            const float mean = wave_sum(s) * (1.f / D); float s2 = 0.f; \
            _Pragma("unroll") for (int j = 0; j < 8; ++j) { v[j] = v[j] - mean; s2 += (v[j][0] * v[j][0] + v[j][1] * v[j][1]) + (v[j][2] * v[j][2] + v[j][3] * v[j][3]); } \
            const float rstd = 1.f / sqrtf(wave_sum(s2) * (1.f / D) + LN_EPS); \
            if (lane == 0) { STATS[2 * row] = mean; STATS[2 * row + 1] = rstd; } \
            GAS v2u* o8 = (GAS v2u*)(X1B + (size_t)row * D) + lane; \
            float lg[16]; \
            _Pragma("unroll") for (int e = 0; e < 16; ++e) lg[e] = 0.f; \
            _Pragma("unroll") for (int j = 0; j < 8; ++j) { const f32x4 gg = *(const LAS f32x4*)(GVr + 256 * j + 4 * lane), bb = *(const LAS f32x4*)(GVr + D + 256 * j + 4 * lane); \
                v[j] = v[j] * rstd * gg + bb; \
                if (f8) ((GAS unsigned*)((GAS unsigned char*)X1B + (size_t)row * D) + lane)[64 * j] = pk4_fp8(v[j][0] * F8_XS, v[j][1] * F8_XS, v[j][2] * F8_XS, v[j][3] * F8_XS); \
                else { v2u w; w.x = pkbf(v[j][0], v[j][1]); w.y = pkbf(v[j][2], v[j][3]); o8[64 * j] = w; } \
                _Pragma("unroll") for (int e = 0; e < 16; ++e) { const f32x4 w4 = *(const LAS f32x4*)(WRt + e * D + 256 * j + 4 * lane); lg[e] += (v[j][0] * w4[0] + v[j][1] * w4[1]) + (v[j][2] * w4[2] + v[j][3] * w4[3]); } } \
              \
            float t8[8], t4[4], t2[2], t1; \
            { const bool hi = (lane & 32) != 0; _Pragma("unroll") for (int i = 0; i < 8; ++i) { const float snd = hi ? lg[i] : lg[8 + i], kp = hi ? lg[8 + i] : lg[i]; t8[i] = kp + __shfl_xor(snd, 32); } } \
            { const bool hi = (lane & 16) != 0; _Pragma("unroll") for (int i = 0; i < 4; ++i) { const float snd = hi ? t8[i] : t8[4 + i], kp = hi ? t8[4 + i] : t8[i]; t4[i] = kp + __shfl_xor(snd, 16); } } \
            { const bool hi = (lane & 8) != 0; _Pragma("unroll") for (int i = 0; i < 2; ++i) { const float snd = hi ? t4[i] : t4[2 + i], kp = hi ? t4[2 + i] : t4[i]; t2[i] = kp + __shfl_xor(snd, 8); } } \
            { const bool hi = (lane & 4) != 0; const float snd = hi ? t2[0] : t2[1], kp = hi ? t2[1] : t2[0]; t1 = kp + __shfl_xor(snd, 4); } \
            t1 += __shfl_xor(t1, 2); t1 += __shfl_xor(t1, 1); t1 += brl; \
            float lgu[16]; float mx = -3.0e38f; \
            _Pragma("unroll") for (int e = 0; e < 16; ++e) { lgu[e] = __builtin_bit_cast(float, __builtin_amdgcn_readlane(__builtin_bit_cast(int, t1), 4 * e)); mx = fmaxf(mx, lgu[e]); } \
            float p[16]; \
            _Pragma("unroll") for (int e = 0; e < 16; ++e) p[e] = __expf(lgu[e] - mx); \
            float gsc[4]; \
            _Pragma("unroll") for (int g = 0; g < 4; ++g) { const float a0 = p[4 * g], a1 = p[4 * g + 1], a2 = p[4 * g + 2], a3 = p[4 * g + 3]; \
                const float hi1 = fmaxf(a0, a1), lo1 = fminf(a0, a1), hi2 = fmaxf(a2, a3), lo2 = fminf(a2, a3); \
                gsc[g] = fmaxf(hi1, hi2) + fmaxf(fminf(hi1, hi2), fmaxf(lo1, lo2)); } \
            int gsel = 0; float best = gsc[0]; \
            _Pragma("unroll") for (int g = 1; g < 4; ++g) if (gsc[g] > best) { best = gsc[g]; gsel = g; } \
            float q[4]; \
            _Pragma("unroll") for (int j = 0; j < 4; ++j) q[j] = gsel == 0 ? p[j] : (gsel == 1 ? p[4 + j] : (gsel == 2 ? p[8 + j] : p[12 + j])); \
            int i0 = 0; float p0 = q[0]; \
            _Pragma("unroll") for (int j = 1; j < 4; ++j) if (q[j] > p0) { p0 = q[j]; i0 = j; } \
            int i1 = -1; float p1 = -1.f; \
            _Pragma("unroll") for (int j = 0; j < 4; ++j) if (j != i0 && q[j] > p1) { p1 = q[j]; i1 = j; } \
            if (lane == 0) { const int e0 = gsel * 4 + i0, e1 = gsel * 4 + i1; const float inv = 1.0f / (p0 + p1); \
                rowE[2 * lr] = e0; rowE[2 * lr + 1] = e1; rowG[2 * lr] = p0 * inv; rowG[2 * lr + 1] = p1 * inv; \
                rowP[2 * lr] = __hip_atomic_fetch_add(&lcnt[e0], 1, __ATOMIC_RELAXED, __HIP_MEMORY_SCOPE_WORKGROUP); rowP[2 * lr + 1] = __hip_atomic_fetch_add(&lcnt[e1], 1, __ATOMIC_RELAXED, __HIP_MEMORY_SCOPE_WORKGROUP); } } while (0)
        PE_LOAD(XA, 0);
#pragma unroll 1
        for (int r = 0; r < 8; r += 2) { PE_LOAD(XB_, r + 1); PE_ROW(XA, r); if (r + 2 < 8) PE_LOAD(XA, r + 2); PE_ROW(XB_, r + 1); }
#undef PE_LOAD
#undef PE_ROW
        __syncthreads();
        if (F.tid < 16) lbase[F.tid] = (int)__hip_atomic_fetch_add(cnt + F.tid, (unsigned)lcnt[F.tid], RLX_AGENT);
        __syncthreads();
        if (F.tid < 128) { const int e = rowE[F.tid], pos = lbase[e] + rowP[F.tid], tok = rb * 64 + (F.tid >> 1);
            LIST[(size_t)e * LCAP + pos] = tok; TOKSLOT[2 * tok + (F.tid & 1)] = e * LCAP + pos; GATEW[2 * tok + (F.tid & 1)] = rowG[F.tid]; }
        __syncthreads();
    }
}
__device__ __forceinline__ void moe_table(const Frame& F0, int layer) {
    PHASE_FRAME(F0);
    LAS int* tab = (LAS int*)(F.lds + AUX_OFF);
    __syncthreads();
    if (F.tid < 16) tab[32 + F.tid] = (int)__hip_atomic_load(F.ctl + CW_CNT + 64 * layer + F.tid, RLX_AGENT);
    __syncthreads();
    if (F.tid == 0) { int run = 0; for (int e = 0; e < 16; ++e) { tab[e] = run; run += (tab[32 + e] + 255) >> 8; } tab[16] = run; }
    __syncthreads();
}
__device__ __forceinline__ void phase_combine_ln2(const Frame& F0, const Args& a, int layer, int probe = 0, int f8 = 0) {
    PHASE_FRAME(F0);
    unsigned char* ws = OPQ_G(unsigned char, a.ws); const LAS int* tab = (const LAS int*)(F.lds + AUX_OFF);
    const bf16* PRE = (const bf16*)a.out; const float* STATS = (const float*)(ws + WS_STATS); const bf16* Y = (const bf16*)(ws + WS_Y); bf16* X2B = (bf16*)(ws + (probe ? WS_R1 : WS_X2B)); unsigned char* X2F8 = ws + WS_X2F8;
    const int* TOKSLOT = (const int*)(ws + WS_TOKSLOT); const float* GATEW = (const float*)(ws + WS_GATEW);
    LAS float* GV = (LAS float*)F.lds;
    { const float* g1 = a.in[I_LN1G] + (size_t)layer * D; const float* b1 = a.in[I_LN1B] + (size_t)layer * D; const float* g2 = a.in[I_LN2G] + (size_t)layer * D; const float* b2 = a.in[I_LN2B] + (size_t)layer * D;
        for (int i = F.tid; i < D; i += 512) { GV[i] = g1[i]; GV[D + i] = b1[i]; GV[2 * D + i] = g2[i]; GV[3 * D + i] = b2[i]; } }
    __syncthreads();
    const int gw = F.vcu * NWAVES + F.wave, NGW = F.G * NWAVES, nrows = (T - gw + NGW - 1) / NGW, lane = F.lane;
    for (int base = 0; base < nrows; base += 64) {
        const int nr = (nrows - base) < 64 ? (nrows - base) : 64;
        float m_mean = 0.f, m_rstd = 0.f, m_w0 = 0.f, m_w1 = 0.f; int m_y0 = 0, m_y1 = 0;
        if (lane < nr) { const int row = gw + NGW * (base + lane); m_mean = STATS[2 * row]; m_rstd = STATS[2 * row + 1]; m_w0 = GATEW[2 * row]; m_w1 = GATEW[2 * row + 1];
            const int s0 = TOKSLOT[2 * row], s1 = TOKSLOT[2 * row + 1]; m_y0 = tab[s0 / LCAP] * 256 + (s0 % LCAP); m_y1 = tab[s1 / LCAP] * 256 + (s1 % LCAP); }
        v2u XA[8], PA[8], QA[8], XB_[8], PB_[8], QB_[8];
#define PH_LOAD(X, P, Q, i) do { const int row_ = gw + NGW * (base + (i)); const size_t y0_ = (size_t)__builtin_amdgcn_readlane(m_y0, (i)), y1_ = (size_t)__builtin_amdgcn_readlane(m_y1, (i)); \
            const GAS v2u* xr_ = (const GAS v2u*)(PRE + (size_t)row_ * D) + lane; const GAS v2u* ya_ = (const GAS v2u*)(Y + y0_ * D) + lane; const GAS v2u* yb_ = (const GAS v2u*)(Y + y1_ * D) + lane; \
            _Pragma("unroll") for (int j = 0; j < 8; ++j) { X[j] = xr_[64 * j]; P[j] = ya_[64 * j]; Q[j] = yb_[64 * j]; } } while (0)
#define PH_ROW(X, P, Q, i) do { const int row_ = gw + NGW * (base + (i)); unsigned gvo_ = (unsigned)(uintptr_t)GV; asm volatile("" : "+v"(gvo_)); const LAS float* GVr = (const LAS float*)(uintptr_t)gvo_;     \
            const float mean = __builtin_bit_cast(float, __builtin_amdgcn_readlane(__builtin_bit_cast(int, m_mean), (i))), rstd = __builtin_bit_cast(float, __builtin_amdgcn_readlane(__builtin_bit_cast(int, m_rstd), (i))); \
            const float w0 = __builtin_bit_cast(float, __builtin_amdgcn_readlane(__builtin_bit_cast(int, m_w0), (i))), w1 = __builtin_bit_cast(float, __builtin_amdgcn_readlane(__builtin_bit_cast(int, m_w1), (i))); \
            f32x4 v[8]; float s = 0.f; \
            _Pragma("unroll") for (int j = 0; j < 8; ++j) { const f32x4 gg = *(const LAS f32x4*)(GVr + 256 * j + 4 * lane), bb = *(const LAS f32x4*)(GVr + D + 256 * j + 4 * lane); \
                const f32x4 x1 = ((f32x4){bflo(X[j].x), bfhi(X[j].x), bflo(X[j].y), bfhi(X[j].y)} - mean) * rstd * gg + bb; \
                f32x4 f; f[0] = w0 * bflo(P[j].x) + w1 * bflo(Q[j].x); f[1] = w0 * bfhi(P[j].x) + w1 * bfhi(Q[j].x); f[2] = w0 * bflo(P[j].y) + w1 * bflo(Q[j].y); f[3] = w0 * bfhi(P[j].y) + w1 * bfhi(Q[j].y); \
                v[j] = x1 * ALPHA + f; s += (v[j][0] + v[j][1]) + (v[j][2] + v[j][3]); } \
            const float m2 = wave_sum(s) * (1.f / D); float q = 0.f; \
            _Pragma("unroll") for (int j = 0; j < 8; ++j) { v[j] = v[j] - m2; q += (v[j][0] * v[j][0] + v[j][1] * v[j][1]) + (v[j][2] * v[j][2] + v[j][3] * v[j][3]); } \
            const float r2 = 1.f / sqrtf(wave_sum(q) * (1.f / D) + LN_EPS); \
            GAS v2u* o8 = (GAS v2u*)(X2B + (size_t)row_ * D) + lane; \
            _Pragma("unroll") for (int j = 0; j < 8; ++j) { const f32x4 gg = *(const LAS f32x4*)(GVr + 2 * D + 256 * j + 4 * lane), bb = *(const LAS f32x4*)(GVr + 3 * D + 256 * j + 4 * lane); \
                const f32x4 o = v[j] * r2 * gg + bb; v2u w; w.x = pkbf(o[0], o[1]); w.y = pkbf(o[2], o[3]); o8[64 * j] = w; \
                if (f8) ((GAS unsigned*)((GAS unsigned char*)X2F8 + (size_t)row_ * D) + lane)[64 * j] = pk4_fp8(o[0] * F8_XS, o[1] * F8_XS, o[2] * F8_XS, o[3] * F8_XS); } } while (0)
        PH_LOAD(XA, PA, QA, 0);
#pragma unroll 1
        for (int i = 0; i < nr; i += 2) {
            if (i + 1 < nr) PH_LOAD(XB_, PB_, QB_, i + 1);
            PH_ROW(XA, PA, QA, i);
            if (i + 2 < nr) PH_LOAD(XA, PA, QA, i + 2);
            if (i + 1 < nr) PH_ROW(XB_, PB_, QB_, i + 1);
        }
#undef PH_LOAD
#undef PH_ROW
    }
}

#ifndef MK_N_LAUNCHES
#define MK_N_LAUNCHES 1
#endif
constexpr int NPL = 10;
constexpr int NPHASE = 1 + NPL * DEPTH;
constexpr int N_LAUNCHES = MK_N_LAUNCHES;
static_assert(N_LAUNCHES == 1 || N_LAUNCHES == NPHASE, "MK_N_LAUNCHES is 1 or NPHASE");

#define GRID_BAR() do { if (N_LAUNCHES == 1) xcd_barrier(bar); } while (0)
#ifndef PH_MASK
#define PH_MASK 0x7ff
#endif
#define IN(k) ((((k) == 0 ? 1u : (2u << (((k) - 1) % NPL))) & (unsigned)(PH_MASK)) && lo <= (k) && (k) < hi)
#define SEAM(k) do { if (IN((k) + 1)) GRID_BAR(); } while (0)
#ifndef PROBE_DUP
#define PROBE_DUP 0
#endif
#define REPS(k) ((((k) == 0 ? 1u : (2u << (((k) - 1) % NPL))) & (unsigned)(PROBE_DUP)) ? 2 : 1)

template <int layer> __device__ __forceinline__ void layer_phases(const Frame& F, const Args& args, const XcdBarrier& bar, const int lo, const int hi) {
            const int pb = 1 + NPL * layer;
            unsigned char* ws = OPQ_G(unsigned char, args.ws);
            if (IN(pb + 0)) { for (int rep = 0; rep < REPS(pb + 0); ++rep) { if (rep) GRID_BAR();
                SchedDense S; S.init(T, NPROJ, F.G, (int)blockIdx.x, ws + WS_XB, D, (const bf16*)(ws + WS_WIN) + (size_t)layer * NPROJ * D, D);
                EpiBf16 E{(bf16*)(ws + WS_PROJ), NPROJ};
                pg8::gemm_phase<EpiBf16, SchedDense, false>(F.lds + RING_OFF, D, D, D, S, E);
                } SEAM(pb + 0);
            }
            if (IN(pb + 1)) { for (int rep = 0; rep < REPS(pb + 1); ++rep) { if (rep) GRID_BAR(); phase_dn_prep(F, args, layer); } SEAM(pb + 1); }
            if (IN(pb + 2)) { for (int rep = 0; rep < REPS(pb + 2); ++rep) { if (rep) GRID_BAR();
                if (blockIdx.x < 32 || F.G <= 32) { for (int u = blockIdx.x; u < NB * NH; u += (F.G < 32 ? F.G : 32)) { phase_dn_scan(F, args, layer, u);
#ifdef SCAN_TWICE
                    __syncthreads(); phase_dn_scan(F, args, layer, u);
#endif
                } }
                if (blockIdx.x >= 32 || F.G <= 32) { const int G2 = F.G <= 32 ? F.G : F.G - 32, c2 = F.G <= 32 ? (int)blockIdx.x : (int)blockIdx.x - 32;
                    { int t_ = threadIdx.x; asm volatile("" : "+v"(t_)); Frame Fp = F; Fp.tid = t_; Fp.lane = t_ & 63;
                      for (int L = c2; L < 256; L += G2) pool_diffs_unit(Fp, ws, L >> 2, L & 3);
                      asm volatile("s_waitcnt vmcnt(0)" ::: "memory"); __syncthreads(); }
                    { SchedPool S{G2, c2, (const char*)(ws + WS_POOLD), (const char*)((const bf16*)(ws + WS_WPOOL) + (size_t)layer * 4 * 65536)};
                      EpiPool E{(bf16*)(ws + WS_MIXIN), args.in[I_POOLS] + (size_t)layer * PW};
                      pg8::gemm_phase<EpiPool, SchedPool, false>(F.lds + RING_OFF, 256, PW, 256, S, E); }
                    { SchedDense S; S.init(T, D, G2, c2, (const bf16*)(ws + WS_PB16) + (size_t)layer * T * PLE, PLE, (const bf16*)(ws + WS_WPP) + (size_t)layer * D * PLE, PLE);
                      EpiBf16 E{(bf16*)(ws + WS_PP), D};
                      pg8::gemm_phase<EpiBf16, SchedDense, false>(F.lds + RING_OFF, PLE, PLE, PLE, S, E); }
#ifndef CONVERT_ALL_IN_PROLOGUE
                    { int t_ = threadIdx.x; asm volatile("" : "+v"(t_)); weight_items(args, ws, (LAS float*)(F.lds + RING_OFF + F.wave * 16384), t_ & 63, 1, layer, c2 * NWAVES + F.wave, G2 * NWAVES); }
#endif
                    }
                } SEAM(pb + 2);
            }
            if (IN(pb + 3)) { for (int rep = 0; rep < REPS(pb + 3); ++rep) { if (rep) GRID_BAR(); phase_dn_norm(F, args, layer); } SEAM(pb + 3); }
            if (IN(pb + 4)) { for (int rep = 0; rep < REPS(pb + 4); ++rep) { if (rep) GRID_BAR();
                SchedDense S; S.init(T, D, F.G, (int)blockIdx.x, ws + WS_MIXIN, D, (const bf16*)(ws + WS_WOUT) + (size_t)layer * D * D, D);
                EpiRes E{(const bf16*)(ws + WS_XB), (bf16*)args.out};
#ifdef PROBE_PD
                { EpiRes E2{(const bf16*)(ws + WS_XB), (bf16*)(ws + WS_R1)}; pg8::gemm_phase<EpiRes, SchedDense, false>(F.lds + RING_OFF, D, D, D, S, E2); }
#endif
                pg8::gemm_phase<EpiRes, SchedDense, false>(F.lds + RING_OFF, D, D, D, S, E);
                } SEAM(pb + 4);
            }
            if (IN(pb + 5)) { for (int rep = 0; rep < REPS(pb + 5); ++rep) { if (rep) GRID_BAR();
#ifdef PROBE_PE
                phase_ln1_router(F, args, layer, 1); __syncthreads();
#endif
                phase_ln1_router(F, args, layer, 0, FP8_LAYER(layer) ? 1 : 0); } SEAM(pb + 5); }
            if (IN(pb + 6)) { for (int rep = 0; rep < REPS(pb + 6); ++rep) { if (rep) GRID_BAR();
                moe_table(F, layer);
                if (FP8_LAYER(layer)) {
                    SchedMoe S{F.G, (int)blockIdx.x, 0, (const LAS int*)(F.lds + AUX_OFF), (const char*)(ws + WS_X1B), (const char*)(ws + WS_WGU + (size_t)layer * NE * 2048 * D * 2), (const int*)(ws + WS_LIST), 1};
                    EpiSwiglu E{(bf16*)(ws + WS_HID), FP8_PG, F8_INV};
                    pg8::gemm_phase<EpiSwiglu, SchedMoe, true, true>(F.lds + RING_OFF, D / 2, D / 2, D / 2, S, E);
                } else {
                    SchedMoe S{F.G, (int)blockIdx.x, 0, (const LAS int*)(F.lds + AUX_OFF), (const char*)(ws + WS_X1B), (const char*)((const bf16*)(ws + WS_WGU) + (size_t)layer * NE * 2048 * D), (const int*)(ws + WS_LIST), 2};
                    EpiSwiglu E{(bf16*)(ws + WS_HID)};
                    pg8::gemm_phase<EpiSwiglu, SchedMoe, true>(F.lds + RING_OFF, D, D, D, S, E);
                }
                } SEAM(pb + 6);
            }
            if (IN(pb + 7)) { for (int rep = 0; rep < REPS(pb + 7); ++rep) { if (rep) GRID_BAR();
                moe_table(F, layer);
                if (FP8_LAST && FP8_PG && layer == DEPTH - 1) {
                    SchedMoe S{F.G, (int)blockIdx.x, 1, (const LAS int*)(F.lds + AUX_OFF), (const char*)(ws + WS_HID), (const char*)(ws + WS_WD + (size_t)layer * NE * D * DE * 2), nullptr, 1};
                    EpiBf16 E{(bf16*)(ws + WS_Y), D, F8_INV};
                    pg8::gemm_phase<EpiBf16, SchedMoe, false, true>(F.lds + RING_OFF, DE / 2, DE / 2, DE / 2, S, E);
                } else {
                    SchedMoe S{F.G, (int)blockIdx.x, 1, (const LAS int*)(F.lds + AUX_OFF), (const char*)(ws + WS_HID), (const char*)((const bf16*)(ws + WS_WD) + (size_t)layer * NE * D * DE), nullptr, 2};
                    EpiBf16 E{(bf16*)(ws + WS_Y), D};
                    pg8::gemm_phase<EpiBf16, SchedMoe, false>(F.lds + RING_OFF, DE, DE, DE, S, E);
                }
                } SEAM(pb + 7);
            }
            if (IN(pb + 8)) { for (int rep = 0; rep < REPS(pb + 8); ++rep) { if (rep) GRID_BAR(); moe_table(F, layer);
#ifdef PROBE_PH
                phase_combine_ln2(F, args, layer, 1);
#endif
                phase_combine_ln2(F, args, layer, 0, (FP8_LAST && FP8_PI && layer == DEPTH - 1) ? 1 : 0); } SEAM(pb + 8); }
            if (IN(pb + 9)) { for (int rep = 0; rep < REPS(pb + 9); ++rep) { if (rep) GRID_BAR();
                if (FP8_LAST && FP8_PI && layer == DEPTH - 1) {
                    SchedDense S; S.init(T, D, F.G, (int)blockIdx.x, ws + WS_X2F8, D / 2, ws + WS_WPG + (size_t)layer * D * D * 2, D / 2);
                    EpiPle E{(const bf16*)(ws + WS_X2B), (const bf16*)(ws + WS_PP), (bf16*)(ws + WS_XB), args.out, 1, F8_INV};
                    pg8::gemm_phase<EpiPle, SchedDense, false, true>(F.lds + RING_OFF, D / 2, D / 2, D / 2, S, E);
                } else {
                    SchedDense S; S.init(T, D, F.G, (int)blockIdx.x, ws + WS_X2B, D, (const bf16*)(ws + WS_WPG) + (size_t)layer * D * D, D);
                    EpiPle E{(const bf16*)(ws + WS_X2B), (const bf16*)(ws + WS_PP), (bf16*)(ws + WS_XB), args.out, layer + 1 < DEPTH ? 0 : 1};
                    pg8::gemm_phase<EpiPle, SchedDense, false>(F.lds + RING_OFF, D, D, D, S, E);
                }
                } SEAM(pb + 9);
            }
}
__global__ void __launch_bounds__(NWAVES * 64, 2) trunk_fwd(Args args) {
    extern __shared__ __attribute__((aligned(16))) unsigned char lds[];
    Frame F;
    F.lds = (LAS unsigned char*)lds;
    F.MISC = (volatile LAS unsigned*)(F.lds + MISC_OFF);
    F.tid = threadIdx.x; F.lane = F.tid & 63; F.wave = __builtin_amdgcn_readfirstlane(F.tid >> 6);
    F.G = gridDim.x; { const int bx = blockIdx.x; F.vcu = (F.G % 8 == 0) ? (bx % 8) * (F.G / 8) + bx / 8 : bx; }
    unsigned char* ws = args.ws;
    F.ctl = (gu32*)(ws + WS_CTL);
    for (int u = F.tid; u < (LDS_BYTES - LDSCTL_OFF) / 4; u += NWAVES * 64) ((LAS unsigned*)(F.lds + LDSCTL_OFF))[u] = 0u;
    __syncthreads();
    XcdBarrier bar; bar.bar = (unsigned*)(F.ctl + CW_BAR); bar.x = 0; bar.st = nullptr;
    if (N_LAUNCHES == 1) bar = xcd_barrier_post((unsigned*)(F.ctl + CW_BAR), F.MISC + 8);
    const int lo = args.ph_lo, hi = args.ph_hi;
    if (IN(0)) { for (int rep = 0; rep < REPS(0); ++rep) { if (rep) GRID_BAR(); p0_prologue(F, args); } SEAM(0); }

    layer_phases<0>(F, args, bar, lo, hi);
    layer_phases<1>(F, args, bar, lo, hi);
    static_assert(DEPTH == 2, "layer_phases instantiations");
#undef IN
#undef SEAM
#undef GRID_BAR
}

extern "C" void kernel_launch(void* const* d_in, const int* in_sizes, int n_in, void* d_out, int out_size, void* d_ws, size_t ws_size, hipStream_t stream) {
    static int grid = 0;
    if (grid == 0) {
        if (n_in != 21 || in_sizes[0] != T * D || out_size != T * D || ws_size < WS_END) { fprintf(stderr, "kernel_launch: unexpected shapes (n_in %d, in0 %d, out %d, ws %zu); nothing launched\n", n_in, n_in > 0 ? in_sizes[0] : -1, out_size, ws_size); grid = -1; return; }
        int dev = 0, cus = 0, per_cu = 0;
        if (hipGetDevice(&dev) != hipSuccess || hipDeviceGetAttribute(&cus, hipDeviceAttributeMultiprocessorCount, dev) != hipSuccess) { grid = -1; return; }
        if (hipFuncSetAttribute((const void*)trunk_fwd, hipFuncAttributeMaxDynamicSharedMemorySize, LDS_BYTES) != hipSuccess) { fprintf(stderr, "kernel_launch: hipFuncSetAttribute failed\n"); grid = -1; return; }
        if (hipOccupancyMaxActiveBlocksPerMultiprocessor(&per_cu, (const void*)trunk_fwd, NWAVES * 64, LDS_BYTES) != hipSuccess || per_cu < 1) { fprintf(stderr, "kernel_launch: occupancy query reports %d workgroups per CU\n", per_cu); }
        (void)hipGetLastError();
        grid = cus;
    }
    if (grid < 0) return;
    if (hipMemsetAsync((char*)d_ws + WS_CTL, 0, CTL_ZERO_BYTES, stream) != hipSuccess) return;
    Args a{};
    for (int i = 0; i < 21; ++i) a.in[i] = (const float*)d_in[i];
    a.out = (float*)d_out; a.ws = (unsigned char*)d_ws;
    for (int li = 0; li < N_LAUNCHES; ++li) {
        a.ph_lo = (N_LAUNCHES == 1) ? 0 : li; a.ph_hi = (N_LAUNCHES == 1) ? NPHASE : li + 1; a.li = li; a.pad = 0;
        hipLaunchKernelGGL(trunk_fwd, dim3(grid), dim3(NWAVES * 64), LDS_BYTES, stream, a);
        const hipError_t le = hipPeekAtLastError();
        if (le != hipSuccess) { fprintf(stderr, "kernel_launch: launch %d failed: %s\n", li, hipGetErrorName(le)); break; }
    }
}
```

```cpp
#define MK_N_LAUNCHES 1
#define CONVERT_ALL_IN_PROLOGUE 1
#define FP8_ALL 1
#define FP8_PG 1
#define FP8_PI 1
#include <hip/hip_runtime.h>
#include <cstdio>
#include <cstdint>

#define GAS __attribute__((address_space(1)))
#define LAS __attribute__((address_space(3)))
typedef unsigned short bf16;
typedef unsigned v4u __attribute__((ext_vector_type(4)));
typedef unsigned v2u __attribute__((ext_vector_type(2)));
typedef float f32x4 __attribute__((ext_vector_type(4)));
typedef float f32x2 __attribute__((ext_vector_type(2)));
typedef short bf16x8 __attribute__((ext_vector_type(8)));
typedef GAS unsigned gu32;
typedef int v4i_t __attribute__((ext_vector_type(4)));
typedef int v8i_t __attribute__((ext_vector_type(8)));

namespace pg8 {
constexpr int BM = 256, BK = 64, HALF = 128, HTB = HALF * BK * 2  , STAGE_BYTES = 8 * HTB, NXCD = 8, WGM = 8;
__host__ __device__ __forceinline__ int lds_byte(int r, int c) { const int st = (r >> 4) * 2 + (c >> 5), rr = r & 15, cc = c & 31, ob = rr * 64 + cc * 2; return st * 1024 + (ob ^ (((ob >> 9) & 1) << 5)); }
__host__ __device__ __forceinline__ void stage_rc(int b, int& R, int& C) { const int st = b / 1024, sb = b % 1024, swz = sb ^ (((sb >> 9) & 1) << 5); R = (st >> 1) * 16 + swz / 64; C = (st & 1) * 32 + (swz % 64) / 2; }
__host__ __device__ __forceinline__ int perm32(int rho) { const int n = rho >> 4, i = rho & 15; return 8 * (i >> 2) + 4 * n + (i & 3); }

struct Unit { int pm, pn; const char* A; const char* B; const int* rows; int nvalid; int aux; };

__device__ __forceinline__ unsigned cvt_pk_bf16(float lo, float hi) { unsigned r; asm volatile("v_cvt_pk_bf16_f32 %0, %1, %2" : "=v"(r) : "v"(lo), "v"(hi)); return r; }

template <class Epi, class Sched, bool GATHER, bool FP8 = false>
__device__ __forceinline__ void gemm_phase(LAS unsigned char* lds, const int K, const int lda, const int ldb, const Sched& S, const Epi& E) {
    int tid_ = threadIdx.x; asm volatile("" : "+v"(tid_));
    const int tid = tid_, wid = __builtin_amdgcn_readfirstlane(tid >> 6), lane = tid & 63, wr = wid >> 2, wc = wid & 3, fr = lane & 15, fq = lane >> 4;
    const int nt = K / BK;
    unsigned voffA[2], voffB[2]; int RA[2], CA[2];
#pragma unroll
    for (int i = 0; i < 2; ++i) { int R, C; stage_rc(tid * 16 + i * 8192, R, C); const int Rb = Epi::PERM ? ((R & ~31) + perm32(R & 31)) : R;
        RA[i] = R; CA[i] = C; voffA[i] = (unsigned)(R * lda + C) * 2u; voffB[i] = (unsigned)(Rb * ldb + C) * 2u; }
    unsigned gA[2][2], gN[2][2];
    const size_t kstep = (size_t)(BK * 2);
    const size_t hstepA = GATHER ? 0 : (size_t)HALF * lda * 2, hstepB = (size_t)HALF * ldb * 2;
    const unsigned ldsw = (unsigned)wid * 1024u;
    const int aoff = lds_byte(wr * 64 + fr, fq * 8), boff = lds_byte(wc * 32 + fr, fq * 8);
#define PG8_SA(b, h) (((b) * 2 + (h)) * HTB)
#define PG8_SB(b, h) ((4 + (b) * 2 + (h)) * HTB)
#define PG8_STAGE_B(bufoff, gbase) do { _Pragma("unroll") for (int _i = 0; _i < 2; ++_i) \
        __builtin_amdgcn_global_load_lds((const unsigned*)((const char*)(gbase) + voffB[_i]), (LAS unsigned*)(lds + (bufoff) + ldsw + _i * 8192), 16, 0, 0); } while (0)
#define PG8_STAGE_A(bufoff, gbase, h) do { _Pragma("unroll") for (int _i = 0; _i < 2; ++_i) \
        __builtin_amdgcn_global_load_lds((const unsigned*)((const char*)(gbase) + (GATHER ? gA[h][_i] : voffA[_i]) + (h) * hstepA), (LAS unsigned*)(lds + (bufoff) + ldsw + _i * 8192), 16, 0, 0); } while (0)
#define PG8_CAT(x0, x1) __builtin_shufflevector(__builtin_bit_cast(v4i_t, (x0)), __builtin_bit_cast(v4i_t, (x1)), 0, 1, 2, 3, 4, 5, 6, 7)
#define PG8_LDA(dst, b, h) do { _Pragma("unroll") for (int m = 0; m < 4; ++m) { if constexpr (FP8) dst##8[m] = PG8_CAT(*(const LAS bf16x8*)(lds + PG8_SA(b, h) + aoff + m * 2048), *(const LAS bf16x8*)(lds + PG8_SA(b, h) + aoff + m * 2048 + 1024)); \
        else { _Pragma("unroll") for (int k = 0; k < 2; ++k) dst[m][k] = *(const LAS bf16x8*)(lds + PG8_SA(b, h) + aoff + m * 2048 + k * 1024); } } } while (0)
#define PG8_LDB(dst, b, h) do { _Pragma("unroll") for (int n = 0; n < 2; ++n) { if constexpr (FP8) dst##8[n] = PG8_CAT(*(const LAS bf16x8*)(lds + PG8_SB(b, h) + boff + n * 2048), *(const LAS bf16x8*)(lds + PG8_SB(b, h) + boff + n * 2048 + 1024)); \
        else { _Pragma("unroll") for (int k = 0; k < 2; ++k) dst[n][k] = *(const LAS bf16x8*)(lds + PG8_SB(b, h) + boff + n * 2048 + k * 1024); } } } while (0)
#define PG8_MMA(ai, bj, At, Bt) do { __builtin_amdgcn_s_setprio(1); \
        if constexpr (FP8) { _Pragma("unroll") for (int m = 0; m < 4; ++m) _Pragma("unroll") for (int n = 0; n < 2; ++n) \
            asm volatile("v_mfma_scale_f32_16x16x128_f8f6f4 %0, %1, %2, %0, %3, %3 op_sel_hi:[0,0,0]" : "+v"(acc[ai][bj][m][n]) : "v"(Bt##8[n]), "v"(At##8[m]), "v"(f8scale)); } \
        else { _Pragma("unroll") for (int m = 0; m < 4; ++m) _Pragma("unroll") for (int n = 0; n < 2; ++n) _Pragma("unroll") for (int k = 0; k < 2; ++k) \
            acc[ai][bj][m][n] = __builtin_amdgcn_mfma_f32_16x16x32_bf16(Bt[n][k], At[m][k], acc[ai][bj][m][n], 0, 0, 0); } \
        __builtin_amdgcn_s_setprio(0); } while (0)
#define PG8_WAIT_V(n) asm volatile("s_waitcnt vmcnt(" #n ")" ::: "memory")
#define PG8_WAIT_L(n) asm volatile("s_waitcnt lgkmcnt(" #n ")" ::: "memory")
#define PG8_BAR __builtin_amdgcn_s_barrier()
#define PG8_SCHED __builtin_amdgcn_sched_barrier(0)
#define PG8_GLOAD(dst, u) do { _Pragma("unroll") for (int _h = 0; _h < 2; ++_h) _Pragma("unroll") for (int _i = 0; _i < 2; ++_i) { const int _r = _h * HALF + RA[_i]; \
        const int _t = (_r < (u).nvalid) ? (u).rows[_r] : 0; dst[_h][_i] = (unsigned)(_t * lda + CA[_i]) * 2u; } } while (0)
    Unit cur, nxt; int ui = 0;
    if (!S.next(0, cur)) return;
    f32x4 acc[2][2][4][2];
#pragma unroll
    for (int a = 0; a < 2; ++a)
#pragma unroll
        for (int b = 0; b < 2; ++b)
#pragma unroll
            for (int m = 0; m < 4; ++m)
#pragma unroll
                for (int n = 0; n < 2; ++n) acc[a][b][m][n] = (f32x4){0.f, 0.f, 0.f, 0.f};
    const unsigned f8scale = 0x7f7f7f7fu;
    bf16x8 At[4][2], B0[2][2], B1[2][2]; v8i_t At8[4], B08[2], B18[2];
    const char* cA = cur.A; const char* cB = cur.B;
    if constexpr (GATHER) { PG8_GLOAD(gA, cur); PG8_WAIT_V(0); }
    PG8_STAGE_B(PG8_SB(0, 0), cB); PG8_STAGE_B(PG8_SB(0, 1), cB + hstepB); PG8_STAGE_A(PG8_SA(0, 0), cA, 0); PG8_STAGE_A(PG8_SA(0, 1), cA, 1);
    if (wr == 1) PG8_BAR;
    PG8_WAIT_V(2); PG8_BAR;
    PG8_STAGE_B(PG8_SB(1, 0), cB + kstep); PG8_STAGE_A(PG8_SA(1, 0), cA + kstep, 0); PG8_STAGE_B(PG8_SB(1, 1), cB + hstepB + kstep);
    PG8_WAIT_V(6); PG8_BAR;
    for (;;) {
        const bool has_next = S.next(ui + 1, nxt);
        const char* nA = has_next ? nxt.A : cA; const char* nB = has_next ? nxt.B : cB;
        if constexpr (GATHER) { if (has_next) { PG8_GLOAD(gN, nxt); } else {
#pragma unroll
            for (int h = 0; h < 2; ++h)
#pragma unroll
                for (int i = 0; i < 2; ++i) gN[h][i] = gA[h][i]; } }
#pragma unroll 1
        for (int t = 0; t < nt; t += 2) {
            const bool last = (t == nt - 2);
            const char* a1 = cA + (size_t)(t + 1) * kstep;
            const char* a2 = last ? nA : cA + (size_t)(t + 2) * kstep; const char* b2 = last ? nB : cB + (size_t)(t + 2) * kstep;
            const char* a3 = a2 + kstep; const char* b3 = b2 + kstep;
            PG8_LDB(B0, 0, 0); PG8_LDB(B1, 0, 1); PG8_SCHED; PG8_LDA(At, 0, 0); PG8_STAGE_A(PG8_SA(1, 1), a1, 1);
            if constexpr (GATHER) { if (last) {
#pragma unroll
                for (int h = 0; h < 2; ++h)
#pragma unroll
                    for (int i = 0; i < 2; ++i) gA[h][i] = gN[h][i]; } }
            PG8_WAIT_V(8); PG8_WAIT_L(0); PG8_BAR; PG8_MMA(0, 0, At, B0); PG8_MMA(0, 1, At, B1); PG8_BAR; PG8_SCHED;
            PG8_LDA(At, 0, 1); PG8_STAGE_B(PG8_SB(0, 0), b2); PG8_STAGE_B(PG8_SB(0, 1), b2 + hstepB); PG8_STAGE_A(PG8_SA(0, 0), a2, 0);
            PG8_WAIT_V(8); PG8_WAIT_L(0); PG8_BAR; PG8_MMA(1, 0, At, B0); PG8_MMA(1, 1, At, B1); PG8_BAR; PG8_SCHED;
            PG8_LDB(B0, 1, 0); PG8_LDB(B1, 1, 1); PG8_SCHED; PG8_LDA(At, 1, 0); PG8_STAGE_A(PG8_SA(0, 1), a2, 1);
            PG8_WAIT_V(8); PG8_WAIT_L(0); PG8_BAR; PG8_MMA(0, 0, At, B0); PG8_MMA(0, 1, At, B1); PG8_BAR; PG8_SCHED;
            PG8_LDA(At, 1, 1); PG8_STAGE_B(PG8_SB(1, 0), b3); PG8_STAGE_B(PG8_SB(1, 1), b3 + hstepB); PG8_STAGE_A(PG8_SA(1, 0), a3, 0);
            PG8_WAIT_V(8); PG8_WAIT_L(0); PG8_BAR; PG8_MMA(1, 0, At, B0); PG8_MMA(1, 1, At, B1); PG8_BAR; PG8_SCHED;
        }
        if (wr == 0) PG8_BAR;
        if constexpr (FP8) asm volatile("s_nop 15\n\ts_nop 15\n\ts_nop 15" ::: "memory");
        E(acc, cur, wr, wc, fr, fq);
        if (!has_next) break;
#pragma unroll
        for (int a = 0; a < 2; ++a)
#pragma unroll
            for (int b = 0; b < 2; ++b)
#pragma unroll
                for (int m = 0; m < 4; ++m)
#pragma unroll
                    for (int n = 0; n < 2; ++n) acc[a][b][m][n] = (f32x4){0.f, 0.f, 0.f, 0.f};
        cur = nxt; cA = nA; cB = nB; ++ui;
        if (wr == 1) PG8_BAR;
    }
    PG8_WAIT_V(0);
    PG8_BAR;
#undef PG8_SA
#undef PG8_SB
#undef PG8_STAGE_A
#undef PG8_STAGE_B
#undef PG8_LDA
#undef PG8_LDB
#undef PG8_MMA
#undef PG8_CAT
#undef PG8_WAIT_V
#undef PG8_WAIT_L
#undef PG8_BAR
#undef PG8_SCHED
#undef PG8_GLOAD
}
}

constexpr int NB = 4, SEQ = 4096, D = 2048, DEPTH = 2;
constexpr int T = NB * SEQ;
constexpr int NH = 8, HD = 128, DNW = 1024, CH = 64, NCH = SEQ / CH;
constexpr int PW = 1024, PG_DIM = 256;
constexpr int IN_COLS = 5136, NPROJ = 5120;
constexpr int NE = 16, DE = 1024, PLE = 256;
constexpr float ALPHA = 1.4142135623730951f;
constexpr float LN_EPS = 1e-5f, RMS_EPS = 1e-6f;
constexpr int LCAP = T;
constexpr int MAXTILES = 2 * T / 256 + NE;

constexpr size_t MiB = 1u << 20;
constexpr size_t WS_CTL = 0, CTL_ZERO_BYTES = 64 * 1024;
constexpr size_t WS_LIST = 2 * MiB;
constexpr size_t WS_TOKSLOT = 3 * MiB, WS_GATEW = WS_TOKSLOT + 128 * 1024, WS_STATS = WS_GATEW + 128 * 1024, WS_CD = WS_STATS + 128 * 1024, WS_WBA = WS_CD + 128 * 1024;
constexpr size_t WS_WIN = 4 * MiB, WS_WOUT = 44 * MiB, WS_WPG = 60 * MiB, WS_WPP = 76 * MiB, WS_WPOOL = 78 * MiB, WS_WGU = 80 * MiB, WS_WD = 336 * MiB, WS_PB16 = 464 * MiB;
constexpr size_t WS_XB = 480 * MiB, WS_R1 = 544 * MiB, WS_R2 = 704 * MiB, WS_R4 = 848 * MiB, WS_R5 = 944 * MiB, WS_END = 1008 * MiB;
constexpr size_t WS_PROJ = WS_R1, WS_HID = WS_R1;
constexpr size_t WS_Y = WS_R2;
constexpr size_t WS_POOLD = WS_R4, WS_PP = WS_R4 + 32 * MiB, WS_X1B = WS_R2;
constexpr size_t WS_MIXIN = WS_R5, WS_X2B = WS_R5;
constexpr size_t WS_X2F8 = WS_R1 + 96 * MiB;
static_assert((size_t)MAXTILES * 256 * 2048 * 2 <= 144 * MiB && (size_t)MAXTILES * 256 * 1024 * 2 <= 160 * MiB, "MoE row buffers");
constexpr int CW_TMO = 0, CW_CODE = 1, CW_CNT = 64  , CW_BAR = 4096;

constexpr int RING_OFF = 0, RING_BYTES = 131072;
constexpr int LDSCTL_OFF = 152 * 1024, MISC_OFF = LDSCTL_OFF + 320;
constexpr int AUX_OFF = LDSCTL_OFF + 1024;
constexpr int LDS_BYTES = 163840;
constexpr int NWAVES = 8;

#define RLX_AGENT __ATOMIC_RELAXED, __HIP_MEMORY_SCOPE_AGENT
#define LDS_WAIT() asm volatile("s_waitcnt lgkmcnt(0)" ::: "memory")
#define VM_WAIT() asm volatile("s_waitcnt vmcnt(0)" ::: "memory")
__device__ __forceinline__ unsigned f2bf(float f) { unsigned u = __builtin_bit_cast(unsigned, f); return (u + 0x7fffu + ((u >> 16) & 1u)) >> 16; }
__device__ __forceinline__ unsigned pk2(float lo, float hi) { return f2bf(lo) | (f2bf(hi) << 16); }
typedef __bf16 bf2_t __attribute__((ext_vector_type(2)));
__device__ __forceinline__ unsigned pkbf(float lo, float hi) { const f32x2 v = {lo, hi}; return __builtin_bit_cast(unsigned, __builtin_convertvector(v, bf2_t)); }
constexpr float F8_XS = 16.0f, F8_WS = 256.0f, F8_INV = 1.0f / 4096.0f;
__device__ __forceinline__ float f8clamp(float x) { return fminf(fmaxf(x, -448.0f), 448.0f); }
__device__ __forceinline__ unsigned pk4_fp8(float a, float b, float c, float d) { unsigned w = 0u; w = (unsigned)__builtin_amdgcn_cvt_pk_fp8_f32(f8clamp(a), f8clamp(b), (int)w, false); w = (unsigned)__builtin_amdgcn_cvt_pk_fp8_f32(f8clamp(c), f8clamp(d), (int)w, true); return w; }
__device__ __forceinline__ float bf2f(unsigned short b) { return __builtin_bit_cast(float, ((unsigned)b) << 16); }
__device__ __forceinline__ float bflo(unsigned w) { return __builtin_bit_cast(float, w << 16); }
__device__ __forceinline__ float bfhi(unsigned w) { return __builtin_bit_cast(float, w & 0xffff0000u); }
__device__ __forceinline__ float sigmoidf_(float x) { return __builtin_amdgcn_rcpf(1.0f + __expf(-x)); }
__device__ __forceinline__ float wave_sum(float v) {
#pragma unroll
    for (int o = 1; o < 64; o <<= 1) v += __shfl_xor(v, o);
    return v;
}
#define XB_TMO      128
#define XB_XCNT(j)  (256  + 64 * (j))
#define XB_XSUB(j)  (1280 + 64 * (j))
#define XB_XGEN(j)  (2304 + 64 * (j))
#define XB_TOP      3328
#define XB_TOPGEN   3392
#define XCD_BAR_WORDS 3456
#define XB_SPIN_CAP (1u << 18)

__device__ __forceinline__ unsigned xb_ld(unsigned* p)              { return __hip_atomic_load(p, __ATOMIC_RELAXED, __HIP_MEMORY_SCOPE_AGENT); }
__device__ __forceinline__ unsigned xb_add(unsigned* p, unsigned v) { return __hip_atomic_fetch_add(p, v, __ATOMIC_RELAXED, __HIP_MEMORY_SCOPE_AGENT); }
__device__ __forceinline__ unsigned xb_xcc_id() { return (unsigned)__builtin_amdgcn_s_getreg((3 << 11) | 20) & 0xFu; }
#define XB_SPIN(cond, bar) do { unsigned _sp = 0; while (cond) { __builtin_amdgcn_s_sleep(1); \
    if ((++_sp & 255u) == 0u) { if (xb_ld(&(bar)[XB_TMO])) break; if (_sp > XB_SPIN_CAP) { atomicAdd(&(bar)[XB_TMO], 1u); break; } } } } while (0)

struct XcdBarrier {
    unsigned* bar; unsigned x;
    volatile LAS unsigned* st;
};

__device__ __forceinline__ XcdBarrier xcd_barrier_post(unsigned* bar, volatile LAS unsigned* st) {
    XcdBarrier b; b.bar = bar; b.x = xb_xcc_id(); b.st = st;
    if (threadIdx.x == 0) (void)xb_add(&bar[XB_XCNT(b.x)], 1u);
    return b;
}
__device__ __forceinline__ void xcd_barrier_complete(unsigned* bar, unsigned x, unsigned& nloc, unsigned& nx) {
    const unsigned G = gridDim.x * gridDim.y * gridDim.z;
    unsigned sum, cnt, mine, sp = 0u;
    for (;;) {
        sum = 0u; cnt = 0u; mine = 0u;
#pragma unroll
        for (unsigned j = 0; j < 16; ++j) { const unsigned c = xb_ld(&bar[XB_XCNT(j)]); sum += c; cnt += (c > 0u) ? 1u : 0u; mine = (j == x) ? c : mine; }
        if (sum == G) break;
        __builtin_amdgcn_s_sleep(1);
        if ((++sp & 255u) == 0u) { if (xb_ld(&bar[XB_TMO])) break; if (sp > XB_SPIN_CAP) { atomicAdd(&bar[XB_TMO], 1u); break; } }
    }
    nloc = mine > 0u ? mine : 1u; nx = cnt > 0u ? cnt : 1u;
}

__device__ __forceinline__ void xcd_barrier(const XcdBarrier& b) {
    asm volatile("s_waitcnt vmcnt(0)" ::: "memory");
    __syncthreads();
    if (threadIdx.x == 0) {
        unsigned* bar = b.bar;
        __builtin_amdgcn_s_waitcnt(0);
        unsigned nloc = b.st[0], nx = b.st[1];
        if (nloc == 0u) { xcd_barrier_complete(bar, b.x, nloc, nx); b.st[0] = nloc; b.st[1] = nx; }
        const unsigned old = xb_add(&bar[XB_XSUB(b.x)], 1u);
        const unsigned gen = old / nloc;
        if (old + 1u == (gen + 1u) * nloc) {
            __builtin_amdgcn_fence(__ATOMIC_RELEASE, "agent");
            asm volatile("s_waitcnt vmcnt(0)" ::: "memory");
            const unsigned og = xb_add(&bar[XB_TOP], 1u);
            const unsigned tg = og / nx;
            if (og + 1u == (tg + 1u) * nx) xb_add(&bar[XB_TOPGEN], 1u);
            else XB_SPIN(xb_ld(&bar[XB_TOPGEN]) == tg, bar);
            __builtin_amdgcn_fence(__ATOMIC_ACQUIRE, "agent");
            xb_add(&bar[XB_XGEN(b.x)], 1u);
            asm volatile("s_waitcnt vmcnt(0)" ::: "memory");
        } else {
            XB_SPIN(xb_ld(&bar[XB_XGEN(b.x)]) == gen, bar);
            __builtin_amdgcn_fence(__ATOMIC_ACQUIRE, "agent");
            asm volatile("s_waitcnt vmcnt(0)" ::: "memory");
        }
    }
    __syncthreads();
}

struct Args { const float* in[21]; float* out; unsigned char* ws; int ph_lo, ph_hi, li, pad; };
enum { I_X = 0, I_P, I_WIN, I_CONVW, I_ALOG, I_DTB, I_NORMW, I_POOLW, I_POOLS, I_WOUT, I_LN1G, I_LN1B, I_WR, I_BR, I_WEG, I_WEU, I_WED, I_LN2G, I_LN2B, I_WPP, I_WPG };
struct Frame {
    LAS unsigned char* lds;
    volatile LAS unsigned* MISC;
    gu32* ctl;
    int tid, lane, wave, vcu, G;
};

#ifndef FP8_LAST
#define FP8_LAST 1
#endif
#ifndef FP8_PG
#define FP8_PG 0
#endif
#ifndef FP8_ALL
#define FP8_ALL 0
#endif
#define FP8_LAYER(l) (FP8_LAST && (FP8_ALL || (l) == DEPTH - 1))
#ifndef FP8_PI
#define FP8_PI 0
#endif
#define PHASE_FRAME(F0) Frame F = F0; { int t_ = threadIdx.x; asm volatile("" : "+v"(t_)); F.tid = t_; F.lane = t_ & 63; }
#define OPQ_S(p) asm volatile("" : "+s"(p))
#define OPQ_G(T, expr) ({ GAS T* g_ = (GAS T*)(expr); asm volatile("" : "+s"(g_)); (T*)g_; })
struct SchedDense {
    int nM, nN, nwg, G, c; const char* A; const char* B; size_t astep, bstep;
    __device__ __forceinline__ void init(int M, int N, int G_, int c_, const void* A_, int lda, const void* B_, int ldb) { nM = M / 256; nN = N / 256; nwg = nM * nN; G = G_; c = c_;
        A = (const char*)A_; B = (const char*)B_; astep = (size_t)256 * lda * 2; bstep = (size_t)256 * ldb * 2; }
    __device__ __forceinline__ bool next(int i, pg8::Unit& u) const {
        const long L = (long)i * G + c; if (L >= nwg) return false;
        int wgid = (int)L; { const int q = nwg / 8, r = nwg % 8, xcd = wgid % 8, off = wgid / 8; wgid = (xcd < r ? xcd * (q + 1) : r * (q + 1) + (xcd - r) * q) + off; }
        const int nig = 8 * nN, gid = wgid / nig, fm = gid * 8, gsz = (nM - fm) < 8 ? (nM - fm) : 8;
        u.pm = fm + ((wgid % nig) % gsz); u.pn = (wgid % nig) / gsz;
        u.A = A + (size_t)u.pm * astep; u.B = B + (size_t)u.pn * bstep; u.rows = nullptr; u.nvalid = 256; u.aux = 0; return true;
    }
};
struct SchedPool {
    int G, c; const char* A; const char* B;
    __device__ __forceinline__ bool next(int i, pg8::Unit& u) const {
        const int L = i * G + c; if (L >= 256) return false;
        u.pm = L >> 2; u.pn = L & 3; u.A = A + ((size_t)u.pm * 256 * PW + u.pn * 256) * 2; u.B = B + (size_t)u.pn * 65536 * 2; u.rows = nullptr; u.nvalid = 256; u.aux = 0; return true;
    }
};
struct SchedMoe {
    int G, c, mode; const LAS int* tab; const char* A; const char* B; const int* list; int esz;
    __device__ __forceinline__ bool next(int i, pg8::Unit& u) const {
        const int L = i * G + c, rt = L >> 3, pn = L & 7;
        const int ntiles = __builtin_amdgcn_readfirstlane(tab[16]); if (rt >= ntiles) return false;
        int e = 0;
#pragma unroll
        for (int k = 1; k < 16; ++k) { const int ts = __builtin_amdgcn_readfirstlane(tab[k]); if (rt >= ts) e = k; }
        const int ts = __builtin_amdgcn_readfirstlane(tab[e]), cn = __builtin_amdgcn_readfirstlane(tab[32 + e]);
        const int r0 = (rt - ts) * 256;
        u.pm = rt; u.pn = pn; u.aux = e;
        if (mode == 0) { u.A = A; u.rows = list + (size_t)e * LCAP + r0; u.nvalid = (cn - r0) < 256 ? (cn - r0) : 256; u.B = B + ((size_t)e * 2048 + pn * 256) * 2048 * esz; }
        else { u.A = A + (size_t)rt * 256 * DE * esz; u.rows = nullptr; u.nvalid = 256; u.B = B + ((size_t)e * 2048 + pn * 256) * DE * esz; }
        return true;
    }
};

using pg8::cvt_pk_bf16;
struct EpiBf16 {
    static constexpr bool PERM = true; bf16* O; int ldc; float scale = 1.0f;
    __device__ __forceinline__ void operator()(const f32x4 (&acc)[2][2][4][2], const pg8::Unit& u, int wr, int wc, int fr, int fq) const {
        const int row0 = u.pm * 256 + wr * 64 + fr, col0 = u.pn * 256 + wc * 32 + 8 * fq;
#pragma unroll
        for (int ai = 0; ai < 2; ++ai)
#pragma unroll
            for (int m = 0; m < 4; ++m) { bf16* rowp = O + (size_t)(row0 + ai * 128 + m * 16) * ldc + col0;
#pragma unroll
                for (int bj = 0; bj < 2; ++bj) { const f32x4 v0 = acc[ai][bj][m][0] * scale, v1 = acc[ai][bj][m][1] * scale;
                    v4u w; w.x = cvt_pk_bf16(v0[0], v0[1]); w.y = cvt_pk_bf16(v0[2], v0[3]); w.z = cvt_pk_bf16(v1[0], v1[1]); w.w = cvt_pk_bf16(v1[2], v1[3]);
                    *(v4u*)(rowp + bj * 128) = w; } }
    }
};
struct EpiPool {
    static constexpr bool PERM = true; bf16* O; const float* scale;
    __device__ __forceinline__ void operator()(const f32x4 (&acc)[2][2][4][2], const pg8::Unit& u, int wr, int wc, int fr, int fq) const {
        const int row0 = u.pm * 256 + wr * 64 + fr, cg = u.pn * 256 + wc * 32 + 8 * fq;
        f32x4 sv[2][2];
#pragma unroll
        for (int bj = 0; bj < 2; ++bj) { sv[bj][0] = *(const f32x4*)(scale + cg + bj * 128); sv[bj][1] = *(const f32x4*)(scale + cg + bj * 128 + 4); }
#pragma unroll
        for (int ai = 0; ai < 2; ++ai)
#pragma unroll
            for (int m = 0; m < 4; ++m) { bf16* rowp = O + (size_t)(row0 + ai * 128 + m * 16) * D + DNW + cg;
#pragma unroll
                for (int bj = 0; bj < 2; ++bj) { const f32x4 v0 = acc[ai][bj][m][0] * sv[bj][0], v1 = acc[ai][bj][m][1] * sv[bj][1];
                    v4u w; w.x = cvt_pk_bf16(v0[0], v0[1]); w.y = cvt_pk_bf16(v0[2], v0[3]); w.z = cvt_pk_bf16(v1[0], v1[1]); w.w = cvt_pk_bf16(v1[2], v1[3]);
                    *(v4u*)(rowp + bj * 128) = w; } }
    }
};
struct EpiRes {
    static constexpr bool PERM = true; const bf16* XB; bf16* PRE;
    __device__ __forceinline__ void operator()(const f32x4 (&acc)[2][2][4][2], const pg8::Unit& u, int wr, int wc, int fr, int fq) const {
        const int row0 = u.pm * 256 + wr * 64 + fr, col0 = u.pn * 256 + wc * 32 + 8 * fq;
#pragma unroll
        for (int ai = 0; ai < 2; ++ai)
#pragma unroll
            for (int m = 0; m < 4; ++m) { const size_t off0 = (size_t)(row0 + ai * 128 + m * 16) * D + col0;
#pragma unroll
                for (int bj = 0; bj < 2; ++bj) { const size_t off = off0 + bj * 128; const v4u x = *(const v4u*)(XB + off); const f32x4 a0 = acc[ai][bj][m][0], a1 = acc[ai][bj][m][1];
                    v4u w; w.x = cvt_pk_bf16(bflo(x.x) * ALPHA + a0[0], bfhi(x.x) * ALPHA + a0[1]); w.y = cvt_pk_bf16(bflo(x.y) * ALPHA + a0[2], bfhi(x.y) * ALPHA + a0[3]);
                    w.z = cvt_pk_bf16(bflo(x.z) * ALPHA + a1[0], bfhi(x.z) * ALPHA + a1[1]); w.w = cvt_pk_bf16(bflo(x.w) * ALPHA + a1[2], bfhi(x.w) * ALPHA + a1[3]);
                    *(v4u*)(PRE + off) = w; } }
    }
};
struct EpiSwiglu {
    static constexpr bool PERM = true; bf16* O; int f8 = 0; float ascale = 1.0f;
    __device__ __forceinline__ void operator()(const f32x4 (&acc)[2][2][4][2], const pg8::Unit& u, int wr, int wc, int fr, int fq) const {
        const int row0 = u.pm * 256 + wr * 64 + fr, col0 = u.pn * 128 + wc * 32 + 8 * fq;
#pragma unroll
        for (int ai = 0; ai < 2; ++ai)
#pragma unroll
            for (int m = 0; m < 4; ++m) { bf16* rowp = O + (size_t)(row0 + ai * 128 + m * 16) * DE + col0;
                float h[8];
#pragma unroll
                for (int n = 0; n < 2; ++n)
#pragma unroll
                    for (int j = 0; j < 4; ++j) { const float g = acc[ai][0][m][n][j] * ascale, up = acc[ai][1][m][n][j] * ascale; h[4 * n + j] = g * sigmoidf_(g) * up; }
                if (f8) { v2u w8; w8.x = pk4_fp8(h[0] * F8_XS, h[1] * F8_XS, h[2] * F8_XS, h[3] * F8_XS); w8.y = pk4_fp8(h[4] * F8_XS, h[5] * F8_XS, h[6] * F8_XS, h[7] * F8_XS);
                    *(v2u*)((unsigned char*)O + (size_t)(row0 + ai * 128 + m * 16) * DE + col0) = w8; }
                else { v4u w; w.x = cvt_pk_bf16(h[0], h[1]); w.y = cvt_pk_bf16(h[2], h[3]); w.z = cvt_pk_bf16(h[4], h[5]); w.w = cvt_pk_bf16(h[6], h[7]);
                *(v4u*)rowp = w; } }
    }
};
struct EpiPle {
    static constexpr bool PERM = true; const bf16* X2B; const bf16* PP; bf16* XB; float* OUT; int last; float ascale = 1.0f;
    __device__ __forceinline__ void operator()(const f32x4 (&acc)[2][2][4][2], const pg8::Unit& u, int wr, int wc, int fr, int fq) const {
        const int row0 = u.pm * 256 + wr * 64 + fr, col0 = u.pn * 256 + wc * 32 + 8 * fq;
#pragma unroll
        for (int ai = 0; ai < 2; ++ai)
#pragma unroll
            for (int m = 0; m < 4; ++m) { const size_t off0 = (size_t)(row0 + ai * 128 + m * 16) * D + col0;
#pragma unroll
                for (int bj = 0; bj < 2; ++bj) { const size_t off = off0 + bj * 128;
                    const v4u xx = *(const v4u*)(X2B + off), pp = *(const v4u*)(PP + off);
                    const f32x4 a0 = acc[ai][bj][m][0] * ascale, a1 = acc[ai][bj][m][1] * ascale;
                    f32x4 o0, o1;
                    o0[0] = bflo(xx.x) + sigmoidf_(a0[0]) * bflo(pp.x); o0[1] = bfhi(xx.x) + sigmoidf_(a0[1]) * bfhi(pp.x); o0[2] = bflo(xx.y) + sigmoidf_(a0[2]) * bflo(pp.y); o0[3] = bfhi(xx.y) + sigmoidf_(a0[3]) * bfhi(pp.y);
                    o1[0] = bflo(xx.z) + sigmoidf_(a1[0]) * bflo(pp.z); o1[1] = bfhi(xx.z) + sigmoidf_(a1[1]) * bfhi(pp.z); o1[2] = bflo(xx.w) + sigmoidf_(a1[2]) * bflo(pp.w); o1[3] = bfhi(xx.w) + sigmoidf_(a1[3]) * bfhi(pp.w);
                    if (last) { *(f32x4*)(OUT + off) = o0; *(f32x4*)(OUT + off + 4) = o1; }
                    else { v4u w; w.x = cvt_pk_bf16(o0[0], o0[1]); w.y = cvt_pk_bf16(o0[2], o0[3]); w.z = cvt_pk_bf16(o1[0], o1[1]); w.w = cvt_pk_bf16(o1[2], o1[3]); *(v4u*)(XB + off) = w; } } }
    }
};

__device__ __forceinline__ void tr_item(const float* W, int ldw, int k0, int n0, bf16* WT, size_t drow0, int ldt, LAS float* scr, int lane) {
#pragma unroll 8
    for (int i = 0; i < 32; ++i) { const int kk = 2 * i + (lane >> 5); scr[kk * 33 + (lane & 31)] = W[(size_t)(k0 + kk) * ldw + n0 + (lane & 31)]; }
    LDS_WAIT(); asm volatile("" ::: "memory");
    const int c = lane & 7;
#pragma unroll
    for (int j = 0; j < 4; ++j) { const int n = (lane >> 3) + 8 * j; const LAS float* s = scr + (8 * c) * 33 + n;
        v4u o; o.x = pk2(s[0 * 33], s[1 * 33]); o.y = pk2(s[2 * 33], s[3 * 33]); o.z = pk2(s[4 * 33], s[5 * 33]); o.w = pk2(s[6 * 33], s[7 * 33]);
        *(GAS v4u*)(WT + (drow0 + n) * ldt + k0 + 8 * c) = o; }
    LDS_WAIT(); asm volatile("" ::: "memory");
}
__device__ __forceinline__ void tr_item8(const float* W, int ldw, int k0, int n0, unsigned char* WT, size_t drow0, int ldt, LAS float* scr, int lane) {
#pragma unroll 8
    for (int i = 0; i < 32; ++i) { const int kk = 2 * i + (lane >> 5); scr[kk * 33 + (lane & 31)] = W[(size_t)(k0 + kk) * ldw + n0 + (lane & 31)]; }
    LDS_WAIT(); asm volatile("" ::: "memory");
    const int c = lane & 7;
#pragma unroll
    for (int j = 0; j < 4; ++j) { const int n = (lane >> 3) + 8 * j; const LAS float* s = scr + (8 * c) * 33 + n;
        v2u o; o.x = pk4_fp8(s[0 * 33] * F8_WS, s[1 * 33] * F8_WS, s[2 * 33] * F8_WS, s[3 * 33] * F8_WS); o.y = pk4_fp8(s[4 * 33] * F8_WS, s[5 * 33] * F8_WS, s[6 * 33] * F8_WS, s[7 * 33] * F8_WS);
        *(GAS v2u*)(WT + (drow0 + n) * ldt + k0 + 8 * c) = o; }
    LDS_WAIT(); asm volatile("" ::: "memory");
}
__device__ __forceinline__ void weight_items(const Args& a, unsigned char* ws, LAS float* scr, int lane, int group, int l, int gw, int NGW) {
    constexpr int I_INA = 32 * 128, I_INB = 32 * 32, I_OUT = 32 * 64, I_PG = 32 * 64, I_PP = 4 * 64, I_POOL = 4 * 32, I_EG = NE * 32 * 32, I_EU = I_EG, I_ED = NE * 16 * 64;
    if (group == 0) {
        for (int it = gw; it < I_INA + I_INB + I_PP + I_POOL; it += NGW) { int r = it;
            if (r < I_INA) { const int kb = r / 128, nb = r % 128; tr_item(a.in[I_WIN] + (size_t)l * D * IN_COLS, IN_COLS, 64 * kb, 32 * nb, (bf16*)(ws + WS_WIN) + (size_t)l * NPROJ * D, 32 * nb, D, scr, lane); continue; } r -= I_INA;
            if (r < I_INB) { const int kb = r / 32, nb = r % 32; tr_item(a.in[I_WIN] + (size_t)l * D * IN_COLS, IN_COLS, 64 * kb, 4112 + 32 * nb, (bf16*)(ws + WS_WIN) + (size_t)l * NPROJ * D, 4096 + 32 * nb, D, scr, lane); continue; } r -= I_INB;
            if (r < I_PP) { const int kb = r / 64, nb = r % 64; tr_item(a.in[I_WPP] + (size_t)l * PLE * D, D, 64 * kb, 32 * nb, (bf16*)(ws + WS_WPP) + (size_t)l * D * PLE, 32 * nb, PLE, scr, lane); continue; } r -= I_PP;
            { const int g = r / 32, rr = r % 32, kb = rr / 8, nb = rr % 8; tr_item(a.in[I_POOLW] + ((size_t)l * 4 + g) * 65536, 256, 64 * kb, 32 * nb, (bf16*)(ws + WS_WPOOL) + ((size_t)l * 4 + g) * 65536, 32 * nb, 256, scr, lane); } }
    } else {
        const bool f8 = FP8_LAYER(l);
        for (int it = gw; it < I_OUT + I_PG + I_EG + I_EU + I_ED; it += NGW) { int r = it;
            if (r < I_OUT) { const int kb = r / 64, nb = r % 64; tr_item(a.in[I_WOUT] + (size_t)l * D * D, D, 64 * kb, 32 * nb, (bf16*)(ws + WS_WOUT) + (size_t)l * D * D, 32 * nb, D, scr, lane); continue; } r -= I_OUT;
            if (r < I_PG) { const int kb = r / 64, nb = r % 64; if (f8 && FP8_PI && l == DEPTH - 1) tr_item8(a.in[I_WPG] + (size_t)l * D * D, D, 64 * kb, 32 * nb, ws + WS_WPG + (size_t)l * D * D * 2, 32 * nb, D, scr, lane); else tr_item(a.in[I_WPG] + (size_t)l * D * D, D, 64 * kb, 32 * nb, (bf16*)(ws + WS_WPG) + (size_t)l * D * D, 32 * nb, D, scr, lane); continue; } r -= I_PG;
            if (r < I_EG) { const int e = r / 1024, rr = r % 1024, kb = rr / 32, nb = rr % 32, h0 = 32 * nb;
                if (f8) tr_item8(a.in[I_WEG] + ((size_t)l * NE + e) * D * DE, DE, 64 * kb, h0, ws + WS_WGU + (size_t)l * NE * 2048 * D * 2 + (size_t)e * 2048 * D, (size_t)(h0 >> 7) * 256 + (h0 & 127), D, scr, lane);
                else tr_item(a.in[I_WEG] + ((size_t)l * NE + e) * D * DE, DE, 64 * kb, h0, (bf16*)(ws + WS_WGU) + ((size_t)l * NE + e) * 2048 * D, (size_t)(h0 >> 7) * 256 + (h0 & 127), D, scr, lane); continue; } r -= I_EG;
            if (r < I_EU) { const int e = r / 1024, rr = r % 1024, kb = rr / 32, nb = rr % 32, h0 = 32 * nb;
                if (f8) tr_item8(a.in[I_WEU] + ((size_t)l * NE + e) * D * DE, DE, 64 * kb, h0, ws + WS_WGU + (size_t)l * NE * 2048 * D * 2 + (size_t)e * 2048 * D, (size_t)(h0 >> 7) * 256 + 128 + (h0 & 127), D, scr, lane);
                else tr_item(a.in[I_WEU] + ((size_t)l * NE + e) * D * DE, DE, 64 * kb, h0, (bf16*)(ws + WS_WGU) + ((size_t)l * NE + e) * 2048 * D, (size_t)(h0 >> 7) * 256 + 128 + (h0 & 127), D, scr, lane); continue; } r -= I_EU;
            { const int e = r / 1024, rr = r % 1024, kb = rr / 64, nb = rr % 64;
                if (f8 && FP8_PG) tr_item8(a.in[I_WED] + ((size_t)l * NE + e) * DE * D, D, 64 * kb, 32 * nb, ws + WS_WD + (size_t)l * NE * D * DE * 2 + (size_t)e * D * DE, 32 * nb, DE, scr, lane);
                else tr_item(a.in[I_WED] + ((size_t)l * NE + e) * DE * D, D, 64 * kb, 32 * nb, (bf16*)(ws + WS_WD) + ((size_t)l * NE + e) * D * DE, 32 * nb, DE, scr, lane); } }
    }
}
__device__ __forceinline__ void p0_prologue(const Frame& F0, const Args& a) {
    PHASE_FRAME(F0);
    LAS float* scr = (LAS float*)(F.lds + RING_OFF + F.wave * 16384);
    const int gw = F.vcu * NWAVES + F.wave, NGW = F.G * NWAVES;
    unsigned char* ws = OPQ_G(unsigned char, a.ws);
#pragma unroll 1
    for (int l = 0; l < DEPTH; ++l) weight_items(a, ws, scr, F.lane, 0, l, gw, NGW);
#ifdef CONVERT_ALL_IN_PROLOGUE
#pragma unroll 1
    for (int l = 0; l < DEPTH; ++l) weight_items(a, ws, scr, F.lane, 1, l, gw, NGW);
#endif
    const size_t gt = (size_t)F.vcu * 512 + F.tid, NGT = (size_t)F.G * 512;
    { const GAS f32x4* src = (const GAS f32x4*)a.in[I_X]; GAS v4u* dst = (GAS v4u*)(ws + WS_XB);
        for (size_t i = gt; i < (size_t)T * D / 8; i += NGT) { const f32x4 v0 = src[2 * i], v1 = src[2 * i + 1]; v4u o; o.x = pk2(v0[0], v0[1]); o.y = pk2(v0[2], v0[3]); o.z = pk2(v1[0], v1[1]); o.w = pk2(v1[2], v1[3]); dst[i] = o; } }
    { const GAS f32x4* src = (const GAS f32x4*)a.in[I_P]; GAS v4u* dst = (GAS v4u*)(ws + WS_PB16);
        for (size_t i = gt; i < (size_t)DEPTH * T * PLE / 8; i += NGT) { const f32x4 v0 = src[2 * i], v1 = src[2 * i + 1]; v4u o; o.x = pk2(v0[0], v0[1]); o.y = pk2(v0[2], v0[3]); o.z = pk2(v1[0], v1[1]); o.w = pk2(v1[2], v1[3]); dst[i] = o; } }
    for (size_t i = gt; i < (size_t)DEPTH * 16 * D; i += NGT) { const int l = (int)(i / (16 * D)), j = (int)((i / D) % 16), k = (int)(i % D);
        ((bf16*)(ws + WS_WBA))[i] = (bf16)f2bf(a.in[I_WIN][((size_t)l * D + k) * IN_COLS + 4096 + j]); }
}

typedef float f32x16 __attribute__((ext_vector_type(16)));
#define MFMA32(a_, b_, c_) __builtin_amdgcn_mfma_f32_32x32x16_bf16((a_), (b_), (c_), 0, 0, 0)
#define PACK8(x, sp) __builtin_bit_cast(bf16x8, (v4u){pkbf((x)[8 * (sp)], (x)[8 * (sp) + 1]), pkbf((x)[8 * (sp) + 2], (x)[8 * (sp) + 3]), pkbf((x)[8 * (sp) + 4], (x)[8 * (sp) + 5]), pkbf((x)[8 * (sp) + 6], (x)[8 * (sp) + 7])})
#define RAW_BAR() do { asm volatile("s_waitcnt lgkmcnt(0)" ::: "memory"); __builtin_amdgcn_s_barrier(); asm volatile("" ::: "memory"); } while (0)
constexpr int IMG_ELEMS = 56 * 512, UIMG_ELEMS = 8 * 1024;
constexpr int FR_WN = 0, FR_QD = 16, FR_AQK = 32, FR_KDT = 40;
constexpr size_t WS_IMG = WS_R2, WS_UIMG = WS_R2 + 112 * MiB;
static_assert((size_t)NB * NCH * NH * IMG_ELEMS * 2 == 112 * MiB && (size_t)NB * NCH * NH * UIMG_ELEMS * 2 == 32 * MiB, "DeltaNet images");

__device__ __forceinline__ void pool_diffs_unit(const Frame& F, unsigned char* ws, int pm, int g) {
    const bf16* PROJ = (const bf16*)(ws + WS_PROJ); bf16* POOLD = (bf16*)(ws + WS_POOLD);
    const int tid = F.tid, cp = tid & 127, rq = tid >> 7, r0 = 256 * pm + 64 * rq, sq0 = r0 % SEQ, col = 256 * g + 2 * cp;
    const bf16* up = PROJ + (size_t)r0 * NPROJ + 4096 + col; bf16* dp = POOLD + (size_t)r0 * PW + col;
#define POOL_BODY(WIN) do { unsigned xr[CH + WIN - 1]; \
        _Pragma("unroll") for (int j = 0; j < WIN - 1; ++j) xr[j] = (sq0 - (WIN - 1) + j >= 0) ? *(const unsigned*)(up + (ptrdiff_t)(j - (WIN - 1)) * NPROJ) : 0u; \
        _Pragma("unroll") for (int i = 0; i < CH; ++i) xr[WIN - 1 + i] = *(const unsigned*)(up + (size_t)i * NPROJ); \
        float s0 = 0.f, s1 = 0.f; \
        _Pragma("unroll") for (int j = 0; j < WIN - 1; ++j) { s0 += bflo(xr[j]); s1 += bfhi(xr[j]); } \
        _Pragma("unroll") for (int i = 0; i < CH; ++i) { const float x0 = bflo(xr[WIN - 1 + i]), x1 = bfhi(xr[WIN - 1 + i]); s0 += x0; s1 += x1; \
            const int pos = sq0 + i; const float inv = __builtin_amdgcn_rcpf((float)((pos + 1) < WIN ? (pos + 1) : WIN)); \
            *(unsigned*)(dp + (size_t)i * PW) = pkbf(s0 * inv - x0, s1 * inv - x1); s0 -= bflo(xr[i]); s1 -= bfhi(xr[i]); } } while (0)
    if (g == 0) POOL_BODY(2); else if (g == 1) POOL_BODY(4); else if (g == 2) POOL_BODY(8); else POOL_BODY(16);
#undef POOL_BODY
}
#ifndef PREP_DUP
#define PREP_DUP 0
#endif
constexpr int PQF = 0, PKF = 33792, PQS = 67584, PKS = 84992, PVT = 102400, PKT = 120832, PTAB = 139264;
constexpr int PAS = PQF;
constexpr int PTB = PKF, PT11T = PKF + 9216, PPART = PKF;
constexpr int F_LD = 132, S_LD = 136, T_LD = 72, A_LD = 68, TT_LD = 40;
__device__ __forceinline__ void phase_dn_prep(const Frame& F0, const Args& a, int layer) {
    PHASE_FRAME(F0);
    unsigned char* ws = OPQ_G(unsigned char, a.ws);
    LAS unsigned char* lds = F.lds;
    LAS float* Qf = (LAS float*)(lds + PQF); LAS float* Kf = (LAS float*)(lds + PKF); LAS float* As = (LAS float*)(lds + PAS);
    LAS bf16* Qs = (LAS bf16*)(lds + PQS); LAS bf16* Ks = (LAS bf16*)(lds + PKS); LAS bf16* Vt = (LAS bf16*)(lds + PVT); LAS bf16* Kt = (LAS bf16*)(lds + PKT);
    LAS bf16* Tb = (LAS bf16*)(lds + PTB); LAS bf16* T11t = (LAS bf16*)(lds + PT11T);
    LAS float* betaS = (LAS float*)(lds + PTAB); LAS float* gS = betaS + 512; LAS float* gamh = gS + 512; LAS float* betah = gamh + 64; LAS float* egam = betah + 64; LAS float* bgam = egam + 64; LAS float* ekd = bgam + 64; LAS float* rkS = ekd + 64;
    const bf16* XB = (const bf16*)(ws + WS_XB); const bf16* PROJ = (const bf16*)(ws + WS_PROJ); const bf16* WBA = (const bf16*)(ws + WS_WBA) + (size_t)layer * 16 * D;
    bf16* IMG = (bf16*)(ws + WS_IMG); bf16* UIMG = (bf16*)(ws + WS_UIMG); float* CD = (float*)(ws + WS_CD);
    const float* convw = a.in[I_CONVW] + (size_t)layer * 4 * 3072; const float* alog = a.in[I_ALOG] + layer * NH; const float* dtb = a.in[I_DTB] + layer * NH;
    const int tid = F.tid, lane = F.lane, wave = F.wave, c32 = lane & 31, hf = lane >> 5;
    for (int unit = F.vcu; unit < NB * NCH; unit += F.G) {
        const int b = unit / NCH, n = unit % NCH, r0 = b * SEQ + n * CH, sq0 = n * CH;
        for (int rep_ = 0; rep_ < ((PREP_DUP & 64) ? 2 : 1); ++rep_)
        { typedef float f32x4v __attribute__((ext_vector_type(4)));
            const int fr = lane & 15, fg = lane >> 4; f32x4v pacc[4];
#pragma unroll
            for (int mt = 0; mt < 4; ++mt) pacc[mt] = (f32x4v){0.f, 0.f, 0.f, 0.f};
#pragma unroll 2
            for (int s = 0; s < 8; ++s) { const int k0 = 256 * wave + 32 * s + 8 * fg;
                const bf16x8 bfr = *(const bf16x8*)(WBA + (size_t)fr * D + k0);
#pragma unroll
                for (int mt = 0; mt < 4; ++mt) { const bf16x8 afr = *(const bf16x8*)(XB + (size_t)(r0 + 16 * mt + fr) * D + k0); pacc[mt] = __builtin_amdgcn_mfma_f32_16x16x32_bf16(afr, bfr, pacc[mt], 0, 0, 0); } }
            LAS float* part = (LAS float*)(lds + PPART) + wave * 1024;
#pragma unroll
            for (int mt = 0; mt < 4; ++mt)
#pragma unroll
                for (int r = 0; r < 4; ++r) part[(16 * mt + 4 * fg + r) * 16 + fr] = pacc[mt][r]; }
        __syncthreads();
        { const int tok = tid >> 3, cp = tid & 7; float s0 = 0.f, s1 = 0.f;
#pragma unroll
            for (int w = 0; w < 8; ++w) { const f32x2 p2 = *(const LAS f32x2*)((LAS float*)(lds + PPART) + w * 1024 + tok * 16 + 2 * cp); s0 += p2[0]; s1 += p2[1]; }
            if (cp < 4) { betaS[tok * 8 + 2 * cp] = sigmoidf_(s0); betaS[tok * 8 + 2 * cp + 1] = sigmoidf_(s1); }
            else { const int h = 2 * (cp - 4); const float z0 = s0 + dtb[h], z1 = s1 + dtb[h + 1];
                const float sp0 = z0 > 20.f ? z0 : log1pf(__expf(z0)), sp1 = z1 > 20.f ? z1 : log1pf(__expf(z1));
                gS[tok * 8 + h] = -__expf(alog[h]) * sp0; gS[tok * 8 + h + 1] = -__expf(alog[h + 1]) * sp1; } }
        __syncthreads();
        if (tid < 8) { float run = 0.f; for (int t = 0; t < CH; ++t) { run += gS[t * 8 + tid]; gS[t * 8 + tid] = run; } }
        __syncthreads();
        unsigned craw[3][11]; unsigned cdum[3][8];
#define PREP_LOADRAW(hh) do { const int cp_ = tid & 63, i0_ = (tid >> 6) * 8; \
            _Pragma("unroll") for (int part_ = 0; part_ < 3; ++part_) { const bf16* src_ = PROJ + (size_t)(r0 + i0_ - 3) * NPROJ + part_ * 1024 + (hh) * HD + 2 * cp_; \
                _Pragma("unroll") for (int j_ = 0; j_ < 11; ++j_) craw[part_][j_] = (sq0 + i0_ - 3 + j_ >= 0) ? *(const unsigned*)(src_ + (ptrdiff_t)j_ * NPROJ) : 0u; \
                if (PREP_DUP & 256) { _Pragma("unroll") for (int j_ = 3; j_ < 11; ++j_) cdum[part_][j_ - 3] = *(const unsigned*)(src_ + (ptrdiff_t)j_ * NPROJ + ((hh) ^ 1) * HD - (hh) * HD); } } } while (0)
        for (int rep2_ = 0; rep2_ < ((PREP_DUP & 128) ? 2 : 1); ++rep2_) {
        PREP_LOADRAW(0);
        for (int h = 0; h < NH; ++h) {
            const size_t chd = (size_t)unit * NH + h; bf16* img = IMG + chd * IMG_ELEMS; bf16* uimg = UIMG + chd * UIMG_ELEMS;
            if (tid < 64) { const float gi = gS[tid * 8 + h], bi = betaS[tid * 8 + h], eg = __expf(gi); gamh[tid] = gi; betah[tid] = bi; egam[tid] = eg; bgam[tid] = bi * eg; ekd[tid] = __expf(gS[63 * 8 + h] - gi); }
            RAW_BAR();
            for (int rep_ = 0; rep_ < ((PREP_DUP & 16) ? 2 : 1); ++rep_)
            { const int cp = tid & 63, rg8 = tid >> 6, i0 = rg8 * 8;
                if (PREP_DUP & 256) {
#pragma unroll
                    for (int p_ = 0; p_ < 3; ++p_)
#pragma unroll
                        for (int j_ = 0; j_ < 8; ++j_) asm volatile("" :: "v"(cdum[p_][j_])); }
#pragma unroll
                for (int part = 0; part < 3; ++part) { const int col = part * 1024 + h * HD + 2 * cp;
                    const f32x2 cw0 = *(const f32x2*)(convw + col), cw1 = *(const f32x2*)(convw + 3072 + col), cw2 = *(const f32x2*)(convw + 2 * 3072 + col), cw3 = *(const f32x2*)(convw + 3 * 3072 + col);
                    float ya[8], yb[8];
#pragma unroll
                    for (int i = 0; i < 8; ++i) { const unsigned x3 = craw[part][i], x2 = craw[part][i + 1], x1 = craw[part][i + 2], x0 = craw[part][i + 3];
                        const float ta = cw0[0] * bflo(x3) + cw1[0] * bflo(x2) + cw2[0] * bflo(x1) + cw3[0] * bflo(x0), tb = cw0[1] * bfhi(x3) + cw1[1] * bfhi(x2) + cw2[1] * bfhi(x1) + cw3[1] * bfhi(x0);
                        ya[i] = ta * sigmoidf_(ta); yb[i] = tb * sigmoidf_(tb); }
                    if (part == 0) {
#pragma unroll
                        for (int i = 0; i < 8; ++i) *(LAS f32x2*)(Qf + (i0 + i) * F_LD + 2 * cp) = (f32x2){ya[i], yb[i]}; }
                    else if (part == 1) {
#pragma unroll
                        for (int i = 0; i < 8; ++i) *(LAS f32x2*)(Kf + (i0 + i) * F_LD + 2 * cp) = (f32x2){ya[i], yb[i]}; }
                    else { v4u o0, o1;
                        o0.x = pkbf(ya[0] * betah[i0 + 0], ya[1] * betah[i0 + 1]); o0.y = pkbf(ya[2] * betah[i0 + 2], ya[3] * betah[i0 + 3]); o0.z = pkbf(ya[4] * betah[i0 + 4], ya[5] * betah[i0 + 5]); o0.w = pkbf(ya[6] * betah[i0 + 6], ya[7] * betah[i0 + 7]);
                        o1.x = pkbf(yb[0] * betah[i0 + 0], yb[1] * betah[i0 + 1]); o1.y = pkbf(yb[2] * betah[i0 + 2], yb[3] * betah[i0 + 3]); o1.z = pkbf(yb[4] * betah[i0 + 4], yb[5] * betah[i0 + 5]); o1.w = pkbf(yb[6] * betah[i0 + 6], yb[7] * betah[i0 + 7]);
                        *(LAS v4u*)(Vt + (2 * cp) * T_LD + i0) = o0; *(LAS v4u*)(Vt + (2 * cp + 1) * T_LD + i0) = o1; } }
            }
            if (h + 1 < NH) PREP_LOADRAW(h + 1);
            for (int rep_ = 0; rep_ < ((PREP_DUP & 1) ? 2 : 1); ++rep_) { if (rep_) RAW_BAR();
            { const int i = tid >> 3, part = tid & 7; const LAS float* qp = Qf + i * F_LD + part * 16; const LAS float* kp = Kf + i * F_LD + part * 16;
                f32x4 qv[4], kv[4]; float sq = 0.f, sk = 0.f;
#pragma unroll
                for (int j = 0; j < 4; ++j) { qv[j] = *(const LAS f32x4*)(qp + 4 * j); kv[j] = *(const LAS f32x4*)(kp + 4 * j);
                    sq += (qv[j][0] * qv[j][0] + qv[j][1] * qv[j][1]) + (qv[j][2] * qv[j][2] + qv[j][3] * qv[j][3]); sk += (kv[j][0] * kv[j][0] + kv[j][1] * kv[j][1]) + (kv[j][2] * kv[j][2] + kv[j][3] * kv[j][3]); }
                sq += __shfl_xor(sq, 1); sq += __shfl_xor(sq, 2); sq += __shfl_xor(sq, 4); sk += __shfl_xor(sk, 1); sk += __shfl_xor(sk, 2); sk += __shfl_xor(sk, 4);
                const float rq = 1.0f / sqrtf(sq + RMS_EPS) * 0.08838834764831845f, rk = 1.0f / sqrtf(sk + RMS_EPS);
                if (part == 0) rkS[i] = rk;
#pragma unroll
                for (int j = 0; j < 4; ++j) { qv[j] = qv[j] * rq; kv[j] = kv[j] * rk; }
                v4u w0, w1;
                w0.x = pkbf(qv[0][0], qv[0][1]); w0.y = pkbf(qv[0][2], qv[0][3]); w0.z = pkbf(qv[1][0], qv[1][1]); w0.w = pkbf(qv[1][2], qv[1][3]); w1.x = pkbf(qv[2][0], qv[2][1]); w1.y = pkbf(qv[2][2], qv[2][3]); w1.z = pkbf(qv[3][0], qv[3][1]); w1.w = pkbf(qv[3][2], qv[3][3]);
                *(LAS v4u*)(Qs + i * S_LD + part * 16) = w0; *(LAS v4u*)(Qs + i * S_LD + part * 16 + 8) = w1;
                w0.x = pkbf(kv[0][0], kv[0][1]); w0.y = pkbf(kv[0][2], kv[0][3]); w0.z = pkbf(kv[1][0], kv[1][1]); w0.w = pkbf(kv[1][2], kv[1][3]); w1.x = pkbf(kv[2][0], kv[2][1]); w1.y = pkbf(kv[2][2], kv[2][3]); w1.z = pkbf(kv[3][0], kv[3][1]); w1.w = pkbf(kv[3][2], kv[3][3]);
                *(LAS v4u*)(Ks + i * S_LD + part * 16) = w0; *(LAS v4u*)(Ks + i * S_LD + part * 16 + 8) = w1;
                const float eg = egam[i]; bf16* fq = img + ((size_t)(FR_QD + (i >> 5) * 8 + part) * 64 + (i & 31)) * 8;
                v4u h0, h1;
                h0.x = pkbf(qv[0][0] * eg, qv[0][1] * eg); h0.y = pkbf(qv[0][2] * eg, qv[0][3] * eg); h0.z = pkbf(qv[2][0] * eg, qv[2][1] * eg); h0.w = pkbf(qv[2][2] * eg, qv[2][3] * eg);
                h1.x = pkbf(qv[1][0] * eg, qv[1][1] * eg); h1.y = pkbf(qv[1][2] * eg, qv[1][3] * eg); h1.z = pkbf(qv[3][0] * eg, qv[3][1] * eg); h1.w = pkbf(qv[3][2] * eg, qv[3][3] * eg);
                *(v4u*)fq = h0; *(v4u*)(fq + 32 * 8) = h1; }
            RAW_BAR();
            { const int c = tid & 127, rg = tid >> 7; float kb[16], kd[16];
#pragma unroll
                for (int i = 0; i < 16; ++i) { const int t = rg * 16 + i; const float kn = Kf[t * F_LD + c] * rkS[t]; kb[i] = kn * bgam[t]; kd[i] = kn * ekd[t]; }
                v4u o0, o1;
                o0.x = pkbf(kb[0], kb[1]); o0.y = pkbf(kb[2], kb[3]); o0.z = pkbf(kb[4], kb[5]); o0.w = pkbf(kb[6], kb[7]); o1.x = pkbf(kb[8], kb[9]); o1.y = pkbf(kb[10], kb[11]); o1.z = pkbf(kb[12], kb[13]); o1.w = pkbf(kb[14], kb[15]);
                *(LAS v4u*)(Kt + c * T_LD + rg * 16) = o0; *(LAS v4u*)(Kt + c * T_LD + rg * 16 + 8) = o1;
                bf16* fk = img + ((size_t)(FR_KDT + (c >> 5) * 4 + rg) * 64 + (c & 31)) * 8;
                v4u h0, h1;
                h0.x = pkbf(kd[0], kd[1]); h0.y = pkbf(kd[2], kd[3]); h0.z = pkbf(kd[8], kd[9]); h0.w = pkbf(kd[10], kd[11]);
                h1.x = pkbf(kd[4], kd[5]); h1.y = pkbf(kd[6], kd[7]); h1.z = pkbf(kd[12], kd[13]); h1.w = pkbf(kd[14], kd[15]);
                *(v4u*)fk = h0; *(v4u*)(fk + 32 * 8) = h1; }
            RAW_BAR();
            }
            for (int rep_ = 0; rep_ < ((PREP_DUP & 2) ? 2 : 1); ++rep_) { if (rep_) RAW_BAR();
            if (wave < 6) { const int pr = wave % 3, iskk = wave / 3, mt = pr == 2 ? 1 : 0, nt = pr == 0 ? 0 : 1;
                const LAS bf16* xs = iskk ? Ks : Qs; f32x16 d;
#pragma unroll
                for (int r = 0; r < 16; ++r) d[r] = 0.f;
#pragma unroll
                for (int s = 0; s < 8; ++s) { const bf16x8 af = *(const LAS bf16x8*)(Ks + (32 * mt + c32) * S_LD + 16 * s + 8 * hf), bfr = *(const LAS bf16x8*)(xs + (32 * nt + c32) * S_LD + 16 * s + 8 * hf); d = MFMA32(af, bfr, d); }
                const int i = 32 * nt + c32; const float gi = gamh[i], bi = betah[i];
#pragma unroll
                for (int r = 0; r < 16; ++r) { const int j = 32 * mt + (r & 3) + 8 * (r >> 2) + 4 * hf; const float de = __expf(gi - gamh[j]);
                    d[r] = iskk ? ((j < i) ? bi * d[r] * de : 0.f) : ((j <= i) ? d[r] * de : 0.f); }
                if (iskk) {
#pragma unroll
                    for (int qd = 0; qd < 4; ++qd) *(LAS f32x4*)(As + i * A_LD + 32 * mt + 8 * qd + 4 * hf) = (f32x4){d[4 * qd], d[4 * qd + 1], d[4 * qd + 2], d[4 * qd + 3]}; }
                else {
#pragma unroll
                    for (int sp = 0; sp < 2; ++sp) *(bf16x8*)(img + ((size_t)(FR_AQK + nt * 4 + 2 * mt + sp) * 64 + lane) * 8) = PACK8(d, sp); } }
            RAW_BAR();
            }
            for (int rep_ = 0; rep_ < ((PREP_DUP & 4) ? 2 : 1); ++rep_) { if (rep_) RAW_BAR();
            if (wave < 2) {
                unsigned asb = (unsigned)(uintptr_t)(As + (32 * wave) * A_LD + 32 * wave); int cb = c32; asm volatile("" : "+v"(asb), "+v"(cb));
                const LAS float* Ab = (const LAS float*)(uintptr_t)asb;
                float arow[32], Tc[32];
#pragma unroll
                for (int i = 0; i < 32; ++i) arow[i] = Ab[i * A_LD + cb];
#pragma unroll
                for (int i = 0; i < 32; ++i) { float ac[4] = {(i == cb) ? 1.f : 0.f, 0.f, 0.f, 0.f}; if (i > 0) asm volatile("" : "+v"(arow[i]), "+v"(Tc[i - 1]));
#pragma unroll
                    for (int j = 0; j < i; ++j) { const float aij = __builtin_bit_cast(float, __builtin_amdgcn_readlane(__builtin_bit_cast(int, arow[i]), j)); ac[j & 3] -= aij * Tc[j]; }
                    Tc[i] = (ac[0] + ac[1]) + (ac[2] + ac[3]); __builtin_amdgcn_sched_barrier(0); }
                if (hf == 0) {
#pragma unroll
                    for (int i = 0; i < 32; ++i) Tb[(32 * wave + i) * T_LD + 32 * wave + c32] = (bf16)(pkbf(Tc[i], 0.f) & 0xffffu);
                    if (wave == 0) {
#pragma unroll
                        for (int q = 0; q < 4; ++q) { v4u o; o.x = pkbf(Tc[8 * q], Tc[8 * q + 1]); o.y = pkbf(Tc[8 * q + 2], Tc[8 * q + 3]); o.z = pkbf(Tc[8 * q + 4], Tc[8 * q + 5]); o.w = pkbf(Tc[8 * q + 6], Tc[8 * q + 7]); *(LAS v4u*)(T11t + c32 * TT_LD + 8 * q) = o; } } } }
            RAW_BAR();
            if (wave == 0) {
                f32x16 x;
#pragma unroll
                for (int r = 0; r < 16; ++r) x[r] = 0.f;
#pragma unroll
                for (int s = 0; s < 2; ++s) { const LAS float* ap = As + (32 + c32) * A_LD + 16 * s + 8 * hf; const f32x4 a0 = *(const LAS f32x4*)ap, a1 = *(const LAS f32x4*)(ap + 4);
                    const bf16x8 af = __builtin_bit_cast(bf16x8, (v4u){pkbf(a0[0], a0[1]), pkbf(a0[2], a0[3]), pkbf(a1[0], a1[1]), pkbf(a1[2], a1[3])});
                    const bf16x8 bfr = *(const LAS bf16x8*)(T11t + c32 * TT_LD + 16 * s + 8 * hf); x = MFMA32(af, bfr, x); }
                f32x16 t21;
#pragma unroll
                for (int r = 0; r < 16; ++r) t21[r] = 0.f;
#pragma unroll
                for (int s = 0; s < 2; ++s) { const LAS bf16* tp = Tb + (32 + c32) * T_LD + 32 + 16 * s + 4 * hf; const v2u lo = *(const LAS v2u*)tp, hi = *(const LAS v2u*)(tp + 8);
                    const bf16x8 af = __builtin_bit_cast(bf16x8, (v4u){lo.x, lo.y, hi.x, hi.y}); const bf16x8 bfr = PACK8(x, s); t21 = MFMA32(af, bfr, t21); }
#pragma unroll
                for (int r = 0; r < 16; ++r) Tb[(32 + (r & 3) + 8 * (r >> 2) + 4 * hf) * T_LD + c32] = (bf16)(pkbf(-t21[r], 0.f) & 0xffffu);
            }
            RAW_BAR();
            }
            for (int rep_ = 0; rep_ < ((PREP_DUP & 8) ? 2 : 1); ++rep_) { if (rep_) RAW_BAR();
            if (wave < 4) {
#pragma unroll
                for (int mt = 0; mt < 2; ++mt) { f32x16 d;
#pragma unroll
                    for (int r = 0; r < 16; ++r) d[r] = 0.f;
#pragma unroll
                    for (int s = 0; s < 4; ++s) if (s < 2 * (mt + 1)) { const bf16x8 af = *(const LAS bf16x8*)(Tb + (32 * mt + c32) * T_LD + 16 * s + 8 * hf), bfr = *(const LAS bf16x8*)(Vt + (32 * wave + c32) * T_LD + 16 * s + 8 * hf); d = MFMA32(af, bfr, d); }
                    bf16* up = uimg + ((size_t)(wave * 2 + mt) * 64 + lane) * 16; *(bf16x8*)up = PACK8(d, 0); *(bf16x8*)(up + 8) = PACK8(d, 1); } }
            else { const int ct = wave - 4;
#pragma unroll
                for (int nt = 0; nt < 2; ++nt) { f32x16 d;
#pragma unroll
                    for (int r = 0; r < 16; ++r) d[r] = 0.f;
#pragma unroll
                    for (int s = 0; s < 4; ++s) if (s < 2 * (nt + 1)) { const bf16x8 af = *(const LAS bf16x8*)(Kt + (32 * ct + c32) * T_LD + 16 * s + 8 * hf), bfr = *(const LAS bf16x8*)(Tb + (32 * nt + c32) * T_LD + 16 * s + 8 * hf); d = MFMA32(af, bfr, d); }
#pragma unroll
                    for (int r = 0; r < 16; ++r) d[r] = -d[r];
#pragma unroll
                    for (int sp = 0; sp < 2; ++sp) *(bf16x8*)(img + ((size_t)(FR_WN + nt * 8 + 2 * ct + sp) * 64 + lane) * 8) = PACK8(d, sp); } }
            }
            if (tid == 0) CD[chd] = egam[63];
            RAW_BAR();
        }
        }
#undef PREP_LOADRAW
    }
}

__host__ __device__ constexpr int sc_p(int k) { const int j = k - 32; return j < 12 ? j % 6 : (j - 12) % 5; }
__host__ __device__ constexpr int sc_slab(int k) { const int j = k - 32; return k < 32 ? (k >> 2) : (j < 12 ? j / 6 : 2 + (j - 12) / 5); }
__host__ __device__ constexpr int sc_kind(int k) { return k < 32 ? ((k & 3) < 2 ? 0 : 1) : ((sc_p(k) == 2 || sc_p(k) == 5) ? 1 : 2); }
__host__ __device__ constexpr int sc_idx(int k) { return k < 32 ? (k & 1) : (sc_p(k) == 0 ? 0 : sc_p(k) == 1 ? 1 : sc_p(k) == 2 ? 1 : sc_p(k) == 3 ? 2 : sc_p(k) == 4 ? 3 : 0); }
__host__ __device__ constexpr int sc_frag(int k) { return k < 32 ? (((k & 3) < 2 ? FR_WN : FR_QD) + (k & 1) * 8 + (k >> 2)) : (sc_kind(k) == 1 ? FR_AQK + sc_idx(k) * 4 + sc_slab(k) : FR_KDT + sc_idx(k) * 4 + sc_slab(k)); }
constexpr int SC_QD = 8;
constexpr int SCB = 57344, OT_OFF = 2 * SCB, OT_LD = 136, OT_BYTES = 64 * OT_LD * 2;
static_assert(OT_OFF + 2 * OT_BYTES <= 152 * 1024, "scan LDS");
__device__ __forceinline__ void phase_dn_scan(const Frame& F0, const Args& a, int layer, int unit) {
    PHASE_FRAME(F0);
    unsigned char* ws = OPQ_G(unsigned char, a.ws);
    LAS unsigned char* lds = F.lds;
    const int b = unit >> 3, h = unit & 7, lane = F.lane;
    const bf16* IMG = (const bf16*)(ws + WS_IMG); const bf16* UIMG = (const bf16*)(ws + WS_UIMG); const float* CD = (const float*)(ws + WS_CD);
    const size_t chd0 = (size_t)b * NCH * NH + h;
    if (F.wave < 4) {
#ifndef SCAN_NO_COMPUTE
        const int w = F.wave, c32 = lane & 31, hf = lane >> 5;
        f32x16 S0, S1, S2, S3;
#pragma unroll
        for (int r = 0; r < 16; ++r) { S0[r] = 0.f; S1[r] = 0.f; S2[r] = 0.f; S3[r] = 0.f; }
        const float cdl = CD[chd0 + (size_t)lane * NH];
        v4u UA[4];
        const __amdgpu_buffer_rsrc_t rsU = __builtin_amdgcn_make_buffer_rsrc((void*)(UIMG + chd0 * UIMG_ELEMS), (short)0, NCH * NH * UIMG_ELEMS * 2, 0x00020000);
        const unsigned uoff = (unsigned)((w * 2) * 64 + lane) * 32u;
#define SC_LOADU(dst, nn) do { _Pragma("unroll") for (int mt_ = 0; mt_ < 2; ++mt_) { _Pragma("unroll") for (int hh_ = 0; hh_ < 2; ++hh_) dst[2 * mt_ + hh_] = __builtin_amdgcn_raw_buffer_load_b128(rsU, uoff + (unsigned)(mt_ * 2048 + hh_ * 16), (unsigned)(nn) * (unsigned)(NH * UIMG_ELEMS * 2), 0); } } while (0)
#define SC_FRAG(bufoff, fi) (*(const LAS bf16x8*)(lds + (bufoff) + (fi) * 1024 + lane * 16))
#define SC_CHUNK(nn, U, bufoff, otoff) do { \
        f32x16 aV0, aV1, aO0, aO1; bf16x8 fq0, fq1, fq2, fq3, fq4, fq5, fq6, fq7, Sbs, Vb0, Vb1, Vb2, Vb3; \
        _Pragma("unroll") for (int q = 0; q < 4; ++q) { aV0[2 * q] = bflo(U[0][q]); aV0[2 * q + 1] = bfhi(U[0][q]); aV0[8 + 2 * q] = bflo(U[1][q]); aV0[8 + 2 * q + 1] = bfhi(U[1][q]); \
            aV1[2 * q] = bflo(U[2][q]); aV1[2 * q + 1] = bfhi(U[2][q]); aV1[8 + 2 * q] = bflo(U[3][q]); aV1[8 + 2 * q + 1] = bfhi(U[3][q]); } \
        _Pragma("unroll") for (int r = 0; r < 16; ++r) { aO0[r] = 0.f; aO1[r] = 0.f; } \
        if ((nn) + 1 < NCH) SC_LOADU(U, (nn) + 1); \
        const float cd = __builtin_bit_cast(float, __builtin_amdgcn_readlane(__builtin_bit_cast(int, cdl), (nn))); \
        fq0 = SC_FRAG(bufoff, 0); \
        fq1 = SC_FRAG(bufoff, 8); \
        fq2 = SC_FRAG(bufoff, 16); \
        fq3 = SC_FRAG(bufoff, 24); \
        fq4 = SC_FRAG(bufoff, 1); \
        fq5 = SC_FRAG(bufoff, 9); \
        fq6 = SC_FRAG(bufoff, 17); \
        fq7 = SC_FRAG(bufoff, 25); \
        Sbs = PACK8(S0, 0); \
        aV0 = MFMA32(fq0, Sbs, aV0); \
        fq0 = SC_FRAG(bufoff, 2); \
        aV1 = MFMA32(fq1, Sbs, aV1); \
        fq1 = SC_FRAG(bufoff, 10); \
        aO0 = MFMA32(fq2, Sbs, aO0); \
        fq2 = SC_FRAG(bufoff, 18); \
        aO1 = MFMA32(fq3, Sbs, aO1); \
        fq3 = SC_FRAG(bufoff, 26); \
        Sbs = PACK8(S0, 1); \
        aV0 = MFMA32(fq4, Sbs, aV0); \
        fq4 = SC_FRAG(bufoff, 3); \
        aV1 = MFMA32(fq5, Sbs, aV1); \
        fq5 = SC_FRAG(bufoff, 11); \
        aO0 = MFMA32(fq6, Sbs, aO0); \
        fq6 = SC_FRAG(bufoff, 19); \
        aO1 = MFMA32(fq7, Sbs, aO1); \
        fq7 = SC_FRAG(bufoff, 27); \
        Sbs = PACK8(S1, 0); \
        aV0 = MFMA32(fq0, Sbs, aV0); \
        fq0 = SC_FRAG(bufoff, 4); \
        aV1 = MFMA32(fq1, Sbs, aV1); \
        fq1 = SC_FRAG(bufoff, 12); \
        aO0 = MFMA32(fq2, Sbs, aO0); \
        fq2 = SC_FRAG(bufoff, 20); \
        aO1 = MFMA32(fq3, Sbs, aO1); \
        fq3 = SC_FRAG(bufoff, 28); \
        Sbs = PACK8(S1, 1); \
        aV0 = MFMA32(fq4, Sbs, aV0); \
        fq4 = SC_FRAG(bufoff, 5); \
        aV1 = MFMA32(fq5, Sbs, aV1); \
        fq5 = SC_FRAG(bufoff, 13); \
        aO0 = MFMA32(fq6, Sbs, aO0); \
        fq6 = SC_FRAG(bufoff, 21); \
        aO1 = MFMA32(fq7, Sbs, aO1); \
        fq7 = SC_FRAG(bufoff, 29); \
        Sbs = PACK8(S2, 0); \
        aV0 = MFMA32(fq0, Sbs, aV0); \
        fq0 = SC_FRAG(bufoff, 6); \
        aV1 = MFMA32(fq1, Sbs, aV1); \
        fq1 = SC_FRAG(bufoff, 14); \
        aO0 = MFMA32(fq2, Sbs, aO0); \
        fq2 = SC_FRAG(bufoff, 22); \
        aO1 = MFMA32(fq3, Sbs, aO1); \
        fq3 = SC_FRAG(bufoff, 30); \
        Sbs = PACK8(S2, 1); \
        aV0 = MFMA32(fq4, Sbs, aV0); \
        fq4 = SC_FRAG(bufoff, 7); \
        aV1 = MFMA32(fq5, Sbs, aV1); \
        fq5 = SC_FRAG(bufoff, 15); \
        aO0 = MFMA32(fq6, Sbs, aO0); \
        fq6 = SC_FRAG(bufoff, 23); \
        aO1 = MFMA32(fq7, Sbs, aO1); \
        fq7 = SC_FRAG(bufoff, 31); \
        Sbs = PACK8(S3, 0); \
        aV0 = MFMA32(fq0, Sbs, aV0); \
        fq0 = SC_FRAG(bufoff, 40); \
        aV1 = MFMA32(fq1, Sbs, aV1); \
        fq1 = SC_FRAG(bufoff, 44); \
        aO0 = MFMA32(fq2, Sbs, aO0); \
        fq2 = SC_FRAG(bufoff, 36); \
        aO1 = MFMA32(fq3, Sbs, aO1); \
        fq3 = SC_FRAG(bufoff, 48); \
        Sbs = PACK8(S3, 1); \
        aV0 = MFMA32(fq4, Sbs, aV0); \
        fq4 = SC_FRAG(bufoff, 52); \
        aV1 = MFMA32(fq5, Sbs, aV1); \
        fq5 = SC_FRAG(bufoff, 32); \
        S0 = S0 * cd; S1 = S1 * cd; S2 = S2 * cd; S3 = S3 * cd; \
        aO0 = MFMA32(fq6, Sbs, aO0); \
        fq6 = SC_FRAG(bufoff, 41); \
        aO1 = MFMA32(fq7, Sbs, aO1); \
        fq7 = SC_FRAG(bufoff, 45); \
        Vb0 = PACK8(aV0, 0); Vb1 = PACK8(aV0, 1); Vb2 = PACK8(aV1, 0); Vb3 = PACK8(aV1, 1); \
        S0 = MFMA32(fq0, Vb0, S0); \
        fq0 = SC_FRAG(bufoff, 37); \
        S1 = MFMA32(fq1, Vb0, S1); \
        fq1 = SC_FRAG(bufoff, 49); \
        aO1 = MFMA32(fq2, Vb0, aO1); \
        fq2 = SC_FRAG(bufoff, 53); \
        S2 = MFMA32(fq3, Vb0, S2); \
        fq3 = SC_FRAG(bufoff, 33); \
        S3 = MFMA32(fq4, Vb0, S3); \
        fq4 = SC_FRAG(bufoff, 42); \
        aO0 = MFMA32(fq5, Vb0, aO0); \
        fq5 = SC_FRAG(bufoff, 46); \
        S0 = MFMA32(fq6, Vb1, S0); \
        fq6 = SC_FRAG(bufoff, 38); \
        S1 = MFMA32(fq7, Vb1, S1); \
        fq7 = SC_FRAG(bufoff, 50); \
        aO1 = MFMA32(fq0, Vb1, aO1); \
        fq0 = SC_FRAG(bufoff, 54); \
        S2 = MFMA32(fq1, Vb1, S2); \
        fq1 = SC_FRAG(bufoff, 43); \
        S3 = MFMA32(fq2, Vb1, S3); \
        fq2 = SC_FRAG(bufoff, 47); \
        aO0 = MFMA32(fq3, Vb1, aO0); \
        fq3 = SC_FRAG(bufoff, 39); \
        S0 = MFMA32(fq4, Vb2, S0); \
        fq4 = SC_FRAG(bufoff, 51); \
        S1 = MFMA32(fq5, Vb2, S1); \
        fq5 = SC_FRAG(bufoff, 55); \
        aO1 = MFMA32(fq6, Vb2, aO1); \
        S2 = MFMA32(fq7, Vb2, S2); \
        S3 = MFMA32(fq0, Vb2, S3); \
        S0 = MFMA32(fq1, Vb3, S0); \
        S1 = MFMA32(fq2, Vb3, S1); \
        aO1 = MFMA32(fq3, Vb3, aO1); \
        S2 = MFMA32(fq4, Vb3, S2); \
        S3 = MFMA32(fq5, Vb3, S3); \
        _Pragma("unroll") for (int r = 0; r < 16; ++r) { \
            *(LAS bf16*)(lds + (otoff) + (((r & 3) + 8 * (r >> 2) + 4 * hf) * OT_LD + 32 * w + c32) * 2) = (bf16)(pkbf(aO0[r], 0.f) & 0xffffu); \
            *(LAS bf16*)(lds + (otoff) + ((32 + (r & 3) + 8 * (r >> 2) + 4 * hf) * OT_LD + 32 * w + c32) * 2) = (bf16)(pkbf(aO1[r], 0.f) & 0xffffu); } \
        RAW_BAR(); } while (0)
        SC_LOADU(UA, 0);
        RAW_BAR();
#pragma unroll 1
        for (int n = 0; n < NCH; n += 2) { SC_CHUNK(n, UA, 0, OT_OFF); SC_CHUNK(n + 1, UA, SCB, OT_OFF + OT_BYTES); }
#undef SC_CHUNK
#undef SC_FRAG
#undef SC_LOADU
#endif
    } else {
#ifndef SCAN_NO_HELPER
        const int ht = F.tid - 256, tok = ht >> 2, q = ht & 3;
        bf16* MIXIN = (bf16*)(ws + WS_MIXIN);
        v4u RA[14], RB[14];
        const __amdgpu_buffer_rsrc_t rsI = __builtin_amdgcn_make_buffer_rsrc((void*)(IMG + chd0 * IMG_ELEMS), (short)0, NCH * NH * IMG_ELEMS * 2, 0x00020000);
#define SH_LOADIMG(dst, nn) do { _Pragma("unroll") for (int i_ = 0; i_ < 14; ++i_) dst[i_] = __builtin_amdgcn_raw_buffer_load_b128(rsI, (unsigned)ht * 16u, (unsigned)(nn) * (unsigned)(NH * IMG_ELEMS * 2) + (unsigned)i_ * 4096u, 0); } while (0)
#define SH_STOREIMG(src, bufoff) do { LAS v4u* p_ = (LAS v4u*)(lds + (bufoff)) + ht; _Pragma("unroll") for (int i_ = 0; i_ < 14; ++i_) p_[i_ * 256] = src[i_]; } while (0)
#define SH_EPI(mm, otoff) do { const LAS v4u* op_ = (const LAS v4u*)(lds + (otoff) + (tok * OT_LD + 32 * q) * 2); \
        v4u* yp_ = (v4u*)(MIXIN + ((size_t)b * SEQ + (size_t)(mm) * CH + tok) * D + h * HD + 32 * q); \
        _Pragma("unroll") for (int i_ = 0; i_ < 4; ++i_) yp_[i_] = op_[i_]; } while (0)
#define SH_STEP(nn, Rcur, Rnext, bufnext, otprev) do { \
        if ((nn) + 2 < NCH) SH_LOADIMG(Rcur, (nn) + 2); \
        if ((nn) >= 1) SH_EPI((nn) - 1, otprev); \
        if ((nn) + 1 < NCH) SH_STOREIMG(Rnext, bufnext); \
        RAW_BAR(); } while (0)
        SH_LOADIMG(RA, 0); SH_LOADIMG(RB, 1);
        SH_STOREIMG(RA, 0);
        RAW_BAR();
#pragma unroll 1
        for (int n = 0; n < NCH; n += 2) { SH_STEP(n, RA, RB, SCB, OT_OFF + OT_BYTES); SH_STEP(n + 1, RB, RA, 0, OT_OFF); }
        SH_EPI(NCH - 1, OT_OFF + OT_BYTES);
#undef SH_STEP
#undef SH_EPI
#undef SH_STOREIMG
#undef SH_LOADIMG
#endif
    }
}

__device__ __forceinline__ void phase_dn_norm(const Frame& F0, const Args& a, int layer) {
    PHASE_FRAME(F0);
    unsigned char* ws = OPQ_G(unsigned char, a.ws);
    const bf16* PROJ = (const bf16*)(ws + WS_PROJ); bf16* MIXIN = (bf16*)(ws + WS_MIXIN);
    const int lane = F.lane, gw = F.vcu * NWAVES + F.wave, NGW = F.G * NWAVES;
    const float* nw = a.in[I_NORMW] + layer * HD + 16 * (lane & 7); f32x4 nwv[4];
#pragma unroll
    for (int i = 0; i < 4; ++i) nwv[i] = *(const f32x4*)(nw + 4 * i);
    v4u OA[2], ZA[2], OB[2], ZB[2];
#define DNN_LOAD(O_, Z_, t) do { const v4u* op_ = (const v4u*)(MIXIN + (size_t)(t) * D + 16 * lane); const v4u* zp_ = (const v4u*)(PROJ + (size_t)(t) * NPROJ + 3072 + 16 * lane); O_[0] = op_[0]; O_[1] = op_[1]; Z_[0] = zp_[0]; Z_[1] = zp_[1]; } while (0)
#define DNN_ROW(O_, Z_, t) do { float ss = 0.f; \
        _Pragma("unroll") for (int i = 0; i < 2; ++i) _Pragma("unroll") for (int j = 0; j < 4; ++j) { const float x0 = bflo(O_[i][j]), x1 = bfhi(O_[i][j]); ss += x0 * x0 + x1 * x1; } \
        ss += __shfl_xor(ss, 1); ss += __shfl_xor(ss, 2); ss += __shfl_xor(ss, 4); const float rr = 1.0f / sqrtf(ss * (1.0f / HD) + RMS_EPS); \
        v4u* yp_ = (v4u*)(MIXIN + (size_t)(t) * D + 16 * lane); \
        _Pragma("unroll") for (int i = 0; i < 2; ++i) { v4u o_; _Pragma("unroll") for (int j = 0; j < 4; ++j) { const float z0 = bflo(Z_[i][j]), z1 = bfhi(Z_[i][j]); const f32x4 nn = nwv[2 * i + (j >> 1)]; \
            o_[j] = pkbf(bflo(O_[i][j]) * rr * nn[2 * (j & 1)] * z0 * sigmoidf_(z0), bfhi(O_[i][j]) * rr * nn[2 * (j & 1) + 1] * z1 * sigmoidf_(z1)); } yp_[i] = o_; } } while (0)
    if (gw < T) DNN_LOAD(OA, ZA, gw);
#pragma unroll 1
    for (int t = gw; t < T; t += 2 * NGW) {
        if (t + NGW < T) DNN_LOAD(OB, ZB, t + NGW);
        DNN_ROW(OA, ZA, t);
        if (t + 2 * NGW < T) DNN_LOAD(OA, ZA, t + 2 * NGW);
        if (t + NGW < T) DNN_ROW(OB, ZB, t + NGW);
    }
#undef DNN_LOAD
#undef DNN_ROW
}

__device__ __forceinline__ void phase_ln1_router(const Frame& F0, const Args& a, int layer, int probe = 0, int f8 = 0) {
    PHASE_FRAME(F0);
    unsigned char* ws = OPQ_G(unsigned char, a.ws);
    LAS float* WRt = (LAS float*)F.lds;
    LAS float* GV = (LAS float*)(F.lds + RING_BYTES);
    LAS int* rowE = (LAS int*)(F.lds + AUX_OFF); LAS int* rowP = rowE + 128; LAS float* rowG = (LAS float*)(rowP + 128); LAS int* lcnt = (LAS int*)(rowG + 128); LAS int* lbase = lcnt + 16;
    const float* wr = OPQ_G(const float, a.in[I_WR]); const float* br = OPQ_G(const float, a.in[I_BR]);
    for (int idx = F.tid; idx < D * NE; idx += 512) WRt[(idx & 15) * D + (idx >> 4)] = wr[idx];
    { const float* g1 = a.in[I_LN1G] + (size_t)layer * D; const float* b1 = a.in[I_LN1B] + (size_t)layer * D; for (int i = F.tid; i < D; i += 512) { GV[i] = g1[i]; GV[D + i] = b1[i]; } }
    const bf16* PRE = (const bf16*)a.out; bf16* X1B = (bf16*)(ws + (probe ? WS_R1 : WS_X1B)); float* STATS = (float*)(ws + (probe ? WS_R1 + 70 * MiB : WS_STATS));
    int* LIST = (int*)(ws + (probe ? WS_R1 + 72 * MiB : WS_LIST)); int* TOKSLOT = (int*)(ws + (probe ? WS_R1 + 80 * MiB : WS_TOKSLOT)); float* GATEW = (float*)(ws + (probe ? WS_R1 + 82 * MiB : WS_GATEW));
    gu32* cnt = F.ctl + CW_CNT + 64 * (layer + (probe ? 2 : 0));
    const int lane = F.lane; const float brl = br[(lane >> 2) & 15];
    for (int rb = F.vcu; rb < T / 64; rb += F.G) {
        if (F.tid < 16) lcnt[F.tid] = 0;
        __syncthreads();
        v2u XA[8], XB_[8];
#define PE_LOAD(X, r) do { const GAS v2u* xr_ = (const GAS v2u*)(PRE + (size_t)(rb * 64 + F.wave * 8 + (r)) * D) + lane; _Pragma("unroll") for (int j = 0; j < 8; ++j) X[j] = xr_[64 * j]; } while (0)
#define PE_ROW(X, r) do { const int lr = F.wave * 8 + (r), row = rb * 64 + lr; unsigned gvo_ = (unsigned)(uintptr_t)GV; asm volatile("" : "+v"(gvo_)); const LAS float* GVr = (const LAS float*)(uintptr_t)gvo_; \
            f32x4 v[8]; float s = 0.f; \
            _Pragma("unroll") for (int j = 0; j < 8; ++j) { v[j] = (f32x4){bflo(X[j].x), bfhi(X[j].x), bflo(X[j].y), bfhi(X[j].y)}; s += (v[j][0] + v[j][1]) + (v[j][2] + v[j][3]); } \
            const float mean = wave_sum(s) * (1.f / D); float s2 = 0.f; \
            _Pragma("unroll") for (int j = 0; j < 8; ++j) { v[j] = v[j] - mean; s2 += (v[j][0] * v[j][0] + v[j][1] * v[j][1]) + (v[j][2] * v[j][2] + v[j][3] * v[j][3]); } \
            const float rstd = 1.f / sqrtf(wave_sum(s2) * (1.f / D) + LN_EPS); \
            if (lane == 0) { STATS[2 * row] = mean; STATS[2 * row + 1] = rstd; } \
            GAS v2u* o8 = (GAS v2u*)(X1B + (size_t)row * D) + lane; \
            float lg[16]; \
            _Pragma("unroll") for (int e = 0; e < 16; ++e) lg[e] = 0.f; \
            _Pragma("unroll") for (int j = 0; j < 8; ++j) { const f32x4 gg = *(const LAS f32x4*)(GVr + 256 * j + 4 * lane), bb = *(const LAS f32x4*)(GVr + D + 256 * j + 4 * lane); \
                v[j] = v[j] * rstd * gg + bb; \
                if (f8) ((GAS unsigned*)((GAS unsigned char*)X1B + (size_t)row * D) + lane)[64 * j] = pk4_fp8(v[j][0] * F8_XS, v[j][1] * F8_XS, v[j][2] * F8_XS, v[j][3] * F8_XS); \
                else { v2u w; w.x = pkbf(v[j][0], v[j][1]); w.y = pkbf(v[j][2], v[j][3]); o8[64 * j] = w; } \
                _Pragma("unroll") for (int e = 0; e < 16; ++e) { const f32x4 w4 = *(const LAS f32x4*)(WRt + e * D + 256 * j + 4 * lane); lg[e] += (v[j][0] * w4[0] + v[j][1] * w4[1]) + (v[j][2] * w4[2] + v[j][3] * w4[3]); } } \
              \
            float t8[8], t4[4], t2[2], t1; \
            { const bool hi = (lane & 32) != 0; _Pragma("unroll") for (int i = 0; i < 8; ++i) { const float snd = hi ? lg[i] : lg[8 + i], kp = hi ? lg[8 + i] : lg[i]; t8[i] = kp + __shfl_xor(snd, 32); } } \
            { const bool hi = (lane & 16) != 0; _Pragma("unroll") for (int i = 0; i < 4; ++i) { const float snd = hi ? t8[i] : t8[4 + i], kp = hi ? t8[4 + i] : t8[i]; t4[i] = kp + __shfl_xor(snd, 16); } } \
            { const bool hi = (lane & 8) != 0; _Pragma("unroll") for (int i = 0; i < 2; ++i) { const float snd = hi ? t4[i] : t4[2 + i], kp = hi ? t4[2 + i] : t4[i]; t2[i] = kp + __shfl_xor(snd, 8); } } \
            { const bool hi = (lane & 4) != 0; const float snd = hi ? t2[0] : t2[1], kp = hi ? t2[1] : t2[0]; t1 = kp + __shfl_xor(snd, 4); } \
            t1 += __shfl_xor(t1, 2); t1 += __shfl_xor(t1, 1); t1 += brl; \
            float lgu[16]; float mx = -3.0e38f; \
            _Pragma("unroll") for (int e = 0; e < 16; ++e) { lgu[e] = __builtin_bit_cast(float, __builtin_amdgcn_readlane(__builtin_bit_cast(int, t1), 4 * e)); mx = fmaxf(mx, lgu[e]); } \
            float p[16]; \
            _Pragma("unroll") for (int e = 0; e < 16; ++e) p[e] = __expf(lgu[e] - mx); \
            float gsc[4]; \
            _Pragma("unroll") for (int g = 0; g < 4; ++g) { const float a0 = p[4 * g], a1 = p[4 * g + 1], a2 = p[4 * g + 2], a3 = p[4 * g + 3]; \
                const float hi1 = fmaxf(a0, a1), lo1 = fminf(a0, a1), hi2 = fmaxf(a2, a3), lo2 = fminf(a2, a3); \
                gsc[g] = fmaxf(hi1, hi2) + fmaxf(fminf(hi1, hi2), fmaxf(lo1, lo2)); } \
            int gsel = 0; float best = gsc[0]; \
            _Pragma("unroll") for (int g = 1; g < 4; ++g) if (gsc[g] > best) { best = gsc[g]; gsel = g; } \
            float q[4]; \
            _Pragma("unroll") for (int j = 0; j < 4; ++j) q[j] = gsel == 0 ? p[j] : (gsel == 1 ? p[4 + j] : (gsel == 2 ? p[8 + j] : p[12 + j])); \
            int i0 = 0; float p0 = q[0]; \
            _Pragma("unroll") for (int j = 1; j < 4; ++j) if (q[j] > p0) { p0 = q[j]; i0 = j; } \
            int i1 = -1; float p1 = -1.f; \
            _Pragma("unroll") for (int j = 0; j < 4; ++j) if (j != i0 && q[j] > p1) { p1 = q[j]; i1 = j; } \
            if (lane == 0) { const int e0 = gsel * 4 + i0, e1 = gsel * 4 + i1; const float inv = 1.0f / (p0 + p1); \
                rowE[2 * lr] = e0; rowE[2 * lr + 1] = e1; rowG[2 * lr] = p0 * inv; rowG[2 * lr + 1] = p1 * inv; \
                rowP[2 * lr] = __hip_atomic_fetch_add(&lcnt[e0], 1, __ATOMIC_RELAXED, __HIP_MEMORY_SCOPE_WORKGROUP); rowP[2 * lr + 1] = __hip_atomic_fetch_add(&lcnt[e1], 1, __ATOMIC_RELAXED, __HIP_MEMORY_SCOPE_WORKGROUP); } } while (0)
        PE_LOAD(XA, 0);
#pragma unroll 1
        for (int r = 0; r < 8; r += 2) { PE_LOAD(XB_, r + 1); PE_ROW(XA, r); if (r + 2 < 8) PE_LOAD(XA, r + 2); PE_ROW(XB_, r + 1); }
#undef PE_LOAD
#undef PE_ROW
        __syncthreads();
        if (F.tid < 16) lbase[F.tid] = (int)__hip_atomic_fetch_add(cnt + F.tid, (unsigned)lcnt[F.tid], RLX_AGENT);
        __syncthreads();
        if (F.tid < 128) { const int e = rowE[F.tid], pos = lbase[e] + rowP[F.tid], tok = rb * 64 + (F.tid >> 1);
            LIST[(size_t)e * LCAP + pos] = tok; TOKSLOT[2 * tok + (F.tid & 1)] = e * LCAP + pos; GATEW[2 * tok + (F.tid & 1)] = rowG[F.tid]; }
        __syncthreads();
    }
}
__device__ __forceinline__ void moe_table(const Frame& F0, int layer) {
    PHASE_FRAME(F0);
    LAS int* tab = (LAS int*)(F.lds + AUX_OFF);
    __syncthreads();
    if (F.tid < 16) tab[32 + F.tid] = (int)__hip_atomic_load(F.ctl + CW_CNT + 64 * layer + F.tid, RLX_AGENT);
    __syncthreads();
    if (F.tid == 0) { int run = 0; for (int e = 0; e < 16; ++e) { tab[e] = run; run += (tab[32 + e] + 255) >> 8; } tab[16] = run; }
    __syncthreads();
}
__device__ __forceinline__ void phase_combine_ln2(const Frame& F0, const Args& a, int layer, int probe = 0, int f8 = 0) {
    PHASE_FRAME(F0);
    unsigned char* ws = OPQ_G(unsigned char, a.ws); const LAS int* tab = (const LAS int*)(F.lds + AUX_OFF);
    const bf16* PRE = (const bf16*)a.out; const float* STATS = (const float*)(ws + WS_STATS); const bf16* Y = (const bf16*)(ws + WS_Y); bf16* X2B = (bf16*)(ws + (probe ? WS_R1 : WS_X2B)); unsigned char* X2F8 = ws + WS_X2F8;
    const int* TOKSLOT = (const int*)(ws + WS_TOKSLOT); const float* GATEW = (const float*)(ws + WS_GATEW);
    LAS float* GV = (LAS float*)F.lds;
    { const float* g1 = a.in[I_LN1G] + (size_t)layer * D; const float* b1 = a.in[I_LN1B] + (size_t)layer * D; const float* g2 = a.in[I_LN2G] + (size_t)layer * D; const float* b2 = a.in[I_LN2B] + (size_t)layer * D;
        for (int i = F.tid; i < D; i += 512) { GV[i] = g1[i]; GV[D + i] = b1[i]; GV[2 * D + i] = g2[i]; GV[3 * D + i] = b2[i]; } }
    __syncthreads();
    const int gw = F.vcu * NWAVES + F.wave, NGW = F.G * NWAVES, nrows = (T - gw + NGW - 1) / NGW, lane = F.lane;
    for (int base = 0; base < nrows; base += 64) {
        const int nr = (nrows - base) < 64 ? (nrows - base) : 64;
        float m_mean = 0.f, m_rstd = 0.f, m_w0 = 0.f, m_w1 = 0.f; int m_y0 = 0, m_y1 = 0;
        if (lane < nr) { const int row = gw + NGW * (base + lane); m_mean = STATS[2 * row]; m_rstd = STATS[2 * row + 1]; m_w0 = GATEW[2 * row]; m_w1 = GATEW[2 * row + 1];
            const int s0 = TOKSLOT[2 * row], s1 = TOKSLOT[2 * row + 1]; m_y0 = tab[s0 / LCAP] * 256 + (s0 % LCAP); m_y1 = tab[s1 / LCAP] * 256 + (s1 % LCAP); }
        v2u XA[8], PA[8], QA[8], XB_[8], PB_[8], QB_[8];
#define PH_LOAD(X, P, Q, i) do { const int row_ = gw + NGW * (base + (i)); const size_t y0_ = (size_t)__builtin_amdgcn_readlane(m_y0, (i)), y1_ = (size_t)__builtin_amdgcn_readlane(m_y1, (i)); \
            const GAS v2u* xr_ = (const GAS v2u*)(PRE + (size_t)row_ * D) + lane; const GAS v2u* ya_ = (const GAS v2u*)(Y + y0_ * D) + lane; const GAS v2u* yb_ = (const GAS v2u*)(Y + y1_ * D) + lane; \
            _Pragma("unroll") for (int j = 0; j < 8; ++j) { X[j] = xr_[64 * j]; P[j] = ya_[64 * j]; Q[j] = yb_[64 * j]; } } while (0)
#define PH_ROW(X, P, Q, i) do { const int row_ = gw + NGW * (base + (i)); unsigned gvo_ = (unsigned)(uintptr_t)GV; asm volatile("" : "+v"(gvo_)); const LAS float* GVr = (const LAS float*)(uintptr_t)gvo_;     \
            const float mean = __builtin_bit_cast(float, __builtin_amdgcn_readlane(__builtin_bit_cast(int, m_mean), (i))), rstd = __builtin_bit_cast(float, __builtin_amdgcn_readlane(__builtin_bit_cast(int, m_rstd), (i))); \
            const float w0 = __builtin_bit_cast(float, __builtin_amdgcn_readlane(__builtin_bit_cast(int, m_w0), (i))), w1 = __builtin_bit_cast(float, __builtin_amdgcn_readlane(__builtin_bit_cast(int, m_w1), (i))); \
            f32x4 v[8]; float s = 0.f; \
            _Pragma("unroll") for (int j = 0; j < 8; ++j) { const f32x4 gg = *(const LAS f32x4*)(GVr + 256 * j + 4 * lane), bb = *(const LAS f32x4*)(GVr + D + 256 * j + 4 * lane); \
                const f32x4 x1 = ((f32x4){bflo(X[j].x), bfhi(X[j].x), bflo(X[j].y), bfhi(X[j].y)} - mean) * rstd * gg + bb; \
                f32x4 f; f[0] = w0 * bflo(P[j].x) + w1 * bflo(Q[j].x); f[1] = w0 * bfhi(P[j].x) + w1 * bfhi(Q[j].x); f[2] = w0 * bflo(P[j].y) + w1 * bflo(Q[j].y); f[3] = w0 * bfhi(P[j].y) + w1 * bfhi(Q[j].y); \
                v[j] = x1 * ALPHA + f; s += (v[j][0] + v[j][1]) + (v[j][2] + v[j][3]); } \
            const float m2 = wave_sum(s) * (1.f / D); float q = 0.f; \
            _Pragma("unroll") for (int j = 0; j < 8; ++j) { v[j] = v[j] - m2; q += (v[j][0] * v[j][0] + v[j][1] * v[j][1]) + (v[j][2] * v[j][2] + v[j][3] * v[j][3]); } \
            const float r2 = 1.f / sqrtf(wave_sum(q) * (1.f / D) + LN_EPS); \
            GAS v2u* o8 = (GAS v2u*)(X2B + (size_t)row_ * D) + lane; \
            _Pragma("unroll") for (int j = 0; j < 8; ++j) { const f32x4 gg = *(const LAS f32x4*)(GVr + 2 * D + 256 * j + 4 * lane), bb = *(const LAS f32x4*)(GVr + 3 * D + 256 * j + 4 * lane); \
                const f32x4 o = v[j] * r2 * gg + bb; v2u w; w.x = pkbf(o[0], o[1]); w.y = pkbf(o[2], o[3]); o8[64 * j] = w; \
                if (f8) ((GAS unsigned*)((GAS unsigned char*)X2F8 + (size_t)row_ * D) + lane)[64 * j] = pk4_fp8(o[0] * F8_XS, o[1] * F8_XS, o[2] * F8_XS, o[3] * F8_XS); } } while (0)
        PH_LOAD(XA, PA, QA, 0);
#pragma unroll 1
        for (int i = 0; i < nr; i += 2) {
            if (i + 1 < nr) PH_LOAD(XB_, PB_, QB_, i + 1);
            PH_ROW(XA, PA, QA, i);
            if (i + 2 < nr) PH_LOAD(XA, PA, QA, i + 2);
            if (i + 1 < nr) PH_ROW(XB_, PB_, QB_, i + 1);
        }
#undef PH_LOAD
#undef PH_ROW
    }
}

#ifndef MK_N_LAUNCHES
#define MK_N_LAUNCHES 1
#endif
constexpr int NPL = 10;
constexpr int NPHASE = 1 + NPL * DEPTH;
constexpr int N_LAUNCHES = MK_N_LAUNCHES;
static_assert(N_LAUNCHES == 1 || N_LAUNCHES == NPHASE, "MK_N_LAUNCHES is 1 or NPHASE");

#define GRID_BAR() do { if (N_LAUNCHES == 1) xcd_barrier(bar); } while (0)
#ifndef PH_MASK
#define PH_MASK 0x7ff
#endif
#define IN(k) ((((k) == 0 ? 1u : (2u << (((k) - 1) % NPL))) & (unsigned)(PH_MASK)) && lo <= (k) && (k) < hi)
#define SEAM(k) do { if (IN((k) + 1)) GRID_BAR(); } while (0)
#ifndef PROBE_DUP
#define PROBE_DUP 0
#endif
#define REPS(k) ((((k) == 0 ? 1u : (2u << (((k) - 1) % NPL))) & (unsigned)(PROBE_DUP)) ? 2 : 1)

template <int layer> __device__ __forceinline__ void layer_phases(const Frame& F, const Args& args, const XcdBarrier& bar, const int lo, const int hi) {
            const int pb = 1 + NPL * layer;
            unsigned char* ws = OPQ_G(unsigned char, args.ws);
            if (IN(pb + 0)) { for (int rep = 0; rep < REPS(pb + 0); ++rep) { if (rep) GRID_BAR();
                SchedDense S; S.init(T, NPROJ, F.G, (int)blockIdx.x, ws + WS_XB, D, (const bf16*)(ws + WS_WIN) + (size_t)layer * NPROJ * D, D);
                EpiBf16 E{(bf16*)(ws + WS_PROJ), NPROJ};
                pg8::gemm_phase<EpiBf16, SchedDense, false>(F.lds + RING_OFF, D, D, D, S, E);
                } SEAM(pb + 0);
            }
            if (IN(pb + 1)) { for (int rep = 0; rep < REPS(pb + 1); ++rep) { if (rep) GRID_BAR(); phase_dn_prep(F, args, layer); } SEAM(pb + 1); }
            if (IN(pb + 2)) { for (int rep = 0; rep < REPS(pb + 2); ++rep) { if (rep) GRID_BAR();
                if (blockIdx.x < 32 || F.G <= 32) { for (int u = blockIdx.x; u < NB * NH; u += (F.G < 32 ? F.G : 32)) { phase_dn_scan(F, args, layer, u);
#ifdef SCAN_TWICE
                    __syncthreads(); phase_dn_scan(F, args, layer, u);
#endif
                } }
                if (blockIdx.x >= 32 || F.G <= 32) { const int G2 = F.G <= 32 ? F.G : F.G - 32, c2 = F.G <= 32 ? (int)blockIdx.x : (int)blockIdx.x - 32;
                    { int t_ = threadIdx.x; asm volatile("" : "+v"(t_)); Frame Fp = F; Fp.tid = t_; Fp.lane = t_ & 63;
                      for (int L = c2; L < 256; L += G2) pool_diffs_unit(Fp, ws, L >> 2, L & 3);
                      asm volatile("s_waitcnt vmcnt(0)" ::: "memory"); __syncthreads(); }
                    { SchedPool S{G2, c2, (const char*)(ws + WS_POOLD), (const char*)((const bf16*)(ws + WS_WPOOL) + (size_t)layer * 4 * 65536)};
                      EpiPool E{(bf16*)(ws + WS_MIXIN), args.in[I_POOLS] + (size_t)layer * PW};
                      pg8::gemm_phase<EpiPool, SchedPool, false>(F.lds + RING_OFF, 256, PW, 256, S, E); }
                    { SchedDense S; S.init(T, D, G2, c2, (const bf16*)(ws + WS_PB16) + (size_t)layer * T * PLE, PLE, (const bf16*)(ws + WS_WPP) + (size_t)layer * D * PLE, PLE);
                      EpiBf16 E{(bf16*)(ws + WS_PP), D};
                      pg8::gemm_phase<EpiBf16, SchedDense, false>(F.lds + RING_OFF, PLE, PLE, PLE, S, E); }
#ifndef CONVERT_ALL_IN_PROLOGUE
                    { int t_ = threadIdx.x; asm volatile("" : "+v"(t_)); weight_items(args, ws, (LAS float*)(F.lds + RING_OFF + F.wave * 16384), t_ & 63, 1, layer, c2 * NWAVES + F.wave, G2 * NWAVES); }
#endif
                    }
                } SEAM(pb + 2);
            }
            if (IN(pb + 3)) { for (int rep = 0; rep < REPS(pb + 3); ++rep) { if (rep) GRID_BAR(); phase_dn_norm(F, args, layer); } SEAM(pb + 3); }
            if (IN(pb + 4)) { for (int rep = 0; rep < REPS(pb + 4); ++rep) { if (rep) GRID_BAR();
                SchedDense S; S.init(T, D, F.G, (int)blockIdx.x, ws + WS_MIXIN, D, (const bf16*)(ws + WS_WOUT) + (size_t)layer * D * D, D);
                EpiRes E{(const bf16*)(ws + WS_XB), (bf16*)args.out};
#ifdef PROBE_PD
                { EpiRes E2{(const bf16*)(ws + WS_XB), (bf16*)(ws + WS_R1)}; pg8::gemm_phase<EpiRes, SchedDense, false>(F.lds + RING_OFF, D, D, D, S, E2); }
#endif
                pg8::gemm_phase<EpiRes, SchedDense, false>(F.lds + RING_OFF, D, D, D, S, E);
                } SEAM(pb + 4);
            }
            if (IN(pb + 5)) { for (int rep = 0; rep < REPS(pb + 5); ++rep) { if (rep) GRID_BAR();
#ifdef PROBE_PE
                phase_ln1_router(F, args, layer, 1); __syncthreads();
#endif
                phase_ln1_router(F, args, layer, 0, FP8_LAYER(layer) ? 1 : 0); } SEAM(pb + 5); }
            if (IN(pb + 6)) { for (int rep = 0; rep < REPS(pb + 6); ++rep) { if (rep) GRID_BAR();
                moe_table(F, layer);
                if (FP8_LAYER(layer)) {
                    SchedMoe S{F.G, (int)blockIdx.x, 0, (const LAS int*)(F.lds + AUX_OFF), (const char*)(ws + WS_X1B), (const char*)(ws + WS_WGU + (size_t)layer * NE * 2048 * D * 2), (const int*)(ws + WS_LIST), 1};
                    EpiSwiglu E{(bf16*)(ws + WS_HID), FP8_PG, F8_INV};
                    pg8::gemm_phase<EpiSwiglu, SchedMoe, true, true>(F.lds + RING_OFF, D / 2, D / 2, D / 2, S, E);
                } else {
                    SchedMoe S{F.G, (int)blockIdx.x, 0, (const LAS int*)(F.lds + AUX_OFF), (const char*)(ws + WS_X1B), (const char*)((const bf16*)(ws + WS_WGU) + (size_t)layer * NE * 2048 * D), (const int*)(ws + WS_LIST), 2};
                    EpiSwiglu E{(bf16*)(ws + WS_HID)};
                    pg8::gemm_phase<EpiSwiglu, SchedMoe, true>(F.lds + RING_OFF, D, D, D, S, E);
                }
                } SEAM(pb + 6);
            }
            if (IN(pb + 7)) { for (int rep = 0; rep < REPS(pb + 7); ++rep) { if (rep) GRID_BAR();
                moe_table(F, layer);
                if (FP8_PG && FP8_LAYER(layer)) {
                    SchedMoe S{F.G, (int)blockIdx.x, 1, (const LAS int*)(F.lds + AUX_OFF), (const char*)(ws + WS_HID), (const char*)(ws + WS_WD + (size_t)layer * NE * D * DE * 2), nullptr, 1};
                    EpiBf16 E{(bf16*)(ws + WS_Y), D, F8_INV};
                    pg8::gemm_phase<EpiBf16, SchedMoe, false, true>(F.lds + RING_OFF, DE / 2, DE / 2, DE / 2, S, E);
                } else {
                    SchedMoe S{F.G, (int)blockIdx.x, 1, (const LAS int*)(F.lds + AUX_OFF), (const char*)(ws + WS_HID), (const char*)((const bf16*)(ws + WS_WD) + (size_t)layer * NE * D * DE), nullptr, 2};
                    EpiBf16 E{(bf16*)(ws + WS_Y), D};
                    pg8::gemm_phase<EpiBf16, SchedMoe, false>(F.lds + RING_OFF, DE, DE, DE, S, E);
                }
                } SEAM(pb + 7);
            }
            if (IN(pb + 8)) { for (int rep = 0; rep < REPS(pb + 8); ++rep) { if (rep) GRID_BAR(); moe_table(F, layer);
#ifdef PROBE_PH
                phase_combine_ln2(F, args, layer, 1);
#endif
                phase_combine_ln2(F, args, layer, 0, (FP8_LAST && FP8_PI && layer == DEPTH - 1) ? 1 : 0); } SEAM(pb + 8); }
            if (IN(pb + 9)) { for (int rep = 0; rep < REPS(pb + 9); ++rep) { if (rep) GRID_BAR();
                if (FP8_LAST && FP8_PI && layer == DEPTH - 1) {
                    SchedDense S; S.init(T, D, F.G, (int)blockIdx.x, ws + WS_X2F8, D / 2, ws + WS_WPG + (size_t)layer * D * D * 2, D / 2);
                    EpiPle E{(const bf16*)(ws + WS_X2B), (const bf16*)(ws + WS_PP), (bf16*)(ws + WS_XB), args.out, 1, F8_INV};
                    pg8::gemm_phase<EpiPle, SchedDense, false, true>(F.lds + RING_OFF, D / 2, D / 2, D / 2, S, E);
                } else {
                    SchedDense S; S.init(T, D, F.G, (int)blockIdx.x, ws + WS_X2B, D, (const bf16*)(ws + WS_WPG) + (size_t)layer * D * D, D);
                    EpiPle E{(const bf16*)(ws + WS_X2B), (const bf16*)(ws + WS_PP), (bf16*)(ws + WS_XB), args.out, layer + 1 < DEPTH ? 0 : 1};
                    pg8::gemm_phase<EpiPle, SchedDense, false>(F.lds + RING_OFF, D, D, D, S, E);
                }
                } SEAM(pb + 9);
            }
}
__global__ void __launch_bounds__(NWAVES * 64, 2) trunk_fwd(Args args) {
    extern __shared__ __attribute__((aligned(16))) unsigned char lds[];
    Frame F;
    F.lds = (LAS unsigned char*)lds;
    F.MISC = (volatile LAS unsigned*)(F.lds + MISC_OFF);
    F.tid = threadIdx.x; F.lane = F.tid & 63; F.wave = __builtin_amdgcn_readfirstlane(F.tid >> 6);
    F.G = gridDim.x; { const int bx = blockIdx.x; F.vcu = (F.G % 8 == 0) ? (bx % 8) * (F.G / 8) + bx / 8 : bx; }
    unsigned char* ws = args.ws;
    F.ctl = (gu32*)(ws + WS_CTL);
    for (int u = F.tid; u < (LDS_BYTES - LDSCTL_OFF) / 4; u += NWAVES * 64) ((LAS unsigned*)(F.lds + LDSCTL_OFF))[u] = 0u;
    __syncthreads();
    XcdBarrier bar; bar.bar = (unsigned*)(F.ctl + CW_BAR); bar.x = 0; bar.st = nullptr;
    if (N_LAUNCHES == 1) bar = xcd_barrier_post((unsigned*)(F.ctl + CW_BAR), F.MISC + 8);
    const int lo = args.ph_lo, hi = args.ph_hi;
    if (IN(0)) { for (int rep = 0; rep < REPS(0); ++rep) { if (rep) GRID_BAR(); p0_prologue(F, args); } SEAM(0); }

    layer_phases<0>(F, args, bar, lo, hi);
    layer_phases<1>(F, args, bar, lo, hi);
    static_assert(DEPTH == 2, "layer_phases instantiations");
#undef IN
#undef SEAM
#undef GRID_BAR
}

extern "C" void kernel_launch(void* const* d_in, const int* in_sizes, int n_in, void* d_out, int out_size, void* d_ws, size_t ws_size, hipStream_t stream) {
    static int grid = 0;
    if (grid == 0) {
        if (n_in != 21 || in_sizes[0] != T * D || out_size != T * D || ws_size < WS_END) { fprintf(stderr, "kernel_launch: unexpected shapes (n_in %d, in0 %d, out %d, ws %zu); nothing launched\n", n_in, n_in > 0 ? in_sizes[0] : -1, out_size, ws_size); grid = -1; return; }
        int dev = 0, cus = 0, per_cu = 0;
        if (hipGetDevice(&dev) != hipSuccess || hipDeviceGetAttribute(&cus, hipDeviceAttributeMultiprocessorCount, dev) != hipSuccess) { grid = -1; return; }
        if (hipFuncSetAttribute((const void*)trunk_fwd, hipFuncAttributeMaxDynamicSharedMemorySize, LDS_BYTES) != hipSuccess) { fprintf(stderr, "kernel_launch: hipFuncSetAttribute failed\n"); grid = -1; return; }
        if (hipOccupancyMaxActiveBlocksPerMultiprocessor(&per_cu, (const void*)trunk_fwd, NWAVES * 64, LDS_BYTES) != hipSuccess || per_cu < 1) { fprintf(stderr, "kernel_launch: occupancy query reports %d workgroups per CU\n", per_cu); }
        (void)hipGetLastError();
        grid = cus;
    }
    if (grid < 0) return;
    if (hipMemsetAsync((char*)d_ws + WS_CTL, 0, CTL_ZERO_BYTES, stream) != hipSuccess) return;
    Args a{};
    for (int i = 0; i < 21; ++i) a.in[i] = (const float*)d_in[i];
    a.out = (float*)d_out; a.ws = (unsigned char*)d_ws;
    for (int li = 0; li < N_LAUNCHES; ++li) {
        a.ph_lo = (N_LAUNCHES == 1) ? 0 : li; a.ph_hi = (N_LAUNCHES == 1) ? NPHASE : li + 1; a.li = li; a.pad = 0;
        hipLaunchKernelGGL(trunk_fwd, dim3(grid), dim3(NWAVES * 64), LDS_BYTES, stream, a);
        const hipError_t le = hipPeekAtLastError();
        if (le != hipSuccess) { fprintf(stderr, "kernel_launch: launch %d failed: %s\n", li, hipGetErrorName(le)); break; }
    }
}
```

```cpp
#define MK_N_LAUNCHES 1
#define FP8_ALL 1
#define FP8_PG 1
#define FP8_PI 1
#define FP8_PI0 1
#include <hip/hip_runtime.h>
#include <cstdio>
#include <cstdint>

#define GAS __attribute__((address_space(1)))
#define LAS __attribute__((address_space(3)))
typedef unsigned short bf16;
typedef unsigned v4u __attribute__((ext_vector_type(4)));
typedef unsigned v2u __attribute__((ext_vector_type(2)));
typedef float f32x4 __attribute__((ext_vector_type(4)));
typedef float f32x2 __attribute__((ext_vector_type(2)));
typedef short bf16x8 __attribute__((ext_vector_type(8)));
typedef GAS unsigned gu32;
typedef int v4i_t __attribute__((ext_vector_type(4)));
typedef int v8i_t __attribute__((ext_vector_type(8)));

namespace pg8 {
constexpr int BM = 256, BK = 64, HALF = 128, HTB = HALF * BK * 2  , STAGE_BYTES = 8 * HTB, NXCD = 8, WGM = 8;
__host__ __device__ __forceinline__ int lds_byte(int r, int c) { const int st = (r >> 4) * 2 + (c >> 5), rr = r & 15, cc = c & 31, ob = rr * 64 + cc * 2; return st * 1024 + (ob ^ (((ob >> 9) & 1) << 5)); }
__host__ __device__ __forceinline__ void stage_rc(int b, int& R, int& C) { const int st = b / 1024, sb = b % 1024, swz = sb ^ (((sb >> 9) & 1) << 5); R = (st >> 1) * 16 + swz / 64; C = (st & 1) * 32 + (swz % 64) / 2; }
__host__ __device__ __forceinline__ int perm32(int rho) { const int n = rho >> 4, i = rho & 15; return 8 * (i >> 2) + 4 * n + (i & 3); }

struct Unit { int pm, pn; const char* A; const char* B; const int* rows; int nvalid; int aux; };

__device__ __forceinline__ unsigned cvt_pk_bf16(float lo, float hi) { unsigned r; asm volatile("v_cvt_pk_bf16_f32 %0, %1, %2" : "=v"(r) : "v"(lo), "v"(hi)); return r; }

template <class Epi, class Sched, bool GATHER, bool FP8 = false>
__device__ __forceinline__ void gemm_phase(LAS unsigned char* lds, const int K, const int lda, const int ldb, const Sched& S, const Epi& E) {
    int tid_ = threadIdx.x; asm volatile("" : "+v"(tid_));
    const int tid = tid_, wid = __builtin_amdgcn_readfirstlane(tid >> 6), lane = tid & 63, wr = wid >> 2, wc = wid & 3, fr = lane & 15, fq = lane >> 4;
    const int nt = K / BK;
    unsigned voffA[2], voffB[2]; int RA[2], CA[2];
#pragma unroll
    for (int i = 0; i < 2; ++i) { int R, C; stage_rc(tid * 16 + i * 8192, R, C); const int Rb = Epi::PERM ? ((R & ~31) + perm32(R & 31)) : R;
        RA[i] = R; CA[i] = C; voffA[i] = (unsigned)(R * lda + C) * 2u; voffB[i] = (unsigned)(Rb * ldb + C) * 2u; }
    unsigned gA[2][2], gN[2][2];
    const size_t kstep = (size_t)(BK * 2);
    const size_t hstepA = GATHER ? 0 : (size_t)HALF * lda * 2, hstepB = (size_t)HALF * ldb * 2;
    const unsigned ldsw = (unsigned)wid * 1024u;
    const int aoff = lds_byte(wr * 64 + fr, fq * 8), boff = lds_byte(wc * 32 + fr, fq * 8);
#define PG8_SA(b, h) (((b) * 2 + (h)) * HTB)
#define PG8_SB(b, h) ((4 + (b) * 2 + (h)) * HTB)
#define PG8_STAGE_B(bufoff, gbase) do { _Pragma("unroll") for (int _i = 0; _i < 2; ++_i) \
        __builtin_amdgcn_global_load_lds((const unsigned*)((const char*)(gbase) + voffB[_i]), (LAS unsigned*)(lds + (bufoff) + ldsw + _i * 8192), 16, 0, 0); } while (0)
#define PG8_STAGE_A(bufoff, gbase, h) do { _Pragma("unroll") for (int _i = 0; _i < 2; ++_i) \
        __builtin_amdgcn_global_load_lds((const unsigned*)((const char*)(gbase) + (GATHER ? gA[h][_i] : voffA[_i]) + (h) * hstepA), (LAS unsigned*)(lds + (bufoff) + ldsw + _i * 8192), 16, 0, 0); } while (0)
#define PG8_CAT(x0, x1) __builtin_shufflevector(__builtin_bit_cast(v4i_t, (x0)), __builtin_bit_cast(v4i_t, (x1)), 0, 1, 2, 3, 4, 5, 6, 7)
#define PG8_LDA(dst, b, h) do { _Pragma("unroll") for (int m = 0; m < 4; ++m) { if constexpr (FP8) dst##8[m] = PG8_CAT(*(const LAS bf16x8*)(lds + PG8_SA(b, h) + aoff + m * 2048), *(const LAS bf16x8*)(lds + PG8_SA(b, h) + aoff + m * 2048 + 1024)); \
        else { _Pragma("unroll") for (int k = 0; k < 2; ++k) dst[m][k] = *(const LAS bf16x8*)(lds + PG8_SA(b, h) + aoff + m * 2048 + k * 1024); } } } while (0)
#define PG8_LDB(dst, b, h) do { _Pragma("unroll") for (int n = 0; n < 2; ++n) { if constexpr (FP8) dst##8[n] = PG8_CAT(*(const LAS bf16x8*)(lds + PG8_SB(b, h) + boff + n * 2048), *(const LAS bf16x8*)(lds + PG8_SB(b, h) + boff + n * 2048 + 1024)); \
        else { _Pragma("unroll") for (int k = 0; k < 2; ++k) dst[n][k] = *(const LAS bf16x8*)(lds + PG8_SB(b, h) + boff + n * 2048 + k * 1024); } } } while (0)
#define PG8_MMA(ai, bj, At, Bt) do { __builtin_amdgcn_s_setprio(1); \
        if constexpr (FP8) { _Pragma("unroll") for (int m = 0; m < 4; ++m) _Pragma("unroll") for (int n = 0; n < 2; ++n) \
            asm volatile("v_mfma_scale_f32_16x16x128_f8f6f4 %0, %1, %2, %0, %3, %3 op_sel_hi:[0,0,0]" : "+v"(acc[ai][bj][m][n]) : "v"(Bt##8[n]), "v"(At##8[m]), "v"(f8scale)); } \
        else { _Pragma("unroll") for (int m = 0; m < 4; ++m) _Pragma("unroll") for (int n = 0; n < 2; ++n) _Pragma("unroll") for (int k = 0; k < 2; ++k) \
            acc[ai][bj][m][n] = __builtin_amdgcn_mfma_f32_16x16x32_bf16(Bt[n][k], At[m][k], acc[ai][bj][m][n], 0, 0, 0); } \
        __builtin_amdgcn_s_setprio(0); } while (0)
#define PG8_WAIT_V(n) asm volatile("s_waitcnt vmcnt(" #n ")" ::: "memory")
#define PG8_WAIT_L(n) asm volatile("s_waitcnt lgkmcnt(" #n ")" ::: "memory")
#define PG8_BAR __builtin_amdgcn_s_barrier()
#define PG8_SCHED __builtin_amdgcn_sched_barrier(0)
#define PG8_GLOAD(dst, u) do { _Pragma("unroll") for (int _h = 0; _h < 2; ++_h) _Pragma("unroll") for (int _i = 0; _i < 2; ++_i) { const int _r = _h * HALF + RA[_i]; \
        const int _t = (_r < (u).nvalid) ? (u).rows[_r] : 0; dst[_h][_i] = (unsigned)(_t * lda + CA[_i]) * 2u; } } while (0)
    Unit cur, nxt; int ui = 0;
    if (!S.next(0, cur)) return;
    f32x4 acc[2][2][4][2];
#pragma unroll
    for (int a = 0; a < 2; ++a)
#pragma unroll
        for (int b = 0; b < 2; ++b)
#pragma unroll
            for (int m = 0; m < 4; ++m)
#pragma unroll
                for (int n = 0; n < 2; ++n) acc[a][b][m][n] = (f32x4){0.f, 0.f, 0.f, 0.f};
    const unsigned f8scale = 0x7f7f7f7fu;
    bf16x8 At[4][2], B0[2][2], B1[2][2]; v8i_t At8[4], B08[2], B18[2];
    const char* cA = cur.A; const char* cB = cur.B;
    if constexpr (GATHER) { PG8_GLOAD(gA, cur); PG8_WAIT_V(0); }
    PG8_STAGE_B(PG8_SB(0, 0), cB); PG8_STAGE_B(PG8_SB(0, 1), cB + hstepB); PG8_STAGE_A(PG8_SA(0, 0), cA, 0); PG8_STAGE_A(PG8_SA(0, 1), cA, 1);
    if (wr == 1) PG8_BAR;
    PG8_WAIT_V(2); PG8_BAR;
    PG8_STAGE_B(PG8_SB(1, 0), cB + kstep); PG8_STAGE_A(PG8_SA(1, 0), cA + kstep, 0); PG8_STAGE_B(PG8_SB(1, 1), cB + hstepB + kstep);
    PG8_WAIT_V(6); PG8_BAR;
    for (;;) {
        const bool has_next = S.next(ui + 1, nxt);
        const char* nA = has_next ? nxt.A : cA; const char* nB = has_next ? nxt.B : cB;
        if constexpr (GATHER) { if (has_next) { PG8_GLOAD(gN, nxt); } else {
#pragma unroll
            for (int h = 0; h < 2; ++h)
#pragma unroll
                for (int i = 0; i < 2; ++i) gN[h][i] = gA[h][i]; } }
#pragma unroll 1
        for (int t = 0; t < nt; t += 2) {
            const bool last = (t == nt - 2);
            const char* a1 = cA + (size_t)(t + 1) * kstep;
            const char* a2 = last ? nA : cA + (size_t)(t + 2) * kstep; const char* b2 = last ? nB : cB + (size_t)(t + 2) * kstep;
            const char* a3 = a2 + kstep; const char* b3 = b2 + kstep;
            PG8_LDB(B0, 0, 0); PG8_LDB(B1, 0, 1); PG8_SCHED; PG8_LDA(At, 0, 0); PG8_STAGE_A(PG8_SA(1, 1), a1, 1);
            if constexpr (GATHER) { if (last) {
#pragma unroll
                for (int h = 0; h < 2; ++h)
#pragma unroll
                    for (int i = 0; i < 2; ++i) gA[h][i] = gN[h][i]; } }
            PG8_WAIT_V(8); PG8_WAIT_L(0); PG8_BAR; PG8_MMA(0, 0, At, B0); PG8_MMA(0, 1, At, B1); PG8_BAR; PG8_SCHED;
            PG8_LDA(At, 0, 1); PG8_STAGE_B(PG8_SB(0, 0), b2); PG8_STAGE_B(PG8_SB(0, 1), b2 + hstepB); PG8_STAGE_A(PG8_SA(0, 0), a2, 0);
            PG8_WAIT_V(8); PG8_WAIT_L(0); PG8_BAR; PG8_MMA(1, 0, At, B0); PG8_MMA(1, 1, At, B1); PG8_BAR; PG8_SCHED;
            PG8_LDB(B0, 1, 0); PG8_LDB(B1, 1, 1); PG8_SCHED; PG8_LDA(At, 1, 0); PG8_STAGE_A(PG8_SA(0, 1), a2, 1);
            PG8_WAIT_V(8); PG8_WAIT_L(0); PG8_BAR; PG8_MMA(0, 0, At, B0); PG8_MMA(0, 1, At, B1); PG8_BAR; PG8_SCHED;
            PG8_LDA(At, 1, 1); PG8_STAGE_B(PG8_SB(1, 0), b3); PG8_STAGE_B(PG8_SB(1, 1), b3 + hstepB); PG8_STAGE_A(PG8_SA(1, 0), a3, 0);
            PG8_WAIT_V(8); PG8_WAIT_L(0); PG8_BAR; PG8_MMA(1, 0, At, B0); PG8_MMA(1, 1, At, B1); PG8_BAR; PG8_SCHED;
        }
        if (wr == 0) PG8_BAR;
        if constexpr (FP8) asm volatile("s_nop 15\n\ts_nop 15\n\ts_nop 15" ::: "memory");
        E(acc, cur, wr, wc, fr, fq);
        if (!has_next) break;
#pragma unroll
        for (int a = 0; a < 2; ++a)
#pragma unroll
            for (int b = 0; b < 2; ++b)
#pragma unroll
                for (int m = 0; m < 4; ++m)
#pragma unroll
                    for (int n = 0; n < 2; ++n) acc[a][b][m][n] = (f32x4){0.f, 0.f, 0.f, 0.f};
        cur = nxt; cA = nA; cB = nB; ++ui;
        if (wr == 1) PG8_BAR;
    }
    PG8_WAIT_V(0);
    PG8_BAR;
#undef PG8_SA
#undef PG8_SB
#undef PG8_STAGE_A
#undef PG8_STAGE_B
#undef PG8_LDA
#undef PG8_LDB
#undef PG8_MMA
#undef PG8_CAT
#undef PG8_WAIT_V
#undef PG8_WAIT_L
#undef PG8_BAR
#undef PG8_SCHED
#undef PG8_GLOAD
}
}

constexpr int NB = 4, SEQ = 4096, D = 2048, DEPTH = 2;
constexpr int T = NB * SEQ;
constexpr int NH = 8, HD = 128, DNW = 1024, CH = 64, NCH = SEQ / CH;
constexpr int PW = 1024, PG_DIM = 256;
constexpr int IN_COLS = 5136, NPROJ = 5120;
constexpr int NE = 16, DE = 1024, PLE = 256;
constexpr float ALPHA = 1.4142135623730951f;
constexpr float LN_EPS = 1e-5f, RMS_EPS = 1e-6f;
constexpr int LCAP = T;
constexpr int MAXTILES = 2 * T / 256 + NE;

constexpr size_t MiB = 1u << 20;
constexpr size_t WS_CTL = 0, CTL_ZERO_BYTES = 64 * 1024;
constexpr size_t WS_LIST = 2 * MiB;
constexpr size_t WS_TOKSLOT = 3 * MiB, WS_GATEW = WS_TOKSLOT + 128 * 1024, WS_STATS = WS_GATEW + 128 * 1024, WS_CD = WS_STATS + 128 * 1024, WS_WBA = WS_CD + 128 * 1024;
constexpr size_t WS_WIN = 4 * MiB, WS_WOUT = 44 * MiB, WS_WPG = 60 * MiB, WS_WPP = 76 * MiB, WS_WPOOL = 78 * MiB, WS_WGU = 80 * MiB, WS_WD = 336 * MiB, WS_PB16 = 464 * MiB;
constexpr size_t WS_XB = 480 * MiB, WS_R1 = 544 * MiB, WS_R2 = 704 * MiB, WS_R4 = 848 * MiB, WS_R5 = 944 * MiB, WS_END = 1008 * MiB;
constexpr size_t WS_PROJ = WS_R1, WS_HID = WS_R1;
constexpr size_t WS_Y = WS_R2;
constexpr size_t WS_POOLD = WS_R4, WS_PP = WS_R4 + 32 * MiB, WS_X1B = WS_R2;
constexpr size_t WS_MIXIN = WS_R5, WS_X2B = WS_R5;
constexpr size_t WS_X2F8 = WS_R1 + 96 * MiB;
static_assert((size_t)MAXTILES * 256 * 2048 * 2 <= 144 * MiB && (size_t)MAXTILES * 256 * 1024 * 2 <= 160 * MiB, "MoE row buffers");
constexpr int CW_TMO = 0, CW_CODE = 1, CW_CNT = 64  , CW_BAR = 4096;

constexpr int RING_OFF = 0, RING_BYTES = 131072;
constexpr int LDSCTL_OFF = 152 * 1024, MISC_OFF = LDSCTL_OFF + 320;
constexpr int AUX_OFF = LDSCTL_OFF + 1024;
constexpr int LDS_BYTES = 163840;
constexpr int NWAVES = 8;

#define RLX_AGENT __ATOMIC_RELAXED, __HIP_MEMORY_SCOPE_AGENT
#define LDS_WAIT() asm volatile("s_waitcnt lgkmcnt(0)" ::: "memory")
#define VM_WAIT() asm volatile("s_waitcnt vmcnt(0)" ::: "memory")
__device__ __forceinline__ unsigned f2bf(float f) { unsigned u = __builtin_bit_cast(unsigned, f); return (u + 0x7fffu + ((u >> 16) & 1u)) >> 16; }
__device__ __forceinline__ unsigned pk2(float lo, float hi) { return f2bf(lo) | (f2bf(hi) << 16); }
typedef __bf16 bf2_t __attribute__((ext_vector_type(2)));
__device__ __forceinline__ unsigned pkbf(float lo, float hi) { const f32x2 v = {lo, hi}; return __builtin_bit_cast(unsigned, __builtin_convertvector(v, bf2_t)); }
constexpr float F8_XS = 16.0f, F8_WS = 256.0f, F8_INV = 1.0f / 4096.0f;
__device__ __forceinline__ float f8clamp(float x) { return fminf(fmaxf(x, -448.0f), 448.0f); }
__device__ __forceinline__ unsigned pk4_fp8(float a, float b, float c, float d) { unsigned w = 0u; w = (unsigned)__builtin_amdgcn_cvt_pk_fp8_f32(f8clamp(a), f8clamp(b), (int)w, false); w = (unsigned)__builtin_amdgcn_cvt_pk_fp8_f32(f8clamp(c), f8clamp(d), (int)w, true); return w; }
__device__ __forceinline__ float bf2f(unsigned short b) { return __builtin_bit_cast(float, ((unsigned)b) << 16); }
__device__ __forceinline__ float bflo(unsigned w) { return __builtin_bit_cast(float, w << 16); }
__device__ __forceinline__ float bfhi(unsigned w) { return __builtin_bit_cast(float, w & 0xffff0000u); }
__device__ __forceinline__ float sigmoidf_(float x) { return __builtin_amdgcn_rcpf(1.0f + __expf(-x)); }
__device__ __forceinline__ float wave_sum(float v) {
#pragma unroll
    for (int o = 1; o < 64; o <<= 1) v += __shfl_xor(v, o);
    return v;
}
#define XB_TMO      128
#define XB_XCNT(j)  (256  + 64 * (j))
#define XB_XSUB(j)  (1280 + 64 * (j))
#define XB_XGEN(j)  (2304 + 64 * (j))
#define XB_TOP      3328
#define XB_TOPGEN   3392
#define XCD_BAR_WORDS 3456
#define XB_SPIN_CAP (1u << 18)

__device__ __forceinline__ unsigned xb_ld(unsigned* p)              { return __hip_atomic_load(p, __ATOMIC_RELAXED, __HIP_MEMORY_SCOPE_AGENT); }
__device__ __forceinline__ unsigned xb_add(unsigned* p, unsigned v) { return __hip_atomic_fetch_add(p, v, __ATOMIC_RELAXED, __HIP_MEMORY_SCOPE_AGENT); }
__device__ __forceinline__ unsigned xb_xcc_id() { return (unsigned)__builtin_amdgcn_s_getreg((3 << 11) | 20) & 0xFu; }
#define XB_SPIN(cond, bar) do { unsigned _sp = 0; while (cond) { __builtin_amdgcn_s_sleep(1); \
    if ((++_sp & 255u) == 0u) { if (xb_ld(&(bar)[XB_TMO])) break; if (_sp > XB_SPIN_CAP) { atomicAdd(&(bar)[XB_TMO], 1u); break; } } } } while (0)

struct XcdBarrier {
    unsigned* bar; unsigned x;
    volatile LAS unsigned* st;
};

__device__ __forceinline__ XcdBarrier xcd_barrier_post(unsigned* bar, volatile LAS unsigned* st) {
    XcdBarrier b; b.bar = bar; b.x = xb_xcc_id(); b.st = st;
    if (threadIdx.x == 0) (void)xb_add(&bar[XB_XCNT(b.x)], 1u);
    return b;
}
__device__ __forceinline__ void xcd_barrier_complete(unsigned* bar, unsigned x, unsigned& nloc, unsigned& nx) {
    const unsigned G = gridDim.x * gridDim.y * gridDim.z;
    unsigned sum, cnt, mine, sp = 0u;
    for (;;) {
        sum = 0u; cnt = 0u; mine = 0u;
#pragma unroll
        for (unsigned j = 0; j < 16; ++j) { const unsigned c = xb_ld(&bar[XB_XCNT(j)]); sum += c; cnt += (c > 0u) ? 1u : 0u; mine = (j == x) ? c : mine; }
        if (sum == G) break;
        __builtin_amdgcn_s_sleep(1);
        if ((++sp & 255u) == 0u) { if (xb_ld(&bar[XB_TMO])) break; if (sp > XB_SPIN_CAP) { atomicAdd(&bar[XB_TMO], 1u); break; } }
    }
    nloc = mine > 0u ? mine : 1u; nx = cnt > 0u ? cnt : 1u;
}

__device__ __forceinline__ void xcd_barrier(const XcdBarrier& b) {
    asm volatile("s_waitcnt vmcnt(0)" ::: "memory");
    __syncthreads();
    if (threadIdx.x == 0) {
        unsigned* bar = b.bar;
        __builtin_amdgcn_s_waitcnt(0);
        unsigned nloc = b.st[0], nx = b.st[1];
        if (nloc == 0u) { xcd_barrier_complete(bar, b.x, nloc, nx); b.st[0] = nloc; b.st[1] = nx; }
        const unsigned old = xb_add(&bar[XB_XSUB(b.x)], 1u);
        const unsigned gen = old / nloc;
        if (old + 1u == (gen + 1u) * nloc) {
            __builtin_amdgcn_fence(__ATOMIC_RELEASE, "agent");
            asm volatile("s_waitcnt vmcnt(0)" ::: "memory");
            const unsigned og = xb_add(&bar[XB_TOP], 1u);
            const unsigned tg = og / nx;
            if (og + 1u == (tg + 1u) * nx) xb_add(&bar[XB_TOPGEN], 1u);
            else XB_SPIN(xb_ld(&bar[XB_TOPGEN]) == tg, bar);
            __builtin_amdgcn_fence(__ATOMIC_ACQUIRE, "agent");
            xb_add(&bar[XB_XGEN(b.x)], 1u);
            asm volatile("s_waitcnt vmcnt(0)" ::: "memory");
        } else {
            XB_SPIN(xb_ld(&bar[XB_XGEN(b.x)]) == gen, bar);
            __builtin_amdgcn_fence(__ATOMIC_ACQUIRE, "agent");
            asm volatile("s_waitcnt vmcnt(0)" ::: "memory");
        }
    }
    __syncthreads();
}

struct Args { const float* in[21]; float* out; unsigned char* ws; int ph_lo, ph_hi, li, pad; };
enum { I_X = 0, I_P, I_WIN, I_CONVW, I_ALOG, I_DTB, I_NORMW, I_POOLW, I_POOLS, I_WOUT, I_LN1G, I_LN1B, I_WR, I_BR, I_WEG, I_WEU, I_WED, I_LN2G, I_LN2B, I_WPP, I_WPG };
struct Frame {
    LAS unsigned char* lds;
    volatile LAS unsigned* MISC;
    gu32* ctl;
    int tid, lane, wave, vcu, G;
};

#ifndef FP8_LAST
#define FP8_LAST 1
#endif
#ifndef FP8_PG
#define FP8_PG 0
#endif
#ifndef FP8_ALL
#define FP8_ALL 0
#endif
#ifndef FP8_PD
#define FP8_PD 0
#endif
#ifndef FP8_PI0
#define FP8_PI0 0
#endif
#define FP8_LAYER(l) (FP8_LAST && (FP8_ALL || (l) == DEPTH - 1))
#ifndef FP8_PI
#define FP8_PI 0
#endif
#define PHASE_FRAME(F0) Frame F = F0; { int t_ = threadIdx.x; asm volatile("" : "+v"(t_)); F.tid = t_; F.lane = t_ & 63; }
#define OPQ_S(p) asm volatile("" : "+s"(p))
#define OPQ_G(T, expr) ({ GAS T* g_ = (GAS T*)(expr); asm volatile("" : "+s"(g_)); (T*)g_; })
struct SchedDense {
    int nM, nN, nwg, G, c; const char* A; const char* B; size_t astep, bstep;
    __device__ __forceinline__ void init(int M, int N, int G_, int c_, const void* A_, int lda, const void* B_, int ldb) { nM = M / 256; nN = N / 256; nwg = nM * nN; G = G_; c = c_;
        A = (const char*)A_; B = (const char*)B_; astep = (size_t)256 * lda * 2; bstep = (size_t)256 * ldb * 2; }
    __device__ __forceinline__ bool next(int i, pg8::Unit& u) const {
        const long L = (long)i * G + c; if (L >= nwg) return false;
        int wgid = (int)L; { const int q = nwg / 8, r = nwg % 8, xcd = wgid % 8, off = wgid / 8; wgid = (xcd < r ? xcd * (q + 1) : r * (q + 1) + (xcd - r) * q) + off; }
        const int nig = 8 * nN, gid = wgid / nig, fm = gid * 8, gsz = (nM - fm) < 8 ? (nM - fm) : 8;
        u.pm = fm + ((wgid % nig) % gsz); u.pn = (wgid % nig) / gsz;
        u.A = A + (size_t)u.pm * astep; u.B = B + (size_t)u.pn * bstep; u.rows = nullptr; u.nvalid = 256; u.aux = 0; return true;
    }
};
struct SchedPool {
    int G, c; const char* A; const char* B;
    __device__ __forceinline__ bool next(int i, pg8::Unit& u) const {
        const int L = i * G + c; if (L >= 256) return false;
        u.pm = L >> 2; u.pn = L & 3; u.A = A + ((size_t)u.pm * 256 * PW + u.pn * 256) * 2; u.B = B + (size_t)u.pn * 65536 * 2; u.rows = nullptr; u.nvalid = 256; u.aux = 0; return true;
    }
};
struct SchedMoe {
    int G, c, mode; const LAS int* tab; const char* A; const char* B; const int* list; int esz;
    __device__ __forceinline__ bool next(int i, pg8::Unit& u) const {
        const int L = i * G + c, rt = L >> 3, pn = L & 7;
        const int ntiles = __builtin_amdgcn_readfirstlane(tab[16]); if (rt >= ntiles) return false;
        int e = 0;
#pragma unroll
        for (int k = 1; k < 16; ++k) { const int ts = __builtin_amdgcn_readfirstlane(tab[k]); if (rt >= ts) e = k; }
        const int ts = __builtin_amdgcn_readfirstlane(tab[e]), cn = __builtin_amdgcn_readfirstlane(tab[32 + e]);
        const int r0 = (rt - ts) * 256;
        u.pm = rt; u.pn = pn; u.aux = e;
        if (mode == 0) { u.A = A; u.rows = list + (size_t)e * LCAP + r0; u.nvalid = (cn - r0) < 256 ? (cn - r0) : 256; u.B = B + ((size_t)e * 2048 + pn * 256) * 2048 * esz; }
        else { u.A = A + (size_t)rt * 256 * DE * esz; u.rows = nullptr; u.nvalid = 256; u.B = B + ((size_t)e * 2048 + pn * 256) * DE * esz; }
        return true;
    }
};

using pg8::cvt_pk_bf16;
struct EpiBf16 {
    static constexpr bool PERM = true; bf16* O; int ldc; float scale = 1.0f;
    __device__ __forceinline__ void operator()(const f32x4 (&acc)[2][2][4][2], const pg8::Unit& u, int wr, int wc, int fr, int fq) const {
        const int row0 = u.pm * 256 + wr * 64 + fr, col0 = u.pn * 256 + wc * 32 + 8 * fq;
#pragma unroll
        for (int ai = 0; ai < 2; ++ai)
#pragma unroll
            for (int m = 0; m < 4; ++m) { bf16* rowp = O + (size_t)(row0 + ai * 128 + m * 16) * ldc + col0;
#pragma unroll
                for (int bj = 0; bj < 2; ++bj) { const f32x4 v0 = acc[ai][bj][m][0] * scale, v1 = acc[ai][bj][m][1] * scale;
                    v4u w; w.x = cvt_pk_bf16(v0[0], v0[1]); w.y = cvt_pk_bf16(v0[2], v0[3]); w.z = cvt_pk_bf16(v1[0], v1[1]); w.w = cvt_pk_bf16(v1[2], v1[3]);
                    *(v4u*)(rowp + bj * 128) = w; } }
    }
};
struct EpiPool {
    static constexpr bool PERM = true; bf16* O; const float* scale; int f8 = 0;
    __device__ __forceinline__ void operator()(const f32x4 (&acc)[2][2][4][2], const pg8::Unit& u, int wr, int wc, int fr, int fq) const {
        const int row0 = u.pm * 256 + wr * 64 + fr, cg = u.pn * 256 + wc * 32 + 8 * fq;
        f32x4 sv[2][2];
#pragma unroll
        for (int bj = 0; bj < 2; ++bj) { sv[bj][0] = *(const f32x4*)(scale + cg + bj * 128); sv[bj][1] = *(const f32x4*)(scale + cg + bj * 128 + 4); }
#pragma unroll
        for (int ai = 0; ai < 2; ++ai)
#pragma unroll
            for (int m = 0; m < 4; ++m) { bf16* rowp = O + (size_t)(row0 + ai * 128 + m * 16) * D + DNW + cg;
#pragma unroll
                for (int bj = 0; bj < 2; ++bj) { const f32x4 v0 = acc[ai][bj][m][0] * sv[bj][0], v1 = acc[ai][bj][m][1] * sv[bj][1];
                    if (f8) { v2u w8; w8.x = pk4_fp8(v0[0] * F8_XS, v0[1] * F8_XS, v0[2] * F8_XS, v0[3] * F8_XS); w8.y = pk4_fp8(v1[0] * F8_XS, v1[1] * F8_XS, v1[2] * F8_XS, v1[3] * F8_XS);
                        *(v2u*)((unsigned char*)O + (size_t)(row0 + ai * 128 + m * 16) * D + DNW + cg + bj * 128) = w8; }
                    else { v4u w; w.x = cvt_pk_bf16(v0[0], v0[1]); w.y = cvt_pk_bf16(v0[2], v0[3]); w.z = cvt_pk_bf16(v1[0], v1[1]); w.w = cvt_pk_bf16(v1[2], v1[3]);
                    *(v4u*)(rowp + bj * 128) = w; } } }
    }
};
struct EpiRes {
    static constexpr bool PERM = true; const bf16* XB; bf16* PRE; float ascale = 1.0f;
    __device__ __forceinline__ void operator()(const f32x4 (&acc)[2][2][4][2], const pg8::Unit& u, int wr, int wc, int fr, int fq) const {
        const int row0 = u.pm * 256 + wr * 64 + fr, col0 = u.pn * 256 + wc * 32 + 8 * fq;
#pragma unroll
        for (int ai = 0; ai < 2; ++ai)
#pragma unroll
            for (int m = 0; m < 4; ++m) { const size_t off0 = (size_t)(row0 + ai * 128 + m * 16) * D + col0;
#pragma unroll
                for (int bj = 0; bj < 2; ++bj) { const size_t off = off0 + bj * 128; const v4u x = *(const v4u*)(XB + off); const f32x4 a0 = acc[ai][bj][m][0] * ascale, a1 = acc[ai][bj][m][1] * ascale;
                    v4u w; w.x = cvt_pk_bf16(bflo(x.x) * ALPHA + a0[0], bfhi(x.x) * ALPHA + a0[1]); w.y = cvt_pk_bf16(bflo(x.y) * ALPHA + a0[2], bfhi(x.y) * ALPHA + a0[3]);
                    w.z = cvt_pk_bf16(bflo(x.z) * ALPHA + a1[0], bfhi(x.z) * ALPHA + a1[1]); w.w = cvt_pk_bf16(bflo(x.w) * ALPHA + a1[2], bfhi(x.w) * ALPHA + a1[3]);
                    *(v4u*)(PRE + off) = w; } }
    }
};
struct EpiSwiglu {
    static constexpr bool PERM = true; bf16* O; int f8 = 0; float ascale = 1.0f;
    __device__ __forceinline__ void operator()(const f32x4 (&acc)[2][2][4][2], const pg8::Unit& u, int wr, int wc, int fr, int fq) const {
        const int row0 = u.pm * 256 + wr * 64 + fr, col0 = u.pn * 128 + wc * 32 + 8 * fq;
#pragma unroll
        for (int ai = 0; ai < 2; ++ai)
#pragma unroll
            for (int m = 0; m < 4; ++m) { bf16* rowp = O + (size_t)(row0 + ai * 128 + m * 16) * DE + col0;
                float h[8];
#pragma unroll
                for (int n = 0; n < 2; ++n)
#pragma unroll
                    for (int j = 0; j < 4; ++j) { const float g = acc[ai][0][m][n][j] * ascale, up = acc[ai][1][m][n][j] * ascale; h[4 * n + j] = g * sigmoidf_(g) * up; }
                if (f8) { v2u w8; w8.x = pk4_fp8(h[0] * F8_XS, h[1] * F8_XS, h[2] * F8_XS, h[3] * F8_XS); w8.y = pk4_fp8(h[4] * F8_XS, h[5] * F8_XS, h[6] * F8_XS, h[7] * F8_XS);
                    *(v2u*)((unsigned char*)O + (size_t)(row0 + ai * 128 + m * 16) * DE + col0) = w8; }
                else { v4u w; w.x = cvt_pk_bf16(h[0], h[1]); w.y = cvt_pk_bf16(h[2], h[3]); w.z = cvt_pk_bf16(h[4], h[5]); w.w = cvt_pk_bf16(h[6], h[7]);
                *(v4u*)rowp = w; } }
    }
};
struct EpiPle {
    static constexpr bool PERM = true; const bf16* X2B; const bf16* PP; bf16* XB; float* OUT; int last; float ascale = 1.0f;
    __device__ __forceinline__ void operator()(const f32x4 (&acc)[2][2][4][2], const pg8::Unit& u, int wr, int wc, int fr, int fq) const {
        const int row0 = u.pm * 256 + wr * 64 + fr, col0 = u.pn * 256 + wc * 32 + 8 * fq;
#pragma unroll
        for (int ai = 0; ai < 2; ++ai)
#pragma unroll
            for (int m = 0; m < 4; ++m) { const size_t off0 = (size_t)(row0 + ai * 128 + m * 16) * D + col0;
#pragma unroll
                for (int bj = 0; bj < 2; ++bj) { const size_t off = off0 + bj * 128;
                    const v4u xx = *(const v4u*)(X2B + off), pp = *(const v4u*)(PP + off);
                    const f32x4 a0 = acc[ai][bj][m][0] * ascale, a1 = acc[ai][bj][m][1] * ascale;
                    f32x4 o0, o1;
                    o0[0] = bflo(xx.x) + sigmoidf_(a0[0]) * bflo(pp.x); o0[1] = bfhi(xx.x) + sigmoidf_(a0[1]) * bfhi(pp.x); o0[2] = bflo(xx.y) + sigmoidf_(a0[2]) * bflo(pp.y); o0[3] = bfhi(xx.y) + sigmoidf_(a0[3]) * bfhi(pp.y);
                    o1[0] = bflo(xx.z) + sigmoidf_(a1[0]) * bflo(pp.z); o1[1] = bfhi(xx.z) + sigmoidf_(a1[1]) * bfhi(pp.z); o1[2] = bflo(xx.w) + sigmoidf_(a1[2]) * bflo(pp.w); o1[3] = bfhi(xx.w) + sigmoidf_(a1[3]) * bfhi(pp.w);
                    if (last) { *(f32x4*)(OUT + off) = o0; *(f32x4*)(OUT + off + 4) = o1; }
                    else { v4u w; w.x = cvt_pk_bf16(o0[0], o0[1]); w.y = cvt_pk_bf16(o0[2], o0[3]); w.z = cvt_pk_bf16(o1[0], o1[1]); w.w = cvt_pk_bf16(o1[2], o1[3]); *(v4u*)(XB + off) = w; } } }
    }
};

__device__ __forceinline__ void tr_item(const float* W, int ldw, int k0, int n0, bf16* WT, size_t drow0, int ldt, LAS float* scr, int lane) {
#pragma unroll 8
    for (int i = 0; i < 32; ++i) { const int kk = 2 * i + (lane >> 5); scr[kk * 33 + (lane & 31)] = W[(size_t)(k0 + kk) * ldw + n0 + (lane & 31)]; }
    LDS_WAIT(); asm volatile("" ::: "memory");
    const int c = lane & 7;
#pragma unroll
    for (int j = 0; j < 4; ++j) { const int n = (lane >> 3) + 8 * j; const LAS float* s = scr + (8 * c) * 33 + n;
        v4u o; o.x = pk2(s[0 * 33], s[1 * 33]); o.y = pk2(s[2 * 33], s[3 * 33]); o.z = pk2(s[4 * 33], s[5 * 33]); o.w = pk2(s[6 * 33], s[7 * 33]);
        *(GAS v4u*)(WT + (drow0 + n) * ldt + k0 + 8 * c) = o; }
    LDS_WAIT(); asm volatile("" ::: "memory");
}
__device__ __forceinline__ void tr_item8(const float* W, int ldw, int k0, int n0, unsigned char* WT, size_t drow0, int ldt, LAS float* scr, int lane) {
#pragma unroll 8
    for (int i = 0; i < 32; ++i) { const int kk = 2 * i + (lane >> 5); scr[kk * 33 + (lane & 31)] = W[(size_t)(k0 + kk) * ldw + n0 + (lane & 31)]; }
    LDS_WAIT(); asm volatile("" ::: "memory");
    const int c = lane & 7;
#pragma unroll
    for (int j = 0; j < 4; ++j) { const int n = (lane >> 3) + 8 * j; const LAS float* s = scr + (8 * c) * 33 + n;
        v2u o; o.x = pk4_fp8(s[0 * 33] * F8_WS, s[1 * 33] * F8_WS, s[2 * 33] * F8_WS, s[3 * 33] * F8_WS); o.y = pk4_fp8(s[4 * 33] * F8_WS, s[5 * 33] * F8_WS, s[6 * 33] * F8_WS, s[7 * 33] * F8_WS);
        *(GAS v2u*)(WT + (drow0 + n) * ldt + k0 + 8 * c) = o; }
    LDS_WAIT(); asm volatile("" ::: "memory");
}
__device__ __forceinline__ void weight_items(const Args& a, unsigned char* ws, LAS float* scr, int lane, int group, int l, int gw, int NGW) {
    constexpr int I_INA = 32 * 128, I_INB = 32 * 32, I_OUT = 32 * 64, I_PG = 32 * 64, I_PP = 4 * 64, I_POOL = 4 * 32, I_EG = NE * 32 * 32, I_EU = I_EG, I_ED = NE * 16 * 64;
    if (group == 0) {
        for (int it = gw; it < I_INA + I_INB + I_PP + I_POOL; it += NGW) { int r = it;
            if (r < I_INA) { const int kb = r / 128, nb = r % 128; tr_item(a.in[I_WIN] + (size_t)l * D * IN_COLS, IN_COLS, 64 * kb, 32 * nb, (bf16*)(ws + WS_WIN) + (size_t)l * NPROJ * D, 32 * nb, D, scr, lane); continue; } r -= I_INA;
            if (r < I_INB) { const int kb = r / 32, nb = r % 32; tr_item(a.in[I_WIN] + (size_t)l * D * IN_COLS, IN_COLS, 64 * kb, 4112 + 32 * nb, (bf16*)(ws + WS_WIN) + (size_t)l * NPROJ * D, 4096 + 32 * nb, D, scr, lane); continue; } r -= I_INB;
            if (r < I_PP) { const int kb = r / 64, nb = r % 64; tr_item(a.in[I_WPP] + (size_t)l * PLE * D, D, 64 * kb, 32 * nb, (bf16*)(ws + WS_WPP) + (size_t)l * D * PLE, 32 * nb, PLE, scr, lane); continue; } r -= I_PP;
            { const int g = r / 32, rr = r % 32, kb = rr / 8, nb = rr % 8; tr_item(a.in[I_POOLW] + ((size_t)l * 4 + g) * 65536, 256, 64 * kb, 32 * nb, (bf16*)(ws + WS_WPOOL) + ((size_t)l * 4 + g) * 65536, 32 * nb, 256, scr, lane); } }
    } else {
        const bool f8 = FP8_LAYER(l);
        for (int it = gw; it < I_OUT + I_PG + I_EG + I_EU + I_ED; it += NGW) { int r = it;
            if (r < I_OUT) { const int kb = r / 64, nb = r % 64; if (FP8_PD) tr_item8(a.in[I_WOUT] + (size_t)l * D * D, D, 64 * kb, 32 * nb, ws + WS_WOUT + (size_t)l * D * D * 2, 32 * nb, D, scr, lane); else tr_item(a.in[I_WOUT] + (size_t)l * D * D, D, 64 * kb, 32 * nb, (bf16*)(ws + WS_WOUT) + (size_t)l * D * D, 32 * nb, D, scr, lane); continue; } r -= I_OUT;
            if (r < I_PG) { const int kb = r / 64, nb = r % 64; if (FP8_PI && (FP8_PI0 || l == DEPTH - 1)) tr_item8(a.in[I_WPG] + (size_t)l * D * D, D, 64 * kb, 32 * nb, ws + WS_WPG + (size_t)l * D * D * 2, 32 * nb, D, scr, lane); else tr_item(a.in[I_WPG] + (size_t)l * D * D, D, 64 * kb, 32 * nb, (bf16*)(ws + WS_WPG) + (size_t)l * D * D, 32 * nb, D, scr, lane); continue; } r -= I_PG;
            if (r < I_EG) { const int e = r / 1024, rr = r % 1024, kb = rr / 32, nb = rr % 32, h0 = 32 * nb;
                if (f8) tr_item8(a.in[I_WEG] + ((size_t)l * NE + e) * D * DE, DE, 64 * kb, h0, ws + WS_WGU + (size_t)l * NE * 2048 * D * 2 + (size_t)e * 2048 * D, (size_t)(h0 >> 7) * 256 + (h0 & 127), D, scr, lane);
                else tr_item(a.in[I_WEG] + ((size_t)l * NE + e) * D * DE, DE, 64 * kb, h0, (bf16*)(ws + WS_WGU) + ((size_t)l * NE + e) * 2048 * D, (size_t)(h0 >> 7) * 256 + (h0 & 127), D, scr, lane); continue; } r -= I_EG;
            if (r < I_EU) { const int e = r / 1024, rr = r % 1024, kb = rr / 32, nb = rr % 32, h0 = 32 * nb;
                if (f8) tr_item8(a.in[I_WEU] + ((size_t)l * NE + e) * D * DE, DE, 64 * kb, h0, ws + WS_WGU + (size_t)l * NE * 2048 * D * 2 + (size_t)e * 2048 * D, (size_t)(h0 >> 7) * 256 + 128 + (h0 & 127), D, scr, lane);
                else tr_item(a.in[I_WEU] + ((size_t)l * NE + e) * D * DE, DE, 64 * kb, h0, (bf16*)(ws + WS_WGU) + ((size_t)l * NE + e) * 2048 * D, (size_t)(h0 >> 7) * 256 + 128 + (h0 & 127), D, scr, lane); continue; } r -= I_EU;
            { const int e = r / 1024, rr = r % 1024, kb = rr / 64, nb = rr % 64;
                if (f8 && FP8_PG) tr_item8(a.in[I_WED] + ((size_t)l * NE + e) * DE * D, D, 64 * kb, 32 * nb, ws + WS_WD + (size_t)l * NE * D * DE * 2 + (size_t)e * D * DE, 32 * nb, DE, scr, lane);
                else tr_item(a.in[I_WED] + ((size_t)l * NE + e) * DE * D, D, 64 * kb, 32 * nb, (bf16*)(ws + WS_WD) + ((size_t)l * NE + e) * D * DE, 32 * nb, DE, scr, lane); } }
    }
}
__device__ __forceinline__ void p0_prologue(const Frame& F0, const Args& a) {
    PHASE_FRAME(F0);
    LAS float* scr = (LAS float*)(F.lds + RING_OFF + F.wave * 16384);
    const int gw = F.vcu * NWAVES + F.wave, NGW = F.G * NWAVES;
    unsigned char* ws = OPQ_G(unsigned char, a.ws);
#pragma unroll 1
    for (int l = 0; l < DEPTH; ++l) weight_items(a, ws, scr, F.lane, 0, l, gw, NGW);
#ifdef CONVERT_ALL_IN_PROLOGUE
#pragma unroll 1
    for (int l = 0; l < DEPTH; ++l) weight_items(a, ws, scr, F.lane, 1, l, gw, NGW);
#endif
    const size_t gt = (size_t)F.vcu * 512 + F.tid, NGT = (size_t)F.G * 512;
    { const GAS f32x4* src = (const GAS f32x4*)a.in[I_X]; GAS v4u* dst = (GAS v4u*)(ws + WS_XB);
        for (size_t i = gt; i < (size_t)T * D / 8; i += NGT) { const f32x4 v0 = src[2 * i], v1 = src[2 * i + 1]; v4u o; o.x = pk2(v0[0], v0[1]); o.y = pk2(v0[2], v0[3]); o.z = pk2(v1[0], v1[1]); o.w = pk2(v1[2], v1[3]); dst[i] = o; } }
    { const GAS f32x4* src = (const GAS f32x4*)a.in[I_P]; GAS v4u* dst = (GAS v4u*)(ws + WS_PB16);
        for (size_t i = gt; i < (size_t)DEPTH * T * PLE / 8; i += NGT) { const f32x4 v0 = src[2 * i], v1 = src[2 * i + 1]; v4u o; o.x = pk2(v0[0], v0[1]); o.y = pk2(v0[2], v0[3]); o.z = pk2(v1[0], v1[1]); o.w = pk2(v1[2], v1[3]); dst[i] = o; } }
    for (size_t i = gt; i < (size_t)DEPTH * 16 * D; i += NGT) { const int l = (int)(i / (16 * D)), j = (int)((i / D) % 16), k = (int)(i % D);
        ((bf16*)(ws + WS_WBA))[i] = (bf16)f2bf(a.in[I_WIN][((size_t)l * D + k) * IN_COLS + 4096 + j]); }
}

typedef float f32x16 __attribute__((ext_vector_type(16)));
#define MFMA32(a_, b_, c_) __builtin_amdgcn_mfma_f32_32x32x16_bf16((a_), (b_), (c_), 0, 0, 0)
#define PACK8(x, sp) __builtin_bit_cast(bf16x8, (v4u){pkbf((x)[8 * (sp)], (x)[8 * (sp) + 1]), pkbf((x)[8 * (sp) + 2], (x)[8 * (sp) + 3]), pkbf((x)[8 * (sp) + 4], (x)[8 * (sp) + 5]), pkbf((x)[8 * (sp) + 6], (x)[8 * (sp) + 7])})
#define RAW_BAR() do { asm volatile("s_waitcnt lgkmcnt(0)" ::: "memory"); __builtin_amdgcn_s_barrier(); asm volatile("" ::: "memory"); } while (0)
constexpr int IMG_ELEMS = 56 * 512, UIMG_ELEMS = 8 * 1024;
constexpr int FR_WN = 0, FR_QD = 16, FR_AQK = 32, FR_KDT = 40;
constexpr size_t WS_IMG = WS_R2, WS_UIMG = WS_R2 + 112 * MiB;
static_assert((size_t)NB * NCH * NH * IMG_ELEMS * 2 == 112 * MiB && (size_t)NB * NCH * NH * UIMG_ELEMS * 2 == 32 * MiB, "DeltaNet images");

__device__ __forceinline__ void pool_diffs_unit(const Frame& F, unsigned char* ws, int pm, int g) {
    const bf16* PROJ = (const bf16*)(ws + WS_PROJ); bf16* POOLD = (bf16*)(ws + WS_POOLD);
    const int tid = F.tid, cp = tid & 127, rq = tid >> 7, r0 = 256 * pm + 64 * rq, sq0 = r0 % SEQ, col = 256 * g + 2 * cp;
    const bf16* up = PROJ + (size_t)r0 * NPROJ + 4096 + col; bf16* dp = POOLD + (size_t)r0 * PW + col;
#define POOL_BODY(WIN) do { unsigned xr[CH + WIN - 1]; \
        _Pragma("unroll") for (int j = 0; j < WIN - 1; ++j) xr[j] = (sq0 - (WIN - 1) + j >= 0) ? *(const unsigned*)(up + (ptrdiff_t)(j - (WIN - 1)) * NPROJ) : 0u; \
        _Pragma("unroll") for (int i = 0; i < CH; ++i) xr[WIN - 1 + i] = *(const unsigned*)(up + (size_t)i * NPROJ); \
        float s0 = 0.f, s1 = 0.f; \
        _Pragma("unroll") for (int j = 0; j < WIN - 1; ++j) { s0 += bflo(xr[j]); s1 += bfhi(xr[j]); } \
        _Pragma("unroll") for (int i = 0; i < CH; ++i) { const float x0 = bflo(xr[WIN - 1 + i]), x1 = bfhi(xr[WIN - 1 + i]); s0 += x0; s1 += x1; \
            const int pos = sq0 + i; const float inv = __builtin_amdgcn_rcpf((float)((pos + 1) < WIN ? (pos + 1) : WIN)); \
            *(unsigned*)(dp + (size_t)i * PW) = pkbf(s0 * inv - x0, s1 * inv - x1); s0 -= bflo(xr[i]); s1 -= bfhi(xr[i]); } } while (0)
    if (g == 0) POOL_BODY(2); else if (g == 1) POOL_BODY(4); else if (g == 2) POOL_BODY(8); else POOL_BODY(16);
#undef POOL_BODY
}
#ifndef PREP_DUP
#define PREP_DUP 0
#endif
constexpr int PQF = 0, PKF = 33792, PQS = 67584, PKS = 84992, PVT = 102400, PKT = 120832, PTAB = 139264;
constexpr int PAS = PQF;
constexpr int PTB = PKF, PT11T = PKF + 9216, PPART = PKF;
constexpr int F_LD = 132, S_LD = 136, T_LD = 72, A_LD = 68, TT_LD = 40;
__device__ __forceinline__ void phase_dn_prep(const Frame& F0, const Args& a, int layer) {
    PHASE_FRAME(F0);
    unsigned char* ws = OPQ_G(unsigned char, a.ws);
    LAS unsigned char* lds = F.lds;
    LAS float* Qf = (LAS float*)(lds + PQF); LAS float* Kf = (LAS float*)(lds + PKF); LAS float* As = (LAS float*)(lds + PAS);
    LAS bf16* Qs = (LAS bf16*)(lds + PQS); LAS bf16* Ks = (LAS bf16*)(lds + PKS); LAS bf16* Vt = (LAS bf16*)(lds + PVT); LAS bf16* Kt = (LAS bf16*)(lds + PKT);
    LAS bf16* Tb = (LAS bf16*)(lds + PTB); LAS bf16* T11t = (LAS bf16*)(lds + PT11T);
    LAS float* betaS = (LAS float*)(lds + PTAB); LAS float* gS = betaS + 512; LAS float* gamh = gS + 512; LAS float* betah = gamh + 64; LAS float* egam = betah + 64; LAS float* bgam = egam + 64; LAS float* ekd = bgam + 64; LAS float* rkS = ekd + 64;
    const bf16* XB = (const bf16*)(ws + WS_XB); const bf16* PROJ = (const bf16*)(ws + WS_PROJ); const bf16* WBA = (const bf16*)(ws + WS_WBA) + (size_t)layer * 16 * D;
    bf16* IMG = (bf16*)(ws + WS_IMG); bf16* UIMG = (bf16*)(ws + WS_UIMG); float* CD = (float*)(ws + WS_CD);
    const float* convw = a.in[I_CONVW] + (size_t)layer * 4 * 3072; const float* alog = a.in[I_ALOG] + layer * NH; const float* dtb = a.in[I_DTB] + layer * NH;
    const int tid = F.tid, lane = F.lane, wave = F.wave, c32 = lane & 31, hf = lane >> 5;
    for (int unit = F.vcu; unit < NB * NCH; unit += F.G) {
        const int b = unit / NCH, n = unit % NCH, r0 = b * SEQ + n * CH, sq0 = n * CH;
        for (int rep_ = 0; rep_ < ((PREP_DUP & 64) ? 2 : 1); ++rep_)
        { typedef float f32x4v __attribute__((ext_vector_type(4)));
            const int fr = lane & 15, fg = lane >> 4; f32x4v pacc[4];
#pragma unroll
            for (int mt = 0; mt < 4; ++mt) pacc[mt] = (f32x4v){0.f, 0.f, 0.f, 0.f};
#pragma unroll 2
            for (int s = 0; s < 8; ++s) { const int k0 = 256 * wave + 32 * s + 8 * fg;
                const bf16x8 bfr = *(const bf16x8*)(WBA + (size_t)fr * D + k0);
#pragma unroll
                for (int mt = 0; mt < 4; ++mt) { const bf16x8 afr = *(const bf16x8*)(XB + (size_t)(r0 + 16 * mt + fr) * D + k0); pacc[mt] = __builtin_amdgcn_mfma_f32_16x16x32_bf16(afr, bfr, pacc[mt], 0, 0, 0); } }
            LAS float* part = (LAS float*)(lds + PPART) + wave * 1024;
#pragma unroll
            for (int mt = 0; mt < 4; ++mt)
#pragma unroll
                for (int r = 0; r < 4; ++r) part[(16 * mt + 4 * fg + r) * 16 + fr] = pacc[mt][r]; }
        __syncthreads();
        { const int tok = tid >> 3, cp = tid & 7; float s0 = 0.f, s1 = 0.f;
#pragma unroll
            for (int w = 0; w < 8; ++w) { const f32x2 p2 = *(const LAS f32x2*)((LAS float*)(lds + PPART) + w * 1024 + tok * 16 + 2 * cp); s0 += p2[0]; s1 += p2[1]; }
            if (cp < 4) { betaS[tok * 8 + 2 * cp] = sigmoidf_(s0); betaS[tok * 8 + 2 * cp + 1] = sigmoidf_(s1); }
            else { const int h = 2 * (cp - 4); const float z0 = s0 + dtb[h], z1 = s1 + dtb[h + 1];
                const float sp0 = z0 > 20.f ? z0 : log1pf(__expf(z0)), sp1 = z1 > 20.f ? z1 : log1pf(__expf(z1));
                gS[tok * 8 + h] = -__expf(alog[h]) * sp0; gS[tok * 8 + h + 1] = -__expf(alog[h + 1]) * sp1; } }
        __syncthreads();
        { float gv = gS[lane * 8 + wave];
#pragma unroll
            for (int o = 1; o < 64; o <<= 1) { const float up_ = __shfl_up(gv, o); if (lane >= o) gv += up_; }
            gS[lane * 8 + wave] = gv; }
        __syncthreads();
        unsigned craw[3][11]; unsigned cdum[3][8];
#define PREP_LOADRAW(hh) do { const int cp_ = tid & 63, i0_ = (tid >> 6) * 8; \
            _Pragma("unroll") for (int part_ = 0; part_ < 3; ++part_) { const bf16* src_ = PROJ + (size_t)(r0 + i0_ - 3) * NPROJ + part_ * 1024 + (hh) * HD + 2 * cp_; \
                _Pragma("unroll") for (int j_ = 0; j_ < 11; ++j_) craw[part_][j_] = (sq0 + i0_ - 3 + j_ >= 0) ? *(const unsigned*)(src_ + (ptrdiff_t)j_ * NPROJ) : 0u; \
                if (PREP_DUP & 256) { _Pragma("unroll") for (int j_ = 3; j_ < 11; ++j_) cdum[part_][j_ - 3] = *(const unsigned*)(src_ + (ptrdiff_t)j_ * NPROJ + ((hh) ^ 1) * HD - (hh) * HD); } } } while (0)
        PREP_LOADRAW(0);
        for (int hh_ = 0; hh_ < ((PREP_DUP & 128) ? 2 * NH : NH); ++hh_) { const int h = hh_ & (NH - 1);
            const size_t chd = (size_t)unit * NH + h; bf16* img = IMG + chd * IMG_ELEMS; bf16* uimg = UIMG + chd * UIMG_ELEMS;
            if (tid < 64) { const float gi = gS[tid * 8 + h], bi = betaS[tid * 8 + h], eg = __expf(gi); gamh[tid] = gi; betah[tid] = bi; egam[tid] = eg; bgam[tid] = bi * eg; ekd[tid] = __expf(gS[63 * 8 + h] - gi); }
            RAW_BAR();
            for (int rep_ = 0; rep_ < ((PREP_DUP & 16) ? 2 : 1); ++rep_)
            { const int cp = tid & 63, rg8 = tid >> 6, i0 = rg8 * 8;
                if (PREP_DUP & 256) {
#pragma unroll
                    for (int p_ = 0; p_ < 3; ++p_)
#pragma unroll
                        for (int j_ = 0; j_ < 8; ++j_) asm volatile("" :: "v"(cdum[p_][j_])); }
#pragma unroll
                for (int part = 0; part < 3; ++part) { const int col = part * 1024 + h * HD + 2 * cp;
                    const f32x2 cw0 = *(const f32x2*)(convw + col), cw1 = *(const f32x2*)(convw + 3072 + col), cw2 = *(const f32x2*)(convw + 2 * 3072 + col), cw3 = *(const f32x2*)(convw + 3 * 3072 + col);
                    float ya[8], yb[8];
#pragma unroll
                    for (int i = 0; i < 8; ++i) { const unsigned x3 = craw[part][i], x2 = craw[part][i + 1], x1 = craw[part][i + 2], x0 = craw[part][i + 3];
                        const float ta = cw0[0] * bflo(x3) + cw1[0] * bflo(x2) + cw2[0] * bflo(x1) + cw3[0] * bflo(x0), tb = cw0[1] * bfhi(x3) + cw1[1] * bfhi(x2) + cw2[1] * bfhi(x1) + cw3[1] * bfhi(x0);
                        ya[i] = ta * sigmoidf_(ta); yb[i] = tb * sigmoidf_(tb); }
                    if (part == 0) {
#pragma unroll
                        for (int i = 0; i < 8; ++i) *(LAS f32x2*)(Qf + (i0 + i) * F_LD + 2 * cp) = (f32x2){ya[i], yb[i]}; }
                    else if (part == 1) {
#pragma unroll
                        for (int i = 0; i < 8; ++i) *(LAS f32x2*)(Kf + (i0 + i) * F_LD + 2 * cp) = (f32x2){ya[i], yb[i]}; }
                    else { v4u o0, o1;
                        o0.x = pkbf(ya[0] * betah[i0 + 0], ya[1] * betah[i0 + 1]); o0.y = pkbf(ya[2] * betah[i0 + 2], ya[3] * betah[i0 + 3]); o0.z = pkbf(ya[4] * betah[i0 + 4], ya[5] * betah[i0 + 5]); o0.w = pkbf(ya[6] * betah[i0 + 6], ya[7] * betah[i0 + 7]);
                        o1.x = pkbf(yb[0] * betah[i0 + 0], yb[1] * betah[i0 + 1]); o1.y = pkbf(yb[2] * betah[i0 + 2], yb[3] * betah[i0 + 3]); o1.z = pkbf(yb[4] * betah[i0 + 4], yb[5] * betah[i0 + 5]); o1.w = pkbf(yb[6] * betah[i0 + 6], yb[7] * betah[i0 + 7]);
                        *(LAS v4u*)(Vt + (2 * cp) * T_LD + i0) = o0; *(LAS v4u*)(Vt + (2 * cp + 1) * T_LD + i0) = o1; } }
            }
            if (hh_ + 1 < ((PREP_DUP & 128) ? 2 * NH : NH)) PREP_LOADRAW((hh_ + 1) & (NH - 1));
            for (int rep_ = 0; rep_ < ((PREP_DUP & 1) ? 2 : 1); ++rep_) { if (rep_) RAW_BAR();
            { const int i = tid >> 3, part = tid & 7; const LAS float* qp = Qf + i * F_LD + part * 16; const LAS float* kp = Kf + i * F_LD + part * 16;
                f32x4 qv[4], kv[4]; float sq = 0.f, sk = 0.f;
#pragma unroll
                for (int j = 0; j < 4; ++j) { qv[j] = *(const LAS f32x4*)(qp + 4 * j); kv[j] = *(const LAS f32x4*)(kp + 4 * j);
                    sq += (qv[j][0] * qv[j][0] + qv[j][1] * qv[j][1]) + (qv[j][2] * qv[j][2] + qv[j][3] * qv[j][3]); sk += (kv[j][0] * kv[j][0] + kv[j][1] * kv[j][1]) + (kv[j][2] * kv[j][2] + kv[j][3] * kv[j][3]); }
                sq += __shfl_xor(sq, 1); sq += __shfl_xor(sq, 2); sq += __shfl_xor(sq, 4); sk += __shfl_xor(sk, 1); sk += __shfl_xor(sk, 2); sk += __shfl_xor(sk, 4);
                const float rq = 1.0f / sqrtf(sq + RMS_EPS) * 0.08838834764831845f, rk = 1.0f / sqrtf(sk + RMS_EPS);
                if (part == 0) rkS[i] = rk;
#pragma unroll
                for (int j = 0; j < 4; ++j) { qv[j] = qv[j] * rq; kv[j] = kv[j] * rk; }
                v4u w0, w1;
                w0.x = pkbf(qv[0][0], qv[0][1]); w0.y = pkbf(qv[0][2], qv[0][3]); w0.z = pkbf(qv[1][0], qv[1][1]); w0.w = pkbf(qv[1][2], qv[1][3]); w1.x = pkbf(qv[2][0], qv[2][1]); w1.y = pkbf(qv[2][2], qv[2][3]); w1.z = pkbf(qv[3][0], qv[3][1]); w1.w = pkbf(qv[3][2], qv[3][3]);
                *(LAS v4u*)(Qs + i * S_LD + part * 16) = w0; *(LAS v4u*)(Qs + i * S_LD + part * 16 + 8) = w1;
                w0.x = pkbf(kv[0][0], kv[0][1]); w0.y = pkbf(kv[0][2], kv[0][3]); w0.z = pkbf(kv[1][0], kv[1][1]); w0.w = pkbf(kv[1][2], kv[1][3]); w1.x = pkbf(kv[2][0], kv[2][1]); w1.y = pkbf(kv[2][2], kv[2][3]); w1.z = pkbf(kv[3][0], kv[3][1]); w1.w = pkbf(kv[3][2], kv[3][3]);
                *(LAS v4u*)(Ks + i * S_LD + part * 16) = w0; *(LAS v4u*)(Ks + i * S_LD + part * 16 + 8) = w1;
                const float eg = egam[i]; bf16* fq = img + ((size_t)(FR_QD + (i >> 5) * 8 + part) * 64 + (i & 31)) * 8;
                v4u h0, h1;
                h0.x = pkbf(qv[0][0] * eg, qv[0][1] * eg); h0.y = pkbf(qv[0][2] * eg, qv[0][3] * eg); h0.z = pkbf(qv[2][0] * eg, qv[2][1] * eg); h0.w = pkbf(qv[2][2] * eg, qv[2][3] * eg);
                h1.x = pkbf(qv[1][0] * eg, qv[1][1] * eg); h1.y = pkbf(qv[1][2] * eg, qv[1][3] * eg); h1.z = pkbf(qv[3][0] * eg, qv[3][1] * eg); h1.w = pkbf(qv[3][2] * eg, qv[3][3] * eg);
                *(v4u*)fq = h0; *(v4u*)(fq + 32 * 8) = h1; }
            RAW_BAR();
            { const int c = tid & 127, rg = tid >> 7; float kb[16], kd[16];
#pragma unroll
                for (int i = 0; i < 16; ++i) { const int t = rg * 16 + i; const float kn = Kf[t * F_LD + c] * rkS[t]; kb[i] = kn * bgam[t]; kd[i] = kn * ekd[t]; }
                v4u o0, o1;
                o0.x = pkbf(kb[0], kb[1]); o0.y = pkbf(kb[2], kb[3]); o0.z = pkbf(kb[4], kb[5]); o0.w = pkbf(kb[6], kb[7]); o1.x = pkbf(kb[8], kb[9]); o1.y = pkbf(kb[10], kb[11]); o1.z = pkbf(kb[12], kb[13]); o1.w = pkbf(kb[14], kb[15]);
                *(LAS v4u*)(Kt + c * T_LD + rg * 16) = o0; *(LAS v4u*)(Kt + c * T_LD + rg * 16 + 8) = o1;
                bf16* fk = img + ((size_t)(FR_KDT + (c >> 5) * 4 + rg) * 64 + (c & 31)) * 8;
                v4u h0, h1;
                h0.x = pkbf(kd[0], kd[1]); h0.y = pkbf(kd[2], kd[3]); h0.z = pkbf(kd[8], kd[9]); h0.w = pkbf(kd[10], kd[11]);
                h1.x = pkbf(kd[4], kd[5]); h1.y = pkbf(kd[6], kd[7]); h1.z = pkbf(kd[12], kd[13]); h1.w = pkbf(kd[14], kd[15]);
                *(v4u*)fk = h0; *(v4u*)(fk + 32 * 8) = h1; }
            RAW_BAR();
            }
            for (int rep_ = 0; rep_ < ((PREP_DUP & 2) ? 2 : 1); ++rep_) { if (rep_) RAW_BAR();
            if (wave < 6) { const int pr = wave % 3, iskk = wave / 3, mt = pr == 2 ? 1 : 0, nt = pr == 0 ? 0 : 1;
                const LAS bf16* xs = iskk ? Ks : Qs; f32x16 d;
#pragma unroll
                for (int r = 0; r < 16; ++r) d[r] = 0.f;
#pragma unroll
                for (int s = 0; s < 8; ++s) { const bf16x8 af = *(const LAS bf16x8*)(Ks + (32 * mt + c32) * S_LD + 16 * s + 8 * hf), bfr = *(const LAS bf16x8*)(xs + (32 * nt + c32) * S_LD + 16 * s + 8 * hf); d = MFMA32(af, bfr, d); }
                const int i = 32 * nt + c32; const float gi = gamh[i], bi = betah[i];
#pragma unroll
                for (int r = 0; r < 16; ++r) { const int j = 32 * mt + (r & 3) + 8 * (r >> 2) + 4 * hf; const float de = __expf(gi - gamh[j]);
                    d[r] = iskk ? ((j < i) ? bi * d[r] * de : 0.f) : ((j <= i) ? d[r] * de : 0.f); }
                if (iskk) {
#pragma unroll
                    for (int qd = 0; qd < 4; ++qd) *(LAS f32x4*)(As + i * A_LD + 32 * mt + 8 * qd + 4 * hf) = (f32x4){d[4 * qd], d[4 * qd + 1], d[4 * qd + 2], d[4 * qd + 3]}; }
                else {
#pragma unroll
                    for (int sp = 0; sp < 2; ++sp) *(bf16x8*)(img + ((size_t)(FR_AQK + nt * 4 + 2 * mt + sp) * 64 + lane) * 8) = PACK8(d, sp); } }
            RAW_BAR();
            }
            for (int rep_ = 0; rep_ < ((PREP_DUP & 4) ? 2 : 1); ++rep_) { if (rep_) RAW_BAR();
            if (wave < 2) {
                unsigned asb = (unsigned)(uintptr_t)(As + (32 * wave) * A_LD + 32 * wave); int cb = c32; asm volatile("" : "+v"(asb), "+v"(cb));
                const LAS float* Ab = (const LAS float*)(uintptr_t)asb;
                float arow[32], Tc[32];
#pragma unroll
                for (int i = 0; i < 32; ++i) arow[i] = Ab[i * A_LD + cb];
#pragma unroll
                for (int i = 0; i < 32; ++i) { float ac[4] = {(i == cb) ? 1.f : 0.f, 0.f, 0.f, 0.f}; if (i > 0) asm volatile("" : "+v"(arow[i]), "+v"(Tc[i - 1]));
#pragma unroll
                    for (int j = 0; j < i; ++j) { const float aij = __builtin_bit_cast(float, __builtin_amdgcn_readlane(__builtin_bit_cast(int, arow[i]), j)); ac[j & 3] -= aij * Tc[j]; }
                    Tc[i] = (ac[0] + ac[1]) + (ac[2] + ac[3]); __builtin_amdgcn_sched_barrier(0); }
                if (hf == 0) {
#pragma unroll
                    for (int i = 0; i < 32; ++i) Tb[(32 * wave + i) * T_LD + 32 * wave + c32] = (bf16)(pkbf(Tc[i], 0.f) & 0xffffu);
                    if (wave == 0) {
#pragma unroll
                        for (int q = 0; q < 4; ++q) { v4u o; o.x = pkbf(Tc[8 * q], Tc[8 * q + 1]); o.y = pkbf(Tc[8 * q + 2], Tc[8 * q + 3]); o.z = pkbf(Tc[8 * q + 4], Tc[8 * q + 5]); o.w = pkbf(Tc[8 * q + 6], Tc[8 * q + 7]); *(LAS v4u*)(T11t + c32 * TT_LD + 8 * q) = o; } } } }
            RAW_BAR();
            if (wave == 0) {
                f32x16 x;
#pragma unroll
                for (int r = 0; r < 16; ++r) x[r] = 0.f;
#pragma unroll
                for (int s = 0; s < 2; ++s) { const LAS float* ap = As + (32 + c32) * A_LD + 16 * s + 8 * hf; const f32x4 a0 = *(const LAS f32x4*)ap, a1 = *(const LAS f32x4*)(ap + 4);
                    const bf16x8 af = __builtin_bit_cast(bf16x8, (v4u){pkbf(a0[0], a0[1]), pkbf(a0[2], a0[3]), pkbf(a1[0], a1[1]), pkbf(a1[2], a1[3])});
                    const bf16x8 bfr = *(const LAS bf16x8*)(T11t + c32 * TT_LD + 16 * s + 8 * hf); x = MFMA32(af, bfr, x); }
                f32x16 t21;
#pragma unroll
                for (int r = 0; r < 16; ++r) t21[r] = 0.f;
#pragma unroll
                for (int s = 0; s < 2; ++s) { const LAS bf16* tp = Tb + (32 + c32) * T_LD + 32 + 16 * s + 4 * hf; const v2u lo = *(const LAS v2u*)tp, hi = *(const LAS v2u*)(tp + 8);
                    const bf16x8 af = __builtin_bit_cast(bf16x8, (v4u){lo.x, lo.y, hi.x, hi.y}); const bf16x8 bfr = PACK8(x, s); t21 = MFMA32(af, bfr, t21); }
#pragma unroll
                for (int r = 0; r < 16; ++r) Tb[(32 + (r & 3) + 8 * (r >> 2) + 4 * hf) * T_LD + c32] = (bf16)(pkbf(-t21[r], 0.f) & 0xffffu);
            }
            RAW_BAR();
            }
            for (int rep_ = 0; rep_ < ((PREP_DUP & 8) ? 2 : 1); ++rep_) { if (rep_) RAW_BAR();
            if (wave < 4) {
#pragma unroll
                for (int mt = 0; mt < 2; ++mt) { f32x16 d;
#pragma unroll
                    for (int r = 0; r < 16; ++r) d[r] = 0.f;
#pragma unroll
                    for (int s = 0; s < 4; ++s) if (s < 2 * (mt + 1)) { const bf16x8 af = *(const LAS bf16x8*)(Tb + (32 * mt + c32) * T_LD + 16 * s + 8 * hf), bfr = *(const LAS bf16x8*)(Vt + (32 * wave + c32) * T_LD + 16 * s + 8 * hf); d = MFMA32(af, bfr, d); }
                    bf16* up = uimg + ((size_t)(wave * 2 + mt) * 64 + lane) * 16; *(bf16x8*)up = PACK8(d, 0); *(bf16x8*)(up + 8) = PACK8(d, 1); } }
            else { const int ct = wave - 4;
#pragma unroll
                for (int nt = 0; nt < 2; ++nt) { f32x16 d;
#pragma unroll
                    for (int r = 0; r < 16; ++r) d[r] = 0.f;
#pragma unroll
                    for (int s = 0; s < 4; ++s) if (s < 2 * (nt + 1)) { const bf16x8 af = *(const LAS bf16x8*)(Kt + (32 * ct + c32) * T_LD + 16 * s + 8 * hf), bfr = *(const LAS bf16x8*)(Tb + (32 * nt + c32) * T_LD + 16 * s + 8 * hf); d = MFMA32(af, bfr, d); }
#pragma unroll
                    for (int r = 0; r < 16; ++r) d[r] = -d[r];
#pragma unroll
                    for (int sp = 0; sp < 2; ++sp) *(bf16x8*)(img + ((size_t)(FR_WN + nt * 8 + 2 * ct + sp) * 64 + lane) * 8) = PACK8(d, sp); } }
            }
            if (tid == 0) CD[chd] = egam[63];
            RAW_BAR();
        }
#undef PREP_LOADRAW
    }
}

__host__ __device__ constexpr int sc_p(int k) { const int j = k - 32; return j < 12 ? j % 6 : (j - 12) % 5; }
__host__ __device__ constexpr int sc_slab(int k) { const int j = k - 32; return k < 32 ? (k >> 2) : (j < 12 ? j / 6 : 2 + (j - 12) / 5); }
__host__ __device__ constexpr int sc_kind(int k) { return k < 32 ? ((k & 3) < 2 ? 0 : 1) : ((sc_p(k) == 2 || sc_p(k) == 5) ? 1 : 2); }
__host__ __device__ constexpr int sc_idx(int k) { return k < 32 ? (k & 1) : (sc_p(k) == 0 ? 0 : sc_p(k) == 1 ? 1 : sc_p(k) == 2 ? 1 : sc_p(k) == 3 ? 2 : sc_p(k) == 4 ? 3 : 0); }
__host__ __device__ constexpr int sc_frag(int k) { return k < 32 ? (((k & 3) < 2 ? FR_WN : FR_QD) + (k & 1) * 8 + (k >> 2)) : (sc_kind(k) == 1 ? FR_AQK + sc_idx(k) * 4 + sc_slab(k) : FR_KDT + sc_idx(k) * 4 + sc_slab(k)); }
constexpr int SC_QD = 8;
constexpr int SCB = 57344, OT_OFF = 2 * SCB, OT_LD = 136, OT_BYTES = 64 * OT_LD * 2;
static_assert(OT_OFF + 2 * OT_BYTES <= 152 * 1024, "scan LDS");
__device__ __forceinline__ void phase_dn_scan(const Frame& F0, const Args& a, int layer, int unit) {
    PHASE_FRAME(F0);
    unsigned char* ws = OPQ_G(unsigned char, a.ws);
    LAS unsigned char* lds = F.lds;
    const int b = unit >> 3, h = unit & 7, lane = F.lane;
    const bf16* IMG = (const bf16*)(ws + WS_IMG); const bf16* UIMG = (const bf16*)(ws + WS_UIMG); const float* CD = (const float*)(ws + WS_CD);
    const size_t chd0 = (size_t)b * NCH * NH + h;
    if (F.wave < 4) {
#ifndef SCAN_NO_COMPUTE
        const int w = F.wave, c32 = lane & 31, hf = lane >> 5;
        f32x16 S0, S1, S2, S3;
#pragma unroll
        for (int r = 0; r < 16; ++r) { S0[r] = 0.f; S1[r] = 0.f; S2[r] = 0.f; S3[r] = 0.f; }
        const float cdl = CD[chd0 + (size_t)lane * NH];
        v4u UA[4];
        const __amdgpu_buffer_rsrc_t rsU = __builtin_amdgcn_make_buffer_rsrc((void*)(UIMG + chd0 * UIMG_ELEMS), (short)0, NCH * NH * UIMG_ELEMS * 2, 0x00020000);
        const unsigned uoff = (unsigned)((w * 2) * 64 + lane) * 32u;
#define SC_LOADU(dst, nn) do { _Pragma("unroll") for (int mt_ = 0; mt_ < 2; ++mt_) { _Pragma("unroll") for (int hh_ = 0; hh_ < 2; ++hh_) dst[2 * mt_ + hh_] = __builtin_amdgcn_raw_buffer_load_b128(rsU, uoff + (unsigned)(mt_ * 2048 + hh_ * 16), (unsigned)(nn) * (unsigned)(NH * UIMG_ELEMS * 2), 0); } } while (0)
#define SC_FRAG(bufoff, fi) (*(const LAS bf16x8*)(lds + (bufoff) + (fi) * 1024 + lane * 16))
#define SC_CHUNK(nn, U, bufoff, otoff) do { \
        f32x16 aV0, aV1, aO0, aO1; bf16x8 fq0, fq1, fq2, fq3, fq4, fq5, fq6, fq7, Sbs, Vb0, Vb1, Vb2, Vb3; \
        _Pragma("unroll") for (int q = 0; q < 4; ++q) { aV0[2 * q] = bflo(U[0][q]); aV0[2 * q + 1] = bfhi(U[0][q]); aV0[8 + 2 * q] = bflo(U[1][q]); aV0[8 + 2 * q + 1] = bfhi(U[1][q]); \
            aV1[2 * q] = bflo(U[2][q]); aV1[2 * q + 1] = bfhi(U[2][q]); aV1[8 + 2 * q] = bflo(U[3][q]); aV1[8 + 2 * q + 1] = bfhi(U[3][q]); } \
        _Pragma("unroll") for (int r = 0; r < 16; ++r) { aO0[r] = 0.f; aO1[r] = 0.f; } \
        if ((nn) + 1 < NCH) SC_LOADU(U, (nn) + 1); \
        const float cd = __builtin_bit_cast(float, __builtin_amdgcn_readlane(__builtin_bit_cast(int, cdl), (nn))); \
        fq0 = SC_FRAG(bufoff, 0); \
        fq1 = SC_FRAG(bufoff, 8); \
        fq2 = SC_FRAG(bufoff, 16); \
        fq3 = SC_FRAG(bufoff, 24); \
        fq4 = SC_FRAG(bufoff, 1); \
        fq5 = SC_FRAG(bufoff, 9); \
        fq6 = SC_FRAG(bufoff, 17); \
        fq7 = SC_FRAG(bufoff, 25); \
        Sbs = PACK8(S0, 0); \
        aV0 = MFMA32(fq0, Sbs, aV0); \
        fq0 = SC_FRAG(bufoff, 2); \
        aV1 = MFMA32(fq1, Sbs, aV1); \
        fq1 = SC_FRAG(bufoff, 10); \
        aO0 = MFMA32(fq2, Sbs, aO0); \
        fq2 = SC_FRAG(bufoff, 18); \
        aO1 = MFMA32(fq3, Sbs, aO1); \
        fq3 = SC_FRAG(bufoff, 26); \
        Sbs = PACK8(S0, 1); \
        aV0 = MFMA32(fq4, Sbs, aV0); \
        fq4 = SC_FRAG(bufoff, 3); \
        aV1 = MFMA32(fq5, Sbs, aV1); \
        fq5 = SC_FRAG(bufoff, 11); \
        aO0 = MFMA32(fq6, Sbs, aO0); \
        fq6 = SC_FRAG(bufoff, 19); \
        aO1 = MFMA32(fq7, Sbs, aO1); \
        fq7 = SC_FRAG(bufoff, 27); \
        Sbs = PACK8(S1, 0); \
        aV0 = MFMA32(fq0, Sbs, aV0); \
        fq0 = SC_FRAG(bufoff, 4); \
        aV1 = MFMA32(fq1, Sbs, aV1); \
        fq1 = SC_FRAG(bufoff, 12); \
        aO0 = MFMA32(fq2, Sbs, aO0); \
        fq2 = SC_FRAG(bufoff, 20); \
        aO1 = MFMA32(fq3, Sbs, aO1); \
        fq3 = SC_FRAG(bufoff, 28); \
        Sbs = PACK8(S1, 1); \
        aV0 = MFMA32(fq4, Sbs, aV0); \
        fq4 = SC_FRAG(bufoff, 5); \
        aV1 = MFMA32(fq5, Sbs, aV1); \
        fq5 = SC_FRAG(bufoff, 13); \
        aO0 = MFMA32(fq6, Sbs, aO0); \
        fq6 = SC_FRAG(bufoff, 21); \
        aO1 = MFMA32(fq7, Sbs, aO1); \
        fq7 = SC_FRAG(bufoff, 29); \
        Sbs = PACK8(S2, 0); \
        aV0 = MFMA32(fq0, Sbs, aV0); \
        fq0 = SC_FRAG(bufoff, 6); \
        aV1 = MFMA32(fq1, Sbs, aV1); \
        fq1 = SC_FRAG(bufoff, 14); \
        aO0 = MFMA32(fq2, Sbs, aO0); \
        fq2 = SC_FRAG(bufoff, 22); \
        aO1 = MFMA32(fq3, Sbs, aO1); \
        fq3 = SC_FRAG(bufoff, 30); \
        Sbs = PACK8(S2, 1); \
        aV0 = MFMA32(fq4, Sbs, aV0); \
        fq4 = SC_FRAG(bufoff, 7); \
        aV1 = MFMA32(fq5, Sbs, aV1); \
        fq5 = SC_FRAG(bufoff, 15); \
        aO0 = MFMA32(fq6, Sbs, aO0); \
        fq6 = SC_FRAG(bufoff, 23); \
        aO1 = MFMA32(fq7, Sbs, aO1); \
        fq7 = SC_FRAG(bufoff, 31); \
        Sbs = PACK8(S3, 0); \
        aV0 = MFMA32(fq0, Sbs, aV0); \
        fq0 = SC_FRAG(bufoff, 40); \
        aV1 = MFMA32(fq1, Sbs, aV1); \
        fq1 = SC_FRAG(bufoff, 44); \
        aO0 = MFMA32(fq2, Sbs, aO0); \
        fq2 = SC_FRAG(bufoff, 36); \
        aO1 = MFMA32(fq3, Sbs, aO1); \
        fq3 = SC_FRAG(bufoff, 48); \
        Sbs = PACK8(S3, 1); \
        aV0 = MFMA32(fq4, Sbs, aV0); \
        fq4 = SC_FRAG(bufoff, 52); \
        aV1 = MFMA32(fq5, Sbs, aV1); \
        fq5 = SC_FRAG(bufoff, 32); \
        S0 = S0 * cd; S1 = S1 * cd; S2 = S2 * cd; S3 = S3 * cd; \
        aO0 = MFMA32(fq6, Sbs, aO0); \
        fq6 = SC_FRAG(bufoff, 41); \
        aO1 = MFMA32(fq7, Sbs, aO1); \
        fq7 = SC_FRAG(bufoff, 45); \
        Vb0 = PACK8(aV0, 0); Vb1 = PACK8(aV0, 1); Vb2 = PACK8(aV1, 0); Vb3 = PACK8(aV1, 1); \
        S0 = MFMA32(fq0, Vb0, S0); \
        fq0 = SC_FRAG(bufoff, 37); \
        S1 = MFMA32(fq1, Vb0, S1); \
        fq1 = SC_FRAG(bufoff, 49); \
        aO1 = MFMA32(fq2, Vb0, aO1); \
        fq2 = SC_FRAG(bufoff, 53); \
        S2 = MFMA32(fq3, Vb0, S2); \
        fq3 = SC_FRAG(bufoff, 33); \
        S3 = MFMA32(fq4, Vb0, S3); \
        fq4 = SC_FRAG(bufoff, 42); \
        aO0 = MFMA32(fq5, Vb0, aO0); \
        fq5 = SC_FRAG(bufoff, 46); \
        S0 = MFMA32(fq6, Vb1, S0); \
        fq6 = SC_FRAG(bufoff, 38); \
        S1 = MFMA32(fq7, Vb1, S1); \
        fq7 = SC_FRAG(bufoff, 50); \
        aO1 = MFMA32(fq0, Vb1, aO1); \
        fq0 = SC_FRAG(bufoff, 54); \
        S2 = MFMA32(fq1, Vb1, S2); \
        fq1 = SC_FRAG(bufoff, 43); \
        S3 = MFMA32(fq2, Vb1, S3); \
        fq2 = SC_FRAG(bufoff, 47); \
        aO0 = MFMA32(fq3, Vb1, aO0); \
        fq3 = SC_FRAG(bufoff, 39); \
        S0 = MFMA32(fq4, Vb2, S0); \
        fq4 = SC_FRAG(bufoff, 51); \
        S1 = MFMA32(fq5, Vb2, S1); \
        fq5 = SC_FRAG(bufoff, 55); \
        aO1 = MFMA32(fq6, Vb2, aO1); \
        S2 = MFMA32(fq7, Vb2, S2); \
        S3 = MFMA32(fq0, Vb2, S3); \
        S0 = MFMA32(fq1, Vb3, S0); \
        S1 = MFMA32(fq2, Vb3, S1); \
        aO1 = MFMA32(fq3, Vb3, aO1); \
        S2 = MFMA32(fq4, Vb3, S2); \
        S3 = MFMA32(fq5, Vb3, S3); \
        _Pragma("unroll") for (int r = 0; r < 16; ++r) { \
            *(LAS bf16*)(lds + (otoff) + (((r & 3) + 8 * (r >> 2) + 4 * hf) * OT_LD + 32 * w + c32) * 2) = (bf16)(pkbf(aO0[r], 0.f) & 0xffffu); \
            *(LAS bf16*)(lds + (otoff) + ((32 + (r & 3) + 8 * (r >> 2) + 4 * hf) * OT_LD + 32 * w + c32) * 2) = (bf16)(pkbf(aO1[r], 0.f) & 0xffffu); } \
        RAW_BAR(); } while (0)
        SC_LOADU(UA, 0);
        RAW_BAR();
#pragma unroll 1
        for (int n = 0; n < NCH; n += 2) { SC_CHUNK(n, UA, 0, OT_OFF); SC_CHUNK(n + 1, UA, SCB, OT_OFF + OT_BYTES); }
#undef SC_CHUNK
#undef SC_FRAG
#undef SC_LOADU
#endif
    } else {
#ifndef SCAN_NO_HELPER
        const int ht = F.tid - 256, tok = ht >> 2, q = ht & 3;
        bf16* OB = FP8_PD ? (bf16*)((unsigned char*)a.out + 64 * MiB) : (bf16*)(ws + WS_MIXIN); const int old_ = FP8_PD ? DNW : D;
        v4u RA[14], RB[14];
        const __amdgpu_buffer_rsrc_t rsI = __builtin_amdgcn_make_buffer_rsrc((void*)(IMG + chd0 * IMG_ELEMS), (short)0, NCH * NH * IMG_ELEMS * 2, 0x00020000);
#define SH_LOADIMG(dst, nn) do { _Pragma("unroll") for (int i_ = 0; i_ < 14; ++i_) dst[i_] = __builtin_amdgcn_raw_buffer_load_b128(rsI, (unsigned)ht * 16u, (unsigned)(nn) * (unsigned)(NH * IMG_ELEMS * 2) + (unsigned)i_ * 4096u, 0); } while (0)
#define SH_STOREIMG(src, bufoff) do { LAS v4u* p_ = (LAS v4u*)(lds + (bufoff)) + ht; _Pragma("unroll") for (int i_ = 0; i_ < 14; ++i_) p_[i_ * 256] = src[i_]; } while (0)
#define SH_EPI(mm, otoff) do { const LAS v4u* op_ = (const LAS v4u*)(lds + (otoff) + (tok * OT_LD + 32 * q) * 2); \
        v4u* yp_ = (v4u*)(OB + ((size_t)b * SEQ + (size_t)(mm) * CH + tok) * old_ + h * HD + 32 * q); \
        _Pragma("unroll") for (int i_ = 0; i_ < 4; ++i_) yp_[i_] = op_[i_]; } while (0)
#define SH_STEP(nn, Rcur, Rnext, bufnext, otprev) do { \
        if ((nn) + 2 < NCH) SH_LOADIMG(Rcur, (nn) + 2); \
        if ((nn) >= 1) SH_EPI((nn) - 1, otprev); \
        if ((nn) + 1 < NCH) SH_STOREIMG(Rnext, bufnext); \
        RAW_BAR(); } while (0)
        SH_LOADIMG(RA, 0); SH_LOADIMG(RB, 1);
        SH_STOREIMG(RA, 0);
        RAW_BAR();
#pragma unroll 1
        for (int n = 0; n < NCH; n += 2) { SH_STEP(n, RA, RB, SCB, OT_OFF + OT_BYTES); SH_STEP(n + 1, RB, RA, 0, OT_OFF); }
        SH_EPI(NCH - 1, OT_OFF + OT_BYTES);
#undef SH_STEP
#undef SH_EPI
#undef SH_STOREIMG
#undef SH_LOADIMG
#endif
    }
}

__device__ __forceinline__ void phase_dn_norm(const Frame& F0, const Args& a, int layer) {
    PHASE_FRAME(F0);
    unsigned char* ws = OPQ_G(unsigned char, a.ws);
    const bf16* PROJ = (const bf16*)(ws + WS_PROJ); bf16* MIXIN = (bf16*)(ws + WS_MIXIN);
    const bf16* OSRC = FP8_PD ? (const bf16*)((unsigned char*)a.out + 64 * MiB) : (const bf16*)(ws + WS_MIXIN); const int old_ = FP8_PD ? DNW : D;
    const int lane = F.lane, gw = F.vcu * NWAVES + F.wave, NGW = F.G * NWAVES;
    const float* nw = a.in[I_NORMW] + layer * HD + 16 * (lane & 7); f32x4 nwv[4];
#pragma unroll
    for (int i = 0; i < 4; ++i) nwv[i] = *(const f32x4*)(nw + 4 * i);
    v4u OA[2], ZA[2], OB[2], ZB[2];
#define DNN_LOAD(O_, Z_, t) do { const v4u* op_ = (const v4u*)(OSRC + (size_t)(t) * old_ + 16 * lane); const v4u* zp_ = (const v4u*)(PROJ + (size_t)(t) * NPROJ + 3072 + 16 * lane); O_[0] = op_[0]; O_[1] = op_[1]; Z_[0] = zp_[0]; Z_[1] = zp_[1]; } while (0)
#define DNN_ROW(O_, Z_, t) do { float ss = 0.f; \
        _Pragma("unroll") for (int i = 0; i < 2; ++i) _Pragma("unroll") for (int j = 0; j < 4; ++j) { const float x0 = bflo(O_[i][j]), x1 = bfhi(O_[i][j]); ss += x0 * x0 + x1 * x1; } \
        ss += __shfl_xor(ss, 1); ss += __shfl_xor(ss, 2); ss += __shfl_xor(ss, 4); const float rr = 1.0f / sqrtf(ss * (1.0f / HD) + RMS_EPS); \
        v4u* yp_ = (v4u*)(MIXIN + (size_t)(t) * D + 16 * lane); float yv_[16]; \
        _Pragma("unroll") for (int i = 0; i < 2; ++i) { _Pragma("unroll") for (int j = 0; j < 4; ++j) { const float z0 = bflo(Z_[i][j]), z1 = bfhi(Z_[i][j]); const f32x4 nn = nwv[2 * i + (j >> 1)]; \
            yv_[8 * i + 2 * j] = bflo(O_[i][j]) * rr * nn[2 * (j & 1)] * z0 * sigmoidf_(z0); yv_[8 * i + 2 * j + 1] = bfhi(O_[i][j]) * rr * nn[2 * (j & 1) + 1] * z1 * sigmoidf_(z1); } } \
        if (FP8_PD) { v4u o8_; _Pragma("unroll") for (int q4 = 0; q4 < 4; ++q4) o8_[q4] = pk4_fp8(yv_[4 * q4] * F8_XS, yv_[4 * q4 + 1] * F8_XS, yv_[4 * q4 + 2] * F8_XS, yv_[4 * q4 + 3] * F8_XS); *(v4u*)((unsigned char*)MIXIN + (size_t)(t) * D + 16 * lane) = o8_; } \
        else { _Pragma("unroll") for (int i = 0; i < 2; ++i) { v4u o_; _Pragma("unroll") for (int j = 0; j < 4; ++j) o_[j] = pkbf(yv_[8 * i + 2 * j], yv_[8 * i + 2 * j + 1]); yp_[i] = o_; } } } while (0)
    if (gw < T) DNN_LOAD(OA, ZA, gw);
#pragma unroll 1
    for (int t = gw; t < T; t += 2 * NGW) {
        if (t + NGW < T) DNN_LOAD(OB, ZB, t + NGW);
        DNN_ROW(OA, ZA, t);
        if (t + 2 * NGW < T) DNN_LOAD(OA, ZA, t + 2 * NGW);
        if (t + NGW < T) DNN_ROW(OB, ZB, t + NGW);
    }
#undef DNN_LOAD
#undef DNN_ROW
}

__device__ __forceinline__ void phase_ln1_router(const Frame& F0, const Args& a, int layer, int probe = 0, int f8 = 0) {
    PHASE_FRAME(F0);
    unsigned char* ws = OPQ_G(unsigned char, a.ws);
    LAS float* WRt = (LAS float*)F.lds;
    LAS float* GV = (LAS float*)(F.lds + RING_BYTES);
    LAS int* rowE = (LAS int*)(F.lds + AUX_OFF); LAS int* rowP = rowE + 128; LAS float* rowG = (LAS float*)(rowP + 128); LAS int* lcnt = (LAS int*)(rowG + 128); LAS int* lbase = lcnt + 16;
    const float* wr = OPQ_G(const float, a.in[I_WR]); const float* br = OPQ_G(const float, a.in[I_BR]);
    for (int idx = F.tid; idx < D * NE; idx += 512) WRt[(idx & 15) * D + (idx >> 4)] = wr[idx];
    { const float* g1 = a.in[I_LN1G] + (size_t)layer * D; const float* b1 = a.in[I_LN1B] + (size_t)layer * D; for (int i = F.tid; i < D; i += 512) { GV[i] = g1[i]; GV[D + i] = b1[i]; } }
    const bf16* PRE = (const bf16*)a.out; bf16* X1B = (bf16*)(ws + (probe ? WS_R1 : WS_X1B)); float* STATS = (float*)(ws + (probe ? WS_R1 + 70 * MiB : WS_STATS));
    int* LIST = (int*)(ws + (probe ? WS_R1 + 72 * MiB : WS_LIST)); int* TOKSLOT = (int*)(ws + (probe ? WS_R1 + 80 * MiB : WS_TOKSLOT)); float* GATEW = (float*)(ws + (probe ? WS_R1 + 82 * MiB : WS_GATEW));
    gu32* cnt = F.ctl + CW_CNT + 64 * (layer + (probe ? 2 : 0));
    const int lane = F.lane; const float brl = br[(lane >> 2) & 15];
    for (int rb = F.vcu; rb < T / 64; rb += F.G) {
        if (F.tid < 16) lcnt[F.tid] = 0;
        __syncthreads();
        v2u XA[8], XB_[8];
#define PE_LOAD(X, r) do { const GAS v2u* xr_ = (const GAS v2u*)(PRE + (size_t)(rb * 64 + F.wave * 8 + (r)) * D) + lane; _Pragma("unroll") for (int j = 0; j < 8; ++j) X[j] = xr_[64 * j]; } while (0)
#define PE_ROW(X, r) do { const int lr = F.wave * 8 + (r), row = rb * 64 + lr; unsigned gvo_ = (unsigned)(uintptr_t)GV; asm volatile("" : "+v"(gvo_)); const LAS float* GVr = (const LAS float*)(uintptr_t)gvo_; \
            f32x4 v[8]; float s = 0.f; \
            _Pragma("unroll") for (int j = 0; j < 8; ++j) { v[j] = (f32x4){bflo(X[j].x), bfhi(X[j].x), bflo(X[j].y), bfhi(X[j].y)}; s += (v[j][0] + v[j][1]) + (v[j][2] + v[j][3]); } \
            const float mean = wave_sum(s) * (1.f / D); float s2 = 0.f; \
            _Pragma("unroll") for (int j = 0; j < 8; ++j) { v[j] = v[j] - mean; s2 += (v[j][0] * v[j][0] + v[j][1] * v[j][1]) + (v[j][2] * v[j][2] + v[j][3] * v[j][3]); } \
            const float rstd = 1.f / sqrtf(wave_sum(s2) * (1.f / D) + LN_EPS); \
            if (lane == 0) { STATS[2 * row] = mean; STATS[2 * row + 1] = rstd; } \
            GAS v2u* o8 = (GAS v2u*)(X1B + (size_t)row * D) + lane; \
            float lg[16]; \
            _Pragma("unroll") for (int e = 0; e < 16; ++e) lg[e] = 0.f; \
            _Pragma("unroll") for (int j = 0; j < 8; ++j) { const f32x4 gg = *(const LAS f32x4*)(GVr + 256 * j + 4 * lane), bb = *(const LAS f32x4*)(GVr + D + 256 * j + 4 * lane); \
                v[j] = v[j] * rstd * gg + bb; \
                if (f8) ((GAS unsigned*)((GAS unsigned char*)X1B + (size_t)row * D) + lane)[64 * j] = pk4_fp8(v[j][0] * F8_XS, v[j][1] * F8_XS, v[j][2] * F8_XS, v[j][3] * F8_XS); \
                else { v2u w; w.x = pkbf(v[j][0], v[j][1]); w.y = pkbf(v[j][2], v[j][3]); o8[64 * j] = w; } \
                _Pragma("unroll") for (int e = 0; e < 16; ++e) { const f32x4 w4 = *(const LAS f32x4*)(WRt + e * D + 256 * j + 4 * lane); lg[e] += (v[j][0] * w4[0] + v[j][1] * w4[1]) + (v[j][2] * w4[2] + v[j][3] * w4[3]); } } \
              \
            float t8[8], t4[4], t2[2], t1; \
            { const bool hi = (lane & 32) != 0; _Pragma("unroll") for (int i = 0; i < 8; ++i) { const float snd = hi ? lg[i] : lg[8 + i], kp = hi ? lg[8 + i] : lg[i]; t8[i] = kp + __shfl_xor(snd, 32); } } \
            { const bool hi = (lane & 16) != 0; _Pragma("unroll") for (int i = 0; i < 4; ++i) { const float snd = hi ? t8[i] : t8[4 + i], kp = hi ? t8[4 + i] : t8[i]; t4[i] = kp + __shfl_xor(snd, 16); } } \
            { const bool hi = (lane & 8) != 0; _Pragma("unroll") for (int i = 0; i < 2; ++i) { const float snd = hi ? t4[i] : t4[2 + i], kp = hi ? t4[2 + i] : t4[i]; t2[i] = kp + __shfl_xor(snd, 8); } } \
            { const bool hi = (lane & 4) != 0; const float snd = hi ? t2[0] : t2[1], kp = hi ? t2[1] : t2[0]; t1 = kp + __shfl_xor(snd, 4); } \
            t1 += __shfl_xor(t1, 2); t1 += __shfl_xor(t1, 1); t1 += brl; \
            float lgu[16]; float mx = -3.0e38f; \
            _Pragma("unroll") for (int e = 0; e < 16; ++e) { lgu[e] = __builtin_bit_cast(float, __builtin_amdgcn_readlane(__builtin_bit_cast(int, t1), 4 * e)); mx = fmaxf(mx, lgu[e]); } \
            float p[16]; \
            _Pragma("unroll") for (int e = 0; e < 16; ++e) p[e] = __expf(lgu[e] - mx); \
            float gsc[4]; \
            _Pragma("unroll") for (int g = 0; g < 4; ++g) { const float a0 = p[4 * g], a1 = p[4 * g + 1], a2 = p[4 * g + 2], a3 = p[4 * g + 3]; \
                const float hi1 = fmaxf(a0, a1), lo1 = fminf(a0, a1), hi2 = fmaxf(a2, a3), lo2 = fminf(a2, a3); \
                gsc[g] = fmaxf(hi1, hi2) + fmaxf(fminf(hi1, hi2), fmaxf(lo1, lo2)); } \
            int gsel = 0; float best = gsc[0]; \
            _Pragma("unroll") for (int g = 1; g < 4; ++g) if (gsc[g] > best) { best = gsc[g]; gsel = g; } \
            float q[4]; \
            _Pragma("unroll") for (int j = 0; j < 4; ++j) q[j] = gsel == 0 ? p[j] : (gsel == 1 ? p[4 + j] : (gsel == 2 ? p[8 + j] : p[12 + j])); \
            int i0 = 0; float p0 = q[0]; \
            _Pragma("unroll") for (int j = 1; j < 4; ++j) if (q[j] > p0) { p0 = q[j]; i0 = j; } \
            int i1 = -1; float p1 = -1.f; \
            _Pragma("unroll") for (int j = 0; j < 4; ++j) if (j != i0 && q[j] > p1) { p1 = q[j]; i1 = j; } \
            if (lane == 0) { const int e0 = gsel * 4 + i0, e1 = gsel * 4 + i1; const float inv = 1.0f / (p0 + p1); \
                rowE[2 * lr] = e0; rowE[2 * lr + 1] = e1; rowG[2 * lr] = p0 * inv; rowG[2 * lr + 1] = p1 * inv; \
                rowP[2 * lr] = __hip_atomic_fetch_add(&lcnt[e0], 1, __ATOMIC_RELAXED, __HIP_MEMORY_SCOPE_WORKGROUP); rowP[2 * lr + 1] = __hip_atomic_fetch_add(&lcnt[e1], 1, __ATOMIC_RELAXED, __HIP_MEMORY_SCOPE_WORKGROUP); } } while (0)
        PE_LOAD(XA, 0);
#pragma unroll 1
        for (int r = 0; r < 8; r += 2) { PE_LOAD(XB_, r + 1); PE_ROW(XA, r); if (r + 2 < 8) PE_LOAD(XA, r + 2); PE_ROW(XB_, r + 1); }
#undef PE_LOAD
#undef PE_ROW
        __syncthreads();
        if (F.tid < 16) lbase[F.tid] = (int)__hip_atomic_fetch_add(cnt + F.tid, (unsigned)lcnt[F.tid], RLX_AGENT);
        __syncthreads();
        if (F.tid < 128) { const int e = rowE[F.tid], pos = lbase[e] + rowP[F.tid], tok = rb * 64 + (F.tid >> 1);
            LIST[(size_t)e * LCAP + pos] = tok; TOKSLOT[2 * tok + (F.tid & 1)] = e * LCAP + pos; GATEW[2 * tok + (F.tid & 1)] = rowG[F.tid]; }
        __syncthreads();
    }
}
__device__ __forceinline__ void moe_table(const Frame& F0, int layer) {
    PHASE_FRAME(F0);
    LAS int* tab = (LAS int*)(F.lds + AUX_OFF);
    __syncthreads();
    if (F.tid < 16) tab[32 + F.tid] = (int)__hip_atomic_load(F.ctl + CW_CNT + 64 * layer + F.tid, RLX_AGENT);
    __syncthreads();
    if (F.tid == 0) { int run = 0; for (int e = 0; e < 16; ++e) { tab[e] = run; run += (tab[32 + e] + 255) >> 8; } tab[16] = run; }
    __syncthreads();
}
__device__ __forceinline__ void phase_combine_ln2(const Frame& F0, const Args& a, int layer, int probe = 0, int f8 = 0) {
    PHASE_FRAME(F0);
    unsigned char* ws = OPQ_G(unsigned char, a.ws); const LAS int* tab = (const LAS int*)(F.lds + AUX_OFF);
    const bf16* PRE = (const bf16*)a.out; const float* STATS = (const float*)(ws + WS_STATS); const bf16* Y = (const bf16*)(ws + WS_Y); bf16* X2B = (bf16*)(ws + (probe ? WS_R1 : WS_X2B)); unsigned char* X2F8 = ws + WS_X2F8;
    const int* TOKSLOT = (const int*)(ws + WS_TOKSLOT); const float* GATEW = (const float*)(ws + WS_GATEW);
    LAS float* GV = (LAS float*)F.lds;
    { const float* g1 = a.in[I_LN1G] + (size_t)layer * D; const float* b1 = a.in[I_LN1B] + (size_t)layer * D; const float* g2 = a.in[I_LN2G] + (size_t)layer * D; const float* b2 = a.in[I_LN2B] + (size_t)layer * D;
        for (int i = F.tid; i < D; i += 512) { GV[i] = g1[i]; GV[D + i] = b1[i]; GV[2 * D + i] = g2[i]; GV[3 * D + i] = b2[i]; } }
    __syncthreads();
    const int gw = F.vcu * NWAVES + F.wave, NGW = F.G * NWAVES, nrows = (T - gw + NGW - 1) / NGW, lane = F.lane;
    for (int base = 0; base < nrows; base += 64) {
        const int nr = (nrows - base) < 64 ? (nrows - base) : 64;
        float m_mean = 0.f, m_rstd = 0.f, m_w0 = 0.f, m_w1 = 0.f; int m_y0 = 0, m_y1 = 0;
        if (lane < nr) { const int row = gw + NGW * (base + lane); m_mean = STATS[2 * row]; m_rstd = STATS[2 * row + 1]; m_w0 = GATEW[2 * row]; m_w1 = GATEW[2 * row + 1];
            const int s0 = TOKSLOT[2 * row], s1 = TOKSLOT[2 * row + 1]; m_y0 = tab[s0 / LCAP] * 256 + (s0 % LCAP); m_y1 = tab[s1 / LCAP] * 256 + (s1 % LCAP); }
        v2u XA[8], PA[8], QA[8], XB_[8], PB_[8], QB_[8];
#define PH_LOAD(X, P, Q, i) do { const int row_ = gw + NGW * (base + (i)); const size_t y0_ = (size_t)__builtin_amdgcn_readlane(m_y0, (i)), y1_ = (size_t)__builtin_amdgcn_readlane(m_y1, (i)); \
            const GAS v2u* xr_ = (const GAS v2u*)(PRE + (size_t)row_ * D) + lane; const GAS v2u* ya_ = (const GAS v2u*)(Y + y0_ * D) + lane; const GAS v2u* yb_ = (const GAS v2u*)(Y + y1_ * D) + lane; \
            _Pragma("unroll") for (int j = 0; j < 8; ++j) { X[j] = xr_[64 * j]; P[j] = ya_[64 * j]; Q[j] = yb_[64 * j]; } } while (0)
#define PH_ROW(X, P, Q, i) do { const int row_ = gw + NGW * (base + (i)); unsigned gvo_ = (unsigned)(uintptr_t)GV; asm volatile("" : "+v"(gvo_)); const LAS float* GVr = (const LAS float*)(uintptr_t)gvo_;     \
            const float mean = __builtin_bit_cast(float, __builtin_amdgcn_readlane(__builtin_bit_cast(int, m_mean), (i))), rstd = __builtin_bit_cast(float, __builtin_amdgcn_readlane(__builtin_bit_cast(int, m_rstd), (i))); \
            const float w0 = __builtin_bit_cast(float, __builtin_amdgcn_readlane(__builtin_bit_cast(int, m_w0), (i))), w1 = __builtin_bit_cast(float, __builtin_amdgcn_readlane(__builtin_bit_cast(int, m_w1), (i))); \
            f32x4 v[8]; float s = 0.f; \
            _Pragma("unroll") for (int j = 0; j < 8; ++j) { const f32x4 gg = *(const LAS f32x4*)(GVr + 256 * j + 4 * lane), bb = *(const LAS f32x4*)(GVr + D + 256 * j + 4 * lane); \
                const f32x4 x1 = ((f32x4){bflo(X[j].x), bfhi(X[j].x), bflo(X[j].y), bfhi(X[j].y)} - mean) * rstd * gg + bb; \
                f32x4 f; f[0] = w0 * bflo(P[j].x) + w1 * bflo(Q[j].x); f[1] = w0 * bfhi(P[j].x) + w1 * bfhi(Q[j].x); f[2] = w0 * bflo(P[j].y) + w1 * bflo(Q[j].y); f[3] = w0 * bfhi(P[j].y) + w1 * bfhi(Q[j].y); \
                v[j] = x1 * ALPHA + f; s += (v[j][0] + v[j][1]) + (v[j][2] + v[j][3]); } \
            const float m2 = wave_sum(s) * (1.f / D); float q = 0.f; \
            _Pragma("unroll") for (int j = 0; j < 8; ++j) { v[j] = v[j] - m2; q += (v[j][0] * v[j][0] + v[j][1] * v[j][1]) + (v[j][2] * v[j][2] + v[j][3] * v[j][3]); } \
            const float r2 = 1.f / sqrtf(wave_sum(q) * (1.f / D) + LN_EPS); \
            GAS v2u* o8 = (GAS v2u*)(X2B + (size_t)row_ * D) + lane; \
            _Pragma("unroll") for (int j = 0; j < 8; ++j) { const f32x4 gg = *(const LAS f32x4*)(GVr + 2 * D + 256 * j + 4 * lane), bb = *(const LAS f32x4*)(GVr + 3 * D + 256 * j + 4 * lane); \
                const f32x4 o = v[j] * r2 * gg + bb; v2u w; w.x = pkbf(o[0], o[1]); w.y = pkbf(o[2], o[3]); o8[64 * j] = w; \
                if (f8) ((GAS unsigned*)((GAS unsigned char*)X2F8 + (size_t)row_ * D) + lane)[64 * j] = pk4_fp8(o[0] * F8_XS, o[1] * F8_XS, o[2] * F8_XS, o[3] * F8_XS); } } while (0)
        PH_LOAD(XA, PA, QA, 0);
#pragma unroll 1
        for (int i = 0; i < nr; i += 2) {
            if (i + 1 < nr) PH_LOAD(XB_, PB_, QB_, i + 1);
            PH_ROW(XA, PA, QA, i);
            if (i + 2 < nr) PH_LOAD(XA, PA, QA, i + 2);
            if (i + 1 < nr) PH_ROW(XB_, PB_, QB_, i + 1);
        }
#undef PH_LOAD
#undef PH_ROW
    }
}

#ifndef MK_N_LAUNCHES
#define MK_N_LAUNCHES 1
#endif
constexpr int NPL = 10;
constexpr int NPHASE = 1 + NPL * DEPTH;
constexpr int N_LAUNCHES = MK_N_LAUNCHES;
static_assert(N_LAUNCHES == 1 || N_LAUNCHES == NPHASE, "MK_N_LAUNCHES is 1 or NPHASE");

#define GRID_BAR() do { if (N_LAUNCHES == 1) xcd_barrier(bar); } while (0)
#ifndef PH_MASK
#define PH_MASK 0x7ff
#endif
#define IN(k) ((((k) == 0 ? 1u : (2u << (((k) - 1) % NPL))) & (unsigned)(PH_MASK)) && lo <= (k) && (k) < hi)
#define SEAM(k) do { if (IN((k) + 1)) GRID_BAR(); } while (0)
#ifndef PROBE_DUP
#define PROBE_DUP 0
#endif
#define REPS(k) ((((k) == 0 ? 1u : (2u << (((k) - 1) % NPL))) & (unsigned)(PROBE_DUP)) ? 2 : 1)

template <int layer> __device__ __forceinline__ void layer_phases(const Frame& F, const Args& args, const XcdBarrier& bar, const int lo, const int hi) {
            const int pb = 1 + NPL * layer;
            unsigned char* ws = OPQ_G(unsigned char, args.ws);
            if (IN(pb + 0)) { for (int rep = 0; rep < REPS(pb + 0); ++rep) { if (rep) GRID_BAR();
                SchedDense S; S.init(T, NPROJ, F.G, (int)blockIdx.x, ws + WS_XB, D, (const bf16*)(ws + WS_WIN) + (size_t)layer * NPROJ * D, D);
                EpiBf16 E{(bf16*)(ws + WS_PROJ), NPROJ};
                pg8::gemm_phase<EpiBf16, SchedDense, false>(F.lds + RING_OFF, D, D, D, S, E);
                } SEAM(pb + 0);
            }
            if (IN(pb + 1)) { for (int rep = 0; rep < REPS(pb + 1); ++rep) { if (rep) GRID_BAR(); phase_dn_prep(F, args, layer); } SEAM(pb + 1); }
            if (IN(pb + 2)) { for (int rep = 0; rep < REPS(pb + 2); ++rep) { if (rep) GRID_BAR();
                if (blockIdx.x < 32 || F.G <= 32) { for (int u = blockIdx.x; u < NB * NH; u += (F.G < 32 ? F.G : 32)) { phase_dn_scan(F, args, layer, u);
#ifdef SCAN_TWICE
                    __syncthreads(); phase_dn_scan(F, args, layer, u);
#endif
                } }
                if (blockIdx.x >= 32 || F.G <= 32) { const int G2 = F.G <= 32 ? F.G : F.G - 32, c2 = F.G <= 32 ? (int)blockIdx.x : (int)blockIdx.x - 32;
                    { int t_ = threadIdx.x; asm volatile("" : "+v"(t_)); Frame Fp = F; Fp.tid = t_; Fp.lane = t_ & 63;
                      for (int L = c2; L < 256; L += G2) pool_diffs_unit(Fp, ws, L >> 2, L & 3);
                      asm volatile("s_waitcnt vmcnt(0)" ::: "memory"); __syncthreads(); }
                    { SchedPool S{G2, c2, (const char*)(ws + WS_POOLD), (const char*)((const bf16*)(ws + WS_WPOOL) + (size_t)layer * 4 * 65536)};
                      EpiPool E{(bf16*)(ws + WS_MIXIN), args.in[I_POOLS] + (size_t)layer * PW, FP8_PD};
                      pg8::gemm_phase<EpiPool, SchedPool, false>(F.lds + RING_OFF, 256, PW, 256, S, E); }
                    { SchedDense S; S.init(T, D, G2, c2, (const bf16*)(ws + WS_PB16) + (size_t)layer * T * PLE, PLE, (const bf16*)(ws + WS_WPP) + (size_t)layer * D * PLE, PLE);
                      EpiBf16 E{(bf16*)(ws + WS_PP), D};
                      pg8::gemm_phase<EpiBf16, SchedDense, false>(F.lds + RING_OFF, PLE, PLE, PLE, S, E); }
#ifndef CONVERT_ALL_IN_PROLOGUE
                    { int t_ = threadIdx.x; asm volatile("" : "+v"(t_)); const int per_ = F.G / 8 - 4, c2v_ = (F.G % 8 == 0 && F.G > 32) ? ((int)blockIdx.x % 8) * per_ + ((int)blockIdx.x / 8 - 4) : c2;
                  weight_items(args, ws, (LAS float*)(F.lds + RING_OFF + F.wave * 16384), t_ & 63, 1, layer, c2v_ * NWAVES + F.wave, G2 * NWAVES); }
#endif
                    }
                } SEAM(pb + 2);
            }
            if (IN(pb + 3)) { for (int rep = 0; rep < REPS(pb + 3); ++rep) { if (rep) GRID_BAR(); phase_dn_norm(F, args, layer); } SEAM(pb + 3); }
            if (IN(pb + 4)) { for (int rep = 0; rep < REPS(pb + 4); ++rep) { if (rep) GRID_BAR();
                if (FP8_PD) { SchedDense S; S.init(T, D, F.G, (int)blockIdx.x, ws + WS_MIXIN, D / 2, ws + WS_WOUT + (size_t)layer * D * D * 2, D / 2);
                    EpiRes E{(const bf16*)(ws + WS_XB), (bf16*)args.out, F8_INV};
                    pg8::gemm_phase<EpiRes, SchedDense, false, true>(F.lds + RING_OFF, D / 2, D / 2, D / 2, S, E); }
                else { SchedDense S; S.init(T, D, F.G, (int)blockIdx.x, ws + WS_MIXIN, D, (const bf16*)(ws + WS_WOUT) + (size_t)layer * D * D, D);
                EpiRes E{(const bf16*)(ws + WS_XB), (bf16*)args.out};
#ifdef PROBE_PD
                { EpiRes E2{(const bf16*)(ws + WS_XB), (bf16*)(ws + WS_R1)}; pg8::gemm_phase<EpiRes, SchedDense, false>(F.lds + RING_OFF, D, D, D, S, E2); }
#endif
                pg8::gemm_phase<EpiRes, SchedDense, false>(F.lds + RING_OFF, D, D, D, S, E); }
                } SEAM(pb + 4);
            }
            if (IN(pb + 5)) { for (int rep = 0; rep < REPS(pb + 5); ++rep) { if (rep) GRID_BAR();
#ifdef PROBE_PE
                phase_ln1_router(F, args, layer, 1); __syncthreads();
#endif
                phase_ln1_router(F, args, layer, 0, FP8_LAYER(layer) ? 1 : 0); } SEAM(pb + 5); }
            if (IN(pb + 6)) { for (int rep = 0; rep < REPS(pb + 6); ++rep) { if (rep) GRID_BAR();
                moe_table(F, layer);
                if (FP8_LAYER(layer)) {
                    SchedMoe S{F.G, (int)blockIdx.x, 0, (const LAS int*)(F.lds + AUX_OFF), (const char*)(ws + WS_X1B), (const char*)(ws + WS_WGU + (size_t)layer * NE * 2048 * D * 2), (const int*)(ws + WS_LIST), 1};
                    EpiSwiglu E{(bf16*)(ws + WS_HID), FP8_PG, F8_INV};
                    pg8::gemm_phase<EpiSwiglu, SchedMoe, true, true>(F.lds + RING_OFF, D / 2, D / 2, D / 2, S, E);
                } else {
                    SchedMoe S{F.G, (int)blockIdx.x, 0, (const LAS int*)(F.lds + AUX_OFF), (const char*)(ws + WS_X1B), (const char*)((const bf16*)(ws + WS_WGU) + (size_t)layer * NE * 2048 * D), (const int*)(ws + WS_LIST), 2};
                    EpiSwiglu E{(bf16*)(ws + WS_HID)};
                    pg8::gemm_phase<EpiSwiglu, SchedMoe, true>(F.lds + RING_OFF, D, D, D, S, E);
                }
                } SEAM(pb + 6);
            }
            if (IN(pb + 7)) { for (int rep = 0; rep < REPS(pb + 7); ++rep) { if (rep) GRID_BAR();
                moe_table(F, layer);
                if (FP8_PG && FP8_LAYER(layer)) {
                    SchedMoe S{F.G, (int)blockIdx.x, 1, (const LAS int*)(F.lds + AUX_OFF), (const char*)(ws + WS_HID), (const char*)(ws + WS_WD + (size_t)layer * NE * D * DE * 2), nullptr, 1};
                    EpiBf16 E{(bf16*)(ws + WS_Y), D, F8_INV};
                    pg8::gemm_phase<EpiBf16, SchedMoe, false, true>(F.lds + RING_OFF, DE / 2, DE / 2, DE / 2, S, E);
                } else {
                    SchedMoe S{F.G, (int)blockIdx.x, 1, (const LAS int*)(F.lds + AUX_OFF), (const char*)(ws + WS_HID), (const char*)((const bf16*)(ws + WS_WD) + (size_t)layer * NE * D * DE), nullptr, 2};
                    EpiBf16 E{(bf16*)(ws + WS_Y), D};
                    pg8::gemm_phase<EpiBf16, SchedMoe, false>(F.lds + RING_OFF, DE, DE, DE, S, E);
                }
                } SEAM(pb + 7);
            }
            if (IN(pb + 8)) { for (int rep = 0; rep < REPS(pb + 8); ++rep) { if (rep) GRID_BAR(); moe_table(F, layer);
#ifdef PROBE_PH
                phase_combine_ln2(F, args, layer, 1);
#endif
                phase_combine_ln2(F, args, layer, 0, (FP8_PI && (FP8_PI0 || layer == DEPTH - 1)) ? 1 : 0); } SEAM(pb + 8); }
            if (IN(pb + 9)) { for (int rep = 0; rep < REPS(pb + 9); ++rep) { if (rep) GRID_BAR();
                if (FP8_PI && (FP8_PI0 || layer == DEPTH - 1)) {
                    SchedDense S; S.init(T, D, F.G, (int)blockIdx.x, ws + WS_X2F8, D / 2, ws + WS_WPG + (size_t)layer * D * D * 2, D / 2);
                    EpiPle E{(const bf16*)(ws + WS_X2B), (const bf16*)(ws + WS_PP), (bf16*)(ws + WS_XB), args.out, layer + 1 < DEPTH ? 0 : 1, F8_INV};
                    pg8::gemm_phase<EpiPle, SchedDense, false, true>(F.lds + RING_OFF, D / 2, D / 2, D / 2, S, E);
                } else {
                    SchedDense S; S.init(T, D, F.G, (int)blockIdx.x, ws + WS_X2B, D, (const bf16*)(ws + WS_WPG) + (size_t)layer * D * D, D);
                    EpiPle E{(const bf16*)(ws + WS_X2B), (const bf16*)(ws + WS_PP), (bf16*)(ws + WS_XB), args.out, layer + 1 < DEPTH ? 0 : 1};
                    pg8::gemm_phase<EpiPle, SchedDense, false>(F.lds + RING_OFF, D, D, D, S, E);
                }
                } SEAM(pb + 9);
            }
}
__global__ void __launch_bounds__(NWAVES * 64, 2) trunk_fwd(Args args) {
    extern __shared__ __attribute__((aligned(16))) unsigned char lds[];
    Frame F;
    F.lds = (LAS unsigned char*)lds;
    F.MISC = (volatile LAS unsigned*)(F.lds + MISC_OFF);
    F.tid = threadIdx.x; F.lane = F.tid & 63; F.wave = __builtin_amdgcn_readfirstlane(F.tid >> 6);
    F.G = gridDim.x; { const int bx = blockIdx.x; F.vcu = (F.G % 8 == 0) ? (bx % 8) * (F.G / 8) + bx / 8 : bx; }
    unsigned char* ws = args.ws;
    F.ctl = (gu32*)(ws + WS_CTL);
    for (int u = F.tid; u < (LDS_BYTES - LDSCTL_OFF) / 4; u += NWAVES * 64) ((LAS unsigned*)(F.lds + LDSCTL_OFF))[u] = 0u;
    __syncthreads();
    XcdBarrier bar; bar.bar = (unsigned*)(F.ctl + CW_BAR); bar.x = 0; bar.st = nullptr;
    if (N_LAUNCHES == 1) bar = xcd_barrier_post((unsigned*)(F.ctl + CW_BAR), F.MISC + 8);
    const int lo = args.ph_lo, hi = args.ph_hi;
    if (IN(0)) { for (int rep = 0; rep < REPS(0); ++rep) { if (rep) GRID_BAR(); p0_prologue(F, args); } SEAM(0); }

    layer_phases<0>(F, args, bar, lo, hi);
    layer_phases<1>(F, args, bar, lo, hi);
    static_assert(DEPTH == 2, "layer_phases instantiations");
#undef IN
#undef SEAM
#undef GRID_BAR
}

extern "C" void kernel_launch(void* const* d_in, const int* in_sizes, int n_in, void* d_out, int out_size, void* d_ws, size_t ws_size, hipStream_t stream) {
    static int grid = 0;
    if (grid == 0) {
        if (n_in != 21 || in_sizes[0] != T * D || out_size != T * D || ws_size < WS_END) { fprintf(stderr, "kernel_launch: unexpected shapes (n_in %d, in0 %d, out %d, ws %zu); nothing launched\n", n_in, n_in > 0 ? in_sizes[0] : -1, out_size, ws_size); grid = -1; return; }
        int dev = 0, cus = 0, per_cu = 0;
        if (hipGetDevice(&dev) != hipSuccess || hipDeviceGetAttribute(&cus, hipDeviceAttributeMultiprocessorCount, dev) != hipSuccess) { grid = -1; return; }
        if (hipFuncSetAttribute((const void*)trunk_fwd, hipFuncAttributeMaxDynamicSharedMemorySize, LDS_BYTES) != hipSuccess) { fprintf(stderr, "kernel_launch: hipFuncSetAttribute failed\n"); grid = -1; return; }
        if (hipOccupancyMaxActiveBlocksPerMultiprocessor(&per_cu, (const void*)trunk_fwd, NWAVES * 64, LDS_BYTES) != hipSuccess || per_cu < 1) { fprintf(stderr, "kernel_launch: occupancy query reports %d workgroups per CU\n", per_cu); }
        (void)hipGetLastError();
        grid = cus;
    }
    if (grid < 0) return;
    if (hipMemsetAsync((char*)d_ws + WS_CTL, 0, CTL_ZERO_BYTES, stream) != hipSuccess) return;
    Args a{};
    for (int i = 0; i < 21; ++i) a.in[i] = (const float*)d_in[i];
    a.out = (float*)d_out; a.ws = (unsigned char*)d_ws;
    for (int li = 0; li < N_LAUNCHES; ++li) {
        a.ph_lo = (N_LAUNCHES == 1) ? 0 : li; a.ph_hi = (N_LAUNCHES == 1) ? NPHASE : li + 1; a.li = li; a.pad = 0;
        hipLaunchKernelGGL(trunk_fwd, dim3(grid), dim3(NWAVES * 64), LDS_BYTES, stream, a);
        const hipError_t le = hipPeekAtLastError();
        if (le != hipSuccess) { fprintf(stderr, "kernel_launch: launch %d failed: %s\n", li, hipGetErrorName(le)); break; }
    }
}
```

```cpp
#define MK_N_LAUNCHES 1
#define FP8_ALL 1
#define FP8_PG 1
#define FP8_PI 1
#define FP8_PI0 1
#include <hip/hip_runtime.h>
#include <cstdio>
#include <cstdint>

#define GAS __attribute__((address_space(1)))
#define LAS __attribute__((address_space(3)))
typedef unsigned short bf16;
typedef unsigned v4u __attribute__((ext_vector_type(4)));
typedef unsigned v2u __attribute__((ext_vector_type(2)));
typedef float f32x4 __attribute__((ext_vector_type(4)));
typedef float f32x2 __attribute__((ext_vector_type(2)));
typedef short bf16x8 __attribute__((ext_vector_type(8)));
typedef GAS unsigned gu32;
typedef int v4i_t __attribute__((ext_vector_type(4)));
typedef int v8i_t __attribute__((ext_vector_type(8)));

namespace pg8 {
constexpr int BM = 256, BK = 64, HALF = 128, HTB = HALF * BK * 2  , STAGE_BYTES = 8 * HTB, NXCD = 8, WGM = 8;
__host__ __device__ __forceinline__ int lds_byte(int r, int c) { const int st = (r >> 4) * 2 + (c >> 5), rr = r & 15, cc = c & 31, ob = rr * 64 + cc * 2; return st * 1024 + (ob ^ (((ob >> 9) & 1) << 5)); }
__host__ __device__ __forceinline__ void stage_rc(int b, int& R, int& C) { const int st = b / 1024, sb = b % 1024, swz = sb ^ (((sb >> 9) & 1) << 5); R = (st >> 1) * 16 + swz / 64; C = (st & 1) * 32 + (swz % 64) / 2; }
__host__ __device__ __forceinline__ int perm32(int rho) { const int n = rho >> 4, i = rho & 15; return 8 * (i >> 2) + 4 * n + (i & 3); }

struct Unit { int pm, pn; const char* A; const char* B; const int* rows; int nvalid; int aux; int rowbase; int half; };

__device__ __forceinline__ unsigned cvt_pk_bf16(float lo, float hi) { unsigned r; asm volatile("v_cvt_pk_bf16_f32 %0, %1, %2" : "=v"(r) : "v"(lo), "v"(hi)); return r; }

template <class Epi, class Sched, bool GATHER, bool FP8 = false>
__device__ __forceinline__ void gemm_phase(LAS unsigned char* lds, const int K, const int lda, const int ldb, const Sched& S, const Epi& E) {
    int tid_ = threadIdx.x; asm volatile("" : "+v"(tid_));
    const int tid = tid_, wid = __builtin_amdgcn_readfirstlane(tid >> 6), lane = tid & 63, wr = wid >> 2, wc = wid & 3, fr = lane & 15, fq = lane >> 4;
    const int nt = K / BK;
    unsigned voffA[2], voffB[2]; int RA[2], CA[2];
#pragma unroll
    for (int i = 0; i < 2; ++i) { int R, C; stage_rc(tid * 16 + i * 8192, R, C); const int Rb = Epi::PERM ? ((R & ~31) + perm32(R & 31)) : R;
        RA[i] = R; CA[i] = C; voffA[i] = (unsigned)(R * lda + C) * 2u; voffB[i] = (unsigned)(Rb * ldb + C) * 2u; }
    unsigned gA[2][2], gN[2][2];
    const size_t kstep = (size_t)(BK * 2);
    const size_t hstepA = GATHER ? 0 : (size_t)HALF * lda * 2, hstepB = (size_t)HALF * ldb * 2;
    const unsigned ldsw = (unsigned)wid * 1024u;
    const int aoff = lds_byte(wr * 64 + fr, fq * 8), boff = lds_byte(wc * 32 + fr, fq * 8);
#define PG8_SA(b, h) (((b) * 2 + (h)) * HTB)
#define PG8_SB(b, h) ((4 + (b) * 2 + (h)) * HTB)
#define PG8_STAGE_B(bufoff, gbase) do { _Pragma("unroll") for (int _i = 0; _i < 2; ++_i) \
        __builtin_amdgcn_global_load_lds((const unsigned*)((const char*)(gbase) + voffB[_i]), (LAS unsigned*)(lds + (bufoff) + ldsw + _i * 8192), 16, 0, 0); } while (0)
#define PG8_STAGE_A(bufoff, gbase, h) do { _Pragma("unroll") for (int _i = 0; _i < 2; ++_i) \
        __builtin_amdgcn_global_load_lds((const unsigned*)((const char*)(gbase) + (GATHER ? gA[h][_i] : voffA[_i]) + (h) * hstepA), (LAS unsigned*)(lds + (bufoff) + ldsw + _i * 8192), 16, 0, 0); } while (0)
#define PG8_CAT(x0, x1) __builtin_shufflevector(__builtin_bit_cast(v4i_t, (x0)), __builtin_bit_cast(v4i_t, (x1)), 0, 1, 2, 3, 4, 5, 6, 7)
#define PG8_LDA(dst, b, h) do { _Pragma("unroll") for (int m = 0; m < 4; ++m) { if constexpr (FP8) dst##8[m] = PG8_CAT(*(const LAS bf16x8*)(lds + PG8_SA(b, h) + aoff + m * 2048), *(const LAS bf16x8*)(lds + PG8_SA(b, h) + aoff + m * 2048 + 1024)); \
        else { _Pragma("unroll") for (int k = 0; k < 2; ++k) dst[m][k] = *(const LAS bf16x8*)(lds + PG8_SA(b, h) + aoff + m * 2048 + k * 1024); } } } while (0)
#define PG8_LDB(dst, b, h) do { _Pragma("unroll") for (int n = 0; n < 2; ++n) { if constexpr (FP8) dst##8[n] = PG8_CAT(*(const LAS bf16x8*)(lds + PG8_SB(b, h) + boff + n * 2048), *(const LAS bf16x8*)(lds + PG8_SB(b, h) + boff + n * 2048 + 1024)); \
        else { _Pragma("unroll") for (int k = 0; k < 2; ++k) dst[n][k] = *(const LAS bf16x8*)(lds + PG8_SB(b, h) + boff + n * 2048 + k * 1024); } } } while (0)
#define PG8_MMA(ai, bj, At, Bt) do { __builtin_amdgcn_s_setprio(1); \
        if constexpr (FP8) { _Pragma("unroll") for (int m = 0; m < 4; ++m) _Pragma("unroll") for (int n = 0; n < 2; ++n) \
            asm volatile("v_mfma_scale_f32_16x16x128_f8f6f4 %0, %1, %2, %0, %3, %3 op_sel_hi:[0,0,0]" : "+v"(acc[ai][bj][m][n]) : "v"(Bt##8[n]), "v"(At##8[m]), "v"(f8scale)); } \
        else { _Pragma("unroll") for (int m = 0; m < 4; ++m) _Pragma("unroll") for (int n = 0; n < 2; ++n) _Pragma("unroll") for (int k = 0; k < 2; ++k) \
            acc[ai][bj][m][n] = __builtin_amdgcn_mfma_f32_16x16x32_bf16(Bt[n][k], At[m][k], acc[ai][bj][m][n], 0, 0, 0); } \
        __builtin_amdgcn_s_setprio(0); } while (0)
#define PG8_WAIT_V(n) asm volatile("s_waitcnt vmcnt(" #n ")" ::: "memory")
#define PG8_WAIT_L(n) asm volatile("s_waitcnt lgkmcnt(" #n ")" ::: "memory")
#define PG8_BAR __builtin_amdgcn_s_barrier()
#define PG8_SCHED __builtin_amdgcn_sched_barrier(0)
#define PG8_GLOAD(dst, u) do { _Pragma("unroll") for (int _h = 0; _h < 2; ++_h) _Pragma("unroll") for (int _i = 0; _i < 2; ++_i) { const int _r = _h * HALF + RA[_i]; \
        const int _rc = _r < (u).nvalid ? _r : (u).nvalid - 1; const int _tl = (u).rows[_rc]; const int _t = (_r < (u).nvalid) ? _tl : 0; dst[_h][_i] = (unsigned)(_t * lda + CA[_i]) * 2u; } } while (0)
    Unit cur, nxt; int ui = 0;
    if (!S.next(0, cur)) return;
    f32x4 acc[2][2][4][2];
#pragma unroll
    for (int a = 0; a < 2; ++a)
#pragma unroll
        for (int b = 0; b < 2; ++b)
#pragma unroll
            for (int m = 0; m < 4; ++m)
#pragma unroll
                for (int n = 0; n < 2; ++n) acc[a][b][m][n] = (f32x4){0.f, 0.f, 0.f, 0.f};
    const unsigned f8scale = 0x7f7f7f7fu;
    bf16x8 At[4][2], B0[2][2], B1[2][2]; v8i_t At8[4], B08[2], B18[2];
    const char* cA = cur.A; const char* cB = cur.B;
    if constexpr (GATHER) { PG8_GLOAD(gA, cur); PG8_WAIT_V(0); }
    PG8_STAGE_B(PG8_SB(0, 0), cB); PG8_STAGE_B(PG8_SB(0, 1), cB + hstepB); PG8_STAGE_A(PG8_SA(0, 0), cA, 0); PG8_STAGE_A(PG8_SA(0, 1), cA, 1);
    if (wr == 1) PG8_BAR;
    PG8_WAIT_V(2); PG8_BAR;
    PG8_STAGE_B(PG8_SB(1, 0), cB + kstep); PG8_STAGE_A(PG8_SA(1, 0), cA + kstep, 0); PG8_STAGE_B(PG8_SB(1, 1), cB + hstepB + kstep);
    PG8_WAIT_V(6); PG8_BAR;
    for (;;) {
        const bool has_next = S.next(ui + 1, nxt); const bool halfu = Sched::RAGGED && cur.half != 0;
        const char* nA = has_next ? nxt.A : cA; const char* nB = has_next ? nxt.B : cB;
        if constexpr (GATHER) { if (has_next) { PG8_GLOAD(gN, nxt); } else {
#pragma unroll
            for (int h = 0; h < 2; ++h)
#pragma unroll
                for (int i = 0; i < 2; ++i) gN[h][i] = gA[h][i]; } }
#pragma unroll 1
        for (int t = 0; t < nt; t += 2) {
            const bool last = (t == nt - 2);
            const char* a1 = cA + (size_t)(t + 1) * kstep;
            const char* a2 = last ? nA : cA + (size_t)(t + 2) * kstep; const char* b2 = last ? nB : cB + (size_t)(t + 2) * kstep;
            const char* a3 = a2 + kstep; const char* b3 = b2 + kstep;
            PG8_LDB(B0, 0, 0); PG8_LDB(B1, 0, 1); PG8_SCHED; PG8_LDA(At, 0, 0); PG8_STAGE_A(PG8_SA(1, 1), a1, 1);
            if constexpr (GATHER) { if (last) {
#pragma unroll
                for (int h = 0; h < 2; ++h)
#pragma unroll
                    for (int i = 0; i < 2; ++i) gA[h][i] = gN[h][i]; } }
            PG8_WAIT_V(8); PG8_WAIT_L(0); PG8_BAR; PG8_MMA(0, 0, At, B0); PG8_MMA(0, 1, At, B1); PG8_BAR; PG8_SCHED;
            if (!halfu) PG8_LDA(At, 0, 1); PG8_STAGE_B(PG8_SB(0, 0), b2); PG8_STAGE_B(PG8_SB(0, 1), b2 + hstepB); PG8_STAGE_A(PG8_SA(0, 0), a2, 0);
            PG8_WAIT_V(8); PG8_WAIT_L(0); PG8_BAR; if (!halfu) { PG8_MMA(1, 0, At, B0); PG8_MMA(1, 1, At, B1); } PG8_BAR; PG8_SCHED;
            PG8_LDB(B0, 1, 0); PG8_LDB(B1, 1, 1); PG8_SCHED; PG8_LDA(At, 1, 0); PG8_STAGE_A(PG8_SA(0, 1), a2, 1);
            PG8_WAIT_V(8); PG8_WAIT_L(0); PG8_BAR; PG8_MMA(0, 0, At, B0); PG8_MMA(0, 1, At, B1); PG8_BAR; PG8_SCHED;
            if (!halfu) PG8_LDA(At, 1, 1); PG8_STAGE_B(PG8_SB(1, 0), b3); PG8_STAGE_B(PG8_SB(1, 1), b3 + hstepB); PG8_STAGE_A(PG8_SA(1, 0), a3, 0);
            PG8_WAIT_V(8); PG8_WAIT_L(0); PG8_BAR; if (!halfu) { PG8_MMA(1, 0, At, B0); PG8_MMA(1, 1, At, B1); } PG8_BAR; PG8_SCHED;
        }
        if (wr == 0) PG8_BAR;
        if constexpr (FP8) asm volatile("s_nop 15\n\ts_nop 15\n\ts_nop 15" ::: "memory");
        E(acc, cur, wr, wc, fr, fq);
        if (!has_next) break;
#pragma unroll
        for (int a = 0; a < 2; ++a)
#pragma unroll
            for (int b = 0; b < 2; ++b)
#pragma unroll
                for (int m = 0; m < 4; ++m)
#pragma unroll
                    for (int n = 0; n < 2; ++n) acc[a][b][m][n] = (f32x4){0.f, 0.f, 0.f, 0.f};
        cur = nxt; cA = nA; cB = nB; ++ui;
        if (wr == 1) PG8_BAR;
    }
    PG8_WAIT_V(0);
    PG8_BAR;
#undef PG8_SA
#undef PG8_SB
#undef PG8_STAGE_A
#undef PG8_STAGE_B
#undef PG8_LDA
#undef PG8_LDB
#undef PG8_MMA
#undef PG8_CAT
#undef PG8_WAIT_V
#undef PG8_WAIT_L
#undef PG8_BAR
#undef PG8_SCHED
#undef PG8_GLOAD
}
}

constexpr int NB = 4, SEQ = 4096, D = 2048, DEPTH = 2;
constexpr int T = NB * SEQ;
constexpr int NH = 8, HD = 128, DNW = 1024, CH = 64, NCH = SEQ / CH;
constexpr int PW = 1024, PG_DIM = 256;
constexpr int IN_COLS = 5136, NPROJ = 5120;
constexpr int NE = 16, DE = 1024, PLE = 256;
constexpr float ALPHA = 1.4142135623730951f;
constexpr float LN_EPS = 1e-5f, RMS_EPS = 1e-6f;
constexpr int LCAP = T;
constexpr int MAXTILES = 2 * T / 256 + NE;

constexpr size_t MiB = 1u << 20;
constexpr size_t WS_CTL = 0, CTL_ZERO_BYTES = 64 * 1024;
constexpr size_t WS_LIST = 2 * MiB;
constexpr size_t WS_TOKSLOT = 3 * MiB, WS_GATEW = WS_TOKSLOT + 128 * 1024, WS_STATS = WS_GATEW + 128 * 1024, WS_CD = WS_STATS + 128 * 1024, WS_WBA = WS_CD + 128 * 1024;
constexpr size_t WS_WIN = 4 * MiB, WS_WOUT = 44 * MiB, WS_WPG = 60 * MiB, WS_WPP = 76 * MiB, WS_WPOOL = 78 * MiB, WS_WGU = 80 * MiB, WS_WD = 336 * MiB, WS_PB16 = 464 * MiB;
constexpr size_t WS_XB = 480 * MiB, WS_R1 = 544 * MiB, WS_R2 = 704 * MiB, WS_R4 = 848 * MiB, WS_R5 = 944 * MiB, WS_END = 1008 * MiB;
constexpr size_t WS_PROJ = WS_R1, WS_HID = WS_R1;
constexpr size_t WS_Y = WS_R2;
constexpr size_t WS_POOLD = WS_R4, WS_PP = WS_R4 + 32 * MiB, WS_X1B = WS_R2;
constexpr size_t WS_MIXIN = WS_R5, WS_X2B = WS_R5;
constexpr size_t WS_X2F8 = WS_R1 + 96 * MiB;
static_assert((size_t)MAXTILES * 256 * 2048 * 2 <= 144 * MiB && (size_t)MAXTILES * 256 * 1024 * 2 <= 160 * MiB, "MoE row buffers");
constexpr int CW_TMO = 0, CW_CODE = 1, CW_CNT = 64  , CW_BAR = 4096;

constexpr int RING_OFF = 0, RING_BYTES = 131072;
constexpr int LDSCTL_OFF = 152 * 1024, MISC_OFF = LDSCTL_OFF + 320;
constexpr int AUX_OFF = LDSCTL_OFF + 1024;
constexpr int LDS_BYTES = 163840;
constexpr int NWAVES = 8;

#define RLX_AGENT __ATOMIC_RELAXED, __HIP_MEMORY_SCOPE_AGENT
#define LDS_WAIT() asm volatile("s_waitcnt lgkmcnt(0)" ::: "memory")
#define VM_WAIT() asm volatile("s_waitcnt vmcnt(0)" ::: "memory")
__device__ __forceinline__ unsigned f2bf(float f) { unsigned u = __builtin_bit_cast(unsigned, f); return (u + 0x7fffu + ((u >> 16) & 1u)) >> 16; }
__device__ __forceinline__ unsigned pk2(float lo, float hi) { return f2bf(lo) | (f2bf(hi) << 16); }
typedef __bf16 bf2_t __attribute__((ext_vector_type(2)));
__device__ __forceinline__ unsigned pkbf(float lo, float hi) { const f32x2 v = {lo, hi}; return __builtin_bit_cast(unsigned, __builtin_convertvector(v, bf2_t)); }
constexpr float F8_XS = 16.0f, F8_WS = 256.0f, F8_INV = 1.0f / 4096.0f;
__device__ __forceinline__ float f8clamp(float x) { return fminf(fmaxf(x, -448.0f), 448.0f); }
__device__ __forceinline__ unsigned pk4_fp8(float a, float b, float c, float d) { unsigned w = 0u; w = (unsigned)__builtin_amdgcn_cvt_pk_fp8_f32(f8clamp(a), f8clamp(b), (int)w, false); w = (unsigned)__builtin_amdgcn_cvt_pk_fp8_f32(f8clamp(c), f8clamp(d), (int)w, true); return w; }
__device__ __forceinline__ float bf2f(unsigned short b) { return __builtin_bit_cast(float, ((unsigned)b) << 16); }
__device__ __forceinline__ float bflo(unsigned w) { return __builtin_bit_cast(float, w << 16); }
__device__ __forceinline__ float bfhi(unsigned w) { return __builtin_bit_cast(float, w & 0xffff0000u); }
__device__ __forceinline__ float sigmoidf_(float x) { return __builtin_amdgcn_rcpf(1.0f + __expf(-x)); }
__device__ __forceinline__ float wave_sum(float v) {
#pragma unroll
    for (int o = 1; o < 64; o <<= 1) v += __shfl_xor(v, o);
    return v;
}
#define XB_TMO      128
#define XB_XCNT(j)  (256  + 64 * (j))
#define XB_XSUB(j)  (1280 + 64 * (j))
#define XB_XGEN(j)  (2304 + 64 * (j))
#define XB_TOP      3328
#define XB_TOPGEN   3392
#define XCD_BAR_WORDS 3456
#define XB_SPIN_CAP (1u << 18)

__device__ __forceinline__ unsigned xb_ld(unsigned* p)              { return __hip_atomic_load(p, __ATOMIC_RELAXED, __HIP_MEMORY_SCOPE_AGENT); }
__device__ __forceinline__ unsigned xb_add(unsigned* p, unsigned v) { return __hip_atomic_fetch_add(p, v, __ATOMIC_RELAXED, __HIP_MEMORY_SCOPE_AGENT); }
__device__ __forceinline__ unsigned xb_xcc_id() { return (unsigned)__builtin_amdgcn_s_getreg((3 << 11) | 20) & 0xFu; }
#define XB_SPIN(cond, bar) do { unsigned _sp = 0; while (cond) { __builtin_amdgcn_s_sleep(1); \
    if ((++_sp & 255u) == 0u) { if (xb_ld(&(bar)[XB_TMO])) break; if (_sp > XB_SPIN_CAP) { atomicAdd(&(bar)[XB_TMO], 1u); break; } } } } while (0)

struct XcdBarrier {
    unsigned* bar; unsigned x;
    volatile LAS unsigned* st;
};

__device__ __forceinline__ XcdBarrier xcd_barrier_post(unsigned* bar, volatile LAS unsigned* st) {
    XcdBarrier b; b.bar = bar; b.x = xb_xcc_id(); b.st = st;
    if (threadIdx.x == 0) (void)xb_add(&bar[XB_XCNT(b.x)], 1u);
    return b;
}
__device__ __forceinline__ void xcd_barrier_complete(unsigned* bar, unsigned x, unsigned& nloc, unsigned& nx) {
    const unsigned G = gridDim.x * gridDim.y * gridDim.z;
    unsigned sum, cnt, mine, sp = 0u;
    for (;;) {
        sum = 0u; cnt = 0u; mine = 0u;
#pragma unroll
        for (unsigned j = 0; j < 16; ++j) { const unsigned c = xb_ld(&bar[XB_XCNT(j)]); sum += c; cnt += (c > 0u) ? 1u : 0u; mine = (j == x) ? c : mine; }
        if (sum == G) break;
        __builtin_amdgcn_s_sleep(1);
        if ((++sp & 255u) == 0u) { if (xb_ld(&bar[XB_TMO])) break; if (sp > XB_SPIN_CAP) { atomicAdd(&bar[XB_TMO], 1u); break; } }
    }
    nloc = mine > 0u ? mine : 1u; nx = cnt > 0u ? cnt : 1u;
}

__device__ __forceinline__ void xcd_barrier(const XcdBarrier& b) {
    asm volatile("s_waitcnt vmcnt(0)" ::: "memory");
    __syncthreads();
    if (threadIdx.x == 0) {
        unsigned* bar = b.bar;
        __builtin_amdgcn_s_waitcnt(0);
        unsigned nloc = b.st[0], nx = b.st[1];
        if (nloc == 0u) { xcd_barrier_complete(bar, b.x, nloc, nx); b.st[0] = nloc; b.st[1] = nx; }
        const unsigned old = xb_add(&bar[XB_XSUB(b.x)], 1u);
        const unsigned gen = old / nloc;
        if (old + 1u == (gen + 1u) * nloc) {
            __builtin_amdgcn_fence(__ATOMIC_RELEASE, "agent");
            asm volatile("s_waitcnt vmcnt(0)" ::: "memory");
            const unsigned og = xb_add(&bar[XB_TOP], 1u);
            const unsigned tg = og / nx;
            if (og + 1u == (tg + 1u) * nx) xb_add(&bar[XB_TOPGEN], 1u);
            else XB_SPIN(xb_ld(&bar[XB_TOPGEN]) == tg, bar);
            __builtin_amdgcn_fence(__ATOMIC_ACQUIRE, "agent");
            xb_add(&bar[XB_XGEN(b.x)], 1u);
            asm volatile("s_waitcnt vmcnt(0)" ::: "memory");
        } else {
            XB_SPIN(xb_ld(&bar[XB_XGEN(b.x)]) == gen, bar);
            __builtin_amdgcn_fence(__ATOMIC_ACQUIRE, "agent");
            asm volatile("s_waitcnt vmcnt(0)" ::: "memory");
        }
    }
    __syncthreads();
}

struct Args { const float* in[21]; float* out; unsigned char* ws; int ph_lo, ph_hi, li, pad; };
enum { I_X = 0, I_P, I_WIN, I_CONVW, I_ALOG, I_DTB, I_NORMW, I_POOLW, I_POOLS, I_WOUT, I_LN1G, I_LN1B, I_WR, I_BR, I_WEG, I_WEU, I_WED, I_LN2G, I_LN2B, I_WPP, I_WPG };
struct Frame {
    LAS unsigned char* lds;
    volatile LAS unsigned* MISC;
    gu32* ctl;
    int tid, lane, wave, vcu, G;
};

#ifndef FP8_LAST
#define FP8_LAST 1
#endif
#ifndef FP8_PG
#define FP8_PG 0
#endif
#ifndef FP8_ALL
#define FP8_ALL 0
#endif
#ifndef FP8_PD
#define FP8_PD 0
#endif
#ifndef FP8_PI0
#define FP8_PI0 0
#endif
#define FP8_LAYER(l) (FP8_LAST && (FP8_ALL || (l) == DEPTH - 1))
#ifndef FP8_PI
#define FP8_PI 0
#endif
#define PHASE_FRAME(F0) Frame F = F0; { int t_ = threadIdx.x; asm volatile("" : "+v"(t_)); F.tid = t_; F.lane = t_ & 63; }
#define OPQ_S(p) asm volatile("" : "+s"(p))
#define OPQ_G(T, expr) ({ GAS T* g_ = (GAS T*)(expr); asm volatile("" : "+s"(g_)); (T*)g_; })
struct SchedDense {
    static constexpr bool RAGGED = false;
    int nM, nN, nwg, G, c; const char* A; const char* B; size_t astep, bstep;
    __device__ __forceinline__ void init(int M, int N, int G_, int c_, const void* A_, int lda, const void* B_, int ldb) { nM = M / 256; nN = N / 256; nwg = nM * nN; G = G_; c = c_;
        A = (const char*)A_; B = (const char*)B_; astep = (size_t)256 * lda * 2; bstep = (size_t)256 * ldb * 2; }
    __device__ __forceinline__ bool next(int i, pg8::Unit& u) const {
        const long L = (long)i * G + c; if (L >= nwg) return false;
        int wgid = (int)L; { const int q = nwg / 8, r = nwg % 8, xcd = wgid % 8, off = wgid / 8; wgid = (xcd < r ? xcd * (q + 1) : r * (q + 1) + (xcd - r) * q) + off; }
        const int nig = 8 * nN, gid = wgid / nig, fm = gid * 8, gsz = (nM - fm) < 8 ? (nM - fm) : 8;
        u.pm = fm + ((wgid % nig) % gsz); u.pn = (wgid % nig) / gsz;
        u.A = A + (size_t)u.pm * astep; u.B = B + (size_t)u.pn * bstep; u.rows = nullptr; u.nvalid = 256; u.aux = 0; u.rowbase = u.pm * 256; u.half = 0; return true;
    }
};
struct SchedPool {
    static constexpr bool RAGGED = false;
    int G, c; const char* A; const char* B;
    __device__ __forceinline__ bool next(int i, pg8::Unit& u) const {
        const int L = i * G + c; if (L >= 256) return false;
        u.pm = L >> 2; u.pn = L & 3; u.A = A + ((size_t)u.pm * 256 * PW + u.pn * 256) * 2; u.B = B + (size_t)u.pn * 65536 * 2; u.rows = nullptr; u.nvalid = 256; u.aux = 0; u.rowbase = u.pm * 256; u.half = 0; return true;
    }
};
struct SchedMoe {
    static constexpr bool RAGGED = true;
    int G, c, mode; const LAS int* tab; const char* A; const char* B; const int* list; int esz;
    __device__ __forceinline__ bool next(int i, pg8::Unit& u) const {
        const int L = i * G + c, nf = __builtin_amdgcn_readfirstlane(tab[64]), nh = __builtin_amdgcn_readfirstlane(tab[96]);
        if (L >= 8 * (nf + nh)) return false;
        const bool half = L >= 8 * nf; const int t = (half ? L - 8 * nf : L) >> 3, pn = L & 7, pbase = half ? 80 : 48;
        int e = 0;
#pragma unroll
        for (int k = 1; k < 16; ++k) { const int ts = __builtin_amdgcn_readfirstlane(tab[pbase + k]); if (t >= ts) e = k; }
        const int tl = t - __builtin_amdgcn_readfirstlane(tab[pbase + e]), cn = __builtin_amdgcn_readfirstlane(tab[32 + e]), blk = __builtin_amdgcn_readfirstlane(tab[e]);
        const int p0 = half ? ((cn >> 8) << 8) + 128 * tl : 256 * tl;
        u.pm = 0; u.pn = pn; u.aux = e; u.half = half ? 1 : 0; u.rowbase = blk * 128 + p0;
        const int nv = cn - p0; u.nvalid = nv < (half ? 128 : 256) ? nv : (half ? 128 : 256);
        if (mode == 0) { u.A = A; u.rows = list + (size_t)e * LCAP + p0; u.B = B + ((size_t)e * 2048 + pn * 256) * 2048 * esz; }
        else { u.A = A + (size_t)u.rowbase * DE * esz; u.rows = nullptr; u.B = B + ((size_t)e * 2048 + pn * 256) * DE * esz; }
        return true;
    }
};

using pg8::cvt_pk_bf16;
struct EpiBf16 {
    static constexpr bool PERM = true; bf16* O; int ldc; float scale = 1.0f;
    __device__ __forceinline__ void operator()(const f32x4 (&acc)[2][2][4][2], const pg8::Unit& u, int wr, int wc, int fr, int fq) const {
        const int row0 = u.rowbase + wr * 64 + fr, col0 = u.pn * 256 + wc * 32 + 8 * fq;
#pragma unroll
        for (int ai = 0; ai < 2; ++ai) if (ai == 0 || !u.half)
#pragma unroll
            for (int m = 0; m < 4; ++m) { bf16* rowp = O + (size_t)(row0 + ai * 128 + m * 16) * ldc + col0;
#pragma unroll
                for (int bj = 0; bj < 2; ++bj) { const f32x4 v0 = acc[ai][bj][m][0] * scale, v1 = acc[ai][bj][m][1] * scale;
                    v4u w; w.x = cvt_pk_bf16(v0[0], v0[1]); w.y = cvt_pk_bf16(v0[2], v0[3]); w.z = cvt_pk_bf16(v1[0], v1[1]); w.w = cvt_pk_bf16(v1[2], v1[3]);
                    *(v4u*)(rowp + bj * 128) = w; } }
    }
};
struct EpiPool {
    static constexpr bool PERM = true; bf16* O; const float* scale; int f8 = 0;
    __device__ __forceinline__ void operator()(const f32x4 (&acc)[2][2][4][2], const pg8::Unit& u, int wr, int wc, int fr, int fq) const {
        const int row0 = u.rowbase + wr * 64 + fr, cg = u.pn * 256 + wc * 32 + 8 * fq;
        f32x4 sv[2][2];
#pragma unroll
        for (int bj = 0; bj < 2; ++bj) { sv[bj][0] = *(const f32x4*)(scale + cg + bj * 128); sv[bj][1] = *(const f32x4*)(scale + cg + bj * 128 + 4); }
#pragma unroll
        for (int ai = 0; ai < 2; ++ai)
#pragma unroll
            for (int m = 0; m < 4; ++m) { bf16* rowp = O + (size_t)(row0 + ai * 128 + m * 16) * D + DNW + cg;
#pragma unroll
                for (int bj = 0; bj < 2; ++bj) { const f32x4 v0 = acc[ai][bj][m][0] * sv[bj][0], v1 = acc[ai][bj][m][1] * sv[bj][1];
                    if (f8) { v2u w8; w8.x = pk4_fp8(v0[0] * F8_XS, v0[1] * F8_XS, v0[2] * F8_XS, v0[3] * F8_XS); w8.y = pk4_fp8(v1[0] * F8_XS, v1[1] * F8_XS, v1[2] * F8_XS, v1[3] * F8_XS);
                        *(v2u*)((unsigned char*)O + (size_t)(row0 + ai * 128 + m * 16) * D + DNW + cg + bj * 128) = w8; }
                    else { v4u w; w.x = cvt_pk_bf16(v0[0], v0[1]); w.y = cvt_pk_bf16(v0[2], v0[3]); w.z = cvt_pk_bf16(v1[0], v1[1]); w.w = cvt_pk_bf16(v1[2], v1[3]);
                    *(v4u*)(rowp + bj * 128) = w; } } }
    }
};
struct EpiRes {
    static constexpr bool PERM = true; const bf16* XB; bf16* PRE; float ascale = 1.0f;
    __device__ __forceinline__ void operator()(const f32x4 (&acc)[2][2][4][2], const pg8::Unit& u, int wr, int wc, int fr, int fq) const {
        const int row0 = u.rowbase + wr * 64 + fr, col0 = u.pn * 256 + wc * 32 + 8 * fq;
#pragma unroll
        for (int ai = 0; ai < 2; ++ai) { v4u xq[4][2];
#pragma unroll
            for (int m = 0; m < 4; ++m)
#pragma unroll
                for (int bj = 0; bj < 2; ++bj) xq[m][bj] = *(const v4u*)(XB + (size_t)(row0 + ai * 128 + m * 16) * D + col0 + bj * 128);
            asm volatile("" : "+v"(xq[0][0]), "+v"(xq[0][1]), "+v"(xq[1][0]), "+v"(xq[1][1]), "+v"(xq[2][0]), "+v"(xq[2][1]), "+v"(xq[3][0]), "+v"(xq[3][1]));
#pragma unroll
            for (int m = 0; m < 4; ++m)
#pragma unroll
                for (int bj = 0; bj < 2; ++bj) { const size_t off = (size_t)(row0 + ai * 128 + m * 16) * D + col0 + bj * 128; const v4u x = xq[m][bj]; const f32x4 a0 = acc[ai][bj][m][0] * ascale, a1 = acc[ai][bj][m][1] * ascale;
                    v4u w; w.x = cvt_pk_bf16(bflo(x.x) * ALPHA + a0[0], bfhi(x.x) * ALPHA + a0[1]); w.y = cvt_pk_bf16(bflo(x.y) * ALPHA + a0[2], bfhi(x.y) * ALPHA + a0[3]);
                    w.z = cvt_pk_bf16(bflo(x.z) * ALPHA + a1[0], bfhi(x.z) * ALPHA + a1[1]); w.w = cvt_pk_bf16(bflo(x.w) * ALPHA + a1[2], bfhi(x.w) * ALPHA + a1[3]);
                    *(v4u*)(PRE + off) = w; } }
    }
};
struct EpiSwiglu {
    static constexpr bool PERM = true; bf16* O; int f8 = 0; float ascale = 1.0f;
    __device__ __forceinline__ void operator()(const f32x4 (&acc)[2][2][4][2], const pg8::Unit& u, int wr, int wc, int fr, int fq) const {
        const int row0 = u.rowbase + wr * 64 + fr, col0 = u.pn * 128 + wc * 32 + 8 * fq;
#pragma unroll
        for (int ai = 0; ai < 2; ++ai) if (ai == 0 || !u.half)
#pragma unroll
            for (int m = 0; m < 4; ++m) { bf16* rowp = O + (size_t)(row0 + ai * 128 + m * 16) * DE + col0;
                float h[8];
#pragma unroll
                for (int n = 0; n < 2; ++n)
#pragma unroll
                    for (int j = 0; j < 4; ++j) { const float g = acc[ai][0][m][n][j] * ascale, up = acc[ai][1][m][n][j] * ascale; h[4 * n + j] = g * sigmoidf_(g) * up; }
                if (f8) { v2u w8; w8.x = pk4_fp8(h[0] * F8_XS, h[1] * F8_XS, h[2] * F8_XS, h[3] * F8_XS); w8.y = pk4_fp8(h[4] * F8_XS, h[5] * F8_XS, h[6] * F8_XS, h[7] * F8_XS);
                    *(v2u*)((unsigned char*)O + (size_t)(row0 + ai * 128 + m * 16) * DE + col0) = w8; }
                else { v4u w; w.x = cvt_pk_bf16(h[0], h[1]); w.y = cvt_pk_bf16(h[2], h[3]); w.z = cvt_pk_bf16(h[4], h[5]); w.w = cvt_pk_bf16(h[6], h[7]);
                *(v4u*)rowp = w; } }
    }
};
struct EpiPle {
    static constexpr bool PERM = true; const bf16* X2B; const bf16* PP; bf16* XB; float* OUT; int last; float ascale = 1.0f;
    __device__ __forceinline__ void operator()(const f32x4 (&acc)[2][2][4][2], const pg8::Unit& u, int wr, int wc, int fr, int fq) const {
        const int row0 = u.rowbase + wr * 64 + fr, col0 = u.pn * 256 + wc * 32 + 8 * fq;
#pragma unroll
        for (int ai = 0; ai < 2; ++ai)
#pragma unroll
            for (int mp = 0; mp < 2; ++mp) { v4u xq[2][2], pq[2][2];
#pragma unroll
                for (int mm = 0; mm < 2; ++mm)
#pragma unroll
                    for (int bj = 0; bj < 2; ++bj) { const size_t off = (size_t)(row0 + ai * 128 + (2 * mp + mm) * 16) * D + col0 + bj * 128; xq[mm][bj] = *(const v4u*)(X2B + off); pq[mm][bj] = *(const v4u*)(PP + off); }
                asm volatile("" : "+v"(xq[0][0]), "+v"(xq[0][1]), "+v"(xq[1][0]), "+v"(xq[1][1]), "+v"(pq[0][0]), "+v"(pq[0][1]), "+v"(pq[1][0]), "+v"(pq[1][1]));
#pragma unroll
                for (int mm = 0; mm < 2; ++mm)
#pragma unroll
                    for (int bj = 0; bj < 2; ++bj) { const int m = 2 * mp + mm; const size_t off = (size_t)(row0 + ai * 128 + m * 16) * D + col0 + bj * 128;
                        const v4u xx = xq[mm][bj], pp = pq[mm][bj];
                        const f32x4 a0 = acc[ai][bj][m][0] * ascale, a1 = acc[ai][bj][m][1] * ascale;
                        f32x4 o0, o1;
                        o0[0] = bflo(xx.x) + sigmoidf_(a0[0]) * bflo(pp.x); o0[1] = bfhi(xx.x) + sigmoidf_(a0[1]) * bfhi(pp.x); o0[2] = bflo(xx.y) + sigmoidf_(a0[2]) * bflo(pp.y); o0[3] = bfhi(xx.y) + sigmoidf_(a0[3]) * bfhi(pp.y);
                        o1[0] = bflo(xx.z) + sigmoidf_(a1[0]) * bflo(pp.z); o1[1] = bfhi(xx.z) + sigmoidf_(a1[1]) * bfhi(pp.z); o1[2] = bflo(xx.w) + sigmoidf_(a1[2]) * bflo(pp.w); o1[3] = bfhi(xx.w) + sigmoidf_(a1[3]) * bfhi(pp.w);
                        if (last) { *(f32x4*)(OUT + off) = o0; *(f32x4*)(OUT + off + 4) = o1; }
                        else { v4u w; w.x = cvt_pk_bf16(o0[0], o0[1]); w.y = cvt_pk_bf16(o0[2], o0[3]); w.z = cvt_pk_bf16(o1[0], o1[1]); w.w = cvt_pk_bf16(o1[2], o1[3]); *(v4u*)(XB + off) = w; } } }
    }
};

__device__ __forceinline__ void tr_item(const float* W, int ldw, int k0, int n0, bf16* WT, size_t drow0, int ldt, LAS float* scr, int lane) {
#pragma unroll 8
    for (int i = 0; i < 32; ++i) { const int kk = 2 * i + (lane >> 5); scr[kk * 33 + (lane & 31)] = W[(size_t)(k0 + kk) * ldw + n0 + (lane & 31)]; }
    LDS_WAIT(); asm volatile("" ::: "memory");
    const int c = lane & 7;
#pragma unroll
    for (int j = 0; j < 4; ++j) { const int n = (lane >> 3) + 8 * j; const LAS float* s = scr + (8 * c) * 33 + n;
        v4u o; o.x = pk2(s[0 * 33], s[1 * 33]); o.y = pk2(s[2 * 33], s[3 * 33]); o.z = pk2(s[4 * 33], s[5 * 33]); o.w = pk2(s[6 * 33], s[7 * 33]);
        *(GAS v4u*)(WT + (drow0 + n) * ldt + k0 + 8 * c) = o; }
    LDS_WAIT(); asm volatile("" ::: "memory");
}
__device__ __forceinline__ void tr_item8(const float* W, int ldw, int k0, int n0, unsigned char* WT, size_t drow0, int ldt, LAS float* scr, int lane) {
#pragma unroll 8
    for (int i = 0; i < 32; ++i) { const int kk = 2 * i + (lane >> 5); scr[kk * 33 + (lane & 31)] = W[(size_t)(k0 + kk) * ldw + n0 + (lane & 31)]; }
    LDS_WAIT(); asm volatile("" ::: "memory");
    const int c = lane & 7;
#pragma unroll
    for (int j = 0; j < 4; ++j) { const int n = (lane >> 3) + 8 * j; const LAS float* s = scr + (8 * c) * 33 + n;
        v2u o; o.x = pk4_fp8(s[0 * 33] * F8_WS, s[1 * 33] * F8_WS, s[2 * 33] * F8_WS, s[3 * 33] * F8_WS); o.y = pk4_fp8(s[4 * 33] * F8_WS, s[5 * 33] * F8_WS, s[6 * 33] * F8_WS, s[7 * 33] * F8_WS);
        *(GAS v2u*)(WT + (drow0 + n) * ldt + k0 + 8 * c) = o; }
    LDS_WAIT(); asm volatile("" ::: "memory");
}
__device__ __forceinline__ void weight_items(const Args& a, unsigned char* ws, LAS float* scr, int lane, int group, int l, int gw, int NGW) {
    constexpr int I_INA = 32 * 128, I_INB = 32 * 32, I_OUT = 32 * 64, I_PG = 32 * 64, I_PP = 4 * 64, I_POOL = 4 * 32, I_EG = NE * 32 * 32, I_EU = I_EG, I_ED = NE * 16 * 64;
    if (group == 0) {
        for (int it = gw; it < I_INA + I_INB + I_PP + I_POOL; it += NGW) { int r = it;
            if (r < I_INA) { const int kb = r / 128, nb = r % 128; tr_item(a.in[I_WIN] + (size_t)l * D * IN_COLS, IN_COLS, 64 * kb, 32 * nb, (bf16*)(ws + WS_WIN) + (size_t)l * NPROJ * D, 32 * nb, D, scr, lane); continue; } r -= I_INA;
            if (r < I_INB) { const int kb = r / 32, nb = r % 32; tr_item(a.in[I_WIN] + (size_t)l * D * IN_COLS, IN_COLS, 64 * kb, 4112 + 32 * nb, (bf16*)(ws + WS_WIN) + (size_t)l * NPROJ * D, 4096 + 32 * nb, D, scr, lane); continue; } r -= I_INB;
            if (r < I_PP) { const int kb = r / 64, nb = r % 64; tr_item(a.in[I_WPP] + (size_t)l * PLE * D, D, 64 * kb, 32 * nb, (bf16*)(ws + WS_WPP) + (size_t)l * D * PLE, 32 * nb, PLE, scr, lane); continue; } r -= I_PP;
            { const int g = r / 32, rr = r % 32, kb = rr / 8, nb = rr % 8; tr_item(a.in[I_POOLW] + ((size_t)l * 4 + g) * 65536, 256, 64 * kb, 32 * nb, (bf16*)(ws + WS_WPOOL) + ((size_t)l * 4 + g) * 65536, 32 * nb, 256, scr, lane); } }
    } else {
        const bool f8 = FP8_LAYER(l);
        for (int it = gw; it < I_OUT + I_PG + I_EG + I_EU + I_ED; it += NGW) { int r = it;
            if (r < I_OUT) { const int kb = r / 64, nb = r % 64; if (FP8_PD) tr_item8(a.in[I_WOUT] + (size_t)l * D * D, D, 64 * kb, 32 * nb, ws + WS_WOUT + (size_t)l * D * D * 2, 32 * nb, D, scr, lane); else tr_item(a.in[I_WOUT] + (size_t)l * D * D, D, 64 * kb, 32 * nb, (bf16*)(ws + WS_WOUT) + (size_t)l * D * D, 32 * nb, D, scr, lane); continue; } r -= I_OUT;
            if (r < I_PG) { const int kb = r / 64, nb = r % 64; if (FP8_PI && (FP8_PI0 || l == DEPTH - 1)) tr_item8(a.in[I_WPG] + (size_t)l * D * D, D, 64 * kb, 32 * nb, ws + WS_WPG + (size_t)l * D * D * 2, 32 * nb, D, scr, lane); else tr_item(a.in[I_WPG] + (size_t)l * D * D, D, 64 * kb, 32 * nb, (bf16*)(ws + WS_WPG) + (size_t)l * D * D, 32 * nb, D, scr, lane); continue; } r -= I_PG;
            if (r < I_EG) { const int e = r / 1024, rr = r % 1024, kb = rr / 32, nb = rr % 32, h0 = 32 * nb;
                if (f8) tr_item8(a.in[I_WEG] + ((size_t)l * NE + e) * D * DE, DE, 64 * kb, h0, ws + WS_WGU + (size_t)l * NE * 2048 * D * 2 + (size_t)e * 2048 * D, (size_t)(h0 >> 7) * 256 + (h0 & 127), D, scr, lane);
                else tr_item(a.in[I_WEG] + ((size_t)l * NE + e) * D * DE, DE, 64 * kb, h0, (bf16*)(ws + WS_WGU) + ((size_t)l * NE + e) * 2048 * D, (size_t)(h0 >> 7) * 256 + (h0 & 127), D, scr, lane); continue; } r -= I_EG;
            if (r < I_EU) { const int e = r / 1024, rr = r % 1024, kb = rr / 32, nb = rr % 32, h0 = 32 * nb;
                if (f8) tr_item8(a.in[I_WEU] + ((size_t)l * NE + e) * D * DE, DE, 64 * kb, h0, ws + WS_WGU + (size_t)l * NE * 2048 * D * 2 + (size_t)e * 2048 * D, (size_t)(h0 >> 7) * 256 + 128 + (h0 & 127), D, scr, lane);
                else tr_item(a.in[I_WEU] + ((size_t)l * NE + e) * D * DE, DE, 64 * kb, h0, (bf16*)(ws + WS_WGU) + ((size_t)l * NE + e) * 2048 * D, (size_t)(h0 >> 7) * 256 + 128 + (h0 & 127), D, scr, lane); continue; } r -= I_EU;
            { const int e = r / 1024, rr = r % 1024, kb = rr / 64, nb = rr % 64;
                if (f8 && FP8_PG) tr_item8(a.in[I_WED] + ((size_t)l * NE + e) * DE * D, D, 64 * kb, 32 * nb, ws + WS_WD + (size_t)l * NE * D * DE * 2 + (size_t)e * D * DE, 32 * nb, DE, scr, lane);
                else tr_item(a.in[I_WED] + ((size_t)l * NE + e) * DE * D, D, 64 * kb, 32 * nb, (bf16*)(ws + WS_WD) + ((size_t)l * NE + e) * D * DE, 32 * nb, DE, scr, lane); } }
    }
}
__device__ __forceinline__ void p0_prologue(const Frame& F0, const Args& a) {
    PHASE_FRAME(F0);
    LAS float* scr = (LAS float*)(F.lds + RING_OFF + F.wave * 16384);
    const int gw = F.vcu * NWAVES + F.wave, NGW = F.G * NWAVES;
    unsigned char* ws = OPQ_G(unsigned char, a.ws);
#pragma unroll 1
    for (int l = 0; l < DEPTH; ++l) weight_items(a, ws, scr, F.lane, 0, l, gw, NGW);
#ifdef CONVERT_ALL_IN_PROLOGUE
#pragma unroll 1
    for (int l = 0; l < DEPTH; ++l) weight_items(a, ws, scr, F.lane, 1, l, gw, NGW);
#endif
    const size_t gt = (size_t)F.vcu * 512 + F.tid, NGT = (size_t)F.G * 512;
    { const GAS f32x4* src = (const GAS f32x4*)a.in[I_X]; GAS v4u* dst = (GAS v4u*)(ws + WS_XB);
        for (size_t i = gt; i < (size_t)T * D / 8; i += NGT) { const f32x4 v0 = src[2 * i], v1 = src[2 * i + 1]; v4u o; o.x = pk2(v0[0], v0[1]); o.y = pk2(v0[2], v0[3]); o.z = pk2(v1[0], v1[1]); o.w = pk2(v1[2], v1[3]); dst[i] = o; } }
    { const GAS f32x4* src = (const GAS f32x4*)a.in[I_P]; GAS v4u* dst = (GAS v4u*)(ws + WS_PB16);
        for (size_t i = gt; i < (size_t)DEPTH * T * PLE / 8; i += NGT) { const f32x4 v0 = src[2 * i], v1 = src[2 * i + 1]; v4u o; o.x = pk2(v0[0], v0[1]); o.y = pk2(v0[2], v0[3]); o.z = pk2(v1[0], v1[1]); o.w = pk2(v1[2], v1[3]); dst[i] = o; } }
    for (size_t i = gt; i < (size_t)DEPTH * 16 * D; i += NGT) { const int l = (int)(i / (16 * D)), j = (int)((i / D) % 16), k = (int)(i % D);
        ((bf16*)(ws + WS_WBA))[i] = (bf16)f2bf(a.in[I_WIN][((size_t)l * D + k) * IN_COLS + 4096 + j]); }
}

typedef float f32x16 __attribute__((ext_vector_type(16)));
#define MFMA32(a_, b_, c_) __builtin_amdgcn_mfma_f32_32x32x16_bf16((a_), (b_), (c_), 0, 0, 0)
#define PACK8(x, sp) __builtin_bit_cast(bf16x8, (v4u){pkbf((x)[8 * (sp)], (x)[8 * (sp) + 1]), pkbf((x)[8 * (sp) + 2], (x)[8 * (sp) + 3]), pkbf((x)[8 * (sp) + 4], (x)[8 * (sp) + 5]), pkbf((x)[8 * (sp) + 6], (x)[8 * (sp) + 7])})
#define RAW_BAR() do { asm volatile("s_waitcnt lgkmcnt(0)" ::: "memory"); __builtin_amdgcn_s_barrier(); asm volatile("" ::: "memory"); } while (0)
constexpr int IMG_ELEMS = 56 * 512, UIMG_ELEMS = 8 * 1024;
constexpr int FR_WN = 0, FR_QD = 16, FR_AQK = 32, FR_KDT = 40;
constexpr size_t WS_IMG = WS_R2, WS_UIMG = WS_R2 + 112 * MiB;
static_assert((size_t)NB * NCH * NH * IMG_ELEMS * 2 == 112 * MiB && (size_t)NB * NCH * NH * UIMG_ELEMS * 2 == 32 * MiB, "DeltaNet images");

__device__ __forceinline__ void pool_diffs_unit(const Frame& F, unsigned char* ws, int pm, int g) {
    const bf16* PROJ = (const bf16*)(ws + WS_PROJ); bf16* POOLD = (bf16*)(ws + WS_POOLD);
    const int tid = F.tid, cp = tid & 127, rq = tid >> 7, r0 = 256 * pm + 64 * rq, sq0 = r0 % SEQ, col = 256 * g + 2 * cp;
    const bf16* up = PROJ + (size_t)r0 * NPROJ + 4096 + col; bf16* dp = POOLD + (size_t)r0 * PW + col;
#define POOL_BODY(WIN) do { unsigned xr[CH + WIN - 1]; \
        _Pragma("unroll") for (int j = 0; j < WIN - 1; ++j) xr[j] = (sq0 - (WIN - 1) + j >= 0) ? *(const unsigned*)(up + (ptrdiff_t)(j - (WIN - 1)) * NPROJ) : 0u; \
        _Pragma("unroll") for (int i = 0; i < CH; ++i) xr[WIN - 1 + i] = *(const unsigned*)(up + (size_t)i * NPROJ); \
        float s0 = 0.f, s1 = 0.f; \
        _Pragma("unroll") for (int j = 0; j < WIN - 1; ++j) { s0 += bflo(xr[j]); s1 += bfhi(xr[j]); } \
        _Pragma("unroll") for (int i = 0; i < CH; ++i) { const float x0 = bflo(xr[WIN - 1 + i]), x1 = bfhi(xr[WIN - 1 + i]); s0 += x0; s1 += x1; \
            const int pos = sq0 + i; const float inv = __builtin_amdgcn_rcpf((float)((pos + 1) < WIN ? (pos + 1) : WIN)); \
            *(unsigned*)(dp + (size_t)i * PW) = pkbf(s0 * inv - x0, s1 * inv - x1); s0 -= bflo(xr[i]); s1 -= bfhi(xr[i]); } } while (0)
    if (g == 0) POOL_BODY(2); else if (g == 1) POOL_BODY(4); else if (g == 2) POOL_BODY(8); else POOL_BODY(16);
#undef POOL_BODY
}
#ifndef PREP_DUP
#define PREP_DUP 0
#endif
constexpr int PQF = 0, PKF = 33792, PQS = 67584, PKS = 84992, PVT = 102400, PKT = 120832, PTAB = 139264;
constexpr int PAS = PQF;
constexpr int PTB = PKF, PT11T = PKF + 9216, PPART = PKF;
constexpr int F_LD = 132, S_LD = 136, T_LD = 72, A_LD = 68, TT_LD = 40;
__device__ __forceinline__ void phase_dn_prep(const Frame& F0, const Args& a, int layer) {
    PHASE_FRAME(F0);
    unsigned char* ws = OPQ_G(unsigned char, a.ws);
    LAS unsigned char* lds = F.lds;
    LAS float* Qf = (LAS float*)(lds + PQF); LAS float* Kf = (LAS float*)(lds + PKF); LAS float* As = (LAS float*)(lds + PAS);
    LAS bf16* Qs = (LAS bf16*)(lds + PQS); LAS bf16* Ks = (LAS bf16*)(lds + PKS); LAS bf16* Vt = (LAS bf16*)(lds + PVT); LAS bf16* Kt = (LAS bf16*)(lds + PKT);
    LAS bf16* Tb = (LAS bf16*)(lds + PTB); LAS bf16* T11t = (LAS bf16*)(lds + PT11T);
    LAS float* betaS = (LAS float*)(lds + PTAB); LAS float* gS = betaS + 512; LAS float* gamh = gS + 512; LAS float* betah = gamh + 64; LAS float* egam = betah + 64; LAS float* bgam = egam + 64; LAS float* ekd = bgam + 64; LAS float* rkS = ekd + 64;
    const bf16* XB = (const bf16*)(ws + WS_XB); const bf16* PROJ = (const bf16*)(ws + WS_PROJ); const bf16* WBA = (const bf16*)(ws + WS_WBA) + (size_t)layer * 16 * D;
    bf16* IMG = (bf16*)(ws + WS_IMG); bf16* UIMG = (bf16*)(ws + WS_UIMG); float* CD = (float*)(ws + WS_CD);
    const float* convw = a.in[I_CONVW] + (size_t)layer * 4 * 3072; const float* alog = a.in[I_ALOG] + layer * NH; const float* dtb = a.in[I_DTB] + layer * NH;
    const int tid = F.tid, lane = F.lane, wave = F.wave, c32 = lane & 31, hf = lane >> 5;
    for (int unit = F.vcu; unit < NB * NCH; unit += F.G) {
        const int b = unit / NCH, n = unit % NCH, r0 = b * SEQ + n * CH, sq0 = n * CH;
        for (int rep_ = 0; rep_ < ((PREP_DUP & 64) ? 2 : 1); ++rep_)
        { typedef float f32x4v __attribute__((ext_vector_type(4)));
            const int fr = lane & 15, fg = lane >> 4; f32x4v pacc[4];
#pragma unroll
            for (int mt = 0; mt < 4; ++mt) pacc[mt] = (f32x4v){0.f, 0.f, 0.f, 0.f};
#pragma unroll 1
            for (int sb = 0; sb < 8; sb += 4) {
                bf16x8 bq[4], aq[4][4];
#pragma unroll
                for (int s = 0; s < 4; ++s) { const int k0 = 256 * wave + 32 * (sb + s) + 8 * fg; bq[s] = *(const bf16x8*)(WBA + (size_t)fr * D + k0);
#pragma unroll
                    for (int mt = 0; mt < 4; ++mt) aq[s][mt] = *(const bf16x8*)(XB + (size_t)(r0 + 16 * mt + fr) * D + k0); }
                asm volatile("" : "+v"(bq[0]), "+v"(bq[1]), "+v"(bq[2]), "+v"(bq[3]), "+v"(aq[0][0]), "+v"(aq[0][1]), "+v"(aq[0][2]), "+v"(aq[0][3]), "+v"(aq[1][0]), "+v"(aq[1][1]), "+v"(aq[1][2]), "+v"(aq[1][3]),
                             "+v"(aq[2][0]), "+v"(aq[2][1]), "+v"(aq[2][2]), "+v"(aq[2][3]), "+v"(aq[3][0]), "+v"(aq[3][1]), "+v"(aq[3][2]), "+v"(aq[3][3]));
#pragma unroll
                for (int s = 0; s < 4; ++s)
#pragma unroll
                    for (int mt = 0; mt < 4; ++mt) pacc[mt] = __builtin_amdgcn_mfma_f32_16x16x32_bf16(aq[s][mt], bq[s], pacc[mt], 0, 0, 0); }
            LAS float* part = (LAS float*)(lds + PPART) + wave * 1024;
#pragma unroll
            for (int mt = 0; mt < 4; ++mt)
#pragma unroll
                for (int r = 0; r < 4; ++r) part[(16 * mt + 4 * fg + r) * 16 + fr] = pacc[mt][r]; }
        __syncthreads();
        { const int tok = tid >> 3, cp = tid & 7; float s0 = 0.f, s1 = 0.f;
#pragma unroll
            for (int w = 0; w < 8; ++w) { const f32x2 p2 = *(const LAS f32x2*)((LAS float*)(lds + PPART) + w * 1024 + tok * 16 + 2 * cp); s0 += p2[0]; s1 += p2[1]; }
            if (cp < 4) { betaS[tok * 8 + 2 * cp] = sigmoidf_(s0); betaS[tok * 8 + 2 * cp + 1] = sigmoidf_(s1); }
            else { const int h = 2 * (cp - 4); const float z0 = s0 + dtb[h], z1 = s1 + dtb[h + 1];
                const float sp0 = z0 > 20.f ? z0 : log1pf(__expf(z0)), sp1 = z1 > 20.f ? z1 : log1pf(__expf(z1));
                gS[tok * 8 + h] = -__expf(alog[h]) * sp0; gS[tok * 8 + h + 1] = -__expf(alog[h + 1]) * sp1; } }
        __syncthreads();
        { float gv = gS[lane * 8 + wave];
#pragma unroll
            for (int o = 1; o < 64; o <<= 1) { const float up_ = __shfl_up(gv, o); if (lane >= o) gv += up_; }
            gS[lane * 8 + wave] = gv; }
        __syncthreads();
        unsigned craw[3][11]; unsigned cdum[3][8];
#define PREP_LOADRAW(hh) do { const int cp_ = tid & 63, i0_ = (tid >> 6) * 8; \
            _Pragma("unroll") for (int part_ = 0; part_ < 3; ++part_) { const bf16* src_ = PROJ + (size_t)(r0 + i0_ - 3) * NPROJ + part_ * 1024 + (hh) * HD + 2 * cp_; \
                _Pragma("unroll") for (int j_ = 0; j_ < 11; ++j_) craw[part_][j_] = (sq0 + i0_ - 3 + j_ >= 0) ? *(const unsigned*)(src_ + (ptrdiff_t)j_ * NPROJ) : 0u; \
                if (PREP_DUP & 256) { _Pragma("unroll") for (int j_ = 3; j_ < 11; ++j_) cdum[part_][j_ - 3] = *(const unsigned*)(src_ + (ptrdiff_t)j_ * NPROJ + ((hh) ^ 1) * HD - (hh) * HD); } } } while (0)
        PREP_LOADRAW(0);
        for (int hh_ = 0; hh_ < ((PREP_DUP & 128) ? 2 * NH : NH); ++hh_) { const int h = hh_ & (NH - 1);
            const size_t chd = (size_t)unit * NH + h; bf16* img = IMG + chd * IMG_ELEMS; bf16* uimg = UIMG + chd * UIMG_ELEMS;
            if (tid < 64) { const float gi = gS[tid * 8 + h], bi = betaS[tid * 8 + h], eg = __expf(gi); gamh[tid] = gi; betah[tid] = bi; egam[tid] = eg; bgam[tid] = bi * eg; ekd[tid] = __expf(gS[63 * 8 + h] - gi); }
            RAW_BAR();
            for (int rep_ = 0; rep_ < ((PREP_DUP & 16) ? 2 : 1); ++rep_)
            { const int cp = tid & 63, rg8 = tid >> 6, i0 = rg8 * 8;
                if (PREP_DUP & 256) {
#pragma unroll
                    for (int p_ = 0; p_ < 3; ++p_)
#pragma unroll
                        for (int j_ = 0; j_ < 8; ++j_) asm volatile("" :: "v"(cdum[p_][j_])); }
#pragma unroll
                for (int part = 0; part < 3; ++part) { const int col = part * 1024 + h * HD + 2 * cp;
                    const f32x2 cw0 = *(const f32x2*)(convw + col), cw1 = *(const f32x2*)(convw + 3072 + col), cw2 = *(const f32x2*)(convw + 2 * 3072 + col), cw3 = *(const f32x2*)(convw + 3 * 3072 + col);
                    float ya[8], yb[8];
#pragma unroll
                    for (int i = 0; i < 8; ++i) { const unsigned x3 = craw[part][i], x2 = craw[part][i + 1], x1 = craw[part][i + 2], x0 = craw[part][i + 3];
                        const float ta = cw0[0] * bflo(x3) + cw1[0] * bflo(x2) + cw2[0] * bflo(x1) + cw3[0] * bflo(x0), tb = cw0[1] * bfhi(x3) + cw1[1] * bfhi(x2) + cw2[1] * bfhi(x1) + cw3[1] * bfhi(x0);
                        ya[i] = ta * sigmoidf_(ta); yb[i] = tb * sigmoidf_(tb); }
                    if (part == 0) {
#pragma unroll
                        for (int i = 0; i < 8; ++i) *(LAS f32x2*)(Qf + (i0 + i) * F_LD + 2 * cp) = (f32x2){ya[i], yb[i]}; }
                    else if (part == 1) {
#pragma unroll
                        for (int i = 0; i < 8; ++i) *(LAS f32x2*)(Kf + (i0 + i) * F_LD + 2 * cp) = (f32x2){ya[i], yb[i]}; }
                    else { v4u o0, o1;
                        o0.x = pkbf(ya[0] * betah[i0 + 0], ya[1] * betah[i0 + 1]); o0.y = pkbf(ya[2] * betah[i0 + 2], ya[3] * betah[i0 + 3]); o0.z = pkbf(ya[4] * betah[i0 + 4], ya[5] * betah[i0 + 5]); o0.w = pkbf(ya[6] * betah[i0 + 6], ya[7] * betah[i0 + 7]);
                        o1.x = pkbf(yb[0] * betah[i0 + 0], yb[1] * betah[i0 + 1]); o1.y = pkbf(yb[2] * betah[i0 + 2], yb[3] * betah[i0 + 3]); o1.z = pkbf(yb[4] * betah[i0 + 4], yb[5] * betah[i0 + 5]); o1.w = pkbf(yb[6] * betah[i0 + 6], yb[7] * betah[i0 + 7]);
                        *(LAS v4u*)(Vt + (2 * cp) * T_LD + i0) = o0; *(LAS v4u*)(Vt + (2 * cp + 1) * T_LD + i0) = o1; } }
            }
            if (hh_ + 1 < ((PREP_DUP & 128) ? 2 * NH : NH)) PREP_LOADRAW((hh_ + 1) & (NH - 1));
            for (int rep_ = 0; rep_ < ((PREP_DUP & 1) ? 2 : 1); ++rep_) { if (rep_) RAW_BAR();
            { const int i = tid >> 3, part = tid & 7; const LAS float* qp = Qf + i * F_LD + part * 16; const LAS float* kp = Kf + i * F_LD + part * 16;
                f32x4 qv[4], kv[4]; float sq = 0.f, sk = 0.f;
#pragma unroll
                for (int j = 0; j < 4; ++j) { qv[j] = *(const LAS f32x4*)(qp + 4 * j); kv[j] = *(const LAS f32x4*)(kp + 4 * j);
                    sq += (qv[j][0] * qv[j][0] + qv[j][1] * qv[j][1]) + (qv[j][2] * qv[j][2] + qv[j][3] * qv[j][3]); sk += (kv[j][0] * kv[j][0] + kv[j][1] * kv[j][1]) + (kv[j][2] * kv[j][2] + kv[j][3] * kv[j][3]); }
                sq += __shfl_xor(sq, 1); sq += __shfl_xor(sq, 2); sq += __shfl_xor(sq, 4); sk += __shfl_xor(sk, 1); sk += __shfl_xor(sk, 2); sk += __shfl_xor(sk, 4);
                const float rq = 1.0f / sqrtf(sq + RMS_EPS) * 0.08838834764831845f, rk = 1.0f / sqrtf(sk + RMS_EPS);
                if (part == 0) rkS[i] = rk;
#pragma unroll
                for (int j = 0; j < 4; ++j) { qv[j] = qv[j] * rq; kv[j] = kv[j] * rk; }
                v4u w0, w1;
                w0.x = pkbf(qv[0][0], qv[0][1]); w0.y = pkbf(qv[0][2], qv[0][3]); w0.z = pkbf(qv[1][0], qv[1][1]); w0.w = pkbf(qv[1][2], qv[1][3]); w1.x = pkbf(qv[2][0], qv[2][1]); w1.y = pkbf(qv[2][2], qv[2][3]); w1.z = pkbf(qv[3][0], qv[3][1]); w1.w = pkbf(qv[3][2], qv[3][3]);
                *(LAS v4u*)(Qs + i * S_LD + part * 16) = w0; *(LAS v4u*)(Qs + i * S_LD + part * 16 + 8) = w1;
                w0.x = pkbf(kv[0][0], kv[0][1]); w0.y = pkbf(kv[0][2], kv[0][3]); w0.z = pkbf(kv[1][0], kv[1][1]); w0.w = pkbf(kv[1][2], kv[1][3]); w1.x = pkbf(kv[2][0], kv[2][1]); w1.y = pkbf(kv[2][2], kv[2][3]); w1.z = pkbf(kv[3][0], kv[3][1]); w1.w = pkbf(kv[3][2], kv[3][3]);
                *(LAS v4u*)(Ks + i * S_LD + part * 16) = w0; *(LAS v4u*)(Ks + i * S_LD + part * 16 + 8) = w1;
                const float eg = egam[i]; bf16* fq = img + ((size_t)(FR_QD + (i >> 5) * 8 + part) * 64 + (i & 31)) * 8;
                v4u h0, h1;
                h0.x = pkbf(qv[0][0] * eg, qv[0][1] * eg); h0.y = pkbf(qv[0][2] * eg, qv[0][3] * eg); h0.z = pkbf(qv[2][0] * eg, qv[2][1] * eg); h0.w = pkbf(qv[2][2] * eg, qv[2][3] * eg);
                h1.x = pkbf(qv[1][0] * eg, qv[1][1] * eg); h1.y = pkbf(qv[1][2] * eg, qv[1][3] * eg); h1.z = pkbf(qv[3][0] * eg, qv[3][1] * eg); h1.w = pkbf(qv[3][2] * eg, qv[3][3] * eg);
                *(v4u*)fq = h0; *(v4u*)(fq + 32 * 8) = h1; }
            RAW_BAR();
            { const int c = tid & 127, rg = tid >> 7; float kb[16], kd[16];
#pragma unroll
                for (int i = 0; i < 16; ++i) { const int t = rg * 16 + i; const float kn = Kf[t * F_LD + c] * rkS[t]; kb[i] = kn * bgam[t]; kd[i] = kn * ekd[t]; }
                v4u o0, o1;
                o0.x = pkbf(kb[0], kb[1]); o0.y = pkbf(kb[2], kb[3]); o0.z = pkbf(kb[4], kb[5]); o0.w = pkbf(kb[6], kb[7]); o1.x = pkbf(kb[8], kb[9]); o1.y = pkbf(kb[10], kb[11]); o1.z = pkbf(kb[12], kb[13]); o1.w = pkbf(kb[14], kb[15]);
                *(LAS v4u*)(Kt + c * T_LD + rg * 16) = o0; *(LAS v4u*)(Kt + c * T_LD + rg * 16 + 8) = o1;
                bf16* fk = img + ((size_t)(FR_KDT + (c >> 5) * 4 + rg) * 64 + (c & 31)) * 8;
                v4u h0, h1;
                h0.x = pkbf(kd[0], kd[1]); h0.y = pkbf(kd[2], kd[3]); h0.z = pkbf(kd[8], kd[9]); h0.w = pkbf(kd[10], kd[11]);
                h1.x = pkbf(kd[4], kd[5]); h1.y = pkbf(kd[6], kd[7]); h1.z = pkbf(kd[12], kd[13]); h1.w = pkbf(kd[14], kd[15]);
                *(v4u*)fk = h0; *(v4u*)(fk + 32 * 8) = h1; }
            RAW_BAR();
            }
            for (int rep_ = 0; rep_ < ((PREP_DUP & 2) ? 2 : 1); ++rep_) { if (rep_) RAW_BAR();
            if (wave < 6) { const int pr = wave % 3, iskk = wave / 3, mt = pr == 2 ? 1 : 0, nt = pr == 0 ? 0 : 1;
                const LAS bf16* xs = iskk ? Ks : Qs; f32x16 d;
#pragma unroll
                for (int r = 0; r < 16; ++r) d[r] = 0.f;
#pragma unroll
                for (int s = 0; s < 8; ++s) { const bf16x8 af = *(const LAS bf16x8*)(Ks + (32 * mt + c32) * S_LD + 16 * s + 8 * hf), bfr = *(const LAS bf16x8*)(xs + (32 * nt + c32) * S_LD + 16 * s + 8 * hf); d = MFMA32(af, bfr, d); }
                const int i = 32 * nt + c32; const float gi = gamh[i], bi = betah[i];
#pragma unroll
                for (int r = 0; r < 16; ++r) { const int j = 32 * mt + (r & 3) + 8 * (r >> 2) + 4 * hf; const float de = __expf(gi - gamh[j]);
                    d[r] = iskk ? ((j < i) ? bi * d[r] * de : 0.f) : ((j <= i) ? d[r] * de : 0.f); }
                if (iskk) {
#pragma unroll
                    for (int qd = 0; qd < 4; ++qd) *(LAS f32x4*)(As + i * A_LD + 32 * mt + 8 * qd + 4 * hf) = (f32x4){d[4 * qd], d[4 * qd + 1], d[4 * qd + 2], d[4 * qd + 3]}; }
                else {
#pragma unroll
                    for (int sp = 0; sp < 2; ++sp) *(bf16x8*)(img + ((size_t)(FR_AQK + nt * 4 + 2 * mt + sp) * 64 + lane) * 8) = PACK8(d, sp); } }
            RAW_BAR();
            }
            for (int rep_ = 0; rep_ < ((PREP_DUP & 4) ? 2 : 1); ++rep_) { if (rep_) RAW_BAR();
            if (wave < 2) {
                unsigned asb = (unsigned)(uintptr_t)(As + (32 * wave) * A_LD + 32 * wave); int cb = c32; asm volatile("" : "+v"(asb), "+v"(cb));
                const LAS float* Ab = (const LAS float*)(uintptr_t)asb;
                float arow[32], Tc[32];
#pragma unroll
                for (int i = 0; i < 32; ++i) arow[i] = Ab[i * A_LD + cb];
#pragma unroll
                for (int i = 0; i < 32; ++i) { float ac[4] = {(i == cb) ? 1.f : 0.f, 0.f, 0.f, 0.f}; if (i > 0) asm volatile("" : "+v"(arow[i]), "+v"(Tc[i - 1]));
#pragma unroll
                    for (int j = 0; j < i; ++j) { const float aij = __builtin_bit_cast(float, __builtin_amdgcn_readlane(__builtin_bit_cast(int, arow[i]), j)); ac[j & 3] -= aij * Tc[j]; }
                    Tc[i] = (ac[0] + ac[1]) + (ac[2] + ac[3]); __builtin_amdgcn_sched_barrier(0); }
                if (hf == 0) {
#pragma unroll
                    for (int i = 0; i < 32; ++i) Tb[(32 * wave + i) * T_LD + 32 * wave + c32] = (bf16)(pkbf(Tc[i], 0.f) & 0xffffu);
                    if (wave == 0) {
#pragma unroll
                        for (int q = 0; q < 4; ++q) { v4u o; o.x = pkbf(Tc[8 * q], Tc[8 * q + 1]); o.y = pkbf(Tc[8 * q + 2], Tc[8 * q + 3]); o.z = pkbf(Tc[8 * q + 4], Tc[8 * q + 5]); o.w = pkbf(Tc[8 * q + 6], Tc[8 * q + 7]); *(LAS v4u*)(T11t + c32 * TT_LD + 8 * q) = o; } } } }
            RAW_BAR();
            if (wave == 0) {
                f32x16 x;
#pragma unroll
                for (int r = 0; r < 16; ++r) x[r] = 0.f;
#pragma unroll
                for (int s = 0; s < 2; ++s) { const LAS float* ap = As + (32 + c32) * A_LD + 16 * s + 8 * hf; const f32x4 a0 = *(const LAS f32x4*)ap, a1 = *(const LAS f32x4*)(ap + 4);
                    const bf16x8 af = __builtin_bit_cast(bf16x8, (v4u){pkbf(a0[0], a0[1]), pkbf(a0[2], a0[3]), pkbf(a1[0], a1[1]), pkbf(a1[2], a1[3])});
                    const bf16x8 bfr = *(const LAS bf16x8*)(T11t + c32 * TT_LD + 16 * s + 8 * hf); x = MFMA32(af, bfr, x); }
                f32x16 t21;
#pragma unroll
                for (int r = 0; r < 16; ++r) t21[r] = 0.f;
#pragma unroll
                for (int s = 0; s < 2; ++s) { const LAS bf16* tp = Tb + (32 + c32) * T_LD + 32 + 16 * s + 4 * hf; const v2u lo = *(const LAS v2u*)tp, hi = *(const LAS v2u*)(tp + 8);
                    const bf16x8 af = __builtin_bit_cast(bf16x8, (v4u){lo.x, lo.y, hi.x, hi.y}); const bf16x8 bfr = PACK8(x, s); t21 = MFMA32(af, bfr, t21); }
#pragma unroll
                for (int r = 0; r < 16; ++r) Tb[(32 + (r & 3) + 8 * (r >> 2) + 4 * hf) * T_LD + c32] = (bf16)(pkbf(-t21[r], 0.f) & 0xffffu);
            }
            RAW_BAR();
            }
            for (int rep_ = 0; rep_ < ((PREP_DUP & 8) ? 2 : 1); ++rep_) { if (rep_) RAW_BAR();
            if (wave < 4) {
#pragma unroll
                for (int mt = 0; mt < 2; ++mt) { f32x16 d;
#pragma unroll
                    for (int r = 0; r < 16; ++r) d[r] = 0.f;
#pragma unroll
                    for (int s = 0; s < 4; ++s) if (s < 2 * (mt + 1)) { const bf16x8 af = *(const LAS bf16x8*)(Tb + (32 * mt + c32) * T_LD + 16 * s + 8 * hf), bfr = *(const LAS bf16x8*)(Vt + (32 * wave + c32) * T_LD + 16 * s + 8 * hf); d = MFMA32(af, bfr, d); }
                    bf16* up = uimg + ((size_t)(wave * 2 + mt) * 64 + lane) * 16; *(bf16x8*)up = PACK8(d, 0); *(bf16x8*)(up + 8) = PACK8(d, 1); } }
            else { const int ct = wave - 4;
#pragma unroll
                for (int nt = 0; nt < 2; ++nt) { f32x16 d;
#pragma unroll
                    for (int r = 0; r < 16; ++r) d[r] = 0.f;
#pragma unroll
                    for (int s = 0; s < 4; ++s) if (s < 2 * (nt + 1)) { const bf16x8 af = *(const LAS bf16x8*)(Kt + (32 * ct + c32) * T_LD + 16 * s + 8 * hf), bfr = *(const LAS bf16x8*)(Tb + (32 * nt + c32) * T_LD + 16 * s + 8 * hf); d = MFMA32(af, bfr, d); }
#pragma unroll
                    for (int r = 0; r < 16; ++r) d[r] = -d[r];
#pragma unroll
                    for (int sp = 0; sp < 2; ++sp) *(bf16x8*)(img + ((size_t)(FR_WN + nt * 8 + 2 * ct + sp) * 64 + lane) * 8) = PACK8(d, sp); } }
            }
            if (tid == 0) CD[chd] = egam[63];
            RAW_BAR();
        }
#undef PREP_LOADRAW
    }
}

__host__ __device__ constexpr int sc_p(int k) { const int j = k - 32; return j < 12 ? j % 6 : (j - 12) % 5; }
__host__ __device__ constexpr int sc_slab(int k) { const int j = k - 32; return k < 32 ? (k >> 2) : (j < 12 ? j / 6 : 2 + (j - 12) / 5); }
__host__ __device__ constexpr int sc_kind(int k) { return k < 32 ? ((k & 3) < 2 ? 0 : 1) : ((sc_p(k) == 2 || sc_p(k) == 5) ? 1 : 2); }
__host__ __device__ constexpr int sc_idx(int k) { return k < 32 ? (k & 1) : (sc_p(k) == 0 ? 0 : sc_p(k) == 1 ? 1 : sc_p(k) == 2 ? 1 : sc_p(k) == 3 ? 2 : sc_p(k) == 4 ? 3 : 0); }
__host__ __device__ constexpr int sc_frag(int k) { return k < 32 ? (((k & 3) < 2 ? FR_WN : FR_QD) + (k & 1) * 8 + (k >> 2)) : (sc_kind(k) == 1 ? FR_AQK + sc_idx(k) * 4 + sc_slab(k) : FR_KDT + sc_idx(k) * 4 + sc_slab(k)); }
constexpr int SC_QD = 8;
constexpr int SCB = 57344, OT_OFF = 2 * SCB, OT_LD = 136, OT_BYTES = 64 * OT_LD * 2;
static_assert(OT_OFF + 2 * OT_BYTES <= 152 * 1024, "scan LDS");
__device__ __forceinline__ void phase_dn_scan(const Frame& F0, const Args& a, int layer, int unit) {
    PHASE_FRAME(F0);
    unsigned char* ws = OPQ_G(unsigned char, a.ws);
    LAS unsigned char* lds = F.lds;
    const int b = unit >> 3, h = unit & 7, lane = F.lane;
    const bf16* IMG = (const bf16*)(ws + WS_IMG); const bf16* UIMG = (const bf16*)(ws + WS_UIMG); const float* CD = (const float*)(ws + WS_CD);
    const size_t chd0 = (size_t)b * NCH * NH + h;
    if (F.wave < 4) {
#ifndef SCAN_NO_COMPUTE
        const int w = F.wave, c32 = lane & 31, hf = lane >> 5;
        f32x16 S0, S1, S2, S3;
#pragma unroll
        for (int r = 0; r < 16; ++r) { S0[r] = 0.f; S1[r] = 0.f; S2[r] = 0.f; S3[r] = 0.f; }
        const float cdl = CD[chd0 + (size_t)lane * NH];
        v4u UA[4];
        const __amdgpu_buffer_rsrc_t rsU = __builtin_amdgcn_make_buffer_rsrc((void*)(UIMG + chd0 * UIMG_ELEMS), (short)0, NCH * NH * UIMG_ELEMS * 2, 0x00020000);
        const unsigned uoff = (unsigned)((w * 2) * 64 + lane) * 32u;
#define SC_LOADU(dst, nn) do { _Pragma("unroll") for (int mt_ = 0; mt_ < 2; ++mt_) { _Pragma("unroll") for (int hh_ = 0; hh_ < 2; ++hh_) dst[2 * mt_ + hh_] = __builtin_amdgcn_raw_buffer_load_b128(rsU, uoff + (unsigned)(mt_ * 2048 + hh_ * 16), (unsigned)(nn) * (unsigned)(NH * UIMG_ELEMS * 2), 0); } } while (0)
#define SC_FRAG(bufoff, fi) (*(const LAS bf16x8*)(lds + (bufoff) + (fi) * 1024 + lane * 16))
#define SC_CHUNK(nn, U, bufoff, otoff) do { \
        f32x16 aV0, aV1, aO0, aO1; bf16x8 fq0, fq1, fq2, fq3, fq4, fq5, fq6, fq7, Sbs, Vb0, Vb1, Vb2, Vb3; \
        _Pragma("unroll") for (int q = 0; q < 4; ++q) { aV0[2 * q] = bflo(U[0][q]); aV0[2 * q + 1] = bfhi(U[0][q]); aV0[8 + 2 * q] = bflo(U[1][q]); aV0[8 + 2 * q + 1] = bfhi(U[1][q]); \
            aV1[2 * q] = bflo(U[2][q]); aV1[2 * q + 1] = bfhi(U[2][q]); aV1[8 + 2 * q] = bflo(U[3][q]); aV1[8 + 2 * q + 1] = bfhi(U[3][q]); } \
        _Pragma("unroll") for (int r = 0; r < 16; ++r) { aO0[r] = 0.f; aO1[r] = 0.f; } \
        if ((nn) + 1 < NCH) SC_LOADU(U, (nn) + 1); \
        const float cd = __builtin_bit_cast(float, __builtin_amdgcn_readlane(__builtin_bit_cast(int, cdl), (nn))); \
        fq0 = SC_FRAG(bufoff, 0); \
        fq1 = SC_FRAG(bufoff, 8); \
        fq2 = SC_FRAG(bufoff, 16); \
        fq3 = SC_FRAG(bufoff, 24); \
        fq4 = SC_FRAG(bufoff, 1); \
        fq5 = SC_FRAG(bufoff, 9); \
        fq6 = SC_FRAG(bufoff, 17); \
        fq7 = SC_FRAG(bufoff, 25); \
        Sbs = PACK8(S0, 0); \
        aV0 = MFMA32(fq0, Sbs, aV0); \
        fq0 = SC_FRAG(bufoff, 2); \
        aV1 = MFMA32(fq1, Sbs, aV1); \
        fq1 = SC_FRAG(bufoff, 10); \
        aO0 = MFMA32(fq2, Sbs, aO0); \
        fq2 = SC_FRAG(bufoff, 18); \
        aO1 = MFMA32(fq3, Sbs, aO1); \
        fq3 = SC_FRAG(bufoff, 26); \
        Sbs = PACK8(S0, 1); \
        aV0 = MFMA32(fq4, Sbs, aV0); \
        fq4 = SC_FRAG(bufoff, 3); \
        aV1 = MFMA32(fq5, Sbs, aV1); \
        fq5 = SC_FRAG(bufoff, 11); \
        aO0 = MFMA32(fq6, Sbs, aO0); \
        fq6 = SC_FRAG(bufoff, 19); \
        aO1 = MFMA32(fq7, Sbs, aO1); \
        fq7 = SC_FRAG(bufoff, 27); \
        Sbs = PACK8(S1, 0); \
        aV0 = MFMA32(fq0, Sbs, aV0); \
        fq0 = SC_FRAG(bufoff, 4); \
        aV1 = MFMA32(fq1, Sbs, aV1); \
        fq1 = SC_FRAG(bufoff, 12); \
        aO0 = MFMA32(fq2, Sbs, aO0); \
        fq2 = SC_FRAG(bufoff, 20); \
        aO1 = MFMA32(fq3, Sbs, aO1); \
        fq3 = SC_FRAG(bufoff, 28); \
        Sbs = PACK8(S1, 1); \
        aV0 = MFMA32(fq4, Sbs, aV0); \
        fq4 = SC_FRAG(bufoff, 5); \
        aV1 = MFMA32(fq5, Sbs, aV1); \
        fq5 = SC_FRAG(bufoff, 13); \
        aO0 = MFMA32(fq6, Sbs, aO0); \
        fq6 = SC_FRAG(bufoff, 21); \
        aO1 = MFMA32(fq7, Sbs, aO1); \
        fq7 = SC_FRAG(bufoff, 29); \
        Sbs = PACK8(S2, 0); \
        aV0 = MFMA32(fq0, Sbs, aV0); \
        fq0 = SC_FRAG(bufoff, 6); \
        aV1 = MFMA32(fq1, Sbs, aV1); \
        fq1 = SC_FRAG(bufoff, 14); \
        aO0 = MFMA32(fq2, Sbs, aO0); \
        fq2 = SC_FRAG(bufoff, 22); \
        aO1 = MFMA32(fq3, Sbs, aO1); \
        fq3 = SC_FRAG(bufoff, 30); \
        Sbs = PACK8(S2, 1); \
        aV0 = MFMA32(fq4, Sbs, aV0); \
        fq4 = SC_FRAG(bufoff, 7); \
        aV1 = MFMA32(fq5, Sbs, aV1); \
        fq5 = SC_FRAG(bufoff, 15); \
        aO0 = MFMA32(fq6, Sbs, aO0); \
        fq6 = SC_FRAG(bufoff, 23); \
        aO1 = MFMA32(fq7, Sbs, aO1); \
        fq7 = SC_FRAG(bufoff, 31); \
        Sbs = PACK8(S3, 0); \
        aV0 = MFMA32(fq0, Sbs, aV0); \
        fq0 = SC_FRAG(bufoff, 40); \
        aV1 = MFMA32(fq1, Sbs, aV1); \
        fq1 = SC_FRAG(bufoff, 44); \
        aO0 = MFMA32(fq2, Sbs, aO0); \
        fq2 = SC_FRAG(bufoff, 36); \
        aO1 = MFMA32(fq3, Sbs, aO1); \
        fq3 = SC_FRAG(bufoff, 48); \
        Sbs = PACK8(S3, 1); \
        aV0 = MFMA32(fq4, Sbs, aV0); \
        fq4 = SC_FRAG(bufoff, 52); \
        aV1 = MFMA32(fq5, Sbs, aV1); \
        fq5 = SC_FRAG(bufoff, 32); \
        S0 = S0 * cd; S1 = S1 * cd; S2 = S2 * cd; S3 = S3 * cd; \
        aO0 = MFMA32(fq6, Sbs, aO0); \
        fq6 = SC_FRAG(bufoff, 41); \
        aO1 = MFMA32(fq7, Sbs, aO1); \
        fq7 = SC_FRAG(bufoff, 45); \
        Vb0 = PACK8(aV0, 0); Vb1 = PACK8(aV0, 1); Vb2 = PACK8(aV1, 0); Vb3 = PACK8(aV1, 1); \
        S0 = MFMA32(fq0, Vb0, S0); \
        fq0 = SC_FRAG(bufoff, 37); \
        S1 = MFMA32(fq1, Vb0, S1); \
        fq1 = SC_FRAG(bufoff, 49); \
        aO1 = MFMA32(fq2, Vb0, aO1); \
        fq2 = SC_FRAG(bufoff, 53); \
        S2 = MFMA32(fq3, Vb0, S2); \
        fq3 = SC_FRAG(bufoff, 33); \
        S3 = MFMA32(fq4, Vb0, S3); \
        fq4 = SC_FRAG(bufoff, 42); \
        aO0 = MFMA32(fq5, Vb0, aO0); \
        fq5 = SC_FRAG(bufoff, 46); \
        S0 = MFMA32(fq6, Vb1, S0); \
        fq6 = SC_FRAG(bufoff, 38); \
        S1 = MFMA32(fq7, Vb1, S1); \
        fq7 = SC_FRAG(bufoff, 50); \
        aO1 = MFMA32(fq0, Vb1, aO1); \
        fq0 = SC_FRAG(bufoff, 54); \
        S2 = MFMA32(fq1, Vb1, S2); \
        fq1 = SC_FRAG(bufoff, 43); \
        S3 = MFMA32(fq2, Vb1, S3); \
        fq2 = SC_FRAG(bufoff, 47); \
        aO0 = MFMA32(fq3, Vb1, aO0); \
        fq3 = SC_FRAG(bufoff, 39); \
        S0 = MFMA32(fq4, Vb2, S0); \
        fq4 = SC_FRAG(bufoff, 51); \
        S1 = MFMA32(fq5, Vb2, S1); \
        fq5 = SC_FRAG(bufoff, 55); \
        aO1 = MFMA32(fq6, Vb2, aO1); \
        S2 = MFMA32(fq7, Vb2, S2); \
        S3 = MFMA32(fq0, Vb2, S3); \
        S0 = MFMA32(fq1, Vb3, S0); \
        S1 = MFMA32(fq2, Vb3, S1); \
        aO1 = MFMA32(fq3, Vb3, aO1); \
        S2 = MFMA32(fq4, Vb3, S2); \
        S3 = MFMA32(fq5, Vb3, S3); \
        _Pragma("unroll") for (int r = 0; r < 16; ++r) { \
            *(LAS bf16*)(lds + (otoff) + (((r & 3) + 8 * (r >> 2) + 4 * hf) * OT_LD + 32 * w + c32) * 2) = (bf16)(pkbf(aO0[r], 0.f) & 0xffffu); \
            *(LAS bf16*)(lds + (otoff) + ((32 + (r & 3) + 8 * (r >> 2) + 4 * hf) * OT_LD + 32 * w + c32) * 2) = (bf16)(pkbf(aO1[r], 0.f) & 0xffffu); } \
        RAW_BAR(); } while (0)
        SC_LOADU(UA, 0);
        RAW_BAR();
#pragma unroll 1
        for (int n = 0; n < NCH; n += 2) { SC_CHUNK(n, UA, 0, OT_OFF); SC_CHUNK(n + 1, UA, SCB, OT_OFF + OT_BYTES); }
#undef SC_CHUNK
#undef SC_FRAG
#undef SC_LOADU
#endif
    } else {
#ifndef SCAN_NO_HELPER
        const int ht = F.tid - 256, tok = ht >> 2, q = ht & 3;
        bf16* OB = FP8_PD ? (bf16*)((unsigned char*)a.out + 64 * MiB) : (bf16*)(ws + WS_MIXIN); const int old_ = FP8_PD ? DNW : D;
        v4u RA[14], RB[14];
        const __amdgpu_buffer_rsrc_t rsI = __builtin_amdgcn_make_buffer_rsrc((void*)(IMG + chd0 * IMG_ELEMS), (short)0, NCH * NH * IMG_ELEMS * 2, 0x00020000);
#define SH_LOADIMG(dst, nn) do { _Pragma("unroll") for (int i_ = 0; i_ < 14; ++i_) dst[i_] = __builtin_amdgcn_raw_buffer_load_b128(rsI, (unsigned)ht * 16u, (unsigned)(nn) * (unsigned)(NH * IMG_ELEMS * 2) + (unsigned)i_ * 4096u, 0); } while (0)
#define SH_STOREIMG(src, bufoff) do { LAS v4u* p_ = (LAS v4u*)(lds + (bufoff)) + ht; _Pragma("unroll") for (int i_ = 0; i_ < 14; ++i_) p_[i_ * 256] = src[i_]; } while (0)
#define SH_EPI(mm, otoff) do { const LAS v4u* op_ = (const LAS v4u*)(lds + (otoff) + (tok * OT_LD + 32 * q) * 2); \
        v4u* yp_ = (v4u*)(OB + ((size_t)b * SEQ + (size_t)(mm) * CH + tok) * old_ + h * HD + 32 * q); \
        _Pragma("unroll") for (int i_ = 0; i_ < 4; ++i_) yp_[i_] = op_[i_]; } while (0)
#define SH_STEP(nn, Rcur, Rnext, bufnext, otprev) do { \
        if ((nn) + 2 < NCH) SH_LOADIMG(Rcur, (nn) + 2); \
        if ((nn) >= 1) SH_EPI((nn) - 1, otprev); \
        if ((nn) + 1 < NCH) SH_STOREIMG(Rnext, bufnext); \
        RAW_BAR(); } while (0)
        SH_LOADIMG(RA, 0); SH_LOADIMG(RB, 1);
        SH_STOREIMG(RA, 0);
        RAW_BAR();
#pragma unroll 1
        for (int n = 0; n < NCH; n += 2) { SH_STEP(n, RA, RB, SCB, OT_OFF + OT_BYTES); SH_STEP(n + 1, RB, RA, 0, OT_OFF); }
        SH_EPI(NCH - 1, OT_OFF + OT_BYTES);
#undef SH_STEP
#undef SH_EPI
#undef SH_STOREIMG
#undef SH_LOADIMG
#endif
    }
}

__device__ __forceinline__ void phase_dn_norm(const Frame& F0, const Args& a, int layer) {
    PHASE_FRAME(F0);
    unsigned char* ws = OPQ_G(unsigned char, a.ws);
    const bf16* PROJ = (const bf16*)(ws + WS_PROJ); bf16* MIXIN = (bf16*)(ws + WS_MIXIN);
    const bf16* OSRC = FP8_PD ? (const bf16*)((unsigned char*)a.out + 64 * MiB) : (const bf16*)(ws + WS_MIXIN); const int old_ = FP8_PD ? DNW : D;
    const int lane = F.lane, gw = F.vcu * NWAVES + F.wave, NGW = F.G * NWAVES;
    const float* nw = a.in[I_NORMW] + layer * HD + 16 * (lane & 7); f32x4 nwv[4];
#pragma unroll
    for (int i = 0; i < 4; ++i) nwv[i] = *(const f32x4*)(nw + 4 * i);
    v4u OA[2], ZA[2], OB[2], ZB[2];
#define DNN_LOAD(O_, Z_, t) do { const v4u* op_ = (const v4u*)(OSRC + (size_t)(t) * old_ + 16 * lane); const v4u* zp_ = (const v4u*)(PROJ + (size_t)(t) * NPROJ + 3072 + 16 * lane); O_[0] = op_[0]; O_[1] = op_[1]; Z_[0] = zp_[0]; Z_[1] = zp_[1]; } while (0)
#define DNN_ROW(O_, Z_, t) do { float ss = 0.f; \
        _Pragma("unroll") for (int i = 0; i < 2; ++i) _Pragma("unroll") for (int j = 0; j < 4; ++j) { const float x0 = bflo(O_[i][j]), x1 = bfhi(O_[i][j]); ss += x0 * x0 + x1 * x1; } \
        ss += __shfl_xor(ss, 1); ss += __shfl_xor(ss, 2); ss += __shfl_xor(ss, 4); const float rr = 1.0f / sqrtf(ss * (1.0f / HD) + RMS_EPS); \
        v4u* yp_ = (v4u*)(MIXIN + (size_t)(t) * D + 16 * lane); float yv_[16]; \
        _Pragma("unroll") for (int i = 0; i < 2; ++i) { _Pragma("unroll") for (int j = 0; j < 4; ++j) { const float z0 = bflo(Z_[i][j]), z1 = bfhi(Z_[i][j]); const f32x4 nn = nwv[2 * i + (j >> 1)]; \
            yv_[8 * i + 2 * j] = bflo(O_[i][j]) * rr * nn[2 * (j & 1)] * z0 * sigmoidf_(z0); yv_[8 * i + 2 * j + 1] = bfhi(O_[i][j]) * rr * nn[2 * (j & 1) + 1] * z1 * sigmoidf_(z1); } } \
        if (FP8_PD) { v4u o8_; _Pragma("unroll") for (int q4 = 0; q4 < 4; ++q4) o8_[q4] = pk4_fp8(yv_[4 * q4] * F8_XS, yv_[4 * q4 + 1] * F8_XS, yv_[4 * q4 + 2] * F8_XS, yv_[4 * q4 + 3] * F8_XS); *(v4u*)((unsigned char*)MIXIN + (size_t)(t) * D + 16 * lane) = o8_; } \
        else { _Pragma("unroll") for (int i = 0; i < 2; ++i) { v4u o_; _Pragma("unroll") for (int j = 0; j < 4; ++j) o_[j] = pkbf(yv_[8 * i + 2 * j], yv_[8 * i + 2 * j + 1]); yp_[i] = o_; } } } while (0)
    if (gw < T) DNN_LOAD(OA, ZA, gw);
#pragma unroll 1
    for (int t = gw; t < T; t += 2 * NGW) {
        if (t + NGW < T) DNN_LOAD(OB, ZB, t + NGW);
        DNN_ROW(OA, ZA, t);
        if (t + 2 * NGW < T) DNN_LOAD(OA, ZA, t + 2 * NGW);
        if (t + NGW < T) DNN_ROW(OB, ZB, t + NGW);
    }
#undef DNN_LOAD
#undef DNN_ROW
}

__device__ __forceinline__ void phase_ln1_router(const Frame& F0, const Args& a, int layer, int probe = 0, int f8 = 0) {
    PHASE_FRAME(F0);
    unsigned char* ws = OPQ_G(unsigned char, a.ws);
    LAS float* WRt = (LAS float*)F.lds;
    LAS float* GV = (LAS float*)(F.lds + RING_BYTES);
    LAS int* rowE = (LAS int*)(F.lds + AUX_OFF); LAS int* rowP = rowE + 128; LAS float* rowG = (LAS float*)(rowP + 128); LAS int* lcnt = (LAS int*)(rowG + 128); LAS int* lbase = lcnt + 16;
    const float* wr = OPQ_G(const float, a.in[I_WR]); const float* br = OPQ_G(const float, a.in[I_BR]);
    for (int idx = F.tid; idx < D * NE; idx += 512) WRt[(idx & 15) * D + (idx >> 4)] = wr[idx];
    { const float* g1 = a.in[I_LN1G] + (size_t)layer * D; const float* b1 = a.in[I_LN1B] + (size_t)layer * D; for (int i = F.tid; i < D; i += 512) { GV[i] = g1[i]; GV[D + i] = b1[i]; } }
    const bf16* PRE = (const bf16*)a.out; bf16* X1B = (bf16*)(ws + (probe ? WS_R1 : WS_X1B)); float* STATS = (float*)(ws + (probe ? WS_R1 + 70 * MiB : WS_STATS));
    int* LIST = (int*)(ws + (probe ? WS_R1 + 72 * MiB : WS_LIST)); int* TOKSLOT = (int*)(ws + (probe ? WS_R1 + 80 * MiB : WS_TOKSLOT)); float* GATEW = (float*)(ws + (probe ? WS_R1 + 82 * MiB : WS_GATEW));
    gu32* cnt = F.ctl + CW_CNT + 64 * (layer + (probe ? 2 : 0));
    const int lane = F.lane; const float brl = br[(lane >> 2) & 15];
    for (int rb = F.vcu; rb < T / 64; rb += F.G) {
        if (F.tid < 16) lcnt[F.tid] = 0;
        __syncthreads();
        v2u XA[8], XB_[8];
#define PE_LOAD(X, r) do { const GAS v2u* xr_ = (const GAS v2u*)(PRE + (size_t)(rb * 64 + F.wave * 8 + (r)) * D) + lane; _Pragma("unroll") for (int j = 0; j < 8; ++j) X[j] = xr_[64 * j]; } while (0)
#define PE_ROW(X, r) do { const int lr = F.wave * 8 + (r), row = rb * 64 + lr; unsigned gvo_ = (unsigned)(uintptr_t)GV; asm volatile("" : "+v"(gvo_)); const LAS float* GVr = (const LAS float*)(uintptr_t)gvo_; \
            f32x4 v[8]; float s = 0.f; \
            _Pragma("unroll") for (int j = 0; j < 8; ++j) { v[j] = (f32x4){bflo(X[j].x), bfhi(X[j].x), bflo(X[j].y), bfhi(X[j].y)}; s += (v[j][0] + v[j][1]) + (v[j][2] + v[j][3]); } \
            const float mean = wave_sum(s) * (1.f / D); float s2 = 0.f; \
            _Pragma("unroll") for (int j = 0; j < 8; ++j) { v[j] = v[j] - mean; s2 += (v[j][0] * v[j][0] + v[j][1] * v[j][1]) + (v[j][2] * v[j][2] + v[j][3] * v[j][3]); } \
            const float rstd = 1.f / sqrtf(wave_sum(s2) * (1.f / D) + LN_EPS); \
            if (lane == 0) { STATS[2 * row] = mean; STATS[2 * row + 1] = rstd; } \
            GAS v2u* o8 = (GAS v2u*)(X1B + (size_t)row * D) + lane; \
            float lg[16]; \
            _Pragma("unroll") for (int e = 0; e < 16; ++e) lg[e] = 0.f; \
            _Pragma("unroll") for (int j = 0; j < 8; ++j) { const f32x4 gg = *(const LAS f32x4*)(GVr + 256 * j + 4 * lane), bb = *(const LAS f32x4*)(GVr + D + 256 * j + 4 * lane); \
                v[j] = v[j] * rstd * gg + bb; \
                if (f8) ((GAS unsigned*)((GAS unsigned char*)X1B + (size_t)row * D) + lane)[64 * j] = pk4_fp8(v[j][0] * F8_XS, v[j][1] * F8_XS, v[j][2] * F8_XS, v[j][3] * F8_XS); \
                else { v2u w; w.x = pkbf(v[j][0], v[j][1]); w.y = pkbf(v[j][2], v[j][3]); o8[64 * j] = w; } \
                _Pragma("unroll") for (int e = 0; e < 16; ++e) { const f32x4 w4 = *(const LAS f32x4*)(WRt + e * D + 256 * j + 4 * lane); lg[e] += (v[j][0] * w4[0] + v[j][1] * w4[1]) + (v[j][2] * w4[2] + v[j][3] * w4[3]); } } \
              \
            float t8[8], t4[4], t2[2], t1; \
            { const bool hi = (lane & 32) != 0; _Pragma("unroll") for (int i = 0; i < 8; ++i) { const float snd = hi ? lg[i] : lg[8 + i], kp = hi ? lg[8 + i] : lg[i]; t8[i] = kp + __shfl_xor(snd, 32); } } \
            { const bool hi = (lane & 16) != 0; _Pragma("unroll") for (int i = 0; i < 4; ++i) { const float snd = hi ? t8[i] : t8[4 + i], kp = hi ? t8[4 + i] : t8[i]; t4[i] = kp + __shfl_xor(snd, 16); } } \
            { const bool hi = (lane & 8) != 0; _Pragma("unroll") for (int i = 0; i < 2; ++i) { const float snd = hi ? t4[i] : t4[2 + i], kp = hi ? t4[2 + i] : t4[i]; t2[i] = kp + __shfl_xor(snd, 8); } } \
            { const bool hi = (lane & 4) != 0; const float snd = hi ? t2[0] : t2[1], kp = hi ? t2[1] : t2[0]; t1 = kp + __shfl_xor(snd, 4); } \
            t1 += __shfl_xor(t1, 2); t1 += __shfl_xor(t1, 1); t1 += brl; \
            float lgu[16]; float mx = -3.0e38f; \
            _Pragma("unroll") for (int e = 0; e < 16; ++e) { lgu[e] = __builtin_bit_cast(float, __builtin_amdgcn_readlane(__builtin_bit_cast(int, t1), 4 * e)); mx = fmaxf(mx, lgu[e]); } \
            float p[16]; \
            _Pragma("unroll") for (int e = 0; e < 16; ++e) p[e] = __expf(lgu[e] - mx); \
            float gsc[4]; \
            _Pragma("unroll") for (int g = 0; g < 4; ++g) { const float a0 = p[4 * g], a1 = p[4 * g + 1], a2 = p[4 * g + 2], a3 = p[4 * g + 3]; \
                const float hi1 = fmaxf(a0, a1), lo1 = fminf(a0, a1), hi2 = fmaxf(a2, a3), lo2 = fminf(a2, a3); \
                gsc[g] = fmaxf(hi1, hi2) + fmaxf(fminf(hi1, hi2), fmaxf(lo1, lo2)); } \
            int gsel = 0; float best = gsc[0]; \
            _Pragma("unroll") for (int g = 1; g < 4; ++g) if (gsc[g] > best) { best = gsc[g]; gsel = g; } \
            float q[4]; \
            _Pragma("unroll") for (int j = 0; j < 4; ++j) q[j] = gsel == 0 ? p[j] : (gsel == 1 ? p[4 + j] : (gsel == 2 ? p[8 + j] : p[12 + j])); \
            int i0 = 0; float p0 = q[0]; \
            _Pragma("unroll") for (int j = 1; j < 4; ++j) if (q[j] > p0) { p0 = q[j]; i0 = j; } \
            int i1 = -1; float p1 = -1.f; \
            _Pragma("unroll") for (int j = 0; j < 4; ++j) if (j != i0 && q[j] > p1) { p1 = q[j]; i1 = j; } \
            if (lane == 0) { const int e0 = gsel * 4 + i0, e1 = gsel * 4 + i1; const float inv = 1.0f / (p0 + p1); \
                rowE[2 * lr] = e0; rowE[2 * lr + 1] = e1; rowG[2 * lr] = p0 * inv; rowG[2 * lr + 1] = p1 * inv; \
                rowP[2 * lr] = __hip_atomic_fetch_add(&lcnt[e0], 1, __ATOMIC_RELAXED, __HIP_MEMORY_SCOPE_WORKGROUP); rowP[2 * lr + 1] = __hip_atomic_fetch_add(&lcnt[e1], 1, __ATOMIC_RELAXED, __HIP_MEMORY_SCOPE_WORKGROUP); } } while (0)
        PE_LOAD(XA, 0);
#pragma unroll 1
        for (int r = 0; r < 8; r += 2) { PE_LOAD(XB_, r + 1); PE_ROW(XA, r); if (r + 2 < 8) PE_LOAD(XA, r + 2); PE_ROW(XB_, r + 1); }
#undef PE_LOAD
#undef PE_ROW
        __syncthreads();
        if (F.tid < 16) lbase[F.tid] = (int)__hip_atomic_fetch_add(cnt + F.tid, (unsigned)lcnt[F.tid], RLX_AGENT);
        __syncthreads();
        if (F.tid < 128) { const int e = rowE[F.tid], pos = lbase[e] + rowP[F.tid], tok = rb * 64 + (F.tid >> 1);
            LIST[(size_t)e * LCAP + pos] = tok; TOKSLOT[2 * tok + (F.tid & 1)] = e * LCAP + pos; GATEW[2 * tok + (F.tid & 1)] = rowG[F.tid]; }
        __syncthreads();
    }
}
__device__ __forceinline__ void moe_table(const Frame& F0, int layer) {
    PHASE_FRAME(F0);
    LAS int* tab = (LAS int*)(F.lds + AUX_OFF);
    __syncthreads();
    if (F.tid < 16) tab[32 + F.tid] = (int)__hip_atomic_load(F.ctl + CW_CNT + 64 * layer + F.tid, RLX_AGENT);
    __syncthreads();
    if (F.tid == 0) { int blk = 0, nf = 0, nh = 0; for (int e = 0; e < 16; ++e) { const int cn = tab[32 + e]; tab[e] = blk; tab[48 + e] = nf; tab[80 + e] = nh; blk += (cn + 127) >> 7; nf += cn >> 8; nh += ((cn & 255) + 127) >> 7; } tab[16] = blk; tab[64] = nf; tab[96] = nh; }
    __syncthreads();
}
__device__ __forceinline__ void phase_combine_ln2(const Frame& F0, const Args& a, int layer, int probe = 0, int f8 = 0) {
    PHASE_FRAME(F0);
    unsigned char* ws = OPQ_G(unsigned char, a.ws); const LAS int* tab = (const LAS int*)(F.lds + AUX_OFF);
    const bf16* PRE = (const bf16*)a.out; const float* STATS = (const float*)(ws + WS_STATS); const bf16* Y = (const bf16*)(ws + WS_Y); bf16* X2B = (bf16*)(ws + (probe ? WS_R1 : WS_X2B)); unsigned char* X2F8 = ws + WS_X2F8;
    const int* TOKSLOT = (const int*)(ws + WS_TOKSLOT); const float* GATEW = (const float*)(ws + WS_GATEW);
    LAS float* GV = (LAS float*)F.lds;
    { const float* g1 = a.in[I_LN1G] + (size_t)layer * D; const float* b1 = a.in[I_LN1B] + (size_t)layer * D; const float* g2 = a.in[I_LN2G] + (size_t)layer * D; const float* b2 = a.in[I_LN2B] + (size_t)layer * D;
        for (int i = F.tid; i < D; i += 512) { GV[i] = g1[i]; GV[D + i] = b1[i]; GV[2 * D + i] = g2[i]; GV[3 * D + i] = b2[i]; } }
    __syncthreads();
    const int gw = F.vcu * NWAVES + F.wave, NGW = F.G * NWAVES, nrows = (T - gw + NGW - 1) / NGW, lane = F.lane;
    for (int base = 0; base < nrows; base += 64) {
        const int nr = (nrows - base) < 64 ? (nrows - base) : 64;
        float m_mean = 0.f, m_rstd = 0.f, m_w0 = 0.f, m_w1 = 0.f; int m_y0 = 0, m_y1 = 0;
        if (lane < nr) { const int row = gw + NGW * (base + lane); m_mean = STATS[2 * row]; m_rstd = STATS[2 * row + 1]; m_w0 = GATEW[2 * row]; m_w1 = GATEW[2 * row + 1];
            const int s0 = TOKSLOT[2 * row], s1 = TOKSLOT[2 * row + 1]; m_y0 = tab[s0 / LCAP] * 128 + (s0 % LCAP); m_y1 = tab[s1 / LCAP] * 128 + (s1 % LCAP); }
        v2u XA[8], PA[8], QA[8], XB_[8], PB_[8], QB_[8];
#define PH_LOAD(X, P, Q, i) do { const int row_ = gw + NGW * (base + (i)); const size_t y0_ = (size_t)__builtin_amdgcn_readlane(m_y0, (i)), y1_ = (size_t)__builtin_amdgcn_readlane(m_y1, (i)); \
            const GAS v2u* xr_ = (const GAS v2u*)(PRE + (size_t)row_ * D) + lane; const GAS v2u* ya_ = (const GAS v2u*)(Y + y0_ * D) + lane; const GAS v2u* yb_ = (const GAS v2u*)(Y + y1_ * D) + lane; \
            _Pragma("unroll") for (int j = 0; j < 8; ++j) { X[j] = xr_[64 * j]; P[j] = ya_[64 * j]; Q[j] = yb_[64 * j]; } } while (0)
#define PH_ROW(X, P, Q, i) do { const int row_ = gw + NGW * (base + (i)); unsigned gvo_ = (unsigned)(uintptr_t)GV; asm volatile("" : "+v"(gvo_)); const LAS float* GVr = (const LAS float*)(uintptr_t)gvo_;     \
            const float mean = __builtin_bit_cast(float, __builtin_amdgcn_readlane(__builtin_bit_cast(int, m_mean), (i))), rstd = __builtin_bit_cast(float, __builtin_amdgcn_readlane(__builtin_bit_cast(int, m_rstd), (i))); \
            const float w0 = __builtin_bit_cast(float, __builtin_amdgcn_readlane(__builtin_bit_cast(int, m_w0), (i))), w1 = __builtin_bit_cast(float, __builtin_amdgcn_readlane(__builtin_bit_cast(int, m_w1), (i))); \
            f32x4 v[8]; float s = 0.f; \
            _Pragma("unroll") for (int j = 0; j < 8; ++j) { const f32x4 gg = *(const LAS f32x4*)(GVr + 256 * j + 4 * lane), bb = *(const LAS f32x4*)(GVr + D + 256 * j + 4 * lane); \
                const f32x4 x1 = ((f32x4){bflo(X[j].x), bfhi(X[j].x), bflo(X[j].y), bfhi(X[j].y)} - mean) * rstd * gg + bb; \
                f32x4 f; f[0] = w0 * bflo(P[j].x) + w1 * bflo(Q[j].x); f[1] = w0 * bfhi(P[j].x) + w1 * bfhi(Q[j].x); f[2] = w0 * bflo(P[j].y) + w1 * bflo(Q[j].y); f[3] = w0 * bfhi(P[j].y) + w1 * bfhi(Q[j].y); \
                v[j] = x1 * ALPHA + f; s += (v[j][0] + v[j][1]) + (v[j][2] + v[j][3]); } \
            const float m2 = wave_sum(s) * (1.f / D); float q = 0.f; \
            _Pragma("unroll") for (int j = 0; j < 8; ++j) { v[j] = v[j] - m2; q += (v[j][0] * v[j][0] + v[j][1] * v[j][1]) + (v[j][2] * v[j][2] + v[j][3] * v[j][3]); } \
            const float r2 = 1.f / sqrtf(wave_sum(q) * (1.f / D) + LN_EPS); \
            GAS v2u* o8 = (GAS v2u*)(X2B + (size_t)row_ * D) + lane; \
            _Pragma("unroll") for (int j = 0; j < 8; ++j) { const f32x4 gg = *(const LAS f32x4*)(GVr + 2 * D + 256 * j + 4 * lane), bb = *(const LAS f32x4*)(GVr + 3 * D + 256 * j + 4 * lane); \
                const f32x4 o = v[j] * r2 * gg + bb; v2u w; w.x = pkbf(o[0], o[1]); w.y = pkbf(o[2], o[3]); o8[64 * j] = w; \
                if (f8) ((GAS unsigned*)((GAS unsigned char*)X2F8 + (size_t)row_ * D) + lane)[64 * j] = pk4_fp8(o[0] * F8_XS, o[1] * F8_XS, o[2] * F8_XS, o[3] * F8_XS); } } while (0)
        PH_LOAD(XA, PA, QA, 0);
#pragma unroll 1
        for (int i = 0; i < nr; i += 2) {
            if (i + 1 < nr) PH_LOAD(XB_, PB_, QB_, i + 1);
            PH_ROW(XA, PA, QA, i);
            if (i + 2 < nr) PH_LOAD(XA, PA, QA, i + 2);
            if (i + 1 < nr) PH_ROW(XB_, PB_, QB_, i + 1);
        }
#undef PH_LOAD
#undef PH_ROW
    }
}

#ifndef MK_N_LAUNCHES
#define MK_N_LAUNCHES 1
#endif
constexpr int NPL = 10;
constexpr int NPHASE = 1 + NPL * DEPTH;
constexpr int N_LAUNCHES = MK_N_LAUNCHES;
static_assert(N_LAUNCHES == 1 || N_LAUNCHES == NPHASE, "MK_N_LAUNCHES is 1 or NPHASE");

#define GRID_BAR() do { if (N_LAUNCHES == 1) xcd_barrier(bar); } while (0)
#ifndef PH_MASK
#define PH_MASK 0x7ff
#endif
#define IN(k) ((((k) == 0 ? 1u : (2u << (((k) - 1) % NPL))) & (unsigned)(PH_MASK)) && lo <= (k) && (k) < hi)
#define SEAM(k) do { if (IN((k) + 1)) GRID_BAR(); } while (0)
#ifndef PROBE_DUP
#define PROBE_DUP 0
#endif
#define REPS(k) ((((k) == 0 ? 1u : (2u << (((k) - 1) % NPL))) & (unsigned)(PROBE_DUP)) ? 2 : 1)

template <int layer> __device__ __forceinline__ void layer_phases(const Frame& F, const Args& args, const XcdBarrier& bar, const int lo, const int hi) {
            const int pb = 1 + NPL * layer;
            unsigned char* ws = OPQ_G(unsigned char, args.ws);
            if (IN(pb + 0)) { for (int rep = 0; rep < REPS(pb + 0); ++rep) { if (rep) GRID_BAR();
                SchedDense S; S.init(T, NPROJ, F.G, (int)blockIdx.x, ws + WS_XB, D, (const bf16*)(ws + WS_WIN) + (size_t)layer * NPROJ * D, D);
                EpiBf16 E{(bf16*)(ws + WS_PROJ), NPROJ};
                pg8::gemm_phase<EpiBf16, SchedDense, false>(F.lds + RING_OFF, D, D, D, S, E);
                } SEAM(pb + 0);
            }
            if (IN(pb + 1)) { for (int rep = 0; rep < REPS(pb + 1); ++rep) { if (rep) GRID_BAR(); phase_dn_prep(F, args, layer); } SEAM(pb + 1); }
            if (IN(pb + 2)) { for (int rep = 0; rep < REPS(pb + 2); ++rep) { if (rep) GRID_BAR();
                if (blockIdx.x < 32 || F.G <= 32) { for (int u = blockIdx.x; u < NB * NH; u += (F.G < 32 ? F.G : 32)) { phase_dn_scan(F, args, layer, u);
#ifdef SCAN_TWICE
                    __syncthreads(); phase_dn_scan(F, args, layer, u);
#endif
                } }
                if (blockIdx.x >= 32 || F.G <= 32) { const int G2 = F.G <= 32 ? F.G : F.G - 32, c2 = F.G <= 32 ? (int)blockIdx.x : (int)blockIdx.x - 32;
                    { int t_ = threadIdx.x; asm volatile("" : "+v"(t_)); Frame Fp = F; Fp.tid = t_; Fp.lane = t_ & 63;
                      for (int L = c2; L < 256; L += G2) pool_diffs_unit(Fp, ws, L >> 2, L & 3);
                      asm volatile("s_waitcnt vmcnt(0)" ::: "memory"); __syncthreads(); }
                    { SchedPool S{G2, c2, (const char*)(ws + WS_POOLD), (const char*)((const bf16*)(ws + WS_WPOOL) + (size_t)layer * 4 * 65536)};
                      EpiPool E{(bf16*)(ws + WS_MIXIN), args.in[I_POOLS] + (size_t)layer * PW, FP8_PD};
                      pg8::gemm_phase<EpiPool, SchedPool, false>(F.lds + RING_OFF, 256, PW, 256, S, E); }
                    { SchedDense S; S.init(T, D, G2, c2, (const bf16*)(ws + WS_PB16) + (size_t)layer * T * PLE, PLE, (const bf16*)(ws + WS_WPP) + (size_t)layer * D * PLE, PLE);
                      EpiBf16 E{(bf16*)(ws + WS_PP), D};
                      pg8::gemm_phase<EpiBf16, SchedDense, false>(F.lds + RING_OFF, PLE, PLE, PLE, S, E); }
#ifndef CONVERT_ALL_IN_PROLOGUE
                    { int t_ = threadIdx.x; asm volatile("" : "+v"(t_)); const int per_ = F.G / 8 - 4, c2v_ = (F.G % 8 == 0 && F.G > 32) ? ((int)blockIdx.x % 8) * per_ + ((int)blockIdx.x / 8 - 4) : c2;
                  weight_items(args, ws, (LAS float*)(F.lds + RING_OFF + F.wave * 16384), t_ & 63, 1, layer, c2v_ * NWAVES + F.wave, G2 * NWAVES); }
#endif
                    }
                } SEAM(pb + 2);
            }
            if (IN(pb + 3)) { for (int rep = 0; rep < REPS(pb + 3); ++rep) { if (rep) GRID_BAR(); phase_dn_norm(F, args, layer); } SEAM(pb + 3); }
            if (IN(pb + 4)) { for (int rep = 0; rep < REPS(pb + 4); ++rep) { if (rep) GRID_BAR();
                if (FP8_PD) { SchedDense S; S.init(T, D, F.G, (int)blockIdx.x, ws + WS_MIXIN, D / 2, ws + WS_WOUT + (size_t)layer * D * D * 2, D / 2);
                    EpiRes E{(const bf16*)(ws + WS_XB), (bf16*)args.out, F8_INV};
                    pg8::gemm_phase<EpiRes, SchedDense, false, true>(F.lds + RING_OFF, D / 2, D / 2, D / 2, S, E); }
                else { SchedDense S; S.init(T, D, F.G, (int)blockIdx.x, ws + WS_MIXIN, D, (const bf16*)(ws + WS_WOUT) + (size_t)layer * D * D, D);
                EpiRes E{(const bf16*)(ws + WS_XB), (bf16*)args.out};
#ifdef PROBE_PD
                { EpiRes E2{(const bf16*)(ws + WS_XB), (bf16*)(ws + WS_R1)}; pg8::gemm_phase<EpiRes, SchedDense, false>(F.lds + RING_OFF, D, D, D, S, E2); }
#endif
                pg8::gemm_phase<EpiRes, SchedDense, false>(F.lds + RING_OFF, D, D, D, S, E); }
                } SEAM(pb + 4);
            }
            if (IN(pb + 5)) { for (int rep = 0; rep < REPS(pb + 5); ++rep) { if (rep) GRID_BAR();
#ifdef PROBE_PE
                phase_ln1_router(F, args, layer, 1); __syncthreads();
#endif
                phase_ln1_router(F, args, layer, 0, FP8_LAYER(layer) ? 1 : 0); } SEAM(pb + 5); }
            if (IN(pb + 6)) { for (int rep = 0; rep < REPS(pb + 6); ++rep) { if (rep) GRID_BAR();
                moe_table(F, layer);
                if (FP8_LAYER(layer)) {
                    SchedMoe S{F.G, (int)blockIdx.x, 0, (const LAS int*)(F.lds + AUX_OFF), (const char*)(ws + WS_X1B), (const char*)(ws + WS_WGU + (size_t)layer * NE * 2048 * D * 2), (const int*)(ws + WS_LIST), 1};
                    EpiSwiglu E{(bf16*)(ws + WS_HID), FP8_PG, F8_INV};
                    pg8::gemm_phase<EpiSwiglu, SchedMoe, true, true>(F.lds + RING_OFF, D / 2, D / 2, D / 2, S, E);
                } else {
                    SchedMoe S{F.G, (int)blockIdx.x, 0, (const LAS int*)(F.lds + AUX_OFF), (const char*)(ws + WS_X1B), (const char*)((const bf16*)(ws + WS_WGU) + (size_t)layer * NE * 2048 * D), (const int*)(ws + WS_LIST), 2};
                    EpiSwiglu E{(bf16*)(ws + WS_HID)};
                    pg8::gemm_phase<EpiSwiglu, SchedMoe, true>(F.lds + RING_OFF, D, D, D, S, E);
                }
                } SEAM(pb + 6);
            }
            if (IN(pb + 7)) { for (int rep = 0; rep < REPS(pb + 7); ++rep) { if (rep) GRID_BAR();
                moe_table(F, layer);
                if (FP8_PG && FP8_LAYER(layer)) {
                    SchedMoe S{F.G, (int)blockIdx.x, 1, (const LAS int*)(F.lds + AUX_OFF), (const char*)(ws + WS_HID), (const char*)(ws + WS_WD + (size_t)layer * NE * D * DE * 2), nullptr, 1};
                    EpiBf16 E{(bf16*)(ws + WS_Y), D, F8_INV};
                    pg8::gemm_phase<EpiBf16, SchedMoe, false, true>(F.lds + RING_OFF, DE / 2, DE / 2, DE / 2, S, E);
                } else {
                    SchedMoe S{F.G, (int)blockIdx.x, 1, (const LAS int*)(F.lds + AUX_OFF), (const char*)(ws + WS_HID), (const char*)((const bf16*)(ws + WS_WD) + (size_t)layer * NE * D * DE), nullptr, 2};
                    EpiBf16 E{(bf16*)(ws + WS_Y), D};
                    pg8::gemm_phase<EpiBf16, SchedMoe, false>(F.lds + RING_OFF, DE, DE, DE, S, E);
                }
                } SEAM(pb + 7);
            }
            if (IN(pb + 8)) { for (int rep = 0; rep < REPS(pb + 8); ++rep) { if (rep) GRID_BAR(); moe_table(F, layer);
#ifdef PROBE_PH
                phase_combine_ln2(F, args, layer, 1);
#endif
                phase_combine_ln2(F, args, layer, 0, (FP8_PI && (FP8_PI0 || layer == DEPTH - 1)) ? 1 : 0); } SEAM(pb + 8); }
            if (IN(pb + 9)) { for (int rep = 0; rep < REPS(pb + 9); ++rep) { if (rep) GRID_BAR();
                if (FP8_PI && (FP8_PI0 || layer == DEPTH - 1)) {
                    SchedDense S; S.init(T, D, F.G, (int)blockIdx.x, ws + WS_X2F8, D / 2, ws + WS_WPG + (size_t)layer * D * D * 2, D / 2);
                    EpiPle E{(const bf16*)(ws + WS_X2B), (const bf16*)(ws + WS_PP), (bf16*)(ws + WS_XB), args.out, layer + 1 < DEPTH ? 0 : 1, F8_INV};
                    pg8::gemm_phase<EpiPle, SchedDense, false, true>(F.lds + RING_OFF, D / 2, D / 2, D / 2, S, E);
                } else {
                    SchedDense S; S.init(T, D, F.G, (int)blockIdx.x, ws + WS_X2B, D, (const bf16*)(ws + WS_WPG) + (size_t)layer * D * D, D);
                    EpiPle E{(const bf16*)(ws + WS_X2B), (const bf16*)(ws + WS_PP), (bf16*)(ws + WS_XB), args.out, layer + 1 < DEPTH ? 0 : 1};
                    pg8::gemm_phase<EpiPle, SchedDense, false>(F.lds + RING_OFF, D, D, D, S, E);
                }
                } SEAM(pb + 9);
            }
}
__global__ void __launch_bounds__(NWAVES * 64, 2) trunk_fwd(Args args) {
    extern __shared__ __attribute__((aligned(16))) unsigned char lds[];
    Frame F;
    F.lds = (LAS unsigned char*)lds;
    F.MISC = (volatile LAS unsigned*)(F.lds + MISC_OFF);
    F.tid = threadIdx.x; F.lane = F.tid & 63; F.wave = __builtin_amdgcn_readfirstlane(F.tid >> 6);
    F.G = gridDim.x; { const int bx = blockIdx.x; F.vcu = (F.G % 8 == 0) ? (bx % 8) * (F.G / 8) + bx / 8 : bx; }
    unsigned char* ws = args.ws;
    F.ctl = (gu32*)(ws + WS_CTL);
    for (int u = F.tid; u < (LDS_BYTES - LDSCTL_OFF) / 4; u += NWAVES * 64) ((LAS unsigned*)(F.lds + LDSCTL_OFF))[u] = 0u;
    __syncthreads();
    XcdBarrier bar; bar.bar = (unsigned*)(F.ctl + CW_BAR); bar.x = 0; bar.st = nullptr;
    if (N_LAUNCHES == 1) bar = xcd_barrier_post((unsigned*)(F.ctl + CW_BAR), F.MISC + 8);
    const int lo = args.ph_lo, hi = args.ph_hi;
    if (IN(0)) { for (int rep = 0; rep < REPS(0); ++rep) { if (rep) GRID_BAR(); p0_prologue(F, args); } SEAM(0); }

    layer_phases<0>(F, args, bar, lo, hi);
    layer_phases<1>(F, args, bar, lo, hi);
    static_assert(DEPTH == 2, "layer_phases instantiations");
#undef IN
#undef SEAM
#undef GRID_BAR
}

extern "C" void kernel_launch(void* const* d_in, const int* in_sizes, int n_in, void* d_out, int out_size, void* d_ws, size_t ws_size, hipStream_t stream) {
    static int grid = 0;
    if (grid == 0) {
        if (n_in != 21 || in_sizes[0] != T * D || out_size != T * D || ws_size < WS_END) { fprintf(stderr, "kernel_launch: unexpected shapes (n_in %d, in0 %d, out %d, ws %zu); nothing launched\n", n_in, n_in > 0 ? in_sizes[0] : -1, out_size, ws_size); grid = -1; return; }
        int dev = 0, cus = 0, per_cu = 0;
        if (hipGetDevice(&dev) != hipSuccess || hipDeviceGetAttribute(&cus, hipDeviceAttributeMultiprocessorCount, dev) != hipSuccess) { grid = -1; return; }
        if (hipFuncSetAttribute((const void*)trunk_fwd, hipFuncAttributeMaxDynamicSharedMemorySize, LDS_BYTES) != hipSuccess) { fprintf(stderr, "kernel_launch: hipFuncSetAttribute failed\n"); grid = -1; return; }
        if (hipOccupancyMaxActiveBlocksPerMultiprocessor(&per_cu, (const void*)trunk_fwd, NWAVES * 64, LDS_BYTES) != hipSuccess || per_cu < 1) { fprintf(stderr, "kernel_launch: occupancy query reports %d workgroups per CU\n", per_cu); }
        (void)hipGetLastError();
        grid = cus;
    }
    if (grid < 0) return;
    if (hipMemsetAsync((char*)d_ws + WS_CTL, 0, CTL_ZERO_BYTES, stream) != hipSuccess) return;
    Args a{};
    for (int i = 0; i < 21; ++i) a.in[i] = (const float*)d_in[i];
    a.out = (float*)d_out; a.ws = (unsigned char*)d_ws;
    for (int li = 0; li < N_LAUNCHES; ++li) {
        a.ph_lo = (N_LAUNCHES == 1) ? 0 : li; a.ph_hi = (N_LAUNCHES == 1) ? NPHASE : li + 1; a.li = li; a.pad = 0;
        hipLaunchKernelGGL(trunk_fwd, dim3(grid), dim3(NWAVES * 64), LDS_BYTES, stream, a);
        const hipError_t le = hipPeekAtLastError();
        if (le != hipSuccess) { fprintf(stderr, "kernel_launch: launch %d failed: %s\n", li, hipGetErrorName(le)); break; }
    }
}
```

```cpp
#define MK_N_LAUNCHES 1
#define FP8_ALL 1
#define FP8_PG 1
#define FP8_PI 1
#define FP8_PI0 1
#include <hip/hip_runtime.h>
#include <cstdio>
#include <cstdint>

#define GAS __attribute__((address_space(1)))
#define LAS __attribute__((address_space(3)))
typedef unsigned short bf16;
typedef unsigned v4u __attribute__((ext_vector_type(4)));
typedef unsigned v2u __attribute__((ext_vector_type(2)));
typedef float f32x4 __attribute__((ext_vector_type(4)));
typedef float f32x2 __attribute__((ext_vector_type(2)));
typedef short bf16x8 __attribute__((ext_vector_type(8)));
typedef GAS unsigned gu32;
typedef int v4i_t __attribute__((ext_vector_type(4)));
typedef int v8i_t __attribute__((ext_vector_type(8)));

namespace pg8 {
constexpr int BM = 256, BK = 64, HALF = 128, HTB = HALF * BK * 2  , STAGE_BYTES = 8 * HTB, NXCD = 8, WGM = 8;
__host__ __device__ __forceinline__ int lds_byte(int r, int c) { const int st = (r >> 4) * 2 + (c >> 5), rr = r & 15, cc = c & 31, ob = rr * 64 + cc * 2; return st * 1024 + (ob ^ (((ob >> 9) & 1) << 5)); }
__host__ __device__ __forceinline__ void stage_rc(int b, int& R, int& C) { const int st = b / 1024, sb = b % 1024, swz = sb ^ (((sb >> 9) & 1) << 5); R = (st >> 1) * 16 + swz / 64; C = (st & 1) * 32 + (swz % 64) / 2; }
__host__ __device__ __forceinline__ int perm32(int rho) { const int n = rho >> 4, i = rho & 15; return 8 * (i >> 2) + 4 * n + (i & 3); }

struct Unit { int pm, pn; const char* A; const char* B; const int* rows; int nvalid; int aux; int rowbase; int half; };

__device__ __forceinline__ unsigned cvt_pk_bf16(float lo, float hi) { unsigned r; asm volatile("v_cvt_pk_bf16_f32 %0, %1, %2" : "=v"(r) : "v"(lo), "v"(hi)); return r; }

template <class Epi, class Sched, bool GATHER, bool FP8 = false>
__device__ __forceinline__ void gemm_phase(LAS unsigned char* lds, const int K, const int lda, const int ldb, const Sched& S, const Epi& E) {
    int tid_ = threadIdx.x; asm volatile("" : "+v"(tid_));
    const int tid = tid_, wid = __builtin_amdgcn_readfirstlane(tid >> 6), lane = tid & 63, wr = wid >> 2, wc = wid & 3, fr = lane & 15, fq = lane >> 4;
    const int nt = K / BK;
    unsigned voffA[2], voffB[2]; int RA[2], CA[2];
#pragma unroll
    for (int i = 0; i < 2; ++i) { int R, C; stage_rc(tid * 16 + i * 8192, R, C); const int Rb = Epi::PERM ? ((R & ~31) + perm32(R & 31)) : R;
        RA[i] = R; CA[i] = C; voffA[i] = (unsigned)(R * lda + C) * 2u; voffB[i] = (unsigned)(Rb * ldb + C) * 2u; }
    unsigned gA[2][2], gN[2][2];
    const size_t kstep = (size_t)(BK * 2);
    const size_t hstepA = GATHER ? 0 : (size_t)HALF * lda * 2, hstepB = (size_t)HALF * ldb * 2;
    const unsigned ldsw = (unsigned)wid * 1024u;
    const int aoff = lds_byte(wr * 64 + fr, fq * 8), boff = lds_byte(wc * 32 + fr, fq * 8);
#define PG8_SA(b, h) (((b) * 2 + (h)) * HTB)
#define PG8_SB(b, h) ((4 + (b) * 2 + (h)) * HTB)
#define PG8_STAGE_B(bufoff, gbase) do { _Pragma("unroll") for (int _i = 0; _i < 2; ++_i) \
        __builtin_amdgcn_global_load_lds((const unsigned*)((const char*)(gbase) + voffB[_i]), (LAS unsigned*)(lds + (bufoff) + ldsw + _i * 8192), 16, 0, 0); } while (0)
#define PG8_STAGE_A(bufoff, gbase, h) do { _Pragma("unroll") for (int _i = 0; _i < 2; ++_i) \
        __builtin_amdgcn_global_load_lds((const unsigned*)((const char*)(gbase) + (GATHER ? gA[h][_i] : voffA[_i]) + (h) * hstepA), (LAS unsigned*)(lds + (bufoff) + ldsw + _i * 8192), 16, 0, 0); } while (0)
#define PG8_CAT(x0, x1) __builtin_shufflevector(__builtin_bit_cast(v4i_t, (x0)), __builtin_bit_cast(v4i_t, (x1)), 0, 1, 2, 3, 4, 5, 6, 7)
#define PG8_LDA(dst, b, h) do { _Pragma("unroll") for (int m = 0; m < 4; ++m) { if constexpr (FP8) dst##8[m] = PG8_CAT(*(const LAS bf16x8*)(lds + PG8_SA(b, h) + aoff + m * 2048), *(const LAS bf16x8*)(lds + PG8_SA(b, h) + aoff + m * 2048 + 1024)); \
        else { _Pragma("unroll") for (int k = 0; k < 2; ++k) dst[m][k] = *(const LAS bf16x8*)(lds + PG8_SA(b, h) + aoff + m * 2048 + k * 1024); } } } while (0)
#define PG8_LDB(dst, b, h) do { _Pragma("unroll") for (int n = 0; n < 2; ++n) { if constexpr (FP8) dst##8[n] = PG8_CAT(*(const LAS bf16x8*)(lds + PG8_SB(b, h) + boff + n * 2048), *(const LAS bf16x8*)(lds + PG8_SB(b, h) + boff + n * 2048 + 1024)); \
        else { _Pragma("unroll") for (int k = 0; k < 2; ++k) dst[n][k] = *(const LAS bf16x8*)(lds + PG8_SB(b, h) + boff + n * 2048 + k * 1024); } } } while (0)
#define PG8_MMA(ai, bj, At, Bt) do { __builtin_amdgcn_s_setprio(1); \
        if constexpr (FP8) { _Pragma("unroll") for (int m = 0; m < 4; ++m) _Pragma("unroll") for (int n = 0; n < 2; ++n) \
            asm volatile("v_mfma_scale_f32_16x16x128_f8f6f4 %0, %1, %2, %0, %3, %3 op_sel_hi:[0,0,0]" : "+v"(acc[ai][bj][m][n]) : "v"(Bt##8[n]), "v"(At##8[m]), "v"(f8scale)); } \
        else { _Pragma("unroll") for (int m = 0; m < 4; ++m) _Pragma("unroll") for (int n = 0; n < 2; ++n) _Pragma("unroll") for (int k = 0; k < 2; ++k) \
            acc[ai][bj][m][n] = __builtin_amdgcn_mfma_f32_16x16x32_bf16(Bt[n][k], At[m][k], acc[ai][bj][m][n], 0, 0, 0); } \
        __builtin_amdgcn_s_setprio(0); } while (0)
#define PG8_WAIT_V(n) asm volatile("s_waitcnt vmcnt(" #n ")" ::: "memory")
#define PG8_WAIT_L(n) asm volatile("s_waitcnt lgkmcnt(" #n ")" ::: "memory")
#define PG8_BAR __builtin_amdgcn_s_barrier()
#define PG8_SCHED __builtin_amdgcn_sched_barrier(0)
#define PG8_GLOAD(dst, u) do { _Pragma("unroll") for (int _h = 0; _h < 2; ++_h) _Pragma("unroll") for (int _i = 0; _i < 2; ++_i) { const int _r = _h * HALF + RA[_i]; \
        const int _rc = _r < (u).nvalid ? _r : (u).nvalid - 1; const int _tl = (u).rows[_rc]; const int _t = (_r < (u).nvalid) ? _tl : 0; dst[_h][_i] = (unsigned)(_t * lda + CA[_i]) * 2u; } } while (0)
    Unit cur, nxt; int ui = 0;
    if (!S.next(0, cur)) return;
    f32x4 acc[2][2][4][2];
#pragma unroll
    for (int a = 0; a < 2; ++a)
#pragma unroll
        for (int b = 0; b < 2; ++b)
#pragma unroll
            for (int m = 0; m < 4; ++m)
#pragma unroll
                for (int n = 0; n < 2; ++n) acc[a][b][m][n] = (f32x4){0.f, 0.f, 0.f, 0.f};
    const unsigned f8scale = 0x7f7f7f7fu;
    bf16x8 At[4][2], B0[2][2], B1[2][2]; v8i_t At8[4], B08[2], B18[2];
    const char* cA = cur.A; const char* cB = cur.B;
    if constexpr (GATHER) { PG8_GLOAD(gA, cur); PG8_WAIT_V(0); }
    PG8_STAGE_B(PG8_SB(0, 0), cB); PG8_STAGE_B(PG8_SB(0, 1), cB + hstepB); PG8_STAGE_A(PG8_SA(0, 0), cA, 0); PG8_STAGE_A(PG8_SA(0, 1), cA, 1);
    if (wr == 1) PG8_BAR;
    PG8_WAIT_V(2); PG8_BAR;
    PG8_STAGE_B(PG8_SB(1, 0), cB + kstep); PG8_STAGE_A(PG8_SA(1, 0), cA + kstep, 0); PG8_STAGE_B(PG8_SB(1, 1), cB + hstepB + kstep);
    PG8_WAIT_V(6); PG8_BAR;
    for (;;) {
        const bool has_next = S.next(ui + 1, nxt); const bool halfu = Sched::RAGGED && cur.half != 0;
        const char* nA = has_next ? nxt.A : cA; const char* nB = has_next ? nxt.B : cB;
        if constexpr (GATHER) { if (has_next) { PG8_GLOAD(gN, nxt); } else {
#pragma unroll
            for (int h = 0; h < 2; ++h)
#pragma unroll
                for (int i = 0; i < 2; ++i) gN[h][i] = gA[h][i]; } }
#pragma unroll 1
        for (int t = 0; t < nt; t += 2) {
            const bool last = (t == nt - 2);
            const char* a1 = cA + (size_t)(t + 1) * kstep;
            const char* a2 = last ? nA : cA + (size_t)(t + 2) * kstep; const char* b2 = last ? nB : cB + (size_t)(t + 2) * kstep;
            const char* a3 = a2 + kstep; const char* b3 = b2 + kstep;
            PG8_LDB(B0, 0, 0); PG8_LDB(B1, 0, 1); PG8_SCHED; PG8_LDA(At, 0, 0); PG8_STAGE_A(PG8_SA(1, 1), a1, 1);
            if constexpr (GATHER) { if (last) {
#pragma unroll
                for (int h = 0; h < 2; ++h)
#pragma unroll
                    for (int i = 0; i < 2; ++i) gA[h][i] = gN[h][i]; } }
            PG8_WAIT_V(8); PG8_WAIT_L(0); PG8_BAR; PG8_MMA(0, 0, At, B0); PG8_MMA(0, 1, At, B1); PG8_BAR; PG8_SCHED;
            if (!halfu) PG8_LDA(At, 0, 1); PG8_STAGE_B(PG8_SB(0, 0), b2); PG8_STAGE_B(PG8_SB(0, 1), b2 + hstepB); PG8_STAGE_A(PG8_SA(0, 0), a2, 0);
            PG8_WAIT_V(8); PG8_WAIT_L(0); PG8_BAR; if (!halfu) { PG8_MMA(1, 0, At, B0); PG8_MMA(1, 1, At, B1); } PG8_BAR; PG8_SCHED;
            PG8_LDB(B0, 1, 0); PG8_LDB(B1, 1, 1); PG8_SCHED; PG8_LDA(At, 1, 0); PG8_STAGE_A(PG8_SA(0, 1), a2, 1);
            PG8_WAIT_V(8); PG8_WAIT_L(0); PG8_BAR; PG8_MMA(0, 0, At, B0); PG8_MMA(0, 1, At, B1); PG8_BAR; PG8_SCHED;
            if (!halfu) PG8_LDA(At, 1, 1); PG8_STAGE_B(PG8_SB(1, 0), b3); PG8_STAGE_B(PG8_SB(1, 1), b3 + hstepB); PG8_STAGE_A(PG8_SA(1, 0), a3, 0);
            PG8_WAIT_V(8); PG8_WAIT_L(0); PG8_BAR; if (!halfu) { PG8_MMA(1, 0, At, B0); PG8_MMA(1, 1, At, B1); } PG8_BAR; PG8_SCHED;
        }
        if (wr == 0) PG8_BAR;
        if constexpr (FP8) asm volatile("s_nop 15\n\ts_nop 15\n\ts_nop 15" ::: "memory");
        E(acc, cur, wr, wc, fr, fq);
        if (!has_next) break;
#pragma unroll
        for (int a = 0; a < 2; ++a)
#pragma unroll
            for (int b = 0; b < 2; ++b)
#pragma unroll
                for (int m = 0; m < 4; ++m)
#pragma unroll
                    for (int n = 0; n < 2; ++n) acc[a][b][m][n] = (f32x4){0.f, 0.f, 0.f, 0.f};
        cur = nxt; cA = nA; cB = nB; ++ui;
        if (wr == 1) PG8_BAR;
    }
    PG8_WAIT_V(0);
    PG8_BAR;
#undef PG8_SA
#undef PG8_SB
#undef PG8_STAGE_A
#undef PG8_STAGE_B
#undef PG8_LDA
#undef PG8_LDB
#undef PG8_MMA
#undef PG8_CAT
#undef PG8_WAIT_V
#undef PG8_WAIT_L
#undef PG8_BAR
#undef PG8_SCHED
#undef PG8_GLOAD
}
}

constexpr int NB = 4, SEQ = 4096, D = 2048, DEPTH = 2;
constexpr int T = NB * SEQ;
constexpr int NH = 8, HD = 128, DNW = 1024, CH = 64, NCH = SEQ / CH;
constexpr int PW = 1024, PG_DIM = 256;
constexpr int IN_COLS = 5136, NPROJ = 5120;
constexpr int NE = 16, DE = 1024, PLE = 256;
constexpr float ALPHA = 1.4142135623730951f;
constexpr float LN_EPS = 1e-5f, RMS_EPS = 1e-6f;
constexpr int LCAP = T;
constexpr int MAXTILES = 2 * T / 256 + NE;

constexpr size_t MiB = 1u << 20;
constexpr size_t WS_CTL = 0, CTL_ZERO_BYTES = 64 * 1024;
constexpr size_t WS_LIST = 2 * MiB;
constexpr size_t WS_TOKSLOT = 3 * MiB, WS_GATEW = WS_TOKSLOT + 128 * 1024, WS_STATS = WS_GATEW + 128 * 1024, WS_CD = WS_STATS + 128 * 1024, WS_WBA = WS_CD + 128 * 1024;
constexpr size_t WS_WIN = 4 * MiB, WS_WOUT = 44 * MiB, WS_WPG = 60 * MiB, WS_WPP = 76 * MiB, WS_WPOOL = 78 * MiB, WS_WGU = 80 * MiB, WS_WD = 336 * MiB, WS_PB16 = 464 * MiB;
constexpr size_t WS_XB = 480 * MiB, WS_R1 = 544 * MiB, WS_R2 = 704 * MiB, WS_R4 = 848 * MiB, WS_R5 = 944 * MiB, WS_END = 1008 * MiB;
constexpr size_t WS_PROJ = WS_R1, WS_HID = WS_R1;
constexpr size_t WS_Y = WS_R2;
constexpr size_t WS_POOLD = WS_R4, WS_PP = WS_R4 + 32 * MiB, WS_X1B = WS_R2;
constexpr size_t WS_MIXIN = WS_R5, WS_X2B = WS_R5;
constexpr size_t WS_X2F8 = WS_R1 + 96 * MiB;
static_assert((size_t)MAXTILES * 256 * 2048 * 2 <= 144 * MiB && (size_t)MAXTILES * 256 * 1024 * 2 <= 160 * MiB, "MoE row buffers");
constexpr int CW_TMO = 0, CW_CODE = 1, CW_CNT = 64  , CW_BAR = 4096;

constexpr int RING_OFF = 0, RING_BYTES = 131072;
constexpr int LDSCTL_OFF = 152 * 1024, MISC_OFF = LDSCTL_OFF + 320;
constexpr int AUX_OFF = LDSCTL_OFF + 1024;
constexpr int LDS_BYTES = 163840;
constexpr int NWAVES = 8;

#define RLX_AGENT __ATOMIC_RELAXED, __HIP_MEMORY_SCOPE_AGENT
#define LDS_WAIT() asm volatile("s_waitcnt lgkmcnt(0)" ::: "memory")
#define VM_WAIT() asm volatile("s_waitcnt vmcnt(0)" ::: "memory")
__device__ __forceinline__ unsigned f2bf(float f) { unsigned u = __builtin_bit_cast(unsigned, f); return (u + 0x7fffu + ((u >> 16) & 1u)) >> 16; }
__device__ __forceinline__ unsigned pk2(float lo, float hi) { return f2bf(lo) | (f2bf(hi) << 16); }
typedef __bf16 bf2_t __attribute__((ext_vector_type(2)));
__device__ __forceinline__ unsigned pkbf(float lo, float hi) { const f32x2 v = {lo, hi}; return __builtin_bit_cast(unsigned, __builtin_convertvector(v, bf2_t)); }
constexpr float F8_XS = 16.0f, F8_WS = 256.0f, F8_INV = 1.0f / 4096.0f;
__device__ __forceinline__ float f8clamp(float x) { return fminf(fmaxf(x, -448.0f), 448.0f); }
__device__ __forceinline__ unsigned pk4_fp8(float a, float b, float c, float d) { unsigned w = 0u; w = (unsigned)__builtin_amdgcn_cvt_pk_fp8_f32(f8clamp(a), f8clamp(b), (int)w, false); w = (unsigned)__builtin_amdgcn_cvt_pk_fp8_f32(f8clamp(c), f8clamp(d), (int)w, true); return w; }
__device__ __forceinline__ float bf2f(unsigned short b) { return __builtin_bit_cast(float, ((unsigned)b) << 16); }
__device__ __forceinline__ float bflo(unsigned w) { return __builtin_bit_cast(float, w << 16); }
__device__ __forceinline__ float bfhi(unsigned w) { return __builtin_bit_cast(float, w & 0xffff0000u); }
__device__ __forceinline__ float sigmoidf_(float x) { return __builtin_amdgcn_rcpf(1.0f + __expf(-x)); }
template <int CTRL> __device__ __forceinline__ float dpp_(float x) { return __builtin_bit_cast(float, __builtin_amdgcn_mov_dpp(__builtin_bit_cast(int, x), CTRL, 0xf, 0xf, true)); }
constexpr int DPP_XOR1 = 0xB1, DPP_XOR2 = 0x4E, DPP_HMIRROR = 0x141, DPP_XOR8 = 0x128;
__device__ __forceinline__ float xrow16_sum(float x) {
    float p = x, q = x; asm volatile("v_nop\n\tv_nop\n\tv_permlane16_swap_b32 %0, %1" : "+v"(p), "+v"(q));
    x = p + q;
    float r = x, s = x; asm volatile("v_nop\n\tv_nop\n\tv_permlane32_swap_b32 %0, %1" : "+v"(r), "+v"(s));
    return r + s;
}
#ifdef OLD_SHUFFLES
__device__ __forceinline__ float row8_sum(float v) { v += __shfl_xor(v, 1); v += __shfl_xor(v, 2); v += __shfl_xor(v, 4); return v; }
__device__ __forceinline__ float wave_sum(float v) {
#pragma unroll
    for (int o = 1; o < 64; o <<= 1) v += __shfl_xor(v, o);
    return v; }
#else
__device__ __forceinline__ float row8_sum(float v) { v += dpp_<DPP_XOR1>(v); v += dpp_<DPP_XOR2>(v); v += dpp_<DPP_HMIRROR>(v); return v; }
__device__ __forceinline__ float wave_sum(float v) { v = row8_sum(v); v += dpp_<DPP_XOR8>(v); return xrow16_sum(v); }
#endif
#define XB_TMO      128
#define XB_XCNT(j)  (256  + 64 * (j))
#define XB_XSUB(j)  (1280 + 64 * (j))
#define XB_XGEN(j)  (2304 + 64 * (j))
#define XB_TOP      3328
#define XB_TOPGEN   3392
#define XCD_BAR_WORDS 3456
#define XB_SPIN_CAP (1u << 18)

__device__ __forceinline__ unsigned xb_ld(unsigned* p)              { return __hip_atomic_load(p, __ATOMIC_RELAXED, __HIP_MEMORY_SCOPE_AGENT); }
__device__ __forceinline__ unsigned xb_add(unsigned* p, unsigned v) { return __hip_atomic_fetch_add(p, v, __ATOMIC_RELAXED, __HIP_MEMORY_SCOPE_AGENT); }
__device__ __forceinline__ unsigned xb_xcc_id() { return (unsigned)__builtin_amdgcn_s_getreg((3 << 11) | 20) & 0xFu; }
#define XB_SPIN(cond, bar) do { unsigned _sp = 0; while (cond) { __builtin_amdgcn_s_sleep(1); \
    if ((++_sp & 255u) == 0u) { if (xb_ld(&(bar)[XB_TMO])) break; if (_sp > XB_SPIN_CAP) { atomicAdd(&(bar)[XB_TMO], 1u); break; } } } } while (0)

struct XcdBarrier {
    unsigned* bar; unsigned x;
    volatile LAS unsigned* st;
};

__device__ __forceinline__ XcdBarrier xcd_barrier_post(unsigned* bar, volatile LAS unsigned* st) {
    XcdBarrier b; b.bar = bar; b.x = xb_xcc_id(); b.st = st;
    if (threadIdx.x == 0) (void)xb_add(&bar[XB_XCNT(b.x)], 1u);
    return b;
}
__device__ __forceinline__ void xcd_barrier_complete(unsigned* bar, unsigned x, unsigned& nloc, unsigned& nx) {
    const unsigned G = gridDim.x * gridDim.y * gridDim.z;
    unsigned sum, cnt, mine, sp = 0u;
    for (;;) {
        sum = 0u; cnt = 0u; mine = 0u;
#pragma unroll
        for (unsigned j = 0; j < 16; ++j) { const unsigned c = xb_ld(&bar[XB_XCNT(j)]); sum += c; cnt += (c > 0u) ? 1u : 0u; mine = (j == x) ? c : mine; }
        if (sum == G) break;
        __builtin_amdgcn_s_sleep(1);
        if ((++sp & 255u) == 0u) { if (xb_ld(&bar[XB_TMO])) break; if (sp > XB_SPIN_CAP) { atomicAdd(&bar[XB_TMO], 1u); break; } }
    }
    nloc = mine > 0u ? mine : 1u; nx = cnt > 0u ? cnt : 1u;
}

__device__ __forceinline__ void xcd_barrier(const XcdBarrier& b) {
    asm volatile("s_waitcnt vmcnt(0)" ::: "memory");
    __syncthreads();
    if (threadIdx.x == 0) {
        unsigned* bar = b.bar;
        __builtin_amdgcn_s_waitcnt(0);
        unsigned nloc = b.st[0], nx = b.st[1];
        if (nloc == 0u) { xcd_barrier_complete(bar, b.x, nloc, nx); b.st[0] = nloc; b.st[1] = nx; }
        const unsigned old = xb_add(&bar[XB_XSUB(b.x)], 1u);
        const unsigned gen = old / nloc;
        if (old + 1u == (gen + 1u) * nloc) {
            __builtin_amdgcn_fence(__ATOMIC_RELEASE, "agent");
            asm volatile("s_waitcnt vmcnt(0)" ::: "memory");
            const unsigned og = xb_add(&bar[XB_TOP], 1u);
            const unsigned tg = og / nx;
            if (og + 1u == (tg + 1u) * nx) xb_add(&bar[XB_TOPGEN], 1u);
            else XB_SPIN(xb_ld(&bar[XB_TOPGEN]) == tg, bar);
            __builtin_amdgcn_fence(__ATOMIC_ACQUIRE, "agent");
            xb_add(&bar[XB_XGEN(b.x)], 1u);
            asm volatile("s_waitcnt vmcnt(0)" ::: "memory");
        } else {
            XB_SPIN(xb_ld(&bar[XB_XGEN(b.x)]) == gen, bar);
            __builtin_amdgcn_fence(__ATOMIC_ACQUIRE, "agent");
            asm volatile("s_waitcnt vmcnt(0)" ::: "memory");
        }
    }
    __syncthreads();
}

struct Args { const float* in[21]; float* out; unsigned char* ws; int ph_lo, ph_hi, li, pad; };
enum { I_X = 0, I_P, I_WIN, I_CONVW, I_ALOG, I_DTB, I_NORMW, I_POOLW, I_POOLS, I_WOUT, I_LN1G, I_LN1B, I_WR, I_BR, I_WEG, I_WEU, I_WED, I_LN2G, I_LN2B, I_WPP, I_WPG };
struct Frame {
    LAS unsigned char* lds;
    volatile LAS unsigned* MISC;
    gu32* ctl;
    int tid, lane, wave, vcu, G;
};

#ifndef FP8_LAST
#define FP8_LAST 1
#endif
#ifndef FP8_PG
#define FP8_PG 0
#endif
#ifndef FP8_ALL
#define FP8_ALL 0
#endif
#ifndef FP8_PD
#define FP8_PD 0
#endif
#ifndef FP8_PI0
#define FP8_PI0 0
#endif
#define FP8_LAYER(l) (FP8_LAST && (FP8_ALL || (l) == DEPTH - 1))
#ifndef FP8_PI
#define FP8_PI 0
#endif
#define PHASE_FRAME(F0) Frame F = F0; { int t_ = threadIdx.x; asm volatile("" : "+v"(t_)); F.tid = t_; F.lane = t_ & 63; }
#define OPQ_S(p) asm volatile("" : "+s"(p))
#define OPQ_G(T, expr) ({ GAS T* g_ = (GAS T*)(expr); asm volatile("" : "+s"(g_)); (T*)g_; })
struct SchedDense {
    static constexpr bool RAGGED = false;
    int nM, nN, nwg, G, c; const char* A; const char* B; size_t astep, bstep;
    __device__ __forceinline__ void init(int M, int N, int G_, int c_, const void* A_, int lda, const void* B_, int ldb) { nM = M / 256; nN = N / 256; nwg = nM * nN; G = G_; c = c_;
        A = (const char*)A_; B = (const char*)B_; astep = (size_t)256 * lda * 2; bstep = (size_t)256 * ldb * 2; }
    __device__ __forceinline__ bool next(int i, pg8::Unit& u) const {
        const long L = (long)i * G + c; if (L >= nwg) return false;
        int wgid = (int)L; { const int q = nwg / 8, r = nwg % 8, xcd = wgid % 8, off = wgid / 8; wgid = (xcd < r ? xcd * (q + 1) : r * (q + 1) + (xcd - r) * q) + off; }
        const int nig = 8 * nN, gid = wgid / nig, fm = gid * 8, gsz = (nM - fm) < 8 ? (nM - fm) : 8;
        u.pm = fm + ((wgid % nig) % gsz); u.pn = (wgid % nig) / gsz;
        u.A = A + (size_t)u.pm * astep; u.B = B + (size_t)u.pn * bstep; u.rows = nullptr; u.nvalid = 256; u.aux = 0; u.rowbase = u.pm * 256; u.half = 0; return true;
    }
};
struct SchedPool {
    static constexpr bool RAGGED = false;
    int G, c; const char* A; const char* B;
    __device__ __forceinline__ bool next(int i, pg8::Unit& u) const {
        const int L = i * G + c; if (L >= 256) return false;
        u.pm = L >> 2; u.pn = L & 3; u.A = A + ((size_t)u.pm * 256 * PW + u.pn * 256) * 2; u.B = B + (size_t)u.pn * 65536 * 2; u.rows = nullptr; u.nvalid = 256; u.aux = 0; u.rowbase = u.pm * 256; u.half = 0; return true;
    }
};
struct SchedMoe {
    static constexpr bool RAGGED = true;
    int G, c, mode; const LAS int* tab; const char* A; const char* B; const int* list; int esz;
    __device__ __forceinline__ bool next(int i, pg8::Unit& u) const {
        const int L = i * G + c, nf = __builtin_amdgcn_readfirstlane(tab[64]), nh = __builtin_amdgcn_readfirstlane(tab[96]);
        if (L >= 8 * (nf + nh)) return false;
        const bool half = L >= 8 * nf; const int t = (half ? L - 8 * nf : L) >> 3, pn = L & 7, pbase = half ? 80 : 48;
        int e = 0;
#pragma unroll
        for (int k = 1; k < 16; ++k) { const int ts = __builtin_amdgcn_readfirstlane(tab[pbase + k]); if (t >= ts) e = k; }
        const int tl = t - __builtin_amdgcn_readfirstlane(tab[pbase + e]), cn = __builtin_amdgcn_readfirstlane(tab[32 + e]), blk = __builtin_amdgcn_readfirstlane(tab[e]);
        const int p0 = half ? ((cn >> 8) << 8) + 128 * tl : 256 * tl;
        u.pm = 0; u.pn = pn; u.aux = e; u.half = half ? 1 : 0; u.rowbase = blk * 128 + p0;
        const int nv = cn - p0; u.nvalid = nv < (half ? 128 : 256) ? nv : (half ? 128 : 256);
        if (mode == 0) { u.A = A; u.rows = list + (size_t)e * LCAP + p0; u.B = B + ((size_t)e * 2048 + pn * 256) * 2048 * esz; }
        else { u.A = A + (size_t)u.rowbase * DE * esz; u.rows = nullptr; u.B = B + ((size_t)e * 2048 + pn * 256) * DE * esz; }
        return true;
    }
};

using pg8::cvt_pk_bf16;
struct EpiBf16 {
    static constexpr bool PERM = true; bf16* O; int ldc; float scale = 1.0f;
    __device__ __forceinline__ void operator()(const f32x4 (&acc)[2][2][4][2], const pg8::Unit& u, int wr, int wc, int fr, int fq) const {
        const int row0 = u.rowbase + wr * 64 + fr, col0 = u.pn * 256 + wc * 32 + 8 * fq;
#pragma unroll
        for (int ai = 0; ai < 2; ++ai) if (ai == 0 || !u.half)
#pragma unroll
            for (int m = 0; m < 4; ++m) { bf16* rowp = O + (size_t)(row0 + ai * 128 + m * 16) * ldc + col0;
#pragma unroll
                for (int bj = 0; bj < 2; ++bj) { const f32x4 v0 = acc[ai][bj][m][0] * scale, v1 = acc[ai][bj][m][1] * scale;
                    v4u w; w.x = cvt_pk_bf16(v0[0], v0[1]); w.y = cvt_pk_bf16(v0[2], v0[3]); w.z = cvt_pk_bf16(v1[0], v1[1]); w.w = cvt_pk_bf16(v1[2], v1[3]);
                    *(v4u*)(rowp + bj * 128) = w; } }
    }
};
struct EpiPool {
    static constexpr bool PERM = true; bf16* O; const float* scale; int f8 = 0;
    __device__ __forceinline__ void operator()(const f32x4 (&acc)[2][2][4][2], const pg8::Unit& u, int wr, int wc, int fr, int fq) const {
        const int row0 = u.rowbase + wr * 64 + fr, cg = u.pn * 256 + wc * 32 + 8 * fq;
        f32x4 sv[2][2];
#pragma unroll
        for (int bj = 0; bj < 2; ++bj) { sv[bj][0] = *(const f32x4*)(scale + cg + bj * 128); sv[bj][1] = *(const f32x4*)(scale + cg + bj * 128 + 4); }
#pragma unroll
        for (int ai = 0; ai < 2; ++ai)
#pragma unroll
            for (int m = 0; m < 4; ++m) { bf16* rowp = O + (size_t)(row0 + ai * 128 + m * 16) * D + DNW + cg;
#pragma unroll
                for (int bj = 0; bj < 2; ++bj) { const f32x4 v0 = acc[ai][bj][m][0] * sv[bj][0], v1 = acc[ai][bj][m][1] * sv[bj][1];
                    if (f8) { v2u w8; w8.x = pk4_fp8(v0[0] * F8_XS, v0[1] * F8_XS, v0[2] * F8_XS, v0[3] * F8_XS); w8.y = pk4_fp8(v1[0] * F8_XS, v1[1] * F8_XS, v1[2] * F8_XS, v1[3] * F8_XS);
                        *(v2u*)((unsigned char*)O + (size_t)(row0 + ai * 128 + m * 16) * D + DNW + cg + bj * 128) = w8; }
                    else { v4u w; w.x = cvt_pk_bf16(v0[0], v0[1]); w.y = cvt_pk_bf16(v0[2], v0[3]); w.z = cvt_pk_bf16(v1[0], v1[1]); w.w = cvt_pk_bf16(v1[2], v1[3]);
                    *(v4u*)(rowp + bj * 128) = w; } } }
    }
};
struct EpiRes {
    static constexpr bool PERM = true; const bf16* XB; bf16* PRE; float ascale = 1.0f;
    __device__ __forceinline__ void operator()(const f32x4 (&acc)[2][2][4][2], const pg8::Unit& u, int wr, int wc, int fr, int fq) const {
        const int row0 = u.rowbase + wr * 64 + fr, col0 = u.pn * 256 + wc * 32 + 8 * fq;
#pragma unroll
        for (int ai = 0; ai < 2; ++ai) { v4u xq[4][2];
#pragma unroll
            for (int m = 0; m < 4; ++m)
#pragma unroll
                for (int bj = 0; bj < 2; ++bj) xq[m][bj] = *(const v4u*)(XB + (size_t)(row0 + ai * 128 + m * 16) * D + col0 + bj * 128);
            asm volatile("" : "+v"(xq[0][0]), "+v"(xq[0][1]), "+v"(xq[1][0]), "+v"(xq[1][1]), "+v"(xq[2][0]), "+v"(xq[2][1]), "+v"(xq[3][0]), "+v"(xq[3][1]));
#pragma unroll
            for (int m = 0; m < 4; ++m)
#pragma unroll
                for (int bj = 0; bj < 2; ++bj) { const size_t off = (size_t)(row0 + ai * 128 + m * 16) * D + col0 + bj * 128; const v4u x = xq[m][bj]; const f32x4 a0 = acc[ai][bj][m][0] * ascale, a1 = acc[ai][bj][m][1] * ascale;
                    v4u w; w.x = cvt_pk_bf16(bflo(x.x) * ALPHA + a0[0], bfhi(x.x) * ALPHA + a0[1]); w.y = cvt_pk_bf16(bflo(x.y) * ALPHA + a0[2], bfhi(x.y) * ALPHA + a0[3]);
                    w.z = cvt_pk_bf16(bflo(x.z) * ALPHA + a1[0], bfhi(x.z) * ALPHA + a1[1]); w.w = cvt_pk_bf16(bflo(x.w) * ALPHA + a1[2], bfhi(x.w) * ALPHA + a1[3]);
                    *(v4u*)(PRE + off) = w; } }
    }
};
struct EpiSwiglu {
    static constexpr bool PERM = true; bf16* O; int f8 = 0; float ascale = 1.0f;
    __device__ __forceinline__ void operator()(const f32x4 (&acc)[2][2][4][2], const pg8::Unit& u, int wr, int wc, int fr, int fq) const {
        const int row0 = u.rowbase + wr * 64 + fr, col0 = u.pn * 128 + wc * 32 + 8 * fq;
#pragma unroll
        for (int ai = 0; ai < 2; ++ai) if (ai == 0 || !u.half)
#pragma unroll
            for (int m = 0; m < 4; ++m) { bf16* rowp = O + (size_t)(row0 + ai * 128 + m * 16) * DE + col0;
                float h[8];
#pragma unroll
                for (int n = 0; n < 2; ++n)
#pragma unroll
                    for (int j = 0; j < 4; ++j) { const float g = acc[ai][0][m][n][j] * ascale, up = acc[ai][1][m][n][j] * ascale; h[4 * n + j] = g * sigmoidf_(g) * up; }
                if (f8) { v2u w8; w8.x = pk4_fp8(h[0] * F8_XS, h[1] * F8_XS, h[2] * F8_XS, h[3] * F8_XS); w8.y = pk4_fp8(h[4] * F8_XS, h[5] * F8_XS, h[6] * F8_XS, h[7] * F8_XS);
                    *(v2u*)((unsigned char*)O + (size_t)(row0 + ai * 128 + m * 16) * DE + col0) = w8; }
                else { v4u w; w.x = cvt_pk_bf16(h[0], h[1]); w.y = cvt_pk_bf16(h[2], h[3]); w.z = cvt_pk_bf16(h[4], h[5]); w.w = cvt_pk_bf16(h[6], h[7]);
                *(v4u*)rowp = w; } }
    }
};
struct EpiPle {
    static constexpr bool PERM = true; const bf16* X2B; const bf16* PP; bf16* XB; float* OUT; int last; float ascale = 1.0f;
    __device__ __forceinline__ void operator()(const f32x4 (&acc)[2][2][4][2], const pg8::Unit& u, int wr, int wc, int fr, int fq) const {
        const int row0 = u.rowbase + wr * 64 + fr, col0 = u.pn * 256 + wc * 32 + 8 * fq;
#pragma unroll
        for (int ai = 0; ai < 2; ++ai)
#pragma unroll
            for (int mp = 0; mp < 2; ++mp) { v4u xq[2][2], pq[2][2];
#pragma unroll
                for (int mm = 0; mm < 2; ++mm)
#pragma unroll
                    for (int bj = 0; bj < 2; ++bj) { const size_t off = (size_t)(row0 + ai * 128 + (2 * mp + mm) * 16) * D + col0 + bj * 128; xq[mm][bj] = *(const v4u*)(X2B + off); pq[mm][bj] = *(const v4u*)(PP + off); }
                asm volatile("" : "+v"(xq[0][0]), "+v"(xq[0][1]), "+v"(xq[1][0]), "+v"(xq[1][1]), "+v"(pq[0][0]), "+v"(pq[0][1]), "+v"(pq[1][0]), "+v"(pq[1][1]));
#pragma unroll
                for (int mm = 0; mm < 2; ++mm)
#pragma unroll
                    for (int bj = 0; bj < 2; ++bj) { const int m = 2 * mp + mm; const size_t off = (size_t)(row0 + ai * 128 + m * 16) * D + col0 + bj * 128;
                        const v4u xx = xq[mm][bj], pp = pq[mm][bj];
                        const f32x4 a0 = acc[ai][bj][m][0] * ascale, a1 = acc[ai][bj][m][1] * ascale;
                        f32x4 o0, o1;
                        o0[0] = bflo(xx.x) + sigmoidf_(a0[0]) * bflo(pp.x); o0[1] = bfhi(xx.x) + sigmoidf_(a0[1]) * bfhi(pp.x); o0[2] = bflo(xx.y) + sigmoidf_(a0[2]) * bflo(pp.y); o0[3] = bfhi(xx.y) + sigmoidf_(a0[3]) * bfhi(pp.y);
                        o1[0] = bflo(xx.z) + sigmoidf_(a1[0]) * bflo(pp.z); o1[1] = bfhi(xx.z) + sigmoidf_(a1[1]) * bfhi(pp.z); o1[2] = bflo(xx.w) + sigmoidf_(a1[2]) * bflo(pp.w); o1[3] = bfhi(xx.w) + sigmoidf_(a1[3]) * bfhi(pp.w);
                        if (last) { *(f32x4*)(OUT + off) = o0; *(f32x4*)(OUT + off + 4) = o1; }
                        else { v4u w; w.x = cvt_pk_bf16(o0[0], o0[1]); w.y = cvt_pk_bf16(o0[2], o0[3]); w.z = cvt_pk_bf16(o1[0], o1[1]); w.w = cvt_pk_bf16(o1[2], o1[3]); *(v4u*)(XB + off) = w; } } }
    }
};

__device__ __forceinline__ void tr_item(const float* W, int ldw, int k0, int n0, bf16* WT, size_t drow0, int ldt, LAS float* scr, int lane) {
#pragma unroll 8
    for (int i = 0; i < 32; ++i) { const int kk = 2 * i + (lane >> 5); scr[kk * 33 + (lane & 31)] = W[(size_t)(k0 + kk) * ldw + n0 + (lane & 31)]; }
    LDS_WAIT(); asm volatile("" ::: "memory");
    const int c = lane & 7;
#pragma unroll
    for (int j = 0; j < 4; ++j) { const int n = (lane >> 3) + 8 * j; const LAS float* s = scr + (8 * c) * 33 + n;
        v4u o; o.x = pk2(s[0 * 33], s[1 * 33]); o.y = pk2(s[2 * 33], s[3 * 33]); o.z = pk2(s[4 * 33], s[5 * 33]); o.w = pk2(s[6 * 33], s[7 * 33]);
        *(GAS v4u*)(WT + (drow0 + n) * ldt + k0 + 8 * c) = o; }
    LDS_WAIT(); asm volatile("" ::: "memory");
}
__device__ __forceinline__ void tr_item8(const float* W, int ldw, int k0, int n0, unsigned char* WT, size_t drow0, int ldt, LAS float* scr, int lane) {
#pragma unroll 8
    for (int i = 0; i < 32; ++i) { const int kk = 2 * i + (lane >> 5); scr[kk * 33 + (lane & 31)] = W[(size_t)(k0 + kk) * ldw + n0 + (lane & 31)]; }
    LDS_WAIT(); asm volatile("" ::: "memory");
    const int c = lane & 7;
#pragma unroll
    for (int j = 0; j < 4; ++j) { const int n = (lane >> 3) + 8 * j; const LAS float* s = scr + (8 * c) * 33 + n;
        v2u o; o.x = pk4_fp8(s[0 * 33] * F8_WS, s[1 * 33] * F8_WS, s[2 * 33] * F8_WS, s[3 * 33] * F8_WS); o.y = pk4_fp8(s[4 * 33] * F8_WS, s[5 * 33] * F8_WS, s[6 * 33] * F8_WS, s[7 * 33] * F8_WS);
        *(GAS v2u*)(WT + (drow0 + n) * ldt + k0 + 8 * c) = o; }
    LDS_WAIT(); asm volatile("" ::: "memory");
}
__device__ __forceinline__ void weight_items(const Args& a, unsigned char* ws, LAS float* scr, int lane, int group, int l, int gw, int NGW) {
    constexpr int I_INA = 32 * 128, I_INB = 32 * 32, I_OUT = 32 * 64, I_PG = 32 * 64, I_PP = 4 * 64, I_POOL = 4 * 32, I_EG = NE * 32 * 32, I_EU = I_EG, I_ED = NE * 16 * 64;
    if (group == 0) {
        for (int it = gw; it < I_INA + I_INB + I_PP + I_POOL; it += NGW) { int r = it;
            if (r < I_INA) { const int kb = r / 128, nb = r % 128; tr_item(a.in[I_WIN] + (size_t)l * D * IN_COLS, IN_COLS, 64 * kb, 32 * nb, (bf16*)(ws + WS_WIN) + (size_t)l * NPROJ * D, 32 * nb, D, scr, lane); continue; } r -= I_INA;
            if (r < I_INB) { const int kb = r / 32, nb = r % 32; tr_item(a.in[I_WIN] + (size_t)l * D * IN_COLS, IN_COLS, 64 * kb, 4112 + 32 * nb, (bf16*)(ws + WS_WIN) + (size_t)l * NPROJ * D, 4096 + 32 * nb, D, scr, lane); continue; } r -= I_INB;
            if (r < I_PP) { const int kb = r / 64, nb = r % 64; tr_item(a.in[I_WPP] + (size_t)l * PLE * D, D, 64 * kb, 32 * nb, (bf16*)(ws + WS_WPP) + (size_t)l * D * PLE, 32 * nb, PLE, scr, lane); continue; } r -= I_PP;
            { const int g = r / 32, rr = r % 32, kb = rr / 8, nb = rr % 8; tr_item(a.in[I_POOLW] + ((size_t)l * 4 + g) * 65536, 256, 64 * kb, 32 * nb, (bf16*)(ws + WS_WPOOL) + ((size_t)l * 4 + g) * 65536, 32 * nb, 256, scr, lane); } }
    } else {
        const bool f8 = FP8_LAYER(l);
        for (int it = gw; it < I_OUT + I_PG + I_EG + I_EU + I_ED; it += NGW) { int r = it;
            if (r < I_OUT) { const int kb = r / 64, nb = r % 64; if (FP8_PD) tr_item8(a.in[I_WOUT] + (size_t)l * D * D, D, 64 * kb, 32 * nb, ws + WS_WOUT + (size_t)l * D * D * 2, 32 * nb, D, scr, lane); else tr_item(a.in[I_WOUT] + (size_t)l * D * D, D, 64 * kb, 32 * nb, (bf16*)(ws + WS_WOUT) + (size_t)l * D * D, 32 * nb, D, scr, lane); continue; } r -= I_OUT;
            if (r < I_PG) { const int kb = r / 64, nb = r % 64; if (FP8_PI && (FP8_PI0 || l == DEPTH - 1)) tr_item8(a.in[I_WPG] + (size_t)l * D * D, D, 64 * kb, 32 * nb, ws + WS_WPG + (size_t)l * D * D * 2, 32 * nb, D, scr, lane); else tr_item(a.in[I_WPG] + (size_t)l * D * D, D, 64 * kb, 32 * nb, (bf16*)(ws + WS_WPG) + (size_t)l * D * D, 32 * nb, D, scr, lane); continue; } r -= I_PG;
            if (r < I_EG) { const int e = r / 1024, rr = r % 1024, kb = rr / 32, nb = rr % 32, h0 = 32 * nb;
                if (f8) tr_item8(a.in[I_WEG] + ((size_t)l * NE + e) * D * DE, DE, 64 * kb, h0, ws + WS_WGU + (size_t)l * NE * 2048 * D * 2 + (size_t)e * 2048 * D, (size_t)(h0 >> 7) * 256 + (h0 & 127), D, scr, lane);
                else tr_item(a.in[I_WEG] + ((size_t)l * NE + e) * D * DE, DE, 64 * kb, h0, (bf16*)(ws + WS_WGU) + ((size_t)l * NE + e) * 2048 * D, (size_t)(h0 >> 7) * 256 + (h0 & 127), D, scr, lane); continue; } r -= I_EG;
            if (r < I_EU) { const int e = r / 1024, rr = r % 1024, kb = rr / 32, nb = rr % 32, h0 = 32 * nb;
                if (f8) tr_item8(a.in[I_WEU] + ((size_t)l * NE + e) * D * DE, DE, 64 * kb, h0, ws + WS_WGU + (size_t)l * NE * 2048 * D * 2 + (size_t)e * 2048 * D, (size_t)(h0 >> 7) * 256 + 128 + (h0 & 127), D, scr, lane);
                else tr_item(a.in[I_WEU] + ((size_t)l * NE + e) * D * DE, DE, 64 * kb, h0, (bf16*)(ws + WS_WGU) + ((size_t)l * NE + e) * 2048 * D, (size_t)(h0 >> 7) * 256 + 128 + (h0 & 127), D, scr, lane); continue; } r -= I_EU;
            { const int e = r / 1024, rr = r % 1024, kb = rr / 64, nb = rr % 64;
                if (f8 && FP8_PG) tr_item8(a.in[I_WED] + ((size_t)l * NE + e) * DE * D, D, 64 * kb, 32 * nb, ws + WS_WD + (size_t)l * NE * D * DE * 2 + (size_t)e * D * DE, 32 * nb, DE, scr, lane);
                else tr_item(a.in[I_WED] + ((size_t)l * NE + e) * DE * D, D, 64 * kb, 32 * nb, (bf16*)(ws + WS_WD) + ((size_t)l * NE + e) * D * DE, 32 * nb, DE, scr, lane); } }
    }
}
__device__ __forceinline__ void p0_prologue(const Frame& F0, const Args& a) {
    PHASE_FRAME(F0);
    LAS float* scr = (LAS float*)(F.lds + RING_OFF + F.wave * 16384);
    const int gw = F.vcu * NWAVES + F.wave, NGW = F.G * NWAVES;
    unsigned char* ws = OPQ_G(unsigned char, a.ws);
#pragma unroll 1
    for (int l = 0; l < DEPTH; ++l) weight_items(a, ws, scr, F.lane, 0, l, gw, NGW);
#ifdef CONVERT_ALL_IN_PROLOGUE
#pragma unroll 1
    for (int l = 0; l < DEPTH; ++l) weight_items(a, ws, scr, F.lane, 1, l, gw, NGW);
#endif
    const size_t gt = (size_t)F.vcu * 512 + F.tid, NGT = (size_t)F.G * 512;
    { const GAS f32x4* src = (const GAS f32x4*)a.in[I_X]; GAS v4u* dst = (GAS v4u*)(ws + WS_XB);
        for (size_t i = gt; i < (size_t)T * D / 8; i += NGT) { const f32x4 v0 = src[2 * i], v1 = src[2 * i + 1]; v4u o; o.x = pk2(v0[0], v0[1]); o.y = pk2(v0[2], v0[3]); o.z = pk2(v1[0], v1[1]); o.w = pk2(v1[2], v1[3]); dst[i] = o; } }
    { const GAS f32x4* src = (const GAS f32x4*)a.in[I_P]; GAS v4u* dst = (GAS v4u*)(ws + WS_PB16);
        for (size_t i = gt; i < (size_t)DEPTH * T * PLE / 8; i += NGT) { const f32x4 v0 = src[2 * i], v1 = src[2 * i + 1]; v4u o; o.x = pk2(v0[0], v0[1]); o.y = pk2(v0[2], v0[3]); o.z = pk2(v1[0], v1[1]); o.w = pk2(v1[2], v1[3]); dst[i] = o; } }
    for (size_t i = gt; i < (size_t)DEPTH * 16 * D; i += NGT) { const int l = (int)(i / (16 * D)), j = (int)((i / D) % 16), k = (int)(i % D);
        ((bf16*)(ws + WS_WBA))[i] = (bf16)f2bf(a.in[I_WIN][((size_t)l * D + k) * IN_COLS + 4096 + j]); }
}

typedef float f32x16 __attribute__((ext_vector_type(16)));
#define MFMA32(a_, b_, c_) __builtin_amdgcn_mfma_f32_32x32x16_bf16((a_), (b_), (c_), 0, 0, 0)
#define PACK8(x, sp) __builtin_bit_cast(bf16x8, (v4u){pkbf((x)[8 * (sp)], (x)[8 * (sp) + 1]), pkbf((x)[8 * (sp) + 2], (x)[8 * (sp) + 3]), pkbf((x)[8 * (sp) + 4], (x)[8 * (sp) + 5]), pkbf((x)[8 * (sp) + 6], (x)[8 * (sp) + 7])})
#define RAW_BAR() do { asm volatile("s_waitcnt lgkmcnt(0)" ::: "memory"); __builtin_amdgcn_s_barrier(); asm volatile("" ::: "memory"); } while (0)
constexpr int IMG_ELEMS = 56 * 512, UIMG_ELEMS = 8 * 1024;
constexpr int FR_WN = 0, FR_QD = 16, FR_AQK = 32, FR_KDT = 40;
constexpr size_t WS_IMG = WS_R2, WS_UIMG = WS_R2 + 112 * MiB;
static_assert((size_t)NB * NCH * NH * IMG_ELEMS * 2 == 112 * MiB && (size_t)NB * NCH * NH * UIMG_ELEMS * 2 == 32 * MiB, "DeltaNet images");

__device__ __forceinline__ void pool_diffs_unit(const Frame& F, unsigned char* ws, int pm, int g) {
    const bf16* PROJ = (const bf16*)(ws + WS_PROJ); bf16* POOLD = (bf16*)(ws + WS_POOLD);
    const int tid = F.tid, cp = tid & 127, rq = tid >> 7, r0 = 256 * pm + 64 * rq, sq0 = r0 % SEQ, col = 256 * g + 2 * cp;
    const bf16* up = PROJ + (size_t)r0 * NPROJ + 4096 + col; bf16* dp = POOLD + (size_t)r0 * PW + col;
#define POOL_BODY(WIN) do { unsigned xr[CH + WIN - 1]; \
        _Pragma("unroll") for (int j = 0; j < WIN - 1; ++j) xr[j] = (sq0 - (WIN - 1) + j >= 0) ? *(const unsigned*)(up + (ptrdiff_t)(j - (WIN - 1)) * NPROJ) : 0u; \
        _Pragma("unroll") for (int i = 0; i < CH; ++i) xr[WIN - 1 + i] = *(const unsigned*)(up + (size_t)i * NPROJ); \
        float s0 = 0.f, s1 = 0.f; \
        _Pragma("unroll") for (int j = 0; j < WIN - 1; ++j) { s0 += bflo(xr[j]); s1 += bfhi(xr[j]); } \
        _Pragma("unroll") for (int i = 0; i < CH; ++i) { const float x0 = bflo(xr[WIN - 1 + i]), x1 = bfhi(xr[WIN - 1 + i]); s0 += x0; s1 += x1; \
            const int pos = sq0 + i; const float inv = __builtin_amdgcn_rcpf((float)((pos + 1) < WIN ? (pos + 1) : WIN)); \
            *(unsigned*)(dp + (size_t)i * PW) = pkbf(s0 * inv - x0, s1 * inv - x1); s0 -= bflo(xr[i]); s1 -= bfhi(xr[i]); } } while (0)
    if (g == 0) POOL_BODY(2); else if (g == 1) POOL_BODY(4); else if (g == 2) POOL_BODY(8); else POOL_BODY(16);
#undef POOL_BODY
}
#ifndef PREP_DUP
#define PREP_DUP 0
#endif
constexpr int PQF = 0, PKF = 33792, PQS = 67584, PKS = 84992, PVT = 102400, PKT = 120832, PTAB = 139264;
constexpr int PAS = PQF;
constexpr int PTB = PKF, PT11T = PKF + 9216, PPART = PKF;
constexpr int F_LD = 132, S_LD = 136, T_LD = 72, A_LD = 68, TT_LD = 40;
__device__ __forceinline__ void phase_dn_prep(const Frame& F0, const Args& a, int layer) {
    PHASE_FRAME(F0);
    unsigned char* ws = OPQ_G(unsigned char, a.ws);
    LAS unsigned char* lds = F.lds;
    LAS float* Qf = (LAS float*)(lds + PQF); LAS float* Kf = (LAS float*)(lds + PKF); LAS float* As = (LAS float*)(lds + PAS);
    LAS bf16* Qs = (LAS bf16*)(lds + PQS); LAS bf16* Ks = (LAS bf16*)(lds + PKS); LAS bf16* Vt = (LAS bf16*)(lds + PVT); LAS bf16* Kt = (LAS bf16*)(lds + PKT);
    LAS bf16* Tb = (LAS bf16*)(lds + PTB); LAS bf16* T11t = (LAS bf16*)(lds + PT11T);
    LAS float* betaS = (LAS float*)(lds + PTAB); LAS float* gS = betaS + 512; LAS float* gamh = gS + 512; LAS float* betah = gamh + 64; LAS float* egam = betah + 64; LAS float* bgam = egam + 64; LAS float* ekd = bgam + 64; LAS float* rkS = ekd + 64;
    const bf16* XB = (const bf16*)(ws + WS_XB); const bf16* PROJ = (const bf16*)(ws + WS_PROJ); const bf16* WBA = (const bf16*)(ws + WS_WBA) + (size_t)layer * 16 * D;
    bf16* IMG = (bf16*)(ws + WS_IMG); bf16* UIMG = (bf16*)(ws + WS_UIMG); float* CD = (float*)(ws + WS_CD);
    const float* convw = a.in[I_CONVW] + (size_t)layer * 4 * 3072; const float* alog = a.in[I_ALOG] + layer * NH; const float* dtb = a.in[I_DTB] + layer * NH;
    const int tid = F.tid, lane = F.lane, wave = F.wave, c32 = lane & 31, hf = lane >> 5;
    for (int unit = F.vcu; unit < NB * NCH; unit += F.G) {
        const int b = unit / NCH, n = unit % NCH, r0 = b * SEQ + n * CH, sq0 = n * CH;
        for (int rep_ = 0; rep_ < ((PREP_DUP & 64) ? 2 : 1); ++rep_)
        { typedef float f32x4v __attribute__((ext_vector_type(4)));
            const int fr = lane & 15, fg = lane >> 4; f32x4v pacc[4];
#pragma unroll
            for (int mt = 0; mt < 4; ++mt) pacc[mt] = (f32x4v){0.f, 0.f, 0.f, 0.f};
#pragma unroll 1
            for (int sb = 0; sb < 8; sb += 4) {
                bf16x8 bq[4], aq[4][4];
#pragma unroll
                for (int s = 0; s < 4; ++s) { const int k0 = 256 * wave + 32 * (sb + s) + 8 * fg; bq[s] = *(const bf16x8*)(WBA + (size_t)fr * D + k0);
#pragma unroll
                    for (int mt = 0; mt < 4; ++mt) aq[s][mt] = *(const bf16x8*)(XB + (size_t)(r0 + 16 * mt + fr) * D + k0); }
                asm volatile("" : "+v"(bq[0]), "+v"(bq[1]), "+v"(bq[2]), "+v"(bq[3]), "+v"(aq[0][0]), "+v"(aq[0][1]), "+v"(aq[0][2]), "+v"(aq[0][3]), "+v"(aq[1][0]), "+v"(aq[1][1]), "+v"(aq[1][2]), "+v"(aq[1][3]),
                             "+v"(aq[2][0]), "+v"(aq[2][1]), "+v"(aq[2][2]), "+v"(aq[2][3]), "+v"(aq[3][0]), "+v"(aq[3][1]), "+v"(aq[3][2]), "+v"(aq[3][3]));
#pragma unroll
                for (int s = 0; s < 4; ++s)
#pragma unroll
                    for (int mt = 0; mt < 4; ++mt) pacc[mt] = __builtin_amdgcn_mfma_f32_16x16x32_bf16(aq[s][mt], bq[s], pacc[mt], 0, 0, 0); }
            LAS float* part = (LAS float*)(lds + PPART) + wave * 1024;
#pragma unroll
            for (int mt = 0; mt < 4; ++mt)
#pragma unroll
                for (int r = 0; r < 4; ++r) part[(16 * mt + 4 * fg + r) * 16 + fr] = pacc[mt][r]; }
        __syncthreads();
        { const int tok = tid >> 3, cp = tid & 7; float s0 = 0.f, s1 = 0.f;
#pragma unroll
            for (int w = 0; w < 8; ++w) { const f32x2 p2 = *(const LAS f32x2*)((LAS float*)(lds + PPART) + w * 1024 + tok * 16 + 2 * cp); s0 += p2[0]; s1 += p2[1]; }
            if (cp < 4) { betaS[tok * 8 + 2 * cp] = sigmoidf_(s0); betaS[tok * 8 + 2 * cp + 1] = sigmoidf_(s1); }
            else { const int h = 2 * (cp - 4); const float z0 = s0 + dtb[h], z1 = s1 + dtb[h + 1];
                const float sp0 = z0 > 20.f ? z0 : log1pf(__expf(z0)), sp1 = z1 > 20.f ? z1 : log1pf(__expf(z1));
                gS[tok * 8 + h] = -__expf(alog[h]) * sp0; gS[tok * 8 + h + 1] = -__expf(alog[h + 1]) * sp1; } }
        __syncthreads();
        { float gv = gS[lane * 8 + wave];
#pragma unroll
            for (int o = 1; o < 64; o <<= 1) { const float up_ = __shfl_up(gv, o); if (lane >= o) gv += up_; }
            gS[lane * 8 + wave] = gv; }
        __syncthreads();
        unsigned craw[3][11]; unsigned cdum[3][8];
#define PREP_LOADRAW(hh) do { const int cp_ = tid & 63, i0_ = (tid >> 6) * 8; \
            _Pragma("unroll") for (int part_ = 0; part_ < 3; ++part_) { const bf16* src_ = PROJ + (size_t)(r0 + i0_ - 3) * NPROJ + part_ * 1024 + (hh) * HD + 2 * cp_; \
                _Pragma("unroll") for (int j_ = 0; j_ < 11; ++j_) craw[part_][j_] = (sq0 + i0_ - 3 + j_ >= 0) ? *(const unsigned*)(src_ + (ptrdiff_t)j_ * NPROJ) : 0u; \
                if (PREP_DUP & 256) { _Pragma("unroll") for (int j_ = 3; j_ < 11; ++j_) cdum[part_][j_ - 3] = *(const unsigned*)(src_ + (ptrdiff_t)j_ * NPROJ + ((hh) ^ 1) * HD - (hh) * HD); } } } while (0)
        PREP_LOADRAW(0);
        for (int hh_ = 0; hh_ < ((PREP_DUP & 128) ? 2 * NH : NH); ++hh_) { const int h = hh_ & (NH - 1);
            const size_t chd = (size_t)unit * NH + h; bf16* img = IMG + chd * IMG_ELEMS; bf16* uimg = UIMG + chd * UIMG_ELEMS;
            if (tid < 64) { const float gi = gS[tid * 8 + h], bi = betaS[tid * 8 + h], eg = __expf(gi); gamh[tid] = gi; betah[tid] = bi; egam[tid] = eg; bgam[tid] = bi * eg; ekd[tid] = __expf(gS[63 * 8 + h] - gi); }
            RAW_BAR();
            for (int rep_ = 0; rep_ < ((PREP_DUP & 16) ? 2 : 1); ++rep_)
            { const int cp = tid & 63, rg8 = tid >> 6, i0 = rg8 * 8;
                if (PREP_DUP & 256) {
#pragma unroll
                    for (int p_ = 0; p_ < 3; ++p_)
#pragma unroll
                        for (int j_ = 0; j_ < 8; ++j_) asm volatile("" :: "v"(cdum[p_][j_])); }
#pragma unroll
                for (int part = 0; part < 3; ++part) { const int col = part * 1024 + h * HD + 2 * cp;
                    const f32x2 cw0 = *(const f32x2*)(convw + col), cw1 = *(const f32x2*)(convw + 3072 + col), cw2 = *(const f32x2*)(convw + 2 * 3072 + col), cw3 = *(const f32x2*)(convw + 3 * 3072 + col);
                    float ya[8], yb[8];
#pragma unroll
                    for (int i = 0; i < 8; ++i) { const unsigned x3 = craw[part][i], x2 = craw[part][i + 1], x1 = craw[part][i + 2], x0 = craw[part][i + 3];
                        const float ta = cw0[0] * bflo(x3) + cw1[0] * bflo(x2) + cw2[0] * bflo(x1) + cw3[0] * bflo(x0), tb = cw0[1] * bfhi(x3) + cw1[1] * bfhi(x2) + cw2[1] * bfhi(x1) + cw3[1] * bfhi(x0);
                        ya[i] = ta * sigmoidf_(ta); yb[i] = tb * sigmoidf_(tb); }
                    if (part == 0) {
#pragma unroll
                        for (int i = 0; i < 8; ++i) *(LAS f32x2*)(Qf + (i0 + i) * F_LD + 2 * cp) = (f32x2){ya[i], yb[i]}; }
                    else if (part == 1) {
#pragma unroll
                        for (int i = 0; i < 8; ++i) *(LAS f32x2*)(Kf + (i0 + i) * F_LD + 2 * cp) = (f32x2){ya[i], yb[i]}; }
                    else { v4u o0, o1;
                        o0.x = pkbf(ya[0] * betah[i0 + 0], ya[1] * betah[i0 + 1]); o0.y = pkbf(ya[2] * betah[i0 + 2], ya[3] * betah[i0 + 3]); o0.z = pkbf(ya[4] * betah[i0 + 4], ya[5] * betah[i0 + 5]); o0.w = pkbf(ya[6] * betah[i0 + 6], ya[7] * betah[i0 + 7]);
                        o1.x = pkbf(yb[0] * betah[i0 + 0], yb[1] * betah[i0 + 1]); o1.y = pkbf(yb[2] * betah[i0 + 2], yb[3] * betah[i0 + 3]); o1.z = pkbf(yb[4] * betah[i0 + 4], yb[5] * betah[i0 + 5]); o1.w = pkbf(yb[6] * betah[i0 + 6], yb[7] * betah[i0 + 7]);
                        *(LAS v4u*)(Vt + (2 * cp) * T_LD + i0) = o0; *(LAS v4u*)(Vt + (2 * cp + 1) * T_LD + i0) = o1; } }
            }
            if (hh_ + 1 < ((PREP_DUP & 128) ? 2 * NH : NH)) PREP_LOADRAW((hh_ + 1) & (NH - 1));
            for (int rep_ = 0; rep_ < ((PREP_DUP & 1) ? 2 : 1); ++rep_) { if (rep_) RAW_BAR();
            { const int i = tid >> 3, part = tid & 7; const LAS float* qp = Qf + i * F_LD + part * 16; const LAS float* kp = Kf + i * F_LD + part * 16;
                f32x4 qv[4], kv[4]; float sq = 0.f, sk = 0.f;
#pragma unroll
                for (int j = 0; j < 4; ++j) { qv[j] = *(const LAS f32x4*)(qp + 4 * j); kv[j] = *(const LAS f32x4*)(kp + 4 * j);
                    sq += (qv[j][0] * qv[j][0] + qv[j][1] * qv[j][1]) + (qv[j][2] * qv[j][2] + qv[j][3] * qv[j][3]); sk += (kv[j][0] * kv[j][0] + kv[j][1] * kv[j][1]) + (kv[j][2] * kv[j][2] + kv[j][3] * kv[j][3]); }
                sq = row8_sum(sq); sk = row8_sum(sk);
                const float rq = 1.0f / sqrtf(sq + RMS_EPS) * 0.08838834764831845f, rk = 1.0f / sqrtf(sk + RMS_EPS);
                if (part == 0) rkS[i] = rk;
#pragma unroll
                for (int j = 0; j < 4; ++j) { qv[j] = qv[j] * rq; kv[j] = kv[j] * rk; }
                v4u w0, w1;
                w0.x = pkbf(qv[0][0], qv[0][1]); w0.y = pkbf(qv[0][2], qv[0][3]); w0.z = pkbf(qv[1][0], qv[1][1]); w0.w = pkbf(qv[1][2], qv[1][3]); w1.x = pkbf(qv[2][0], qv[2][1]); w1.y = pkbf(qv[2][2], qv[2][3]); w1.z = pkbf(qv[3][0], qv[3][1]); w1.w = pkbf(qv[3][2], qv[3][3]);
                *(LAS v4u*)(Qs + i * S_LD + part * 16) = w0; *(LAS v4u*)(Qs + i * S_LD + part * 16 + 8) = w1;
                w0.x = pkbf(kv[0][0], kv[0][1]); w0.y = pkbf(kv[0][2], kv[0][3]); w0.z = pkbf(kv[1][0], kv[1][1]); w0.w = pkbf(kv[1][2], kv[1][3]); w1.x = pkbf(kv[2][0], kv[2][1]); w1.y = pkbf(kv[2][2], kv[2][3]); w1.z = pkbf(kv[3][0], kv[3][1]); w1.w = pkbf(kv[3][2], kv[3][3]);
                *(LAS v4u*)(Ks + i * S_LD + part * 16) = w0; *(LAS v4u*)(Ks + i * S_LD + part * 16 + 8) = w1;
                const float eg = egam[i]; bf16* fq = img + ((size_t)(FR_QD + (i >> 5) * 8 + part) * 64 + (i & 31)) * 8;
                v4u h0, h1;
                h0.x = pkbf(qv[0][0] * eg, qv[0][1] * eg); h0.y = pkbf(qv[0][2] * eg, qv[0][3] * eg); h0.z = pkbf(qv[2][0] * eg, qv[2][1] * eg); h0.w = pkbf(qv[2][2] * eg, qv[2][3] * eg);
                h1.x = pkbf(qv[1][0] * eg, qv[1][1] * eg); h1.y = pkbf(qv[1][2] * eg, qv[1][3] * eg); h1.z = pkbf(qv[3][0] * eg, qv[3][1] * eg); h1.w = pkbf(qv[3][2] * eg, qv[3][3] * eg);
                *(v4u*)fq = h0; *(v4u*)(fq + 32 * 8) = h1; }
            RAW_BAR();
            { const int c = tid & 127, rg = tid >> 7; float kb[16], kd[16];
#pragma unroll
                for (int i = 0; i < 16; ++i) { const int t = rg * 16 + i; const float kn = Kf[t * F_LD + c] * rkS[t]; kb[i] = kn * bgam[t]; kd[i] = kn * ekd[t]; }
                v4u o0, o1;
                o0.x = pkbf(kb[0], kb[1]); o0.y = pkbf(kb[2], kb[3]); o0.z = pkbf(kb[4], kb[5]); o0.w = pkbf(kb[6], kb[7]); o1.x = pkbf(kb[8], kb[9]); o1.y = pkbf(kb[10], kb[11]); o1.z = pkbf(kb[12], kb[13]); o1.w = pkbf(kb[14], kb[15]);
                *(LAS v4u*)(Kt + c * T_LD + rg * 16) = o0; *(LAS v4u*)(Kt + c * T_LD + rg * 16 + 8) = o1;
                bf16* fk = img + ((size_t)(FR_KDT + (c >> 5) * 4 + rg) * 64 + (c & 31)) * 8;
                v4u h0, h1;
                h0.x = pkbf(kd[0], kd[1]); h0.y = pkbf(kd[2], kd[3]); h0.z = pkbf(kd[8], kd[9]); h0.w = pkbf(kd[10], kd[11]);
                h1.x = pkbf(kd[4], kd[5]); h1.y = pkbf(kd[6], kd[7]); h1.z = pkbf(kd[12], kd[13]); h1.w = pkbf(kd[14], kd[15]);
                *(v4u*)fk = h0; *(v4u*)(fk + 32 * 8) = h1; }
            RAW_BAR();
            }
            for (int rep_ = 0; rep_ < ((PREP_DUP & 2) ? 2 : 1); ++rep_) { if (rep_) RAW_BAR();
            if (wave < 6) { const int pr = wave % 3, iskk = wave / 3, mt = pr == 2 ? 1 : 0, nt = pr == 0 ? 0 : 1;
                const LAS bf16* xs = iskk ? Ks : Qs; f32x16 d;
#pragma unroll
                for (int r = 0; r < 16; ++r) d[r] = 0.f;
#pragma unroll
                for (int s = 0; s < 8; ++s) { const bf16x8 af = *(const LAS bf16x8*)(Ks + (32 * mt + c32) * S_LD + 16 * s + 8 * hf), bfr = *(const LAS bf16x8*)(xs + (32 * nt + c32) * S_LD + 16 * s + 8 * hf); d = MFMA32(af, bfr, d); }
                const int i = 32 * nt + c32; const float gi = gamh[i], bi = betah[i];
#pragma unroll
                for (int r = 0; r < 16; ++r) { const int j = 32 * mt + (r & 3) + 8 * (r >> 2) + 4 * hf; const float de = __expf(gi - gamh[j]);
                    d[r] = iskk ? ((j < i) ? bi * d[r] * de : 0.f) : ((j <= i) ? d[r] * de : 0.f); }
                if (iskk) {
#pragma unroll
                    for (int qd = 0; qd < 4; ++qd) *(LAS f32x4*)(As + i * A_LD + 32 * mt + 8 * qd + 4 * hf) = (f32x4){d[4 * qd], d[4 * qd + 1], d[4 * qd + 2], d[4 * qd + 3]}; }
                else {
#pragma unroll
                    for (int sp = 0; sp < 2; ++sp) *(bf16x8*)(img + ((size_t)(FR_AQK + nt * 4 + 2 * mt + sp) * 64 + lane) * 8) = PACK8(d, sp); } }
            RAW_BAR();
            }
            for (int rep_ = 0; rep_ < ((PREP_DUP & 4) ? 2 : 1); ++rep_) { if (rep_) RAW_BAR();
            if (wave < 2) {
                unsigned asb = (unsigned)(uintptr_t)(As + (32 * wave) * A_LD + 32 * wave); int cb = c32; asm volatile("" : "+v"(asb), "+v"(cb));
                const LAS float* Ab = (const LAS float*)(uintptr_t)asb;
                float arow[32], Tc[32];
#pragma unroll
                for (int i = 0; i < 32; ++i) arow[i] = Ab[i * A_LD + cb];
#pragma unroll
                for (int i = 0; i < 32; ++i) { float ac[4] = {(i == cb) ? 1.f : 0.f, 0.f, 0.f, 0.f}; if (i > 0) asm volatile("" : "+v"(arow[i]), "+v"(Tc[i - 1]));
#pragma unroll
                    for (int j = 0; j < i; ++j) { const float aij = __builtin_bit_cast(float, __builtin_amdgcn_readlane(__builtin_bit_cast(int, arow[i]), j)); ac[j & 3] -= aij * Tc[j]; }
                    Tc[i] = (ac[0] + ac[1]) + (ac[2] + ac[3]); __builtin_amdgcn_sched_barrier(0); }
                if (hf == 0) {
#pragma unroll
                    for (int i = 0; i < 32; ++i) Tb[(32 * wave + i) * T_LD + 32 * wave + c32] = (bf16)(pkbf(Tc[i], 0.f) & 0xffffu);
                    if (wave == 0) {
#pragma unroll
                        for (int q = 0; q < 4; ++q) { v4u o; o.x = pkbf(Tc[8 * q], Tc[8 * q + 1]); o.y = pkbf(Tc[8 * q + 2], Tc[8 * q + 3]); o.z = pkbf(Tc[8 * q + 4], Tc[8 * q + 5]); o.w = pkbf(Tc[8 * q + 6], Tc[8 * q + 7]); *(LAS v4u*)(T11t + c32 * TT_LD + 8 * q) = o; } } } }
            RAW_BAR();
            if (wave == 0) {
                f32x16 x;
#pragma unroll
                for (int r = 0; r < 16; ++r) x[r] = 0.f;
#pragma unroll
                for (int s = 0; s < 2; ++s) { const LAS float* ap = As + (32 + c32) * A_LD + 16 * s + 8 * hf; const f32x4 a0 = *(const LAS f32x4*)ap, a1 = *(const LAS f32x4*)(ap + 4);
                    const bf16x8 af = __builtin_bit_cast(bf16x8, (v4u){pkbf(a0[0], a0[1]), pkbf(a0[2], a0[3]), pkbf(a1[0], a1[1]), pkbf(a1[2], a1[3])});
                    const bf16x8 bfr = *(const LAS bf16x8*)(T11t + c32 * TT_LD + 16 * s + 8 * hf); x = MFMA32(af, bfr, x); }
                f32x16 t21;
#pragma unroll
                for (int r = 0; r < 16; ++r) t21[r] = 0.f;
#pragma unroll
                for (int s = 0; s < 2; ++s) { const LAS bf16* tp = Tb + (32 + c32) * T_LD + 32 + 16 * s + 4 * hf; const v2u lo = *(const LAS v2u*)tp, hi = *(const LAS v2u*)(tp + 8);
                    const bf16x8 af = __builtin_bit_cast(bf16x8, (v4u){lo.x, lo.y, hi.x, hi.y}); const bf16x8 bfr = PACK8(x, s); t21 = MFMA32(af, bfr, t21); }
#pragma unroll
                for (int r = 0; r < 16; ++r) Tb[(32 + (r & 3) + 8 * (r >> 2) + 4 * hf) * T_LD + c32] = (bf16)(pkbf(-t21[r], 0.f) & 0xffffu);
            }
            RAW_BAR();
            }
            for (int rep_ = 0; rep_ < ((PREP_DUP & 8) ? 2 : 1); ++rep_) { if (rep_) RAW_BAR();
            if (wave < 4) {
#pragma unroll
                for (int mt = 0; mt < 2; ++mt) { f32x16 d;
#pragma unroll
                    for (int r = 0; r < 16; ++r) d[r] = 0.f;
#pragma unroll
                    for (int s = 0; s < 4; ++s) if (s < 2 * (mt + 1)) { const bf16x8 af = *(const LAS bf16x8*)(Tb + (32 * mt + c32) * T_LD + 16 * s + 8 * hf), bfr = *(const LAS bf16x8*)(Vt + (32 * wave + c32) * T_LD + 16 * s + 8 * hf); d = MFMA32(af, bfr, d); }
                    bf16* up = uimg + ((size_t)(wave * 2 + mt) * 64 + lane) * 16; *(bf16x8*)up = PACK8(d, 0); *(bf16x8*)(up + 8) = PACK8(d, 1); } }
            else { const int ct = wave - 4;
#pragma unroll
                for (int nt = 0; nt < 2; ++nt) { f32x16 d;
#pragma unroll
                    for (int r = 0; r < 16; ++r) d[r] = 0.f;
#pragma unroll
                    for (int s = 0; s < 4; ++s) if (s < 2 * (nt + 1)) { const bf16x8 af = *(const LAS bf16x8*)(Kt + (32 * ct + c32) * T_LD + 16 * s + 8 * hf), bfr = *(const LAS bf16x8*)(Tb + (32 * nt + c32) * T_LD + 16 * s + 8 * hf); d = MFMA32(af, bfr, d); }
#pragma unroll
                    for (int r = 0; r < 16; ++r) d[r] = -d[r];
#pragma unroll
                    for (int sp = 0; sp < 2; ++sp) *(bf16x8*)(img + ((size_t)(FR_WN + nt * 8 + 2 * ct + sp) * 64 + lane) * 8) = PACK8(d, sp); } }
            }
            if (tid == 0) CD[chd] = egam[63];
            RAW_BAR();
        }
#undef PREP_LOADRAW
    }
}

__host__ __device__ constexpr int sc_p(int k) { const int j = k - 32; return j < 12 ? j % 6 : (j - 12) % 5; }
__host__ __device__ constexpr int sc_slab(int k) { const int j = k - 32; return k < 32 ? (k >> 2) : (j < 12 ? j / 6 : 2 + (j - 12) / 5); }
__host__ __device__ constexpr int sc_kind(int k) { return k < 32 ? ((k & 3) < 2 ? 0 : 1) : ((sc_p(k) == 2 || sc_p(k) == 5) ? 1 : 2); }
__host__ __device__ constexpr int sc_idx(int k) { return k < 32 ? (k & 1) : (sc_p(k) == 0 ? 0 : sc_p(k) == 1 ? 1 : sc_p(k) == 2 ? 1 : sc_p(k) == 3 ? 2 : sc_p(k) == 4 ? 3 : 0); }
__host__ __device__ constexpr int sc_frag(int k) { return k < 32 ? (((k & 3) < 2 ? FR_WN : FR_QD) + (k & 1) * 8 + (k >> 2)) : (sc_kind(k) == 1 ? FR_AQK + sc_idx(k) * 4 + sc_slab(k) : FR_KDT + sc_idx(k) * 4 + sc_slab(k)); }
constexpr int SC_QD = 8;
constexpr int SCB = 57344, OT_OFF = 2 * SCB, OT_LD = 136, OT_BYTES = 64 * OT_LD * 2;
static_assert(OT_OFF + 2 * OT_BYTES <= 152 * 1024, "scan LDS");
__device__ __forceinline__ void phase_dn_scan(const Frame& F0, const Args& a, int layer, int unit) {
    PHASE_FRAME(F0);
    unsigned char* ws = OPQ_G(unsigned char, a.ws);
    LAS unsigned char* lds = F.lds;
    const int b = unit >> 3, h = unit & 7, lane = F.lane;
    const bf16* IMG = (const bf16*)(ws + WS_IMG); const bf16* UIMG = (const bf16*)(ws + WS_UIMG); const float* CD = (const float*)(ws + WS_CD);
    const size_t chd0 = (size_t)b * NCH * NH + h;
    if (F.wave < 4) {
#ifndef SCAN_NO_COMPUTE
        const int w = F.wave, c32 = lane & 31, hf = lane >> 5;
        f32x16 S0, S1, S2, S3;
#pragma unroll
        for (int r = 0; r < 16; ++r) { S0[r] = 0.f; S1[r] = 0.f; S2[r] = 0.f; S3[r] = 0.f; }
        const float cdl = CD[chd0 + (size_t)lane * NH];
        v4u UA[4];
        const __amdgpu_buffer_rsrc_t rsU = __builtin_amdgcn_make_buffer_rsrc((void*)(UIMG + chd0 * UIMG_ELEMS), (short)0, NCH * NH * UIMG_ELEMS * 2, 0x00020000);
        const unsigned uoff = (unsigned)((w * 2) * 64 + lane) * 32u;
#define SC_LOADU(dst, nn) do { _Pragma("unroll") for (int mt_ = 0; mt_ < 2; ++mt_) { _Pragma("unroll") for (int hh_ = 0; hh_ < 2; ++hh_) dst[2 * mt_ + hh_] = __builtin_amdgcn_raw_buffer_load_b128(rsU, uoff + (unsigned)(mt_ * 2048 + hh_ * 16), (unsigned)(nn) * (unsigned)(NH * UIMG_ELEMS * 2), 0); } } while (0)
#define SC_FRAG(bufoff, fi) (*(const LAS bf16x8*)(lds + (bufoff) + (fi) * 1024 + lane * 16))
#define SC_CHUNK(nn, U, bufoff, otoff) do { \
        f32x16 aV0, aV1, aO0, aO1; bf16x8 fq0, fq1, fq2, fq3, fq4, fq5, fq6, fq7, Sbs, Vb0, Vb1, Vb2, Vb3; \
        _Pragma("unroll") for (int q = 0; q < 4; ++q) { aV0[2 * q] = bflo(U[0][q]); aV0[2 * q + 1] = bfhi(U[0][q]); aV0[8 + 2 * q] = bflo(U[1][q]); aV0[8 + 2 * q + 1] = bfhi(U[1][q]); \
            aV1[2 * q] = bflo(U[2][q]); aV1[2 * q + 1] = bfhi(U[2][q]); aV1[8 + 2 * q] = bflo(U[3][q]); aV1[8 + 2 * q + 1] = bfhi(U[3][q]); } \
        _Pragma("unroll") for (int r = 0; r < 16; ++r) { aO0[r] = 0.f; aO1[r] = 0.f; } \
        if ((nn) + 1 < NCH) SC_LOADU(U, (nn) + 1); \
        const float cd = __builtin_bit_cast(float, __builtin_amdgcn_readlane(__builtin_bit_cast(int, cdl), (nn))); \
        fq0 = SC_FRAG(bufoff, 0); \
        fq1 = SC_FRAG(bufoff, 8); \
        fq2 = SC_FRAG(bufoff, 16); \
        fq3 = SC_FRAG(bufoff, 24); \
        fq4 = SC_FRAG(bufoff, 1); \
        fq5 = SC_FRAG(bufoff, 9); \
        fq6 = SC_FRAG(bufoff, 17); \
        fq7 = SC_FRAG(bufoff, 25); \
        Sbs = PACK8(S0, 0); \
        aV0 = MFMA32(fq0, Sbs, aV0); \
        fq0 = SC_FRAG(bufoff, 2); \
        aV1 = MFMA32(fq1, Sbs, aV1); \
        fq1 = SC_FRAG(bufoff, 10); \
        aO0 = MFMA32(fq2, Sbs, aO0); \
        fq2 = SC_FRAG(bufoff, 18); \
        aO1 = MFMA32(fq3, Sbs, aO1); \
        fq3 = SC_FRAG(bufoff, 26); \
        Sbs = PACK8(S0, 1); \
        aV0 = MFMA32(fq4, Sbs, aV0); \
        fq4 = SC_FRAG(bufoff, 3); \
        aV1 = MFMA32(fq5, Sbs, aV1); \
        fq5 = SC_FRAG(bufoff, 11); \
        aO0 = MFMA32(fq6, Sbs, aO0); \
        fq6 = SC_FRAG(bufoff, 19); \
        aO1 = MFMA32(fq7, Sbs, aO1); \
        fq7 = SC_FRAG(bufoff, 27); \
        Sbs = PACK8(S1, 0); \
        aV0 = MFMA32(fq0, Sbs, aV0); \
        fq0 = SC_FRAG(bufoff, 4); \
        aV1 = MFMA32(fq1, Sbs, aV1); \
        fq1 = SC_FRAG(bufoff, 12); \
        aO0 = MFMA32(fq2, Sbs, aO0); \
        fq2 = SC_FRAG(bufoff, 20); \
        aO1 = MFMA32(fq3, Sbs, aO1); \
        fq3 = SC_FRAG(bufoff, 28); \
        Sbs = PACK8(S1, 1); \
        aV0 = MFMA32(fq4, Sbs, aV0); \
        fq4 = SC_FRAG(bufoff, 5); \
        aV1 = MFMA32(fq5, Sbs, aV1); \
        fq5 = SC_FRAG(bufoff, 13); \
        aO0 = MFMA32(fq6, Sbs, aO0); \
        fq6 = SC_FRAG(bufoff, 21); \
        aO1 = MFMA32(fq7, Sbs, aO1); \
        fq7 = SC_FRAG(bufoff, 29); \
        Sbs = PACK8(S2, 0); \
        aV0 = MFMA32(fq0, Sbs, aV0); \
        fq0 = SC_FRAG(bufoff, 6); \
        aV1 = MFMA32(fq1, Sbs, aV1); \
        fq1 = SC_FRAG(bufoff, 14); \
        aO0 = MFMA32(fq2, Sbs, aO0); \
        fq2 = SC_FRAG(bufoff, 22); \
        aO1 = MFMA32(fq3, Sbs, aO1); \
        fq3 = SC_FRAG(bufoff, 30); \
        Sbs = PACK8(S2, 1); \
        aV0 = MFMA32(fq4, Sbs, aV0); \
        fq4 = SC_FRAG(bufoff, 7); \
        aV1 = MFMA32(fq5, Sbs, aV1); \
        fq5 = SC_FRAG(bufoff, 15); \
        aO0 = MFMA32(fq6, Sbs, aO0); \
        fq6 = SC_FRAG(bufoff, 23); \
        aO1 = MFMA32(fq7, Sbs, aO1); \
        fq7 = SC_FRAG(bufoff, 31); \
        Sbs = PACK8(S3, 0); \
        aV0 = MFMA32(fq0, Sbs, aV0); \
        fq0 = SC_FRAG(bufoff, 40); \
        aV1 = MFMA32(fq1, Sbs, aV1); \
        fq1 = SC_FRAG(bufoff, 44); \
        aO0 = MFMA32(fq2, Sbs, aO0); \
        fq2 = SC_FRAG(bufoff, 36); \
        aO1 = MFMA32(fq3, Sbs, aO1); \
        fq3 = SC_FRAG(bufoff, 48); \
        Sbs = PACK8(S3, 1); \
        aV0 = MFMA32(fq4, Sbs, aV0); \
        fq4 = SC_FRAG(bufoff, 52); \
        aV1 = MFMA32(fq5, Sbs, aV1); \
        fq5 = SC_FRAG(bufoff, 32); \
        S0 = S0 * cd; S1 = S1 * cd; S2 = S2 * cd; S3 = S3 * cd; \
        aO0 = MFMA32(fq6, Sbs, aO0); \
        fq6 = SC_FRAG(bufoff, 41); \
        aO1 = MFMA32(fq7, Sbs, aO1); \
        fq7 = SC_FRAG(bufoff, 45); \
        Vb0 = PACK8(aV0, 0); Vb1 = PACK8(aV0, 1); Vb2 = PACK8(aV1, 0); Vb3 = PACK8(aV1, 1); \
        S0 = MFMA32(fq0, Vb0, S0); \
        fq0 = SC_FRAG(bufoff, 37); \
        S1 = MFMA32(fq1, Vb0, S1); \
        fq1 = SC_FRAG(bufoff, 49); \
        aO1 = MFMA32(fq2, Vb0, aO1); \
        fq2 = SC_FRAG(bufoff, 53); \
        S2 = MFMA32(fq3, Vb0, S2); \
        fq3 = SC_FRAG(bufoff, 33); \
        S3 = MFMA32(fq4, Vb0, S3); \
        fq4 = SC_FRAG(bufoff, 42); \
        aO0 = MFMA32(fq5, Vb0, aO0); \
        fq5 = SC_FRAG(bufoff, 46); \
        S0 = MFMA32(fq6, Vb1, S0); \
        fq6 = SC_FRAG(bufoff, 38); \
        S1 = MFMA32(fq7, Vb1, S1); \
        fq7 = SC_FRAG(bufoff, 50); \
        aO1 = MFMA32(fq0, Vb1, aO1); \
        fq0 = SC_FRAG(bufoff, 54); \
        S2 = MFMA32(fq1, Vb1, S2); \
        fq1 = SC_FRAG(bufoff, 43); \
        S3 = MFMA32(fq2, Vb1, S3); \
        fq2 = SC_FRAG(bufoff, 47); \
        aO0 = MFMA32(fq3, Vb1, aO0); \
        fq3 = SC_FRAG(bufoff, 39); \
        S0 = MFMA32(fq4, Vb2, S0); \
        fq4 = SC_FRAG(bufoff, 51); \
        S1 = MFMA32(fq5, Vb2, S1); \
        fq5 = SC_FRAG(bufoff, 55); \
        aO1 = MFMA32(fq6, Vb2, aO1); \
        S2 = MFMA32(fq7, Vb2, S2); \
        S3 = MFMA32(fq0, Vb2, S3); \
        S0 = MFMA32(fq1, Vb3, S0); \
        S1 = MFMA32(fq2, Vb3, S1); \
        aO1 = MFMA32(fq3, Vb3, aO1); \
        S2 = MFMA32(fq4, Vb3, S2); \
        S3 = MFMA32(fq5, Vb3, S3); \
        _Pragma("unroll") for (int r = 0; r < 16; ++r) { \
            *(LAS bf16*)(lds + (otoff) + (((r & 3) + 8 * (r >> 2) + 4 * hf) * OT_LD + 32 * w + c32) * 2) = (bf16)(pkbf(aO0[r], 0.f) & 0xffffu); \
            *(LAS bf16*)(lds + (otoff) + ((32 + (r & 3) + 8 * (r >> 2) + 4 * hf) * OT_LD + 32 * w + c32) * 2) = (bf16)(pkbf(aO1[r], 0.f) & 0xffffu); } \
        RAW_BAR(); } while (0)
        SC_LOADU(UA, 0);
        RAW_BAR();
#pragma unroll 1
        for (int n = 0; n < NCH; n += 2) { SC_CHUNK(n, UA, 0, OT_OFF); SC_CHUNK(n + 1, UA, SCB, OT_OFF + OT_BYTES); }
#undef SC_CHUNK
#undef SC_FRAG
#undef SC_LOADU
#endif
    } else {
#ifndef SCAN_NO_HELPER
        const int ht = F.tid - 256, tok = ht >> 2, q = ht & 3;
        bf16* OB = FP8_PD ? (bf16*)((unsigned char*)a.out + 64 * MiB) : (bf16*)(ws + WS_MIXIN); const int old_ = FP8_PD ? DNW : D;
        v4u RA[14], RB[14];
        const __amdgpu_buffer_rsrc_t rsI = __builtin_amdgcn_make_buffer_rsrc((void*)(IMG + chd0 * IMG_ELEMS), (short)0, NCH * NH * IMG_ELEMS * 2, 0x00020000);
#define SH_LOADIMG(dst, nn) do { _Pragma("unroll") for (int i_ = 0; i_ < 14; ++i_) dst[i_] = __builtin_amdgcn_raw_buffer_load_b128(rsI, (unsigned)ht * 16u, (unsigned)(nn) * (unsigned)(NH * IMG_ELEMS * 2) + (unsigned)i_ * 4096u, 0); } while (0)
#define SH_STOREIMG(src, bufoff) do { LAS v4u* p_ = (LAS v4u*)(lds + (bufoff)) + ht; _Pragma("unroll") for (int i_ = 0; i_ < 14; ++i_) p_[i_ * 256] = src[i_]; } while (0)
#define SH_EPI(mm, otoff) do { const LAS v4u* op_ = (const LAS v4u*)(lds + (otoff) + (tok * OT_LD + 32 * q) * 2); \
        v4u* yp_ = (v4u*)(OB + ((size_t)b * SEQ + (size_t)(mm) * CH + tok) * old_ + h * HD + 32 * q); \
        _Pragma("unroll") for (int i_ = 0; i_ < 4; ++i_) yp_[i_] = op_[i_]; } while (0)
#define SH_STEP(nn, Rcur, Rnext, bufnext, otprev) do { \
        if ((nn) + 2 < NCH) SH_LOADIMG(Rcur, (nn) + 2); \
        if ((nn) >= 1) SH_EPI((nn) - 1, otprev); \
        if ((nn) + 1 < NCH) SH_STOREIMG(Rnext, bufnext); \
        RAW_BAR(); } while (0)
        SH_LOADIMG(RA, 0); SH_LOADIMG(RB, 1);
        SH_STOREIMG(RA, 0);
        RAW_BAR();
#pragma unroll 1
        for (int n = 0; n < NCH; n += 2) { SH_STEP(n, RA, RB, SCB, OT_OFF + OT_BYTES); SH_STEP(n + 1, RB, RA, 0, OT_OFF); }
        SH_EPI(NCH - 1, OT_OFF + OT_BYTES);
#undef SH_STEP
#undef SH_EPI
#undef SH_STOREIMG
#undef SH_LOADIMG
#endif
    }
}

__device__ __forceinline__ void phase_dn_norm(const Frame& F0, const Args& a, int layer) {
    PHASE_FRAME(F0);
    unsigned char* ws = OPQ_G(unsigned char, a.ws);
    const bf16* PROJ = (const bf16*)(ws + WS_PROJ); bf16* MIXIN = (bf16*)(ws + WS_MIXIN);
    const bf16* OSRC = FP8_PD ? (const bf16*)((unsigned char*)a.out + 64 * MiB) : (const bf16*)(ws + WS_MIXIN); const int old_ = FP8_PD ? DNW : D;
    const int lane = F.lane, gw = F.vcu * NWAVES + F.wave, NGW = F.G * NWAVES;
    const float* nw = a.in[I_NORMW] + layer * HD + 16 * (lane & 7); f32x4 nwv[4];
#pragma unroll
    for (int i = 0; i < 4; ++i) nwv[i] = *(const f32x4*)(nw + 4 * i);
    v4u OA[2], ZA[2], OB[2], ZB[2];
#define DNN_LOAD(O_, Z_, t) do { const v4u* op_ = (const v4u*)(OSRC + (size_t)(t) * old_ + 16 * lane); const v4u* zp_ = (const v4u*)(PROJ + (size_t)(t) * NPROJ + 3072 + 16 * lane); O_[0] = op_[0]; O_[1] = op_[1]; Z_[0] = zp_[0]; Z_[1] = zp_[1]; } while (0)
#define DNN_ROW(O_, Z_, t) do { float ss = 0.f; \
        _Pragma("unroll") for (int i = 0; i < 2; ++i) _Pragma("unroll") for (int j = 0; j < 4; ++j) { const float x0 = bflo(O_[i][j]), x1 = bfhi(O_[i][j]); ss += x0 * x0 + x1 * x1; } \
        ss = row8_sum(ss); const float rr = 1.0f / sqrtf(ss * (1.0f / HD) + RMS_EPS); \
        v4u* yp_ = (v4u*)(MIXIN + (size_t)(t) * D + 16 * lane); float yv_[16]; \
        _Pragma("unroll") for (int i = 0; i < 2; ++i) { _Pragma("unroll") for (int j = 0; j < 4; ++j) { const float z0 = bflo(Z_[i][j]), z1 = bfhi(Z_[i][j]); const f32x4 nn = nwv[2 * i + (j >> 1)]; \
            yv_[8 * i + 2 * j] = bflo(O_[i][j]) * rr * nn[2 * (j & 1)] * z0 * sigmoidf_(z0); yv_[8 * i + 2 * j + 1] = bfhi(O_[i][j]) * rr * nn[2 * (j & 1) + 1] * z1 * sigmoidf_(z1); } } \
        if (FP8_PD) { v4u o8_; _Pragma("unroll") for (int q4 = 0; q4 < 4; ++q4) o8_[q4] = pk4_fp8(yv_[4 * q4] * F8_XS, yv_[4 * q4 + 1] * F8_XS, yv_[4 * q4 + 2] * F8_XS, yv_[4 * q4 + 3] * F8_XS); *(v4u*)((unsigned char*)MIXIN + (size_t)(t) * D + 16 * lane) = o8_; } \
        else { _Pragma("unroll") for (int i = 0; i < 2; ++i) { v4u o_; _Pragma("unroll") for (int j = 0; j < 4; ++j) o_[j] = pkbf(yv_[8 * i + 2 * j], yv_[8 * i + 2 * j + 1]); yp_[i] = o_; } } } while (0)
    if (gw < T) DNN_LOAD(OA, ZA, gw);
#pragma unroll 1
    for (int t = gw; t < T; t += 2 * NGW) {
        if (t + NGW < T) DNN_LOAD(OB, ZB, t + NGW);
        DNN_ROW(OA, ZA, t);
        if (t + 2 * NGW < T) DNN_LOAD(OA, ZA, t + 2 * NGW);
        if (t + NGW < T) DNN_ROW(OB, ZB, t + NGW);
    }
#undef DNN_LOAD
#undef DNN_ROW
}

__device__ __forceinline__ void phase_ln1_router(const Frame& F0, const Args& a, int layer, int probe = 0, int f8 = 0) {
    PHASE_FRAME(F0);
    unsigned char* ws = OPQ_G(unsigned char, a.ws);
    LAS float* WRt = (LAS float*)F.lds;
    LAS float* GV = (LAS float*)(F.lds + RING_BYTES);
    LAS int* rowE = (LAS int*)(F.lds + AUX_OFF); LAS int* rowP = rowE + 128; LAS float* rowG = (LAS float*)(rowP + 128); LAS int* lcnt = (LAS int*)(rowG + 128); LAS int* lbase = lcnt + 16;
    const float* wr = OPQ_G(const float, a.in[I_WR]); const float* br = OPQ_G(const float, a.in[I_BR]);
    for (int idx = F.tid; idx < D * NE; idx += 512) WRt[(idx & 15) * D + (idx >> 4)] = wr[idx];
    { const float* g1 = a.in[I_LN1G] + (size_t)layer * D; const float* b1 = a.in[I_LN1B] + (size_t)layer * D; for (int i = F.tid; i < D; i += 512) { GV[i] = g1[i]; GV[D + i] = b1[i]; } }
    const bf16* PRE = (const bf16*)a.out; bf16* X1B = (bf16*)(ws + (probe ? WS_R1 : WS_X1B)); float* STATS = (float*)(ws + (probe ? WS_R1 + 70 * MiB : WS_STATS));
    int* LIST = (int*)(ws + (probe ? WS_R1 + 72 * MiB : WS_LIST)); int* TOKSLOT = (int*)(ws + (probe ? WS_R1 + 80 * MiB : WS_TOKSLOT)); float* GATEW = (float*)(ws + (probe ? WS_R1 + 82 * MiB : WS_GATEW));
    gu32* cnt = F.ctl + CW_CNT + 64 * (layer + (probe ? 2 : 0));
    const int lane = F.lane; const float brl = br[lane & 15];
    for (int rb = F.vcu; rb < T / 64; rb += F.G) {
        if (F.tid < 16) lcnt[F.tid] = 0;
        __syncthreads();
        v2u XA[8], XB_[8];
#define PE_LOAD(X, r) do { const GAS v2u* xr_ = (const GAS v2u*)(PRE + (size_t)(rb * 64 + F.wave * 8 + (r)) * D) + lane; _Pragma("unroll") for (int j = 0; j < 8; ++j) X[j] = xr_[64 * j]; } while (0)
#define PE_ROW(X, r) do { const int lr = F.wave * 8 + (r), row = rb * 64 + lr; unsigned gvo_ = (unsigned)(uintptr_t)GV; asm volatile("" : "+v"(gvo_)); const LAS float* GVr = (const LAS float*)(uintptr_t)gvo_; \
            f32x4 v[8]; float s = 0.f; \
            _Pragma("unroll") for (int j = 0; j < 8; ++j) { v[j] = (f32x4){bflo(X[j].x), bfhi(X[j].x), bflo(X[j].y), bfhi(X[j].y)}; s += (v[j][0] + v[j][1]) + (v[j][2] + v[j][3]); } \
            const float mean = wave_sum(s) * (1.f / D); float s2 = 0.f; \
            _Pragma("unroll") for (int j = 0; j < 8; ++j) { v[j] = v[j] - mean; s2 += (v[j][0] * v[j][0] + v[j][1] * v[j][1]) + (v[j][2] * v[j][2] + v[j][3] * v[j][3]); } \
            const float rstd = 1.f / sqrtf(wave_sum(s2) * (1.f / D) + LN_EPS); \
            if (lane == 0) { STATS[2 * row] = mean; STATS[2 * row + 1] = rstd; } \
            GAS v2u* o8 = (GAS v2u*)(X1B + (size_t)row * D) + lane; \
            f32x2 lg2[16]; \
            _Pragma("unroll") for (int e = 0; e < 16; ++e) lg2[e] = (f32x2){0.f, 0.f}; \
            _Pragma("unroll") for (int j = 0; j < 8; ++j) { const f32x4 gg = *(const LAS f32x4*)(GVr + 256 * j + 4 * lane), bb = *(const LAS f32x4*)(GVr + D + 256 * j + 4 * lane); \
                v[j] = v[j] * rstd * gg + bb; \
                if (f8) ((GAS unsigned*)((GAS unsigned char*)X1B + (size_t)row * D) + lane)[64 * j] = pk4_fp8(v[j][0] * F8_XS, v[j][1] * F8_XS, v[j][2] * F8_XS, v[j][3] * F8_XS); \
                else { v2u w; w.x = pkbf(v[j][0], v[j][1]); w.y = pkbf(v[j][2], v[j][3]); o8[64 * j] = w; } \
                const f32x2 vlo = {v[j][0], v[j][1]}, vhi = {v[j][2], v[j][3]}; \
                _Pragma("unroll") for (int e = 0; e < 16; ++e) { const f32x4 w4 = *(const LAS f32x4*)(WRt + e * D + 256 * j + 4 * lane); \
                    lg2[e] = __builtin_elementwise_fma(vlo, (f32x2){w4[0], w4[1]}, lg2[e]); lg2[e] = __builtin_elementwise_fma(vhi, (f32x2){w4[2], w4[3]}, lg2[e]); } } \
            float lg[16]; \
            _Pragma("unroll") for (int e = 0; e < 16; ++e) lg[e] = lg2[e][0] + lg2[e][1]; \
              \
            float t8[8], t4[4], t2[2], t1; \
            { const bool hi = (lane & 8) != 0; _Pragma("unroll") for (int i = 0; i < 8; ++i) { const float snd = hi ? lg[i] : lg[8 + i], kp = hi ? lg[8 + i] : lg[i]; t8[i] = kp + dpp_<DPP_XOR8>(snd); } } \
            { const bool hi = (lane & 4) != 0; _Pragma("unroll") for (int i = 0; i < 4; ++i) { const float snd = hi ? t8[i] : t8[4 + i], kp = hi ? t8[4 + i] : t8[i]; t4[i] = kp + dpp_<DPP_HMIRROR>(snd); } } \
            { const bool hi = (lane & 2) != 0; _Pragma("unroll") for (int i = 0; i < 2; ++i) { const float snd = hi ? t4[i] : t4[2 + i], kp = hi ? t4[2 + i] : t4[i]; t2[i] = kp + dpp_<DPP_XOR2>(snd); } } \
            { const bool hi = (lane & 1) != 0; const float snd = hi ? t2[0] : t2[1], kp = hi ? t2[1] : t2[0]; t1 = kp + dpp_<DPP_XOR1>(snd); } \
            t1 = xrow16_sum(t1) + brl; \
            float lgu[16]; float mx = -3.0e38f; \
            _Pragma("unroll") for (int e = 0; e < 16; ++e) { lgu[e] = __builtin_bit_cast(float, __builtin_amdgcn_readlane(__builtin_bit_cast(int, t1), e)); mx = fmaxf(mx, lgu[e]); } \
            float p[16]; \
            _Pragma("unroll") for (int e = 0; e < 16; ++e) p[e] = __expf(lgu[e] - mx); \
            float gsc[4]; \
            _Pragma("unroll") for (int g = 0; g < 4; ++g) { const float a0 = p[4 * g], a1 = p[4 * g + 1], a2 = p[4 * g + 2], a3 = p[4 * g + 3]; \
                const float hi1 = fmaxf(a0, a1), lo1 = fminf(a0, a1), hi2 = fmaxf(a2, a3), lo2 = fminf(a2, a3); \
                gsc[g] = fmaxf(hi1, hi2) + fmaxf(fminf(hi1, hi2), fmaxf(lo1, lo2)); } \
            int gsel = 0; float best = gsc[0]; \
            _Pragma("unroll") for (int g = 1; g < 4; ++g) if (gsc[g] > best) { best = gsc[g]; gsel = g; } \
            float q[4]; \
            _Pragma("unroll") for (int j = 0; j < 4; ++j) q[j] = gsel == 0 ? p[j] : (gsel == 1 ? p[4 + j] : (gsel == 2 ? p[8 + j] : p[12 + j])); \
            int i0 = 0; float p0 = q[0]; \
            _Pragma("unroll") for (int j = 1; j < 4; ++j) if (q[j] > p0) { p0 = q[j]; i0 = j; } \
            int i1 = -1; float p1 = -1.f; \
            _Pragma("unroll") for (int j = 0; j < 4; ++j) if (j != i0 && q[j] > p1) { p1 = q[j]; i1 = j; } \
            if (lane == 0) { const int e0 = gsel * 4 + i0, e1 = gsel * 4 + i1; const float inv = 1.0f / (p0 + p1); \
                rowE[2 * lr] = e0; rowE[2 * lr + 1] = e1; rowG[2 * lr] = p0 * inv; rowG[2 * lr + 1] = p1 * inv; \
                rowP[2 * lr] = __hip_atomic_fetch_add(&lcnt[e0], 1, __ATOMIC_RELAXED, __HIP_MEMORY_SCOPE_WORKGROUP); rowP[2 * lr + 1] = __hip_atomic_fetch_add(&lcnt[e1], 1, __ATOMIC_RELAXED, __HIP_MEMORY_SCOPE_WORKGROUP); } } while (0)
        PE_LOAD(XA, 0);
#pragma unroll 1
        for (int r = 0; r < 8; r += 2) { PE_LOAD(XB_, r + 1); PE_ROW(XA, r); if (r + 2 < 8) PE_LOAD(XA, r + 2); PE_ROW(XB_, r + 1); }
#undef PE_LOAD
#undef PE_ROW
        __syncthreads();
        if (F.tid < 16) lbase[F.tid] = (int)__hip_atomic_fetch_add(cnt + F.tid, (unsigned)lcnt[F.tid], RLX_AGENT);
        __syncthreads();
        if (F.tid < 128) { const int e = rowE[F.tid], pos = lbase[e] + rowP[F.tid], tok = rb * 64 + (F.tid >> 1);
            LIST[(size_t)e * LCAP + pos] = tok; TOKSLOT[2 * tok + (F.tid & 1)] = e * LCAP + pos; GATEW[2 * tok + (F.tid & 1)] = rowG[F.tid]; }
        __syncthreads();
    }
}
__device__ __forceinline__ void moe_table(const Frame& F0, int layer) {
    PHASE_FRAME(F0);
    LAS int* tab = (LAS int*)(F.lds + AUX_OFF);
    __syncthreads();
    if (F.tid < 16) tab[32 + F.tid] = (int)__hip_atomic_load(F.ctl + CW_CNT + 64 * layer + F.tid, RLX_AGENT);
    __syncthreads();
    if (F.tid == 0) { int blk = 0, nf = 0, nh = 0; for (int e = 0; e < 16; ++e) { const int cn = tab[32 + e]; tab[e] = blk; tab[48 + e] = nf; tab[80 + e] = nh; blk += (cn + 127) >> 7; nf += cn >> 8; nh += ((cn & 255) + 127) >> 7; } tab[16] = blk; tab[64] = nf; tab[96] = nh; }
    __syncthreads();
}
__device__ __forceinline__ void phase_combine_ln2(const Frame& F0, const Args& a, int layer, int probe = 0, int f8 = 0) {
    PHASE_FRAME(F0);
    unsigned char* ws = OPQ_G(unsigned char, a.ws); const LAS int* tab = (const LAS int*)(F.lds + AUX_OFF);
    const bf16* PRE = (const bf16*)a.out; const float* STATS = (const float*)(ws + WS_STATS); const bf16* Y = (const bf16*)(ws + WS_Y); bf16* X2B = (bf16*)(ws + (probe ? WS_R1 : WS_X2B)); unsigned char* X2F8 = ws + WS_X2F8;
    const int* TOKSLOT = (const int*)(ws + WS_TOKSLOT); const float* GATEW = (const float*)(ws + WS_GATEW);
    LAS float* GV = (LAS float*)F.lds;
    { const float* g1 = a.in[I_LN1G] + (size_t)layer * D; const float* b1 = a.in[I_LN1B] + (size_t)layer * D; const float* g2 = a.in[I_LN2G] + (size_t)layer * D; const float* b2 = a.in[I_LN2B] + (size_t)layer * D;
        for (int i = F.tid; i < D; i += 512) { GV[i] = g1[i]; GV[D + i] = b1[i]; GV[2 * D + i] = g2[i]; GV[3 * D + i] = b2[i]; } }
    __syncthreads();
    const int gw = F.vcu * NWAVES + F.wave, NGW = F.G * NWAVES, nrows = (T - gw + NGW - 1) / NGW, lane = F.lane;
    for (int base = 0; base < nrows; base += 64) {
        const int nr = (nrows - base) < 64 ? (nrows - base) : 64;
        float m_mean = 0.f, m_rstd = 0.f, m_w0 = 0.f, m_w1 = 0.f; int m_y0 = 0, m_y1 = 0;
        if (lane < nr) { const int row = gw + NGW * (base + lane); m_mean = STATS[2 * row]; m_rstd = STATS[2 * row + 1]; m_w0 = GATEW[2 * row]; m_w1 = GATEW[2 * row + 1];
            const int s0 = TOKSLOT[2 * row], s1 = TOKSLOT[2 * row + 1]; m_y0 = tab[s0 / LCAP] * 128 + (s0 % LCAP); m_y1 = tab[s1 / LCAP] * 128 + (s1 % LCAP); }
        v2u XA[8], PA[8], QA[8], XB_[8], PB_[8], QB_[8];
#define PH_LOAD(X, P, Q, i) do { const int row_ = gw + NGW * (base + (i)); const size_t y0_ = (size_t)__builtin_amdgcn_readlane(m_y0, (i)), y1_ = (size_t)__builtin_amdgcn_readlane(m_y1, (i)); \
            const GAS v2u* xr_ = (const GAS v2u*)(PRE + (size_t)row_ * D) + lane; const GAS v2u* ya_ = (const GAS v2u*)(Y + y0_ * D) + lane; const GAS v2u* yb_ = (const GAS v2u*)(Y + y1_ * D) + lane; \
            _Pragma("unroll") for (int j = 0; j < 8; ++j) { X[j] = xr_[64 * j]; P[j] = ya_[64 * j]; Q[j] = yb_[64 * j]; } } while (0)
#define PH_ROW(X, P, Q, i) do { const int row_ = gw + NGW * (base + (i)); unsigned gvo_ = (unsigned)(uintptr_t)GV; asm volatile("" : "+v"(gvo_)); const LAS float* GVr = (const LAS float*)(uintptr_t)gvo_;     \
            const float mean = __builtin_bit_cast(float, __builtin_amdgcn_readlane(__builtin_bit_cast(int, m_mean), (i))), rstd = __builtin_bit_cast(float, __builtin_amdgcn_readlane(__builtin_bit_cast(int, m_rstd), (i))); \
            const float w0 = __builtin_bit_cast(float, __builtin_amdgcn_readlane(__builtin_bit_cast(int, m_w0), (i))), w1 = __builtin_bit_cast(float, __builtin_amdgcn_readlane(__builtin_bit_cast(int, m_w1), (i))); \
            f32x4 v[8]; float s = 0.f; \
            _Pragma("unroll") for (int j = 0; j < 8; ++j) { const f32x4 gg = *(const LAS f32x4*)(GVr + 256 * j + 4 * lane), bb = *(const LAS f32x4*)(GVr + D + 256 * j + 4 * lane); \
                const f32x4 x1 = ((f32x4){bflo(X[j].x), bfhi(X[j].x), bflo(X[j].y), bfhi(X[j].y)} - mean) * rstd * gg + bb; \
                f32x4 f; f[0] = w0 * bflo(P[j].x) + w1 * bflo(Q[j].x); f[1] = w0 * bfhi(P[j].x) + w1 * bfhi(Q[j].x); f[2] = w0 * bflo(P[j].y) + w1 * bflo(Q[j].y); f[3] = w0 * bfhi(P[j].y) + w1 * bfhi(Q[j].y); \
                v[j] = x1 * ALPHA + f; s += (v[j][0] + v[j][1]) + (v[j][2] + v[j][3]); } \
            const float m2 = wave_sum(s) * (1.f / D); float q = 0.f; \
            _Pragma("unroll") for (int j = 0; j < 8; ++j) { v[j] = v[j] - m2; q += (v[j][0] * v[j][0] + v[j][1] * v[j][1]) + (v[j][2] * v[j][2] + v[j][3] * v[j][3]); } \
            const float r2 = 1.f / sqrtf(wave_sum(q) * (1.f / D) + LN_EPS); \
            GAS v2u* o8 = (GAS v2u*)(X2B + (size_t)row_ * D) + lane; \
            _Pragma("unroll") for (int j = 0; j < 8; ++j) { const f32x4 gg = *(const LAS f32x4*)(GVr + 2 * D + 256 * j + 4 * lane), bb = *(const LAS f32x4*)(GVr + 3 * D + 256 * j + 4 * lane); \
                const f32x4 o = v[j] * r2 * gg + bb; v2u w; w.x = pkbf(o[0], o[1]); w.y = pkbf(o[2], o[3]); o8[64 * j] = w; \
                if (f8) ((GAS unsigned*)((GAS unsigned char*)X2F8 + (size_t)row_ * D) + lane)[64 * j] = pk4_fp8(o[0] * F8_XS, o[1] * F8_XS, o[2] * F8_XS, o[3] * F8_XS); } } while (0)
        PH_LOAD(XA, PA, QA, 0);
#pragma unroll 1
        for (int i = 0; i < nr; i += 2) {
            if (i + 1 < nr) PH_LOAD(XB_, PB_, QB_, i + 1);
            PH_ROW(XA, PA, QA, i);
            if (i + 2 < nr) PH_LOAD(XA, PA, QA, i + 2);
            if (i + 1 < nr) PH_ROW(XB_, PB_, QB_, i + 1);
        }
#undef PH_LOAD
#undef PH_ROW
    }
}

#ifndef MK_N_LAUNCHES
#define MK_N_LAUNCHES 1
#endif
constexpr int NPL = 10;
constexpr int NPHASE = 1 + NPL * DEPTH;
constexpr int N_LAUNCHES = MK_N_LAUNCHES;
static_assert(N_LAUNCHES == 1 || N_LAUNCHES == NPHASE, "MK_N_LAUNCHES is 1 or NPHASE");

#define GRID_BAR() do { if (N_LAUNCHES == 1) xcd_barrier(bar); } while (0)
#ifndef PH_MASK
#define PH_MASK 0x7ff
#endif
#define IN(k) ((((k) == 0 ? 1u : (2u << (((k) - 1) % NPL))) & (unsigned)(PH_MASK)) && lo <= (k) && (k) < hi)
#define SEAM(k) do { if (IN((k) + 1)) GRID_BAR(); } while (0)
#ifndef PROBE_DUP
#define PROBE_DUP 0
#endif
#define REPS(k) ((((k) == 0 ? 1u : (2u << (((k) - 1) % NPL))) & (unsigned)(PROBE_DUP)) ? 2 : 1)

template <int layer> __device__ __forceinline__ void layer_phases(const Frame& F, const Args& args, const XcdBarrier& bar, const int lo, const int hi) {
            const int pb = 1 + NPL * layer;
            unsigned char* ws = OPQ_G(unsigned char, args.ws);
            if (IN(pb + 0)) { for (int rep = 0; rep < REPS(pb + 0); ++rep) { if (rep) GRID_BAR();
                SchedDense S; S.init(T, NPROJ, F.G, (int)blockIdx.x, ws + WS_XB, D, (const bf16*)(ws + WS_WIN) + (size_t)layer * NPROJ * D, D);
                EpiBf16 E{(bf16*)(ws + WS_PROJ), NPROJ};
                pg8::gemm_phase<EpiBf16, SchedDense, false>(F.lds + RING_OFF, D, D, D, S, E);
                } SEAM(pb + 0);
            }
            if (IN(pb + 1)) { for (int rep = 0; rep < REPS(pb + 1); ++rep) { if (rep) GRID_BAR(); phase_dn_prep(F, args, layer); } SEAM(pb + 1); }
            if (IN(pb + 2)) { for (int rep = 0; rep < REPS(pb + 2); ++rep) { if (rep) GRID_BAR();
                if (blockIdx.x < 32 || F.G <= 32) { for (int u = blockIdx.x; u < NB * NH; u += (F.G < 32 ? F.G : 32)) { phase_dn_scan(F, args, layer, u);
#ifdef SCAN_TWICE
                    __syncthreads(); phase_dn_scan(F, args, layer, u);
#endif
                } }
                if (blockIdx.x >= 32 || F.G <= 32) { const int G2 = F.G <= 32 ? F.G : F.G - 32, c2 = F.G <= 32 ? (int)blockIdx.x : (int)blockIdx.x - 32;
                    { int t_ = threadIdx.x; asm volatile("" : "+v"(t_)); Frame Fp = F; Fp.tid = t_; Fp.lane = t_ & 63;
                      for (int L = c2; L < 256; L += G2) pool_diffs_unit(Fp, ws, L >> 2, L & 3);
                      asm volatile("s_waitcnt vmcnt(0)" ::: "memory"); __syncthreads(); }
                    { SchedPool S{G2, c2, (const char*)(ws + WS_POOLD), (const char*)((const bf16*)(ws + WS_WPOOL) + (size_t)layer * 4 * 65536)};
                      EpiPool E{(bf16*)(ws + WS_MIXIN), args.in[I_POOLS] + (size_t)layer * PW, FP8_PD};
                      pg8::gemm_phase<EpiPool, SchedPool, false>(F.lds + RING_OFF, 256, PW, 256, S, E); }
                    { SchedDense S; S.init(T, D, G2, c2, (const bf16*)(ws + WS_PB16) + (size_t)layer * T * PLE, PLE, (const bf16*)(ws + WS_WPP) + (size_t)layer * D * PLE, PLE);
                      EpiBf16 E{(bf16*)(ws + WS_PP), D};
                      pg8::gemm_phase<EpiBf16, SchedDense, false>(F.lds + RING_OFF, PLE, PLE, PLE, S, E); }
#ifndef CONVERT_ALL_IN_PROLOGUE
                    { int t_ = threadIdx.x; asm volatile("" : "+v"(t_)); const int per_ = F.G / 8 - 4, c2v_ = (F.G % 8 == 0 && F.G > 32) ? ((int)blockIdx.x % 8) * per_ + ((int)blockIdx.x / 8 - 4) : c2;
                  weight_items(args, ws, (LAS float*)(F.lds + RING_OFF + F.wave * 16384), t_ & 63, 1, layer, c2v_ * NWAVES + F.wave, G2 * NWAVES); }
#endif
                    }
                } SEAM(pb + 2);
            }
            if (IN(pb + 3)) { for (int rep = 0; rep < REPS(pb + 3); ++rep) { if (rep) GRID_BAR(); phase_dn_norm(F, args, layer); } SEAM(pb + 3); }
            if (IN(pb + 4)) { for (int rep = 0; rep < REPS(pb + 4); ++rep) { if (rep) GRID_BAR();
                if (FP8_PD) { SchedDense S; S.init(T, D, F.G, (int)blockIdx.x, ws + WS_MIXIN, D / 2, ws + WS_WOUT + (size_t)layer * D * D * 2, D / 2);
                    EpiRes E{(const bf16*)(ws + WS_XB), (bf16*)args.out, F8_INV};
                    pg8::gemm_phase<EpiRes, SchedDense, false, true>(F.lds + RING_OFF, D / 2, D / 2, D / 2, S, E); }
                else { SchedDense S; S.init(T, D, F.G, (int)blockIdx.x, ws + WS_MIXIN, D, (const bf16*)(ws + WS_WOUT) + (size_t)layer * D * D, D);
                EpiRes E{(const bf16*)(ws + WS_XB), (bf16*)args.out};
#ifdef PROBE_PD
                { EpiRes E2{(const bf16*)(ws + WS_XB), (bf16*)(ws + WS_R1)}; pg8::gemm_phase<EpiRes, SchedDense, false>(F.lds + RING_OFF, D, D, D, S, E2); }
#endif
                pg8::gemm_phase<EpiRes, SchedDense, false>(F.lds + RING_OFF, D, D, D, S, E); }
                } SEAM(pb + 4);
            }
            if (IN(pb + 5)) { for (int rep = 0; rep < REPS(pb + 5); ++rep) { if (rep) GRID_BAR();
#ifdef PROBE_PE
                phase_ln1_router(F, args, layer, 1); __syncthreads();
#endif
                phase_ln1_router(F, args, layer, 0, FP8_LAYER(layer) ? 1 : 0); } SEAM(pb + 5); }
            if (IN(pb + 6)) { for (int rep = 0; rep < REPS(pb + 6); ++rep) { if (rep) GRID_BAR();
                moe_table(F, layer);
                if (FP8_LAYER(layer)) {
                    SchedMoe S{F.G, (int)blockIdx.x, 0, (const LAS int*)(F.lds + AUX_OFF), (const char*)(ws + WS_X1B), (const char*)(ws + WS_WGU + (size_t)layer * NE * 2048 * D * 2), (const int*)(ws + WS_LIST), 1};
                    EpiSwiglu E{(bf16*)(ws + WS_HID), FP8_PG, F8_INV};
                    pg8::gemm_phase<EpiSwiglu, SchedMoe, true, true>(F.lds + RING_OFF, D / 2, D / 2, D / 2, S, E);
                } else {
                    SchedMoe S{F.G, (int)blockIdx.x, 0, (const LAS int*)(F.lds + AUX_OFF), (const char*)(ws + WS_X1B), (const char*)((const bf16*)(ws + WS_WGU) + (size_t)layer * NE * 2048 * D), (const int*)(ws + WS_LIST), 2};
                    EpiSwiglu E{(bf16*)(ws + WS_HID)};
                    pg8::gemm_phase<EpiSwiglu, SchedMoe, true>(F.lds + RING_OFF, D, D, D, S, E);
                }
                } SEAM(pb + 6);
            }
            if (IN(pb + 7)) { for (int rep = 0; rep < REPS(pb + 7); ++rep) { if (rep) GRID_BAR();
                moe_table(F, layer);
                if (FP8_PG && FP8_LAYER(layer)) {
                    SchedMoe S{F.G, (int)blockIdx.x, 1, (const LAS int*)(F.lds + AUX_OFF), (const char*)(ws + WS_HID), (const char*)(ws + WS_WD + (size_t)layer * NE * D * DE * 2), nullptr, 1};
                    EpiBf16 E{(bf16*)(ws + WS_Y), D, F8_INV};
                    pg8::gemm_phase<EpiBf16, SchedMoe, false, true>(F.lds + RING_OFF, DE / 2, DE / 2, DE / 2, S, E);
                } else {
                    SchedMoe S{F.G, (int)blockIdx.x, 1, (const LAS int*)(F.lds + AUX_OFF), (const char*)(ws + WS_HID), (const char*)((const bf16*)(ws + WS_WD) + (size_t)layer * NE * D * DE), nullptr, 2};
                    EpiBf16 E{(bf16*)(ws + WS_Y), D};
                    pg8::gemm_phase<EpiBf16, SchedMoe, false>(F.lds + RING_OFF, DE, DE, DE, S, E);
                }
                } SEAM(pb + 7);
            }
            if (IN(pb + 8)) { for (int rep = 0; rep < REPS(pb + 8); ++rep) { if (rep) GRID_BAR(); moe_table(F, layer);
#ifdef PROBE_PH
                phase_combine_ln2(F, args, layer, 1);
#endif
                phase_combine_ln2(F, args, layer, 0, (FP8_PI && (FP8_PI0 || layer == DEPTH - 1)) ? 1 : 0); } SEAM(pb + 8); }
            if (IN(pb + 9)) { for (int rep = 0; rep < REPS(pb + 9); ++rep) { if (rep) GRID_BAR();
                if (FP8_PI && (FP8_PI0 || layer == DEPTH - 1)) {
                    SchedDense S; S.init(T, D, F.G, (int)blockIdx.x, ws + WS_X2F8, D / 2, ws + WS_WPG + (size_t)layer * D * D * 2, D / 2);
                    EpiPle E{(const bf16*)(ws + WS_X2B), (const bf16*)(ws + WS_PP), (bf16*)(ws + WS_XB), args.out, layer + 1 < DEPTH ? 0 : 1, F8_INV};
                    pg8::gemm_phase<EpiPle, SchedDense, false, true>(F.lds + RING_OFF, D / 2, D / 2, D / 2, S, E);
                } else {
                    SchedDense S; S.init(T, D, F.G, (int)blockIdx.x, ws + WS_X2B, D, (const bf16*)(ws + WS_WPG) + (size_t)layer * D * D, D);
                    EpiPle E{(const bf16*)(ws + WS_X2B), (const bf16*)(ws + WS_PP), (bf16*)(ws + WS_XB), args.out, layer + 1 < DEPTH ? 0 : 1};
                    pg8::gemm_phase<EpiPle, SchedDense, false>(F.lds + RING_OFF, D, D, D, S, E);
                }
                } SEAM(pb + 9);
            }
}
__global__ void __launch_bounds__(NWAVES * 64, 2) trunk_fwd(Args args) {
    extern __shared__ __attribute__((aligned(16))) unsigned char lds[];
    Frame F;
    F.lds = (LAS unsigned char*)lds;
    F.MISC = (volatile LAS unsigned*)(F.lds + MISC_OFF);
    F.tid = threadIdx.x; F.lane = F.tid & 63; F.wave = __builtin_amdgcn_readfirstlane(F.tid >> 6);
    F.G = gridDim.x; { const int bx = blockIdx.x; F.vcu = (F.G % 8 == 0) ? (bx % 8) * (F.G / 8) + bx / 8 : bx; }
    unsigned char* ws = args.ws;
    F.ctl = (gu32*)(ws + WS_CTL);
    for (int u = F.tid; u < (LDS_BYTES - LDSCTL_OFF) / 4; u += NWAVES * 64) ((LAS unsigned*)(F.lds + LDSCTL_OFF))[u] = 0u;
    __syncthreads();
    XcdBarrier bar; bar.bar = (unsigned*)(F.ctl + CW_BAR); bar.x = 0; bar.st = nullptr;
    if (N_LAUNCHES == 1) bar = xcd_barrier_post((unsigned*)(F.ctl + CW_BAR), F.MISC + 8);
    const int lo = args.ph_lo, hi = args.ph_hi;
    if (IN(0)) { for (int rep = 0; rep < REPS(0); ++rep) { if (rep) GRID_BAR(); p0_prologue(F, args); } SEAM(0); }

    layer_phases<0>(F, args, bar, lo, hi);
    layer_phases<1>(F, args, bar, lo, hi);
    static_assert(DEPTH == 2, "layer_phases instantiations");
#undef IN
#undef SEAM
#undef GRID_BAR
}

extern "C" void kernel_launch(void* const* d_in, const int* in_sizes, int n_in, void* d_out, int out_size, void* d_ws, size_t ws_size, hipStream_t stream) {
    static int grid = 0;
    if (grid == 0) {
        if (n_in != 21 || in_sizes[0] != T * D || out_size != T * D || ws_size < WS_END) { fprintf(stderr, "kernel_launch: unexpected shapes (n_in %d, in0 %d, out %d, ws %zu); nothing launched\n", n_in, n_in > 0 ? in_sizes[0] : -1, out_size, ws_size); grid = -1; return; }
        int dev = 0, cus = 0, per_cu = 0;
        if (hipGetDevice(&dev) != hipSuccess || hipDeviceGetAttribute(&cus, hipDeviceAttributeMultiprocessorCount, dev) != hipSuccess) { grid = -1; return; }
        if (hipFuncSetAttribute((const void*)trunk_fwd, hipFuncAttributeMaxDynamicSharedMemorySize, LDS_BYTES) != hipSuccess) { fprintf(stderr, "kernel_launch: hipFuncSetAttribute failed\n"); grid = -1; return; }
        if (hipOccupancyMaxActiveBlocksPerMultiprocessor(&per_cu, (const void*)trunk_fwd, NWAVES * 64, LDS_BYTES) != hipSuccess || per_cu < 1) { fprintf(stderr, "kernel_launch: occupancy query reports %d workgroups per CU\n", per_cu); }
        (void)hipGetLastError();
        grid = cus;
    }
    if (grid < 0) return;
    if (hipMemsetAsync((char*)d_ws + WS_CTL, 0, CTL_ZERO_BYTES, stream) != hipSuccess) return;
    Args a{};
    for (int i = 0; i < 21; ++i) a.in[i] = (const float*)d_in[i];
    a.out = (float*)d_out; a.ws = (unsigned char*)d_ws;
    for (int li = 0; li < N_LAUNCHES; ++li) {
        a.ph_lo = (N_LAUNCHES == 1) ? 0 : li; a.ph_hi = (N_LAUNCHES == 1) ? NPHASE : li + 1; a.li = li; a.pad = 0;
        hipLaunchKernelGGL(trunk_fwd, dim3(grid), dim3(NWAVES * 64), LDS_BYTES, stream, a);
        const hipError_t le = hipPeekAtLastError();
        if (le != hipSuccess) { fprintf(stderr, "kernel_launch: launch %d failed: %s\n", li, hipGetErrorName(le)); break; }
    }
}
```

```cpp
#define MK_N_LAUNCHES 1
#define FP8_ALL 1
#define FP8_PG 1
#define FP8_PI 1
#define FP8_PI0 1
#define FP8_PD 1
#include <hip/hip_runtime.h>
#include <cstdio>
#include <cstdint>

#define GAS __attribute__((address_space(1)))
#define LAS __attribute__((address_space(3)))
typedef unsigned short bf16;
typedef unsigned v4u __attribute__((ext_vector_type(4)));
typedef unsigned v2u __attribute__((ext_vector_type(2)));
typedef float f32x4 __attribute__((ext_vector_type(4)));
typedef float f32x2 __attribute__((ext_vector_type(2)));
typedef short bf16x8 __attribute__((ext_vector_type(8)));
typedef GAS unsigned gu32;
typedef int v4i_t __attribute__((ext_vector_type(4)));
typedef int v8i_t __attribute__((ext_vector_type(8)));

namespace pg8 {
constexpr int BM = 256, BK = 64, HALF = 128, HTB = HALF * BK * 2  , STAGE_BYTES = 8 * HTB, NXCD = 8, WGM = 8;
__host__ __device__ __forceinline__ int lds_byte(int r, int c) { const int st = (r >> 4) * 2 + (c >> 5), rr = r & 15, cc = c & 31, ob = rr * 64 + cc * 2; return st * 1024 + (ob ^ (((ob >> 9) & 1) << 5)); }
__host__ __device__ __forceinline__ void stage_rc(int b, int& R, int& C) { const int st = b / 1024, sb = b % 1024, swz = sb ^ (((sb >> 9) & 1) << 5); R = (st >> 1) * 16 + swz / 64; C = (st & 1) * 32 + (swz % 64) / 2; }
__host__ __device__ __forceinline__ int perm32(int rho) { const int n = rho >> 4, i = rho & 15; return 8 * (i >> 2) + 4 * n + (i & 3); }

struct Unit { int pm, pn; const char* A; const char* B; const int* rows; int nvalid; int aux; int rowbase; int half; };

__device__ __forceinline__ unsigned cvt_pk_bf16(float lo, float hi) { unsigned r; asm volatile("v_cvt_pk_bf16_f32 %0, %1, %2" : "=v"(r) : "v"(lo), "v"(hi)); return r; }

template <class Epi, class Sched, bool GATHER, bool FP8 = false>
__device__ __forceinline__ void gemm_phase(LAS unsigned char* lds, const int K, const int lda, const int ldb, const Sched& S, const Epi& E) {
    int tid_ = threadIdx.x; asm volatile("" : "+v"(tid_));
    const int tid = tid_, wid = __builtin_amdgcn_readfirstlane(tid >> 6), lane = tid & 63, wr = wid >> 2, wc = wid & 3, fr = lane & 15, fq = lane >> 4;
    const int nt = K / BK;
    unsigned voffA[2], voffB[2]; int RA[2], CA[2];
#pragma unroll
    for (int i = 0; i < 2; ++i) { int R, C; stage_rc(tid * 16 + i * 8192, R, C); const int Rb = Epi::PERM ? ((R & ~31) + perm32(R & 31)) : R;
        RA[i] = R; CA[i] = C; voffA[i] = (unsigned)(R * lda + C) * 2u; voffB[i] = (unsigned)(Rb * ldb + C) * 2u; }
    unsigned gA[2][2], gN[2][2];
    const size_t kstep = (size_t)(BK * 2);
    const size_t hstepA = GATHER ? 0 : (size_t)HALF * lda * 2, hstepB = (size_t)HALF * ldb * 2;
    const unsigned ldsw = (unsigned)wid * 1024u;
    const int aoff = lds_byte(wr * 64 + fr, fq * 8), boff = lds_byte(wc * 32 + fr, fq * 8);
#define PG8_SA(b, h) (((b) * 2 + (h)) * HTB)
#define PG8_SB(b, h) ((4 + (b) * 2 + (h)) * HTB)
#define PG8_STAGE_B(bufoff, gbase) do { _Pragma("unroll") for (int _i = 0; _i < 2; ++_i) \
        __builtin_amdgcn_global_load_lds((const unsigned*)((const char*)(gbase) + voffB[_i]), (LAS unsigned*)(lds + (bufoff) + ldsw + _i * 8192), 16, 0, 0); } while (0)
#define PG8_STAGE_A(bufoff, gbase, h) do { _Pragma("unroll") for (int _i = 0; _i < 2; ++_i) \
        __builtin_amdgcn_global_load_lds((const unsigned*)((const char*)(gbase) + (GATHER ? gA[h][_i] : voffA[_i]) + (h) * hstepA), (LAS unsigned*)(lds + (bufoff) + ldsw + _i * 8192), 16, 0, 0); } while (0)
#define PG8_CAT(x0, x1) __builtin_shufflevector(__builtin_bit_cast(v4i_t, (x0)), __builtin_bit_cast(v4i_t, (x1)), 0, 1, 2, 3, 4, 5, 6, 7)
#define PG8_LDA(dst, b, h) do { _Pragma("unroll") for (int m = 0; m < 4; ++m) { if constexpr (FP8) dst##8[m] = PG8_CAT(*(const LAS bf16x8*)(lds + PG8_SA(b, h) + aoff + m * 2048), *(const LAS bf16x8*)(lds + PG8_SA(b, h) + aoff + m * 2048 + 1024)); \
        else { _Pragma("unroll") for (int k = 0; k < 2; ++k) dst[m][k] = *(const LAS bf16x8*)(lds + PG8_SA(b, h) + aoff + m * 2048 + k * 1024); } } } while (0)
#define PG8_LDB(dst, b, h) do { _Pragma("unroll") for (int n = 0; n < 2; ++n) { if constexpr (FP8) dst##8[n] = PG8_CAT(*(const LAS bf16x8*)(lds + PG8_SB(b, h) + boff + n * 2048), *(const LAS bf16x8*)(lds + PG8_SB(b, h) + boff + n * 2048 + 1024)); \
        else { _Pragma("unroll") for (int k = 0; k < 2; ++k) dst[n][k] = *(const LAS bf16x8*)(lds + PG8_SB(b, h) + boff + n * 2048 + k * 1024); } } } while (0)
#define PG8_MMA(ai, bj, At, Bt) do { __builtin_amdgcn_s_setprio(1); \
        if constexpr (FP8) { _Pragma("unroll") for (int m = 0; m < 4; ++m) _Pragma("unroll") for (int n = 0; n < 2; ++n) \
            asm volatile("v_mfma_scale_f32_16x16x128_f8f6f4 %0, %1, %2, %0, %3, %3 op_sel_hi:[0,0,0]" : "+v"(acc[ai][bj][m][n]) : "v"(Bt##8[n]), "v"(At##8[m]), "v"(f8scale)); } \
        else { _Pragma("unroll") for (int m = 0; m < 4; ++m) _Pragma("unroll") for (int n = 0; n < 2; ++n) _Pragma("unroll") for (int k = 0; k < 2; ++k) \
            acc[ai][bj][m][n] = __builtin_amdgcn_mfma_f32_16x16x32_bf16(Bt[n][k], At[m][k], acc[ai][bj][m][n], 0, 0, 0); } \
        __builtin_amdgcn_s_setprio(0); } while (0)
#define PG8_WAIT_V(n) asm volatile("s_waitcnt vmcnt(" #n ")" ::: "memory")
#define PG8_WAIT_L(n) asm volatile("s_waitcnt lgkmcnt(" #n ")" ::: "memory")
#define PG8_BAR __builtin_amdgcn_s_barrier()
#define PG8_SCHED __builtin_amdgcn_sched_barrier(0)
#define PG8_GLOAD(dst, u) do { _Pragma("unroll") for (int _h = 0; _h < 2; ++_h) _Pragma("unroll") for (int _i = 0; _i < 2; ++_i) { const int _r = _h * HALF + RA[_i]; \
        const int _rc = _r < (u).nvalid ? _r : (u).nvalid - 1; const int _tl = (u).rows[_rc]; const int _t = (_r < (u).nvalid) ? _tl : 0; dst[_h][_i] = (unsigned)(_t * lda + CA[_i]) * 2u; } } while (0)
    Unit cur, nxt; int ui = 0;
    if (!S.next(0, cur)) return;
    f32x4 acc[2][2][4][2];
#pragma unroll
    for (int a = 0; a < 2; ++a)
#pragma unroll
        for (int b = 0; b < 2; ++b)
#pragma unroll
            for (int m = 0; m < 4; ++m)
#pragma unroll
                for (int n = 0; n < 2; ++n) acc[a][b][m][n] = (f32x4){0.f, 0.f, 0.f, 0.f};
    const unsigned f8scale = 0x7f7f7f7fu;
    bf16x8 At[4][2], B0[2][2], B1[2][2]; v8i_t At8[4], B08[2], B18[2];
    const char* cA = cur.A; const char* cB = cur.B;
    if constexpr (GATHER) { PG8_GLOAD(gA, cur); PG8_WAIT_V(0); }
    PG8_STAGE_B(PG8_SB(0, 0), cB); PG8_STAGE_B(PG8_SB(0, 1), cB + hstepB); PG8_STAGE_A(PG8_SA(0, 0), cA, 0); PG8_STAGE_A(PG8_SA(0, 1), cA, 1);
    if (wr == 1) PG8_BAR;
    PG8_WAIT_V(2); PG8_BAR;
    PG8_STAGE_B(PG8_SB(1, 0), cB + kstep); PG8_STAGE_A(PG8_SA(1, 0), cA + kstep, 0); PG8_STAGE_B(PG8_SB(1, 1), cB + hstepB + kstep);
    PG8_WAIT_V(6); PG8_BAR;
    for (;;) {
        const bool has_next = S.next(ui + 1, nxt); const bool halfu = Sched::RAGGED && cur.half != 0;
        const char* nA = has_next ? nxt.A : cA; const char* nB = has_next ? nxt.B : cB;
        if constexpr (GATHER) { if (has_next) { PG8_GLOAD(gN, nxt); } else {
#pragma unroll
            for (int h = 0; h < 2; ++h)
#pragma unroll
                for (int i = 0; i < 2; ++i) gN[h][i] = gA[h][i]; } }
#pragma unroll 1
        for (int t = 0; t < nt; t += 2) {
            const bool last = (t == nt - 2);
            const char* a1 = cA + (size_t)(t + 1) * kstep;
            const char* a2 = last ? nA : cA + (size_t)(t + 2) * kstep; const char* b2 = last ? nB : cB + (size_t)(t + 2) * kstep;
            const char* a3 = a2 + kstep; const char* b3 = b2 + kstep;
            PG8_LDB(B0, 0, 0); PG8_LDB(B1, 0, 1); PG8_SCHED; PG8_LDA(At, 0, 0); PG8_STAGE_A(PG8_SA(1, 1), a1, 1);
            if constexpr (GATHER) { if (last) {
#pragma unroll
                for (int h = 0; h < 2; ++h)
#pragma unroll
                    for (int i = 0; i < 2; ++i) gA[h][i] = gN[h][i]; } }
            PG8_WAIT_V(8); PG8_WAIT_L(0); PG8_BAR; PG8_MMA(0, 0, At, B0); PG8_MMA(0, 1, At, B1); PG8_BAR; PG8_SCHED;
            if (!halfu) PG8_LDA(At, 0, 1); PG8_STAGE_B(PG8_SB(0, 0), b2); PG8_STAGE_B(PG8_SB(0, 1), b2 + hstepB); PG8_STAGE_A(PG8_SA(0, 0), a2, 0);
            PG8_WAIT_V(8); PG8_WAIT_L(0); PG8_BAR; if (!halfu) { PG8_MMA(1, 0, At, B0); PG8_MMA(1, 1, At, B1); } PG8_BAR; PG8_SCHED;
            PG8_LDB(B0, 1, 0); PG8_LDB(B1, 1, 1); PG8_SCHED; PG8_LDA(At, 1, 0); PG8_STAGE_A(PG8_SA(0, 1), a2, 1);
            PG8_WAIT_V(8); PG8_WAIT_L(0); PG8_BAR; PG8_MMA(0, 0, At, B0); PG8_MMA(0, 1, At, B1); PG8_BAR; PG8_SCHED;
            if (!halfu) PG8_LDA(At, 1, 1); PG8_STAGE_B(PG8_SB(1, 0), b3); PG8_STAGE_B(PG8_SB(1, 1), b3 + hstepB); PG8_STAGE_A(PG8_SA(1, 0), a3, 0);
            PG8_WAIT_V(8); PG8_WAIT_L(0); PG8_BAR; if (!halfu) { PG8_MMA(1, 0, At, B0); PG8_MMA(1, 1, At, B1); } PG8_BAR; PG8_SCHED;
        }
        if (wr == 0) PG8_BAR;
        if constexpr (FP8) asm volatile("s_nop 15\n\ts_nop 15\n\ts_nop 15" ::: "memory");
        E(acc, cur, wr, wc, fr, fq);
        if (!has_next) break;
#pragma unroll
        for (int a = 0; a < 2; ++a)
#pragma unroll
            for (int b = 0; b < 2; ++b)
#pragma unroll
                for (int m = 0; m < 4; ++m)
#pragma unroll
                    for (int n = 0; n < 2; ++n) acc[a][b][m][n] = (f32x4){0.f, 0.f, 0.f, 0.f};
        cur = nxt; cA = nA; cB = nB; ++ui;
        if (wr == 1) PG8_BAR;
    }
    PG8_WAIT_V(0);
    PG8_BAR;
#undef PG8_SA
#undef PG8_SB
#undef PG8_STAGE_A
#undef PG8_STAGE_B
#undef PG8_LDA
#undef PG8_LDB
#undef PG8_MMA
#undef PG8_CAT
#undef PG8_WAIT_V
#undef PG8_WAIT_L
#undef PG8_BAR
#undef PG8_SCHED
#undef PG8_GLOAD
}
}

constexpr int NB = 4, SEQ = 4096, D = 2048, DEPTH = 2;
constexpr int T = NB * SEQ;
constexpr int NH = 8, HD = 128, DNW = 1024, CH = 64, NCH = SEQ / CH;
constexpr int PW = 1024, PG_DIM = 256;
constexpr int IN_COLS = 5136, NPROJ = 5120;
constexpr int NE = 16, DE = 1024, PLE = 256;
constexpr float ALPHA = 1.4142135623730951f;
constexpr float LN_EPS = 1e-5f, RMS_EPS = 1e-6f;
constexpr int LCAP = T;
constexpr int MAXTILES = 2 * T / 256 + NE;

constexpr size_t MiB = 1u << 20;
constexpr size_t WS_CTL = 0, CTL_ZERO_BYTES = 64 * 1024;
constexpr size_t WS_LIST = 2 * MiB;
constexpr size_t WS_TOKSLOT = 3 * MiB, WS_GATEW = WS_TOKSLOT + 128 * 1024, WS_STATS = WS_GATEW + 128 * 1024, WS_CD = WS_STATS + 128 * 1024, WS_WBA = WS_CD + 128 * 1024;
constexpr size_t WS_WIN = 4 * MiB, WS_WOUT = 44 * MiB, WS_WPG = 60 * MiB, WS_WPP = 76 * MiB, WS_WPOOL = 78 * MiB, WS_WGU = 80 * MiB, WS_WD = 336 * MiB, WS_PB16 = 464 * MiB;
constexpr size_t WS_XB = 480 * MiB, WS_R1 = 544 * MiB, WS_R2 = 704 * MiB, WS_R4 = 848 * MiB, WS_R5 = 944 * MiB, WS_END = 1008 * MiB;
constexpr size_t WS_PROJ = WS_R1, WS_HID = WS_R1;
constexpr size_t WS_Y = WS_R2;
constexpr size_t WS_POOLD = WS_R4, WS_PP = WS_R4 + 32 * MiB, WS_X1B = WS_R2;
constexpr size_t WS_MIXIN = WS_R5, WS_X2B = WS_R5;
constexpr size_t WS_X2F8 = WS_R1 + 96 * MiB;
static_assert((size_t)MAXTILES * 256 * 2048 * 2 <= 144 * MiB && (size_t)MAXTILES * 256 * 1024 * 2 <= 160 * MiB, "MoE row buffers");
constexpr int CW_TMO = 0, CW_CODE = 1, CW_CNT = 64  , CW_BAR = 4096;

constexpr int RING_OFF = 0, RING_BYTES = 131072;
constexpr int LDSCTL_OFF = 152 * 1024, MISC_OFF = LDSCTL_OFF + 320;
constexpr int AUX_OFF = LDSCTL_OFF + 1024;
constexpr int LDS_BYTES = 163840;
constexpr int NWAVES = 8;

#define RLX_AGENT __ATOMIC_RELAXED, __HIP_MEMORY_SCOPE_AGENT
#define LDS_WAIT() asm volatile("s_waitcnt lgkmcnt(0)" ::: "memory")
#define VM_WAIT() asm volatile("s_waitcnt vmcnt(0)" ::: "memory")
__device__ __forceinline__ unsigned f2bf(float f) { unsigned u = __builtin_bit_cast(unsigned, f); return (u + 0x7fffu + ((u >> 16) & 1u)) >> 16; }
__device__ __forceinline__ unsigned pk2(float lo, float hi) { return f2bf(lo) | (f2bf(hi) << 16); }
typedef __bf16 bf2_t __attribute__((ext_vector_type(2)));
__device__ __forceinline__ unsigned pkbf(float lo, float hi) { const f32x2 v = {lo, hi}; return __builtin_bit_cast(unsigned, __builtin_convertvector(v, bf2_t)); }
constexpr float F8_XS = 16.0f, F8_WS = 256.0f, F8_INV = 1.0f / 4096.0f;
__device__ __forceinline__ float f8clamp(float x) { return fminf(fmaxf(x, -448.0f), 448.0f); }
__device__ __forceinline__ unsigned pk4_fp8(float a, float b, float c, float d) { unsigned w = 0u; w = (unsigned)__builtin_amdgcn_cvt_pk_fp8_f32(f8clamp(a), f8clamp(b), (int)w, false); w = (unsigned)__builtin_amdgcn_cvt_pk_fp8_f32(f8clamp(c), f8clamp(d), (int)w, true); return w; }
__device__ __forceinline__ float bf2f(unsigned short b) { return __builtin_bit_cast(float, ((unsigned)b) << 16); }
__device__ __forceinline__ float bflo(unsigned w) { return __builtin_bit_cast(float, w << 16); }
__device__ __forceinline__ float bfhi(unsigned w) { return __builtin_bit_cast(float, w & 0xffff0000u); }
__device__ __forceinline__ float sigmoidf_(float x) { return __builtin_amdgcn_rcpf(1.0f + __expf(-x)); }
template <int CTRL> __device__ __forceinline__ float dpp_(float x) { return __builtin_bit_cast(float, __builtin_amdgcn_mov_dpp(__builtin_bit_cast(int, x), CTRL, 0xf, 0xf, true)); }
constexpr int DPP_XOR1 = 0xB1, DPP_XOR2 = 0x4E, DPP_HMIRROR = 0x141, DPP_XOR8 = 0x128;
__device__ __forceinline__ float xrow16_sum(float x) {
    float p = x, q = x; asm volatile("v_nop\n\tv_nop\n\tv_permlane16_swap_b32 %0, %1" : "+v"(p), "+v"(q));
    x = p + q;
    float r = x, s = x; asm volatile("v_nop\n\tv_nop\n\tv_permlane32_swap_b32 %0, %1" : "+v"(r), "+v"(s));
    return r + s;
}
#ifdef OLD_SHUFFLES
__device__ __forceinline__ float row8_sum(float v) { v += __shfl_xor(v, 1); v += __shfl_xor(v, 2); v += __shfl_xor(v, 4); return v; }
__device__ __forceinline__ float wave_sum(float v) {
#pragma unroll
    for (int o = 1; o < 64; o <<= 1) v += __shfl_xor(v, o);
    return v; }
#else
__device__ __forceinline__ float row8_sum(float v) { v += dpp_<DPP_XOR1>(v); v += dpp_<DPP_XOR2>(v); v += dpp_<DPP_HMIRROR>(v); return v; }
__device__ __forceinline__ float wave_sum(float v) { v = row8_sum(v); v += dpp_<DPP_XOR8>(v); return xrow16_sum(v); }
#endif
#define XB_TMO      128
#define XB_XCNT(j)  (256  + 64 * (j))
#define XB_XSUB(j)  (1280 + 64 * (j))
#define XB_XGEN(j)  (2304 + 64 * (j))
#define XB_TOP      3328
#define XB_TOPGEN   3392
#define XCD_BAR_WORDS 3456
#define XB_SPIN_CAP (1u << 18)

__device__ __forceinline__ unsigned xb_ld(unsigned* p)              { return __hip_atomic_load(p, __ATOMIC_RELAXED, __HIP_MEMORY_SCOPE_AGENT); }
__device__ __forceinline__ unsigned xb_add(unsigned* p, unsigned v) { return __hip_atomic_fetch_add(p, v, __ATOMIC_RELAXED, __HIP_MEMORY_SCOPE_AGENT); }
__device__ __forceinline__ unsigned xb_xcc_id() { return (unsigned)__builtin_amdgcn_s_getreg((3 << 11) | 20) & 0xFu; }
#define XB_SPIN(cond, bar) do { unsigned _sp = 0; while (cond) { __builtin_amdgcn_s_sleep(1); \
    if ((++_sp & 255u) == 0u) { if (xb_ld(&(bar)[XB_TMO])) break; if (_sp > XB_SPIN_CAP) { atomicAdd(&(bar)[XB_TMO], 1u); break; } } } } while (0)

struct XcdBarrier {
    unsigned* bar; unsigned x;
    volatile LAS unsigned* st;
};

__device__ __forceinline__ XcdBarrier xcd_barrier_post(unsigned* bar, volatile LAS unsigned* st) {
    XcdBarrier b; b.bar = bar; b.x = xb_xcc_id(); b.st = st;
    if (threadIdx.x == 0) (void)xb_add(&bar[XB_XCNT(b.x)], 1u);
    return b;
}
__device__ __forceinline__ void xcd_barrier_complete(unsigned* bar, unsigned x, unsigned& nloc, unsigned& nx) {
    const unsigned G = gridDim.x * gridDim.y * gridDim.z;
    unsigned sum, cnt, mine, sp = 0u;
    for (;;) {
        sum = 0u; cnt = 0u; mine = 0u;
#pragma unroll
        for (unsigned j = 0; j < 16; ++j) { const unsigned c = xb_ld(&bar[XB_XCNT(j)]); sum += c; cnt += (c > 0u) ? 1u : 0u; mine = (j == x) ? c : mine; }
        if (sum == G) break;
        __builtin_amdgcn_s_sleep(1);
        if ((++sp & 255u) == 0u) { if (xb_ld(&bar[XB_TMO])) break; if (sp > XB_SPIN_CAP) { atomicAdd(&bar[XB_TMO], 1u); break; } }
    }
    nloc = mine > 0u ? mine : 1u; nx = cnt > 0u ? cnt : 1u;
}

__device__ __forceinline__ void xcd_barrier(const XcdBarrier& b) {
    asm volatile("s_waitcnt vmcnt(0)" ::: "memory");
    __syncthreads();
    if (threadIdx.x == 0) {
        unsigned* bar = b.bar;
        __builtin_amdgcn_s_waitcnt(0);
        unsigned nloc = b.st[0], nx = b.st[1];
        if (nloc == 0u) { xcd_barrier_complete(bar, b.x, nloc, nx); b.st[0] = nloc; b.st[1] = nx; }
        const unsigned old = xb_add(&bar[XB_XSUB(b.x)], 1u);
        const unsigned gen = old / nloc;
        if (old + 1u == (gen + 1u) * nloc) {
            __builtin_amdgcn_fence(__ATOMIC_RELEASE, "agent");
            asm volatile("s_waitcnt vmcnt(0)" ::: "memory");
            const unsigned og = xb_add(&bar[XB_TOP], 1u);
            const unsigned tg = og / nx;
            if (og + 1u == (tg + 1u) * nx) xb_add(&bar[XB_TOPGEN], 1u);
            else XB_SPIN(xb_ld(&bar[XB_TOPGEN]) == tg, bar);
            __builtin_amdgcn_fence(__ATOMIC_ACQUIRE, "agent");
            xb_add(&bar[XB_XGEN(b.x)], 1u);
            asm volatile("s_waitcnt vmcnt(0)" ::: "memory");
        } else {
            XB_SPIN(xb_ld(&bar[XB_XGEN(b.x)]) == gen, bar);
            __builtin_amdgcn_fence(__ATOMIC_ACQUIRE, "agent");
            asm volatile("s_waitcnt vmcnt(0)" ::: "memory");
        }
    }
    __syncthreads();
}

struct Args { const float* in[21]; float* out; unsigned char* ws; int ph_lo, ph_hi, li, pad; };
enum { I_X = 0, I_P, I_WIN, I_CONVW, I_ALOG, I_DTB, I_NORMW, I_POOLW, I_POOLS, I_WOUT, I_LN1G, I_LN1B, I_WR, I_BR, I_WEG, I_WEU, I_WED, I_LN2G, I_LN2B, I_WPP, I_WPG };
struct Frame {
    LAS unsigned char* lds;
    volatile LAS unsigned* MISC;
    gu32* ctl;
    int tid, lane, wave, vcu, G;
};

#ifndef FP8_LAST
#define FP8_LAST 1
#endif
#ifndef FP8_PG
#define FP8_PG 0
#endif
#ifndef FP8_ALL
#define FP8_ALL 0
#endif
#ifndef FP8_PD
#define FP8_PD 0
#endif
#ifndef FP8_PD_ALL
#define FP8_PD_ALL 0
#endif
#define FP8_PDL(l) (FP8_PD && (FP8_PD_ALL || (l) == DEPTH - 1))
#ifndef FP8_PI0
#define FP8_PI0 0
#endif
#define FP8_LAYER(l) (FP8_LAST && (FP8_ALL || (l) == DEPTH - 1))
#ifndef FP8_PI
#define FP8_PI 0
#endif
#define PHASE_FRAME(F0) Frame F = F0; { int t_ = threadIdx.x; asm volatile("" : "+v"(t_)); F.tid = t_; F.lane = t_ & 63; }
#define OPQ_S(p) asm volatile("" : "+s"(p))
#define OPQ_G(T, expr) ({ GAS T* g_ = (GAS T*)(expr); asm volatile("" : "+s"(g_)); (T*)g_; })
struct SchedDense {
    static constexpr bool RAGGED = false;
    int nM, nN, nwg, G, c; const char* A; const char* B; size_t astep, bstep;
    __device__ __forceinline__ void init(int M, int N, int G_, int c_, const void* A_, int lda, const void* B_, int ldb) { nM = M / 256; nN = N / 256; nwg = nM * nN; G = G_; c = c_;
        A = (const char*)A_; B = (const char*)B_; astep = (size_t)256 * lda * 2; bstep = (size_t)256 * ldb * 2; }
    __device__ __forceinline__ bool next(int i, pg8::Unit& u) const {
        const long L = (long)i * G + c; if (L >= nwg) return false;
        int wgid = (int)L; { const int q = nwg / 8, r = nwg % 8, xcd = wgid % 8, off = wgid / 8; wgid = (xcd < r ? xcd * (q + 1) : r * (q + 1) + (xcd - r) * q) + off; }
        const int nig = 8 * nN, gid = wgid / nig, fm = gid * 8, gsz = (nM - fm) < 8 ? (nM - fm) : 8;
        u.pm = fm + ((wgid % nig) % gsz); u.pn = (wgid % nig) / gsz;
        u.A = A + (size_t)u.pm * astep; u.B = B + (size_t)u.pn * bstep; u.rows = nullptr; u.nvalid = 256; u.aux = 0; u.rowbase = u.pm * 256; u.half = 0; return true;
    }
};
struct SchedPool {
    static constexpr bool RAGGED = false;
    int G, c; const char* A; const char* B;
    __device__ __forceinline__ bool next(int i, pg8::Unit& u) const {
        const int L = i * G + c; if (L >= 256) return false;
        u.pm = L >> 2; u.pn = L & 3; u.A = A + ((size_t)u.pm * 256 * PW + u.pn * 256) * 2; u.B = B + (size_t)u.pn * 65536 * 2; u.rows = nullptr; u.nvalid = 256; u.aux = 0; u.rowbase = u.pm * 256; u.half = 0; return true;
    }
};
struct SchedMoe {
    static constexpr bool RAGGED = true;
    int G, c, mode; const LAS int* tab; const char* A; const char* B; const int* list; int esz;
    __device__ __forceinline__ bool next(int i, pg8::Unit& u) const {
        const int L = i * G + c, nf = __builtin_amdgcn_readfirstlane(tab[64]), nh = __builtin_amdgcn_readfirstlane(tab[96]);
        if (L >= 8 * (nf + nh)) return false;
        const bool half = L >= 8 * nf; const int t = (half ? L - 8 * nf : L) >> 3, pn = L & 7, pbase = half ? 80 : 48;
        int e = 0;
#pragma unroll
        for (int k = 1; k < 16; ++k) { const int ts = __builtin_amdgcn_readfirstlane(tab[pbase + k]); if (t >= ts) e = k; }
        const int tl = t - __builtin_amdgcn_readfirstlane(tab[pbase + e]), cn = __builtin_amdgcn_readfirstlane(tab[32 + e]), blk = __builtin_amdgcn_readfirstlane(tab[e]);
        const int p0 = half ? ((cn >> 8) << 8) + 128 * tl : 256 * tl;
        u.pm = 0; u.pn = pn; u.aux = e; u.half = half ? 1 : 0; u.rowbase = blk * 128 + p0;
        const int nv = cn - p0; u.nvalid = nv < (half ? 128 : 256) ? nv : (half ? 128 : 256);
        if (mode == 0) { u.A = A; u.rows = list + (size_t)e * LCAP + p0; u.B = B + ((size_t)e * 2048 + pn * 256) * 2048 * esz; }
        else { u.A = A + (size_t)u.rowbase * DE * esz; u.rows = nullptr; u.B = B + ((size_t)e * 2048 + pn * 256) * DE * esz; }
        return true;
    }
};

using pg8::cvt_pk_bf16;
struct EpiBf16 {
    static constexpr bool PERM = true; bf16* O; int ldc; float scale = 1.0f;
    __device__ __forceinline__ void operator()(const f32x4 (&acc)[2][2][4][2], const pg8::Unit& u, int wr, int wc, int fr, int fq) const {
        const int row0 = u.rowbase + wr * 64 + fr, col0 = u.pn * 256 + wc * 32 + 8 * fq;
#pragma unroll
        for (int ai = 0; ai < 2; ++ai) if (ai == 0 || !u.half)
#pragma unroll
            for (int m = 0; m < 4; ++m) { bf16* rowp = O + (size_t)(row0 + ai * 128 + m * 16) * ldc + col0;
#pragma unroll
                for (int bj = 0; bj < 2; ++bj) { const f32x4 v0 = acc[ai][bj][m][0] * scale, v1 = acc[ai][bj][m][1] * scale;
                    v4u w; w.x = cvt_pk_bf16(v0[0], v0[1]); w.y = cvt_pk_bf16(v0[2], v0[3]); w.z = cvt_pk_bf16(v1[0], v1[1]); w.w = cvt_pk_bf16(v1[2], v1[3]);
                    *(v4u*)(rowp + bj * 128) = w; } }
    }
};
struct EpiPool {
    static constexpr bool PERM = true; bf16* O; const float* scale; int f8 = 0;
    __device__ __forceinline__ void operator()(const f32x4 (&acc)[2][2][4][2], const pg8::Unit& u, int wr, int wc, int fr, int fq) const {
        const int row0 = u.rowbase + wr * 64 + fr, cg = u.pn * 256 + wc * 32 + 8 * fq;
        f32x4 sv[2][2];
#pragma unroll
        for (int bj = 0; bj < 2; ++bj) { sv[bj][0] = *(const f32x4*)(scale + cg + bj * 128); sv[bj][1] = *(const f32x4*)(scale + cg + bj * 128 + 4); }
#pragma unroll
        for (int ai = 0; ai < 2; ++ai)
#pragma unroll
            for (int m = 0; m < 4; ++m) { bf16* rowp = O + (size_t)(row0 + ai * 128 + m * 16) * D + DNW + cg;
#pragma unroll
                for (int bj = 0; bj < 2; ++bj) { const f32x4 v0 = acc[ai][bj][m][0] * sv[bj][0], v1 = acc[ai][bj][m][1] * sv[bj][1];
                    if (f8) { v2u w8; w8.x = pk4_fp8(v0[0] * F8_XS, v0[1] * F8_XS, v0[2] * F8_XS, v0[3] * F8_XS); w8.y = pk4_fp8(v1[0] * F8_XS, v1[1] * F8_XS, v1[2] * F8_XS, v1[3] * F8_XS);
                        *(v2u*)((unsigned char*)O + (size_t)(row0 + ai * 128 + m * 16) * D + DNW + cg + bj * 128) = w8; }
                    else { v4u w; w.x = cvt_pk_bf16(v0[0], v0[1]); w.y = cvt_pk_bf16(v0[2], v0[3]); w.z = cvt_pk_bf16(v1[0], v1[1]); w.w = cvt_pk_bf16(v1[2], v1[3]);
                    *(v4u*)(rowp + bj * 128) = w; } } }
    }
};
struct EpiRes {
    static constexpr bool PERM = true; const bf16* XB; bf16* PRE; float ascale = 1.0f;
    __device__ __forceinline__ void operator()(const f32x4 (&acc)[2][2][4][2], const pg8::Unit& u, int wr, int wc, int fr, int fq) const {
        const int row0 = u.rowbase + wr * 64 + fr, col0 = u.pn * 256 + wc * 32 + 8 * fq;
#pragma unroll
        for (int ai = 0; ai < 2; ++ai) { v4u xq[4][2];
#pragma unroll
            for (int m = 0; m < 4; ++m)
#pragma unroll
                for (int bj = 0; bj < 2; ++bj) xq[m][bj] = *(const v4u*)(XB + (size_t)(row0 + ai * 128 + m * 16) * D + col0 + bj * 128);
            asm volatile("" : "+v"(xq[0][0]), "+v"(xq[0][1]), "+v"(xq[1][0]), "+v"(xq[1][1]), "+v"(xq[2][0]), "+v"(xq[2][1]), "+v"(xq[3][0]), "+v"(xq[3][1]));
#pragma unroll
            for (int m = 0; m < 4; ++m)
#pragma unroll
                for (int bj = 0; bj < 2; ++bj) { const size_t off = (size_t)(row0 + ai * 128 + m * 16) * D + col0 + bj * 128; const v4u x = xq[m][bj]; const f32x4 a0 = acc[ai][bj][m][0] * ascale, a1 = acc[ai][bj][m][1] * ascale;
                    v4u w; w.x = cvt_pk_bf16(bflo(x.x) * ALPHA + a0[0], bfhi(x.x) * ALPHA + a0[1]); w.y = cvt_pk_bf16(bflo(x.y) * ALPHA + a0[2], bfhi(x.y) * ALPHA + a0[3]);
                    w.z = cvt_pk_bf16(bflo(x.z) * ALPHA + a1[0], bfhi(x.z) * ALPHA + a1[1]); w.w = cvt_pk_bf16(bflo(x.w) * ALPHA + a1[2], bfhi(x.w) * ALPHA + a1[3]);
                    *(v4u*)(PRE + off) = w; } }
    }
};
struct EpiSwiglu {
    static constexpr bool PERM = true; bf16* O; int f8 = 0; float ascale = 1.0f;
    __device__ __forceinline__ void operator()(const f32x4 (&acc)[2][2][4][2], const pg8::Unit& u, int wr, int wc, int fr, int fq) const {
        const int row0 = u.rowbase + wr * 64 + fr, col0 = u.pn * 128 + wc * 32 + 8 * fq;
#pragma unroll
        for (int ai = 0; ai < 2; ++ai) if (ai == 0 || !u.half)
#pragma unroll
            for (int m = 0; m < 4; ++m) { bf16* rowp = O + (size_t)(row0 + ai * 128 + m * 16) * DE + col0;
                float h[8];
#pragma unroll
                for (int n = 0; n < 2; ++n)
#pragma unroll
                    for (int j = 0; j < 4; ++j) { const float g = acc[ai][0][m][n][j] * ascale, up = acc[ai][1][m][n][j] * ascale; h[4 * n + j] = g * sigmoidf_(g) * up; }
                if (f8) { v2u w8; w8.x = pk4_fp8(h[0] * F8_XS, h[1] * F8_XS, h[2] * F8_XS, h[3] * F8_XS); w8.y = pk4_fp8(h[4] * F8_XS, h[5] * F8_XS, h[6] * F8_XS, h[7] * F8_XS);
                    *(v2u*)((unsigned char*)O + (size_t)(row0 + ai * 128 + m * 16) * DE + col0) = w8; }
                else { v4u w; w.x = cvt_pk_bf16(h[0], h[1]); w.y = cvt_pk_bf16(h[2], h[3]); w.z = cvt_pk_bf16(h[4], h[5]); w.w = cvt_pk_bf16(h[6], h[7]);
                *(v4u*)rowp = w; } }
    }
};
struct EpiPle {
    static constexpr bool PERM = true; const bf16* X2B; const bf16* PP; bf16* XB; float* OUT; int last; float ascale = 1.0f;
    __device__ __forceinline__ void operator()(const f32x4 (&acc)[2][2][4][2], const pg8::Unit& u, int wr, int wc, int fr, int fq) const {
        const int row0 = u.rowbase + wr * 64 + fr, col0 = u.pn * 256 + wc * 32 + 8 * fq;
#pragma unroll
        for (int ai = 0; ai < 2; ++ai)
#pragma unroll
            for (int mp = 0; mp < 2; ++mp) { v4u xq[2][2], pq[2][2];
#pragma unroll
                for (int mm = 0; mm < 2; ++mm)
#pragma unroll
                    for (int bj = 0; bj < 2; ++bj) { const size_t off = (size_t)(row0 + ai * 128 + (2 * mp + mm) * 16) * D + col0 + bj * 128; xq[mm][bj] = *(const v4u*)(X2B + off); pq[mm][bj] = *(const v4u*)(PP + off); }
                asm volatile("" : "+v"(xq[0][0]), "+v"(xq[0][1]), "+v"(xq[1][0]), "+v"(xq[1][1]), "+v"(pq[0][0]), "+v"(pq[0][1]), "+v"(pq[1][0]), "+v"(pq[1][1]));
#pragma unroll
                for (int mm = 0; mm < 2; ++mm)
#pragma unroll
                    for (int bj = 0; bj < 2; ++bj) { const int m = 2 * mp + mm; const size_t off = (size_t)(row0 + ai * 128 + m * 16) * D + col0 + bj * 128;
                        const v4u xx = xq[mm][bj], pp = pq[mm][bj];
                        const f32x4 a0 = acc[ai][bj][m][0] * ascale, a1 = acc[ai][bj][m][1] * ascale;
                        f32x4 o0, o1;
                        o0[0] = bflo(xx.x) + sigmoidf_(a0[0]) * bflo(pp.x); o0[1] = bfhi(xx.x) + sigmoidf_(a0[1]) * bfhi(pp.x); o0[2] = bflo(xx.y) + sigmoidf_(a0[2]) * bflo(pp.y); o0[3] = bfhi(xx.y) + sigmoidf_(a0[3]) * bfhi(pp.y);
                        o1[0] = bflo(xx.z) + sigmoidf_(a1[0]) * bflo(pp.z); o1[1] = bfhi(xx.z) + sigmoidf_(a1[1]) * bfhi(pp.z); o1[2] = bflo(xx.w) + sigmoidf_(a1[2]) * bflo(pp.w); o1[3] = bfhi(xx.w) + sigmoidf_(a1[3]) * bfhi(pp.w);
                        if (last) { *(f32x4*)(OUT + off) = o0; *(f32x4*)(OUT + off + 4) = o1; }
                        else { v4u w; w.x = cvt_pk_bf16(o0[0], o0[1]); w.y = cvt_pk_bf16(o0[2], o0[3]); w.z = cvt_pk_bf16(o1[0], o1[1]); w.w = cvt_pk_bf16(o1[2], o1[3]); *(v4u*)(XB + off) = w; } } }
    }
};

__device__ __forceinline__ void tr_item(const float* W, int ldw, int k0, int n0, bf16* WT, size_t drow0, int ldt, LAS float* scr, int lane) {
#pragma unroll 8
    for (int i = 0; i < 32; ++i) { const int kk = 2 * i + (lane >> 5); scr[kk * 33 + (lane & 31)] = W[(size_t)(k0 + kk) * ldw + n0 + (lane & 31)]; }
    LDS_WAIT(); asm volatile("" ::: "memory");
    const int c = lane & 7;
#pragma unroll
    for (int j = 0; j < 4; ++j) { const int n = (lane >> 3) + 8 * j; const LAS float* s = scr + (8 * c) * 33 + n;
        v4u o; o.x = pk2(s[0 * 33], s[1 * 33]); o.y = pk2(s[2 * 33], s[3 * 33]); o.z = pk2(s[4 * 33], s[5 * 33]); o.w = pk2(s[6 * 33], s[7 * 33]);
        *(GAS v4u*)(WT + (drow0 + n) * ldt + k0 + 8 * c) = o; }
    LDS_WAIT(); asm volatile("" ::: "memory");
}
__device__ __forceinline__ void tr_item8(const float* W, int ldw, int k0, int n0, unsigned char* WT, size_t drow0, int ldt, LAS float* scr, int lane) {
#pragma unroll 8
    for (int i = 0; i < 32; ++i) { const int kk = 2 * i + (lane >> 5); scr[kk * 33 + (lane & 31)] = W[(size_t)(k0 + kk) * ldw + n0 + (lane & 31)]; }
    LDS_WAIT(); asm volatile("" ::: "memory");
    const int c = lane & 7;
#pragma unroll
    for (int j = 0; j < 4; ++j) { const int n = (lane >> 3) + 8 * j; const LAS float* s = scr + (8 * c) * 33 + n;
        v2u o; o.x = pk4_fp8(s[0 * 33] * F8_WS, s[1 * 33] * F8_WS, s[2 * 33] * F8_WS, s[3 * 33] * F8_WS); o.y = pk4_fp8(s[4 * 33] * F8_WS, s[5 * 33] * F8_WS, s[6 * 33] * F8_WS, s[7 * 33] * F8_WS);
        *(GAS v2u*)(WT + (drow0 + n) * ldt + k0 + 8 * c) = o; }
    LDS_WAIT(); asm volatile("" ::: "memory");
}
__device__ __forceinline__ void weight_items(const Args& a, unsigned char* ws, LAS float* scr, int lane, int group, int l, int gw, int NGW) {
    constexpr int I_INA = 32 * 128, I_INB = 32 * 32, I_OUT = 32 * 64, I_PG = 32 * 64, I_PP = 4 * 64, I_POOL = 4 * 32, I_EG = NE * 32 * 32, I_EU = I_EG, I_ED = NE * 16 * 64;
    if (group == 0) {
        for (int it = gw; it < I_INA + I_INB + I_PP + I_POOL; it += NGW) { int r = it;
            if (r < I_INA) { const int kb = r / 128, nb = r % 128; tr_item(a.in[I_WIN] + (size_t)l * D * IN_COLS, IN_COLS, 64 * kb, 32 * nb, (bf16*)(ws + WS_WIN) + (size_t)l * NPROJ * D, 32 * nb, D, scr, lane); continue; } r -= I_INA;
            if (r < I_INB) { const int kb = r / 32, nb = r % 32; tr_item(a.in[I_WIN] + (size_t)l * D * IN_COLS, IN_COLS, 64 * kb, 4112 + 32 * nb, (bf16*)(ws + WS_WIN) + (size_t)l * NPROJ * D, 4096 + 32 * nb, D, scr, lane); continue; } r -= I_INB;
            if (r < I_PP) { const int kb = r / 64, nb = r % 64; tr_item(a.in[I_WPP] + (size_t)l * PLE * D, D, 64 * kb, 32 * nb, (bf16*)(ws + WS_WPP) + (size_t)l * D * PLE, 32 * nb, PLE, scr, lane); continue; } r -= I_PP;
            { const int g = r / 32, rr = r % 32, kb = rr / 8, nb = rr % 8; tr_item(a.in[I_POOLW] + ((size_t)l * 4 + g) * 65536, 256, 64 * kb, 32 * nb, (bf16*)(ws + WS_WPOOL) + ((size_t)l * 4 + g) * 65536, 32 * nb, 256, scr, lane); } }
    } else {
        const bool f8 = FP8_LAYER(l);
        for (int it = gw; it < I_OUT + I_PG + I_EG + I_EU + I_ED; it += NGW) { int r = it;
            if (r < I_OUT) { const int kb = r / 64, nb = r % 64; if (FP8_PDL(l)) tr_item8(a.in[I_WOUT] + (size_t)l * D * D, D, 64 * kb, 32 * nb, ws + WS_WOUT + (size_t)l * D * D * 2, 32 * nb, D, scr, lane); else tr_item(a.in[I_WOUT] + (size_t)l * D * D, D, 64 * kb, 32 * nb, (bf16*)(ws + WS_WOUT) + (size_t)l * D * D, 32 * nb, D, scr, lane); continue; } r -= I_OUT;
            if (r < I_PG) { const int kb = r / 64, nb = r % 64; if (FP8_PI && (FP8_PI0 || l == DEPTH - 1)) tr_item8(a.in[I_WPG] + (size_t)l * D * D, D, 64 * kb, 32 * nb, ws + WS_WPG + (size_t)l * D * D * 2, 32 * nb, D, scr, lane); else tr_item(a.in[I_WPG] + (size_t)l * D * D, D, 64 * kb, 32 * nb, (bf16*)(ws + WS_WPG) + (size_t)l * D * D, 32 * nb, D, scr, lane); continue; } r -= I_PG;
            if (r < I_EG) { const int e = r / 1024, rr = r % 1024, kb = rr / 32, nb = rr % 32, h0 = 32 * nb;
                if (f8) tr_item8(a.in[I_WEG] + ((size_t)l * NE + e) * D * DE, DE, 64 * kb, h0, ws + WS_WGU + (size_t)l * NE * 2048 * D * 2 + (size_t)e * 2048 * D, (size_t)(h0 >> 7) * 256 + (h0 & 127), D, scr, lane);
                else tr_item(a.in[I_WEG] + ((size_t)l * NE + e) * D * DE, DE, 64 * kb, h0, (bf16*)(ws + WS_WGU) + ((size_t)l * NE + e) * 2048 * D, (size_t)(h0 >> 7) * 256 + (h0 & 127), D, scr, lane); continue; } r -= I_EG;
            if (r < I_EU) { const int e = r / 1024, rr = r % 1024, kb = rr / 32, nb = rr % 32, h0 = 32 * nb;
                if (f8) tr_item8(a.in[I_WEU] + ((size_t)l * NE + e) * D * DE, DE, 64 * kb, h0, ws + WS_WGU + (size_t)l * NE * 2048 * D * 2 + (size_t)e * 2048 * D, (size_t)(h0 >> 7) * 256 + 128 + (h0 & 127), D, scr, lane);
                else tr_item(a.in[I_WEU] + ((size_t)l * NE + e) * D * DE, DE, 64 * kb, h0, (bf16*)(ws + WS_WGU) + ((size_t)l * NE + e) * 2048 * D, (size_t)(h0 >> 7) * 256 + 128 + (h0 & 127), D, scr, lane); continue; } r -= I_EU;
            { const int e = r / 1024, rr = r % 1024, kb = rr / 64, nb = rr % 64;
                if (f8 && FP8_PG) tr_item8(a.in[I_WED] + ((size_t)l * NE + e) * DE * D, D, 64 * kb, 32 * nb, ws + WS_WD + (size_t)l * NE * D * DE * 2 + (size_t)e * D * DE, 32 * nb, DE, scr, lane);
                else tr_item(a.in[I_WED] + ((size_t)l * NE + e) * DE * D, D, 64 * kb, 32 * nb, (bf16*)(ws + WS_WD) + ((size_t)l * NE + e) * D * DE, 32 * nb, DE, scr, lane); } }
    }
}
__device__ __forceinline__ void p0_prologue(const Frame& F0, const Args& a) {
    PHASE_FRAME(F0);
    LAS float* scr = (LAS float*)(F.lds + RING_OFF + F.wave * 16384);
    const int gw = F.vcu * NWAVES + F.wave, NGW = F.G * NWAVES;
    unsigned char* ws = OPQ_G(unsigned char, a.ws);
#pragma unroll 1
    for (int l = 0; l < DEPTH; ++l) weight_items(a, ws, scr, F.lane, 0, l, gw, NGW);
#ifdef CONVERT_ALL_IN_PROLOGUE
#pragma unroll 1
    for (int l = 0; l < DEPTH; ++l) weight_items(a, ws, scr, F.lane, 1, l, gw, NGW);
#endif
    const size_t gt = (size_t)F.vcu * 512 + F.tid, NGT = (size_t)F.G * 512;
    { const GAS f32x4* src = (const GAS f32x4*)a.in[I_X]; GAS v4u* dst = (GAS v4u*)(ws + WS_XB);
        for (size_t i = gt; i < (size_t)T * D / 8; i += NGT) { const f32x4 v0 = src[2 * i], v1 = src[2 * i + 1]; v4u o; o.x = pk2(v0[0], v0[1]); o.y = pk2(v0[2], v0[3]); o.z = pk2(v1[0], v1[1]); o.w = pk2(v1[2], v1[3]); dst[i] = o; } }
    { const GAS f32x4* src = (const GAS f32x4*)a.in[I_P]; GAS v4u* dst = (GAS v4u*)(ws + WS_PB16);
        for (size_t i = gt; i < (size_t)DEPTH * T * PLE / 8; i += NGT) { const f32x4 v0 = src[2 * i], v1 = src[2 * i + 1]; v4u o; o.x = pk2(v0[0], v0[1]); o.y = pk2(v0[2], v0[3]); o.z = pk2(v1[0], v1[1]); o.w = pk2(v1[2], v1[3]); dst[i] = o; } }
    for (size_t i = gt; i < (size_t)DEPTH * 16 * D; i += NGT) { const int l = (int)(i / (16 * D)), j = (int)((i / D) % 16), k = (int)(i % D);
        ((bf16*)(ws + WS_WBA))[i] = (bf16)f2bf(a.in[I_WIN][((size_t)l * D + k) * IN_COLS + 4096 + j]); }
}

typedef float f32x16 __attribute__((ext_vector_type(16)));
#define MFMA32(a_, b_, c_) __builtin_amdgcn_mfma_f32_32x32x16_bf16((a_), (b_), (c_), 0, 0, 0)
#define PACK8(x, sp) __builtin_bit_cast(bf16x8, (v4u){pkbf((x)[8 * (sp)], (x)[8 * (sp) + 1]), pkbf((x)[8 * (sp) + 2], (x)[8 * (sp) + 3]), pkbf((x)[8 * (sp) + 4], (x)[8 * (sp) + 5]), pkbf((x)[8 * (sp) + 6], (x)[8 * (sp) + 7])})
#define RAW_BAR() do { asm volatile("s_waitcnt lgkmcnt(0)" ::: "memory"); __builtin_amdgcn_s_barrier(); asm volatile("" ::: "memory"); } while (0)
constexpr int IMG_ELEMS = 56 * 512, UIMG_ELEMS = 8 * 1024;
constexpr int FR_WN = 0, FR_QD = 16, FR_AQK = 32, FR_KDT = 40;
constexpr size_t WS_IMG = WS_R2, WS_UIMG = WS_R2 + 112 * MiB;
static_assert((size_t)NB * NCH * NH * IMG_ELEMS * 2 == 112 * MiB && (size_t)NB * NCH * NH * UIMG_ELEMS * 2 == 32 * MiB, "DeltaNet images");

__device__ __forceinline__ void pool_diffs_unit(const Frame& F, unsigned char* ws, int pm, int g) {
    const bf16* PROJ = (const bf16*)(ws + WS_PROJ); bf16* POOLD = (bf16*)(ws + WS_POOLD);
    const int tid = F.tid, cp = tid & 127, rq = tid >> 7, r0 = 256 * pm + 64 * rq, sq0 = r0 % SEQ, col = 256 * g + 2 * cp;
    const bf16* up = PROJ + (size_t)r0 * NPROJ + 4096 + col; bf16* dp = POOLD + (size_t)r0 * PW + col;
#define POOL_BODY(WIN) do { unsigned xr[CH + WIN - 1]; \
        _Pragma("unroll") for (int j = 0; j < WIN - 1; ++j) xr[j] = (sq0 - (WIN - 1) + j >= 0) ? *(const unsigned*)(up + (ptrdiff_t)(j - (WIN - 1)) * NPROJ) : 0u; \
        _Pragma("unroll") for (int i = 0; i < CH; ++i) xr[WIN - 1 + i] = *(const unsigned*)(up + (size_t)i * NPROJ); \
        float s0 = 0.f, s1 = 0.f; \
        _Pragma("unroll") for (int j = 0; j < WIN - 1; ++j) { s0 += bflo(xr[j]); s1 += bfhi(xr[j]); } \
        _Pragma("unroll") for (int i = 0; i < CH; ++i) { const float x0 = bflo(xr[WIN - 1 + i]), x1 = bfhi(xr[WIN - 1 + i]); s0 += x0; s1 += x1; \
            const int pos = sq0 + i; const float inv = __builtin_amdgcn_rcpf((float)((pos + 1) < WIN ? (pos + 1) : WIN)); \
            *(unsigned*)(dp + (size_t)i * PW) = pkbf(s0 * inv - x0, s1 * inv - x1); s0 -= bflo(xr[i]); s1 -= bfhi(xr[i]); } } while (0)
    if (g == 0) POOL_BODY(2); else if (g == 1) POOL_BODY(4); else if (g == 2) POOL_BODY(8); else POOL_BODY(16);
#undef POOL_BODY
}
#ifndef PREP_DUP
#define PREP_DUP 0
#endif
constexpr int PQF = 0, PKF = 33792, PQS = 67584, PKS = 84992, PVT = 102400, PKT = 120832, PTAB = 139264;
constexpr int PAS = PQF;
constexpr int PTB = PKF, PT11T = PKF + 9216, PPART = PKF;
constexpr int F_LD = 132, S_LD = 136, T_LD = 72, A_LD = 68, TT_LD = 40;
__device__ __forceinline__ void phase_dn_prep(const Frame& F0, const Args& a, int layer) {
    PHASE_FRAME(F0);
    unsigned char* ws = OPQ_G(unsigned char, a.ws);
    LAS unsigned char* lds = F.lds;
    LAS float* Qf = (LAS float*)(lds + PQF); LAS float* Kf = (LAS float*)(lds + PKF); LAS float* As = (LAS float*)(lds + PAS);
    LAS bf16* Qs = (LAS bf16*)(lds + PQS); LAS bf16* Ks = (LAS bf16*)(lds + PKS); LAS bf16* Vt = (LAS bf16*)(lds + PVT); LAS bf16* Kt = (LAS bf16*)(lds + PKT);
    LAS bf16* Tb = (LAS bf16*)(lds + PTB); LAS bf16* T11t = (LAS bf16*)(lds + PT11T);
    LAS float* betaS = (LAS float*)(lds + PTAB); LAS float* gS = betaS + 512; LAS float* gamh = gS + 512; LAS float* betah = gamh + 64; LAS float* egam = betah + 64; LAS float* bgam = egam + 64; LAS float* ekd = bgam + 64; LAS float* rkS = ekd + 64;
    const bf16* XB = (const bf16*)(ws + WS_XB); const bf16* PROJ = (const bf16*)(ws + WS_PROJ); const bf16* WBA = (const bf16*)(ws + WS_WBA) + (size_t)layer * 16 * D;
    bf16* IMG = (bf16*)(ws + WS_IMG); bf16* UIMG = (bf16*)(ws + WS_UIMG); float* CD = (float*)(ws + WS_CD);
    const float* convw = a.in[I_CONVW] + (size_t)layer * 4 * 3072; const float* alog = a.in[I_ALOG] + layer * NH; const float* dtb = a.in[I_DTB] + layer * NH;
    const int tid = F.tid, lane = F.lane, wave = F.wave, c32 = lane & 31, hf = lane >> 5;
    for (int unit = F.vcu; unit < NB * NCH; unit += F.G) {
        const int b = unit / NCH, n = unit % NCH, r0 = b * SEQ + n * CH, sq0 = n * CH;
        for (int rep_ = 0; rep_ < ((PREP_DUP & 64) ? 2 : 1); ++rep_)
        { typedef float f32x4v __attribute__((ext_vector_type(4)));
            const int fr = lane & 15, fg = lane >> 4; f32x4v pacc[4];
#pragma unroll
            for (int mt = 0; mt < 4; ++mt) pacc[mt] = (f32x4v){0.f, 0.f, 0.f, 0.f};
#pragma unroll 1
            for (int sb = 0; sb < 8; sb += 4) {
                bf16x8 bq[4], aq[4][4];
#pragma unroll
                for (int s = 0; s < 4; ++s) { const int k0 = 256 * wave + 32 * (sb + s) + 8 * fg; bq[s] = *(const bf16x8*)(WBA + (size_t)fr * D + k0);
#pragma unroll
                    for (int mt = 0; mt < 4; ++mt) aq[s][mt] = *(const bf16x8*)(XB + (size_t)(r0 + 16 * mt + fr) * D + k0); }
                asm volatile("" : "+v"(bq[0]), "+v"(bq[1]), "+v"(bq[2]), "+v"(bq[3]), "+v"(aq[0][0]), "+v"(aq[0][1]), "+v"(aq[0][2]), "+v"(aq[0][3]), "+v"(aq[1][0]), "+v"(aq[1][1]), "+v"(aq[1][2]), "+v"(aq[1][3]),
                             "+v"(aq[2][0]), "+v"(aq[2][1]), "+v"(aq[2][2]), "+v"(aq[2][3]), "+v"(aq[3][0]), "+v"(aq[3][1]), "+v"(aq[3][2]), "+v"(aq[3][3]));
#pragma unroll
                for (int s = 0; s < 4; ++s)
#pragma unroll
                    for (int mt = 0; mt < 4; ++mt) pacc[mt] = __builtin_amdgcn_mfma_f32_16x16x32_bf16(aq[s][mt], bq[s], pacc[mt], 0, 0, 0); }
            LAS float* part = (LAS float*)(lds + PPART) + wave * 1024;
#pragma unroll
            for (int mt = 0; mt < 4; ++mt)
#pragma unroll
                for (int r = 0; r < 4; ++r) part[(16 * mt + 4 * fg + r) * 16 + fr] = pacc[mt][r]; }
        __syncthreads();
        { const int tok = tid >> 3, cp = tid & 7; float s0 = 0.f, s1 = 0.f;
#pragma unroll
            for (int w = 0; w < 8; ++w) { const f32x2 p2 = *(const LAS f32x2*)((LAS float*)(lds + PPART) + w * 1024 + tok * 16 + 2 * cp); s0 += p2[0]; s1 += p2[1]; }
            if (cp < 4) { betaS[tok * 8 + 2 * cp] = sigmoidf_(s0); betaS[tok * 8 + 2 * cp + 1] = sigmoidf_(s1); }
            else { const int h = 2 * (cp - 4); const float z0 = s0 + dtb[h], z1 = s1 + dtb[h + 1];
                const float sp0 = z0 > 20.f ? z0 : log1pf(__expf(z0)), sp1 = z1 > 20.f ? z1 : log1pf(__expf(z1));
                gS[tok * 8 + h] = -__expf(alog[h]) * sp0; gS[tok * 8 + h + 1] = -__expf(alog[h + 1]) * sp1; } }
        __syncthreads();
        { float gv = gS[lane * 8 + wave];
#pragma unroll
            for (int o = 1; o < 64; o <<= 1) { const float up_ = __shfl_up(gv, o); if (lane >= o) gv += up_; }
            gS[lane * 8 + wave] = gv; }
        __syncthreads();
        unsigned craw[3][11]; unsigned cdum[3][8];
#define PREP_LOADRAW(hh) do { const int cp_ = tid & 63, i0_ = (tid >> 6) * 8; \
            _Pragma("unroll") for (int part_ = 0; part_ < 3; ++part_) { const bf16* src_ = PROJ + (size_t)(r0 + i0_ - 3) * NPROJ + part_ * 1024 + (hh) * HD + 2 * cp_; \
                _Pragma("unroll") for (int j_ = 0; j_ < 11; ++j_) craw[part_][j_] = (sq0 + i0_ - 3 + j_ >= 0) ? *(const unsigned*)(src_ + (ptrdiff_t)j_ * NPROJ) : 0u; \
                if (PREP_DUP & 256) { _Pragma("unroll") for (int j_ = 3; j_ < 11; ++j_) cdum[part_][j_ - 3] = *(const unsigned*)(src_ + (ptrdiff_t)j_ * NPROJ + ((hh) ^ 1) * HD - (hh) * HD); } } } while (0)
        PREP_LOADRAW(0);
        for (int hh_ = 0; hh_ < ((PREP_DUP & 128) ? 2 * NH : NH); ++hh_) { const int h = hh_ & (NH - 1);
            const size_t chd = (size_t)unit * NH + h; bf16* img = IMG + chd * IMG_ELEMS; bf16* uimg = UIMG + chd * UIMG_ELEMS;
            if (tid < 64) { const float gi = gS[tid * 8 + h], bi = betaS[tid * 8 + h], eg = __expf(gi); gamh[tid] = gi; betah[tid] = bi; egam[tid] = eg; bgam[tid] = bi * eg; ekd[tid] = __expf(gS[63 * 8 + h] - gi); }
            RAW_BAR();
            for (int rep_ = 0; rep_ < ((PREP_DUP & 16) ? 2 : 1); ++rep_)
            { const int cp = tid & 63, rg8 = tid >> 6, i0 = rg8 * 8;
                if (PREP_DUP & 256) {
#pragma unroll
                    for (int p_ = 0; p_ < 3; ++p_)
#pragma unroll
                        for (int j_ = 0; j_ < 8; ++j_) asm volatile("" :: "v"(cdum[p_][j_])); }
#pragma unroll
                for (int part = 0; part < 3; ++part) { const int col = part * 1024 + h * HD + 2 * cp;
                    const f32x2 cw0 = *(const f32x2*)(convw + col), cw1 = *(const f32x2*)(convw + 3072 + col), cw2 = *(const f32x2*)(convw + 2 * 3072 + col), cw3 = *(const f32x2*)(convw + 3 * 3072 + col);
                    float ya[8], yb[8];
#pragma unroll
                    for (int i = 0; i < 8; ++i) { const unsigned x3 = craw[part][i], x2 = craw[part][i + 1], x1 = craw[part][i + 2], x0 = craw[part][i + 3];
                        const float ta = cw0[0] * bflo(x3) + cw1[0] * bflo(x2) + cw2[0] * bflo(x1) + cw3[0] * bflo(x0), tb = cw0[1] * bfhi(x3) + cw1[1] * bfhi(x2) + cw2[1] * bfhi(x1) + cw3[1] * bfhi(x0);
                        ya[i] = ta * sigmoidf_(ta); yb[i] = tb * sigmoidf_(tb); }
                    if (part == 0) {
#pragma unroll
                        for (int i = 0; i < 8; ++i) *(LAS f32x2*)(Qf + (i0 + i) * F_LD + 2 * cp) = (f32x2){ya[i], yb[i]}; }
                    else if (part == 1) {
#pragma unroll
                        for (int i = 0; i < 8; ++i) *(LAS f32x2*)(Kf + (i0 + i) * F_LD + 2 * cp) = (f32x2){ya[i], yb[i]}; }
                    else { v4u o0, o1;
                        o0.x = pkbf(ya[0] * betah[i0 + 0], ya[1] * betah[i0 + 1]); o0.y = pkbf(ya[2] * betah[i0 + 2], ya[3] * betah[i0 + 3]); o0.z = pkbf(ya[4] * betah[i0 + 4], ya[5] * betah[i0 + 5]); o0.w = pkbf(ya[6] * betah[i0 + 6], ya[7] * betah[i0 + 7]);
                        o1.x = pkbf(yb[0] * betah[i0 + 0], yb[1] * betah[i0 + 1]); o1.y = pkbf(yb[2] * betah[i0 + 2], yb[3] * betah[i0 + 3]); o1.z = pkbf(yb[4] * betah[i0 + 4], yb[5] * betah[i0 + 5]); o1.w = pkbf(yb[6] * betah[i0 + 6], yb[7] * betah[i0 + 7]);
                        *(LAS v4u*)(Vt + (2 * cp) * T_LD + i0) = o0; *(LAS v4u*)(Vt + (2 * cp + 1) * T_LD + i0) = o1; } }
            }
            if (hh_ + 1 < ((PREP_DUP & 128) ? 2 * NH : NH)) PREP_LOADRAW((hh_ + 1) & (NH - 1));
            for (int rep_ = 0; rep_ < ((PREP_DUP & 1) ? 2 : 1); ++rep_) { if (rep_) RAW_BAR();
            { const int i = tid >> 3, part = tid & 7; const LAS float* qp = Qf + i * F_LD + part * 16; const LAS float* kp = Kf + i * F_LD + part * 16;
                f32x4 qv[4], kv[4]; float sq = 0.f, sk = 0.f;
#pragma unroll
                for (int j = 0; j < 4; ++j) { qv[j] = *(const LAS f32x4*)(qp + 4 * j); kv[j] = *(const LAS f32x4*)(kp + 4 * j);
                    sq += (qv[j][0] * qv[j][0] + qv[j][1] * qv[j][1]) + (qv[j][2] * qv[j][2] + qv[j][3] * qv[j][3]); sk += (kv[j][0] * kv[j][0] + kv[j][1] * kv[j][1]) + (kv[j][2] * kv[j][2] + kv[j][3] * kv[j][3]); }
                sq = row8_sum(sq); sk = row8_sum(sk);
                const float rq = 1.0f / sqrtf(sq + RMS_EPS) * 0.08838834764831845f, rk = 1.0f / sqrtf(sk + RMS_EPS);
                if (part == 0) rkS[i] = rk;
#pragma unroll
                for (int j = 0; j < 4; ++j) { qv[j] = qv[j] * rq; kv[j] = kv[j] * rk; }
                v4u w0, w1;
                w0.x = pkbf(qv[0][0], qv[0][1]); w0.y = pkbf(qv[0][2], qv[0][3]); w0.z = pkbf(qv[1][0], qv[1][1]); w0.w = pkbf(qv[1][2], qv[1][3]); w1.x = pkbf(qv[2][0], qv[2][1]); w1.y = pkbf(qv[2][2], qv[2][3]); w1.z = pkbf(qv[3][0], qv[3][1]); w1.w = pkbf(qv[3][2], qv[3][3]);
                *(LAS v4u*)(Qs + i * S_LD + part * 16) = w0; *(LAS v4u*)(Qs + i * S_LD + part * 16 + 8) = w1;
                w0.x = pkbf(kv[0][0], kv[0][1]); w0.y = pkbf(kv[0][2], kv[0][3]); w0.z = pkbf(kv[1][0], kv[1][1]); w0.w = pkbf(kv[1][2], kv[1][3]); w1.x = pkbf(kv[2][0], kv[2][1]); w1.y = pkbf(kv[2][2], kv[2][3]); w1.z = pkbf(kv[3][0], kv[3][1]); w1.w = pkbf(kv[3][2], kv[3][3]);
                *(LAS v4u*)(Ks + i * S_LD + part * 16) = w0; *(LAS v4u*)(Ks + i * S_LD + part * 16 + 8) = w1;
                const float eg = egam[i]; bf16* fq = img + ((size_t)(FR_QD + (i >> 5) * 8 + part) * 64 + (i & 31)) * 8;
                v4u h0, h1;
                h0.x = pkbf(qv[0][0] * eg, qv[0][1] * eg); h0.y = pkbf(qv[0][2] * eg, qv[0][3] * eg); h0.z = pkbf(qv[2][0] * eg, qv[2][1] * eg); h0.w = pkbf(qv[2][2] * eg, qv[2][3] * eg);
                h1.x = pkbf(qv[1][0] * eg, qv[1][1] * eg); h1.y = pkbf(qv[1][2] * eg, qv[1][3] * eg); h1.z = pkbf(qv[3][0] * eg, qv[3][1] * eg); h1.w = pkbf(qv[3][2] * eg, qv[3][3] * eg);
                *(v4u*)fq = h0; *(v4u*)(fq + 32 * 8) = h1; }
            RAW_BAR();
            { const int c = tid & 127, rg = tid >> 7; float kb[16], kd[16];
#pragma unroll
                for (int i = 0; i < 16; ++i) { const int t = rg * 16 + i; const float kn = Kf[t * F_LD + c] * rkS[t]; kb[i] = kn * bgam[t]; kd[i] = kn * ekd[t]; }
                v4u o0, o1;
                o0.x = pkbf(kb[0], kb[1]); o0.y = pkbf(kb[2], kb[3]); o0.z = pkbf(kb[4], kb[5]); o0.w = pkbf(kb[6], kb[7]); o1.x = pkbf(kb[8], kb[9]); o1.y = pkbf(kb[10], kb[11]); o1.z = pkbf(kb[12], kb[13]); o1.w = pkbf(kb[14], kb[15]);
                *(LAS v4u*)(Kt + c * T_LD + rg * 16) = o0; *(LAS v4u*)(Kt + c * T_LD + rg * 16 + 8) = o1;
                bf16* fk = img + ((size_t)(FR_KDT + (c >> 5) * 4 + rg) * 64 + (c & 31)) * 8;
                v4u h0, h1;
                h0.x = pkbf(kd[0], kd[1]); h0.y = pkbf(kd[2], kd[3]); h0.z = pkbf(kd[8], kd[9]); h0.w = pkbf(kd[10], kd[11]);
                h1.x = pkbf(kd[4], kd[5]); h1.y = pkbf(kd[6], kd[7]); h1.z = pkbf(kd[12], kd[13]); h1.w = pkbf(kd[14], kd[15]);
                *(v4u*)fk = h0; *(v4u*)(fk + 32 * 8) = h1; }
            RAW_BAR();
            }
            for (int rep_ = 0; rep_ < ((PREP_DUP & 2) ? 2 : 1); ++rep_) { if (rep_) RAW_BAR();
            if (wave < 6) { const int pr = wave % 3, iskk = wave / 3, mt = pr == 2 ? 1 : 0, nt = pr == 0 ? 0 : 1;
                const LAS bf16* xs = iskk ? Ks : Qs; f32x16 d;
#pragma unroll
                for (int r = 0; r < 16; ++r) d[r] = 0.f;
#pragma unroll
                for (int s = 0; s < 8; ++s) { const bf16x8 af = *(const LAS bf16x8*)(Ks + (32 * mt + c32) * S_LD + 16 * s + 8 * hf), bfr = *(const LAS bf16x8*)(xs + (32 * nt + c32) * S_LD + 16 * s + 8 * hf); d = MFMA32(af, bfr, d); }
                const int i = 32 * nt + c32; const float gi = gamh[i], bi = betah[i];
#pragma unroll
                for (int r = 0; r < 16; ++r) { const int j = 32 * mt + (r & 3) + 8 * (r >> 2) + 4 * hf; const float de = __expf(gi - gamh[j]);
                    d[r] = iskk ? ((j < i) ? bi * d[r] * de : 0.f) : ((j <= i) ? d[r] * de : 0.f); }
                if (iskk) {
#pragma unroll
                    for (int qd = 0; qd < 4; ++qd) *(LAS f32x4*)(As + i * A_LD + 32 * mt + 8 * qd + 4 * hf) = (f32x4){d[4 * qd], d[4 * qd + 1], d[4 * qd + 2], d[4 * qd + 3]}; }
                else {
#pragma unroll
                    for (int sp = 0; sp < 2; ++sp) *(bf16x8*)(img + ((size_t)(FR_AQK + nt * 4 + 2 * mt + sp) * 64 + lane) * 8) = PACK8(d, sp); } }
            RAW_BAR();
            }
            for (int rep_ = 0; rep_ < ((PREP_DUP & 4) ? 2 : 1); ++rep_) { if (rep_) RAW_BAR();
            if (wave < 2) {
                unsigned asb = (unsigned)(uintptr_t)(As + (32 * wave) * A_LD + 32 * wave); int cb = c32; asm volatile("" : "+v"(asb), "+v"(cb));
                const LAS float* Ab = (const LAS float*)(uintptr_t)asb;
                float arow[32], Tc[32];
#pragma unroll
                for (int i = 0; i < 32; ++i) arow[i] = Ab[i * A_LD + cb];
#pragma unroll
                for (int i = 0; i < 32; ++i) { float ac[4] = {(i == cb) ? 1.f : 0.f, 0.f, 0.f, 0.f}; if (i > 0) asm volatile("" : "+v"(arow[i]), "+v"(Tc[i - 1]));
#pragma unroll
                    for (int j = 0; j < i; ++j) { const float aij = __builtin_bit_cast(float, __builtin_amdgcn_readlane(__builtin_bit_cast(int, arow[i]), j)); ac[j & 3] -= aij * Tc[j]; }
                    Tc[i] = (ac[0] + ac[1]) + (ac[2] + ac[3]); __builtin_amdgcn_sched_barrier(0); }
                if (hf == 0) {
#pragma unroll
                    for (int i = 0; i < 32; ++i) Tb[(32 * wave + i) * T_LD + 32 * wave + c32] = (bf16)(pkbf(Tc[i], 0.f) & 0xffffu);
                    if (wave == 0) {
#pragma unroll
                        for (int q = 0; q < 4; ++q) { v4u o; o.x = pkbf(Tc[8 * q], Tc[8 * q + 1]); o.y = pkbf(Tc[8 * q + 2], Tc[8 * q + 3]); o.z = pkbf(Tc[8 * q + 4], Tc[8 * q + 5]); o.w = pkbf(Tc[8 * q + 6], Tc[8 * q + 7]); *(LAS v4u*)(T11t + c32 * TT_LD + 8 * q) = o; } } } }
            RAW_BAR();
            if (wave == 0) {
                f32x16 x;
#pragma unroll
                for (int r = 0; r < 16; ++r) x[r] = 0.f;
#pragma unroll
                for (int s = 0; s < 2; ++s) { const LAS float* ap = As + (32 + c32) * A_LD + 16 * s + 8 * hf; const f32x4 a0 = *(const LAS f32x4*)ap, a1 = *(const LAS f32x4*)(ap + 4);
                    const bf16x8 af = __builtin_bit_cast(bf16x8, (v4u){pkbf(a0[0], a0[1]), pkbf(a0[2], a0[3]), pkbf(a1[0], a1[1]), pkbf(a1[2], a1[3])});
                    const bf16x8 bfr = *(const LAS bf16x8*)(T11t + c32 * TT_LD + 16 * s + 8 * hf); x = MFMA32(af, bfr, x); }
                f32x16 t21;
#pragma unroll
                for (int r = 0; r < 16; ++r) t21[r] = 0.f;
#pragma unroll
                for (int s = 0; s < 2; ++s) { const LAS bf16* tp = Tb + (32 + c32) * T_LD + 32 + 16 * s + 4 * hf; const v2u lo = *(const LAS v2u*)tp, hi = *(const LAS v2u*)(tp + 8);
                    const bf16x8 af = __builtin_bit_cast(bf16x8, (v4u){lo.x, lo.y, hi.x, hi.y}); const bf16x8 bfr = PACK8(x, s); t21 = MFMA32(af, bfr, t21); }
#pragma unroll
                for (int r = 0; r < 16; ++r) Tb[(32 + (r & 3) + 8 * (r >> 2) + 4 * hf) * T_LD + c32] = (bf16)(pkbf(-t21[r], 0.f) & 0xffffu);
            }
            RAW_BAR();
            }
            for (int rep_ = 0; rep_ < ((PREP_DUP & 8) ? 2 : 1); ++rep_) { if (rep_) RAW_BAR();
            if (wave < 4) {
#pragma unroll
                for (int mt = 0; mt < 2; ++mt) { f32x16 d;
#pragma unroll
                    for (int r = 0; r < 16; ++r) d[r] = 0.f;
#pragma unroll
                    for (int s = 0; s < 4; ++s) if (s < 2 * (mt + 1)) { const bf16x8 af = *(const LAS bf16x8*)(Tb + (32 * mt + c32) * T_LD + 16 * s + 8 * hf), bfr = *(const LAS bf16x8*)(Vt + (32 * wave + c32) * T_LD + 16 * s + 8 * hf); d = MFMA32(af, bfr, d); }
                    bf16* up = uimg + ((size_t)(wave * 2 + mt) * 64 + lane) * 16; *(bf16x8*)up = PACK8(d, 0); *(bf16x8*)(up + 8) = PACK8(d, 1); } }
            else { const int ct = wave - 4;
#pragma unroll
                for (int nt = 0; nt < 2; ++nt) { f32x16 d;
#pragma unroll
                    for (int r = 0; r < 16; ++r) d[r] = 0.f;
#pragma unroll
                    for (int s = 0; s < 4; ++s) if (s < 2 * (nt + 1)) { const bf16x8 af = *(const LAS bf16x8*)(Kt + (32 * ct + c32) * T_LD + 16 * s + 8 * hf), bfr = *(const LAS bf16x8*)(Tb + (32 * nt + c32) * T_LD + 16 * s + 8 * hf); d = MFMA32(af, bfr, d); }
#pragma unroll
                    for (int r = 0; r < 16; ++r) d[r] = -d[r];
#pragma unroll
                    for (int sp = 0; sp < 2; ++sp) *(bf16x8*)(img + ((size_t)(FR_WN + nt * 8 + 2 * ct + sp) * 64 + lane) * 8) = PACK8(d, sp); } }
            }
            if (tid == 0) CD[chd] = egam[63];
            RAW_BAR();
        }
#undef PREP_LOADRAW
    }
}

__host__ __device__ constexpr int sc_p(int k) { const int j = k - 32; return j < 12 ? j % 6 : (j - 12) % 5; }
__host__ __device__ constexpr int sc_slab(int k) { const int j = k - 32; return k < 32 ? (k >> 2) : (j < 12 ? j / 6 : 2 + (j - 12) / 5); }
__host__ __device__ constexpr int sc_kind(int k) { return k < 32 ? ((k & 3) < 2 ? 0 : 1) : ((sc_p(k) == 2 || sc_p(k) == 5) ? 1 : 2); }
__host__ __device__ constexpr int sc_idx(int k) { return k < 32 ? (k & 1) : (sc_p(k) == 0 ? 0 : sc_p(k) == 1 ? 1 : sc_p(k) == 2 ? 1 : sc_p(k) == 3 ? 2 : sc_p(k) == 4 ? 3 : 0); }
__host__ __device__ constexpr int sc_frag(int k) { return k < 32 ? (((k & 3) < 2 ? FR_WN : FR_QD) + (k & 1) * 8 + (k >> 2)) : (sc_kind(k) == 1 ? FR_AQK + sc_idx(k) * 4 + sc_slab(k) : FR_KDT + sc_idx(k) * 4 + sc_slab(k)); }
constexpr int SC_QD = 8;
constexpr int SCB = 57344, OT_OFF = 2 * SCB, OT_LD = 136, OT_BYTES = 64 * OT_LD * 2;
static_assert(OT_OFF + 2 * OT_BYTES <= 152 * 1024, "scan LDS");
__device__ __forceinline__ void phase_dn_scan(const Frame& F0, const Args& a, int layer, int unit) {
    PHASE_FRAME(F0);
    unsigned char* ws = OPQ_G(unsigned char, a.ws);
    LAS unsigned char* lds = F.lds;
    const int b = unit >> 3, h = unit & 7, lane = F.lane;
    const bf16* IMG = (const bf16*)(ws + WS_IMG); const bf16* UIMG = (const bf16*)(ws + WS_UIMG); const float* CD = (const float*)(ws + WS_CD);
    const size_t chd0 = (size_t)b * NCH * NH + h;
    if (F.wave < 4) {
#ifndef SCAN_NO_COMPUTE
        const int w = F.wave, c32 = lane & 31, hf = lane >> 5;
        f32x16 S0, S1, S2, S3;
#pragma unroll
        for (int r = 0; r < 16; ++r) { S0[r] = 0.f; S1[r] = 0.f; S2[r] = 0.f; S3[r] = 0.f; }
        const float cdl = CD[chd0 + (size_t)lane * NH];
        v4u UA[4];
        const __amdgpu_buffer_rsrc_t rsU = __builtin_amdgcn_make_buffer_rsrc((void*)(UIMG + chd0 * UIMG_ELEMS), (short)0, NCH * NH * UIMG_ELEMS * 2, 0x00020000);
        const unsigned uoff = (unsigned)((w * 2) * 64 + lane) * 32u;
#define SC_LOADU(dst, nn) do { _Pragma("unroll") for (int mt_ = 0; mt_ < 2; ++mt_) { _Pragma("unroll") for (int hh_ = 0; hh_ < 2; ++hh_) dst[2 * mt_ + hh_] = __builtin_amdgcn_raw_buffer_load_b128(rsU, uoff + (unsigned)(mt_ * 2048 + hh_ * 16), (unsigned)(nn) * (unsigned)(NH * UIMG_ELEMS * 2), 0); } } while (0)
#define SC_FRAG(bufoff, fi) (*(const LAS bf16x8*)(lds + (bufoff) + (fi) * 1024 + lane * 16))
#define SC_CHUNK(nn, U, bufoff, otoff) do { \
        f32x16 aV0, aV1, aO0, aO1; bf16x8 fq0, fq1, fq2, fq3, fq4, fq5, fq6, fq7, Sbs, Vb0, Vb1, Vb2, Vb3; \
        _Pragma("unroll") for (int q = 0; q < 4; ++q) { aV0[2 * q] = bflo(U[0][q]); aV0[2 * q + 1] = bfhi(U[0][q]); aV0[8 + 2 * q] = bflo(U[1][q]); aV0[8 + 2 * q + 1] = bfhi(U[1][q]); \
            aV1[2 * q] = bflo(U[2][q]); aV1[2 * q + 1] = bfhi(U[2][q]); aV1[8 + 2 * q] = bflo(U[3][q]); aV1[8 + 2 * q + 1] = bfhi(U[3][q]); } \
        _Pragma("unroll") for (int r = 0; r < 16; ++r) { aO0[r] = 0.f; aO1[r] = 0.f; } \
        if ((nn) + 1 < NCH) SC_LOADU(U, (nn) + 1); \
        const float cd = __builtin_bit_cast(float, __builtin_amdgcn_readlane(__builtin_bit_cast(int, cdl), (nn))); \
        fq0 = SC_FRAG(bufoff, 0); \
        fq1 = SC_FRAG(bufoff, 8); \
        fq2 = SC_FRAG(bufoff, 16); \
        fq3 = SC_FRAG(bufoff, 24); \
        fq4 = SC_FRAG(bufoff, 1); \
        fq5 = SC_FRAG(bufoff, 9); \
        fq6 = SC_FRAG(bufoff, 17); \
        fq7 = SC_FRAG(bufoff, 25); \
        Sbs = PACK8(S0, 0); \
        aV0 = MFMA32(fq0, Sbs, aV0); \
        fq0 = SC_FRAG(bufoff, 2); \
        aV1 = MFMA32(fq1, Sbs, aV1); \
        fq1 = SC_FRAG(bufoff, 10); \
        aO0 = MFMA32(fq2, Sbs, aO0); \
        fq2 = SC_FRAG(bufoff, 18); \
        aO1 = MFMA32(fq3, Sbs, aO1); \
        fq3 = SC_FRAG(bufoff, 26); \
        Sbs = PACK8(S0, 1); \
        aV0 = MFMA32(fq4, Sbs, aV0); \
        fq4 = SC_FRAG(bufoff, 3); \
        aV1 = MFMA32(fq5, Sbs, aV1); \
        fq5 = SC_FRAG(bufoff, 11); \
        aO0 = MFMA32(fq6, Sbs, aO0); \
        fq6 = SC_FRAG(bufoff, 19); \
        aO1 = MFMA32(fq7, Sbs, aO1); \
        fq7 = SC_FRAG(bufoff, 27); \
        Sbs = PACK8(S1, 0); \
        aV0 = MFMA32(fq0, Sbs, aV0); \
        fq0 = SC_FRAG(bufoff, 4); \
        aV1 = MFMA32(fq1, Sbs, aV1); \
        fq1 = SC_FRAG(bufoff, 12); \
        aO0 = MFMA32(fq2, Sbs, aO0); \
        fq2 = SC_FRAG(bufoff, 20); \
        aO1 = MFMA32(fq3, Sbs, aO1); \
        fq3 = SC_FRAG(bufoff, 28); \
        Sbs = PACK8(S1, 1); \
        aV0 = MFMA32(fq4, Sbs, aV0); \
        fq4 = SC_FRAG(bufoff, 5); \
        aV1 = MFMA32(fq5, Sbs, aV1); \
        fq5 = SC_FRAG(bufoff, 13); \
        aO0 = MFMA32(fq6, Sbs, aO0); \
        fq6 = SC_FRAG(bufoff, 21); \
        aO1 = MFMA32(fq7, Sbs, aO1); \
        fq7 = SC_FRAG(bufoff, 29); \
        Sbs = PACK8(S2, 0); \
        aV0 = MFMA32(fq0, Sbs, aV0); \
        fq0 = SC_FRAG(bufoff, 6); \
        aV1 = MFMA32(fq1, Sbs, aV1); \
        fq1 = SC_FRAG(bufoff, 14); \
        aO0 = MFMA32(fq2, Sbs, aO0); \
        fq2 = SC_FRAG(bufoff, 22); \
        aO1 = MFMA32(fq3, Sbs, aO1); \
        fq3 = SC_FRAG(bufoff, 30); \
        Sbs = PACK8(S2, 1); \
        aV0 = MFMA32(fq4, Sbs, aV0); \
        fq4 = SC_FRAG(bufoff, 7); \
        aV1 = MFMA32(fq5, Sbs, aV1); \
        fq5 = SC_FRAG(bufoff, 15); \
        aO0 = MFMA32(fq6, Sbs, aO0); \
        fq6 = SC_FRAG(bufoff, 23); \
        aO1 = MFMA32(fq7, Sbs, aO1); \
        fq7 = SC_FRAG(bufoff, 31); \
        Sbs = PACK8(S3, 0); \
        aV0 = MFMA32(fq0, Sbs, aV0); \
        fq0 = SC_FRAG(bufoff, 40); \
        aV1 = MFMA32(fq1, Sbs, aV1); \
        fq1 = SC_FRAG(bufoff, 44); \
        aO0 = MFMA32(fq2, Sbs, aO0); \
        fq2 = SC_FRAG(bufoff, 36); \
        aO1 = MFMA32(fq3, Sbs, aO1); \
        fq3 = SC_FRAG(bufoff, 48); \
        Sbs = PACK8(S3, 1); \
        aV0 = MFMA32(fq4, Sbs, aV0); \
        fq4 = SC_FRAG(bufoff, 52); \
        aV1 = MFMA32(fq5, Sbs, aV1); \
        fq5 = SC_FRAG(bufoff, 32); \
        S0 = S0 * cd; S1 = S1 * cd; S2 = S2 * cd; S3 = S3 * cd; \
        aO0 = MFMA32(fq6, Sbs, aO0); \
        fq6 = SC_FRAG(bufoff, 41); \
        aO1 = MFMA32(fq7, Sbs, aO1); \
        fq7 = SC_FRAG(bufoff, 45); \
        Vb0 = PACK8(aV0, 0); Vb1 = PACK8(aV0, 1); Vb2 = PACK8(aV1, 0); Vb3 = PACK8(aV1, 1); \
        S0 = MFMA32(fq0, Vb0, S0); \
        fq0 = SC_FRAG(bufoff, 37); \
        S1 = MFMA32(fq1, Vb0, S1); \
        fq1 = SC_FRAG(bufoff, 49); \
        aO1 = MFMA32(fq2, Vb0, aO1); \
        fq2 = SC_FRAG(bufoff, 53); \
        S2 = MFMA32(fq3, Vb0, S2); \
        fq3 = SC_FRAG(bufoff, 33); \
        S3 = MFMA32(fq4, Vb0, S3); \
        fq4 = SC_FRAG(bufoff, 42); \
        aO0 = MFMA32(fq5, Vb0, aO0); \
        fq5 = SC_FRAG(bufoff, 46); \
        S0 = MFMA32(fq6, Vb1, S0); \
        fq6 = SC_FRAG(bufoff, 38); \
        S1 = MFMA32(fq7, Vb1, S1); \
        fq7 = SC_FRAG(bufoff, 50); \
        aO1 = MFMA32(fq0, Vb1, aO1); \
        fq0 = SC_FRAG(bufoff, 54); \
        S2 = MFMA32(fq1, Vb1, S2); \
        fq1 = SC_FRAG(bufoff, 43); \
        S3 = MFMA32(fq2, Vb1, S3); \
        fq2 = SC_FRAG(bufoff, 47); \
        aO0 = MFMA32(fq3, Vb1, aO0); \
        fq3 = SC_FRAG(bufoff, 39); \
        S0 = MFMA32(fq4, Vb2, S0); \
        fq4 = SC_FRAG(bufoff, 51); \
        S1 = MFMA32(fq5, Vb2, S1); \
        fq5 = SC_FRAG(bufoff, 55); \
        aO1 = MFMA32(fq6, Vb2, aO1); \
        S2 = MFMA32(fq7, Vb2, S2); \
        S3 = MFMA32(fq0, Vb2, S3); \
        S0 = MFMA32(fq1, Vb3, S0); \
        S1 = MFMA32(fq2, Vb3, S1); \
        aO1 = MFMA32(fq3, Vb3, aO1); \
        S2 = MFMA32(fq4, Vb3, S2); \
        S3 = MFMA32(fq5, Vb3, S3); \
        _Pragma("unroll") for (int r = 0; r < 16; ++r) { \
            *(LAS bf16*)(lds + (otoff) + (((r & 3) + 8 * (r >> 2) + 4 * hf) * OT_LD + 32 * w + c32) * 2) = (bf16)(pkbf(aO0[r], 0.f) & 0xffffu); \
            *(LAS bf16*)(lds + (otoff) + ((32 + (r & 3) + 8 * (r >> 2) + 4 * hf) * OT_LD + 32 * w + c32) * 2) = (bf16)(pkbf(aO1[r], 0.f) & 0xffffu); } \
        RAW_BAR(); } while (0)
        SC_LOADU(UA, 0);
        RAW_BAR();
#pragma unroll 1
        for (int n = 0; n < NCH; n += 2) { SC_CHUNK(n, UA, 0, OT_OFF); SC_CHUNK(n + 1, UA, SCB, OT_OFF + OT_BYTES); }
#undef SC_CHUNK
#undef SC_FRAG
#undef SC_LOADU
#endif
    } else {
#ifndef SCAN_NO_HELPER
        const int ht = F.tid - 256, tok = ht >> 2, q = ht & 3;
        bf16* OB = FP8_PDL(layer) ? (bf16*)((unsigned char*)a.out + 64 * MiB) : (bf16*)(ws + WS_MIXIN); const int old_ = FP8_PDL(layer) ? DNW : D;
        v4u RA[14], RB[14];
        const __amdgpu_buffer_rsrc_t rsI = __builtin_amdgcn_make_buffer_rsrc((void*)(IMG + chd0 * IMG_ELEMS), (short)0, NCH * NH * IMG_ELEMS * 2, 0x00020000);
#define SH_LOADIMG(dst, nn) do { _Pragma("unroll") for (int i_ = 0; i_ < 14; ++i_) dst[i_] = __builtin_amdgcn_raw_buffer_load_b128(rsI, (unsigned)ht * 16u, (unsigned)(nn) * (unsigned)(NH * IMG_ELEMS * 2) + (unsigned)i_ * 4096u, 0); } while (0)
#define SH_STOREIMG(src, bufoff) do { LAS v4u* p_ = (LAS v4u*)(lds + (bufoff)) + ht; _Pragma("unroll") for (int i_ = 0; i_ < 14; ++i_) p_[i_ * 256] = src[i_]; } while (0)
#define SH_EPI(mm, otoff) do { const LAS v4u* op_ = (const LAS v4u*)(lds + (otoff) + (tok * OT_LD + 32 * q) * 2); \
        v4u* yp_ = (v4u*)(OB + ((size_t)b * SEQ + (size_t)(mm) * CH + tok) * old_ + h * HD + 32 * q); \
        _Pragma("unroll") for (int i_ = 0; i_ < 4; ++i_) yp_[i_] = op_[i_]; } while (0)
#define SH_STEP(nn, Rcur, Rnext, bufnext, otprev) do { \
        if ((nn) + 2 < NCH) SH_LOADIMG(Rcur, (nn) + 2); \
        if ((nn) >= 1) SH_EPI((nn) - 1, otprev); \
        if ((nn) + 1 < NCH) SH_STOREIMG(Rnext, bufnext); \
        RAW_BAR(); } while (0)
        SH_LOADIMG(RA, 0); SH_LOADIMG(RB, 1);
        SH_STOREIMG(RA, 0);
        RAW_BAR();
#pragma unroll 1
        for (int n = 0; n < NCH; n += 2) { SH_STEP(n, RA, RB, SCB, OT_OFF + OT_BYTES); SH_STEP(n + 1, RB, RA, 0, OT_OFF); }
        SH_EPI(NCH - 1, OT_OFF + OT_BYTES);
#undef SH_STEP
#undef SH_EPI
#undef SH_STOREIMG
#undef SH_LOADIMG
#endif
    }
}

__device__ __forceinline__ void phase_dn_norm(const Frame& F0, const Args& a, int layer) {
    PHASE_FRAME(F0);
    unsigned char* ws = OPQ_G(unsigned char, a.ws);
    const bf16* PROJ = (const bf16*)(ws + WS_PROJ); bf16* MIXIN = (bf16*)(ws + WS_MIXIN);
    const bf16* OSRC = FP8_PDL(layer) ? (const bf16*)((unsigned char*)a.out + 64 * MiB) : (const bf16*)(ws + WS_MIXIN); const int old_ = FP8_PDL(layer) ? DNW : D;
    const int lane = F.lane, gw = F.vcu * NWAVES + F.wave, NGW = F.G * NWAVES;
    const float* nw = a.in[I_NORMW] + layer * HD + 16 * (lane & 7); f32x4 nwv[4];
#pragma unroll
    for (int i = 0; i < 4; ++i) nwv[i] = *(const f32x4*)(nw + 4 * i);
    v4u OA[2], ZA[2], OB[2], ZB[2];
#define DNN_LOAD(O_, Z_, t) do { const v4u* op_ = (const v4u*)(OSRC + (size_t)(t) * old_ + 16 * lane); const v4u* zp_ = (const v4u*)(PROJ + (size_t)(t) * NPROJ + 3072 + 16 * lane); O_[0] = op_[0]; O_[1] = op_[1]; Z_[0] = zp_[0]; Z_[1] = zp_[1]; } while (0)
#define DNN_ROW(O_, Z_, t) do { float ss = 0.f; \
        _Pragma("unroll") for (int i = 0; i < 2; ++i) _Pragma("unroll") for (int j = 0; j < 4; ++j) { const float x0 = bflo(O_[i][j]), x1 = bfhi(O_[i][j]); ss += x0 * x0 + x1 * x1; } \
        ss = row8_sum(ss); const float rr = 1.0f / sqrtf(ss * (1.0f / HD) + RMS_EPS); \
        v4u* yp_ = (v4u*)(MIXIN + (size_t)(t) * D + 16 * lane); float yv_[16]; \
        _Pragma("unroll") for (int i = 0; i < 2; ++i) { _Pragma("unroll") for (int j = 0; j < 4; ++j) { const float z0 = bflo(Z_[i][j]), z1 = bfhi(Z_[i][j]); const f32x4 nn = nwv[2 * i + (j >> 1)]; \
            yv_[8 * i + 2 * j] = bflo(O_[i][j]) * rr * nn[2 * (j & 1)] * z0 * sigmoidf_(z0); yv_[8 * i + 2 * j + 1] = bfhi(O_[i][j]) * rr * nn[2 * (j & 1) + 1] * z1 * sigmoidf_(z1); } } \
        if (FP8_PDL(layer)) { v4u o8_; _Pragma("unroll") for (int q4 = 0; q4 < 4; ++q4) o8_[q4] = pk4_fp8(yv_[4 * q4] * F8_XS, yv_[4 * q4 + 1] * F8_XS, yv_[4 * q4 + 2] * F8_XS, yv_[4 * q4 + 3] * F8_XS); *(v4u*)((unsigned char*)MIXIN + (size_t)(t) * D + 16 * lane) = o8_; } \
        else { _Pragma("unroll") for (int i = 0; i < 2; ++i) { v4u o_; _Pragma("unroll") for (int j = 0; j < 4; ++j) o_[j] = pkbf(yv_[8 * i + 2 * j], yv_[8 * i + 2 * j + 1]); yp_[i] = o_; } } } while (0)
    if (gw < T) DNN_LOAD(OA, ZA, gw);
#pragma unroll 1
    for (int t = gw; t < T; t += 2 * NGW) {
        if (t + NGW < T) DNN_LOAD(OB, ZB, t + NGW);
        DNN_ROW(OA, ZA, t);
        if (t + 2 * NGW < T) DNN_LOAD(OA, ZA, t + 2 * NGW);
        if (t + NGW < T) DNN_ROW(OB, ZB, t + NGW);
    }
#undef DNN_LOAD
#undef DNN_ROW
}

__device__ __forceinline__ void phase_ln1_router(const Frame& F0, const Args& a, int layer, int probe = 0, int f8 = 0) {
    PHASE_FRAME(F0);
    unsigned char* ws = OPQ_G(unsigned char, a.ws);
    LAS float* WRt = (LAS float*)F.lds;
    LAS float* GV = (LAS float*)(F.lds + RING_BYTES);
    LAS int* rowE = (LAS int*)(F.lds + AUX_OFF); LAS int* rowP = rowE + 128; LAS float* rowG = (LAS float*)(rowP + 128); LAS int* lcnt = (LAS int*)(rowG + 128); LAS int* lbase = lcnt + 16;
    const float* wr = OPQ_G(const float, a.in[I_WR]); const float* br = OPQ_G(const float, a.in[I_BR]);
    for (int idx = F.tid; idx < D * NE; idx += 512) WRt[(idx & 15) * D + (idx >> 4)] = wr[idx];
    { const float* g1 = a.in[I_LN1G] + (size_t)layer * D; const float* b1 = a.in[I_LN1B] + (size_t)layer * D; for (int i = F.tid; i < D; i += 512) { GV[i] = g1[i]; GV[D + i] = b1[i]; } }
    const bf16* PRE = (const bf16*)a.out; bf16* X1B = (bf16*)(ws + (probe ? WS_R1 : WS_X1B)); float* STATS = (float*)(ws + (probe ? WS_R1 + 70 * MiB : WS_STATS));
    int* LIST = (int*)(ws + (probe ? WS_R1 + 72 * MiB : WS_LIST)); int* TOKSLOT = (int*)(ws + (probe ? WS_R1 + 80 * MiB : WS_TOKSLOT)); float* GATEW = (float*)(ws + (probe ? WS_R1 + 82 * MiB : WS_GATEW));
    gu32* cnt = F.ctl + CW_CNT + 64 * (layer + (probe ? 2 : 0));
    const int lane = F.lane; const float brl = br[lane & 15];
    for (int rb = F.vcu; rb < T / 64; rb += F.G) {
        if (F.tid < 16) lcnt[F.tid] = 0;
        __syncthreads();
        v2u XA[8], XB_[8];
#define PE_LOAD(X, r) do { const GAS v2u* xr_ = (const GAS v2u*)(PRE + (size_t)(rb * 64 + F.wave * 8 + (r)) * D) + lane; _Pragma("unroll") for (int j = 0; j < 8; ++j) X[j] = xr_[64 * j]; } while (0)
#define PE_ROW(X, r) do { const int lr = F.wave * 8 + (r), row = rb * 64 + lr; unsigned gvo_ = (unsigned)(uintptr_t)GV; asm volatile("" : "+v"(gvo_)); const LAS float* GVr = (const LAS float*)(uintptr_t)gvo_; \
            f32x4 v[8]; float s = 0.f; \
            _Pragma("unroll") for (int j = 0; j < 8; ++j) { v[j] = (f32x4){bflo(X[j].x), bfhi(X[j].x), bflo(X[j].y), bfhi(X[j].y)}; s += (v[j][0] + v[j][1]) + (v[j][2] + v[j][3]); } \
            const float mean = wave_sum(s) * (1.f / D); float s2 = 0.f; \
            _Pragma("unroll") for (int j = 0; j < 8; ++j) { v[j] = v[j] - mean; s2 += (v[j][0] * v[j][0] + v[j][1] * v[j][1]) + (v[j][2] * v[j][2] + v[j][3] * v[j][3]); } \
            const float rstd = 1.f / sqrtf(wave_sum(s2) * (1.f / D) + LN_EPS); \
            if (lane == 0) { STATS[2 * row] = mean; STATS[2 * row + 1] = rstd; } \
            GAS v2u* o8 = (GAS v2u*)(X1B + (size_t)row * D) + lane; \
            f32x2 lg2[16]; \
            _Pragma("unroll") for (int e = 0; e < 16; ++e) lg2[e] = (f32x2){0.f, 0.f}; \
            _Pragma("unroll") for (int j = 0; j < 8; ++j) { const f32x4 gg = *(const LAS f32x4*)(GVr + 256 * j + 4 * lane), bb = *(const LAS f32x4*)(GVr + D + 256 * j + 4 * lane); \
                v[j] = v[j] * rstd * gg + bb; \
                if (f8) ((GAS unsigned*)((GAS unsigned char*)X1B + (size_t)row * D) + lane)[64 * j] = pk4_fp8(v[j][0] * F8_XS, v[j][1] * F8_XS, v[j][2] * F8_XS, v[j][3] * F8_XS); \
                else { v2u w; w.x = pkbf(v[j][0], v[j][1]); w.y = pkbf(v[j][2], v[j][3]); o8[64 * j] = w; } \
                const f32x2 vlo = {v[j][0], v[j][1]}, vhi = {v[j][2], v[j][3]}; \
                _Pragma("unroll") for (int e = 0; e < 16; ++e) { const f32x4 w4 = *(const LAS f32x4*)(WRt + e * D + 256 * j + 4 * lane); \
                    lg2[e] = __builtin_elementwise_fma(vlo, (f32x2){w4[0], w4[1]}, lg2[e]); lg2[e] = __builtin_elementwise_fma(vhi, (f32x2){w4[2], w4[3]}, lg2[e]); } } \
            float lg[16]; \
            _Pragma("unroll") for (int e = 0; e < 16; ++e) lg[e] = lg2[e][0] + lg2[e][1]; \
              \
            float t8[8], t4[4], t2[2], t1; \
            { const bool hi = (lane & 8) != 0; _Pragma("unroll") for (int i = 0; i < 8; ++i) { const float snd = hi ? lg[i] : lg[8 + i], kp = hi ? lg[8 + i] : lg[i]; t8[i] = kp + dpp_<DPP_XOR8>(snd); } } \
            { const bool hi = (lane & 4) != 0; _Pragma("unroll") for (int i = 0; i < 4; ++i) { const float snd = hi ? t8[i] : t8[4 + i], kp = hi ? t8[4 + i] : t8[i]; t4[i] = kp + dpp_<DPP_HMIRROR>(snd); } } \
            { const bool hi = (lane & 2) != 0; _Pragma("unroll") for (int i = 0; i < 2; ++i) { const float snd = hi ? t4[i] : t4[2 + i], kp = hi ? t4[2 + i] : t4[i]; t2[i] = kp + dpp_<DPP_XOR2>(snd); } } \
            { const bool hi = (lane & 1) != 0; const float snd = hi ? t2[0] : t2[1], kp = hi ? t2[1] : t2[0]; t1 = kp + dpp_<DPP_XOR1>(snd); } \
            t1 = xrow16_sum(t1) + brl; \
            float lgu[16]; float mx = -3.0e38f; \
            _Pragma("unroll") for (int e = 0; e < 16; ++e) { lgu[e] = __builtin_bit_cast(float, __builtin_amdgcn_readlane(__builtin_bit_cast(int, t1), e)); mx = fmaxf(mx, lgu[e]); } \
            float p[16]; \
            _Pragma("unroll") for (int e = 0; e < 16; ++e) p[e] = __expf(lgu[e] - mx); \
            float gsc[4]; \
            _Pragma("unroll") for (int g = 0; g < 4; ++g) { const float a0 = p[4 * g], a1 = p[4 * g + 1], a2 = p[4 * g + 2], a3 = p[4 * g + 3]; \
                const float hi1 = fmaxf(a0, a1), lo1 = fminf(a0, a1), hi2 = fmaxf(a2, a3), lo2 = fminf(a2, a3); \
                gsc[g] = fmaxf(hi1, hi2) + fmaxf(fminf(hi1, hi2), fmaxf(lo1, lo2)); } \
            int gsel = 0; float best = gsc[0]; \
            _Pragma("unroll") for (int g = 1; g < 4; ++g) if (gsc[g] > best) { best = gsc[g]; gsel = g; } \
            float q[4]; \
            _Pragma("unroll") for (int j = 0; j < 4; ++j) q[j] = gsel == 0 ? p[j] : (gsel == 1 ? p[4 + j] : (gsel == 2 ? p[8 + j] : p[12 + j])); \
            int i0 = 0; float p0 = q[0]; \
            _Pragma("unroll") for (int j = 1; j < 4; ++j) if (q[j] > p0) { p0 = q[j]; i0 = j; } \
            int i1 = -1; float p1 = -1.f; \
            _Pragma("unroll") for (int j = 0; j < 4; ++j) if (j != i0 && q[j] > p1) { p1 = q[j]; i1 = j; } \
            if (lane == 0) { const int e0 = gsel * 4 + i0, e1 = gsel * 4 + i1; const float inv = 1.0f / (p0 + p1); \
                rowE[2 * lr] = e0; rowE[2 * lr + 1] = e1; rowG[2 * lr] = p0 * inv; rowG[2 * lr + 1] = p1 * inv; \
                rowP[2 * lr] = __hip_atomic_fetch_add(&lcnt[e0], 1, __ATOMIC_RELAXED, __HIP_MEMORY_SCOPE_WORKGROUP); rowP[2 * lr + 1] = __hip_atomic_fetch_add(&lcnt[e1], 1, __ATOMIC_RELAXED, __HIP_MEMORY_SCOPE_WORKGROUP); } } while (0)
        PE_LOAD(XA, 0);
#pragma unroll 1
        for (int r = 0; r < 8; r += 2) { PE_LOAD(XB_, r + 1); PE_ROW(XA, r); if (r + 2 < 8) PE_LOAD(XA, r + 2); PE_ROW(XB_, r + 1); }
#undef PE_LOAD
#undef PE_ROW
        __syncthreads();
        if (F.tid < 16) lbase[F.tid] = (int)__hip_atomic_fetch_add(cnt + F.tid, (unsigned)lcnt[F.tid], RLX_AGENT);
        __syncthreads();
        if (F.tid < 128) { const int e = rowE[F.tid], pos = lbase[e] + rowP[F.tid], tok = rb * 64 + (F.tid >> 1);
            LIST[(size_t)e * LCAP + pos] = tok; TOKSLOT[2 * tok + (F.tid & 1)] = e * LCAP + pos; GATEW[2 * tok + (F.tid & 1)] = rowG[F.tid]; }
        __syncthreads();
    }
}
__device__ __forceinline__ void moe_table(const Frame& F0, int layer) {
    PHASE_FRAME(F0);
    LAS int* tab = (LAS int*)(F.lds + AUX_OFF);
    __syncthreads();
    if (F.tid < 16) tab[32 + F.tid] = (int)__hip_atomic_load(F.ctl + CW_CNT + 64 * layer + F.tid, RLX_AGENT);
    __syncthreads();
    if (F.tid == 0) { int blk = 0, nf = 0, nh = 0; for (int e = 0; e < 16; ++e) { const int cn = tab[32 + e]; tab[e] = blk; tab[48 + e] = nf; tab[80 + e] = nh; blk += (cn + 127) >> 7; nf += cn >> 8; nh += ((cn & 255) + 127) >> 7; } tab[16] = blk; tab[64] = nf; tab[96] = nh; }
    __syncthreads();
}
__device__ __forceinline__ void phase_combine_ln2(const Frame& F0, const Args& a, int layer, int probe = 0, int f8 = 0) {
    PHASE_FRAME(F0);
    unsigned char* ws = OPQ_G(unsigned char, a.ws); const LAS int* tab = (const LAS int*)(F.lds + AUX_OFF);
    const bf16* PRE = (const bf16*)a.out; const float* STATS = (const float*)(ws + WS_STATS); const bf16* Y = (const bf16*)(ws + WS_Y); bf16* X2B = (bf16*)(ws + (probe ? WS_R1 : WS_X2B)); unsigned char* X2F8 = ws + WS_X2F8;
    const int* TOKSLOT = (const int*)(ws + WS_TOKSLOT); const float* GATEW = (const float*)(ws + WS_GATEW);
    LAS float* GV = (LAS float*)F.lds;
    { const float* g1 = a.in[I_LN1G] + (size_t)layer * D; const float* b1 = a.in[I_LN1B] + (size_t)layer * D; const float* g2 = a.in[I_LN2G] + (size_t)layer * D; const float* b2 = a.in[I_LN2B] + (size_t)layer * D;
        for (int i = F.tid; i < D; i += 512) { GV[i] = g1[i]; GV[D + i] = b1[i]; GV[2 * D + i] = g2[i]; GV[3 * D + i] = b2[i]; } }
    __syncthreads();
    const int gw = F.vcu * NWAVES + F.wave, NGW = F.G * NWAVES, nrows = (T - gw + NGW - 1) / NGW, lane = F.lane;
    for (int base = 0; base < nrows; base += 64) {
        const int nr = (nrows - base) < 64 ? (nrows - base) : 64;
        float m_mean = 0.f, m_rstd = 0.f, m_w0 = 0.f, m_w1 = 0.f; int m_y0 = 0, m_y1 = 0;
        if (lane < nr) { const int row = gw + NGW * (base + lane); m_mean = STATS[2 * row]; m_rstd = STATS[2 * row + 1]; m_w0 = GATEW[2 * row]; m_w1 = GATEW[2 * row + 1];
            const int s0 = TOKSLOT[2 * row], s1 = TOKSLOT[2 * row + 1]; m_y0 = tab[s0 / LCAP] * 128 + (s0 % LCAP); m_y1 = tab[s1 / LCAP] * 128 + (s1 % LCAP); }
        v2u XA[8], PA[8], QA[8], XB_[8], PB_[8], QB_[8];
#define PH_LOAD(X, P, Q, i) do { const int row_ = gw + NGW * (base + (i)); const size_t y0_ = (size_t)__builtin_amdgcn_readlane(m_y0, (i)), y1_ = (size_t)__builtin_amdgcn_readlane(m_y1, (i)); \
            const GAS v2u* xr_ = (const GAS v2u*)(PRE + (size_t)row_ * D) + lane; const GAS v2u* ya_ = (const GAS v2u*)(Y + y0_ * D) + lane; const GAS v2u* yb_ = (const GAS v2u*)(Y + y1_ * D) + lane; \
            _Pragma("unroll") for (int j = 0; j < 8; ++j) { X[j] = xr_[64 * j]; P[j] = ya_[64 * j]; Q[j] = yb_[64 * j]; } } while (0)
#define PH_ROW(X, P, Q, i) do { const int row_ = gw + NGW * (base + (i)); unsigned gvo_ = (unsigned)(uintptr_t)GV; asm volatile("" : "+v"(gvo_)); const LAS float* GVr = (const LAS float*)(uintptr_t)gvo_;     \
            const float mean = __builtin_bit_cast(float, __builtin_amdgcn_readlane(__builtin_bit_cast(int, m_mean), (i))), rstd = __builtin_bit_cast(float, __builtin_amdgcn_readlane(__builtin_bit_cast(int, m_rstd), (i))); \
            const float w0 = __builtin_bit_cast(float, __builtin_amdgcn_readlane(__builtin_bit_cast(int, m_w0), (i))), w1 = __builtin_bit_cast(float, __builtin_amdgcn_readlane(__builtin_bit_cast(int, m_w1), (i))); \
            f32x4 v[8]; float s = 0.f; \
            _Pragma("unroll") for (int j = 0; j < 8; ++j) { const f32x4 gg = *(const LAS f32x4*)(GVr + 256 * j + 4 * lane), bb = *(const LAS f32x4*)(GVr + D + 256 * j + 4 * lane); \
                const f32x4 x1 = ((f32x4){bflo(X[j].x), bfhi(X[j].x), bflo(X[j].y), bfhi(X[j].y)} - mean) * rstd * gg + bb; \
                f32x4 f; f[0] = w0 * bflo(P[j].x) + w1 * bflo(Q[j].x); f[1] = w0 * bfhi(P[j].x) + w1 * bfhi(Q[j].x); f[2] = w0 * bflo(P[j].y) + w1 * bflo(Q[j].y); f[3] = w0 * bfhi(P[j].y) + w1 * bfhi(Q[j].y); \
                v[j] = x1 * ALPHA + f; s += (v[j][0] + v[j][1]) + (v[j][2] + v[j][3]); } \
            const float m2 = wave_sum(s) * (1.f / D); float q = 0.f; \
            _Pragma("unroll") for (int j = 0; j < 8; ++j) { v[j] = v[j] - m2; q += (v[j][0] * v[j][0] + v[j][1] * v[j][1]) + (v[j][2] * v[j][2] + v[j][3] * v[j][3]); } \
            const float r2 = 1.f / sqrtf(wave_sum(q) * (1.f / D) + LN_EPS); \
            GAS v2u* o8 = (GAS v2u*)(X2B + (size_t)row_ * D) + lane; \
            _Pragma("unroll") for (int j = 0; j < 8; ++j) { const f32x4 gg = *(const LAS f32x4*)(GVr + 2 * D + 256 * j + 4 * lane), bb = *(const LAS f32x4*)(GVr + 3 * D + 256 * j + 4 * lane); \
                const f32x4 o = v[j] * r2 * gg + bb; v2u w; w.x = pkbf(o[0], o[1]); w.y = pkbf(o[2], o[3]); o8[64 * j] = w; \
                if (f8) ((GAS unsigned*)((GAS unsigned char*)X2F8 + (size_t)row_ * D) + lane)[64 * j] = pk4_fp8(o[0] * F8_XS, o[1] * F8_XS, o[2] * F8_XS, o[3] * F8_XS); } } while (0)
        PH_LOAD(XA, PA, QA, 0);
#pragma unroll 1
        for (int i = 0; i < nr; i += 2) {
            if (i + 1 < nr) PH_LOAD(XB_, PB_, QB_, i + 1);
            PH_ROW(XA, PA, QA, i);
            if (i + 2 < nr) PH_LOAD(XA, PA, QA, i + 2);
            if (i + 1 < nr) PH_ROW(XB_, PB_, QB_, i + 1);
        }
#undef PH_LOAD
#undef PH_ROW
    }
}

#ifndef MK_N_LAUNCHES
#define MK_N_LAUNCHES 1
#endif
constexpr int NPL = 10;
constexpr int NPHASE = 1 + NPL * DEPTH;
constexpr int N_LAUNCHES = MK_N_LAUNCHES;
static_assert(N_LAUNCHES == 1 || N_LAUNCHES == NPHASE, "MK_N_LAUNCHES is 1 or NPHASE");

#define GRID_BAR() do { if (N_LAUNCHES == 1) xcd_barrier(bar); } while (0)
#ifndef PH_MASK
#define PH_MASK 0x7ff
#endif
#define IN(k) ((((k) == 0 ? 1u : (2u << (((k) - 1) % NPL))) & (unsigned)(PH_MASK)) && lo <= (k) && (k) < hi)
#define SEAM(k) do { if (IN((k) + 1)) GRID_BAR(); } while (0)
#ifndef PROBE_DUP
#define PROBE_DUP 0
#endif
#define REPS(k) ((((k) == 0 ? 1u : (2u << (((k) - 1) % NPL))) & (unsigned)(PROBE_DUP)) ? 2 : 1)

template <int layer> __device__ __forceinline__ void layer_phases(const Frame& F, const Args& args, const XcdBarrier& bar, const int lo, const int hi) {
            const int pb = 1 + NPL * layer;
            unsigned char* ws = OPQ_G(unsigned char, args.ws);
            if (IN(pb + 0)) { for (int rep = 0; rep < REPS(pb + 0); ++rep) { if (rep) GRID_BAR();
                SchedDense S; S.init(T, NPROJ, F.G, (int)blockIdx.x, ws + WS_XB, D, (const bf16*)(ws + WS_WIN) + (size_t)layer * NPROJ * D, D);
                EpiBf16 E{(bf16*)(ws + WS_PROJ), NPROJ};
                pg8::gemm_phase<EpiBf16, SchedDense, false>(F.lds + RING_OFF, D, D, D, S, E);
                } SEAM(pb + 0);
            }
            if (IN(pb + 1)) { for (int rep = 0; rep < REPS(pb + 1); ++rep) { if (rep) GRID_BAR(); phase_dn_prep(F, args, layer); } SEAM(pb + 1); }
            if (IN(pb + 2)) { for (int rep = 0; rep < REPS(pb + 2); ++rep) { if (rep) GRID_BAR();
                if (blockIdx.x < 32 || F.G <= 32) { for (int u = blockIdx.x; u < NB * NH; u += (F.G < 32 ? F.G : 32)) { phase_dn_scan(F, args, layer, u);
#ifdef SCAN_TWICE
                    __syncthreads(); phase_dn_scan(F, args, layer, u);
#endif
                } }
                if (blockIdx.x >= 32 || F.G <= 32) { const int G2 = F.G <= 32 ? F.G : F.G - 32, c2 = F.G <= 32 ? (int)blockIdx.x : (int)blockIdx.x - 32;
                    { int t_ = threadIdx.x; asm volatile("" : "+v"(t_)); Frame Fp = F; Fp.tid = t_; Fp.lane = t_ & 63;
                      for (int L = c2; L < 256; L += G2) pool_diffs_unit(Fp, ws, L >> 2, L & 3);
                      asm volatile("s_waitcnt vmcnt(0)" ::: "memory"); __syncthreads(); }
                    { SchedPool S{G2, c2, (const char*)(ws + WS_POOLD), (const char*)((const bf16*)(ws + WS_WPOOL) + (size_t)layer * 4 * 65536)};
                      EpiPool E{(bf16*)(ws + WS_MIXIN), args.in[I_POOLS] + (size_t)layer * PW, FP8_PDL(layer)};
                      pg8::gemm_phase<EpiPool, SchedPool, false>(F.lds + RING_OFF, 256, PW, 256, S, E); }
                    { SchedDense S; S.init(T, D, G2, c2, (const bf16*)(ws + WS_PB16) + (size_t)layer * T * PLE, PLE, (const bf16*)(ws + WS_WPP) + (size_t)layer * D * PLE, PLE);
                      EpiBf16 E{(bf16*)(ws + WS_PP), D};
                      pg8::gemm_phase<EpiBf16, SchedDense, false>(F.lds + RING_OFF, PLE, PLE, PLE, S, E); }
#ifndef CONVERT_ALL_IN_PROLOGUE
                    { int t_ = threadIdx.x; asm volatile("" : "+v"(t_)); const int per_ = F.G / 8 - 4, c2v_ = (F.G % 8 == 0 && F.G > 32) ? ((int)blockIdx.x % 8) * per_ + ((int)blockIdx.x / 8 - 4) : c2;
                  weight_items(args, ws, (LAS float*)(F.lds + RING_OFF + F.wave * 16384), t_ & 63, 1, layer, c2v_ * NWAVES + F.wave, G2 * NWAVES); }
#endif
                    }
                } SEAM(pb + 2);
            }
            if (IN(pb + 3)) { for (int rep = 0; rep < REPS(pb + 3); ++rep) { if (rep) GRID_BAR(); phase_dn_norm(F, args, layer); } SEAM(pb + 3); }
            if (IN(pb + 4)) { for (int rep = 0; rep < REPS(pb + 4); ++rep) { if (rep) GRID_BAR();
                if (FP8_PDL(layer)) { SchedDense S; S.init(T, D, F.G, (int)blockIdx.x, ws + WS_MIXIN, D / 2, ws + WS_WOUT + (size_t)layer * D * D * 2, D / 2);
                    EpiRes E{(const bf16*)(ws + WS_XB), (bf16*)args.out, F8_INV};
                    pg8::gemm_phase<EpiRes, SchedDense, false, true>(F.lds + RING_OFF, D / 2, D / 2, D / 2, S, E); }
                else { SchedDense S; S.init(T, D, F.G, (int)blockIdx.x, ws + WS_MIXIN, D, (const bf16*)(ws + WS_WOUT) + (size_t)layer * D * D, D);
                EpiRes E{(const bf16*)(ws + WS_XB), (bf16*)args.out};
#ifdef PROBE_PD
                { EpiRes E2{(const bf16*)(ws + WS_XB), (bf16*)(ws + WS_R1)}; pg8::gemm_phase<EpiRes, SchedDense, false>(F.lds + RING_OFF, D, D, D, S, E2); }
#endif
                pg8::gemm_phase<EpiRes, SchedDense, false>(F.lds + RING_OFF, D, D, D, S, E); }
                } SEAM(pb + 4);
            }
            if (IN(pb + 5)) { for (int rep = 0; rep < REPS(pb + 5); ++rep) { if (rep) GRID_BAR();
#ifdef PROBE_PE
                phase_ln1_router(F, args, layer, 1); __syncthreads();
#endif
                phase_ln1_router(F, args, layer, 0, FP8_LAYER(layer) ? 1 : 0); } SEAM(pb + 5); }
            if (IN(pb + 6)) { for (int rep = 0; rep < REPS(pb + 6); ++rep) { if (rep) GRID_BAR();
                moe_table(F, layer);
                if (FP8_LAYER(layer)) {
                    SchedMoe S{F.G, (int)blockIdx.x, 0, (const LAS int*)(F.lds + AUX_OFF), (const char*)(ws + WS_X1B), (const char*)(ws + WS_WGU + (size_t)layer * NE * 2048 * D * 2), (const int*)(ws + WS_LIST), 1};
                    EpiSwiglu E{(bf16*)(ws + WS_HID), FP8_PG, F8_INV};
                    pg8::gemm_phase<EpiSwiglu, SchedMoe, true, true>(F.lds + RING_OFF, D / 2, D / 2, D / 2, S, E);
                } else {
                    SchedMoe S{F.G, (int)blockIdx.x, 0, (const LAS int*)(F.lds + AUX_OFF), (const char*)(ws + WS_X1B), (const char*)((const bf16*)(ws + WS_WGU) + (size_t)layer * NE * 2048 * D), (const int*)(ws + WS_LIST), 2};
                    EpiSwiglu E{(bf16*)(ws + WS_HID)};
                    pg8::gemm_phase<EpiSwiglu, SchedMoe, true>(F.lds + RING_OFF, D, D, D, S, E);
                }
                } SEAM(pb + 6);
            }
            if (IN(pb + 7)) { for (int rep = 0; rep < REPS(pb + 7); ++rep) { if (rep) GRID_BAR();
                moe_table(F, layer);
                if (FP8_PG && FP8_LAYER(layer)) {
                    SchedMoe S{F.G, (int)blockIdx.x, 1, (const LAS int*)(F.lds + AUX_OFF), (const char*)(ws + WS_HID), (const char*)(ws + WS_WD + (size_t)layer * NE * D * DE * 2), nullptr, 1};
                    EpiBf16 E{(bf16*)(ws + WS_Y), D, F8_INV};
                    pg8::gemm_phase<EpiBf16, SchedMoe, false, true>(F.lds + RING_OFF, DE / 2, DE / 2, DE / 2, S, E);
                } else {
                    SchedMoe S{F.G, (int)blockIdx.x, 1, (const LAS int*)(F.lds + AUX_OFF), (const char*)(ws + WS_HID), (const char*)((const bf16*)(ws + WS_WD) + (size_t)layer * NE * D * DE), nullptr, 2};
                    EpiBf16 E{(bf16*)(ws + WS_Y), D};
                    pg8::gemm_phase<EpiBf16, SchedMoe, false>(F.lds + RING_OFF, DE, DE, DE, S, E);
                }
                } SEAM(pb + 7);
            }
            if (IN(pb + 8)) { for (int rep = 0; rep < REPS(pb + 8); ++rep) { if (rep) GRID_BAR(); moe_table(F, layer);
#ifdef PROBE_PH
                phase_combine_ln2(F, args, layer, 1);
#endif
                phase_combine_ln2(F, args, layer, 0, (FP8_PI && (FP8_PI0 || layer == DEPTH - 1)) ? 1 : 0); } SEAM(pb + 8); }
            if (IN(pb + 9)) { for (int rep = 0; rep < REPS(pb + 9); ++rep) { if (rep) GRID_BAR();
                if (FP8_PI && (FP8_PI0 || layer == DEPTH - 1)) {
                    SchedDense S; S.init(T, D, F.G, (int)blockIdx.x, ws + WS_X2F8, D / 2, ws + WS_WPG + (size_t)layer * D * D * 2, D / 2);
                    EpiPle E{(const bf16*)(ws + WS_X2B), (const bf16*)(ws + WS_PP), (bf16*)(ws + WS_XB), args.out, layer + 1 < DEPTH ? 0 : 1, F8_INV};
                    pg8::gemm_phase<EpiPle, SchedDense, false, true>(F.lds + RING_OFF, D / 2, D / 2, D / 2, S, E);
                } else {
                    SchedDense S; S.init(T, D, F.G, (int)blockIdx.x, ws + WS_X2B, D, (const bf16*)(ws + WS_WPG) + (size_t)layer * D * D, D);
                    EpiPle E{(const bf16*)(ws + WS_X2B), (const bf16*)(ws + WS_PP), (bf16*)(ws + WS_XB), args.out, layer + 1 < DEPTH ? 0 : 1};
                    pg8::gemm_phase<EpiPle, SchedDense, false>(F.lds + RING_OFF, D, D, D, S, E);
                }
                } SEAM(pb + 9);
            }
}
__global__ void __launch_bounds__(NWAVES * 64, 2) trunk_fwd(Args args) {
    extern __shared__ __attribute__((aligned(16))) unsigned char lds[];
    Frame F;
    F.lds = (LAS unsigned char*)lds;
    F.MISC = (volatile LAS unsigned*)(F.lds + MISC_OFF);
    F.tid = threadIdx.x; F.lane = F.tid & 63; F.wave = __builtin_amdgcn_readfirstlane(F.tid >> 6);
    F.G = gridDim.x; { const int bx = blockIdx.x; F.vcu = (F.G % 8 == 0) ? (bx % 8) * (F.G / 8) + bx / 8 : bx; }
    unsigned char* ws = args.ws;
    F.ctl = (gu32*)(ws + WS_CTL);
    for (int u = F.tid; u < (LDS_BYTES - LDSCTL_OFF) / 4; u += NWAVES * 64) ((LAS unsigned*)(F.lds + LDSCTL_OFF))[u] = 0u;
    __syncthreads();
    XcdBarrier bar; bar.bar = (unsigned*)(F.ctl + CW_BAR); bar.x = 0; bar.st = nullptr;
    if (N_LAUNCHES == 1) bar = xcd_barrier_post((unsigned*)(F.ctl + CW_BAR), F.MISC + 8);
    const int lo = args.ph_lo, hi = args.ph_hi;
    if (IN(0)) { for (int rep = 0; rep < REPS(0); ++rep) { if (rep) GRID_BAR(); p0_prologue(F, args); } SEAM(0); }

    layer_phases<0>(F, args, bar, lo, hi);
    layer_phases<1>(F, args, bar, lo, hi);
    static_assert(DEPTH == 2, "layer_phases instantiations");
#undef IN
#undef SEAM
#undef GRID_BAR
}

extern "C" void kernel_launch(void* const* d_in, const int* in_sizes, int n_in, void* d_out, int out_size, void* d_ws, size_t ws_size, hipStream_t stream) {
    static int grid = 0;
    if (grid == 0) {
        if (n_in != 21 || in_sizes[0] != T * D || out_size != T * D || ws_size < WS_END) { fprintf(stderr, "kernel_launch: unexpected shapes (n_in %d, in0 %d, out %d, ws %zu); nothing launched\n", n_in, n_in > 0 ? in_sizes[0] : -1, out_size, ws_size); grid = -1; return; }
        int dev = 0, cus = 0, per_cu = 0;
        if (hipGetDevice(&dev) != hipSuccess || hipDeviceGetAttribute(&cus, hipDeviceAttributeMultiprocessorCount, dev) != hipSuccess) { grid = -1; return; }
        if (hipFuncSetAttribute((const void*)trunk_fwd, hipFuncAttributeMaxDynamicSharedMemorySize, LDS_BYTES) != hipSuccess) { fprintf(stderr, "kernel_launch: hipFuncSetAttribute failed\n"); grid = -1; return; }
        if (hipOccupancyMaxActiveBlocksPerMultiprocessor(&per_cu, (const void*)trunk_fwd, NWAVES * 64, LDS_BYTES) != hipSuccess || per_cu < 1) { fprintf(stderr, "kernel_launch: occupancy query reports %d workgroups per CU\n", per_cu); }
        (void)hipGetLastError();
        grid = cus;
    }
    if (grid < 0) return;
    if (hipMemsetAsync((char*)d_ws + WS_CTL, 0, CTL_ZERO_BYTES, stream) != hipSuccess) return;
    Args a{};
    for (int i = 0; i < 21; ++i) a.in[i] = (const float*)d_in[i];
    a.out = (float*)d_out; a.ws = (unsigned char*)d_ws;
    for (int li = 0; li < N_LAUNCHES; ++li) {
        a.ph_lo = (N_LAUNCHES == 1) ? 0 : li; a.ph_hi = (N_LAUNCHES == 1) ? NPHASE : li + 1; a.li = li; a.pad = 0;
        hipLaunchKernelGGL(trunk_fwd, dim3(grid), dim3(NWAVES * 64), LDS_BYTES, stream, a);
        const hipError_t le = hipPeekAtLastError();
        if (le != hipSuccess) { fprintf(stderr, "kernel_launch: launch %d failed: %s\n", li, hipGetErrorName(le)); break; }
    }
}
```

```cpp
#define MK_N_LAUNCHES 1
#define FP8_ALL 1
#define FP8_PG 1
#define FP8_PI 1
#define FP8_PI0 1
#define FP8_PD 1
#include <hip/hip_runtime.h>
#include <cstdio>
#include <cstdint>

#define GAS __attribute__((address_space(1)))
#define LAS __attribute__((address_space(3)))
typedef unsigned short bf16;
typedef unsigned v4u __attribute__((ext_vector_type(4)));
typedef unsigned v2u __attribute__((ext_vector_type(2)));
typedef float f32x4 __attribute__((ext_vector_type(4)));
typedef float f32x2 __attribute__((ext_vector_type(2)));
typedef short bf16x8 __attribute__((ext_vector_type(8)));
typedef GAS unsigned gu32;
typedef int v4i_t __attribute__((ext_vector_type(4)));
typedef int v8i_t __attribute__((ext_vector_type(8)));

namespace pg8 {
constexpr int BM = 256, BK = 64, HALF = 128, HTB = HALF * BK * 2  , STAGE_BYTES = 8 * HTB, NXCD = 8, WGM = 8;
__host__ __device__ __forceinline__ int lds_byte(int r, int c) { const int st = (r >> 4) * 2 + (c >> 5), rr = r & 15, cc = c & 31, ob = rr * 64 + cc * 2; return st * 1024 + (ob ^ (((ob >> 9) & 1) << 5)); }
__host__ __device__ __forceinline__ void stage_rc(int b, int& R, int& C) { const int st = b / 1024, sb = b % 1024, swz = sb ^ (((sb >> 9) & 1) << 5); R = (st >> 1) * 16 + swz / 64; C = (st & 1) * 32 + (swz % 64) / 2; }
__host__ __device__ __forceinline__ int perm32(int rho) { const int n = rho >> 4, i = rho & 15; return 8 * (i >> 2) + 4 * n + (i & 3); }

struct Unit { int pm, pn; const char* A; const char* B; const int* rows; int nvalid; int aux; int rowbase; int half; };

__device__ __forceinline__ unsigned cvt_pk_bf16(float lo, float hi) { unsigned r; asm volatile("v_cvt_pk_bf16_f32 %0, %1, %2" : "=v"(r) : "v"(lo), "v"(hi)); return r; }

template <class Epi, class Sched, bool GATHER, bool FP8 = false>
__device__ __forceinline__ void gemm_phase(LAS unsigned char* lds, const int K, const int lda, const int ldb, const Sched& S, const Epi& E) {
    int tid_ = threadIdx.x; asm volatile("" : "+v"(tid_));
    const int tid = tid_, wid = __builtin_amdgcn_readfirstlane(tid >> 6), lane = tid & 63, wr = wid >> 2, wc = wid & 3, fr = lane & 15, fq = lane >> 4;
    const int nt = K / BK;
    unsigned voffA[2], voffB[2]; int RA[2], CA[2];
#pragma unroll
    for (int i = 0; i < 2; ++i) { int R, C; stage_rc(tid * 16 + i * 8192, R, C); const int Rb = Epi::PERM ? ((R & ~31) + perm32(R & 31)) : R;
        RA[i] = R; CA[i] = C; voffA[i] = (unsigned)(R * lda + C) * 2u; voffB[i] = (unsigned)(Rb * ldb + C) * 2u; }
    unsigned gA[2][2], gN[2][2];
    const size_t kstep = (size_t)(BK * 2);
    const size_t hstepA = GATHER ? 0 : (size_t)HALF * lda * 2, hstepB = (size_t)HALF * ldb * 2;
    const unsigned ldsw = (unsigned)wid * 1024u;
    const int aoff = lds_byte(wr * 64 + fr, fq * 8), boff = lds_byte(wc * 32 + fr, fq * 8);
#define PG8_SA(b, h) (((b) * 2 + (h)) * HTB)
#define PG8_SB(b, h) ((4 + (b) * 2 + (h)) * HTB)
#define PG8_STAGE_B(bufoff, gbase) do { _Pragma("unroll") for (int _i = 0; _i < 2; ++_i) \
        __builtin_amdgcn_global_load_lds((const unsigned*)((const char*)(gbase) + voffB[_i]), (LAS unsigned*)(lds + (bufoff) + ldsw + _i * 8192), 16, 0, 0); } while (0)
#define PG8_STAGE_A(bufoff, gbase, h) do { _Pragma("unroll") for (int _i = 0; _i < 2; ++_i) \
        __builtin_amdgcn_global_load_lds((const unsigned*)((const char*)(gbase) + (GATHER ? gA[h][_i] : voffA[_i]) + (h) * hstepA), (LAS unsigned*)(lds + (bufoff) + ldsw + _i * 8192), 16, 0, 0); } while (0)
#define PG8_CAT(x0, x1) __builtin_shufflevector(__builtin_bit_cast(v4i_t, (x0)), __builtin_bit_cast(v4i_t, (x1)), 0, 1, 2, 3, 4, 5, 6, 7)
#define PG8_LDA(dst, b, h) do { _Pragma("unroll") for (int m = 0; m < 4; ++m) { if constexpr (FP8) dst##8[m] = PG8_CAT(*(const LAS bf16x8*)(lds + PG8_SA(b, h) + aoff + m * 2048), *(const LAS bf16x8*)(lds + PG8_SA(b, h) + aoff + m * 2048 + 1024)); \
        else { _Pragma("unroll") for (int k = 0; k < 2; ++k) dst[m][k] = *(const LAS bf16x8*)(lds + PG8_SA(b, h) + aoff + m * 2048 + k * 1024); } } } while (0)
#define PG8_LDB(dst, b, h) do { _Pragma("unroll") for (int n = 0; n < 2; ++n) { if constexpr (FP8) dst##8[n] = PG8_CAT(*(const LAS bf16x8*)(lds + PG8_SB(b, h) + boff + n * 2048), *(const LAS bf16x8*)(lds + PG8_SB(b, h) + boff + n * 2048 + 1024)); \
        else { _Pragma("unroll") for (int k = 0; k < 2; ++k) dst[n][k] = *(const LAS bf16x8*)(lds + PG8_SB(b, h) + boff + n * 2048 + k * 1024); } } } while (0)
#define PG8_MMA(ai, bj, At, Bt) do { __builtin_amdgcn_s_setprio(1); \
        if constexpr (FP8) { _Pragma("unroll") for (int m = 0; m < 4; ++m) _Pragma("unroll") for (int n = 0; n < 2; ++n) \
            asm volatile("v_mfma_scale_f32_16x16x128_f8f6f4 %0, %1, %2, %0, %3, %3 op_sel_hi:[0,0,0]" : "+v"(acc[ai][bj][m][n]) : "v"(Bt##8[n]), "v"(At##8[m]), "v"(f8scale)); } \
        else { _Pragma("unroll") for (int m = 0; m < 4; ++m) _Pragma("unroll") for (int n = 0; n < 2; ++n) _Pragma("unroll") for (int k = 0; k < 2; ++k) \
            acc[ai][bj][m][n] = __builtin_amdgcn_mfma_f32_16x16x32_bf16(Bt[n][k], At[m][k], acc[ai][bj][m][n], 0, 0, 0); } \
        __builtin_amdgcn_s_setprio(0); } while (0)
#define PG8_WAIT_V(n) asm volatile("s_waitcnt vmcnt(" #n ")" ::: "memory")
#define PG8_WAIT_L(n) asm volatile("s_waitcnt lgkmcnt(" #n ")" ::: "memory")
#define PG8_BAR __builtin_amdgcn_s_barrier()
#define PG8_SCHED __builtin_amdgcn_sched_barrier(0)
#define PG8_GLOAD(dst, u) do { _Pragma("unroll") for (int _h = 0; _h < 2; ++_h) _Pragma("unroll") for (int _i = 0; _i < 2; ++_i) { const int _r = _h * HALF + RA[_i]; \
        const int _rc = _r < (u).nvalid ? _r : (u).nvalid - 1; const int _tl = (u).rows[_rc]; const int _t = (_r < (u).nvalid) ? _tl : 0; dst[_h][_i] = (unsigned)(_t * lda + CA[_i]) * 2u; } } while (0)
    Unit cur, nxt; int ui = 0;
    if (!S.next(0, cur)) return;
    f32x4 acc[2][2][4][2];
#pragma unroll
    for (int a = 0; a < 2; ++a)
#pragma unroll
        for (int b = 0; b < 2; ++b)
#pragma unroll
            for (int m = 0; m < 4; ++m)
#pragma unroll
                for (int n = 0; n < 2; ++n) acc[a][b][m][n] = (f32x4){0.f, 0.f, 0.f, 0.f};
    const unsigned f8scale = 0x7f7f7f7fu;
    bf16x8 At[4][2], B0[2][2], B1[2][2]; v8i_t At8[4], B08[2], B18[2];
    const char* cA = cur.A; const char* cB = cur.B;
    if constexpr (GATHER) { PG8_GLOAD(gA, cur); PG8_WAIT_V(0); }
    PG8_STAGE_B(PG8_SB(0, 0), cB); PG8_STAGE_B(PG8_SB(0, 1), cB + hstepB); PG8_STAGE_A(PG8_SA(0, 0), cA, 0); PG8_STAGE_A(PG8_SA(0, 1), cA, 1);
    if (wr == 1) PG8_BAR;
    PG8_WAIT_V(2); PG8_BAR;
    PG8_STAGE_B(PG8_SB(1, 0), cB + kstep); PG8_STAGE_A(PG8_SA(1, 0), cA + kstep, 0); PG8_STAGE_B(PG8_SB(1, 1), cB + hstepB + kstep);
    PG8_WAIT_V(6); PG8_BAR;
    for (;;) {
        const bool has_next = S.next(ui + 1, nxt); const bool halfu = Sched::RAGGED && cur.half != 0;
        const char* nA = has_next ? nxt.A : cA; const char* nB = has_next ? nxt.B : cB;
        if constexpr (GATHER) { if (has_next) { PG8_GLOAD(gN, nxt); } else {
#pragma unroll
            for (int h = 0; h < 2; ++h)
#pragma unroll
                for (int i = 0; i < 2; ++i) gN[h][i] = gA[h][i]; } }
#pragma unroll 1
        for (int t = 0; t < nt; t += 2) {
            const bool last = (t == nt - 2);
            const char* a1 = cA + (size_t)(t + 1) * kstep;
            const char* a2 = last ? nA : cA + (size_t)(t + 2) * kstep; const char* b2 = last ? nB : cB + (size_t)(t + 2) * kstep;
            const char* a3 = a2 + kstep; const char* b3 = b2 + kstep;
            PG8_LDB(B0, 0, 0); PG8_LDB(B1, 0, 1); PG8_SCHED; PG8_LDA(At, 0, 0); PG8_STAGE_A(PG8_SA(1, 1), a1, 1);
            if constexpr (GATHER) { if (last) {
#pragma unroll
                for (int h = 0; h < 2; ++h)
#pragma unroll
                    for (int i = 0; i < 2; ++i) gA[h][i] = gN[h][i]; } }
            PG8_WAIT_V(8); PG8_WAIT_L(0); PG8_BAR; PG8_MMA(0, 0, At, B0); PG8_MMA(0, 1, At, B1); PG8_BAR; PG8_SCHED;
            if (!halfu) PG8_LDA(At, 0, 1); PG8_STAGE_B(PG8_SB(0, 0), b2); PG8_STAGE_B(PG8_SB(0, 1), b2 + hstepB); PG8_STAGE_A(PG8_SA(0, 0), a2, 0);
            PG8_WAIT_V(8); PG8_WAIT_L(0); PG8_BAR; if (!halfu) { PG8_MMA(1, 0, At, B0); PG8_MMA(1, 1, At, B1); } PG8_BAR; PG8_SCHED;
            PG8_LDB(B0, 1, 0); PG8_LDB(B1, 1, 1); PG8_SCHED; PG8_LDA(At, 1, 0); PG8_STAGE_A(PG8_SA(0, 1), a2, 1);
            PG8_WAIT_V(8); PG8_WAIT_L(0); PG8_BAR; PG8_MMA(0, 0, At, B0); PG8_MMA(0, 1, At, B1); PG8_BAR; PG8_SCHED;
            if (!halfu) PG8_LDA(At, 1, 1); PG8_STAGE_B(PG8_SB(1, 0), b3); PG8_STAGE_B(PG8_SB(1, 1), b3 + hstepB); PG8_STAGE_A(PG8_SA(1, 0), a3, 0);
            PG8_WAIT_V(8); PG8_WAIT_L(0); PG8_BAR; if (!halfu) { PG8_MMA(1, 0, At, B0); PG8_MMA(1, 1, At, B1); } PG8_BAR; PG8_SCHED;
        }
        if (wr == 0) PG8_BAR;
        if constexpr (FP8) asm volatile("s_nop 15\n\ts_nop 15\n\ts_nop 15" ::: "memory");
        E(acc, cur, wr, wc, fr, fq);
        if (!has_next) break;
#pragma unroll
        for (int a = 0; a < 2; ++a)
#pragma unroll
            for (int b = 0; b < 2; ++b)
#pragma unroll
                for (int m = 0; m < 4; ++m)
#pragma unroll
                    for (int n = 0; n < 2; ++n) acc[a][b][m][n] = (f32x4){0.f, 0.f, 0.f, 0.f};
        cur = nxt; cA = nA; cB = nB; ++ui;
        if (wr == 1) PG8_BAR;
    }
    PG8_WAIT_V(0);
    PG8_BAR;
#undef PG8_SA
#undef PG8_SB
#undef PG8_STAGE_A
#undef PG8_STAGE_B
#undef PG8_LDA
#undef PG8_LDB
#undef PG8_MMA
#undef PG8_CAT
#undef PG8_WAIT_V
#undef PG8_WAIT_L
#undef PG8_BAR
#undef PG8_SCHED
#undef PG8_GLOAD
}
}

constexpr int NB = 4, SEQ = 4096, D = 2048, DEPTH = 2;
constexpr int T = NB * SEQ;
constexpr int NH = 8, HD = 128, DNW = 1024, CH = 64, NCH = SEQ / CH;
constexpr int PW = 1024, PG_DIM = 256;
constexpr int IN_COLS = 5136, NPROJ = 5120;
constexpr int NE = 16, DE = 1024, PLE = 256;
constexpr float ALPHA = 1.4142135623730951f;
constexpr float LN_EPS = 1e-5f, RMS_EPS = 1e-6f;
constexpr int LCAP = T;
constexpr int MAXTILES = 2 * T / 256 + NE;

constexpr size_t MiB = 1u << 20;
constexpr size_t WS_CTL = 0, CTL_ZERO_BYTES = 64 * 1024;
constexpr size_t WS_LIST = 2 * MiB;
constexpr size_t WS_TOKSLOT = 3 * MiB, WS_GATEW = WS_TOKSLOT + 128 * 1024, WS_STATS = WS_GATEW + 128 * 1024, WS_CD = WS_STATS + 128 * 1024, WS_WBA = WS_CD + 128 * 1024;
constexpr size_t WS_WIN = 4 * MiB, WS_WOUT = 44 * MiB, WS_WPG = 60 * MiB, WS_WPP = 76 * MiB, WS_WPOOL = 78 * MiB, WS_WGU = 80 * MiB, WS_WD = 336 * MiB, WS_PB16 = 464 * MiB;
constexpr size_t WS_XB = 480 * MiB, WS_R1 = 544 * MiB, WS_R2 = 704 * MiB, WS_R4 = 848 * MiB, WS_R5 = 944 * MiB, WS_END = 1008 * MiB;
constexpr size_t WS_PROJ = WS_R1, WS_HID = WS_R1;
constexpr size_t WS_Y = WS_R2;
constexpr size_t WS_POOLD = WS_R4, WS_PP = WS_R4 + 32 * MiB, WS_X1B = WS_R2;
constexpr size_t WS_MIXIN = WS_R5, WS_X2B = WS_R5;
constexpr size_t WS_X2F8 = WS_R1 + 96 * MiB;
static_assert((size_t)MAXTILES * 256 * 2048 * 2 <= 144 * MiB && (size_t)MAXTILES * 256 * 1024 * 2 <= 160 * MiB, "MoE row buffers");
constexpr int CW_TMO = 0, CW_CODE = 1, CW_CNT = 64  , CW_CONV = 512  , CW_BAR = 4096;

constexpr int RING_OFF = 0, RING_BYTES = 131072;
constexpr int LDSCTL_OFF = 152 * 1024, MISC_OFF = LDSCTL_OFF + 320;
constexpr int AUX_OFF = LDSCTL_OFF + 1024;
constexpr int LDS_BYTES = 163840;
constexpr int NWAVES = 8;

#define RLX_AGENT __ATOMIC_RELAXED, __HIP_MEMORY_SCOPE_AGENT
#define LDS_WAIT() asm volatile("s_waitcnt lgkmcnt(0)" ::: "memory")
#define VM_WAIT() asm volatile("s_waitcnt vmcnt(0)" ::: "memory")
__device__ __forceinline__ unsigned f2bf(float f) { unsigned u = __builtin_bit_cast(unsigned, f); return (u + 0x7fffu + ((u >> 16) & 1u)) >> 16; }
__device__ __forceinline__ unsigned pk2(float lo, float hi) { return f2bf(lo) | (f2bf(hi) << 16); }
typedef __bf16 bf2_t __attribute__((ext_vector_type(2)));
__device__ __forceinline__ unsigned pkbf(float lo, float hi) { const f32x2 v = {lo, hi}; return __builtin_bit_cast(unsigned, __builtin_convertvector(v, bf2_t)); }
constexpr float F8_XS = 16.0f, F8_WS = 256.0f, F8_INV = 1.0f / 4096.0f;
__device__ __forceinline__ float f8clamp(float x) { return fminf(fmaxf(x, -448.0f), 448.0f); }
__device__ __forceinline__ unsigned pk4_fp8(float a, float b, float c, float d) { unsigned w = 0u; w = (unsigned)__builtin_amdgcn_cvt_pk_fp8_f32(f8clamp(a), f8clamp(b), (int)w, false); w = (unsigned)__builtin_amdgcn_cvt_pk_fp8_f32(f8clamp(c), f8clamp(d), (int)w, true); return w; }
__device__ __forceinline__ float bf2f(unsigned short b) { return __builtin_bit_cast(float, ((unsigned)b) << 16); }
__device__ __forceinline__ float bflo(unsigned w) { return __builtin_bit_cast(float, w << 16); }
__device__ __forceinline__ float bfhi(unsigned w) { return __builtin_bit_cast(float, w & 0xffff0000u); }
__device__ __forceinline__ float sigmoidf_(float x) { return __builtin_amdgcn_rcpf(1.0f + __expf(-x)); }
template <int CTRL> __device__ __forceinline__ float dpp_(float x) { return __builtin_bit_cast(float, __builtin_amdgcn_mov_dpp(__builtin_bit_cast(int, x), CTRL, 0xf, 0xf, true)); }
constexpr int DPP_XOR1 = 0xB1, DPP_XOR2 = 0x4E, DPP_HMIRROR = 0x141, DPP_XOR8 = 0x128;
__device__ __forceinline__ float xrow16_sum(float x) {
    float p = x, q = x; asm volatile("v_nop\n\tv_nop\n\tv_permlane16_swap_b32 %0, %1" : "+v"(p), "+v"(q));
    x = p + q;
    float r = x, s = x; asm volatile("v_nop\n\tv_nop\n\tv_permlane32_swap_b32 %0, %1" : "+v"(r), "+v"(s));
    return r + s;
}
#ifdef OLD_SHUFFLES
__device__ __forceinline__ float row8_sum(float v) { v += __shfl_xor(v, 1); v += __shfl_xor(v, 2); v += __shfl_xor(v, 4); return v; }
__device__ __forceinline__ float wave_sum(float v) {
#pragma unroll
    for (int o = 1; o < 64; o <<= 1) v += __shfl_xor(v, o);
    return v; }
#else
__device__ __forceinline__ float row8_sum(float v) { v += dpp_<DPP_XOR1>(v); v += dpp_<DPP_XOR2>(v); v += dpp_<DPP_HMIRROR>(v); return v; }
__device__ __forceinline__ float wave_sum(float v) { v = row8_sum(v); v += dpp_<DPP_XOR8>(v); return xrow16_sum(v); }
#endif
#define XB_TMO      128
#define XB_XCNT(j)  (256  + 64 * (j))
#define XB_XSUB(j)  (1280 + 64 * (j))
#define XB_XGEN(j)  (2304 + 64 * (j))
#define XB_TOP      3328
#define XB_TOPGEN   3392
#define XCD_BAR_WORDS 3456
#define XB_SPIN_CAP (1u << 18)

__device__ __forceinline__ unsigned xb_ld(unsigned* p)              { return __hip_atomic_load(p, __ATOMIC_RELAXED, __HIP_MEMORY_SCOPE_AGENT); }
__device__ __forceinline__ unsigned xb_add(unsigned* p, unsigned v) { return __hip_atomic_fetch_add(p, v, __ATOMIC_RELAXED, __HIP_MEMORY_SCOPE_AGENT); }
__device__ __forceinline__ unsigned xb_xcc_id() { return (unsigned)__builtin_amdgcn_s_getreg((3 << 11) | 20) & 0xFu; }
#define XB_SPIN(cond, bar) do { unsigned _sp = 0; while (cond) { __builtin_amdgcn_s_sleep(1); \
    if ((++_sp & 255u) == 0u) { if (xb_ld(&(bar)[XB_TMO])) break; if (_sp > XB_SPIN_CAP) { atomicAdd(&(bar)[XB_TMO], 1u); break; } } } } while (0)

struct XcdBarrier {
    unsigned* bar; unsigned x;
    volatile LAS unsigned* st;
};

__device__ __forceinline__ XcdBarrier xcd_barrier_post(unsigned* bar, volatile LAS unsigned* st) {
    XcdBarrier b; b.bar = bar; b.x = xb_xcc_id(); b.st = st;
    if (threadIdx.x == 0) (void)xb_add(&bar[XB_XCNT(b.x)], 1u);
    return b;
}
__device__ __forceinline__ void xcd_barrier_complete(unsigned* bar, unsigned x, unsigned& nloc, unsigned& nx) {
    const unsigned G = gridDim.x * gridDim.y * gridDim.z;
    unsigned sum, cnt, mine, sp = 0u;
    for (;;) {
        sum = 0u; cnt = 0u; mine = 0u;
#pragma unroll
        for (unsigned j = 0; j < 16; ++j) { const unsigned c = xb_ld(&bar[XB_XCNT(j)]); sum += c; cnt += (c > 0u) ? 1u : 0u; mine = (j == x) ? c : mine; }
        if (sum == G) break;
        __builtin_amdgcn_s_sleep(1);
        if ((++sp & 255u) == 0u) { if (xb_ld(&bar[XB_TMO])) break; if (sp > XB_SPIN_CAP) { atomicAdd(&bar[XB_TMO], 1u); break; } }
    }
    nloc = mine > 0u ? mine : 1u; nx = cnt > 0u ? cnt : 1u;
}

__device__ __forceinline__ void xcd_barrier(const XcdBarrier& b) {
    asm volatile("s_waitcnt vmcnt(0)" ::: "memory");
    __syncthreads();
    if (threadIdx.x == 0) {
        unsigned* bar = b.bar;
        __builtin_amdgcn_s_waitcnt(0);
        unsigned nloc = b.st[0], nx = b.st[1];
        if (nloc == 0u) { xcd_barrier_complete(bar, b.x, nloc, nx); b.st[0] = nloc; b.st[1] = nx; }
        const unsigned old = xb_add(&bar[XB_XSUB(b.x)], 1u);
        const unsigned gen = old / nloc;
        if (old + 1u == (gen + 1u) * nloc) {
            __builtin_amdgcn_fence(__ATOMIC_RELEASE, "agent");
            asm volatile("s_waitcnt vmcnt(0)" ::: "memory");
            const unsigned og = xb_add(&bar[XB_TOP], 1u);
            const unsigned tg = og / nx;
            if (og + 1u == (tg + 1u) * nx) xb_add(&bar[XB_TOPGEN], 1u);
            else XB_SPIN(xb_ld(&bar[XB_TOPGEN]) == tg, bar);
            __builtin_amdgcn_fence(__ATOMIC_ACQUIRE, "agent");
            xb_add(&bar[XB_XGEN(b.x)], 1u);
            asm volatile("s_waitcnt vmcnt(0)" ::: "memory");
        } else {
            XB_SPIN(xb_ld(&bar[XB_XGEN(b.x)]) == gen, bar);
            __builtin_amdgcn_fence(__ATOMIC_ACQUIRE, "agent");
            asm volatile("s_waitcnt vmcnt(0)" ::: "memory");
        }
    }
    __syncthreads();
}

struct Args { const float* in[21]; float* out; unsigned char* ws; int ph_lo, ph_hi, li, pad; };
enum { I_X = 0, I_P, I_WIN, I_CONVW, I_ALOG, I_DTB, I_NORMW, I_POOLW, I_POOLS, I_WOUT, I_LN1G, I_LN1B, I_WR, I_BR, I_WEG, I_WEU, I_WED, I_LN2G, I_LN2B, I_WPP, I_WPG };
struct Frame {
    LAS unsigned char* lds;
    volatile LAS unsigned* MISC;
    gu32* ctl;
    int tid, lane, wave, vcu, G;
};

#ifndef FP8_LAST
#define FP8_LAST 1
#endif
#ifndef FP8_PG
#define FP8_PG 0
#endif
#ifndef FP8_ALL
#define FP8_ALL 0
#endif
#ifndef FP8_PD
#define FP8_PD 0
#endif
#ifndef FP8_PD_ALL
#define FP8_PD_ALL 0
#endif
#define FP8_PDL(l) (FP8_PD && (FP8_PD_ALL || (l) == DEPTH - 1))
#ifndef FP8_PI0
#define FP8_PI0 0
#endif
#define FP8_LAYER(l) (FP8_LAST && (FP8_ALL || (l) == DEPTH - 1))
#ifndef FP8_PI
#define FP8_PI 0
#endif
#define PHASE_FRAME(F0) Frame F = F0; { int t_ = threadIdx.x; asm volatile("" : "+v"(t_)); F.tid = t_; F.lane = t_ & 63; }
#define OPQ_S(p) asm volatile("" : "+s"(p))
#define OPQ_G(T, expr) ({ GAS T* g_ = (GAS T*)(expr); asm volatile("" : "+s"(g_)); (T*)g_; })
struct SchedDense {
    static constexpr bool RAGGED = false;
    int nM, nN, nwg, G, c; const char* A; const char* B; size_t astep, bstep;
    __device__ __forceinline__ void init(int M, int N, int G_, int c_, const void* A_, int lda, const void* B_, int ldb) { nM = M / 256; nN = N / 256; nwg = nM * nN; G = G_; c = c_;
        A = (const char*)A_; B = (const char*)B_; astep = (size_t)256 * lda * 2; bstep = (size_t)256 * ldb * 2; }
    __device__ __forceinline__ bool next(int i, pg8::Unit& u) const {
        const long L = (long)i * G + c; if (L >= nwg) return false;
        int wgid = (int)L; { const int q = nwg / 8, r = nwg % 8, xcd = wgid % 8, off = wgid / 8; wgid = (xcd < r ? xcd * (q + 1) : r * (q + 1) + (xcd - r) * q) + off; }
        const int nig = 8 * nN, gid = wgid / nig, fm = gid * 8, gsz = (nM - fm) < 8 ? (nM - fm) : 8;
        u.pm = fm + ((wgid % nig) % gsz); u.pn = (wgid % nig) / gsz;
        u.A = A + (size_t)u.pm * astep; u.B = B + (size_t)u.pn * bstep; u.rows = nullptr; u.nvalid = 256; u.aux = 0; u.rowbase = u.pm * 256; u.half = 0; return true;
    }
};
struct SchedPool {
    static constexpr bool RAGGED = false;
    int G, c; const char* A; const char* B;
    __device__ __forceinline__ bool next(int i, pg8::Unit& u) const {
        const int L = i * G + c; if (L >= 256) return false;
        u.pm = L >> 2; u.pn = L & 3; u.A = A + ((size_t)u.pm * 256 * PW + u.pn * 256) * 2; u.B = B + (size_t)u.pn * 65536 * 2; u.rows = nullptr; u.nvalid = 256; u.aux = 0; u.rowbase = u.pm * 256; u.half = 0; return true;
    }
};
struct SchedMoe {
    static constexpr bool RAGGED = true;
    int G, c, mode; const LAS int* tab; const char* A; const char* B; const int* list; int esz;
    __device__ __forceinline__ bool next(int i, pg8::Unit& u) const {
        const int L = i * G + c, nf = __builtin_amdgcn_readfirstlane(tab[64]), nh = __builtin_amdgcn_readfirstlane(tab[96]);
        if (L >= 8 * (nf + nh)) return false;
        const bool half = L >= 8 * nf; const int t = (half ? L - 8 * nf : L) >> 3, pn = L & 7, pbase = half ? 80 : 48;
        int e = 0;
#pragma unroll
        for (int k = 1; k < 16; ++k) { const int ts = __builtin_amdgcn_readfirstlane(tab[pbase + k]); if (t >= ts) e = k; }
        const int tl = t - __builtin_amdgcn_readfirstlane(tab[pbase + e]), cn = __builtin_amdgcn_readfirstlane(tab[32 + e]), blk = __builtin_amdgcn_readfirstlane(tab[e]);
        const int p0 = half ? ((cn >> 8) << 8) + 128 * tl : 256 * tl;
        u.pm = 0; u.pn = pn; u.aux = e; u.half = half ? 1 : 0; u.rowbase = blk * 128 + p0;
        const int nv = cn - p0; u.nvalid = nv < (half ? 128 : 256) ? nv : (half ? 128 : 256);
        if (mode == 0) { u.A = A; u.rows = list + (size_t)e * LCAP + p0; u.B = B + ((size_t)e * 2048 + pn * 256) * 2048 * esz; }
        else { u.A = A + (size_t)u.rowbase * DE * esz; u.rows = nullptr; u.B = B + ((size_t)e * 2048 + pn * 256) * DE * esz; }
        return true;
    }
};

using pg8::cvt_pk_bf16;
struct EpiBf16 {
    static constexpr bool PERM = true; bf16* O; int ldc; float scale = 1.0f;
    __device__ __forceinline__ void operator()(const f32x4 (&acc)[2][2][4][2], const pg8::Unit& u, int wr, int wc, int fr, int fq) const {
        const int row0 = u.rowbase + wr * 64 + fr, col0 = u.pn * 256 + wc * 32 + 8 * fq;
#pragma unroll
        for (int ai = 0; ai < 2; ++ai) if (ai == 0 || !u.half)
#pragma unroll
            for (int m = 0; m < 4; ++m) { bf16* rowp = O + (size_t)(row0 + ai * 128 + m * 16) * ldc + col0;
#pragma unroll
                for (int bj = 0; bj < 2; ++bj) { const f32x4 v0 = acc[ai][bj][m][0] * scale, v1 = acc[ai][bj][m][1] * scale;
                    v4u w; w.x = cvt_pk_bf16(v0[0], v0[1]); w.y = cvt_pk_bf16(v0[2], v0[3]); w.z = cvt_pk_bf16(v1[0], v1[1]); w.w = cvt_pk_bf16(v1[2], v1[3]);
                    *(v4u*)(rowp + bj * 128) = w; } }
    }
};
struct EpiPool {
    static constexpr bool PERM = true; bf16* O; const float* scale; int f8 = 0;
    __device__ __forceinline__ void operator()(const f32x4 (&acc)[2][2][4][2], const pg8::Unit& u, int wr, int wc, int fr, int fq) const {
        const int row0 = u.rowbase + wr * 64 + fr, cg = u.pn * 256 + wc * 32 + 8 * fq;
        f32x4 sv[2][2];
#pragma unroll
        for (int bj = 0; bj < 2; ++bj) { sv[bj][0] = *(const f32x4*)(scale + cg + bj * 128); sv[bj][1] = *(const f32x4*)(scale + cg + bj * 128 + 4); }
#pragma unroll
        for (int ai = 0; ai < 2; ++ai)
#pragma unroll
            for (int m = 0; m < 4; ++m) { bf16* rowp = O + (size_t)(row0 + ai * 128 + m * 16) * D + DNW + cg;
#pragma unroll
                for (int bj = 0; bj < 2; ++bj) { const f32x4 v0 = acc[ai][bj][m][0] * sv[bj][0], v1 = acc[ai][bj][m][1] * sv[bj][1];
                    if (f8) { v2u w8; w8.x = pk4_fp8(v0[0] * F8_XS, v0[1] * F8_XS, v0[2] * F8_XS, v0[3] * F8_XS); w8.y = pk4_fp8(v1[0] * F8_XS, v1[1] * F8_XS, v1[2] * F8_XS, v1[3] * F8_XS);
                        *(v2u*)((unsigned char*)O + (size_t)(row0 + ai * 128 + m * 16) * D + DNW + cg + bj * 128) = w8; }
                    else { v4u w; w.x = cvt_pk_bf16(v0[0], v0[1]); w.y = cvt_pk_bf16(v0[2], v0[3]); w.z = cvt_pk_bf16(v1[0], v1[1]); w.w = cvt_pk_bf16(v1[2], v1[3]);
                    *(v4u*)(rowp + bj * 128) = w; } } }
    }
};
struct EpiRes {
    static constexpr bool PERM = true; const bf16* XB; bf16* PRE; float ascale = 1.0f;
    __device__ __forceinline__ void operator()(const f32x4 (&acc)[2][2][4][2], const pg8::Unit& u, int wr, int wc, int fr, int fq) const {
        const int row0 = u.rowbase + wr * 64 + fr, col0 = u.pn * 256 + wc * 32 + 8 * fq;
#pragma unroll
        for (int ai = 0; ai < 2; ++ai) { v4u xq[4][2];
#pragma unroll
            for (int m = 0; m < 4; ++m)
#pragma unroll
                for (int bj = 0; bj < 2; ++bj) xq[m][bj] = *(const v4u*)(XB + (size_t)(row0 + ai * 128 + m * 16) * D + col0 + bj * 128);
            asm volatile("" : "+v"(xq[0][0]), "+v"(xq[0][1]), "+v"(xq[1][0]), "+v"(xq[1][1]), "+v"(xq[2][0]), "+v"(xq[2][1]), "+v"(xq[3][0]), "+v"(xq[3][1]));
#pragma unroll
            for (int m = 0; m < 4; ++m)
#pragma unroll
                for (int bj = 0; bj < 2; ++bj) { const size_t off = (size_t)(row0 + ai * 128 + m * 16) * D + col0 + bj * 128; const v4u x = xq[m][bj]; const f32x4 a0 = acc[ai][bj][m][0] * ascale, a1 = acc[ai][bj][m][1] * ascale;
                    v4u w; w.x = cvt_pk_bf16(bflo(x.x) * ALPHA + a0[0], bfhi(x.x) * ALPHA + a0[1]); w.y = cvt_pk_bf16(bflo(x.y) * ALPHA + a0[2], bfhi(x.y) * ALPHA + a0[3]);
                    w.z = cvt_pk_bf16(bflo(x.z) * ALPHA + a1[0], bfhi(x.z) * ALPHA + a1[1]); w.w = cvt_pk_bf16(bflo(x.w) * ALPHA + a1[2], bfhi(x.w) * ALPHA + a1[3]);
                    *(v4u*)(PRE + off) = w; } }
    }
};
struct EpiSwiglu {
    static constexpr bool PERM = true; bf16* O; int f8 = 0; float ascale = 1.0f;
    __device__ __forceinline__ void operator()(const f32x4 (&acc)[2][2][4][2], const pg8::Unit& u, int wr, int wc, int fr, int fq) const {
        const int row0 = u.rowbase + wr * 64 + fr, col0 = u.pn * 128 + wc * 32 + 8 * fq;
#pragma unroll
        for (int ai = 0; ai < 2; ++ai) if (ai == 0 || !u.half)
#pragma unroll
            for (int m = 0; m < 4; ++m) { bf16* rowp = O + (size_t)(row0 + ai * 128 + m * 16) * DE + col0;
                float h[8];
#pragma unroll
                for (int n = 0; n < 2; ++n)
#pragma unroll
                    for (int j = 0; j < 4; ++j) { const float g = acc[ai][0][m][n][j] * ascale, up = acc[ai][1][m][n][j] * ascale; h[4 * n + j] = g * sigmoidf_(g) * up; }
                if (f8) { v2u w8; w8.x = pk4_fp8(h[0] * F8_XS, h[1] * F8_XS, h[2] * F8_XS, h[3] * F8_XS); w8.y = pk4_fp8(h[4] * F8_XS, h[5] * F8_XS, h[6] * F8_XS, h[7] * F8_XS);
                    *(v2u*)((unsigned char*)O + (size_t)(row0 + ai * 128 + m * 16) * DE + col0) = w8; }
                else { v4u w; w.x = cvt_pk_bf16(h[0], h[1]); w.y = cvt_pk_bf16(h[2], h[3]); w.z = cvt_pk_bf16(h[4], h[5]); w.w = cvt_pk_bf16(h[6], h[7]);
                *(v4u*)rowp = w; } }
    }
};
struct EpiPle {
    static constexpr bool PERM = true; const bf16* X2B; const bf16* PP; bf16* XB; float* OUT; int last; float ascale = 1.0f;
    __device__ __forceinline__ void operator()(const f32x4 (&acc)[2][2][4][2], const pg8::Unit& u, int wr, int wc, int fr, int fq) const {
        const int row0 = u.rowbase + wr * 64 + fr, col0 = u.pn * 256 + wc * 32 + 8 * fq;
#pragma unroll
        for (int ai = 0; ai < 2; ++ai)
#pragma unroll
            for (int mp = 0; mp < 2; ++mp) { v4u xq[2][2], pq[2][2];
#pragma unroll
                for (int mm = 0; mm < 2; ++mm)
#pragma unroll
                    for (int bj = 0; bj < 2; ++bj) { const size_t off = (size_t)(row0 + ai * 128 + (2 * mp + mm) * 16) * D + col0 + bj * 128; xq[mm][bj] = *(const v4u*)(X2B + off); pq[mm][bj] = *(const v4u*)(PP + off); }
                asm volatile("" : "+v"(xq[0][0]), "+v"(xq[0][1]), "+v"(xq[1][0]), "+v"(xq[1][1]), "+v"(pq[0][0]), "+v"(pq[0][1]), "+v"(pq[1][0]), "+v"(pq[1][1]));
#pragma unroll
                for (int mm = 0; mm < 2; ++mm)
#pragma unroll
                    for (int bj = 0; bj < 2; ++bj) { const int m = 2 * mp + mm; const size_t off = (size_t)(row0 + ai * 128 + m * 16) * D + col0 + bj * 128;
                        const v4u xx = xq[mm][bj], pp = pq[mm][bj];
                        const f32x4 a0 = acc[ai][bj][m][0] * ascale, a1 = acc[ai][bj][m][1] * ascale;
                        f32x4 o0, o1;
                        o0[0] = bflo(xx.x) + sigmoidf_(a0[0]) * bflo(pp.x); o0[1] = bfhi(xx.x) + sigmoidf_(a0[1]) * bfhi(pp.x); o0[2] = bflo(xx.y) + sigmoidf_(a0[2]) * bflo(pp.y); o0[3] = bfhi(xx.y) + sigmoidf_(a0[3]) * bfhi(pp.y);
                        o1[0] = bflo(xx.z) + sigmoidf_(a1[0]) * bflo(pp.z); o1[1] = bfhi(xx.z) + sigmoidf_(a1[1]) * bfhi(pp.z); o1[2] = bflo(xx.w) + sigmoidf_(a1[2]) * bflo(pp.w); o1[3] = bfhi(xx.w) + sigmoidf_(a1[3]) * bfhi(pp.w);
                        if (last) { *(f32x4*)(OUT + off) = o0; *(f32x4*)(OUT + off + 4) = o1; }
                        else { v4u w; w.x = cvt_pk_bf16(o0[0], o0[1]); w.y = cvt_pk_bf16(o0[2], o0[3]); w.z = cvt_pk_bf16(o1[0], o1[1]); w.w = cvt_pk_bf16(o1[2], o1[3]); *(v4u*)(XB + off) = w; } } }
    }
};

__device__ __forceinline__ void tr_item(const float* W, int ldw, int k0, int n0, bf16* WT, size_t drow0, int ldt, LAS float* scr, int lane) {
#pragma unroll 8
    for (int i = 0; i < 32; ++i) { const int kk = 2 * i + (lane >> 5); scr[kk * 33 + (lane & 31)] = W[(size_t)(k0 + kk) * ldw + n0 + (lane & 31)]; }
    LDS_WAIT(); asm volatile("" ::: "memory");
    const int c = lane & 7;
#pragma unroll
    for (int j = 0; j < 4; ++j) { const int n = (lane >> 3) + 8 * j; const LAS float* s = scr + (8 * c) * 33 + n;
        v4u o; o.x = pk2(s[0 * 33], s[1 * 33]); o.y = pk2(s[2 * 33], s[3 * 33]); o.z = pk2(s[4 * 33], s[5 * 33]); o.w = pk2(s[6 * 33], s[7 * 33]);
        *(GAS v4u*)(WT + (drow0 + n) * ldt + k0 + 8 * c) = o; }
    LDS_WAIT(); asm volatile("" ::: "memory");
}
__device__ __forceinline__ void tr_item8(const float* W, int ldw, int k0, int n0, unsigned char* WT, size_t drow0, int ldt, LAS float* scr, int lane) {
#pragma unroll 8
    for (int i = 0; i < 32; ++i) { const int kk = 2 * i + (lane >> 5); scr[kk * 33 + (lane & 31)] = W[(size_t)(k0 + kk) * ldw + n0 + (lane & 31)]; }
    LDS_WAIT(); asm volatile("" ::: "memory");
    const int c = lane & 7;
#pragma unroll
    for (int j = 0; j < 4; ++j) { const int n = (lane >> 3) + 8 * j; const LAS float* s = scr + (8 * c) * 33 + n;
        v2u o; o.x = pk4_fp8(s[0 * 33] * F8_WS, s[1 * 33] * F8_WS, s[2 * 33] * F8_WS, s[3 * 33] * F8_WS); o.y = pk4_fp8(s[4 * 33] * F8_WS, s[5 * 33] * F8_WS, s[6 * 33] * F8_WS, s[7 * 33] * F8_WS);
        *(GAS v2u*)(WT + (drow0 + n) * ldt + k0 + 8 * c) = o; }
    LDS_WAIT(); asm volatile("" ::: "memory");
}
__device__ __forceinline__ void weight_items(const Args& a, unsigned char* ws, LAS float* scr, int lane, int group, int l, int gw, int NGW, gu32* ctr = nullptr) {
    constexpr int I_INA = 32 * 128, I_INB = 32 * 32, I_OUT = 32 * 64, I_PG = 32 * 64, I_PP = 4 * 64, I_POOL = 4 * 32, I_EG = NE * 32 * 32, I_EU = I_EG, I_ED = NE * 16 * 64;
    if (group == 0) {
        for (int it = gw; it < I_INA + I_INB + I_PP + I_POOL; it += NGW) { int r = it;
            if (r < I_INA) { const int kb = r / 128, nb = r % 128; tr_item(a.in[I_WIN] + (size_t)l * D * IN_COLS, IN_COLS, 64 * kb, 32 * nb, (bf16*)(ws + WS_WIN) + (size_t)l * NPROJ * D, 32 * nb, D, scr, lane); continue; } r -= I_INA;
            if (r < I_INB) { const int kb = r / 32, nb = r % 32; tr_item(a.in[I_WIN] + (size_t)l * D * IN_COLS, IN_COLS, 64 * kb, 4112 + 32 * nb, (bf16*)(ws + WS_WIN) + (size_t)l * NPROJ * D, 4096 + 32 * nb, D, scr, lane); continue; } r -= I_INB;
            if (r < I_PP) { const int kb = r / 64, nb = r % 64; tr_item(a.in[I_WPP] + (size_t)l * PLE * D, D, 64 * kb, 32 * nb, (bf16*)(ws + WS_WPP) + (size_t)l * D * PLE, 32 * nb, PLE, scr, lane); continue; } r -= I_PP;
            { const int g = r / 32, rr = r % 32, kb = rr / 8, nb = rr % 8; tr_item(a.in[I_POOLW] + ((size_t)l * 4 + g) * 65536, 256, 64 * kb, 32 * nb, (bf16*)(ws + WS_WPOOL) + ((size_t)l * 4 + g) * 65536, 32 * nb, 256, scr, lane); } }
    } else {
        const bool f8 = FP8_LAYER(l);
        constexpr int NIT = I_OUT + I_PG + I_EG + I_EU + I_ED;
        int it = gw - NGW, kk = 8; unsigned cb = 0u;
        for (;;) {
            if (ctr) { if (kk == 8) { unsigned b = 0u; if (lane == 0) b = __hip_atomic_fetch_add(ctr, 8u, RLX_AGENT); cb = (unsigned)__builtin_amdgcn_readfirstlane((int)b); kk = 0; if (cb >= (unsigned)NIT) break; }
                it = (int)cb + kk; ++kk; if (it >= NIT) continue; }
            else { it += NGW; if (it >= NIT) break; }
            int r = it;
            if (r < I_OUT) { const int kb = r / 64, nb = r % 64; if (FP8_PDL(l)) tr_item8(a.in[I_WOUT] + (size_t)l * D * D, D, 64 * kb, 32 * nb, ws + WS_WOUT + (size_t)l * D * D * 2, 32 * nb, D, scr, lane); else tr_item(a.in[I_WOUT] + (size_t)l * D * D, D, 64 * kb, 32 * nb, (bf16*)(ws + WS_WOUT) + (size_t)l * D * D, 32 * nb, D, scr, lane); continue; } r -= I_OUT;
            if (r < I_PG) { const int kb = r / 64, nb = r % 64; if (FP8_PI && (FP8_PI0 || l == DEPTH - 1)) tr_item8(a.in[I_WPG] + (size_t)l * D * D, D, 64 * kb, 32 * nb, ws + WS_WPG + (size_t)l * D * D * 2, 32 * nb, D, scr, lane); else tr_item(a.in[I_WPG] + (size_t)l * D * D, D, 64 * kb, 32 * nb, (bf16*)(ws + WS_WPG) + (size_t)l * D * D, 32 * nb, D, scr, lane); continue; } r -= I_PG;
            if (r < I_EG) { const int e = r / 1024, rr = r % 1024, kb = rr / 32, nb = rr % 32, h0 = 32 * nb;
                if (f8) tr_item8(a.in[I_WEG] + ((size_t)l * NE + e) * D * DE, DE, 64 * kb, h0, ws + WS_WGU + (size_t)l * NE * 2048 * D * 2 + (size_t)e * 2048 * D, (size_t)(h0 >> 7) * 256 + (h0 & 127), D, scr, lane);
                else tr_item(a.in[I_WEG] + ((size_t)l * NE + e) * D * DE, DE, 64 * kb, h0, (bf16*)(ws + WS_WGU) + ((size_t)l * NE + e) * 2048 * D, (size_t)(h0 >> 7) * 256 + (h0 & 127), D, scr, lane); continue; } r -= I_EG;
            if (r < I_EU) { const int e = r / 1024, rr = r % 1024, kb = rr / 32, nb = rr % 32, h0 = 32 * nb;
                if (f8) tr_item8(a.in[I_WEU] + ((size_t)l * NE + e) * D * DE, DE, 64 * kb, h0, ws + WS_WGU + (size_t)l * NE * 2048 * D * 2 + (size_t)e * 2048 * D, (size_t)(h0 >> 7) * 256 + 128 + (h0 & 127), D, scr, lane);
                else tr_item(a.in[I_WEU] + ((size_t)l * NE + e) * D * DE, DE, 64 * kb, h0, (bf16*)(ws + WS_WGU) + ((size_t)l * NE + e) * 2048 * D, (size_t)(h0 >> 7) * 256 + 128 + (h0 & 127), D, scr, lane); continue; } r -= I_EU;
            { const int e = r / 1024, rr = r % 1024, kb = rr / 64, nb = rr % 64;
                if (f8 && FP8_PG) tr_item8(a.in[I_WED] + ((size_t)l * NE + e) * DE * D, D, 64 * kb, 32 * nb, ws + WS_WD + (size_t)l * NE * D * DE * 2 + (size_t)e * D * DE, 32 * nb, DE, scr, lane);
                else tr_item(a.in[I_WED] + ((size_t)l * NE + e) * DE * D, D, 64 * kb, 32 * nb, (bf16*)(ws + WS_WD) + ((size_t)l * NE + e) * D * DE, 32 * nb, DE, scr, lane); } }
    }
}
__device__ __forceinline__ void p0_prologue(const Frame& F0, const Args& a) {
    PHASE_FRAME(F0);
    LAS float* scr = (LAS float*)(F.lds + RING_OFF + F.wave * 16384);
    const int gw = F.vcu * NWAVES + F.wave, NGW = F.G * NWAVES;
    unsigned char* ws = OPQ_G(unsigned char, a.ws);
#pragma unroll 1
    for (int l = 0; l < DEPTH; ++l) weight_items(a, ws, scr, F.lane, 0, l, gw, NGW);
#ifdef CONVERT_ALL_IN_PROLOGUE
#pragma unroll 1
    for (int l = 0; l < DEPTH; ++l) weight_items(a, ws, scr, F.lane, 1, l, gw, NGW);
#endif
    const size_t gt = (size_t)F.vcu * 512 + F.tid, NGT = (size_t)F.G * 512;
    { const GAS f32x4* src = (const GAS f32x4*)a.in[I_X]; GAS v4u* dst = (GAS v4u*)(ws + WS_XB);
        for (size_t i = gt; i < (size_t)T * D / 8; i += NGT) { const f32x4 v0 = src[2 * i], v1 = src[2 * i + 1]; v4u o; o.x = pk2(v0[0], v0[1]); o.y = pk2(v0[2], v0[3]); o.z = pk2(v1[0], v1[1]); o.w = pk2(v1[2], v1[3]); dst[i] = o; } }
    { const GAS f32x4* src = (const GAS f32x4*)a.in[I_P]; GAS v4u* dst = (GAS v4u*)(ws + WS_PB16);
        for (size_t i = gt; i < (size_t)DEPTH * T * PLE / 8; i += NGT) { const f32x4 v0 = src[2 * i], v1 = src[2 * i + 1]; v4u o; o.x = pk2(v0[0], v0[1]); o.y = pk2(v0[2], v0[3]); o.z = pk2(v1[0], v1[1]); o.w = pk2(v1[2], v1[3]); dst[i] = o; } }
    for (size_t i = gt; i < (size_t)DEPTH * 16 * D; i += NGT) { const int l = (int)(i / (16 * D)), j = (int)((i / D) % 16), k = (int)(i % D);
        ((bf16*)(ws + WS_WBA))[i] = (bf16)f2bf(a.in[I_WIN][((size_t)l * D + k) * IN_COLS + 4096 + j]); }
}

typedef float f32x16 __attribute__((ext_vector_type(16)));
#define MFMA32(a_, b_, c_) __builtin_amdgcn_mfma_f32_32x32x16_bf16((a_), (b_), (c_), 0, 0, 0)
#define PACK8(x, sp) __builtin_bit_cast(bf16x8, (v4u){pkbf((x)[8 * (sp)], (x)[8 * (sp) + 1]), pkbf((x)[8 * (sp) + 2], (x)[8 * (sp) + 3]), pkbf((x)[8 * (sp) + 4], (x)[8 * (sp) + 5]), pkbf((x)[8 * (sp) + 6], (x)[8 * (sp) + 7])})
#define RAW_BAR() do { asm volatile("s_waitcnt lgkmcnt(0)" ::: "memory"); __builtin_amdgcn_s_barrier(); asm volatile("" ::: "memory"); } while (0)
constexpr int IMG_ELEMS = 56 * 512, UIMG_ELEMS = 8 * 1024;
constexpr int FR_WN = 0, FR_QD = 16, FR_AQK = 32, FR_KDT = 40;
constexpr size_t WS_IMG = WS_R2, WS_UIMG = WS_R2 + 112 * MiB;
static_assert((size_t)NB * NCH * NH * IMG_ELEMS * 2 == 112 * MiB && (size_t)NB * NCH * NH * UIMG_ELEMS * 2 == 32 * MiB, "DeltaNet images");

__device__ __forceinline__ void pool_diffs_unit(const Frame& F, unsigned char* ws, int pm, int g) {
    const bf16* PROJ = (const bf16*)(ws + WS_PROJ); bf16* POOLD = (bf16*)(ws + WS_POOLD);
    const int tid = F.tid, cp = tid & 127, rq = tid >> 7, r0 = 256 * pm + 64 * rq, sq0 = r0 % SEQ, col = 256 * g + 2 * cp;
    const bf16* up = PROJ + (size_t)r0 * NPROJ + 4096 + col; bf16* dp = POOLD + (size_t)r0 * PW + col;
#define POOL_BODY(WIN) do { unsigned xr[CH + WIN - 1]; \
        _Pragma("unroll") for (int j = 0; j < WIN - 1; ++j) xr[j] = (sq0 - (WIN - 1) + j >= 0) ? *(const unsigned*)(up + (ptrdiff_t)(j - (WIN - 1)) * NPROJ) : 0u; \
        _Pragma("unroll") for (int i = 0; i < CH; ++i) xr[WIN - 1 + i] = *(const unsigned*)(up + (size_t)i * NPROJ); \
        float s0 = 0.f, s1 = 0.f; \
        _Pragma("unroll") for (int j = 0; j < WIN - 1; ++j) { s0 += bflo(xr[j]); s1 += bfhi(xr[j]); } \
        _Pragma("unroll") for (int i = 0; i < CH; ++i) { const float x0 = bflo(xr[WIN - 1 + i]), x1 = bfhi(xr[WIN - 1 + i]); s0 += x0; s1 += x1; \
            const int pos = sq0 + i; const float inv = __builtin_amdgcn_rcpf((float)((pos + 1) < WIN ? (pos + 1) : WIN)); \
            *(unsigned*)(dp + (size_t)i * PW) = pkbf(s0 * inv - x0, s1 * inv - x1); s0 -= bflo(xr[i]); s1 -= bfhi(xr[i]); } } while (0)
    if (g == 0) POOL_BODY(2); else if (g == 1) POOL_BODY(4); else if (g == 2) POOL_BODY(8); else POOL_BODY(16);
#undef POOL_BODY
}
#ifndef PREP_DUP
#define PREP_DUP 0
#endif
constexpr int PQF = 0, PKF = 33792, PQS = 67584, PKS = 84992, PVT = 102400, PKT = 120832, PTAB = 139264;
constexpr int PAS = PQF;
constexpr int PTB = PKF, PT11T = PKF + 9216, PPART = PKF;
constexpr int F_LD = 132, S_LD = 136, T_LD = 72, A_LD = 68, TT_LD = 40;
__device__ __forceinline__ void phase_dn_prep(const Frame& F0, const Args& a, int layer) {
    PHASE_FRAME(F0);
    unsigned char* ws = OPQ_G(unsigned char, a.ws);
    LAS unsigned char* lds = F.lds;
    LAS float* Qf = (LAS float*)(lds + PQF); LAS float* Kf = (LAS float*)(lds + PKF); LAS float* As = (LAS float*)(lds + PAS);
    LAS bf16* Qs = (LAS bf16*)(lds + PQS); LAS bf16* Ks = (LAS bf16*)(lds + PKS); LAS bf16* Vt = (LAS bf16*)(lds + PVT); LAS bf16* Kt = (LAS bf16*)(lds + PKT);
    LAS bf16* Tb = (LAS bf16*)(lds + PTB); LAS bf16* T11t = (LAS bf16*)(lds + PT11T);
    LAS float* betaS = (LAS float*)(lds + PTAB); LAS float* gS = betaS + 512; LAS float* gamh = gS + 512; LAS float* betah = gamh + 64; LAS float* egam = betah + 64; LAS float* bgam = egam + 64; LAS float* ekd = bgam + 64; LAS float* rkS = ekd + 64;
    const bf16* XB = (const bf16*)(ws + WS_XB); const bf16* PROJ = (const bf16*)(ws + WS_PROJ); const bf16* WBA = (const bf16*)(ws + WS_WBA) + (size_t)layer * 16 * D;
    bf16* IMG = (bf16*)(ws + WS_IMG); bf16* UIMG = (bf16*)(ws + WS_UIMG); float* CD = (float*)(ws + WS_CD);
    const float* convw = a.in[I_CONVW] + (size_t)layer * 4 * 3072; const float* alog = a.in[I_ALOG] + layer * NH; const float* dtb = a.in[I_DTB] + layer * NH;
    const int tid = F.tid, lane = F.lane, wave = F.wave, c32 = lane & 31, hf = lane >> 5;
    for (int unit = F.vcu; unit < NB * NCH; unit += F.G) {
        const int b = unit / NCH, n = unit % NCH, r0 = b * SEQ + n * CH, sq0 = n * CH;
        for (int rep_ = 0; rep_ < ((PREP_DUP & 64) ? 2 : 1); ++rep_)
        { typedef float f32x4v __attribute__((ext_vector_type(4)));
            const int fr = lane & 15, fg = lane >> 4; f32x4v pacc[4];
#pragma unroll
            for (int mt = 0; mt < 4; ++mt) pacc[mt] = (f32x4v){0.f, 0.f, 0.f, 0.f};
#pragma unroll 1
            for (int sb = 0; sb < 8; sb += 4) {
                bf16x8 bq[4], aq[4][4];
#pragma unroll
                for (int s = 0; s < 4; ++s) { const int k0 = 256 * wave + 32 * (sb + s) + 8 * fg; bq[s] = *(const bf16x8*)(WBA + (size_t)fr * D + k0);
#pragma unroll
                    for (int mt = 0; mt < 4; ++mt) aq[s][mt] = *(const bf16x8*)(XB + (size_t)(r0 + 16 * mt + fr) * D + k0); }
                asm volatile("" : "+v"(bq[0]), "+v"(bq[1]), "+v"(bq[2]), "+v"(bq[3]), "+v"(aq[0][0]), "+v"(aq[0][1]), "+v"(aq[0][2]), "+v"(aq[0][3]), "+v"(aq[1][0]), "+v"(aq[1][1]), "+v"(aq[1][2]), "+v"(aq[1][3]),
                             "+v"(aq[2][0]), "+v"(aq[2][1]), "+v"(aq[2][2]), "+v"(aq[2][3]), "+v"(aq[3][0]), "+v"(aq[3][1]), "+v"(aq[3][2]), "+v"(aq[3][3]));
#pragma unroll
                for (int s = 0; s < 4; ++s)
#pragma unroll
                    for (int mt = 0; mt < 4; ++mt) pacc[mt] = __builtin_amdgcn_mfma_f32_16x16x32_bf16(aq[s][mt], bq[s], pacc[mt], 0, 0, 0); }
            LAS float* part = (LAS float*)(lds + PPART) + wave * 1024;
#pragma unroll
            for (int mt = 0; mt < 4; ++mt)
#pragma unroll
                for (int r = 0; r < 4; ++r) part[(16 * mt + 4 * fg + r) * 16 + fr] = pacc[mt][r]; }
        __syncthreads();
        { const int tok = tid >> 3, cp = tid & 7; float s0 = 0.f, s1 = 0.f;
#pragma unroll
            for (int w = 0; w < 8; ++w) { const f32x2 p2 = *(const LAS f32x2*)((LAS float*)(lds + PPART) + w * 1024 + tok * 16 + 2 * cp); s0 += p2[0]; s1 += p2[1]; }
            if (cp < 4) { betaS[tok * 8 + 2 * cp] = sigmoidf_(s0); betaS[tok * 8 + 2 * cp + 1] = sigmoidf_(s1); }
            else { const int h = 2 * (cp - 4); const float z0 = s0 + dtb[h], z1 = s1 + dtb[h + 1];
                const float sp0 = z0 > 20.f ? z0 : log1pf(__expf(z0)), sp1 = z1 > 20.f ? z1 : log1pf(__expf(z1));
                gS[tok * 8 + h] = -__expf(alog[h]) * sp0; gS[tok * 8 + h + 1] = -__expf(alog[h + 1]) * sp1; } }
        __syncthreads();
        { float gv = gS[lane * 8 + wave];
#pragma unroll
            for (int o = 1; o < 64; o <<= 1) { const float up_ = __shfl_up(gv, o); if (lane >= o) gv += up_; }
            gS[lane * 8 + wave] = gv; }
        __syncthreads();
        unsigned craw[3][11]; unsigned cdum[3][8];
#define PREP_LOADRAW(hh) do { const int cp_ = tid & 63, i0_ = (tid >> 6) * 8; \
            _Pragma("unroll") for (int part_ = 0; part_ < 3; ++part_) { const bf16* src_ = PROJ + (size_t)(r0 + i0_ - 3) * NPROJ + part_ * 1024 + (hh) * HD + 2 * cp_; \
                _Pragma("unroll") for (int j_ = 0; j_ < 11; ++j_) craw[part_][j_] = (sq0 + i0_ - 3 + j_ >= 0) ? *(const unsigned*)(src_ + (ptrdiff_t)j_ * NPROJ) : 0u; \
                if (PREP_DUP & 256) { _Pragma("unroll") for (int j_ = 3; j_ < 11; ++j_) cdum[part_][j_ - 3] = *(const unsigned*)(src_ + (ptrdiff_t)j_ * NPROJ + ((hh) ^ 1) * HD - (hh) * HD); } } } while (0)
        PREP_LOADRAW(0);
        for (int hh_ = 0; hh_ < ((PREP_DUP & 128) ? 2 * NH : NH); ++hh_) { const int h = hh_ & (NH - 1);
            const size_t chd = (size_t)unit * NH + h; bf16* img = IMG + chd * IMG_ELEMS; bf16* uimg = UIMG + chd * UIMG_ELEMS;
            if (tid < 64) { const float gi = gS[tid * 8 + h], bi = betaS[tid * 8 + h], eg = __expf(gi); gamh[tid] = gi; betah[tid] = bi; egam[tid] = eg; bgam[tid] = bi * eg; ekd[tid] = __expf(gS[63 * 8 + h] - gi); }
            RAW_BAR();
            for (int rep_ = 0; rep_ < ((PREP_DUP & 16) ? 2 : 1); ++rep_)
            { const int cp = tid & 63, rg8 = tid >> 6, i0 = rg8 * 8;
                if (PREP_DUP & 256) {
#pragma unroll
                    for (int p_ = 0; p_ < 3; ++p_)
#pragma unroll
                        for (int j_ = 0; j_ < 8; ++j_) asm volatile("" :: "v"(cdum[p_][j_])); }
#pragma unroll
                for (int part = 0; part < 3; ++part) { const int col = part * 1024 + h * HD + 2 * cp;
                    const f32x2 cw0 = *(const f32x2*)(convw + col), cw1 = *(const f32x2*)(convw + 3072 + col), cw2 = *(const f32x2*)(convw + 2 * 3072 + col), cw3 = *(const f32x2*)(convw + 3 * 3072 + col);
                    float ya[8], yb[8];
#pragma unroll
                    for (int i = 0; i < 8; ++i) { const unsigned x3 = craw[part][i], x2 = craw[part][i + 1], x1 = craw[part][i + 2], x0 = craw[part][i + 3];
                        const float ta = cw0[0] * bflo(x3) + cw1[0] * bflo(x2) + cw2[0] * bflo(x1) + cw3[0] * bflo(x0), tb = cw0[1] * bfhi(x3) + cw1[1] * bfhi(x2) + cw2[1] * bfhi(x1) + cw3[1] * bfhi(x0);
                        ya[i] = ta * sigmoidf_(ta); yb[i] = tb * sigmoidf_(tb); }
                    if (part == 0) {
#pragma unroll
                        for (int i = 0; i < 8; ++i) *(LAS f32x2*)(Qf + (i0 + i) * F_LD + 2 * cp) = (f32x2){ya[i], yb[i]}; }
                    else if (part == 1) {
#pragma unroll
                        for (int i = 0; i < 8; ++i) *(LAS f32x2*)(Kf + (i0 + i) * F_LD + 2 * cp) = (f32x2){ya[i], yb[i]}; }
                    else { v4u o0, o1;
                        o0.x = pkbf(ya[0] * betah[i0 + 0], ya[1] * betah[i0 + 1]); o0.y = pkbf(ya[2] * betah[i0 + 2], ya[3] * betah[i0 + 3]); o0.z = pkbf(ya[4] * betah[i0 + 4], ya[5] * betah[i0 + 5]); o0.w = pkbf(ya[6] * betah[i0 + 6], ya[7] * betah[i0 + 7]);
                        o1.x = pkbf(yb[0] * betah[i0 + 0], yb[1] * betah[i0 + 1]); o1.y = pkbf(yb[2] * betah[i0 + 2], yb[3] * betah[i0 + 3]); o1.z = pkbf(yb[4] * betah[i0 + 4], yb[5] * betah[i0 + 5]); o1.w = pkbf(yb[6] * betah[i0 + 6], yb[7] * betah[i0 + 7]);
                        *(LAS v4u*)(Vt + (2 * cp) * T_LD + i0) = o0; *(LAS v4u*)(Vt + (2 * cp + 1) * T_LD + i0) = o1; } }
            }
            if (hh_ + 1 < ((PREP_DUP & 128) ? 2 * NH : NH)) PREP_LOADRAW((hh_ + 1) & (NH - 1));
            for (int rep_ = 0; rep_ < ((PREP_DUP & 1) ? 2 : 1); ++rep_) { if (rep_) RAW_BAR();
            { const int i = tid >> 3, part = tid & 7; const LAS float* qp = Qf + i * F_LD + part * 16; const LAS float* kp = Kf + i * F_LD + part * 16;
                f32x4 qv[4], kv[4]; float sq = 0.f, sk = 0.f;
#pragma unroll
                for (int j = 0; j < 4; ++j) { qv[j] = *(const LAS f32x4*)(qp + 4 * j); kv[j] = *(const LAS f32x4*)(kp + 4 * j);
                    sq += (qv[j][0] * qv[j][0] + qv[j][1] * qv[j][1]) + (qv[j][2] * qv[j][2] + qv[j][3] * qv[j][3]); sk += (kv[j][0] * kv[j][0] + kv[j][1] * kv[j][1]) + (kv[j][2] * kv[j][2] + kv[j][3] * kv[j][3]); }
                sq = row8_sum(sq); sk = row8_sum(sk);
                const float rq = 1.0f / sqrtf(sq + RMS_EPS) * 0.08838834764831845f, rk = 1.0f / sqrtf(sk + RMS_EPS);
                if (part == 0) rkS[i] = rk;
#pragma unroll
                for (int j = 0; j < 4; ++j) { qv[j] = qv[j] * rq; kv[j] = kv[j] * rk; }
                v4u w0, w1;
                w0.x = pkbf(qv[0][0], qv[0][1]); w0.y = pkbf(qv[0][2], qv[0][3]); w0.z = pkbf(qv[1][0], qv[1][1]); w0.w = pkbf(qv[1][2], qv[1][3]); w1.x = pkbf(qv[2][0], qv[2][1]); w1.y = pkbf(qv[2][2], qv[2][3]); w1.z = pkbf(qv[3][0], qv[3][1]); w1.w = pkbf(qv[3][2], qv[3][3]);
                *(LAS v4u*)(Qs + i * S_LD + part * 16) = w0; *(LAS v4u*)(Qs + i * S_LD + part * 16 + 8) = w1;
                w0.x = pkbf(kv[0][0], kv[0][1]); w0.y = pkbf(kv[0][2], kv[0][3]); w0.z = pkbf(kv[1][0], kv[1][1]); w0.w = pkbf(kv[1][2], kv[1][3]); w1.x = pkbf(kv[2][0], kv[2][1]); w1.y = pkbf(kv[2][2], kv[2][3]); w1.z = pkbf(kv[3][0], kv[3][1]); w1.w = pkbf(kv[3][2], kv[3][3]);
                *(LAS v4u*)(Ks + i * S_LD + part * 16) = w0; *(LAS v4u*)(Ks + i * S_LD + part * 16 + 8) = w1;
                const float eg = egam[i]; bf16* fq = img + ((size_t)(FR_QD + (i >> 5) * 8 + part) * 64 + (i & 31)) * 8;
                v4u h0, h1;
                h0.x = pkbf(qv[0][0] * eg, qv[0][1] * eg); h0.y = pkbf(qv[0][2] * eg, qv[0][3] * eg); h0.z = pkbf(qv[2][0] * eg, qv[2][1] * eg); h0.w = pkbf(qv[2][2] * eg, qv[2][3] * eg);
                h1.x = pkbf(qv[1][0] * eg, qv[1][1] * eg); h1.y = pkbf(qv[1][2] * eg, qv[1][3] * eg); h1.z = pkbf(qv[3][0] * eg, qv[3][1] * eg); h1.w = pkbf(qv[3][2] * eg, qv[3][3] * eg);
                *(v4u*)fq = h0; *(v4u*)(fq + 32 * 8) = h1; }
            RAW_BAR();
            { const int c = tid & 127, rg = tid >> 7; float kb[16], kd[16];
#pragma unroll
                for (int i = 0; i < 16; ++i) { const int t = rg * 16 + i; const float kn = Kf[t * F_LD + c] * rkS[t]; kb[i] = kn * bgam[t]; kd[i] = kn * ekd[t]; }
                v4u o0, o1;
                o0.x = pkbf(kb[0], kb[1]); o0.y = pkbf(kb[2], kb[3]); o0.z = pkbf(kb[4], kb[5]); o0.w = pkbf(kb[6], kb[7]); o1.x = pkbf(kb[8], kb[9]); o1.y = pkbf(kb[10], kb[11]); o1.z = pkbf(kb[12], kb[13]); o1.w = pkbf(kb[14], kb[15]);
                *(LAS v4u*)(Kt + c * T_LD + rg * 16) = o0; *(LAS v4u*)(Kt + c * T_LD + rg * 16 + 8) = o1;
                bf16* fk = img + ((size_t)(FR_KDT + (c >> 5) * 4 + rg) * 64 + (c & 31)) * 8;
                v4u h0, h1;
                h0.x = pkbf(kd[0], kd[1]); h0.y = pkbf(kd[2], kd[3]); h0.z = pkbf(kd[8], kd[9]); h0.w = pkbf(kd[10], kd[11]);
                h1.x = pkbf(kd[4], kd[5]); h1.y = pkbf(kd[6], kd[7]); h1.z = pkbf(kd[12], kd[13]); h1.w = pkbf(kd[14], kd[15]);
                *(v4u*)fk = h0; *(v4u*)(fk + 32 * 8) = h1; }
            RAW_BAR();
            }
            for (int rep_ = 0; rep_ < ((PREP_DUP & 2) ? 2 : 1); ++rep_) { if (rep_) RAW_BAR();
            if (wave < 6) { const int pr = wave % 3, iskk = wave / 3, mt = pr == 2 ? 1 : 0, nt = pr == 0 ? 0 : 1;
                const LAS bf16* xs = iskk ? Ks : Qs; f32x16 d;
#pragma unroll
                for (int r = 0; r < 16; ++r) d[r] = 0.f;
#pragma unroll
                for (int s = 0; s < 8; ++s) { const bf16x8 af = *(const LAS bf16x8*)(Ks + (32 * mt + c32) * S_LD + 16 * s + 8 * hf), bfr = *(const LAS bf16x8*)(xs + (32 * nt + c32) * S_LD + 16 * s + 8 * hf); d = MFMA32(af, bfr, d); }
                const int i = 32 * nt + c32; const float gi = gamh[i], bi = betah[i];
#pragma unroll
                for (int r = 0; r < 16; ++r) { const int j = 32 * mt + (r & 3) + 8 * (r >> 2) + 4 * hf; const float de = __expf(gi - gamh[j]);
                    d[r] = iskk ? ((j < i) ? bi * d[r] * de : 0.f) : ((j <= i) ? d[r] * de : 0.f); }
                if (iskk) {
#pragma unroll
                    for (int qd = 0; qd < 4; ++qd) *(LAS f32x4*)(As + i * A_LD + 32 * mt + 8 * qd + 4 * hf) = (f32x4){d[4 * qd], d[4 * qd + 1], d[4 * qd + 2], d[4 * qd + 3]}; }
                else {
#pragma unroll
                    for (int sp = 0; sp < 2; ++sp) *(bf16x8*)(img + ((size_t)(FR_AQK + nt * 4 + 2 * mt + sp) * 64 + lane) * 8) = PACK8(d, sp); } }
            RAW_BAR();
            }
            for (int rep_ = 0; rep_ < ((PREP_DUP & 4) ? 2 : 1); ++rep_) { if (rep_) RAW_BAR();
            if (wave < 2) {
                unsigned asb = (unsigned)(uintptr_t)(As + (32 * wave) * A_LD + 32 * wave); int cb = c32; asm volatile("" : "+v"(asb), "+v"(cb));
                const LAS float* Ab = (const LAS float*)(uintptr_t)asb;
                float arow[32], Tc[32];
#pragma unroll
                for (int i = 0; i < 32; ++i) arow[i] = Ab[i * A_LD + cb];
#pragma unroll
                for (int i = 0; i < 32; ++i) { float ac[4] = {(i == cb) ? 1.f : 0.f, 0.f, 0.f, 0.f}; if (i > 0) asm volatile("" : "+v"(arow[i]), "+v"(Tc[i - 1]));
#pragma unroll
                    for (int j = 0; j < i; ++j) { const float aij = __builtin_bit_cast(float, __builtin_amdgcn_readlane(__builtin_bit_cast(int, arow[i]), j)); ac[j & 3] -= aij * Tc[j]; }
                    Tc[i] = (ac[0] + ac[1]) + (ac[2] + ac[3]); __builtin_amdgcn_sched_barrier(0); }
                if (hf == 0) {
#pragma unroll
                    for (int i = 0; i < 32; ++i) Tb[(32 * wave + i) * T_LD + 32 * wave + c32] = (bf16)(pkbf(Tc[i], 0.f) & 0xffffu);
                    if (wave == 0) {
#pragma unroll
                        for (int q = 0; q < 4; ++q) { v4u o; o.x = pkbf(Tc[8 * q], Tc[8 * q + 1]); o.y = pkbf(Tc[8 * q + 2], Tc[8 * q + 3]); o.z = pkbf(Tc[8 * q + 4], Tc[8 * q + 5]); o.w = pkbf(Tc[8 * q + 6], Tc[8 * q + 7]); *(LAS v4u*)(T11t + c32 * TT_LD + 8 * q) = o; } } } }
            RAW_BAR();
            if (wave == 0) {
                f32x16 x;
#pragma unroll
                for (int r = 0; r < 16; ++r) x[r] = 0.f;
#pragma unroll
                for (int s = 0; s < 2; ++s) { const LAS float* ap = As + (32 + c32) * A_LD + 16 * s + 8 * hf; const f32x4 a0 = *(const LAS f32x4*)ap, a1 = *(const LAS f32x4*)(ap + 4);
                    const bf16x8 af = __builtin_bit_cast(bf16x8, (v4u){pkbf(a0[0], a0[1]), pkbf(a0[2], a0[3]), pkbf(a1[0], a1[1]), pkbf(a1[2], a1[3])});
                    const bf16x8 bfr = *(const LAS bf16x8*)(T11t + c32 * TT_LD + 16 * s + 8 * hf); x = MFMA32(af, bfr, x); }
                f32x16 t21;
#pragma unroll
                for (int r = 0; r < 16; ++r) t21[r] = 0.f;
#pragma unroll
                for (int s = 0; s < 2; ++s) { const LAS bf16* tp = Tb + (32 + c32) * T_LD + 32 + 16 * s + 4 * hf; const v2u lo = *(const LAS v2u*)tp, hi = *(const LAS v2u*)(tp + 8);
                    const bf16x8 af = __builtin_bit_cast(bf16x8, (v4u){lo.x, lo.y, hi.x, hi.y}); const bf16x8 bfr = PACK8(x, s); t21 = MFMA32(af, bfr, t21); }
#pragma unroll
                for (int r = 0; r < 16; ++r) Tb[(32 + (r & 3) + 8 * (r >> 2) + 4 * hf) * T_LD + c32] = (bf16)(pkbf(-t21[r], 0.f) & 0xffffu);
            }
            RAW_BAR();
            }
            for (int rep_ = 0; rep_ < ((PREP_DUP & 8) ? 2 : 1); ++rep_) { if (rep_) RAW_BAR();
            if (wave < 4) {
#pragma unroll
                for (int mt = 0; mt < 2; ++mt) { f32x16 d;
#pragma unroll
                    for (int r = 0; r < 16; ++r) d[r] = 0.f;
#pragma unroll
                    for (int s = 0; s < 4; ++s) if (s < 2 * (mt + 1)) { const bf16x8 af = *(const LAS bf16x8*)(Tb + (32 * mt + c32) * T_LD + 16 * s + 8 * hf), bfr = *(const LAS bf16x8*)(Vt + (32 * wave + c32) * T_LD + 16 * s + 8 * hf); d = MFMA32(af, bfr, d); }
                    bf16* up = uimg + ((size_t)(wave * 2 + mt) * 64 + lane) * 16; *(bf16x8*)up = PACK8(d, 0); *(bf16x8*)(up + 8) = PACK8(d, 1); } }
            else { const int ct = wave - 4;
#pragma unroll
                for (int nt = 0; nt < 2; ++nt) { f32x16 d;
#pragma unroll
                    for (int r = 0; r < 16; ++r) d[r] = 0.f;
#pragma unroll
                    for (int s = 0; s < 4; ++s) if (s < 2 * (nt + 1)) { const bf16x8 af = *(const LAS bf16x8*)(Kt + (32 * ct + c32) * T_LD + 16 * s + 8 * hf), bfr = *(const LAS bf16x8*)(Tb + (32 * nt + c32) * T_LD + 16 * s + 8 * hf); d = MFMA32(af, bfr, d); }
#pragma unroll
                    for (int r = 0; r < 16; ++r) d[r] = -d[r];
#pragma unroll
                    for (int sp = 0; sp < 2; ++sp) *(bf16x8*)(img + ((size_t)(FR_WN + nt * 8 + 2 * ct + sp) * 64 + lane) * 8) = PACK8(d, sp); } }
            }
            if (tid == 0) CD[chd] = egam[63];
            RAW_BAR();
        }
#undef PREP_LOADRAW
    }
}

__host__ __device__ constexpr int sc_p(int k) { const int j = k - 32; return j < 12 ? j % 6 : (j - 12) % 5; }
__host__ __device__ constexpr int sc_slab(int k) { const int j = k - 32; return k < 32 ? (k >> 2) : (j < 12 ? j / 6 : 2 + (j - 12) / 5); }
__host__ __device__ constexpr int sc_kind(int k) { return k < 32 ? ((k & 3) < 2 ? 0 : 1) : ((sc_p(k) == 2 || sc_p(k) == 5) ? 1 : 2); }
__host__ __device__ constexpr int sc_idx(int k) { return k < 32 ? (k & 1) : (sc_p(k) == 0 ? 0 : sc_p(k) == 1 ? 1 : sc_p(k) == 2 ? 1 : sc_p(k) == 3 ? 2 : sc_p(k) == 4 ? 3 : 0); }
__host__ __device__ constexpr int sc_frag(int k) { return k < 32 ? (((k & 3) < 2 ? FR_WN : FR_QD) + (k & 1) * 8 + (k >> 2)) : (sc_kind(k) == 1 ? FR_AQK + sc_idx(k) * 4 + sc_slab(k) : FR_KDT + sc_idx(k) * 4 + sc_slab(k)); }
constexpr int SC_QD = 8;
constexpr int SCB = 57344, OT_OFF = 2 * SCB, OT_LD = 136, OT_BYTES = 64 * OT_LD * 2;
static_assert(OT_OFF + 2 * OT_BYTES <= 152 * 1024, "scan LDS");
__device__ __forceinline__ void phase_dn_scan(const Frame& F0, const Args& a, int layer, int unit) {
    PHASE_FRAME(F0);
    unsigned char* ws = OPQ_G(unsigned char, a.ws);
    LAS unsigned char* lds = F.lds;
    const int b = unit >> 3, h = unit & 7, lane = F.lane;
    const bf16* IMG = (const bf16*)(ws + WS_IMG); const bf16* UIMG = (const bf16*)(ws + WS_UIMG); const float* CD = (const float*)(ws + WS_CD);
    const size_t chd0 = (size_t)b * NCH * NH + h;
    if (F.wave < 4) {
#ifndef SCAN_NO_COMPUTE
        const int w = F.wave, c32 = lane & 31, hf = lane >> 5;
        f32x16 S0, S1, S2, S3;
#pragma unroll
        for (int r = 0; r < 16; ++r) { S0[r] = 0.f; S1[r] = 0.f; S2[r] = 0.f; S3[r] = 0.f; }
        const float cdl = CD[chd0 + (size_t)lane * NH];
        v4u UA[4];
        const __amdgpu_buffer_rsrc_t rsU = __builtin_amdgcn_make_buffer_rsrc((void*)(UIMG + chd0 * UIMG_ELEMS), (short)0, NCH * NH * UIMG_ELEMS * 2, 0x00020000);
        const unsigned uoff = (unsigned)((w * 2) * 64 + lane) * 32u;
#define SC_LOADU(dst, nn) do { _Pragma("unroll") for (int mt_ = 0; mt_ < 2; ++mt_) { _Pragma("unroll") for (int hh_ = 0; hh_ < 2; ++hh_) dst[2 * mt_ + hh_] = __builtin_amdgcn_raw_buffer_load_b128(rsU, uoff + (unsigned)(mt_ * 2048 + hh_ * 16), (unsigned)(nn) * (unsigned)(NH * UIMG_ELEMS * 2), 0); } } while (0)
#define SC_FRAG(bufoff, fi) (*(const LAS bf16x8*)(lds + (bufoff) + (fi) * 1024 + lane * 16))
#define SC_CHUNK(nn, U, bufoff, otoff) do { \
        f32x16 aV0, aV1, aO0, aO1; bf16x8 fq0, fq1, fq2, fq3, fq4, fq5, fq6, fq7, Sbs, Vb0, Vb1, Vb2, Vb3; \
        _Pragma("unroll") for (int q = 0; q < 4; ++q) { aV0[2 * q] = bflo(U[0][q]); aV0[2 * q + 1] = bfhi(U[0][q]); aV0[8 + 2 * q] = bflo(U[1][q]); aV0[8 + 2 * q + 1] = bfhi(U[1][q]); \
            aV1[2 * q] = bflo(U[2][q]); aV1[2 * q + 1] = bfhi(U[2][q]); aV1[8 + 2 * q] = bflo(U[3][q]); aV1[8 + 2 * q + 1] = bfhi(U[3][q]); } \
        _Pragma("unroll") for (int r = 0; r < 16; ++r) { aO0[r] = 0.f; aO1[r] = 0.f; } \
        if ((nn) + 1 < NCH) SC_LOADU(U, (nn) + 1); \
        const float cd = __builtin_bit_cast(float, __builtin_amdgcn_readlane(__builtin_bit_cast(int, cdl), (nn))); \
        fq0 = SC_FRAG(bufoff, 0); \
        fq1 = SC_FRAG(bufoff, 8); \
        fq2 = SC_FRAG(bufoff, 16); \
        fq3 = SC_FRAG(bufoff, 24); \
        fq4 = SC_FRAG(bufoff, 1); \
        fq5 = SC_FRAG(bufoff, 9); \
        fq6 = SC_FRAG(bufoff, 17); \
        fq7 = SC_FRAG(bufoff, 25); \
        Sbs = PACK8(S0, 0); \
        aV0 = MFMA32(fq0, Sbs, aV0); \
        fq0 = SC_FRAG(bufoff, 2); \
        aV1 = MFMA32(fq1, Sbs, aV1); \
        fq1 = SC_FRAG(bufoff, 10); \
        aO0 = MFMA32(fq2, Sbs, aO0); \
        fq2 = SC_FRAG(bufoff, 18); \
        aO1 = MFMA32(fq3, Sbs, aO1); \
        fq3 = SC_FRAG(bufoff, 26); \
        Sbs = PACK8(S0, 1); \
        aV0 = MFMA32(fq4, Sbs, aV0); \
        fq4 = SC_FRAG(bufoff, 3); \
        aV1 = MFMA32(fq5, Sbs, aV1); \
        fq5 = SC_FRAG(bufoff, 11); \
        aO0 = MFMA32(fq6, Sbs, aO0); \
        fq6 = SC_FRAG(bufoff, 19); \
        aO1 = MFMA32(fq7, Sbs, aO1); \
        fq7 = SC_FRAG(bufoff, 27); \
        Sbs = PACK8(S1, 0); \
        aV0 = MFMA32(fq0, Sbs, aV0); \
        fq0 = SC_FRAG(bufoff, 4); \
        aV1 = MFMA32(fq1, Sbs, aV1); \
        fq1 = SC_FRAG(bufoff, 12); \
        aO0 = MFMA32(fq2, Sbs, aO0); \
        fq2 = SC_FRAG(bufoff, 20); \
        aO1 = MFMA32(fq3, Sbs, aO1); \
        fq3 = SC_FRAG(bufoff, 28); \
        Sbs = PACK8(S1, 1); \
        aV0 = MFMA32(fq4, Sbs, aV0); \
        fq4 = SC_FRAG(bufoff, 5); \
        aV1 = MFMA32(fq5, Sbs, aV1); \
        fq5 = SC_FRAG(bufoff, 13); \
        aO0 = MFMA32(fq6, Sbs, aO0); \
        fq6 = SC_FRAG(bufoff, 21); \
        aO1 = MFMA32(fq7, Sbs, aO1); \
        fq7 = SC_FRAG(bufoff, 29); \
        Sbs = PACK8(S2, 0); \
        aV0 = MFMA32(fq0, Sbs, aV0); \
        fq0 = SC_FRAG(bufoff, 6); \
        aV1 = MFMA32(fq1, Sbs, aV1); \
        fq1 = SC_FRAG(bufoff, 14); \
        aO0 = MFMA32(fq2, Sbs, aO0); \
        fq2 = SC_FRAG(bufoff, 22); \
        aO1 = MFMA32(fq3, Sbs, aO1); \
        fq3 = SC_FRAG(bufoff, 30); \
        Sbs = PACK8(S2, 1); \
        aV0 = MFMA32(fq4, Sbs, aV0); \
        fq4 = SC_FRAG(bufoff, 7); \
        aV1 = MFMA32(fq5, Sbs, aV1); \
        fq5 = SC_FRAG(bufoff, 15); \
        aO0 = MFMA32(fq6, Sbs, aO0); \
        fq6 = SC_FRAG(bufoff, 23); \
        aO1 = MFMA32(fq7, Sbs, aO1); \
        fq7 = SC_FRAG(bufoff, 31); \
        Sbs = PACK8(S3, 0); \
        aV0 = MFMA32(fq0, Sbs, aV0); \
        fq0 = SC_FRAG(bufoff, 40); \
        aV1 = MFMA32(fq1, Sbs, aV1); \
        fq1 = SC_FRAG(bufoff, 44); \
        aO0 = MFMA32(fq2, Sbs, aO0); \
        fq2 = SC_FRAG(bufoff, 36); \
        aO1 = MFMA32(fq3, Sbs, aO1); \
        fq3 = SC_FRAG(bufoff, 48); \
        Sbs = PACK8(S3, 1); \
        aV0 = MFMA32(fq4, Sbs, aV0); \
        fq4 = SC_FRAG(bufoff, 52); \
        aV1 = MFMA32(fq5, Sbs, aV1); \
        fq5 = SC_FRAG(bufoff, 32); \
        S0 = S0 * cd; S1 = S1 * cd; S2 = S2 * cd; S3 = S3 * cd; \
        aO0 = MFMA32(fq6, Sbs, aO0); \
        fq6 = SC_FRAG(bufoff, 41); \
        aO1 = MFMA32(fq7, Sbs, aO1); \
        fq7 = SC_FRAG(bufoff, 45); \
        Vb0 = PACK8(aV0, 0); Vb1 = PACK8(aV0, 1); Vb2 = PACK8(aV1, 0); Vb3 = PACK8(aV1, 1); \
        S0 = MFMA32(fq0, Vb0, S0); \
        fq0 = SC_FRAG(bufoff, 37); \
        S1 = MFMA32(fq1, Vb0, S1); \
        fq1 = SC_FRAG(bufoff, 49); \
        aO1 = MFMA32(fq2, Vb0, aO1); \
        fq2 = SC_FRAG(bufoff, 53); \
        S2 = MFMA32(fq3, Vb0, S2); \
        fq3 = SC_FRAG(bufoff, 33); \
        S3 = MFMA32(fq4, Vb0, S3); \
        fq4 = SC_FRAG(bufoff, 42); \
        aO0 = MFMA32(fq5, Vb0, aO0); \
        fq5 = SC_FRAG(bufoff, 46); \
        S0 = MFMA32(fq6, Vb1, S0); \
        fq6 = SC_FRAG(bufoff, 38); \
        S1 = MFMA32(fq7, Vb1, S1); \
        fq7 = SC_FRAG(bufoff, 50); \
        aO1 = MFMA32(fq0, Vb1, aO1); \
        fq0 = SC_FRAG(bufoff, 54); \
        S2 = MFMA32(fq1, Vb1, S2); \
        fq1 = SC_FRAG(bufoff, 43); \
        S3 = MFMA32(fq2, Vb1, S3); \
        fq2 = SC_FRAG(bufoff, 47); \
        aO0 = MFMA32(fq3, Vb1, aO0); \
        fq3 = SC_FRAG(bufoff, 39); \
        S0 = MFMA32(fq4, Vb2, S0); \
        fq4 = SC_FRAG(bufoff, 51); \
        S1 = MFMA32(fq5, Vb2, S1); \
        fq5 = SC_FRAG(bufoff, 55); \
        aO1 = MFMA32(fq6, Vb2, aO1); \
        S2 = MFMA32(fq7, Vb2, S2); \
        S3 = MFMA32(fq0, Vb2, S3); \
        S0 = MFMA32(fq1, Vb3, S0); \
        S1 = MFMA32(fq2, Vb3, S1); \
        aO1 = MFMA32(fq3, Vb3, aO1); \
        S2 = MFMA32(fq4, Vb3, S2); \
        S3 = MFMA32(fq5, Vb3, S3); \
        _Pragma("unroll") for (int r = 0; r < 16; ++r) { \
            *(LAS bf16*)(lds + (otoff) + (((r & 3) + 8 * (r >> 2) + 4 * hf) * OT_LD + 32 * w + c32) * 2) = (bf16)(pkbf(aO0[r], 0.f) & 0xffffu); \
            *(LAS bf16*)(lds + (otoff) + ((32 + (r & 3) + 8 * (r >> 2) + 4 * hf) * OT_LD + 32 * w + c32) * 2) = (bf16)(pkbf(aO1[r], 0.f) & 0xffffu); } \
        RAW_BAR(); } while (0)
        SC_LOADU(UA, 0);
        RAW_BAR();
#pragma unroll 1
        for (int n = 0; n < NCH; n += 2) { SC_CHUNK(n, UA, 0, OT_OFF); SC_CHUNK(n + 1, UA, SCB, OT_OFF + OT_BYTES); }
#undef SC_CHUNK
#undef SC_FRAG
#undef SC_LOADU
#endif
    } else {
#ifndef SCAN_NO_HELPER
        const int ht = F.tid - 256, tok = ht >> 2, q = ht & 3;
        bf16* OB = FP8_PDL(layer) ? (bf16*)((unsigned char*)a.out + 64 * MiB) : (bf16*)(ws + WS_MIXIN); const int old_ = FP8_PDL(layer) ? DNW : D;
        v4u RA[14], RB[14];
        const __amdgpu_buffer_rsrc_t rsI = __builtin_amdgcn_make_buffer_rsrc((void*)(IMG + chd0 * IMG_ELEMS), (short)0, NCH * NH * IMG_ELEMS * 2, 0x00020000);
#define SH_LOADIMG(dst, nn) do { _Pragma("unroll") for (int i_ = 0; i_ < 14; ++i_) dst[i_] = __builtin_amdgcn_raw_buffer_load_b128(rsI, (unsigned)ht * 16u, (unsigned)(nn) * (unsigned)(NH * IMG_ELEMS * 2) + (unsigned)i_ * 4096u, 0); } while (0)
#define SH_STOREIMG(src, bufoff) do { LAS v4u* p_ = (LAS v4u*)(lds + (bufoff)) + ht; _Pragma("unroll") for (int i_ = 0; i_ < 14; ++i_) p_[i_ * 256] = src[i_]; } while (0)
#define SH_EPI(mm, otoff) do { const LAS v4u* op_ = (const LAS v4u*)(lds + (otoff) + (tok * OT_LD + 32 * q) * 2); \
        v4u* yp_ = (v4u*)(OB + ((size_t)b * SEQ + (size_t)(mm) * CH + tok) * old_ + h * HD + 32 * q); \
        _Pragma("unroll") for (int i_ = 0; i_ < 4; ++i_) yp_[i_] = op_[i_]; } while (0)
#define SH_STEP(nn, Rcur, Rnext, bufnext, otprev) do { \
        if ((nn) + 2 < NCH) SH_LOADIMG(Rcur, (nn) + 2); \
        if ((nn) >= 1) SH_EPI((nn) - 1, otprev); \
        if ((nn) + 1 < NCH) SH_STOREIMG(Rnext, bufnext); \
        RAW_BAR(); } while (0)
        SH_LOADIMG(RA, 0); SH_LOADIMG(RB, 1);
        SH_STOREIMG(RA, 0);
        RAW_BAR();
#pragma unroll 1
        for (int n = 0; n < NCH; n += 2) { SH_STEP(n, RA, RB, SCB, OT_OFF + OT_BYTES); SH_STEP(n + 1, RB, RA, 0, OT_OFF); }
        SH_EPI(NCH - 1, OT_OFF + OT_BYTES);
#undef SH_STEP
#undef SH_EPI
#undef SH_STOREIMG
#undef SH_LOADIMG
#endif
    }
}

__device__ __forceinline__ void phase_dn_norm(const Frame& F0, const Args& a, int layer) {
    PHASE_FRAME(F0);
    unsigned char* ws = OPQ_G(unsigned char, a.ws);
    const bf16* PROJ = (const bf16*)(ws + WS_PROJ); bf16* MIXIN = (bf16*)(ws + WS_MIXIN);
    const bf16* OSRC = FP8_PDL(layer) ? (const bf16*)((unsigned char*)a.out + 64 * MiB) : (const bf16*)(ws + WS_MIXIN); const int old_ = FP8_PDL(layer) ? DNW : D;
    const int lane = F.lane, gw = F.vcu * NWAVES + F.wave, NGW = F.G * NWAVES;
    const float* nw = a.in[I_NORMW] + layer * HD + 16 * (lane & 7); f32x4 nwv[4];
#pragma unroll
    for (int i = 0; i < 4; ++i) nwv[i] = *(const f32x4*)(nw + 4 * i);
    v4u OA[2], ZA[2], OB[2], ZB[2];
#define DNN_LOAD(O_, Z_, t) do { const v4u* op_ = (const v4u*)(OSRC + (size_t)(t) * old_ + 16 * lane); const v4u* zp_ = (const v4u*)(PROJ + (size_t)(t) * NPROJ + 3072 + 16 * lane); O_[0] = op_[0]; O_[1] = op_[1]; Z_[0] = zp_[0]; Z_[1] = zp_[1]; } while (0)
#define DNN_ROW(O_, Z_, t) do { float ss = 0.f; \
        _Pragma("unroll") for (int i = 0; i < 2; ++i) _Pragma("unroll") for (int j = 0; j < 4; ++j) { const float x0 = bflo(O_[i][j]), x1 = bfhi(O_[i][j]); ss += x0 * x0 + x1 * x1; } \
        ss = row8_sum(ss); const float rr = 1.0f / sqrtf(ss * (1.0f / HD) + RMS_EPS); \
        v4u* yp_ = (v4u*)(MIXIN + (size_t)(t) * D + 16 * lane); float yv_[16]; \
        _Pragma("unroll") for (int i = 0; i < 2; ++i) { _Pragma("unroll") for (int j = 0; j < 4; ++j) { const float z0 = bflo(Z_[i][j]), z1 = bfhi(Z_[i][j]); const f32x4 nn = nwv[2 * i + (j >> 1)]; \
            yv_[8 * i + 2 * j] = bflo(O_[i][j]) * rr * nn[2 * (j & 1)] * z0 * sigmoidf_(z0); yv_[8 * i + 2 * j + 1] = bfhi(O_[i][j]) * rr * nn[2 * (j & 1) + 1] * z1 * sigmoidf_(z1); } } \
        if (FP8_PDL(layer)) { v4u o8_; _Pragma("unroll") for (int q4 = 0; q4 < 4; ++q4) o8_[q4] = pk4_fp8(yv_[4 * q4] * F8_XS, yv_[4 * q4 + 1] * F8_XS, yv_[4 * q4 + 2] * F8_XS, yv_[4 * q4 + 3] * F8_XS); *(v4u*)((unsigned char*)MIXIN + (size_t)(t) * D + 16 * lane) = o8_; } \
        else { _Pragma("unroll") for (int i = 0; i < 2; ++i) { v4u o_; _Pragma("unroll") for (int j = 0; j < 4; ++j) o_[j] = pkbf(yv_[8 * i + 2 * j], yv_[8 * i + 2 * j + 1]); yp_[i] = o_; } } } while (0)
    if (gw < T) DNN_LOAD(OA, ZA, gw);
#pragma unroll 1
    for (int t = gw; t < T; t += 2 * NGW) {
        if (t + NGW < T) DNN_LOAD(OB, ZB, t + NGW);
        DNN_ROW(OA, ZA, t);
        if (t + 2 * NGW < T) DNN_LOAD(OA, ZA, t + 2 * NGW);
        if (t + NGW < T) DNN_ROW(OB, ZB, t + NGW);
    }
#undef DNN_LOAD
#undef DNN_ROW
}

__device__ __forceinline__ void phase_ln1_router(const Frame& F0, const Args& a, int layer, int probe = 0, int f8 = 0) {
    PHASE_FRAME(F0);
    unsigned char* ws = OPQ_G(unsigned char, a.ws);
    LAS float* WRt = (LAS float*)F.lds;
    LAS float* GV = (LAS float*)(F.lds + RING_BYTES);
    LAS int* rowE = (LAS int*)(F.lds + AUX_OFF); LAS int* rowP = rowE + 128; LAS float* rowG = (LAS float*)(rowP + 128); LAS int* lcnt = (LAS int*)(rowG + 128); LAS int* lbase = lcnt + 16;
    const float* wr = OPQ_G(const float, a.in[I_WR]); const float* br = OPQ_G(const float, a.in[I_BR]);
    for (int idx = F.tid; idx < D * NE; idx += 512) WRt[(idx & 15) * D + (idx >> 4)] = wr[idx];
    { const float* g1 = a.in[I_LN1G] + (size_t)layer * D; const float* b1 = a.in[I_LN1B] + (size_t)layer * D; for (int i = F.tid; i < D; i += 512) { GV[i] = g1[i]; GV[D + i] = b1[i]; } }
    const bf16* PRE = (const bf16*)a.out; bf16* X1B = (bf16*)(ws + (probe ? WS_R1 : WS_X1B)); float* STATS = (float*)(ws + (probe ? WS_R1 + 70 * MiB : WS_STATS));
    int* LIST = (int*)(ws + (probe ? WS_R1 + 72 * MiB : WS_LIST)); int* TOKSLOT = (int*)(ws + (probe ? WS_R1 + 80 * MiB : WS_TOKSLOT)); float* GATEW = (float*)(ws + (probe ? WS_R1 + 82 * MiB : WS_GATEW));
    gu32* cnt = F.ctl + CW_CNT + 64 * (layer + (probe ? 2 : 0));
    const int lane = F.lane; const float brl = br[lane & 15];
    for (int rb = F.vcu; rb < T / 64; rb += F.G) {
        if (F.tid < 16) lcnt[F.tid] = 0;
        __syncthreads();
        v2u XA[8], XB_[8];
#define PE_LOAD(X, r) do { const GAS v2u* xr_ = (const GAS v2u*)(PRE + (size_t)(rb * 64 + F.wave * 8 + (r)) * D) + lane; _Pragma("unroll") for (int j = 0; j < 8; ++j) X[j] = xr_[64 * j]; } while (0)
#define PE_ROW(X, r) do { const int lr = F.wave * 8 + (r), row = rb * 64 + lr; unsigned gvo_ = (unsigned)(uintptr_t)GV; asm volatile("" : "+v"(gvo_)); const LAS float* GVr = (const LAS float*)(uintptr_t)gvo_; \
            f32x4 v[8]; float s = 0.f; \
            _Pragma("unroll") for (int j = 0; j < 8; ++j) { v[j] = (f32x4){bflo(X[j].x), bfhi(X[j].x), bflo(X[j].y), bfhi(X[j].y)}; s += (v[j][0] + v[j][1]) + (v[j][2] + v[j][3]); } \
            const float mean = wave_sum(s) * (1.f / D); float s2 = 0.f; \
            _Pragma("unroll") for (int j = 0; j < 8; ++j) { v[j] = v[j] - mean; s2 += (v[j][0] * v[j][0] + v[j][1] * v[j][1]) + (v[j][2] * v[j][2] + v[j][3] * v[j][3]); } \
            const float rstd = 1.f / sqrtf(wave_sum(s2) * (1.f / D) + LN_EPS); \
            if (lane == 0) { STATS[2 * row] = mean; STATS[2 * row + 1] = rstd; } \
            GAS v2u* o8 = (GAS v2u*)(X1B + (size_t)row * D) + lane; \
            f32x2 lg2[16]; \
            _Pragma("unroll") for (int e = 0; e < 16; ++e) lg2[e] = (f32x2){0.f, 0.f}; \
            _Pragma("unroll") for (int j = 0; j < 8; ++j) { const f32x4 gg = *(const LAS f32x4*)(GVr + 256 * j + 4 * lane), bb = *(const LAS f32x4*)(GVr + D + 256 * j + 4 * lane); \
                v[j] = v[j] * rstd * gg + bb; \
                if (f8) ((GAS unsigned*)((GAS unsigned char*)X1B + (size_t)row * D) + lane)[64 * j] = pk4_fp8(v[j][0] * F8_XS, v[j][1] * F8_XS, v[j][2] * F8_XS, v[j][3] * F8_XS); \
                else { v2u w; w.x = pkbf(v[j][0], v[j][1]); w.y = pkbf(v[j][2], v[j][3]); o8[64 * j] = w; } \
                const f32x2 vlo = {v[j][0], v[j][1]}, vhi = {v[j][2], v[j][3]}; \
                _Pragma("unroll") for (int e = 0; e < 16; ++e) { const f32x4 w4 = *(const LAS f32x4*)(WRt + e * D + 256 * j + 4 * lane); \
                    lg2[e] = __builtin_elementwise_fma(vlo, (f32x2){w4[0], w4[1]}, lg2[e]); lg2[e] = __builtin_elementwise_fma(vhi, (f32x2){w4[2], w4[3]}, lg2[e]); } } \
            float lg[16]; \
            _Pragma("unroll") for (int e = 0; e < 16; ++e) lg[e] = lg2[e][0] + lg2[e][1]; \
              \
            float t8[8], t4[4], t2[2], t1; \
            { const bool hi = (lane & 8) != 0; _Pragma("unroll") for (int i = 0; i < 8; ++i) { const float snd = hi ? lg[i] : lg[8 + i], kp = hi ? lg[8 + i] : lg[i]; t8[i] = kp + dpp_<DPP_XOR8>(snd); } } \
            { const bool hi = (lane & 4) != 0; _Pragma("unroll") for (int i = 0; i < 4; ++i) { const float snd = hi ? t8[i] : t8[4 + i], kp = hi ? t8[4 + i] : t8[i]; t4[i] = kp + dpp_<DPP_HMIRROR>(snd); } } \
            { const bool hi = (lane & 2) != 0; _Pragma("unroll") for (int i = 0; i < 2; ++i) { const float snd = hi ? t4[i] : t4[2 + i], kp = hi ? t4[2 + i] : t4[i]; t2[i] = kp + dpp_<DPP_XOR2>(snd); } } \
            { const bool hi = (lane & 1) != 0; const float snd = hi ? t2[0] : t2[1], kp = hi ? t2[1] : t2[0]; t1 = kp + dpp_<DPP_XOR1>(snd); } \
            t1 = xrow16_sum(t1) + brl; \
            float lgu[16]; float mx = -3.0e38f; \
            _Pragma("unroll") for (int e = 0; e < 16; ++e) { lgu[e] = __builtin_bit_cast(float, __builtin_amdgcn_readlane(__builtin_bit_cast(int, t1), e)); mx = fmaxf(mx, lgu[e]); } \
            float p[16]; \
            _Pragma("unroll") for (int e = 0; e < 16; ++e) p[e] = __expf(lgu[e] - mx); \
            float gsc[4]; \
            _Pragma("unroll") for (int g = 0; g < 4; ++g) { const float a0 = p[4 * g], a1 = p[4 * g + 1], a2 = p[4 * g + 2], a3 = p[4 * g + 3]; \
                const float hi1 = fmaxf(a0, a1), lo1 = fminf(a0, a1), hi2 = fmaxf(a2, a3), lo2 = fminf(a2, a3); \
                gsc[g] = fmaxf(hi1, hi2) + fmaxf(fminf(hi1, hi2), fmaxf(lo1, lo2)); } \
            int gsel = 0; float best = gsc[0]; \
            _Pragma("unroll") for (int g = 1; g < 4; ++g) if (gsc[g] > best) { best = gsc[g]; gsel = g; } \
            float q[4]; \
            _Pragma("unroll") for (int j = 0; j < 4; ++j) q[j] = gsel == 0 ? p[j] : (gsel == 1 ? p[4 + j] : (gsel == 2 ? p[8 + j] : p[12 + j])); \
            int i0 = 0; float p0 = q[0]; \
            _Pragma("unroll") for (int j = 1; j < 4; ++j) if (q[j] > p0) { p0 = q[j]; i0 = j; } \
            int i1 = -1; float p1 = -1.f; \
            _Pragma("unroll") for (int j = 0; j < 4; ++j) if (j != i0 && q[j] > p1) { p1 = q[j]; i1 = j; } \
            if (lane == 0) { const int e0 = gsel * 4 + i0, e1 = gsel * 4 + i1; const float inv = 1.0f / (p0 + p1); \
                rowE[2 * lr] = e0; rowE[2 * lr + 1] = e1; rowG[2 * lr] = p0 * inv; rowG[2 * lr + 1] = p1 * inv; \
                rowP[2 * lr] = __hip_atomic_fetch_add(&lcnt[e0], 1, __ATOMIC_RELAXED, __HIP_MEMORY_SCOPE_WORKGROUP); rowP[2 * lr + 1] = __hip_atomic_fetch_add(&lcnt[e1], 1, __ATOMIC_RELAXED, __HIP_MEMORY_SCOPE_WORKGROUP); } } while (0)
        PE_LOAD(XA, 0);
#pragma unroll 1
        for (int r = 0; r < 8; r += 2) { PE_LOAD(XB_, r + 1); PE_ROW(XA, r); if (r + 2 < 8) PE_LOAD(XA, r + 2); PE_ROW(XB_, r + 1); }
#undef PE_LOAD
#undef PE_ROW
        __syncthreads();
        if (F.tid < 16) lbase[F.tid] = (int)__hip_atomic_fetch_add(cnt + F.tid, (unsigned)lcnt[F.tid], RLX_AGENT);
        __syncthreads();
        if (F.tid < 128) { const int e = rowE[F.tid], pos = lbase[e] + rowP[F.tid], tok = rb * 64 + (F.tid >> 1);
            LIST[(size_t)e * LCAP + pos] = tok; TOKSLOT[2 * tok + (F.tid & 1)] = e * LCAP + pos; GATEW[2 * tok + (F.tid & 1)] = rowG[F.tid]; }
        __syncthreads();
    }
}
__device__ __forceinline__ void moe_table(const Frame& F0, int layer) {
    PHASE_FRAME(F0);
    LAS int* tab = (LAS int*)(F.lds + AUX_OFF);
    __syncthreads();
    if (F.tid < 16) tab[32 + F.tid] = (int)__hip_atomic_load(F.ctl + CW_CNT + 64 * layer + F.tid, RLX_AGENT);
    __syncthreads();
    if (F.tid == 0) { int blk = 0, nf = 0, nh = 0; for (int e = 0; e < 16; ++e) { const int cn = tab[32 + e]; tab[e] = blk; tab[48 + e] = nf; tab[80 + e] = nh; blk += (cn + 127) >> 7; nf += cn >> 8; nh += ((cn & 255) + 127) >> 7; } tab[16] = blk; tab[64] = nf; tab[96] = nh; }
    __syncthreads();
}
__device__ __forceinline__ void phase_combine_ln2(const Frame& F0, const Args& a, int layer, int probe = 0, int f8 = 0) {
    PHASE_FRAME(F0);
    unsigned char* ws = OPQ_G(unsigned char, a.ws); const LAS int* tab = (const LAS int*)(F.lds + AUX_OFF);
    const bf16* PRE = (const bf16*)a.out; const float* STATS = (const float*)(ws + WS_STATS); const bf16* Y = (const bf16*)(ws + WS_Y); bf16* X2B = (bf16*)(ws + (probe ? WS_R1 : WS_X2B)); unsigned char* X2F8 = ws + WS_X2F8;
    const int* TOKSLOT = (const int*)(ws + WS_TOKSLOT); const float* GATEW = (const float*)(ws + WS_GATEW);
    LAS float* GV = (LAS float*)F.lds;
    { const float* g1 = a.in[I_LN1G] + (size_t)layer * D; const float* b1 = a.in[I_LN1B] + (size_t)layer * D; const float* g2 = a.in[I_LN2G] + (size_t)layer * D; const float* b2 = a.in[I_LN2B] + (size_t)layer * D;
        for (int i = F.tid; i < D; i += 512) { GV[i] = g1[i]; GV[D + i] = b1[i]; GV[2 * D + i] = g2[i]; GV[3 * D + i] = b2[i]; } }
    __syncthreads();
    const int gw = F.vcu * NWAVES + F.wave, NGW = F.G * NWAVES, nrows = (T - gw + NGW - 1) / NGW, lane = F.lane;
    for (int base = 0; base < nrows; base += 64) {
        const int nr = (nrows - base) < 64 ? (nrows - base) : 64;
        float m_mean = 0.f, m_rstd = 0.f, m_w0 = 0.f, m_w1 = 0.f; int m_y0 = 0, m_y1 = 0;
        if (lane < nr) { const int row = gw + NGW * (base + lane); m_mean = STATS[2 * row]; m_rstd = STATS[2 * row + 1]; m_w0 = GATEW[2 * row]; m_w1 = GATEW[2 * row + 1];
            const int s0 = TOKSLOT[2 * row], s1 = TOKSLOT[2 * row + 1]; m_y0 = tab[s0 / LCAP] * 128 + (s0 % LCAP); m_y1 = tab[s1 / LCAP] * 128 + (s1 % LCAP); }
        v2u XA[8], PA[8], QA[8], XB_[8], PB_[8], QB_[8];
#define PH_LOAD(X, P, Q, i) do { const int row_ = gw + NGW * (base + (i)); const size_t y0_ = (size_t)__builtin_amdgcn_readlane(m_y0, (i)), y1_ = (size_t)__builtin_amdgcn_readlane(m_y1, (i)); \
            const GAS v2u* xr_ = (const GAS v2u*)(PRE + (size_t)row_ * D) + lane; const GAS v2u* ya_ = (const GAS v2u*)(Y + y0_ * D) + lane; const GAS v2u* yb_ = (const GAS v2u*)(Y + y1_ * D) + lane; \
            _Pragma("unroll") for (int j = 0; j < 8; ++j) { X[j] = xr_[64 * j]; P[j] = ya_[64 * j]; Q[j] = yb_[64 * j]; } } while (0)
#define PH_ROW(X, P, Q, i) do { const int row_ = gw + NGW * (base + (i)); unsigned gvo_ = (unsigned)(uintptr_t)GV; asm volatile("" : "+v"(gvo_)); const LAS float* GVr = (const LAS float*)(uintptr_t)gvo_;     \
            const float mean = __builtin_bit_cast(float, __builtin_amdgcn_readlane(__builtin_bit_cast(int, m_mean), (i))), rstd = __builtin_bit_cast(float, __builtin_amdgcn_readlane(__builtin_bit_cast(int, m_rstd), (i))); \
            const float w0 = __builtin_bit_cast(float, __builtin_amdgcn_readlane(__builtin_bit_cast(int, m_w0), (i))), w1 = __builtin_bit_cast(float, __builtin_amdgcn_readlane(__builtin_bit_cast(int, m_w1), (i))); \
            f32x4 v[8]; float s = 0.f; \
            _Pragma("unroll") for (int j = 0; j < 8; ++j) { const f32x4 gg = *(const LAS f32x4*)(GVr + 256 * j + 4 * lane), bb = *(const LAS f32x4*)(GVr + D + 256 * j + 4 * lane); \
                const f32x4 x1 = ((f32x4){bflo(X[j].x), bfhi(X[j].x), bflo(X[j].y), bfhi(X[j].y)} - mean) * rstd * gg + bb; \
                f32x4 f; f[0] = w0 * bflo(P[j].x) + w1 * bflo(Q[j].x); f[1] = w0 * bfhi(P[j].x) + w1 * bfhi(Q[j].x); f[2] = w0 * bflo(P[j].y) + w1 * bflo(Q[j].y); f[3] = w0 * bfhi(P[j].y) + w1 * bfhi(Q[j].y); \
                v[j] = x1 * ALPHA + f; s += (v[j][0] + v[j][1]) + (v[j][2] + v[j][3]); } \
            const float m2 = wave_sum(s) * (1.f / D); float q = 0.f; \
            _Pragma("unroll") for (int j = 0; j < 8; ++j) { v[j] = v[j] - m2; q += (v[j][0] * v[j][0] + v[j][1] * v[j][1]) + (v[j][2] * v[j][2] + v[j][3] * v[j][3]); } \
            const float r2 = 1.f / sqrtf(wave_sum(q) * (1.f / D) + LN_EPS); \
            GAS v2u* o8 = (GAS v2u*)(X2B + (size_t)row_ * D) + lane; \
            _Pragma("unroll") for (int j = 0; j < 8; ++j) { const f32x4 gg = *(const LAS f32x4*)(GVr + 2 * D + 256 * j + 4 * lane), bb = *(const LAS f32x4*)(GVr + 3 * D + 256 * j + 4 * lane); \
                const f32x4 o = v[j] * r2 * gg + bb; v2u w; w.x = pkbf(o[0], o[1]); w.y = pkbf(o[2], o[3]); o8[64 * j] = w; \
                if (f8) ((GAS unsigned*)((GAS unsigned char*)X2F8 + (size_t)row_ * D) + lane)[64 * j] = pk4_fp8(o[0] * F8_XS, o[1] * F8_XS, o[2] * F8_XS, o[3] * F8_XS); } } while (0)
        PH_LOAD(XA, PA, QA, 0);
#pragma unroll 1
        for (int i = 0; i < nr; i += 2) {
            if (i + 1 < nr) PH_LOAD(XB_, PB_, QB_, i + 1);
            PH_ROW(XA, PA, QA, i);
            if (i + 2 < nr) PH_LOAD(XA, PA, QA, i + 2);
            if (i + 1 < nr) PH_ROW(XB_, PB_, QB_, i + 1);
        }
#undef PH_LOAD
#undef PH_ROW
    }
}

#ifndef MK_N_LAUNCHES
#define MK_N_LAUNCHES 1
#endif
constexpr int NPL = 10;
constexpr int NPHASE = 1 + NPL * DEPTH;
constexpr int N_LAUNCHES = MK_N_LAUNCHES;
static_assert(N_LAUNCHES == 1 || N_LAUNCHES == NPHASE, "MK_N_LAUNCHES is 1 or NPHASE");

#define GRID_BAR() do { if (N_LAUNCHES == 1) xcd_barrier(bar); } while (0)
#ifndef PH_MASK
#define PH_MASK 0x7ff
#endif
#define IN(k) ((((k) == 0 ? 1u : (2u << (((k) - 1) % NPL))) & (unsigned)(PH_MASK)) && lo <= (k) && (k) < hi)
#define SEAM(k) do { if (IN((k) + 1)) GRID_BAR(); } while (0)
#ifndef PROBE_DUP
#define PROBE_DUP 0
#endif
#define REPS(k) ((((k) == 0 ? 1u : (2u << (((k) - 1) % NPL))) & (unsigned)(PROBE_DUP)) ? 2 : 1)

template <int layer> __device__ __forceinline__ void layer_phases(const Frame& F, const Args& args, const XcdBarrier& bar, const int lo, const int hi) {
            const int pb = 1 + NPL * layer;
            unsigned char* ws = OPQ_G(unsigned char, args.ws);
            if (IN(pb + 0)) { for (int rep = 0; rep < REPS(pb + 0); ++rep) { if (rep) GRID_BAR();
                SchedDense S; S.init(T, NPROJ, F.G, (int)blockIdx.x, ws + WS_XB, D, (const bf16*)(ws + WS_WIN) + (size_t)layer * NPROJ * D, D);
                EpiBf16 E{(bf16*)(ws + WS_PROJ), NPROJ};
                pg8::gemm_phase<EpiBf16, SchedDense, false>(F.lds + RING_OFF, D, D, D, S, E);
                } SEAM(pb + 0);
            }
            if (IN(pb + 1)) { for (int rep = 0; rep < REPS(pb + 1); ++rep) { if (rep) GRID_BAR(); phase_dn_prep(F, args, layer); } SEAM(pb + 1); }
            if (IN(pb + 2)) { for (int rep = 0; rep < REPS(pb + 2); ++rep) { if (rep) GRID_BAR();
                if (blockIdx.x < 32 || F.G <= 32) { for (int u = blockIdx.x; u < NB * NH; u += (F.G < 32 ? F.G : 32)) { phase_dn_scan(F, args, layer, u);
#ifdef SCAN_TWICE
                    __syncthreads(); phase_dn_scan(F, args, layer, u);
#endif
                } }
                { const bool big = F.G >= 160; const int NGEMM = big ? 96 : (F.G > 32 ? F.G - 32 : F.G); const int c2 = F.G > 32 ? (int)blockIdx.x - 32 : (int)blockIdx.x;
                  if (c2 >= 0 && c2 < NGEMM) {
                    { int t_ = threadIdx.x; asm volatile("" : "+v"(t_)); Frame Fp = F; Fp.tid = t_; Fp.lane = t_ & 63;
                      for (int L = c2; L < 256; L += NGEMM) pool_diffs_unit(Fp, ws, L >> 2, L & 3);
                      asm volatile("s_waitcnt vmcnt(0)" ::: "memory"); __syncthreads(); }
                    { SchedPool S{NGEMM, c2, (const char*)(ws + WS_POOLD), (const char*)((const bf16*)(ws + WS_WPOOL) + (size_t)layer * 4 * 65536)};
                      EpiPool E{(bf16*)(ws + WS_MIXIN), args.in[I_POOLS] + (size_t)layer * PW, FP8_PDL(layer)};
                      pg8::gemm_phase<EpiPool, SchedPool, false>(F.lds + RING_OFF, 256, PW, 256, S, E); }
                    { SchedDense S; S.init(T, D, NGEMM, c2, (const bf16*)(ws + WS_PB16) + (size_t)layer * T * PLE, PLE, (const bf16*)(ws + WS_WPP) + (size_t)layer * D * PLE, PLE);
                      EpiBf16 E{(bf16*)(ws + WS_PP), D};
                      pg8::gemm_phase<EpiBf16, SchedDense, false>(F.lds + RING_OFF, PLE, PLE, PLE, S, E); } }
#ifndef CONVERT_ALL_IN_PROLOGUE
                  __syncthreads();
                  { int t_ = threadIdx.x; asm volatile("" : "+v"(t_));
                    weight_items(args, ws, (LAS float*)(F.lds + RING_OFF + F.wave * 16384), t_ & 63, 1, layer, 0, 1, F.ctl + CW_CONV + 64 * layer); }
#endif
                }
                } SEAM(pb + 2);
            }
            if (IN(pb + 3)) { for (int rep = 0; rep < REPS(pb + 3); ++rep) { if (rep) GRID_BAR(); phase_dn_norm(F, args, layer); } SEAM(pb + 3); }
            if (IN(pb + 4)) { for (int rep = 0; rep < REPS(pb + 4); ++rep) { if (rep) GRID_BAR();
                if (FP8_PDL(layer)) { SchedDense S; S.init(T, D, F.G, (int)blockIdx.x, ws + WS_MIXIN, D / 2, ws + WS_WOUT + (size_t)layer * D * D * 2, D / 2);
                    EpiRes E{(const bf16*)(ws + WS_XB), (bf16*)args.out, F8_INV};
                    pg8::gemm_phase<EpiRes, SchedDense, false, true>(F.lds + RING_OFF, D / 2, D / 2, D / 2, S, E); }
                else { SchedDense S; S.init(T, D, F.G, (int)blockIdx.x, ws + WS_MIXIN, D, (const bf16*)(ws + WS_WOUT) + (size_t)layer * D * D, D);
                EpiRes E{(const bf16*)(ws + WS_XB), (bf16*)args.out};
#ifdef PROBE_PD
                { EpiRes E2{(const bf16*)(ws + WS_XB), (bf16*)(ws + WS_R1)}; pg8::gemm_phase<EpiRes, SchedDense, false>(F.lds + RING_OFF, D, D, D, S, E2); }
#endif
                pg8::gemm_phase<EpiRes, SchedDense, false>(F.lds + RING_OFF, D, D, D, S, E); }
                } SEAM(pb + 4);
            }
            if (IN(pb + 5)) { for (int rep = 0; rep < REPS(pb + 5); ++rep) { if (rep) GRID_BAR();
#ifdef PROBE_PE
                phase_ln1_router(F, args, layer, 1); __syncthreads();
#endif
                phase_ln1_router(F, args, layer, 0, FP8_LAYER(layer) ? 1 : 0); } SEAM(pb + 5); }
            if (IN(pb + 6)) { for (int rep = 0; rep < REPS(pb + 6); ++rep) { if (rep) GRID_BAR();
                moe_table(F, layer);
                if (FP8_LAYER(layer)) {
                    SchedMoe S{F.G, (int)blockIdx.x, 0, (const LAS int*)(F.lds + AUX_OFF), (const char*)(ws + WS_X1B), (const char*)(ws + WS_WGU + (size_t)layer * NE * 2048 * D * 2), (const int*)(ws + WS_LIST), 1};
                    EpiSwiglu E{(bf16*)(ws + WS_HID), FP8_PG, F8_INV};
                    pg8::gemm_phase<EpiSwiglu, SchedMoe, true, true>(F.lds + RING_OFF, D / 2, D / 2, D / 2, S, E);
                } else {
                    SchedMoe S{F.G, (int)blockIdx.x, 0, (const LAS int*)(F.lds + AUX_OFF), (const char*)(ws + WS_X1B), (const char*)((const bf16*)(ws + WS_WGU) + (size_t)layer * NE * 2048 * D), (const int*)(ws + WS_LIST), 2};
                    EpiSwiglu E{(bf16*)(ws + WS_HID)};
                    pg8::gemm_phase<EpiSwiglu, SchedMoe, true>(F.lds + RING_OFF, D, D, D, S, E);
                }
                } SEAM(pb + 6);
            }
            if (IN(pb + 7)) { for (int rep = 0; rep < REPS(pb + 7); ++rep) { if (rep) GRID_BAR();
                moe_table(F, layer);
                if (FP8_PG && FP8_LAYER(layer)) {
                    SchedMoe S{F.G, (int)blockIdx.x, 1, (const LAS int*)(F.lds + AUX_OFF), (const char*)(ws + WS_HID), (const char*)(ws + WS_WD + (size_t)layer * NE * D * DE * 2), nullptr, 1};
                    EpiBf16 E{(bf16*)(ws + WS_Y), D, F8_INV};
                    pg8::gemm_phase<EpiBf16, SchedMoe, false, true>(F.lds + RING_OFF, DE / 2, DE / 2, DE / 2, S, E);
                } else {
                    SchedMoe S{F.G, (int)blockIdx.x, 1, (const LAS int*)(F.lds + AUX_OFF), (const char*)(ws + WS_HID), (const char*)((const bf16*)(ws + WS_WD) + (size_t)layer * NE * D * DE), nullptr, 2};
                    EpiBf16 E{(bf16*)(ws + WS_Y), D};
                    pg8::gemm_phase<EpiBf16, SchedMoe, false>(F.lds + RING_OFF, DE, DE, DE, S, E);
                }
                } SEAM(pb + 7);
            }
            if (IN(pb + 8)) { for (int rep = 0; rep < REPS(pb + 8); ++rep) { if (rep) GRID_BAR(); moe_table(F, layer);
#ifdef PROBE_PH
                phase_combine_ln2(F, args, layer, 1);
#endif
                phase_combine_ln2(F, args, layer, 0, (FP8_PI && (FP8_PI0 || layer == DEPTH - 1)) ? 1 : 0); } SEAM(pb + 8); }
            if (IN(pb + 9)) { for (int rep = 0; rep < REPS(pb + 9); ++rep) { if (rep) GRID_BAR();
                if (FP8_PI && (FP8_PI0 || layer == DEPTH - 1)) {
                    SchedDense S; S.init(T, D, F.G, (int)blockIdx.x, ws + WS_X2F8, D / 2, ws + WS_WPG + (size_t)layer * D * D * 2, D / 2);
                    EpiPle E{(const bf16*)(ws + WS_X2B), (const bf16*)(ws + WS_PP), (bf16*)(ws + WS_XB), args.out, layer + 1 < DEPTH ? 0 : 1, F8_INV};
                    pg8::gemm_phase<EpiPle, SchedDense, false, true>(F.lds + RING_OFF, D / 2, D / 2, D / 2, S, E);
                } else {
                    SchedDense S; S.init(T, D, F.G, (int)blockIdx.x, ws + WS_X2B, D, (const bf16*)(ws + WS_WPG) + (size_t)layer * D * D, D);
                    EpiPle E{(const bf16*)(ws + WS_X2B), (const bf16*)(ws + WS_PP), (bf16*)(ws + WS_XB), args.out, layer + 1 < DEPTH ? 0 : 1};
                    pg8::gemm_phase<EpiPle, SchedDense, false>(F.lds + RING_OFF, D, D, D, S, E);
                }
                } SEAM(pb + 9);
            }
}
__global__ void __launch_bounds__(NWAVES * 64, 2) trunk_fwd(Args args) {
    extern __shared__ __attribute__((aligned(16))) unsigned char lds[];
    Frame F;
    F.lds = (LAS unsigned char*)lds;
    F.MISC = (volatile LAS unsigned*)(F.lds + MISC_OFF);
    F.tid = threadIdx.x; F.lane = F.tid & 63; F.wave = __builtin_amdgcn_readfirstlane(F.tid >> 6);
    F.G = gridDim.x; { const int bx = blockIdx.x; F.vcu = (F.G % 8 == 0) ? (bx % 8) * (F.G / 8) + bx / 8 : bx; }
    unsigned char* ws = args.ws;
    F.ctl = (gu32*)(ws + WS_CTL);
    for (int u = F.tid; u < (LDS_BYTES - LDSCTL_OFF) / 4; u += NWAVES * 64) ((LAS unsigned*)(F.lds + LDSCTL_OFF))[u] = 0u;
    __syncthreads();
    XcdBarrier bar; bar.bar = (unsigned*)(F.ctl + CW_BAR); bar.x = 0; bar.st = nullptr;
    if (N_LAUNCHES == 1) bar = xcd_barrier_post((unsigned*)(F.ctl + CW_BAR), F.MISC + 8);
    const int lo = args.ph_lo, hi = args.ph_hi;
    if (IN(0)) { for (int rep = 0; rep < REPS(0); ++rep) { if (rep) GRID_BAR(); p0_prologue(F, args); } SEAM(0); }

    layer_phases<0>(F, args, bar, lo, hi);
    layer_phases<1>(F, args, bar, lo, hi);
    static_assert(DEPTH == 2, "layer_phases instantiations");
#undef IN
#undef SEAM
#undef GRID_BAR
}

extern "C" void kernel_launch(void* const* d_in, const int* in_sizes, int n_in, void* d_out, int out_size, void* d_ws, size_t ws_size, hipStream_t stream) {
    static int grid = 0;
    if (grid == 0) {
        if (n_in != 21 || in_sizes[0] != T * D || out_size != T * D || ws_size < WS_END) { fprintf(stderr, "kernel_launch: unexpected shapes (n_in %d, in0 %d, out %d, ws %zu); nothing launched\n", n_in, n_in > 0 ? in_sizes[0] : -1, out_size, ws_size); grid = -1; return; }
        int dev = 0, cus = 0, per_cu = 0;
        if (hipGetDevice(&dev) != hipSuccess || hipDeviceGetAttribute(&cus, hipDeviceAttributeMultiprocessorCount, dev) != hipSuccess) { grid = -1; return; }
        if (hipFuncSetAttribute((const void*)trunk_fwd, hipFuncAttributeMaxDynamicSharedMemorySize, LDS_BYTES) != hipSuccess) { fprintf(stderr, "kernel_launch: hipFuncSetAttribute failed\n"); grid = -1; return; }
        if (hipOccupancyMaxActiveBlocksPerMultiprocessor(&per_cu, (const void*)trunk_fwd, NWAVES * 64, LDS_BYTES) != hipSuccess || per_cu < 1) { fprintf(stderr, "kernel_launch: occupancy query reports %d workgroups per CU\n", per_cu); }
        (void)hipGetLastError();
        grid = cus;
    }
    if (grid < 0) return;
    if (hipMemsetAsync((char*)d_ws + WS_CTL, 0, CTL_ZERO_BYTES, stream) != hipSuccess) return;
    Args a{};
    for (int i = 0; i < 21; ++i) a.in[i] = (const float*)d_in[i];
    a.out = (float*)d_out; a.ws = (unsigned char*)d_ws;
    for (int li = 0; li < N_LAUNCHES; ++li) {
        a.ph_lo = (N_LAUNCHES == 1) ? 0 : li; a.ph_hi = (N_LAUNCHES == 1) ? NPHASE : li + 1; a.li = li; a.pad = 0;
        hipLaunchKernelGGL(trunk_fwd, dim3(grid), dim3(NWAVES * 64), LDS_BYTES, stream, a);
        const hipError_t le = hipPeekAtLastError();
        if (le != hipSuccess) { fprintf(stderr, "kernel_launch: launch %d failed: %s\n", li, hipGetErrorName(le)); break; }
    }
}
```

```cpp
#define MK_N_LAUNCHES 1
#define FP8_ALL 1
#define FP8_PG 1
#define FP8_PI 1
#define FP8_PI0 1
#define FP8_PD 1
#include <hip/hip_runtime.h>
#include <cstdio>
#include <cstdint>

#define GAS __attribute__((address_space(1)))
#define LAS __attribute__((address_space(3)))
typedef unsigned short bf16;
typedef unsigned v4u __attribute__((ext_vector_type(4)));
typedef unsigned v2u __attribute__((ext_vector_type(2)));
typedef float f32x4 __attribute__((ext_vector_type(4)));
typedef float f32x2 __attribute__((ext_vector_type(2)));
typedef short bf16x8 __attribute__((ext_vector_type(8)));
typedef GAS unsigned gu32;
typedef int v4i_t __attribute__((ext_vector_type(4)));
typedef int v8i_t __attribute__((ext_vector_type(8)));

namespace pg8 {
constexpr int BM = 256, BK = 64, HALF = 128, HTB = HALF * BK * 2  , STAGE_BYTES = 8 * HTB, NXCD = 8, WGM = 8;
__host__ __device__ __forceinline__ int lds_byte(int r, int c) { const int st = (r >> 4) * 2 + (c >> 5), rr = r & 15, cc = c & 31, ob = rr * 64 + cc * 2; return st * 1024 + (ob ^ (((ob >> 9) & 1) << 5)); }
__host__ __device__ __forceinline__ void stage_rc(int b, int& R, int& C) { const int st = b / 1024, sb = b % 1024, swz = sb ^ (((sb >> 9) & 1) << 5); R = (st >> 1) * 16 + swz / 64; C = (st & 1) * 32 + (swz % 64) / 2; }
__host__ __device__ __forceinline__ int perm32(int rho) { const int n = rho >> 4, i = rho & 15; return 8 * (i >> 2) + 4 * n + (i & 3); }

struct Unit { int pm, pn; const char* A; const char* B; const int* rows; int nvalid; int aux; int rowbase; int half; };

__device__ __forceinline__ unsigned cvt_pk_bf16(float lo, float hi) { unsigned r; asm volatile("v_cvt_pk_bf16_f32 %0, %1, %2" : "=v"(r) : "v"(lo), "v"(hi)); return r; }

template <class Epi, class Sched, bool GATHER, bool FP8 = false>
__device__ __forceinline__ void gemm_phase(LAS unsigned char* lds, const int K, const int lda, const int ldb, const Sched& S, const Epi& E) {
    int tid_ = threadIdx.x; asm volatile("" : "+v"(tid_));
    const int tid = tid_, wid = __builtin_amdgcn_readfirstlane(tid >> 6), lane = tid & 63, wr = wid >> 2, wc = wid & 3, fr = lane & 15, fq = lane >> 4;
    const int nt = K / BK;
    unsigned voffA[2], voffB[2]; int RA[2], CA[2];
#pragma unroll
    for (int i = 0; i < 2; ++i) { int R, C; stage_rc(tid * 16 + i * 8192, R, C); const int Rb = Epi::PERM ? ((R & ~31) + perm32(R & 31)) : R;
        RA[i] = R; CA[i] = C; voffA[i] = (unsigned)(R * lda + C) * 2u; voffB[i] = (unsigned)(Rb * ldb + C) * 2u; }
    unsigned gA[2][2], gN[2][2];
    const size_t kstep = (size_t)(BK * 2);
    const size_t hstepA = GATHER ? 0 : (size_t)HALF * lda * 2, hstepB = (size_t)HALF * ldb * 2;
    const unsigned ldsw = (unsigned)wid * 1024u;
    const int aoff = lds_byte(wr * 64 + fr, fq * 8), boff = lds_byte(wc * 32 + fr, fq * 8);
#define PG8_SA(b, h) (((b) * 2 + (h)) * HTB)
#define PG8_SB(b, h) ((4 + (b) * 2 + (h)) * HTB)
#define PG8_STAGE_B(bufoff, gbase) do { _Pragma("unroll") for (int _i = 0; _i < 2; ++_i) \
        __builtin_amdgcn_global_load_lds((const unsigned*)((const char*)(gbase) + voffB[_i]), (LAS unsigned*)(lds + (bufoff) + ldsw + _i * 8192), 16, 0, 0); } while (0)
#define PG8_STAGE_A(bufoff, gbase, h) do { _Pragma("unroll") for (int _i = 0; _i < 2; ++_i) \
        __builtin_amdgcn_global_load_lds((const unsigned*)((const char*)(gbase) + (GATHER ? gA[h][_i] : voffA[_i]) + (h) * hstepA), (LAS unsigned*)(lds + (bufoff) + ldsw + _i * 8192), 16, 0, 0); } while (0)
#define PG8_CAT(x0, x1) __builtin_shufflevector(__builtin_bit_cast(v4i_t, (x0)), __builtin_bit_cast(v4i_t, (x1)), 0, 1, 2, 3, 4, 5, 6, 7)
#define PG8_LDA(dst, b, h) do { _Pragma("unroll") for (int m = 0; m < 4; ++m) { if constexpr (FP8) dst##8[m] = PG8_CAT(*(const LAS bf16x8*)(lds + PG8_SA(b, h) + aoff + m * 2048), *(const LAS bf16x8*)(lds + PG8_SA(b, h) + aoff + m * 2048 + 1024)); \
        else { _Pragma("unroll") for (int k = 0; k < 2; ++k) dst[m][k] = *(const LAS bf16x8*)(lds + PG8_SA(b, h) + aoff + m * 2048 + k * 1024); } } } while (0)
#define PG8_LDB(dst, b, h) do { _Pragma("unroll") for (int n = 0; n < 2; ++n) { if constexpr (FP8) dst##8[n] = PG8_CAT(*(const LAS bf16x8*)(lds + PG8_SB(b, h) + boff + n * 2048), *(const LAS bf16x8*)(lds + PG8_SB(b, h) + boff + n * 2048 + 1024)); \
        else { _Pragma("unroll") for (int k = 0; k < 2; ++k) dst[n][k] = *(const LAS bf16x8*)(lds + PG8_SB(b, h) + boff + n * 2048 + k * 1024); } } } while (0)
#define PG8_MMA(ai, bj, At, Bt) do { __builtin_amdgcn_s_setprio(1); \
        if constexpr (FP8) { _Pragma("unroll") for (int m = 0; m < 4; ++m) _Pragma("unroll") for (int n = 0; n < 2; ++n) \
            asm volatile("v_mfma_scale_f32_16x16x128_f8f6f4 %0, %1, %2, %0, %3, %3 op_sel_hi:[0,0,0]" : "+v"(acc[ai][bj][m][n]) : "v"(Bt##8[n]), "v"(At##8[m]), "v"(f8scale)); } \
        else { _Pragma("unroll") for (int m = 0; m < 4; ++m) _Pragma("unroll") for (int n = 0; n < 2; ++n) _Pragma("unroll") for (int k = 0; k < 2; ++k) \
            acc[ai][bj][m][n] = __builtin_amdgcn_mfma_f32_16x16x32_bf16(Bt[n][k], At[m][k], acc[ai][bj][m][n], 0, 0, 0); } \
        __builtin_amdgcn_s_setprio(0); } while (0)
#define PG8_WAIT_V(n) asm volatile("s_waitcnt vmcnt(" #n ")" ::: "memory")
#define PG8_WAIT_L(n) asm volatile("s_waitcnt lgkmcnt(" #n ")" ::: "memory")
#define PG8_BAR __builtin_amdgcn_s_barrier()
#define PG8_SCHED __builtin_amdgcn_sched_barrier(0)
#define PG8_GLOAD(dst, u) do { _Pragma("unroll") for (int _h = 0; _h < 2; ++_h) _Pragma("unroll") for (int _i = 0; _i < 2; ++_i) { const int _r = _h * HALF + RA[_i]; \
        const int _rc = _r < (u).nvalid ? _r : (u).nvalid - 1; const int _tl = (u).rows[_rc]; const int _t = (_r < (u).nvalid) ? _tl : 0; dst[_h][_i] = (unsigned)(_t * lda + CA[_i]) * 2u; } } while (0)
    Unit cur, nxt; int ui = 0;
    if (!S.next(0, cur)) return;
    f32x4 acc[2][2][4][2];
#pragma unroll
    for (int a = 0; a < 2; ++a)
#pragma unroll
        for (int b = 0; b < 2; ++b)
#pragma unroll
            for (int m = 0; m < 4; ++m)
#pragma unroll
                for (int n = 0; n < 2; ++n) acc[a][b][m][n] = (f32x4){0.f, 0.f, 0.f, 0.f};
    const unsigned f8scale = 0x7f7f7f7fu;
    bf16x8 At[4][2], B0[2][2], B1[2][2]; v8i_t At8[4], B08[2], B18[2];
    const char* cA = cur.A; const char* cB = cur.B;
    if constexpr (GATHER) { PG8_GLOAD(gA, cur); PG8_WAIT_V(0); }
    PG8_STAGE_B(PG8_SB(0, 0), cB); PG8_STAGE_B(PG8_SB(0, 1), cB + hstepB); PG8_STAGE_A(PG8_SA(0, 0), cA, 0); PG8_STAGE_A(PG8_SA(0, 1), cA, 1);
    if (wr == 1) PG8_BAR;
    PG8_WAIT_V(2); PG8_BAR;
    PG8_STAGE_B(PG8_SB(1, 0), cB + kstep); PG8_STAGE_A(PG8_SA(1, 0), cA + kstep, 0); PG8_STAGE_B(PG8_SB(1, 1), cB + hstepB + kstep);
    PG8_WAIT_V(6); PG8_BAR;
    for (;;) {
        const bool has_next = S.next(ui + 1, nxt); const bool halfu = Sched::RAGGED && cur.half != 0;
        const char* nA = has_next ? nxt.A : cA; const char* nB = has_next ? nxt.B : cB;
        if constexpr (GATHER) { if (has_next) { PG8_GLOAD(gN, nxt); } else {
#pragma unroll
            for (int h = 0; h < 2; ++h)
#pragma unroll
                for (int i = 0; i < 2; ++i) gN[h][i] = gA[h][i]; } }
#pragma unroll 1
        for (int t = 0; t < nt; t += 2) {
            const bool last = (t == nt - 2);
            const char* a1 = cA + (size_t)(t + 1) * kstep;
            const char* a2 = last ? nA : cA + (size_t)(t + 2) * kstep; const char* b2 = last ? nB : cB + (size_t)(t + 2) * kstep;
            const char* a3 = a2 + kstep; const char* b3 = b2 + kstep;
            PG8_LDB(B0, 0, 0); PG8_LDB(B1, 0, 1); PG8_SCHED; PG8_LDA(At, 0, 0); PG8_STAGE_A(PG8_SA(1, 1), a1, 1);
            if constexpr (GATHER) { if (last) {
#pragma unroll
                for (int h = 0; h < 2; ++h)
#pragma unroll
                    for (int i = 0; i < 2; ++i) gA[h][i] = gN[h][i]; } }
            PG8_WAIT_V(8); PG8_WAIT_L(0); PG8_BAR; PG8_MMA(0, 0, At, B0); PG8_MMA(0, 1, At, B1); PG8_BAR; PG8_SCHED;
            if (!halfu) PG8_LDA(At, 0, 1); PG8_STAGE_B(PG8_SB(0, 0), b2); PG8_STAGE_B(PG8_SB(0, 1), b2 + hstepB); PG8_STAGE_A(PG8_SA(0, 0), a2, 0);
            PG8_WAIT_V(8); PG8_WAIT_L(0); PG8_BAR; if (!halfu) { PG8_MMA(1, 0, At, B0); PG8_MMA(1, 1, At, B1); } PG8_BAR; PG8_SCHED;
            PG8_LDB(B0, 1, 0); PG8_LDB(B1, 1, 1); PG8_SCHED; PG8_LDA(At, 1, 0); PG8_STAGE_A(PG8_SA(0, 1), a2, 1);
            PG8_WAIT_V(8); PG8_WAIT_L(0); PG8_BAR; PG8_MMA(0, 0, At, B0); PG8_MMA(0, 1, At, B1); PG8_BAR; PG8_SCHED;
            if (!halfu) PG8_LDA(At, 1, 1); PG8_STAGE_B(PG8_SB(1, 0), b3); PG8_STAGE_B(PG8_SB(1, 1), b3 + hstepB); PG8_STAGE_A(PG8_SA(1, 0), a3, 0);
            PG8_WAIT_V(8); PG8_WAIT_L(0); PG8_BAR; if (!halfu) { PG8_MMA(1, 0, At, B0); PG8_MMA(1, 1, At, B1); } PG8_BAR; PG8_SCHED;
        }
        if (wr == 0) PG8_BAR;
        if constexpr (FP8) asm volatile("s_nop 15\n\ts_nop 15\n\ts_nop 15" ::: "memory");
        E(acc, cur, wr, wc, fr, fq);
        if (!has_next) break;
#pragma unroll
        for (int a = 0; a < 2; ++a)
#pragma unroll
            for (int b = 0; b < 2; ++b)
#pragma unroll
                for (int m = 0; m < 4; ++m)
#pragma unroll
                    for (int n = 0; n < 2; ++n) acc[a][b][m][n] = (f32x4){0.f, 0.f, 0.f, 0.f};
        cur = nxt; cA = nA; cB = nB; ++ui;
        if (wr == 1) PG8_BAR;
    }
    PG8_WAIT_V(0);
    PG8_BAR;
#undef PG8_SA
#undef PG8_SB
#undef PG8_STAGE_A
#undef PG8_STAGE_B
#undef PG8_LDA
#undef PG8_LDB
#undef PG8_MMA
#undef PG8_CAT
#undef PG8_WAIT_V
#undef PG8_WAIT_L
#undef PG8_BAR
#undef PG8_SCHED
#undef PG8_GLOAD
}
}

constexpr int NB = 4, SEQ = 4096, D = 2048, DEPTH = 2;
constexpr int T = NB * SEQ;
constexpr int NH = 8, HD = 128, DNW = 1024, CH = 64, NCH = SEQ / CH;
constexpr int PW = 1024, PG_DIM = 256;
constexpr int IN_COLS = 5136, NPROJ = 5120;
constexpr int NE = 16, DE = 1024, PLE = 256;
constexpr float ALPHA = 1.4142135623730951f;
constexpr float LN_EPS = 1e-5f, RMS_EPS = 1e-6f;
constexpr int LCAP = T;
constexpr int MAXTILES = 2 * T / 256 + NE;

constexpr size_t MiB = 1u << 20;
constexpr size_t WS_CTL = 0, CTL_ZERO_BYTES = 64 * 1024;
constexpr size_t WS_LIST = 2 * MiB;
constexpr size_t WS_TOKSLOT = 3 * MiB, WS_GATEW = WS_TOKSLOT + 128 * 1024, WS_STATS = WS_GATEW + 128 * 1024, WS_CD = WS_STATS + 128 * 1024, WS_WBA = WS_CD + 128 * 1024;
constexpr size_t WS_WIN = 4 * MiB, WS_WOUT = 44 * MiB, WS_WPG = 60 * MiB, WS_WPP = 76 * MiB, WS_WPOOL = 78 * MiB, WS_WGU = 80 * MiB, WS_WD = 336 * MiB, WS_PB16 = 464 * MiB;
constexpr size_t WS_XB = 480 * MiB, WS_R1 = 544 * MiB, WS_R2 = 704 * MiB, WS_R4 = 848 * MiB, WS_R5 = 944 * MiB, WS_END = 1008 * MiB;
constexpr size_t WS_PROJ = WS_R1, WS_HID = WS_R1;
constexpr size_t WS_Y = WS_R2;
constexpr size_t WS_POOLD = WS_R4, WS_PP = WS_R4 + 32 * MiB, WS_X1B = WS_R2;
constexpr size_t WS_MIXIN = WS_R5, WS_X2B = WS_R5;
constexpr size_t WS_X2F8 = WS_R1 + 96 * MiB;
static_assert((size_t)MAXTILES * 256 * 2048 * 2 <= 144 * MiB && (size_t)MAXTILES * 256 * 1024 * 2 <= 160 * MiB, "MoE row buffers");
constexpr int CW_TMO = 0, CW_CODE = 1, CW_CNT = 64  , CW_CONV = 512  , CW_BAR = 4096;

constexpr int RING_OFF = 0, RING_BYTES = 131072;
constexpr int LDSCTL_OFF = 152 * 1024, MISC_OFF = LDSCTL_OFF + 320;
constexpr int AUX_OFF = LDSCTL_OFF + 1024;
constexpr int LDS_BYTES = 163840;
constexpr int NWAVES = 8;

#define RLX_AGENT __ATOMIC_RELAXED, __HIP_MEMORY_SCOPE_AGENT
#define LDS_WAIT() asm volatile("s_waitcnt lgkmcnt(0)" ::: "memory")
#define VM_WAIT() asm volatile("s_waitcnt vmcnt(0)" ::: "memory")
__device__ __forceinline__ unsigned f2bf(float f) { unsigned u = __builtin_bit_cast(unsigned, f); return (u + 0x7fffu + ((u >> 16) & 1u)) >> 16; }
__device__ __forceinline__ unsigned pk2(float lo, float hi) { return f2bf(lo) | (f2bf(hi) << 16); }
typedef __bf16 bf2_t __attribute__((ext_vector_type(2)));
__device__ __forceinline__ unsigned pkbf(float lo, float hi) { const f32x2 v = {lo, hi}; return __builtin_bit_cast(unsigned, __builtin_convertvector(v, bf2_t)); }
constexpr float F8_XS = 16.0f, F8_WS = 256.0f, F8_INV = 1.0f / 4096.0f;
__device__ __forceinline__ float f8clamp(float x) { return fminf(fmaxf(x, -448.0f), 448.0f); }
__device__ __forceinline__ unsigned pk4_fp8(float a, float b, float c, float d) { unsigned w = 0u; w = (unsigned)__builtin_amdgcn_cvt_pk_fp8_f32(f8clamp(a), f8clamp(b), (int)w, false); w = (unsigned)__builtin_amdgcn_cvt_pk_fp8_f32(f8clamp(c), f8clamp(d), (int)w, true); return w; }
__device__ __forceinline__ float bf2f(unsigned short b) { return __builtin_bit_cast(float, ((unsigned)b) << 16); }
__device__ __forceinline__ float bflo(unsigned w) { return __builtin_bit_cast(float, w << 16); }
__device__ __forceinline__ float bfhi(unsigned w) { return __builtin_bit_cast(float, w & 0xffff0000u); }
__device__ __forceinline__ float sigmoidf_(float x) { return __builtin_amdgcn_rcpf(1.0f + __expf(-x)); }
template <int CTRL> __device__ __forceinline__ float dpp_(float x) { return __builtin_bit_cast(float, __builtin_amdgcn_mov_dpp(__builtin_bit_cast(int, x), CTRL, 0xf, 0xf, true)); }
constexpr int DPP_XOR1 = 0xB1, DPP_XOR2 = 0x4E, DPP_HMIRROR = 0x141, DPP_XOR8 = 0x128;
__device__ __forceinline__ float xrow16_sum(float x) {
    float p = x, q = x; asm volatile("v_nop\n\tv_nop\n\tv_permlane16_swap_b32 %0, %1" : "+v"(p), "+v"(q));
    x = p + q;
    float r = x, s = x; asm volatile("v_nop\n\tv_nop\n\tv_permlane32_swap_b32 %0, %1" : "+v"(r), "+v"(s));
    return r + s;
}
#ifdef OLD_SHUFFLES
__device__ __forceinline__ float row8_sum(float v) { v += __shfl_xor(v, 1); v += __shfl_xor(v, 2); v += __shfl_xor(v, 4); return v; }
__device__ __forceinline__ float wave_sum(float v) {
#pragma unroll
    for (int o = 1; o < 64; o <<= 1) v += __shfl_xor(v, o);
    return v; }
#else
__device__ __forceinline__ float row8_sum(float v) { v += dpp_<DPP_XOR1>(v); v += dpp_<DPP_XOR2>(v); v += dpp_<DPP_HMIRROR>(v); return v; }
__device__ __forceinline__ float wave_sum(float v) { v = row8_sum(v); v += dpp_<DPP_XOR8>(v); return xrow16_sum(v); }
#endif
#define XB_TMO      128
#define XB_XCNT(j)  (256  + 64 * (j))
#define XB_XSUB(j)  (1280 + 64 * (j))
#define XB_XGEN(j)  (2304 + 64 * (j))
#define XB_TOP      3328
#define XB_TOPGEN   3392
#define XCD_BAR_WORDS 3456
#define XB_SPIN_CAP (1u << 18)

__device__ __forceinline__ unsigned xb_ld(unsigned* p)              { return __hip_atomic_load(p, __ATOMIC_RELAXED, __HIP_MEMORY_SCOPE_AGENT); }
__device__ __forceinline__ unsigned xb_add(unsigned* p, unsigned v) { return __hip_atomic_fetch_add(p, v, __ATOMIC_RELAXED, __HIP_MEMORY_SCOPE_AGENT); }
__device__ __forceinline__ unsigned xb_xcc_id() { return (unsigned)__builtin_amdgcn_s_getreg((3 << 11) | 20) & 0xFu; }
#define XB_SPIN(cond, bar) do { unsigned _sp = 0; while (cond) { __builtin_amdgcn_s_sleep(1); \
    if ((++_sp & 255u) == 0u) { if (xb_ld(&(bar)[XB_TMO])) break; if (_sp > XB_SPIN_CAP) { atomicAdd(&(bar)[XB_TMO], 1u); break; } } } } while (0)

struct XcdBarrier {
    unsigned* bar; unsigned x;
    volatile LAS unsigned* st;
};

__device__ __forceinline__ XcdBarrier xcd_barrier_post(unsigned* bar, volatile LAS unsigned* st) {
    XcdBarrier b; b.bar = bar; b.x = xb_xcc_id(); b.st = st;
    if (threadIdx.x == 0) (void)xb_add(&bar[XB_XCNT(b.x)], 1u);
    return b;
}
__device__ __forceinline__ void xcd_barrier_complete(unsigned* bar, unsigned x, unsigned& nloc, unsigned& nx) {
    const unsigned G = gridDim.x * gridDim.y * gridDim.z;
    unsigned sum, cnt, mine, sp = 0u;
    for (;;) {
        sum = 0u; cnt = 0u; mine = 0u;
#pragma unroll
        for (unsigned j = 0; j < 16; ++j) { const unsigned c = xb_ld(&bar[XB_XCNT(j)]); sum += c; cnt += (c > 0u) ? 1u : 0u; mine = (j == x) ? c : mine; }
        if (sum == G) break;
        __builtin_amdgcn_s_sleep(1);
        if ((++sp & 255u) == 0u) { if (xb_ld(&bar[XB_TMO])) break; if (sp > XB_SPIN_CAP) { atomicAdd(&bar[XB_TMO], 1u); break; } }
    }
    nloc = mine > 0u ? mine : 1u; nx = cnt > 0u ? cnt : 1u;
}

__device__ __forceinline__ void xcd_barrier(const XcdBarrier& b) {
    asm volatile("s_waitcnt vmcnt(0)" ::: "memory");
    __syncthreads();
    if (threadIdx.x == 0) {
        unsigned* bar = b.bar;
        __builtin_amdgcn_s_waitcnt(0);
        unsigned nloc = b.st[0], nx = b.st[1];
        if (nloc == 0u) { xcd_barrier_complete(bar, b.x, nloc, nx); b.st[0] = nloc; b.st[1] = nx; }
        const unsigned old = xb_add(&bar[XB_XSUB(b.x)], 1u);
        const unsigned gen = old / nloc;
        if (old + 1u == (gen + 1u) * nloc) {
            __builtin_amdgcn_fence(__ATOMIC_RELEASE, "agent");
            asm volatile("s_waitcnt vmcnt(0)" ::: "memory");
            const unsigned og = xb_add(&bar[XB_TOP], 1u);
            const unsigned tg = og / nx;
            if (og + 1u == (tg + 1u) * nx) xb_add(&bar[XB_TOPGEN], 1u);
            else XB_SPIN(xb_ld(&bar[XB_TOPGEN]) == tg, bar);
            __builtin_amdgcn_fence(__ATOMIC_ACQUIRE, "agent");
            xb_add(&bar[XB_XGEN(b.x)], 1u);
            asm volatile("s_waitcnt vmcnt(0)" ::: "memory");
        } else {
            XB_SPIN(xb_ld(&bar[XB_XGEN(b.x)]) == gen, bar);
            __builtin_amdgcn_fence(__ATOMIC_ACQUIRE, "agent");
            asm volatile("s_waitcnt vmcnt(0)" ::: "memory");
        }
    }
    __syncthreads();
}

struct Args { const float* in[21]; float* out; unsigned char* ws; int ph_lo, ph_hi, li, pad; };
enum { I_X = 0, I_P, I_WIN, I_CONVW, I_ALOG, I_DTB, I_NORMW, I_POOLW, I_POOLS, I_WOUT, I_LN1G, I_LN1B, I_WR, I_BR, I_WEG, I_WEU, I_WED, I_LN2G, I_LN2B, I_WPP, I_WPG };
struct Frame {
    LAS unsigned char* lds;
    volatile LAS unsigned* MISC;
    gu32* ctl;
    int tid, lane, wave, vcu, G;
};

#ifndef FP8_LAST
#define FP8_LAST 1
#endif
#ifndef FP8_PG
#define FP8_PG 0
#endif
#ifndef FP8_ALL
#define FP8_ALL 0
#endif
#ifndef FP8_PD
#define FP8_PD 0
#endif
#ifndef FP8_PD_ALL
#define FP8_PD_ALL 0
#endif
#define FP8_PDL(l) (FP8_PD && (FP8_PD_ALL || (l) == DEPTH - 1))
#ifndef FP8_PI0
#define FP8_PI0 0
#endif
#define FP8_LAYER(l) (FP8_LAST && (FP8_ALL || (l) == DEPTH - 1))
#ifndef FP8_PI
#define FP8_PI 0
#endif
#define PHASE_FRAME(F0) Frame F = F0; { int t_ = threadIdx.x; asm volatile("" : "+v"(t_)); F.tid = t_; F.lane = t_ & 63; }
#define OPQ_S(p) asm volatile("" : "+s"(p))
#define OPQ_G(T, expr) ({ GAS T* g_ = (GAS T*)(expr); asm volatile("" : "+s"(g_)); (T*)g_; })
struct SchedDense {
    static constexpr bool RAGGED = false;
    int nM, nN, nwg, G, c; const char* A; const char* B; size_t astep, bstep;
    __device__ __forceinline__ void init(int M, int N, int G_, int c_, const void* A_, int lda, const void* B_, int ldb) { nM = M / 256; nN = N / 256; nwg = nM * nN; G = G_; c = c_;
        A = (const char*)A_; B = (const char*)B_; astep = (size_t)256 * lda * 2; bstep = (size_t)256 * ldb * 2; }
    __device__ __forceinline__ bool next(int i, pg8::Unit& u) const {
        const long L = (long)i * G + c; if (L >= nwg) return false;
        int wgid = (int)L; { const int q = nwg / 8, r = nwg % 8, xcd = wgid % 8, off = wgid / 8; wgid = (xcd < r ? xcd * (q + 1) : r * (q + 1) + (xcd - r) * q) + off; }
        const int nig = 8 * nN, gid = wgid / nig, fm = gid * 8, gsz = (nM - fm) < 8 ? (nM - fm) : 8;
        u.pm = fm + ((wgid % nig) % gsz); u.pn = (wgid % nig) / gsz;
        u.A = A + (size_t)u.pm * astep; u.B = B + (size_t)u.pn * bstep; u.rows = nullptr; u.nvalid = 256; u.aux = 0; u.rowbase = u.pm * 256; u.half = 0; return true;
    }
};
struct SchedPool {
    static constexpr bool RAGGED = false;
    int G, c; const char* A; const char* B;
    __device__ __forceinline__ bool next(int i, pg8::Unit& u) const {
        const int L = i * G + c; if (L >= 256) return false;
        u.pm = L >> 2; u.pn = L & 3; u.A = A + ((size_t)u.pm * 256 * PW + u.pn * 256) * 2; u.B = B + (size_t)u.pn * 65536 * 2; u.rows = nullptr; u.nvalid = 256; u.aux = 0; u.rowbase = u.pm * 256; u.half = 0; return true;
    }
};
struct SchedMoe {
    static constexpr bool RAGGED = true;
    int G, c, mode; const LAS int* tab; const char* A; const char* B; const int* list; int esz;
    __device__ __forceinline__ bool next(int i, pg8::Unit& u) const {
        const int L = i * G + c, nf = __builtin_amdgcn_readfirstlane(tab[64]), nh = __builtin_amdgcn_readfirstlane(tab[96]);
        if (L >= 8 * (nf + nh)) return false;
        const bool half = L >= 8 * nf; const int t = (half ? L - 8 * nf : L) >> 3, pn = L & 7, pbase = half ? 80 : 48;
        int e = 0;
#pragma unroll
        for (int k = 1; k < 16; ++k) { const int ts = __builtin_amdgcn_readfirstlane(tab[pbase + k]); if (t >= ts) e = k; }
        const int tl = t - __builtin_amdgcn_readfirstlane(tab[pbase + e]), cn = __builtin_amdgcn_readfirstlane(tab[32 + e]), blk = __builtin_amdgcn_readfirstlane(tab[e]);
        const int p0 = half ? ((cn >> 8) << 8) + 128 * tl : 256 * tl;
        u.pm = 0; u.pn = pn; u.aux = e; u.half = half ? 1 : 0; u.rowbase = blk * 128 + p0;
        const int nv = cn - p0; u.nvalid = nv < (half ? 128 : 256) ? nv : (half ? 128 : 256);
        if (mode == 0) { u.A = A; u.rows = list + (size_t)e * LCAP + p0; u.B = B + ((size_t)e * 2048 + pn * 256) * 2048 * esz; }
        else { u.A = A + (size_t)u.rowbase * DE * esz; u.rows = nullptr; u.B = B + ((size_t)e * 2048 + pn * 256) * DE * esz; }
        return true;
    }
};

using pg8::cvt_pk_bf16;
struct EpiBf16 {
    static constexpr bool PERM = true; bf16* O; int ldc; float scale = 1.0f;
    __device__ __forceinline__ void operator()(const f32x4 (&acc)[2][2][4][2], const pg8::Unit& u, int wr, int wc, int fr, int fq) const {
        const int row0 = u.rowbase + wr * 64 + fr, col0 = u.pn * 256 + wc * 32 + 8 * fq;
#pragma unroll
        for (int ai = 0; ai < 2; ++ai) if (ai == 0 || !u.half)
#pragma unroll
            for (int m = 0; m < 4; ++m) { bf16* rowp = O + (size_t)(row0 + ai * 128 + m * 16) * ldc + col0;
#pragma unroll
                for (int bj = 0; bj < 2; ++bj) { const f32x4 v0 = acc[ai][bj][m][0] * scale, v1 = acc[ai][bj][m][1] * scale;
                    v4u w; w.x = cvt_pk_bf16(v0[0], v0[1]); w.y = cvt_pk_bf16(v0[2], v0[3]); w.z = cvt_pk_bf16(v1[0], v1[1]); w.w = cvt_pk_bf16(v1[2], v1[3]);
                    *(v4u*)(rowp + bj * 128) = w; } }
    }
};
struct EpiPool {
    static constexpr bool PERM = true; bf16* O; const float* scale; int f8 = 0;
    __device__ __forceinline__ void operator()(const f32x4 (&acc)[2][2][4][2], const pg8::Unit& u, int wr, int wc, int fr, int fq) const {
        const int row0 = u.rowbase + wr * 64 + fr, cg = u.pn * 256 + wc * 32 + 8 * fq;
        f32x4 sv[2][2];
#pragma unroll
        for (int bj = 0; bj < 2; ++bj) { sv[bj][0] = *(const f32x4*)(scale + cg + bj * 128); sv[bj][1] = *(const f32x4*)(scale + cg + bj * 128 + 4); }
#pragma unroll
        for (int ai = 0; ai < 2; ++ai)
#pragma unroll
            for (int m = 0; m < 4; ++m) { bf16* rowp = O + (size_t)(row0 + ai * 128 + m * 16) * D + DNW + cg;
#pragma unroll
                for (int bj = 0; bj < 2; ++bj) { const f32x4 v0 = acc[ai][bj][m][0] * sv[bj][0], v1 = acc[ai][bj][m][1] * sv[bj][1];
                    if (f8) { v2u w8; w8.x = pk4_fp8(v0[0] * F8_XS, v0[1] * F8_XS, v0[2] * F8_XS, v0[3] * F8_XS); w8.y = pk4_fp8(v1[0] * F8_XS, v1[1] * F8_XS, v1[2] * F8_XS, v1[3] * F8_XS);
                        *(v2u*)((unsigned char*)O + (size_t)(row0 + ai * 128 + m * 16) * D + DNW + cg + bj * 128) = w8; }
                    else { v4u w; w.x = cvt_pk_bf16(v0[0], v0[1]); w.y = cvt_pk_bf16(v0[2], v0[3]); w.z = cvt_pk_bf16(v1[0], v1[1]); w.w = cvt_pk_bf16(v1[2], v1[3]);
                    *(v4u*)(rowp + bj * 128) = w; } } }
    }
};
struct EpiRes {
    static constexpr bool PERM = true; const bf16* XB; bf16* PRE; float ascale = 1.0f;
    __device__ __forceinline__ void operator()(const f32x4 (&acc)[2][2][4][2], const pg8::Unit& u, int wr, int wc, int fr, int fq) const {
        const int row0 = u.rowbase + wr * 64 + fr, col0 = u.pn * 256 + wc * 32 + 8 * fq;
#pragma unroll
        for (int ai = 0; ai < 2; ++ai) { v4u xq[4][2];
#pragma unroll
            for (int m = 0; m < 4; ++m)
#pragma unroll
                for (int bj = 0; bj < 2; ++bj) xq[m][bj] = *(const v4u*)(XB + (size_t)(row0 + ai * 128 + m * 16) * D + col0 + bj * 128);
            asm volatile("" : "+v"(xq[0][0]), "+v"(xq[0][1]), "+v"(xq[1][0]), "+v"(xq[1][1]), "+v"(xq[2][0]), "+v"(xq[2][1]), "+v"(xq[3][0]), "+v"(xq[3][1]));
#pragma unroll
            for (int m = 0; m < 4; ++m)
#pragma unroll
                for (int bj = 0; bj < 2; ++bj) { const size_t off = (size_t)(row0 + ai * 128 + m * 16) * D + col0 + bj * 128; const v4u x = xq[m][bj]; const f32x4 a0 = acc[ai][bj][m][0] * ascale, a1 = acc[ai][bj][m][1] * ascale;
                    v4u w; w.x = cvt_pk_bf16(bflo(x.x) * ALPHA + a0[0], bfhi(x.x) * ALPHA + a0[1]); w.y = cvt_pk_bf16(bflo(x.y) * ALPHA + a0[2], bfhi(x.y) * ALPHA + a0[3]);
                    w.z = cvt_pk_bf16(bflo(x.z) * ALPHA + a1[0], bfhi(x.z) * ALPHA + a1[1]); w.w = cvt_pk_bf16(bflo(x.w) * ALPHA + a1[2], bfhi(x.w) * ALPHA + a1[3]);
                    *(v4u*)(PRE + off) = w; } }
    }
};
struct EpiSwiglu {
    static constexpr bool PERM = true; bf16* O; int f8 = 0; float ascale = 1.0f;
    __device__ __forceinline__ void operator()(const f32x4 (&acc)[2][2][4][2], const pg8::Unit& u, int wr, int wc, int fr, int fq) const {
        const int row0 = u.rowbase + wr * 64 + fr, col0 = u.pn * 128 + wc * 32 + 8 * fq;
#pragma unroll
        for (int ai = 0; ai < 2; ++ai) if (ai == 0 || !u.half)
#pragma unroll
            for (int m = 0; m < 4; ++m) { bf16* rowp = O + (size_t)(row0 + ai * 128 + m * 16) * DE + col0;
                float h[8];
#pragma unroll
                for (int n = 0; n < 2; ++n)
#pragma unroll
                    for (int j = 0; j < 4; ++j) { const float g = acc[ai][0][m][n][j] * ascale, up = acc[ai][1][m][n][j] * ascale; h[4 * n + j] = g * sigmoidf_(g) * up; }
                if (f8) { v2u w8; w8.x = pk4_fp8(h[0] * F8_XS, h[1] * F8_XS, h[2] * F8_XS, h[3] * F8_XS); w8.y = pk4_fp8(h[4] * F8_XS, h[5] * F8_XS, h[6] * F8_XS, h[7] * F8_XS);
                    *(v2u*)((unsigned char*)O + (size_t)(row0 + ai * 128 + m * 16) * DE + col0) = w8; }
                else { v4u w; w.x = cvt_pk_bf16(h[0], h[1]); w.y = cvt_pk_bf16(h[2], h[3]); w.z = cvt_pk_bf16(h[4], h[5]); w.w = cvt_pk_bf16(h[6], h[7]);
                *(v4u*)rowp = w; } }
    }
};
struct EpiPle {
    static constexpr bool PERM = true; const bf16* X2B; const bf16* PP; bf16* XB; float* OUT; int last; float ascale = 1.0f;
    __device__ __forceinline__ void operator()(const f32x4 (&acc)[2][2][4][2], const pg8::Unit& u, int wr, int wc, int fr, int fq) const {
        const int row0 = u.rowbase + wr * 64 + fr, col0 = u.pn * 256 + wc * 32 + 8 * fq;
#pragma unroll
        for (int ai = 0; ai < 2; ++ai)
#pragma unroll
            for (int mp = 0; mp < 2; ++mp) { v4u xq[2][2], pq[2][2];
#pragma unroll
                for (int mm = 0; mm < 2; ++mm)
#pragma unroll
                    for (int bj = 0; bj < 2; ++bj) { const size_t off = (size_t)(row0 + ai * 128 + (2 * mp + mm) * 16) * D + col0 + bj * 128; xq[mm][bj] = *(const v4u*)(X2B + off); pq[mm][bj] = *(const v4u*)(PP + off); }
                asm volatile("" : "+v"(xq[0][0]), "+v"(xq[0][1]), "+v"(xq[1][0]), "+v"(xq[1][1]), "+v"(pq[0][0]), "+v"(pq[0][1]), "+v"(pq[1][0]), "+v"(pq[1][1]));
#pragma unroll
                for (int mm = 0; mm < 2; ++mm)
#pragma unroll
                    for (int bj = 0; bj < 2; ++bj) { const int m = 2 * mp + mm; const size_t off = (size_t)(row0 + ai * 128 + m * 16) * D + col0 + bj * 128;
                        const v4u xx = xq[mm][bj], pp = pq[mm][bj];
                        const f32x4 a0 = acc[ai][bj][m][0] * ascale, a1 = acc[ai][bj][m][1] * ascale;
                        f32x4 o0, o1;
                        o0[0] = bflo(xx.x) + sigmoidf_(a0[0]) * bflo(pp.x); o0[1] = bfhi(xx.x) + sigmoidf_(a0[1]) * bfhi(pp.x); o0[2] = bflo(xx.y) + sigmoidf_(a0[2]) * bflo(pp.y); o0[3] = bfhi(xx.y) + sigmoidf_(a0[3]) * bfhi(pp.y);
                        o1[0] = bflo(xx.z) + sigmoidf_(a1[0]) * bflo(pp.z); o1[1] = bfhi(xx.z) + sigmoidf_(a1[1]) * bfhi(pp.z); o1[2] = bflo(xx.w) + sigmoidf_(a1[2]) * bflo(pp.w); o1[3] = bfhi(xx.w) + sigmoidf_(a1[3]) * bfhi(pp.w);
                        if (last) { *(f32x4*)(OUT + off) = o0; *(f32x4*)(OUT + off + 4) = o1; }
                        else { v4u w; w.x = cvt_pk_bf16(o0[0], o0[1]); w.y = cvt_pk_bf16(o0[2], o0[3]); w.z = cvt_pk_bf16(o1[0], o1[1]); w.w = cvt_pk_bf16(o1[2], o1[3]); *(v4u*)(XB + off) = w; } } }
    }
};

__device__ __forceinline__ void tr_item(const float* W, int ldw, int k0, int n0, bf16* WT, size_t drow0, int ldt, LAS float* scr, int lane) {
#pragma unroll 8
    for (int i = 0; i < 32; ++i) { const int kk = 2 * i + (lane >> 5); scr[kk * 33 + (lane & 31)] = W[(size_t)(k0 + kk) * ldw + n0 + (lane & 31)]; }
    LDS_WAIT(); asm volatile("" ::: "memory");
    const int c = lane & 7;
#pragma unroll
    for (int j = 0; j < 4; ++j) { const int n = (lane >> 3) + 8 * j; const LAS float* s = scr + (8 * c) * 33 + n;
        v4u o; o.x = pk2(s[0 * 33], s[1 * 33]); o.y = pk2(s[2 * 33], s[3 * 33]); o.z = pk2(s[4 * 33], s[5 * 33]); o.w = pk2(s[6 * 33], s[7 * 33]);
        *(GAS v4u*)(WT + (drow0 + n) * ldt + k0 + 8 * c) = o; }
    LDS_WAIT(); asm volatile("" ::: "memory");
}
__device__ __forceinline__ void tr_item8(const float* W, int ldw, int k0, int n0, unsigned char* WT, size_t drow0, int ldt, LAS float* scr, int lane) {
#pragma unroll 8
    for (int i = 0; i < 32; ++i) { const int kk = 2 * i + (lane >> 5); scr[kk * 33 + (lane & 31)] = W[(size_t)(k0 + kk) * ldw + n0 + (lane & 31)]; }
    LDS_WAIT(); asm volatile("" ::: "memory");
    const int c = lane & 7;
#pragma unroll
    for (int j = 0; j < 4; ++j) { const int n = (lane >> 3) + 8 * j; const LAS float* s = scr + (8 * c) * 33 + n;
        v2u o; o.x = pk4_fp8(s[0 * 33] * F8_WS, s[1 * 33] * F8_WS, s[2 * 33] * F8_WS, s[3 * 33] * F8_WS); o.y = pk4_fp8(s[4 * 33] * F8_WS, s[5 * 33] * F8_WS, s[6 * 33] * F8_WS, s[7 * 33] * F8_WS);
        *(GAS v2u*)(WT + (drow0 + n) * ldt + k0 + 8 * c) = o; }
    LDS_WAIT(); asm volatile("" ::: "memory");
}
__device__ __forceinline__ void weight_items(const Args& a, unsigned char* ws, LAS float* scr, int lane, int group, int l, int gw, int NGW, gu32* ctr = nullptr) {
    constexpr int I_INA = 32 * 128, I_INB = 32 * 32, I_OUT = 32 * 64, I_PG = 32 * 64, I_PP = 4 * 64, I_POOL = 4 * 32, I_EG = NE * 32 * 32, I_EU = I_EG, I_ED = NE * 16 * 64;
    if (group == 0) {
        for (int it = gw; it < I_INA + I_INB + I_PP + I_POOL; it += NGW) { int r = it;
            if (r < I_INA) { const int kb = r / 128, nb = r % 128; tr_item(a.in[I_WIN] + (size_t)l * D * IN_COLS, IN_COLS, 64 * kb, 32 * nb, (bf16*)(ws + WS_WIN) + (size_t)l * NPROJ * D, 32 * nb, D, scr, lane); continue; } r -= I_INA;
            if (r < I_INB) { const int kb = r / 32, nb = r % 32; tr_item(a.in[I_WIN] + (size_t)l * D * IN_COLS, IN_COLS, 64 * kb, 4112 + 32 * nb, (bf16*)(ws + WS_WIN) + (size_t)l * NPROJ * D, 4096 + 32 * nb, D, scr, lane); continue; } r -= I_INB;
            if (r < I_PP) { const int kb = r / 64, nb = r % 64; tr_item(a.in[I_WPP] + (size_t)l * PLE * D, D, 64 * kb, 32 * nb, (bf16*)(ws + WS_WPP) + (size_t)l * D * PLE, 32 * nb, PLE, scr, lane); continue; } r -= I_PP;
            { const int g = r / 32, rr = r % 32, kb = rr / 8, nb = rr % 8; tr_item(a.in[I_POOLW] + ((size_t)l * 4 + g) * 65536, 256, 64 * kb, 32 * nb, (bf16*)(ws + WS_WPOOL) + ((size_t)l * 4 + g) * 65536, 32 * nb, 256, scr, lane); } }
    } else {
        const bool f8 = FP8_LAYER(l);
        constexpr int NIT = I_OUT + I_PG + I_EG + I_EU + I_ED;
        int it = gw - NGW, kk = 8; unsigned cb = 0u;
        for (;;) {
            if (ctr) { if (kk == 8) { unsigned b = 0u; if (lane == 0) b = __hip_atomic_fetch_add(ctr, 8u, RLX_AGENT); cb = (unsigned)__builtin_amdgcn_readfirstlane((int)b); kk = 0; if (cb >= (unsigned)NIT) break; }
                it = (int)cb + kk; ++kk; if (it >= NIT) continue; }
            else { it += NGW; if (it >= NIT) break; }
            int r = it;
            if (r < I_OUT) { const int kb = r / 64, nb = r % 64; if (FP8_PDL(l)) tr_item8(a.in[I_WOUT] + (size_t)l * D * D, D, 64 * kb, 32 * nb, ws + WS_WOUT + (size_t)l * D * D * 2, 32 * nb, D, scr, lane); else tr_item(a.in[I_WOUT] + (size_t)l * D * D, D, 64 * kb, 32 * nb, (bf16*)(ws + WS_WOUT) + (size_t)l * D * D, 32 * nb, D, scr, lane); continue; } r -= I_OUT;
            if (r < I_PG) { const int kb = r / 64, nb = r % 64; if (FP8_PI && (FP8_PI0 || l == DEPTH - 1)) tr_item8(a.in[I_WPG] + (size_t)l * D * D, D, 64 * kb, 32 * nb, ws + WS_WPG + (size_t)l * D * D * 2, 32 * nb, D, scr, lane); else tr_item(a.in[I_WPG] + (size_t)l * D * D, D, 64 * kb, 32 * nb, (bf16*)(ws + WS_WPG) + (size_t)l * D * D, 32 * nb, D, scr, lane); continue; } r -= I_PG;
            if (r < I_EG) { const int e = r / 1024, rr = r % 1024, kb = rr / 32, nb = rr % 32, h0 = 32 * nb;
                if (f8) tr_item8(a.in[I_WEG] + ((size_t)l * NE + e) * D * DE, DE, 64 * kb, h0, ws + WS_WGU + (size_t)l * NE * 2048 * D * 2 + (size_t)e * 2048 * D, (size_t)(h0 >> 7) * 256 + (h0 & 127), D, scr, lane);
                else tr_item(a.in[I_WEG] + ((size_t)l * NE + e) * D * DE, DE, 64 * kb, h0, (bf16*)(ws + WS_WGU) + ((size_t)l * NE + e) * 2048 * D, (size_t)(h0 >> 7) * 256 + (h0 & 127), D, scr, lane); continue; } r -= I_EG;
            if (r < I_EU) { const int e = r / 1024, rr = r % 1024, kb = rr / 32, nb = rr % 32, h0 = 32 * nb;
                if (f8) tr_item8(a.in[I_WEU] + ((size_t)l * NE + e) * D * DE, DE, 64 * kb, h0, ws + WS_WGU + (size_t)l * NE * 2048 * D * 2 + (size_t)e * 2048 * D, (size_t)(h0 >> 7) * 256 + 128 + (h0 & 127), D, scr, lane);
                else tr_item(a.in[I_WEU] + ((size_t)l * NE + e) * D * DE, DE, 64 * kb, h0, (bf16*)(ws + WS_WGU) + ((size_t)l * NE + e) * 2048 * D, (size_t)(h0 >> 7) * 256 + 128 + (h0 & 127), D, scr, lane); continue; } r -= I_EU;
            { const int e = r / 1024, rr = r % 1024, kb = rr / 64, nb = rr % 64;
                if (f8 && FP8_PG) tr_item8(a.in[I_WED] + ((size_t)l * NE + e) * DE * D, D, 64 * kb, 32 * nb, ws + WS_WD + (size_t)l * NE * D * DE * 2 + (size_t)e * D * DE, 32 * nb, DE, scr, lane);
                else tr_item(a.in[I_WED] + ((size_t)l * NE + e) * DE * D, D, 64 * kb, 32 * nb, (bf16*)(ws + WS_WD) + ((size_t)l * NE + e) * D * DE, 32 * nb, DE, scr, lane); } }
    }
}
__device__ __forceinline__ void p0_prologue(const Frame& F0, const Args& a) {
    PHASE_FRAME(F0);
    LAS float* scr = (LAS float*)(F.lds + RING_OFF + F.wave * 16384);
    const int gw = F.vcu * NWAVES + F.wave, NGW = F.G * NWAVES;
    unsigned char* ws = OPQ_G(unsigned char, a.ws);
#pragma unroll 1
    for (int l = 0; l < DEPTH; ++l) weight_items(a, ws, scr, F.lane, 0, l, gw, NGW);
#ifdef CONVERT_ALL_IN_PROLOGUE
#pragma unroll 1
    for (int l = 0; l < DEPTH; ++l) weight_items(a, ws, scr, F.lane, 1, l, gw, NGW);
#endif
    const size_t gt = (size_t)F.vcu * 512 + F.tid, NGT = (size_t)F.G * 512;
    { const GAS f32x4* src = (const GAS f32x4*)a.in[I_X]; GAS v4u* dst = (GAS v4u*)(ws + WS_XB);
        for (size_t i = gt; i < (size_t)T * D / 8; i += NGT) { const f32x4 v0 = src[2 * i], v1 = src[2 * i + 1]; v4u o; o.x = pk2(v0[0], v0[1]); o.y = pk2(v0[2], v0[3]); o.z = pk2(v1[0], v1[1]); o.w = pk2(v1[2], v1[3]); dst[i] = o; } }
    { const GAS f32x4* src = (const GAS f32x4*)a.in[I_P]; GAS v4u* dst = (GAS v4u*)(ws + WS_PB16);
        for (size_t i = gt; i < (size_t)DEPTH * T * PLE / 8; i += NGT) { const f32x4 v0 = src[2 * i], v1 = src[2 * i + 1]; v4u o; o.x = pk2(v0[0], v0[1]); o.y = pk2(v0[2], v0[3]); o.z = pk2(v1[0], v1[1]); o.w = pk2(v1[2], v1[3]); dst[i] = o; } }
    for (size_t i = gt; i < (size_t)DEPTH * 16 * D; i += NGT) { const int l = (int)(i / (16 * D)), j = (int)((i / D) % 16), k = (int)(i % D);
        ((bf16*)(ws + WS_WBA))[i] = (bf16)f2bf(a.in[I_WIN][((size_t)l * D + k) * IN_COLS + 4096 + j]); }
}

typedef float f32x16 __attribute__((ext_vector_type(16)));
#define MFMA32(a_, b_, c_) __builtin_amdgcn_mfma_f32_32x32x16_bf16((a_), (b_), (c_), 0, 0, 0)
#define PACK8(x, sp) __builtin_bit_cast(bf16x8, (v4u){pkbf((x)[8 * (sp)], (x)[8 * (sp) + 1]), pkbf((x)[8 * (sp) + 2], (x)[8 * (sp) + 3]), pkbf((x)[8 * (sp) + 4], (x)[8 * (sp) + 5]), pkbf((x)[8 * (sp) + 6], (x)[8 * (sp) + 7])})
#define RAW_BAR() do { asm volatile("s_waitcnt lgkmcnt(0)" ::: "memory"); __builtin_amdgcn_s_barrier(); asm volatile("" ::: "memory"); } while (0)
constexpr int IMG_ELEMS = 56 * 512, UIMG_ELEMS = 8 * 1024;
constexpr int FR_WN = 0, FR_QD = 16, FR_AQK = 32, FR_KDT = 40;
constexpr size_t WS_IMG = WS_R2, WS_UIMG = WS_R2 + 112 * MiB;
static_assert((size_t)NB * NCH * NH * IMG_ELEMS * 2 == 112 * MiB && (size_t)NB * NCH * NH * UIMG_ELEMS * 2 == 32 * MiB, "DeltaNet images");

__device__ __forceinline__ void pool_diffs_unit(const Frame& F, unsigned char* ws, int pm, int g) {
    const bf16* PROJ = (const bf16*)(ws + WS_PROJ); bf16* POOLD = (bf16*)(ws + WS_POOLD);
    const int tid = F.tid, cp = tid & 127, rq = tid >> 7, r0 = 256 * pm + 64 * rq, sq0 = r0 % SEQ, col = 256 * g + 2 * cp;
    const bf16* up = PROJ + (size_t)r0 * NPROJ + 4096 + col; bf16* dp = POOLD + (size_t)r0 * PW + col;
#define POOL_BODY(WIN) do { unsigned xr[CH + WIN - 1]; \
        _Pragma("unroll") for (int j = 0; j < WIN - 1; ++j) xr[j] = (sq0 - (WIN - 1) + j >= 0) ? *(const unsigned*)(up + (ptrdiff_t)(j - (WIN - 1)) * NPROJ) : 0u; \
        _Pragma("unroll") for (int i = 0; i < CH; ++i) xr[WIN - 1 + i] = *(const unsigned*)(up + (size_t)i * NPROJ); \
        float s0 = 0.f, s1 = 0.f; \
        _Pragma("unroll") for (int j = 0; j < WIN - 1; ++j) { s0 += bflo(xr[j]); s1 += bfhi(xr[j]); } \
        _Pragma("unroll") for (int i = 0; i < CH; ++i) { const float x0 = bflo(xr[WIN - 1 + i]), x1 = bfhi(xr[WIN - 1 + i]); s0 += x0; s1 += x1; \
            const int pos = sq0 + i; const float inv = __builtin_amdgcn_rcpf((float)((pos + 1) < WIN ? (pos + 1) : WIN)); \
            *(unsigned*)(dp + (size_t)i * PW) = pkbf(s0 * inv - x0, s1 * inv - x1); s0 -= bflo(xr[i]); s1 -= bfhi(xr[i]); } } while (0)
    if (g == 0) POOL_BODY(2); else if (g == 1) POOL_BODY(4); else if (g == 2) POOL_BODY(8); else POOL_BODY(16);
#undef POOL_BODY
}
#ifndef PREP_DUP
#define PREP_DUP 0
#endif
constexpr int PQF = 0, PKF = 33792, PQS = 67584, PKS = 84992, PVT = 102400, PKT = 120832, PTAB = 139264;
constexpr int PAS = PQF;
constexpr int PTB = PKF, PT11T = PKF + 9216, PPART = PKF;
constexpr int F_LD = 132, S_LD = 136, T_LD = 72, A_LD = 68, TT_LD = 40;
__device__ __forceinline__ void phase_dn_prep(const Frame& F0, const Args& a, int layer) {
    PHASE_FRAME(F0);
    unsigned char* ws = OPQ_G(unsigned char, a.ws);
    LAS unsigned char* lds = F.lds;
    LAS float* Qf = (LAS float*)(lds + PQF); LAS float* Kf = (LAS float*)(lds + PKF); LAS float* As = (LAS float*)(lds + PAS);
    LAS bf16* Qs = (LAS bf16*)(lds + PQS); LAS bf16* Ks = (LAS bf16*)(lds + PKS); LAS bf16* Vt = (LAS bf16*)(lds + PVT); LAS bf16* Kt = (LAS bf16*)(lds + PKT);
    LAS bf16* Tb = (LAS bf16*)(lds + PTB); LAS bf16* T11t = (LAS bf16*)(lds + PT11T);
    LAS float* betaS = (LAS float*)(lds + PTAB); LAS float* gS = betaS + 512; LAS float* gamh = gS + 512; LAS float* betah = gamh + 64; LAS float* egam = betah + 64; LAS float* bgam = egam + 64; LAS float* ekd = bgam + 64; LAS float* rkS = ekd + 64;
    const bf16* XB = (const bf16*)(ws + WS_XB); const bf16* PROJ = (const bf16*)(ws + WS_PROJ); const bf16* WBA = (const bf16*)(ws + WS_WBA) + (size_t)layer * 16 * D;
    bf16* IMG = (bf16*)(ws + WS_IMG); bf16* UIMG = (bf16*)(ws + WS_UIMG); float* CD = (float*)(ws + WS_CD);
    const float* convw = a.in[I_CONVW] + (size_t)layer * 4 * 3072; const float* alog = a.in[I_ALOG] + layer * NH; const float* dtb = a.in[I_DTB] + layer * NH;
    const int tid = F.tid, lane = F.lane, wave = F.wave, c32 = lane & 31, hf = lane >> 5;
    for (int unit = F.vcu; unit < NB * NCH; unit += F.G) {
        const int b = unit / NCH, n = unit % NCH, r0 = b * SEQ + n * CH, sq0 = n * CH;
        for (int rep_ = 0; rep_ < ((PREP_DUP & 64) ? 2 : 1); ++rep_)
        { typedef float f32x4v __attribute__((ext_vector_type(4)));
            const int fr = lane & 15, fg = lane >> 4; f32x4v pacc[4];
#pragma unroll
            for (int mt = 0; mt < 4; ++mt) pacc[mt] = (f32x4v){0.f, 0.f, 0.f, 0.f};
#pragma unroll 1
            for (int sb = 0; sb < 8; sb += 4) {
                bf16x8 bq[4], aq[4][4];
#pragma unroll
                for (int s = 0; s < 4; ++s) { const int k0 = 256 * wave + 32 * (sb + s) + 8 * fg; bq[s] = *(const bf16x8*)(WBA + (size_t)fr * D + k0);
#pragma unroll
                    for (int mt = 0; mt < 4; ++mt) aq[s][mt] = *(const bf16x8*)(XB + (size_t)(r0 + 16 * mt + fr) * D + k0); }
                asm volatile("" : "+v"(bq[0]), "+v"(bq[1]), "+v"(bq[2]), "+v"(bq[3]), "+v"(aq[0][0]), "+v"(aq[0][1]), "+v"(aq[0][2]), "+v"(aq[0][3]), "+v"(aq[1][0]), "+v"(aq[1][1]), "+v"(aq[1][2]), "+v"(aq[1][3]),
                             "+v"(aq[2][0]), "+v"(aq[2][1]), "+v"(aq[2][2]), "+v"(aq[2][3]), "+v"(aq[3][0]), "+v"(aq[3][1]), "+v"(aq[3][2]), "+v"(aq[3][3]));
#pragma unroll
                for (int s = 0; s < 4; ++s)
#pragma unroll
                    for (int mt = 0; mt < 4; ++mt) pacc[mt] = __builtin_amdgcn_mfma_f32_16x16x32_bf16(aq[s][mt], bq[s], pacc[mt], 0, 0, 0); }
            LAS float* part = (LAS float*)(lds + PPART) + wave * 1024;
#pragma unroll
            for (int mt = 0; mt < 4; ++mt)
#pragma unroll
                for (int r = 0; r < 4; ++r) part[(16 * mt + 4 * fg + r) * 16 + fr] = pacc[mt][r]; }
        __syncthreads();
        { const int tok = tid >> 3, cp = tid & 7; float s0 = 0.f, s1 = 0.f;
#pragma unroll
            for (int w = 0; w < 8; ++w) { const f32x2 p2 = *(const LAS f32x2*)((LAS float*)(lds + PPART) + w * 1024 + tok * 16 + 2 * cp); s0 += p2[0]; s1 += p2[1]; }
            if (cp < 4) { betaS[tok * 8 + 2 * cp] = sigmoidf_(s0); betaS[tok * 8 + 2 * cp + 1] = sigmoidf_(s1); }
            else { const int h = 2 * (cp - 4); const float z0 = s0 + dtb[h], z1 = s1 + dtb[h + 1];
                const float sp0 = z0 > 20.f ? z0 : log1pf(__expf(z0)), sp1 = z1 > 20.f ? z1 : log1pf(__expf(z1));
                gS[tok * 8 + h] = -__expf(alog[h]) * sp0; gS[tok * 8 + h + 1] = -__expf(alog[h + 1]) * sp1; } }
        __syncthreads();
        { float gv = gS[lane * 8 + wave];
#pragma unroll
            for (int o = 1; o < 64; o <<= 1) { const float up_ = __shfl_up(gv, o); if (lane >= o) gv += up_; }
            gS[lane * 8 + wave] = gv; }
        __syncthreads();
        unsigned craw[3][11]; unsigned cdum[3][8];
#define PREP_LOADRAW(hh) do { const int cp_ = tid & 63, i0_ = (tid >> 6) * 8; \
            _Pragma("unroll") for (int part_ = 0; part_ < 3; ++part_) { const bf16* src_ = PROJ + (size_t)(r0 + i0_ - 3) * NPROJ + part_ * 1024 + (hh) * HD + 2 * cp_; \
                _Pragma("unroll") for (int j_ = 0; j_ < 11; ++j_) craw[part_][j_] = (sq0 + i0_ - 3 + j_ >= 0) ? *(const unsigned*)(src_ + (ptrdiff_t)j_ * NPROJ) : 0u; \
                if (PREP_DUP & 256) { _Pragma("unroll") for (int j_ = 3; j_ < 11; ++j_) cdum[part_][j_ - 3] = *(const unsigned*)(src_ + (ptrdiff_t)j_ * NPROJ + ((hh) ^ 1) * HD - (hh) * HD); } } } while (0)
        PREP_LOADRAW(0);
        for (int hh_ = 0; hh_ < ((PREP_DUP & 128) ? 2 * NH : NH); ++hh_) { const int h = hh_ & (NH - 1);
            const size_t chd = (size_t)unit * NH + h; bf16* img = IMG + chd * IMG_ELEMS; bf16* uimg = UIMG + chd * UIMG_ELEMS;
            if (tid < 64) { const float gi = gS[tid * 8 + h], bi = betaS[tid * 8 + h], eg = __expf(gi); gamh[tid] = gi; betah[tid] = bi; egam[tid] = eg; bgam[tid] = bi * eg; ekd[tid] = __expf(gS[63 * 8 + h] - gi); }
            RAW_BAR();
            for (int rep_ = 0; rep_ < ((PREP_DUP & 16) ? 2 : 1); ++rep_)
            { const int cp = tid & 63, rg8 = tid >> 6, i0 = rg8 * 8;
                if (PREP_DUP & 256) {
#pragma unroll
                    for (int p_ = 0; p_ < 3; ++p_)
#pragma unroll
                        for (int j_ = 0; j_ < 8; ++j_) asm volatile("" :: "v"(cdum[p_][j_])); }
#pragma unroll
                for (int part = 0; part < 3; ++part) { const int col = part * 1024 + h * HD + 2 * cp;
                    const f32x2 cw0 = *(const f32x2*)(convw + col), cw1 = *(const f32x2*)(convw + 3072 + col), cw2 = *(const f32x2*)(convw + 2 * 3072 + col), cw3 = *(const f32x2*)(convw + 3 * 3072 + col);
                    float ya[8], yb[8];
#pragma unroll
                    for (int i = 0; i < 8; ++i) { const unsigned x3 = craw[part][i], x2 = craw[part][i + 1], x1 = craw[part][i + 2], x0 = craw[part][i + 3];
                        const float ta = cw0[0] * bflo(x3) + cw1[0] * bflo(x2) + cw2[0] * bflo(x1) + cw3[0] * bflo(x0), tb = cw0[1] * bfhi(x3) + cw1[1] * bfhi(x2) + cw2[1] * bfhi(x1) + cw3[1] * bfhi(x0);
                        ya[i] = ta * sigmoidf_(ta); yb[i] = tb * sigmoidf_(tb); }
                    if (part == 0) {
#pragma unroll
                        for (int i = 0; i < 8; ++i) *(LAS f32x2*)(Qf + (i0 + i) * F_LD + 2 * cp) = (f32x2){ya[i], yb[i]}; }
                    else if (part == 1) {
#pragma unroll
                        for (int i = 0; i < 8; ++i) *(LAS f32x2*)(Kf + (i0 + i) * F_LD + 2 * cp) = (f32x2){ya[i], yb[i]}; }
                    else { v4u o0, o1;
                        o0.x = pkbf(ya[0] * betah[i0 + 0], ya[1] * betah[i0 + 1]); o0.y = pkbf(ya[2] * betah[i0 + 2], ya[3] * betah[i0 + 3]); o0.z = pkbf(ya[4] * betah[i0 + 4], ya[5] * betah[i0 + 5]); o0.w = pkbf(ya[6] * betah[i0 + 6], ya[7] * betah[i0 + 7]);
                        o1.x = pkbf(yb[0] * betah[i0 + 0], yb[1] * betah[i0 + 1]); o1.y = pkbf(yb[2] * betah[i0 + 2], yb[3] * betah[i0 + 3]); o1.z = pkbf(yb[4] * betah[i0 + 4], yb[5] * betah[i0 + 5]); o1.w = pkbf(yb[6] * betah[i0 + 6], yb[7] * betah[i0 + 7]);
                        *(LAS v4u*)(Vt + (2 * cp) * T_LD + i0) = o0; *(LAS v4u*)(Vt + (2 * cp + 1) * T_LD + i0) = o1; } }
            }
            if (hh_ + 1 < ((PREP_DUP & 128) ? 2 * NH : NH)) PREP_LOADRAW((hh_ + 1) & (NH - 1));
            for (int rep_ = 0; rep_ < ((PREP_DUP & 1) ? 2 : 1); ++rep_) { if (rep_) RAW_BAR();
            { const int i = tid >> 3, part = tid & 7; const LAS float* qp = Qf + i * F_LD + part * 16; const LAS float* kp = Kf + i * F_LD + part * 16;
                f32x4 qv[4], kv[4]; float sq = 0.f, sk = 0.f;
#pragma unroll
                for (int j = 0; j < 4; ++j) { qv[j] = *(const LAS f32x4*)(qp + 4 * j); kv[j] = *(const LAS f32x4*)(kp + 4 * j);
                    sq += (qv[j][0] * qv[j][0] + qv[j][1] * qv[j][1]) + (qv[j][2] * qv[j][2] + qv[j][3] * qv[j][3]); sk += (kv[j][0] * kv[j][0] + kv[j][1] * kv[j][1]) + (kv[j][2] * kv[j][2] + kv[j][3] * kv[j][3]); }
                sq = row8_sum(sq); sk = row8_sum(sk);
                const float rq = 1.0f / sqrtf(sq + RMS_EPS) * 0.08838834764831845f, rk = 1.0f / sqrtf(sk + RMS_EPS);
                if (part == 0) rkS[i] = rk;
#pragma unroll
                for (int j = 0; j < 4; ++j) { qv[j] = qv[j] * rq; kv[j] = kv[j] * rk; }
                v4u w0, w1;
                w0.x = pkbf(qv[0][0], qv[0][1]); w0.y = pkbf(qv[0][2], qv[0][3]); w0.z = pkbf(qv[1][0], qv[1][1]); w0.w = pkbf(qv[1][2], qv[1][3]); w1.x = pkbf(qv[2][0], qv[2][1]); w1.y = pkbf(qv[2][2], qv[2][3]); w1.z = pkbf(qv[3][0], qv[3][1]); w1.w = pkbf(qv[3][2], qv[3][3]);
                *(LAS v4u*)(Qs + i * S_LD + part * 16) = w0; *(LAS v4u*)(Qs + i * S_LD + part * 16 + 8) = w1;
                w0.x = pkbf(kv[0][0], kv[0][1]); w0.y = pkbf(kv[0][2], kv[0][3]); w0.z = pkbf(kv[1][0], kv[1][1]); w0.w = pkbf(kv[1][2], kv[1][3]); w1.x = pkbf(kv[2][0], kv[2][1]); w1.y = pkbf(kv[2][2], kv[2][3]); w1.z = pkbf(kv[3][0], kv[3][1]); w1.w = pkbf(kv[3][2], kv[3][3]);
                *(LAS v4u*)(Ks + i * S_LD + part * 16) = w0; *(LAS v4u*)(Ks + i * S_LD + part * 16 + 8) = w1;
                const float eg = egam[i]; bf16* fq = img + ((size_t)(FR_QD + (i >> 5) * 8 + part) * 64 + (i & 31)) * 8;
                v4u h0, h1;
                h0.x = pkbf(qv[0][0] * eg, qv[0][1] * eg); h0.y = pkbf(qv[0][2] * eg, qv[0][3] * eg); h0.z = pkbf(qv[2][0] * eg, qv[2][1] * eg); h0.w = pkbf(qv[2][2] * eg, qv[2][3] * eg);
                h1.x = pkbf(qv[1][0] * eg, qv[1][1] * eg); h1.y = pkbf(qv[1][2] * eg, qv[1][3] * eg); h1.z = pkbf(qv[3][0] * eg, qv[3][1] * eg); h1.w = pkbf(qv[3][2] * eg, qv[3][3] * eg);
                *(v4u*)fq = h0; *(v4u*)(fq + 32 * 8) = h1; }
            RAW_BAR();
            { const int c = tid & 127, rg = tid >> 7; float kb[16], kd[16];
#pragma unroll
                for (int i = 0; i < 16; ++i) { const int t = rg * 16 + i; const float kn = Kf[t * F_LD + c] * rkS[t]; kb[i] = kn * bgam[t]; kd[i] = kn * ekd[t]; }
                v4u o0, o1;
                o0.x = pkbf(kb[0], kb[1]); o0.y = pkbf(kb[2], kb[3]); o0.z = pkbf(kb[4], kb[5]); o0.w = pkbf(kb[6], kb[7]); o1.x = pkbf(kb[8], kb[9]); o1.y = pkbf(kb[10], kb[11]); o1.z = pkbf(kb[12], kb[13]); o1.w = pkbf(kb[14], kb[15]);
                *(LAS v4u*)(Kt + c * T_LD + rg * 16) = o0; *(LAS v4u*)(Kt + c * T_LD + rg * 16 + 8) = o1;
                bf16* fk = img + ((size_t)(FR_KDT + (c >> 5) * 4 + rg) * 64 + (c & 31)) * 8;
                v4u h0, h1;
                h0.x = pkbf(kd[0], kd[1]); h0.y = pkbf(kd[2], kd[3]); h0.z = pkbf(kd[8], kd[9]); h0.w = pkbf(kd[10], kd[11]);
                h1.x = pkbf(kd[4], kd[5]); h1.y = pkbf(kd[6], kd[7]); h1.z = pkbf(kd[12], kd[13]); h1.w = pkbf(kd[14], kd[15]);
                *(v4u*)fk = h0; *(v4u*)(fk + 32 * 8) = h1; }
            RAW_BAR();
            }
            for (int rep_ = 0; rep_ < ((PREP_DUP & 2) ? 2 : 1); ++rep_) { if (rep_) RAW_BAR();
            if (wave < 6) { const int pr = wave % 3, iskk = wave / 3, mt = pr == 2 ? 1 : 0, nt = pr == 0 ? 0 : 1;
                const LAS bf16* xs = iskk ? Ks : Qs; f32x16 d;
#pragma unroll
                for (int r = 0; r < 16; ++r) d[r] = 0.f;
#pragma unroll
                for (int s = 0; s < 8; ++s) { const bf16x8 af = *(const LAS bf16x8*)(Ks + (32 * mt + c32) * S_LD + 16 * s + 8 * hf), bfr = *(const LAS bf16x8*)(xs + (32 * nt + c32) * S_LD + 16 * s + 8 * hf); d = MFMA32(af, bfr, d); }
                const int i = 32 * nt + c32; const float gi = gamh[i], bi = betah[i];
#pragma unroll
                for (int r = 0; r < 16; ++r) { const int j = 32 * mt + (r & 3) + 8 * (r >> 2) + 4 * hf; const float de = __expf(gi - gamh[j]);
                    d[r] = iskk ? ((j < i) ? bi * d[r] * de : 0.f) : ((j <= i) ? d[r] * de : 0.f); }
                if (iskk) {
#pragma unroll
                    for (int qd = 0; qd < 4; ++qd) *(LAS f32x4*)(As + i * A_LD + 32 * mt + 8 * qd + 4 * hf) = (f32x4){d[4 * qd], d[4 * qd + 1], d[4 * qd + 2], d[4 * qd + 3]}; }
                else {
#pragma unroll
                    for (int sp = 0; sp < 2; ++sp) *(bf16x8*)(img + ((size_t)(FR_AQK + nt * 4 + 2 * mt + sp) * 64 + lane) * 8) = PACK8(d, sp); } }
            RAW_BAR();
            }
            for (int rep_ = 0; rep_ < ((PREP_DUP & 4) ? 2 : 1); ++rep_) { if (rep_) RAW_BAR();
            if (wave < 2) {
                unsigned asb = (unsigned)(uintptr_t)(As + (32 * wave) * A_LD + 32 * wave); int cb = c32; asm volatile("" : "+v"(asb), "+v"(cb));
                const LAS float* Ab = (const LAS float*)(uintptr_t)asb;
                float arow[32], Tc[32];
#pragma unroll
                for (int i = 0; i < 32; ++i) arow[i] = Ab[i * A_LD + cb];
#pragma unroll
                for (int i = 0; i < 32; ++i) { float ac[4] = {(i == cb) ? 1.f : 0.f, 0.f, 0.f, 0.f}; if (i > 0) asm volatile("" : "+v"(arow[i]), "+v"(Tc[i - 1]));
#pragma unroll
                    for (int j = 0; j < i; ++j) { const float aij = __builtin_bit_cast(float, __builtin_amdgcn_readlane(__builtin_bit_cast(int, arow[i]), j)); ac[j & 3] -= aij * Tc[j]; }
                    Tc[i] = (ac[0] + ac[1]) + (ac[2] + ac[3]); __builtin_amdgcn_sched_barrier(0); }
                if (hf == 0) {
#pragma unroll
                    for (int i = 0; i < 32; ++i) Tb[(32 * wave + i) * T_LD + 32 * wave + c32] = (bf16)(pkbf(Tc[i], 0.f) & 0xffffu);
                    if (wave == 0) {
#pragma unroll
                        for (int q = 0; q < 4; ++q) { v4u o; o.x = pkbf(Tc[8 * q], Tc[8 * q + 1]); o.y = pkbf(Tc[8 * q + 2], Tc[8 * q + 3]); o.z = pkbf(Tc[8 * q + 4], Tc[8 * q + 5]); o.w = pkbf(Tc[8 * q + 6], Tc[8 * q + 7]); *(LAS v4u*)(T11t + c32 * TT_LD + 8 * q) = o; } } } }
            RAW_BAR();
            if (wave == 0) {
                f32x16 x;
#pragma unroll
                for (int r = 0; r < 16; ++r) x[r] = 0.f;
#pragma unroll
                for (int s = 0; s < 2; ++s) { const LAS float* ap = As + (32 + c32) * A_LD + 16 * s + 8 * hf; const f32x4 a0 = *(const LAS f32x4*)ap, a1 = *(const LAS f32x4*)(ap + 4);
                    const bf16x8 af = __builtin_bit_cast(bf16x8, (v4u){pkbf(a0[0], a0[1]), pkbf(a0[2], a0[3]), pkbf(a1[0], a1[1]), pkbf(a1[2], a1[3])});
                    const bf16x8 bfr = *(const LAS bf16x8*)(T11t + c32 * TT_LD + 16 * s + 8 * hf); x = MFMA32(af, bfr, x); }
                f32x16 t21;
#pragma unroll
                for (int r = 0; r < 16; ++r) t21[r] = 0.f;
#pragma unroll
                for (int s = 0; s < 2; ++s) { const LAS bf16* tp = Tb + (32 + c32) * T_LD + 32 + 16 * s + 4 * hf; const v2u lo = *(const LAS v2u*)tp, hi = *(const LAS v2u*)(tp + 8);
                    const bf16x8 af = __builtin_bit_cast(bf16x8, (v4u){lo.x, lo.y, hi.x, hi.y}); const bf16x8 bfr = PACK8(x, s); t21 = MFMA32(af, bfr, t21); }
#pragma unroll
                for (int r = 0; r < 16; ++r) Tb[(32 + (r & 3) + 8 * (r >> 2) + 4 * hf) * T_LD + c32] = (bf16)(pkbf(-t21[r], 0.f) & 0xffffu);
            }
            RAW_BAR();
            }
            for (int rep_ = 0; rep_ < ((PREP_DUP & 8) ? 2 : 1); ++rep_) { if (rep_) RAW_BAR();
            if (wave < 4) {
#pragma unroll
                for (int mt = 0; mt < 2; ++mt) { f32x16 d;
#pragma unroll
                    for (int r = 0; r < 16; ++r) d[r] = 0.f;
#pragma unroll
                    for (int s = 0; s < 4; ++s) if (s < 2 * (mt + 1)) { const bf16x8 af = *(const LAS bf16x8*)(Tb + (32 * mt + c32) * T_LD + 16 * s + 8 * hf), bfr = *(const LAS bf16x8*)(Vt + (32 * wave + c32) * T_LD + 16 * s + 8 * hf); d = MFMA32(af, bfr, d); }
                    bf16* up = uimg + ((size_t)(wave * 2 + mt) * 64 + lane) * 16; *(bf16x8*)up = PACK8(d, 0); *(bf16x8*)(up + 8) = PACK8(d, 1); } }
            else { const int ct = wave - 4;
#pragma unroll
                for (int nt = 0; nt < 2; ++nt) { f32x16 d;
#pragma unroll
                    for (int r = 0; r < 16; ++r) d[r] = 0.f;
#pragma unroll
                    for (int s = 0; s < 4; ++s) if (s < 2 * (nt + 1)) { const bf16x8 af = *(const LAS bf16x8*)(Kt + (32 * ct + c32) * T_LD + 16 * s + 8 * hf), bfr = *(const LAS bf16x8*)(Tb + (32 * nt + c32) * T_LD + 16 * s + 8 * hf); d = MFMA32(af, bfr, d); }
#pragma unroll
                    for (int r = 0; r < 16; ++r) d[r] = -d[r];
#pragma unroll
                    for (int sp = 0; sp < 2; ++sp) *(bf16x8*)(img + ((size_t)(FR_WN + nt * 8 + 2 * ct + sp) * 64 + lane) * 8) = PACK8(d, sp); } }
            }
            if (tid == 0) CD[chd] = egam[63];
            RAW_BAR();
        }
#undef PREP_LOADRAW
    }
}

__host__ __device__ constexpr int sc_p(int k) { const int j = k - 32; return j < 12 ? j % 6 : (j - 12) % 5; }
__host__ __device__ constexpr int sc_slab(int k) { const int j = k - 32; return k < 32 ? (k >> 2) : (j < 12 ? j / 6 : 2 + (j - 12) / 5); }
__host__ __device__ constexpr int sc_kind(int k) { return k < 32 ? ((k & 3) < 2 ? 0 : 1) : ((sc_p(k) == 2 || sc_p(k) == 5) ? 1 : 2); }
__host__ __device__ constexpr int sc_idx(int k) { return k < 32 ? (k & 1) : (sc_p(k) == 0 ? 0 : sc_p(k) == 1 ? 1 : sc_p(k) == 2 ? 1 : sc_p(k) == 3 ? 2 : sc_p(k) == 4 ? 3 : 0); }
__host__ __device__ constexpr int sc_frag(int k) { return k < 32 ? (((k & 3) < 2 ? FR_WN : FR_QD) + (k & 1) * 8 + (k >> 2)) : (sc_kind(k) == 1 ? FR_AQK + sc_idx(k) * 4 + sc_slab(k) : FR_KDT + sc_idx(k) * 4 + sc_slab(k)); }
constexpr int SC_QD = 8;
constexpr int SCB = 57344, OT_OFF = 2 * SCB, OT_LD = 136, OT_BYTES = 64 * OT_LD * 2;
static_assert(OT_OFF + 2 * OT_BYTES <= 152 * 1024, "scan LDS");
__device__ __forceinline__ void phase_dn_scan(const Frame& F0, const Args& a, int layer, int unit) {
    PHASE_FRAME(F0);
    unsigned char* ws = OPQ_G(unsigned char, a.ws);
    LAS unsigned char* lds = F.lds;
    const int b = unit >> 3, h = unit & 7, lane = F.lane;
    const bf16* IMG = (const bf16*)(ws + WS_IMG); const bf16* UIMG = (const bf16*)(ws + WS_UIMG); const float* CD = (const float*)(ws + WS_CD);
    const size_t chd0 = (size_t)b * NCH * NH + h;
    if (F.wave < 4) {
#ifndef SCAN_NO_COMPUTE
        const int w = F.wave, c32 = lane & 31, hf = lane >> 5;
        f32x16 S0, S1, S2, S3;
#pragma unroll
        for (int r = 0; r < 16; ++r) { S0[r] = 0.f; S1[r] = 0.f; S2[r] = 0.f; S3[r] = 0.f; }
        const float cdl = CD[chd0 + (size_t)lane * NH];
        v4u UA[4];
        const __amdgpu_buffer_rsrc_t rsU = __builtin_amdgcn_make_buffer_rsrc((void*)(UIMG + chd0 * UIMG_ELEMS), (short)0, NCH * NH * UIMG_ELEMS * 2, 0x00020000);
        const unsigned uoff = (unsigned)((w * 2) * 64 + lane) * 32u;
#define SC_LOADU(dst, nn) do { _Pragma("unroll") for (int mt_ = 0; mt_ < 2; ++mt_) { _Pragma("unroll") for (int hh_ = 0; hh_ < 2; ++hh_) dst[2 * mt_ + hh_] = __builtin_amdgcn_raw_buffer_load_b128(rsU, uoff + (unsigned)(mt_ * 2048 + hh_ * 16), (unsigned)(nn) * (unsigned)(NH * UIMG_ELEMS * 2), 0); } } while (0)
#define SC_FRAG(bufoff, fi) (*(const LAS bf16x8*)(lds + (bufoff) + (fi) * 1024 + lane * 16))
#define SC_CHUNK(nn, U, bufoff, otoff) do { \
        f32x16 aV0, aV1, aO0, aO1; bf16x8 fq0, fq1, fq2, fq3, fq4, fq5, fq6, fq7, Sbs, Vb0, Vb1, Vb2, Vb3; \
        _Pragma("unroll") for (int q = 0; q < 4; ++q) { aV0[2 * q] = bflo(U[0][q]); aV0[2 * q + 1] = bfhi(U[0][q]); aV0[8 + 2 * q] = bflo(U[1][q]); aV0[8 + 2 * q + 1] = bfhi(U[1][q]); \
            aV1[2 * q] = bflo(U[2][q]); aV1[2 * q + 1] = bfhi(U[2][q]); aV1[8 + 2 * q] = bflo(U[3][q]); aV1[8 + 2 * q + 1] = bfhi(U[3][q]); } \
        _Pragma("unroll") for (int r = 0; r < 16; ++r) { aO0[r] = 0.f; aO1[r] = 0.f; } \
        if ((nn) + 1 < NCH) SC_LOADU(U, (nn) + 1); \
        const float cd = __builtin_bit_cast(float, __builtin_amdgcn_readlane(__builtin_bit_cast(int, cdl), (nn))); \
        fq0 = SC_FRAG(bufoff, 0); \
        fq1 = SC_FRAG(bufoff, 8); \
        fq2 = SC_FRAG(bufoff, 16); \
        fq3 = SC_FRAG(bufoff, 24); \
        fq4 = SC_FRAG(bufoff, 1); \
        fq5 = SC_FRAG(bufoff, 9); \
        fq6 = SC_FRAG(bufoff, 17); \
        fq7 = SC_FRAG(bufoff, 25); \
        Sbs = PACK8(S0, 0); \
        aV0 = MFMA32(fq0, Sbs, aV0); \
        fq0 = SC_FRAG(bufoff, 2); \
        aV1 = MFMA32(fq1, Sbs, aV1); \
        fq1 = SC_FRAG(bufoff, 10); \
        aO0 = MFMA32(fq2, Sbs, aO0); \
        fq2 = SC_FRAG(bufoff, 18); \
        aO1 = MFMA32(fq3, Sbs, aO1); \
        fq3 = SC_FRAG(bufoff, 26); \
        Sbs = PACK8(S0, 1); \
        aV0 = MFMA32(fq4, Sbs, aV0); \
        fq4 = SC_FRAG(bufoff, 3); \
        aV1 = MFMA32(fq5, Sbs, aV1); \
        fq5 = SC_FRAG(bufoff, 11); \
        aO0 = MFMA32(fq6, Sbs, aO0); \
        fq6 = SC_FRAG(bufoff, 19); \
        aO1 = MFMA32(fq7, Sbs, aO1); \
        fq7 = SC_FRAG(bufoff, 27); \
        Sbs = PACK8(S1, 0); \
        aV0 = MFMA32(fq0, Sbs, aV0); \
        fq0 = SC_FRAG(bufoff, 4); \
        aV1 = MFMA32(fq1, Sbs, aV1); \
        fq1 = SC_FRAG(bufoff, 12); \
        aO0 = MFMA32(fq2, Sbs, aO0); \
        fq2 = SC_FRAG(bufoff, 20); \
        aO1 = MFMA32(fq3, Sbs, aO1); \
        fq3 = SC_FRAG(bufoff, 28); \
        Sbs = PACK8(S1, 1); \
        aV0 = MFMA32(fq4, Sbs, aV0); \
        fq4 = SC_FRAG(bufoff, 5); \
        aV1 = MFMA32(fq5, Sbs, aV1); \
        fq5 = SC_FRAG(bufoff, 13); \
        aO0 = MFMA32(fq6, Sbs, aO0); \
        fq6 = SC_FRAG(bufoff, 21); \
        aO1 = MFMA32(fq7, Sbs, aO1); \
        fq7 = SC_FRAG(bufoff, 29); \
        Sbs = PACK8(S2, 0); \
        aV0 = MFMA32(fq0, Sbs, aV0); \
        fq0 = SC_FRAG(bufoff, 6); \
        aV1 = MFMA32(fq1, Sbs, aV1); \
        fq1 = SC_FRAG(bufoff, 14); \
        aO0 = MFMA32(fq2, Sbs, aO0); \
        fq2 = SC_FRAG(bufoff, 22); \
        aO1 = MFMA32(fq3, Sbs, aO1); \
        fq3 = SC_FRAG(bufoff, 30); \
        Sbs = PACK8(S2, 1); \
        aV0 = MFMA32(fq4, Sbs, aV0); \
        fq4 = SC_FRAG(bufoff, 7); \
        aV1 = MFMA32(fq5, Sbs, aV1); \
        fq5 = SC_FRAG(bufoff, 15); \
        aO0 = MFMA32(fq6, Sbs, aO0); \
        fq6 = SC_FRAG(bufoff, 23); \
        aO1 = MFMA32(fq7, Sbs, aO1); \
        fq7 = SC_FRAG(bufoff, 31); \
        Sbs = PACK8(S3, 0); \
        aV0 = MFMA32(fq0, Sbs, aV0); \
        fq0 = SC_FRAG(bufoff, 40); \
        aV1 = MFMA32(fq1, Sbs, aV1); \
        fq1 = SC_FRAG(bufoff, 44); \
        aO0 = MFMA32(fq2, Sbs, aO0); \
        fq2 = SC_FRAG(bufoff, 36); \
        aO1 = MFMA32(fq3, Sbs, aO1); \
        fq3 = SC_FRAG(bufoff, 48); \
        Sbs = PACK8(S3, 1); \
        aV0 = MFMA32(fq4, Sbs, aV0); \
        fq4 = SC_FRAG(bufoff, 52); \
        aV1 = MFMA32(fq5, Sbs, aV1); \
        fq5 = SC_FRAG(bufoff, 32); \
        S0 = S0 * cd; S1 = S1 * cd; S2 = S2 * cd; S3 = S3 * cd; \
        aO0 = MFMA32(fq6, Sbs, aO0); \
        fq6 = SC_FRAG(bufoff, 41); \
        aO1 = MFMA32(fq7, Sbs, aO1); \
        fq7 = SC_FRAG(bufoff, 45); \
        Vb0 = PACK8(aV0, 0); Vb1 = PACK8(aV0, 1); Vb2 = PACK8(aV1, 0); Vb3 = PACK8(aV1, 1); \
        S0 = MFMA32(fq0, Vb0, S0); \
        fq0 = SC_FRAG(bufoff, 37); \
        S1 = MFMA32(fq1, Vb0, S1); \
        fq1 = SC_FRAG(bufoff, 49); \
        aO1 = MFMA32(fq2, Vb0, aO1); \
        fq2 = SC_FRAG(bufoff, 53); \
        S2 = MFMA32(fq3, Vb0, S2); \
        fq3 = SC_FRAG(bufoff, 33); \
        S3 = MFMA32(fq4, Vb0, S3); \
        fq4 = SC_FRAG(bufoff, 42); \
        aO0 = MFMA32(fq5, Vb0, aO0); \
        fq5 = SC_FRAG(bufoff, 46); \
        S0 = MFMA32(fq6, Vb1, S0); \
        fq6 = SC_FRAG(bufoff, 38); \
        S1 = MFMA32(fq7, Vb1, S1); \
        fq7 = SC_FRAG(bufoff, 50); \
        aO1 = MFMA32(fq0, Vb1, aO1); \
        fq0 = SC_FRAG(bufoff, 54); \
        S2 = MFMA32(fq1, Vb1, S2); \
        fq1 = SC_FRAG(bufoff, 43); \
        S3 = MFMA32(fq2, Vb1, S3); \
        fq2 = SC_FRAG(bufoff, 47); \
        aO0 = MFMA32(fq3, Vb1, aO0); \
        fq3 = SC_FRAG(bufoff, 39); \
        S0 = MFMA32(fq4, Vb2, S0); \
        fq4 = SC_FRAG(bufoff, 51); \
        S1 = MFMA32(fq5, Vb2, S1); \
        fq5 = SC_FRAG(bufoff, 55); \
        aO1 = MFMA32(fq6, Vb2, aO1); \
        S2 = MFMA32(fq7, Vb2, S2); \
        S3 = MFMA32(fq0, Vb2, S3); \
        S0 = MFMA32(fq1, Vb3, S0); \
        S1 = MFMA32(fq2, Vb3, S1); \
        aO1 = MFMA32(fq3, Vb3, aO1); \
        S2 = MFMA32(fq4, Vb3, S2); \
        S3 = MFMA32(fq5, Vb3, S3); \
        _Pragma("unroll") for (int r = 0; r < 16; ++r) { \
            *(LAS bf16*)(lds + (otoff) + (((r & 3) + 8 * (r >> 2) + 4 * hf) * OT_LD + 32 * w + c32) * 2) = (bf16)(pkbf(aO0[r], 0.f) & 0xffffu); \
            *(LAS bf16*)(lds + (otoff) + ((32 + (r & 3) + 8 * (r >> 2) + 4 * hf) * OT_LD + 32 * w + c32) * 2) = (bf16)(pkbf(aO1[r], 0.f) & 0xffffu); } \
        RAW_BAR(); } while (0)
        SC_LOADU(UA, 0);
        RAW_BAR();
#pragma unroll 1
        for (int n = 0; n < NCH; n += 2) { SC_CHUNK(n, UA, 0, OT_OFF); SC_CHUNK(n + 1, UA, SCB, OT_OFF + OT_BYTES); }
#undef SC_CHUNK
#undef SC_FRAG
#undef SC_LOADU
#endif
    } else {
#ifndef SCAN_NO_HELPER
        const int ht = F.tid - 256, tok = ht >> 2, q = ht & 3;
        bf16* OB = FP8_PDL(layer) ? (bf16*)((unsigned char*)a.out + 64 * MiB) : (bf16*)(ws + WS_MIXIN); const int old_ = FP8_PDL(layer) ? DNW : D;
        v4u RA[14], RB[14];
        const __amdgpu_buffer_rsrc_t rsI = __builtin_amdgcn_make_buffer_rsrc((void*)(IMG + chd0 * IMG_ELEMS), (short)0, NCH * NH * IMG_ELEMS * 2, 0x00020000);
#define SH_LOADIMG(dst, nn) do { _Pragma("unroll") for (int i_ = 0; i_ < 14; ++i_) dst[i_] = __builtin_amdgcn_raw_buffer_load_b128(rsI, (unsigned)ht * 16u, (unsigned)(nn) * (unsigned)(NH * IMG_ELEMS * 2) + (unsigned)i_ * 4096u, 0); } while (0)
#define SH_STOREIMG(src, bufoff) do { LAS v4u* p_ = (LAS v4u*)(lds + (bufoff)) + ht; _Pragma("unroll") for (int i_ = 0; i_ < 14; ++i_) p_[i_ * 256] = src[i_]; } while (0)
#define SH_EPI(mm, otoff) do { const LAS v4u* op_ = (const LAS v4u*)(lds + (otoff) + (tok * OT_LD + 32 * q) * 2); \
        v4u* yp_ = (v4u*)(OB + ((size_t)b * SEQ + (size_t)(mm) * CH + tok) * old_ + h * HD + 32 * q); \
        _Pragma("unroll") for (int i_ = 0; i_ < 4; ++i_) yp_[i_] = op_[i_]; } while (0)
#define SH_STEP(nn, Rcur, Rnext, bufnext, otprev) do { \
        if ((nn) + 2 < NCH) SH_LOADIMG(Rcur, (nn) + 2); \
        if ((nn) >= 1) SH_EPI((nn) - 1, otprev); \
        if ((nn) + 1 < NCH) SH_STOREIMG(Rnext, bufnext); \
        RAW_BAR(); } while (0)
        SH_LOADIMG(RA, 0); SH_LOADIMG(RB, 1);
        SH_STOREIMG(RA, 0);
        RAW_BAR();
#pragma unroll 1
        for (int n = 0; n < NCH; n += 2) { SH_STEP(n, RA, RB, SCB, OT_OFF + OT_BYTES); SH_STEP(n + 1, RB, RA, 0, OT_OFF); }
        SH_EPI(NCH - 1, OT_OFF + OT_BYTES);
#undef SH_STEP
#undef SH_EPI
#undef SH_STOREIMG
#undef SH_LOADIMG
#endif
    }
}

__device__ __forceinline__ void phase_dn_norm(const Frame& F0, const Args& a, int layer) {
    PHASE_FRAME(F0);
    unsigned char* ws = OPQ_G(unsigned char, a.ws);
    const bf16* PROJ = (const bf16*)(ws + WS_PROJ); bf16* MIXIN = (bf16*)(ws + WS_MIXIN);
    const bf16* OSRC = FP8_PDL(layer) ? (const bf16*)((unsigned char*)a.out + 64 * MiB) : (const bf16*)(ws + WS_MIXIN); const int old_ = FP8_PDL(layer) ? DNW : D;
    const int lane = F.lane, gw = F.vcu * NWAVES + F.wave, NGW = F.G * NWAVES;
    const float* nw = a.in[I_NORMW] + layer * HD + 16 * (lane & 7); f32x4 nwv[4];
#pragma unroll
    for (int i = 0; i < 4; ++i) nwv[i] = *(const f32x4*)(nw + 4 * i);
    v4u OA[2], ZA[2], OB[2], ZB[2];
#define DNN_LOAD(O_, Z_, t) do { const v4u* op_ = (const v4u*)(OSRC + (size_t)(t) * old_ + 16 * lane); const v4u* zp_ = (const v4u*)(PROJ + (size_t)(t) * NPROJ + 3072 + 16 * lane); O_[0] = op_[0]; O_[1] = op_[1]; Z_[0] = zp_[0]; Z_[1] = zp_[1]; } while (0)
#define DNN_ROW(O_, Z_, t) do { float ss = 0.f; \
        _Pragma("unroll") for (int i = 0; i < 2; ++i) _Pragma("unroll") for (int j = 0; j < 4; ++j) { const float x0 = bflo(O_[i][j]), x1 = bfhi(O_[i][j]); ss += x0 * x0 + x1 * x1; } \
        ss = row8_sum(ss); const float rr = 1.0f / sqrtf(ss * (1.0f / HD) + RMS_EPS); \
        v4u* yp_ = (v4u*)(MIXIN + (size_t)(t) * D + 16 * lane); float yv_[16]; \
        _Pragma("unroll") for (int i = 0; i < 2; ++i) { _Pragma("unroll") for (int j = 0; j < 4; ++j) { const float z0 = bflo(Z_[i][j]), z1 = bfhi(Z_[i][j]); const f32x4 nn = nwv[2 * i + (j >> 1)]; \
            yv_[8 * i + 2 * j] = bflo(O_[i][j]) * rr * nn[2 * (j & 1)] * z0 * sigmoidf_(z0); yv_[8 * i + 2 * j + 1] = bfhi(O_[i][j]) * rr * nn[2 * (j & 1) + 1] * z1 * sigmoidf_(z1); } } \
        if (FP8_PDL(layer)) { v4u o8_; _Pragma("unroll") for (int q4 = 0; q4 < 4; ++q4) o8_[q4] = pk4_fp8(yv_[4 * q4] * F8_XS, yv_[4 * q4 + 1] * F8_XS, yv_[4 * q4 + 2] * F8_XS, yv_[4 * q4 + 3] * F8_XS); *(v4u*)((unsigned char*)MIXIN + (size_t)(t) * D + 16 * lane) = o8_; } \
        else { _Pragma("unroll") for (int i = 0; i < 2; ++i) { v4u o_; _Pragma("unroll") for (int j = 0; j < 4; ++j) o_[j] = pkbf(yv_[8 * i + 2 * j], yv_[8 * i + 2 * j + 1]); yp_[i] = o_; } } } while (0)
    if (gw < T) DNN_LOAD(OA, ZA, gw);
#pragma unroll 1
    for (int t = gw; t < T; t += 2 * NGW) {
        if (t + NGW < T) DNN_LOAD(OB, ZB, t + NGW);
        DNN_ROW(OA, ZA, t);
        if (t + 2 * NGW < T) DNN_LOAD(OA, ZA, t + 2 * NGW);
        if (t + NGW < T) DNN_ROW(OB, ZB, t + NGW);
    }
#undef DNN_LOAD
#undef DNN_ROW
}

constexpr int WG_LD = 2056;
__device__ __forceinline__ void phase_ln1_router(const Frame& F0, const Args& a, int layer, int probe = 0, int f8 = 0) {
    PHASE_FRAME(F0);
    unsigned char* ws = OPQ_G(unsigned char, a.ws);
    LAS bf16* WgT = (LAS bf16*)F.lds;
    LAS float* GV = (LAS float*)(F.lds + 16 * WG_LD * 2);
    LAS float* part = GV + 2 * D;
    LAS float* rst = part + 2 * 64 * 16;
    LAS float* sgcb = rst + 128;
    LAS int* rowE = (LAS int*)(F.lds + AUX_OFF); LAS int* rowP = rowE + 128; LAS float* rowG = (LAS float*)(rowP + 128); LAS int* lcnt = (LAS int*)(rowG + 128); LAS int* lbase = lcnt + 16;
    const float* wr = OPQ_G(const float, a.in[I_WR]); const float* br = OPQ_G(const float, a.in[I_BR]);
    const float* g1 = a.in[I_LN1G] + (size_t)layer * D; const float* b1 = a.in[I_LN1B] + (size_t)layer * D;
    const int tid = F.tid, lane = F.lane, wave = F.wave;
    for (int i = tid; i < D; i += 512) { GV[i] = g1[i]; GV[D + i] = b1[i]; }
    { const int e = tid & 15, kp = tid >> 4; float s1 = 0.f, s2 = 0.f;
        for (int k = 64 * kp; k < 64 * kp + 64; k += 2) { const float w0 = wr[(size_t)k * NE + e], w1 = wr[(size_t)(k + 1) * NE + e]; const unsigned pk = pkbf(g1[k] * w0, g1[k + 1] * w1);
            *(LAS unsigned*)(WgT + e * WG_LD + k) = pk; s1 += bflo(pk) + bfhi(pk); s2 += b1[k] * w0 + b1[k + 1] * w1; }
        part[kp * 16 + e] = s1; part[512 + kp * 16 + e] = s2; }
    __syncthreads();
    if (tid < 32) { const int e = tid & 15, which = tid >> 4; float s = 0.f; for (int kp = 0; kp < 32; ++kp) s += part[which * 512 + kp * 16 + e]; sgcb[which * 16 + e] = which ? s + br[e] : s; }
    __syncthreads();
    const bf16* PRE = (const bf16*)a.out; bf16* X1B = (bf16*)(ws + (probe ? WS_R1 : WS_X1B)); float* STATS = (float*)(ws + (probe ? WS_R1 + 70 * MiB : WS_STATS));
    int* LIST = (int*)(ws + (probe ? WS_R1 + 72 * MiB : WS_LIST)); int* TOKSLOT = (int*)(ws + (probe ? WS_R1 + 80 * MiB : WS_TOKSLOT)); float* GATEW = (float*)(ws + (probe ? WS_R1 + 82 * MiB : WS_GATEW));
    gu32* cnt = F.ctl + CW_CNT + 64 * (layer + (probe ? 2 : 0));
    for (int rb = F.vcu; rb < T / 64; rb += F.G) {
        if (tid < 16) lcnt[tid] = 0;
        v2u XA[8], XB_[8];
#define PE_LOAD(X, r) do { const GAS v2u* xr_ = (const GAS v2u*)(PRE + (size_t)(rb * 64 + wave * 8 + (r)) * D) + lane; _Pragma("unroll") for (int j = 0; j < 8; ++j) X[j] = xr_[64 * j]; } while (0)
#define PE_ROW(X, r) do { const int lr = wave * 8 + (r), row = rb * 64 + lr; unsigned gvo_ = (unsigned)(uintptr_t)GV; asm volatile("" : "+v"(gvo_)); const LAS float* GVr = (const LAS float*)(uintptr_t)gvo_; \
            f32x4 v[8]; float s = 0.f; \
            _Pragma("unroll") for (int j = 0; j < 8; ++j) { v[j] = (f32x4){bflo(X[j].x), bfhi(X[j].x), bflo(X[j].y), bfhi(X[j].y)}; s += (v[j][0] + v[j][1]) + (v[j][2] + v[j][3]); } \
            const float mean = wave_sum(s) * (1.f / D); float s2 = 0.f; \
            _Pragma("unroll") for (int j = 0; j < 8; ++j) { v[j] = v[j] - mean; s2 += (v[j][0] * v[j][0] + v[j][1] * v[j][1]) + (v[j][2] * v[j][2] + v[j][3] * v[j][3]); } \
            const float rstd = 1.f / sqrtf(wave_sum(s2) * (1.f / D) + LN_EPS); \
            if (lane == 0) { STATS[2 * row] = mean; STATS[2 * row + 1] = rstd; rst[2 * lr] = mean; rst[2 * lr + 1] = rstd; } \
            GAS v2u* o8 = (GAS v2u*)(X1B + (size_t)row * D) + lane; \
            _Pragma("unroll") for (int j = 0; j < 8; ++j) { const f32x4 gg = *(const LAS f32x4*)(GVr + 256 * j + 4 * lane), bb = *(const LAS f32x4*)(GVr + D + 256 * j + 4 * lane); \
                v[j] = v[j] * rstd * gg + bb; \
                if (f8) ((GAS unsigned*)((GAS unsigned char*)X1B + (size_t)row * D) + lane)[64 * j] = pk4_fp8(v[j][0] * F8_XS, v[j][1] * F8_XS, v[j][2] * F8_XS, v[j][3] * F8_XS); \
                else { v2u w; w.x = pkbf(v[j][0], v[j][1]); w.y = pkbf(v[j][2], v[j][3]); o8[64 * j] = w; } } } while (0)
        PE_LOAD(XA, 0);
#pragma unroll 1
        for (int r = 0; r < 8; r += 2) { PE_LOAD(XB_, r + 1); PE_ROW(XA, r); if (r + 2 < 8) PE_LOAD(XA, r + 2); PE_ROW(XB_, r + 1); }
#undef PE_LOAD
#undef PE_ROW
        { const int mt = wave & 3, kh = wave >> 2, fr = lane & 15, fg = lane >> 4; typedef float f32x4v __attribute__((ext_vector_type(4))); f32x4v acc = {0.f, 0.f, 0.f, 0.f};
            const bf16* arow = PRE + (size_t)(rb * 64 + 16 * mt + fr) * D + 1024 * kh + 8 * fg; const LAS bf16* brow = WgT + fr * WG_LD + 1024 * kh + 8 * fg;
#pragma unroll 1
            for (int sb = 0; sb < 32; sb += 8) { bf16x8 aq[8];
#pragma unroll
                for (int s = 0; s < 8; ++s) aq[s] = *(const bf16x8*)(arow + 32 * (sb + s));
                asm volatile("" : "+v"(aq[0]), "+v"(aq[1]), "+v"(aq[2]), "+v"(aq[3]), "+v"(aq[4]), "+v"(aq[5]), "+v"(aq[6]), "+v"(aq[7]));
#pragma unroll
                for (int s = 0; s < 8; ++s) acc = __builtin_amdgcn_mfma_f32_16x16x32_bf16(aq[s], *(const LAS bf16x8*)(brow + 32 * (sb + s)), acc, 0, 0, 0); }
#pragma unroll
            for (int r = 0; r < 4; ++r) part[(kh * 64 + 16 * mt + 4 * fg + r) * 16 + fr] = acc[r]; }
        __syncthreads();
        if (tid < 64) { const int lr = tid; const float mean = rst[2 * lr], rstd = rst[2 * lr + 1]; float p[16]; float mx = -3.0e38f;
#pragma unroll
            for (int e = 0; e < 16; ++e) { p[e] = rstd * ((part[lr * 16 + e] + part[(64 + lr) * 16 + e]) - mean * sgcb[e]) + sgcb[16 + e]; mx = fmaxf(mx, p[e]); }
#pragma unroll
            for (int e = 0; e < 16; ++e) p[e] = __expf(p[e] - mx);
            float gsc[4];
#pragma unroll
            for (int g = 0; g < 4; ++g) { const float a0 = p[4 * g], a1 = p[4 * g + 1], a2 = p[4 * g + 2], a3 = p[4 * g + 3];
                const float hi1 = fmaxf(a0, a1), lo1 = fminf(a0, a1), hi2 = fmaxf(a2, a3), lo2 = fminf(a2, a3);
                gsc[g] = fmaxf(hi1, hi2) + fmaxf(fminf(hi1, hi2), fmaxf(lo1, lo2)); }
            int gsel = 0; float best = gsc[0];
#pragma unroll
            for (int g = 1; g < 4; ++g) if (gsc[g] > best) { best = gsc[g]; gsel = g; }
            float q[4];
#pragma unroll
            for (int j = 0; j < 4; ++j) q[j] = gsel == 0 ? p[j] : (gsel == 1 ? p[4 + j] : (gsel == 2 ? p[8 + j] : p[12 + j]));
            int i0 = 0; float p0 = q[0];
#pragma unroll
            for (int j = 1; j < 4; ++j) if (q[j] > p0) { p0 = q[j]; i0 = j; }
            int i1 = -1; float p1 = -1.f;
#pragma unroll
            for (int j = 0; j < 4; ++j) if (j != i0 && q[j] > p1) { p1 = q[j]; i1 = j; }
            const int e0 = gsel * 4 + i0, e1 = gsel * 4 + i1; const float inv = 1.0f / (p0 + p1);
            rowE[2 * lr] = e0; rowE[2 * lr + 1] = e1; rowG[2 * lr] = p0 * inv; rowG[2 * lr + 1] = p1 * inv;
            rowP[2 * lr] = __hip_atomic_fetch_add(&lcnt[e0], 1, __ATOMIC_RELAXED, __HIP_MEMORY_SCOPE_WORKGROUP); rowP[2 * lr + 1] = __hip_atomic_fetch_add(&lcnt[e1], 1, __ATOMIC_RELAXED, __HIP_MEMORY_SCOPE_WORKGROUP); }
        __syncthreads();
        if (tid < 16) lbase[tid] = (int)__hip_atomic_fetch_add(cnt + tid, (unsigned)lcnt[tid], RLX_AGENT);
        __syncthreads();
        if (tid < 128) { const int e = rowE[tid], pos = lbase[e] + rowP[tid], tok = rb * 64 + (tid >> 1);
            LIST[(size_t)e * LCAP + pos] = tok; TOKSLOT[2 * tok + (tid & 1)] = e * LCAP + pos; GATEW[2 * tok + (tid & 1)] = rowG[tid]; }
        __syncthreads();
    }
}
__device__ __forceinline__ void moe_table(const Frame& F0, int layer) {
    PHASE_FRAME(F0);
    LAS int* tab = (LAS int*)(F.lds + AUX_OFF);
    __syncthreads();
    if (F.tid < 16) tab[32 + F.tid] = (int)__hip_atomic_load(F.ctl + CW_CNT + 64 * layer + F.tid, RLX_AGENT);
    __syncthreads();
    if (F.tid == 0) { int blk = 0, nf = 0, nh = 0; for (int e = 0; e < 16; ++e) { const int cn = tab[32 + e]; tab[e] = blk; tab[48 + e] = nf; tab[80 + e] = nh; blk += (cn + 127) >> 7; nf += cn >> 8; nh += ((cn & 255) + 127) >> 7; } tab[16] = blk; tab[64] = nf; tab[96] = nh; }
    __syncthreads();
}
__device__ __forceinline__ void phase_combine_ln2(const Frame& F0, const Args& a, int layer, int probe = 0, int f8 = 0) {
    PHASE_FRAME(F0);
    unsigned char* ws = OPQ_G(unsigned char, a.ws); const LAS int* tab = (const LAS int*)(F.lds + AUX_OFF);
    const bf16* PRE = (const bf16*)a.out; const float* STATS = (const float*)(ws + WS_STATS); const bf16* Y = (const bf16*)(ws + WS_Y); bf16* X2B = (bf16*)(ws + (probe ? WS_R1 : WS_X2B)); unsigned char* X2F8 = ws + WS_X2F8;
    const int* TOKSLOT = (const int*)(ws + WS_TOKSLOT); const float* GATEW = (const float*)(ws + WS_GATEW);
    LAS float* GV = (LAS float*)F.lds;
    { const float* g1 = a.in[I_LN1G] + (size_t)layer * D; const float* b1 = a.in[I_LN1B] + (size_t)layer * D; const float* g2 = a.in[I_LN2G] + (size_t)layer * D; const float* b2 = a.in[I_LN2B] + (size_t)layer * D;
        for (int i = F.tid; i < D; i += 512) { GV[i] = g1[i]; GV[D + i] = b1[i]; GV[2 * D + i] = g2[i]; GV[3 * D + i] = b2[i]; } }
    __syncthreads();
    const int gw = F.vcu * NWAVES + F.wave, NGW = F.G * NWAVES, nrows = (T - gw + NGW - 1) / NGW, lane = F.lane;
    for (int base = 0; base < nrows; base += 64) {
        const int nr = (nrows - base) < 64 ? (nrows - base) : 64;
        float m_mean = 0.f, m_rstd = 0.f, m_w0 = 0.f, m_w1 = 0.f; int m_y0 = 0, m_y1 = 0;
        if (lane < nr) { const int row = gw + NGW * (base + lane); m_mean = STATS[2 * row]; m_rstd = STATS[2 * row + 1]; m_w0 = GATEW[2 * row]; m_w1 = GATEW[2 * row + 1];
            const int s0 = TOKSLOT[2 * row], s1 = TOKSLOT[2 * row + 1]; m_y0 = tab[s0 / LCAP] * 128 + (s0 % LCAP); m_y1 = tab[s1 / LCAP] * 128 + (s1 % LCAP); }
        v2u XA[8], PA[8], QA[8], XB_[8], PB_[8], QB_[8];
#define PH_LOAD(X, P, Q, i) do { const int row_ = gw + NGW * (base + (i)); const size_t y0_ = (size_t)__builtin_amdgcn_readlane(m_y0, (i)), y1_ = (size_t)__builtin_amdgcn_readlane(m_y1, (i)); \
            const GAS v2u* xr_ = (const GAS v2u*)(PRE + (size_t)row_ * D) + lane; const GAS v2u* ya_ = (const GAS v2u*)(Y + y0_ * D) + lane; const GAS v2u* yb_ = (const GAS v2u*)(Y + y1_ * D) + lane; \
            _Pragma("unroll") for (int j = 0; j < 8; ++j) { X[j] = xr_[64 * j]; P[j] = ya_[64 * j]; Q[j] = yb_[64 * j]; } } while (0)
#define PH_ROW(X, P, Q, i) do { const int row_ = gw + NGW * (base + (i)); unsigned gvo_ = (unsigned)(uintptr_t)GV; asm volatile("" : "+v"(gvo_)); const LAS float* GVr = (const LAS float*)(uintptr_t)gvo_;     \
            const float mean = __builtin_bit_cast(float, __builtin_amdgcn_readlane(__builtin_bit_cast(int, m_mean), (i))), rstd = __builtin_bit_cast(float, __builtin_amdgcn_readlane(__builtin_bit_cast(int, m_rstd), (i))); \
            const float w0 = __builtin_bit_cast(float, __builtin_amdgcn_readlane(__builtin_bit_cast(int, m_w0), (i))), w1 = __builtin_bit_cast(float, __builtin_amdgcn_readlane(__builtin_bit_cast(int, m_w1), (i))); \
            f32x4 v[8]; float s = 0.f; \
            _Pragma("unroll") for (int j = 0; j < 8; ++j) { const f32x4 gg = *(const LAS f32x4*)(GVr + 256 * j + 4 * lane), bb = *(const LAS f32x4*)(GVr + D + 256 * j + 4 * lane); \
                const f32x4 x1 = ((f32x4){bflo(X[j].x), bfhi(X[j].x), bflo(X[j].y), bfhi(X[j].y)} - mean) * rstd * gg + bb; \
                f32x4 f; f[0] = w0 * bflo(P[j].x) + w1 * bflo(Q[j].x); f[1] = w0 * bfhi(P[j].x) + w1 * bfhi(Q[j].x); f[2] = w0 * bflo(P[j].y) + w1 * bflo(Q[j].y); f[3] = w0 * bfhi(P[j].y) + w1 * bfhi(Q[j].y); \
                v[j] = x1 * ALPHA + f; s += (v[j][0] + v[j][1]) + (v[j][2] + v[j][3]); } \
            const float m2 = wave_sum(s) * (1.f / D); float q = 0.f; \
            _Pragma("unroll") for (int j = 0; j < 8; ++j) { v[j] = v[j] - m2; q += (v[j][0] * v[j][0] + v[j][1] * v[j][1]) + (v[j][2] * v[j][2] + v[j][3] * v[j][3]); } \
            const float r2 = 1.f / sqrtf(wave_sum(q) * (1.f / D) + LN_EPS); \
            GAS v2u* o8 = (GAS v2u*)(X2B + (size_t)row_ * D) + lane; \
            _Pragma("unroll") for (int j = 0; j < 8; ++j) { const f32x4 gg = *(const LAS f32x4*)(GVr + 2 * D + 256 * j + 4 * lane), bb = *(const LAS f32x4*)(GVr + 3 * D + 256 * j + 4 * lane); \
                const f32x4 o = v[j] * r2 * gg + bb; v2u w; w.x = pkbf(o[0], o[1]); w.y = pkbf(o[2], o[3]); o8[64 * j] = w; \
                if (f8) ((GAS unsigned*)((GAS unsigned char*)X2F8 + (size_t)row_ * D) + lane)[64 * j] = pk4_fp8(o[0] * F8_XS, o[1] * F8_XS, o[2] * F8_XS, o[3] * F8_XS); } } while (0)
        PH_LOAD(XA, PA, QA, 0);
#pragma unroll 1
        for (int i = 0; i < nr; i += 2) {
            if (i + 1 < nr) PH_LOAD(XB_, PB_, QB_, i + 1);
            PH_ROW(XA, PA, QA, i);
            if (i + 2 < nr) PH_LOAD(XA, PA, QA, i + 2);
            if (i + 1 < nr) PH_ROW(XB_, PB_, QB_, i + 1);
        }
#undef PH_LOAD
#undef PH_ROW
    }
}

#ifndef MK_N_LAUNCHES
#define MK_N_LAUNCHES 1
#endif
constexpr int NPL = 10;
constexpr int NPHASE = 1 + NPL * DEPTH;
constexpr int N_LAUNCHES = MK_N_LAUNCHES;
static_assert(N_LAUNCHES == 1 || N_LAUNCHES == NPHASE, "MK_N_LAUNCHES is 1 or NPHASE");

#define GRID_BAR() do { if (N_LAUNCHES == 1) xcd_barrier(bar); } while (0)
#ifndef PH_MASK
#define PH_MASK 0x7ff
#endif
#define IN(k) ((((k) == 0 ? 1u : (2u << (((k) - 1) % NPL))) & (unsigned)(PH_MASK)) && lo <= (k) && (k) < hi)
#define SEAM(k) do { if (IN((k) + 1)) GRID_BAR(); } while (0)
#ifndef PROBE_DUP
#define PROBE_DUP 0
#endif
#define REPS(k) ((((k) == 0 ? 1u : (2u << (((k) - 1) % NPL))) & (unsigned)(PROBE_DUP)) ? 2 : 1)

template <int layer> __device__ __forceinline__ void layer_phases(const Frame& F, const Args& args, const XcdBarrier& bar, const int lo, const int hi) {
            const int pb = 1 + NPL * layer;
            unsigned char* ws = OPQ_G(unsigned char, args.ws);
            if (IN(pb + 0)) { for (int rep = 0; rep < REPS(pb + 0); ++rep) { if (rep) GRID_BAR();
                SchedDense S; S.init(T, NPROJ, F.G, (int)blockIdx.x, ws + WS_XB, D, (const bf16*)(ws + WS_WIN) + (size_t)layer * NPROJ * D, D);
                EpiBf16 E{(bf16*)(ws + WS_PROJ), NPROJ};
                pg8::gemm_phase<EpiBf16, SchedDense, false>(F.lds + RING_OFF, D, D, D, S, E);
                } SEAM(pb + 0);
            }
            if (IN(pb + 1)) { for (int rep = 0; rep < REPS(pb + 1); ++rep) { if (rep) GRID_BAR(); phase_dn_prep(F, args, layer); } SEAM(pb + 1); }
            if (IN(pb + 2)) { for (int rep = 0; rep < REPS(pb + 2); ++rep) { if (rep) GRID_BAR();
                if (blockIdx.x < 32 || F.G <= 32) { for (int u = blockIdx.x; u < NB * NH; u += (F.G < 32 ? F.G : 32)) { phase_dn_scan(F, args, layer, u);
#ifdef SCAN_TWICE
                    __syncthreads(); phase_dn_scan(F, args, layer, u);
#endif
                } }
                { const bool big = F.G >= 160; const int NGEMM = big ? 96 : (F.G > 32 ? F.G - 32 : F.G); const int c2 = F.G > 32 ? (int)blockIdx.x - 32 : (int)blockIdx.x;
                  if (c2 >= 0 && c2 < NGEMM) {
                    { int t_ = threadIdx.x; asm volatile("" : "+v"(t_)); Frame Fp = F; Fp.tid = t_; Fp.lane = t_ & 63;
                      for (int L = c2; L < 256; L += NGEMM) pool_diffs_unit(Fp, ws, L >> 2, L & 3);
                      asm volatile("s_waitcnt vmcnt(0)" ::: "memory"); __syncthreads(); }
                    { SchedPool S{NGEMM, c2, (const char*)(ws + WS_POOLD), (const char*)((const bf16*)(ws + WS_WPOOL) + (size_t)layer * 4 * 65536)};
                      EpiPool E{(bf16*)(ws + WS_MIXIN), args.in[I_POOLS] + (size_t)layer * PW, FP8_PDL(layer)};
                      pg8::gemm_phase<EpiPool, SchedPool, false>(F.lds + RING_OFF, 256, PW, 256, S, E); }
                    { SchedDense S; S.init(T, D, NGEMM, c2, (const bf16*)(ws + WS_PB16) + (size_t)layer * T * PLE, PLE, (const bf16*)(ws + WS_WPP) + (size_t)layer * D * PLE, PLE);
                      EpiBf16 E{(bf16*)(ws + WS_PP), D};
                      pg8::gemm_phase<EpiBf16, SchedDense, false>(F.lds + RING_OFF, PLE, PLE, PLE, S, E); } }
#ifndef CONVERT_ALL_IN_PROLOGUE
                  __syncthreads();
                  { int t_ = threadIdx.x; asm volatile("" : "+v"(t_));
                    weight_items(args, ws, (LAS float*)(F.lds + RING_OFF + F.wave * 16384), t_ & 63, 1, layer, 0, 1, F.ctl + CW_CONV + 64 * layer); }
#endif
                }
                } SEAM(pb + 2);
            }
            if (IN(pb + 3)) { for (int rep = 0; rep < REPS(pb + 3); ++rep) { if (rep) GRID_BAR(); phase_dn_norm(F, args, layer); } SEAM(pb + 3); }
            if (IN(pb + 4)) { for (int rep = 0; rep < REPS(pb + 4); ++rep) { if (rep) GRID_BAR();
                if (FP8_PDL(layer)) { SchedDense S; S.init(T, D, F.G, (int)blockIdx.x, ws + WS_MIXIN, D / 2, ws + WS_WOUT + (size_t)layer * D * D * 2, D / 2);
                    EpiRes E{(const bf16*)(ws + WS_XB), (bf16*)args.out, F8_INV};
                    pg8::gemm_phase<EpiRes, SchedDense, false, true>(F.lds + RING_OFF, D / 2, D / 2, D / 2, S, E); }
                else { SchedDense S; S.init(T, D, F.G, (int)blockIdx.x, ws + WS_MIXIN, D, (const bf16*)(ws + WS_WOUT) + (size_t)layer * D * D, D);
                EpiRes E{(const bf16*)(ws + WS_XB), (bf16*)args.out};
#ifdef PROBE_PD
                { EpiRes E2{(const bf16*)(ws + WS_XB), (bf16*)(ws + WS_R1)}; pg8::gemm_phase<EpiRes, SchedDense, false>(F.lds + RING_OFF, D, D, D, S, E2); }
#endif
                pg8::gemm_phase<EpiRes, SchedDense, false>(F.lds + RING_OFF, D, D, D, S, E); }
                } SEAM(pb + 4);
            }
            if (IN(pb + 5)) { for (int rep = 0; rep < REPS(pb + 5); ++rep) { if (rep) GRID_BAR();
#ifdef PROBE_PE
                phase_ln1_router(F, args, layer, 1); __syncthreads();
#endif
                phase_ln1_router(F, args, layer, 0, FP8_LAYER(layer) ? 1 : 0); } SEAM(pb + 5); }
            if (IN(pb + 6)) { for (int rep = 0; rep < REPS(pb + 6); ++rep) { if (rep) GRID_BAR();
                moe_table(F, layer);
                if (FP8_LAYER(layer)) {
                    SchedMoe S{F.G, (int)blockIdx.x, 0, (const LAS int*)(F.lds + AUX_OFF), (const char*)(ws + WS_X1B), (const char*)(ws + WS_WGU + (size_t)layer * NE * 2048 * D * 2), (const int*)(ws + WS_LIST), 1};
                    EpiSwiglu E{(bf16*)(ws + WS_HID), FP8_PG, F8_INV};
                    pg8::gemm_phase<EpiSwiglu, SchedMoe, true, true>(F.lds + RING_OFF, D / 2, D / 2, D / 2, S, E);
                } else {
                    SchedMoe S{F.G, (int)blockIdx.x, 0, (const LAS int*)(F.lds + AUX_OFF), (const char*)(ws + WS_X1B), (const char*)((const bf16*)(ws + WS_WGU) + (size_t)layer * NE * 2048 * D), (const int*)(ws + WS_LIST), 2};
                    EpiSwiglu E{(bf16*)(ws + WS_HID)};
                    pg8::gemm_phase<EpiSwiglu, SchedMoe, true>(F.lds + RING_OFF, D, D, D, S, E);
                }
                } SEAM(pb + 6);
            }
            if (IN(pb + 7)) { for (int rep = 0; rep < REPS(pb + 7); ++rep) { if (rep) GRID_BAR();
                moe_table(F, layer);
                if (FP8_PG && FP8_LAYER(layer)) {
                    SchedMoe S{F.G, (int)blockIdx.x, 1, (const LAS int*)(F.lds + AUX_OFF), (const char*)(ws + WS_HID), (const char*)(ws + WS_WD + (size_t)layer * NE * D * DE * 2), nullptr, 1};
                    EpiBf16 E{(bf16*)(ws + WS_Y), D, F8_INV};
                    pg8::gemm_phase<EpiBf16, SchedMoe, false, true>(F.lds + RING_OFF, DE / 2, DE / 2, DE / 2, S, E);
                } else {
                    SchedMoe S{F.G, (int)blockIdx.x, 1, (const LAS int*)(F.lds + AUX_OFF), (const char*)(ws + WS_HID), (const char*)((const bf16*)(ws + WS_WD) + (size_t)layer * NE * D * DE), nullptr, 2};
                    EpiBf16 E{(bf16*)(ws + WS_Y), D};
                    pg8::gemm_phase<EpiBf16, SchedMoe, false>(F.lds + RING_OFF, DE, DE, DE, S, E);
                }
                } SEAM(pb + 7);
            }
            if (IN(pb + 8)) { for (int rep = 0; rep < REPS(pb + 8); ++rep) { if (rep) GRID_BAR(); moe_table(F, layer);
#ifdef PROBE_PH
                phase_combine_ln2(F, args, layer, 1);
#endif
                phase_combine_ln2(F, args, layer, 0, (FP8_PI && (FP8_PI0 || layer == DEPTH - 1)) ? 1 : 0); } SEAM(pb + 8); }
            if (IN(pb + 9)) { for (int rep = 0; rep < REPS(pb + 9); ++rep) { if (rep) GRID_BAR();
                if (FP8_PI && (FP8_PI0 || layer == DEPTH - 1)) {
                    SchedDense S; S.init(T, D, F.G, (int)blockIdx.x, ws + WS_X2F8, D / 2, ws + WS_WPG + (size_t)layer * D * D * 2, D / 2);
                    EpiPle E{(const bf16*)(ws + WS_X2B), (const bf16*)(ws + WS_PP), (bf16*)(ws + WS_XB), args.out, layer + 1 < DEPTH ? 0 : 1, F8_INV};
                    pg8::gemm_phase<EpiPle, SchedDense, false, true>(F.lds + RING_OFF, D / 2, D / 2, D / 2, S, E);
                } else {
                    SchedDense S; S.init(T, D, F.G, (int)blockIdx.x, ws + WS_X2B, D, (const bf16*)(ws + WS_WPG) + (size_t)layer * D * D, D);
                    EpiPle E{(const bf16*)(ws + WS_X2B), (const bf16*)(ws + WS_PP), (bf16*)(ws + WS_XB), args.out, layer + 1 < DEPTH ? 0 : 1};
                    pg8::gemm_phase<EpiPle, SchedDense, false>(F.lds + RING_OFF, D, D, D, S, E);
                }
                } SEAM(pb + 9);
            }
}
__global__ void __launch_bounds__(NWAVES * 64, 2) trunk_fwd(Args args) {
    extern __shared__ __attribute__((aligned(16))) unsigned char lds[];
    Frame F;
    F.lds = (LAS unsigned char*)lds;
    F.MISC = (volatile LAS unsigned*)(F.lds + MISC_OFF);
    F.tid = threadIdx.x; F.lane = F.tid & 63; F.wave = __builtin_amdgcn_readfirstlane(F.tid >> 6);
    F.G = gridDim.x; { const int bx = blockIdx.x; F.vcu = (F.G % 8 == 0) ? (bx % 8) * (F.G / 8) + bx / 8 : bx; }
    unsigned char* ws = args.ws;
    F.ctl = (gu32*)(ws + WS_CTL);
    for (int u = F.tid; u < (LDS_BYTES - LDSCTL_OFF) / 4; u += NWAVES * 64) ((LAS unsigned*)(F.lds + LDSCTL_OFF))[u] = 0u;
    __syncthreads();
    XcdBarrier bar; bar.bar = (unsigned*)(F.ctl + CW_BAR); bar.x = 0; bar.st = nullptr;
    if (N_LAUNCHES == 1) bar = xcd_barrier_post((unsigned*)(F.ctl + CW_BAR), F.MISC + 8);
    const int lo = args.ph_lo, hi = args.ph_hi;
    if (IN(0)) { for (int rep = 0; rep < REPS(0); ++rep) { if (rep) GRID_BAR(); p0_prologue(F, args); } SEAM(0); }

    layer_phases<0>(F, args, bar, lo, hi);
    layer_phases<1>(F, args, bar, lo, hi);
    static_assert(DEPTH == 2, "layer_phases instantiations");
#undef IN
#undef SEAM
#undef GRID_BAR
}

extern "C" void kernel_launch(void* const* d_in, const int* in_sizes, int n_in, void* d_out, int out_size, void* d_ws, size_t ws_size, hipStream_t stream) {
    static int grid = 0;
    if (grid == 0) {
        if (n_in != 21 || in_sizes[0] != T * D || out_size != T * D || ws_size < WS_END) { fprintf(stderr, "kernel_launch: unexpected shapes (n_in %d, in0 %d, out %d, ws %zu); nothing launched\n", n_in, n_in > 0 ? in_sizes[0] : -1, out_size, ws_size); grid = -1; return; }
        int dev = 0, cus = 0, per_cu = 0;
        if (hipGetDevice(&dev) != hipSuccess || hipDeviceGetAttribute(&cus, hipDeviceAttributeMultiprocessorCount, dev) != hipSuccess) { grid = -1; return; }
        if (hipFuncSetAttribute((const void*)trunk_fwd, hipFuncAttributeMaxDynamicSharedMemorySize, LDS_BYTES) != hipSuccess) { fprintf(stderr, "kernel_launch: hipFuncSetAttribute failed\n"); grid = -1; return; }
        if (hipOccupancyMaxActiveBlocksPerMultiprocessor(&per_cu, (const void*)trunk_fwd, NWAVES * 64, LDS_BYTES) != hipSuccess || per_cu < 1) { fprintf(stderr, "kernel_launch: occupancy query reports %d workgroups per CU\n", per_cu); }
        (void)hipGetLastError();
        grid = cus;
    }
    if (grid < 0) return;
    if (hipMemsetAsync((char*)d_ws + WS_CTL, 0, CTL_ZERO_BYTES, stream) != hipSuccess) return;
    Args a{};
    for (int i = 0; i < 21; ++i) a.in[i] = (const float*)d_in[i];
    a.out = (float*)d_out; a.ws = (unsigned char*)d_ws;
    for (int li = 0; li < N_LAUNCHES; ++li) {
        a.ph_lo = (N_LAUNCHES == 1) ? 0 : li; a.ph_hi = (N_LAUNCHES == 1) ? NPHASE : li + 1; a.li = li; a.pad = 0;
        hipLaunchKernelGGL(trunk_fwd, dim3(grid), dim3(NWAVES * 64), LDS_BYTES, stream, a);
        const hipError_t le = hipPeekAtLastError();
        if (le != hipSuccess) { fprintf(stderr, "kernel_launch: launch %d failed: %s\n", li, hipGetErrorName(le)); break; }
    }
}
```

```cpp
#define MK_N_LAUNCHES 1
#define FP8_ALL 1
#define FP8_PG 1
#define FP8_PI 1
#define FP8_PI0 1
#define FP8_PD 1
#include <hip/hip_runtime.h>
#include <cstdio>
#include <cstdint>

#define GAS __attribute__((address_space(1)))
#define LAS __attribute__((address_space(3)))
typedef unsigned short bf16;
typedef unsigned v4u __attribute__((ext_vector_type(4)));
typedef unsigned v2u __attribute__((ext_vector_type(2)));
typedef float f32x4 __attribute__((ext_vector_type(4)));
typedef float f32x2 __attribute__((ext_vector_type(2)));
typedef short bf16x8 __attribute__((ext_vector_type(8)));
typedef GAS unsigned gu32;
typedef int v4i_t __attribute__((ext_vector_type(4)));
typedef int v8i_t __attribute__((ext_vector_type(8)));

namespace pg8 {
constexpr int BM = 256, BK = 64, HALF = 128, HTB = HALF * BK * 2  , STAGE_BYTES = 8 * HTB, NXCD = 8, WGM = 8;
__host__ __device__ __forceinline__ int lds_byte(int r, int c) { const int st = (r >> 4) * 2 + (c >> 5), rr = r & 15, cc = c & 31, ob = rr * 64 + cc * 2; return st * 1024 + (ob ^ (((ob >> 9) & 1) << 5)); }
__host__ __device__ __forceinline__ void stage_rc(int b, int& R, int& C) { const int st = b / 1024, sb = b % 1024, swz = sb ^ (((sb >> 9) & 1) << 5); R = (st >> 1) * 16 + swz / 64; C = (st & 1) * 32 + (swz % 64) / 2; }
__host__ __device__ __forceinline__ int perm32(int rho) { const int n = rho >> 4, i = rho & 15; return 8 * (i >> 2) + 4 * n + (i & 3); }

struct Unit { int pm, pn; const char* A; const char* B; const int* rows; int nvalid; int aux; int rowbase; int half; };

__device__ __forceinline__ unsigned cvt_pk_bf16(float lo, float hi) { unsigned r; asm volatile("v_cvt_pk_bf16_f32 %0, %1, %2" : "=v"(r) : "v"(lo), "v"(hi)); return r; }

template <class Epi, class Sched, bool GATHER, bool FP8 = false>
__device__ __forceinline__ void gemm_phase(LAS unsigned char* lds, const int K, const int lda, const int ldb, const Sched& S, const Epi& E) {
    int tid_ = threadIdx.x; asm volatile("" : "+v"(tid_));
    const int tid = tid_, wid = __builtin_amdgcn_readfirstlane(tid >> 6), lane = tid & 63, wr = wid >> 2, wc = wid & 3, fr = lane & 15, fq = lane >> 4;
    const int nt = K / BK;
    unsigned voffA[2], voffB[2]; int RA[2], CA[2];
#pragma unroll
    for (int i = 0; i < 2; ++i) { int R, C; stage_rc(tid * 16 + i * 8192, R, C); const int Rb = Epi::PERM ? ((R & ~31) + perm32(R & 31)) : R;
        RA[i] = R; CA[i] = C; voffA[i] = (unsigned)(R * lda + C) * 2u; voffB[i] = (unsigned)(Rb * ldb + C) * 2u; }
    unsigned gA[2][2], gN[2][2];
    const size_t kstep = (size_t)(BK * 2);
    const size_t hstepA = GATHER ? 0 : (size_t)HALF * lda * 2, hstepB = (size_t)HALF * ldb * 2;
    const unsigned ldsw = (unsigned)wid * 1024u;
    const int aoff = lds_byte(wr * 64 + fr, fq * 8), boff = lds_byte(wc * 32 + fr, fq * 8);
#define PG8_SA(b, h) (((b) * 2 + (h)) * HTB)
#define PG8_SB(b, h) ((4 + (b) * 2 + (h)) * HTB)
#define PG8_STAGE_B(bufoff, gbase) do { _Pragma("unroll") for (int _i = 0; _i < 2; ++_i) \
        __builtin_amdgcn_global_load_lds((const unsigned*)((const char*)(gbase) + voffB[_i]), (LAS unsigned*)(lds + (bufoff) + ldsw + _i * 8192), 16, 0, 0); } while (0)
#define PG8_STAGE_A(bufoff, gbase, h) do { _Pragma("unroll") for (int _i = 0; _i < 2; ++_i) \
        __builtin_amdgcn_global_load_lds((const unsigned*)((const char*)(gbase) + (GATHER ? gA[h][_i] : voffA[_i]) + (h) * hstepA), (LAS unsigned*)(lds + (bufoff) + ldsw + _i * 8192), 16, 0, 0); } while (0)
#define PG8_CAT(x0, x1) __builtin_shufflevector(__builtin_bit_cast(v4i_t, (x0)), __builtin_bit_cast(v4i_t, (x1)), 0, 1, 2, 3, 4, 5, 6, 7)
#define PG8_LDA(dst, b, h) do { _Pragma("unroll") for (int m = 0; m < 4; ++m) { if constexpr (FP8) dst##8[m] = PG8_CAT(*(const LAS bf16x8*)(lds + PG8_SA(b, h) + aoff + m * 2048), *(const LAS bf16x8*)(lds + PG8_SA(b, h) + aoff + m * 2048 + 1024)); \
        else { _Pragma("unroll") for (int k = 0; k < 2; ++k) dst[m][k] = *(const LAS bf16x8*)(lds + PG8_SA(b, h) + aoff + m * 2048 + k * 1024); } } } while (0)
#define PG8_LDB(dst, b, h) do { _Pragma("unroll") for (int n = 0; n < 2; ++n) { if constexpr (FP8) dst##8[n] = PG8_CAT(*(const LAS bf16x8*)(lds + PG8_SB(b, h) + boff + n * 2048), *(const LAS bf16x8*)(lds + PG8_SB(b, h) + boff + n * 2048 + 1024)); \
        else { _Pragma("unroll") for (int k = 0; k < 2; ++k) dst[n][k] = *(const LAS bf16x8*)(lds + PG8_SB(b, h) + boff + n * 2048 + k * 1024); } } } while (0)
#define PG8_MMA(ai, bj, At, Bt) do { __builtin_amdgcn_s_setprio(1); \
        if constexpr (FP8) { _Pragma("unroll") for (int m = 0; m < 4; ++m) _Pragma("unroll") for (int n = 0; n < 2; ++n) \
            asm volatile("v_mfma_scale_f32_16x16x128_f8f6f4 %0, %1, %2, %0, %3, %3 op_sel_hi:[0,0,0]" : "+v"(acc[ai][bj][m][n]) : "v"(Bt##8[n]), "v"(At##8[m]), "v"(f8scale)); } \
        else { _Pragma("unroll") for (int m = 0; m < 4; ++m) _Pragma("unroll") for (int n = 0; n < 2; ++n) _Pragma("unroll") for (int k = 0; k < 2; ++k) \
            acc[ai][bj][m][n] = __builtin_amdgcn_mfma_f32_16x16x32_bf16(Bt[n][k], At[m][k], acc[ai][bj][m][n], 0, 0, 0); } \
        __builtin_amdgcn_s_setprio(0); } while (0)
#define PG8_WAIT_V(n) asm volatile("s_waitcnt vmcnt(" #n ")" ::: "memory")
#define PG8_WAIT_L(n) asm volatile("s_waitcnt lgkmcnt(" #n ")" ::: "memory")
#define PG8_BAR __builtin_amdgcn_s_barrier()
#define PG8_SCHED __builtin_amdgcn_sched_barrier(0)
#define PG8_GLOAD(dst, u) do { _Pragma("unroll") for (int _h = 0; _h < 2; ++_h) _Pragma("unroll") for (int _i = 0; _i < 2; ++_i) { const int _r = _h * HALF + RA[_i]; \
        const int _rc = _r < (u).nvalid ? _r : (u).nvalid - 1; const int _tl = (u).rows[_rc]; const int _t = (_r < (u).nvalid) ? _tl : 0; dst[_h][_i] = (unsigned)(_t * lda + CA[_i]) * 2u; } } while (0)
    Unit cur, nxt; int ui = 0;
    if (!S.next(0, cur)) return;
    f32x4 acc[2][2][4][2];
#pragma unroll
    for (int a = 0; a < 2; ++a)
#pragma unroll
        for (int b = 0; b < 2; ++b)
#pragma unroll
            for (int m = 0; m < 4; ++m)
#pragma unroll
                for (int n = 0; n < 2; ++n) acc[a][b][m][n] = (f32x4){0.f, 0.f, 0.f, 0.f};
    const unsigned f8scale = 0x7f7f7f7fu;
    bf16x8 At[4][2], B0[2][2], B1[2][2]; v8i_t At8[4], B08[2], B18[2];
    const char* cA = cur.A; const char* cB = cur.B;
    if constexpr (GATHER) { PG8_GLOAD(gA, cur); PG8_WAIT_V(0); }
    PG8_STAGE_B(PG8_SB(0, 0), cB); PG8_STAGE_B(PG8_SB(0, 1), cB + hstepB); PG8_STAGE_A(PG8_SA(0, 0), cA, 0); PG8_STAGE_A(PG8_SA(0, 1), cA, 1);
    if (wr == 1) PG8_BAR;
    PG8_WAIT_V(2); PG8_BAR;
    PG8_STAGE_B(PG8_SB(1, 0), cB + kstep); PG8_STAGE_A(PG8_SA(1, 0), cA + kstep, 0); PG8_STAGE_B(PG8_SB(1, 1), cB + hstepB + kstep);
    PG8_WAIT_V(6); PG8_BAR;
    for (;;) {
        const bool has_next = S.next(ui + 1, nxt); const bool halfu = Sched::RAGGED && cur.half != 0;
        const char* nA = has_next ? nxt.A : cA; const char* nB = has_next ? nxt.B : cB;
        if constexpr (GATHER) { if (has_next) { PG8_GLOAD(gN, nxt); } else {
#pragma unroll
            for (int h = 0; h < 2; ++h)
#pragma unroll
                for (int i = 0; i < 2; ++i) gN[h][i] = gA[h][i]; } }
#pragma unroll 1
        for (int t = 0; t < nt; t += 2) {
            const bool last = (t == nt - 2);
            const char* a1 = cA + (size_t)(t + 1) * kstep;
            const char* a2 = last ? nA : cA + (size_t)(t + 2) * kstep; const char* b2 = last ? nB : cB + (size_t)(t + 2) * kstep;
            const char* a3 = a2 + kstep; const char* b3 = b2 + kstep;
            PG8_LDB(B0, 0, 0); PG8_LDB(B1, 0, 1); PG8_SCHED; PG8_LDA(At, 0, 0); PG8_STAGE_A(PG8_SA(1, 1), a1, 1);
            if constexpr (GATHER) { if (last) {
#pragma unroll
                for (int h = 0; h < 2; ++h)
#pragma unroll
                    for (int i = 0; i < 2; ++i) gA[h][i] = gN[h][i]; } }
            PG8_WAIT_V(8); PG8_WAIT_L(0); PG8_BAR; PG8_MMA(0, 0, At, B0); PG8_MMA(0, 1, At, B1); PG8_BAR; PG8_SCHED;
            if (!halfu) PG8_LDA(At, 0, 1); PG8_STAGE_B(PG8_SB(0, 0), b2); PG8_STAGE_B(PG8_SB(0, 1), b2 + hstepB); PG8_STAGE_A(PG8_SA(0, 0), a2, 0);
            PG8_WAIT_V(8); PG8_WAIT_L(0); PG8_BAR; if (!halfu) { PG8_MMA(1, 0, At, B0); PG8_MMA(1, 1, At, B1); } PG8_BAR; PG8_SCHED;
            PG8_LDB(B0, 1, 0); PG8_LDB(B1, 1, 1); PG8_SCHED; PG8_LDA(At, 1, 0); PG8_STAGE_A(PG8_SA(0, 1), a2, 1);
            PG8_WAIT_V(8); PG8_WAIT_L(0); PG8_BAR; PG8_MMA(0, 0, At, B0); PG8_MMA(0, 1, At, B1); PG8_BAR; PG8_SCHED;
            if (!halfu) PG8_LDA(At, 1, 1); PG8_STAGE_B(PG8_SB(1, 0), b3); PG8_STAGE_B(PG8_SB(1, 1), b3 + hstepB); PG8_STAGE_A(PG8_SA(1, 0), a3, 0);
            PG8_WAIT_V(8); PG8_WAIT_L(0); PG8_BAR; if (!halfu) { PG8_MMA(1, 0, At, B0); PG8_MMA(1, 1, At, B1); } PG8_BAR; PG8_SCHED;
        }
        if (wr == 0) PG8_BAR;
        if constexpr (FP8) asm volatile("s_nop 15\n\ts_nop 15\n\ts_nop 15" ::: "memory");
        E(acc, cur, wr, wc, fr, fq);
        if (!has_next) break;
#pragma unroll
        for (int a = 0; a < 2; ++a)
#pragma unroll
            for (int b = 0; b < 2; ++b)
#pragma unroll
                for (int m = 0; m < 4; ++m)
#pragma unroll
                    for (int n = 0; n < 2; ++n) acc[a][b][m][n] = (f32x4){0.f, 0.f, 0.f, 0.f};
        cur = nxt; cA = nA; cB = nB; ++ui;
        if (wr == 1) PG8_BAR;
    }
    PG8_WAIT_V(0);
    PG8_BAR;
#undef PG8_SA
#undef PG8_SB
#undef PG8_STAGE_A
#undef PG8_STAGE_B
#undef PG8_LDA
#undef PG8_LDB
#undef PG8_MMA
#undef PG8_CAT
#undef PG8_WAIT_V
#undef PG8_WAIT_L
#undef PG8_BAR
#undef PG8_SCHED
#undef PG8_GLOAD
}
}

constexpr int NB = 4, SEQ = 4096, D = 2048, DEPTH = 2;
constexpr int T = NB * SEQ;
constexpr int NH = 8, HD = 128, DNW = 1024, CH = 64, NCH = SEQ / CH;
constexpr int PW = 1024, PG_DIM = 256;
constexpr int IN_COLS = 5136, NPROJ = 5120;
constexpr int NE = 16, DE = 1024, PLE = 256;
constexpr float ALPHA = 1.4142135623730951f;
constexpr float LN_EPS = 1e-5f, RMS_EPS = 1e-6f;
constexpr int LCAP = T;
constexpr int MAXTILES = 2 * T / 256 + NE;

constexpr size_t MiB = 1u << 20;
constexpr size_t WS_CTL = 0, CTL_ZERO_BYTES = 64 * 1024;
constexpr size_t WS_LIST = 2 * MiB;
constexpr size_t WS_TOKSLOT = 3 * MiB, WS_GATEW = WS_TOKSLOT + 128 * 1024, WS_STATS = WS_GATEW + 128 * 1024, WS_CD = WS_STATS + 128 * 1024, WS_WBA = WS_CD + 128 * 1024;
constexpr size_t WS_WIN = 4 * MiB, WS_WOUT = 44 * MiB, WS_WPG = 60 * MiB, WS_WPP = 76 * MiB, WS_WPOOL = 78 * MiB, WS_WGU = 80 * MiB, WS_WD = 336 * MiB, WS_PB16 = 464 * MiB;
constexpr size_t WS_XB = 480 * MiB, WS_R1 = 544 * MiB, WS_R2 = 704 * MiB, WS_R4 = 848 * MiB, WS_R5 = 944 * MiB, WS_END = 1008 * MiB;
constexpr size_t WS_PROJ = WS_R1, WS_HID = WS_R1;
constexpr size_t WS_Y = WS_R2;
constexpr size_t WS_POOLD = WS_R4, WS_PP = WS_R4 + 32 * MiB, WS_X1B = WS_R2;
constexpr size_t WS_MIXIN = WS_R5, WS_X2B = WS_R5;
constexpr size_t WS_X2F8 = WS_R1 + 96 * MiB;
static_assert((size_t)MAXTILES * 256 * 2048 * 2 <= 144 * MiB && (size_t)MAXTILES * 256 * 1024 * 2 <= 160 * MiB, "MoE row buffers");
constexpr int CW_TMO = 0, CW_CODE = 1, CW_CNT = 64  , CW_CONV = 512  , CW_BAR = 4096;

constexpr int RING_OFF = 0, RING_BYTES = 131072;
constexpr int LDSCTL_OFF = 152 * 1024, MISC_OFF = LDSCTL_OFF + 320;
constexpr int AUX_OFF = LDSCTL_OFF + 1024;
constexpr int LDS_BYTES = 163840;
constexpr int NWAVES = 8;

#define RLX_AGENT __ATOMIC_RELAXED, __HIP_MEMORY_SCOPE_AGENT
#define LDS_WAIT() asm volatile("s_waitcnt lgkmcnt(0)" ::: "memory")
#define VM_WAIT() asm volatile("s_waitcnt vmcnt(0)" ::: "memory")
__device__ __forceinline__ unsigned f2bf(float f) { unsigned u = __builtin_bit_cast(unsigned, f); return (u + 0x7fffu + ((u >> 16) & 1u)) >> 16; }
__device__ __forceinline__ unsigned pk2(float lo, float hi) { return f2bf(lo) | (f2bf(hi) << 16); }
typedef __bf16 bf2_t __attribute__((ext_vector_type(2)));
__device__ __forceinline__ unsigned pkbf(float lo, float hi) { const f32x2 v = {lo, hi}; return __builtin_bit_cast(unsigned, __builtin_convertvector(v, bf2_t)); }
constexpr float F8_XS = 16.0f, F8_WS = 256.0f, F8_INV = 1.0f / 4096.0f;
__device__ __forceinline__ float f8clamp(float x) { return fminf(fmaxf(x, -448.0f), 448.0f); }
__device__ __forceinline__ unsigned pk4_fp8(float a, float b, float c, float d) { unsigned w = 0u; w = (unsigned)__builtin_amdgcn_cvt_pk_fp8_f32(f8clamp(a), f8clamp(b), (int)w, false); w = (unsigned)__builtin_amdgcn_cvt_pk_fp8_f32(f8clamp(c), f8clamp(d), (int)w, true); return w; }
__device__ __forceinline__ float bf2f(unsigned short b) { return __builtin_bit_cast(float, ((unsigned)b) << 16); }
__device__ __forceinline__ float bflo(unsigned w) { return __builtin_bit_cast(float, w << 16); }
__device__ __forceinline__ float bfhi(unsigned w) { return __builtin_bit_cast(float, w & 0xffff0000u); }
__device__ __forceinline__ float sigmoidf_(float x) { return __builtin_amdgcn_rcpf(1.0f + __expf(-x)); }
template <int CTRL> __device__ __forceinline__ float dpp_(float x) { return __builtin_bit_cast(float, __builtin_amdgcn_mov_dpp(__builtin_bit_cast(int, x), CTRL, 0xf, 0xf, true)); }
constexpr int DPP_XOR1 = 0xB1, DPP_XOR2 = 0x4E, DPP_HMIRROR = 0x141, DPP_XOR8 = 0x128;
__device__ __forceinline__ float xrow16_sum(float x) {
    float p = x, q = x; asm volatile("v_nop\n\tv_nop\n\tv_permlane16_swap_b32 %0, %1" : "+v"(p), "+v"(q));
    x = p + q;
    float r = x, s = x; asm volatile("v_nop\n\tv_nop\n\tv_permlane32_swap_b32 %0, %1" : "+v"(r), "+v"(s));
    return r + s;
}
#ifdef OLD_SHUFFLES
__device__ __forceinline__ float row8_sum(float v) { v += __shfl_xor(v, 1); v += __shfl_xor(v, 2); v += __shfl_xor(v, 4); return v; }
__device__ __forceinline__ float wave_sum(float v) {
#pragma unroll
    for (int o = 1; o < 64; o <<= 1) v += __shfl_xor(v, o);
    return v; }
#else
__device__ __forceinline__ float row8_sum(float v) { v += dpp_<DPP_XOR1>(v); v += dpp_<DPP_XOR2>(v); v += dpp_<DPP_HMIRROR>(v); return v; }
__device__ __forceinline__ float wave_sum(float v) { v = row8_sum(v); v += dpp_<DPP_XOR8>(v); return xrow16_sum(v); }
#endif
#define XB_TMO      128
#define XB_XCNT(j)  (256  + 64 * (j))
#define XB_XSUB(j)  (1280 + 64 * (j))
#define XB_XGEN(j)  (2304 + 64 * (j))
#define XB_TOP      3328
#define XB_TOPGEN   3392
#define XCD_BAR_WORDS 3456
#define XB_SPIN_CAP (1u << 18)

__device__ __forceinline__ unsigned xb_ld(unsigned* p)              { return __hip_atomic_load(p, __ATOMIC_RELAXED, __HIP_MEMORY_SCOPE_AGENT); }
__device__ __forceinline__ unsigned xb_add(unsigned* p, unsigned v) { return __hip_atomic_fetch_add(p, v, __ATOMIC_RELAXED, __HIP_MEMORY_SCOPE_AGENT); }
__device__ __forceinline__ unsigned xb_xcc_id() { return (unsigned)__builtin_amdgcn_s_getreg((3 << 11) | 20) & 0xFu; }
#define XB_SPIN(cond, bar) do { unsigned _sp = 0; while (cond) { __builtin_amdgcn_s_sleep(1); \
    if ((++_sp & 255u) == 0u) { if (xb_ld(&(bar)[XB_TMO])) break; if (_sp > XB_SPIN_CAP) { atomicAdd(&(bar)[XB_TMO], 1u); break; } } } } while (0)

struct XcdBarrier {
    unsigned* bar; unsigned x;
    volatile LAS unsigned* st;
};

__device__ __forceinline__ XcdBarrier xcd_barrier_post(unsigned* bar, volatile LAS unsigned* st) {
    XcdBarrier b; b.bar = bar; b.x = xb_xcc_id(); b.st = st;
    if (threadIdx.x == 0) (void)xb_add(&bar[XB_XCNT(b.x)], 1u);
    return b;
}
__device__ __forceinline__ void xcd_barrier_complete(unsigned* bar, unsigned x, unsigned& nloc, unsigned& nx) {
    const unsigned G = gridDim.x * gridDim.y * gridDim.z;
    unsigned sum, cnt, mine, sp = 0u;
    for (;;) {
        sum = 0u; cnt = 0u; mine = 0u;
#pragma unroll
        for (unsigned j = 0; j < 16; ++j) { const unsigned c = xb_ld(&bar[XB_XCNT(j)]); sum += c; cnt += (c > 0u) ? 1u : 0u; mine = (j == x) ? c : mine; }
        if (sum == G) break;
        __builtin_amdgcn_s_sleep(1);
        if ((++sp & 255u) == 0u) { if (xb_ld(&bar[XB_TMO])) break; if (sp > XB_SPIN_CAP) { atomicAdd(&bar[XB_TMO], 1u); break; } }
    }
    nloc = mine > 0u ? mine : 1u; nx = cnt > 0u ? cnt : 1u;
}

__device__ __forceinline__ void xcd_barrier(const XcdBarrier& b) {
    asm volatile("s_waitcnt vmcnt(0)" ::: "memory");
    __syncthreads();
    if (threadIdx.x == 0) {
        unsigned* bar = b.bar;
        __builtin_amdgcn_s_waitcnt(0);
        unsigned nloc = b.st[0], nx = b.st[1];
        if (nloc == 0u) { xcd_barrier_complete(bar, b.x, nloc, nx); b.st[0] = nloc; b.st[1] = nx; }
        const unsigned old = xb_add(&bar[XB_XSUB(b.x)], 1u);
        const unsigned gen = old / nloc;
        if (old + 1u == (gen + 1u) * nloc) {
            __builtin_amdgcn_fence(__ATOMIC_RELEASE, "agent");
            asm volatile("s_waitcnt vmcnt(0)" ::: "memory");
            const unsigned og = xb_add(&bar[XB_TOP], 1u);
            const unsigned tg = og / nx;
            if (og + 1u == (tg + 1u) * nx) xb_add(&bar[XB_TOPGEN], 1u);
            else XB_SPIN(xb_ld(&bar[XB_TOPGEN]) == tg, bar);
            __builtin_amdgcn_fence(__ATOMIC_ACQUIRE, "agent");
            xb_add(&bar[XB_XGEN(b.x)], 1u);
            asm volatile("s_waitcnt vmcnt(0)" ::: "memory");
        } else {
            XB_SPIN(xb_ld(&bar[XB_XGEN(b.x)]) == gen, bar);
            __builtin_amdgcn_fence(__ATOMIC_ACQUIRE, "agent");
            asm volatile("s_waitcnt vmcnt(0)" ::: "memory");
        }
    }
    __syncthreads();
}

struct Args { const float* in[21]; float* out; unsigned char* ws; int ph_lo, ph_hi, li, pad; };
enum { I_X = 0, I_P, I_WIN, I_CONVW, I_ALOG, I_DTB, I_NORMW, I_POOLW, I_POOLS, I_WOUT, I_LN1G, I_LN1B, I_WR, I_BR, I_WEG, I_WEU, I_WED, I_LN2G, I_LN2B, I_WPP, I_WPG };
struct Frame {
    LAS unsigned char* lds;
    volatile LAS unsigned* MISC;
    gu32* ctl;
    int tid, lane, wave, vcu, G;
};

#ifndef FP8_LAST
#define FP8_LAST 1
#endif
#ifndef FP8_PG
#define FP8_PG 0
#endif
#ifndef FP8_ALL
#define FP8_ALL 0
#endif
#ifndef FP8_PD
#define FP8_PD 0
#endif
#ifndef FP8_PD_ALL
#define FP8_PD_ALL 0
#endif
#define FP8_PDL(l) (FP8_PD && (FP8_PD_ALL || (l) == DEPTH - 1))
#ifndef FP8_PI0
#define FP8_PI0 0
#endif
#define FP8_LAYER(l) (FP8_LAST && (FP8_ALL || (l) == DEPTH - 1))
#ifndef FP8_PI
#define FP8_PI 0
#endif
#define PHASE_FRAME(F0) Frame F = F0; { int t_ = threadIdx.x; asm volatile("" : "+v"(t_)); F.tid = t_; F.lane = t_ & 63; }
#define OPQ_S(p) asm volatile("" : "+s"(p))
#define OPQ_G(T, expr) ({ GAS T* g_ = (GAS T*)(expr); asm volatile("" : "+s"(g_)); (T*)g_; })
struct SchedDense {
    static constexpr bool RAGGED = false;
    int nM, nN, nwg, G, c; const char* A; const char* B; size_t astep, bstep;
    __device__ __forceinline__ void init(int M, int N, int G_, int c_, const void* A_, int lda, const void* B_, int ldb) { nM = M / 256; nN = N / 256; nwg = nM * nN; G = G_; c = c_;
        A = (const char*)A_; B = (const char*)B_; astep = (size_t)256 * lda * 2; bstep = (size_t)256 * ldb * 2; }
    __device__ __forceinline__ bool next(int i, pg8::Unit& u) const {
        const long L = (long)i * G + c; if (L >= nwg) return false;
        int wgid = (int)L; { const int q = nwg / 8, r = nwg % 8, xcd = wgid % 8, off = wgid / 8; wgid = (xcd < r ? xcd * (q + 1) : r * (q + 1) + (xcd - r) * q) + off; }
        const int nig = 8 * nN, gid = wgid / nig, fm = gid * 8, gsz = (nM - fm) < 8 ? (nM - fm) : 8;
        u.pm = fm + ((wgid % nig) % gsz); u.pn = (wgid % nig) / gsz;
        u.A = A + (size_t)u.pm * astep; u.B = B + (size_t)u.pn * bstep; u.rows = nullptr; u.nvalid = 256; u.aux = 0; u.rowbase = u.pm * 256; u.half = 0; return true;
    }
};
struct SchedPool {
    static constexpr bool RAGGED = false;
    int G, c; const char* A; const char* B;
    __device__ __forceinline__ bool next(int i, pg8::Unit& u) const {
        const int L = i * G + c; if (L >= 256) return false;
        u.pm = L >> 2; u.pn = L & 3; u.A = A + ((size_t)u.pm * 256 * PW + u.pn * 256) * 2; u.B = B + (size_t)u.pn * 65536 * 2; u.rows = nullptr; u.nvalid = 256; u.aux = 0; u.rowbase = u.pm * 256; u.half = 0; return true;
    }
};
struct SchedMoe {
    static constexpr bool RAGGED = true;
    int G, c, mode; const LAS int* tab; const char* A; const char* B; const int* list; int esz;
    __device__ __forceinline__ bool next(int i, pg8::Unit& u) const {
        const int L = i * G + c, nf = __builtin_amdgcn_readfirstlane(tab[64]), nh = __builtin_amdgcn_readfirstlane(tab[96]);
        if (L >= 8 * (nf + nh)) return false;
        const bool half = L >= 8 * nf; const int t = (half ? L - 8 * nf : L) >> 3, pn = L & 7, pbase = half ? 80 : 48;
        int e = 0;
#pragma unroll
        for (int k = 1; k < 16; ++k) { const int ts = __builtin_amdgcn_readfirstlane(tab[pbase + k]); if (t >= ts) e = k; }
        const int tl = t - __builtin_amdgcn_readfirstlane(tab[pbase + e]), cn = __builtin_amdgcn_readfirstlane(tab[32 + e]), blk = __builtin_amdgcn_readfirstlane(tab[e]);
        const int p0 = half ? ((cn >> 8) << 8) + 128 * tl : 256 * tl;
        u.pm = 0; u.pn = pn; u.aux = e; u.half = half ? 1 : 0; u.rowbase = blk * 128 + p0;
        const int nv = cn - p0; u.nvalid = nv < (half ? 128 : 256) ? nv : (half ? 128 : 256);
        if (mode == 0) { u.A = A; u.rows = list + (size_t)e * LCAP + p0; u.B = B + ((size_t)e * 2048 + pn * 256) * 2048 * esz; }
        else { u.A = A + (size_t)u.rowbase * DE * esz; u.rows = nullptr; u.B = B + ((size_t)e * 2048 + pn * 256) * DE * esz; }
        return true;
    }
};

using pg8::cvt_pk_bf16;
struct EpiBf16 {
    static constexpr bool PERM = true; bf16* O; int ldc; float scale = 1.0f;
    __device__ __forceinline__ void operator()(const f32x4 (&acc)[2][2][4][2], const pg8::Unit& u, int wr, int wc, int fr, int fq) const {
        const int row0 = u.rowbase + wr * 64 + fr, col0 = u.pn * 256 + wc * 32 + 8 * fq;
#pragma unroll
        for (int ai = 0; ai < 2; ++ai) if (ai == 0 || !u.half)
#pragma unroll
            for (int m = 0; m < 4; ++m) { bf16* rowp = O + (size_t)(row0 + ai * 128 + m * 16) * ldc + col0;
#pragma unroll
                for (int bj = 0; bj < 2; ++bj) { const f32x4 v0 = acc[ai][bj][m][0] * scale, v1 = acc[ai][bj][m][1] * scale;
                    v4u w; w.x = cvt_pk_bf16(v0[0], v0[1]); w.y = cvt_pk_bf16(v0[2], v0[3]); w.z = cvt_pk_bf16(v1[0], v1[1]); w.w = cvt_pk_bf16(v1[2], v1[3]);
                    *(v4u*)(rowp + bj * 128) = w; } }
    }
};
struct EpiPool {
    static constexpr bool PERM = true; bf16* O; const float* scale; int f8 = 0;
    __device__ __forceinline__ void operator()(const f32x4 (&acc)[2][2][4][2], const pg8::Unit& u, int wr, int wc, int fr, int fq) const {
        const int row0 = u.rowbase + wr * 64 + fr, cg = u.pn * 256 + wc * 32 + 8 * fq;
        f32x4 sv[2][2];
#pragma unroll
        for (int bj = 0; bj < 2; ++bj) { sv[bj][0] = *(const f32x4*)(scale + cg + bj * 128); sv[bj][1] = *(const f32x4*)(scale + cg + bj * 128 + 4); }
#pragma unroll
        for (int ai = 0; ai < 2; ++ai)
#pragma unroll
            for (int m = 0; m < 4; ++m) { bf16* rowp = O + (size_t)(row0 + ai * 128 + m * 16) * D + DNW + cg;
#pragma unroll
                for (int bj = 0; bj < 2; ++bj) { const f32x4 v0 = acc[ai][bj][m][0] * sv[bj][0], v1 = acc[ai][bj][m][1] * sv[bj][1];
                    if (f8) { v2u w8; w8.x = pk4_fp8(v0[0] * F8_XS, v0[1] * F8_XS, v0[2] * F8_XS, v0[3] * F8_XS); w8.y = pk4_fp8(v1[0] * F8_XS, v1[1] * F8_XS, v1[2] * F8_XS, v1[3] * F8_XS);
                        *(v2u*)((unsigned char*)O + (size_t)(row0 + ai * 128 + m * 16) * D + DNW + cg + bj * 128) = w8; }
                    else { v4u w; w.x = cvt_pk_bf16(v0[0], v0[1]); w.y = cvt_pk_bf16(v0[2], v0[3]); w.z = cvt_pk_bf16(v1[0], v1[1]); w.w = cvt_pk_bf16(v1[2], v1[3]);
                    *(v4u*)(rowp + bj * 128) = w; } } }
    }
};
struct EpiRes {
    static constexpr bool PERM = true; const bf16* XB; bf16* PRE; float ascale = 1.0f;
    __device__ __forceinline__ void operator()(const f32x4 (&acc)[2][2][4][2], const pg8::Unit& u, int wr, int wc, int fr, int fq) const {
        const int row0 = u.rowbase + wr * 64 + fr, col0 = u.pn * 256 + wc * 32 + 8 * fq;
#pragma unroll
        for (int ai = 0; ai < 2; ++ai) { v4u xq[4][2];
#pragma unroll
            for (int m = 0; m < 4; ++m)
#pragma unroll
                for (int bj = 0; bj < 2; ++bj) xq[m][bj] = *(const v4u*)(XB + (size_t)(row0 + ai * 128 + m * 16) * D + col0 + bj * 128);
            asm volatile("" : "+v"(xq[0][0]), "+v"(xq[0][1]), "+v"(xq[1][0]), "+v"(xq[1][1]), "+v"(xq[2][0]), "+v"(xq[2][1]), "+v"(xq[3][0]), "+v"(xq[3][1]));
#pragma unroll
            for (int m = 0; m < 4; ++m)
#pragma unroll
                for (int bj = 0; bj < 2; ++bj) { const size_t off = (size_t)(row0 + ai * 128 + m * 16) * D + col0 + bj * 128; const v4u x = xq[m][bj]; const f32x4 a0 = acc[ai][bj][m][0] * ascale, a1 = acc[ai][bj][m][1] * ascale;
                    v4u w; w.x = cvt_pk_bf16(bflo(x.x) * ALPHA + a0[0], bfhi(x.x) * ALPHA + a0[1]); w.y = cvt_pk_bf16(bflo(x.y) * ALPHA + a0[2], bfhi(x.y) * ALPHA + a0[3]);
                    w.z = cvt_pk_bf16(bflo(x.z) * ALPHA + a1[0], bfhi(x.z) * ALPHA + a1[1]); w.w = cvt_pk_bf16(bflo(x.w) * ALPHA + a1[2], bfhi(x.w) * ALPHA + a1[3]);
                    *(v4u*)(PRE + off) = w; } }
    }
};
struct EpiSwiglu {
    static constexpr bool PERM = true; bf16* O; int f8 = 0; float ascale = 1.0f;
    __device__ __forceinline__ void operator()(const f32x4 (&acc)[2][2][4][2], const pg8::Unit& u, int wr, int wc, int fr, int fq) const {
        const int row0 = u.rowbase + wr * 64 + fr, col0 = u.pn * 128 + wc * 32 + 8 * fq;
#pragma unroll
        for (int ai = 0; ai < 2; ++ai) if (ai == 0 || !u.half)
#pragma unroll
            for (int m = 0; m < 4; ++m) { bf16* rowp = O + (size_t)(row0 + ai * 128 + m * 16) * DE + col0;
                float h[8];
#pragma unroll
                for (int n = 0; n < 2; ++n)
#pragma unroll
                    for (int j = 0; j < 4; ++j) { const float g = acc[ai][0][m][n][j] * ascale, up = acc[ai][1][m][n][j] * ascale; h[4 * n + j] = g * sigmoidf_(g) * up; }
                if (f8) { v2u w8; w8.x = pk4_fp8(h[0] * F8_XS, h[1] * F8_XS, h[2] * F8_XS, h[3] * F8_XS); w8.y = pk4_fp8(h[4] * F8_XS, h[5] * F8_XS, h[6] * F8_XS, h[7] * F8_XS);
                    *(v2u*)((unsigned char*)O + (size_t)(row0 + ai * 128 + m * 16) * DE + col0) = w8; }
                else { v4u w; w.x = cvt_pk_bf16(h[0], h[1]); w.y = cvt_pk_bf16(h[2], h[3]); w.z = cvt_pk_bf16(h[4], h[5]); w.w = cvt_pk_bf16(h[6], h[7]);
                *(v4u*)rowp = w; } }
    }
};
struct EpiPle {
    static constexpr bool PERM = true; const bf16* X2B; const bf16* PP; bf16* XB; float* OUT; int last; float ascale = 1.0f;
    __device__ __forceinline__ void operator()(const f32x4 (&acc)[2][2][4][2], const pg8::Unit& u, int wr, int wc, int fr, int fq) const {
        const int row0 = u.rowbase + wr * 64 + fr, col0 = u.pn * 256 + wc * 32 + 8 * fq;
#pragma unroll
        for (int ai = 0; ai < 2; ++ai)
#pragma unroll
            for (int mp = 0; mp < 2; ++mp) { v4u xq[2][2], pq[2][2];
#pragma unroll
                for (int mm = 0; mm < 2; ++mm)
#pragma unroll
                    for (int bj = 0; bj < 2; ++bj) { const size_t off = (size_t)(row0 + ai * 128 + (2 * mp + mm) * 16) * D + col0 + bj * 128; xq[mm][bj] = *(const v4u*)(X2B + off); pq[mm][bj] = *(const v4u*)(PP + off); }
                asm volatile("" : "+v"(xq[0][0]), "+v"(xq[0][1]), "+v"(xq[1][0]), "+v"(xq[1][1]), "+v"(pq[0][0]), "+v"(pq[0][1]), "+v"(pq[1][0]), "+v"(pq[1][1]));
#pragma unroll
                for (int mm = 0; mm < 2; ++mm)
#pragma unroll
                    for (int bj = 0; bj < 2; ++bj) { const int m = 2 * mp + mm; const size_t off = (size_t)(row0 + ai * 128 + m * 16) * D + col0 + bj * 128;
                        const v4u xx = xq[mm][bj], pp = pq[mm][bj];
                        const f32x4 a0 = acc[ai][bj][m][0] * ascale, a1 = acc[ai][bj][m][1] * ascale;
                        f32x4 o0, o1;
                        o0[0] = bflo(xx.x) + sigmoidf_(a0[0]) * bflo(pp.x); o0[1] = bfhi(xx.x) + sigmoidf_(a0[1]) * bfhi(pp.x); o0[2] = bflo(xx.y) + sigmoidf_(a0[2]) * bflo(pp.y); o0[3] = bfhi(xx.y) + sigmoidf_(a0[3]) * bfhi(pp.y);
                        o1[0] = bflo(xx.z) + sigmoidf_(a1[0]) * bflo(pp.z); o1[1] = bfhi(xx.z) + sigmoidf_(a1[1]) * bfhi(pp.z); o1[2] = bflo(xx.w) + sigmoidf_(a1[2]) * bflo(pp.w); o1[3] = bfhi(xx.w) + sigmoidf_(a1[3]) * bfhi(pp.w);
                        if (last) { *(f32x4*)(OUT + off) = o0; *(f32x4*)(OUT + off + 4) = o1; }
                        else { v4u w; w.x = cvt_pk_bf16(o0[0], o0[1]); w.y = cvt_pk_bf16(o0[2], o0[3]); w.z = cvt_pk_bf16(o1[0], o1[1]); w.w = cvt_pk_bf16(o1[2], o1[3]); *(v4u*)(XB + off) = w; } } }
    }
};

__device__ __forceinline__ void tr_item(const float* W, int ldw, int k0, int n0, bf16* WT, size_t drow0, int ldt, LAS float* scr, int lane) {
#pragma unroll 8
    for (int i = 0; i < 32; ++i) { const int kk = 2 * i + (lane >> 5); scr[kk * 33 + (lane & 31)] = W[(size_t)(k0 + kk) * ldw + n0 + (lane & 31)]; }
    LDS_WAIT(); asm volatile("" ::: "memory");
    const int c = lane & 7;
#pragma unroll
    for (int j = 0; j < 4; ++j) { const int n = (lane >> 3) + 8 * j; const LAS float* s = scr + (8 * c) * 33 + n;
        v4u o; o.x = pk2(s[0 * 33], s[1 * 33]); o.y = pk2(s[2 * 33], s[3 * 33]); o.z = pk2(s[4 * 33], s[5 * 33]); o.w = pk2(s[6 * 33], s[7 * 33]);
        *(GAS v4u*)(WT + (drow0 + n) * ldt + k0 + 8 * c) = o; }
    LDS_WAIT(); asm volatile("" ::: "memory");
}
__device__ __forceinline__ void tr_item8(const float* W, int ldw, int k0, int n0, unsigned char* WT, size_t drow0, int ldt, LAS float* scr, int lane) {
#pragma unroll 8
    for (int i = 0; i < 32; ++i) { const int kk = 2 * i + (lane >> 5); scr[kk * 33 + (lane & 31)] = W[(size_t)(k0 + kk) * ldw + n0 + (lane & 31)]; }
    LDS_WAIT(); asm volatile("" ::: "memory");
    const int c = lane & 7;
#pragma unroll
    for (int j = 0; j < 4; ++j) { const int n = (lane >> 3) + 8 * j; const LAS float* s = scr + (8 * c) * 33 + n;
        v2u o; o.x = pk4_fp8(s[0 * 33] * F8_WS, s[1 * 33] * F8_WS, s[2 * 33] * F8_WS, s[3 * 33] * F8_WS); o.y = pk4_fp8(s[4 * 33] * F8_WS, s[5 * 33] * F8_WS, s[6 * 33] * F8_WS, s[7 * 33] * F8_WS);
        *(GAS v2u*)(WT + (drow0 + n) * ldt + k0 + 8 * c) = o; }
    LDS_WAIT(); asm volatile("" ::: "memory");
}
__device__ __forceinline__ void weight_items(const Args& a, unsigned char* ws, LAS float* scr, int lane, int group, int l, int gw, int NGW, gu32* ctr = nullptr) {
    constexpr int I_INA = 32 * 128, I_INB = 32 * 32, I_OUT = 32 * 64, I_PG = 32 * 64, I_PP = 4 * 64, I_POOL = 4 * 32, I_EG = NE * 32 * 32, I_EU = I_EG, I_ED = NE * 16 * 64;
    if (group == 0) {
        for (int it = gw; it < I_INA + I_INB + I_PP + I_POOL; it += NGW) { int r = it;
            if (r < I_INA) { const int kb = r / 128, nb = r % 128; tr_item(a.in[I_WIN] + (size_t)l * D * IN_COLS, IN_COLS, 64 * kb, 32 * nb, (bf16*)(ws + WS_WIN) + (size_t)l * NPROJ * D, 32 * nb, D, scr, lane); continue; } r -= I_INA;
            if (r < I_INB) { const int kb = r / 32, nb = r % 32; tr_item(a.in[I_WIN] + (size_t)l * D * IN_COLS, IN_COLS, 64 * kb, 4112 + 32 * nb, (bf16*)(ws + WS_WIN) + (size_t)l * NPROJ * D, 4096 + 32 * nb, D, scr, lane); continue; } r -= I_INB;
            if (r < I_PP) { const int kb = r / 64, nb = r % 64; tr_item(a.in[I_WPP] + (size_t)l * PLE * D, D, 64 * kb, 32 * nb, (bf16*)(ws + WS_WPP) + (size_t)l * D * PLE, 32 * nb, PLE, scr, lane); continue; } r -= I_PP;
            { const int g = r / 32, rr = r % 32, kb = rr / 8, nb = rr % 8; tr_item(a.in[I_POOLW] + ((size_t)l * 4 + g) * 65536, 256, 64 * kb, 32 * nb, (bf16*)(ws + WS_WPOOL) + ((size_t)l * 4 + g) * 65536, 32 * nb, 256, scr, lane); } }
    } else {
        const bool f8 = FP8_LAYER(l);
        constexpr int NIT = I_OUT + I_PG + I_EG + I_EU + I_ED;
        int it = gw - NGW, kk = 8; unsigned cb = 0u;
        for (;;) {
            if (ctr) { if (kk == 8) { unsigned b = 0u; if (lane == 0) b = __hip_atomic_fetch_add(ctr, 8u, RLX_AGENT); cb = (unsigned)__builtin_amdgcn_readfirstlane((int)b); kk = 0; if (cb >= (unsigned)NIT) break; }
                it = (int)cb + kk; ++kk; if (it >= NIT) continue; }
            else { it += NGW; if (it >= NIT) break; }
            int r = it;
            if (r < I_OUT) { const int kb = r / 64, nb = r % 64; if (FP8_PDL(l)) tr_item8(a.in[I_WOUT] + (size_t)l * D * D, D, 64 * kb, 32 * nb, ws + WS_WOUT + (size_t)l * D * D * 2, 32 * nb, D, scr, lane); else tr_item(a.in[I_WOUT] + (size_t)l * D * D, D, 64 * kb, 32 * nb, (bf16*)(ws + WS_WOUT) + (size_t)l * D * D, 32 * nb, D, scr, lane); continue; } r -= I_OUT;
            if (r < I_PG) { const int kb = r / 64, nb = r % 64; if (FP8_PI && (FP8_PI0 || l == DEPTH - 1)) tr_item8(a.in[I_WPG] + (size_t)l * D * D, D, 64 * kb, 32 * nb, ws + WS_WPG + (size_t)l * D * D * 2, 32 * nb, D, scr, lane); else tr_item(a.in[I_WPG] + (size_t)l * D * D, D, 64 * kb, 32 * nb, (bf16*)(ws + WS_WPG) + (size_t)l * D * D, 32 * nb, D, scr, lane); continue; } r -= I_PG;
            if (r < I_EG) { const int e = r / 1024, rr = r % 1024, kb = rr / 32, nb = rr % 32, h0 = 32 * nb;
                if (f8) tr_item8(a.in[I_WEG] + ((size_t)l * NE + e) * D * DE, DE, 64 * kb, h0, ws + WS_WGU + (size_t)l * NE * 2048 * D * 2 + (size_t)e * 2048 * D, (size_t)(h0 >> 7) * 256 + (h0 & 127), D, scr, lane);
                else tr_item(a.in[I_WEG] + ((size_t)l * NE + e) * D * DE, DE, 64 * kb, h0, (bf16*)(ws + WS_WGU) + ((size_t)l * NE + e) * 2048 * D, (size_t)(h0 >> 7) * 256 + (h0 & 127), D, scr, lane); continue; } r -= I_EG;
            if (r < I_EU) { const int e = r / 1024, rr = r % 1024, kb = rr / 32, nb = rr % 32, h0 = 32 * nb;
                if (f8) tr_item8(a.in[I_WEU] + ((size_t)l * NE + e) * D * DE, DE, 64 * kb, h0, ws + WS_WGU + (size_t)l * NE * 2048 * D * 2 + (size_t)e * 2048 * D, (size_t)(h0 >> 7) * 256 + 128 + (h0 & 127), D, scr, lane);
                else tr_item(a.in[I_WEU] + ((size_t)l * NE + e) * D * DE, DE, 64 * kb, h0, (bf16*)(ws + WS_WGU) + ((size_t)l * NE + e) * 2048 * D, (size_t)(h0 >> 7) * 256 + 128 + (h0 & 127), D, scr, lane); continue; } r -= I_EU;
            { const int e = r / 1024, rr = r % 1024, kb = rr / 64, nb = rr % 64;
                if (f8 && FP8_PG) tr_item8(a.in[I_WED] + ((size_t)l * NE + e) * DE * D, D, 64 * kb, 32 * nb, ws + WS_WD + (size_t)l * NE * D * DE * 2 + (size_t)e * D * DE, 32 * nb, DE, scr, lane);
                else tr_item(a.in[I_WED] + ((size_t)l * NE + e) * DE * D, D, 64 * kb, 32 * nb, (bf16*)(ws + WS_WD) + ((size_t)l * NE + e) * D * DE, 32 * nb, DE, scr, lane); } }
    }
}
__device__ __forceinline__ void p0_prologue(const Frame& F0, const Args& a) {
    PHASE_FRAME(F0);
    LAS float* scr = (LAS float*)(F.lds + RING_OFF + F.wave * 16384);
    const int gw = F.vcu * NWAVES + F.wave, NGW = F.G * NWAVES;
    unsigned char* ws = OPQ_G(unsigned char, a.ws);
#pragma unroll 1
    for (int l = 0; l < DEPTH; ++l) weight_items(a, ws, scr, F.lane, 0, l, gw, NGW);
#ifdef CONVERT_ALL_IN_PROLOGUE
#pragma unroll 1
    for (int l = 0; l < DEPTH; ++l) weight_items(a, ws, scr, F.lane, 1, l, gw, NGW);
#endif
    const size_t gt = (size_t)F.vcu * 512 + F.tid, NGT = (size_t)F.G * 512;
    { const GAS f32x4* src = (const GAS f32x4*)a.in[I_X]; GAS v4u* dst = (GAS v4u*)(ws + WS_XB);
        for (size_t i = gt; i < (size_t)T * D / 8; i += NGT) { const f32x4 v0 = src[2 * i], v1 = src[2 * i + 1]; v4u o; o.x = pk2(v0[0], v0[1]); o.y = pk2(v0[2], v0[3]); o.z = pk2(v1[0], v1[1]); o.w = pk2(v1[2], v1[3]); dst[i] = o; } }
    { const GAS f32x4* src = (const GAS f32x4*)a.in[I_P]; GAS v4u* dst = (GAS v4u*)(ws + WS_PB16);
        for (size_t i = gt; i < (size_t)DEPTH * T * PLE / 8; i += NGT) { const f32x4 v0 = src[2 * i], v1 = src[2 * i + 1]; v4u o; o.x = pk2(v0[0], v0[1]); o.y = pk2(v0[2], v0[3]); o.z = pk2(v1[0], v1[1]); o.w = pk2(v1[2], v1[3]); dst[i] = o; } }
    for (size_t i = gt; i < (size_t)DEPTH * 16 * D; i += NGT) { const int l = (int)(i / (16 * D)), j = (int)((i / D) % 16), k = (int)(i % D);
        ((bf16*)(ws + WS_WBA))[i] = (bf16)f2bf(a.in[I_WIN][((size_t)l * D + k) * IN_COLS + 4096 + j]); }
}

typedef float f32x16 __attribute__((ext_vector_type(16)));
#define MFMA32(a_, b_, c_) __builtin_amdgcn_mfma_f32_32x32x16_bf16((a_), (b_), (c_), 0, 0, 0)
#define PACK8(x, sp) __builtin_bit_cast(bf16x8, (v4u){pkbf((x)[8 * (sp)], (x)[8 * (sp) + 1]), pkbf((x)[8 * (sp) + 2], (x)[8 * (sp) + 3]), pkbf((x)[8 * (sp) + 4], (x)[8 * (sp) + 5]), pkbf((x)[8 * (sp) + 6], (x)[8 * (sp) + 7])})
#define RAW_BAR() do { asm volatile("s_waitcnt lgkmcnt(0)" ::: "memory"); __builtin_amdgcn_s_barrier(); asm volatile("" ::: "memory"); } while (0)
constexpr int IMG_ELEMS = 56 * 512, UIMG_ELEMS = 8 * 1024;
constexpr int FR_WN = 0, FR_QD = 16, FR_AQK = 32, FR_KDT = 40;
constexpr size_t WS_IMG = WS_R2, WS_UIMG = WS_R2 + 112 * MiB;
static_assert((size_t)NB * NCH * NH * IMG_ELEMS * 2 == 112 * MiB && (size_t)NB * NCH * NH * UIMG_ELEMS * 2 == 32 * MiB, "DeltaNet images");

__device__ __forceinline__ void pool_diffs_unit(const Frame& F, unsigned char* ws, int pm, int g) {
    const bf16* PROJ = (const bf16*)(ws + WS_PROJ); bf16* POOLD = (bf16*)(ws + WS_POOLD);
    const int tid = F.tid, cp = tid & 127, rq = tid >> 7, r0 = 256 * pm + 64 * rq, sq0 = r0 % SEQ, col = 256 * g + 2 * cp;
    const bf16* up = PROJ + (size_t)r0 * NPROJ + 4096 + col; bf16* dp = POOLD + (size_t)r0 * PW + col;
#define POOL_BODY(WIN) do { unsigned xr[CH + WIN - 1]; \
        _Pragma("unroll") for (int j = 0; j < WIN - 1; ++j) xr[j] = (sq0 - (WIN - 1) + j >= 0) ? *(const unsigned*)(up + (ptrdiff_t)(j - (WIN - 1)) * NPROJ) : 0u; \
        _Pragma("unroll") for (int i = 0; i < CH; ++i) xr[WIN - 1 + i] = *(const unsigned*)(up + (size_t)i * NPROJ); \
        float s0 = 0.f, s1 = 0.f; \
        _Pragma("unroll") for (int j = 0; j < WIN - 1; ++j) { s0 += bflo(xr[j]); s1 += bfhi(xr[j]); } \
        _Pragma("unroll") for (int i = 0; i < CH; ++i) { const float x0 = bflo(xr[WIN - 1 + i]), x1 = bfhi(xr[WIN - 1 + i]); s0 += x0; s1 += x1; \
            const int pos = sq0 + i; const float inv = __builtin_amdgcn_rcpf((float)((pos + 1) < WIN ? (pos + 1) : WIN)); \
            *(unsigned*)(dp + (size_t)i * PW) = pkbf(s0 * inv - x0, s1 * inv - x1); s0 -= bflo(xr[i]); s1 -= bfhi(xr[i]); } } while (0)
    if (g == 0) POOL_BODY(2); else if (g == 1) POOL_BODY(4); else if (g == 2) POOL_BODY(8); else POOL_BODY(16);
#undef POOL_BODY
}
#ifndef PREP_DUP
#define PREP_DUP 0
#endif
constexpr int PQF = 0, PKF = 33792, PQS = 67584, PKS = 84992, PVT = 102400, PKT = 120832, PTAB = 139264;
constexpr int PAS = PQF;
constexpr int PTB = PKF, PT11T = PKF + 9216, PPART = PKF;
constexpr int F_LD = 132, S_LD = 136, T_LD = 72, A_LD = 68, TT_LD = 40;
__device__ __forceinline__ void phase_dn_prep(const Frame& F0, const Args& a, int layer) {
    PHASE_FRAME(F0);
    unsigned char* ws = OPQ_G(unsigned char, a.ws);
    LAS unsigned char* lds = F.lds;
    LAS float* Qf = (LAS float*)(lds + PQF); LAS float* Kf = (LAS float*)(lds + PKF); LAS float* As = (LAS float*)(lds + PAS);
    LAS bf16* Qs = (LAS bf16*)(lds + PQS); LAS bf16* Ks = (LAS bf16*)(lds + PKS); LAS bf16* Vt = (LAS bf16*)(lds + PVT); LAS bf16* Kt = (LAS bf16*)(lds + PKT);
    LAS bf16* Tb = (LAS bf16*)(lds + PTB); LAS bf16* T11t = (LAS bf16*)(lds + PT11T);
    LAS float* betaS = (LAS float*)(lds + PTAB); LAS float* gS = betaS + 512; LAS float* gamh = gS + 512; LAS float* betah = gamh + 64; LAS float* egam = betah + 64; LAS float* bgam = egam + 64; LAS float* ekd = bgam + 64; LAS float* rkS = ekd + 64;
    const bf16* XB = (const bf16*)(ws + WS_XB); const bf16* PROJ = (const bf16*)(ws + WS_PROJ); const bf16* WBA = (const bf16*)(ws + WS_WBA) + (size_t)layer * 16 * D;
    bf16* IMG = (bf16*)(ws + WS_IMG); bf16* UIMG = (bf16*)(ws + WS_UIMG); float* CD = (float*)(ws + WS_CD);
    const float* convw = a.in[I_CONVW] + (size_t)layer * 4 * 3072; const float* alog = a.in[I_ALOG] + layer * NH; const float* dtb = a.in[I_DTB] + layer * NH;
    const int tid = F.tid, lane = F.lane, wave = F.wave, c32 = lane & 31, hf = lane >> 5;
    for (int unit = F.vcu; unit < NB * NCH; unit += F.G) {
        const int b = unit / NCH, n = unit % NCH, r0 = b * SEQ + n * CH, sq0 = n * CH;
        for (int rep_ = 0; rep_ < ((PREP_DUP & 64) ? 2 : 1); ++rep_)
        { typedef float f32x4v __attribute__((ext_vector_type(4)));
            const int fr = lane & 15, fg = lane >> 4; f32x4v pacc[4];
#pragma unroll
            for (int mt = 0; mt < 4; ++mt) pacc[mt] = (f32x4v){0.f, 0.f, 0.f, 0.f};
#pragma unroll 1
            for (int sb = 0; sb < 8; sb += 4) {
                bf16x8 bq[4], aq[4][4];
#pragma unroll
                for (int s = 0; s < 4; ++s) { const int k0 = 256 * wave + 32 * (sb + s) + 8 * fg; bq[s] = *(const bf16x8*)(WBA + (size_t)fr * D + k0);
#pragma unroll
                    for (int mt = 0; mt < 4; ++mt) aq[s][mt] = *(const bf16x8*)(XB + (size_t)(r0 + 16 * mt + fr) * D + k0); }
                asm volatile("" : "+v"(bq[0]), "+v"(bq[1]), "+v"(bq[2]), "+v"(bq[3]), "+v"(aq[0][0]), "+v"(aq[0][1]), "+v"(aq[0][2]), "+v"(aq[0][3]), "+v"(aq[1][0]), "+v"(aq[1][1]), "+v"(aq[1][2]), "+v"(aq[1][3]),
                             "+v"(aq[2][0]), "+v"(aq[2][1]), "+v"(aq[2][2]), "+v"(aq[2][3]), "+v"(aq[3][0]), "+v"(aq[3][1]), "+v"(aq[3][2]), "+v"(aq[3][3]));
#pragma unroll
                for (int s = 0; s < 4; ++s)
#pragma unroll
                    for (int mt = 0; mt < 4; ++mt) pacc[mt] = __builtin_amdgcn_mfma_f32_16x16x32_bf16(aq[s][mt], bq[s], pacc[mt], 0, 0, 0); }
            LAS float* part = (LAS float*)(lds + PPART) + wave * 1024;
#pragma unroll
            for (int mt = 0; mt < 4; ++mt)
#pragma unroll
                for (int r = 0; r < 4; ++r) part[(16 * mt + 4 * fg + r) * 16 + fr] = pacc[mt][r]; }
        __syncthreads();
        { const int tok = tid >> 3, cp = tid & 7; float s0 = 0.f, s1 = 0.f;
#pragma unroll
            for (int w = 0; w < 8; ++w) { const f32x2 p2 = *(const LAS f32x2*)((LAS float*)(lds + PPART) + w * 1024 + tok * 16 + 2 * cp); s0 += p2[0]; s1 += p2[1]; }
            if (cp < 4) { betaS[tok * 8 + 2 * cp] = sigmoidf_(s0); betaS[tok * 8 + 2 * cp + 1] = sigmoidf_(s1); }
            else { const int h = 2 * (cp - 4); const float z0 = s0 + dtb[h], z1 = s1 + dtb[h + 1];
                const float sp0 = z0 > 20.f ? z0 : log1pf(__expf(z0)), sp1 = z1 > 20.f ? z1 : log1pf(__expf(z1));
                gS[tok * 8 + h] = -__expf(alog[h]) * sp0; gS[tok * 8 + h + 1] = -__expf(alog[h + 1]) * sp1; } }
        __syncthreads();
        { float gv = gS[lane * 8 + wave];
#pragma unroll
            for (int o = 1; o < 64; o <<= 1) { const float up_ = __shfl_up(gv, o); if (lane >= o) gv += up_; }
            gS[lane * 8 + wave] = gv; }
        __syncthreads();
        unsigned craw[3][11]; unsigned cdum[3][8];
#define PREP_LOADRAW(hh) do { const int cp_ = tid & 63, i0_ = (tid >> 6) * 8; \
            _Pragma("unroll") for (int part_ = 0; part_ < 3; ++part_) { const bf16* src_ = PROJ + (size_t)(r0 + i0_ - 3) * NPROJ + part_ * 1024 + (hh) * HD + 2 * cp_; \
                _Pragma("unroll") for (int j_ = 0; j_ < 11; ++j_) craw[part_][j_] = (sq0 + i0_ - 3 + j_ >= 0) ? *(const unsigned*)(src_ + (ptrdiff_t)j_ * NPROJ) : 0u; \
                if (PREP_DUP & 256) { _Pragma("unroll") for (int j_ = 3; j_ < 11; ++j_) cdum[part_][j_ - 3] = *(const unsigned*)(src_ + (ptrdiff_t)j_ * NPROJ + ((hh) ^ 1) * HD - (hh) * HD); } } } while (0)
        PREP_LOADRAW(0);
        for (int hh_ = 0; hh_ < ((PREP_DUP & 128) ? 2 * NH : NH); ++hh_) { const int h = hh_ & (NH - 1);
            const size_t chd = (size_t)unit * NH + h; bf16* img = IMG + chd * IMG_ELEMS; bf16* uimg = UIMG + chd * UIMG_ELEMS;
            for (int rep_ = 0; rep_ < ((PREP_DUP & 16) ? 2 : 1); ++rep_)
            { const int cp = tid & 63, rg8 = tid >> 6, i0 = rg8 * 8;
                if (PREP_DUP & 256) {
#pragma unroll
                    for (int p_ = 0; p_ < 3; ++p_)
#pragma unroll
                        for (int j_ = 0; j_ < 8; ++j_) asm volatile("" :: "v"(cdum[p_][j_])); }
#pragma unroll
                for (int part = 0; part < 3; ++part) { const int col = part * 1024 + h * HD + 2 * cp;
                    const f32x2 cw0 = *(const f32x2*)(convw + col), cw1 = *(const f32x2*)(convw + 3072 + col), cw2 = *(const f32x2*)(convw + 2 * 3072 + col), cw3 = *(const f32x2*)(convw + 3 * 3072 + col);
                    float ya[8], yb[8];
#pragma unroll
                    for (int i = 0; i < 8; ++i) { const unsigned x3 = craw[part][i], x2 = craw[part][i + 1], x1 = craw[part][i + 2], x0 = craw[part][i + 3];
                        const float ta = cw0[0] * bflo(x3) + cw1[0] * bflo(x2) + cw2[0] * bflo(x1) + cw3[0] * bflo(x0), tb = cw0[1] * bfhi(x3) + cw1[1] * bfhi(x2) + cw2[1] * bfhi(x1) + cw3[1] * bfhi(x0);
                        ya[i] = ta * sigmoidf_(ta); yb[i] = tb * sigmoidf_(tb); }
                    if (part == 0) {
#pragma unroll
                        for (int i = 0; i < 8; ++i) *(LAS f32x2*)(Qf + (i0 + i) * F_LD + 2 * cp) = (f32x2){ya[i], yb[i]}; }
                    else if (part == 1) {
#pragma unroll
                        for (int i = 0; i < 8; ++i) *(LAS f32x2*)(Kf + (i0 + i) * F_LD + 2 * cp) = (f32x2){ya[i], yb[i]}; }
                    else { v4u o0, o1;
                        o0.x = pkbf(ya[0] * betaS[(i0 + 0) * 8 + h], ya[1] * betaS[(i0 + 1) * 8 + h]); o0.y = pkbf(ya[2] * betaS[(i0 + 2) * 8 + h], ya[3] * betaS[(i0 + 3) * 8 + h]); o0.z = pkbf(ya[4] * betaS[(i0 + 4) * 8 + h], ya[5] * betaS[(i0 + 5) * 8 + h]); o0.w = pkbf(ya[6] * betaS[(i0 + 6) * 8 + h], ya[7] * betaS[(i0 + 7) * 8 + h]);
                        o1.x = pkbf(yb[0] * betaS[(i0 + 0) * 8 + h], yb[1] * betaS[(i0 + 1) * 8 + h]); o1.y = pkbf(yb[2] * betaS[(i0 + 2) * 8 + h], yb[3] * betaS[(i0 + 3) * 8 + h]); o1.z = pkbf(yb[4] * betaS[(i0 + 4) * 8 + h], yb[5] * betaS[(i0 + 5) * 8 + h]); o1.w = pkbf(yb[6] * betaS[(i0 + 6) * 8 + h], yb[7] * betaS[(i0 + 7) * 8 + h]);
                        *(LAS v4u*)(Vt + (2 * cp) * T_LD + i0) = o0; *(LAS v4u*)(Vt + (2 * cp + 1) * T_LD + i0) = o1; } }
            }
            if (hh_ + 1 < ((PREP_DUP & 128) ? 2 * NH : NH)) PREP_LOADRAW((hh_ + 1) & (NH - 1));
            for (int rep_ = 0; rep_ < ((PREP_DUP & 1) ? 2 : 1); ++rep_) { if (rep_) RAW_BAR();
            { const int i = tid >> 3, part = tid & 7; const LAS float* qp = Qf + i * F_LD + part * 16; const LAS float* kp = Kf + i * F_LD + part * 16;
                f32x4 qv[4], kv[4]; float sq = 0.f, sk = 0.f;
#pragma unroll
                for (int j = 0; j < 4; ++j) { qv[j] = *(const LAS f32x4*)(qp + 4 * j); kv[j] = *(const LAS f32x4*)(kp + 4 * j);
                    sq += (qv[j][0] * qv[j][0] + qv[j][1] * qv[j][1]) + (qv[j][2] * qv[j][2] + qv[j][3] * qv[j][3]); sk += (kv[j][0] * kv[j][0] + kv[j][1] * kv[j][1]) + (kv[j][2] * kv[j][2] + kv[j][3] * kv[j][3]); }
                sq = row8_sum(sq); sk = row8_sum(sk);
                const float rq = 1.0f / sqrtf(sq + RMS_EPS) * 0.08838834764831845f, rk = 1.0f / sqrtf(sk + RMS_EPS);
                const float gi_ = gS[i * 8 + h], eg = __expf(gi_);
                if (part == 0) { const float bi_ = betaS[i * 8 + h]; rkS[i] = rk; gamh[i] = gi_; betah[i] = bi_; egam[i] = eg; bgam[i] = bi_ * eg; ekd[i] = __expf(gS[63 * 8 + h] - gi_); }
#pragma unroll
                for (int j = 0; j < 4; ++j) { qv[j] = qv[j] * rq; kv[j] = kv[j] * rk; }
                v4u w0, w1;
                w0.x = pkbf(qv[0][0], qv[0][1]); w0.y = pkbf(qv[0][2], qv[0][3]); w0.z = pkbf(qv[1][0], qv[1][1]); w0.w = pkbf(qv[1][2], qv[1][3]); w1.x = pkbf(qv[2][0], qv[2][1]); w1.y = pkbf(qv[2][2], qv[2][3]); w1.z = pkbf(qv[3][0], qv[3][1]); w1.w = pkbf(qv[3][2], qv[3][3]);
                *(LAS v4u*)(Qs + i * S_LD + part * 16) = w0; *(LAS v4u*)(Qs + i * S_LD + part * 16 + 8) = w1;
                w0.x = pkbf(kv[0][0], kv[0][1]); w0.y = pkbf(kv[0][2], kv[0][3]); w0.z = pkbf(kv[1][0], kv[1][1]); w0.w = pkbf(kv[1][2], kv[1][3]); w1.x = pkbf(kv[2][0], kv[2][1]); w1.y = pkbf(kv[2][2], kv[2][3]); w1.z = pkbf(kv[3][0], kv[3][1]); w1.w = pkbf(kv[3][2], kv[3][3]);
                *(LAS v4u*)(Ks + i * S_LD + part * 16) = w0; *(LAS v4u*)(Ks + i * S_LD + part * 16 + 8) = w1;
                bf16* fq = img + ((size_t)(FR_QD + (i >> 5) * 8 + part) * 64 + (i & 31)) * 8;
                v4u h0, h1;
                h0.x = pkbf(qv[0][0] * eg, qv[0][1] * eg); h0.y = pkbf(qv[0][2] * eg, qv[0][3] * eg); h0.z = pkbf(qv[2][0] * eg, qv[2][1] * eg); h0.w = pkbf(qv[2][2] * eg, qv[2][3] * eg);
                h1.x = pkbf(qv[1][0] * eg, qv[1][1] * eg); h1.y = pkbf(qv[1][2] * eg, qv[1][3] * eg); h1.z = pkbf(qv[3][0] * eg, qv[3][1] * eg); h1.w = pkbf(qv[3][2] * eg, qv[3][3] * eg);
                *(v4u*)fq = h0; *(v4u*)(fq + 32 * 8) = h1; }
            RAW_BAR();
            { const int c = tid & 127, rg = tid >> 7; float kb[16], kd[16];
#pragma unroll
                for (int i = 0; i < 16; ++i) { const int t = rg * 16 + i; const float kn = Kf[t * F_LD + c] * rkS[t]; kb[i] = kn * bgam[t]; kd[i] = kn * ekd[t]; }
                v4u o0, o1;
                o0.x = pkbf(kb[0], kb[1]); o0.y = pkbf(kb[2], kb[3]); o0.z = pkbf(kb[4], kb[5]); o0.w = pkbf(kb[6], kb[7]); o1.x = pkbf(kb[8], kb[9]); o1.y = pkbf(kb[10], kb[11]); o1.z = pkbf(kb[12], kb[13]); o1.w = pkbf(kb[14], kb[15]);
                *(LAS v4u*)(Kt + c * T_LD + rg * 16) = o0; *(LAS v4u*)(Kt + c * T_LD + rg * 16 + 8) = o1;
                bf16* fk = img + ((size_t)(FR_KDT + (c >> 5) * 4 + rg) * 64 + (c & 31)) * 8;
                v4u h0, h1;
                h0.x = pkbf(kd[0], kd[1]); h0.y = pkbf(kd[2], kd[3]); h0.z = pkbf(kd[8], kd[9]); h0.w = pkbf(kd[10], kd[11]);
                h1.x = pkbf(kd[4], kd[5]); h1.y = pkbf(kd[6], kd[7]); h1.z = pkbf(kd[12], kd[13]); h1.w = pkbf(kd[14], kd[15]);
                *(v4u*)fk = h0; *(v4u*)(fk + 32 * 8) = h1; }
            RAW_BAR();
            }
            for (int rep_ = 0; rep_ < ((PREP_DUP & 2) ? 2 : 1); ++rep_) { if (rep_) RAW_BAR();
            if (wave < 6) { const int pr = wave % 3, iskk = wave / 3, mt = pr == 2 ? 1 : 0, nt = pr == 0 ? 0 : 1;
                const LAS bf16* xs = iskk ? Ks : Qs; f32x16 d;
#pragma unroll
                for (int r = 0; r < 16; ++r) d[r] = 0.f;
#pragma unroll
                for (int s = 0; s < 8; ++s) { const bf16x8 af = *(const LAS bf16x8*)(Ks + (32 * mt + c32) * S_LD + 16 * s + 8 * hf), bfr = *(const LAS bf16x8*)(xs + (32 * nt + c32) * S_LD + 16 * s + 8 * hf); d = MFMA32(af, bfr, d); }
                const int i = 32 * nt + c32; const float gi = gamh[i], bi = betah[i];
#pragma unroll
                for (int r = 0; r < 16; ++r) { const int j = 32 * mt + (r & 3) + 8 * (r >> 2) + 4 * hf; const float de = __expf(gi - gamh[j]);
                    d[r] = iskk ? ((j < i) ? bi * d[r] * de : 0.f) : ((j <= i) ? d[r] * de : 0.f); }
                if (iskk) {
#pragma unroll
                    for (int qd = 0; qd < 4; ++qd) *(LAS f32x4*)(As + i * A_LD + 32 * mt + 8 * qd + 4 * hf) = (f32x4){d[4 * qd], d[4 * qd + 1], d[4 * qd + 2], d[4 * qd + 3]}; }
                else {
#pragma unroll
                    for (int sp = 0; sp < 2; ++sp) *(bf16x8*)(img + ((size_t)(FR_AQK + nt * 4 + 2 * mt + sp) * 64 + lane) * 8) = PACK8(d, sp); } }
            RAW_BAR();
            }
            for (int rep_ = 0; rep_ < ((PREP_DUP & 4) ? 2 : 1); ++rep_) { if (rep_) RAW_BAR();
            if (wave < 2) {
                unsigned asb = (unsigned)(uintptr_t)(As + (32 * wave) * A_LD + 32 * wave); int cb = c32; asm volatile("" : "+v"(asb), "+v"(cb));
                const LAS float* Ab = (const LAS float*)(uintptr_t)asb;
                float arow[32], Tc[32];
#pragma unroll
                for (int i = 0; i < 32; ++i) arow[i] = Ab[i * A_LD + cb];
#pragma unroll
                for (int i = 0; i < 32; ++i) { float ac[4] = {(i == cb) ? 1.f : 0.f, 0.f, 0.f, 0.f}; if (i > 0) asm volatile("" : "+v"(arow[i]), "+v"(Tc[i - 1]));
#pragma unroll
                    for (int j = 0; j < i; ++j) { const float aij = __builtin_bit_cast(float, __builtin_amdgcn_readlane(__builtin_bit_cast(int, arow[i]), j)); ac[j & 3] -= aij * Tc[j]; }
                    Tc[i] = (ac[0] + ac[1]) + (ac[2] + ac[3]); __builtin_amdgcn_sched_barrier(0); }
                if (hf == 0) {
#pragma unroll
                    for (int i = 0; i < 32; ++i) Tb[(32 * wave + i) * T_LD + 32 * wave + c32] = (bf16)(pkbf(Tc[i], 0.f) & 0xffffu);
                    if (wave == 0) {
#pragma unroll
                        for (int q = 0; q < 4; ++q) { v4u o; o.x = pkbf(Tc[8 * q], Tc[8 * q + 1]); o.y = pkbf(Tc[8 * q + 2], Tc[8 * q + 3]); o.z = pkbf(Tc[8 * q + 4], Tc[8 * q + 5]); o.w = pkbf(Tc[8 * q + 6], Tc[8 * q + 7]); *(LAS v4u*)(T11t + c32 * TT_LD + 8 * q) = o; } } } }
            RAW_BAR();
            if (wave == 0) {
                f32x16 x;
#pragma unroll
                for (int r = 0; r < 16; ++r) x[r] = 0.f;
#pragma unroll
                for (int s = 0; s < 2; ++s) { const LAS float* ap = As + (32 + c32) * A_LD + 16 * s + 8 * hf; const f32x4 a0 = *(const LAS f32x4*)ap, a1 = *(const LAS f32x4*)(ap + 4);
                    const bf16x8 af = __builtin_bit_cast(bf16x8, (v4u){pkbf(a0[0], a0[1]), pkbf(a0[2], a0[3]), pkbf(a1[0], a1[1]), pkbf(a1[2], a1[3])});
                    const bf16x8 bfr = *(const LAS bf16x8*)(T11t + c32 * TT_LD + 16 * s + 8 * hf); x = MFMA32(af, bfr, x); }
                f32x16 t21;
#pragma unroll
                for (int r = 0; r < 16; ++r) t21[r] = 0.f;
#pragma unroll
                for (int s = 0; s < 2; ++s) { const LAS bf16* tp = Tb + (32 + c32) * T_LD + 32 + 16 * s + 4 * hf; const v2u lo = *(const LAS v2u*)tp, hi = *(const LAS v2u*)(tp + 8);
                    const bf16x8 af = __builtin_bit_cast(bf16x8, (v4u){lo.x, lo.y, hi.x, hi.y}); const bf16x8 bfr = PACK8(x, s); t21 = MFMA32(af, bfr, t21); }
#pragma unroll
                for (int r = 0; r < 16; ++r) Tb[(32 + (r & 3) + 8 * (r >> 2) + 4 * hf) * T_LD + c32] = (bf16)(pkbf(-t21[r], 0.f) & 0xffffu);
            }
            RAW_BAR();
            }
            for (int rep_ = 0; rep_ < ((PREP_DUP & 8) ? 2 : 1); ++rep_) { if (rep_) RAW_BAR();
            if (wave < 4) {
#pragma unroll
                for (int mt = 0; mt < 2; ++mt) { f32x16 d;
#pragma unroll
                    for (int r = 0; r < 16; ++r) d[r] = 0.f;
#pragma unroll
                    for (int s = 0; s < 4; ++s) if (s < 2 * (mt + 1)) { const bf16x8 af = *(const LAS bf16x8*)(Tb + (32 * mt + c32) * T_LD + 16 * s + 8 * hf), bfr = *(const LAS bf16x8*)(Vt + (32 * wave + c32) * T_LD + 16 * s + 8 * hf); d = MFMA32(af, bfr, d); }
                    bf16* up = uimg + ((size_t)(wave * 2 + mt) * 64 + lane) * 16; *(bf16x8*)up = PACK8(d, 0); *(bf16x8*)(up + 8) = PACK8(d, 1); } }
            else { const int ct = wave - 4;
#pragma unroll
                for (int nt = 0; nt < 2; ++nt) { f32x16 d;
#pragma unroll
                    for (int r = 0; r < 16; ++r) d[r] = 0.f;
#pragma unroll
                    for (int s = 0; s < 4; ++s) if (s < 2 * (nt + 1)) { const bf16x8 af = *(const LAS bf16x8*)(Kt + (32 * ct + c32) * T_LD + 16 * s + 8 * hf), bfr = *(const LAS bf16x8*)(Tb + (32 * nt + c32) * T_LD + 16 * s + 8 * hf); d = MFMA32(af, bfr, d); }
#pragma unroll
                    for (int r = 0; r < 16; ++r) d[r] = -d[r];
#pragma unroll
                    for (int sp = 0; sp < 2; ++sp) *(bf16x8*)(img + ((size_t)(FR_WN + nt * 8 + 2 * ct + sp) * 64 + lane) * 8) = PACK8(d, sp); } }
            }
            if (tid == 0) CD[chd] = egam[63];
            RAW_BAR();
        }
#undef PREP_LOADRAW
    }
}

__host__ __device__ constexpr int sc_p(int k) { const int j = k - 32; return j < 12 ? j % 6 : (j - 12) % 5; }
__host__ __device__ constexpr int sc_slab(int k) { const int j = k - 32; return k < 32 ? (k >> 2) : (j < 12 ? j / 6 : 2 + (j - 12) / 5); }
__host__ __device__ constexpr int sc_kind(int k) { return k < 32 ? ((k & 3) < 2 ? 0 : 1) : ((sc_p(k) == 2 || sc_p(k) == 5) ? 1 : 2); }
__host__ __device__ constexpr int sc_idx(int k) { return k < 32 ? (k & 1) : (sc_p(k) == 0 ? 0 : sc_p(k) == 1 ? 1 : sc_p(k) == 2 ? 1 : sc_p(k) == 3 ? 2 : sc_p(k) == 4 ? 3 : 0); }
__host__ __device__ constexpr int sc_frag(int k) { return k < 32 ? (((k & 3) < 2 ? FR_WN : FR_QD) + (k & 1) * 8 + (k >> 2)) : (sc_kind(k) == 1 ? FR_AQK + sc_idx(k) * 4 + sc_slab(k) : FR_KDT + sc_idx(k) * 4 + sc_slab(k)); }
constexpr int SC_QD = 8;
constexpr int SCB = 57344, OT_OFF = 2 * SCB, OT_LD = 136, OT_BYTES = 64 * OT_LD * 2;
static_assert(OT_OFF + 2 * OT_BYTES <= 152 * 1024, "scan LDS");
__device__ __forceinline__ void phase_dn_scan(const Frame& F0, const Args& a, int layer, int unit) {
    PHASE_FRAME(F0);
    unsigned char* ws = OPQ_G(unsigned char, a.ws);
    LAS unsigned char* lds = F.lds;
    const int b = unit >> 3, h = unit & 7, lane = F.lane;
    const bf16* IMG = (const bf16*)(ws + WS_IMG); const bf16* UIMG = (const bf16*)(ws + WS_UIMG); const float* CD = (const float*)(ws + WS_CD);
    const size_t chd0 = (size_t)b * NCH * NH + h;
    if (F.wave < 4) {
#ifndef SCAN_NO_COMPUTE
        const int w = F.wave, c32 = lane & 31, hf = lane >> 5;
        f32x16 S0, S1, S2, S3;
#pragma unroll
        for (int r = 0; r < 16; ++r) { S0[r] = 0.f; S1[r] = 0.f; S2[r] = 0.f; S3[r] = 0.f; }
        const float cdl = CD[chd0 + (size_t)lane * NH];
        v4u UA[4];
        const __amdgpu_buffer_rsrc_t rsU = __builtin_amdgcn_make_buffer_rsrc((void*)(UIMG + chd0 * UIMG_ELEMS), (short)0, NCH * NH * UIMG_ELEMS * 2, 0x00020000);
        const unsigned uoff = (unsigned)((w * 2) * 64 + lane) * 32u;
#define SC_LOADU(dst, nn) do { _Pragma("unroll") for (int mt_ = 0; mt_ < 2; ++mt_) { _Pragma("unroll") for (int hh_ = 0; hh_ < 2; ++hh_) dst[2 * mt_ + hh_] = __builtin_amdgcn_raw_buffer_load_b128(rsU, uoff + (unsigned)(mt_ * 2048 + hh_ * 16), (unsigned)(nn) * (unsigned)(NH * UIMG_ELEMS * 2), 0); } } while (0)
#define SC_FRAG(bufoff, fi) (*(const LAS bf16x8*)(lds + (bufoff) + (fi) * 1024 + lane * 16))
#define SC_CHUNK(nn, U, bufoff, otoff) do { \
        f32x16 aV0, aV1, aO0, aO1; bf16x8 fq0, fq1, fq2, fq3, fq4, fq5, fq6, fq7, Sbs, Vb0, Vb1, Vb2, Vb3; \
        _Pragma("unroll") for (int q = 0; q < 4; ++q) { aV0[2 * q] = bflo(U[0][q]); aV0[2 * q + 1] = bfhi(U[0][q]); aV0[8 + 2 * q] = bflo(U[1][q]); aV0[8 + 2 * q + 1] = bfhi(U[1][q]); \
            aV1[2 * q] = bflo(U[2][q]); aV1[2 * q + 1] = bfhi(U[2][q]); aV1[8 + 2 * q] = bflo(U[3][q]); aV1[8 + 2 * q + 1] = bfhi(U[3][q]); } \
        _Pragma("unroll") for (int r = 0; r < 16; ++r) { aO0[r] = 0.f; aO1[r] = 0.f; } \
        if ((nn) + 1 < NCH) SC_LOADU(U, (nn) + 1); \
        const float cd = __builtin_bit_cast(float, __builtin_amdgcn_readlane(__builtin_bit_cast(int, cdl), (nn))); \
        fq0 = SC_FRAG(bufoff, 0); \
        fq1 = SC_FRAG(bufoff, 8); \
        fq2 = SC_FRAG(bufoff, 16); \
        fq3 = SC_FRAG(bufoff, 24); \
        fq4 = SC_FRAG(bufoff, 1); \
        fq5 = SC_FRAG(bufoff, 9); \
        fq6 = SC_FRAG(bufoff, 17); \
        fq7 = SC_FRAG(bufoff, 25); \
        Sbs = PACK8(S0, 0); \
        aV0 = MFMA32(fq0, Sbs, aV0); \
        fq0 = SC_FRAG(bufoff, 2); \
        aV1 = MFMA32(fq1, Sbs, aV1); \
        fq1 = SC_FRAG(bufoff, 10); \
        aO0 = MFMA32(fq2, Sbs, aO0); \
        fq2 = SC_FRAG(bufoff, 18); \
        aO1 = MFMA32(fq3, Sbs, aO1); \
        fq3 = SC_FRAG(bufoff, 26); \
        Sbs = PACK8(S0, 1); \
        aV0 = MFMA32(fq4, Sbs, aV0); \
        fq4 = SC_FRAG(bufoff, 3); \
        aV1 = MFMA32(fq5, Sbs, aV1); \
        fq5 = SC_FRAG(bufoff, 11); \
        aO0 = MFMA32(fq6, Sbs, aO0); \
        fq6 = SC_FRAG(bufoff, 19); \
        aO1 = MFMA32(fq7, Sbs, aO1); \
        fq7 = SC_FRAG(bufoff, 27); \
        Sbs = PACK8(S1, 0); \
        aV0 = MFMA32(fq0, Sbs, aV0); \
        fq0 = SC_FRAG(bufoff, 4); \
        aV1 = MFMA32(fq1, Sbs, aV1); \
        fq1 = SC_FRAG(bufoff, 12); \
        aO0 = MFMA32(fq2, Sbs, aO0); \
        fq2 = SC_FRAG(bufoff, 20); \
        aO1 = MFMA32(fq3, Sbs, aO1); \
        fq3 = SC_FRAG(bufoff, 28); \
        Sbs = PACK8(S1, 1); \
        aV0 = MFMA32(fq4, Sbs, aV0); \
        fq4 = SC_FRAG(bufoff, 5); \
        aV1 = MFMA32(fq5, Sbs, aV1); \
        fq5 = SC_FRAG(bufoff, 13); \
        aO0 = MFMA32(fq6, Sbs, aO0); \
        fq6 = SC_FRAG(bufoff, 21); \
        aO1 = MFMA32(fq7, Sbs, aO1); \
        fq7 = SC_FRAG(bufoff, 29); \
        Sbs = PACK8(S2, 0); \
        aV0 = MFMA32(fq0, Sbs, aV0); \
        fq0 = SC_FRAG(bufoff, 6); \
        aV1 = MFMA32(fq1, Sbs, aV1); \
        fq1 = SC_FRAG(bufoff, 14); \
        aO0 = MFMA32(fq2, Sbs, aO0); \
        fq2 = SC_FRAG(bufoff, 22); \
        aO1 = MFMA32(fq3, Sbs, aO1); \
        fq3 = SC_FRAG(bufoff, 30); \
        Sbs = PACK8(S2, 1); \
        aV0 = MFMA32(fq4, Sbs, aV0); \
        fq4 = SC_FRAG(bufoff, 7); \
        aV1 = MFMA32(fq5, Sbs, aV1); \
        fq5 = SC_FRAG(bufoff, 15); \
        aO0 = MFMA32(fq6, Sbs, aO0); \
        fq6 = SC_FRAG(bufoff, 23); \
        aO1 = MFMA32(fq7, Sbs, aO1); \
        fq7 = SC_FRAG(bufoff, 31); \
        Sbs = PACK8(S3, 0); \
        aV0 = MFMA32(fq0, Sbs, aV0); \
        fq0 = SC_FRAG(bufoff, 40); \
        aV1 = MFMA32(fq1, Sbs, aV1); \
        fq1 = SC_FRAG(bufoff, 44); \
        aO0 = MFMA32(fq2, Sbs, aO0); \
        fq2 = SC_FRAG(bufoff, 36); \
        aO1 = MFMA32(fq3, Sbs, aO1); \
        fq3 = SC_FRAG(bufoff, 48); \
        Sbs = PACK8(S3, 1); \
        aV0 = MFMA32(fq4, Sbs, aV0); \
        fq4 = SC_FRAG(bufoff, 52); \
        aV1 = MFMA32(fq5, Sbs, aV1); \
        fq5 = SC_FRAG(bufoff, 32); \
        S0 = S0 * cd; S1 = S1 * cd; S2 = S2 * cd; S3 = S3 * cd; \
        aO0 = MFMA32(fq6, Sbs, aO0); \
        fq6 = SC_FRAG(bufoff, 41); \
        aO1 = MFMA32(fq7, Sbs, aO1); \
        fq7 = SC_FRAG(bufoff, 45); \
        Vb0 = PACK8(aV0, 0); Vb1 = PACK8(aV0, 1); Vb2 = PACK8(aV1, 0); Vb3 = PACK8(aV1, 1); \
        S0 = MFMA32(fq0, Vb0, S0); \
        fq0 = SC_FRAG(bufoff, 37); \
        S1 = MFMA32(fq1, Vb0, S1); \
        fq1 = SC_FRAG(bufoff, 49); \
        aO1 = MFMA32(fq2, Vb0, aO1); \
        fq2 = SC_FRAG(bufoff, 53); \
        S2 = MFMA32(fq3, Vb0, S2); \
        fq3 = SC_FRAG(bufoff, 33); \
        S3 = MFMA32(fq4, Vb0, S3); \
        fq4 = SC_FRAG(bufoff, 42); \
        aO0 = MFMA32(fq5, Vb0, aO0); \
        fq5 = SC_FRAG(bufoff, 46); \
        S0 = MFMA32(fq6, Vb1, S0); \
        fq6 = SC_FRAG(bufoff, 38); \
        S1 = MFMA32(fq7, Vb1, S1); \
        fq7 = SC_FRAG(bufoff, 50); \
        aO1 = MFMA32(fq0, Vb1, aO1); \
        fq0 = SC_FRAG(bufoff, 54); \
        S2 = MFMA32(fq1, Vb1, S2); \
        fq1 = SC_FRAG(bufoff, 43); \
        S3 = MFMA32(fq2, Vb1, S3); \
        fq2 = SC_FRAG(bufoff, 47); \
        aO0 = MFMA32(fq3, Vb1, aO0); \
        fq3 = SC_FRAG(bufoff, 39); \
        S0 = MFMA32(fq4, Vb2, S0); \
        fq4 = SC_FRAG(bufoff, 51); \
        S1 = MFMA32(fq5, Vb2, S1); \
        fq5 = SC_FRAG(bufoff, 55); \
        aO1 = MFMA32(fq6, Vb2, aO1); \
        S2 = MFMA32(fq7, Vb2, S2); \
        S3 = MFMA32(fq0, Vb2, S3); \
        S0 = MFMA32(fq1, Vb3, S0); \
        S1 = MFMA32(fq2, Vb3, S1); \
        aO1 = MFMA32(fq3, Vb3, aO1); \
        S2 = MFMA32(fq4, Vb3, S2); \
        S3 = MFMA32(fq5, Vb3, S3); \
        _Pragma("unroll") for (int r = 0; r < 16; ++r) { \
            *(LAS bf16*)(lds + (otoff) + (((r & 3) + 8 * (r >> 2) + 4 * hf) * OT_LD + 32 * w + c32) * 2) = (bf16)(pkbf(aO0[r], 0.f) & 0xffffu); \
            *(LAS bf16*)(lds + (otoff) + ((32 + (r & 3) + 8 * (r >> 2) + 4 * hf) * OT_LD + 32 * w + c32) * 2) = (bf16)(pkbf(aO1[r], 0.f) & 0xffffu); } \
        RAW_BAR(); } while (0)
        SC_LOADU(UA, 0);
        RAW_BAR();
#pragma unroll 1
        for (int n = 0; n < NCH; n += 2) { SC_CHUNK(n, UA, 0, OT_OFF); SC_CHUNK(n + 1, UA, SCB, OT_OFF + OT_BYTES); }
#undef SC_CHUNK
#undef SC_FRAG
#undef SC_LOADU
#endif
    } else {
#ifndef SCAN_NO_HELPER
        const int ht = F.tid - 256, tok = ht >> 2, q = ht & 3;
        bf16* OB = FP8_PDL(layer) ? (bf16*)((unsigned char*)a.out + 64 * MiB) : (bf16*)(ws + WS_MIXIN); const int old_ = FP8_PDL(layer) ? DNW : D;
        v4u RA[14], RB[14];
        const __amdgpu_buffer_rsrc_t rsI = __builtin_amdgcn_make_buffer_rsrc((void*)(IMG + chd0 * IMG_ELEMS), (short)0, NCH * NH * IMG_ELEMS * 2, 0x00020000);
#define SH_LOADIMG(dst, nn) do { _Pragma("unroll") for (int i_ = 0; i_ < 14; ++i_) dst[i_] = __builtin_amdgcn_raw_buffer_load_b128(rsI, (unsigned)ht * 16u, (unsigned)(nn) * (unsigned)(NH * IMG_ELEMS * 2) + (unsigned)i_ * 4096u, 0); } while (0)
#define SH_STOREIMG(src, bufoff) do { LAS v4u* p_ = (LAS v4u*)(lds + (bufoff)) + ht; _Pragma("unroll") for (int i_ = 0; i_ < 14; ++i_) p_[i_ * 256] = src[i_]; } while (0)
#define SH_EPI(mm, otoff) do { const LAS v4u* op_ = (const LAS v4u*)(lds + (otoff) + (tok * OT_LD + 32 * q) * 2); \
        v4u* yp_ = (v4u*)(OB + ((size_t)b * SEQ + (size_t)(mm) * CH + tok) * old_ + h * HD + 32 * q); \
        _Pragma("unroll") for (int i_ = 0; i_ < 4; ++i_) yp_[i_] = op_[i_]; } while (0)
#define SH_STEP(nn, Rcur, Rnext, bufnext, otprev) do { \
        if ((nn) + 2 < NCH) SH_LOADIMG(Rcur, (nn) + 2); \
        if ((nn) >= 1) SH_EPI((nn) - 1, otprev); \
        if ((nn) + 1 < NCH) SH_STOREIMG(Rnext, bufnext); \
        RAW_BAR(); } while (0)
        SH_LOADIMG(RA, 0); SH_LOADIMG(RB, 1);
        SH_STOREIMG(RA, 0);
        RAW_BAR();
#pragma unroll 1
        for (int n = 0; n < NCH; n += 2) { SH_STEP(n, RA, RB, SCB, OT_OFF + OT_BYTES); SH_STEP(n + 1, RB, RA, 0, OT_OFF); }
        SH_EPI(NCH - 1, OT_OFF + OT_BYTES);
#undef SH_STEP
#undef SH_EPI
#undef SH_STOREIMG
#undef SH_LOADIMG
#endif
    }
}

__device__ __forceinline__ void phase_dn_norm(const Frame& F0, const Args& a, int layer) {
    PHASE_FRAME(F0);
    unsigned char* ws = OPQ_G(unsigned char, a.ws);
    const bf16* PROJ = (const bf16*)(ws + WS_PROJ); bf16* MIXIN = (bf16*)(ws + WS_MIXIN);
    const bf16* OSRC = FP8_PDL(layer) ? (const bf16*)((unsigned char*)a.out + 64 * MiB) : (const bf16*)(ws + WS_MIXIN); const int old_ = FP8_PDL(layer) ? DNW : D;
    const int lane = F.lane, gw = F.vcu * NWAVES + F.wave, NGW = F.G * NWAVES;
    const float* nw = a.in[I_NORMW] + layer * HD + 16 * (lane & 7); f32x4 nwv[4];
#pragma unroll
    for (int i = 0; i < 4; ++i) nwv[i] = *(const f32x4*)(nw + 4 * i);
    v4u OA[2], ZA[2], OB[2], ZB[2];
#define DNN_LOAD(O_, Z_, t) do { const v4u* op_ = (const v4u*)(OSRC + (size_t)(t) * old_ + 16 * lane); const v4u* zp_ = (const v4u*)(PROJ + (size_t)(t) * NPROJ + 3072 + 16 * lane); O_[0] = op_[0]; O_[1] = op_[1]; Z_[0] = zp_[0]; Z_[1] = zp_[1]; } while (0)
#define DNN_ROW(O_, Z_, t) do { float ss = 0.f; \
        _Pragma("unroll") for (int i = 0; i < 2; ++i) _Pragma("unroll") for (int j = 0; j < 4; ++j) { const float x0 = bflo(O_[i][j]), x1 = bfhi(O_[i][j]); ss += x0 * x0 + x1 * x1; } \
        ss = row8_sum(ss); const float rr = 1.0f / sqrtf(ss * (1.0f / HD) + RMS_EPS); \
        v4u* yp_ = (v4u*)(MIXIN + (size_t)(t) * D + 16 * lane); float yv_[16]; \
        _Pragma("unroll") for (int i = 0; i < 2; ++i) { _Pragma("unroll") for (int j = 0; j < 4; ++j) { const float z0 = bflo(Z_[i][j]), z1 = bfhi(Z_[i][j]); const f32x4 nn = nwv[2 * i + (j >> 1)]; \
            yv_[8 * i + 2 * j] = bflo(O_[i][j]) * rr * nn[2 * (j & 1)] * z0 * sigmoidf_(z0); yv_[8 * i + 2 * j + 1] = bfhi(O_[i][j]) * rr * nn[2 * (j & 1) + 1] * z1 * sigmoidf_(z1); } } \
        if (FP8_PDL(layer)) { v4u o8_; _Pragma("unroll") for (int q4 = 0; q4 < 4; ++q4) o8_[q4] = pk4_fp8(yv_[4 * q4] * F8_XS, yv_[4 * q4 + 1] * F8_XS, yv_[4 * q4 + 2] * F8_XS, yv_[4 * q4 + 3] * F8_XS); *(v4u*)((unsigned char*)MIXIN + (size_t)(t) * D + 16 * lane) = o8_; } \
        else { _Pragma("unroll") for (int i = 0; i < 2; ++i) { v4u o_; _Pragma("unroll") for (int j = 0; j < 4; ++j) o_[j] = pkbf(yv_[8 * i + 2 * j], yv_[8 * i + 2 * j + 1]); yp_[i] = o_; } } } while (0)
    if (gw < T) DNN_LOAD(OA, ZA, gw);
#pragma unroll 1
    for (int t = gw; t < T; t += 2 * NGW) {
        if (t + NGW < T) DNN_LOAD(OB, ZB, t + NGW);
        DNN_ROW(OA, ZA, t);
        if (t + 2 * NGW < T) DNN_LOAD(OA, ZA, t + 2 * NGW);
        if (t + NGW < T) DNN_ROW(OB, ZB, t + NGW);
    }
#undef DNN_LOAD
#undef DNN_ROW
}

constexpr int WG_LD = 2056;
__device__ __forceinline__ void phase_ln1_router(const Frame& F0, const Args& a, int layer, int probe = 0, int f8 = 0) {
    PHASE_FRAME(F0);
    unsigned char* ws = OPQ_G(unsigned char, a.ws);
    LAS bf16* WgT = (LAS bf16*)F.lds;
    LAS float* GV = (LAS float*)(F.lds + 16 * WG_LD * 2);
    LAS float* part = GV + 2 * D;
    LAS float* rst = part + 2 * 64 * 16;
    LAS float* sgcb = rst + 128;
    LAS int* rowE = (LAS int*)(F.lds + AUX_OFF); LAS int* rowP = rowE + 128; LAS float* rowG = (LAS float*)(rowP + 128); LAS int* lcnt = (LAS int*)(rowG + 128); LAS int* lbase = lcnt + 16;
    const float* wr = OPQ_G(const float, a.in[I_WR]); const float* br = OPQ_G(const float, a.in[I_BR]);
    const float* g1 = a.in[I_LN1G] + (size_t)layer * D; const float* b1 = a.in[I_LN1B] + (size_t)layer * D;
    const int tid = F.tid, lane = F.lane, wave = F.wave;
    for (int i = tid; i < D; i += 512) { GV[i] = g1[i]; GV[D + i] = b1[i]; }
    { const int e = tid & 15, kp = tid >> 4; float s1 = 0.f, s2 = 0.f;
        for (int k = 64 * kp; k < 64 * kp + 64; k += 2) { const float w0 = wr[(size_t)k * NE + e], w1 = wr[(size_t)(k + 1) * NE + e]; const unsigned pk = pkbf(g1[k] * w0, g1[k + 1] * w1);
            *(LAS unsigned*)(WgT + e * WG_LD + k) = pk; s1 += bflo(pk) + bfhi(pk); s2 += b1[k] * w0 + b1[k + 1] * w1; }
        part[kp * 16 + e] = s1; part[512 + kp * 16 + e] = s2; }
    __syncthreads();
    if (tid < 32) { const int e = tid & 15, which = tid >> 4; float s = 0.f; for (int kp = 0; kp < 32; ++kp) s += part[which * 512 + kp * 16 + e]; sgcb[which * 16 + e] = which ? s + br[e] : s; }
    __syncthreads();
    const bf16* PRE = (const bf16*)a.out; bf16* X1B = (bf16*)(ws + (probe ? WS_R1 : WS_X1B)); float* STATS = (float*)(ws + (probe ? WS_R1 + 70 * MiB : WS_STATS));
    int* LIST = (int*)(ws + (probe ? WS_R1 + 72 * MiB : WS_LIST)); int* TOKSLOT = (int*)(ws + (probe ? WS_R1 + 80 * MiB : WS_TOKSLOT)); float* GATEW = (float*)(ws + (probe ? WS_R1 + 82 * MiB : WS_GATEW));
    gu32* cnt = F.ctl + CW_CNT + 64 * (layer + (probe ? 2 : 0));
    for (int rb = F.vcu; rb < T / 64; rb += F.G) {
        if (tid < 16) lcnt[tid] = 0;
        v2u XA[8], XB_[8];
#define PE_LOAD(X, r) do { const GAS v2u* xr_ = (const GAS v2u*)(PRE + (size_t)(rb * 64 + wave * 8 + (r)) * D) + lane; _Pragma("unroll") for (int j = 0; j < 8; ++j) X[j] = xr_[64 * j]; } while (0)
#define PE_ROW(X, r) do { const int lr = wave * 8 + (r), row = rb * 64 + lr; unsigned gvo_ = (unsigned)(uintptr_t)GV; asm volatile("" : "+v"(gvo_)); const LAS float* GVr = (const LAS float*)(uintptr_t)gvo_; \
            f32x4 v[8]; float s = 0.f; \
            _Pragma("unroll") for (int j = 0; j < 8; ++j) { v[j] = (f32x4){bflo(X[j].x), bfhi(X[j].x), bflo(X[j].y), bfhi(X[j].y)}; s += (v[j][0] + v[j][1]) + (v[j][2] + v[j][3]); } \
            const float mean = wave_sum(s) * (1.f / D); float s2 = 0.f; \
            _Pragma("unroll") for (int j = 0; j < 8; ++j) { v[j] = v[j] - mean; s2 += (v[j][0] * v[j][0] + v[j][1] * v[j][1]) + (v[j][2] * v[j][2] + v[j][3] * v[j][3]); } \
            const float rstd = 1.f / sqrtf(wave_sum(s2) * (1.f / D) + LN_EPS); \
            if (lane == 0) { STATS[2 * row] = mean; STATS[2 * row + 1] = rstd; rst[2 * lr] = mean; rst[2 * lr + 1] = rstd; } \
            GAS v2u* o8 = (GAS v2u*)(X1B + (size_t)row * D) + lane; \
            _Pragma("unroll") for (int j = 0; j < 8; ++j) { const f32x4 gg = *(const LAS f32x4*)(GVr + 256 * j + 4 * lane), bb = *(const LAS f32x4*)(GVr + D + 256 * j + 4 * lane); \
                v[j] = v[j] * rstd * gg + bb; \
                if (f8) ((GAS unsigned*)((GAS unsigned char*)X1B + (size_t)row * D) + lane)[64 * j] = pk4_fp8(v[j][0] * F8_XS, v[j][1] * F8_XS, v[j][2] * F8_XS, v[j][3] * F8_XS); \
                else { v2u w; w.x = pkbf(v[j][0], v[j][1]); w.y = pkbf(v[j][2], v[j][3]); o8[64 * j] = w; } } } while (0)
        PE_LOAD(XA, 0);
#pragma unroll 1
        for (int r = 0; r < 8; r += 2) { PE_LOAD(XB_, r + 1); PE_ROW(XA, r); if (r + 2 < 8) PE_LOAD(XA, r + 2); PE_ROW(XB_, r + 1); }
#undef PE_LOAD
#undef PE_ROW
        { const int mt = wave & 3, kh = wave >> 2, fr = lane & 15, fg = lane >> 4; typedef float f32x4v __attribute__((ext_vector_type(4))); f32x4v acc = {0.f, 0.f, 0.f, 0.f};
            const bf16* arow = PRE + (size_t)(rb * 64 + 16 * mt + fr) * D + 1024 * kh + 8 * fg; const LAS bf16* brow = WgT + fr * WG_LD + 1024 * kh + 8 * fg;
#pragma unroll 1
            for (int sb = 0; sb < 32; sb += 8) { bf16x8 aq[8];
#pragma unroll
                for (int s = 0; s < 8; ++s) aq[s] = *(const bf16x8*)(arow + 32 * (sb + s));
                asm volatile("" : "+v"(aq[0]), "+v"(aq[1]), "+v"(aq[2]), "+v"(aq[3]), "+v"(aq[4]), "+v"(aq[5]), "+v"(aq[6]), "+v"(aq[7]));
#pragma unroll
                for (int s = 0; s < 8; ++s) acc = __builtin_amdgcn_mfma_f32_16x16x32_bf16(aq[s], *(const LAS bf16x8*)(brow + 32 * (sb + s)), acc, 0, 0, 0); }
#pragma unroll
            for (int r = 0; r < 4; ++r) part[(kh * 64 + 16 * mt + 4 * fg + r) * 16 + fr] = acc[r]; }
        __syncthreads();
        if (tid < 64) { const int lr = tid; const float mean = rst[2 * lr], rstd = rst[2 * lr + 1]; float p[16]; float mx = -3.0e38f;
#pragma unroll
            for (int e = 0; e < 16; ++e) { p[e] = rstd * ((part[lr * 16 + e] + part[(64 + lr) * 16 + e]) - mean * sgcb[e]) + sgcb[16 + e]; mx = fmaxf(mx, p[e]); }
#pragma unroll
            for (int e = 0; e < 16; ++e) p[e] = __expf(p[e] - mx);
            float gsc[4];
#pragma unroll
            for (int g = 0; g < 4; ++g) { const float a0 = p[4 * g], a1 = p[4 * g + 1], a2 = p[4 * g + 2], a3 = p[4 * g + 3];
                const float hi1 = fmaxf(a0, a1), lo1 = fminf(a0, a1), hi2 = fmaxf(a2, a3), lo2 = fminf(a2, a3);
                gsc[g] = fmaxf(hi1, hi2) + fmaxf(fminf(hi1, hi2), fmaxf(lo1, lo2)); }
            int gsel = 0; float best = gsc[0];
#pragma unroll
            for (int g = 1; g < 4; ++g) if (gsc[g] > best) { best = gsc[g]; gsel = g; }
            float q[4];
#pragma unroll
            for (int j = 0; j < 4; ++j) q[j] = gsel == 0 ? p[j] : (gsel == 1 ? p[4 + j] : (gsel == 2 ? p[8 + j] : p[12 + j]));
            int i0 = 0; float p0 = q[0];
#pragma unroll
            for (int j = 1; j < 4; ++j) if (q[j] > p0) { p0 = q[j]; i0 = j; }
            int i1 = -1; float p1 = -1.f;
#pragma unroll
            for (int j = 0; j < 4; ++j) if (j != i0 && q[j] > p1) { p1 = q[j]; i1 = j; }
            const int e0 = gsel * 4 + i0, e1 = gsel * 4 + i1; const float inv = 1.0f / (p0 + p1);
            rowE[2 * lr] = e0; rowE[2 * lr + 1] = e1; rowG[2 * lr] = p0 * inv; rowG[2 * lr + 1] = p1 * inv;
            rowP[2 * lr] = __hip_atomic_fetch_add(&lcnt[e0], 1, __ATOMIC_RELAXED, __HIP_MEMORY_SCOPE_WORKGROUP); rowP[2 * lr + 1] = __hip_atomic_fetch_add(&lcnt[e1], 1, __ATOMIC_RELAXED, __HIP_MEMORY_SCOPE_WORKGROUP); }
        __syncthreads();
        if (tid < 16) lbase[tid] = (int)__hip_atomic_fetch_add(cnt + tid, (unsigned)lcnt[tid], RLX_AGENT);
        __syncthreads();
        if (tid < 128) { const int e = rowE[tid], pos = lbase[e] + rowP[tid], tok = rb * 64 + (tid >> 1);
            LIST[(size_t)e * LCAP + pos] = tok; TOKSLOT[2 * tok + (tid & 1)] = e * LCAP + pos; GATEW[2 * tok + (tid & 1)] = rowG[tid]; }
        __syncthreads();
    }
}
__device__ __forceinline__ void moe_table(const Frame& F0, int layer) {
    PHASE_FRAME(F0);
    LAS int* tab = (LAS int*)(F.lds + AUX_OFF);
    __syncthreads();
    if (F.tid < 16) tab[32 + F.tid] = (int)__hip_atomic_load(F.ctl + CW_CNT + 64 * layer + F.tid, RLX_AGENT);
    __syncthreads();
    if (F.tid == 0) { int blk = 0, nf = 0, nh = 0; for (int e = 0; e < 16; ++e) { const int cn = tab[32 + e]; tab[e] = blk; tab[48 + e] = nf; tab[80 + e] = nh; blk += (cn + 127) >> 7; nf += cn >> 8; nh += ((cn & 255) + 127) >> 7; } tab[16] = blk; tab[64] = nf; tab[96] = nh; }
    __syncthreads();
}
__device__ __forceinline__ void phase_combine_ln2(const Frame& F0, const Args& a, int layer, int probe = 0, int f8 = 0) {
    PHASE_FRAME(F0);
    unsigned char* ws = OPQ_G(unsigned char, a.ws); const LAS int* tab = (const LAS int*)(F.lds + AUX_OFF);
    const bf16* PRE = (const bf16*)a.out; const float* STATS = (const float*)(ws + WS_STATS); const bf16* Y = (const bf16*)(ws + WS_Y); bf16* X2B = (bf16*)(ws + (probe ? WS_R1 : WS_X2B)); unsigned char* X2F8 = ws + WS_X2F8;
    const int* TOKSLOT = (const int*)(ws + WS_TOKSLOT); const float* GATEW = (const float*)(ws + WS_GATEW);
    LAS float* GV = (LAS float*)F.lds;
    { const float* g1 = a.in[I_LN1G] + (size_t)layer * D; const float* b1 = a.in[I_LN1B] + (size_t)layer * D; const float* g2 = a.in[I_LN2G] + (size_t)layer * D; const float* b2 = a.in[I_LN2B] + (size_t)layer * D;
        for (int i = F.tid; i < D; i += 512) { GV[i] = g1[i]; GV[D + i] = b1[i]; GV[2 * D + i] = g2[i]; GV[3 * D + i] = b2[i]; } }
    __syncthreads();
    const int gw = F.vcu * NWAVES + F.wave, NGW = F.G * NWAVES, nrows = (T - gw + NGW - 1) / NGW, lane = F.lane;
    for (int base = 0; base < nrows; base += 64) {
        const int nr = (nrows - base) < 64 ? (nrows - base) : 64;
        float m_mean = 0.f, m_rstd = 0.f, m_w0 = 0.f, m_w1 = 0.f; int m_y0 = 0, m_y1 = 0;
        if (lane < nr) { const int row = gw + NGW * (base + lane); m_mean = STATS[2 * row]; m_rstd = STATS[2 * row + 1]; m_w0 = GATEW[2 * row]; m_w1 = GATEW[2 * row + 1];
            const int s0 = TOKSLOT[2 * row], s1 = TOKSLOT[2 * row + 1]; m_y0 = tab[s0 / LCAP] * 128 + (s0 % LCAP); m_y1 = tab[s1 / LCAP] * 128 + (s1 % LCAP); }
        v2u XA[8], PA[8], QA[8], XB_[8], PB_[8], QB_[8];
#define PH_LOAD(X, P, Q, i) do { const int row_ = gw + NGW * (base + (i)); const size_t y0_ = (size_t)__builtin_amdgcn_readlane(m_y0, (i)), y1_ = (size_t)__builtin_amdgcn_readlane(m_y1, (i)); \
            const GAS v2u* xr_ = (const GAS v2u*)(PRE + (size_t)row_ * D) + lane; const GAS v2u* ya_ = (const GAS v2u*)(Y + y0_ * D) + lane; const GAS v2u* yb_ = (const GAS v2u*)(Y + y1_ * D) + lane; \
            _Pragma("unroll") for (int j = 0; j < 8; ++j) { X[j] = xr_[64 * j]; P[j] = ya_[64 * j]; Q[j] = yb_[64 * j]; } } while (0)
#define PH_ROW(X, P, Q, i) do { const int row_ = gw + NGW * (base + (i)); unsigned gvo_ = (unsigned)(uintptr_t)GV; asm volatile("" : "+v"(gvo_)); const LAS float* GVr = (const LAS float*)(uintptr_t)gvo_;     \
            const float mean = __builtin_bit_cast(float, __builtin_amdgcn_readlane(__builtin_bit_cast(int, m_mean), (i))), rstd = __builtin_bit_cast(float, __builtin_amdgcn_readlane(__builtin_bit_cast(int, m_rstd), (i))); \
            const float w0 = __builtin_bit_cast(float, __builtin_amdgcn_readlane(__builtin_bit_cast(int, m_w0), (i))), w1 = __builtin_bit_cast(float, __builtin_amdgcn_readlane(__builtin_bit_cast(int, m_w1), (i))); \
            f32x4 v[8]; float s = 0.f; \
            _Pragma("unroll") for (int j = 0; j < 8; ++j) { const f32x4 gg = *(const LAS f32x4*)(GVr + 256 * j + 4 * lane), bb = *(const LAS f32x4*)(GVr + D + 256 * j + 4 * lane); \
                const f32x4 x1 = ((f32x4){bflo(X[j].x), bfhi(X[j].x), bflo(X[j].y), bfhi(X[j].y)} - mean) * rstd * gg + bb; \
                f32x4 f; f[0] = w0 * bflo(P[j].x) + w1 * bflo(Q[j].x); f[1] = w0 * bfhi(P[j].x) + w1 * bfhi(Q[j].x); f[2] = w0 * bflo(P[j].y) + w1 * bflo(Q[j].y); f[3] = w0 * bfhi(P[j].y) + w1 * bfhi(Q[j].y); \
                v[j] = x1 * ALPHA + f; s += (v[j][0] + v[j][1]) + (v[j][2] + v[j][3]); } \
            const float m2 = wave_sum(s) * (1.f / D); float q = 0.f; \
            _Pragma("unroll") for (int j = 0; j < 8; ++j) { v[j] = v[j] - m2; q += (v[j][0] * v[j][0] + v[j][1] * v[j][1]) + (v[j][2] * v[j][2] + v[j][3] * v[j][3]); } \
            const float r2 = 1.f / sqrtf(wave_sum(q) * (1.f / D) + LN_EPS); \
            GAS v2u* o8 = (GAS v2u*)(X2B + (size_t)row_ * D) + lane; \
            _Pragma("unroll") for (int j = 0; j < 8; ++j) { const f32x4 gg = *(const LAS f32x4*)(GVr + 2 * D + 256 * j + 4 * lane), bb = *(const LAS f32x4*)(GVr + 3 * D + 256 * j + 4 * lane); \
                const f32x4 o = v[j] * r2 * gg + bb; v2u w; w.x = pkbf(o[0], o[1]); w.y = pkbf(o[2], o[3]); o8[64 * j] = w; \
                if (f8) ((GAS unsigned*)((GAS unsigned char*)X2F8 + (size_t)row_ * D) + lane)[64 * j] = pk4_fp8(o[0] * F8_XS, o[1] * F8_XS, o[2] * F8_XS, o[3] * F8_XS); } } while (0)
        PH_LOAD(XA, PA, QA, 0);
#pragma unroll 1
        for (int i = 0; i < nr; i += 2) {
            if (i + 1 < nr) PH_LOAD(XB_, PB_, QB_, i + 1);
            PH_ROW(XA, PA, QA, i);
            if (i + 2 < nr) PH_LOAD(XA, PA, QA, i + 2);
            if (i + 1 < nr) PH_ROW(XB_, PB_, QB_, i + 1);
        }
#undef PH_LOAD
#undef PH_ROW
    }
}

#ifndef MK_N_LAUNCHES
#define MK_N_LAUNCHES 1
#endif
constexpr int NPL = 10;
constexpr int NPHASE = 1 + NPL * DEPTH;
constexpr int N_LAUNCHES = MK_N_LAUNCHES;
static_assert(N_LAUNCHES == 1 || N_LAUNCHES == NPHASE, "MK_N_LAUNCHES is 1 or NPHASE");

#define GRID_BAR() do { if (N_LAUNCHES == 1) xcd_barrier(bar); } while (0)
#ifndef PH_MASK
#define PH_MASK 0x7ff
#endif
#define IN(k) ((((k) == 0 ? 1u : (2u << (((k) - 1) % NPL))) & (unsigned)(PH_MASK)) && lo <= (k) && (k) < hi)
#define SEAM(k) do { if (IN((k) + 1)) GRID_BAR(); } while (0)
#ifndef PROBE_DUP
#define PROBE_DUP 0
#endif
#define REPS(k) ((((k) == 0 ? 1u : (2u << (((k) - 1) % NPL))) & (unsigned)(PROBE_DUP)) ? 2 : 1)

template <int layer> __device__ __forceinline__ void layer_phases(const Frame& F, const Args& args, const XcdBarrier& bar, const int lo, const int hi) {
            const int pb = 1 + NPL * layer;
            unsigned char* ws = OPQ_G(unsigned char, args.ws);
            if (IN(pb + 0)) { for (int rep = 0; rep < REPS(pb + 0); ++rep) { if (rep) GRID_BAR();
                SchedDense S; S.init(T, NPROJ, F.G, (int)blockIdx.x, ws + WS_XB, D, (const bf16*)(ws + WS_WIN) + (size_t)layer * NPROJ * D, D);
                EpiBf16 E{(bf16*)(ws + WS_PROJ), NPROJ};
                pg8::gemm_phase<EpiBf16, SchedDense, false>(F.lds + RING_OFF, D, D, D, S, E);
                } SEAM(pb + 0);
            }
            if (IN(pb + 1)) { for (int rep = 0; rep < REPS(pb + 1); ++rep) { if (rep) GRID_BAR(); phase_dn_prep(F, args, layer); } SEAM(pb + 1); }
            if (IN(pb + 2)) { for (int rep = 0; rep < REPS(pb + 2); ++rep) { if (rep) GRID_BAR();
                if (blockIdx.x < 32 || F.G <= 32) { for (int u = blockIdx.x; u < NB * NH; u += (F.G < 32 ? F.G : 32)) { phase_dn_scan(F, args, layer, u);
#ifdef SCAN_TWICE
                    __syncthreads(); phase_dn_scan(F, args, layer, u);
#endif
                } }
                { const bool big = F.G >= 160; const int NGEMM = big ? 96 : (F.G > 32 ? F.G - 32 : F.G); const int c2 = F.G > 32 ? (int)blockIdx.x - 32 : (int)blockIdx.x;
                  if (c2 >= 0 && c2 < NGEMM) {
                    { int t_ = threadIdx.x; asm volatile("" : "+v"(t_)); Frame Fp = F; Fp.tid = t_; Fp.lane = t_ & 63;
                      for (int L = c2; L < 256; L += NGEMM) pool_diffs_unit(Fp, ws, L >> 2, L & 3);
                      asm volatile("s_waitcnt vmcnt(0)" ::: "memory"); __syncthreads(); }
                    { SchedPool S{NGEMM, c2, (const char*)(ws + WS_POOLD), (const char*)((const bf16*)(ws + WS_WPOOL) + (size_t)layer * 4 * 65536)};
                      EpiPool E{(bf16*)(ws + WS_MIXIN), args.in[I_POOLS] + (size_t)layer * PW, FP8_PDL(layer)};
                      pg8::gemm_phase<EpiPool, SchedPool, false>(F.lds + RING_OFF, 256, PW, 256, S, E); }
                    { SchedDense S; S.init(T, D, NGEMM, c2, (const bf16*)(ws + WS_PB16) + (size_t)layer * T * PLE, PLE, (const bf16*)(ws + WS_WPP) + (size_t)layer * D * PLE, PLE);
                      EpiBf16 E{(bf16*)(ws + WS_PP), D};
                      pg8::gemm_phase<EpiBf16, SchedDense, false>(F.lds + RING_OFF, PLE, PLE, PLE, S, E); } }
#ifndef CONVERT_ALL_IN_PROLOGUE
                  __syncthreads();
                  { int t_ = threadIdx.x; asm volatile("" : "+v"(t_));
                    weight_items(args, ws, (LAS float*)(F.lds + RING_OFF + F.wave * 16384), t_ & 63, 1, layer, 0, 1, F.ctl + CW_CONV + 64 * layer); }
#endif
                }
                } SEAM(pb + 2);
            }
            if (IN(pb + 3)) { for (int rep = 0; rep < REPS(pb + 3); ++rep) { if (rep) GRID_BAR(); phase_dn_norm(F, args, layer); } SEAM(pb + 3); }
            if (IN(pb + 4)) { for (int rep = 0; rep < REPS(pb + 4); ++rep) { if (rep) GRID_BAR();
                if (FP8_PDL(layer)) { SchedDense S; S.init(T, D, F.G, (int)blockIdx.x, ws + WS_MIXIN, D / 2, ws + WS_WOUT + (size_t)layer * D * D * 2, D / 2);
                    EpiRes E{(const bf16*)(ws + WS_XB), (bf16*)args.out, F8_INV};
                    pg8::gemm_phase<EpiRes, SchedDense, false, true>(F.lds + RING_OFF, D / 2, D / 2, D / 2, S, E); }
                else { SchedDense S; S.init(T, D, F.G, (int)blockIdx.x, ws + WS_MIXIN, D, (const bf16*)(ws + WS_WOUT) + (size_t)layer * D * D, D);
                EpiRes E{(const bf16*)(ws + WS_XB), (bf16*)args.out};
#ifdef PROBE_PD
                { EpiRes E2{(const bf16*)(ws + WS_XB), (bf16*)(ws + WS_R1)}; pg8::gemm_phase<EpiRes, SchedDense, false>(F.lds + RING_OFF, D, D, D, S, E2); }
#endif
                pg8::gemm_phase<EpiRes, SchedDense, false>(F.lds + RING_OFF, D, D, D, S, E); }
                } SEAM(pb + 4);
            }
            if (IN(pb + 5)) { for (int rep = 0; rep < REPS(pb + 5); ++rep) { if (rep) GRID_BAR();
#ifdef PROBE_PE
                phase_ln1_router(F, args, layer, 1); __syncthreads();
#endif
                phase_ln1_router(F, args, layer, 0, FP8_LAYER(layer) ? 1 : 0); } SEAM(pb + 5); }
            if (IN(pb + 6)) { for (int rep = 0; rep < REPS(pb + 6); ++rep) { if (rep) GRID_BAR();
                moe_table(F, layer);
                if (FP8_LAYER(layer)) {
                    SchedMoe S{F.G, (int)blockIdx.x, 0, (const LAS int*)(F.lds + AUX_OFF), (const char*)(ws + WS_X1B), (const char*)(ws + WS_WGU + (size_t)layer * NE * 2048 * D * 2), (const int*)(ws + WS_LIST), 1};
                    EpiSwiglu E{(bf16*)(ws + WS_HID), FP8_PG, F8_INV};
                    pg8::gemm_phase<EpiSwiglu, SchedMoe, true, true>(F.lds + RING_OFF, D / 2, D / 2, D / 2, S, E);
                } else {
                    SchedMoe S{F.G, (int)blockIdx.x, 0, (const LAS int*)(F.lds + AUX_OFF), (const char*)(ws + WS_X1B), (const char*)((const bf16*)(ws + WS_WGU) + (size_t)layer * NE * 2048 * D), (const int*)(ws + WS_LIST), 2};
                    EpiSwiglu E{(bf16*)(ws + WS_HID)};
                    pg8::gemm_phase<EpiSwiglu, SchedMoe, true>(F.lds + RING_OFF, D, D, D, S, E);
                }
                } SEAM(pb + 6);
            }
            if (IN(pb + 7)) { for (int rep = 0; rep < REPS(pb + 7); ++rep) { if (rep) GRID_BAR();
                moe_table(F, layer);
                if (FP8_PG && FP8_LAYER(layer)) {
                    SchedMoe S{F.G, (int)blockIdx.x, 1, (const LAS int*)(F.lds + AUX_OFF), (const char*)(ws + WS_HID), (const char*)(ws + WS_WD + (size_t)layer * NE * D * DE * 2), nullptr, 1};
                    EpiBf16 E{(bf16*)(ws + WS_Y), D, F8_INV};
                    pg8::gemm_phase<EpiBf16, SchedMoe, false, true>(F.lds + RING_OFF, DE / 2, DE / 2, DE / 2, S, E);
                } else {
                    SchedMoe S{F.G, (int)blockIdx.x, 1, (const LAS int*)(F.lds + AUX_OFF), (const char*)(ws + WS_HID), (const char*)((const bf16*)(ws + WS_WD) + (size_t)layer * NE * D * DE), nullptr, 2};
                    EpiBf16 E{(bf16*)(ws + WS_Y), D};
                    pg8::gemm_phase<EpiBf16, SchedMoe, false>(F.lds + RING_OFF, DE, DE, DE, S, E);
                }
                } SEAM(pb + 7);
            }
            if (IN(pb + 8)) { for (int rep = 0; rep < REPS(pb + 8); ++rep) { if (rep) GRID_BAR(); moe_table(F, layer);
#ifdef PROBE_PH
                phase_combine_ln2(F, args, layer, 1);
#endif
                phase_combine_ln2(F, args, layer, 0, (FP8_PI && (FP8_PI0 || layer == DEPTH - 1)) ? 1 : 0); } SEAM(pb + 8); }
            if (IN(pb + 9)) { for (int rep = 0; rep < REPS(pb + 9); ++rep) { if (rep) GRID_BAR();
                if (FP8_PI && (FP8_PI0 || layer == DEPTH - 1)) {
                    SchedDense S; S.init(T, D, F.G, (int)blockIdx.x, ws + WS_X2F8, D / 2, ws + WS_WPG + (size_t)layer * D * D * 2, D / 2);
                    EpiPle E{(const bf16*)(ws + WS_X2B), (const bf16*)(ws + WS_PP), (bf16*)(ws + WS_XB), args.out, layer + 1 < DEPTH ? 0 : 1, F8_INV};
                    pg8::gemm_phase<EpiPle, SchedDense, false, true>(F.lds + RING_OFF, D / 2, D / 2, D / 2, S, E);
                } else {
                    SchedDense S; S.init(T, D, F.G, (int)blockIdx.x, ws + WS_X2B, D, (const bf16*)(ws + WS_WPG) + (size_t)layer * D * D, D);
                    EpiPle E{(const bf16*)(ws + WS_X2B), (const bf16*)(ws + WS_PP), (bf16*)(ws + WS_XB), args.out, layer + 1 < DEPTH ? 0 : 1};
                    pg8::gemm_phase<EpiPle, SchedDense, false>(F.lds + RING_OFF, D, D, D, S, E);
                }
                } SEAM(pb + 9);
            }
}
__global__ void __launch_bounds__(NWAVES * 64, 2) trunk_fwd(Args args) {
    extern __shared__ __attribute__((aligned(16))) unsigned char lds[];
    Frame F;
    F.lds = (LAS unsigned char*)lds;
    F.MISC = (volatile LAS unsigned*)(F.lds + MISC_OFF);
    F.tid = threadIdx.x; F.lane = F.tid & 63; F.wave = __builtin_amdgcn_readfirstlane(F.tid >> 6);
    F.G = gridDim.x; { const int bx = blockIdx.x; F.vcu = (F.G % 8 == 0) ? (bx % 8) * (F.G / 8) + bx / 8 : bx; }
    unsigned char* ws = args.ws;
    F.ctl = (gu32*)(ws + WS_CTL);
    for (int u = F.tid; u < (LDS_BYTES - LDSCTL_OFF) / 4; u += NWAVES * 64) ((LAS unsigned*)(F.lds + LDSCTL_OFF))[u] = 0u;
    __syncthreads();
    XcdBarrier bar; bar.bar = (unsigned*)(F.ctl + CW_BAR); bar.x = 0; bar.st = nullptr;
    if (N_LAUNCHES == 1) bar = xcd_barrier_post((unsigned*)(F.ctl + CW_BAR), F.MISC + 8);
    const int lo = args.ph_lo, hi = args.ph_hi;
    if (IN(0)) { for (int rep = 0; rep < REPS(0); ++rep) { if (rep) GRID_BAR(); p0_prologue(F, args); } SEAM(0); }

    layer_phases<0>(F, args, bar, lo, hi);
    layer_phases<1>(F, args, bar, lo, hi);
    static_assert(DEPTH == 2, "layer_phases instantiations");
#undef IN
#undef SEAM
#undef GRID_BAR
}

extern "C" void kernel_launch(void* const* d_in, const int* in_sizes, int n_in, void* d_out, int out_size, void* d_ws, size_t ws_size, hipStream_t stream) {
    static int grid = 0;
    if (grid == 0) {
        if (n_in != 21 || in_sizes[0] != T * D || out_size != T * D || ws_size < WS_END) { fprintf(stderr, "kernel_launch: unexpected shapes (n_in %d, in0 %d, out %d, ws %zu); nothing launched\n", n_in, n_in > 0 ? in_sizes[0] : -1, out_size, ws_size); grid = -1; return; }
        int dev = 0, cus = 0, per_cu = 0;
        if (hipGetDevice(&dev) != hipSuccess || hipDeviceGetAttribute(&cus, hipDeviceAttributeMultiprocessorCount, dev) != hipSuccess) { grid = -1; return; }
        if (hipFuncSetAttribute((const void*)trunk_fwd, hipFuncAttributeMaxDynamicSharedMemorySize, LDS_BYTES) != hipSuccess) { fprintf(stderr, "kernel_launch: hipFuncSetAttribute failed\n"); grid = -1; return; }
        if (hipOccupancyMaxActiveBlocksPerMultiprocessor(&per_cu, (const void*)trunk_fwd, NWAVES * 64, LDS_BYTES) != hipSuccess || per_cu < 1) { fprintf(stderr, "kernel_launch: occupancy query reports %d workgroups per CU\n", per_cu); }
        (void)hipGetLastError();
        grid = cus;
    }
    if (grid < 0) return;
    if (hipMemsetAsync((char*)d_ws + WS_CTL, 0, CTL_ZERO_BYTES, stream) != hipSuccess) return;
    Args a{};
    for (int i = 0; i < 21; ++i) a.in[i] = (const float*)d_in[i];
    a.out = (float*)d_out; a.ws = (unsigned char*)d_ws;
    for (int li = 0; li < N_LAUNCHES; ++li) {
        a.ph_lo = (N_LAUNCHES == 1) ? 0 : li; a.ph_hi = (N_LAUNCHES == 1) ? NPHASE : li + 1; a.li = li; a.pad = 0;
        hipLaunchKernelGGL(trunk_fwd, dim3(grid), dim3(NWAVES * 64), LDS_BYTES, stream, a);
        const hipError_t le = hipPeekAtLastError();
        if (le != hipSuccess) { fprintf(stderr, "kernel_launch: launch %d failed: %s\n", li, hipGetErrorName(le)); break; }
    }
}
```

```cpp
#define MK_N_LAUNCHES 1
#define FP8_ALL 1
#define FP8_PG 1
#define FP8_PI 1
#define FP8_PI0 1
#define FP8_PD 1
#define Y_F8 1
#define FP8_PA 1
#define FP8_PA_ALL 1
#define FP8_PA_HI_E 12
#define NT_WEIGHTS 1
#define GATHER_LDS_IDX 1
#define MOE_SCHED_FAST 1
#define PE_EARLY 1
#define SCAN_DEEP 1
#define SCAN_DEEP_U 1
#define SCAN_Q6 1
#define F8_NOSCALE 1
#define MOE_XCD_MAP 1
#define ROWS_XCD 1
#include <hip/hip_runtime.h>
#include <cstdio>
#include <cstdint>

#define GAS __attribute__((address_space(1)))
#define LAS __attribute__((address_space(3)))
typedef unsigned short bf16;
typedef unsigned v4u __attribute__((ext_vector_type(4)));
typedef unsigned v2u __attribute__((ext_vector_type(2)));
typedef float f32x4 __attribute__((ext_vector_type(4)));
typedef float f32x2 __attribute__((ext_vector_type(2)));
typedef short bf16x8 __attribute__((ext_vector_type(8)));
typedef GAS unsigned gu32;
typedef int v4i_t __attribute__((ext_vector_type(4)));
typedef int v8i_t __attribute__((ext_vector_type(8)));

namespace pg8 {
constexpr int BM = 256, BK = 64, HALF = 128, HTB = HALF * BK * 2  , STAGE_BYTES = 8 * HTB, NXCD = 8, WGM = 8;
__host__ __device__ __forceinline__ int lds_byte(int r, int c) { const int st = (r >> 4) * 2 + (c >> 5), rr = r & 15, cc = c & 31, ob = rr * 64 + cc * 2; return st * 1024 + (ob ^ (((ob >> 9) & 1) << 5)); }
__host__ __device__ __forceinline__ void stage_rc(int b, int& R, int& C) { const int st = b / 1024, sb = b % 1024, swz = sb ^ (((sb >> 9) & 1) << 5); R = (st >> 1) * 16 + swz / 64; C = (st & 1) * 32 + (swz % 64) / 2; }
__host__ __device__ __forceinline__ int perm32(int rho) { const int n = rho >> 4, i = rho & 15; return 8 * (i >> 2) + 4 * n + (i & 3); }

struct Unit { int pm, pn; const char* A; const char* B; const int* rows; int nvalid; int aux; int rowbase; int half; };

__device__ __forceinline__ unsigned cvt_pk_bf16(float lo, float hi) { unsigned r; asm volatile("v_cvt_pk_bf16_f32 %0, %1, %2" : "=v"(r) : "v"(lo), "v"(hi)); return r; }

constexpr int GIDX_OFF = 152 * 1024 + 1024 + 2048;
template <class Epi, class Sched, bool GATHER, bool FP8 = false>
__device__ __forceinline__ void gemm_phase(LAS unsigned char* lds, const int K, const int lda, const int ldb, const Sched& S, const Epi& E) {
    int tid_ = threadIdx.x; asm volatile("" : "+v"(tid_));
    const int tid = tid_, wid = __builtin_amdgcn_readfirstlane(tid >> 6), lane = tid & 63, wr = wid >> 2, wc = wid & 3, fr = lane & 15, fq = lane >> 4;
    const int nt = K / BK;
    unsigned voffA[2], voffB[2]; int RA[2], CA[2];
#pragma unroll
    for (int i = 0; i < 2; ++i) { int R, C; stage_rc(tid * 16 + i * 8192, R, C); const int Rb = Epi::PERM ? ((R & ~31) + perm32(R & 31)) : R;
        RA[i] = R; CA[i] = C; voffA[i] = (unsigned)(R * lda + C) * 2u; voffB[i] = (unsigned)(Rb * ldb + C) * 2u; }
    unsigned gA[2][2], gN[2][2];
    const size_t kstep = (size_t)(BK * 2);
    const size_t hstepA = GATHER ? 0 : (size_t)HALF * lda * 2, hstepB = (size_t)HALF * ldb * 2;
    const unsigned ldsw = (unsigned)wid * 1024u;
    const int aoff = lds_byte(wr * 64 + fr, fq * 8), boff = lds_byte(wc * 32 + fr, fq * 8);
#define PG8_SA(b, h) (((b) * 2 + (h)) * HTB)
#define PG8_SB(b, h) ((4 + (b) * 2 + (h)) * HTB)
#define PG8_STAGE_B(bufoff, gbase) do { _Pragma("unroll") for (int _i = 0; _i < 2; ++_i) \
        __builtin_amdgcn_global_load_lds((const unsigned*)((const char*)(gbase) + voffB[_i]), (LAS unsigned*)(lds + (bufoff) + ldsw + _i * 8192), 16, 0, 0); } while (0)
#define PG8_STAGE_A(bufoff, gbase, h) do { _Pragma("unroll") for (int _i = 0; _i < 2; ++_i) \
        __builtin_amdgcn_global_load_lds((const unsigned*)((const char*)(gbase) + (GATHER ? gA[h][_i] : voffA[_i]) + (h) * hstepA), (LAS unsigned*)(lds + (bufoff) + ldsw + _i * 8192), 16, 0, 0); } while (0)
#define PG8_CAT(x0, x1) __builtin_shufflevector(__builtin_bit_cast(v4i_t, (x0)), __builtin_bit_cast(v4i_t, (x1)), 0, 1, 2, 3, 4, 5, 6, 7)
#define PG8_LDA(dst, b, h) do { _Pragma("unroll") for (int m = 0; m < 4; ++m) { if constexpr (FP8) dst##8[m] = PG8_CAT(*(const LAS bf16x8*)(lds + PG8_SA(b, h) + aoff + m * 2048), *(const LAS bf16x8*)(lds + PG8_SA(b, h) + aoff + m * 2048 + 1024)); \
        else { _Pragma("unroll") for (int k = 0; k < 2; ++k) dst[m][k] = *(const LAS bf16x8*)(lds + PG8_SA(b, h) + aoff + m * 2048 + k * 1024); } } } while (0)
#define PG8_LDB(dst, b, h) do { _Pragma("unroll") for (int n = 0; n < 2; ++n) { if constexpr (FP8) dst##8[n] = PG8_CAT(*(const LAS bf16x8*)(lds + PG8_SB(b, h) + boff + n * 2048), *(const LAS bf16x8*)(lds + PG8_SB(b, h) + boff + n * 2048 + 1024)); \
        else { _Pragma("unroll") for (int k = 0; k < 2; ++k) dst[n][k] = *(const LAS bf16x8*)(lds + PG8_SB(b, h) + boff + n * 2048 + k * 1024); } } } while (0)
#ifdef F8_NOSCALE
#define PG8_F8MFMA(c, a, b) asm volatile("v_mfma_f32_16x16x128_f8f6f4 %0, %1, %2, %0" : "+v"(c) : "v"(a), "v"(b))
#else
#define PG8_F8MFMA(c, a, b) asm volatile("v_mfma_scale_f32_16x16x128_f8f6f4 %0, %1, %2, %0, %3, %3 op_sel_hi:[0,0,0]" : "+v"(c) : "v"(a), "v"(b), "v"(f8scale))
#endif
#define PG8_MMA(ai, bj, At, Bt) do { __builtin_amdgcn_s_setprio(1); \
        if constexpr (FP8) { _Pragma("unroll") for (int m = 0; m < 4; ++m) _Pragma("unroll") for (int n = 0; n < 2; ++n) \
            PG8_F8MFMA(acc[ai][bj][m][n], Bt##8[n], At##8[m]); } \
        else { _Pragma("unroll") for (int m = 0; m < 4; ++m) _Pragma("unroll") for (int n = 0; n < 2; ++n) _Pragma("unroll") for (int k = 0; k < 2; ++k) \
            acc[ai][bj][m][n] = __builtin_amdgcn_mfma_f32_16x16x32_bf16(Bt[n][k], At[m][k], acc[ai][bj][m][n], 0, 0, 0); } \
        __builtin_amdgcn_s_setprio(0); } while (0)
#define PG8_WAIT_V(n) asm volatile("s_waitcnt vmcnt(" #n ")" ::: "memory")
#define PG8_WAIT_L(n) asm volatile("s_waitcnt lgkmcnt(" #n ")" ::: "memory")
#define PG8_BAR __builtin_amdgcn_s_barrier()
#define PG8_SCHED __builtin_amdgcn_sched_barrier(0)
#define PG8_GLOAD(dst, u) do { _Pragma("unroll") for (int _h = 0; _h < 2; ++_h) _Pragma("unroll") for (int _i = 0; _i < 2; ++_i) { const int _r = _h * HALF + RA[_i]; \
        const int _rc = _r < (u).nvalid ? _r : (u).nvalid - 1; const int _tl = (u).rows[_rc]; const int _t = (_r < (u).nvalid) ? _tl : 0; dst[_h][_i] = (unsigned)(_t * lda + CA[_i]) * 2u; } } while (0)
    Unit cur, nxt; int ui = 0;
    if (!S.next(0, cur)) return;
    f32x4 acc[2][2][4][2];
#pragma unroll
    for (int a = 0; a < 2; ++a)
#pragma unroll
        for (int b = 0; b < 2; ++b)
#pragma unroll
            for (int m = 0; m < 4; ++m)
#pragma unroll
                for (int n = 0; n < 2; ++n) acc[a][b][m][n] = (f32x4){0.f, 0.f, 0.f, 0.f};
    const unsigned f8scale = 0x7f7f7f7fu;
    bf16x8 At[4][2], B0[2][2], B1[2][2]; v8i_t At8[4], B08[2], B18[2];
    const char* cA = cur.A; const char* cB = cur.B;
    if constexpr (GATHER) { PG8_GLOAD(gA, cur); PG8_WAIT_V(0); }
    PG8_STAGE_B(PG8_SB(0, 0), cB); PG8_STAGE_B(PG8_SB(0, 1), cB + hstepB); PG8_STAGE_A(PG8_SA(0, 0), cA, 0); PG8_STAGE_A(PG8_SA(0, 1), cA, 1);
    if (wr == 1) PG8_BAR;
    PG8_WAIT_V(2); PG8_BAR;
    PG8_STAGE_B(PG8_SB(1, 0), cB + kstep); PG8_STAGE_A(PG8_SA(1, 0), cA + kstep, 0); PG8_STAGE_B(PG8_SB(1, 1), cB + hstepB + kstep);
    PG8_WAIT_V(6); PG8_BAR;
    for (;;) {
        const bool has_next = S.next(ui + 1, nxt); const bool halfu = Sched::RAGGED && cur.half != 0;
        const char* nA = has_next ? nxt.A : cA; const char* nB = has_next ? nxt.B : cB;
#ifdef GATHER_LDS_IDX
        if constexpr (GATHER) { if (has_next) { if (wid == 0) __builtin_amdgcn_global_load_lds((const unsigned*)(nxt.rows) + lane * 4, (LAS unsigned*)(lds + GIDX_OFF), 16, 0, 0); } else {
#else
        if constexpr (GATHER) { if (has_next) { PG8_GLOAD(gN, nxt); } else {
#endif
#pragma unroll
            for (int h = 0; h < 2; ++h)
#pragma unroll
                for (int i = 0; i < 2; ++i) gN[h][i] = gA[h][i]; } }
#pragma unroll 1
        for (int t = 0; t < nt; t += 2) {
            const bool last = (t == nt - 2);
            const char* a1 = cA + (size_t)(t + 1) * kstep;
            const char* a2 = last ? nA : cA + (size_t)(t + 2) * kstep; const char* b2 = last ? nB : cB + (size_t)(t + 2) * kstep;
            const char* a3 = a2 + kstep; const char* b3 = b2 + kstep;
            PG8_LDB(B0, 0, 0); PG8_LDB(B1, 0, 1); PG8_SCHED; PG8_LDA(At, 0, 0); PG8_STAGE_A(PG8_SA(1, 1), a1, 1);
            if constexpr (GATHER) { if (last) {
#pragma unroll
                for (int h = 0; h < 2; ++h)
#pragma unroll
                    for (int i = 0; i < 2; ++i) gA[h][i] = gN[h][i]; } }
            PG8_WAIT_V(8); PG8_WAIT_L(0); PG8_BAR; PG8_MMA(0, 0, At, B0); PG8_MMA(0, 1, At, B1); PG8_BAR; PG8_SCHED;
            if (!halfu) PG8_LDA(At, 0, 1); PG8_STAGE_B(PG8_SB(0, 0), b2); PG8_STAGE_B(PG8_SB(0, 1), b2 + hstepB); PG8_STAGE_A(PG8_SA(0, 0), a2, 0);
            PG8_WAIT_V(8); PG8_WAIT_L(0); PG8_BAR; if (!halfu) { PG8_MMA(1, 0, At, B0); PG8_MMA(1, 1, At, B1); } PG8_BAR; PG8_SCHED;
            PG8_LDB(B0, 1, 0); PG8_LDB(B1, 1, 1); PG8_SCHED; PG8_LDA(At, 1, 0); PG8_STAGE_A(PG8_SA(0, 1), a2, 1);
            PG8_WAIT_V(8); PG8_WAIT_L(0); PG8_BAR; PG8_MMA(0, 0, At, B0); PG8_MMA(0, 1, At, B1); PG8_BAR; PG8_SCHED;
            if (!halfu) PG8_LDA(At, 1, 1); PG8_STAGE_B(PG8_SB(1, 0), b3); PG8_STAGE_B(PG8_SB(1, 1), b3 + hstepB); PG8_STAGE_A(PG8_SA(1, 0), a3, 0);
            PG8_WAIT_V(8); PG8_WAIT_L(0); PG8_BAR; if (!halfu) { PG8_MMA(1, 0, At, B0); PG8_MMA(1, 1, At, B1); } PG8_BAR; PG8_SCHED;
#ifdef GATHER_LDS_IDX
            if constexpr (GATHER) { if (t == 0 && has_next) {
#pragma unroll
                for (int _h = 0; _h < 2; ++_h)
#pragma unroll
                    for (int _i = 0; _i < 2; ++_i) { const int _r = _h * HALF + RA[_i]; const int _tl = *(const LAS int*)(lds + GIDX_OFF + _r * 4); const int _t = (_r < nxt.nvalid) ? _tl : 0; gN[_h][_i] = (unsigned)(_t * lda + CA[_i]) * 2u; } } }
#endif
        }
        if (wr == 0) PG8_BAR;
        if constexpr (FP8) asm volatile("s_nop 15\n\ts_nop 15\n\ts_nop 15" ::: "memory");
        E(acc, cur, wr, wc, fr, fq);
        if (!has_next) break;
#pragma unroll
        for (int a = 0; a < 2; ++a)
#pragma unroll
            for (int b = 0; b < 2; ++b)
#pragma unroll
                for (int m = 0; m < 4; ++m)
#pragma unroll
                    for (int n = 0; n < 2; ++n) acc[a][b][m][n] = (f32x4){0.f, 0.f, 0.f, 0.f};
        cur = nxt; cA = nA; cB = nB; ++ui;
        if (wr == 1) PG8_BAR;
    }
    PG8_WAIT_V(0);
    PG8_BAR;
#undef PG8_SA
#undef PG8_SB
#undef PG8_STAGE_A
#undef PG8_STAGE_B
#undef PG8_LDA
#undef PG8_LDB
#undef PG8_MMA
#undef PG8_CAT
#undef PG8_WAIT_V
#undef PG8_WAIT_L
#undef PG8_BAR
#undef PG8_SCHED
#undef PG8_GLOAD
}
}

constexpr int NB = 4, SEQ = 4096, D = 2048, DEPTH = 2;
constexpr int T = NB * SEQ;
constexpr int NH = 8, HD = 128, DNW = 1024, CH = 64, NCH = SEQ / CH;
constexpr int PW = 1024, PG_DIM = 256;
constexpr int IN_COLS = 5136, NPROJ = 5120;
constexpr int NE = 16, DE = 1024, PLE = 256;
constexpr float ALPHA = 1.4142135623730951f;
constexpr float LN_EPS = 1e-5f, RMS_EPS = 1e-6f;
constexpr int LCAP = T;
constexpr int MAXTILES = 2 * T / 256 + NE;

constexpr size_t MiB = 1u << 20;
constexpr size_t WS_CTL = 0, CTL_ZERO_BYTES = 64 * 1024;
constexpr size_t WS_LIST = 2 * MiB;
constexpr size_t WS_TOKSLOT = 3 * MiB, WS_GATEW = WS_TOKSLOT + 128 * 1024, WS_STATS = WS_GATEW + 128 * 1024, WS_CD = WS_STATS + 128 * 1024, WS_WBA = WS_CD + 128 * 1024;
constexpr size_t WS_WIN = 4 * MiB, WS_WOUT = 44 * MiB, WS_WPG = 60 * MiB, WS_WPP = 76 * MiB, WS_WPOOL = 78 * MiB, WS_WGU = 80 * MiB, WS_WD = 336 * MiB, WS_PB16 = 464 * MiB;
constexpr size_t WS_XB = 480 * MiB, WS_R1 = 544 * MiB, WS_R2 = 704 * MiB, WS_R4 = 848 * MiB, WS_R5 = 944 * MiB, WS_END = 1008 * MiB;
constexpr size_t WS_PROJ = WS_R1, WS_HID = WS_R1;
constexpr size_t WS_Y = WS_R2;
constexpr size_t WS_POOLD = WS_R4, WS_PP = WS_R4 + 32 * MiB, WS_X1B = WS_R2;
constexpr size_t WS_MIXIN = WS_R5, WS_X2B = WS_R5;
constexpr size_t WS_WIN8 = WS_WGU + 64 * MiB;
constexpr size_t WS_XBF8 = WS_R2;
constexpr size_t WS_X2F8 = WS_R1 + 96 * MiB;
static_assert((size_t)MAXTILES * 256 * 2048 * 2 <= 144 * MiB && (size_t)MAXTILES * 256 * 1024 * 2 <= 160 * MiB, "MoE row buffers");
constexpr int CW_TMO = 0, CW_CODE = 1, CW_CNT = 64  , CW_CONV = 512  , CW_BAR = 4096;

constexpr int RING_OFF = 0, RING_BYTES = 131072;
constexpr int LDSCTL_OFF = 152 * 1024, MISC_OFF = LDSCTL_OFF + 320;
constexpr int AUX_OFF = LDSCTL_OFF + 1024;
constexpr int LDS_BYTES = 163840;
constexpr int NWAVES = 8;

#define RLX_AGENT __ATOMIC_RELAXED, __HIP_MEMORY_SCOPE_AGENT
#define LDS_WAIT() asm volatile("s_waitcnt lgkmcnt(0)" ::: "memory")
#define VM_WAIT() asm volatile("s_waitcnt vmcnt(0)" ::: "memory")
__device__ __forceinline__ unsigned f2bf(float f) { unsigned u = __builtin_bit_cast(unsigned, f); return (u + 0x7fffu + ((u >> 16) & 1u)) >> 16; }
__device__ __forceinline__ unsigned pk2(float lo, float hi) { return f2bf(lo) | (f2bf(hi) << 16); }
typedef __bf16 bf2_t __attribute__((ext_vector_type(2)));
__device__ __forceinline__ unsigned pkbf(float lo, float hi) { const f32x2 v = {lo, hi}; return __builtin_bit_cast(unsigned, __builtin_convertvector(v, bf2_t)); }
constexpr float F8_XS = 16.0f, F8_WS = 256.0f, F8_INV = 1.0f / 4096.0f;
__device__ __forceinline__ float f8clamp(float x) { return fminf(fmaxf(x, -448.0f), 448.0f); }
__device__ __forceinline__ unsigned pk4_fp8(float a, float b, float c, float d) { unsigned w = 0u; w = (unsigned)__builtin_amdgcn_cvt_pk_fp8_f32(f8clamp(a), f8clamp(b), (int)w, false); w = (unsigned)__builtin_amdgcn_cvt_pk_fp8_f32(f8clamp(c), f8clamp(d), (int)w, true); return w; }
__device__ __forceinline__ float bf2f(unsigned short b) { return __builtin_bit_cast(float, ((unsigned)b) << 16); }
__device__ __forceinline__ float bflo(unsigned w) { return __builtin_bit_cast(float, w << 16); }
__device__ __forceinline__ float bfhi(unsigned w) { return __builtin_bit_cast(float, w & 0xffff0000u); }
__device__ __forceinline__ float sigmoidf_(float x) { return __builtin_amdgcn_rcpf(1.0f + __expf(-x)); }
template <int CTRL> __device__ __forceinline__ float dpp_(float x) { return __builtin_bit_cast(float, __builtin_amdgcn_mov_dpp(__builtin_bit_cast(int, x), CTRL, 0xf, 0xf, true)); }
constexpr int DPP_XOR1 = 0xB1, DPP_XOR2 = 0x4E, DPP_HMIRROR = 0x141, DPP_XOR8 = 0x128;
__device__ __forceinline__ float xrow16_sum(float x) {
    float p = x, q = x; asm volatile("v_nop\n\tv_nop\n\tv_permlane16_swap_b32 %0, %1" : "+v"(p), "+v"(q));
    x = p + q;
    float r = x, s = x; asm volatile("v_nop\n\tv_nop\n\tv_permlane32_swap_b32 %0, %1" : "+v"(r), "+v"(s));
    return r + s;
}
#ifdef OLD_SHUFFLES
__device__ __forceinline__ float row8_sum(float v) { v += __shfl_xor(v, 1); v += __shfl_xor(v, 2); v += __shfl_xor(v, 4); return v; }
__device__ __forceinline__ float wave_sum(float v) {
#pragma unroll
    for (int o = 1; o < 64; o <<= 1) v += __shfl_xor(v, o);
    return v; }
#else
__device__ __forceinline__ float row8_sum(float v) { v += dpp_<DPP_XOR1>(v); v += dpp_<DPP_XOR2>(v); v += dpp_<DPP_HMIRROR>(v); return v; }
__device__ __forceinline__ float wave_sum(float v) { v = row8_sum(v); v += dpp_<DPP_XOR8>(v); return xrow16_sum(v); }
#endif
#define XB_TMO      128
#define XB_XCNT(j)  (256  + 64 * (j))
#define XB_XSUB(j)  (1280 + 64 * (j))
#define XB_XGEN(j)  (2304 + 64 * (j))
#define XB_TOP      3328
#define XB_TOPGEN   3392
#define XCD_BAR_WORDS 3456
#define XB_SPIN_CAP (1u << 18)

__device__ __forceinline__ unsigned xb_ld(unsigned* p)              { return __hip_atomic_load(p, __ATOMIC_RELAXED, __HIP_MEMORY_SCOPE_AGENT); }
__device__ __forceinline__ unsigned xb_add(unsigned* p, unsigned v) { return __hip_atomic_fetch_add(p, v, __ATOMIC_RELAXED, __HIP_MEMORY_SCOPE_AGENT); }
__device__ __forceinline__ unsigned xb_xcc_id() { return (unsigned)__builtin_amdgcn_s_getreg((3 << 11) | 20) & 0xFu; }
#define XB_SPIN(cond, bar) do { unsigned _sp = 0; while (cond) { __builtin_amdgcn_s_sleep(1); \
    if ((++_sp & 255u) == 0u) { if (xb_ld(&(bar)[XB_TMO])) break; if (_sp > XB_SPIN_CAP) { atomicAdd(&(bar)[XB_TMO], 1u); break; } } } } while (0)

struct XcdBarrier {
    unsigned* bar; unsigned x;
    volatile LAS unsigned* st;
};

__device__ __forceinline__ XcdBarrier xcd_barrier_post(unsigned* bar, volatile LAS unsigned* st) {
    XcdBarrier b; b.bar = bar; b.x = xb_xcc_id(); b.st = st;
    if (threadIdx.x == 0) (void)xb_add(&bar[XB_XCNT(b.x)], 1u);
    return b;
}
__device__ __forceinline__ void xcd_barrier_complete(unsigned* bar, unsigned x, unsigned& nloc, unsigned& nx) {
    const unsigned G = gridDim.x * gridDim.y * gridDim.z;
    unsigned sum, cnt, mine, sp = 0u;
    for (;;) {
        sum = 0u; cnt = 0u; mine = 0u;
#pragma unroll
        for (unsigned j = 0; j < 16; ++j) { const unsigned c = xb_ld(&bar[XB_XCNT(j)]); sum += c; cnt += (c > 0u) ? 1u : 0u; mine = (j == x) ? c : mine; }
        if (sum == G) break;
        __builtin_amdgcn_s_sleep(1);
        if ((++sp & 255u) == 0u) { if (xb_ld(&bar[XB_TMO])) break; if (sp > XB_SPIN_CAP) { atomicAdd(&bar[XB_TMO], 1u); break; } }
    }
    nloc = mine > 0u ? mine : 1u; nx = cnt > 0u ? cnt : 1u;
}

__device__ __forceinline__ void xcd_barrier(const XcdBarrier& b) {
    asm volatile("s_waitcnt vmcnt(0)" ::: "memory");
    __syncthreads();
    if (threadIdx.x == 0) {
        unsigned* bar = b.bar;
        __builtin_amdgcn_s_waitcnt(0);
        unsigned nloc = b.st[0], nx = b.st[1];
        if (nloc == 0u) { xcd_barrier_complete(bar, b.x, nloc, nx); b.st[0] = nloc; b.st[1] = nx; }
        const unsigned old = xb_add(&bar[XB_XSUB(b.x)], 1u);
        const unsigned gen = old / nloc;
        if (old + 1u == (gen + 1u) * nloc) {
            __builtin_amdgcn_fence(__ATOMIC_RELEASE, "agent");
            asm volatile("s_waitcnt vmcnt(0)" ::: "memory");
            const unsigned og = xb_add(&bar[XB_TOP], 1u);
            const unsigned tg = og / nx;
            if (og + 1u == (tg + 1u) * nx) xb_add(&bar[XB_TOPGEN], 1u);
            else XB_SPIN(xb_ld(&bar[XB_TOPGEN]) == tg, bar);
            __builtin_amdgcn_fence(__ATOMIC_ACQUIRE, "agent");
            xb_add(&bar[XB_XGEN(b.x)], 1u);
            asm volatile("s_waitcnt vmcnt(0)" ::: "memory");
        } else {
            XB_SPIN(xb_ld(&bar[XB_XGEN(b.x)]) == gen, bar);
            __builtin_amdgcn_fence(__ATOMIC_ACQUIRE, "agent");
            asm volatile("s_waitcnt vmcnt(0)" ::: "memory");
        }
    }
    __syncthreads();
}

struct Args { const float* in[21]; float* out; unsigned char* ws; int ph_lo, ph_hi, li, pad; };
enum { I_X = 0, I_P, I_WIN, I_CONVW, I_ALOG, I_DTB, I_NORMW, I_POOLW, I_POOLS, I_WOUT, I_LN1G, I_LN1B, I_WR, I_BR, I_WEG, I_WEU, I_WED, I_LN2G, I_LN2B, I_WPP, I_WPG };
struct Frame {
    LAS unsigned char* lds;
    volatile LAS unsigned* MISC;
    gu32* ctl;
    int tid, lane, wave, vcu, G;
};

#ifndef FP8_LAST
#define FP8_LAST 1
#endif
#ifndef FP8_PG
#define FP8_PG 0
#endif
#ifndef FP8_ALL
#define FP8_ALL 0
#endif
#ifndef FP8_PD
#define FP8_PD 0
#endif
#define Y_F8S 64.0f
#ifndef FP8_PD_ALL
#define FP8_PD_ALL 0
#endif
#define FP8_PDL(l) (FP8_PD && (FP8_PD_ALL || (l) == DEPTH - 1))
#ifndef FP8_PI0
#define FP8_PI0 0
#endif
#ifndef FP8_PA
#define FP8_PA 0
#endif
#ifndef FP8_PA_ALL
#define FP8_PA_ALL 0
#endif
#define FP8_PAL(l) (FP8_PA && (FP8_PA_ALL || (l) == DEPTH - 1))
#ifndef FP8_PA_LO_E
#define FP8_PA_LO_E 0
#endif
#ifndef FP8_PA_HI_E
#define FP8_PA_HI_E 20
#endif
#ifndef FP8_PA_HI
#define FP8_PA_HI 20
#endif
#define FP8_PA_LO(l) ((l) == DEPTH - 1 ? FP8_PA_PN0 : FP8_PA_LO_E)
#define FP8_PA_HIF(l) ((l) == DEPTH - 1 ? FP8_PA_HI : FP8_PA_HI_E)
#define FP8_PA_TILE(l, row) (FP8_PAL(l) && (row) >= 256 * FP8_PA_LO(l) && (row) < 256 * FP8_PA_HIF(l))
#ifndef FP8_PA_PN0
#define FP8_PA_PN0 0
#endif
#define FP8_LAYER(l) (FP8_LAST && (FP8_ALL || (l) == DEPTH - 1))
static_assert(!FP8_PA || (FP8_LAST && FP8_ALL), "WS_WIN8 sits in the half of layer 0's expert-weight region that the fp8 experts leave free");
#ifndef FP8_PI
#define FP8_PI 0
#endif
#define PHASE_FRAME(F0) Frame F = F0; { int t_ = threadIdx.x; asm volatile("" : "+v"(t_)); F.tid = t_; F.lane = t_ & 63; }
#define OPQ_S(p) asm volatile("" : "+s"(p))
#define OPQ_G(T, expr) ({ GAS T* g_ = (GAS T*)(expr); asm volatile("" : "+s"(g_)); (T*)g_; })
struct SchedDense {
    static constexpr bool RAGGED = false;
    int nM, nN, nwg, G, c, pn0; const char* A; const char* B; size_t astep, bstep;
    __device__ __forceinline__ void init(int M, int N, int G_, int c_, const void* A_, int lda, const void* B_, int ldb, int pn0_ = 0) { nM = M / 256; nN = N / 256; nwg = nM * nN; G = G_; c = c_; pn0 = pn0_;
        A = (const char*)A_; B = (const char*)B_; astep = (size_t)256 * lda * 2; bstep = (size_t)256 * ldb * 2; }
    __device__ __forceinline__ bool next(int i, pg8::Unit& u) const {
        const long L = (long)i * G + c; if (L >= nwg) return false;
        int wgid = (int)L; { const int q = nwg / 8, r = nwg % 8, xcd = wgid % 8, off = wgid / 8; wgid = (xcd < r ? xcd * (q + 1) : r * (q + 1) + (xcd - r) * q) + off; }
        const int nig = 8 * nN, gid = wgid / nig, fm = gid * 8, gsz = (nM - fm) < 8 ? (nM - fm) : 8;
        u.pm = fm + ((wgid % nig) % gsz); u.pn = pn0 + (wgid % nig) / gsz;
        u.A = A + (size_t)u.pm * astep; u.B = B + (size_t)u.pn * bstep; u.rows = nullptr; u.nvalid = 256; u.aux = 0; u.rowbase = u.pm * 256; u.half = 0; return true;
    }
};
struct SchedPool {
    static constexpr bool RAGGED = false;
    int G, c; const char* A; const char* B;
    __device__ __forceinline__ bool next(int i, pg8::Unit& u) const {
        const int L = i * G + c; if (L >= 256) return false;
        u.pm = L >> 2; u.pn = L & 3; u.A = A + ((size_t)u.pm * 256 * PW + u.pn * 256) * 2; u.B = B + (size_t)u.pn * 65536 * 2; u.rows = nullptr; u.nvalid = 256; u.aux = 0; u.rowbase = u.pm * 256; u.half = 0; return true;
    }
};
struct SchedMoe {
    static constexpr bool RAGGED = true;
    int G, c, mode; const LAS int* tab; const char* A; const char* B; const int* list; int esz;
    __device__ __forceinline__ bool next(int i, pg8::Unit& u) const {
#ifdef MOE_SCHED_FAST
        const int ln = (int)__builtin_amdgcn_mbcnt_hi(~0u, __builtin_amdgcn_mbcnt_lo(~0u, 0u)), lk = ln < 16 ? ln : 16;
        const int vB = tab[lk], vC = tab[32 + (lk & 15)], vF = tab[48 + lk], vH = tab[80 + lk];
        const int L = i * G + c, nf = __builtin_amdgcn_readlane(vF, 16), nh = __builtin_amdgcn_readlane(vH, 16);
        if (L >= 8 * (nf + nh)) return false;
        const bool half = L >= 8 * nf; int t, pn;
        { const int Lr = half ? L - 8 * nf : L, nt_ = half ? nh : nf; t = Lr >> 3; pn = Lr & 7;
#ifdef MOE_XCD_MAP
          if ((G & 7) == 0 && (t | 1) < nt_) { const int j = Lr & 15, x = j & 7, r = j >> 3; t = (Lr >> 4) * 2 + (x >> 2); pn = (x & 3) * 2 + r; }
#endif
        }
        const int vP = half ? vH : vF;
        const int e = __builtin_popcountll(__builtin_amdgcn_ballot_w64(ln < 16 && vP <= t)) - 1;
        const int tl = t - __builtin_amdgcn_readlane(vP, e), cn = __builtin_amdgcn_readlane(vC, e), blk = __builtin_amdgcn_readlane(vB, e);
#else
        const int L = i * G + c, nf = __builtin_amdgcn_readfirstlane(tab[64]), nh = __builtin_amdgcn_readfirstlane(tab[96]);
        if (L >= 8 * (nf + nh)) return false;
        const bool half = L >= 8 * nf; const int t = (half ? L - 8 * nf : L) >> 3, pn = L & 7, pbase = half ? 80 : 48;
        int e = 0;
#pragma unroll
        for (int k = 1; k < 16; ++k) { const int ts = __builtin_amdgcn_readfirstlane(tab[pbase + k]); if (t >= ts) e = k; }
        const int tl = t - __builtin_amdgcn_readfirstlane(tab[pbase + e]), cn = __builtin_amdgcn_readfirstlane(tab[32 + e]), blk = __builtin_amdgcn_readfirstlane(tab[e]);
#endif
        const int p0 = half ? ((cn >> 8) << 8) + 128 * tl : 256 * tl;
        u.pm = 0; u.pn = pn; u.aux = e; u.half = half ? 1 : 0; u.rowbase = blk * 128 + p0;
        const int nv = cn - p0; u.nvalid = nv < (half ? 128 : 256) ? nv : (half ? 128 : 256);
        if (mode == 0) { u.A = A; u.rows = list + (size_t)e * LCAP + p0; u.B = B + ((size_t)e * 2048 + pn * 256) * 2048 * esz; }
        else { u.A = A + (size_t)u.rowbase * DE * esz; u.rows = nullptr; u.B = B + ((size_t)e * 2048 + pn * 256) * DE * esz; }
        return true;
    }
};

using pg8::cvt_pk_bf16;
struct EpiBf16 {
    static constexpr bool PERM = true; bf16* O; int ldc; float scale = 1.0f;
    __device__ __forceinline__ void operator()(const f32x4 (&acc)[2][2][4][2], const pg8::Unit& u, int wr, int wc, int fr, int fq) const {
        const int row0 = u.rowbase + wr * 64 + fr, col0 = u.pn * 256 + wc * 32 + 8 * fq;
#pragma unroll
        for (int ai = 0; ai < 2; ++ai) if (ai == 0 || !u.half)
#pragma unroll
            for (int m = 0; m < 4; ++m) { bf16* rowp = O + (size_t)(row0 + ai * 128 + m * 16) * ldc + col0;
#pragma unroll
                for (int bj = 0; bj < 2; ++bj) { const f32x4 v0 = acc[ai][bj][m][0] * scale, v1 = acc[ai][bj][m][1] * scale;
                    v4u w; w.x = cvt_pk_bf16(v0[0], v0[1]); w.y = cvt_pk_bf16(v0[2], v0[3]); w.z = cvt_pk_bf16(v1[0], v1[1]); w.w = cvt_pk_bf16(v1[2], v1[3]);
                    *(v4u*)(rowp + bj * 128) = w; } }
    }
};
struct EpiF8 {
    static constexpr bool PERM = true; unsigned char* O; int ldc; float scale = 1.0f;
    __device__ __forceinline__ void operator()(const f32x4 (&acc)[2][2][4][2], const pg8::Unit& u, int wr, int wc, int fr, int fq) const {
        const int row0 = u.rowbase + wr * 64 + fr, col0 = u.pn * 256 + wc * 32 + 8 * fq;
#pragma unroll
        for (int ai = 0; ai < 2; ++ai) if (ai == 0 || !u.half)
#pragma unroll
            for (int m = 0; m < 4; ++m) { unsigned char* rowp = O + (size_t)(row0 + ai * 128 + m * 16) * ldc + col0;
#pragma unroll
                for (int bj = 0; bj < 2; ++bj) { const f32x4 v0 = acc[ai][bj][m][0] * scale, v1 = acc[ai][bj][m][1] * scale;
                    v2u w; w.x = pk4_fp8(v0[0], v0[1], v0[2], v0[3]); w.y = pk4_fp8(v1[0], v1[1], v1[2], v1[3]);
                    *(v2u*)(rowp + bj * 128) = w; } }
    }
};
struct EpiPool {
    static constexpr bool PERM = true; bf16* O; const float* scale; int f8 = 0;
    __device__ __forceinline__ void operator()(const f32x4 (&acc)[2][2][4][2], const pg8::Unit& u, int wr, int wc, int fr, int fq) const {
        const int row0 = u.rowbase + wr * 64 + fr, cg = u.pn * 256 + wc * 32 + 8 * fq;
        f32x4 sv[2][2];
#pragma unroll
        for (int bj = 0; bj < 2; ++bj) { sv[bj][0] = *(const f32x4*)(scale + cg + bj * 128); sv[bj][1] = *(const f32x4*)(scale + cg + bj * 128 + 4); }
#pragma unroll
        for (int ai = 0; ai < 2; ++ai)
#pragma unroll
            for (int m = 0; m < 4; ++m) { bf16* rowp = O + (size_t)(row0 + ai * 128 + m * 16) * D + DNW + cg;
#pragma unroll
                for (int bj = 0; bj < 2; ++bj) { const f32x4 v0 = acc[ai][bj][m][0] * sv[bj][0], v1 = acc[ai][bj][m][1] * sv[bj][1];
                    if (f8) { v2u w8; w8.x = pk4_fp8(v0[0] * F8_XS, v0[1] * F8_XS, v0[2] * F8_XS, v0[3] * F8_XS); w8.y = pk4_fp8(v1[0] * F8_XS, v1[1] * F8_XS, v1[2] * F8_XS, v1[3] * F8_XS);
                        *(v2u*)((unsigned char*)O + (size_t)(row0 + ai * 128 + m * 16) * D + DNW + cg + bj * 128) = w8; }
                    else { v4u w; w.x = cvt_pk_bf16(v0[0], v0[1]); w.y = cvt_pk_bf16(v0[2], v0[3]); w.z = cvt_pk_bf16(v1[0], v1[1]); w.w = cvt_pk_bf16(v1[2], v1[3]);
                    *(v4u*)(rowp + bj * 128) = w; } } }
    }
};
struct EpiRes {
    static constexpr bool PERM = true; const bf16* XB; bf16* PRE; float ascale = 1.0f;
    __device__ __forceinline__ void operator()(const f32x4 (&acc)[2][2][4][2], const pg8::Unit& u, int wr, int wc, int fr, int fq) const {
        const int row0 = u.rowbase + wr * 64 + fr, col0 = u.pn * 256 + wc * 32 + 8 * fq;
#pragma unroll
        for (int ai = 0; ai < 2; ++ai) { v4u xq[4][2];
#pragma unroll
            for (int m = 0; m < 4; ++m)
#pragma unroll
                for (int bj = 0; bj < 2; ++bj) xq[m][bj] = *(const v4u*)(XB + (size_t)(row0 + ai * 128 + m * 16) * D + col0 + bj * 128);
            asm volatile("" : "+v"(xq[0][0]), "+v"(xq[0][1]), "+v"(xq[1][0]), "+v"(xq[1][1]), "+v"(xq[2][0]), "+v"(xq[2][1]), "+v"(xq[3][0]), "+v"(xq[3][1]));
#pragma unroll
            for (int m = 0; m < 4; ++m)
#pragma unroll
                for (int bj = 0; bj < 2; ++bj) { const size_t off = (size_t)(row0 + ai * 128 + m * 16) * D + col0 + bj * 128; const v4u x = xq[m][bj]; const f32x4 a0 = acc[ai][bj][m][0] * ascale, a1 = acc[ai][bj][m][1] * ascale;
                    v4u w; w.x = cvt_pk_bf16(bflo(x.x) * ALPHA + a0[0], bfhi(x.x) * ALPHA + a0[1]); w.y = cvt_pk_bf16(bflo(x.y) * ALPHA + a0[2], bfhi(x.y) * ALPHA + a0[3]);
                    w.z = cvt_pk_bf16(bflo(x.z) * ALPHA + a1[0], bfhi(x.z) * ALPHA + a1[1]); w.w = cvt_pk_bf16(bflo(x.w) * ALPHA + a1[2], bfhi(x.w) * ALPHA + a1[3]);
                    *(v4u*)(PRE + off) = w; } }
    }
};
struct EpiSwiglu {
    static constexpr bool PERM = true; bf16* O; int f8 = 0; float ascale = 1.0f;
    __device__ __forceinline__ void operator()(const f32x4 (&acc)[2][2][4][2], const pg8::Unit& u, int wr, int wc, int fr, int fq) const {
        const int row0 = u.rowbase + wr * 64 + fr, col0 = u.pn * 128 + wc * 32 + 8 * fq;
#pragma unroll
        for (int ai = 0; ai < 2; ++ai) if (ai == 0 || !u.half)
#pragma unroll
            for (int m = 0; m < 4; ++m) { bf16* rowp = O + (size_t)(row0 + ai * 128 + m * 16) * DE + col0;
                float h[8];
#pragma unroll
                for (int n = 0; n < 2; ++n)
#pragma unroll
                    for (int j = 0; j < 4; ++j) { const float g = acc[ai][0][m][n][j] * ascale, up = acc[ai][1][m][n][j] * ascale; h[4 * n + j] = g * sigmoidf_(g) * up; }
                if (f8) { v2u w8; w8.x = pk4_fp8(h[0] * F8_XS, h[1] * F8_XS, h[2] * F8_XS, h[3] * F8_XS); w8.y = pk4_fp8(h[4] * F8_XS, h[5] * F8_XS, h[6] * F8_XS, h[7] * F8_XS);
                    *(v2u*)((unsigned char*)O + (size_t)(row0 + ai * 128 + m * 16) * DE + col0) = w8; }
                else { v4u w; w.x = cvt_pk_bf16(h[0], h[1]); w.y = cvt_pk_bf16(h[2], h[3]); w.z = cvt_pk_bf16(h[4], h[5]); w.w = cvt_pk_bf16(h[6], h[7]);
                *(v4u*)rowp = w; } }
    }
};
struct EpiPle {
    static constexpr bool PERM = true; const bf16* X2B; const bf16* PP; bf16* XB; float* OUT; int last; float ascale = 1.0f; unsigned char* XF8 = nullptr;
    __device__ __forceinline__ void operator()(const f32x4 (&acc)[2][2][4][2], const pg8::Unit& u, int wr, int wc, int fr, int fq) const {
        const int row0 = u.rowbase + wr * 64 + fr, col0 = u.pn * 256 + wc * 32 + 8 * fq;
#pragma unroll
        for (int ai = 0; ai < 2; ++ai)
#pragma unroll
            for (int mp = 0; mp < 2; ++mp) { v4u xq[2][2], pq[2][2];
#pragma unroll
                for (int mm = 0; mm < 2; ++mm)
#pragma unroll
                    for (int bj = 0; bj < 2; ++bj) { const size_t off = (size_t)(row0 + ai * 128 + (2 * mp + mm) * 16) * D + col0 + bj * 128; xq[mm][bj] = *(const v4u*)(X2B + off); pq[mm][bj] = *(const v4u*)(PP + off); }
                asm volatile("" : "+v"(xq[0][0]), "+v"(xq[0][1]), "+v"(xq[1][0]), "+v"(xq[1][1]), "+v"(pq[0][0]), "+v"(pq[0][1]), "+v"(pq[1][0]), "+v"(pq[1][1]));
#pragma unroll
                for (int mm = 0; mm < 2; ++mm)
#pragma unroll
                    for (int bj = 0; bj < 2; ++bj) { const int m = 2 * mp + mm; const size_t off = (size_t)(row0 + ai * 128 + m * 16) * D + col0 + bj * 128;
                        const v4u xx = xq[mm][bj], pp = pq[mm][bj];
                        const f32x4 a0 = acc[ai][bj][m][0] * ascale, a1 = acc[ai][bj][m][1] * ascale;
                        f32x4 o0, o1;
                        o0[0] = bflo(xx.x) + sigmoidf_(a0[0]) * bflo(pp.x); o0[1] = bfhi(xx.x) + sigmoidf_(a0[1]) * bfhi(pp.x); o0[2] = bflo(xx.y) + sigmoidf_(a0[2]) * bflo(pp.y); o0[3] = bfhi(xx.y) + sigmoidf_(a0[3]) * bfhi(pp.y);
                        o1[0] = bflo(xx.z) + sigmoidf_(a1[0]) * bflo(pp.z); o1[1] = bfhi(xx.z) + sigmoidf_(a1[1]) * bfhi(pp.z); o1[2] = bflo(xx.w) + sigmoidf_(a1[2]) * bflo(pp.w); o1[3] = bfhi(xx.w) + sigmoidf_(a1[3]) * bfhi(pp.w);
                        if (last) { *(f32x4*)(OUT + off) = o0; *(f32x4*)(OUT + off + 4) = o1; }
                        else { v4u w; w.x = cvt_pk_bf16(o0[0], o0[1]); w.y = cvt_pk_bf16(o0[2], o0[3]); w.z = cvt_pk_bf16(o1[0], o1[1]); w.w = cvt_pk_bf16(o1[2], o1[3]); *(v4u*)(XB + off) = w;
                            if (XF8) { v2u w8; w8.x = pk4_fp8(o0[0] * F8_XS, o0[1] * F8_XS, o0[2] * F8_XS, o0[3] * F8_XS); w8.y = pk4_fp8(o1[0] * F8_XS, o1[1] * F8_XS, o1[2] * F8_XS, o1[3] * F8_XS); *(v2u*)(XF8 + off) = w8; } } } }
    }
};

#ifdef NT_WEIGHTS
#define WLOAD(p) __builtin_nontemporal_load(p)
#else
#define WLOAD(p) (*(p))
#endif
__device__ __forceinline__ void tr_item(const float* W, int ldw, int k0, int n0, bf16* WT, size_t drow0, int ldt, LAS float* scr, int lane) {
#pragma unroll 8
    for (int i = 0; i < 32; ++i) { const int kk = 2 * i + (lane >> 5); scr[kk * 33 + (lane & 31)] = WLOAD(W + (size_t)(k0 + kk) * ldw + n0 + (lane & 31)); }
    LDS_WAIT(); asm volatile("" ::: "memory");
    const int c = lane & 7;
#pragma unroll
    for (int j = 0; j < 4; ++j) { const int n = (lane >> 3) + 8 * j; const LAS float* s = scr + (8 * c) * 33 + n;
        v4u o; o.x = pk2(s[0 * 33], s[1 * 33]); o.y = pk2(s[2 * 33], s[3 * 33]); o.z = pk2(s[4 * 33], s[5 * 33]); o.w = pk2(s[6 * 33], s[7 * 33]);
        *(GAS v4u*)(WT + (drow0 + n) * ldt + k0 + 8 * c) = o; }
    LDS_WAIT(); asm volatile("" ::: "memory");
}
__device__ __forceinline__ void tr_item8(const float* W, int ldw, int k0, int n0, unsigned char* WT, size_t drow0, int ldt, LAS float* scr, int lane) {
#pragma unroll 8
    for (int i = 0; i < 32; ++i) { const int kk = 2 * i + (lane >> 5); scr[kk * 33 + (lane & 31)] = WLOAD(W + (size_t)(k0 + kk) * ldw + n0 + (lane & 31)); }
    LDS_WAIT(); asm volatile("" ::: "memory");
    const int c = lane & 7;
#pragma unroll
    for (int j = 0; j < 4; ++j) { const int n = (lane >> 3) + 8 * j; const LAS float* s = scr + (8 * c) * 33 + n;
        v2u o; o.x = pk4_fp8(s[0 * 33] * F8_WS, s[1 * 33] * F8_WS, s[2 * 33] * F8_WS, s[3 * 33] * F8_WS); o.y = pk4_fp8(s[4 * 33] * F8_WS, s[5 * 33] * F8_WS, s[6 * 33] * F8_WS, s[7 * 33] * F8_WS);
        *(GAS v2u*)(WT + (drow0 + n) * ldt + k0 + 8 * c) = o; }
    LDS_WAIT(); asm volatile("" ::: "memory");
}
__device__ __forceinline__ void weight_items(const Args& a, unsigned char* ws, LAS float* scr, int lane, int group, int l, int gw, int NGW, gu32* ctr = nullptr) {
    constexpr int I_INA = 32 * 128, I_INB = 32 * 32, I_OUT = 32 * 64, I_PG = 32 * 64, I_PP = 4 * 64, I_POOL = 4 * 32, I_EG = NE * 32 * 32, I_EU = I_EG, I_ED = NE * 16 * 64;
    if (group == 0) {
        for (int it = gw; it < I_INA + I_INB + I_PP + I_POOL; it += NGW) { int r = it;
            if (r < I_INA) { const int kb = r / 128, nb = r % 128;
                if (FP8_PA_TILE(l, 32 * nb)) tr_item8(a.in[I_WIN] + (size_t)l * D * IN_COLS, IN_COLS, 64 * kb, 32 * nb, ws + WS_WIN8 + (size_t)(DEPTH - 1 - l) * 12 * MiB, 32 * nb, D, scr, lane);
                else tr_item(a.in[I_WIN] + (size_t)l * D * IN_COLS, IN_COLS, 64 * kb, 32 * nb, (bf16*)(ws + WS_WIN) + (size_t)l * NPROJ * D, 32 * nb, D, scr, lane); continue; } r -= I_INA;
            if (r < I_INB) { const int kb = r / 32, nb = r % 32;
                if (FP8_PA_TILE(l, 4096 + 32 * nb)) tr_item8(a.in[I_WIN] + (size_t)l * D * IN_COLS, IN_COLS, 64 * kb, 4112 + 32 * nb, ws + WS_WIN8 + (size_t)(DEPTH - 1 - l) * 12 * MiB, 4096 + 32 * nb, D, scr, lane);
                else tr_item(a.in[I_WIN] + (size_t)l * D * IN_COLS, IN_COLS, 64 * kb, 4112 + 32 * nb, (bf16*)(ws + WS_WIN) + (size_t)l * NPROJ * D, 4096 + 32 * nb, D, scr, lane); continue; } r -= I_INB;
            if (r < I_PP) { const int kb = r / 64, nb = r % 64; tr_item(a.in[I_WPP] + (size_t)l * PLE * D, D, 64 * kb, 32 * nb, (bf16*)(ws + WS_WPP) + (size_t)l * D * PLE, 32 * nb, PLE, scr, lane); continue; } r -= I_PP;
            { const int g = r / 32, rr = r % 32, kb = rr / 8, nb = rr % 8; tr_item(a.in[I_POOLW] + ((size_t)l * 4 + g) * 65536, 256, 64 * kb, 32 * nb, (bf16*)(ws + WS_WPOOL) + ((size_t)l * 4 + g) * 65536, 32 * nb, 256, scr, lane); } }
    } else {
        const bool f8 = FP8_LAYER(l);
        constexpr int NIT = I_OUT + I_PG + I_EG + I_EU + I_ED;
        int it = gw - NGW, kk = 8; unsigned cb = 0u;
        for (;;) {
            if (ctr) { if (kk == 8) { unsigned b = 0u; if (lane == 0) b = __hip_atomic_fetch_add(ctr, 8u, RLX_AGENT); cb = (unsigned)__builtin_amdgcn_readfirstlane((int)b); kk = 0; if (cb >= (unsigned)NIT) break; }
                it = (int)cb + kk; ++kk; if (it >= NIT) continue; }
            else { it += NGW; if (it >= NIT) break; }
            int r = it;
            if (r < I_OUT) { const int kb = r / 64, nb = r % 64; if (FP8_PDL(l)) tr_item8(a.in[I_WOUT] + (size_t)l * D * D, D, 64 * kb, 32 * nb, ws + WS_WOUT + (size_t)l * D * D * 2, 32 * nb, D, scr, lane); else tr_item(a.in[I_WOUT] + (size_t)l * D * D, D, 64 * kb, 32 * nb, (bf16*)(ws + WS_WOUT) + (size_t)l * D * D, 32 * nb, D, scr, lane); continue; } r -= I_OUT;
            if (r < I_PG) { const int kb = r / 64, nb = r % 64; if (FP8_PI && (FP8_PI0 || l == DEPTH - 1)) tr_item8(a.in[I_WPG] + (size_t)l * D * D, D, 64 * kb, 32 * nb, ws + WS_WPG + (size_t)l * D * D * 2, 32 * nb, D, scr, lane); else tr_item(a.in[I_WPG] + (size_t)l * D * D, D, 64 * kb, 32 * nb, (bf16*)(ws + WS_WPG) + (size_t)l * D * D, 32 * nb, D, scr, lane); continue; } r -= I_PG;
            if (r < I_EG) { const int e = r / 1024, rr = r % 1024, kb = rr / 32, nb = rr % 32, h0 = 32 * nb;
                if (f8) tr_item8(a.in[I_WEG] + ((size_t)l * NE + e) * D * DE, DE, 64 * kb, h0, ws + WS_WGU + (size_t)l * NE * 2048 * D * 2 + (size_t)e * 2048 * D, (size_t)(h0 >> 7) * 256 + (h0 & 127), D, scr, lane);
                else tr_item(a.in[I_WEG] + ((size_t)l * NE + e) * D * DE, DE, 64 * kb, h0, (bf16*)(ws + WS_WGU) + ((size_t)l * NE + e) * 2048 * D, (size_t)(h0 >> 7) * 256 + (h0 & 127), D, scr, lane); continue; } r -= I_EG;
            if (r < I_EU) { const int e = r / 1024, rr = r % 1024, kb = rr / 32, nb = rr % 32, h0 = 32 * nb;
                if (f8) tr_item8(a.in[I_WEU] + ((size_t)l * NE + e) * D * DE, DE, 64 * kb, h0, ws + WS_WGU + (size_t)l * NE * 2048 * D * 2 + (size_t)e * 2048 * D, (size_t)(h0 >> 7) * 256 + 128 + (h0 & 127), D, scr, lane);
                else tr_item(a.in[I_WEU] + ((size_t)l * NE + e) * D * DE, DE, 64 * kb, h0, (bf16*)(ws + WS_WGU) + ((size_t)l * NE + e) * 2048 * D, (size_t)(h0 >> 7) * 256 + 128 + (h0 & 127), D, scr, lane); continue; } r -= I_EU;
            { const int e = r / 1024, rr = r % 1024, kb = rr / 64, nb = rr % 64;
                if (f8 && FP8_PG) tr_item8(a.in[I_WED] + ((size_t)l * NE + e) * DE * D, D, 64 * kb, 32 * nb, ws + WS_WD + (size_t)l * NE * D * DE * 2 + (size_t)e * D * DE, 32 * nb, DE, scr, lane);
                else tr_item(a.in[I_WED] + ((size_t)l * NE + e) * DE * D, D, 64 * kb, 32 * nb, (bf16*)(ws + WS_WD) + ((size_t)l * NE + e) * D * DE, 32 * nb, DE, scr, lane); } }
    }
}
__device__ __forceinline__ void p0_prologue(const Frame& F0, const Args& a) {
    PHASE_FRAME(F0);
    LAS float* scr = (LAS float*)(F.lds + RING_OFF + F.wave * 16384);
    const int gw = F.vcu * NWAVES + F.wave, NGW = F.G * NWAVES;
    unsigned char* ws = OPQ_G(unsigned char, a.ws);
#pragma unroll 1
    for (int l = 0; l < DEPTH; ++l) weight_items(a, ws, scr, F.lane, 0, l, gw, NGW);
#ifdef CONVERT_ALL_IN_PROLOGUE
#pragma unroll 1
    for (int l = 0; l < DEPTH; ++l) weight_items(a, ws, scr, F.lane, 1, l, gw, NGW);
#endif
    const size_t gt = (size_t)F.vcu * 512 + F.tid, NGT = (size_t)F.G * 512;
    { const GAS f32x4* src = (const GAS f32x4*)a.in[I_X]; GAS v4u* dst = (GAS v4u*)(ws + WS_XB);
        for (size_t i = gt; i < (size_t)T * D / 8; i += NGT) { const f32x4 v0 = WLOAD(src + 2 * i), v1 = WLOAD(src + 2 * i + 1); v4u o; o.x = pk2(v0[0], v0[1]); o.y = pk2(v0[2], v0[3]); o.z = pk2(v1[0], v1[1]); o.w = pk2(v1[2], v1[3]); dst[i] = o;
            if (FP8_PAL(0)) { v2u o8; o8.x = pk4_fp8(v0[0] * F8_XS, v0[1] * F8_XS, v0[2] * F8_XS, v0[3] * F8_XS); o8.y = pk4_fp8(v1[0] * F8_XS, v1[1] * F8_XS, v1[2] * F8_XS, v1[3] * F8_XS); ((GAS v2u*)(ws + WS_XBF8))[i] = o8; } } }
    { const GAS f32x4* src = (const GAS f32x4*)a.in[I_P]; GAS v4u* dst = (GAS v4u*)(ws + WS_PB16);
        for (size_t i = gt; i < (size_t)DEPTH * T * PLE / 8; i += NGT) { const f32x4 v0 = WLOAD(src + 2 * i), v1 = WLOAD(src + 2 * i + 1); v4u o; o.x = pk2(v0[0], v0[1]); o.y = pk2(v0[2], v0[3]); o.z = pk2(v1[0], v1[1]); o.w = pk2(v1[2], v1[3]); dst[i] = o; } }
    for (size_t i = gt; i < (size_t)DEPTH * 16 * D; i += NGT) { const int l = (int)(i / (16 * D)), j = (int)((i / D) % 16), k = (int)(i % D);
        ((bf16*)(ws + WS_WBA))[i] = (bf16)f2bf(a.in[I_WIN][((size_t)l * D + k) * IN_COLS + 4096 + j]); }
}

typedef float f32x16 __attribute__((ext_vector_type(16)));
#define MFMA32(a_, b_, c_) __builtin_amdgcn_mfma_f32_32x32x16_bf16((a_), (b_), (c_), 0, 0, 0)
#define PACK8(x, sp) __builtin_bit_cast(bf16x8, (v4u){pkbf((x)[8 * (sp)], (x)[8 * (sp) + 1]), pkbf((x)[8 * (sp) + 2], (x)[8 * (sp) + 3]), pkbf((x)[8 * (sp) + 4], (x)[8 * (sp) + 5]), pkbf((x)[8 * (sp) + 6], (x)[8 * (sp) + 7])})
#define RAW_BAR() do { asm volatile("s_waitcnt lgkmcnt(0)" ::: "memory"); __builtin_amdgcn_s_barrier(); asm volatile("" ::: "memory"); } while (0)
constexpr int IMG_ELEMS = 56 * 512, UIMG_ELEMS = 8 * 1024;
constexpr int FR_WN = 0, FR_QD = 16, FR_AQK = 32, FR_KDT = 40;
constexpr size_t WS_IMG = WS_R2, WS_UIMG = WS_R2 + 112 * MiB;
static_assert((size_t)NB * NCH * NH * IMG_ELEMS * 2 == 112 * MiB && (size_t)NB * NCH * NH * UIMG_ELEMS * 2 == 32 * MiB, "DeltaNet images");

__device__ __forceinline__ void pool_diffs_unit(const Frame& F, unsigned char* ws, int pm, int g) {
    const bf16* PROJ = (const bf16*)(ws + WS_PROJ); bf16* POOLD = (bf16*)(ws + WS_POOLD);
    const int tid = F.tid, cp = tid & 127, rq = tid >> 7, r0 = 256 * pm + 64 * rq, sq0 = r0 % SEQ, col = 256 * g + 2 * cp;
    const bf16* up = PROJ + (size_t)r0 * NPROJ + 4096 + col; bf16* dp = POOLD + (size_t)r0 * PW + col;
#define POOL_BODY(WIN) do { unsigned xr[CH + WIN - 1]; \
        _Pragma("unroll") for (int j = 0; j < WIN - 1; ++j) xr[j] = (sq0 - (WIN - 1) + j >= 0) ? *(const unsigned*)(up + (ptrdiff_t)(j - (WIN - 1)) * NPROJ) : 0u; \
        _Pragma("unroll") for (int i = 0; i < CH; ++i) xr[WIN - 1 + i] = *(const unsigned*)(up + (size_t)i * NPROJ); \
        float s0 = 0.f, s1 = 0.f; \
        _Pragma("unroll") for (int j = 0; j < WIN - 1; ++j) { s0 += bflo(xr[j]); s1 += bfhi(xr[j]); } \
        _Pragma("unroll") for (int i = 0; i < CH; ++i) { const float x0 = bflo(xr[WIN - 1 + i]), x1 = bfhi(xr[WIN - 1 + i]); s0 += x0; s1 += x1; \
            const int pos = sq0 + i; const float inv = __builtin_amdgcn_rcpf((float)((pos + 1) < WIN ? (pos + 1) : WIN)); \
            *(unsigned*)(dp + (size_t)i * PW) = pkbf(s0 * inv - x0, s1 * inv - x1); s0 -= bflo(xr[i]); s1 -= bfhi(xr[i]); } } while (0)
    if (g == 0) POOL_BODY(2); else if (g == 1) POOL_BODY(4); else if (g == 2) POOL_BODY(8); else POOL_BODY(16);
#undef POOL_BODY
}
#ifndef PREP_DUP
#define PREP_DUP 0
#endif
constexpr int PQF = 0, PKF = 33792, PQS = 67584, PKS = 84992, PVT = 102400, PKT = 120832, PTAB = 139264;
constexpr int PAS = PQF;
constexpr int PTB = PKF, PT11T = PKF + 9216, PPART = PKF;
constexpr int F_LD = 132, S_LD = 136, T_LD = 72, A_LD = 68, TT_LD = 40;
__device__ __forceinline__ void phase_dn_prep(const Frame& F0, const Args& a, int layer) {
    PHASE_FRAME(F0);
    unsigned char* ws = OPQ_G(unsigned char, a.ws);
    LAS unsigned char* lds = F.lds;
    LAS float* Qf = (LAS float*)(lds + PQF); LAS float* Kf = (LAS float*)(lds + PKF); LAS float* As = (LAS float*)(lds + PAS);
    LAS bf16* Qs = (LAS bf16*)(lds + PQS); LAS bf16* Ks = (LAS bf16*)(lds + PKS); LAS bf16* Vt = (LAS bf16*)(lds + PVT); LAS bf16* Kt = (LAS bf16*)(lds + PKT);
    LAS bf16* Tb = (LAS bf16*)(lds + PTB); LAS bf16* T11t = (LAS bf16*)(lds + PT11T);
    LAS float* betaS = (LAS float*)(lds + PTAB); LAS float* gS = betaS + 512; LAS float* gamh = gS + 512; LAS float* betah = gamh + 64; LAS float* egam = betah + 64; LAS float* bgam = egam + 64; LAS float* ekd = bgam + 64; LAS float* rkS = ekd + 64;
    const bf16* XB = (const bf16*)(ws + WS_XB); const bf16* PROJ = (const bf16*)(ws + WS_PROJ); const bf16* WBA = (const bf16*)(ws + WS_WBA) + (size_t)layer * 16 * D;
    bf16* IMG = (bf16*)(ws + WS_IMG); bf16* UIMG = (bf16*)(ws + WS_UIMG); float* CD = (float*)(ws + WS_CD);
    const float* convw = a.in[I_CONVW] + (size_t)layer * 4 * 3072; const float* alog = a.in[I_ALOG] + layer * NH; const float* dtb = a.in[I_DTB] + layer * NH;
    const int tid = F.tid, lane = F.lane, wave = F.wave, c32 = lane & 31, hf = lane >> 5;
    for (int unit = F.vcu; unit < NB * NCH; unit += F.G) {
        const int b = unit / NCH, n = unit % NCH, r0 = b * SEQ + n * CH, sq0 = n * CH;
        for (int rep_ = 0; rep_ < ((PREP_DUP & 64) ? 2 : 1); ++rep_)
        { typedef float f32x4v __attribute__((ext_vector_type(4)));
            const int fr = lane & 15, fg = lane >> 4; f32x4v pacc[4];
#pragma unroll
            for (int mt = 0; mt < 4; ++mt) pacc[mt] = (f32x4v){0.f, 0.f, 0.f, 0.f};
#pragma unroll 1
            for (int sb = 0; sb < 8; sb += 4) {
                bf16x8 bq[4], aq[4][4];
#pragma unroll
                for (int s = 0; s < 4; ++s) { const int k0 = 256 * wave + 32 * (sb + s) + 8 * fg; bq[s] = *(const bf16x8*)(WBA + (size_t)fr * D + k0);
#pragma unroll
                    for (int mt = 0; mt < 4; ++mt) aq[s][mt] = *(const bf16x8*)(XB + (size_t)(r0 + 16 * mt + fr) * D + k0); }
                asm volatile("" : "+v"(bq[0]), "+v"(bq[1]), "+v"(bq[2]), "+v"(bq[3]), "+v"(aq[0][0]), "+v"(aq[0][1]), "+v"(aq[0][2]), "+v"(aq[0][3]), "+v"(aq[1][0]), "+v"(aq[1][1]), "+v"(aq[1][2]), "+v"(aq[1][3]),
                             "+v"(aq[2][0]), "+v"(aq[2][1]), "+v"(aq[2][2]), "+v"(aq[2][3]), "+v"(aq[3][0]), "+v"(aq[3][1]), "+v"(aq[3][2]), "+v"(aq[3][3]));
#pragma unroll
                for (int s = 0; s < 4; ++s)
#pragma unroll
                    for (int mt = 0; mt < 4; ++mt) pacc[mt] = __builtin_amdgcn_mfma_f32_16x16x32_bf16(aq[s][mt], bq[s], pacc[mt], 0, 0, 0); }
            LAS float* part = (LAS float*)(lds + PPART) + wave * 1024;
#pragma unroll
            for (int mt = 0; mt < 4; ++mt)
#pragma unroll
                for (int r = 0; r < 4; ++r) part[(16 * mt + 4 * fg + r) * 16 + fr] = pacc[mt][r]; }
        __syncthreads();
        { const int tok = tid >> 3, cp = tid & 7; float s0 = 0.f, s1 = 0.f;
#pragma unroll
            for (int w = 0; w < 8; ++w) { const f32x2 p2 = *(const LAS f32x2*)((LAS float*)(lds + PPART) + w * 1024 + tok * 16 + 2 * cp); s0 += p2[0]; s1 += p2[1]; }
            if (cp < 4) { betaS[tok * 8 + 2 * cp] = sigmoidf_(s0); betaS[tok * 8 + 2 * cp + 1] = sigmoidf_(s1); }
            else { const int h = 2 * (cp - 4); const float z0 = s0 + dtb[h], z1 = s1 + dtb[h + 1];
                const float sp0 = z0 > 20.f ? z0 : log1pf(__expf(z0)), sp1 = z1 > 20.f ? z1 : log1pf(__expf(z1));
                gS[tok * 8 + h] = -__expf(alog[h]) * sp0; gS[tok * 8 + h + 1] = -__expf(alog[h + 1]) * sp1; } }
        __syncthreads();
        { float gv = gS[lane * 8 + wave];
#pragma unroll
            for (int o = 1; o < 64; o <<= 1) { const float up_ = __shfl_up(gv, o); if (lane >= o) gv += up_; }
            gS[lane * 8 + wave] = gv; }
        __syncthreads();
        unsigned craw[3][11]; unsigned cdum[3][8];
#define PREP_LOADRAW(hh) do { const int cp_ = tid & 63, i0_ = (tid >> 6) * 8; \
            _Pragma("unroll") for (int part_ = 0; part_ < 3; ++part_) { const bf16* src_ = PROJ + (size_t)(r0 + i0_ - 3) * NPROJ + part_ * 1024 + (hh) * HD + 2 * cp_; \
                _Pragma("unroll") for (int j_ = 0; j_ < 11; ++j_) craw[part_][j_] = (sq0 + i0_ - 3 + j_ >= 0) ? *(const unsigned*)(src_ + (ptrdiff_t)j_ * NPROJ) : 0u; \
                if (PREP_DUP & 256) { _Pragma("unroll") for (int j_ = 3; j_ < 11; ++j_) cdum[part_][j_ - 3] = *(const unsigned*)(src_ + (ptrdiff_t)j_ * NPROJ + ((hh) ^ 1) * HD - (hh) * HD); } } } while (0)
        PREP_LOADRAW(0);
        for (int hh_ = 0; hh_ < ((PREP_DUP & 128) ? 2 * NH : NH); ++hh_) { const int h = hh_ & (NH - 1);
            const size_t chd = (size_t)unit * NH + h; bf16* img = IMG + chd * IMG_ELEMS; bf16* uimg = UIMG + chd * UIMG_ELEMS;
            for (int rep_ = 0; rep_ < ((PREP_DUP & 16) ? 2 : 1); ++rep_)
            { const int cp = tid & 63, rg8 = tid >> 6, i0 = rg8 * 8;
                if (PREP_DUP & 256) {
#pragma unroll
                    for (int p_ = 0; p_ < 3; ++p_)
#pragma unroll
                        for (int j_ = 0; j_ < 8; ++j_) asm volatile("" :: "v"(cdum[p_][j_])); }
#pragma unroll
                for (int part = 0; part < 3; ++part) { const int col = part * 1024 + h * HD + 2 * cp;
                    const f32x2 cw0 = *(const f32x2*)(convw + col), cw1 = *(const f32x2*)(convw + 3072 + col), cw2 = *(const f32x2*)(convw + 2 * 3072 + col), cw3 = *(const f32x2*)(convw + 3 * 3072 + col);
                    float ya[8], yb[8];
#pragma unroll
                    for (int i = 0; i < 8; ++i) { const unsigned x3 = craw[part][i], x2 = craw[part][i + 1], x1 = craw[part][i + 2], x0 = craw[part][i + 3];
                        const float ta = cw0[0] * bflo(x3) + cw1[0] * bflo(x2) + cw2[0] * bflo(x1) + cw3[0] * bflo(x0), tb = cw0[1] * bfhi(x3) + cw1[1] * bfhi(x2) + cw2[1] * bfhi(x1) + cw3[1] * bfhi(x0);
                        ya[i] = ta * sigmoidf_(ta); yb[i] = tb * sigmoidf_(tb); }
                    if (part == 0) {
#pragma unroll
                        for (int i = 0; i < 8; ++i) *(LAS f32x2*)(Qf + (i0 + i) * F_LD + 2 * cp) = (f32x2){ya[i], yb[i]}; }
                    else if (part == 1) {
#pragma unroll
                        for (int i = 0; i < 8; ++i) *(LAS f32x2*)(Kf + (i0 + i) * F_LD + 2 * cp) = (f32x2){ya[i], yb[i]}; }
                    else { v4u o0, o1;
                        o0.x = pkbf(ya[0] * betaS[(i0 + 0) * 8 + h], ya[1] * betaS[(i0 + 1) * 8 + h]); o0.y = pkbf(ya[2] * betaS[(i0 + 2) * 8 + h], ya[3] * betaS[(i0 + 3) * 8 + h]); o0.z = pkbf(ya[4] * betaS[(i0 + 4) * 8 + h], ya[5] * betaS[(i0 + 5) * 8 + h]); o0.w = pkbf(ya[6] * betaS[(i0 + 6) * 8 + h], ya[7] * betaS[(i0 + 7) * 8 + h]);
                        o1.x = pkbf(yb[0] * betaS[(i0 + 0) * 8 + h], yb[1] * betaS[(i0 + 1) * 8 + h]); o1.y = pkbf(yb[2] * betaS[(i0 + 2) * 8 + h], yb[3] * betaS[(i0 + 3) * 8 + h]); o1.z = pkbf(yb[4] * betaS[(i0 + 4) * 8 + h], yb[5] * betaS[(i0 + 5) * 8 + h]); o1.w = pkbf(yb[6] * betaS[(i0 + 6) * 8 + h], yb[7] * betaS[(i0 + 7) * 8 + h]);
                        *(LAS v4u*)(Vt + (2 * cp) * T_LD + i0) = o0; *(LAS v4u*)(Vt + (2 * cp + 1) * T_LD + i0) = o1; } }
            }
            if (hh_ + 1 < ((PREP_DUP & 128) ? 2 * NH : NH)) PREP_LOADRAW((hh_ + 1) & (NH - 1));
            for (int rep_ = 0; rep_ < ((PREP_DUP & 1) ? 2 : 1); ++rep_) { if (rep_) RAW_BAR();
            { const int i = tid >> 3, part = tid & 7; const LAS float* qp = Qf + i * F_LD + part * 16; const LAS float* kp = Kf + i * F_LD + part * 16;
                f32x4 qv[4], kv[4]; float sq = 0.f, sk = 0.f;
#pragma unroll
                for (int j = 0; j < 4; ++j) { qv[j] = *(const LAS f32x4*)(qp + 4 * j); kv[j] = *(const LAS f32x4*)(kp + 4 * j);
                    sq += (qv[j][0] * qv[j][0] + qv[j][1] * qv[j][1]) + (qv[j][2] * qv[j][2] + qv[j][3] * qv[j][3]); sk += (kv[j][0] * kv[j][0] + kv[j][1] * kv[j][1]) + (kv[j][2] * kv[j][2] + kv[j][3] * kv[j][3]); }
                sq = row8_sum(sq); sk = row8_sum(sk);
                const float rq = 1.0f / sqrtf(sq + RMS_EPS) * 0.08838834764831845f, rk = 1.0f / sqrtf(sk + RMS_EPS);
                const float gi_ = gS[i * 8 + h], eg = __expf(gi_);
                if (part == 0) { const float bi_ = betaS[i * 8 + h]; rkS[i] = rk; gamh[i] = gi_; betah[i] = bi_; egam[i] = eg; bgam[i] = bi_ * eg; ekd[i] = __expf(gS[63 * 8 + h] - gi_); }
#pragma unroll
                for (int j = 0; j < 4; ++j) { qv[j] = qv[j] * rq; kv[j] = kv[j] * rk; }
                v4u w0, w1;
                w0.x = pkbf(qv[0][0], qv[0][1]); w0.y = pkbf(qv[0][2], qv[0][3]); w0.z = pkbf(qv[1][0], qv[1][1]); w0.w = pkbf(qv[1][2], qv[1][3]); w1.x = pkbf(qv[2][0], qv[2][1]); w1.y = pkbf(qv[2][2], qv[2][3]); w1.z = pkbf(qv[3][0], qv[3][1]); w1.w = pkbf(qv[3][2], qv[3][3]);
                *(LAS v4u*)(Qs + i * S_LD + part * 16) = w0; *(LAS v4u*)(Qs + i * S_LD + part * 16 + 8) = w1;
                w0.x = pkbf(kv[0][0], kv[0][1]); w0.y = pkbf(kv[0][2], kv[0][3]); w0.z = pkbf(kv[1][0], kv[1][1]); w0.w = pkbf(kv[1][2], kv[1][3]); w1.x = pkbf(kv[2][0], kv[2][1]); w1.y = pkbf(kv[2][2], kv[2][3]); w1.z = pkbf(kv[3][0], kv[3][1]); w1.w = pkbf(kv[3][2], kv[3][3]);
                *(LAS v4u*)(Ks + i * S_LD + part * 16) = w0; *(LAS v4u*)(Ks + i * S_LD + part * 16 + 8) = w1;
                bf16* fq = img + ((size_t)(FR_QD + (i >> 5) * 8 + part) * 64 + (i & 31)) * 8;
                v4u h0, h1;
                h0.x = pkbf(qv[0][0] * eg, qv[0][1] * eg); h0.y = pkbf(qv[0][2] * eg, qv[0][3] * eg); h0.z = pkbf(qv[2][0] * eg, qv[2][1] * eg); h0.w = pkbf(qv[2][2] * eg, qv[2][3] * eg);
                h1.x = pkbf(qv[1][0] * eg, qv[1][1] * eg); h1.y = pkbf(qv[1][2] * eg, qv[1][3] * eg); h1.z = pkbf(qv[3][0] * eg, qv[3][1] * eg); h1.w = pkbf(qv[3][2] * eg, qv[3][3] * eg);
                *(v4u*)fq = h0; *(v4u*)(fq + 32 * 8) = h1; }
            RAW_BAR();
            { const int c = tid & 127, rg = tid >> 7; float kb[16], kd[16];
#pragma unroll
                for (int i = 0; i < 16; ++i) { const int t = rg * 16 + i; const float kn = Kf[t * F_LD + c] * rkS[t]; kb[i] = kn * bgam[t]; kd[i] = kn * ekd[t]; }
                v4u o0, o1;
                o0.x = pkbf(kb[0], kb[1]); o0.y = pkbf(kb[2], kb[3]); o0.z = pkbf(kb[4], kb[5]); o0.w = pkbf(kb[6], kb[7]); o1.x = pkbf(kb[8], kb[9]); o1.y = pkbf(kb[10], kb[11]); o1.z = pkbf(kb[12], kb[13]); o1.w = pkbf(kb[14], kb[15]);
                *(LAS v4u*)(Kt + c * T_LD + rg * 16) = o0; *(LAS v4u*)(Kt + c * T_LD + rg * 16 + 8) = o1;
                bf16* fk = img + ((size_t)(FR_KDT + (c >> 5) * 4 + rg) * 64 + (c & 31)) * 8;
                v4u h0, h1;
                h0.x = pkbf(kd[0], kd[1]); h0.y = pkbf(kd[2], kd[3]); h0.z = pkbf(kd[8], kd[9]); h0.w = pkbf(kd[10], kd[11]);
                h1.x = pkbf(kd[4], kd[5]); h1.y = pkbf(kd[6], kd[7]); h1.z = pkbf(kd[12], kd[13]); h1.w = pkbf(kd[14], kd[15]);
                *(v4u*)fk = h0; *(v4u*)(fk + 32 * 8) = h1; }
            RAW_BAR();
            }
            for (int rep_ = 0; rep_ < ((PREP_DUP & 2) ? 2 : 1); ++rep_) { if (rep_) RAW_BAR();
            if (wave < 6) { const int pr = wave % 3, iskk = wave / 3, mt = pr == 2 ? 1 : 0, nt = pr == 0 ? 0 : 1;
                const LAS bf16* xs = iskk ? Ks : Qs; f32x16 d;
#pragma unroll
                for (int r = 0; r < 16; ++r) d[r] = 0.f;
#pragma unroll
                for (int s = 0; s < 8; ++s) { const bf16x8 af = *(const LAS bf16x8*)(Ks + (32 * mt + c32) * S_LD + 16 * s + 8 * hf), bfr = *(const LAS bf16x8*)(xs + (32 * nt + c32) * S_LD + 16 * s + 8 * hf); d = MFMA32(af, bfr, d); }
                const int i = 32 * nt + c32; const float gi = gamh[i], bi = betah[i];
#pragma unroll
                for (int r = 0; r < 16; ++r) { const int j = 32 * mt + (r & 3) + 8 * (r >> 2) + 4 * hf; const float de = __expf(gi - gamh[j]);
                    d[r] = iskk ? ((j < i) ? bi * d[r] * de : 0.f) : ((j <= i) ? d[r] * de : 0.f); }
                if (iskk) {
#pragma unroll
                    for (int qd = 0; qd < 4; ++qd) *(LAS f32x4*)(As + i * A_LD + 32 * mt + 8 * qd + 4 * hf) = (f32x4){d[4 * qd], d[4 * qd + 1], d[4 * qd + 2], d[4 * qd + 3]}; }
                else {
#pragma unroll
                    for (int sp = 0; sp < 2; ++sp) *(bf16x8*)(img + ((size_t)(FR_AQK + nt * 4 + 2 * mt + sp) * 64 + lane) * 8) = PACK8(d, sp); } }
            RAW_BAR();
            }
            for (int rep_ = 0; rep_ < ((PREP_DUP & 4) ? 2 : 1); ++rep_) { if (rep_) RAW_BAR();
            if (wave < 2) {
                unsigned asb = (unsigned)(uintptr_t)(As + (32 * wave) * A_LD + 32 * wave); int cb = c32; asm volatile("" : "+v"(asb), "+v"(cb));
                const LAS float* Ab = (const LAS float*)(uintptr_t)asb;
                float arow[32], Tc[32];
#pragma unroll
                for (int i = 0; i < 32; ++i) arow[i] = Ab[i * A_LD + cb];
#pragma unroll
                for (int i = 0; i < 32; ++i) { float ac[4] = {(i == cb) ? 1.f : 0.f, 0.f, 0.f, 0.f}; if (i > 0) asm volatile("" : "+v"(arow[i]), "+v"(Tc[i - 1]));
#pragma unroll
                    for (int j = 0; j < i; ++j) { const float aij = __builtin_bit_cast(float, __builtin_amdgcn_readlane(__builtin_bit_cast(int, arow[i]), j)); ac[j & 3] -= aij * Tc[j]; }
                    Tc[i] = (ac[0] + ac[1]) + (ac[2] + ac[3]); __builtin_amdgcn_sched_barrier(0); }
                if (hf == 0) {
#pragma unroll
                    for (int i = 0; i < 32; ++i) Tb[(32 * wave + i) * T_LD + 32 * wave + c32] = (bf16)(pkbf(Tc[i], 0.f) & 0xffffu);
                    if (wave == 0) {
#pragma unroll
                        for (int q = 0; q < 4; ++q) { v4u o; o.x = pkbf(Tc[8 * q], Tc[8 * q + 1]); o.y = pkbf(Tc[8 * q + 2], Tc[8 * q + 3]); o.z = pkbf(Tc[8 * q + 4], Tc[8 * q + 5]); o.w = pkbf(Tc[8 * q + 6], Tc[8 * q + 7]); *(LAS v4u*)(T11t + c32 * TT_LD + 8 * q) = o; } } } }
            RAW_BAR();
            if (wave == 0) {
                f32x16 x;
#pragma unroll
                for (int r = 0; r < 16; ++r) x[r] = 0.f;
#pragma unroll
                for (int s = 0; s < 2; ++s) { const LAS float* ap = As + (32 + c32) * A_LD + 16 * s + 8 * hf; const f32x4 a0 = *(const LAS f32x4*)ap, a1 = *(const LAS f32x4*)(ap + 4);
                    const bf16x8 af = __builtin_bit_cast(bf16x8, (v4u){pkbf(a0[0], a0[1]), pkbf(a0[2], a0[3]), pkbf(a1[0], a1[1]), pkbf(a1[2], a1[3])});
                    const bf16x8 bfr = *(const LAS bf16x8*)(T11t + c32 * TT_LD + 16 * s + 8 * hf); x = MFMA32(af, bfr, x); }
                f32x16 t21;
#pragma unroll
                for (int r = 0; r < 16; ++r) t21[r] = 0.f;
#pragma unroll
                for (int s = 0; s < 2; ++s) { const LAS bf16* tp = Tb + (32 + c32) * T_LD + 32 + 16 * s + 4 * hf; const v2u lo = *(const LAS v2u*)tp, hi = *(const LAS v2u*)(tp + 8);
                    const bf16x8 af = __builtin_bit_cast(bf16x8, (v4u){lo.x, lo.y, hi.x, hi.y}); const bf16x8 bfr = PACK8(x, s); t21 = MFMA32(af, bfr, t21); }
#pragma unroll
                for (int r = 0; r < 16; ++r) Tb[(32 + (r & 3) + 8 * (r >> 2) + 4 * hf) * T_LD + c32] = (bf16)(pkbf(-t21[r], 0.f) & 0xffffu);
            }
            RAW_BAR();
            }
            for (int rep_ = 0; rep_ < ((PREP_DUP & 8) ? 2 : 1); ++rep_) { if (rep_) RAW_BAR();
            if (wave < 4) {
#pragma unroll
                for (int mt = 0; mt < 2; ++mt) { f32x16 d;
#pragma unroll
                    for (int r = 0; r < 16; ++r) d[r] = 0.f;
#pragma unroll
                    for (int s = 0; s < 4; ++s) if (s < 2 * (mt + 1)) { const bf16x8 af = *(const LAS bf16x8*)(Tb + (32 * mt + c32) * T_LD + 16 * s + 8 * hf), bfr = *(const LAS bf16x8*)(Vt + (32 * wave + c32) * T_LD + 16 * s + 8 * hf); d = MFMA32(af, bfr, d); }
                    bf16* up = uimg + ((size_t)(wave * 2 + mt) * 64 + lane) * 16; *(bf16x8*)up = PACK8(d, 0); *(bf16x8*)(up + 8) = PACK8(d, 1); } }
            else { const int ct = wave - 4;
#pragma unroll
                for (int nt = 0; nt < 2; ++nt) { f32x16 d;
#pragma unroll
                    for (int r = 0; r < 16; ++r) d[r] = 0.f;
#pragma unroll
                    for (int s = 0; s < 4; ++s) if (s < 2 * (nt + 1)) { const bf16x8 af = *(const LAS bf16x8*)(Kt + (32 * ct + c32) * T_LD + 16 * s + 8 * hf), bfr = *(const LAS bf16x8*)(Tb + (32 * nt + c32) * T_LD + 16 * s + 8 * hf); d = MFMA32(af, bfr, d); }
#pragma unroll
                    for (int r = 0; r < 16; ++r) d[r] = -d[r];
#pragma unroll
                    for (int sp = 0; sp < 2; ++sp) *(bf16x8*)(img + ((size_t)(FR_WN + nt * 8 + 2 * ct + sp) * 64 + lane) * 8) = PACK8(d, sp); } }
            }
            if (tid == 0) CD[chd] = egam[63];
            RAW_BAR();
        }
#undef PREP_LOADRAW
    }
}

__host__ __device__ constexpr int sc_p(int k) { const int j = k - 32; return j < 12 ? j % 6 : (j - 12) % 5; }
__host__ __device__ constexpr int sc_slab(int k) { const int j = k - 32; return k < 32 ? (k >> 2) : (j < 12 ? j / 6 : 2 + (j - 12) / 5); }
__host__ __device__ constexpr int sc_kind(int k) { return k < 32 ? ((k & 3) < 2 ? 0 : 1) : ((sc_p(k) == 2 || sc_p(k) == 5) ? 1 : 2); }
__host__ __device__ constexpr int sc_idx(int k) { return k < 32 ? (k & 1) : (sc_p(k) == 0 ? 0 : sc_p(k) == 1 ? 1 : sc_p(k) == 2 ? 1 : sc_p(k) == 3 ? 2 : sc_p(k) == 4 ? 3 : 0); }
__host__ __device__ constexpr int sc_frag(int k) { return k < 32 ? (((k & 3) < 2 ? FR_WN : FR_QD) + (k & 1) * 8 + (k >> 2)) : (sc_kind(k) == 1 ? FR_AQK + sc_idx(k) * 4 + sc_slab(k) : FR_KDT + sc_idx(k) * 4 + sc_slab(k)); }
constexpr int SC_QD = 8;
constexpr int SCB = 57344, OT_OFF = 2 * SCB, OT_LD = 136, OT_BYTES = 64 * OT_LD * 2;
static_assert(OT_OFF + 2 * OT_BYTES <= 152 * 1024, "scan LDS");
__device__ __forceinline__ void phase_dn_scan(const Frame& F0, const Args& a, int layer, int unit) {
    PHASE_FRAME(F0);
    unsigned char* ws = OPQ_G(unsigned char, a.ws);
    LAS unsigned char* lds = F.lds;
    const int b = unit >> 3, h = unit & 7, lane = F.lane;
    const bf16* IMG = (const bf16*)(ws + WS_IMG); const bf16* UIMG = (const bf16*)(ws + WS_UIMG); const float* CD = (const float*)(ws + WS_CD);
    const size_t chd0 = (size_t)b * NCH * NH + h;
    if (F.wave < 4) {
#ifndef SCAN_NO_COMPUTE
        const int w = F.wave, c32 = lane & 31, hf = lane >> 5;
        f32x16 S0, S1, S2, S3;
#pragma unroll
        for (int r = 0; r < 16; ++r) { S0[r] = 0.f; S1[r] = 0.f; S2[r] = 0.f; S3[r] = 0.f; }
        const float cdl = CD[chd0 + (size_t)lane * NH];
        v4u UA[4];
#ifdef SCAN_DEEP_U
        v4u UB[4];
#endif
        const __amdgpu_buffer_rsrc_t rsU = __builtin_amdgcn_make_buffer_rsrc((void*)(UIMG + chd0 * UIMG_ELEMS), (short)0, NCH * NH * UIMG_ELEMS * 2, 0x00020000);
        const unsigned uoff = (unsigned)((w * 2) * 64 + lane) * 32u;
#ifdef SCAN_DEEP_U
#define SC_ULEAD 2
#else
#define SC_ULEAD 1
#endif
#define SC_LOADU(dst, nn) do { _Pragma("unroll") for (int mt_ = 0; mt_ < 2; ++mt_) { _Pragma("unroll") for (int hh_ = 0; hh_ < 2; ++hh_) dst[2 * mt_ + hh_] = __builtin_amdgcn_raw_buffer_load_b128(rsU, uoff + (unsigned)(mt_ * 2048 + hh_ * 16), (unsigned)(nn) * (unsigned)(NH * UIMG_ELEMS * 2), 0); } } while (0)
#define SC_FRAG(bufoff, fi) (*(const LAS bf16x8*)(lds + (bufoff) + (fi) * 1024 + lane * 16))
#define SC_BODY8(bufoff) \
        fq0 = SC_FRAG(bufoff, 0); \
        fq1 = SC_FRAG(bufoff, 8); \
        fq2 = SC_FRAG(bufoff, 16); \
        fq3 = SC_FRAG(bufoff, 24); \
        fq4 = SC_FRAG(bufoff, 1); \
        fq5 = SC_FRAG(bufoff, 9); \
        fq6 = SC_FRAG(bufoff, 17); \
        fq7 = SC_FRAG(bufoff, 25); \
        Sbs = PACK8(S0, 0); \
        aV0 = MFMA32(fq0, Sbs, aV0); \
        fq0 = SC_FRAG(bufoff, 2); \
        aV1 = MFMA32(fq1, Sbs, aV1); \
        fq1 = SC_FRAG(bufoff, 10); \
        aO0 = MFMA32(fq2, Sbs, aO0); \
        fq2 = SC_FRAG(bufoff, 18); \
        aO1 = MFMA32(fq3, Sbs, aO1); \
        fq3 = SC_FRAG(bufoff, 26); \
        Sbs = PACK8(S0, 1); \
        aV0 = MFMA32(fq4, Sbs, aV0); \
        fq4 = SC_FRAG(bufoff, 3); \
        aV1 = MFMA32(fq5, Sbs, aV1); \
        fq5 = SC_FRAG(bufoff, 11); \
        aO0 = MFMA32(fq6, Sbs, aO0); \
        fq6 = SC_FRAG(bufoff, 19); \
        aO1 = MFMA32(fq7, Sbs, aO1); \
        fq7 = SC_FRAG(bufoff, 27); \
        Sbs = PACK8(S1, 0); \
        aV0 = MFMA32(fq0, Sbs, aV0); \
        fq0 = SC_FRAG(bufoff, 4); \
        aV1 = MFMA32(fq1, Sbs, aV1); \
        fq1 = SC_FRAG(bufoff, 12); \
        aO0 = MFMA32(fq2, Sbs, aO0); \
        fq2 = SC_FRAG(bufoff, 20); \
        aO1 = MFMA32(fq3, Sbs, aO1); \
        fq3 = SC_FRAG(bufoff, 28); \
        Sbs = PACK8(S1, 1); \
        aV0 = MFMA32(fq4, Sbs, aV0); \
        fq4 = SC_FRAG(bufoff, 5); \
        aV1 = MFMA32(fq5, Sbs, aV1); \
        fq5 = SC_FRAG(bufoff, 13); \
        aO0 = MFMA32(fq6, Sbs, aO0); \
        fq6 = SC_FRAG(bufoff, 21); \
        aO1 = MFMA32(fq7, Sbs, aO1); \
        fq7 = SC_FRAG(bufoff, 29); \
        Sbs = PACK8(S2, 0); \
        aV0 = MFMA32(fq0, Sbs, aV0); \
        fq0 = SC_FRAG(bufoff, 6); \
        aV1 = MFMA32(fq1, Sbs, aV1); \
        fq1 = SC_FRAG(bufoff, 14); \
        aO0 = MFMA32(fq2, Sbs, aO0); \
        fq2 = SC_FRAG(bufoff, 22); \
        aO1 = MFMA32(fq3, Sbs, aO1); \
        fq3 = SC_FRAG(bufoff, 30); \
        Sbs = PACK8(S2, 1); \
        aV0 = MFMA32(fq4, Sbs, aV0); \
        fq4 = SC_FRAG(bufoff, 7); \
        aV1 = MFMA32(fq5, Sbs, aV1); \
        fq5 = SC_FRAG(bufoff, 15); \
        aO0 = MFMA32(fq6, Sbs, aO0); \
        fq6 = SC_FRAG(bufoff, 23); \
        aO1 = MFMA32(fq7, Sbs, aO1); \
        fq7 = SC_FRAG(bufoff, 31); \
        Sbs = PACK8(S3, 0); \
        aV0 = MFMA32(fq0, Sbs, aV0); \
        fq0 = SC_FRAG(bufoff, 40); \
        aV1 = MFMA32(fq1, Sbs, aV1); \
        fq1 = SC_FRAG(bufoff, 44); \
        aO0 = MFMA32(fq2, Sbs, aO0); \
        fq2 = SC_FRAG(bufoff, 36); \
        aO1 = MFMA32(fq3, Sbs, aO1); \
        fq3 = SC_FRAG(bufoff, 48); \
        Sbs = PACK8(S3, 1); \
        aV0 = MFMA32(fq4, Sbs, aV0); \
        fq4 = SC_FRAG(bufoff, 52); \
        aV1 = MFMA32(fq5, Sbs, aV1); \
        fq5 = SC_FRAG(bufoff, 32); \
        S0 = S0 * cd; S1 = S1 * cd; S2 = S2 * cd; S3 = S3 * cd; \
        aO0 = MFMA32(fq6, Sbs, aO0); \
        fq6 = SC_FRAG(bufoff, 41); \
        aO1 = MFMA32(fq7, Sbs, aO1); \
        fq7 = SC_FRAG(bufoff, 45); \
        Vb0 = PACK8(aV0, 0); Vb1 = PACK8(aV0, 1); Vb2 = PACK8(aV1, 0); Vb3 = PACK8(aV1, 1); \
        S0 = MFMA32(fq0, Vb0, S0); \
        fq0 = SC_FRAG(bufoff, 37); \
        S1 = MFMA32(fq1, Vb0, S1); \
        fq1 = SC_FRAG(bufoff, 49); \
        aO1 = MFMA32(fq2, Vb0, aO1); \
        fq2 = SC_FRAG(bufoff, 53); \
        S2 = MFMA32(fq3, Vb0, S2); \
        fq3 = SC_FRAG(bufoff, 33); \
        S3 = MFMA32(fq4, Vb0, S3); \
        fq4 = SC_FRAG(bufoff, 42); \
        aO0 = MFMA32(fq5, Vb0, aO0); \
        fq5 = SC_FRAG(bufoff, 46); \
        S0 = MFMA32(fq6, Vb1, S0); \
        fq6 = SC_FRAG(bufoff, 38); \
        S1 = MFMA32(fq7, Vb1, S1); \
        fq7 = SC_FRAG(bufoff, 50); \
        aO1 = MFMA32(fq0, Vb1, aO1); \
        fq0 = SC_FRAG(bufoff, 54); \
        S2 = MFMA32(fq1, Vb1, S2); \
        fq1 = SC_FRAG(bufoff, 43); \
        S3 = MFMA32(fq2, Vb1, S3); \
        fq2 = SC_FRAG(bufoff, 47); \
        aO0 = MFMA32(fq3, Vb1, aO0); \
        fq3 = SC_FRAG(bufoff, 39); \
        S0 = MFMA32(fq4, Vb2, S0); \
        fq4 = SC_FRAG(bufoff, 51); \
        S1 = MFMA32(fq5, Vb2, S1); \
        fq5 = SC_FRAG(bufoff, 55); \
        aO1 = MFMA32(fq6, Vb2, aO1); \
        S2 = MFMA32(fq7, Vb2, S2); \
        S3 = MFMA32(fq0, Vb2, S3); \
        S0 = MFMA32(fq1, Vb3, S0); \
        S1 = MFMA32(fq2, Vb3, S1); \
        aO1 = MFMA32(fq3, Vb3, aO1); \
        S2 = MFMA32(fq4, Vb3, S2); \
        S3 = MFMA32(fq5, Vb3, S3);
#define SC_BODY6(bufoff) \
        fq0 = SC_FRAG(bufoff, 0); \
        fq1 = SC_FRAG(bufoff, 8); \
        fq2 = SC_FRAG(bufoff, 16); \
        fq3 = SC_FRAG(bufoff, 24); \
        fq4 = SC_FRAG(bufoff, 1); \
        fq5 = SC_FRAG(bufoff, 9); \
        Sbs = PACK8(S0, 0); \
        aV0 = MFMA32(fq0, Sbs, aV0); \
        fq0 = SC_FRAG(bufoff, 17); \
        aV1 = MFMA32(fq1, Sbs, aV1); \
        fq1 = SC_FRAG(bufoff, 25); \
        aO0 = MFMA32(fq2, Sbs, aO0); \
        fq2 = SC_FRAG(bufoff, 2); \
        aO1 = MFMA32(fq3, Sbs, aO1); \
        fq3 = SC_FRAG(bufoff, 10); \
        Sbs = PACK8(S0, 1); \
        aV0 = MFMA32(fq4, Sbs, aV0); \
        fq4 = SC_FRAG(bufoff, 18); \
        aV1 = MFMA32(fq5, Sbs, aV1); \
        fq5 = SC_FRAG(bufoff, 26); \
        aO0 = MFMA32(fq0, Sbs, aO0); \
        fq0 = SC_FRAG(bufoff, 3); \
        aO1 = MFMA32(fq1, Sbs, aO1); \
        fq1 = SC_FRAG(bufoff, 11); \
        Sbs = PACK8(S1, 0); \
        aV0 = MFMA32(fq2, Sbs, aV0); \
        fq2 = SC_FRAG(bufoff, 19); \
        aV1 = MFMA32(fq3, Sbs, aV1); \
        fq3 = SC_FRAG(bufoff, 27); \
        aO0 = MFMA32(fq4, Sbs, aO0); \
        fq4 = SC_FRAG(bufoff, 4); \
        aO1 = MFMA32(fq5, Sbs, aO1); \
        fq5 = SC_FRAG(bufoff, 12); \
        Sbs = PACK8(S1, 1); \
        aV0 = MFMA32(fq0, Sbs, aV0); \
        fq0 = SC_FRAG(bufoff, 20); \
        aV1 = MFMA32(fq1, Sbs, aV1); \
        fq1 = SC_FRAG(bufoff, 28); \
        aO0 = MFMA32(fq2, Sbs, aO0); \
        fq2 = SC_FRAG(bufoff, 5); \
        aO1 = MFMA32(fq3, Sbs, aO1); \
        fq3 = SC_FRAG(bufoff, 13); \
        Sbs = PACK8(S2, 0); \
        aV0 = MFMA32(fq4, Sbs, aV0); \
        fq4 = SC_FRAG(bufoff, 21); \
        aV1 = MFMA32(fq5, Sbs, aV1); \
        fq5 = SC_FRAG(bufoff, 29); \
        aO0 = MFMA32(fq0, Sbs, aO0); \
        fq0 = SC_FRAG(bufoff, 6); \
        aO1 = MFMA32(fq1, Sbs, aO1); \
        fq1 = SC_FRAG(bufoff, 14); \
        Sbs = PACK8(S2, 1); \
        aV0 = MFMA32(fq2, Sbs, aV0); \
        fq2 = SC_FRAG(bufoff, 22); \
        aV1 = MFMA32(fq3, Sbs, aV1); \
        fq3 = SC_FRAG(bufoff, 30); \
        aO0 = MFMA32(fq4, Sbs, aO0); \
        fq4 = SC_FRAG(bufoff, 7); \
        aO1 = MFMA32(fq5, Sbs, aO1); \
        fq5 = SC_FRAG(bufoff, 15); \
        Sbs = PACK8(S3, 0); \
        aV0 = MFMA32(fq0, Sbs, aV0); \
        fq0 = SC_FRAG(bufoff, 23); \
        aV1 = MFMA32(fq1, Sbs, aV1); \
        fq1 = SC_FRAG(bufoff, 31); \
        aO0 = MFMA32(fq2, Sbs, aO0); \
        fq2 = SC_FRAG(bufoff, 40); \
        aO1 = MFMA32(fq3, Sbs, aO1); \
        fq3 = SC_FRAG(bufoff, 44); \
        Sbs = PACK8(S3, 1); \
        aV0 = MFMA32(fq4, Sbs, aV0); \
        fq4 = SC_FRAG(bufoff, 36); \
        aV1 = MFMA32(fq5, Sbs, aV1); \
        fq5 = SC_FRAG(bufoff, 48); \
        S0 = S0 * cd; S1 = S1 * cd; S2 = S2 * cd; S3 = S3 * cd; \
        aO0 = MFMA32(fq0, Sbs, aO0); \
        fq0 = SC_FRAG(bufoff, 52); \
        aO1 = MFMA32(fq1, Sbs, aO1); \
        fq1 = SC_FRAG(bufoff, 32); \
        Vb0 = PACK8(aV0, 0); Vb1 = PACK8(aV0, 1); Vb2 = PACK8(aV1, 0); Vb3 = PACK8(aV1, 1); \
        S0 = MFMA32(fq2, Vb0, S0); \
        fq2 = SC_FRAG(bufoff, 41); \
        S1 = MFMA32(fq3, Vb0, S1); \
        fq3 = SC_FRAG(bufoff, 45); \
        aO1 = MFMA32(fq4, Vb0, aO1); \
        fq4 = SC_FRAG(bufoff, 37); \
        S2 = MFMA32(fq5, Vb0, S2); \
        fq5 = SC_FRAG(bufoff, 49); \
        S3 = MFMA32(fq0, Vb0, S3); \
        fq0 = SC_FRAG(bufoff, 53); \
        aO0 = MFMA32(fq1, Vb0, aO0); \
        fq1 = SC_FRAG(bufoff, 33); \
        S0 = MFMA32(fq2, Vb1, S0); \
        fq2 = SC_FRAG(bufoff, 42); \
        S1 = MFMA32(fq3, Vb1, S1); \
        fq3 = SC_FRAG(bufoff, 46); \
        aO1 = MFMA32(fq4, Vb1, aO1); \
        fq4 = SC_FRAG(bufoff, 38); \
        S2 = MFMA32(fq5, Vb1, S2); \
        fq5 = SC_FRAG(bufoff, 50); \
        S3 = MFMA32(fq0, Vb1, S3); \
        fq0 = SC_FRAG(bufoff, 54); \
        aO0 = MFMA32(fq1, Vb1, aO0); \
        fq1 = SC_FRAG(bufoff, 43); \
        S0 = MFMA32(fq2, Vb2, S0); \
        fq2 = SC_FRAG(bufoff, 47); \
        S1 = MFMA32(fq3, Vb2, S1); \
        fq3 = SC_FRAG(bufoff, 39); \
        aO1 = MFMA32(fq4, Vb2, aO1); \
        fq4 = SC_FRAG(bufoff, 51); \
        S2 = MFMA32(fq5, Vb2, S2); \
        fq5 = SC_FRAG(bufoff, 55); \
        S3 = MFMA32(fq0, Vb2, S3); \
        S0 = MFMA32(fq1, Vb3, S0); \
        S1 = MFMA32(fq2, Vb3, S1); \
        aO1 = MFMA32(fq3, Vb3, aO1); \
        S2 = MFMA32(fq4, Vb3, S2); \
        S3 = MFMA32(fq5, Vb3, S3);
#ifdef SCAN_Q6
#define SC_BODY(bufoff) SC_BODY6(bufoff)
#else
#define SC_BODY(bufoff) SC_BODY8(bufoff)
#endif
#define SC_CHUNK(nn, U, bufoff, otoff) do { \
        f32x16 aV0, aV1, aO0, aO1; bf16x8 fq0, fq1, fq2, fq3, fq4, fq5, fq6, fq7, Sbs, Vb0, Vb1, Vb2, Vb3; \
        _Pragma("unroll") for (int q = 0; q < 4; ++q) { aV0[2 * q] = bflo(U[0][q]); aV0[2 * q + 1] = bfhi(U[0][q]); aV0[8 + 2 * q] = bflo(U[1][q]); aV0[8 + 2 * q + 1] = bfhi(U[1][q]); \
            aV1[2 * q] = bflo(U[2][q]); aV1[2 * q + 1] = bfhi(U[2][q]); aV1[8 + 2 * q] = bflo(U[3][q]); aV1[8 + 2 * q + 1] = bfhi(U[3][q]); } \
        _Pragma("unroll") for (int r = 0; r < 16; ++r) { aO0[r] = 0.f; aO1[r] = 0.f; } \
        if ((nn) + SC_ULEAD < NCH) SC_LOADU(U, (nn) + SC_ULEAD); \
        const float cd = __builtin_bit_cast(float, __builtin_amdgcn_readlane(__builtin_bit_cast(int, cdl), (nn))); \
        SC_BODY(bufoff) \
        _Pragma("unroll") for (int r = 0; r < 16; ++r) { \
            *(LAS bf16*)(lds + (otoff) + (((r & 3) + 8 * (r >> 2) + 4 * hf) * OT_LD + 32 * w + c32) * 2) = (bf16)(pkbf(aO0[r], 0.f) & 0xffffu); \
            *(LAS bf16*)(lds + (otoff) + ((32 + (r & 3) + 8 * (r >> 2) + 4 * hf) * OT_LD + 32 * w + c32) * 2) = (bf16)(pkbf(aO1[r], 0.f) & 0xffffu); } \
        RAW_BAR(); } while (0)
#ifdef SCAN_DEEP_U
        SC_LOADU(UA, 0); SC_LOADU(UB, 1);
        RAW_BAR();
#pragma unroll 1
        for (int n = 0; n < NCH; n += 2) { SC_CHUNK(n, UA, 0, OT_OFF); SC_CHUNK(n + 1, UB, SCB, OT_OFF + OT_BYTES); }
#else
        SC_LOADU(UA, 0);
        RAW_BAR();
#pragma unroll 1
        for (int n = 0; n < NCH; n += 2) { SC_CHUNK(n, UA, 0, OT_OFF); SC_CHUNK(n + 1, UA, SCB, OT_OFF + OT_BYTES); }
#endif
#undef SC_CHUNK
#undef SC_FRAG
#undef SC_LOADU
#endif
    } else {
#ifndef SCAN_NO_HELPER
        const int ht = F.tid - 256, tok = ht >> 2, q = ht & 3;
        bf16* OB = FP8_PDL(layer) ? (bf16*)((unsigned char*)a.out + 64 * MiB) : (bf16*)(ws + WS_MIXIN); const int old_ = FP8_PDL(layer) ? DNW : D;
        v4u RA[14], RB[14];
#ifdef SCAN_DEEP
        v4u RC[14];
#endif
        const __amdgpu_buffer_rsrc_t rsI = __builtin_amdgcn_make_buffer_rsrc((void*)(IMG + chd0 * IMG_ELEMS), (short)0, NCH * NH * IMG_ELEMS * 2, 0x00020000);
#define SH_LOADIMG(dst, nn) do { _Pragma("unroll") for (int i_ = 0; i_ < 14; ++i_) dst[i_] = __builtin_amdgcn_raw_buffer_load_b128(rsI, (unsigned)ht * 16u, (unsigned)(nn) * (unsigned)(NH * IMG_ELEMS * 2) + (unsigned)i_ * 4096u, 0); } while (0)
#define SH_STOREIMG(src, bufoff) do { LAS v4u* p_ = (LAS v4u*)(lds + (bufoff)) + ht; _Pragma("unroll") for (int i_ = 0; i_ < 14; ++i_) p_[i_ * 256] = src[i_]; } while (0)
#define SH_EPI(mm, otoff) do { const LAS v4u* op_ = (const LAS v4u*)(lds + (otoff) + (tok * OT_LD + 32 * q) * 2); \
        v4u* yp_ = (v4u*)(OB + ((size_t)b * SEQ + (size_t)(mm) * CH + tok) * old_ + h * HD + 32 * q); \
        _Pragma("unroll") for (int i_ = 0; i_ < 4; ++i_) yp_[i_] = op_[i_]; } while (0)
#define SH_STEP(nn, Rcur, Rnext, bufnext, otprev) do { \
        if ((nn) + 2 < NCH) SH_LOADIMG(Rcur, (nn) + 2); \
        if ((nn) >= 1) SH_EPI((nn) - 1, otprev); \
        if ((nn) + 1 < NCH) SH_STOREIMG(Rnext, bufnext); \
        RAW_BAR(); } while (0)
#ifdef SCAN_DEEP
#define SH_STEP3(nn, Rload, Rstore, bufnext, otprev) do { \
        if ((nn) + 3 < NCH) SH_LOADIMG(Rload, (nn) + 3); \
        if ((nn) >= 1) SH_EPI((nn) - 1, otprev); \
        if ((nn) + 1 < NCH) SH_STOREIMG(Rstore, bufnext); \
        RAW_BAR(); } while (0)
        static_assert(NCH == 64, "the helper's step loop is written for 64 chunks (10 x 6 + 4)");
        SH_LOADIMG(RA, 0); SH_LOADIMG(RB, 1); SH_LOADIMG(RC, 2);
        SH_STOREIMG(RA, 0);
        RAW_BAR();
#pragma unroll 1
        for (int n = 0; n < 60; n += 6) {
            SH_STEP3(n, RA, RB, SCB, OT_OFF + OT_BYTES); SH_STEP3(n + 1, RB, RC, 0, OT_OFF); SH_STEP3(n + 2, RC, RA, SCB, OT_OFF + OT_BYTES);
            SH_STEP3(n + 3, RA, RB, 0, OT_OFF); SH_STEP3(n + 4, RB, RC, SCB, OT_OFF + OT_BYTES); SH_STEP3(n + 5, RC, RA, 0, OT_OFF); }
        SH_STEP3(60, RA, RB, SCB, OT_OFF + OT_BYTES); SH_STEP3(61, RB, RC, 0, OT_OFF); SH_STEP3(62, RC, RA, SCB, OT_OFF + OT_BYTES); SH_STEP3(63, RA, RB, 0, OT_OFF);
        SH_EPI(NCH - 1, OT_OFF + OT_BYTES);
#undef SH_STEP3
#else
        SH_LOADIMG(RA, 0); SH_LOADIMG(RB, 1);
        SH_STOREIMG(RA, 0);
        RAW_BAR();
#pragma unroll 1
        for (int n = 0; n < NCH; n += 2) { SH_STEP(n, RA, RB, SCB, OT_OFF + OT_BYTES); SH_STEP(n + 1, RB, RA, 0, OT_OFF); }
        SH_EPI(NCH - 1, OT_OFF + OT_BYTES);
#endif
#undef SH_STEP
#undef SH_EPI
#undef SH_STOREIMG
#undef SH_LOADIMG
#endif
    }
}

__device__ __forceinline__ void phase_dn_norm(const Frame& F0, const Args& a, int layer) {
    PHASE_FRAME(F0);
    unsigned char* ws = OPQ_G(unsigned char, a.ws);
    const bf16* PROJ = (const bf16*)(ws + WS_PROJ); bf16* MIXIN = (bf16*)(ws + WS_MIXIN);
    const bf16* OSRC = FP8_PDL(layer) ? (const bf16*)((unsigned char*)a.out + 64 * MiB) : (const bf16*)(ws + WS_MIXIN); const int old_ = FP8_PDL(layer) ? DNW : D;
    const int lane = F.lane, gw = F.vcu * NWAVES + F.wave, NGW = F.G * NWAVES;
    const float* nw = a.in[I_NORMW] + layer * HD + 16 * (lane & 7); f32x4 nwv[4];
#pragma unroll
    for (int i = 0; i < 4; ++i) nwv[i] = *(const f32x4*)(nw + 4 * i);
    v4u OA[2], ZA[2], OB[2], ZB[2];
#define DNN_LOAD(O_, Z_, t) do { const v4u* op_ = (const v4u*)(OSRC + (size_t)(t) * old_ + 16 * lane); const v4u* zp_ = (const v4u*)(PROJ + (size_t)(t) * NPROJ + 3072 + 16 * lane); O_[0] = op_[0]; O_[1] = op_[1]; Z_[0] = zp_[0]; Z_[1] = zp_[1]; } while (0)
#define DNN_ROW(O_, Z_, t) do { float ss = 0.f; \
        _Pragma("unroll") for (int i = 0; i < 2; ++i) _Pragma("unroll") for (int j = 0; j < 4; ++j) { const float x0 = bflo(O_[i][j]), x1 = bfhi(O_[i][j]); ss += x0 * x0 + x1 * x1; } \
        ss = row8_sum(ss); const float rr = 1.0f / sqrtf(ss * (1.0f / HD) + RMS_EPS); \
        v4u* yp_ = (v4u*)(MIXIN + (size_t)(t) * D + 16 * lane); float yv_[16]; \
        _Pragma("unroll") for (int i = 0; i < 2; ++i) { _Pragma("unroll") for (int j = 0; j < 4; ++j) { const float z0 = bflo(Z_[i][j]), z1 = bfhi(Z_[i][j]); const f32x4 nn = nwv[2 * i + (j >> 1)]; \
            yv_[8 * i + 2 * j] = bflo(O_[i][j]) * rr * nn[2 * (j & 1)] * z0 * sigmoidf_(z0); yv_[8 * i + 2 * j + 1] = bfhi(O_[i][j]) * rr * nn[2 * (j & 1) + 1] * z1 * sigmoidf_(z1); } } \
        if (FP8_PDL(layer)) { v4u o8_; _Pragma("unroll") for (int q4 = 0; q4 < 4; ++q4) o8_[q4] = pk4_fp8(yv_[4 * q4] * F8_XS, yv_[4 * q4 + 1] * F8_XS, yv_[4 * q4 + 2] * F8_XS, yv_[4 * q4 + 3] * F8_XS); *(v4u*)((unsigned char*)MIXIN + (size_t)(t) * D + 16 * lane) = o8_; } \
        else { _Pragma("unroll") for (int i = 0; i < 2; ++i) { v4u o_; _Pragma("unroll") for (int j = 0; j < 4; ++j) o_[j] = pkbf(yv_[8 * i + 2 * j], yv_[8 * i + 2 * j + 1]); yp_[i] = o_; } } } while (0)
#ifdef ROWS_XCD
    { const int RPW = (T + NGW - 1) / NGW, t0 = gw * RPW, t1 = (t0 + RPW) < T ? (t0 + RPW) : T;
        if (t0 < t1) DNN_LOAD(OA, ZA, t0);
#pragma unroll 1
        for (int t = t0; t < t1; t += 2) {
            if (t + 1 < t1) DNN_LOAD(OB, ZB, t + 1);
            DNN_ROW(OA, ZA, t);
            if (t + 2 < t1) DNN_LOAD(OA, ZA, t + 2);
            if (t + 1 < t1) DNN_ROW(OB, ZB, t + 1);
        } }
#else
    if (gw < T) DNN_LOAD(OA, ZA, gw);
#pragma unroll 1
    for (int t = gw; t < T; t += 2 * NGW) {
        if (t + NGW < T) DNN_LOAD(OB, ZB, t + NGW);
        DNN_ROW(OA, ZA, t);
        if (t + 2 * NGW < T) DNN_LOAD(OA, ZA, t + 2 * NGW);
        if (t + NGW < T) DNN_ROW(OB, ZB, t + NGW);
    }
#endif
#undef DNN_LOAD
#undef DNN_ROW
}

constexpr int WG_LD = 2056;
__device__ __forceinline__ void phase_ln1_router(const Frame& F0, const Args& a, int layer, int probe = 0, int f8 = 0) {
    PHASE_FRAME(F0);
    unsigned char* ws = OPQ_G(unsigned char, a.ws);
    LAS bf16* WgT = (LAS bf16*)F.lds;
    LAS float* GV = (LAS float*)(F.lds + 16 * WG_LD * 2);
    LAS float* part = GV + 2 * D;
    LAS float* rst = part + 2 * 64 * 16;
    LAS float* sgcb = rst + 128;
    LAS int* rowE = (LAS int*)(F.lds + AUX_OFF); LAS int* rowP = rowE + 128; LAS float* rowG = (LAS float*)(rowP + 128); LAS int* lcnt = (LAS int*)(rowG + 128); LAS int* lbase = lcnt + 16;
    const float* wr = OPQ_G(const float, a.in[I_WR]); const float* br = OPQ_G(const float, a.in[I_BR]);
    const float* g1 = a.in[I_LN1G] + (size_t)layer * D; const float* b1 = a.in[I_LN1B] + (size_t)layer * D;
    const int tid = F.tid, lane = F.lane, wave = F.wave;
    const bf16* PRE = (const bf16*)a.out;
    v2u XA[8], XB_[8];
#define PE_LOAD(X, rb_, r) do { const GAS v2u* xr_ = (const GAS v2u*)(PRE + (size_t)((rb_) * 64 + wave * 8 + (r)) * D) + lane; _Pragma("unroll") for (int j = 0; j < 8; ++j) X[j] = xr_[64 * j]; } while (0)
#ifdef PE_EARLY
    if (F.vcu < T / 64) { PE_LOAD(XA, F.vcu, 0); asm volatile("" ::: "memory"); }
#endif
    for (int i = tid; i < D; i += 512) { GV[i] = g1[i]; GV[D + i] = b1[i]; }
    { const int e = tid & 15, kp = tid >> 4; float s1 = 0.f, s2 = 0.f;
        for (int k = 64 * kp; k < 64 * kp + 64; k += 2) { const float w0 = wr[(size_t)k * NE + e], w1 = wr[(size_t)(k + 1) * NE + e]; const unsigned pk = pkbf(g1[k] * w0, g1[k + 1] * w1);
            *(LAS unsigned*)(WgT + e * WG_LD + k) = pk; s1 += bflo(pk) + bfhi(pk); s2 += b1[k] * w0 + b1[k + 1] * w1; }
        part[kp * 16 + e] = s1; part[512 + kp * 16 + e] = s2; }
    __syncthreads();
    if (tid < 32) { const int e = tid & 15, which = tid >> 4; float s = 0.f; for (int kp = 0; kp < 32; ++kp) s += part[which * 512 + kp * 16 + e]; sgcb[which * 16 + e] = which ? s + br[e] : s; }
    __syncthreads();
    bf16* X1B = (bf16*)(ws + (probe ? WS_R1 : WS_X1B)); float* STATS = (float*)(ws + (probe ? WS_R1 + 70 * MiB : WS_STATS));
    int* LIST = (int*)(ws + (probe ? WS_R1 + 72 * MiB : WS_LIST)); int* TOKSLOT = (int*)(ws + (probe ? WS_R1 + 80 * MiB : WS_TOKSLOT)); float* GATEW = (float*)(ws + (probe ? WS_R1 + 82 * MiB : WS_GATEW));
    gu32* cnt = F.ctl + CW_CNT + 64 * (layer + (probe ? 2 : 0));
    for (int rb = F.vcu; rb < T / 64; rb += F.G) {
        if (tid < 16) lcnt[tid] = 0;
#define PE_ROW(X, r) do { const int lr = wave * 8 + (r), row = rb * 64 + lr; unsigned gvo_ = (unsigned)(uintptr_t)GV; asm volatile("" : "+v"(gvo_)); const LAS float* GVr = (const LAS float*)(uintptr_t)gvo_; \
            f32x4 v[8]; float s = 0.f; \
            _Pragma("unroll") for (int j = 0; j < 8; ++j) { v[j] = (f32x4){bflo(X[j].x), bfhi(X[j].x), bflo(X[j].y), bfhi(X[j].y)}; s += (v[j][0] + v[j][1]) + (v[j][2] + v[j][3]); } \
            const float mean = wave_sum(s) * (1.f / D); float s2 = 0.f; \
            _Pragma("unroll") for (int j = 0; j < 8; ++j) { v[j] = v[j] - mean; s2 += (v[j][0] * v[j][0] + v[j][1] * v[j][1]) + (v[j][2] * v[j][2] + v[j][3] * v[j][3]); } \
            const float rstd = 1.f / sqrtf(wave_sum(s2) * (1.f / D) + LN_EPS); \
            if (lane == 0) { STATS[2 * row] = mean; STATS[2 * row + 1] = rstd; rst[2 * lr] = mean; rst[2 * lr + 1] = rstd; } \
            GAS v2u* o8 = (GAS v2u*)(X1B + (size_t)row * D) + lane; \
            _Pragma("unroll") for (int j = 0; j < 8; ++j) { const f32x4 gg = *(const LAS f32x4*)(GVr + 256 * j + 4 * lane), bb = *(const LAS f32x4*)(GVr + D + 256 * j + 4 * lane); \
                v[j] = v[j] * rstd * gg + bb; \
                if (f8) ((GAS unsigned*)((GAS unsigned char*)X1B + (size_t)row * D) + lane)[64 * j] = pk4_fp8(v[j][0] * F8_XS, v[j][1] * F8_XS, v[j][2] * F8_XS, v[j][3] * F8_XS); \
                else { v2u w; w.x = pkbf(v[j][0], v[j][1]); w.y = pkbf(v[j][2], v[j][3]); o8[64 * j] = w; } } } while (0)
#ifdef PE_EARLY
        if (rb != F.vcu) PE_LOAD(XA, rb, 0);
#else
        PE_LOAD(XA, rb, 0);
#endif
#pragma unroll 1
        for (int r = 0; r < 8; r += 2) { PE_LOAD(XB_, rb, r + 1); PE_ROW(XA, r); if (r + 2 < 8) PE_LOAD(XA, rb, r + 2); PE_ROW(XB_, r + 1); }
#undef PE_ROW
        { const int mt = wave & 3, kh = wave >> 2, fr = lane & 15, fg = lane >> 4; typedef float f32x4v __attribute__((ext_vector_type(4))); f32x4v acc = {0.f, 0.f, 0.f, 0.f};
            const bf16* arow = PRE + (size_t)(rb * 64 + 16 * mt + fr) * D + 1024 * kh + 8 * fg; const LAS bf16* brow = WgT + fr * WG_LD + 1024 * kh + 8 * fg;
#ifdef PE_EARLY
#pragma unroll 1
            for (int sb = 0; sb < 32; sb += 16) { bf16x8 aq[16];
#pragma unroll
                for (int s = 0; s < 16; ++s) aq[s] = *(const bf16x8*)(arow + 32 * (sb + s));
                asm volatile("" : "+v"(aq[0]), "+v"(aq[1]), "+v"(aq[2]), "+v"(aq[3]), "+v"(aq[4]), "+v"(aq[5]), "+v"(aq[6]), "+v"(aq[7]), "+v"(aq[8]), "+v"(aq[9]), "+v"(aq[10]), "+v"(aq[11]), "+v"(aq[12]), "+v"(aq[13]), "+v"(aq[14]), "+v"(aq[15]));
#pragma unroll
                for (int s = 0; s < 16; ++s) acc = __builtin_amdgcn_mfma_f32_16x16x32_bf16(aq[s], *(const LAS bf16x8*)(brow + 32 * (sb + s)), acc, 0, 0, 0); }
#else
#pragma unroll 1
            for (int sb = 0; sb < 32; sb += 8) { bf16x8 aq[8];
#pragma unroll
                for (int s = 0; s < 8; ++s) aq[s] = *(const bf16x8*)(arow + 32 * (sb + s));
                asm volatile("" : "+v"(aq[0]), "+v"(aq[1]), "+v"(aq[2]), "+v"(aq[3]), "+v"(aq[4]), "+v"(aq[5]), "+v"(aq[6]), "+v"(aq[7]));
#pragma unroll
                for (int s = 0; s < 8; ++s) acc = __builtin_amdgcn_mfma_f32_16x16x32_bf16(aq[s], *(const LAS bf16x8*)(brow + 32 * (sb + s)), acc, 0, 0, 0); }
#endif
#pragma unroll
            for (int r = 0; r < 4; ++r) part[(kh * 64 + 16 * mt + 4 * fg + r) * 16 + fr] = acc[r]; }
        __syncthreads();
        if (tid < 64) { const int lr = tid; const float mean = rst[2 * lr], rstd = rst[2 * lr + 1]; float p[16]; float mx = -3.0e38f;
#pragma unroll
            for (int e = 0; e < 16; ++e) { p[e] = rstd * ((part[lr * 16 + e] + part[(64 + lr) * 16 + e]) - mean * sgcb[e]) + sgcb[16 + e]; mx = fmaxf(mx, p[e]); }
#pragma unroll
            for (int e = 0; e < 16; ++e) p[e] = __expf(p[e] - mx);
            float gsc[4];
#pragma unroll
            for (int g = 0; g < 4; ++g) { const float a0 = p[4 * g], a1 = p[4 * g + 1], a2 = p[4 * g + 2], a3 = p[4 * g + 3];
                const float hi1 = fmaxf(a0, a1), lo1 = fminf(a0, a1), hi2 = fmaxf(a2, a3), lo2 = fminf(a2, a3);
                gsc[g] = fmaxf(hi1, hi2) + fmaxf(fminf(hi1, hi2), fmaxf(lo1, lo2)); }
            int gsel = 0; float best = gsc[0];
#pragma unroll
            for (int g = 1; g < 4; ++g) if (gsc[g] > best) { best = gsc[g]; gsel = g; }
            float q[4];
#pragma unroll
            for (int j = 0; j < 4; ++j) q[j] = gsel == 0 ? p[j] : (gsel == 1 ? p[4 + j] : (gsel == 2 ? p[8 + j] : p[12 + j]));
            int i0 = 0; float p0 = q[0];
#pragma unroll
            for (int j = 1; j < 4; ++j) if (q[j] > p0) { p0 = q[j]; i0 = j; }
            int i1 = -1; float p1 = -1.f;
#pragma unroll
            for (int j = 0; j < 4; ++j) if (j != i0 && q[j] > p1) { p1 = q[j]; i1 = j; }
            const int e0 = gsel * 4 + i0, e1 = gsel * 4 + i1; const float inv = 1.0f / (p0 + p1);
            rowE[2 * lr] = e0; rowE[2 * lr + 1] = e1; rowG[2 * lr] = p0 * inv; rowG[2 * lr + 1] = p1 * inv;
            rowP[2 * lr] = __hip_atomic_fetch_add(&lcnt[e0], 1, __ATOMIC_RELAXED, __HIP_MEMORY_SCOPE_WORKGROUP); rowP[2 * lr + 1] = __hip_atomic_fetch_add(&lcnt[e1], 1, __ATOMIC_RELAXED, __HIP_MEMORY_SCOPE_WORKGROUP); }
        __syncthreads();
        if (tid < 16) lbase[tid] = (int)__hip_atomic_fetch_add(cnt + tid, (unsigned)lcnt[tid], RLX_AGENT);
        __syncthreads();
        if (tid < 128) { const int e = rowE[tid], pos = lbase[e] + rowP[tid], tok = rb * 64 + (tid >> 1);
            LIST[(size_t)e * LCAP + pos] = tok; TOKSLOT[2 * tok + (tid & 1)] = e * LCAP + pos; GATEW[2 * tok + (tid & 1)] = rowG[tid]; }
        __syncthreads();
    }
#undef PE_LOAD
}
__device__ __forceinline__ void moe_table(const Frame& F0, int layer) {
    PHASE_FRAME(F0);
    LAS int* tab = (LAS int*)(F.lds + AUX_OFF);
    __syncthreads();
    if (F.tid < 16) tab[32 + F.tid] = (int)__hip_atomic_load(F.ctl + CW_CNT + 64 * layer + F.tid, RLX_AGENT);
    __syncthreads();
    if (F.tid == 0) { int blk = 0, nf = 0, nh = 0; for (int e = 0; e < 16; ++e) { const int cn = tab[32 + e]; tab[e] = blk; tab[48 + e] = nf; tab[80 + e] = nh; blk += (cn + 127) >> 7; nf += cn >> 8; nh += ((cn & 255) + 127) >> 7; } tab[16] = blk; tab[64] = nf; tab[96] = nh; }
    __syncthreads();
}
#ifdef Y_F8
typedef unsigned YW_T;
#define YW_ESZ 1
#define YW_SCL (1.0f / Y_F8S)
#define YW_COMBINE(f, P, Q) do { const f32x2 pl_ = __builtin_amdgcn_cvt_pk_f32_fp8((int)(P), false), ph_ = __builtin_amdgcn_cvt_pk_f32_fp8((int)(P), true), ql_ = __builtin_amdgcn_cvt_pk_f32_fp8((int)(Q), false), qh_ = __builtin_amdgcn_cvt_pk_f32_fp8((int)(Q), true); \
        f[0] = w0 * pl_[0] + w1 * ql_[0]; f[1] = w0 * pl_[1] + w1 * ql_[1]; f[2] = w0 * ph_[0] + w1 * qh_[0]; f[3] = w0 * ph_[1] + w1 * qh_[1]; } while (0)
#else
typedef v2u YW_T;
#define YW_ESZ 2
#define YW_SCL 1.0f
#define YW_COMBINE(f, P, Q) do { f[0] = w0 * bflo((P).x) + w1 * bflo((Q).x); f[1] = w0 * bfhi((P).x) + w1 * bfhi((Q).x); f[2] = w0 * bflo((P).y) + w1 * bflo((Q).y); f[3] = w0 * bfhi((P).y) + w1 * bfhi((Q).y); } while (0)
#endif
__device__ __forceinline__ void phase_combine_ln2(const Frame& F0, const Args& a, int layer, int probe = 0, int f8 = 0) {
    PHASE_FRAME(F0);
    unsigned char* ws = OPQ_G(unsigned char, a.ws); const LAS int* tab = (const LAS int*)(F.lds + AUX_OFF);
    const bf16* PRE = (const bf16*)a.out; const float* STATS = (const float*)(ws + WS_STATS); const bf16* Y = (const bf16*)(ws + WS_Y); bf16* X2B = (bf16*)(ws + (probe ? WS_R1 : WS_X2B)); unsigned char* X2F8 = ws + WS_X2F8;
    const int* TOKSLOT = (const int*)(ws + WS_TOKSLOT); const float* GATEW = (const float*)(ws + WS_GATEW);
    LAS float* GV = (LAS float*)F.lds;
    { const float* g1 = a.in[I_LN1G] + (size_t)layer * D; const float* b1 = a.in[I_LN1B] + (size_t)layer * D; const float* g2 = a.in[I_LN2G] + (size_t)layer * D; const float* b2 = a.in[I_LN2B] + (size_t)layer * D;
        for (int i = F.tid; i < D; i += 512) { GV[i] = g1[i]; GV[D + i] = b1[i]; GV[2 * D + i] = g2[i]; GV[3 * D + i] = b2[i]; } }
    __syncthreads();
#ifdef ROWS_XCD
    const int gw = F.vcu * NWAVES + F.wave, NGW = F.G * NWAVES, RPW = (T + NGW - 1) / NGW, lane = F.lane, nrows = (T - gw * RPW) < RPW ? ((T - gw * RPW) > 0 ? T - gw * RPW : 0) : RPW;
#define PH_ROWIDX(k) (gw * RPW + (k))
#else
    const int gw = F.vcu * NWAVES + F.wave, NGW = F.G * NWAVES, nrows = (T - gw + NGW - 1) / NGW, lane = F.lane;
#define PH_ROWIDX(k) (gw + NGW * (k))
#endif
    for (int base = 0; base < nrows; base += 64) {
        const int nr = (nrows - base) < 64 ? (nrows - base) : 64;
        float m_mean = 0.f, m_rstd = 0.f, m_w0 = 0.f, m_w1 = 0.f; int m_y0 = 0, m_y1 = 0;
        if (lane < nr) { const int row = PH_ROWIDX(base + lane); m_mean = STATS[2 * row]; m_rstd = STATS[2 * row + 1]; m_w0 = GATEW[2 * row]; m_w1 = GATEW[2 * row + 1];
            const int s0 = TOKSLOT[2 * row], s1 = TOKSLOT[2 * row + 1]; m_y0 = tab[s0 / LCAP] * 128 + (s0 % LCAP); m_y1 = tab[s1 / LCAP] * 128 + (s1 % LCAP); }
        v2u XA[8], XB_[8]; YW_T PA[8], QA[8], PB_[8], QB_[8];
#define PH_LOAD(X, P, Q, i) do { const int row_ = PH_ROWIDX(base + (i)); const size_t y0_ = (size_t)__builtin_amdgcn_readlane(m_y0, (i)), y1_ = (size_t)__builtin_amdgcn_readlane(m_y1, (i)); \
            const GAS v2u* xr_ = (const GAS v2u*)(PRE + (size_t)row_ * D) + lane; const GAS YW_T* ya_ = (const GAS YW_T*)((const GAS unsigned char*)Y + y0_ * D * YW_ESZ) + lane; const GAS YW_T* yb_ = (const GAS YW_T*)((const GAS unsigned char*)Y + y1_ * D * YW_ESZ) + lane; \
            _Pragma("unroll") for (int j = 0; j < 8; ++j) { X[j] = xr_[64 * j]; P[j] = ya_[64 * j]; Q[j] = yb_[64 * j]; } } while (0)
#define PH_ROW(X, P, Q, i) do { const int row_ = PH_ROWIDX(base + (i)); unsigned gvo_ = (unsigned)(uintptr_t)GV; asm volatile("" : "+v"(gvo_)); const LAS float* GVr = (const LAS float*)(uintptr_t)gvo_;     \
            const float mean = __builtin_bit_cast(float, __builtin_amdgcn_readlane(__builtin_bit_cast(int, m_mean), (i))), rstd = __builtin_bit_cast(float, __builtin_amdgcn_readlane(__builtin_bit_cast(int, m_rstd), (i))); \
            const float w0 = YW_SCL * __builtin_bit_cast(float, __builtin_amdgcn_readlane(__builtin_bit_cast(int, m_w0), (i))), w1 = YW_SCL * __builtin_bit_cast(float, __builtin_amdgcn_readlane(__builtin_bit_cast(int, m_w1), (i))); \
            f32x4 v[8]; float s = 0.f; \
            _Pragma("unroll") for (int j = 0; j < 8; ++j) { const f32x4 gg = *(const LAS f32x4*)(GVr + 256 * j + 4 * lane), bb = *(const LAS f32x4*)(GVr + D + 256 * j + 4 * lane); \
                const f32x4 x1 = ((f32x4){bflo(X[j].x), bfhi(X[j].x), bflo(X[j].y), bfhi(X[j].y)} - mean) * rstd * gg + bb; \
                f32x4 f; YW_COMBINE(f, P[j], Q[j]); \
                v[j] = x1 * ALPHA + f; s += (v[j][0] + v[j][1]) + (v[j][2] + v[j][3]); } \
            const float m2 = wave_sum(s) * (1.f / D); float q = 0.f; \
            _Pragma("unroll") for (int j = 0; j < 8; ++j) { v[j] = v[j] - m2; q += (v[j][0] * v[j][0] + v[j][1] * v[j][1]) + (v[j][2] * v[j][2] + v[j][3] * v[j][3]); } \
            const float r2 = 1.f / sqrtf(wave_sum(q) * (1.f / D) + LN_EPS); \
            GAS v2u* o8 = (GAS v2u*)(X2B + (size_t)row_ * D) + lane; \
            _Pragma("unroll") for (int j = 0; j < 8; ++j) { const f32x4 gg = *(const LAS f32x4*)(GVr + 2 * D + 256 * j + 4 * lane), bb = *(const LAS f32x4*)(GVr + 3 * D + 256 * j + 4 * lane); \
                const f32x4 o = v[j] * r2 * gg + bb; v2u w; w.x = pkbf(o[0], o[1]); w.y = pkbf(o[2], o[3]); o8[64 * j] = w; \
                if (f8) ((GAS unsigned*)((GAS unsigned char*)X2F8 + (size_t)row_ * D) + lane)[64 * j] = pk4_fp8(o[0] * F8_XS, o[1] * F8_XS, o[2] * F8_XS, o[3] * F8_XS); } } while (0)
        PH_LOAD(XA, PA, QA, 0);
#pragma unroll 1
        for (int i = 0; i < nr; i += 2) {
            if (i + 1 < nr) PH_LOAD(XB_, PB_, QB_, i + 1);
            PH_ROW(XA, PA, QA, i);
            if (i + 2 < nr) PH_LOAD(XA, PA, QA, i + 2);
            if (i + 1 < nr) PH_ROW(XB_, PB_, QB_, i + 1);
        }
#undef PH_LOAD
#undef PH_ROW
#undef PH_ROWIDX
    }
}

#ifndef MK_N_LAUNCHES
#define MK_N_LAUNCHES 1
#endif
constexpr int NPL = 10;
constexpr int NPHASE = 1 + NPL * DEPTH;
constexpr int N_LAUNCHES = MK_N_LAUNCHES;
static_assert(N_LAUNCHES == 1 || N_LAUNCHES == NPHASE, "MK_N_LAUNCHES is 1 or NPHASE");

#define GRID_BAR() do { if (N_LAUNCHES == 1) xcd_barrier(bar); } while (0)
#ifndef PH_MASK
#define PH_MASK 0x7ff
#endif
#define IN(k) ((((k) == 0 ? 1u : (2u << (((k) - 1) % NPL))) & (unsigned)(PH_MASK)) && lo <= (k) && (k) < hi)
#define SEAM(k) do { if (IN((k) + 1)) GRID_BAR(); } while (0)
#ifndef PROBE_DUP
#define PROBE_DUP 0
#endif
#define REPS(k) ((((k) == 0 ? 1u : (2u << (((k) - 1) % NPL))) & (unsigned)(PROBE_DUP)) ? 2 : 1)

template <int layer> __device__ __forceinline__ void layer_phases(const Frame& F, const Args& args, const XcdBarrier& bar, const int lo, const int hi) {
            const int pb = 1 + NPL * layer;
            unsigned char* ws = OPQ_G(unsigned char, args.ws);
            if (IN(pb + 0)) { for (int rep = 0; rep < REPS(pb + 0); ++rep) { if (rep) GRID_BAR();
                if (FP8_PAL(layer)) {
                    constexpr int LO = FP8_PA_LO(layer), HI = FP8_PA_HIF(layer);
                    if (LO > 0) { SchedDense S; S.init(T, 256 * LO, F.G, (int)blockIdx.x, ws + WS_XB, D, (const bf16*)(ws + WS_WIN) + (size_t)layer * NPROJ * D, D);
                        EpiBf16 E{(bf16*)(ws + WS_PROJ), NPROJ};
                        pg8::gemm_phase<EpiBf16, SchedDense, false>(F.lds + RING_OFF, D, D, D, S, E); }
                    { SchedDense S; S.init(T, 256 * (HI - LO), F.G, (int)blockIdx.x, ws + WS_XBF8, D / 2, ws + WS_WIN8 + (size_t)(DEPTH - 1 - layer) * 12 * MiB, D / 2, LO);
                        EpiBf16 E{(bf16*)(ws + WS_PROJ), NPROJ, F8_INV};
                        pg8::gemm_phase<EpiBf16, SchedDense, false, true>(F.lds + RING_OFF, D / 2, D / 2, D / 2, S, E); }
                    if (HI < 20) { SchedDense S; S.init(T, 256 * (20 - HI), F.G, (int)blockIdx.x, ws + WS_XB, D, (const bf16*)(ws + WS_WIN) + (size_t)layer * NPROJ * D, D, HI);
                        EpiBf16 E{(bf16*)(ws + WS_PROJ), NPROJ};
                        pg8::gemm_phase<EpiBf16, SchedDense, false>(F.lds + RING_OFF, D, D, D, S, E); }
                } else {
                SchedDense S; S.init(T, NPROJ, F.G, (int)blockIdx.x, ws + WS_XB, D, (const bf16*)(ws + WS_WIN) + (size_t)layer * NPROJ * D, D);
                EpiBf16 E{(bf16*)(ws + WS_PROJ), NPROJ};
                pg8::gemm_phase<EpiBf16, SchedDense, false>(F.lds + RING_OFF, D, D, D, S, E);
                }
                } SEAM(pb + 0);
            }
            if (IN(pb + 1)) { for (int rep = 0; rep < REPS(pb + 1); ++rep) { if (rep) GRID_BAR(); phase_dn_prep(F, args, layer); } SEAM(pb + 1); }
            if (IN(pb + 2)) { for (int rep = 0; rep < REPS(pb + 2); ++rep) { if (rep) GRID_BAR();
                if (blockIdx.x < 32 || F.G <= 32) { for (int u = blockIdx.x; u < NB * NH; u += (F.G < 32 ? F.G : 32)) { phase_dn_scan(F, args, layer, u);
#ifdef SCAN_TWICE
                    __syncthreads(); phase_dn_scan(F, args, layer, u);
#endif
                } }
                { const bool big = F.G >= 160; const int NGEMM = big ? 96 : (F.G > 32 ? F.G - 32 : F.G); const int c2 = F.G > 32 ? (int)blockIdx.x - 32 : (int)blockIdx.x;
                  if (c2 >= 0 && c2 < NGEMM) {
                    { int t_ = threadIdx.x; asm volatile("" : "+v"(t_)); Frame Fp = F; Fp.tid = t_; Fp.lane = t_ & 63;
                      for (int L = c2; L < 256; L += NGEMM) pool_diffs_unit(Fp, ws, L >> 2, L & 3);
                      asm volatile("s_waitcnt vmcnt(0)" ::: "memory"); __syncthreads(); }
                    { SchedPool S{NGEMM, c2, (const char*)(ws + WS_POOLD), (const char*)((const bf16*)(ws + WS_WPOOL) + (size_t)layer * 4 * 65536)};
                      EpiPool E{(bf16*)(ws + WS_MIXIN), args.in[I_POOLS] + (size_t)layer * PW, FP8_PDL(layer)};
                      pg8::gemm_phase<EpiPool, SchedPool, false>(F.lds + RING_OFF, 256, PW, 256, S, E); }
                    { SchedDense S; S.init(T, D, NGEMM, c2, (const bf16*)(ws + WS_PB16) + (size_t)layer * T * PLE, PLE, (const bf16*)(ws + WS_WPP) + (size_t)layer * D * PLE, PLE);
                      EpiBf16 E{(bf16*)(ws + WS_PP), D};
                      pg8::gemm_phase<EpiBf16, SchedDense, false>(F.lds + RING_OFF, PLE, PLE, PLE, S, E); } }
#ifndef CONVERT_ALL_IN_PROLOGUE
                  __syncthreads();
                  { int t_ = threadIdx.x; asm volatile("" : "+v"(t_));
                    weight_items(args, ws, (LAS float*)(F.lds + RING_OFF + F.wave * 16384), t_ & 63, 1, layer, 0, 1, F.ctl + CW_CONV + 64 * layer); }
#endif
                }
                } SEAM(pb + 2);
            }
            if (IN(pb + 3)) { for (int rep = 0; rep < REPS(pb + 3); ++rep) { if (rep) GRID_BAR(); phase_dn_norm(F, args, layer); } SEAM(pb + 3); }
            if (IN(pb + 4)) { for (int rep = 0; rep < REPS(pb + 4); ++rep) { if (rep) GRID_BAR();
                if (FP8_PDL(layer)) { SchedDense S; S.init(T, D, F.G, (int)blockIdx.x, ws + WS_MIXIN, D / 2, ws + WS_WOUT + (size_t)layer * D * D * 2, D / 2);
                    EpiRes E{(const bf16*)(ws + WS_XB), (bf16*)args.out, F8_INV};
                    pg8::gemm_phase<EpiRes, SchedDense, false, true>(F.lds + RING_OFF, D / 2, D / 2, D / 2, S, E); }
                else { SchedDense S; S.init(T, D, F.G, (int)blockIdx.x, ws + WS_MIXIN, D, (const bf16*)(ws + WS_WOUT) + (size_t)layer * D * D, D);
                EpiRes E{(const bf16*)(ws + WS_XB), (bf16*)args.out};
#ifdef PROBE_PD
                { EpiRes E2{(const bf16*)(ws + WS_XB), (bf16*)(ws + WS_R1)}; pg8::gemm_phase<EpiRes, SchedDense, false>(F.lds + RING_OFF, D, D, D, S, E2); }
#endif
                pg8::gemm_phase<EpiRes, SchedDense, false>(F.lds + RING_OFF, D, D, D, S, E); }
                } SEAM(pb + 4);
            }
            if (IN(pb + 5)) { for (int rep = 0; rep < REPS(pb + 5); ++rep) { if (rep) GRID_BAR();
#ifdef PROBE_PE
                phase_ln1_router(F, args, layer, 1); __syncthreads();
#endif
                phase_ln1_router(F, args, layer, 0, FP8_LAYER(layer) ? 1 : 0); } SEAM(pb + 5); }
            if (IN(pb + 6)) { for (int rep = 0; rep < REPS(pb + 6); ++rep) { if (rep) GRID_BAR();
                moe_table(F, layer);
                if (FP8_LAYER(layer)) {
                    SchedMoe S{F.G, (int)blockIdx.x, 0, (const LAS int*)(F.lds + AUX_OFF), (const char*)(ws + WS_X1B), (const char*)(ws + WS_WGU + (size_t)layer * NE * 2048 * D * 2), (const int*)(ws + WS_LIST), 1};
                    EpiSwiglu E{(bf16*)(ws + WS_HID), FP8_PG, F8_INV};
                    pg8::gemm_phase<EpiSwiglu, SchedMoe, true, true>(F.lds + RING_OFF, D / 2, D / 2, D / 2, S, E);
                } else {
                    SchedMoe S{F.G, (int)blockIdx.x, 0, (const LAS int*)(F.lds + AUX_OFF), (const char*)(ws + WS_X1B), (const char*)((const bf16*)(ws + WS_WGU) + (size_t)layer * NE * 2048 * D), (const int*)(ws + WS_LIST), 2};
                    EpiSwiglu E{(bf16*)(ws + WS_HID)};
                    pg8::gemm_phase<EpiSwiglu, SchedMoe, true>(F.lds + RING_OFF, D, D, D, S, E);
                }
                } SEAM(pb + 6);
            }
            if (IN(pb + 7)) { for (int rep = 0; rep < REPS(pb + 7); ++rep) { if (rep) GRID_BAR();
                moe_table(F, layer);
                if (FP8_PG && FP8_LAYER(layer)) {
                    SchedMoe S{F.G, (int)blockIdx.x, 1, (const LAS int*)(F.lds + AUX_OFF), (const char*)(ws + WS_HID), (const char*)(ws + WS_WD + (size_t)layer * NE * D * DE * 2), nullptr, 1};
#ifdef Y_F8
                    EpiF8 E{ws + WS_Y, D, F8_INV * Y_F8S};
                    pg8::gemm_phase<EpiF8, SchedMoe, false, true>(F.lds + RING_OFF, DE / 2, DE / 2, DE / 2, S, E);
#else
                    EpiBf16 E{(bf16*)(ws + WS_Y), D, F8_INV};
                    pg8::gemm_phase<EpiBf16, SchedMoe, false, true>(F.lds + RING_OFF, DE / 2, DE / 2, DE / 2, S, E);
#endif
                } else {
                    SchedMoe S{F.G, (int)blockIdx.x, 1, (const LAS int*)(F.lds + AUX_OFF), (const char*)(ws + WS_HID), (const char*)((const bf16*)(ws + WS_WD) + (size_t)layer * NE * D * DE), nullptr, 2};
                    EpiBf16 E{(bf16*)(ws + WS_Y), D};
                    pg8::gemm_phase<EpiBf16, SchedMoe, false>(F.lds + RING_OFF, DE, DE, DE, S, E);
                }
                } SEAM(pb + 7);
            }
            if (IN(pb + 8)) { for (int rep = 0; rep < REPS(pb + 8); ++rep) { if (rep) GRID_BAR(); moe_table(F, layer);
#ifdef PROBE_PH
                phase_combine_ln2(F, args, layer, 1);
#endif
                phase_combine_ln2(F, args, layer, 0, (FP8_PI && (FP8_PI0 || layer == DEPTH - 1)) ? 1 : 0); } SEAM(pb + 8); }
            if (IN(pb + 9)) { for (int rep = 0; rep < REPS(pb + 9); ++rep) { if (rep) GRID_BAR();
                if (FP8_PI && (FP8_PI0 || layer == DEPTH - 1)) {
                    SchedDense S; S.init(T, D, F.G, (int)blockIdx.x, ws + WS_X2F8, D / 2, ws + WS_WPG + (size_t)layer * D * D * 2, D / 2);
                    EpiPle E{(const bf16*)(ws + WS_X2B), (const bf16*)(ws + WS_PP), (bf16*)(ws + WS_XB), args.out, layer + 1 < DEPTH ? 0 : 1, F8_INV, (FP8_PA && layer + 2 == DEPTH) ? ws + WS_XBF8 : nullptr};
                    pg8::gemm_phase<EpiPle, SchedDense, false, true>(F.lds + RING_OFF, D / 2, D / 2, D / 2, S, E);
                } else {
                    SchedDense S; S.init(T, D, F.G, (int)blockIdx.x, ws + WS_X2B, D, (const bf16*)(ws + WS_WPG) + (size_t)layer * D * D, D);
                    EpiPle E{(const bf16*)(ws + WS_X2B), (const bf16*)(ws + WS_PP), (bf16*)(ws + WS_XB), args.out, layer + 1 < DEPTH ? 0 : 1};
                    pg8::gemm_phase<EpiPle, SchedDense, false>(F.lds + RING_OFF, D, D, D, S, E);
                }
                } SEAM(pb + 9);
            }
}
__global__ void __launch_bounds__(NWAVES * 64, 2) trunk_fwd(Args args) {
    extern __shared__ __attribute__((aligned(16))) unsigned char lds[];
    Frame F;
    F.lds = (LAS unsigned char*)lds;
    F.MISC = (volatile LAS unsigned*)(F.lds + MISC_OFF);
    F.tid = threadIdx.x; F.lane = F.tid & 63; F.wave = __builtin_amdgcn_readfirstlane(F.tid >> 6);
    F.G = gridDim.x; { const int bx = blockIdx.x; F.vcu = (F.G % 8 == 0) ? (bx % 8) * (F.G / 8) + bx / 8 : bx; }
    unsigned char* ws = args.ws;
    F.ctl = (gu32*)(ws + WS_CTL);
    for (int u = F.tid; u < (LDS_BYTES - LDSCTL_OFF) / 4; u += NWAVES * 64) ((LAS unsigned*)(F.lds + LDSCTL_OFF))[u] = 0u;
    __syncthreads();
    XcdBarrier bar; bar.bar = (unsigned*)(F.ctl + CW_BAR); bar.x = 0; bar.st = nullptr;
    if (N_LAUNCHES == 1) bar = xcd_barrier_post((unsigned*)(F.ctl + CW_BAR), F.MISC + 8);
    const int lo = args.ph_lo, hi = args.ph_hi;
    if (IN(0)) { for (int rep = 0; rep < REPS(0); ++rep) { if (rep) GRID_BAR(); p0_prologue(F, args); } SEAM(0); }

    layer_phases<0>(F, args, bar, lo, hi);
    layer_phases<1>(F, args, bar, lo, hi);
    static_assert(DEPTH == 2, "layer_phases instantiations");
#undef IN
#undef SEAM
#undef GRID_BAR
}

extern "C" void kernel_launch(void* const* d_in, const int* in_sizes, int n_in, void* d_out, int out_size, void* d_ws, size_t ws_size, hipStream_t stream) {
    static int grid = 0;
    if (grid == 0) {
        if (n_in != 21 || in_sizes[0] != T * D || out_size != T * D || ws_size < WS_END) { fprintf(stderr, "kernel_launch: unexpected shapes (n_in %d, in0 %d, out %d, ws %zu); nothing launched\n", n_in, n_in > 0 ? in_sizes[0] : -1, out_size, ws_size); grid = -1; return; }
        int dev = 0, cus = 0, per_cu = 0;
        if (hipGetDevice(&dev) != hipSuccess || hipDeviceGetAttribute(&cus, hipDeviceAttributeMultiprocessorCount, dev) != hipSuccess) { grid = -1; return; }
        if (hipFuncSetAttribute((const void*)trunk_fwd, hipFuncAttributeMaxDynamicSharedMemorySize, LDS_BYTES) != hipSuccess) { fprintf(stderr, "kernel_launch: hipFuncSetAttribute failed\n"); grid = -1; return; }
        if (hipOccupancyMaxActiveBlocksPerMultiprocessor(&per_cu, (const void*)trunk_fwd, NWAVES * 64, LDS_BYTES) != hipSuccess || per_cu < 1) { fprintf(stderr, "kernel_launch: occupancy query reports %d workgroups per CU\n", per_cu); }
        (void)hipGetLastError();
        grid = cus;
    }
    if (grid < 0) return;
    if (hipMemsetAsync((char*)d_ws + WS_CTL, 0, CTL_ZERO_BYTES, stream) != hipSuccess) return;
    Args a{};
    for (int i = 0; i < 21; ++i) a.in[i] = (const float*)d_in[i];
    a.out = (float*)d_out; a.ws = (unsigned char*)d_ws;
    for (int li = 0; li < N_LAUNCHES; ++li) {
        a.ph_lo = (N_LAUNCHES == 1) ? 0 : li; a.ph_hi = (N_LAUNCHES == 1) ? NPHASE : li + 1; a.li = li; a.pad = 0;
        hipLaunchKernelGGL(trunk_fwd, dim3(grid), dim3(NWAVES * 64), LDS_BYTES, stream, a);
        const hipError_t le = hipPeekAtLastError();
        if (le != hipSuccess) { fprintf(stderr, "kernel_launch: launch %d failed: %s\n", li, hipGetErrorName(le)); break; }
    }
}
```

```cpp
#define MK_N_LAUNCHES 1
#define FP8_ALL 1
#define FP8_PG 1
#define FP8_PI 1
#define FP8_PI0 1
#define FP8_PD 1
#define Y_F8 1
#define FP8_PA 1
#define FP8_PA_ALL 1
#define FP8_PA_HI_E 12
#define NT_WEIGHTS 1
#define GATHER_LDS_IDX 1
#define MOE_SCHED_FAST 1
#define PE_EARLY 1
#define SCAN_DEEP 1
#define SCAN_DEEP_U 1
#define SCAN_Q6 1
#define F8_NOSCALE 1
#define MOE_XCD_MAP 1
#define MOE_XCD_MAP2 1
#include <hip/hip_runtime.h>
#include <cstdio>
#include <cstdint>

#define GAS __attribute__((address_space(1)))
#define LAS __attribute__((address_space(3)))
typedef unsigned short bf16;
typedef unsigned v4u __attribute__((ext_vector_type(4)));
typedef unsigned v2u __attribute__((ext_vector_type(2)));
typedef float f32x4 __attribute__((ext_vector_type(4)));
typedef float f32x2 __attribute__((ext_vector_type(2)));
typedef short bf16x8 __attribute__((ext_vector_type(8)));
typedef GAS unsigned gu32;
typedef int v4i_t __attribute__((ext_vector_type(4)));
typedef int v8i_t __attribute__((ext_vector_type(8)));

namespace pg8 {
constexpr int BM = 256, BK = 64, HALF = 128, HTB = HALF * BK * 2  , STAGE_BYTES = 8 * HTB, NXCD = 8, WGM = 8;
__host__ __device__ __forceinline__ int lds_byte(int r, int c) { const int st = (r >> 4) * 2 + (c >> 5), rr = r & 15, cc = c & 31, ob = rr * 64 + cc * 2; return st * 1024 + (ob ^ (((ob >> 9) & 1) << 5)); }
__host__ __device__ __forceinline__ void stage_rc(int b, int& R, int& C) { const int st = b / 1024, sb = b % 1024, swz = sb ^ (((sb >> 9) & 1) << 5); R = (st >> 1) * 16 + swz / 64; C = (st & 1) * 32 + (swz % 64) / 2; }
__host__ __device__ __forceinline__ int perm32(int rho) { const int n = rho >> 4, i = rho & 15; return 8 * (i >> 2) + 4 * n + (i & 3); }

struct Unit { int pm, pn; const char* A; const char* B; const int* rows; int nvalid; int aux; int rowbase; int half; };

__device__ __forceinline__ unsigned cvt_pk_bf16(float lo, float hi) { unsigned r; asm volatile("v_cvt_pk_bf16_f32 %0, %1, %2" : "=v"(r) : "v"(lo), "v"(hi)); return r; }

constexpr int GIDX_OFF = 152 * 1024 + 1024 + 2048;
template <class Epi, class Sched, bool GATHER, bool FP8 = false>
__device__ __forceinline__ void gemm_phase(LAS unsigned char* lds, const int K, const int lda, const int ldb, const Sched& S, const Epi& E) {
    int tid_ = threadIdx.x; asm volatile("" : "+v"(tid_));
    const int tid = tid_, wid = __builtin_amdgcn_readfirstlane(tid >> 6), lane = tid & 63, wr = wid >> 2, wc = wid & 3, fr = lane & 15, fq = lane >> 4;
    const int nt = K / BK;
    unsigned voffA[2], voffB[2]; int RA[2], CA[2];
#pragma unroll
    for (int i = 0; i < 2; ++i) { int R, C; stage_rc(tid * 16 + i * 8192, R, C); const int Rb = Epi::PERM ? ((R & ~31) + perm32(R & 31)) : R;
        RA[i] = R; CA[i] = C; voffA[i] = (unsigned)(R * lda + C) * 2u; voffB[i] = (unsigned)(Rb * ldb + C) * 2u; }
    unsigned gA[2][2], gN[2][2];
    const size_t kstep = (size_t)(BK * 2);
    const size_t hstepA = GATHER ? 0 : (size_t)HALF * lda * 2, hstepB = (size_t)HALF * ldb * 2;
    const unsigned ldsw = (unsigned)wid * 1024u;
    const int aoff = lds_byte(wr * 64 + fr, fq * 8), boff = lds_byte(wc * 32 + fr, fq * 8);
#define PG8_SA(b, h) (((b) * 2 + (h)) * HTB)
#define PG8_SB(b, h) ((4 + (b) * 2 + (h)) * HTB)
#define PG8_STAGE_B(bufoff, gbase) do { _Pragma("unroll") for (int _i = 0; _i < 2; ++_i) \
        __builtin_amdgcn_global_load_lds((const unsigned*)((const char*)(gbase) + voffB[_i]), (LAS unsigned*)(lds + (bufoff) + ldsw + _i * 8192), 16, 0, 0); } while (0)
#define PG8_STAGE_A(bufoff, gbase, h) do { _Pragma("unroll") for (int _i = 0; _i < 2; ++_i) \
        __builtin_amdgcn_global_load_lds((const unsigned*)((const char*)(gbase) + (GATHER ? gA[h][_i] : voffA[_i]) + (h) * hstepA), (LAS unsigned*)(lds + (bufoff) + ldsw + _i * 8192), 16, 0, 0); } while (0)
#define PG8_CAT(x0, x1) __builtin_shufflevector(__builtin_bit_cast(v4i_t, (x0)), __builtin_bit_cast(v4i_t, (x1)), 0, 1, 2, 3, 4, 5, 6, 7)
#define PG8_LDA(dst, b, h) do { _Pragma("unroll") for (int m = 0; m < 4; ++m) { if constexpr (FP8) dst##8[m] = PG8_CAT(*(const LAS bf16x8*)(lds + PG8_SA(b, h) + aoff + m * 2048), *(const LAS bf16x8*)(lds + PG8_SA(b, h) + aoff + m * 2048 + 1024)); \
        else { _Pragma("unroll") for (int k = 0; k < 2; ++k) dst[m][k] = *(const LAS bf16x8*)(lds + PG8_SA(b, h) + aoff + m * 2048 + k * 1024); } } } while (0)
#define PG8_LDB(dst, b, h) do { _Pragma("unroll") for (int n = 0; n < 2; ++n) { if constexpr (FP8) dst##8[n] = PG8_CAT(*(const LAS bf16x8*)(lds + PG8_SB(b, h) + boff + n * 2048), *(const LAS bf16x8*)(lds + PG8_SB(b, h) + boff + n * 2048 + 1024)); \
        else { _Pragma("unroll") for (int k = 0; k < 2; ++k) dst[n][k] = *(const LAS bf16x8*)(lds + PG8_SB(b, h) + boff + n * 2048 + k * 1024); } } } while (0)
#ifdef F8_NOSCALE
#define PG8_F8MFMA(c, a, b) asm volatile("v_mfma_f32_16x16x128_f8f6f4 %0, %1, %2, %0" : "+v"(c) : "v"(a), "v"(b))
#else
#define PG8_F8MFMA(c, a, b) asm volatile("v_mfma_scale_f32_16x16x128_f8f6f4 %0, %1, %2, %0, %3, %3 op_sel_hi:[0,0,0]" : "+v"(c) : "v"(a), "v"(b), "v"(f8scale))
#endif
#define PG8_MMA(ai, bj, At, Bt) do { __builtin_amdgcn_s_setprio(1); \
        if constexpr (FP8) { _Pragma("unroll") for (int m = 0; m < 4; ++m) _Pragma("unroll") for (int n = 0; n < 2; ++n) \
            PG8_F8MFMA(acc[ai][bj][m][n], Bt##8[n], At##8[m]); } \
        else { _Pragma("unroll") for (int m = 0; m < 4; ++m) _Pragma("unroll") for (int n = 0; n < 2; ++n) _Pragma("unroll") for (int k = 0; k < 2; ++k) \
            acc[ai][bj][m][n] = __builtin_amdgcn_mfma_f32_16x16x32_bf16(Bt[n][k], At[m][k], acc[ai][bj][m][n], 0, 0, 0); } \
        __builtin_amdgcn_s_setprio(0); } while (0)
#define PG8_WAIT_V(n) asm volatile("s_waitcnt vmcnt(" #n ")" ::: "memory")
#define PG8_WAIT_L(n) asm volatile("s_waitcnt lgkmcnt(" #n ")" ::: "memory")
#define PG8_BAR __builtin_amdgcn_s_barrier()
#define PG8_SCHED __builtin_amdgcn_sched_barrier(0)
#define PG8_GLOAD(dst, u) do { _Pragma("unroll") for (int _h = 0; _h < 2; ++_h) _Pragma("unroll") for (int _i = 0; _i < 2; ++_i) { const int _r = _h * HALF + RA[_i]; \
        const int _rc = _r < (u).nvalid ? _r : (u).nvalid - 1; const int _tl = (u).rows[_rc]; const int _t = (_r < (u).nvalid) ? _tl : 0; dst[_h][_i] = (unsigned)(_t * lda + CA[_i]) * 2u; } } while (0)
    Unit cur, nxt; int ui = 0;
    if (!S.next(0, cur)) return;
    f32x4 acc[2][2][4][2];
#pragma unroll
    for (int a = 0; a < 2; ++a)
#pragma unroll
        for (int b = 0; b < 2; ++b)
#pragma unroll
            for (int m = 0; m < 4; ++m)
#pragma unroll
                for (int n = 0; n < 2; ++n) acc[a][b][m][n] = (f32x4){0.f, 0.f, 0.f, 0.f};
    const unsigned f8scale = 0x7f7f7f7fu;
    bf16x8 At[4][2], B0[2][2], B1[2][2]; v8i_t At8[4], B08[2], B18[2];
    const char* cA = cur.A; const char* cB = cur.B;
    if constexpr (GATHER) { PG8_GLOAD(gA, cur); PG8_WAIT_V(0); }
    PG8_STAGE_B(PG8_SB(0, 0), cB); PG8_STAGE_B(PG8_SB(0, 1), cB + hstepB); PG8_STAGE_A(PG8_SA(0, 0), cA, 0); PG8_STAGE_A(PG8_SA(0, 1), cA, 1);
    if (wr == 1) PG8_BAR;
    PG8_WAIT_V(2); PG8_BAR;
    PG8_STAGE_B(PG8_SB(1, 0), cB + kstep); PG8_STAGE_A(PG8_SA(1, 0), cA + kstep, 0); PG8_STAGE_B(PG8_SB(1, 1), cB + hstepB + kstep);
    PG8_WAIT_V(6); PG8_BAR;
    for (;;) {
        const bool has_next = S.next(ui + 1, nxt); const bool halfu = Sched::RAGGED && cur.half != 0;
        const char* nA = has_next ? nxt.A : cA; const char* nB = has_next ? nxt.B : cB;
#ifdef GATHER_LDS_IDX
        if constexpr (GATHER) { if (has_next) { if (wid == 0) __builtin_amdgcn_global_load_lds((const unsigned*)(nxt.rows) + lane * 4, (LAS unsigned*)(lds + GIDX_OFF), 16, 0, 0); } else {
#else
        if constexpr (GATHER) { if (has_next) { PG8_GLOAD(gN, nxt); } else {
#endif
#pragma unroll
            for (int h = 0; h < 2; ++h)
#pragma unroll
                for (int i = 0; i < 2; ++i) gN[h][i] = gA[h][i]; } }
#pragma unroll 1
        for (int t = 0; t < nt; t += 2) {
            const bool last = (t == nt - 2);
            const char* a1 = cA + (size_t)(t + 1) * kstep;
            const char* a2 = last ? nA : cA + (size_t)(t + 2) * kstep; const char* b2 = last ? nB : cB + (size_t)(t + 2) * kstep;
            const char* a3 = a2 + kstep; const char* b3 = b2 + kstep;
            PG8_LDB(B0, 0, 0); PG8_LDB(B1, 0, 1); PG8_SCHED; PG8_LDA(At, 0, 0); PG8_STAGE_A(PG8_SA(1, 1), a1, 1);
            if constexpr (GATHER) { if (last) {
#pragma unroll
                for (int h = 0; h < 2; ++h)
#pragma unroll
                    for (int i = 0; i < 2; ++i) gA[h][i] = gN[h][i]; } }
            PG8_WAIT_V(8); PG8_WAIT_L(0); PG8_BAR; PG8_MMA(0, 0, At, B0); PG8_MMA(0, 1, At, B1); PG8_BAR; PG8_SCHED;
            if (!halfu) PG8_LDA(At, 0, 1); PG8_STAGE_B(PG8_SB(0, 0), b2); PG8_STAGE_B(PG8_SB(0, 1), b2 + hstepB); PG8_STAGE_A(PG8_SA(0, 0), a2, 0);
            PG8_WAIT_V(8); PG8_WAIT_L(0); PG8_BAR; if (!halfu) { PG8_MMA(1, 0, At, B0); PG8_MMA(1, 1, At, B1); } PG8_BAR; PG8_SCHED;
            PG8_LDB(B0, 1, 0); PG8_LDB(B1, 1, 1); PG8_SCHED; PG8_LDA(At, 1, 0); PG8_STAGE_A(PG8_SA(0, 1), a2, 1);
            PG8_WAIT_V(8); PG8_WAIT_L(0); PG8_BAR; PG8_MMA(0, 0, At, B0); PG8_MMA(0, 1, At, B1); PG8_BAR; PG8_SCHED;
            if (!halfu) PG8_LDA(At, 1, 1); PG8_STAGE_B(PG8_SB(1, 0), b3); PG8_STAGE_B(PG8_SB(1, 1), b3 + hstepB); PG8_STAGE_A(PG8_SA(1, 0), a3, 0);
            PG8_WAIT_V(8); PG8_WAIT_L(0); PG8_BAR; if (!halfu) { PG8_MMA(1, 0, At, B0); PG8_MMA(1, 1, At, B1); } PG8_BAR; PG8_SCHED;
#ifdef GATHER_LDS_IDX
            if constexpr (GATHER) { if (t == 0 && has_next) {
#pragma unroll
                for (int _h = 0; _h < 2; ++_h)
#pragma unroll
                    for (int _i = 0; _i < 2; ++_i) { const int _r = _h * HALF + RA[_i]; const int _tl = *(const LAS int*)(lds + GIDX_OFF + _r * 4); const int _t = (_r < nxt.nvalid) ? _tl : 0; gN[_h][_i] = (unsigned)(_t * lda + CA[_i]) * 2u; } } }
#endif
        }
        if (wr == 0) PG8_BAR;
        if constexpr (FP8) asm volatile("s_nop 15\n\ts_nop 15\n\ts_nop 15" ::: "memory");
        E(acc, cur, wr, wc, fr, fq);
        if (!has_next) break;
#pragma unroll
        for (int a = 0; a < 2; ++a)
#pragma unroll
            for (int b = 0; b < 2; ++b)
#pragma unroll
                for (int m = 0; m < 4; ++m)
#pragma unroll
                    for (int n = 0; n < 2; ++n) acc[a][b][m][n] = (f32x4){0.f, 0.f, 0.f, 0.f};
        cur = nxt; cA = nA; cB = nB; ++ui;
        if (wr == 1) PG8_BAR;
    }
    PG8_WAIT_V(0);
    PG8_BAR;
#undef PG8_SA
#undef PG8_SB
#undef PG8_STAGE_A
#undef PG8_STAGE_B
#undef PG8_LDA
#undef PG8_LDB
#undef PG8_MMA
#undef PG8_CAT
#undef PG8_WAIT_V
#undef PG8_WAIT_L
#undef PG8_BAR
#undef PG8_SCHED
#undef PG8_GLOAD
}
}

constexpr int NB = 4, SEQ = 4096, D = 2048, DEPTH = 2;
constexpr int T = NB * SEQ;
constexpr int NH = 8, HD = 128, DNW = 1024, CH = 64, NCH = SEQ / CH;
constexpr int PW = 1024, PG_DIM = 256;
constexpr int IN_COLS = 5136, NPROJ = 5120;
constexpr int NE = 16, DE = 1024, PLE = 256;
constexpr float ALPHA = 1.4142135623730951f;
constexpr float LN_EPS = 1e-5f, RMS_EPS = 1e-6f;
constexpr int LCAP = T;
constexpr int MAXTILES = 2 * T / 256 + NE;

constexpr size_t MiB = 1u << 20;
constexpr size_t WS_CTL = 0, CTL_ZERO_BYTES = 64 * 1024;
constexpr size_t WS_LIST = 2 * MiB;
constexpr size_t WS_TOKSLOT = 3 * MiB, WS_GATEW = WS_TOKSLOT + 128 * 1024, WS_STATS = WS_GATEW + 128 * 1024, WS_CD = WS_STATS + 128 * 1024, WS_WBA = WS_CD + 128 * 1024;
constexpr size_t WS_WIN = 4 * MiB, WS_WOUT = 44 * MiB, WS_WPG = 60 * MiB, WS_WPP = 76 * MiB, WS_WPOOL = 78 * MiB, WS_WGU = 80 * MiB, WS_WD = 336 * MiB, WS_PB16 = 464 * MiB;
constexpr size_t WS_XB = 480 * MiB, WS_R1 = 544 * MiB, WS_R2 = 704 * MiB, WS_R4 = 848 * MiB, WS_R5 = 944 * MiB, WS_END = 1008 * MiB;
constexpr size_t WS_PROJ = WS_R1, WS_HID = WS_R1;
constexpr size_t WS_Y = WS_R2;
constexpr size_t WS_POOLD = WS_R4, WS_PP = WS_R4 + 32 * MiB, WS_X1B = WS_R2;
constexpr size_t WS_MIXIN = WS_R5, WS_X2B = WS_R5;
constexpr size_t WS_WIN8 = WS_WGU + 64 * MiB;
constexpr size_t WS_XBF8 = WS_R2;
constexpr size_t WS_X2F8 = WS_R1 + 96 * MiB;
static_assert((size_t)MAXTILES * 256 * 2048 * 2 <= 144 * MiB && (size_t)MAXTILES * 256 * 1024 * 2 <= 160 * MiB, "MoE row buffers");
constexpr int CW_TMO = 0, CW_CODE = 1, CW_CNT = 64  , CW_CONV = 512  , CW_BAR = 4096;

constexpr int RING_OFF = 0, RING_BYTES = 131072;
constexpr int LDSCTL_OFF = 152 * 1024, MISC_OFF = LDSCTL_OFF + 320;
constexpr int AUX_OFF = LDSCTL_OFF + 1024;
constexpr int LDS_BYTES = 163840;
constexpr int NWAVES = 8;

#define RLX_AGENT __ATOMIC_RELAXED, __HIP_MEMORY_SCOPE_AGENT
#define LDS_WAIT() asm volatile("s_waitcnt lgkmcnt(0)" ::: "memory")
#define VM_WAIT() asm volatile("s_waitcnt vmcnt(0)" ::: "memory")
__device__ __forceinline__ unsigned f2bf(float f) { unsigned u = __builtin_bit_cast(unsigned, f); return (u + 0x7fffu + ((u >> 16) & 1u)) >> 16; }
__device__ __forceinline__ unsigned pk2(float lo, float hi) { return f2bf(lo) | (f2bf(hi) << 16); }
typedef __bf16 bf2_t __attribute__((ext_vector_type(2)));
__device__ __forceinline__ unsigned pkbf(float lo, float hi) { const f32x2 v = {lo, hi}; return __builtin_bit_cast(unsigned, __builtin_convertvector(v, bf2_t)); }
constexpr float F8_XS = 16.0f, F8_WS = 256.0f, F8_INV = 1.0f / 4096.0f;
__device__ __forceinline__ float f8clamp(float x) { return fminf(fmaxf(x, -448.0f), 448.0f); }
__device__ __forceinline__ unsigned pk4_fp8(float a, float b, float c, float d) { unsigned w = 0u; w = (unsigned)__builtin_amdgcn_cvt_pk_fp8_f32(f8clamp(a), f8clamp(b), (int)w, false); w = (unsigned)__builtin_amdgcn_cvt_pk_fp8_f32(f8clamp(c), f8clamp(d), (int)w, true); return w; }
__device__ __forceinline__ float bf2f(unsigned short b) { return __builtin_bit_cast(float, ((unsigned)b) << 16); }
__device__ __forceinline__ float bflo(unsigned w) { return __builtin_bit_cast(float, w << 16); }
__device__ __forceinline__ float bfhi(unsigned w) { return __builtin_bit_cast(float, w & 0xffff0000u); }
__device__ __forceinline__ float sigmoidf_(float x) { return __builtin_amdgcn_rcpf(1.0f + __expf(-x)); }
template <int CTRL> __device__ __forceinline__ float dpp_(float x) { return __builtin_bit_cast(float, __builtin_amdgcn_mov_dpp(__builtin_bit_cast(int, x), CTRL, 0xf, 0xf, true)); }
constexpr int DPP_XOR1 = 0xB1, DPP_XOR2 = 0x4E, DPP_HMIRROR = 0x141, DPP_XOR8 = 0x128;
__device__ __forceinline__ float xrow16_sum(float x) {
    float p = x, q = x; asm volatile("v_nop\n\tv_nop\n\tv_permlane16_swap_b32 %0, %1" : "+v"(p), "+v"(q));
    x = p + q;
    float r = x, s = x; asm volatile("v_nop\n\tv_nop\n\tv_permlane32_swap_b32 %0, %1" : "+v"(r), "+v"(s));
    return r + s;
}
#ifdef OLD_SHUFFLES
__device__ __forceinline__ float row8_sum(float v) { v += __shfl_xor(v, 1); v += __shfl_xor(v, 2); v += __shfl_xor(v, 4); return v; }
__device__ __forceinline__ float wave_sum(float v) {
#pragma unroll
    for (int o = 1; o < 64; o <<= 1) v += __shfl_xor(v, o);
    return v; }
#else
__device__ __forceinline__ float row8_sum(float v) { v += dpp_<DPP_XOR1>(v); v += dpp_<DPP_XOR2>(v); v += dpp_<DPP_HMIRROR>(v); return v; }
__device__ __forceinline__ float wave_sum(float v) { v = row8_sum(v); v += dpp_<DPP_XOR8>(v); return xrow16_sum(v); }
#endif
#define XB_TMO      128
#define XB_XCNT(j)  (256  + 64 * (j))
#define XB_XSUB(j)  (1280 + 64 * (j))
#define XB_XGEN(j)  (2304 + 64 * (j))
#define XB_TOP      3328
#define XB_TOPGEN   3392
#define XCD_BAR_WORDS 3456
#define XB_SPIN_CAP (1u << 18)

__device__ __forceinline__ unsigned xb_ld(unsigned* p)              { return __hip_atomic_load(p, __ATOMIC_RELAXED, __HIP_MEMORY_SCOPE_AGENT); }
__device__ __forceinline__ unsigned xb_add(unsigned* p, unsigned v) { return __hip_atomic_fetch_add(p, v, __ATOMIC_RELAXED, __HIP_MEMORY_SCOPE_AGENT); }
__device__ __forceinline__ unsigned xb_xcc_id() { return (unsigned)__builtin_amdgcn_s_getreg((3 << 11) | 20) & 0xFu; }
#define XB_SPIN(cond, bar) do { unsigned _sp = 0; while (cond) { __builtin_amdgcn_s_sleep(1); \
    if ((++_sp & 255u) == 0u) { if (xb_ld(&(bar)[XB_TMO])) break; if (_sp > XB_SPIN_CAP) { atomicAdd(&(bar)[XB_TMO], 1u); break; } } } } while (0)

struct XcdBarrier {
    unsigned* bar; unsigned x;
    volatile LAS unsigned* st;
};

__device__ __forceinline__ XcdBarrier xcd_barrier_post(unsigned* bar, volatile LAS unsigned* st) {
    XcdBarrier b; b.bar = bar; b.x = xb_xcc_id(); b.st = st;
    if (threadIdx.x == 0) (void)xb_add(&bar[XB_XCNT(b.x)], 1u);
    return b;
}
__device__ __forceinline__ void xcd_barrier_complete(unsigned* bar, unsigned x, unsigned& nloc, unsigned& nx) {
    const unsigned G = gridDim.x * gridDim.y * gridDim.z;
    unsigned sum, cnt, mine, sp = 0u;
    for (;;) {
        sum = 0u; cnt = 0u; mine = 0u;
#pragma unroll
        for (unsigned j = 0; j < 16; ++j) { const unsigned c = xb_ld(&bar[XB_XCNT(j)]); sum += c; cnt += (c > 0u) ? 1u : 0u; mine = (j == x) ? c : mine; }
        if (sum == G) break;
        __builtin_amdgcn_s_sleep(1);
        if ((++sp & 255u) == 0u) { if (xb_ld(&bar[XB_TMO])) break; if (sp > XB_SPIN_CAP) { atomicAdd(&bar[XB_TMO], 1u); break; } }
    }
    nloc = mine > 0u ? mine : 1u; nx = cnt > 0u ? cnt : 1u;
}

__device__ __forceinline__ void xcd_barrier(const XcdBarrier& b) {
    asm volatile("s_waitcnt vmcnt(0)" ::: "memory");
    __syncthreads();
    if (threadIdx.x == 0) {
        unsigned* bar = b.bar;
        __builtin_amdgcn_s_waitcnt(0);
        unsigned nloc = b.st[0], nx = b.st[1];
        if (nloc == 0u) { xcd_barrier_complete(bar, b.x, nloc, nx); b.st[0] = nloc; b.st[1] = nx; }
        const unsigned old = xb_add(&bar[XB_XSUB(b.x)], 1u);
        const unsigned gen = old / nloc;
        if (old + 1u == (gen + 1u) * nloc) {
            __builtin_amdgcn_fence(__ATOMIC_RELEASE, "agent");
            asm volatile("s_waitcnt vmcnt(0)" ::: "memory");
            const unsigned og = xb_add(&bar[XB_TOP], 1u);
            const unsigned tg = og / nx;
            if (og + 1u == (tg + 1u) * nx) xb_add(&bar[XB_TOPGEN], 1u);
            else XB_SPIN(xb_ld(&bar[XB_TOPGEN]) == tg, bar);
            __builtin_amdgcn_fence(__ATOMIC_ACQUIRE, "agent");
            xb_add(&bar[XB_XGEN(b.x)], 1u);
            asm volatile("s_waitcnt vmcnt(0)" ::: "memory");
        } else {
            XB_SPIN(xb_ld(&bar[XB_XGEN(b.x)]) == gen, bar);
            __builtin_amdgcn_fence(__ATOMIC_ACQUIRE, "agent");
            asm volatile("s_waitcnt vmcnt(0)" ::: "memory");
        }
    }
    __syncthreads();
}

struct Args { const float* in[21]; float* out; unsigned char* ws; int ph_lo, ph_hi, li, pad; };
enum { I_X = 0, I_P, I_WIN, I_CONVW, I_ALOG, I_DTB, I_NORMW, I_POOLW, I_POOLS, I_WOUT, I_LN1G, I_LN1B, I_WR, I_BR, I_WEG, I_WEU, I_WED, I_LN2G, I_LN2B, I_WPP, I_WPG };
struct Frame {
    LAS unsigned char* lds;
    volatile LAS unsigned* MISC;
    gu32* ctl;
    int tid, lane, wave, vcu, G;
};

#ifndef FP8_LAST
#define FP8_LAST 1
#endif
#ifndef FP8_PG
#define FP8_PG 0
#endif
#ifndef FP8_ALL
#define FP8_ALL 0
#endif
#ifndef FP8_PD
#define FP8_PD 0
#endif
#define Y_F8S 64.0f
#ifndef FP8_PD_ALL
#define FP8_PD_ALL 0
#endif
#define FP8_PDL(l) (FP8_PD && (FP8_PD_ALL || (l) == DEPTH - 1))
#ifndef FP8_PI0
#define FP8_PI0 0
#endif
#ifndef FP8_PA
#define FP8_PA 0
#endif
#ifndef FP8_PA_ALL
#define FP8_PA_ALL 0
#endif
#define FP8_PAL(l) (FP8_PA && (FP8_PA_ALL || (l) == DEPTH - 1))
#ifndef FP8_PA_LO_E
#define FP8_PA_LO_E 0
#endif
#ifndef FP8_PA_HI_E
#define FP8_PA_HI_E 20
#endif
#ifndef FP8_PA_HI
#define FP8_PA_HI 20
#endif
#define FP8_PA_LO(l) ((l) == DEPTH - 1 ? FP8_PA_PN0 : FP8_PA_LO_E)
#define FP8_PA_HIF(l) ((l) == DEPTH - 1 ? FP8_PA_HI : FP8_PA_HI_E)
#define FP8_PA_TILE(l, row) (FP8_PAL(l) && (row) >= 256 * FP8_PA_LO(l) && (row) < 256 * FP8_PA_HIF(l))
#ifndef FP8_PA_PN0
#define FP8_PA_PN0 0
#endif
#define FP8_LAYER(l) (FP8_LAST && (FP8_ALL || (l) == DEPTH - 1))
static_assert(!FP8_PA || (FP8_LAST && FP8_ALL), "WS_WIN8 sits in the half of layer 0's expert-weight region that the fp8 experts leave free");
#ifndef FP8_PI
#define FP8_PI 0
#endif
#define PHASE_FRAME(F0) Frame F = F0; { int t_ = threadIdx.x; asm volatile("" : "+v"(t_)); F.tid = t_; F.lane = t_ & 63; }
#define OPQ_S(p) asm volatile("" : "+s"(p))
#define OPQ_G(T, expr) ({ GAS T* g_ = (GAS T*)(expr); asm volatile("" : "+s"(g_)); (T*)g_; })
struct SchedDense {
    static constexpr bool RAGGED = false;
    int nM, nN, nwg, G, c, pn0; const char* A; const char* B; size_t astep, bstep;
    __device__ __forceinline__ void init(int M, int N, int G_, int c_, const void* A_, int lda, const void* B_, int ldb, int pn0_ = 0) { nM = M / 256; nN = N / 256; nwg = nM * nN; G = G_; c = c_; pn0 = pn0_;
        A = (const char*)A_; B = (const char*)B_; astep = (size_t)256 * lda * 2; bstep = (size_t)256 * ldb * 2; }
    __device__ __forceinline__ bool next(int i, pg8::Unit& u) const {
        const long L = (long)i * G + c; if (L >= nwg) return false;
        int wgid = (int)L; { const int q = nwg / 8, r = nwg % 8, xcd = wgid % 8, off = wgid / 8; wgid = (xcd < r ? xcd * (q + 1) : r * (q + 1) + (xcd - r) * q) + off; }
        const int nig = 8 * nN, gid = wgid / nig, fm = gid * 8, gsz = (nM - fm) < 8 ? (nM - fm) : 8;
        u.pm = fm + ((wgid % nig) % gsz); u.pn = pn0 + (wgid % nig) / gsz;
        u.A = A + (size_t)u.pm * astep; u.B = B + (size_t)u.pn * bstep; u.rows = nullptr; u.nvalid = 256; u.aux = 0; u.rowbase = u.pm * 256; u.half = 0; return true;
    }
};
struct SchedPool {
    static constexpr bool RAGGED = false;
    int G, c; const char* A; const char* B;
    __device__ __forceinline__ bool next(int i, pg8::Unit& u) const {
        const int L = i * G + c; if (L >= 256) return false;
        u.pm = L >> 2; u.pn = L & 3; u.A = A + ((size_t)u.pm * 256 * PW + u.pn * 256) * 2; u.B = B + (size_t)u.pn * 65536 * 2; u.rows = nullptr; u.nvalid = 256; u.aux = 0; u.rowbase = u.pm * 256; u.half = 0; return true;
    }
};
struct SchedMoe {
    static constexpr bool RAGGED = true;
    int G, c, mode; const LAS int* tab; const char* A; const char* B; const int* list; int esz;
    __device__ __forceinline__ bool next(int i, pg8::Unit& u) const {
#ifdef MOE_SCHED_FAST
        const int ln = (int)__builtin_amdgcn_mbcnt_hi(~0u, __builtin_amdgcn_mbcnt_lo(~0u, 0u)), lk = ln < 16 ? ln : 16;
        const int vB = tab[lk], vC = tab[32 + (lk & 15)], vF = tab[48 + lk], vH = tab[80 + lk];
        const int L = i * G + c, nf = __builtin_amdgcn_readlane(vF, 16), nh = __builtin_amdgcn_readlane(vH, 16);
        if (L >= 8 * (nf + nh)) return false;
        const bool half = L >= 8 * nf; int t, pn;
        { const int Lr = half ? L - 8 * nf : L, nt_ = half ? nh : nf; t = Lr >> 3; pn = Lr & 7;
#ifdef MOE_XCD_MAP
          if ((G & 7) == 0 && (t | 1) < nt_) { const int j = Lr & 15, x = j & 7, r = j >> 3; t = (Lr >> 4) * 2 + (x >> 2); pn = (x & 3) * 2 + r; }
#endif
#ifdef MOE_XCD_MAP2
          if (G == 256 && ((Lr >> 8) * 32 + 31) < nt_) { const int j = Lr & 255, x = j & 7, r = j >> 3; t = 32 * (Lr >> 8) + 8 * (x >> 1) + (r & 7); pn = 4 * (x & 1) + (r >> 3); }
#endif
        }
        const int vP = half ? vH : vF;
        const int e = __builtin_popcountll(__builtin_amdgcn_ballot_w64(ln < 16 && vP <= t)) - 1;
        const int tl = t - __builtin_amdgcn_readlane(vP, e), cn = __builtin_amdgcn_readlane(vC, e), blk = __builtin_amdgcn_readlane(vB, e);
#else
        const int L = i * G + c, nf = __builtin_amdgcn_readfirstlane(tab[64]), nh = __builtin_amdgcn_readfirstlane(tab[96]);
        if (L >= 8 * (nf + nh)) return false;
        const bool half = L >= 8 * nf; const int t = (half ? L - 8 * nf : L) >> 3, pn = L & 7, pbase = half ? 80 : 48;
        int e = 0;
#pragma unroll
        for (int k = 1; k < 16; ++k) { const int ts = __builtin_amdgcn_readfirstlane(tab[pbase + k]); if (t >= ts) e = k; }
        const int tl = t - __builtin_amdgcn_readfirstlane(tab[pbase + e]), cn = __builtin_amdgcn_readfirstlane(tab[32 + e]), blk = __builtin_amdgcn_readfirstlane(tab[e]);
#endif
        const int p0 = half ? ((cn >> 8) << 8) + 128 * tl : 256 * tl;
        u.pm = 0; u.pn = pn; u.aux = e; u.half = half ? 1 : 0; u.rowbase = blk * 128 + p0;
        const int nv = cn - p0; u.nvalid = nv < (half ? 128 : 256) ? nv : (half ? 128 : 256);
        if (mode == 0) { u.A = A; u.rows = list + (size_t)e * LCAP + p0; u.B = B + ((size_t)e * 2048 + pn * 256) * 2048 * esz; }
        else { u.A = A + (size_t)u.rowbase * DE * esz; u.rows = nullptr; u.B = B + ((size_t)e * 2048 + pn * 256) * DE * esz; }
        return true;
    }
};

using pg8::cvt_pk_bf16;
struct EpiBf16 {
    static constexpr bool PERM = true; bf16* O; int ldc; float scale = 1.0f;
    __device__ __forceinline__ void operator()(const f32x4 (&acc)[2][2][4][2], const pg8::Unit& u, int wr, int wc, int fr, int fq) const {
        const int row0 = u.rowbase + wr * 64 + fr, col0 = u.pn * 256 + wc * 32 + 8 * fq;
#pragma unroll
        for (int ai = 0; ai < 2; ++ai) if (ai == 0 || !u.half)
#pragma unroll
            for (int m = 0; m < 4; ++m) { bf16* rowp = O + (size_t)(row0 + ai * 128 + m * 16) * ldc + col0;
#pragma unroll
                for (int bj = 0; bj < 2; ++bj) { const f32x4 v0 = acc[ai][bj][m][0] * scale, v1 = acc[ai][bj][m][1] * scale;
                    v4u w; w.x = cvt_pk_bf16(v0[0], v0[1]); w.y = cvt_pk_bf16(v0[2], v0[3]); w.z = cvt_pk_bf16(v1[0], v1[1]); w.w = cvt_pk_bf16(v1[2], v1[3]);
                    *(v4u*)(rowp + bj * 128) = w; } }
    }
};
struct EpiF8 {
    static constexpr bool PERM = true; unsigned char* O; int ldc; float scale = 1.0f;
    __device__ __forceinline__ void operator()(const f32x4 (&acc)[2][2][4][2], const pg8::Unit& u, int wr, int wc, int fr, int fq) const {
        const int row0 = u.rowbase + wr * 64 + fr, col0 = u.pn * 256 + wc * 32 + 8 * fq;
#pragma unroll
        for (int ai = 0; ai < 2; ++ai) if (ai == 0 || !u.half)
#pragma unroll
            for (int m = 0; m < 4; ++m) { unsigned char* rowp = O + (size_t)(row0 + ai * 128 + m * 16) * ldc + col0;
#pragma unroll
                for (int bj = 0; bj < 2; ++bj) { const f32x4 v0 = acc[ai][bj][m][0] * scale, v1 = acc[ai][bj][m][1] * scale;
                    v2u w; w.x = pk4_fp8(v0[0], v0[1], v0[2], v0[3]); w.y = pk4_fp8(v1[0], v1[1], v1[2], v1[3]);
                    *(v2u*)(rowp + bj * 128) = w; } }
    }
};
struct EpiPool {
    static constexpr bool PERM = true; bf16* O; const float* scale; int f8 = 0;
    __device__ __forceinline__ void operator()(const f32x4 (&acc)[2][2][4][2], const pg8::Unit& u, int wr, int wc, int fr, int fq) const {
        const int row0 = u.rowbase + wr * 64 + fr, cg = u.pn * 256 + wc * 32 + 8 * fq;
        f32x4 sv[2][2];
#pragma unroll
        for (int bj = 0; bj < 2; ++bj) { sv[bj][0] = *(const f32x4*)(scale + cg + bj * 128); sv[bj][1] = *(const f32x4*)(scale + cg + bj * 128 + 4); }
#pragma unroll
        for (int ai = 0; ai < 2; ++ai)
#pragma unroll
            for (int m = 0; m < 4; ++m) { bf16* rowp = O + (size_t)(row0 + ai * 128 + m * 16) * D + DNW + cg;
#pragma unroll
                for (int bj = 0; bj < 2; ++bj) { const f32x4 v0 = acc[ai][bj][m][0] * sv[bj][0], v1 = acc[ai][bj][m][1] * sv[bj][1];
                    if (f8) { v2u w8; w8.x = pk4_fp8(v0[0] * F8_XS, v0[1] * F8_XS, v0[2] * F8_XS, v0[3] * F8_XS); w8.y = pk4_fp8(v1[0] * F8_XS, v1[1] * F8_XS, v1[2] * F8_XS, v1[3] * F8_XS);
                        *(v2u*)((unsigned char*)O + (size_t)(row0 + ai * 128 + m * 16) * D + DNW + cg + bj * 128) = w8; }
                    else { v4u w; w.x = cvt_pk_bf16(v0[0], v0[1]); w.y = cvt_pk_bf16(v0[2], v0[3]); w.z = cvt_pk_bf16(v1[0], v1[1]); w.w = cvt_pk_bf16(v1[2], v1[3]);
                    *(v4u*)(rowp + bj * 128) = w; } } }
    }
};
struct EpiRes {
    static constexpr bool PERM = true; const bf16* XB; bf16* PRE; float ascale = 1.0f;
    __device__ __forceinline__ void operator()(const f32x4 (&acc)[2][2][4][2], const pg8::Unit& u, int wr, int wc, int fr, int fq) const {
        const int row0 = u.rowbase + wr * 64 + fr, col0 = u.pn * 256 + wc * 32 + 8 * fq;
#pragma unroll
        for (int ai = 0; ai < 2; ++ai) { v4u xq[4][2];
#pragma unroll
            for (int m = 0; m < 4; ++m)
#pragma unroll
                for (int bj = 0; bj < 2; ++bj) xq[m][bj] = *(const v4u*)(XB + (size_t)(row0 + ai * 128 + m * 16) * D + col0 + bj * 128);
            asm volatile("" : "+v"(xq[0][0]), "+v"(xq[0][1]), "+v"(xq[1][0]), "+v"(xq[1][1]), "+v"(xq[2][0]), "+v"(xq[2][1]), "+v"(xq[3][0]), "+v"(xq[3][1]));
#pragma unroll
            for (int m = 0; m < 4; ++m)
#pragma unroll
                for (int bj = 0; bj < 2; ++bj) { const size_t off = (size_t)(row0 + ai * 128 + m * 16) * D + col0 + bj * 128; const v4u x = xq[m][bj]; const f32x4 a0 = acc[ai][bj][m][0] * ascale, a1 = acc[ai][bj][m][1] * ascale;
                    v4u w; w.x = cvt_pk_bf16(bflo(x.x) * ALPHA + a0[0], bfhi(x.x) * ALPHA + a0[1]); w.y = cvt_pk_bf16(bflo(x.y) * ALPHA + a0[2], bfhi(x.y) * ALPHA + a0[3]);
                    w.z = cvt_pk_bf16(bflo(x.z) * ALPHA + a1[0], bfhi(x.z) * ALPHA + a1[1]); w.w = cvt_pk_bf16(bflo(x.w) * ALPHA + a1[2], bfhi(x.w) * ALPHA + a1[3]);
                    *(v4u*)(PRE + off) = w; } }
    }
};
struct EpiSwiglu {
    static constexpr bool PERM = true; bf16* O; int f8 = 0; float ascale = 1.0f;
    __device__ __forceinline__ void operator()(const f32x4 (&acc)[2][2][4][2], const pg8::Unit& u, int wr, int wc, int fr, int fq) const {
        const int row0 = u.rowbase + wr * 64 + fr, col0 = u.pn * 128 + wc * 32 + 8 * fq;
#pragma unroll
        for (int ai = 0; ai < 2; ++ai) if (ai == 0 || !u.half)
#pragma unroll
            for (int m = 0; m < 4; ++m) { bf16* rowp = O + (size_t)(row0 + ai * 128 + m * 16) * DE + col0;
                float h[8];
#pragma unroll
                for (int n = 0; n < 2; ++n)
#pragma unroll
                    for (int j = 0; j < 4; ++j) { const float g = acc[ai][0][m][n][j] * ascale, up = acc[ai][1][m][n][j] * ascale; h[4 * n + j] = g * sigmoidf_(g) * up; }
                if (f8) { v2u w8; w8.x = pk4_fp8(h[0] * F8_XS, h[1] * F8_XS, h[2] * F8_XS, h[3] * F8_XS); w8.y = pk4_fp8(h[4] * F8_XS, h[5] * F8_XS, h[6] * F8_XS, h[7] * F8_XS);
                    *(v2u*)((unsigned char*)O + (size_t)(row0 + ai * 128 + m * 16) * DE + col0) = w8; }
                else { v4u w; w.x = cvt_pk_bf16(h[0], h[1]); w.y = cvt_pk_bf16(h[2], h[3]); w.z = cvt_pk_bf16(h[4], h[5]); w.w = cvt_pk_bf16(h[6], h[7]);
                *(v4u*)rowp = w; } }
    }
};
struct EpiPle {
    static constexpr bool PERM = true; const bf16* X2B; const bf16* PP; bf16* XB; float* OUT; int last; float ascale = 1.0f; unsigned char* XF8 = nullptr;
    __device__ __forceinline__ void operator()(const f32x4 (&acc)[2][2][4][2], const pg8::Unit& u, int wr, int wc, int fr, int fq) const {
        const int row0 = u.rowbase + wr * 64 + fr, col0 = u.pn * 256 + wc * 32 + 8 * fq;
#pragma unroll
        for (int ai = 0; ai < 2; ++ai)
#pragma unroll
            for (int mp = 0; mp < 2; ++mp) { v4u xq[2][2], pq[2][2];
#pragma unroll
                for (int mm = 0; mm < 2; ++mm)
#pragma unroll
                    for (int bj = 0; bj < 2; ++bj) { const size_t off = (size_t)(row0 + ai * 128 + (2 * mp + mm) * 16) * D + col0 + bj * 128; xq[mm][bj] = *(const v4u*)(X2B + off); pq[mm][bj] = *(const v4u*)(PP + off); }
                asm volatile("" : "+v"(xq[0][0]), "+v"(xq[0][1]), "+v"(xq[1][0]), "+v"(xq[1][1]), "+v"(pq[0][0]), "+v"(pq[0][1]), "+v"(pq[1][0]), "+v"(pq[1][1]));
#pragma unroll
                for (int mm = 0; mm < 2; ++mm)
#pragma unroll
                    for (int bj = 0; bj < 2; ++bj) { const int m = 2 * mp + mm; const size_t off = (size_t)(row0 + ai * 128 + m * 16) * D + col0 + bj * 128;
                        const v4u xx = xq[mm][bj], pp = pq[mm][bj];
                        const f32x4 a0 = acc[ai][bj][m][0] * ascale, a1 = acc[ai][bj][m][1] * ascale;
                        f32x4 o0, o1;
                        o0[0] = bflo(xx.x) + sigmoidf_(a0[0]) * bflo(pp.x); o0[1] = bfhi(xx.x) + sigmoidf_(a0[1]) * bfhi(pp.x); o0[2] = bflo(xx.y) + sigmoidf_(a0[2]) * bflo(pp.y); o0[3] = bfhi(xx.y) + sigmoidf_(a0[3]) * bfhi(pp.y);
                        o1[0] = bflo(xx.z) + sigmoidf_(a1[0]) * bflo(pp.z); o1[1] = bfhi(xx.z) + sigmoidf_(a1[1]) * bfhi(pp.z); o1[2] = bflo(xx.w) + sigmoidf_(a1[2]) * bflo(pp.w); o1[3] = bfhi(xx.w) + sigmoidf_(a1[3]) * bfhi(pp.w);
                        if (last) { *(f32x4*)(OUT + off) = o0; *(f32x4*)(OUT + off + 4) = o1; }
                        else { v4u w; w.x = cvt_pk_bf16(o0[0], o0[1]); w.y = cvt_pk_bf16(o0[2], o0[3]); w.z = cvt_pk_bf16(o1[0], o1[1]); w.w = cvt_pk_bf16(o1[2], o1[3]); *(v4u*)(XB + off) = w;
                            if (XF8) { v2u w8; w8.x = pk4_fp8(o0[0] * F8_XS, o0[1] * F8_XS, o0[2] * F8_XS, o0[3] * F8_XS); w8.y = pk4_fp8(o1[0] * F8_XS, o1[1] * F8_XS, o1[2] * F8_XS, o1[3] * F8_XS); *(v2u*)(XF8 + off) = w8; } } } }
    }
};

#ifdef NT_WEIGHTS
#define WLOAD(p) __builtin_nontemporal_load(p)
#else
#define WLOAD(p) (*(p))
#endif
__device__ __forceinline__ void tr_item(const float* W, int ldw, int k0, int n0, bf16* WT, size_t drow0, int ldt, LAS float* scr, int lane) {
#pragma unroll 8
    for (int i = 0; i < 32; ++i) { const int kk = 2 * i + (lane >> 5); scr[kk * 33 + (lane & 31)] = WLOAD(W + (size_t)(k0 + kk) * ldw + n0 + (lane & 31)); }
    LDS_WAIT(); asm volatile("" ::: "memory");
    const int c = lane & 7;
#pragma unroll
    for (int j = 0; j < 4; ++j) { const int n = (lane >> 3) + 8 * j; const LAS float* s = scr + (8 * c) * 33 + n;
        v4u o; o.x = pk2(s[0 * 33], s[1 * 33]); o.y = pk2(s[2 * 33], s[3 * 33]); o.z = pk2(s[4 * 33], s[5 * 33]); o.w = pk2(s[6 * 33], s[7 * 33]);
        *(GAS v4u*)(WT + (drow0 + n) * ldt + k0 + 8 * c) = o; }
    LDS_WAIT(); asm volatile("" ::: "memory");
}
__device__ __forceinline__ void tr_item8(const float* W, int ldw, int k0, int n0, unsigned char* WT, size_t drow0, int ldt, LAS float* scr, int lane) {
#pragma unroll 8
    for (int i = 0; i < 32; ++i) { const int kk = 2 * i + (lane >> 5); scr[kk * 33 + (lane & 31)] = WLOAD(W + (size_t)(k0 + kk) * ldw + n0 + (lane & 31)); }
    LDS_WAIT(); asm volatile("" ::: "memory");
    const int c = lane & 7;
#pragma unroll
    for (int j = 0; j < 4; ++j) { const int n = (lane >> 3) + 8 * j; const LAS float* s = scr + (8 * c) * 33 + n;
        v2u o; o.x = pk4_fp8(s[0 * 33] * F8_WS, s[1 * 33] * F8_WS, s[2 * 33] * F8_WS, s[3 * 33] * F8_WS); o.y = pk4_fp8(s[4 * 33] * F8_WS, s[5 * 33] * F8_WS, s[6 * 33] * F8_WS, s[7 * 33] * F8_WS);
        *(GAS v2u*)(WT + (drow0 + n) * ldt + k0 + 8 * c) = o; }
    LDS_WAIT(); asm volatile("" ::: "memory");
}
__device__ __forceinline__ void weight_items(const Args& a, unsigned char* ws, LAS float* scr, int lane, int group, int l, int gw, int NGW, gu32* ctr = nullptr) {
    constexpr int I_INA = 32 * 128, I_INB = 32 * 32, I_OUT = 32 * 64, I_PG = 32 * 64, I_PP = 4 * 64, I_POOL = 4 * 32, I_EG = NE * 32 * 32, I_EU = I_EG, I_ED = NE * 16 * 64;
    if (group == 0) {
        for (int it = gw; it < I_INA + I_INB + I_PP + I_POOL; it += NGW) { int r = it;
            if (r < I_INA) { const int kb = r / 128, nb = r % 128;
                if (FP8_PA_TILE(l, 32 * nb)) tr_item8(a.in[I_WIN] + (size_t)l * D * IN_COLS, IN_COLS, 64 * kb, 32 * nb, ws + WS_WIN8 + (size_t)(DEPTH - 1 - l) * 12 * MiB, 32 * nb, D, scr, lane);
                else tr_item(a.in[I_WIN] + (size_t)l * D * IN_COLS, IN_COLS, 64 * kb, 32 * nb, (bf16*)(ws + WS_WIN) + (size_t)l * NPROJ * D, 32 * nb, D, scr, lane); continue; } r -= I_INA;
            if (r < I_INB) { const int kb = r / 32, nb = r % 32;
                if (FP8_PA_TILE(l, 4096 + 32 * nb)) tr_item8(a.in[I_WIN] + (size_t)l * D * IN_COLS, IN_COLS, 64 * kb, 4112 + 32 * nb, ws + WS_WIN8 + (size_t)(DEPTH - 1 - l) * 12 * MiB, 4096 + 32 * nb, D, scr, lane);
                else tr_item(a.in[I_WIN] + (size_t)l * D * IN_COLS, IN_COLS, 64 * kb, 4112 + 32 * nb, (bf16*)(ws + WS_WIN) + (size_t)l * NPROJ * D, 4096 + 32 * nb, D, scr, lane); continue; } r -= I_INB;
            if (r < I_PP) { const int kb = r / 64, nb = r % 64; tr_item(a.in[I_WPP] + (size_t)l * PLE * D, D, 64 * kb, 32 * nb, (bf16*)(ws + WS_WPP) + (size_t)l * D * PLE, 32 * nb, PLE, scr, lane); continue; } r -= I_PP;
            { const int g = r / 32, rr = r % 32, kb = rr / 8, nb = rr % 8; tr_item(a.in[I_POOLW] + ((size_t)l * 4 + g) * 65536, 256, 64 * kb, 32 * nb, (bf16*)(ws + WS_WPOOL) + ((size_t)l * 4 + g) * 65536, 32 * nb, 256, scr, lane); } }
    } else {
        const bool f8 = FP8_LAYER(l);
        constexpr int NIT = I_OUT + I_PG + I_EG + I_EU + I_ED;
        int it = gw - NGW, kk = 8; unsigned cb = 0u;
        for (;;) {
            if (ctr) { if (kk == 8) { unsigned b = 0u; if (lane == 0) b = __hip_atomic_fetch_add(ctr, 8u, RLX_AGENT); cb = (unsigned)__builtin_amdgcn_readfirstlane((int)b); kk = 0; if (cb >= (unsigned)NIT) break; }
                it = (int)cb + kk; ++kk; if (it >= NIT) continue; }
            else { it += NGW; if (it >= NIT) break; }
            int r = it;
            if (r < I_OUT) { const int kb = r / 64, nb = r % 64; if (FP8_PDL(l)) tr_item8(a.in[I_WOUT] + (size_t)l * D * D, D, 64 * kb, 32 * nb, ws + WS_WOUT + (size_t)l * D * D * 2, 32 * nb, D, scr, lane); else tr_item(a.in[I_WOUT] + (size_t)l * D * D, D, 64 * kb, 32 * nb, (bf16*)(ws + WS_WOUT) + (size_t)l * D * D, 32 * nb, D, scr, lane); continue; } r -= I_OUT;
            if (r < I_PG) { const int kb = r / 64, nb = r % 64; if (FP8_PI && (FP8_PI0 || l == DEPTH - 1)) tr_item8(a.in[I_WPG] + (size_t)l * D * D, D, 64 * kb, 32 * nb, ws + WS_WPG + (size_t)l * D * D * 2, 32 * nb, D, scr, lane); else tr_item(a.in[I_WPG] + (size_t)l * D * D, D, 64 * kb, 32 * nb, (bf16*)(ws + WS_WPG) + (size_t)l * D * D, 32 * nb, D, scr, lane); continue; } r -= I_PG;
            if (r < I_EG) { const int e = r / 1024, rr = r % 1024, kb = rr / 32, nb = rr % 32, h0 = 32 * nb;
                if (f8) tr_item8(a.in[I_WEG] + ((size_t)l * NE + e) * D * DE, DE, 64 * kb, h0, ws + WS_WGU + (size_t)l * NE * 2048 * D * 2 + (size_t)e * 2048 * D, (size_t)(h0 >> 7) * 256 + (h0 & 127), D, scr, lane);
                else tr_item(a.in[I_WEG] + ((size_t)l * NE + e) * D * DE, DE, 64 * kb, h0, (bf16*)(ws + WS_WGU) + ((size_t)l * NE + e) * 2048 * D, (size_t)(h0 >> 7) * 256 + (h0 & 127), D, scr, lane); continue; } r -= I_EG;
            if (r < I_EU) { const int e = r / 1024, rr = r % 1024, kb = rr / 32, nb = rr % 32, h0 = 32 * nb;
                if (f8) tr_item8(a.in[I_WEU] + ((size_t)l * NE + e) * D * DE, DE, 64 * kb, h0, ws + WS_WGU + (size_t)l * NE * 2048 * D * 2 + (size_t)e * 2048 * D, (size_t)(h0 >> 7) * 256 + 128 + (h0 & 127), D, scr, lane);
                else tr_item(a.in[I_WEU] + ((size_t)l * NE + e) * D * DE, DE, 64 * kb, h0, (bf16*)(ws + WS_WGU) + ((size_t)l * NE + e) * 2048 * D, (size_t)(h0 >> 7) * 256 + 128 + (h0 & 127), D, scr, lane); continue; } r -= I_EU;
            { const int e = r / 1024, rr = r % 1024, kb = rr / 64, nb = rr % 64;
                if (f8 && FP8_PG) tr_item8(a.in[I_WED] + ((size_t)l * NE + e) * DE * D, D, 64 * kb, 32 * nb, ws + WS_WD + (size_t)l * NE * D * DE * 2 + (size_t)e * D * DE, 32 * nb, DE, scr, lane);
                else tr_item(a.in[I_WED] + ((size_t)l * NE + e) * DE * D, D, 64 * kb, 32 * nb, (bf16*)(ws + WS_WD) + ((size_t)l * NE + e) * D * DE, 32 * nb, DE, scr, lane); } }
    }
}
__device__ __forceinline__ void p0_prologue(const Frame& F0, const Args& a) {
    PHASE_FRAME(F0);
    LAS float* scr = (LAS float*)(F.lds + RING_OFF + F.wave * 16384);
    const int gw = F.vcu * NWAVES + F.wave, NGW = F.G * NWAVES;
    unsigned char* ws = OPQ_G(unsigned char, a.ws);
#pragma unroll 1
    for (int l = 0; l < DEPTH; ++l) weight_items(a, ws, scr, F.lane, 0, l, gw, NGW);
#ifdef CONVERT_ALL_IN_PROLOGUE
#pragma unroll 1
    for (int l = 0; l < DEPTH; ++l) weight_items(a, ws, scr, F.lane, 1, l, gw, NGW);
#endif
    const size_t gt = (size_t)F.vcu * 512 + F.tid, NGT = (size_t)F.G * 512;
    { const GAS f32x4* src = (const GAS f32x4*)a.in[I_X]; GAS v4u* dst = (GAS v4u*)(ws + WS_XB);
        for (size_t i = gt; i < (size_t)T * D / 8; i += NGT) { const f32x4 v0 = WLOAD(src + 2 * i), v1 = WLOAD(src + 2 * i + 1); v4u o; o.x = pk2(v0[0], v0[1]); o.y = pk2(v0[2], v0[3]); o.z = pk2(v1[0], v1[1]); o.w = pk2(v1[2], v1[3]); dst[i] = o;
            if (FP8_PAL(0)) { v2u o8; o8.x = pk4_fp8(v0[0] * F8_XS, v0[1] * F8_XS, v0[2] * F8_XS, v0[3] * F8_XS); o8.y = pk4_fp8(v1[0] * F8_XS, v1[1] * F8_XS, v1[2] * F8_XS, v1[3] * F8_XS); ((GAS v2u*)(ws + WS_XBF8))[i] = o8; } } }
    { const GAS f32x4* src = (const GAS f32x4*)a.in[I_P]; GAS v4u* dst = (GAS v4u*)(ws + WS_PB16);
        for (size_t i = gt; i < (size_t)DEPTH * T * PLE / 8; i += NGT) { const f32x4 v0 = WLOAD(src + 2 * i), v1 = WLOAD(src + 2 * i + 1); v4u o; o.x = pk2(v0[0], v0[1]); o.y = pk2(v0[2], v0[3]); o.z = pk2(v1[0], v1[1]); o.w = pk2(v1[2], v1[3]); dst[i] = o; } }
    for (size_t i = gt; i < (size_t)DEPTH * 16 * D; i += NGT) { const int l = (int)(i / (16 * D)), j = (int)((i / D) % 16), k = (int)(i % D);
        ((bf16*)(ws + WS_WBA))[i] = (bf16)f2bf(a.in[I_WIN][((size_t)l * D + k) * IN_COLS + 4096 + j]); }
}

typedef float f32x16 __attribute__((ext_vector_type(16)));
#define MFMA32(a_, b_, c_) __builtin_amdgcn_mfma_f32_32x32x16_bf16((a_), (b_), (c_), 0, 0, 0)
#define PACK8(x, sp) __builtin_bit_cast(bf16x8, (v4u){pkbf((x)[8 * (sp)], (x)[8 * (sp) + 1]), pkbf((x)[8 * (sp) + 2], (x)[8 * (sp) + 3]), pkbf((x)[8 * (sp) + 4], (x)[8 * (sp) + 5]), pkbf((x)[8 * (sp) + 6], (x)[8 * (sp) + 7])})
#define RAW_BAR() do { asm volatile("s_waitcnt lgkmcnt(0)" ::: "memory"); __builtin_amdgcn_s_barrier(); asm volatile("" ::: "memory"); } while (0)
constexpr int IMG_ELEMS = 56 * 512, UIMG_ELEMS = 8 * 1024;
constexpr int FR_WN = 0, FR_QD = 16, FR_AQK = 32, FR_KDT = 40;
constexpr size_t WS_IMG = WS_R2, WS_UIMG = WS_R2 + 112 * MiB;
static_assert((size_t)NB * NCH * NH * IMG_ELEMS * 2 == 112 * MiB && (size_t)NB * NCH * NH * UIMG_ELEMS * 2 == 32 * MiB, "DeltaNet images");

__device__ __forceinline__ void pool_diffs_unit(const Frame& F, unsigned char* ws, int pm, int g) {
    const bf16* PROJ = (const bf16*)(ws + WS_PROJ); bf16* POOLD = (bf16*)(ws + WS_POOLD);
    const int tid = F.tid, cp = tid & 127, rq = tid >> 7, r0 = 256 * pm + 64 * rq, sq0 = r0 % SEQ, col = 256 * g + 2 * cp;
    const bf16* up = PROJ + (size_t)r0 * NPROJ + 4096 + col; bf16* dp = POOLD + (size_t)r0 * PW + col;
#define POOL_BODY(WIN) do { unsigned xr[CH + WIN - 1]; \
        _Pragma("unroll") for (int j = 0; j < WIN - 1; ++j) xr[j] = (sq0 - (WIN - 1) + j >= 0) ? *(const unsigned*)(up + (ptrdiff_t)(j - (WIN - 1)) * NPROJ) : 0u; \
        _Pragma("unroll") for (int i = 0; i < CH; ++i) xr[WIN - 1 + i] = *(const unsigned*)(up + (size_t)i * NPROJ); \
        float s0 = 0.f, s1 = 0.f; \
        _Pragma("unroll") for (int j = 0; j < WIN - 1; ++j) { s0 += bflo(xr[j]); s1 += bfhi(xr[j]); } \
        _Pragma("unroll") for (int i = 0; i < CH; ++i) { const float x0 = bflo(xr[WIN - 1 + i]), x1 = bfhi(xr[WIN - 1 + i]); s0 += x0; s1 += x1; \
            const int pos = sq0 + i; const float inv = __builtin_amdgcn_rcpf((float)((pos + 1) < WIN ? (pos + 1) : WIN)); \
            *(unsigned*)(dp + (size_t)i * PW) = pkbf(s0 * inv - x0, s1 * inv - x1); s0 -= bflo(xr[i]); s1 -= bfhi(xr[i]); } } while (0)
    if (g == 0) POOL_BODY(2); else if (g == 1) POOL_BODY(4); else if (g == 2) POOL_BODY(8); else POOL_BODY(16);
#undef POOL_BODY
}
#ifndef PREP_DUP
#define PREP_DUP 0
#endif
constexpr int PQF = 0, PKF = 33792, PQS = 67584, PKS = 84992, PVT = 102400, PKT = 120832, PTAB = 139264;
constexpr int PAS = PQF;
constexpr int PTB = PKF, PT11T = PKF + 9216, PPART = PKF;
constexpr int F_LD = 132, S_LD = 136, T_LD = 72, A_LD = 68, TT_LD = 40;
__device__ __forceinline__ void phase_dn_prep(const Frame& F0, const Args& a, int layer) {
    PHASE_FRAME(F0);
    unsigned char* ws = OPQ_G(unsigned char, a.ws);
    LAS unsigned char* lds = F.lds;
    LAS float* Qf = (LAS float*)(lds + PQF); LAS float* Kf = (LAS float*)(lds + PKF); LAS float* As = (LAS float*)(lds + PAS);
    LAS bf16* Qs = (LAS bf16*)(lds + PQS); LAS bf16* Ks = (LAS bf16*)(lds + PKS); LAS bf16* Vt = (LAS bf16*)(lds + PVT); LAS bf16* Kt = (LAS bf16*)(lds + PKT);
    LAS bf16* Tb = (LAS bf16*)(lds + PTB); LAS bf16* T11t = (LAS bf16*)(lds + PT11T);
    LAS float* betaS = (LAS float*)(lds + PTAB); LAS float* gS = betaS + 512; LAS float* gamh = gS + 512; LAS float* betah = gamh + 64; LAS float* egam = betah + 64; LAS float* bgam = egam + 64; LAS float* ekd = bgam + 64; LAS float* rkS = ekd + 64;
    const bf16* XB = (const bf16*)(ws + WS_XB); const bf16* PROJ = (const bf16*)(ws + WS_PROJ); const bf16* WBA = (const bf16*)(ws + WS_WBA) + (size_t)layer * 16 * D;
    bf16* IMG = (bf16*)(ws + WS_IMG); bf16* UIMG = (bf16*)(ws + WS_UIMG); float* CD = (float*)(ws + WS_CD);
    const float* convw = a.in[I_CONVW] + (size_t)layer * 4 * 3072; const float* alog = a.in[I_ALOG] + layer * NH; const float* dtb = a.in[I_DTB] + layer * NH;
    const int tid = F.tid, lane = F.lane, wave = F.wave, c32 = lane & 31, hf = lane >> 5;
    for (int unit = F.vcu; unit < NB * NCH; unit += F.G) {
        const int b = unit / NCH, n = unit % NCH, r0 = b * SEQ + n * CH, sq0 = n * CH;
        for (int rep_ = 0; rep_ < ((PREP_DUP & 64) ? 2 : 1); ++rep_)
        { typedef float f32x4v __attribute__((ext_vector_type(4)));
            const int fr = lane & 15, fg = lane >> 4; f32x4v pacc[4];
#pragma unroll
            for (int mt = 0; mt < 4; ++mt) pacc[mt] = (f32x4v){0.f, 0.f, 0.f, 0.f};
#pragma unroll 1
            for (int sb = 0; sb < 8; sb += 4) {
                bf16x8 bq[4], aq[4][4];
#pragma unroll
                for (int s = 0; s < 4; ++s) { const int k0 = 256 * wave + 32 * (sb + s) + 8 * fg; bq[s] = *(const bf16x8*)(WBA + (size_t)fr * D + k0);
#pragma unroll
                    for (int mt = 0; mt < 4; ++mt) aq[s][mt] = *(const bf16x8*)(XB + (size_t)(r0 + 16 * mt + fr) * D + k0); }
                asm volatile("" : "+v"(bq[0]), "+v"(bq[1]), "+v"(bq[2]), "+v"(bq[3]), "+v"(aq[0][0]), "+v"(aq[0][1]), "+v"(aq[0][2]), "+v"(aq[0][3]), "+v"(aq[1][0]), "+v"(aq[1][1]), "+v"(aq[1][2]), "+v"(aq[1][3]),
                             "+v"(aq[2][0]), "+v"(aq[2][1]), "+v"(aq[2][2]), "+v"(aq[2][3]), "+v"(aq[3][0]), "+v"(aq[3][1]), "+v"(aq[3][2]), "+v"(aq[3][3]));
#pragma unroll
                for (int s = 0; s < 4; ++s)
#pragma unroll
                    for (int mt = 0; mt < 4; ++mt) pacc[mt] = __builtin_amdgcn_mfma_f32_16x16x32_bf16(aq[s][mt], bq[s], pacc[mt], 0, 0, 0); }
            LAS float* part = (LAS float*)(lds + PPART) + wave * 1024;
#pragma unroll
            for (int mt = 0; mt < 4; ++mt)
#pragma unroll
                for (int r = 0; r < 4; ++r) part[(16 * mt + 4 * fg + r) * 16 + fr] = pacc[mt][r]; }
        __syncthreads();
        { const int tok = tid >> 3, cp = tid & 7; float s0 = 0.f, s1 = 0.f;
#pragma unroll
            for (int w = 0; w < 8; ++w) { const f32x2 p2 = *(const LAS f32x2*)((LAS float*)(lds + PPART) + w * 1024 + tok * 16 + 2 * cp); s0 += p2[0]; s1 += p2[1]; }
            if (cp < 4) { betaS[tok * 8 + 2 * cp] = sigmoidf_(s0); betaS[tok * 8 + 2 * cp + 1] = sigmoidf_(s1); }
            else { const int h = 2 * (cp - 4); const float z0 = s0 + dtb[h], z1 = s1 + dtb[h + 1];
                const float sp0 = z0 > 20.f ? z0 : log1pf(__expf(z0)), sp1 = z1 > 20.f ? z1 : log1pf(__expf(z1));
                gS[tok * 8 + h] = -__expf(alog[h]) * sp0; gS[tok * 8 + h + 1] = -__expf(alog[h + 1]) * sp1; } }
        __syncthreads();
        { float gv = gS[lane * 8 + wave];
#pragma unroll
            for (int o = 1; o < 64; o <<= 1) { const float up_ = __shfl_up(gv, o); if (lane >= o) gv += up_; }
            gS[lane * 8 + wave] = gv; }
        __syncthreads();
        unsigned craw[3][11]; unsigned cdum[3][8];
#define PREP_LOADRAW(hh) do { const int cp_ = tid & 63, i0_ = (tid >> 6) * 8; \
            _Pragma("unroll") for (int part_ = 0; part_ < 3; ++part_) { const bf16* src_ = PROJ + (size_t)(r0 + i0_ - 3) * NPROJ + part_ * 1024 + (hh) * HD + 2 * cp_; \
                _Pragma("unroll") for (int j_ = 0; j_ < 11; ++j_) craw[part_][j_] = (sq0 + i0_ - 3 + j_ >= 0) ? *(const unsigned*)(src_ + (ptrdiff_t)j_ * NPROJ) : 0u; \
                if (PREP_DUP & 256) { _Pragma("unroll") for (int j_ = 3; j_ < 11; ++j_) cdum[part_][j_ - 3] = *(const unsigned*)(src_ + (ptrdiff_t)j_ * NPROJ + ((hh) ^ 1) * HD - (hh) * HD); } } } while (0)
        PREP_LOADRAW(0);
        for (int hh_ = 0; hh_ < ((PREP_DUP & 128) ? 2 * NH : NH); ++hh_) { const int h = hh_ & (NH - 1);
            const size_t chd = (size_t)unit * NH + h; bf16* img = IMG + chd * IMG_ELEMS; bf16* uimg = UIMG + chd * UIMG_ELEMS;
            for (int rep_ = 0; rep_ < ((PREP_DUP & 16) ? 2 : 1); ++rep_)
            { const int cp = tid & 63, rg8 = tid >> 6, i0 = rg8 * 8;
                if (PREP_DUP & 256) {
#pragma unroll
                    for (int p_ = 0; p_ < 3; ++p_)
#pragma unroll
                        for (int j_ = 0; j_ < 8; ++j_) asm volatile("" :: "v"(cdum[p_][j_])); }
#pragma unroll
                for (int part = 0; part < 3; ++part) { const int col = part * 1024 + h * HD + 2 * cp;
                    const f32x2 cw0 = *(const f32x2*)(convw + col), cw1 = *(const f32x2*)(convw + 3072 + col), cw2 = *(const f32x2*)(convw + 2 * 3072 + col), cw3 = *(const f32x2*)(convw + 3 * 3072 + col);
                    float ya[8], yb[8];
#pragma unroll
                    for (int i = 0; i < 8; ++i) { const unsigned x3 = craw[part][i], x2 = craw[part][i + 1], x1 = craw[part][i + 2], x0 = craw[part][i + 3];
                        const float ta = cw0[0] * bflo(x3) + cw1[0] * bflo(x2) + cw2[0] * bflo(x1) + cw3[0] * bflo(x0), tb = cw0[1] * bfhi(x3) + cw1[1] * bfhi(x2) + cw2[1] * bfhi(x1) + cw3[1] * bfhi(x0);
                        ya[i] = ta * sigmoidf_(ta); yb[i] = tb * sigmoidf_(tb); }
                    if (part == 0) {
#pragma unroll
                        for (int i = 0; i < 8; ++i) *(LAS f32x2*)(Qf + (i0 + i) * F_LD + 2 * cp) = (f32x2){ya[i], yb[i]}; }
                    else if (part == 1) {
#pragma unroll
                        for (int i = 0; i < 8; ++i) *(LAS f32x2*)(Kf + (i0 + i) * F_LD + 2 * cp) = (f32x2){ya[i], yb[i]}; }
                    else { v4u o0, o1;
                        o0.x = pkbf(ya[0] * betaS[(i0 + 0) * 8 + h], ya[1] * betaS[(i0 + 1) * 8 + h]); o0.y = pkbf(ya[2] * betaS[(i0 + 2) * 8 + h], ya[3] * betaS[(i0 + 3) * 8 + h]); o0.z = pkbf(ya[4] * betaS[(i0 + 4) * 8 + h], ya[5] * betaS[(i0 + 5) * 8 + h]); o0.w = pkbf(ya[6] * betaS[(i0 + 6) * 8 + h], ya[7] * betaS[(i0 + 7) * 8 + h]);
                        o1.x = pkbf(yb[0] * betaS[(i0 + 0) * 8 + h], yb[1] * betaS[(i0 + 1) * 8 + h]); o1.y = pkbf(yb[2] * betaS[(i0 + 2) * 8 + h], yb[3] * betaS[(i0 + 3) * 8 + h]); o1.z = pkbf(yb[4] * betaS[(i0 + 4) * 8 + h], yb[5] * betaS[(i0 + 5) * 8 + h]); o1.w = pkbf(yb[6] * betaS[(i0 + 6) * 8 + h], yb[7] * betaS[(i0 + 7) * 8 + h]);
                        *(LAS v4u*)(Vt + (2 * cp) * T_LD + i0) = o0; *(LAS v4u*)(Vt + (2 * cp + 1) * T_LD + i0) = o1; } }
            }
            if (hh_ + 1 < ((PREP_DUP & 128) ? 2 * NH : NH)) PREP_LOADRAW((hh_ + 1) & (NH - 1));
            for (int rep_ = 0; rep_ < ((PREP_DUP & 1) ? 2 : 1); ++rep_) { if (rep_) RAW_BAR();
            { const int i = tid >> 3, part = tid & 7; const LAS float* qp = Qf + i * F_LD + part * 16; const LAS float* kp = Kf + i * F_LD + part * 16;
                f32x4 qv[4], kv[4]; float sq = 0.f, sk = 0.f;
#pragma unroll
                for (int j = 0; j < 4; ++j) { qv[j] = *(const LAS f32x4*)(qp + 4 * j); kv[j] = *(const LAS f32x4*)(kp + 4 * j);
                    sq += (qv[j][0] * qv[j][0] + qv[j][1] * qv[j][1]) + (qv[j][2] * qv[j][2] + qv[j][3] * qv[j][3]); sk += (kv[j][0] * kv[j][0] + kv[j][1] * kv[j][1]) + (kv[j][2] * kv[j][2] + kv[j][3] * kv[j][3]); }
                sq = row8_sum(sq); sk = row8_sum(sk);
                const float rq = 1.0f / sqrtf(sq + RMS_EPS) * 0.08838834764831845f, rk = 1.0f / sqrtf(sk + RMS_EPS);
                const float gi_ = gS[i * 8 + h], eg = __expf(gi_);
                if (part == 0) { const float bi_ = betaS[i * 8 + h]; rkS[i] = rk; gamh[i] = gi_; betah[i] = bi_; egam[i] = eg; bgam[i] = bi_ * eg; ekd[i] = __expf(gS[63 * 8 + h] - gi_); }
#pragma unroll
                for (int j = 0; j < 4; ++j) { qv[j] = qv[j] * rq; kv[j] = kv[j] * rk; }
                v4u w0, w1;
                w0.x = pkbf(qv[0][0], qv[0][1]); w0.y = pkbf(qv[0][2], qv[0][3]); w0.z = pkbf(qv[1][0], qv[1][1]); w0.w = pkbf(qv[1][2], qv[1][3]); w1.x = pkbf(qv[2][0], qv[2][1]); w1.y = pkbf(qv[2][2], qv[2][3]); w1.z = pkbf(qv[3][0], qv[3][1]); w1.w = pkbf(qv[3][2], qv[3][3]);
                *(LAS v4u*)(Qs + i * S_LD + part * 16) = w0; *(LAS v4u*)(Qs + i * S_LD + part * 16 + 8) = w1;
                w0.x = pkbf(kv[0][0], kv[0][1]); w0.y = pkbf(kv[0][2], kv[0][3]); w0.z = pkbf(kv[1][0], kv[1][1]); w0.w = pkbf(kv[1][2], kv[1][3]); w1.x = pkbf(kv[2][0], kv[2][1]); w1.y = pkbf(kv[2][2], kv[2][3]); w1.z = pkbf(kv[3][0], kv[3][1]); w1.w = pkbf(kv[3][2], kv[3][3]);
                *(LAS v4u*)(Ks + i * S_LD + part * 16) = w0; *(LAS v4u*)(Ks + i * S_LD + part * 16 + 8) = w1;
                bf16* fq = img + ((size_t)(FR_QD + (i >> 5) * 8 + part) * 64 + (i & 31)) * 8;
                v4u h0, h1;
                h0.x = pkbf(qv[0][0] * eg, qv[0][1] * eg); h0.y = pkbf(qv[0][2] * eg, qv[0][3] * eg); h0.z = pkbf(qv[2][0] * eg, qv[2][1] * eg); h0.w = pkbf(qv[2][2] * eg, qv[2][3] * eg);
                h1.x = pkbf(qv[1][0] * eg, qv[1][1] * eg); h1.y = pkbf(qv[1][2] * eg, qv[1][3] * eg); h1.z = pkbf(qv[3][0] * eg, qv[3][1] * eg); h1.w = pkbf(qv[3][2] * eg, qv[3][3] * eg);
                *(v4u*)fq = h0; *(v4u*)(fq + 32 * 8) = h1; }
            RAW_BAR();
            { const int c = tid & 127, rg = tid >> 7; float kb[16], kd[16];
#pragma unroll
                for (int i = 0; i < 16; ++i) { const int t = rg * 16 + i; const float kn = Kf[t * F_LD + c] * rkS[t]; kb[i] = kn * bgam[t]; kd[i] = kn * ekd[t]; }
                v4u o0, o1;
                o0.x = pkbf(kb[0], kb[1]); o0.y = pkbf(kb[2], kb[3]); o0.z = pkbf(kb[4], kb[5]); o0.w = pkbf(kb[6], kb[7]); o1.x = pkbf(kb[8], kb[9]); o1.y = pkbf(kb[10], kb[11]); o1.z = pkbf(kb[12], kb[13]); o1.w = pkbf(kb[14], kb[15]);
                *(LAS v4u*)(Kt + c * T_LD + rg * 16) = o0; *(LAS v4u*)(Kt + c * T_LD + rg * 16 + 8) = o1;
                bf16* fk = img + ((size_t)(FR_KDT + (c >> 5) * 4 + rg) * 64 + (c & 31)) * 8;
                v4u h0, h1;
                h0.x = pkbf(kd[0], kd[1]); h0.y = pkbf(kd[2], kd[3]); h0.z = pkbf(kd[8], kd[9]); h0.w = pkbf(kd[10], kd[11]);
                h1.x = pkbf(kd[4], kd[5]); h1.y = pkbf(kd[6], kd[7]); h1.z = pkbf(kd[12], kd[13]); h1.w = pkbf(kd[14], kd[15]);
                *(v4u*)fk = h0; *(v4u*)(fk + 32 * 8) = h1; }
            RAW_BAR();
            }
            for (int rep_ = 0; rep_ < ((PREP_DUP & 2) ? 2 : 1); ++rep_) { if (rep_) RAW_BAR();
            if (wave < 6) { const int pr = wave % 3, iskk = wave / 3, mt = pr == 2 ? 1 : 0, nt = pr == 0 ? 0 : 1;
                const LAS bf16* xs = iskk ? Ks : Qs; f32x16 d;
#pragma unroll
                for (int r = 0; r < 16; ++r) d[r] = 0.f;
#pragma unroll
                for (int s = 0; s < 8; ++s) { const bf16x8 af = *(const LAS bf16x8*)(Ks + (32 * mt + c32) * S_LD + 16 * s + 8 * hf), bfr = *(const LAS bf16x8*)(xs + (32 * nt + c32) * S_LD + 16 * s + 8 * hf); d = MFMA32(af, bfr, d); }
                const int i = 32 * nt + c32; const float gi = gamh[i], bi = betah[i];
#pragma unroll
                for (int r = 0; r < 16; ++r) { const int j = 32 * mt + (r & 3) + 8 * (r >> 2) + 4 * hf; const float de = __expf(gi - gamh[j]);
                    d[r] = iskk ? ((j < i) ? bi * d[r] * de : 0.f) : ((j <= i) ? d[r] * de : 0.f); }
                if (iskk) {
#pragma unroll
                    for (int qd = 0; qd < 4; ++qd) *(LAS f32x4*)(As + i * A_LD + 32 * mt + 8 * qd + 4 * hf) = (f32x4){d[4 * qd], d[4 * qd + 1], d[4 * qd + 2], d[4 * qd + 3]}; }
                else {
#pragma unroll
                    for (int sp = 0; sp < 2; ++sp) *(bf16x8*)(img + ((size_t)(FR_AQK + nt * 4 + 2 * mt + sp) * 64 + lane) * 8) = PACK8(d, sp); } }
            RAW_BAR();
            }
            for (int rep_ = 0; rep_ < ((PREP_DUP & 4) ? 2 : 1); ++rep_) { if (rep_) RAW_BAR();
            if (wave < 2) {
                unsigned asb = (unsigned)(uintptr_t)(As + (32 * wave) * A_LD + 32 * wave); int cb = c32; asm volatile("" : "+v"(asb), "+v"(cb));
                const LAS float* Ab = (const LAS float*)(uintptr_t)asb;
                float arow[32], Tc[32];
#pragma unroll
                for (int i = 0; i < 32; ++i) arow[i] = Ab[i * A_LD + cb];
#pragma unroll
                for (int i = 0; i < 32; ++i) { float ac[4] = {(i == cb) ? 1.f : 0.f, 0.f, 0.f, 0.f}; if (i > 0) asm volatile("" : "+v"(arow[i]), "+v"(Tc[i - 1]));
#pragma unroll
                    for (int j = 0; j < i; ++j) { const float aij = __builtin_bit_cast(float, __builtin_amdgcn_readlane(__builtin_bit_cast(int, arow[i]), j)); ac[j & 3] -= aij * Tc[j]; }
                    Tc[i] = (ac[0] + ac[1]) + (ac[2] + ac[3]); __builtin_amdgcn_sched_barrier(0); }
                if (hf == 0) {
#pragma unroll
                    for (int i = 0; i < 32; ++i) Tb[(32 * wave + i) * T_LD + 32 * wave + c32] = (bf16)(pkbf(Tc[i], 0.f) & 0xffffu);
                    if (wave == 0) {
#pragma unroll
                        for (int q = 0; q < 4; ++q) { v4u o; o.x = pkbf(Tc[8 * q], Tc[8 * q + 1]); o.y = pkbf(Tc[8 * q + 2], Tc[8 * q + 3]); o.z = pkbf(Tc[8 * q + 4], Tc[8 * q + 5]); o.w = pkbf(Tc[8 * q + 6], Tc[8 * q + 7]); *(LAS v4u*)(T11t + c32 * TT_LD + 8 * q) = o; } } } }
            RAW_BAR();
            if (wave == 0) {
                f32x16 x;
#pragma unroll
                for (int r = 0; r < 16; ++r) x[r] = 0.f;
#pragma unroll
                for (int s = 0; s < 2; ++s) { const LAS float* ap = As + (32 + c32) * A_LD + 16 * s + 8 * hf; const f32x4 a0 = *(const LAS f32x4*)ap, a1 = *(const LAS f32x4*)(ap + 4);
                    const bf16x8 af = __builtin_bit_cast(bf16x8, (v4u){pkbf(a0[0], a0[1]), pkbf(a0[2], a0[3]), pkbf(a1[0], a1[1]), pkbf(a1[2], a1[3])});
                    const bf16x8 bfr = *(const LAS bf16x8*)(T11t + c32 * TT_LD + 16 * s + 8 * hf); x = MFMA32(af, bfr, x); }
                f32x16 t21;
#pragma unroll
                for (int r = 0; r < 16; ++r) t21[r] = 0.f;
#pragma unroll
                for (int s = 0; s < 2; ++s) { const LAS bf16* tp = Tb + (32 + c32) * T_LD + 32 + 16 * s + 4 * hf; const v2u lo = *(const LAS v2u*)tp, hi = *(const LAS v2u*)(tp + 8);
                    const bf16x8 af = __builtin_bit_cast(bf16x8, (v4u){lo.x, lo.y, hi.x, hi.y}); const bf16x8 bfr = PACK8(x, s); t21 = MFMA32(af, bfr, t21); }
#pragma unroll
                for (int r = 0; r < 16; ++r) Tb[(32 + (r & 3) + 8 * (r >> 2) + 4 * hf) * T_LD + c32] = (bf16)(pkbf(-t21[r], 0.f) & 0xffffu);
            }
            RAW_BAR();
            }
            for (int rep_ = 0; rep_ < ((PREP_DUP & 8) ? 2 : 1); ++rep_) { if (rep_) RAW_BAR();
            if (wave < 4) {
#pragma unroll
                for (int mt = 0; mt < 2; ++mt) { f32x16 d;
#pragma unroll
                    for (int r = 0; r < 16; ++r) d[r] = 0.f;
#pragma unroll
                    for (int s = 0; s < 4; ++s) if (s < 2 * (mt + 1)) { const bf16x8 af = *(const LAS bf16x8*)(Tb + (32 * mt + c32) * T_LD + 16 * s + 8 * hf), bfr = *(const LAS bf16x8*)(Vt + (32 * wave + c32) * T_LD + 16 * s + 8 * hf); d = MFMA32(af, bfr, d); }
                    bf16* up = uimg + ((size_t)(wave * 2 + mt) * 64 + lane) * 16; *(bf16x8*)up = PACK8(d, 0); *(bf16x8*)(up + 8) = PACK8(d, 1); } }
            else { const int ct = wave - 4;
#pragma unroll
                for (int nt = 0; nt < 2; ++nt) { f32x16 d;
#pragma unroll
                    for (int r = 0; r < 16; ++r) d[r] = 0.f;
#pragma unroll
                    for (int s = 0; s < 4; ++s) if (s < 2 * (nt + 1)) { const bf16x8 af = *(const LAS bf16x8*)(Kt + (32 * ct + c32) * T_LD + 16 * s + 8 * hf), bfr = *(const LAS bf16x8*)(Tb + (32 * nt + c32) * T_LD + 16 * s + 8 * hf); d = MFMA32(af, bfr, d); }
#pragma unroll
                    for (int r = 0; r < 16; ++r) d[r] = -d[r];
#pragma unroll
                    for (int sp = 0; sp < 2; ++sp) *(bf16x8*)(img + ((size_t)(FR_WN + nt * 8 + 2 * ct + sp) * 64 + lane) * 8) = PACK8(d, sp); } }
            }
            if (tid == 0) CD[chd] = egam[63];
            RAW_BAR();
        }
#undef PREP_LOADRAW
    }
}

__host__ __device__ constexpr int sc_p(int k) { const int j = k - 32; return j < 12 ? j % 6 : (j - 12) % 5; }
__host__ __device__ constexpr int sc_slab(int k) { const int j = k - 32; return k < 32 ? (k >> 2) : (j < 12 ? j / 6 : 2 + (j - 12) / 5); }
__host__ __device__ constexpr int sc_kind(int k) { return k < 32 ? ((k & 3) < 2 ? 0 : 1) : ((sc_p(k) == 2 || sc_p(k) == 5) ? 1 : 2); }
__host__ __device__ constexpr int sc_idx(int k) { return k < 32 ? (k & 1) : (sc_p(k) == 0 ? 0 : sc_p(k) == 1 ? 1 : sc_p(k) == 2 ? 1 : sc_p(k) == 3 ? 2 : sc_p(k) == 4 ? 3 : 0); }
__host__ __device__ constexpr int sc_frag(int k) { return k < 32 ? (((k & 3) < 2 ? FR_WN : FR_QD) + (k & 1) * 8 + (k >> 2)) : (sc_kind(k) == 1 ? FR_AQK + sc_idx(k) * 4 + sc_slab(k) : FR_KDT + sc_idx(k) * 4 + sc_slab(k)); }
constexpr int SC_QD = 8;
constexpr int SCB = 57344, OT_OFF = 2 * SCB, OT_LD = 136, OT_BYTES = 64 * OT_LD * 2;
static_assert(OT_OFF + 2 * OT_BYTES <= 152 * 1024, "scan LDS");
__device__ __forceinline__ void phase_dn_scan(const Frame& F0, const Args& a, int layer, int unit) {
    PHASE_FRAME(F0);
    unsigned char* ws = OPQ_G(unsigned char, a.ws);
    LAS unsigned char* lds = F.lds;
    const int b = unit >> 3, h = unit & 7, lane = F.lane;
    const bf16* IMG = (const bf16*)(ws + WS_IMG); const bf16* UIMG = (const bf16*)(ws + WS_UIMG); const float* CD = (const float*)(ws + WS_CD);
    const size_t chd0 = (size_t)b * NCH * NH + h;
    if (F.wave < 4) {
#ifndef SCAN_NO_COMPUTE
        const int w = F.wave, c32 = lane & 31, hf = lane >> 5;
        f32x16 S0, S1, S2, S3;
#pragma unroll
        for (int r = 0; r < 16; ++r) { S0[r] = 0.f; S1[r] = 0.f; S2[r] = 0.f; S3[r] = 0.f; }
        const float cdl = CD[chd0 + (size_t)lane * NH];
        v4u UA[4];
#ifdef SCAN_DEEP_U
        v4u UB[4];
#endif
        const __amdgpu_buffer_rsrc_t rsU = __builtin_amdgcn_make_buffer_rsrc((void*)(UIMG + chd0 * UIMG_ELEMS), (short)0, NCH * NH * UIMG_ELEMS * 2, 0x00020000);
        const unsigned uoff = (unsigned)((w * 2) * 64 + lane) * 32u;
#ifdef SCAN_DEEP_U
#define SC_ULEAD 2
#else
#define SC_ULEAD 1
#endif
#define SC_LOADU(dst, nn) do { _Pragma("unroll") for (int mt_ = 0; mt_ < 2; ++mt_) { _Pragma("unroll") for (int hh_ = 0; hh_ < 2; ++hh_) dst[2 * mt_ + hh_] = __builtin_amdgcn_raw_buffer_load_b128(rsU, uoff + (unsigned)(mt_ * 2048 + hh_ * 16), (unsigned)(nn) * (unsigned)(NH * UIMG_ELEMS * 2), 0); } } while (0)
#define SC_FRAG(bufoff, fi) (*(const LAS bf16x8*)(lds + (bufoff) + (fi) * 1024 + lane * 16))
#define SC_BODY8(bufoff) \
        fq0 = SC_FRAG(bufoff, 0); \
        fq1 = SC_FRAG(bufoff, 8); \
        fq2 = SC_FRAG(bufoff, 16); \
        fq3 = SC_FRAG(bufoff, 24); \
        fq4 = SC_FRAG(bufoff, 1); \
        fq5 = SC_FRAG(bufoff, 9); \
        fq6 = SC_FRAG(bufoff, 17); \
        fq7 = SC_FRAG(bufoff, 25); \
        Sbs = PACK8(S0, 0); \
        aV0 = MFMA32(fq0, Sbs, aV0); \
        fq0 = SC_FRAG(bufoff, 2); \
        aV1 = MFMA32(fq1, Sbs, aV1); \
        fq1 = SC_FRAG(bufoff, 10); \
        aO0 = MFMA32(fq2, Sbs, aO0); \
        fq2 = SC_FRAG(bufoff, 18); \
        aO1 = MFMA32(fq3, Sbs, aO1); \
        fq3 = SC_FRAG(bufoff, 26); \
        Sbs = PACK8(S0, 1); \
        aV0 = MFMA32(fq4, Sbs, aV0); \
        fq4 = SC_FRAG(bufoff, 3); \
        aV1 = MFMA32(fq5, Sbs, aV1); \
        fq5 = SC_FRAG(bufoff, 11); \
        aO0 = MFMA32(fq6, Sbs, aO0); \
        fq6 = SC_FRAG(bufoff, 19); \
        aO1 = MFMA32(fq7, Sbs, aO1); \
        fq7 = SC_FRAG(bufoff, 27); \
        Sbs = PACK8(S1, 0); \
        aV0 = MFMA32(fq0, Sbs, aV0); \
        fq0 = SC_FRAG(bufoff, 4); \
        aV1 = MFMA32(fq1, Sbs, aV1); \
        fq1 = SC_FRAG(bufoff, 12); \
        aO0 = MFMA32(fq2, Sbs, aO0); \
        fq2 = SC_FRAG(bufoff, 20); \
        aO1 = MFMA32(fq3, Sbs, aO1); \
        fq3 = SC_FRAG(bufoff, 28); \
        Sbs = PACK8(S1, 1); \
        aV0 = MFMA32(fq4, Sbs, aV0); \
        fq4 = SC_FRAG(bufoff, 5); \
        aV1 = MFMA32(fq5, Sbs, aV1); \
        fq5 = SC_FRAG(bufoff, 13); \
        aO0 = MFMA32(fq6, Sbs, aO0); \
        fq6 = SC_FRAG(bufoff, 21); \
        aO1 = MFMA32(fq7, Sbs, aO1); \
        fq7 = SC_FRAG(bufoff, 29); \
        Sbs = PACK8(S2, 0); \
        aV0 = MFMA32(fq0, Sbs, aV0); \
        fq0 = SC_FRAG(bufoff, 6); \
        aV1 = MFMA32(fq1, Sbs, aV1); \
        fq1 = SC_FRAG(bufoff, 14); \
        aO0 = MFMA32(fq2, Sbs, aO0); \
        fq2 = SC_FRAG(bufoff, 22); \
        aO1 = MFMA32(fq3, Sbs, aO1); \
        fq3 = SC_FRAG(bufoff, 30); \
        Sbs = PACK8(S2, 1); \
        aV0 = MFMA32(fq4, Sbs, aV0); \
        fq4 = SC_FRAG(bufoff, 7); \
        aV1 = MFMA32(fq5, Sbs, aV1); \
        fq5 = SC_FRAG(bufoff, 15); \
        aO0 = MFMA32(fq6, Sbs, aO0); \
        fq6 = SC_FRAG(bufoff, 23); \
        aO1 = MFMA32(fq7, Sbs, aO1); \
        fq7 = SC_FRAG(bufoff, 31); \
        Sbs = PACK8(S3, 0); \
        aV0 = MFMA32(fq0, Sbs, aV0); \
        fq0 = SC_FRAG(bufoff, 40); \
        aV1 = MFMA32(fq1, Sbs, aV1); \
        fq1 = SC_FRAG(bufoff, 44); \
        aO0 = MFMA32(fq2, Sbs, aO0); \
        fq2 = SC_FRAG(bufoff, 36); \
        aO1 = MFMA32(fq3, Sbs, aO1); \
        fq3 = SC_FRAG(bufoff, 48); \
        Sbs = PACK8(S3, 1); \
        aV0 = MFMA32(fq4, Sbs, aV0); \
        fq4 = SC_FRAG(bufoff, 52); \
        aV1 = MFMA32(fq5, Sbs, aV1); \
        fq5 = SC_FRAG(bufoff, 32); \
        S0 = S0 * cd; S1 = S1 * cd; S2 = S2 * cd; S3 = S3 * cd; \
        aO0 = MFMA32(fq6, Sbs, aO0); \
        fq6 = SC_FRAG(bufoff, 41); \
        aO1 = MFMA32(fq7, Sbs, aO1); \
        fq7 = SC_FRAG(bufoff, 45); \
        Vb0 = PACK8(aV0, 0); Vb1 = PACK8(aV0, 1); Vb2 = PACK8(aV1, 0); Vb3 = PACK8(aV1, 1); \
        S0 = MFMA32(fq0, Vb0, S0); \
        fq0 = SC_FRAG(bufoff, 37); \
        S1 = MFMA32(fq1, Vb0, S1); \
        fq1 = SC_FRAG(bufoff, 49); \
        aO1 = MFMA32(fq2, Vb0, aO1); \
        fq2 = SC_FRAG(bufoff, 53); \
        S2 = MFMA32(fq3, Vb0, S2); \
        fq3 = SC_FRAG(bufoff, 33); \
        S3 = MFMA32(fq4, Vb0, S3); \
        fq4 = SC_FRAG(bufoff, 42); \
        aO0 = MFMA32(fq5, Vb0, aO0); \
        fq5 = SC_FRAG(bufoff, 46); \
        S0 = MFMA32(fq6, Vb1, S0); \
        fq6 = SC_FRAG(bufoff, 38); \
        S1 = MFMA32(fq7, Vb1, S1); \
        fq7 = SC_FRAG(bufoff, 50); \
        aO1 = MFMA32(fq0, Vb1, aO1); \
        fq0 = SC_FRAG(bufoff, 54); \
        S2 = MFMA32(fq1, Vb1, S2); \
        fq1 = SC_FRAG(bufoff, 43); \
        S3 = MFMA32(fq2, Vb1, S3); \
        fq2 = SC_FRAG(bufoff, 47); \
        aO0 = MFMA32(fq3, Vb1, aO0); \
        fq3 = SC_FRAG(bufoff, 39); \
        S0 = MFMA32(fq4, Vb2, S0); \
        fq4 = SC_FRAG(bufoff, 51); \
        S1 = MFMA32(fq5, Vb2, S1); \
        fq5 = SC_FRAG(bufoff, 55); \
        aO1 = MFMA32(fq6, Vb2, aO1); \
        S2 = MFMA32(fq7, Vb2, S2); \
        S3 = MFMA32(fq0, Vb2, S3); \
        S0 = MFMA32(fq1, Vb3, S0); \
        S1 = MFMA32(fq2, Vb3, S1); \
        aO1 = MFMA32(fq3, Vb3, aO1); \
        S2 = MFMA32(fq4, Vb3, S2); \
        S3 = MFMA32(fq5, Vb3, S3);
#define SC_BODY6(bufoff) \
        fq0 = SC_FRAG(bufoff, 0); \
        fq1 = SC_FRAG(bufoff, 8); \
        fq2 = SC_FRAG(bufoff, 16); \
        fq3 = SC_FRAG(bufoff, 24); \
        fq4 = SC_FRAG(bufoff, 1); \
        fq5 = SC_FRAG(bufoff, 9); \
        Sbs = PACK8(S0, 0); \
        aV0 = MFMA32(fq0, Sbs, aV0); \
        fq0 = SC_FRAG(bufoff, 17); \
        aV1 = MFMA32(fq1, Sbs, aV1); \
        fq1 = SC_FRAG(bufoff, 25); \
        aO0 = MFMA32(fq2, Sbs, aO0); \
        fq2 = SC_FRAG(bufoff, 2); \
        aO1 = MFMA32(fq3, Sbs, aO1); \
        fq3 = SC_FRAG(bufoff, 10); \
        Sbs = PACK8(S0, 1); \
        aV0 = MFMA32(fq4, Sbs, aV0); \
        fq4 = SC_FRAG(bufoff, 18); \
        aV1 = MFMA32(fq5, Sbs, aV1); \
        fq5 = SC_FRAG(bufoff, 26); \
        aO0 = MFMA32(fq0, Sbs, aO0); \
        fq0 = SC_FRAG(bufoff, 3); \
        aO1 = MFMA32(fq1, Sbs, aO1); \
        fq1 = SC_FRAG(bufoff, 11); \
        Sbs = PACK8(S1, 0); \
        aV0 = MFMA32(fq2, Sbs, aV0); \
        fq2 = SC_FRAG(bufoff, 19); \
        aV1 = MFMA32(fq3, Sbs, aV1); \
        fq3 = SC_FRAG(bufoff, 27); \
        aO0 = MFMA32(fq4, Sbs, aO0); \
        fq4 = SC_FRAG(bufoff, 4); \
        aO1 = MFMA32(fq5, Sbs, aO1); \
        fq5 = SC_FRAG(bufoff, 12); \
        Sbs = PACK8(S1, 1); \
        aV0 = MFMA32(fq0, Sbs, aV0); \
        fq0 = SC_FRAG(bufoff, 20); \
        aV1 = MFMA32(fq1, Sbs, aV1); \
        fq1 = SC_FRAG(bufoff, 28); \
        aO0 = MFMA32(fq2, Sbs, aO0); \
        fq2 = SC_FRAG(bufoff, 5); \
        aO1 = MFMA32(fq3, Sbs, aO1); \
        fq3 = SC_FRAG(bufoff, 13); \
        Sbs = PACK8(S2, 0); \
        aV0 = MFMA32(fq4, Sbs, aV0); \
        fq4 = SC_FRAG(bufoff, 21); \
        aV1 = MFMA32(fq5, Sbs, aV1); \
        fq5 = SC_FRAG(bufoff, 29); \
        aO0 = MFMA32(fq0, Sbs, aO0); \
        fq0 = SC_FRAG(bufoff, 6); \
        aO1 = MFMA32(fq1, Sbs, aO1); \
        fq1 = SC_FRAG(bufoff, 14); \
        Sbs = PACK8(S2, 1); \
        aV0 = MFMA32(fq2, Sbs, aV0); \
        fq2 = SC_FRAG(bufoff, 22); \
        aV1 = MFMA32(fq3, Sbs, aV1); \
        fq3 = SC_FRAG(bufoff, 30); \
        aO0 = MFMA32(fq4, Sbs, aO0); \
        fq4 = SC_FRAG(bufoff, 7); \
        aO1 = MFMA32(fq5, Sbs, aO1); \
        fq5 = SC_FRAG(bufoff, 15); \
        Sbs = PACK8(S3, 0); \
        aV0 = MFMA32(fq0, Sbs, aV0); \
        fq0 = SC_FRAG(bufoff, 23); \
        aV1 = MFMA32(fq1, Sbs, aV1); \
        fq1 = SC_FRAG(bufoff, 31); \
        aO0 = MFMA32(fq2, Sbs, aO0); \
        fq2 = SC_FRAG(bufoff, 40); \
        aO1 = MFMA32(fq3, Sbs, aO1); \
        fq3 = SC_FRAG(bufoff, 44); \
        Sbs = PACK8(S3, 1); \
        aV0 = MFMA32(fq4, Sbs, aV0); \
        fq4 = SC_FRAG(bufoff, 36); \
        aV1 = MFMA32(fq5, Sbs, aV1); \
        fq5 = SC_FRAG(bufoff, 48); \
        S0 = S0 * cd; S1 = S1 * cd; S2 = S2 * cd; S3 = S3 * cd; \
        aO0 = MFMA32(fq0, Sbs, aO0); \
        fq0 = SC_FRAG(bufoff, 52); \
        aO1 = MFMA32(fq1, Sbs, aO1); \
        fq1 = SC_FRAG(bufoff, 32); \
        Vb0 = PACK8(aV0, 0); Vb1 = PACK8(aV0, 1); Vb2 = PACK8(aV1, 0); Vb3 = PACK8(aV1, 1); \
        S0 = MFMA32(fq2, Vb0, S0); \
        fq2 = SC_FRAG(bufoff, 41); \
        S1 = MFMA32(fq3, Vb0, S1); \
        fq3 = SC_FRAG(bufoff, 45); \
        aO1 = MFMA32(fq4, Vb0, aO1); \
        fq4 = SC_FRAG(bufoff, 37); \
        S2 = MFMA32(fq5, Vb0, S2); \
        fq5 = SC_FRAG(bufoff, 49); \
        S3 = MFMA32(fq0, Vb0, S3); \
        fq0 = SC_FRAG(bufoff, 53); \
        aO0 = MFMA32(fq1, Vb0, aO0); \
        fq1 = SC_FRAG(bufoff, 33); \
        S0 = MFMA32(fq2, Vb1, S0); \
        fq2 = SC_FRAG(bufoff, 42); \
        S1 = MFMA32(fq3, Vb1, S1); \
        fq3 = SC_FRAG(bufoff, 46); \
        aO1 = MFMA32(fq4, Vb1, aO1); \
        fq4 = SC_FRAG(bufoff, 38); \
        S2 = MFMA32(fq5, Vb1, S2); \
        fq5 = SC_FRAG(bufoff, 50); \
        S3 = MFMA32(fq0, Vb1, S3); \
        fq0 = SC_FRAG(bufoff, 54); \
        aO0 = MFMA32(fq1, Vb1, aO0); \
        fq1 = SC_FRAG(bufoff, 43); \
        S0 = MFMA32(fq2, Vb2, S0); \
        fq2 = SC_FRAG(bufoff, 47); \
        S1 = MFMA32(fq3, Vb2, S1); \
        fq3 = SC_FRAG(bufoff, 39); \
        aO1 = MFMA32(fq4, Vb2, aO1); \
        fq4 = SC_FRAG(bufoff, 51); \
        S2 = MFMA32(fq5, Vb2, S2); \
        fq5 = SC_FRAG(bufoff, 55); \
        S3 = MFMA32(fq0, Vb2, S3); \
        S0 = MFMA32(fq1, Vb3, S0); \
        S1 = MFMA32(fq2, Vb3, S1); \
        aO1 = MFMA32(fq3, Vb3, aO1); \
        S2 = MFMA32(fq4, Vb3, S2); \
        S3 = MFMA32(fq5, Vb3, S3);
#ifdef SCAN_Q6
#define SC_BODY(bufoff) SC_BODY6(bufoff)
#else
#define SC_BODY(bufoff) SC_BODY8(bufoff)
#endif
#define SC_CHUNK(nn, U, bufoff, otoff) do { \
        f32x16 aV0, aV1, aO0, aO1; bf16x8 fq0, fq1, fq2, fq3, fq4, fq5, fq6, fq7, Sbs, Vb0, Vb1, Vb2, Vb3; \
        _Pragma("unroll") for (int q = 0; q < 4; ++q) { aV0[2 * q] = bflo(U[0][q]); aV0[2 * q + 1] = bfhi(U[0][q]); aV0[8 + 2 * q] = bflo(U[1][q]); aV0[8 + 2 * q + 1] = bfhi(U[1][q]); \
            aV1[2 * q] = bflo(U[2][q]); aV1[2 * q + 1] = bfhi(U[2][q]); aV1[8 + 2 * q] = bflo(U[3][q]); aV1[8 + 2 * q + 1] = bfhi(U[3][q]); } \
        _Pragma("unroll") for (int r = 0; r < 16; ++r) { aO0[r] = 0.f; aO1[r] = 0.f; } \
        if ((nn) + SC_ULEAD < NCH) SC_LOADU(U, (nn) + SC_ULEAD); \
        const float cd = __builtin_bit_cast(float, __builtin_amdgcn_readlane(__builtin_bit_cast(int, cdl), (nn))); \
        SC_BODY(bufoff) \
        _Pragma("unroll") for (int r = 0; r < 16; ++r) { \
            *(LAS bf16*)(lds + (otoff) + (((r & 3) + 8 * (r >> 2) + 4 * hf) * OT_LD + 32 * w + c32) * 2) = (bf16)(pkbf(aO0[r], 0.f) & 0xffffu); \
            *(LAS bf16*)(lds + (otoff) + ((32 + (r & 3) + 8 * (r >> 2) + 4 * hf) * OT_LD + 32 * w + c32) * 2) = (bf16)(pkbf(aO1[r], 0.f) & 0xffffu); } \
        RAW_BAR(); } while (0)
#ifdef SCAN_DEEP_U
        SC_LOADU(UA, 0); SC_LOADU(UB, 1);
        RAW_BAR();
#pragma unroll 1
        for (int n = 0; n < NCH; n += 2) { SC_CHUNK(n, UA, 0, OT_OFF); SC_CHUNK(n + 1, UB, SCB, OT_OFF + OT_BYTES); }
#else
        SC_LOADU(UA, 0);
        RAW_BAR();
#pragma unroll 1
        for (int n = 0; n < NCH; n += 2) { SC_CHUNK(n, UA, 0, OT_OFF); SC_CHUNK(n + 1, UA, SCB, OT_OFF + OT_BYTES); }
#endif
#undef SC_CHUNK
#undef SC_FRAG
#undef SC_LOADU
#endif
    } else {
#ifndef SCAN_NO_HELPER
        const int ht = F.tid - 256, tok = ht >> 2, q = ht & 3;
        bf16* OB = FP8_PDL(layer) ? (bf16*)((unsigned char*)a.out + 64 * MiB) : (bf16*)(ws + WS_MIXIN); const int old_ = FP8_PDL(layer) ? DNW : D;
        v4u RA[14], RB[14];
#ifdef SCAN_DEEP
        v4u RC[14];
#endif
        const __amdgpu_buffer_rsrc_t rsI = __builtin_amdgcn_make_buffer_rsrc((void*)(IMG + chd0 * IMG_ELEMS), (short)0, NCH * NH * IMG_ELEMS * 2, 0x00020000);
#define SH_LOADIMG(dst, nn) do { _Pragma("unroll") for (int i_ = 0; i_ < 14; ++i_) dst[i_] = __builtin_amdgcn_raw_buffer_load_b128(rsI, (unsigned)ht * 16u, (unsigned)(nn) * (unsigned)(NH * IMG_ELEMS * 2) + (unsigned)i_ * 4096u, 0); } while (0)
#define SH_STOREIMG(src, bufoff) do { LAS v4u* p_ = (LAS v4u*)(lds + (bufoff)) + ht; _Pragma("unroll") for (int i_ = 0; i_ < 14; ++i_) p_[i_ * 256] = src[i_]; } while (0)
#define SH_EPI(mm, otoff) do { const LAS v4u* op_ = (const LAS v4u*)(lds + (otoff) + (tok * OT_LD + 32 * q) * 2); \
        v4u* yp_ = (v4u*)(OB + ((size_t)b * SEQ + (size_t)(mm) * CH + tok) * old_ + h * HD + 32 * q); \
        _Pragma("unroll") for (int i_ = 0; i_ < 4; ++i_) yp_[i_] = op_[i_]; } while (0)
#define SH_STEP(nn, Rcur, Rnext, bufnext, otprev) do { \
        if ((nn) + 2 < NCH) SH_LOADIMG(Rcur, (nn) + 2); \
        if ((nn) >= 1) SH_EPI((nn) - 1, otprev); \
        if ((nn) + 1 < NCH) SH_STOREIMG(Rnext, bufnext); \
        RAW_BAR(); } while (0)
#ifdef SCAN_DEEP
#define SH_STEP3(nn, Rload, Rstore, bufnext, otprev) do { \
        if ((nn) + 3 < NCH) SH_LOADIMG(Rload, (nn) + 3); \
        if ((nn) >= 1) SH_EPI((nn) - 1, otprev); \
        if ((nn) + 1 < NCH) SH_STOREIMG(Rstore, bufnext); \
        RAW_BAR(); } while (0)
        static_assert(NCH == 64, "the helper's step loop is written for 64 chunks (10 x 6 + 4)");
        SH_LOADIMG(RA, 0); SH_LOADIMG(RB, 1); SH_LOADIMG(RC, 2);
        SH_STOREIMG(RA, 0);
        RAW_BAR();
#pragma unroll 1
        for (int n = 0; n < 60; n += 6) {
            SH_STEP3(n, RA, RB, SCB, OT_OFF + OT_BYTES); SH_STEP3(n + 1, RB, RC, 0, OT_OFF); SH_STEP3(n + 2, RC, RA, SCB, OT_OFF + OT_BYTES);
            SH_STEP3(n + 3, RA, RB, 0, OT_OFF); SH_STEP3(n + 4, RB, RC, SCB, OT_OFF + OT_BYTES); SH_STEP3(n + 5, RC, RA, 0, OT_OFF); }
        SH_STEP3(60, RA, RB, SCB, OT_OFF + OT_BYTES); SH_STEP3(61, RB, RC, 0, OT_OFF); SH_STEP3(62, RC, RA, SCB, OT_OFF + OT_BYTES); SH_STEP3(63, RA, RB, 0, OT_OFF);
        SH_EPI(NCH - 1, OT_OFF + OT_BYTES);
#undef SH_STEP3
#else
        SH_LOADIMG(RA, 0); SH_LOADIMG(RB, 1);
        SH_STOREIMG(RA, 0);
        RAW_BAR();
#pragma unroll 1
        for (int n = 0; n < NCH; n += 2) { SH_STEP(n, RA, RB, SCB, OT_OFF + OT_BYTES); SH_STEP(n + 1, RB, RA, 0, OT_OFF); }
        SH_EPI(NCH - 1, OT_OFF + OT_BYTES);
#endif
#undef SH_STEP
#undef SH_EPI
#undef SH_STOREIMG
#undef SH_LOADIMG
#endif
    }
}

__device__ __forceinline__ void phase_dn_norm(const Frame& F0, const Args& a, int layer) {
    PHASE_FRAME(F0);
    unsigned char* ws = OPQ_G(unsigned char, a.ws);
    const bf16* PROJ = (const bf16*)(ws + WS_PROJ); bf16* MIXIN = (bf16*)(ws + WS_MIXIN);
    const bf16* OSRC = FP8_PDL(layer) ? (const bf16*)((unsigned char*)a.out + 64 * MiB) : (const bf16*)(ws + WS_MIXIN); const int old_ = FP8_PDL(layer) ? DNW : D;
    const int lane = F.lane, gw = F.vcu * NWAVES + F.wave, NGW = F.G * NWAVES;
    const float* nw = a.in[I_NORMW] + layer * HD + 16 * (lane & 7); f32x4 nwv[4];
#pragma unroll
    for (int i = 0; i < 4; ++i) nwv[i] = *(const f32x4*)(nw + 4 * i);
    v4u OA[2], ZA[2], OB[2], ZB[2];
#define DNN_LOAD(O_, Z_, t) do { const v4u* op_ = (const v4u*)(OSRC + (size_t)(t) * old_ + 16 * lane); const v4u* zp_ = (const v4u*)(PROJ + (size_t)(t) * NPROJ + 3072 + 16 * lane); O_[0] = op_[0]; O_[1] = op_[1]; Z_[0] = zp_[0]; Z_[1] = zp_[1]; } while (0)
#define DNN_ROW(O_, Z_, t) do { float ss = 0.f; \
        _Pragma("unroll") for (int i = 0; i < 2; ++i) _Pragma("unroll") for (int j = 0; j < 4; ++j) { const float x0 = bflo(O_[i][j]), x1 = bfhi(O_[i][j]); ss += x0 * x0 + x1 * x1; } \
        ss = row8_sum(ss); const float rr = 1.0f / sqrtf(ss * (1.0f / HD) + RMS_EPS); \
        v4u* yp_ = (v4u*)(MIXIN + (size_t)(t) * D + 16 * lane); float yv_[16]; \
        _Pragma("unroll") for (int i = 0; i < 2; ++i) { _Pragma("unroll") for (int j = 0; j < 4; ++j) { const float z0 = bflo(Z_[i][j]), z1 = bfhi(Z_[i][j]); const f32x4 nn = nwv[2 * i + (j >> 1)]; \
            yv_[8 * i + 2 * j] = bflo(O_[i][j]) * rr * nn[2 * (j & 1)] * z0 * sigmoidf_(z0); yv_[8 * i + 2 * j + 1] = bfhi(O_[i][j]) * rr * nn[2 * (j & 1) + 1] * z1 * sigmoidf_(z1); } } \
        if (FP8_PDL(layer)) { v4u o8_; _Pragma("unroll") for (int q4 = 0; q4 < 4; ++q4) o8_[q4] = pk4_fp8(yv_[4 * q4] * F8_XS, yv_[4 * q4 + 1] * F8_XS, yv_[4 * q4 + 2] * F8_XS, yv_[4 * q4 + 3] * F8_XS); *(v4u*)((unsigned char*)MIXIN + (size_t)(t) * D + 16 * lane) = o8_; } \
        else { _Pragma("unroll") for (int i = 0; i < 2; ++i) { v4u o_; _Pragma("unroll") for (int j = 0; j < 4; ++j) o_[j] = pkbf(yv_[8 * i + 2 * j], yv_[8 * i + 2 * j + 1]); yp_[i] = o_; } } } while (0)
    if (gw < T) DNN_LOAD(OA, ZA, gw);
#pragma unroll 1
    for (int t = gw; t < T; t += 2 * NGW) {
        if (t + NGW < T) DNN_LOAD(OB, ZB, t + NGW);
        DNN_ROW(OA, ZA, t);
        if (t + 2 * NGW < T) DNN_LOAD(OA, ZA, t + 2 * NGW);
        if (t + NGW < T) DNN_ROW(OB, ZB, t + NGW);
    }
#undef DNN_LOAD
#undef DNN_ROW
}

constexpr int WG_LD = 2056;
__device__ __forceinline__ void phase_ln1_router(const Frame& F0, const Args& a, int layer, int probe = 0, int f8 = 0) {
    PHASE_FRAME(F0);
    unsigned char* ws = OPQ_G(unsigned char, a.ws);
    LAS bf16* WgT = (LAS bf16*)F.lds;
    LAS float* GV = (LAS float*)(F.lds + 16 * WG_LD * 2);
    LAS float* part = GV + 2 * D;
    LAS float* rst = part + 2 * 64 * 16;
    LAS float* sgcb = rst + 128;
    LAS int* rowE = (LAS int*)(F.lds + AUX_OFF); LAS int* rowP = rowE + 128; LAS float* rowG = (LAS float*)(rowP + 128); LAS int* lcnt = (LAS int*)(rowG + 128); LAS int* lbase = lcnt + 16;
    const float* wr = OPQ_G(const float, a.in[I_WR]); const float* br = OPQ_G(const float, a.in[I_BR]);
    const float* g1 = a.in[I_LN1G] + (size_t)layer * D; const float* b1 = a.in[I_LN1B] + (size_t)layer * D;
    const int tid = F.tid, lane = F.lane, wave = F.wave;
    const bf16* PRE = (const bf16*)a.out;
    v2u XA[8], XB_[8];
#define PE_LOAD(X, rb_, r) do { const GAS v2u* xr_ = (const GAS v2u*)(PRE + (size_t)((rb_) * 64 + wave * 8 + (r)) * D) + lane; _Pragma("unroll") for (int j = 0; j < 8; ++j) X[j] = xr_[64 * j]; } while (0)
#ifdef PE_EARLY
    if (F.vcu < T / 64) { PE_LOAD(XA, F.vcu, 0); asm volatile("" ::: "memory"); }
#endif
    for (int i = tid; i < D; i += 512) { GV[i] = g1[i]; GV[D + i] = b1[i]; }
    { const int e = tid & 15, kp = tid >> 4; float s1 = 0.f, s2 = 0.f;
        for (int k = 64 * kp; k < 64 * kp + 64; k += 2) { const float w0 = wr[(size_t)k * NE + e], w1 = wr[(size_t)(k + 1) * NE + e]; const unsigned pk = pkbf(g1[k] * w0, g1[k + 1] * w1);
            *(LAS unsigned*)(WgT + e * WG_LD + k) = pk; s1 += bflo(pk) + bfhi(pk); s2 += b1[k] * w0 + b1[k + 1] * w1; }
        part[kp * 16 + e] = s1; part[512 + kp * 16 + e] = s2; }
    __syncthreads();
    if (tid < 32) { const int e = tid & 15, which = tid >> 4; float s = 0.f; for (int kp = 0; kp < 32; ++kp) s += part[which * 512 + kp * 16 + e]; sgcb[which * 16 + e] = which ? s + br[e] : s; }
    __syncthreads();
    bf16* X1B = (bf16*)(ws + (probe ? WS_R1 : WS_X1B)); float* STATS = (float*)(ws + (probe ? WS_R1 + 70 * MiB : WS_STATS));
    int* LIST = (int*)(ws + (probe ? WS_R1 + 72 * MiB : WS_LIST)); int* TOKSLOT = (int*)(ws + (probe ? WS_R1 + 80 * MiB : WS_TOKSLOT)); float* GATEW = (float*)(ws + (probe ? WS_R1 + 82 * MiB : WS_GATEW));
    gu32* cnt = F.ctl + CW_CNT + 64 * (layer + (probe ? 2 : 0));
    for (int rb = F.vcu; rb < T / 64; rb += F.G) {
        if (tid < 16) lcnt[tid] = 0;
#define PE_ROW(X, r) do { const int lr = wave * 8 + (r), row = rb * 64 + lr; unsigned gvo_ = (unsigned)(uintptr_t)GV; asm volatile("" : "+v"(gvo_)); const LAS float* GVr = (const LAS float*)(uintptr_t)gvo_; \
            f32x4 v[8]; float s = 0.f; \
            _Pragma("unroll") for (int j = 0; j < 8; ++j) { v[j] = (f32x4){bflo(X[j].x), bfhi(X[j].x), bflo(X[j].y), bfhi(X[j].y)}; s += (v[j][0] + v[j][1]) + (v[j][2] + v[j][3]); } \
            const float mean = wave_sum(s) * (1.f / D); float s2 = 0.f; \
            _Pragma("unroll") for (int j = 0; j < 8; ++j) { v[j] = v[j] - mean; s2 += (v[j][0] * v[j][0] + v[j][1] * v[j][1]) + (v[j][2] * v[j][2] + v[j][3] * v[j][3]); } \
            const float rstd = 1.f / sqrtf(wave_sum(s2) * (1.f / D) + LN_EPS); \
            if (lane == 0) { STATS[2 * row] = mean; STATS[2 * row + 1] = rstd; rst[2 * lr] = mean; rst[2 * lr + 1] = rstd; } \
            GAS v2u* o8 = (GAS v2u*)(X1B + (size_t)row * D) + lane; \
            _Pragma("unroll") for (int j = 0; j < 8; ++j) { const f32x4 gg = *(const LAS f32x4*)(GVr + 256 * j + 4 * lane), bb = *(const LAS f32x4*)(GVr + D + 256 * j + 4 * lane); \
                v[j] = v[j] * rstd * gg + bb; \
                if (f8) ((GAS unsigned*)((GAS unsigned char*)X1B + (size_t)row * D) + lane)[64 * j] = pk4_fp8(v[j][0] * F8_XS, v[j][1] * F8_XS, v[j][2] * F8_XS, v[j][3] * F8_XS); \
                else { v2u w; w.x = pkbf(v[j][0], v[j][1]); w.y = pkbf(v[j][2], v[j][3]); o8[64 * j] = w; } } } while (0)
#ifdef PE_EARLY
        if (rb != F.vcu) PE_LOAD(XA, rb, 0);
#else
        PE_LOAD(XA, rb, 0);
#endif
#pragma unroll 1
        for (int r = 0; r < 8; r += 2) { PE_LOAD(XB_, rb, r + 1); PE_ROW(XA, r); if (r + 2 < 8) PE_LOAD(XA, rb, r + 2); PE_ROW(XB_, r + 1); }
#undef PE_ROW
        { const int mt = wave & 3, kh = wave >> 2, fr = lane & 15, fg = lane >> 4; typedef float f32x4v __attribute__((ext_vector_type(4))); f32x4v acc = {0.f, 0.f, 0.f, 0.f};
            const bf16* arow = PRE + (size_t)(rb * 64 + 16 * mt + fr) * D + 1024 * kh + 8 * fg; const LAS bf16* brow = WgT + fr * WG_LD + 1024 * kh + 8 * fg;
#ifdef PE_EARLY
#pragma unroll 1
            for (int sb = 0; sb < 32; sb += 16) { bf16x8 aq[16];
#pragma unroll
                for (int s = 0; s < 16; ++s) aq[s] = *(const bf16x8*)(arow + 32 * (sb + s));
                asm volatile("" : "+v"(aq[0]), "+v"(aq[1]), "+v"(aq[2]), "+v"(aq[3]), "+v"(aq[4]), "+v"(aq[5]), "+v"(aq[6]), "+v"(aq[7]), "+v"(aq[8]), "+v"(aq[9]), "+v"(aq[10]), "+v"(aq[11]), "+v"(aq[12]), "+v"(aq[13]), "+v"(aq[14]), "+v"(aq[15]));
#pragma unroll
                for (int s = 0; s < 16; ++s) acc = __builtin_amdgcn_mfma_f32_16x16x32_bf16(aq[s], *(const LAS bf16x8*)(brow + 32 * (sb + s)), acc, 0, 0, 0); }
#else
#pragma unroll 1
            for (int sb = 0; sb < 32; sb += 8) { bf16x8 aq[8];
#pragma unroll
                for (int s = 0; s < 8; ++s) aq[s] = *(const bf16x8*)(arow + 32 * (sb + s));
                asm volatile("" : "+v"(aq[0]), "+v"(aq[1]), "+v"(aq[2]), "+v"(aq[3]), "+v"(aq[4]), "+v"(aq[5]), "+v"(aq[6]), "+v"(aq[7]));
#pragma unroll
                for (int s = 0; s < 8; ++s) acc = __builtin_amdgcn_mfma_f32_16x16x32_bf16(aq[s], *(const LAS bf16x8*)(brow + 32 * (sb + s)), acc, 0, 0, 0); }
#endif
#pragma unroll
            for (int r = 0; r < 4; ++r) part[(kh * 64 + 16 * mt + 4 * fg + r) * 16 + fr] = acc[r]; }
        __syncthreads();
        if (tid < 64) { const int lr = tid; const float mean = rst[2 * lr], rstd = rst[2 * lr + 1]; float p[16]; float mx = -3.0e38f;
#pragma unroll
            for (int e = 0; e < 16; ++e) { p[e] = rstd * ((part[lr * 16 + e] + part[(64 + lr) * 16 + e]) - mean * sgcb[e]) + sgcb[16 + e]; mx = fmaxf(mx, p[e]); }
#pragma unroll
            for (int e = 0; e < 16; ++e) p[e] = __expf(p[e] - mx);
            float gsc[4];
#pragma unroll
            for (int g = 0; g < 4; ++g) { const float a0 = p[4 * g], a1 = p[4 * g + 1], a2 = p[4 * g + 2], a3 = p[4 * g + 3];
                const float hi1 = fmaxf(a0, a1), lo1 = fminf(a0, a1), hi2 = fmaxf(a2, a3), lo2 = fminf(a2, a3);
                gsc[g] = fmaxf(hi1, hi2) + fmaxf(fminf(hi1, hi2), fmaxf(lo1, lo2)); }
            int gsel = 0; float best = gsc[0];
#pragma unroll
            for (int g = 1; g < 4; ++g) if (gsc[g] > best) { best = gsc[g]; gsel = g; }
            float q[4];
#pragma unroll
            for (int j = 0; j < 4; ++j) q[j] = gsel == 0 ? p[j] : (gsel == 1 ? p[4 + j] : (gsel == 2 ? p[8 + j] : p[12 + j]));
            int i0 = 0; float p0 = q[0];
#pragma unroll
            for (int j = 1; j < 4; ++j) if (q[j] > p0) { p0 = q[j]; i0 = j; }
            int i1 = -1; float p1 = -1.f;
#pragma unroll
            for (int j = 0; j < 4; ++j) if (j != i0 && q[j] > p1) { p1 = q[j]; i1 = j; }
            const int e0 = gsel * 4 + i0, e1 = gsel * 4 + i1; const float inv = 1.0f / (p0 + p1);
            rowE[2 * lr] = e0; rowE[2 * lr + 1] = e1; rowG[2 * lr] = p0 * inv; rowG[2 * lr + 1] = p1 * inv;
            rowP[2 * lr] = __hip_atomic_fetch_add(&lcnt[e0], 1, __ATOMIC_RELAXED, __HIP_MEMORY_SCOPE_WORKGROUP); rowP[2 * lr + 1] = __hip_atomic_fetch_add(&lcnt[e1], 1, __ATOMIC_RELAXED, __HIP_MEMORY_SCOPE_WORKGROUP); }
        __syncthreads();
        if (tid < 16) lbase[tid] = (int)__hip_atomic_fetch_add(cnt + tid, (unsigned)lcnt[tid], RLX_AGENT);
        __syncthreads();
        if (tid < 128) { const int e = rowE[tid], pos = lbase[e] + rowP[tid], tok = rb * 64 + (tid >> 1);
            LIST[(size_t)e * LCAP + pos] = tok; TOKSLOT[2 * tok + (tid & 1)] = e * LCAP + pos; GATEW[2 * tok + (tid & 1)] = rowG[tid]; }
        __syncthreads();
    }
#undef PE_LOAD
}
__device__ __forceinline__ void moe_table(const Frame& F0, int layer) {
    PHASE_FRAME(F0);
    LAS int* tab = (LAS int*)(F.lds + AUX_OFF);
    __syncthreads();
    if (F.tid < 16) tab[32 + F.tid] = (int)__hip_atomic_load(F.ctl + CW_CNT + 64 * layer + F.tid, RLX_AGENT);
    __syncthreads();
    if (F.tid == 0) { int blk = 0, nf = 0, nh = 0; for (int e = 0; e < 16; ++e) { const int cn = tab[32 + e]; tab[e] = blk; tab[48 + e] = nf; tab[80 + e] = nh; blk += (cn + 127) >> 7; nf += cn >> 8; nh += ((cn & 255) + 127) >> 7; } tab[16] = blk; tab[64] = nf; tab[96] = nh; }
    __syncthreads();
}
#ifdef Y_F8
typedef unsigned YW_T;
#define YW_ESZ 1
#define YW_SCL (1.0f / Y_F8S)
#define YW_COMBINE(f, P, Q) do { const f32x2 pl_ = __builtin_amdgcn_cvt_pk_f32_fp8((int)(P), false), ph_ = __builtin_amdgcn_cvt_pk_f32_fp8((int)(P), true), ql_ = __builtin_amdgcn_cvt_pk_f32_fp8((int)(Q), false), qh_ = __builtin_amdgcn_cvt_pk_f32_fp8((int)(Q), true); \
        f[0] = w0 * pl_[0] + w1 * ql_[0]; f[1] = w0 * pl_[1] + w1 * ql_[1]; f[2] = w0 * ph_[0] + w1 * qh_[0]; f[3] = w0 * ph_[1] + w1 * qh_[1]; } while (0)
#else
typedef v2u YW_T;
#define YW_ESZ 2
#define YW_SCL 1.0f
#define YW_COMBINE(f, P, Q) do { f[0] = w0 * bflo((P).x) + w1 * bflo((Q).x); f[1] = w0 * bfhi((P).x) + w1 * bfhi((Q).x); f[2] = w0 * bflo((P).y) + w1 * bflo((Q).y); f[3] = w0 * bfhi((P).y) + w1 * bfhi((Q).y); } while (0)
#endif
__device__ __forceinline__ void phase_combine_ln2(const Frame& F0, const Args& a, int layer, int probe = 0, int f8 = 0) {
    PHASE_FRAME(F0);
    unsigned char* ws = OPQ_G(unsigned char, a.ws); const LAS int* tab = (const LAS int*)(F.lds + AUX_OFF);
    const bf16* PRE = (const bf16*)a.out; const float* STATS = (const float*)(ws + WS_STATS); const bf16* Y = (const bf16*)(ws + WS_Y); bf16* X2B = (bf16*)(ws + (probe ? WS_R1 : WS_X2B)); unsigned char* X2F8 = ws + WS_X2F8;
    const int* TOKSLOT = (const int*)(ws + WS_TOKSLOT); const float* GATEW = (const float*)(ws + WS_GATEW);
    LAS float* GV = (LAS float*)F.lds;
    { const float* g1 = a.in[I_LN1G] + (size_t)layer * D; const float* b1 = a.in[I_LN1B] + (size_t)layer * D; const float* g2 = a.in[I_LN2G] + (size_t)layer * D; const float* b2 = a.in[I_LN2B] + (size_t)layer * D;
        for (int i = F.tid; i < D; i += 512) { GV[i] = g1[i]; GV[D + i] = b1[i]; GV[2 * D + i] = g2[i]; GV[3 * D + i] = b2[i]; } }
    __syncthreads();
    const int gw = F.vcu * NWAVES + F.wave, NGW = F.G * NWAVES, nrows = (T - gw + NGW - 1) / NGW, lane = F.lane;
    for (int base = 0; base < nrows; base += 64) {
        const int nr = (nrows - base) < 64 ? (nrows - base) : 64;
        float m_mean = 0.f, m_rstd = 0.f, m_w0 = 0.f, m_w1 = 0.f; int m_y0 = 0, m_y1 = 0;
        if (lane < nr) { const int row = gw + NGW * (base + lane); m_mean = STATS[2 * row]; m_rstd = STATS[2 * row + 1]; m_w0 = GATEW[2 * row]; m_w1 = GATEW[2 * row + 1];
            const int s0 = TOKSLOT[2 * row], s1 = TOKSLOT[2 * row + 1]; m_y0 = tab[s0 / LCAP] * 128 + (s0 % LCAP); m_y1 = tab[s1 / LCAP] * 128 + (s1 % LCAP); }
        v2u XA[8], XB_[8]; YW_T PA[8], QA[8], PB_[8], QB_[8];
#define PH_LOAD(X, P, Q, i) do { const int row_ = gw + NGW * (base + (i)); const size_t y0_ = (size_t)__builtin_amdgcn_readlane(m_y0, (i)), y1_ = (size_t)__builtin_amdgcn_readlane(m_y1, (i)); \
            const GAS v2u* xr_ = (const GAS v2u*)(PRE + (size_t)row_ * D) + lane; const GAS YW_T* ya_ = (const GAS YW_T*)((const GAS unsigned char*)Y + y0_ * D * YW_ESZ) + lane; const GAS YW_T* yb_ = (const GAS YW_T*)((const GAS unsigned char*)Y + y1_ * D * YW_ESZ) + lane; \
            _Pragma("unroll") for (int j = 0; j < 8; ++j) { X[j] = xr_[64 * j]; P[j] = ya_[64 * j]; Q[j] = yb_[64 * j]; } } while (0)
#define PH_ROW(X, P, Q, i) do { const int row_ = gw + NGW * (base + (i)); unsigned gvo_ = (unsigned)(uintptr_t)GV; asm volatile("" : "+v"(gvo_)); const LAS float* GVr = (const LAS float*)(uintptr_t)gvo_;     \
            const float mean = __builtin_bit_cast(float, __builtin_amdgcn_readlane(__builtin_bit_cast(int, m_mean), (i))), rstd = __builtin_bit_cast(float, __builtin_amdgcn_readlane(__builtin_bit_cast(int, m_rstd), (i))); \
            const float w0 = YW_SCL * __builtin_bit_cast(float, __builtin_amdgcn_readlane(__builtin_bit_cast(int, m_w0), (i))), w1 = YW_SCL * __builtin_bit_cast(float, __builtin_amdgcn_readlane(__builtin_bit_cast(int, m_w1), (i))); \
            f32x4 v[8]; float s = 0.f; \
            _Pragma("unroll") for (int j = 0; j < 8; ++j) { const f32x4 gg = *(const LAS f32x4*)(GVr + 256 * j + 4 * lane), bb = *(const LAS f32x4*)(GVr + D + 256 * j + 4 * lane); \
                const f32x4 x1 = ((f32x4){bflo(X[j].x), bfhi(X[j].x), bflo(X[j].y), bfhi(X[j].y)} - mean) * rstd * gg + bb; \
                f32x4 f; YW_COMBINE(f, P[j], Q[j]); \
                v[j] = x1 * ALPHA + f; s += (v[j][0] + v[j][1]) + (v[j][2] + v[j][3]); } \
            const float m2 = wave_sum(s) * (1.f / D); float q = 0.f; \
            _Pragma("unroll") for (int j = 0; j < 8; ++j) { v[j] = v[j] - m2; q += (v[j][0] * v[j][0] + v[j][1] * v[j][1]) + (v[j][2] * v[j][2] + v[j][3] * v[j][3]); } \
            const float r2 = 1.f / sqrtf(wave_sum(q) * (1.f / D) + LN_EPS); \
            GAS v2u* o8 = (GAS v2u*)(X2B + (size_t)row_ * D) + lane; \
            _Pragma("unroll") for (int j = 0; j < 8; ++j) { const f32x4 gg = *(const LAS f32x4*)(GVr + 2 * D + 256 * j + 4 * lane), bb = *(const LAS f32x4*)(GVr + 3 * D + 256 * j + 4 * lane); \
                const f32x4 o = v[j] * r2 * gg + bb; v2u w; w.x = pkbf(o[0], o[1]); w.y = pkbf(o[2], o[3]); o8[64 * j] = w; \
                if (f8) ((GAS unsigned*)((GAS unsigned char*)X2F8 + (size_t)row_ * D) + lane)[64 * j] = pk4_fp8(o[0] * F8_XS, o[1] * F8_XS, o[2] * F8_XS, o[3] * F8_XS); } } while (0)
        PH_LOAD(XA, PA, QA, 0);
#pragma unroll 1
        for (int i = 0; i < nr; i += 2) {
            if (i + 1 < nr) PH_LOAD(XB_, PB_, QB_, i + 1);
            PH_ROW(XA, PA, QA, i);
            if (i + 2 < nr) PH_LOAD(XA, PA, QA, i + 2);
            if (i + 1 < nr) PH_ROW(XB_, PB_, QB_, i + 1);
        }
#undef PH_LOAD
#undef PH_ROW
    }
}

#ifndef MK_N_LAUNCHES
#define MK_N_LAUNCHES 1
#endif
constexpr int NPL = 10;
constexpr int NPHASE = 1 + NPL * DEPTH;
constexpr int N_LAUNCHES = MK_N_LAUNCHES;
static_assert(N_LAUNCHES == 1 || N_LAUNCHES == NPHASE, "MK_N_LAUNCHES is 1 or NPHASE");

#define GRID_BAR() do { if (N_LAUNCHES == 1) xcd_barrier(bar); } while (0)
#ifndef PH_MASK
#define PH_MASK 0x7ff
#endif
#define IN(k) ((((k) == 0 ? 1u : (2u << (((k) - 1) % NPL))) & (unsigned)(PH_MASK)) && lo <= (k) && (k) < hi)
#define SEAM(k) do { if (IN((k) + 1)) GRID_BAR(); } while (0)
#ifndef PROBE_DUP
#define PROBE_DUP 0
#endif
#define REPS(k) ((((k) == 0 ? 1u : (2u << (((k) - 1) % NPL))) & (unsigned)(PROBE_DUP)) ? 2 : 1)

template <int layer> __device__ __forceinline__ void layer_phases(const Frame& F, const Args& args, const XcdBarrier& bar, const int lo, const int hi) {
            const int pb = 1 + NPL * layer;
            unsigned char* ws = OPQ_G(unsigned char, args.ws);
            if (IN(pb + 0)) { for (int rep = 0; rep < REPS(pb + 0); ++rep) { if (rep) GRID_BAR();
                if (FP8_PAL(layer)) {
                    constexpr int LO = FP8_PA_LO(layer), HI = FP8_PA_HIF(layer);
                    if (LO > 0) { SchedDense S; S.init(T, 256 * LO, F.G, (int)blockIdx.x, ws + WS_XB, D, (const bf16*)(ws + WS_WIN) + (size_t)layer * NPROJ * D, D);
                        EpiBf16 E{(bf16*)(ws + WS_PROJ), NPROJ};
                        pg8::gemm_phase<EpiBf16, SchedDense, false>(F.lds + RING_OFF, D, D, D, S, E); }
                    { SchedDense S; S.init(T, 256 * (HI - LO), F.G, (int)blockIdx.x, ws + WS_XBF8, D / 2, ws + WS_WIN8 + (size_t)(DEPTH - 1 - layer) * 12 * MiB, D / 2, LO);
                        EpiBf16 E{(bf16*)(ws + WS_PROJ), NPROJ, F8_INV};
                        pg8::gemm_phase<EpiBf16, SchedDense, false, true>(F.lds + RING_OFF, D / 2, D / 2, D / 2, S, E); }
                    if (HI < 20) { SchedDense S; S.init(T, 256 * (20 - HI), F.G, (int)blockIdx.x, ws + WS_XB, D, (const bf16*)(ws + WS_WIN) + (size_t)layer * NPROJ * D, D, HI);
                        EpiBf16 E{(bf16*)(ws + WS_PROJ), NPROJ};
                        pg8::gemm_phase<EpiBf16, SchedDense, false>(F.lds + RING_OFF, D, D, D, S, E); }
                } else {
                SchedDense S; S.init(T, NPROJ, F.G, (int)blockIdx.x, ws + WS_XB, D, (const bf16*)(ws + WS_WIN) + (size_t)layer * NPROJ * D, D);
                EpiBf16 E{(bf16*)(ws + WS_PROJ), NPROJ};
                pg8::gemm_phase<EpiBf16, SchedDense, false>(F.lds + RING_OFF, D, D, D, S, E);
                }
                } SEAM(pb + 0);
            }
            if (IN(pb + 1)) { for (int rep = 0; rep < REPS(pb + 1); ++rep) { if (rep) GRID_BAR(); phase_dn_prep(F, args, layer); } SEAM(pb + 1); }
            if (IN(pb + 2)) { for (int rep = 0; rep < REPS(pb + 2); ++rep) { if (rep) GRID_BAR();
                if (blockIdx.x < 32 || F.G <= 32) { for (int u = blockIdx.x; u < NB * NH; u += (F.G < 32 ? F.G : 32)) { phase_dn_scan(F, args, layer, u);
#ifdef SCAN_TWICE
                    __syncthreads(); phase_dn_scan(F, args, layer, u);
#endif
                } }
                { const bool big = F.G >= 160; const int NGEMM = big ? 96 : (F.G > 32 ? F.G - 32 : F.G); const int c2 = F.G > 32 ? (int)blockIdx.x - 32 : (int)blockIdx.x;
                  if (c2 >= 0 && c2 < NGEMM) {
                    { int t_ = threadIdx.x; asm volatile("" : "+v"(t_)); Frame Fp = F; Fp.tid = t_; Fp.lane = t_ & 63;
                      for (int L = c2; L < 256; L += NGEMM) pool_diffs_unit(Fp, ws, L >> 2, L & 3);
                      asm volatile("s_waitcnt vmcnt(0)" ::: "memory"); __syncthreads(); }
                    { SchedPool S{NGEMM, c2, (const char*)(ws + WS_POOLD), (const char*)((const bf16*)(ws + WS_WPOOL) + (size_t)layer * 4 * 65536)};
                      EpiPool E{(bf16*)(ws + WS_MIXIN), args.in[I_POOLS] + (size_t)layer * PW, FP8_PDL(layer)};
                      pg8::gemm_phase<EpiPool, SchedPool, false>(F.lds + RING_OFF, 256, PW, 256, S, E); }
                    { SchedDense S; S.init(T, D, NGEMM, c2, (const bf16*)(ws + WS_PB16) + (size_t)layer * T * PLE, PLE, (const bf16*)(ws + WS_WPP) + (size_t)layer * D * PLE, PLE);
                      EpiBf16 E{(bf16*)(ws + WS_PP), D};
                      pg8::gemm_phase<EpiBf16, SchedDense, false>(F.lds + RING_OFF, PLE, PLE, PLE, S, E); } }
#ifndef CONVERT_ALL_IN_PROLOGUE
                  __syncthreads();
                  { int t_ = threadIdx.x; asm volatile("" : "+v"(t_));
                    weight_items(args, ws, (LAS float*)(F.lds + RING_OFF + F.wave * 16384), t_ & 63, 1, layer, 0, 1, F.ctl + CW_CONV + 64 * layer); }
#endif
                }
                } SEAM(pb + 2);
            }
            if (IN(pb + 3)) { for (int rep = 0; rep < REPS(pb + 3); ++rep) { if (rep) GRID_BAR(); phase_dn_norm(F, args, layer); } SEAM(pb + 3); }
            if (IN(pb + 4)) { for (int rep = 0; rep < REPS(pb + 4); ++rep) { if (rep) GRID_BAR();
                if (FP8_PDL(layer)) { SchedDense S; S.init(T, D, F.G, (int)blockIdx.x, ws + WS_MIXIN, D / 2, ws + WS_WOUT + (size_t)layer * D * D * 2, D / 2);
                    EpiRes E{(const bf16*)(ws + WS_XB), (bf16*)args.out, F8_INV};
                    pg8::gemm_phase<EpiRes, SchedDense, false, true>(F.lds + RING_OFF, D / 2, D / 2, D / 2, S, E); }
                else { SchedDense S; S.init(T, D, F.G, (int)blockIdx.x, ws + WS_MIXIN, D, (const bf16*)(ws + WS_WOUT) + (size_t)layer * D * D, D);
                EpiRes E{(const bf16*)(ws + WS_XB), (bf16*)args.out};
#ifdef PROBE_PD
                { EpiRes E2{(const bf16*)(ws + WS_XB), (bf16*)(ws + WS_R1)}; pg8::gemm_phase<EpiRes, SchedDense, false>(F.lds + RING_OFF, D, D, D, S, E2); }
#endif
                pg8::gemm_phase<EpiRes, SchedDense, false>(F.lds + RING_OFF, D, D, D, S, E); }
                } SEAM(pb + 4);
            }
            if (IN(pb + 5)) { for (int rep = 0; rep < REPS(pb + 5); ++rep) { if (rep) GRID_BAR();
#ifdef PROBE_PE
                phase_ln1_router(F, args, layer, 1); __syncthreads();
#endif
                phase_ln1_router(F, args, layer, 0, FP8_LAYER(layer) ? 1 : 0); } SEAM(pb + 5); }
            if (IN(pb + 6)) { for (int rep = 0; rep < REPS(pb + 6); ++rep) { if (rep) GRID_BAR();
                moe_table(F, layer);
                if (FP8_LAYER(layer)) {
                    SchedMoe S{F.G, (int)blockIdx.x, 0, (const LAS int*)(F.lds + AUX_OFF), (const char*)(ws + WS_X1B), (const char*)(ws + WS_WGU + (size_t)layer * NE * 2048 * D * 2), (const int*)(ws + WS_LIST), 1};
                    EpiSwiglu E{(bf16*)(ws + WS_HID), FP8_PG, F8_INV};
                    pg8::gemm_phase<EpiSwiglu, SchedMoe, true, true>(F.lds + RING_OFF, D / 2, D / 2, D / 2, S, E);
                } else {
                    SchedMoe S{F.G, (int)blockIdx.x, 0, (const LAS int*)(F.lds + AUX_OFF), (const char*)(ws + WS_X1B), (const char*)((const bf16*)(ws + WS_WGU) + (size_t)layer * NE * 2048 * D), (const int*)(ws + WS_LIST), 2};
                    EpiSwiglu E{(bf16*)(ws + WS_HID)};
                    pg8::gemm_phase<EpiSwiglu, SchedMoe, true>(F.lds + RING_OFF, D, D, D, S, E);
                }
                } SEAM(pb + 6);
            }
            if (IN(pb + 7)) { for (int rep = 0; rep < REPS(pb + 7); ++rep) { if (rep) GRID_BAR();
                moe_table(F, layer);
                if (FP8_PG && FP8_LAYER(layer)) {
                    SchedMoe S{F.G, (int)blockIdx.x, 1, (const LAS int*)(F.lds + AUX_OFF), (const char*)(ws + WS_HID), (const char*)(ws + WS_WD + (size_t)layer * NE * D * DE * 2), nullptr, 1};
#ifdef Y_F8
                    EpiF8 E{ws + WS_Y, D, F8_INV * Y_F8S};
                    pg8::gemm_phase<EpiF8, SchedMoe, false, true>(F.lds + RING_OFF, DE / 2, DE / 2, DE / 2, S, E);
#else
                    EpiBf16 E{(bf16*)(ws + WS_Y), D, F8_INV};
                    pg8::gemm_phase<EpiBf16, SchedMoe, false, true>(F.lds + RING_OFF, DE / 2, DE / 2, DE / 2, S, E);
#endif
                } else {
                    SchedMoe S{F.G, (int)blockIdx.x, 1, (const LAS int*)(F.lds + AUX_OFF), (const char*)(ws + WS_HID), (const char*)((const bf16*)(ws + WS_WD) + (size_t)layer * NE * D * DE), nullptr, 2};
                    EpiBf16 E{(bf16*)(ws + WS_Y), D};
                    pg8::gemm_phase<EpiBf16, SchedMoe, false>(F.lds + RING_OFF, DE, DE, DE, S, E);
                }
                } SEAM(pb + 7);
            }
            if (IN(pb + 8)) { for (int rep = 0; rep < REPS(pb + 8); ++rep) { if (rep) GRID_BAR(); moe_table(F, layer);
#ifdef PROBE_PH
                phase_combine_ln2(F, args, layer, 1);
#endif
                phase_combine_ln2(F, args, layer, 0, (FP8_PI && (FP8_PI0 || layer == DEPTH - 1)) ? 1 : 0); } SEAM(pb + 8); }
            if (IN(pb + 9)) { for (int rep = 0; rep < REPS(pb + 9); ++rep) { if (rep) GRID_BAR();
                if (FP8_PI && (FP8_PI0 || layer == DEPTH - 1)) {
                    SchedDense S; S.init(T, D, F.G, (int)blockIdx.x, ws + WS_X2F8, D / 2, ws + WS_WPG + (size_t)layer * D * D * 2, D / 2);
                    EpiPle E{(const bf16*)(ws + WS_X2B), (const bf16*)(ws + WS_PP), (bf16*)(ws + WS_XB), args.out, layer + 1 < DEPTH ? 0 : 1, F8_INV, (FP8_PA && layer + 2 == DEPTH) ? ws + WS_XBF8 : nullptr};
                    pg8::gemm_phase<EpiPle, SchedDense, false, true>(F.lds + RING_OFF, D / 2, D / 2, D / 2, S, E);
                } else {
                    SchedDense S; S.init(T, D, F.G, (int)blockIdx.x, ws + WS_X2B, D, (const bf16*)(ws + WS_WPG) + (size_t)layer * D * D, D);
                    EpiPle E{(const bf16*)(ws + WS_X2B), (const bf16*)(ws + WS_PP), (bf16*)(ws + WS_XB), args.out, layer + 1 < DEPTH ? 0 : 1};
                    pg8::gemm_phase<EpiPle, SchedDense, false>(F.lds + RING_OFF, D, D, D, S, E);
                }
                } SEAM(pb + 9);
            }
}
__global__ void __launch_bounds__(NWAVES * 64, 2) trunk_fwd(Args args) {
    extern __shared__ __attribute__((aligned(16))) unsigned char lds[];
    Frame F;
    F.lds = (LAS unsigned char*)lds;
    F.MISC = (volatile LAS unsigned*)(F.lds + MISC_OFF);
    F.tid = threadIdx.x; F.lane = F.tid & 63; F.wave = __builtin_amdgcn_readfirstlane(F.tid >> 6);
    F.G = gridDim.x; { const int bx = blockIdx.x; F.vcu = (F.G % 8 == 0) ? (bx % 8) * (F.G / 8) + bx / 8 : bx; }
    unsigned char* ws = args.ws;
    F.ctl = (gu32*)(ws + WS_CTL);
    for (int u = F.tid; u < (LDS_BYTES - LDSCTL_OFF) / 4; u += NWAVES * 64) ((LAS unsigned*)(F.lds + LDSCTL_OFF))[u] = 0u;
    __syncthreads();
    XcdBarrier bar; bar.bar = (unsigned*)(F.ctl + CW_BAR); bar.x = 0; bar.st = nullptr;
    if (N_LAUNCHES == 1) bar = xcd_barrier_post((unsigned*)(F.ctl + CW_BAR), F.MISC + 8);
    const int lo = args.ph_lo, hi = args.ph_hi;
    if (IN(0)) { for (int rep = 0; rep < REPS(0); ++rep) { if (rep) GRID_BAR(); p0_prologue(F, args); } SEAM(0); }

    layer_phases<0>(F, args, bar, lo, hi);
    layer_phases<1>(F, args, bar, lo, hi);
    static_assert(DEPTH == 2, "layer_phases instantiations");
#undef IN
#undef SEAM
#undef GRID_BAR
}

extern "C" void kernel_launch(void* const* d_in, const int* in_sizes, int n_in, void* d_out, int out_size, void* d_ws, size_t ws_size, hipStream_t stream) {
    static int grid = 0;
    if (grid == 0) {
        if (n_in != 21 || in_sizes[0] != T * D || out_size != T * D || ws_size < WS_END) { fprintf(stderr, "kernel_launch: unexpected shapes (n_in %d, in0 %d, out %d, ws %zu); nothing launched\n", n_in, n_in > 0 ? in_sizes[0] : -1, out_size, ws_size); grid = -1; return; }
        int dev = 0, cus = 0, per_cu = 0;
        if (hipGetDevice(&dev) != hipSuccess || hipDeviceGetAttribute(&cus, hipDeviceAttributeMultiprocessorCount, dev) != hipSuccess) { grid = -1; return; }
        if (hipFuncSetAttribute((const void*)trunk_fwd, hipFuncAttributeMaxDynamicSharedMemorySize, LDS_BYTES) != hipSuccess) { fprintf(stderr, "kernel_launch: hipFuncSetAttribute failed\n"); grid = -1; return; }
        if (hipOccupancyMaxActiveBlocksPerMultiprocessor(&per_cu, (const void*)trunk_fwd, NWAVES * 64, LDS_BYTES) != hipSuccess || per_cu < 1) { fprintf(stderr, "kernel_launch: occupancy query reports %d workgroups per CU\n", per_cu); }
        (void)hipGetLastError();
        grid = cus;
    }
    if (grid < 0) return;
    if (hipMemsetAsync((char*)d_ws + WS_CTL, 0, CTL_ZERO_BYTES, stream) != hipSuccess) return;
    Args a{};
    for (int i = 0; i < 21; ++i) a.in[i] = (const float*)d_in[i];
    a.out = (float*)d_out; a.ws = (unsigned char*)d_ws;
    for (int li = 0; li < N_LAUNCHES; ++li) {
        a.ph_lo = (N_LAUNCHES == 1) ? 0 : li; a.ph_hi = (N_LAUNCHES == 1) ? NPHASE : li + 1; a.li = li; a.pad = 0;
        hipLaunchKernelGGL(trunk_fwd, dim3(grid), dim3(NWAVES * 64), LDS_BYTES, stream, a);
        const hipError_t le = hipPeekAtLastError();
        if (le != hipSuccess) { fprintf(stderr, "kernel_launch: launch %d failed: %s\n", li, hipGetErrorName(le)); break; }
    }
}
```
